# Optimizing an MI355X kernel written in HIP

```python
import jax
import jax.numpy as jnp
from jax import lax
import numpy as np

D_MODEL = 1024
BATCH = 16
SEQ = 2048
DEPTH = 1

GRID_W = 64
CTX_LEN = 256
EPS = 1e-6
N_MOD = 6

MLA_V = 128
MLA_HEADS = D_MODEL // MLA_V
MLA_NOPE = 128
MLA_ROPE = 64
MLA_QK = MLA_NOPE + MLA_ROPE
MLA_Q_RANK = 3 * D_MODEL // 4
MLA_KV_RANK = D_MODEL // 4
MLA_WIDTH = MLA_HEADS * MLA_V
ROPE_BASE = 10000.0
Q_BLOCK = 128

HG_DK = 128
HG_HEADS = D_MODEL // HG_DK
HG_DV = D_MODEL // HG_HEADS
HG_FDIM = HG_HEADS * HG_DK
HG_WIDTH = HG_HEADS * HG_DV
HG_CHUNK = 64

N_EXPERTS = 32
TOP_K = 4
D_EXPERT = D_MODEL
SWIGLU_LIMIT = 7.0
SWIGLU_ALPHA = 1.702
MOE_BLOCK = 128

IN_SPLITS = (MLA_Q_RANK, MLA_KV_RANK + MLA_ROPE, HG_FDIM, HG_FDIM, HG_FDIM, HG_WIDTH, HG_WIDTH, D_MODEL, D_MODEL)
D_IN = MLA_Q_RANK + MLA_KV_RANK + MLA_ROPE + 3 * HG_FDIM + 2 * HG_WIDTH + 2 * D_MODEL

kernel_name = 'hybrid_mla_hgrn2_moe_diffusion_block'


def rmsnorm(x, g):
    xf = x.astype(jnp.float32)
    y = xf * lax.rsqrt(jnp.mean(xf * xf, axis=-1, keepdims=True) + EPS)
    return (y * g.astype(jnp.float32)).astype(x.dtype)


def split_cols(p):
    return jnp.split(p, np.cumsum(IN_SPLITS)[:-1].tolist(), axis=-1)


def axial_rope_tables(rows):
    row = jnp.repeat(jnp.arange(rows), GRID_W).astype(jnp.float32)
    col = jnp.tile(jnp.arange(GRID_W), rows).astype(jnp.float32)
    n_freq = MLA_ROPE // 4
    inv = ROPE_BASE ** (-jnp.arange(n_freq, dtype=jnp.float32) / n_freq)
    ang = jnp.concatenate([row[:, None] * inv, col[:, None] * inv], axis=-1)
    return jnp.cos(ang), jnp.sin(ang)


def apply_rope(x, cos, sin):
    half = MLA_ROPE // 2
    x1 = x[..., :half].astype(jnp.float32)
    x2 = x[..., half:].astype(jnp.float32)
    return jnp.concatenate([x1 * cos - x2 * sin, x1 * sin + x2 * cos], axis=-1).astype(x.dtype)


def mla_queries(q_in, q_norm_g, w_q_b, cos, sin):
    b, n, _ = q_in.shape
    q = (rmsnorm(q_in, q_norm_g) @ w_q_b).reshape(b, n, MLA_HEADS, MLA_QK)
    q_nope, q_rope = q[..., :MLA_NOPE], q[..., MLA_NOPE:]
    if cos is not None:
        q_rope = apply_rope(q_rope, cos[:, None, :], sin[:, None, :])
    return jnp.concatenate([q_nope, q_rope], axis=-1)


def mla_keys_values(kv_in, kv_norm_g, w_kv_b, cos, sin):
    b, n, _ = kv_in.shape
    c_kv, k_rope = kv_in[..., :MLA_KV_RANK], kv_in[..., MLA_KV_RANK:]
    kv = (rmsnorm(c_kv, kv_norm_g) @ w_kv_b).reshape(b, n, MLA_HEADS, MLA_NOPE + MLA_V)
    k_nope, v = kv[..., :MLA_NOPE], kv[..., MLA_NOPE:]
    if cos is not None:
        k_rope = apply_rope(k_rope, cos, sin)
    k_rope = jnp.broadcast_to(k_rope[:, :, None, :], (b, n, MLA_HEADS, MLA_ROPE))
    return jnp.concatenate([k_nope, k_rope], axis=-1), v


def block_attention(q, k, v):
    b, n, h, dk = q.shape
    nb = n // Q_BLOCK
    scale = dk ** -0.5
    q_blocks = q.reshape(b, nb, Q_BLOCK, h, dk).transpose(1, 0, 2, 3, 4)

    def one_block(qb):
        s = jnp.einsum('bqhd,bkhd->bhqk', qb, k, preferred_element_type=jnp.float32) * scale
        p = jax.nn.softmax(s, axis=-1).astype(v.dtype)
        return jnp.einsum('bhqk,bkhd->bqhd', p, v)

    out = lax.map(one_block, q_blocks)
    return out.transpose(1, 0, 2, 3, 4).reshape(b, n, h * v.shape[-1])


def hgrn2_chunk_scan(q, k, v, log_f, s0):
    b, n, h, dk = q.shape
    dv = v.shape[-1]
    nc = n // HG_CHUNK

    def chunks(a):
        return a.reshape(b, nc, HG_CHUNK, h, a.shape[-1]).transpose(1, 0, 3, 2, 4)

    lower_tri = jnp.tril(jnp.ones((HG_CHUNK, HG_CHUNK), dtype=bool))[:, :, None]

    def step(state, inp):
        qc, kc, vc, gc = inp
        cum = jnp.cumsum(gc, axis=2)
        o_inter = jnp.einsum('bhtk,bhkv->bhtv', qc * jnp.exp(cum), state)
        rel = cum[:, :, :, None, :] - cum[:, :, None, :, :]
        decay = jnp.where(lower_tri, jnp.exp(jnp.minimum(rel, 0.0)), 0.0)
        att = jnp.einsum('bhtk,bhtsk,bhsk->bhts', qc, decay, kc)
        o_intra = jnp.einsum('bhts,bhsv->bhtv', att, vc)
        last = cum[:, :, -1:, :]
        state = jnp.exp(last[:, :, 0, :])[..., None] * state + jnp.einsum('bhsk,bhsv->bhkv', kc * jnp.exp(last - cum), vc)
        return state, o_inter + o_intra

    s_final, o = lax.scan(step, s0, (chunks(q), chunks(k), chunks(v), chunks(log_f)))
    return o.transpose(1, 0, 3, 2, 4).reshape(b, n, h, dv), s_final


def hgrn2_gates(z, lb):
    b, n = z.shape[:2]
    f = lb + (1.0 - lb) * jax.nn.sigmoid(z.astype(jnp.float32))
    return (1.0 - f).reshape(b, n, HG_HEADS, HG_DK), jnp.log(f).reshape(b, n, HG_HEADS, HG_DK)


def hgrn2_qv(p):
    b, n = p[2].shape[:2]
    q = (jax.nn.silu(p[2].astype(jnp.float32)) * HG_DK ** -0.5).reshape(b, n, HG_HEADS, HG_DK)
    v = p[5].astype(jnp.float32).reshape(b, n, HG_HEADS, HG_DV)
    return q, v


def hgrn2_readout(o, g, hg_norm_g):
    b, n = g.shape[:2]
    gate = jax.nn.silu(g.astype(jnp.float32)).reshape(b, n, HG_HEADS, HG_DV)
    return (rmsnorm(o, hg_norm_g) * gate).reshape(b, n, HG_WIDTH).astype(g.dtype)


def merge_branches(p, y_mla, y_hg, w_out):
    g_mla = jax.nn.sigmoid(p[7].astype(jnp.float32))
    g_hg = jax.nn.sigmoid(p[8].astype(jnp.float32))
    y = g_mla * y_mla.astype(jnp.float32) + g_hg * y_hg.astype(jnp.float32)
    return y.astype(p[7].dtype) @ w_out


def token_mixer(h_lat, h_ctx, cos, sin, lb_fwd, lb_bwd, w_in, q_norm_g, w_q_b, kv_norm_g, w_kv_b, hg_norm_g, w_out, with_ctx_out):
    lat = split_cols(h_lat @ w_in)
    ctx = split_cols(h_ctx @ w_in)
    k_lat, v_lat = mla_keys_values(lat[1], kv_norm_g, w_kv_b, cos, sin)
    k_ctx, v_ctx = mla_keys_values(ctx[1], kv_norm_g, w_kv_b, None, None)
    q_lat = mla_queries(lat[0], q_norm_g, w_q_b, cos, sin)
    y_mla_lat = block_attention(q_lat, jnp.concatenate([k_lat, k_ctx], axis=1), jnp.concatenate([v_lat, v_ctx], axis=1))
    q_l, v_l = hgrn2_qv(lat)
    q_c, v_c = hgrn2_qv(ctx)
    kf_l, gf_l = hgrn2_gates(lat[3], lb_fwd)
    kb_l, gb_l = hgrn2_gates(lat[4], lb_bwd)
    kf_c, gf_c = hgrn2_gates(ctx[3], lb_fwd)
    kb_c, gb_c = hgrn2_gates(ctx[4], lb_bwd)
    b = h_lat.shape[0]
    s0 = jnp.zeros((b, HG_HEADS, HG_DK, HG_DV), jnp.float32)
    flip = lambda a: jnp.flip(a, axis=1)
    o_cf, s_cf = hgrn2_chunk_scan(q_c, kf_c, v_c, gf_c, s0)
    o_cb, s_cb = hgrn2_chunk_scan(flip(q_c), flip(kb_c), flip(v_c), flip(gb_c), s0)
    o_lf, _ = hgrn2_chunk_scan(q_l, kf_l, v_l, gf_l, s_cf)
    o_lb, _ = hgrn2_chunk_scan(flip(q_l), flip(kb_l), flip(v_l), flip(gb_l), s_cb)
    y_hg_lat = hgrn2_readout(o_lf + flip(o_lb), lat[6], hg_norm_g)
    out_lat = merge_branches(lat, y_mla_lat, y_hg_lat, w_out)
    if not with_ctx_out:
        return out_lat, None
    q_ctx = mla_queries(ctx[0], q_norm_g, w_q_b, None, None)
    y_mla_ctx = block_attention(q_ctx, k_ctx, v_ctx)
    y_hg_ctx = hgrn2_readout(o_cf + flip(o_cb), ctx[6], hg_norm_g)
    return out_lat, merge_branches(ctx, y_mla_ctx, y_hg_ctx, w_out)


def moe_ffn(h, w_router, b_router, w_gate_up, b_gate_up, w_down, b_down):
    shp = h.shape
    t = h.reshape(-1, shp[-1])
    n_tok = t.shape[0]
    n_pair = n_tok * TOP_K
    logits = (t @ w_router + b_router).astype(jnp.float32)
    top_val, top_idx = lax.top_k(logits, TOP_K)
    probs = jax.nn.softmax(top_val, axis=-1)
    flat_e = top_idx.reshape(-1)
    flat_tok = jnp.arange(n_pair, dtype=jnp.int32) // TOP_K
    order = jnp.argsort(flat_e)
    sorted_e = flat_e[order]
    counts = jnp.bincount(flat_e, length=N_EXPERTS)
    padded = (counts + MOE_BLOCK - 1) // MOE_BLOCK * MOE_BLOCK
    start = jnp.cumsum(counts) - counts
    pad_end = jnp.cumsum(padded)
    pad_start = pad_end - padded
    dest_sorted = pad_start[sorted_e] + jnp.arange(n_pair, dtype=jnp.int32) - start[sorted_e]
    dest = jnp.zeros((n_pair,), jnp.int32).at[order].set(dest_sorted.astype(jnp.int32))
    n_rows = n_pair + N_EXPERTS * MOE_BLOCK
    n_blocks = n_rows // MOE_BLOCK
    row_tok = jnp.full((n_rows,), n_tok, jnp.int32).at[dest].set(flat_tok)
    t_ext = jnp.concatenate([t, jnp.zeros((1, t.shape[-1]), t.dtype)], axis=0)
    x_rows = t_ext[row_tok].reshape(n_blocks, MOE_BLOCK, -1)
    block_start = jnp.arange(n_blocks, dtype=jnp.int32) * MOE_BLOCK
    block_e = jnp.minimum(jnp.searchsorted(pad_end, block_start, side='right'), N_EXPERTS - 1)

    def expert_block(args):
        xb, e = args
        gu = xb @ w_gate_up[e] + b_gate_up[e]
        x_glu = jnp.minimum(gu[:, 0::2], SWIGLU_LIMIT)
        x_lin = jnp.clip(gu[:, 1::2], -SWIGLU_LIMIT, SWIGLU_LIMIT)
        act = x_glu * jax.nn.sigmoid(SWIGLU_ALPHA * x_glu) * (x_lin + 1)
        return act @ w_down[e] + b_down[e]

    y_rows = lax.map(expert_block, (x_rows, block_e)).reshape(n_rows, -1)
    y_pairs = y_rows[dest].reshape(n_tok, TOP_K, -1)
    out = jnp.einsum('tk,tkd->td', probs.astype(y_pairs.dtype), y_pairs)
    return out.reshape(shp)


def setup_inputs(seed: int = 0) -> dict:
    key = jax.random.key(seed)
    ks = jax.random.split(key, 24)
    f32 = jnp.float32
    nrm = lambda k, shape, scale: jax.random.normal(k, shape, f32) * scale
    gain = lambda k, shape: 1.0 + 0.02 * jax.random.normal(k, shape, f32)
    return {
        'x': nrm(ks[0], (BATCH, SEQ, D_MODEL), 1.0),
        'c': nrm(ks[1], (BATCH, D_MODEL), 1.0),
        'ctx': nrm(ks[2], (BATCH, CTX_LEN, D_MODEL), 1.0),
        'c_ctx': nrm(ks[3], (D_MODEL,), 1.0),
        'w_mod': nrm(ks[4], (DEPTH, D_MODEL, N_MOD * D_MODEL), 0.5 * D_MODEL ** -0.5),
        'b_mod': nrm(ks[5], (DEPTH, N_MOD * D_MODEL), 0.02),
        'norm_mix_g': gain(ks[6], (DEPTH, D_MODEL)),
        'w_in': nrm(ks[7], (DEPTH, D_MODEL, D_IN), D_MODEL ** -0.5),
        'mla_q_norm_g': gain(ks[8], (DEPTH, MLA_Q_RANK)),
        'w_q_b': nrm(ks[9], (DEPTH, MLA_Q_RANK, MLA_HEADS * MLA_QK), MLA_Q_RANK ** -0.5),
        'mla_kv_norm_g': gain(ks[10], (DEPTH, MLA_KV_RANK)),
        'w_kv_b': nrm(ks[11], (DEPTH, MLA_KV_RANK, MLA_HEADS * (MLA_NOPE + MLA_V)), MLA_KV_RANK ** -0.5),
        'hg_lb_logits': nrm(ks[12], (2, DEPTH + 1, HG_FDIM), 1.0),
        'hg_norm_g': gain(ks[13], (DEPTH, HG_DV)),
        'w_out': nrm(ks[14], (DEPTH, D_MODEL, D_MODEL), D_MODEL ** -0.5),
        'norm_ffn_g': gain(ks[15], (DEPTH, D_MODEL)),
        'w_router': nrm(ks[16], (DEPTH, D_MODEL, N_EXPERTS), D_MODEL ** -0.5),
        'b_router': nrm(ks[17], (DEPTH, N_EXPERTS), 0.01),
        'w_gate_up': nrm(ks[18], (DEPTH, N_EXPERTS, D_MODEL, 2 * D_EXPERT), D_MODEL ** -0.5),
        'b_gate_up': nrm(ks[19], (DEPTH, N_EXPERTS, 2 * D_EXPERT), 0.01),
        'w_down': nrm(ks[20], (DEPTH, N_EXPERTS, D_EXPERT, D_MODEL), D_EXPERT ** -0.5),
        'b_down': nrm(ks[21], (DEPTH, N_EXPERTS, D_MODEL), 0.01),
        'final_norm_g': gain(ks[22], (D_MODEL,)),
    }


def reference(x, c, ctx, c_ctx, w_mod, b_mod, norm_mix_g, w_in, mla_q_norm_g, w_q_b, mla_kv_norm_g, w_kv_b, hg_lb_logits, hg_norm_g, w_out, norm_ffn_g, w_router, b_router, w_gate_up, b_gate_up, w_down, b_down, final_norm_g):
    rows = x.shape[1] // GRID_W
    cos, sin = axial_rope_tables(rows)
    lb = jnp.cumsum(jax.nn.softmax(hg_lb_logits.astype(jnp.float32), axis=1), axis=1)
    silu_c = jax.nn.silu(c)
    silu_cc = jax.nn.silu(c_ctx)
    n_ctx = ctx.shape[1]
    for l in range(DEPTH):
        last = l == DEPTH - 1
        mod_lat = jnp.split((silu_c @ w_mod[l] + b_mod[l])[:, None, :], N_MOD, axis=-1)
        mod_ctx = jnp.split((silu_cc @ w_mod[l] + b_mod[l])[None, None, :], N_MOD, axis=-1)
        h_lat = rmsnorm(x, norm_mix_g[l]) * (1 + mod_lat[1]) + mod_lat[0]
        h_ctx = rmsnorm(ctx, norm_mix_g[l]) * (1 + mod_ctx[1]) + mod_ctx[0]
        mix_lat, mix_ctx = token_mixer(h_lat, h_ctx, cos, sin, lb[0, l], lb[1, l], w_in[l], mla_q_norm_g[l], w_q_b[l], mla_kv_norm_g[l], w_kv_b[l], hg_norm_g[l], w_out[l], not last)
        x = x + mod_lat[2] * mix_lat
        h_lat = rmsnorm(x, norm_ffn_g[l]) * (1 + mod_lat[4]) + mod_lat[3]
        if last:
            x = x + mod_lat[5] * moe_ffn(h_lat, w_router[l], b_router[l], w_gate_up[l], b_gate_up[l], w_down[l], b_down[l])
        else:
            ctx = ctx + mod_ctx[2] * mix_ctx
            h_ctx = rmsnorm(ctx, norm_ffn_g[l]) * (1 + mod_ctx[4]) + mod_ctx[3]
            y = moe_ffn(jnp.concatenate([h_ctx, h_lat], axis=1), w_router[l], b_router[l], w_gate_up[l], b_gate_up[l], w_down[l], b_down[l])
            ctx = ctx + mod_ctx[5] * y[:, :n_ctx]
            x = x + mod_lat[5] * y[:, n_ctx:]
    return rmsnorm(x, final_norm_g)
```

```cpp
#include <hip/hip_runtime.h>
#include <stdint.h>

typedef unsigned short bf16_t;
__device__ __forceinline__ float bf2f(bf16_t v) { return __uint_as_float(((unsigned)v) << 16); }
__device__ __forceinline__ bf16_t f2bf(float f) { unsigned u = __float_as_uint(f); u += 0x7FFFu + ((u >> 16) & 1u); return (bf16_t)(u >> 16); }
__device__ __forceinline__ float sigmoidf_(float x) { return 1.0f / (1.0f + __expf(-x)); }
__device__ __forceinline__ float siluf_(float x) { return x / (1.0f + __expf(-x)); }

constexpr int D = 1024, NB = 16, SEQ = 2048, CTXL = 256;
constexpr int L = NB * SEQ;
constexpr int RC = NB * CTXL;
constexpr int R = L + RC;
constexpr int NKEY = SEQ + CTXL;
constexpr float EPS = 1e-6f;
constexpr int NE = 32, CAP = 32768;
constexpr int MAXROWS = 131072 + NE * 256;

constexpr size_t MiB = 1048576;
constexpr size_t OFF_SMALL = 0;
constexpr size_t OFF_CNT = 0;
constexpr size_t OFF_OFFS = 1024;
constexpr size_t OFF_TILEE = 2048;
constexpr size_t OFF_LB = 8192;
constexpr size_t OFF_MOD = 16384;
constexpr size_t OFF_SSQQ = 512 * 1024;
constexpr size_t OFF_SSQKV = 768 * 1024;
constexpr size_t OFF_TOPI = 1 * MiB;
constexpr size_t OFF_TOPP = 1 * MiB + 512 * 1024;
constexpr size_t OFF_ROWPAIR = 2 * MiB;
constexpr size_t OFF_LIST = 3 * MiB;
constexpr size_t OFF_H = 32 * MiB;
constexpr size_t OFF_QA = 104 * MiB;
constexpr size_t OFF_CKV = 152 * MiB;
constexpr size_t OFF_KR = 170 * MiB;
constexpr size_t OFF_OF = 104 * MiB;
constexpr size_t OFF_HQ = 175 * MiB;
constexpr size_t OFF_FF = 239 * MiB;
constexpr size_t OFF_FB = 311 * MiB;
constexpr size_t OFF_IV = 383 * MiB;
constexpr size_t OFF_OG = 455 * MiB;
constexpr size_t OFF_GM = 519 * MiB;
constexpr size_t OFF_GH = 583 * MiB;
constexpr size_t OFF_Q = 647 * MiB;
constexpr size_t OFF_K = 743 * MiB;
constexpr size_t OFF_V = 851 * MiB;
constexpr size_t OFF_OB = 923 * MiB;
constexpr size_t OFF_YP = 296 * MiB;
constexpr size_t OFF_ACT = 568 * MiB;

struct SegOut { bf16_t *qa, *ckv, *kr, *hq, *ff, *fb, *iv, *og, *gm, *gh; };

__global__ void k_init(const float* __restrict__ lbl, float* lb, int* cnt) {
    int i = blockIdx.x * blockDim.x + threadIdx.x;
    if (i < 2048) { int d = i >> 10, j = i & 1023; float a = lbl[(d * 2 + 0) * 1024 + j], b = lbl[(d * 2 + 1) * 1024 + j]; lb[i] = 1.0f / (1.0f + __expf(b - a)); }
    if (i < 32) cnt[i] = 0;
}

__global__ __launch_bounds__(256) void k_mod(const float* __restrict__ c, const float* __restrict__ cctx, const float* __restrict__ wmod, const float* __restrict__ bmod, float* modv) {
    __shared__ float s[1024];
    int r = blockIdx.y; const float* src = r < 16 ? c + r * 1024 : cctx;
    for (int k = threadIdx.x; k < 1024; k += 256) s[k] = siluf_(src[k]);
    __syncthreads();
    int j = blockIdx.x * 256 + threadIdx.x; float acc = 0.f;
    for (int k = 0; k < 1024; ++k) acc += s[k] * wmod[(size_t)k * 6144 + j];
    modv[r * 6144 + j] = acc + bmod[j];
}

__device__ __forceinline__ float block_sum256(float v, float* red) {
    for (int o = 32; o > 0; o >>= 1) v += __shfl_xor(v, o);
    int w = threadIdx.x >> 6; if ((threadIdx.x & 63) == 0) red[w] = v; __syncthreads();
    float t = red[0] + red[1] + red[2] + red[3]; __syncthreads(); return t;
}

__global__ __launch_bounds__(256) void k_norm1(const float* __restrict__ x, const float* __restrict__ ctx, const float* __restrict__ g, const float* __restrict__ modv, bf16_t* h) {
    __shared__ float red[4];
    int row = blockIdx.x; const float* src = row < L ? x + (size_t)row * D : ctx + (size_t)(row - L) * D;
    const float* mod = modv + (row < L ? row / SEQ : 16) * 6144;
    int c = threadIdx.x * 4; float4 v = *(const float4*)(src + c);
    float ss = block_sum256(v.x * v.x + v.y * v.y + v.z * v.z + v.w * v.w, red);
    float rs = rsqrtf(ss * (1.0f / D) + EPS);
    float o[4] = {v.x, v.y, v.z, v.w}; ushort4 w; bf16_t* wp = (bf16_t*)&w;
    for (int i = 0; i < 4; ++i) wp[i] = f2bf(o[i] * rs * g[c + i] * (1.0f + mod[1024 + c + i]) + mod[c + i]);
    *(ushort4*)(h + (size_t)row * D + c) = w;
}

__global__ __launch_bounds__(256) void k_rowssq(const bf16_t* __restrict__ buf, int width, int nrows, float* ssq) {
    int row = blockIdx.x * 4 + (threadIdx.x >> 6), lane = threadIdx.x & 63; if (row >= nrows) return;
    float s = 0.f; for (int k = lane; k < width; k += 64) { float v = bf2f(buf[(size_t)row * width + k]); s += v * v; }
    for (int o = 32; o > 0; o >>= 1) s += __shfl_xor(s, o);
    if (lane == 0) ssq[row] = s;
}

__device__ __forceinline__ void rope_cs(int t, int i, float& cs, float& sn) {
    int j = i & 15; float inv = __expf(-(float)j * (9.210340371976184f / 16.0f)); float pos = (i < 16) ? (float)(t >> 6) : (float)(t & 63);
    float ang = pos * inv; cs = cosf(ang); sn = sinf(ang);
}

__global__ __launch_bounds__(256) void k_krope(const bf16_t* __restrict__ kr, bf16_t* Kb) {
    int gid = blockIdx.x * 256 + threadIdx.x; int row = gid >> 5, i = gid & 31; if (row >= R) return;
    float x1 = bf2f(kr[(size_t)row * 64 + i]), x2 = bf2f(kr[(size_t)row * 64 + 32 + i]); float o1 = x1, o2 = x2; int b, pos;
    if (row < L) { b = row / SEQ; pos = row % SEQ; float cs, sn; rope_cs(pos, i, cs, sn); o1 = x1 * cs - x2 * sn; o2 = x1 * sn + x2 * cs; }
    else { b = (row - L) / CTXL; pos = SEQ + (row - L) % CTXL; }
    bf16_t w1 = f2bf(o1), w2 = f2bf(o2);
    for (int h = 0; h < 8; ++h) { bf16_t* p = Kb + ((size_t)(b * 8 + h) * NKEY + pos) * 192 + 128; p[i] = w1; p[32 + i] = w2; }
}

template <class AL, class EP>
__global__ __launch_bounds__(256) void k_ngemm(int K, const float* __restrict__ W, int ldw, size_t wzstride, AL al, EP ep) {
    __shared__ float As[16][68]; __shared__ float Bs[16][64];
    const int z = blockIdx.z, row0 = blockIdx.y * 64, col0 = blockIdx.x * 64, tid = threadIdx.x;
    const int mvalid = al.rows(z); if (row0 >= mvalid) return;
    const float* Wz = W + (size_t)z * wzstride;
    const int ar = tid >> 2, ak = (tid & 3) * 4; const bf16_t* arow = (row0 + ar < mvalid) ? al.rowptr(z, row0 + ar) : nullptr;
    const int bk = tid >> 4, bn = (tid & 15) * 4;
    const int ty = tid >> 4, tx = tid & 15;
    float acc[4][4] = {};
    for (int k0 = 0; k0 < K; k0 += 16) {
        float a4[4] = {0.f, 0.f, 0.f, 0.f};
        if (arow) { ushort4 u = *(const ushort4*)(arow + k0 + ak); const bf16_t* up = (const bf16_t*)&u; for (int i = 0; i < 4; ++i) a4[i] = bf2f(up[i]) * al.kscale(k0 + ak + i); }
        float4 b4 = *(const float4*)(Wz + (size_t)(k0 + bk) * ldw + col0 + bn);
        __syncthreads();
        for (int i = 0; i < 4; ++i) As[ak + i][ar] = a4[i];
        *(float4*)&Bs[bk][bn] = b4;
        __syncthreads();
#pragma unroll
        for (int kk = 0; kk < 16; ++kk) {
            float4 av = *(const float4*)&As[kk][ty * 4]; float4 bv = *(const float4*)&Bs[kk][tx * 4];
            float a[4] = {av.x, av.y, av.z, av.w}, b[4] = {bv.x, bv.y, bv.z, bv.w};
#pragma unroll
            for (int i = 0; i < 4; ++i)
#pragma unroll
                for (int j = 0; j < 4; ++j) acc[i][j] += a[i] * b[j];
        }
    }
    for (int i = 0; i < 4; ++i) { int row = row0 + ty * 4 + i; if (row < mvalid) ep.store(z, row, col0 + tx * 4, acc[i]); }
}

__device__ __forceinline__ void st4bf(bf16_t* dst, const float* v) { ushort4 w; bf16_t* wp = (bf16_t*)&w; for (int i = 0; i < 4; ++i) wp[i] = f2bf(v[i]); *(ushort4*)dst = w; }

struct ALDense { const bf16_t* A; int lda; int nrows; const float* ks;
    __device__ int rows(int) const { return nrows; }
    __device__ const bf16_t* rowptr(int, int row) const { return A + (size_t)row * lda; }
    __device__ float kscale(int k) const { return ks ? ks[k] : 1.0f; } };

struct EpiInN { SegOut s;
    __device__ void store(int, int row, int col, const float* v) const {
        bf16_t* dst;
        if (col < 768) { if (row >= L) return; dst = s.qa + (size_t)row * 768 + col; }
        else if (col < 1024) dst = s.ckv + (size_t)row * 256 + (col - 768);
        else if (col < 1088) dst = s.kr + (size_t)row * 64 + (col - 1024);
        else { int c = col - 1088, seg = c >> 10, cc = c & 1023; bool latonly = (seg == 0 || seg >= 4); if (latonly && row >= L) return;
            bf16_t* base = seg == 0 ? s.hq : seg == 1 ? s.ff : seg == 2 ? s.fb : seg == 3 ? s.iv : seg == 4 ? s.og : seg == 5 ? s.gm : s.gh;
            dst = base + (size_t)row * 1024 + cc; }
        st4bf(dst, v);
    } };

struct EpiQN { bf16_t* q; const float* ssq;
    __device__ void store(int, int row, int col, const float* v) const { float rs = rsqrtf(ssq[row] * (1.0f / 768.0f) + EPS); float o[4]; for (int i = 0; i < 4; ++i) o[i] = v[i] * rs; st4bf(q + (size_t)row * 1536 + col, o); } };

struct EpiKVN { bf16_t *Kb, *Vb; const float* ssq;
    __device__ void store(int, int row, int col, const float* v) const {
        float rs = rsqrtf(ssq[row] * (1.0f / 256.0f) + EPS); float o[4]; for (int i = 0; i < 4; ++i) o[i] = v[i] * rs;
        int b, pos; if (row < L) { b = row / SEQ; pos = row % SEQ; } else { b = (row - L) / CTXL; pos = SEQ + (row - L) % CTXL; }
        int h = col >> 8, w = col & 255; size_t kvrow = (size_t)(b * 8 + h) * NKEY + pos;
        if (w < 128) st4bf(Kb + kvrow * 192 + w, o); else st4bf(Vb + kvrow * 128 + (w - 128), o);
    } };

struct EpiOutN { float* x1; const float* x; const float* modv;
    __device__ void store(int, int row, int col, const float* v) const {
        const float* gate = modv + (row / SEQ) * 6144 + 2 * 1024; float4 xv = *(const float4*)(x + (size_t)row * D + col);
        float4 o; o.x = xv.x + gate[col] * v[0]; o.y = xv.y + gate[col + 1] * v[1]; o.z = xv.z + gate[col + 2] * v[2]; o.w = xv.w + gate[col + 3] * v[3];
        *(float4*)(x1 + (size_t)row * D + col) = o;
    } };

struct ALMoe1 { const bf16_t* h2; const int* cnt; const int* list;
    __device__ int rows(int z) const { return cnt[z]; }
    __device__ const bf16_t* rowptr(int z, int row) const { return h2 + (size_t)(list[z * CAP + row] >> 2) * D; }
    __device__ float kscale(int) const { return 1.0f; } };
struct EpiMoe1N { bf16_t* act; const int* offs; const float* bgu;
    __device__ void store(int z, int row, int col, const float* v) const {
        const float* bb = bgu + z * 2048 + col; ushort2 w; bf16_t* wp = (bf16_t*)&w;
        for (int p = 0; p < 2; ++p) { float glu = fminf(v[2 * p] + bb[2 * p], 7.0f); float lin = fminf(fmaxf(v[2 * p + 1] + bb[2 * p + 1], -7.0f), 7.0f);
            wp[p] = f2bf(glu * sigmoidf_(1.702f * glu) * (lin + 1.0f)); }
        *(ushort2*)(act + (size_t)(offs[z] + row) * D + (col >> 1)) = w;
    } };
struct ALMoe2 { const bf16_t* act; const int* cnt; const int* offs;
    __device__ int rows(int z) const { return cnt[z]; }
    __device__ const bf16_t* rowptr(int z, int row) const { return act + (size_t)(offs[z] + row) * D; }
    __device__ float kscale(int) const { return 1.0f; } };
struct EpiMoe2N { bf16_t* yp; const int* list; const float* bd;
    __device__ void store(int z, int row, int col, const float* v) const {
        int pair = list[z * CAP + row]; const float* bb = bd + z * 1024 + col; float o[4]; for (int i = 0; i < 4; ++i) o[i] = v[i] + bb[i];
        st4bf(yp + (size_t)pair * D + col, o);
    } };

__global__ __launch_bounds__(256) void k_nattn(const bf16_t* __restrict__ Q, const bf16_t* __restrict__ Kb, const bf16_t* __restrict__ Vb, bf16_t* Y) {
    __shared__ float qs[4][192]; __shared__ float sc[4][NKEY];
    const int tid = threadIdx.x, blk = blockIdx.x, qg = blk & 511, h = (blk >> 9) & 7, b = blk >> 12;
    for (int idx = tid; idx < 4 * 192; idx += 256) { int qi = idx / 192, d = idx % 192; int row = b * SEQ + qg * 4 + qi; qs[qi][d] = bf2f(Q[(size_t)row * 1536 + h * 192 + d]); }
    __syncthreads();
    float n1 = 0.f, n2 = 0.f;
    if (tid < 128) { int qi = tid >> 5, i = tid & 31; int t = qg * 4 + qi; float cs, sn; rope_cs(t, i, cs, sn); float x1 = qs[qi][128 + i], x2 = qs[qi][160 + i]; n1 = x1 * cs - x2 * sn; n2 = x1 * sn + x2 * cs; }
    __syncthreads();
    if (tid < 128) { int qi = tid >> 5, i = tid & 31; qs[qi][128 + i] = n1; qs[qi][160 + i] = n2; }
    __syncthreads();
    const bf16_t* Kp = Kb + (size_t)(b * 8 + h) * NKEY * 192; const bf16_t* Vp = Vb + (size_t)(b * 8 + h) * NKEY * 128;
    const float scale = 0.07216878364870322f;
    for (int key = tid; key < NKEY; key += 256) {
        const bf16_t* kr = Kp + (size_t)key * 192; float s0 = 0.f, s1 = 0.f, s2 = 0.f, s3 = 0.f;
        for (int d = 0; d < 192; d += 8) { uint4 u = *(const uint4*)(kr + d); const bf16_t* up = (const bf16_t*)&u;
            for (int j = 0; j < 8; ++j) { float kv = bf2f(up[j]); s0 += qs[0][d + j] * kv; s1 += qs[1][d + j] * kv; s2 += qs[2][d + j] * kv; s3 += qs[3][d + j] * kv; } }
        sc[0][key] = s0 * scale; sc[1][key] = s1 * scale; sc[2][key] = s2 * scale; sc[3][key] = s3 * scale;
    }
    __syncthreads();
    { int w = tid >> 6, lane = tid & 63; float m = -1e30f; for (int k = lane; k < NKEY; k += 64) m = fmaxf(m, sc[w][k]);
      for (int o = 32; o > 0; o >>= 1) m = fmaxf(m, __shfl_xor(m, o));
      float s = 0.f; for (int k = lane; k < NKEY; k += 64) { float e = __expf(sc[w][k] - m); sc[w][k] = e; s += e; }
      for (int o = 32; o > 0; o >>= 1) s += __shfl_xor(s, o);
      float inv = 1.0f / s; for (int k = lane; k < NKEY; k += 64) sc[w][k] *= inv; }
    __syncthreads();
    { int dv = tid & 127, qh = tid >> 7; float o0 = 0.f, o1 = 0.f;
      for (int k = 0; k < NKEY; ++k) { float v = bf2f(Vp[(size_t)k * 128 + dv]); o0 += sc[qh * 2][k] * v; o1 += sc[qh * 2 + 1][k] * v; }
      int row = b * SEQ + qg * 4 + qh * 2; Y[(size_t)row * D + h * 128 + dv] = f2bf(o0); Y[(size_t)(row + 1) * D + h * 128 + dv] = f2bf(o1); }
}

__global__ __launch_bounds__(256) void k_nscan(const bf16_t* __restrict__ hq, const bf16_t* __restrict__ ff, const bf16_t* __restrict__ fb, const bf16_t* __restrict__ iv, const float* __restrict__ lb, bf16_t* of, bf16_t* ob) {
    __shared__ float sf[128], sk[128], sq[128], so[2][128];
    const int tid = threadIdx.x, blk = blockIdx.x, dir = blk & 1, h = (blk >> 1) & 7, b = blk >> 4;
    const bf16_t* fz = dir ? fb : ff; bf16_t* out = dir ? ob : of;
    const int dv = tid & 127, half = tid >> 7;
    float S[64];
#pragma unroll
    for (int j = 0; j < 64; ++j) S[j] = 0.f;
    const float lbv = lb[dir * 1024 + h * 128 + (tid & 127)];
    for (int step = 0; step < NKEY; ++step) {
        int row; bool islat;
        if (step < CTXL) { int s = dir ? (CTXL - 1 - step) : step; row = L + b * CTXL + s; islat = false; }
        else { int t = step - CTXL; t = dir ? (SEQ - 1 - t) : t; row = b * SEQ + t; islat = true; }
        if (tid < 128) { float z = bf2f(fz[(size_t)row * D + h * 128 + tid]); float f = lbv + (1.0f - lbv) * sigmoidf_(z); sf[tid] = f; sk[tid] = 1.0f - f;
            if (islat) { float zq = bf2f(hq[(size_t)row * D + h * 128 + tid]); sq[tid] = siluf_(zq) * 0.08838834764831845f; } }
        float v = bf2f(iv[(size_t)row * D + h * 128 + dv]);
        __syncthreads();
        float o = 0.f;
#pragma unroll
        for (int j = 0; j < 64; ++j) { int dk = half * 64 + j; S[j] = sf[dk] * S[j] + sk[dk] * v; o += S[j] * sq[dk]; }
        if (islat) so[half][dv] = o;
        __syncthreads();
        if (islat && half == 0) out[(size_t)row * D + h * 128 + dv] = f2bf(so[0][dv] + so[1][dv]);
    }
}

__global__ __launch_bounds__(256) void k_merge(bf16_t* y, const bf16_t* __restrict__ of, const bf16_t* __restrict__ ob, const bf16_t* __restrict__ og, const bf16_t* __restrict__ gm, const bf16_t* __restrict__ gh, const float* __restrict__ ghg) {
    int row = blockIdx.x, c = threadIdx.x * 4; size_t off = (size_t)row * D + c;
    ushort4 a = *(const ushort4*)(of + off), bb = *(const ushort4*)(ob + off), g1 = *(const ushort4*)(og + off), g2 = *(const ushort4*)(gm + off), g3 = *(const ushort4*)(gh + off), ym = *(const ushort4*)(y + off);
    const bf16_t *ap = (const bf16_t*)&a, *bp = (const bf16_t*)&bb, *p1 = (const bf16_t*)&g1, *p2 = (const bf16_t*)&g2, *p3 = (const bf16_t*)&g3, *pm = (const bf16_t*)&ym;
    float o[4], ss = 0.f; for (int i = 0; i < 4; ++i) { o[i] = bf2f(ap[i]) + bf2f(bp[i]); ss += o[i] * o[i]; }
    for (int m = 16; m > 0; m >>= 1) ss += __shfl_xor(ss, m);
    float rs = rsqrtf(ss * (1.0f / 128.0f) + EPS); float r[4];
    for (int i = 0; i < 4; ++i) { float yh = o[i] * rs * ghg[(c + i) & 127] * siluf_(bf2f(p1[i])); r[i] = sigmoidf_(bf2f(p2[i])) * bf2f(pm[i]) + sigmoidf_(bf2f(p3[i])) * yh; }
    st4bf(y + off, r);
}

__global__ __launch_bounds__(256) void k_norm2_router(const float* __restrict__ x1, const float* __restrict__ g, const float* __restrict__ modv, const float* __restrict__ wr, const float* __restrict__ br, bf16_t* h2, int* topi, float* topp, int* cnt, int* list) {
    __shared__ float red[4]; __shared__ float hs[1024]; __shared__ float part[8][32];
    int row = blockIdx.x, tid = threadIdx.x, c = tid * 4; const float* mod = modv + (row / SEQ) * 6144;
    float4 v = *(const float4*)(x1 + (size_t)row * D + c);
    float ss = block_sum256(v.x * v.x + v.y * v.y + v.z * v.z + v.w * v.w, red); float rs = rsqrtf(ss * (1.0f / D) + EPS);
    float xv[4] = {v.x, v.y, v.z, v.w}, o[4];
    for (int i = 0; i < 4; ++i) { o[i] = xv[i] * rs * g[c + i] * (1.0f + mod[4 * 1024 + c + i]) + mod[3 * 1024 + c + i]; hs[c + i] = o[i]; }
    st4bf(h2 + (size_t)row * D + c, o);
    __syncthreads();
    { int e = tid & 31, p = tid >> 5; float a = 0.f; for (int j = p * 128; j < p * 128 + 128; ++j) a += hs[j] * wr[j * 32 + e]; part[p][e] = a; }
    __syncthreads();
    if (tid < 64) {
        int e = tid & 31; float cur = br[e];
#pragma unroll
        for (int p = 0; p < 8; ++p) cur += part[p][e];
        float tv0 = 0.f, sum = 0.f; float myp = 0.f; int myk = -1;
        int sel_i[4]; float sel_e[4];
#pragma unroll
        for (int k = 0; k < 4; ++k) {
            float m = cur; int mi = e;
#pragma unroll
            for (int o = 16; o > 0; o >>= 1) { float om = __shfl_xor(m, o); int oi = __shfl_xor(mi, o); if (om > m || (om == m && oi < mi)) { m = om; mi = oi; } }
            if (k == 0) tv0 = m;
            sel_i[k] = mi; sel_e[k] = __expf(m - tv0); sum += sel_e[k];
            if (e == mi) cur = -3.0e38f;
        }
#pragma unroll
        for (int k = 0; k < 4; ++k) if (tid == k) { myk = sel_i[k]; myp = sel_e[k] / sum; }
        if (tid < 4) { int pair = row * 4 + tid; topi[pair] = myk; topp[pair] = myp; int pos = atomicAdd(&cnt[myk], 1); list[myk * CAP + pos] = pair; }
    }
}

__global__ void k_moe_offs(const int* cnt, int* offs, int* tilee) {
    if (threadIdx.x == 0 && blockIdx.x == 0) { int o = 0, t = 0; for (int e = 0; e < NE; ++e) { offs[e] = o; int nt = (cnt[e] + 255) >> 8; for (int i = 0; i < nt; ++i) tilee[t++] = e; o += nt * 256; } offs[NE] = o; offs[NE + 1] = t; }
}

__global__ __launch_bounds__(256) void k_final(float* out, const bf16_t* __restrict__ yp, const float* __restrict__ topp, const float* __restrict__ modv, const float* __restrict__ fg) {
    __shared__ float red[4];
    int row = blockIdx.x, c = threadIdx.x * 4; const float* gate = modv + (row / SEQ) * 6144 + 5 * 1024;
    float4 v = *(const float4*)(out + (size_t)row * D + c); float xv[4] = {v.x, v.y, v.z, v.w}; float m[4] = {0.f, 0.f, 0.f, 0.f};
    for (int k = 0; k < 4; ++k) { float p = topp[row * 4 + k]; ushort4 u = *(const ushort4*)(yp + (size_t)(row * 4 + k) * D + c); const bf16_t* up = (const bf16_t*)&u; for (int i = 0; i < 4; ++i) m[i] += p * bf2f(up[i]); }
    float ss = 0.f; for (int i = 0; i < 4; ++i) { xv[i] += gate[c + i] * m[i]; ss += xv[i] * xv[i]; }
    ss = block_sum256(ss, red); float rs = rsqrtf(ss * (1.0f / D) + EPS);
    float4 o; o.x = xv[0] * rs * fg[c]; o.y = xv[1] * rs * fg[c + 1]; o.z = xv[2] * rs * fg[c + 2]; o.w = xv[3] * rs * fg[c + 3];
    *(float4*)(out + (size_t)row * D + c) = o;
}

extern "C" void kernel_launch(void* const* d_in, const int* in_sizes, int n_in, void* d_out, int out_size, void* d_ws, size_t ws_size, hipStream_t stream) {
    const float* x = (const float*)d_in[0]; const float* c = (const float*)d_in[1]; const float* ctx = (const float*)d_in[2]; const float* cctx = (const float*)d_in[3];
    const float* w_mod = (const float*)d_in[4]; const float* b_mod = (const float*)d_in[5]; const float* g_mix = (const float*)d_in[6]; const float* w_in = (const float*)d_in[7];
    const float* g_q = (const float*)d_in[8]; const float* w_qb = (const float*)d_in[9]; const float* g_kv = (const float*)d_in[10]; const float* w_kvb = (const float*)d_in[11];
    const float* lbl = (const float*)d_in[12]; const float* g_hg = (const float*)d_in[13]; const float* w_out = (const float*)d_in[14]; const float* g_ffn = (const float*)d_in[15];
    const float* w_r = (const float*)d_in[16]; const float* b_r = (const float*)d_in[17]; const float* w_gu = (const float*)d_in[18]; const float* b_gu = (const float*)d_in[19];
    const float* w_dn = (const float*)d_in[20]; const float* b_dn = (const float*)d_in[21]; const float* g_fin = (const float*)d_in[22];
    char* ws = (char*)d_ws; float* out = (float*)d_out;
    int* cnt = (int*)(ws + OFF_CNT); int* offs = (int*)(ws + OFF_OFFS); int* tilee = (int*)(ws + OFF_TILEE); float* lb = (float*)(ws + OFF_LB); float* modv = (float*)(ws + OFF_MOD);
    float* ssqq = (float*)(ws + OFF_SSQQ); float* ssqkv = (float*)(ws + OFF_SSQKV); int* topi = (int*)(ws + OFF_TOPI); float* topp = (float*)(ws + OFF_TOPP); int* list = (int*)(ws + OFF_LIST);
    bf16_t* Bh = (bf16_t*)(ws + OFF_H);
    SegOut so; so.qa = (bf16_t*)(ws + OFF_QA); so.ckv = (bf16_t*)(ws + OFF_CKV); so.kr = (bf16_t*)(ws + OFF_KR); so.hq = (bf16_t*)(ws + OFF_HQ); so.ff = (bf16_t*)(ws + OFF_FF);
    so.fb = (bf16_t*)(ws + OFF_FB); so.iv = (bf16_t*)(ws + OFF_IV); so.og = (bf16_t*)(ws + OFF_OG); so.gm = (bf16_t*)(ws + OFF_GM); so.gh = (bf16_t*)(ws + OFF_GH);
    bf16_t* Bq = (bf16_t*)(ws + OFF_Q); bf16_t* BK = (bf16_t*)(ws + OFF_K); bf16_t* BV = (bf16_t*)(ws + OFF_V); bf16_t* Bof = (bf16_t*)(ws + OFF_OF); bf16_t* Bob = (bf16_t*)(ws + OFF_OB);
    bf16_t* Byp = (bf16_t*)(ws + OFF_YP); bf16_t* Bact = (bf16_t*)(ws + OFF_ACT);

    k_init<<<8, 256, 0, stream>>>(lbl, lb, cnt);
    k_mod<<<dim3(24, 17), 256, 0, stream>>>(c, cctx, w_mod, b_mod, modv);
    k_norm1<<<R, 256, 0, stream>>>(x, ctx, g_mix, modv, Bh);
    { ALDense al{Bh, D, R, nullptr}; EpiInN ep{so}; k_ngemm<<<dim3(8256 / 64, R / 64, 1), 256, 0, stream>>>(1024, w_in, 8256, 0, al, ep); }
    k_rowssq<<<L / 4, 256, 0, stream>>>(so.qa, 768, L, ssqq);
    k_rowssq<<<R / 4, 256, 0, stream>>>(so.ckv, 256, R, ssqkv);
    { ALDense al{so.qa, 768, L, g_q}; EpiQN ep{Bq, ssqq}; k_ngemm<<<dim3(1536 / 64, L / 64, 1), 256, 0, stream>>>(768, w_qb, 1536, 0, al, ep); }
    { ALDense al{so.ckv, 256, R, g_kv}; EpiKVN ep{BK, BV, ssqkv}; k_ngemm<<<dim3(2048 / 64, R / 64, 1), 256, 0, stream>>>(256, w_kvb, 2048, 0, al, ep); }
    k_krope<<<R * 32 / 256, 256, 0, stream>>>(so.kr, BK);
    k_nattn<<<NB * 8 * 512, 256, 0, stream>>>(Bq, BK, BV, Bh);
    k_nscan<<<NB * 8 * 2, 256, 0, stream>>>(so.hq, so.ff, so.fb, so.iv, lb, Bof, Bob);
    k_merge<<<L, 256, 0, stream>>>(Bh, Bof, Bob, so.og, so.gm, so.gh, g_hg);
    { ALDense al{Bh, D, L, nullptr}; EpiOutN ep{out, x, modv}; k_ngemm<<<dim3(1024 / 64, L / 64, 1), 256, 0, stream>>>(1024, w_out, 1024, 0, al, ep); }
    k_norm2_router<<<L, 256, 0, stream>>>(out, g_ffn, modv, w_r, b_r, Bh, topi, topp, cnt, list);
    k_moe_offs<<<1, 64, 0, stream>>>(cnt, offs, tilee);
    { ALMoe1 al{Bh, cnt, list}; EpiMoe1N ep{Bact, offs, b_gu}; k_ngemm<<<dim3(2048 / 64, CAP / 64, NE), 256, 0, stream>>>(1024, w_gu, 2048, (size_t)1024 * 2048, al, ep); }
    { ALMoe2 al{Bact, cnt, offs}; EpiMoe2N ep{Byp, list, b_dn}; k_ngemm<<<dim3(1024 / 64, CAP / 64, NE), 256, 0, stream>>>(1024, w_dn, 1024, (size_t)1024 * 1024, al, ep); }
    k_final<<<L, 256, 0, stream>>>(out, Byp, topp, modv, g_fin);
}
```

```cpp
#include <hip/hip_runtime.h>
#include <stdint.h>

typedef unsigned short bf16_t;
__device__ __forceinline__ float bf2f(bf16_t v) { return __uint_as_float(((unsigned)v) << 16); }
__device__ __forceinline__ bf16_t f2bf(float f) { unsigned u = __float_as_uint(f); u += 0x7FFFu + ((u >> 16) & 1u); return (bf16_t)(u >> 16); }
__device__ __forceinline__ float sigmoidf_(float x) { return 1.0f / (1.0f + __expf(-x)); }
__device__ __forceinline__ float siluf_(float x) { return x / (1.0f + __expf(-x)); }

constexpr int D = 1024, NB = 16, SEQ = 2048, CTXL = 256;
constexpr int L = NB * SEQ;
constexpr int RC = NB * CTXL;
constexpr int R = L + RC;
constexpr int NKEY = SEQ + CTXL;
constexpr float EPS = 1e-6f;
constexpr int NE = 32, CAP = 32768;
constexpr int MAXROWS = 131072 + NE * 256;

constexpr size_t MiB = 1048576;
constexpr size_t OFF_SMALL = 0;
constexpr size_t OFF_CNT = 0;
constexpr size_t OFF_OFFS = 1024;
constexpr size_t OFF_TILEE = 2048;
constexpr size_t OFF_LB = 8192;
constexpr size_t OFF_MOD = 16384;
constexpr size_t OFF_SSQQ = 512 * 1024;
constexpr size_t OFF_SSQKV = 768 * 1024;
constexpr size_t OFF_TOPI = 1 * MiB;
constexpr size_t OFF_TOPP = 1 * MiB + 512 * 1024;
constexpr size_t OFF_ROWPAIR = 2 * MiB;
constexpr size_t OFF_LIST = 3 * MiB;
constexpr size_t OFF_H = 32 * MiB;
constexpr size_t OFF_QA = 104 * MiB;
constexpr size_t OFF_CKV = 152 * MiB;
constexpr size_t OFF_KR = 170 * MiB;
constexpr size_t OFF_OF = 104 * MiB;
constexpr size_t OFF_HQ = 175 * MiB;
constexpr size_t SEG_STRIDE = 72 * MiB;
constexpr size_t OFF_FF = OFF_HQ + 1 * SEG_STRIDE;
constexpr size_t OFF_FB = OFF_HQ + 2 * SEG_STRIDE;
constexpr size_t OFF_IV = OFF_HQ + 3 * SEG_STRIDE;
constexpr size_t OFF_OG = OFF_HQ + 4 * SEG_STRIDE;
constexpr size_t OFF_GM = OFF_HQ + 5 * SEG_STRIDE;
constexpr size_t OFF_GH = OFF_HQ + 6 * SEG_STRIDE;
constexpr size_t OFF_Q = 679 * MiB;
constexpr size_t OFF_K = 775 * MiB;
constexpr size_t OFF_V = 883 * MiB;
constexpr size_t OFF_OB = 955 * MiB;
constexpr size_t OFF_YP = 296 * MiB;
constexpr size_t OFF_ACT = 568 * MiB;

struct SegOut { bf16_t *qa, *ckv, *kr, *hq, *ff, *fb, *iv, *og, *gm, *gh; };

__global__ void k_init(const float* __restrict__ lbl, float* lb, int* cnt) {
    int i = blockIdx.x * blockDim.x + threadIdx.x;
    if (i < 2048) { int d = i >> 10, j = i & 1023; float a = lbl[(d * 2 + 0) * 1024 + j], b = lbl[(d * 2 + 1) * 1024 + j]; lb[i] = 1.0f / (1.0f + __expf(b - a)); }
    if (i < 32) cnt[i] = 0;
}

__global__ __launch_bounds__(256) void k_mod(const float* __restrict__ c, const float* __restrict__ cctx, const float* __restrict__ wmod, const float* __restrict__ bmod, float* modv) {
    __shared__ float s[1024];
    int r = blockIdx.y; const float* src = r < 16 ? c + r * 1024 : cctx;
    for (int k = threadIdx.x; k < 1024; k += 256) s[k] = siluf_(src[k]);
    __syncthreads();
    int j = blockIdx.x * 256 + threadIdx.x; float acc = 0.f;
    for (int k = 0; k < 1024; ++k) acc += s[k] * wmod[(size_t)k * 6144 + j];
    modv[r * 6144 + j] = acc + bmod[j];
}

__device__ __forceinline__ float block_sum256(float v, float* red) {
    for (int o = 32; o > 0; o >>= 1) v += __shfl_xor(v, o);
    int w = threadIdx.x >> 6; if ((threadIdx.x & 63) == 0) red[w] = v; __syncthreads();
    float t = red[0] + red[1] + red[2] + red[3]; __syncthreads(); return t;
}

__global__ __launch_bounds__(256) void k_norm1(const float* __restrict__ x, const float* __restrict__ ctx, const float* __restrict__ g, const float* __restrict__ modv, bf16_t* h) {
    __shared__ float red[4];
    int row = blockIdx.x; const float* src = row < L ? x + (size_t)row * D : ctx + (size_t)(row - L) * D;
    const float* mod = modv + (row < L ? row / SEQ : 16) * 6144;
    int c = threadIdx.x * 4; float4 v = *(const float4*)(src + c);
    float ss = block_sum256(v.x * v.x + v.y * v.y + v.z * v.z + v.w * v.w, red);
    float rs = rsqrtf(ss * (1.0f / D) + EPS);
    float o[4] = {v.x, v.y, v.z, v.w}; ushort4 w; bf16_t* wp = (bf16_t*)&w;
    for (int i = 0; i < 4; ++i) wp[i] = f2bf(o[i] * rs * g[c + i] * (1.0f + mod[1024 + c + i]) + mod[c + i]);
    *(ushort4*)(h + (size_t)row * D + c) = w;
}

__global__ __launch_bounds__(256) void k_rowssq(const bf16_t* __restrict__ buf, int width, int nrows, float* ssq) {
    int row = blockIdx.x * 4 + (threadIdx.x >> 6), lane = threadIdx.x & 63; if (row >= nrows) return;
    float s = 0.f; for (int k = lane; k < width; k += 64) { float v = bf2f(buf[(size_t)row * width + k]); s += v * v; }
    for (int o = 32; o > 0; o >>= 1) s += __shfl_xor(s, o);
    if (lane == 0) ssq[row] = s;
}

__device__ __forceinline__ void rope_cs(int t, int i, float& cs, float& sn) {
    int j = i & 15; float inv = __expf(-(float)j * (9.210340371976184f / 16.0f)); float pos = (i < 16) ? (float)(t >> 6) : (float)(t & 63);
    float ang = pos * inv; cs = cosf(ang); sn = sinf(ang);
}

__global__ __launch_bounds__(256) void k_krope(const bf16_t* __restrict__ kr, bf16_t* Kb) {
    int gid = blockIdx.x * 256 + threadIdx.x; int row = gid >> 5, i = gid & 31; if (row >= R) return;
    float x1 = bf2f(kr[(size_t)row * 64 + i]), x2 = bf2f(kr[(size_t)row * 64 + 32 + i]); float o1 = x1, o2 = x2; int b, pos;
    if (row < L) { b = row / SEQ; pos = row % SEQ; float cs, sn; rope_cs(pos, i, cs, sn); o1 = x1 * cs - x2 * sn; o2 = x1 * sn + x2 * cs; }
    else { b = (row - L) / CTXL; pos = SEQ + (row - L) % CTXL; }
    bf16_t w1 = f2bf(o1), w2 = f2bf(o2);
    for (int h = 0; h < 8; ++h) { bf16_t* p = Kb + ((size_t)(b * 8 + h) * NKEY + pos) * 192 + 128; p[i] = w1; p[32 + i] = w2; }
}

template <class AL, class EP>
__global__ __launch_bounds__(256) void k_ngemm(int K, const float* __restrict__ W, int ldw, size_t wzstride, AL al, EP ep) {
    __shared__ float As[16][68]; __shared__ float Bs[16][64];
    const int z = blockIdx.z, row0 = blockIdx.y * 64, col0 = blockIdx.x * 64, tid = threadIdx.x;
    const int mvalid = al.rows(z); if (row0 >= mvalid) return;
    const float* Wz = W + (size_t)z * wzstride;
    const int ar = tid >> 2, ak = (tid & 3) * 4; const bf16_t* arow = (row0 + ar < mvalid) ? al.rowptr(z, row0 + ar) : nullptr;
    const int bk = tid >> 4, bn = (tid & 15) * 4;
    const int ty = tid >> 4, tx = tid & 15;
    float acc[4][4] = {};
    for (int k0 = 0; k0 < K; k0 += 16) {
        float a4[4] = {0.f, 0.f, 0.f, 0.f};
        if (arow) { ushort4 u = *(const ushort4*)(arow + k0 + ak); const bf16_t* up = (const bf16_t*)&u; for (int i = 0; i < 4; ++i) a4[i] = bf2f(up[i]) * al.kscale(k0 + ak + i); }
        float4 b4 = *(const float4*)(Wz + (size_t)(k0 + bk) * ldw + col0 + bn);
        __syncthreads();
        for (int i = 0; i < 4; ++i) As[ak + i][ar] = a4[i];
        *(float4*)&Bs[bk][bn] = b4;
        __syncthreads();
#pragma unroll
        for (int kk = 0; kk < 16; ++kk) {
            float4 av = *(const float4*)&As[kk][ty * 4]; float4 bv = *(const float4*)&Bs[kk][tx * 4];
            float a[4] = {av.x, av.y, av.z, av.w}, b[4] = {bv.x, bv.y, bv.z, bv.w};
#pragma unroll
            for (int i = 0; i < 4; ++i)
#pragma unroll
                for (int j = 0; j < 4; ++j) acc[i][j] += a[i] * b[j];
        }
    }
    for (int i = 0; i < 4; ++i) { int row = row0 + ty * 4 + i; if (row < mvalid) ep.store(z, row, col0 + tx * 4, acc[i]); }
}

__device__ __forceinline__ void st4bf(bf16_t* dst, const float* v) { ushort4 w; bf16_t* wp = (bf16_t*)&w; for (int i = 0; i < 4; ++i) wp[i] = f2bf(v[i]); *(ushort4*)dst = w; }

struct ALDense { const bf16_t* A; int lda; int nrows; const float* ks;
    __device__ int rows(int) const { return nrows; }
    __device__ const bf16_t* rowptr(int, int row) const { return A + (size_t)row * lda; }
    __device__ float kscale(int k) const { return ks ? ks[k] : 1.0f; } };

struct EpiInN { SegOut s;
    __device__ void store(int, int row, int col, const float* v) const {
        bf16_t* dst;
        if (col < 768) { if (row >= L) return; dst = s.qa + (size_t)row * 768 + col; }
        else if (col < 1024) dst = s.ckv + (size_t)row * 256 + (col - 768);
        else if (col < 1088) dst = s.kr + (size_t)row * 64 + (col - 1024);
        else { int c = col - 1088, seg = c >> 10, cc = c & 1023; bool latonly = (seg == 0 || seg >= 4); if (latonly && row >= L) return;
            bf16_t* base = seg == 0 ? s.hq : seg == 1 ? s.ff : seg == 2 ? s.fb : seg == 3 ? s.iv : seg == 4 ? s.og : seg == 5 ? s.gm : s.gh;
            dst = base + (size_t)row * 1024 + cc; }
        st4bf(dst, v);
    } };

struct EpiQN { bf16_t* q; const float* ssq;
    __device__ void store(int, int row, int col, const float* v) const { float rs = rsqrtf(ssq[row] * (1.0f / 768.0f) + EPS); float o[4]; for (int i = 0; i < 4; ++i) o[i] = v[i] * rs; st4bf(q + (size_t)row * 1536 + col, o); } };

struct EpiKVN { bf16_t *Kb, *Vb; const float* ssq;
    __device__ void store(int, int row, int col, const float* v) const {
        float rs = rsqrtf(ssq[row] * (1.0f / 256.0f) + EPS); float o[4]; for (int i = 0; i < 4; ++i) o[i] = v[i] * rs;
        int b, pos; if (row < L) { b = row / SEQ; pos = row % SEQ; } else { b = (row - L) / CTXL; pos = SEQ + (row - L) % CTXL; }
        int h = col >> 8, w = col & 255; size_t kvrow = (size_t)(b * 8 + h) * NKEY + pos;
        if (w < 128) st4bf(Kb + kvrow * 192 + w, o); else st4bf(Vb + kvrow * 128 + (w - 128), o);
    } };

struct EpiOutN { float* x1; const float* x; const float* modv;
    __device__ void store(int, int row, int col, const float* v) const {
        const float* gate = modv + (row / SEQ) * 6144 + 2 * 1024; float4 xv = *(const float4*)(x + (size_t)row * D + col);
        float4 o; o.x = xv.x + gate[col] * v[0]; o.y = xv.y + gate[col + 1] * v[1]; o.z = xv.z + gate[col + 2] * v[2]; o.w = xv.w + gate[col + 3] * v[3];
        *(float4*)(x1 + (size_t)row * D + col) = o;
    } };

struct ALMoe1 { const bf16_t* h2; const int* cnt; const int* list;
    __device__ int rows(int z) const { return cnt[z]; }
    __device__ const bf16_t* rowptr(int z, int row) const { return h2 + (size_t)(list[z * CAP + row] >> 2) * D; }
    __device__ float kscale(int) const { return 1.0f; } };
struct EpiMoe1N { bf16_t* act; const int* offs; const float* bgu;
    __device__ void store(int z, int row, int col, const float* v) const {
        const float* bb = bgu + z * 2048 + col; ushort2 w; bf16_t* wp = (bf16_t*)&w;
        for (int p = 0; p < 2; ++p) { float glu = fminf(v[2 * p] + bb[2 * p], 7.0f); float lin = fminf(fmaxf(v[2 * p + 1] + bb[2 * p + 1], -7.0f), 7.0f);
            wp[p] = f2bf(glu * sigmoidf_(1.702f * glu) * (lin + 1.0f)); }
        *(ushort2*)(act + (size_t)(offs[z] + row) * D + (col >> 1)) = w;
    } };
struct ALMoe2 { const bf16_t* act; const int* cnt; const int* offs;
    __device__ int rows(int z) const { return cnt[z]; }
    __device__ const bf16_t* rowptr(int z, int row) const { return act + (size_t)(offs[z] + row) * D; }
    __device__ float kscale(int) const { return 1.0f; } };
struct EpiMoe2N { bf16_t* yp; const int* list; const float* bd;
    __device__ void store(int z, int row, int col, const float* v) const {
        int pair = list[z * CAP + row]; const float* bb = bd + z * 1024 + col; float o[4]; for (int i = 0; i < 4; ++i) o[i] = v[i] + bb[i];
        st4bf(yp + (size_t)pair * D + col, o);
    } };

__global__ __launch_bounds__(256) void k_nattn(const bf16_t* __restrict__ Q, const bf16_t* __restrict__ Kb, const bf16_t* __restrict__ Vb, bf16_t* Y) {
    __shared__ float qs[4][192]; __shared__ float sc[4][NKEY];
    const int tid = threadIdx.x, blk = blockIdx.x, qg = blk & 511, h = (blk >> 9) & 7, b = blk >> 12;
    for (int idx = tid; idx < 4 * 192; idx += 256) { int qi = idx / 192, d = idx % 192; int row = b * SEQ + qg * 4 + qi; qs[qi][d] = bf2f(Q[(size_t)row * 1536 + h * 192 + d]); }
    __syncthreads();
    float n1 = 0.f, n2 = 0.f;
    if (tid < 128) { int qi = tid >> 5, i = tid & 31; int t = qg * 4 + qi; float cs, sn; rope_cs(t, i, cs, sn); float x1 = qs[qi][128 + i], x2 = qs[qi][160 + i]; n1 = x1 * cs - x2 * sn; n2 = x1 * sn + x2 * cs; }
    __syncthreads();
    if (tid < 128) { int qi = tid >> 5, i = tid & 31; qs[qi][128 + i] = n1; qs[qi][160 + i] = n2; }
    __syncthreads();
    const bf16_t* Kp = Kb + (size_t)(b * 8 + h) * NKEY * 192; const bf16_t* Vp = Vb + (size_t)(b * 8 + h) * NKEY * 128;
    const float scale = 0.07216878364870322f;
    for (int key = tid; key < NKEY; key += 256) {
        const bf16_t* kr = Kp + (size_t)key * 192; float s0 = 0.f, s1 = 0.f, s2 = 0.f, s3 = 0.f;
        for (int d = 0; d < 192; d += 8) { uint4 u = *(const uint4*)(kr + d); const bf16_t* up = (const bf16_t*)&u;
            for (int j = 0; j < 8; ++j) { float kv = bf2f(up[j]); s0 += qs[0][d + j] * kv; s1 += qs[1][d + j] * kv; s2 += qs[2][d + j] * kv; s3 += qs[3][d + j] * kv; } }
        sc[0][key] = s0 * scale; sc[1][key] = s1 * scale; sc[2][key] = s2 * scale; sc[3][key] = s3 * scale;
    }
    __syncthreads();
    { int w = tid >> 6, lane = tid & 63; float m = -1e30f; for (int k = lane; k < NKEY; k += 64) m = fmaxf(m, sc[w][k]);
      for (int o = 32; o > 0; o >>= 1) m = fmaxf(m, __shfl_xor(m, o));
      float s = 0.f; for (int k = lane; k < NKEY; k += 64) { float e = __expf(sc[w][k] - m); sc[w][k] = e; s += e; }
      for (int o = 32; o > 0; o >>= 1) s += __shfl_xor(s, o);
      float inv = 1.0f / s; for (int k = lane; k < NKEY; k += 64) sc[w][k] *= inv; }
    __syncthreads();
    { int dv = tid & 127, qh = tid >> 7; float o0 = 0.f, o1 = 0.f;
      for (int k = 0; k < NKEY; ++k) { float v = bf2f(Vp[(size_t)k * 128 + dv]); o0 += sc[qh * 2][k] * v; o1 += sc[qh * 2 + 1][k] * v; }
      int row = b * SEQ + qg * 4 + qh * 2; Y[(size_t)row * D + h * 128 + dv] = f2bf(o0); Y[(size_t)(row + 1) * D + h * 128 + dv] = f2bf(o1); }
}

__global__ __launch_bounds__(256) void k_nscan(const bf16_t* __restrict__ hq, const bf16_t* __restrict__ ff, const bf16_t* __restrict__ fb, const bf16_t* __restrict__ iv, const float* __restrict__ lb, bf16_t* of, bf16_t* ob) {
    __shared__ float sf[128], sk[128], sq[128], so[2][128];
    const int tid = threadIdx.x, blk = blockIdx.x, dir = blk & 1, h = (blk >> 1) & 7, b = blk >> 4;
    const bf16_t* fz = dir ? fb : ff; bf16_t* out = dir ? ob : of;
    const int dv = tid & 127, half = tid >> 7;
    float S[64];
#pragma unroll
    for (int j = 0; j < 64; ++j) S[j] = 0.f;
    const float lbv = lb[dir * 1024 + h * 128 + (tid & 127)];
    for (int step = 0; step < NKEY; ++step) {
        int row; bool islat;
        if (step < CTXL) { int s = dir ? (CTXL - 1 - step) : step; row = L + b * CTXL + s; islat = false; }
        else { int t = step - CTXL; t = dir ? (SEQ - 1 - t) : t; row = b * SEQ + t; islat = true; }
        if (tid < 128) { float z = bf2f(fz[(size_t)row * D + h * 128 + tid]); float f = lbv + (1.0f - lbv) * sigmoidf_(z); sf[tid] = f; sk[tid] = 1.0f - f;
            if (islat) { float zq = bf2f(hq[(size_t)row * D + h * 128 + tid]); sq[tid] = siluf_(zq) * 0.08838834764831845f; } }
        float v = bf2f(iv[(size_t)row * D + h * 128 + dv]);
        __syncthreads();
        float o = 0.f;
#pragma unroll
        for (int j = 0; j < 64; ++j) { int dk = half * 64 + j; S[j] = sf[dk] * S[j] + sk[dk] * v; o += S[j] * sq[dk]; }
        if (islat) so[half][dv] = o;
        __syncthreads();
        if (islat && half == 0) out[(size_t)row * D + h * 128 + dv] = f2bf(so[0][dv] + so[1][dv]);
    }
}

__global__ __launch_bounds__(256) void k_merge(bf16_t* y, const bf16_t* __restrict__ of, const bf16_t* __restrict__ ob, const bf16_t* __restrict__ og, const bf16_t* __restrict__ gm, const bf16_t* __restrict__ gh, const float* __restrict__ ghg) {
    int row = blockIdx.x, c = threadIdx.x * 4; size_t off = (size_t)row * D + c;
    ushort4 a = *(const ushort4*)(of + off), bb = *(const ushort4*)(ob + off), g1 = *(const ushort4*)(og + off), g2 = *(const ushort4*)(gm + off), g3 = *(const ushort4*)(gh + off), ym = *(const ushort4*)(y + off);
    const bf16_t *ap = (const bf16_t*)&a, *bp = (const bf16_t*)&bb, *p1 = (const bf16_t*)&g1, *p2 = (const bf16_t*)&g2, *p3 = (const bf16_t*)&g3, *pm = (const bf16_t*)&ym;
    float o[4], ss = 0.f; for (int i = 0; i < 4; ++i) { o[i] = bf2f(ap[i]) + bf2f(bp[i]); ss += o[i] * o[i]; }
    for (int m = 16; m > 0; m >>= 1) ss += __shfl_xor(ss, m);
    float rs = rsqrtf(ss * (1.0f / 128.0f) + EPS); float r[4];
    for (int i = 0; i < 4; ++i) { float yh = o[i] * rs * ghg[(c + i) & 127] * siluf_(bf2f(p1[i])); r[i] = sigmoidf_(bf2f(p2[i])) * bf2f(pm[i]) + sigmoidf_(bf2f(p3[i])) * yh; }
    st4bf(y + off, r);
}

__global__ __launch_bounds__(256) void k_norm2_router(const float* __restrict__ x1, const float* __restrict__ g, const float* __restrict__ modv, const float* __restrict__ wr, const float* __restrict__ br, bf16_t* h2, int* topi, float* topp, int* cnt, int* list) {
    __shared__ float red[4]; __shared__ float hs[1024]; __shared__ float part[8][32];
    int row = blockIdx.x, tid = threadIdx.x, c = tid * 4; const float* mod = modv + (row / SEQ) * 6144;
    float4 v = *(const float4*)(x1 + (size_t)row * D + c);
    float ss = block_sum256(v.x * v.x + v.y * v.y + v.z * v.z + v.w * v.w, red); float rs = rsqrtf(ss * (1.0f / D) + EPS);
    float xv[4] = {v.x, v.y, v.z, v.w}, o[4];
    for (int i = 0; i < 4; ++i) { o[i] = xv[i] * rs * g[c + i] * (1.0f + mod[4 * 1024 + c + i]) + mod[3 * 1024 + c + i]; hs[c + i] = o[i]; }
    st4bf(h2 + (size_t)row * D + c, o);
    __syncthreads();
    { int e = tid & 31, p = tid >> 5; float a = 0.f; for (int j = p * 128; j < p * 128 + 128; ++j) a += hs[j] * wr[j * 32 + e]; part[p][e] = a; }
    __syncthreads();
    if (tid < 64) {
        int e = tid & 31; float cur = br[e];
#pragma unroll
        for (int p = 0; p < 8; ++p) cur += part[p][e];
        float tv0 = 0.f, sum = 0.f; float myp = 0.f; int myk = -1;
        int sel_i[4]; float sel_e[4];
#pragma unroll
        for (int k = 0; k < 4; ++k) {
            float m = cur; int mi = e;
#pragma unroll
            for (int o = 16; o > 0; o >>= 1) { float om = __shfl_xor(m, o); int oi = __shfl_xor(mi, o); if (om > m || (om == m && oi < mi)) { m = om; mi = oi; } }
            if (k == 0) tv0 = m;
            sel_i[k] = mi; sel_e[k] = __expf(m - tv0); sum += sel_e[k];
            if (e == mi) cur = -3.0e38f;
        }
#pragma unroll
        for (int k = 0; k < 4; ++k) if (tid == k) { myk = sel_i[k]; myp = sel_e[k] / sum; }
        if (tid < 4) { int pair = row * 4 + tid; topi[pair] = myk; topp[pair] = myp; int pos = atomicAdd(&cnt[myk], 1); list[myk * CAP + pos] = pair; }
    }
}

__global__ void k_moe_offs(const int* cnt, int* offs, int* tilee) {
    if (threadIdx.x == 0 && blockIdx.x == 0) { int o = 0, t = 0; for (int e = 0; e < NE; ++e) { offs[e] = o; int nt = (cnt[e] + 255) >> 8; for (int i = 0; i < nt; ++i) tilee[t++] = e; o += nt * 256; } offs[NE] = o; offs[NE + 1] = t; }
}

__global__ __launch_bounds__(256) void k_final(float* out, const bf16_t* __restrict__ yp, const float* __restrict__ topp, const float* __restrict__ modv, const float* __restrict__ fg) {
    __shared__ float red[4];
    int row = blockIdx.x, c = threadIdx.x * 4; const float* gate = modv + (row / SEQ) * 6144 + 5 * 1024;
    float4 v = *(const float4*)(out + (size_t)row * D + c); float xv[4] = {v.x, v.y, v.z, v.w}; float m[4] = {0.f, 0.f, 0.f, 0.f};
    for (int k = 0; k < 4; ++k) { float p = topp[row * 4 + k]; ushort4 u = *(const ushort4*)(yp + (size_t)(row * 4 + k) * D + c); const bf16_t* up = (const bf16_t*)&u; for (int i = 0; i < 4; ++i) m[i] += p * bf2f(up[i]); }
    float ss = 0.f; for (int i = 0; i < 4; ++i) { xv[i] += gate[c + i] * m[i]; ss += xv[i] * xv[i]; }
    ss = block_sum256(ss, red); float rs = rsqrtf(ss * (1.0f / D) + EPS);
    float4 o; o.x = xv[0] * rs * fg[c]; o.y = xv[1] * rs * fg[c + 1]; o.z = xv[2] * rs * fg[c + 2]; o.w = xv[3] * rs * fg[c + 3];
    *(float4*)(out + (size_t)row * D + c) = o;
}

#define LAS __attribute__((address_space(3)))
typedef short bf16x8 __attribute__((ext_vector_type(8)));
typedef float f32x4 __attribute__((ext_vector_type(4)));
typedef unsigned u32x4 __attribute__((ext_vector_type(4)));
typedef unsigned u32x2 __attribute__((ext_vector_type(2)));

constexpr size_t OFF_WT_IN = 8 * MiB;
constexpr size_t OFF_WT_QB = 25 * MiB;
constexpr size_t OFF_WT_KVB = 28 * MiB;
constexpr size_t OFF_WT_OUT = 29 * MiB;
constexpr size_t OFF_WT_GU = 104 * MiB;
constexpr size_t OFF_WT_DN = 232 * MiB;

struct Params {
    const float *x, *c, *ctx, *cctx, *w_mod, *b_mod, *g_mix, *w_in, *g_q, *w_qb, *g_kv, *w_kvb, *lbl, *g_hg, *w_out, *g_ffn, *w_r, *b_r, *w_gu, *b_gu, *w_dn, *b_dn, *g_fin;
    float* out; char* ws;
};

__device__ __forceinline__ unsigned cvt_pk_bf16(float lo, float hi) { unsigned r; asm volatile("v_cvt_pk_bf16_f32 %0, %1, %2" : "=v"(r) : "v"(lo), "v"(hi)); return r; }

namespace pg8 {
constexpr int BM = 256, BK = 64, HALF = 128, HTB = HALF * BK * 2, STAGE_BYTES = 8 * HTB, NXCD = 8, WGM = 8;
__device__ __forceinline__ int lds_byte(int r, int c) { const int st = (r >> 4) * 2 + (c >> 5), rr = r & 15, cc = c & 31, ob = rr * 64 + cc * 2; return st * 1024 + (ob ^ (((ob >> 9) & 1) << 5)); }
__device__ __forceinline__ void stage_rc(int b, int& R, int& C) { const int st = b / 1024, sb = b % 1024, swz = sb ^ (((sb >> 9) & 1) << 5); R = (st >> 1) * 16 + swz / 64; C = (st & 1) * 32 + (swz % 64) / 2; }
__device__ __forceinline__ int perm32(int rho) { const int n = rho >> 4, i = rho & 15; return 8 * (i >> 2) + 4 * n + (i & 3); }
struct Unit { int pm, pn; const char* b; int e, pos0, cnt; };

__device__ __forceinline__ int xcd_remap(int L, int nwg) { const int q = nwg / NXCD, r = nwg % NXCD, xcd = L % NXCD, off = L / NXCD; return (xcd < r ? xcd * (q + 1) : r * (q + 1) + (xcd - r) * q) + off; }

struct DenseSched {
    int nM, nN, nwg, G, c, lda; const char* Bt; size_t btile;
    __device__ void init(int M, int N, int K, int lda_, const void* Bt_, int G_, int c_) { nM = M / BM; nN = N / BM; nwg = nM * nN; G = G_; c = c_; lda = lda_; Bt = (const char*)Bt_; btile = (size_t)BM * K * 2; }
    __device__ __forceinline__ void tile(int wgid, int& pm, int& pn) const { const int nig = WGM * nN, gid = wgid / nig, fm = gid * WGM, gsz = (nM - fm) < WGM ? (nM - fm) : WGM; pm = fm + ((wgid % nig) % gsz); pn = (wgid % nig) / gsz; }
    __device__ __forceinline__ bool next(int i, Unit& u) const { const int Lx = i * G + c; if (Lx >= nwg) return false; tile(xcd_remap(Lx, nwg), u.pm, u.pn); u.b = Bt + (size_t)u.pn * btile; u.e = 0; u.pos0 = 0; u.cnt = 0; return true; }
    __device__ __forceinline__ void aoff(const Unit& u, const int (&Rr)[2], const int (&Cc)[2], unsigned (&va)[2][2]) const {
#pragma unroll
        for (int h = 0; h < 2; ++h)
#pragma unroll
            for (int i = 0; i < 2; ++i) va[h][i] = (unsigned)((u.pm * BM + h * HALF + Rr[i]) * lda + Cc[i]) * 2u; }
};
struct InSched : DenseSched {
    __device__ void init2(const void* Bt_, int G_, int c_) { init(L, 8448, 1024, 1024, Bt_, G_, c_); }
    __device__ __forceinline__ bool next(int i, Unit& u) const {
        const int Lx = i * G + c; const int nlat = nwg;
        if (Lx < nlat) { tile(xcd_remap(Lx, nlat), u.pm, u.pn); }
        else { const int j = Lx - nlat; if (j >= 16 * 14) return false; const int q = j >> 4; u.pm = 128 + (j & 15); u.pn = q == 0 ? 3 : (q <= 12 ? 7 + q : 32); }
        u.b = Bt + (size_t)u.pn * btile; u.e = 0; u.pos0 = 0; u.cnt = 0; return true; }
};
template <bool GATHER> struct MoeSched {
    int nN, G, c; const char* Wt; size_t wexp, btile; const LAS int* tab; const int* list;
    __device__ __forceinline__ bool next(int i, Unit& u) const {
        const int nwg = tab[33] * nN; const int Lx = i * G + c; if (Lx >= nwg) return false;
        const int w = xcd_remap(Lx, nwg); const int rt = w / nN; u.pn = w % nN; u.pm = rt;
        int e = 0; while (tab[e + 1] <= rt) ++e;
        u.e = e; u.pos0 = (rt - tab[e]) * BM; u.cnt = tab[64 + e]; u.b = Wt + (size_t)e * wexp + (size_t)u.pn * btile; return true; }
    __device__ __forceinline__ void aoff(const Unit& u, const int (&Rr)[2], const int (&Cc)[2], unsigned (&va)[2][2]) const {
#pragma unroll
        for (int h = 0; h < 2; ++h)
#pragma unroll
            for (int i = 0; i < 2; ++i) {
                if (GATHER) { const int pos = u.pos0 + h * HALF + Rr[i]; const int pair = pos < u.cnt ? list[u.e * CAP + pos] : 0; va[h][i] = (unsigned)((pair >> 2) * D + Cc[i]) * 2u; }
                else va[h][i] = (unsigned)((u.pm * BM + h * HALF + Rr[i]) * D + Cc[i]) * 2u; } }
};

template <class Epi, class Sched>
__device__ __forceinline__ void gemm_phase(LAS unsigned char* lds, const char* Abase, const int K, const Sched& S, const Epi& E) {
    const int tid = threadIdx.x, wid = __builtin_amdgcn_readfirstlane(tid >> 6), lane = tid & 63, wr = wid >> 2, wc = wid & 3, fr = lane & 15, fq = lane >> 4;
    const int nt = K / BK;
    int Rr[2], Cc[2]; unsigned voffB[2];
#pragma unroll
    for (int i = 0; i < 2; ++i) { int R_, C_; stage_rc(tid * 16 + i * 8192, R_, C_); Rr[i] = R_; Cc[i] = C_; const int Rb = Epi::PERM ? ((R_ & ~31) + perm32(R_ & 31)) : R_; voffB[i] = (unsigned)(Rb * K + C_) * 2u; }
    const size_t kstep = (size_t)(BK * 2);
    const size_t hstep = (size_t)HALF * K * 2;
    const unsigned ldsw = (unsigned)wid * 1024u;
    const int aoff = lds_byte(wr * 64 + fr, fq * 8), boff = lds_byte(wc * 32 + fr, fq * 8);
#define PG8_SA(b, h) (((b) * 2 + (h)) * HTB)
#define PG8_SB(b, h) ((4 + (b) * 2 + (h)) * HTB)
#define PG8_STAGE_B(bufoff, gbase) do { _Pragma("unroll") for (int _i = 0; _i < 2; ++_i) \
        __builtin_amdgcn_global_load_lds((const unsigned*)((const char*)(gbase) + voffB[_i]), (LAS unsigned*)(lds + (bufoff) + ldsw + _i * 8192), 16, 0, 0); } while (0)
#define PG8_STAGE_A(bufoff, v0, v1, kb) do { \
        __builtin_amdgcn_global_load_lds((const unsigned*)(Abase + (kb) + (v0)), (LAS unsigned*)(lds + (bufoff) + ldsw), 16, 0, 0); \
        __builtin_amdgcn_global_load_lds((const unsigned*)(Abase + (kb) + (v1)), (LAS unsigned*)(lds + (bufoff) + ldsw + 8192), 16, 0, 0); } while (0)
#define PG8_LDA(dst, b, h) do { _Pragma("unroll") for (int m = 0; m < 4; ++m) _Pragma("unroll") for (int k = 0; k < 2; ++k) dst[m][k] = *(const LAS bf16x8*)(lds + PG8_SA(b, h) + aoff + m * 2048 + k * 1024); } while (0)
#define PG8_LDB(dst, b, h) do { _Pragma("unroll") for (int n = 0; n < 2; ++n) _Pragma("unroll") for (int k = 0; k < 2; ++k) dst[n][k] = *(const LAS bf16x8*)(lds + PG8_SB(b, h) + boff + n * 2048 + k * 1024); } while (0)
#define PG8_MMA(ai, bj, At, Bt) do { __builtin_amdgcn_s_setprio(1); _Pragma("unroll") for (int m = 0; m < 4; ++m) _Pragma("unroll") for (int n = 0; n < 2; ++n) _Pragma("unroll") for (int k = 0; k < 2; ++k) \
        acc[ai][bj][m][n] = __builtin_amdgcn_mfma_f32_16x16x32_bf16(Bt[n][k], At[m][k], acc[ai][bj][m][n], 0, 0, 0); __builtin_amdgcn_s_setprio(0); } while (0)
#define PG8_WAIT_V(n) asm volatile("s_waitcnt vmcnt(" #n ")" ::: "memory")
#define PG8_WAIT_L(n) asm volatile("s_waitcnt lgkmcnt(" #n ")" ::: "memory")
#define PG8_BAR __builtin_amdgcn_s_barrier()
#define PG8_SCHED __builtin_amdgcn_sched_barrier(0)
    Unit cur, nxt; int ui = 0;
    if (!S.next(0, cur)) return;
    f32x4 acc[2][2][4][2];
#pragma unroll
    for (int a = 0; a < 2; ++a)
#pragma unroll
        for (int b = 0; b < 2; ++b)
#pragma unroll
            for (int m = 0; m < 4; ++m)
#pragma unroll
                for (int n = 0; n < 2; ++n) acc[a][b][m][n] = (f32x4){0.f, 0.f, 0.f, 0.f};
    bf16x8 At[4][2], B0[2][2], B1[2][2];
    unsigned vc[2][2], vn[2][2];
    S.aoff(cur, Rr, Cc, vc);
    const char* cB = cur.b;
    PG8_STAGE_B(PG8_SB(0, 0), cB); PG8_STAGE_A(PG8_SA(0, 0), vc[0][0], vc[0][1], 0); PG8_STAGE_B(PG8_SB(0, 1), cB + hstep); PG8_STAGE_A(PG8_SA(0, 1), vc[1][0], vc[1][1], 0);
    if (wr == 1) PG8_BAR;
    PG8_WAIT_V(4); PG8_BAR;
    PG8_STAGE_B(PG8_SB(1, 0), cB + kstep); PG8_STAGE_A(PG8_SA(1, 0), vc[0][0], vc[0][1], kstep); PG8_STAGE_B(PG8_SB(1, 1), cB + hstep + kstep);
    PG8_WAIT_V(6); PG8_BAR;
    for (;;) {
        const bool has_next = S.next(ui + 1, nxt);
        if (has_next) S.aoff(nxt, Rr, Cc, vn);
        else {
#pragma unroll
            for (int h = 0; h < 2; ++h)
#pragma unroll
                for (int i = 0; i < 2; ++i) vn[h][i] = vc[h][i]; }
        const char* nB = has_next ? nxt.b : cB;
        for (int t = 0; t < nt; t += 2) {
            const bool last = (t == nt - 2);
            const size_t k1 = (size_t)(t + 1) * kstep;
            const size_t k2 = last ? 0 : (size_t)(t + 2) * kstep;
            const unsigned s00 = last ? vn[0][0] : vc[0][0], s01 = last ? vn[0][1] : vc[0][1], s10 = last ? vn[1][0] : vc[1][0], s11 = last ? vn[1][1] : vc[1][1];
            const char* b2 = last ? nB : cB + (size_t)(t + 2) * kstep; const char* b3 = b2 + kstep;
            PG8_LDB(B0, 0, 0); PG8_SCHED; PG8_LDA(At, 0, 0); PG8_STAGE_A(PG8_SA(1, 1), vc[1][0], vc[1][1], k1);
            PG8_WAIT_L(8); PG8_BAR; PG8_WAIT_L(0); PG8_MMA(0, 0, At, B0); PG8_BAR; PG8_SCHED;
            PG8_LDB(B1, 0, 1); PG8_STAGE_B(PG8_SB(0, 0), b2);
            PG8_BAR; PG8_WAIT_L(0); PG8_MMA(0, 1, At, B1); PG8_BAR;
            PG8_LDA(At, 0, 1); PG8_STAGE_A(PG8_SA(0, 0), s00, s01, k2);
            PG8_BAR; PG8_WAIT_L(0); PG8_MMA(1, 0, At, B0); PG8_BAR; PG8_SCHED;
            PG8_STAGE_B(PG8_SB(0, 1), b2 + hstep);
            PG8_WAIT_V(6); PG8_BAR; PG8_MMA(1, 1, At, B1); PG8_BAR;
            PG8_LDB(B0, 1, 0); PG8_SCHED; PG8_LDA(At, 1, 0); PG8_STAGE_A(PG8_SA(0, 1), s10, s11, k2);
            PG8_WAIT_L(8); PG8_BAR; PG8_WAIT_L(0); PG8_MMA(0, 0, At, B0); PG8_BAR; PG8_SCHED;
            PG8_LDB(B1, 1, 1); PG8_STAGE_B(PG8_SB(1, 0), b3);
            PG8_BAR; PG8_WAIT_L(0); PG8_MMA(0, 1, At, B1); PG8_BAR;
            PG8_LDA(At, 1, 1); PG8_STAGE_A(PG8_SA(1, 0), s00, s01, k2 + kstep);
            PG8_BAR; PG8_WAIT_L(0); PG8_MMA(1, 0, At, B0); PG8_BAR; PG8_SCHED;
            PG8_STAGE_B(PG8_SB(1, 1), b3 + hstep);
            PG8_WAIT_V(6); PG8_BAR; PG8_MMA(1, 1, At, B1); PG8_BAR;
        }
        E(acc, cur, wr, wc, fr, fq);
        if (!has_next) break;
#pragma unroll
        for (int a = 0; a < 2; ++a)
#pragma unroll
            for (int b = 0; b < 2; ++b)
#pragma unroll
                for (int m = 0; m < 4; ++m)
#pragma unroll
                    for (int n = 0; n < 2; ++n) acc[a][b][m][n] = (f32x4){0.f, 0.f, 0.f, 0.f};
        cur = nxt; cB = nB; ++ui;
#pragma unroll
        for (int h = 0; h < 2; ++h)
#pragma unroll
            for (int i = 0; i < 2; ++i) vc[h][i] = vn[h][i];
    }
    PG8_WAIT_V(0);
    if (wr == 0) PG8_BAR;
    PG8_BAR;
#undef PG8_SA
#undef PG8_SB
#undef PG8_STAGE_A
#undef PG8_STAGE_B
#undef PG8_LDA
#undef PG8_LDB
#undef PG8_MMA
#undef PG8_WAIT_V
#undef PG8_WAIT_L
#undef PG8_BAR
#undef PG8_SCHED
}

typedef f32x4 Acc[2][2][4][2];
__device__ __forceinline__ u32x4 pack8(const f32x4 v0, const f32x4 v1) { u32x4 w; w.x = cvt_pk_bf16(v0[0], v0[1]); w.y = cvt_pk_bf16(v0[2], v0[3]); w.z = cvt_pk_bf16(v1[0], v1[1]); w.w = cvt_pk_bf16(v1[2], v1[3]); return w; }

struct EpiIn { static constexpr bool PERM = true; char* ws;
    __device__ __forceinline__ void operator()(const Acc& acc, const Unit& u, int wr, int wc, int fr, int fq) const {
        const int pn = u.pn; size_t boff; int ld, cb;
        if (pn < 3) { boff = OFF_QA; ld = 768; cb = pn * 256; } else if (pn == 3) { boff = OFF_CKV; ld = 256; cb = 0; }
        else if (pn < 32) { boff = OFF_HQ + (size_t)((pn - 4) >> 2) * SEG_STRIDE; ld = 1024; cb = ((pn - 4) & 3) * 256; }
        else { boff = OFF_KR; ld = 64; cb = 0; }
        bf16_t* base = (bf16_t*)(ws + boff);
        const int row0 = u.pm * BM + wr * 64 + fr, col0 = wc * 32 + 8 * fq;
        if (pn == 32 && wc >= 2) return;
        float* ssq = (float*)(ws + (pn < 3 ? OFF_SSQQ : OFF_SSQKV));
#pragma unroll
        for (int ai = 0; ai < 2; ++ai)
#pragma unroll
            for (int m = 0; m < 4; ++m) { const int row = row0 + ai * HALF + m * 16; bf16_t* rowp = base + (size_t)row * ld + cb + col0;
                const f32x4 v0 = acc[ai][0][m][0], v1 = acc[ai][0][m][1];
                *(u32x4*)rowp = pack8(v0, v1);
                if (pn != 32) { const f32x4 w0 = acc[ai][1][m][0], w1 = acc[ai][1][m][1]; *(u32x4*)(rowp + HALF) = pack8(w0, w1);
                    if (pn <= 3) { float ss = (v0[0] * v0[0] + v0[1] * v0[1]) + (v0[2] * v0[2] + v0[3] * v0[3]) + (v1[0] * v1[0] + v1[1] * v1[1]) + (v1[2] * v1[2] + v1[3] * v1[3])
                                          + (w0[0] * w0[0] + w0[1] * w0[1]) + (w0[2] * w0[2] + w0[3] * w0[3]) + (w1[0] * w1[0] + w1[1] * w1[1]) + (w1[2] * w1[2] + w1[3] * w1[3]);
                        ss += __shfl_xor(ss, 16); ss += __shfl_xor(ss, 32); if (fq == 0) atomicAdd(ssq + row, ss); } } }
    } };

struct EpiQ { static constexpr bool PERM = true; bf16_t* q; const float* ssq;
    __device__ __forceinline__ void operator()(const Acc& acc, const Unit& u, int wr, int wc, int fr, int fq) const {
        const int row0 = u.pm * BM + wr * 64 + fr, col0 = u.pn * BM + wc * 32 + 8 * fq;
#pragma unroll
        for (int ai = 0; ai < 2; ++ai)
#pragma unroll
            for (int m = 0; m < 4; ++m) { const int row = row0 + ai * HALF + m * 16; const float rs = rsqrtf(ssq[row] * (1.0f / 768.0f) + EPS); bf16_t* rowp = q + (size_t)row * 1536 + col0;
#pragma unroll
                for (int bj = 0; bj < 2; ++bj) *(u32x4*)(rowp + bj * HALF) = pack8(acc[ai][bj][m][0] * rs, acc[ai][bj][m][1] * rs); }
    } };

struct EpiKV { static constexpr bool PERM = true; bf16_t *Kb, *Vb; const float* ssq;
    __device__ __forceinline__ void operator()(const Acc& acc, const Unit& u, int wr, int wc, int fr, int fq) const {
        const int row0 = u.pm * BM + wr * 64 + fr, col0 = wc * 32 + 8 * fq;
#pragma unroll
        for (int ai = 0; ai < 2; ++ai)
#pragma unroll
            for (int m = 0; m < 4; ++m) { const int row = row0 + ai * HALF + m * 16; const float rs = rsqrtf(ssq[row] * (1.0f / 256.0f) + EPS);
                int b, pos; if (row < L) { b = row >> 11; pos = row & 2047; } else { b = (row - L) >> 8; pos = SEQ + ((row - L) & 255); }
                const size_t kvrow = (size_t)(b * 8 + u.pn) * NKEY + pos;
                *(u32x4*)(Kb + kvrow * 192 + col0) = pack8(acc[ai][0][m][0] * rs, acc[ai][0][m][1] * rs);
                *(u32x4*)(Vb + kvrow * 128 + col0) = pack8(acc[ai][1][m][0] * rs, acc[ai][1][m][1] * rs); }
    } };

struct EpiOut { static constexpr bool PERM = false; float* x1; const float* x; const float* modv;
    __device__ __forceinline__ void operator()(const Acc& acc, const Unit& u, int wr, int wc, int fr, int fq) const {
        const int row0 = u.pm * BM + wr * 64 + fr, col0 = u.pn * BM + wc * 32 + 4 * fq;
#pragma unroll
        for (int ai = 0; ai < 2; ++ai)
#pragma unroll
            for (int m = 0; m < 4; ++m) { const int row = row0 + ai * HALF + m * 16; const float* gate = modv + (row >> 11) * 6144 + 2 * 1024 + col0; const float* xr = x + (size_t)row * D + col0; float* o = x1 + (size_t)row * D + col0;
#pragma unroll
                for (int bj = 0; bj < 2; ++bj)
#pragma unroll
                    for (int n = 0; n < 2; ++n) { const int co = bj * HALF + n * 16; const f32x4 g = *(const f32x4*)(gate + co), xv = *(const f32x4*)(xr + co); *(f32x4*)(o + co) = xv + g * acc[ai][bj][m][n]; } }
    } };

struct EpiMoe1 { static constexpr bool PERM = true; bf16_t* act; const float* bgu;
    __device__ __forceinline__ void operator()(const Acc& acc, const Unit& u, int wr, int wc, int fr, int fq) const {
        const int row0 = u.pm * BM + wr * 64 + fr, o0 = u.pn * 128 + wc * 16 + 4 * fq;
        f32x4 bg[2], bl[2];
#pragma unroll
        for (int bj = 0; bj < 2; ++bj) { const float* bp = bgu + u.e * 2048 + 2 * (o0 + bj * 64); const f32x4 t0 = *(const f32x4*)bp, t1 = *(const f32x4*)(bp + 4);
            bg[bj] = (f32x4){t0[0], t0[2], t1[0], t1[2]}; bl[bj] = (f32x4){t0[1], t0[3], t1[1], t1[3]}; }
#pragma unroll
        for (int ai = 0; ai < 2; ++ai)
#pragma unroll
            for (int m = 0; m < 4; ++m) { const int row = row0 + ai * HALF + m * 16; bf16_t* rowp = act + (size_t)row * D + o0;
#pragma unroll
                for (int bj = 0; bj < 2; ++bj) { const f32x4 g4 = acc[ai][bj][m][0] + bg[bj], l4 = acc[ai][bj][m][1] + bl[bj]; float r[4];
#pragma unroll
                    for (int j = 0; j < 4; ++j) { const float glu = fminf(g4[j], 7.0f), lin = fminf(fmaxf(l4[j], -7.0f), 7.0f); r[j] = glu * sigmoidf_(1.702f * glu) * (lin + 1.0f); }
                    u32x2 w; w.x = cvt_pk_bf16(r[0], r[1]); w.y = cvt_pk_bf16(r[2], r[3]); *(u32x2*)(rowp + bj * 64) = w; } }
    } };

struct EpiMoe2 { static constexpr bool PERM = true; bf16_t* yp; const float* bd; const int* list;
    __device__ __forceinline__ void operator()(const Acc& acc, const Unit& u, int wr, int wc, int fr, int fq) const {
        const int r0 = wr * 64 + fr, col0 = u.pn * BM + wc * 32 + 8 * fq;
        f32x4 bv[2][2];
#pragma unroll
        for (int bj = 0; bj < 2; ++bj)
#pragma unroll
            for (int n = 0; n < 2; ++n) bv[bj][n] = *(const f32x4*)(bd + u.e * 1024 + col0 + bj * HALF + 4 * n);
#pragma unroll
        for (int ai = 0; ai < 2; ++ai)
#pragma unroll
            for (int m = 0; m < 4; ++m) { const int pos = u.pos0 + r0 + ai * HALF + m * 16; if (pos < u.cnt) { const int pair = list[u.e * CAP + pos]; bf16_t* rowp = yp + (size_t)pair * D + col0;
#pragma unroll
                for (int bj = 0; bj < 2; ++bj) *(u32x4*)(rowp + bj * HALF) = pack8(acc[ai][bj][m][0] + bv[bj][0], acc[ai][bj][m][1] + bv[bj][1]); } }
    } };
}

__device__ __forceinline__ int conv_src_col(int kind, int c) {
    if (kind == 0) return c;
    if (kind == 1) { if (c < 1024) return c; if (c < 8192) return c + 64; if (c < 8256) return c - 8192 + 1024; return -1; }
    const int pn = c >> 8, p = c & 255, bj = p >> 7, wc = (p >> 5) & 3, fq = (p >> 3) & 3, n = (p >> 2) & 1, i = p & 3; const int o = 128 * pn + 64 * bj + 16 * wc + 4 * fq + i; return 2 * o + n;
}
__device__ __forceinline__ void conv_tile(LAS float* tl, const float* __restrict__ W, int ldw, bf16_t* Wt, int K, int kind, const float* __restrict__ kscale, int k0, int c0) {
    const int tid = threadIdx.x; const int cc = tid & 63, sc = conv_src_col(kind, c0 + cc);
#pragma unroll
    for (int i = 0; i < 8; ++i) { const int kk = (tid >> 6) + 8 * i; float v = 0.f; if (sc >= 0) { v = W[(size_t)(k0 + kk) * ldw + sc]; if (kscale) v *= kscale[k0 + kk]; } tl[kk * 65 + cc] = v; }
    __syncthreads();
    { const int c2 = tid >> 3, kq = (tid & 7) * 8; float v[8];
#pragma unroll
      for (int j = 0; j < 8; ++j) v[j] = tl[(kq + j) * 65 + c2];
      u32x4 w; w.x = cvt_pk_bf16(v[0], v[1]); w.y = cvt_pk_bf16(v[2], v[3]); w.z = cvt_pk_bf16(v[4], v[5]); w.w = cvt_pk_bf16(v[6], v[7]);
      *(u32x4*)(Wt + (size_t)(c0 + c2) * K + k0 + kq) = w; }
    __syncthreads();
}
__device__ __forceinline__ void conv_matrix(LAS float* tl, const float* W, int ldw, bf16_t* Wt, int K, int Nout, int kind, const float* kscale, int& tctr) {
    const int nk = K / 64, ntile = nk * (Nout / 64);
    for (int t = 0; t < ntile; ++t, ++tctr) { if ((tctr % (int)gridDim.x) != (int)blockIdx.x) continue; conv_tile(tl, W, ldw, Wt, K, kind, kscale, (t % nk) * 64, (t / nk) * 64); }
}

__device__ __forceinline__ float half_sum256(float v, LAS float* red) {
    for (int o = 32; o > 0; o >>= 1) v += __shfl_xor(v, o);
    const int w = threadIdx.x >> 6, hb = (threadIdx.x >> 8) * 4; if ((threadIdx.x & 63) == 0) red[w] = v; __syncthreads();
    const float t = red[hb] + red[hb + 1] + red[hb + 2] + red[hb + 3]; __syncthreads(); return t;
}

__device__ __forceinline__ void phase0(const Params& p, LAS unsigned char* lds) {
    char* ws = p.ws; const int tid = threadIdx.x, gsz = gridDim.x * 512, gid = blockIdx.x * 512 + tid;
    float* lb = (float*)(ws + OFF_LB); int* cnt = (int*)(ws + OFF_CNT); float* ssqq = (float*)(ws + OFF_SSQQ); float* ssqkv = (float*)(ws + OFF_SSQKV); float* modv = (float*)(ws + OFF_MOD);
    for (int i = gid; i < 2048; i += gsz) { const int d = i >> 10, j = i & 1023; const float a = p.lbl[(d * 2 + 0) * 1024 + j], b = p.lbl[(d * 2 + 1) * 1024 + j]; lb[i] = 1.0f / (1.0f + __expf(b - a)); }
    for (int i = gid; i < 32; i += gsz) cnt[i] = 0;
    for (int i = gid; i < L; i += gsz) ssqq[i] = 0.f;
    for (int i = gid; i < R; i += gsz) ssqkv[i] = 0.f;
    { LAS float* sil = (LAS float*)lds;
      LAS float* part = (LAS float*)(lds + 17 * 1024 * 4);
      bool loaded = false;
      for (int item = blockIdx.x; item < 96; item += gridDim.x) {
          if (!loaded) { for (int i = tid; i < 17 * 1024; i += 512) { const int r = i >> 10, k = i & 1023; sil[i] = siluf_(r < 16 ? p.c[r * 1024 + k] : p.cctx[k]); } loaded = true; __syncthreads(); }
          const int j = tid & 63, ks = tid >> 6; float a[17];
#pragma unroll
          for (int r = 0; r < 17; ++r) a[r] = 0.f;
          for (int k = ks * 128; k < ks * 128 + 128; ++k) { const float w = p.w_mod[(size_t)k * 6144 + item * 64 + j];
#pragma unroll
              for (int r = 0; r < 17; ++r) a[r] += sil[r * 1024 + k] * w; }
#pragma unroll
          for (int r = 0; r < 17; ++r) part[(ks * 17 + r) * 64 + j] = a[r];
          __syncthreads();
          for (int i = tid; i < 17 * 64; i += 512) { const int r = i >> 6, jj = i & 63; float s = p.b_mod[item * 64 + jj]; for (int q = 0; q < 8; ++q) s += part[(q * 17 + r) * 64 + jj]; modv[r * 6144 + item * 64 + jj] = s; }
          __syncthreads();
      } }
    __syncthreads();
    { LAS float* tl = (LAS float*)lds; int tctr = 0;
      conv_matrix(tl, p.w_in, 8256, (bf16_t*)(ws + OFF_WT_IN), 1024, 8448, 1, nullptr, tctr);
      conv_matrix(tl, p.w_qb, 1536, (bf16_t*)(ws + OFF_WT_QB), 768, 1536, 0, p.g_q, tctr);
      conv_matrix(tl, p.w_kvb, 2048, (bf16_t*)(ws + OFF_WT_KVB), 256, 2048, 0, p.g_kv, tctr);
      conv_matrix(tl, p.w_out, 1024, (bf16_t*)(ws + OFF_WT_OUT), 1024, 1024, 0, nullptr, tctr); }
}

__device__ __forceinline__ void phase1(const Params& p, LAS unsigned char* lds) {
    LAS float* red = (LAS float*)lds; const float* modv = (const float*)(p.ws + OFF_MOD); bf16_t* h = (bf16_t*)(p.ws + OFF_H);
    const int half = threadIdx.x >> 8, c = (threadIdx.x & 255) * 4;
    for (int row = blockIdx.x * 2 + half; row < R; row += gridDim.x * 2) {
        const float* src = row < L ? p.x + (size_t)row * D : p.ctx + (size_t)(row - L) * D; const float* mod = modv + (row < L ? row / SEQ : 16) * 6144;
        const float4 v = *(const float4*)(src + c);
        const float ss = half_sum256(v.x * v.x + v.y * v.y + v.z * v.z + v.w * v.w, red); const float rs = rsqrtf(ss * (1.0f / D) + EPS);
        const float4 g = *(const float4*)(p.g_mix + c), sc = *(const float4*)(mod + 1024 + c), sh = *(const float4*)(mod + c);
        u32x2 w; w.x = cvt_pk_bf16(v.x * rs * g.x * (1.0f + sc.x) + sh.x, v.y * rs * g.y * (1.0f + sc.y) + sh.y); w.y = cvt_pk_bf16(v.z * rs * g.z * (1.0f + sc.z) + sh.z, v.w * rs * g.w * (1.0f + sc.w) + sh.w);
        *(u32x2*)(h + (size_t)row * D + c) = w;
    }
}

__device__ __forceinline__ SegOut make_seg(char* ws) { SegOut so; so.qa = (bf16_t*)(ws + OFF_QA); so.ckv = (bf16_t*)(ws + OFF_CKV); so.kr = (bf16_t*)(ws + OFF_KR); so.hq = (bf16_t*)(ws + OFF_HQ); so.ff = (bf16_t*)(ws + OFF_FF);
    so.fb = (bf16_t*)(ws + OFF_FB); so.iv = (bf16_t*)(ws + OFF_IV); so.og = (bf16_t*)(ws + OFF_OG); so.gm = (bf16_t*)(ws + OFF_GM); so.gh = (bf16_t*)(ws + OFF_GH); return so; }

__device__ __forceinline__ void phase2(const Params& p, LAS unsigned char* lds) {
    pg8::InSched S; S.init2(p.ws + OFF_WT_IN, gridDim.x, blockIdx.x);
    pg8::EpiIn E{p.ws};
    pg8::gemm_phase(lds, (const char*)(p.ws + OFF_H), 1024, S, E);
}
__device__ __forceinline__ void phase3(const Params& p, LAS unsigned char* lds) {
    char* ws = p.ws;
    { pg8::DenseSched S; S.init(L, 1536, 768, 768, ws + OFF_WT_QB, gridDim.x, blockIdx.x); pg8::EpiQ E{(bf16_t*)(ws + OFF_Q), (const float*)(ws + OFF_SSQQ)}; pg8::gemm_phase(lds, (const char*)(ws + OFF_QA), 768, S, E); }
    { pg8::DenseSched S; S.init(R, 2048, 256, 256, ws + OFF_WT_KVB, gridDim.x, blockIdx.x); pg8::EpiKV E{(bf16_t*)(ws + OFF_K), (bf16_t*)(ws + OFF_V), (const float*)(ws + OFF_SSQKV)}; pg8::gemm_phase(lds, (const char*)(ws + OFF_CKV), 256, S, E); }
    { const bf16_t* kr = (const bf16_t*)(ws + OFF_KR); bf16_t* Kb = (bf16_t*)(ws + OFF_K);
      for (int gid = blockIdx.x * 512 + threadIdx.x; gid < R * 32; gid += gridDim.x * 512) { const int row = gid >> 5, i = gid & 31;
          const float x1 = bf2f(kr[(size_t)row * 64 + i]), x2 = bf2f(kr[(size_t)row * 64 + 32 + i]); float o1 = x1, o2 = x2; int b, pos;
          if (row < L) { b = row / SEQ; pos = row % SEQ; float cs, sn; rope_cs(pos, i, cs, sn); o1 = x1 * cs - x2 * sn; o2 = x1 * sn + x2 * cs; } else { b = (row - L) / CTXL; pos = SEQ + (row - L) % CTXL; }
          const bf16_t w1 = f2bf(o1), w2 = f2bf(o2);
          for (int h = 0; h < 8; ++h) { bf16_t* q = Kb + ((size_t)(b * 8 + h) * NKEY + pos) * 192 + 128; q[i] = w1; q[32 + i] = w2; } } }
}
__device__ __forceinline__ void phase4(const Params& p, LAS unsigned char*) {
    char* ws = p.ws; bf16_t* y = (bf16_t*)(ws + OFF_H); const bf16_t* of = (const bf16_t*)(ws + OFF_OF); const bf16_t* ob = (const bf16_t*)(ws + OFF_OB);
    const bf16_t* og = (const bf16_t*)(ws + OFF_OG); const bf16_t* gm = (const bf16_t*)(ws + OFF_GM); const bf16_t* gh = (const bf16_t*)(ws + OFF_GH);
    const int half = threadIdx.x >> 8, c = (threadIdx.x & 255) * 4;
    for (int row = blockIdx.x * 2 + half; row < L; row += gridDim.x * 2) { const size_t off = (size_t)row * D + c;
        const ushort4 a = *(const ushort4*)(of + off), bb = *(const ushort4*)(ob + off), g1 = *(const ushort4*)(og + off), g2 = *(const ushort4*)(gm + off), g3 = *(const ushort4*)(gh + off), ym = *(const ushort4*)(y + off);
        const bf16_t *ap = (const bf16_t*)&a, *bp = (const bf16_t*)&bb, *p1 = (const bf16_t*)&g1, *p2 = (const bf16_t*)&g2, *p3 = (const bf16_t*)&g3, *pm = (const bf16_t*)&ym;
        float o[4], ss = 0.f;
#pragma unroll
        for (int i = 0; i < 4; ++i) { o[i] = bf2f(ap[i]) + bf2f(bp[i]); ss += o[i] * o[i]; }
        for (int m = 16; m > 0; m >>= 1) ss += __shfl_xor(ss, m);
        const float rs = rsqrtf(ss * (1.0f / 128.0f) + EPS); float r[4];
#pragma unroll
        for (int i = 0; i < 4; ++i) { const float yh = o[i] * rs * p.g_hg[(c + i) & 127] * siluf_(bf2f(p1[i])); r[i] = sigmoidf_(bf2f(p2[i])) * bf2f(pm[i]) + sigmoidf_(bf2f(p3[i])) * yh; }
        u32x2 w; w.x = cvt_pk_bf16(r[0], r[1]); w.y = cvt_pk_bf16(r[2], r[3]); *(u32x2*)(y + off) = w; }
}
__device__ __forceinline__ void phase5(const Params& p, LAS unsigned char* lds) {
    char* ws = p.ws;
    { pg8::DenseSched S; S.init(L, 1024, 1024, 1024, ws + OFF_WT_OUT, gridDim.x, blockIdx.x); pg8::EpiOut E{p.out, p.x, (const float*)(ws + OFF_MOD)}; pg8::gemm_phase(lds, (const char*)(ws + OFF_H), 1024, S, E); }
    { LAS float* tl = (LAS float*)lds; int tctr = 0;
      for (int e = 0; e < NE; ++e) conv_matrix(tl, p.w_gu + (size_t)e * 1024 * 2048, 2048, (bf16_t*)(ws + OFF_WT_GU) + (size_t)e * 2048 * 1024, 1024, 2048, 2, nullptr, tctr);
      for (int e = 0; e < NE; ++e) conv_matrix(tl, p.w_dn + (size_t)e * 1024 * 1024, 1024, (bf16_t*)(ws + OFF_WT_DN) + (size_t)e * 1024 * 1024, 1024, 1024, 0, nullptr, tctr); }
}
__device__ __forceinline__ void phase6(const Params& p, LAS unsigned char* lds) {
    char* ws = p.ws; const float* modv = (const float*)(ws + OFF_MOD); bf16_t* h2 = (bf16_t*)(ws + OFF_H); int* topi = (int*)(ws + OFF_TOPI); float* topp = (float*)(ws + OFF_TOPP); int* cnt = (int*)(ws + OFF_CNT); int* list = (int*)(ws + OFF_LIST);
    LAS float* red = (LAS float*)lds;
    LAS float* hs = (LAS float*)(lds + 64);
    LAS float* part = (LAS float*)(lds + 64 + 8192);
    LAS int* lcnt = (LAS int*)(lds + 64 + 8192 + 2048);
    LAS int* lent = (LAS int*)(lds + 64 + 8192 + 2048 + 512);
    const int tid = threadIdx.x, half = tid >> 8, t2 = tid & 255, c = t2 * 4;
    if (tid < 96) lcnt[tid] = 0;
    __syncthreads();
    int it = 0;
    for (int row0 = blockIdx.x * 2; row0 < L; row0 += gridDim.x * 2, ++it) {
        const int row = row0 + half; const float* mod = modv + (row / SEQ) * 6144;
        const float4 v = *(const float4*)(p.out + (size_t)row * D + c);
        const float ss = half_sum256(v.x * v.x + v.y * v.y + v.z * v.z + v.w * v.w, red); const float rs = rsqrtf(ss * (1.0f / D) + EPS);
        const float4 g = *(const float4*)(p.g_ffn + c), sc = *(const float4*)(mod + 4 * 1024 + c), sh = *(const float4*)(mod + 3 * 1024 + c);
        float o[4] = {v.x * rs * g.x * (1.0f + sc.x) + sh.x, v.y * rs * g.y * (1.0f + sc.y) + sh.y, v.z * rs * g.z * (1.0f + sc.z) + sh.z, v.w * rs * g.w * (1.0f + sc.w) + sh.w};
#pragma unroll
        for (int i = 0; i < 4; ++i) hs[half * 1024 + c + i] = o[i];
        u32x2 w; w.x = cvt_pk_bf16(o[0], o[1]); w.y = cvt_pk_bf16(o[2], o[3]); *(u32x2*)(h2 + (size_t)row * D + c) = w;
        __syncthreads();
        { const int e = t2 & 31, q = t2 >> 5; float a = 0.f; for (int j = q * 128; j < q * 128 + 128; ++j) a += hs[half * 1024 + j] * p.w_r[j * 32 + e]; part[(half * 8 + q) * 32 + e] = a; }
        __syncthreads();
        if (t2 < 64) {
            const int e = t2 & 31; float cur = p.b_r[e];
#pragma unroll
            for (int q = 0; q < 8; ++q) cur += part[(half * 8 + q) * 32 + e];
            float tv0 = 0.f, sum = 0.f; int sel_i[4]; float sel_e[4];
#pragma unroll
            for (int k = 0; k < 4; ++k) { float m = cur; int mi = e;
#pragma unroll
                for (int o2 = 16; o2 > 0; o2 >>= 1) { const float om = __shfl_xor(m, o2); const int oi = __shfl_xor(mi, o2); if (om > m || (om == m && oi < mi)) { m = om; mi = oi; } }
                if (k == 0) tv0 = m; sel_i[k] = mi; sel_e[k] = __expf(m - tv0); sum += sel_e[k]; if (e == mi) cur = -3.0e38f; }
            int myk = 0; float myp = 0.f;
#pragma unroll
            for (int k = 0; k < 4; ++k) if (t2 == k) { myk = sel_i[k]; myp = sel_e[k] / sum; }
            if (t2 < 4) { const int pair = row * 4 + t2; topi[pair] = myk; topp[pair] = myp; __hip_atomic_fetch_add(&lcnt[myk], 1, __ATOMIC_RELAXED, __HIP_MEMORY_SCOPE_WORKGROUP); lent[(it * 2 + half) * 4 + t2] = myk; }
        }
        __syncthreads();
    }
    if (tid < 32) { const int n = lcnt[tid]; lcnt[32 + tid] = n > 0 ? atomicAdd(&cnt[tid], n) : 0; lcnt[64 + tid] = 0; }
    __syncthreads();
    const int nent = it * 8;
    for (int s = tid; s < nent; s += 512) { const int e = lent[s]; const int ii = s >> 3, hh = (s >> 2) & 1, k = s & 3; const int row = blockIdx.x * 2 + ii * gridDim.x * 2 + hh; const int pos = lcnt[32 + e] + __hip_atomic_fetch_add(&lcnt[64 + e], 1, __ATOMIC_RELAXED, __HIP_MEMORY_SCOPE_WORKGROUP); list[e * CAP + pos] = row * 4 + k; }
}
__device__ __forceinline__ void moe_table(const int* cnt, LAS int* tab) {
    if (threadIdx.x == 0) { int t = 0; for (int e = 0; e < NE; ++e) { tab[e] = t; const int n = cnt[e]; tab[64 + e] = n; t += (n + 255) >> 8; } tab[32] = t; tab[33] = t; }
    __syncthreads();
}
constexpr int LDS_TAB = pg8::STAGE_BYTES;
__device__ __forceinline__ void phase7(const Params& p, LAS unsigned char* lds) {
    char* ws = p.ws; LAS int* tab = (LAS int*)(lds + LDS_TAB); moe_table((const int*)(ws + OFF_CNT), tab);
    pg8::MoeSched<true> S; S.nN = 8; S.G = gridDim.x; S.c = blockIdx.x; S.Wt = ws + OFF_WT_GU; S.wexp = (size_t)2048 * 1024 * 2; S.btile = (size_t)256 * 1024 * 2; S.tab = tab; S.list = (const int*)(ws + OFF_LIST);
    pg8::EpiMoe1 E{(bf16_t*)(ws + OFF_ACT), p.b_gu};
    pg8::gemm_phase(lds, (const char*)(ws + OFF_H), 1024, S, E);
}
__device__ __forceinline__ void phase8(const Params& p, LAS unsigned char* lds) {
    char* ws = p.ws; LAS int* tab = (LAS int*)(lds + LDS_TAB); moe_table((const int*)(ws + OFF_CNT), tab);
    pg8::MoeSched<false> S; S.nN = 4; S.G = gridDim.x; S.c = blockIdx.x; S.Wt = ws + OFF_WT_DN; S.wexp = (size_t)1024 * 1024 * 2; S.btile = (size_t)256 * 1024 * 2; S.tab = tab; S.list = (const int*)(ws + OFF_LIST);
    pg8::EpiMoe2 E{(bf16_t*)(ws + OFF_YP), p.b_dn, (const int*)(ws + OFF_LIST)};
    pg8::gemm_phase(lds, (const char*)(ws + OFF_ACT), 1024, S, E);
}
__device__ __forceinline__ void phase9(const Params& p, LAS unsigned char* lds) {
    char* ws = p.ws; LAS float* red = (LAS float*)lds; const float* modv = (const float*)(ws + OFF_MOD); const bf16_t* yp = (const bf16_t*)(ws + OFF_YP); const float* topp = (const float*)(ws + OFF_TOPP);
    const int half = threadIdx.x >> 8, c = (threadIdx.x & 255) * 4;
    for (int row = blockIdx.x * 2 + half; row < L; row += gridDim.x * 2) {
        const float* gate = modv + (row / SEQ) * 6144 + 5 * 1024; const float4 v = *(const float4*)(p.out + (size_t)row * D + c); float xv[4] = {v.x, v.y, v.z, v.w}, m[4] = {0.f, 0.f, 0.f, 0.f};
#pragma unroll
        for (int k = 0; k < 4; ++k) { const float pk = topp[row * 4 + k]; const ushort4 u = *(const ushort4*)(yp + (size_t)(row * 4 + k) * D + c); const bf16_t* up = (const bf16_t*)&u;
#pragma unroll
            for (int i = 0; i < 4; ++i) m[i] += pk * bf2f(up[i]); }
        float ss = 0.f;
#pragma unroll
        for (int i = 0; i < 4; ++i) { xv[i] += gate[c + i] * m[i]; ss += xv[i] * xv[i]; }
        ss = half_sum256(ss, red); const float rs = rsqrtf(ss * (1.0f / D) + EPS); const float4 fg = *(const float4*)(p.g_fin + c);
        float4 o; o.x = xv[0] * rs * fg.x; o.y = xv[1] * rs * fg.y; o.z = xv[2] * rs * fg.z; o.w = xv[3] * rs * fg.w; *(float4*)(p.out + (size_t)row * D + c) = o; }
}

constexpr int LDS_BYTES = 147456;
template <int PH> __global__ void __launch_bounds__(512, 2) k_phase(Params p) {
    extern __shared__ __attribute__((aligned(16))) unsigned char smem[];
    LAS unsigned char* lds = (LAS unsigned char*)smem;
    if constexpr (PH == 0) phase0(p, lds);
    if constexpr (PH == 1) phase1(p, lds);
    if constexpr (PH == 2) phase2(p, lds);
    if constexpr (PH == 3) phase3(p, lds);
    if constexpr (PH == 4) phase4(p, lds);
    if constexpr (PH == 5) phase5(p, lds);
    if constexpr (PH == 6) phase6(p, lds);
    if constexpr (PH == 7) phase7(p, lds);
    if constexpr (PH == 8) phase8(p, lds);
    if constexpr (PH == 9) phase9(p, lds);
}
template <int PH> static void launch_phase(const Params& p, int grid, hipStream_t stream) {
    static bool attr = false;
    if (!attr) { (void)hipFuncSetAttribute((const void*)k_phase<PH>, hipFuncAttributeMaxDynamicSharedMemorySize, LDS_BYTES); attr = true; }
    hipLaunchKernelGGL(k_phase<PH>, dim3(grid), dim3(512), LDS_BYTES, stream, p);
}
extern "C" void kernel_launch(void* const* d_in, const int* in_sizes, int n_in, void* d_out, int out_size, void* d_ws, size_t ws_size, hipStream_t stream) {
    Params p{};
    p.x = (const float*)d_in[0]; p.c = (const float*)d_in[1]; p.ctx = (const float*)d_in[2]; p.cctx = (const float*)d_in[3]; p.w_mod = (const float*)d_in[4]; p.b_mod = (const float*)d_in[5];
    p.g_mix = (const float*)d_in[6]; p.w_in = (const float*)d_in[7]; p.g_q = (const float*)d_in[8]; p.w_qb = (const float*)d_in[9]; p.g_kv = (const float*)d_in[10]; p.w_kvb = (const float*)d_in[11];
    p.lbl = (const float*)d_in[12]; p.g_hg = (const float*)d_in[13]; p.w_out = (const float*)d_in[14]; p.g_ffn = (const float*)d_in[15]; p.w_r = (const float*)d_in[16]; p.b_r = (const float*)d_in[17];
    p.w_gu = (const float*)d_in[18]; p.b_gu = (const float*)d_in[19]; p.w_dn = (const float*)d_in[20]; p.b_dn = (const float*)d_in[21]; p.g_fin = (const float*)d_in[22];
    p.out = (float*)d_out; p.ws = (char*)d_ws;
    char* ws = (char*)d_ws; const int grid = 256;
    SegOut so; so.qa = (bf16_t*)(ws + OFF_QA); so.ckv = (bf16_t*)(ws + OFF_CKV); so.kr = (bf16_t*)(ws + OFF_KR); so.hq = (bf16_t*)(ws + OFF_HQ); so.ff = (bf16_t*)(ws + OFF_FF);
    so.fb = (bf16_t*)(ws + OFF_FB); so.iv = (bf16_t*)(ws + OFF_IV); so.og = (bf16_t*)(ws + OFF_OG); so.gm = (bf16_t*)(ws + OFF_GM); so.gh = (bf16_t*)(ws + OFF_GH);
    launch_phase<0>(p, grid, stream);
    launch_phase<1>(p, grid, stream);
    launch_phase<2>(p, grid, stream);
    launch_phase<3>(p, grid, stream);
    k_nattn<<<NB * 8 * 512, 256, 0, stream>>>((const bf16_t*)(ws + OFF_Q), (const bf16_t*)(ws + OFF_K), (const bf16_t*)(ws + OFF_V), (bf16_t*)(ws + OFF_H));
    k_nscan<<<NB * 8 * 2, 256, 0, stream>>>(so.hq, so.ff, so.fb, so.iv, (const float*)(ws + OFF_LB), (bf16_t*)(ws + OFF_OF), (bf16_t*)(ws + OFF_OB));
    launch_phase<4>(p, grid, stream);
    launch_phase<5>(p, grid, stream);
    launch_phase<6>(p, grid, stream);
    launch_phase<7>(p, grid, stream);
    launch_phase<8>(p, grid, stream);
    launch_phase<9>(p, grid, stream);
}
```

```cpp
#include <hip/hip_runtime.h>
#include <stdint.h>

typedef unsigned short bf16_t;
__device__ __forceinline__ float bf2f(bf16_t v) { return __uint_as_float(((unsigned)v) << 16); }
__device__ __forceinline__ bf16_t f2bf(float f) { unsigned u = __float_as_uint(f); u += 0x7FFFu + ((u >> 16) & 1u); return (bf16_t)(u >> 16); }
__device__ __forceinline__ float sigmoidf_(float x) { return 1.0f / (1.0f + __expf(-x)); }
__device__ __forceinline__ float siluf_(float x) { return x / (1.0f + __expf(-x)); }

constexpr int D = 1024, NB = 16, SEQ = 2048, CTXL = 256;
constexpr int L = NB * SEQ;
constexpr int RC = NB * CTXL;
constexpr int R = L + RC;
constexpr int NKEY = SEQ + CTXL;
constexpr float EPS = 1e-6f;
constexpr int NE = 32, CAP = 32768;
constexpr int MAXROWS = 131072 + NE * 256;

constexpr size_t MiB = 1048576;
constexpr size_t OFF_SMALL = 0;
constexpr size_t OFF_BAR = 0;
constexpr size_t OFF_CNT = 16384;
constexpr size_t OFF_OFFS = 16384 + 1024;
constexpr size_t OFF_TILEE = 16384 + 2048;
constexpr size_t OFF_LB = 24576;
constexpr size_t OFF_MOD = 32768;
constexpr size_t OFF_SSQQ = 512 * 1024;
constexpr size_t OFF_SSQKV = 768 * 1024;
constexpr size_t OFF_TOPI = 1 * MiB;
constexpr size_t OFF_TOPP = 1 * MiB + 512 * 1024;
constexpr size_t OFF_ROWPAIR = 2 * MiB;
constexpr size_t OFF_LIST = 3 * MiB;
constexpr size_t OFF_H = 32 * MiB;
constexpr size_t OFF_QA = 104 * MiB;
constexpr size_t OFF_CKV = 152 * MiB;
constexpr size_t OFF_KR = 170 * MiB;
constexpr size_t OFF_OF = 104 * MiB;
constexpr size_t OFF_HQ = 175 * MiB;
constexpr size_t SEG_STRIDE = 72 * MiB;
constexpr size_t OFF_FF = OFF_HQ + 1 * SEG_STRIDE;
constexpr size_t OFF_FB = OFF_HQ + 2 * SEG_STRIDE;
constexpr size_t OFF_IV = OFF_HQ + 3 * SEG_STRIDE;
constexpr size_t OFF_OG = OFF_HQ + 4 * SEG_STRIDE;
constexpr size_t OFF_GM = OFF_HQ + 5 * SEG_STRIDE;
constexpr size_t OFF_GH = OFF_HQ + 6 * SEG_STRIDE;
constexpr size_t OFF_Q = 679 * MiB;
constexpr size_t OFF_K = 775 * MiB;
constexpr size_t OFF_V = 883 * MiB;
constexpr size_t OFF_OB = 955 * MiB;
constexpr size_t OFF_YP = 296 * MiB;
constexpr size_t OFF_ACT = 568 * MiB;

struct SegOut { bf16_t *qa, *ckv, *kr, *hq, *ff, *fb, *iv, *og, *gm, *gh; };

__global__ void k_init(const float* __restrict__ lbl, float* lb, int* cnt) {
    int i = blockIdx.x * blockDim.x + threadIdx.x;
    if (i < 2048) { int d = i >> 10, j = i & 1023; float a = lbl[(d * 2 + 0) * 1024 + j], b = lbl[(d * 2 + 1) * 1024 + j]; lb[i] = 1.0f / (1.0f + __expf(b - a)); }
    if (i < 32) cnt[i] = 0;
}

__global__ __launch_bounds__(256) void k_mod(const float* __restrict__ c, const float* __restrict__ cctx, const float* __restrict__ wmod, const float* __restrict__ bmod, float* modv) {
    __shared__ float s[1024];
    int r = blockIdx.y; const float* src = r < 16 ? c + r * 1024 : cctx;
    for (int k = threadIdx.x; k < 1024; k += 256) s[k] = siluf_(src[k]);
    __syncthreads();
    int j = blockIdx.x * 256 + threadIdx.x; float acc = 0.f;
    for (int k = 0; k < 1024; ++k) acc += s[k] * wmod[(size_t)k * 6144 + j];
    modv[r * 6144 + j] = acc + bmod[j];
}

__device__ __forceinline__ float block_sum256(float v, float* red) {
    for (int o = 32; o > 0; o >>= 1) v += __shfl_xor(v, o);
    int w = threadIdx.x >> 6; if ((threadIdx.x & 63) == 0) red[w] = v; __syncthreads();
    float t = red[0] + red[1] + red[2] + red[3]; __syncthreads(); return t;
}

__global__ __launch_bounds__(256) void k_norm1(const float* __restrict__ x, const float* __restrict__ ctx, const float* __restrict__ g, const float* __restrict__ modv, bf16_t* h) {
    __shared__ float red[4];
    int row = blockIdx.x; const float* src = row < L ? x + (size_t)row * D : ctx + (size_t)(row - L) * D;
    const float* mod = modv + (row < L ? row / SEQ : 16) * 6144;
    int c = threadIdx.x * 4; float4 v = *(const float4*)(src + c);
    float ss = block_sum256(v.x * v.x + v.y * v.y + v.z * v.z + v.w * v.w, red);
    float rs = rsqrtf(ss * (1.0f / D) + EPS);
    float o[4] = {v.x, v.y, v.z, v.w}; ushort4 w; bf16_t* wp = (bf16_t*)&w;
    for (int i = 0; i < 4; ++i) wp[i] = f2bf(o[i] * rs * g[c + i] * (1.0f + mod[1024 + c + i]) + mod[c + i]);
    *(ushort4*)(h + (size_t)row * D + c) = w;
}

__global__ __launch_bounds__(256) void k_rowssq(const bf16_t* __restrict__ buf, int width, int nrows, float* ssq) {
    int row = blockIdx.x * 4 + (threadIdx.x >> 6), lane = threadIdx.x & 63; if (row >= nrows) return;
    float s = 0.f; for (int k = lane; k < width; k += 64) { float v = bf2f(buf[(size_t)row * width + k]); s += v * v; }
    for (int o = 32; o > 0; o >>= 1) s += __shfl_xor(s, o);
    if (lane == 0) ssq[row] = s;
}

__device__ __forceinline__ void rope_cs(int t, int i, float& cs, float& sn) {
    int j = i & 15; float inv = __expf(-(float)j * (9.210340371976184f / 16.0f)); float pos = (i < 16) ? (float)(t >> 6) : (float)(t & 63);
    float ang = pos * inv; cs = cosf(ang); sn = sinf(ang);
}

__global__ __launch_bounds__(256) void k_krope(const bf16_t* __restrict__ kr, bf16_t* Kb) {
    int gid = blockIdx.x * 256 + threadIdx.x; int row = gid >> 5, i = gid & 31; if (row >= R) return;
    float x1 = bf2f(kr[(size_t)row * 64 + i]), x2 = bf2f(kr[(size_t)row * 64 + 32 + i]); float o1 = x1, o2 = x2; int b, pos;
    if (row < L) { b = row / SEQ; pos = row % SEQ; float cs, sn; rope_cs(pos, i, cs, sn); o1 = x1 * cs - x2 * sn; o2 = x1 * sn + x2 * cs; }
    else { b = (row - L) / CTXL; pos = SEQ + (row - L) % CTXL; }
    bf16_t w1 = f2bf(o1), w2 = f2bf(o2);
    for (int h = 0; h < 8; ++h) { bf16_t* p = Kb + ((size_t)(b * 8 + h) * NKEY + pos) * 192 + 128; p[i] = w1; p[32 + i] = w2; }
}

template <class AL, class EP>
__global__ __launch_bounds__(256) void k_ngemm(int K, const float* __restrict__ W, int ldw, size_t wzstride, AL al, EP ep) {
    __shared__ float As[16][68]; __shared__ float Bs[16][64];
    const int z = blockIdx.z, row0 = blockIdx.y * 64, col0 = blockIdx.x * 64, tid = threadIdx.x;
    const int mvalid = al.rows(z); if (row0 >= mvalid) return;
    const float* Wz = W + (size_t)z * wzstride;
    const int ar = tid >> 2, ak = (tid & 3) * 4; const bf16_t* arow = (row0 + ar < mvalid) ? al.rowptr(z, row0 + ar) : nullptr;
    const int bk = tid >> 4, bn = (tid & 15) * 4;
    const int ty = tid >> 4, tx = tid & 15;
    float acc[4][4] = {};
    for (int k0 = 0; k0 < K; k0 += 16) {
        float a4[4] = {0.f, 0.f, 0.f, 0.f};
        if (arow) { ushort4 u = *(const ushort4*)(arow + k0 + ak); const bf16_t* up = (const bf16_t*)&u; for (int i = 0; i < 4; ++i) a4[i] = bf2f(up[i]) * al.kscale(k0 + ak + i); }
        float4 b4 = *(const float4*)(Wz + (size_t)(k0 + bk) * ldw + col0 + bn);
        __syncthreads();
        for (int i = 0; i < 4; ++i) As[ak + i][ar] = a4[i];
        *(float4*)&Bs[bk][bn] = b4;
        __syncthreads();
#pragma unroll
        for (int kk = 0; kk < 16; ++kk) {
            float4 av = *(const float4*)&As[kk][ty * 4]; float4 bv = *(const float4*)&Bs[kk][tx * 4];
            float a[4] = {av.x, av.y, av.z, av.w}, b[4] = {bv.x, bv.y, bv.z, bv.w};
#pragma unroll
            for (int i = 0; i < 4; ++i)
#pragma unroll
                for (int j = 0; j < 4; ++j) acc[i][j] += a[i] * b[j];
        }
    }
    for (int i = 0; i < 4; ++i) { int row = row0 + ty * 4 + i; if (row < mvalid) ep.store(z, row, col0 + tx * 4, acc[i]); }
}

__device__ __forceinline__ void st4bf(bf16_t* dst, const float* v) { ushort4 w; bf16_t* wp = (bf16_t*)&w; for (int i = 0; i < 4; ++i) wp[i] = f2bf(v[i]); *(ushort4*)dst = w; }

struct ALDense { const bf16_t* A; int lda; int nrows; const float* ks;
    __device__ int rows(int) const { return nrows; }
    __device__ const bf16_t* rowptr(int, int row) const { return A + (size_t)row * lda; }
    __device__ float kscale(int k) const { return ks ? ks[k] : 1.0f; } };

struct EpiInN { SegOut s;
    __device__ void store(int, int row, int col, const float* v) const {
        bf16_t* dst;
        if (col < 768) { if (row >= L) return; dst = s.qa + (size_t)row * 768 + col; }
        else if (col < 1024) dst = s.ckv + (size_t)row * 256 + (col - 768);
        else if (col < 1088) dst = s.kr + (size_t)row * 64 + (col - 1024);
        else { int c = col - 1088, seg = c >> 10, cc = c & 1023; bool latonly = (seg == 0 || seg >= 4); if (latonly && row >= L) return;
            bf16_t* base = seg == 0 ? s.hq : seg == 1 ? s.ff : seg == 2 ? s.fb : seg == 3 ? s.iv : seg == 4 ? s.og : seg == 5 ? s.gm : s.gh;
            dst = base + (size_t)row * 1024 + cc; }
        st4bf(dst, v);
    } };

struct EpiQN { bf16_t* q; const float* ssq;
    __device__ void store(int, int row, int col, const float* v) const { float rs = rsqrtf(ssq[row] * (1.0f / 768.0f) + EPS); float o[4]; for (int i = 0; i < 4; ++i) o[i] = v[i] * rs; st4bf(q + (size_t)row * 1536 + col, o); } };

struct EpiKVN { bf16_t *Kb, *Vb; const float* ssq;
    __device__ void store(int, int row, int col, const float* v) const {
        float rs = rsqrtf(ssq[row] * (1.0f / 256.0f) + EPS); float o[4]; for (int i = 0; i < 4; ++i) o[i] = v[i] * rs;
        int b, pos; if (row < L) { b = row / SEQ; pos = row % SEQ; } else { b = (row - L) / CTXL; pos = SEQ + (row - L) % CTXL; }
        int h = col >> 8, w = col & 255; size_t kvrow = (size_t)(b * 8 + h) * NKEY + pos;
        if (w < 128) st4bf(Kb + kvrow * 192 + w, o); else st4bf(Vb + kvrow * 128 + (w - 128), o);
    } };

struct EpiOutN { float* x1; const float* x; const float* modv;
    __device__ void store(int, int row, int col, const float* v) const {
        const float* gate = modv + (row / SEQ) * 6144 + 2 * 1024; float4 xv = *(const float4*)(x + (size_t)row * D + col);
        float4 o; o.x = xv.x + gate[col] * v[0]; o.y = xv.y + gate[col + 1] * v[1]; o.z = xv.z + gate[col + 2] * v[2]; o.w = xv.w + gate[col + 3] * v[3];
        *(float4*)(x1 + (size_t)row * D + col) = o;
    } };

struct ALMoe1 { const bf16_t* h2; const int* cnt; const int* list;
    __device__ int rows(int z) const { return cnt[z]; }
    __device__ const bf16_t* rowptr(int z, int row) const { return h2 + (size_t)(list[z * CAP + row] >> 2) * D; }
    __device__ float kscale(int) const { return 1.0f; } };
struct EpiMoe1N { bf16_t* act; const int* offs; const float* bgu;
    __device__ void store(int z, int row, int col, const float* v) const {
        const float* bb = bgu + z * 2048 + col; ushort2 w; bf16_t* wp = (bf16_t*)&w;
        for (int p = 0; p < 2; ++p) { float glu = fminf(v[2 * p] + bb[2 * p], 7.0f); float lin = fminf(fmaxf(v[2 * p + 1] + bb[2 * p + 1], -7.0f), 7.0f);
            wp[p] = f2bf(glu * sigmoidf_(1.702f * glu) * (lin + 1.0f)); }
        *(ushort2*)(act + (size_t)(offs[z] + row) * D + (col >> 1)) = w;
    } };
struct ALMoe2 { const bf16_t* act; const int* cnt; const int* offs;
    __device__ int rows(int z) const { return cnt[z]; }
    __device__ const bf16_t* rowptr(int z, int row) const { return act + (size_t)(offs[z] + row) * D; }
    __device__ float kscale(int) const { return 1.0f; } };
struct EpiMoe2N { bf16_t* yp; const int* list; const float* bd;
    __device__ void store(int z, int row, int col, const float* v) const {
        int pair = list[z * CAP + row]; const float* bb = bd + z * 1024 + col; float o[4]; for (int i = 0; i < 4; ++i) o[i] = v[i] + bb[i];
        st4bf(yp + (size_t)pair * D + col, o);
    } };

__global__ __launch_bounds__(256) void k_nattn(const bf16_t* __restrict__ Q, const bf16_t* __restrict__ Kb, const bf16_t* __restrict__ Vb, bf16_t* Y) {
    __shared__ float qs[4][192]; __shared__ float sc[4][NKEY];
    const int tid = threadIdx.x, blk = blockIdx.x, qg = blk & 511, h = (blk >> 9) & 7, b = blk >> 12;
    for (int idx = tid; idx < 4 * 192; idx += 256) { int qi = idx / 192, d = idx % 192; int row = b * SEQ + qg * 4 + qi; qs[qi][d] = bf2f(Q[(size_t)row * 1536 + h * 192 + d]); }
    __syncthreads();
    float n1 = 0.f, n2 = 0.f;
    if (tid < 128) { int qi = tid >> 5, i = tid & 31; int t = qg * 4 + qi; float cs, sn; rope_cs(t, i, cs, sn); float x1 = qs[qi][128 + i], x2 = qs[qi][160 + i]; n1 = x1 * cs - x2 * sn; n2 = x1 * sn + x2 * cs; }
    __syncthreads();
    if (tid < 128) { int qi = tid >> 5, i = tid & 31; qs[qi][128 + i] = n1; qs[qi][160 + i] = n2; }
    __syncthreads();
    const bf16_t* Kp = Kb + (size_t)(b * 8 + h) * NKEY * 192; const bf16_t* Vp = Vb + (size_t)(b * 8 + h) * NKEY * 128;
    const float scale = 0.07216878364870322f;
    for (int key = tid; key < NKEY; key += 256) {
        const bf16_t* kr = Kp + (size_t)key * 192; float s0 = 0.f, s1 = 0.f, s2 = 0.f, s3 = 0.f;
        for (int d = 0; d < 192; d += 8) { uint4 u = *(const uint4*)(kr + d); const bf16_t* up = (const bf16_t*)&u;
            for (int j = 0; j < 8; ++j) { float kv = bf2f(up[j]); s0 += qs[0][d + j] * kv; s1 += qs[1][d + j] * kv; s2 += qs[2][d + j] * kv; s3 += qs[3][d + j] * kv; } }
        sc[0][key] = s0 * scale; sc[1][key] = s1 * scale; sc[2][key] = s2 * scale; sc[3][key] = s3 * scale;
    }
    __syncthreads();
    { int w = tid >> 6, lane = tid & 63; float m = -1e30f; for (int k = lane; k < NKEY; k += 64) m = fmaxf(m, sc[w][k]);
      for (int o = 32; o > 0; o >>= 1) m = fmaxf(m, __shfl_xor(m, o));
      float s = 0.f; for (int k = lane; k < NKEY; k += 64) { float e = __expf(sc[w][k] - m); sc[w][k] = e; s += e; }
      for (int o = 32; o > 0; o >>= 1) s += __shfl_xor(s, o);
      float inv = 1.0f / s; for (int k = lane; k < NKEY; k += 64) sc[w][k] *= inv; }
    __syncthreads();
    { int dv = tid & 127, qh = tid >> 7; float o0 = 0.f, o1 = 0.f;
      for (int k = 0; k < NKEY; ++k) { float v = bf2f(Vp[(size_t)k * 128 + dv]); o0 += sc[qh * 2][k] * v; o1 += sc[qh * 2 + 1][k] * v; }
      int row = b * SEQ + qg * 4 + qh * 2; Y[(size_t)row * D + h * 128 + dv] = f2bf(o0); Y[(size_t)(row + 1) * D + h * 128 + dv] = f2bf(o1); }
}

__global__ __launch_bounds__(256) void k_nscan(const bf16_t* __restrict__ hq, const bf16_t* __restrict__ ff, const bf16_t* __restrict__ fb, const bf16_t* __restrict__ iv, const float* __restrict__ lb, bf16_t* of, bf16_t* ob) {
    __shared__ float sf[128], sk[128], sq[128], so[2][128];
    const int tid = threadIdx.x, blk = blockIdx.x, dir = blk & 1, h = (blk >> 1) & 7, b = blk >> 4;
    const bf16_t* fz = dir ? fb : ff; bf16_t* out = dir ? ob : of;
    const int dv = tid & 127, half = tid >> 7;
    float S[64];
#pragma unroll
    for (int j = 0; j < 64; ++j) S[j] = 0.f;
    const float lbv = lb[dir * 1024 + h * 128 + (tid & 127)];
    for (int step = 0; step < NKEY; ++step) {
        int row; bool islat;
        if (step < CTXL) { int s = dir ? (CTXL - 1 - step) : step; row = L + b * CTXL + s; islat = false; }
        else { int t = step - CTXL; t = dir ? (SEQ - 1 - t) : t; row = b * SEQ + t; islat = true; }
        if (tid < 128) { float z = bf2f(fz[(size_t)row * D + h * 128 + tid]); float f = lbv + (1.0f - lbv) * sigmoidf_(z); sf[tid] = f; sk[tid] = 1.0f - f;
            if (islat) { float zq = bf2f(hq[(size_t)row * D + h * 128 + tid]); sq[tid] = siluf_(zq) * 0.08838834764831845f; } }
        float v = bf2f(iv[(size_t)row * D + h * 128 + dv]);
        __syncthreads();
        float o = 0.f;
#pragma unroll
        for (int j = 0; j < 64; ++j) { int dk = half * 64 + j; S[j] = sf[dk] * S[j] + sk[dk] * v; o += S[j] * sq[dk]; }
        if (islat) so[half][dv] = o;
        __syncthreads();
        if (islat && half == 0) out[(size_t)row * D + h * 128 + dv] = f2bf(so[0][dv] + so[1][dv]);
    }
}

__global__ __launch_bounds__(256) void k_merge(bf16_t* y, const bf16_t* __restrict__ of, const bf16_t* __restrict__ ob, const bf16_t* __restrict__ og, const bf16_t* __restrict__ gm, const bf16_t* __restrict__ gh, const float* __restrict__ ghg) {
    int row = blockIdx.x, c = threadIdx.x * 4; size_t off = (size_t)row * D + c;
    ushort4 a = *(const ushort4*)(of + off), bb = *(const ushort4*)(ob + off), g1 = *(const ushort4*)(og + off), g2 = *(const ushort4*)(gm + off), g3 = *(const ushort4*)(gh + off), ym = *(const ushort4*)(y + off);
    const bf16_t *ap = (const bf16_t*)&a, *bp = (const bf16_t*)&bb, *p1 = (const bf16_t*)&g1, *p2 = (const bf16_t*)&g2, *p3 = (const bf16_t*)&g3, *pm = (const bf16_t*)&ym;
    float o[4], ss = 0.f; for (int i = 0; i < 4; ++i) { o[i] = bf2f(ap[i]) + bf2f(bp[i]); ss += o[i] * o[i]; }
    for (int m = 16; m > 0; m >>= 1) ss += __shfl_xor(ss, m);
    float rs = rsqrtf(ss * (1.0f / 128.0f) + EPS); float r[4];
    for (int i = 0; i < 4; ++i) { float yh = o[i] * rs * ghg[(c + i) & 127] * siluf_(bf2f(p1[i])); r[i] = sigmoidf_(bf2f(p2[i])) * bf2f(pm[i]) + sigmoidf_(bf2f(p3[i])) * yh; }
    st4bf(y + off, r);
}

__global__ __launch_bounds__(256) void k_norm2_router(const float* __restrict__ x1, const float* __restrict__ g, const float* __restrict__ modv, const float* __restrict__ wr, const float* __restrict__ br, bf16_t* h2, int* topi, float* topp, int* cnt, int* list) {
    __shared__ float red[4]; __shared__ float hs[1024]; __shared__ float part[8][32];
    int row = blockIdx.x, tid = threadIdx.x, c = tid * 4; const float* mod = modv + (row / SEQ) * 6144;
    float4 v = *(const float4*)(x1 + (size_t)row * D + c);
    float ss = block_sum256(v.x * v.x + v.y * v.y + v.z * v.z + v.w * v.w, red); float rs = rsqrtf(ss * (1.0f / D) + EPS);
    float xv[4] = {v.x, v.y, v.z, v.w}, o[4];
    for (int i = 0; i < 4; ++i) { o[i] = xv[i] * rs * g[c + i] * (1.0f + mod[4 * 1024 + c + i]) + mod[3 * 1024 + c + i]; hs[c + i] = o[i]; }
    st4bf(h2 + (size_t)row * D + c, o);
    __syncthreads();
    { int e = tid & 31, p = tid >> 5; float a = 0.f; for (int j = p * 128; j < p * 128 + 128; ++j) a += hs[j] * wr[j * 32 + e]; part[p][e] = a; }
    __syncthreads();
    if (tid < 64) {
        int e = tid & 31; float cur = br[e];
#pragma unroll
        for (int p = 0; p < 8; ++p) cur += part[p][e];
        float tv0 = 0.f, sum = 0.f; float myp = 0.f; int myk = -1;
        int sel_i[4]; float sel_e[4];
#pragma unroll
        for (int k = 0; k < 4; ++k) {
            float m = cur; int mi = e;
#pragma unroll
            for (int o = 16; o > 0; o >>= 1) { float om = __shfl_xor(m, o); int oi = __shfl_xor(mi, o); if (om > m || (om == m && oi < mi)) { m = om; mi = oi; } }
            if (k == 0) tv0 = m;
            sel_i[k] = mi; sel_e[k] = __expf(m - tv0); sum += sel_e[k];
            if (e == mi) cur = -3.0e38f;
        }
#pragma unroll
        for (int k = 0; k < 4; ++k) if (tid == k) { myk = sel_i[k]; myp = sel_e[k] / sum; }
        if (tid < 4) { int pair = row * 4 + tid; topi[pair] = myk; topp[pair] = myp; int pos = atomicAdd(&cnt[myk], 1); list[myk * CAP + pos] = pair; }
    }
}

__global__ void k_moe_offs(const int* cnt, int* offs, int* tilee) {
    if (threadIdx.x == 0 && blockIdx.x == 0) { int o = 0, t = 0; for (int e = 0; e < NE; ++e) { offs[e] = o; int nt = (cnt[e] + 255) >> 8; for (int i = 0; i < nt; ++i) tilee[t++] = e; o += nt * 256; } offs[NE] = o; offs[NE + 1] = t; }
}

__global__ __launch_bounds__(256) void k_final(float* out, const bf16_t* __restrict__ yp, const float* __restrict__ topp, const float* __restrict__ modv, const float* __restrict__ fg) {
    __shared__ float red[4];
    int row = blockIdx.x, c = threadIdx.x * 4; const float* gate = modv + (row / SEQ) * 6144 + 5 * 1024;
    float4 v = *(const float4*)(out + (size_t)row * D + c); float xv[4] = {v.x, v.y, v.z, v.w}; float m[4] = {0.f, 0.f, 0.f, 0.f};
    for (int k = 0; k < 4; ++k) { float p = topp[row * 4 + k]; ushort4 u = *(const ushort4*)(yp + (size_t)(row * 4 + k) * D + c); const bf16_t* up = (const bf16_t*)&u; for (int i = 0; i < 4; ++i) m[i] += p * bf2f(up[i]); }
    float ss = 0.f; for (int i = 0; i < 4; ++i) { xv[i] += gate[c + i] * m[i]; ss += xv[i] * xv[i]; }
    ss = block_sum256(ss, red); float rs = rsqrtf(ss * (1.0f / D) + EPS);
    float4 o; o.x = xv[0] * rs * fg[c]; o.y = xv[1] * rs * fg[c + 1]; o.z = xv[2] * rs * fg[c + 2]; o.w = xv[3] * rs * fg[c + 3];
    *(float4*)(out + (size_t)row * D + c) = o;
}

#define LAS __attribute__((address_space(3)))
__device__ __forceinline__ int otid() { int t = threadIdx.x; asm volatile("" : "+v"(t)); return t; }
typedef short bf16x8 __attribute__((ext_vector_type(8)));
typedef float f32x4 __attribute__((ext_vector_type(4)));
typedef unsigned u32x4 __attribute__((ext_vector_type(4)));
typedef unsigned u32x2 __attribute__((ext_vector_type(2)));

constexpr size_t OFF_ROPE = 7 * MiB;
constexpr size_t OFF_WT_IN = 8 * MiB;
constexpr size_t OFF_WT_QB = 25 * MiB;
constexpr size_t OFF_WT_KVB = 28 * MiB;
constexpr size_t OFF_WT_OUT = 29 * MiB;
constexpr size_t OFF_WT_GU = 104 * MiB;
constexpr size_t OFF_WT_DN = 232 * MiB;

struct Params {
    const float *x, *c, *ctx, *cctx, *w_mod, *b_mod, *g_mix, *w_in, *g_q, *w_qb, *g_kv, *w_kvb, *lbl, *g_hg, *w_out, *g_ffn, *w_r, *b_r, *w_gu, *b_gu, *w_dn, *b_dn, *g_fin;
    float* out; char* ws;
};

typedef __bf16 bf16v2_t __attribute__((ext_vector_type(2)));
__device__ __forceinline__ unsigned cvt_pk_bf16(float lo, float hi) { bf16v2_t v = {(__bf16)lo, (__bf16)hi}; return __builtin_bit_cast(unsigned, v); }

namespace pg8 {
constexpr int BM = 256, BK = 64, HALF = 128, HTB = HALF * BK * 2, STAGE_BYTES = 8 * HTB, NXCD = 8, WGM = 8;
__device__ __forceinline__ int lds_byte(int r, int c) { const int st = (r >> 4) * 2 + (c >> 5), rr = r & 15, cc = c & 31, ob = rr * 64 + cc * 2; return st * 1024 + (ob ^ (((ob >> 9) & 1) << 5)); }
__device__ __forceinline__ void stage_rc(int b, int& R, int& C) { const int st = b / 1024, sb = b % 1024, swz = sb ^ (((sb >> 9) & 1) << 5); R = (st >> 1) * 16 + swz / 64; C = (st & 1) * 32 + (swz % 64) / 2; }
__device__ __forceinline__ int perm32(int rho) { const int n = rho >> 4, i = rho & 15; return 8 * (i >> 2) + 4 * n + (i & 3); }
struct Unit { int pm, pn; const char* b; int e, pos0, cnt; };

__device__ __forceinline__ int xcd_remap(int L, int nwg) { const int q = nwg / NXCD, r = nwg % NXCD, xcd = L % NXCD, off = L / NXCD; return (xcd < r ? xcd * (q + 1) : r * (q + 1) + (xcd - r) * q) + off; }

struct DenseSched {
    int nM, nN, nwg, G, c, lda; const char* Bt; size_t btile;
    __device__ void init(int M, int N, int K, int lda_, const void* Bt_, int G_, int c_) { nM = M / BM; nN = N / BM; nwg = nM * nN; G = G_; c = c_; lda = lda_; Bt = (const char*)Bt_; btile = (size_t)BM * K * 2; }
    __device__ __forceinline__ void tile(int wgid, int& pm, int& pn) const { const int nig = WGM * nN, gid = wgid / nig, fm = gid * WGM, gsz = (nM - fm) < WGM ? (nM - fm) : WGM; pm = fm + ((wgid % nig) % gsz); pn = (wgid % nig) / gsz; }
    __device__ __forceinline__ bool next(int i, Unit& u) const { const int Lx = i * G + c; if (Lx >= nwg) return false; tile(xcd_remap(Lx, nwg), u.pm, u.pn); u.b = Bt + (size_t)u.pn * btile; u.e = 0; u.pos0 = 0; u.cnt = 0; return true; }
    __device__ __forceinline__ void aoff(const Unit& u, const int (&Rr)[2], const int (&Cc)[2], unsigned (&va)[2][2]) const {
#pragma unroll
        for (int h = 0; h < 2; ++h)
#pragma unroll
            for (int i = 0; i < 2; ++i) va[h][i] = (unsigned)((u.pm * BM + h * HALF + Rr[i]) * lda + Cc[i]) * 2u; }
};
struct InSched : DenseSched {
    __device__ void init2(const void* Bt_, int G_, int c_) { init(L, 8448, 1024, 1024, Bt_, G_, c_); }
    __device__ __forceinline__ bool next(int i, Unit& u) const {
        const int Lx = i * G + c; const int nlat = nwg;
        if (Lx < nlat) { tile(xcd_remap(Lx, nlat), u.pm, u.pn); }
        else { const int j = Lx - nlat; if (j >= 16 * 14) return false; const int q = j >> 4; u.pm = 128 + (j & 15); u.pn = q == 0 ? 3 : (q <= 12 ? 7 + q : 32); }
        u.b = Bt + (size_t)u.pn * btile; u.e = 0; u.pos0 = 0; u.cnt = 0; return true; }
};
template <bool GATHER> struct MoeSched {
    int nN, G, c; const char* Wt; size_t wexp, btile; const LAS int* tab; const int* list;
    __device__ __forceinline__ bool next(int i, Unit& u) const {
        const int nwg = tab[33] * nN; const int Lx = i * G + c; if (Lx >= nwg) return false;
        const int w = xcd_remap(Lx, nwg); const int rt = w / nN; u.pn = w % nN; u.pm = rt;
        int e = 0; while (tab[e + 1] <= rt) ++e;
        u.e = e; u.pos0 = (rt - tab[e]) * BM; u.cnt = tab[64 + e]; u.b = Wt + (size_t)e * wexp + (size_t)u.pn * btile; return true; }
    __device__ __forceinline__ void aoff(const Unit& u, const int (&Rr)[2], const int (&Cc)[2], unsigned (&va)[2][2]) const {
#pragma unroll
        for (int h = 0; h < 2; ++h)
#pragma unroll
            for (int i = 0; i < 2; ++i) {
                if (GATHER) { const int pos = u.pos0 + h * HALF + Rr[i]; const int pair = pos < u.cnt ? list[u.e * CAP + pos] : 0; va[h][i] = (unsigned)((pair >> 2) * D + Cc[i]) * 2u; }
                else va[h][i] = (unsigned)((u.pm * BM + h * HALF + Rr[i]) * D + Cc[i]) * 2u; } }
};

template <class Epi, class Sched>
__device__ __forceinline__ void gemm_phase(LAS unsigned char* lds, const char* Abase, const int K, const Sched& S, const Epi& E) {
    const int tid = otid(), wid = __builtin_amdgcn_readfirstlane(tid >> 6), lane = tid & 63, wr = wid >> 2, wc = wid & 3, fr = lane & 15, fq = lane >> 4;
    const int nt = K / BK;
    int Rr[2], Cc[2]; unsigned voffB[2];
#pragma unroll
    for (int i = 0; i < 2; ++i) { int R_, C_; stage_rc(tid * 16 + i * 8192, R_, C_); Rr[i] = R_; Cc[i] = C_; const int Rb = Epi::PERM ? ((R_ & ~31) + perm32(R_ & 31)) : R_; voffB[i] = (unsigned)(Rb * K + C_) * 2u; }
    const size_t kstep = (size_t)(BK * 2);
    const size_t hstep = (size_t)HALF * K * 2;
    const unsigned ldsw = (unsigned)wid * 1024u;
    const int aoff = lds_byte(wr * 64 + fr, fq * 8), boff = lds_byte(wc * 32 + fr, fq * 8);
#define PG8_SA(b, h) (((b) * 2 + (h)) * HTB)
#define PG8_SB(b, h) ((4 + (b) * 2 + (h)) * HTB)
#define PG8_STAGE_B(bufoff, gbase) do { _Pragma("unroll") for (int _i = 0; _i < 2; ++_i) \
        __builtin_amdgcn_global_load_lds((const unsigned*)((const char*)(gbase) + voffB[_i]), (LAS unsigned*)(lds + (bufoff) + ldsw + _i * 8192), 16, 0, 0); } while (0)
#define PG8_STAGE_A(bufoff, v0, v1, kb) do { \
        __builtin_amdgcn_global_load_lds((const unsigned*)(Abase + (kb) + (v0)), (LAS unsigned*)(lds + (bufoff) + ldsw), 16, 0, 0); \
        __builtin_amdgcn_global_load_lds((const unsigned*)(Abase + (kb) + (v1)), (LAS unsigned*)(lds + (bufoff) + ldsw + 8192), 16, 0, 0); } while (0)
#define PG8_LDA(dst, b, h) do { _Pragma("unroll") for (int m = 0; m < 4; ++m) _Pragma("unroll") for (int k = 0; k < 2; ++k) dst[m][k] = *(const LAS bf16x8*)(lds + PG8_SA(b, h) + aoff + m * 2048 + k * 1024); } while (0)
#define PG8_LDB(dst, b, h) do { _Pragma("unroll") for (int n = 0; n < 2; ++n) _Pragma("unroll") for (int k = 0; k < 2; ++k) dst[n][k] = *(const LAS bf16x8*)(lds + PG8_SB(b, h) + boff + n * 2048 + k * 1024); } while (0)
#define PG8_MMA(ai, bj, At, Bt) do { __builtin_amdgcn_s_setprio(1); _Pragma("unroll") for (int m = 0; m < 4; ++m) _Pragma("unroll") for (int n = 0; n < 2; ++n) _Pragma("unroll") for (int k = 0; k < 2; ++k) \
        acc[ai][bj][m][n] = __builtin_amdgcn_mfma_f32_16x16x32_bf16(Bt[n][k], At[m][k], acc[ai][bj][m][n], 0, 0, 0); __builtin_amdgcn_s_setprio(0); } while (0)
#define PG8_WAIT_V(n) asm volatile("s_waitcnt vmcnt(" #n ")" ::: "memory")
#define PG8_WAIT_L(n) asm volatile("s_waitcnt lgkmcnt(" #n ")" ::: "memory")
#define PG8_BAR __builtin_amdgcn_s_barrier()
#define PG8_SCHED __builtin_amdgcn_sched_barrier(0)
    Unit cur, nxt; int ui = 0;
    if (!S.next(0, cur)) return;
    f32x4 acc[2][2][4][2];
#pragma unroll
    for (int a = 0; a < 2; ++a)
#pragma unroll
        for (int b = 0; b < 2; ++b)
#pragma unroll
            for (int m = 0; m < 4; ++m)
#pragma unroll
                for (int n = 0; n < 2; ++n) acc[a][b][m][n] = (f32x4){0.f, 0.f, 0.f, 0.f};
    bf16x8 At[4][2], B0[2][2], B1[2][2];
    unsigned vc[2][2], vn[2][2];
    S.aoff(cur, Rr, Cc, vc);
    const char* cB = cur.b;
    PG8_STAGE_B(PG8_SB(0, 0), cB); PG8_STAGE_A(PG8_SA(0, 0), vc[0][0], vc[0][1], 0); PG8_STAGE_B(PG8_SB(0, 1), cB + hstep); PG8_STAGE_A(PG8_SA(0, 1), vc[1][0], vc[1][1], 0);
    if (wr == 1) PG8_BAR;
    PG8_WAIT_V(4); PG8_BAR;
    PG8_STAGE_B(PG8_SB(1, 0), cB + kstep); PG8_STAGE_A(PG8_SA(1, 0), vc[0][0], vc[0][1], kstep); PG8_STAGE_B(PG8_SB(1, 1), cB + hstep + kstep);
    PG8_WAIT_V(6); PG8_BAR;
    for (;;) {
        const bool has_next = S.next(ui + 1, nxt);
        if (has_next) S.aoff(nxt, Rr, Cc, vn);
        else {
#pragma unroll
            for (int h = 0; h < 2; ++h)
#pragma unroll
                for (int i = 0; i < 2; ++i) vn[h][i] = vc[h][i]; }
        const char* nB = has_next ? nxt.b : cB;
        for (int t = 0; t < nt; t += 2) {
            const bool last = (t == nt - 2);
            const size_t k1 = (size_t)(t + 1) * kstep;
            const size_t k2 = last ? 0 : (size_t)(t + 2) * kstep;
            const unsigned s00 = last ? vn[0][0] : vc[0][0], s01 = last ? vn[0][1] : vc[0][1], s10 = last ? vn[1][0] : vc[1][0], s11 = last ? vn[1][1] : vc[1][1];
            const char* b2 = last ? nB : cB + (size_t)(t + 2) * kstep; const char* b3 = b2 + kstep;
            PG8_LDB(B0, 0, 0); PG8_SCHED; PG8_LDA(At, 0, 0); PG8_STAGE_A(PG8_SA(1, 1), vc[1][0], vc[1][1], k1);
            PG8_WAIT_L(8); PG8_BAR; PG8_WAIT_L(0); PG8_MMA(0, 0, At, B0); PG8_BAR; PG8_SCHED;
            PG8_LDB(B1, 0, 1); PG8_STAGE_B(PG8_SB(0, 0), b2);
            PG8_BAR; PG8_WAIT_L(0); PG8_MMA(0, 1, At, B1); PG8_BAR;
            PG8_LDA(At, 0, 1); PG8_STAGE_A(PG8_SA(0, 0), s00, s01, k2);
            PG8_BAR; PG8_WAIT_L(0); PG8_MMA(1, 0, At, B0); PG8_BAR; PG8_SCHED;
            PG8_STAGE_B(PG8_SB(0, 1), b2 + hstep);
            PG8_WAIT_V(6); PG8_BAR; PG8_MMA(1, 1, At, B1); PG8_BAR;
            PG8_LDB(B0, 1, 0); PG8_SCHED; PG8_LDA(At, 1, 0); PG8_STAGE_A(PG8_SA(0, 1), s10, s11, k2);
            PG8_WAIT_L(8); PG8_BAR; PG8_WAIT_L(0); PG8_MMA(0, 0, At, B0); PG8_BAR; PG8_SCHED;
            PG8_LDB(B1, 1, 1); PG8_STAGE_B(PG8_SB(1, 0), b3);
            PG8_BAR; PG8_WAIT_L(0); PG8_MMA(0, 1, At, B1); PG8_BAR;
            PG8_LDA(At, 1, 1); PG8_STAGE_A(PG8_SA(1, 0), s00, s01, k2 + kstep);
            PG8_BAR; PG8_WAIT_L(0); PG8_MMA(1, 0, At, B0); PG8_BAR; PG8_SCHED;
            PG8_STAGE_B(PG8_SB(1, 1), b3 + hstep);
            PG8_WAIT_V(6); PG8_BAR; PG8_MMA(1, 1, At, B1); PG8_BAR;
        }
        E(acc, cur, wr, wc, fr, fq);
        if (!has_next) break;
#pragma unroll
        for (int a = 0; a < 2; ++a)
#pragma unroll
            for (int b = 0; b < 2; ++b)
#pragma unroll
                for (int m = 0; m < 4; ++m)
#pragma unroll
                    for (int n = 0; n < 2; ++n) acc[a][b][m][n] = (f32x4){0.f, 0.f, 0.f, 0.f};
        cur = nxt; cB = nB; ++ui;
#pragma unroll
        for (int h = 0; h < 2; ++h)
#pragma unroll
            for (int i = 0; i < 2; ++i) vc[h][i] = vn[h][i];
    }
    PG8_WAIT_V(0);
    if (wr == 0) PG8_BAR;
    PG8_BAR;
#undef PG8_SA
#undef PG8_SB
#undef PG8_STAGE_A
#undef PG8_STAGE_B
#undef PG8_LDA
#undef PG8_LDB
#undef PG8_MMA
#undef PG8_WAIT_V
#undef PG8_WAIT_L
#undef PG8_BAR
#undef PG8_SCHED
}

typedef f32x4 Acc[2][2][4][2];
__device__ __forceinline__ u32x4 pack8(const f32x4 v0, const f32x4 v1) { u32x4 w; w.x = cvt_pk_bf16(v0[0], v0[1]); w.y = cvt_pk_bf16(v0[2], v0[3]); w.z = cvt_pk_bf16(v1[0], v1[1]); w.w = cvt_pk_bf16(v1[2], v1[3]); return w; }

struct EpiIn { static constexpr bool PERM = true; char* ws;
    __device__ __forceinline__ void operator()(const Acc& acc, const Unit& u, int wr, int wc, int fr, int fq) const {
        const int pn = u.pn; size_t boff; int ld, cb;
        if (pn < 3) { boff = OFF_QA; ld = 768; cb = pn * 256; } else if (pn == 3) { boff = OFF_CKV; ld = 256; cb = 0; }
        else if (pn < 32) { boff = OFF_HQ + (size_t)((pn - 4) >> 2) * SEG_STRIDE; ld = 1024; cb = ((pn - 4) & 3) * 256; }
        else { boff = OFF_KR; ld = 64; cb = 0; }
        bf16_t* base = (bf16_t*)(ws + boff);
        const int row0 = u.pm * BM + wr * 64 + fr, col0 = wc * 32 + 8 * fq;
        if (pn == 32 && wc >= 2) return;
        float* ssq = (float*)(ws + (pn < 3 ? OFF_SSQQ : OFF_SSQKV));
#pragma unroll
        for (int ai = 0; ai < 2; ++ai)
#pragma unroll
            for (int m = 0; m < 4; ++m) { const int row = row0 + ai * HALF + m * 16; bf16_t* rowp = base + (size_t)row * ld + cb + col0;
                const f32x4 v0 = acc[ai][0][m][0], v1 = acc[ai][0][m][1];
                *(u32x4*)rowp = pack8(v0, v1);
                if (pn != 32) { const f32x4 w0 = acc[ai][1][m][0], w1 = acc[ai][1][m][1]; *(u32x4*)(rowp + HALF) = pack8(w0, w1);
                    if (pn <= 3) { float ss = (v0[0] * v0[0] + v0[1] * v0[1]) + (v0[2] * v0[2] + v0[3] * v0[3]) + (v1[0] * v1[0] + v1[1] * v1[1]) + (v1[2] * v1[2] + v1[3] * v1[3])
                                          + (w0[0] * w0[0] + w0[1] * w0[1]) + (w0[2] * w0[2] + w0[3] * w0[3]) + (w1[0] * w1[0] + w1[1] * w1[1]) + (w1[2] * w1[2] + w1[3] * w1[3]);
                        ss += __shfl_xor(ss, 16); ss += __shfl_xor(ss, 32); if (fq == 0) atomicAdd(ssq + row, ss); } } }
    } };

struct EpiQ { static constexpr bool PERM = true; bf16_t* q; const float* ssq;
    __device__ __forceinline__ void operator()(const Acc& acc, const Unit& u, int wr, int wc, int fr, int fq) const {
        const int row0 = u.pm * BM + wr * 64 + fr, col0 = u.pn * BM + wc * 32 + 8 * fq;
#pragma unroll
        for (int ai = 0; ai < 2; ++ai)
#pragma unroll
            for (int m = 0; m < 4; ++m) { const int row = row0 + ai * HALF + m * 16; const float rs = rsqrtf(ssq[row] * (1.0f / 768.0f) + EPS); bf16_t* rowp = q + (size_t)row * 1536 + col0;
#pragma unroll
                for (int bj = 0; bj < 2; ++bj) *(u32x4*)(rowp + bj * HALF) = pack8(acc[ai][bj][m][0] * rs, acc[ai][bj][m][1] * rs); }
    } };

struct EpiKV { static constexpr bool PERM = true; bf16_t *Kb, *Vb; const float* ssq;
    __device__ __forceinline__ void operator()(const Acc& acc, const Unit& u, int wr, int wc, int fr, int fq) const {
        const int row0 = u.pm * BM + wr * 64 + fr, col0 = wc * 32 + 8 * fq;
#pragma unroll
        for (int ai = 0; ai < 2; ++ai)
#pragma unroll
            for (int m = 0; m < 4; ++m) { const int row = row0 + ai * HALF + m * 16; const float rs = rsqrtf(ssq[row] * (1.0f / 256.0f) + EPS);
                int b, pos; if (row < L) { b = row >> 11; pos = row & 2047; } else { b = (row - L) >> 8; pos = SEQ + ((row - L) & 255); }
                const size_t kvrow = (size_t)(b * 8 + u.pn) * NKEY + pos;
                *(u32x4*)(Kb + kvrow * 192 + col0) = pack8(acc[ai][0][m][0] * rs, acc[ai][0][m][1] * rs);
                *(u32x4*)(Vb + kvrow * 128 + col0) = pack8(acc[ai][1][m][0] * rs, acc[ai][1][m][1] * rs); }
    } };

struct EpiOut { static constexpr bool PERM = false; float* x1; const float* x; const float* modv;
    __device__ __forceinline__ void operator()(const Acc& acc, const Unit& u, int wr, int wc, int fr, int fq) const {
        const int row0 = u.pm * BM + wr * 64 + fr, col0 = u.pn * BM + wc * 32 + 4 * fq;
#pragma unroll
        for (int ai = 0; ai < 2; ++ai)
#pragma unroll
            for (int m = 0; m < 4; ++m) { const int row = row0 + ai * HALF + m * 16; const float* gate = modv + (row >> 11) * 6144 + 2 * 1024 + col0; const float* xr = x + (size_t)row * D + col0; float* o = x1 + (size_t)row * D + col0;
#pragma unroll
                for (int bj = 0; bj < 2; ++bj)
#pragma unroll
                    for (int n = 0; n < 2; ++n) { const int co = bj * HALF + n * 16; const f32x4 g = *(const f32x4*)(gate + co), xv = *(const f32x4*)(xr + co); *(f32x4*)(o + co) = xv + g * acc[ai][bj][m][n]; } }
    } };

struct EpiMoe1 { static constexpr bool PERM = true; bf16_t* act; const float* bgu;
    __device__ __forceinline__ void operator()(const Acc& acc, const Unit& u, int wr, int wc, int fr, int fq) const {
        const int row0 = u.pm * BM + wr * 64 + fr, o0 = u.pn * 128 + wc * 16 + 4 * fq;
        f32x4 bg[2], bl[2];
#pragma unroll
        for (int bj = 0; bj < 2; ++bj) { const float* bp = bgu + u.e * 2048 + 2 * (o0 + bj * 64); const f32x4 t0 = *(const f32x4*)bp, t1 = *(const f32x4*)(bp + 4);
            bg[bj] = (f32x4){t0[0], t0[2], t1[0], t1[2]}; bl[bj] = (f32x4){t0[1], t0[3], t1[1], t1[3]}; }
#pragma unroll
        for (int ai = 0; ai < 2; ++ai)
#pragma unroll
            for (int m = 0; m < 4; ++m) { const int row = row0 + ai * HALF + m * 16; bf16_t* rowp = act + (size_t)row * D + o0;
#pragma unroll
                for (int bj = 0; bj < 2; ++bj) { const f32x4 g4 = acc[ai][bj][m][0] + bg[bj], l4 = acc[ai][bj][m][1] + bl[bj]; float r[4];
#pragma unroll
                    for (int j = 0; j < 4; ++j) { const float glu = fminf(g4[j], 7.0f), lin = fminf(fmaxf(l4[j], -7.0f), 7.0f); r[j] = glu * sigmoidf_(1.702f * glu) * (lin + 1.0f); }
                    u32x2 w; w.x = cvt_pk_bf16(r[0], r[1]); w.y = cvt_pk_bf16(r[2], r[3]); *(u32x2*)(rowp + bj * 64) = w; } }
    } };

struct EpiMoe2 { static constexpr bool PERM = true; bf16_t* yp; const float* bd; const int* list;
    __device__ __forceinline__ void operator()(const Acc& acc, const Unit& u, int wr, int wc, int fr, int fq) const {
        const int r0 = wr * 64 + fr, col0 = u.pn * BM + wc * 32 + 8 * fq;
        f32x4 bv[2][2];
#pragma unroll
        for (int bj = 0; bj < 2; ++bj)
#pragma unroll
            for (int n = 0; n < 2; ++n) bv[bj][n] = *(const f32x4*)(bd + u.e * 1024 + col0 + bj * HALF + 4 * n);
#pragma unroll
        for (int ai = 0; ai < 2; ++ai)
#pragma unroll
            for (int m = 0; m < 4; ++m) { const int pos = u.pos0 + r0 + ai * HALF + m * 16; if (pos < u.cnt) { const int pair = list[u.e * CAP + pos]; bf16_t* rowp = yp + (size_t)pair * D + col0;
#pragma unroll
                for (int bj = 0; bj < 2; ++bj) *(u32x4*)(rowp + bj * HALF) = pack8(acc[ai][bj][m][0] + bv[bj][0], acc[ai][bj][m][1] + bv[bj][1]); } }
    } };
}

__device__ __forceinline__ int conv_src_col(int kind, int c) {
    if (kind == 0) return c;
    if (kind == 1) { if (c < 1024) return c; if (c < 8192) return c + 64; if (c < 8256) return c - 8192 + 1024; return -1; }
    const int pn = c >> 8, p = c & 255, bj = p >> 7, wc = (p >> 5) & 3, fq = (p >> 3) & 3, n = (p >> 2) & 1, i = p & 3; const int o = 128 * pn + 64 * bj + 16 * wc + 4 * fq + i; return 2 * o + n;
}
__device__ __forceinline__ void conv_tile(LAS float* tl, const float* __restrict__ W, int ldw, bf16_t* Wt, int K, int kind, const float* __restrict__ kscale, int k0, int c0) {
    const int tid = otid(); const int cc = tid & 63, sc = conv_src_col(kind, c0 + cc);
#pragma unroll
    for (int i = 0; i < 8; ++i) { const int kk = (tid >> 6) + 8 * i; float v = 0.f; if (sc >= 0) { v = W[(size_t)(k0 + kk) * ldw + sc]; if (kscale) v *= kscale[k0 + kk]; } tl[kk * 65 + cc] = v; }
    __syncthreads();
    { const int c2 = tid >> 3, kq = (tid & 7) * 8; float v[8];
#pragma unroll
      for (int j = 0; j < 8; ++j) v[j] = tl[(kq + j) * 65 + c2];
      u32x4 w; w.x = cvt_pk_bf16(v[0], v[1]); w.y = cvt_pk_bf16(v[2], v[3]); w.z = cvt_pk_bf16(v[4], v[5]); w.w = cvt_pk_bf16(v[6], v[7]);
      *(u32x4*)(Wt + (size_t)(c0 + c2) * K + k0 + kq) = w; }
    __syncthreads();
}
__device__ __forceinline__ void conv_matrix(LAS float* tl, const float* W, int ldw, bf16_t* Wt, int K, int Nout, int kind, const float* kscale, int& tctr) {
    const int nk = K / 64, ntile = nk * (Nout / 64);
    for (int t = 0; t < ntile; ++t, ++tctr) { if ((tctr % (int)gridDim.x) != (int)blockIdx.x) continue; conv_tile(tl, W, ldw, Wt, K, kind, kscale, (t % nk) * 64, (t / nk) * 64); }
}

__device__ __forceinline__ float half_sum256(float v, LAS float* red) {
    for (int o = 32; o > 0; o >>= 1) v += __shfl_xor(v, o);
    const int w = otid() >> 6, hb = (otid() >> 8) * 4; if ((otid() & 63) == 0) red[w] = v; __syncthreads();
    const float t = red[hb] + red[hb + 1] + red[hb + 2] + red[hb + 3]; __syncthreads(); return t;
}

__device__ __forceinline__ void phase0(const Params& p, LAS unsigned char* lds) {
    char* ws = p.ws; const int tid = otid(), gsz = gridDim.x * 512, gid = blockIdx.x * 512 + tid;
    float* lb = (float*)(ws + OFF_LB); int* cnt = (int*)(ws + OFF_CNT); float* ssqq = (float*)(ws + OFF_SSQQ); float* ssqkv = (float*)(ws + OFF_SSQKV); float* modv = (float*)(ws + OFF_MOD);
    for (int i = gid; i < 2048; i += gsz) { const int d = i >> 10, j = i & 1023; const float a = p.lbl[(d * 2 + 0) * 1024 + j], b = p.lbl[(d * 2 + 1) * 1024 + j]; lb[i] = 1.0f / (1.0f + __expf(b - a)); }
    for (int i = gid; i < 32; i += gsz) cnt[i] = 0;
    { float* ropet = (float*)(ws + OFF_ROPE); for (int i = gid; i < SEQ * 32; i += gsz) { const int t = i >> 5, j = i & 31; float cs, sn; rope_cs(t, j, cs, sn); ropet[t * 64 + j] = cs; ropet[t * 64 + 32 + j] = sn; } }
    for (int i = gid; i < L; i += gsz) ssqq[i] = 0.f;
    for (int i = gid; i < R; i += gsz) ssqkv[i] = 0.f;
    { LAS float* sil = (LAS float*)lds;
      LAS float* part = (LAS float*)(lds + 17 * 1024 * 4);
      bool loaded = false;
      for (int item = blockIdx.x; item < 96; item += gridDim.x) {
          if (!loaded) { for (int i = tid; i < 17 * 1024; i += 512) { const int r = i >> 10, k = i & 1023; sil[i] = siluf_(r < 16 ? p.c[r * 1024 + k] : p.cctx[k]); } loaded = true; __syncthreads(); }
          const int j = tid & 63, ks = tid >> 6; float a[17];
#pragma unroll
          for (int r = 0; r < 17; ++r) a[r] = 0.f;
          for (int k = ks * 128; k < ks * 128 + 128; ++k) { const float w = p.w_mod[(size_t)k * 6144 + item * 64 + j];
#pragma unroll
              for (int r = 0; r < 17; ++r) a[r] += sil[r * 1024 + k] * w; }
#pragma unroll
          for (int r = 0; r < 17; ++r) part[(ks * 17 + r) * 64 + j] = a[r];
          __syncthreads();
          for (int i = tid; i < 17 * 64; i += 512) { const int r = i >> 6, jj = i & 63; float s = p.b_mod[item * 64 + jj]; for (int q = 0; q < 8; ++q) s += part[(q * 17 + r) * 64 + jj]; modv[r * 6144 + item * 64 + jj] = s; }
          __syncthreads();
      } }
    __syncthreads();
    { LAS float* tl = (LAS float*)lds; int tctr = 0;
      conv_matrix(tl, p.w_in, 8256, (bf16_t*)(ws + OFF_WT_IN), 1024, 8448, 1, nullptr, tctr);
      conv_matrix(tl, p.w_qb, 1536, (bf16_t*)(ws + OFF_WT_QB), 768, 1536, 0, p.g_q, tctr);
      conv_matrix(tl, p.w_kvb, 2048, (bf16_t*)(ws + OFF_WT_KVB), 256, 2048, 0, p.g_kv, tctr);
      conv_matrix(tl, p.w_out, 1024, (bf16_t*)(ws + OFF_WT_OUT), 1024, 1024, 0, nullptr, tctr); }
}

__device__ __forceinline__ void phase1(const Params& p, LAS unsigned char* lds) {
    LAS float* red = (LAS float*)lds; const float* modv = (const float*)(p.ws + OFF_MOD); bf16_t* h = (bf16_t*)(p.ws + OFF_H);
    const int half = otid() >> 8, c = (otid() & 255) * 4;
    for (int row = blockIdx.x * 2 + half; row < R; row += gridDim.x * 2) {
        const float* src = row < L ? p.x + (size_t)row * D : p.ctx + (size_t)(row - L) * D; const float* mod = modv + (row < L ? row / SEQ : 16) * 6144;
        const float4 v = *(const float4*)(src + c);
        const float ss = half_sum256(v.x * v.x + v.y * v.y + v.z * v.z + v.w * v.w, red); const float rs = rsqrtf(ss * (1.0f / D) + EPS);
        const float4 g = *(const float4*)(p.g_mix + c), sc = *(const float4*)(mod + 1024 + c), sh = *(const float4*)(mod + c);
        u32x2 w; w.x = cvt_pk_bf16(v.x * rs * g.x * (1.0f + sc.x) + sh.x, v.y * rs * g.y * (1.0f + sc.y) + sh.y); w.y = cvt_pk_bf16(v.z * rs * g.z * (1.0f + sc.z) + sh.z, v.w * rs * g.w * (1.0f + sc.w) + sh.w);
        *(u32x2*)(h + (size_t)row * D + c) = w;
    }
}

__device__ __forceinline__ SegOut make_seg(char* ws) { SegOut so; so.qa = (bf16_t*)(ws + OFF_QA); so.ckv = (bf16_t*)(ws + OFF_CKV); so.kr = (bf16_t*)(ws + OFF_KR); so.hq = (bf16_t*)(ws + OFF_HQ); so.ff = (bf16_t*)(ws + OFF_FF);
    so.fb = (bf16_t*)(ws + OFF_FB); so.iv = (bf16_t*)(ws + OFF_IV); so.og = (bf16_t*)(ws + OFF_OG); so.gm = (bf16_t*)(ws + OFF_GM); so.gh = (bf16_t*)(ws + OFF_GH); return so; }

__device__ __forceinline__ void phase2(const Params& p, LAS unsigned char* lds) {
    pg8::InSched S; S.init2(p.ws + OFF_WT_IN, gridDim.x, blockIdx.x);
    pg8::EpiIn E{p.ws};
    pg8::gemm_phase(lds, (const char*)(p.ws + OFF_H), 1024, S, E);
}
__device__ __forceinline__ void phase3(const Params& p, LAS unsigned char* lds) {
    char* ws = p.ws;
    { pg8::DenseSched S; S.init(L, 1536, 768, 768, ws + OFF_WT_QB, gridDim.x, blockIdx.x); pg8::EpiQ E{(bf16_t*)(ws + OFF_Q), (const float*)(ws + OFF_SSQQ)}; pg8::gemm_phase(lds, (const char*)(ws + OFF_QA), 768, S, E); }
    { pg8::DenseSched S; S.init(R, 2048, 256, 256, ws + OFF_WT_KVB, gridDim.x, blockIdx.x); pg8::EpiKV E{(bf16_t*)(ws + OFF_K), (bf16_t*)(ws + OFF_V), (const float*)(ws + OFF_SSQKV)}; pg8::gemm_phase(lds, (const char*)(ws + OFF_CKV), 256, S, E); }
    { const bf16_t* kr = (const bf16_t*)(ws + OFF_KR); bf16_t* Kb = (bf16_t*)(ws + OFF_K); const float* ropet = (const float*)(ws + OFF_ROPE);
      for (int gid = blockIdx.x * 512 + otid(); gid < R * 32; gid += gridDim.x * 512) { const int row = gid >> 5, i = gid & 31;
          const float x1 = bf2f(kr[(size_t)row * 64 + i]), x2 = bf2f(kr[(size_t)row * 64 + 32 + i]); float o1 = x1, o2 = x2; int b, pos;
          if (row < L) { b = row / SEQ; pos = row % SEQ; const float cs = ropet[pos * 64 + i], sn = ropet[pos * 64 + 32 + i]; o1 = x1 * cs - x2 * sn; o2 = x1 * sn + x2 * cs; } else { b = (row - L) / CTXL; pos = SEQ + (row - L) % CTXL; }
          const bf16_t w1 = f2bf(o1), w2 = f2bf(o2);
          for (int h = 0; h < 8; ++h) { bf16_t* q = Kb + ((size_t)(b * 8 + h) * NKEY + pos) * 192 + 128; q[i] = w1; q[32 + i] = w2; } } }
}
__device__ __forceinline__ void phase4(const Params& p, LAS unsigned char*) {
    char* ws = p.ws; bf16_t* y = (bf16_t*)(ws + OFF_H); const bf16_t* of = (const bf16_t*)(ws + OFF_OF); const bf16_t* ob = (const bf16_t*)(ws + OFF_OB);
    const bf16_t* og = (const bf16_t*)(ws + OFF_OG); const bf16_t* gm = (const bf16_t*)(ws + OFF_GM); const bf16_t* gh = (const bf16_t*)(ws + OFF_GH);
    const int half = otid() >> 8, c = (otid() & 255) * 4;
    for (int row = blockIdx.x * 2 + half; row < L; row += gridDim.x * 2) { const size_t off = (size_t)row * D + c;
        const ushort4 a = *(const ushort4*)(of + off), bb = *(const ushort4*)(ob + off), g1 = *(const ushort4*)(og + off), g2 = *(const ushort4*)(gm + off), g3 = *(const ushort4*)(gh + off), ym = *(const ushort4*)(y + off);
        const bf16_t *ap = (const bf16_t*)&a, *bp = (const bf16_t*)&bb, *p1 = (const bf16_t*)&g1, *p2 = (const bf16_t*)&g2, *p3 = (const bf16_t*)&g3, *pm = (const bf16_t*)&ym;
        float o[4], ss = 0.f;
#pragma unroll
        for (int i = 0; i < 4; ++i) { o[i] = bf2f(ap[i]) + bf2f(bp[i]); ss += o[i] * o[i]; }
        for (int m = 16; m > 0; m >>= 1) ss += __shfl_xor(ss, m);
        const float rs = rsqrtf(ss * (1.0f / 128.0f) + EPS); float r[4];
#pragma unroll
        for (int i = 0; i < 4; ++i) { const float yh = o[i] * rs * p.g_hg[(c + i) & 127] * siluf_(bf2f(p1[i])); r[i] = sigmoidf_(bf2f(p2[i])) * bf2f(pm[i]) + sigmoidf_(bf2f(p3[i])) * yh; }
        u32x2 w; w.x = cvt_pk_bf16(r[0], r[1]); w.y = cvt_pk_bf16(r[2], r[3]); *(u32x2*)(y + off) = w; }
}
__device__ __forceinline__ void phase5(const Params& p, LAS unsigned char* lds) {
    char* ws = p.ws;
    { pg8::DenseSched S; S.init(L, 1024, 1024, 1024, ws + OFF_WT_OUT, gridDim.x, blockIdx.x); pg8::EpiOut E{p.out, p.x, (const float*)(ws + OFF_MOD)}; pg8::gemm_phase(lds, (const char*)(ws + OFF_H), 1024, S, E); }
    { LAS float* tl = (LAS float*)lds; int tctr = 0;
      for (int e = 0; e < NE; ++e) conv_matrix(tl, p.w_gu + (size_t)e * 1024 * 2048, 2048, (bf16_t*)(ws + OFF_WT_GU) + (size_t)e * 2048 * 1024, 1024, 2048, 2, nullptr, tctr);
      for (int e = 0; e < NE; ++e) conv_matrix(tl, p.w_dn + (size_t)e * 1024 * 1024, 1024, (bf16_t*)(ws + OFF_WT_DN) + (size_t)e * 1024 * 1024, 1024, 1024, 0, nullptr, tctr); }
}
__device__ __forceinline__ void phase6(const Params& p, LAS unsigned char* lds) {
    char* ws = p.ws; const float* modv = (const float*)(ws + OFF_MOD); bf16_t* h2 = (bf16_t*)(ws + OFF_H); int* topi = (int*)(ws + OFF_TOPI); float* topp = (float*)(ws + OFF_TOPP); int* cnt = (int*)(ws + OFF_CNT); int* list = (int*)(ws + OFF_LIST);
    LAS float* red = (LAS float*)lds;
    LAS float* hs = (LAS float*)(lds + 64);
    LAS float* part = (LAS float*)(lds + 64 + 8192);
    LAS int* lcnt = (LAS int*)(lds + 64 + 8192 + 2048);
    LAS int* lent = (LAS int*)(lds + 64 + 8192 + 2048 + 512);
    const int tid = otid(), half = tid >> 8, t2 = tid & 255, c = t2 * 4;
    if (tid < 96) lcnt[tid] = 0;
    __syncthreads();
    int it = 0;
    for (int row0 = blockIdx.x * 2; row0 < L; row0 += gridDim.x * 2, ++it) {
        const int row = row0 + half; const float* mod = modv + (row / SEQ) * 6144;
        const float4 v = *(const float4*)(p.out + (size_t)row * D + c);
        const float ss = half_sum256(v.x * v.x + v.y * v.y + v.z * v.z + v.w * v.w, red); const float rs = rsqrtf(ss * (1.0f / D) + EPS);
        const float4 g = *(const float4*)(p.g_ffn + c), sc = *(const float4*)(mod + 4 * 1024 + c), sh = *(const float4*)(mod + 3 * 1024 + c);
        float o[4] = {v.x * rs * g.x * (1.0f + sc.x) + sh.x, v.y * rs * g.y * (1.0f + sc.y) + sh.y, v.z * rs * g.z * (1.0f + sc.z) + sh.z, v.w * rs * g.w * (1.0f + sc.w) + sh.w};
#pragma unroll
        for (int i = 0; i < 4; ++i) hs[half * 1024 + c + i] = o[i];
        u32x2 w; w.x = cvt_pk_bf16(o[0], o[1]); w.y = cvt_pk_bf16(o[2], o[3]); *(u32x2*)(h2 + (size_t)row * D + c) = w;
        __syncthreads();
        { const int e = t2 & 31, q = t2 >> 5; float a = 0.f; for (int j = q * 128; j < q * 128 + 128; ++j) a += hs[half * 1024 + j] * p.w_r[j * 32 + e]; part[(half * 8 + q) * 32 + e] = a; }
        __syncthreads();
        if (t2 < 64) {
            const int e = t2 & 31; float cur = p.b_r[e];
#pragma unroll
            for (int q = 0; q < 8; ++q) cur += part[(half * 8 + q) * 32 + e];
            float tv0 = 0.f, sum = 0.f; int sel_i[4]; float sel_e[4];
#pragma unroll
            for (int k = 0; k < 4; ++k) { float m = cur; int mi = e;
#pragma unroll
                for (int o2 = 16; o2 > 0; o2 >>= 1) { const float om = __shfl_xor(m, o2); const int oi = __shfl_xor(mi, o2); if (om > m || (om == m && oi < mi)) { m = om; mi = oi; } }
                if (k == 0) tv0 = m; sel_i[k] = mi; sel_e[k] = __expf(m - tv0); sum += sel_e[k]; if (e == mi) cur = -3.0e38f; }
            int myk = 0; float myp = 0.f;
#pragma unroll
            for (int k = 0; k < 4; ++k) if (t2 == k) { myk = sel_i[k]; myp = sel_e[k] / sum; }
            if (t2 < 4) { const int pair = row * 4 + t2; topi[pair] = myk; topp[pair] = myp; __hip_atomic_fetch_add(&lcnt[myk], 1, __ATOMIC_RELAXED, __HIP_MEMORY_SCOPE_WORKGROUP); lent[(it * 2 + half) * 4 + t2] = myk; }
        }
        __syncthreads();
    }
    if (tid < 32) { const int n = lcnt[tid]; lcnt[32 + tid] = n > 0 ? atomicAdd(&cnt[tid], n) : 0; lcnt[64 + tid] = 0; }
    __syncthreads();
    const int nent = it * 8;
    for (int s = tid; s < nent; s += 512) { const int e = lent[s]; const int ii = s >> 3, hh = (s >> 2) & 1, k = s & 3; const int row = blockIdx.x * 2 + ii * gridDim.x * 2 + hh; const int pos = lcnt[32 + e] + __hip_atomic_fetch_add(&lcnt[64 + e], 1, __ATOMIC_RELAXED, __HIP_MEMORY_SCOPE_WORKGROUP); list[e * CAP + pos] = row * 4 + k; }
}
__device__ __forceinline__ void moe_table(const int* cnt, LAS int* tab) {
    if (otid() == 0) { int t = 0; for (int e = 0; e < NE; ++e) { tab[e] = t; const int n = cnt[e]; tab[64 + e] = n; t += (n + 255) >> 8; } tab[32] = t; tab[33] = t; }
    __syncthreads();
}
constexpr int LDS_TAB = pg8::STAGE_BYTES;
__device__ __forceinline__ void phase7(const Params& p, LAS unsigned char* lds) {
    char* ws = p.ws; LAS int* tab = (LAS int*)(lds + LDS_TAB); moe_table((const int*)(ws + OFF_CNT), tab);
    pg8::MoeSched<true> S; S.nN = 8; S.G = gridDim.x; S.c = blockIdx.x; S.Wt = ws + OFF_WT_GU; S.wexp = (size_t)2048 * 1024 * 2; S.btile = (size_t)256 * 1024 * 2; S.tab = tab; S.list = (const int*)(ws + OFF_LIST);
    pg8::EpiMoe1 E{(bf16_t*)(ws + OFF_ACT), p.b_gu};
    pg8::gemm_phase(lds, (const char*)(ws + OFF_H), 1024, S, E);
}
__device__ __forceinline__ void phase8(const Params& p, LAS unsigned char* lds) {
    char* ws = p.ws; LAS int* tab = (LAS int*)(lds + LDS_TAB); moe_table((const int*)(ws + OFF_CNT), tab);
    pg8::MoeSched<false> S; S.nN = 4; S.G = gridDim.x; S.c = blockIdx.x; S.Wt = ws + OFF_WT_DN; S.wexp = (size_t)1024 * 1024 * 2; S.btile = (size_t)256 * 1024 * 2; S.tab = tab; S.list = (const int*)(ws + OFF_LIST);
    pg8::EpiMoe2 E{(bf16_t*)(ws + OFF_YP), p.b_dn, (const int*)(ws + OFF_LIST)};
    pg8::gemm_phase(lds, (const char*)(ws + OFF_ACT), 1024, S, E);
}
__device__ __forceinline__ void phase9(const Params& p, LAS unsigned char* lds) {
    char* ws = p.ws; LAS float* red = (LAS float*)lds; const float* modv = (const float*)(ws + OFF_MOD); const bf16_t* yp = (const bf16_t*)(ws + OFF_YP); const float* topp = (const float*)(ws + OFF_TOPP);
    const int half = otid() >> 8, c = (otid() & 255) * 4;
    for (int row = blockIdx.x * 2 + half; row < L; row += gridDim.x * 2) {
        const float* gate = modv + (row / SEQ) * 6144 + 5 * 1024; const float4 v = *(const float4*)(p.out + (size_t)row * D + c); float xv[4] = {v.x, v.y, v.z, v.w}, m[4] = {0.f, 0.f, 0.f, 0.f};
#pragma unroll
        for (int k = 0; k < 4; ++k) { const float pk = topp[row * 4 + k]; const ushort4 u = *(const ushort4*)(yp + (size_t)(row * 4 + k) * D + c); const bf16_t* up = (const bf16_t*)&u;
#pragma unroll
            for (int i = 0; i < 4; ++i) m[i] += pk * bf2f(up[i]); }
        float ss = 0.f;
#pragma unroll
        for (int i = 0; i < 4; ++i) { xv[i] += gate[c + i] * m[i]; ss += xv[i] * xv[i]; }
        ss = half_sum256(ss, red); const float rs = rsqrtf(ss * (1.0f / D) + EPS); const float4 fg = *(const float4*)(p.g_fin + c);
        float4 o; o.x = xv[0] * rs * fg.x; o.y = xv[1] * rs * fg.y; o.z = xv[2] * rs * fg.z; o.w = xv[3] * rs * fg.w; *(float4*)(p.out + (size_t)row * D + c) = o; }
}

namespace at {
using s16x4  = __attribute__((ext_vector_type(4))) short;
using f32x16 = __attribute__((ext_vector_type(16))) float;
constexpr int NW = 8, QBLK = 32, KVBLK = 64, DK = 192, DV = 128;
constexpr float SCALE = 0.07216878364870322f;
constexpr float THR = 8.f;
constexpr int SHM_V = KVBLK * DV * 2, SHM_K = KVBLK * DK * 2, SHM_ATTN = 2 * SHM_V + 2 * SHM_K + NW * 64 * 4;
#define KSWZ(row, colB) ((row) * 384 + ((colB) ^ (((row) & 7) << 4)))
#define SBAR() __builtin_amdgcn_sched_barrier(0)
__device__ __forceinline__ int crow(int r, int hi) { return (r & 3) + 8 * (r >> 2) + 4 * hi; }
__device__ __forceinline__ unsigned cvtpk(float lo, float hi) { return cvt_pk_bf16(lo, hi); }

__device__ __forceinline__ void partialSM(f32x16& p0, f32x16& p1, float& m_reg, float& mn, float& alpha) {
  constexpr float C = SCALE * 1.4426950408889634f;
  float pmax = p0[0];
#pragma unroll
  for (int r = 1; r < 16; ++r) pmax = fmaxf(pmax, p0[r]);
#pragma unroll
  for (int r = 0; r < 16; ++r) pmax = fmaxf(pmax, p1[r]);
  { auto rr = __builtin_amdgcn_permlane32_swap(__float_as_uint(pmax), __float_as_uint(pmax), false, false);
    pmax = fmaxf(__uint_as_float(rr[0]), __uint_as_float(rr[1])); }
  if (__builtin_expect(__all(pmax - m_reg <= THR / SCALE), 1)) { mn = m_reg; alpha = 1.f; }
  else { mn = fmaxf(m_reg, pmax); alpha = __builtin_amdgcn_exp2f((m_reg - mn) * C); m_reg = mn; }
  float mnC = -mn * C;
#pragma unroll
  for (int r = 0; r < 16; ++r) p0[r] = fmaf(p0[r], C, mnC);
#pragma unroll
  for (int r = 0; r < 16; ++r) p1[r] = fmaf(p1[r], C, mnC);
#pragma unroll
  for (int r = 0; r < 16; ++r) p0[r] = __builtin_amdgcn_exp2f(p0[r]);
}
__device__ __forceinline__ void finishSM(f32x16& p0, f32x16& p1, float alpha, float& l_reg, bf16x8& pa0, bf16x8& pa1, bf16x8& pa2, bf16x8& pa3) {
#pragma unroll
  for (int r = 0; r < 16; ++r) p1[r] = __builtin_amdgcn_exp2f(p1[r]);
  float ps = 0;
#pragma unroll
  for (int r = 0; r < 16; ++r) ps += p0[r];
#pragma unroll
  for (int r = 0; r < 16; ++r) ps += p1[r];
  { auto rr = __builtin_amdgcn_permlane32_swap(__float_as_uint(ps), __float_as_uint(ps), false, false);
    ps = __uint_as_float(rr[0]) + __uint_as_float(rr[1]); }
  l_reg = l_reg * alpha + ps;
#define PK4(P, BASE, OUT) do { unsigned a0 = cvtpk(P[BASE + 0], P[BASE + 1]), a1 = cvtpk(P[BASE + 2], P[BASE + 3]);   \
    unsigned b0 = cvtpk(P[BASE + 4], P[BASE + 5]), b1 = cvtpk(P[BASE + 6], P[BASE + 7]);                              \
    auto r0 = __builtin_amdgcn_permlane32_swap(a0, b0, false, false); auto r1 = __builtin_amdgcn_permlane32_swap(a1, b1, false, false); \
    u32x4 w = {r0[0], r1[0], r0[1], r1[1]}; OUT = *reinterpret_cast<bf16x8*>(&w); } while (0)
  PK4(p0, 0, pa0); PK4(p0, 8, pa1); PK4(p1, 0, pa2); PK4(p1, 8, pa3);
#undef PK4
}
__device__ __forceinline__ void qkt(f32x16& p0, f32x16& p1, const LAS char* Ks, const bf16x8 (&qr)[12], int r32, int hi) {
  p0 = f32x16{}; p1 = f32x16{};
#pragma unroll
  for (int d0 = 0; d0 < 12; ++d0) { const int cb = (d0 * 16 + hi * 8) * 2;
    const bf16x8 b0 = *reinterpret_cast<const LAS bf16x8*>(Ks + KSWZ(r32, cb));
    const bf16x8 b1 = *reinterpret_cast<const LAS bf16x8*>(Ks + KSWZ(32 + r32, cb));
    p0 = __builtin_amdgcn_mfma_f32_32x32x16_bf16(b0, qr[d0], p0, 0, 0, 0);
    p1 = __builtin_amdgcn_mfma_f32_32x32x16_bf16(b1, qr[d0], p1, 0, 0, 0); }
}
__device__ __forceinline__ int v_st(int k, int c) { const int kk = (k & ~0xC) | ((k & 4) << 1) | ((k & 8) >> 1); return ((kk >> 3) * 4 + (c >> 5)) * 512 + ((kk & 7) * 32 + (c & 31)) * 2; }
__device__ __forceinline__ int v_rd_base(int lane) { return ((lane & 3) << 3) | (((lane >> 2) & 3) << 6) | (((lane >> 4) & 1) << 5) | (((lane >> 5) & 1) << 8); }
constexpr int v_rd_off(int d0, int ks, int half) { return d0 * 512 + ks * 4096 + half * 2048; }
template <int OFF> __device__ __forceinline__ s16x4 tr_read(int vb) { s16x4 r; asm volatile("ds_read_b64_tr_b16 %0, %1 offset:%2" : "=&v"(r) : "v"(vb), "i"(OFF) : "memory"); return r; }
template <int D0> __device__ __forceinline__ void pv_one(f32x16& od, int vb, bf16x8 pa0, bf16x8 pa1, bf16x8 pa2, bf16x8 pa3) {
  const s16x4 l0 = tr_read<v_rd_off(D0, 0, 0)>(vb), h0 = tr_read<v_rd_off(D0, 0, 1)>(vb), l1 = tr_read<v_rd_off(D0, 1, 0)>(vb), h1 = tr_read<v_rd_off(D0, 1, 1)>(vb);
  const s16x4 l2 = tr_read<v_rd_off(D0, 2, 0)>(vb), h2 = tr_read<v_rd_off(D0, 2, 1)>(vb), l3 = tr_read<v_rd_off(D0, 3, 0)>(vb), h3 = tr_read<v_rd_off(D0, 3, 1)>(vb);
  asm volatile("s_waitcnt lgkmcnt(0)" ::: "memory"); SBAR();
#define PK(Lo, Hi) (bf16x8){Lo[0], Lo[1], Lo[2], Lo[3], Hi[0], Hi[1], Hi[2], Hi[3]}
  od = __builtin_amdgcn_mfma_f32_32x32x16_bf16(pa0, PK(l0, h0), od, 0, 0, 0);
  od = __builtin_amdgcn_mfma_f32_32x32x16_bf16(pa1, PK(l1, h1), od, 0, 0, 0);
  od = __builtin_amdgcn_mfma_f32_32x32x16_bf16(pa2, PK(l2, h2), od, 0, 0, 0);
  od = __builtin_amdgcn_mfma_f32_32x32x16_bf16(pa3, PK(l3, h3), od, 0, 0, 0);
#undef PK
}
__device__ __forceinline__ void pv_d0(f32x16 (&o)[4], int vb, bf16x8 pa0, bf16x8 pa1, bf16x8 pa2, bf16x8 pa3) {
  pv_one<0>(o[0], vb, pa0, pa1, pa2, pa3); pv_one<1>(o[1], vb, pa0, pa1, pa2, pa3); pv_one<2>(o[2], vb, pa0, pa1, pa2, pa3); pv_one<3>(o[3], vb, pa0, pa1, pa2, pa3);
}

__device__ __forceinline__ void attn_unit(const bf16_t* __restrict__ Qb, const bf16_t* __restrict__ Kh, const bf16_t* __restrict__ Vh, bf16_t* __restrict__ Ob, int t0, const float* __restrict__ ropet, LAS char* lds) {
  constexpr int LDQ = 1536, LDO = 1024, NT = NKEY / KVBLK;
  const int tid = otid(), wid = tid >> 6, lane = tid & 63, r32 = lane & 31, hi = lane >> 5;
  LAS char* V_lds = lds; LAS char* K_lds = lds + 2 * SHM_V;
  LAS float* wsl = (LAS float*)(lds + 2 * SHM_V + 2 * SHM_K) + wid * 64; LAS float* li_l = wsl; LAS float* al_l = wsl + 32;
  float m_reg = -1e30f, l_reg = 0; f32x16 o[4] = {}; bf16x8 qr[12];
  { const bf16_t* Qw = Qb + (size_t)(wid * QBLK + r32) * LDQ + hi * 8;
#pragma unroll
    for (int d0 = 0; d0 < 12; ++d0) qr[d0] = *reinterpret_cast<const bf16x8*>(Qw + d0 * 16);
    const float* rt = ropet + (size_t)(t0 + wid * QBLK + r32) * 64 + 8 * hi;
#pragma unroll
    for (int g = 0; g < 2; ++g) {
      const f32x4 c0 = *(const f32x4*)(rt + 16 * g), c1 = *(const f32x4*)(rt + 16 * g + 4), s0 = *(const f32x4*)(rt + 32 + 16 * g), s1 = *(const f32x4*)(rt + 32 + 16 * g + 4);
      float n1[8], n2[8];
#pragma unroll
      for (int j = 0; j < 8; ++j) { const float cs = j < 4 ? c0[j & 3] : c1[j & 3], sn = j < 4 ? s0[j & 3] : s1[j & 3];
        const float x1 = bf2f((bf16_t)qr[8 + g][j]), x2 = bf2f((bf16_t)qr[10 + g][j]); n1[j] = x1 * cs - x2 * sn; n2[j] = x1 * sn + x2 * cs; }
      u32x4 w1 = {cvtpk(n1[0], n1[1]), cvtpk(n1[2], n1[3]), cvtpk(n1[4], n1[5]), cvtpk(n1[6], n1[7])}; u32x4 w2 = {cvtpk(n2[0], n2[1]), cvtpk(n2[2], n2[3]), cvtpk(n2[4], n2[5]), cvtpk(n2[6], n2[7])};
      qr[8 + g] = *reinterpret_cast<bf16x8*>(&w1); qr[10 + g] = *reinterpret_cast<bf16x8*>(&w2); } }
  const int sr = tid >> 4, sc = (tid & 15) * 8, vst0 = v_st(sr, sc), vst1 = v_st(32 + sr, sc);
  int kgo[3], kst[3];
#pragma unroll
  for (int i = 0; i < 3; ++i) { const int c = tid + 512 * i, row = c / 24, c8 = (c % 24) * 8; kgo[i] = row * DK + c8; kst[i] = KSWZ(row, c8 * 2); }
  const int vb0 = (int)(uintptr_t)V_lds + v_rd_base(lane);
  bf16x8 sv0, sv1, sk0, sk1, sk2;
#define SLOAD(k0) do { sv0 = *reinterpret_cast<const bf16x8*>(&Vh[(size_t)((k0) + sr) * DV + sc]); sv1 = *reinterpret_cast<const bf16x8*>(&Vh[(size_t)((k0) + 32 + sr) * DV + sc]); \
    sk0 = *reinterpret_cast<const bf16x8*>(&Kh[(size_t)(k0) * DK + kgo[0]]); sk1 = *reinterpret_cast<const bf16x8*>(&Kh[(size_t)(k0) * DK + kgo[1]]); sk2 = *reinterpret_cast<const bf16x8*>(&Kh[(size_t)(k0) * DK + kgo[2]]); } while (0)
#define SWRITE(b) do { *(LAS bf16x8*)(V_lds + (b) * SHM_V + vst0) = sv0; *(LAS bf16x8*)(V_lds + (b) * SHM_V + vst1) = sv1; \
    *(LAS bf16x8*)(K_lds + (b) * SHM_K + kst[0]) = sk0; *(LAS bf16x8*)(K_lds + (b) * SHM_K + kst[1]) = sk1; *(LAS bf16x8*)(K_lds + (b) * SHM_K + kst[2]) = sk2; } while (0)
#define RESC(a) do { if (__any((a) < 1.f)) { if (hi == 0) al_l[r32] = (a); asm volatile("s_waitcnt lgkmcnt(0)" ::: "memory"); \
    _Pragma("unroll") for (int d = 0; d < 4; ++d) _Pragma("unroll") for (int r = 0; r < 16; ++r) o[d][r] *= al_l[crow(r, hi)]; } } while (0)
  f32x16 p0, p1; float mn, al; bf16x8 pa0, pa1, pa2, pa3;
  SLOAD(0); asm volatile("s_waitcnt vmcnt(0)" ::: "memory"); SWRITE(0); __syncthreads();
  for (int j = 0; j < NT; ++j) {
    const int bsel = j & 1;
    if (j + 1 < NT) SLOAD((j + 1) * KVBLK);
    SBAR(); qkt(p0, p1, K_lds + bsel * SHM_K, qr, r32, hi);
    partialSM(p0, p1, m_reg, mn, al);
    RESC(al);
    finishSM(p0, p1, al, l_reg, pa0, pa1, pa2, pa3); SBAR();
    pv_d0(o, vb0 + bsel * SHM_V, pa0, pa1, pa2, pa3);
    if (j + 1 < NT) { asm volatile("s_waitcnt vmcnt(0)" ::: "memory"); SWRITE(bsel ^ 1); }
    __syncthreads();
  }
  if (hi == 0) li_l[r32] = l_reg; asm volatile("s_waitcnt lgkmcnt(0)" ::: "memory");
  float rli[16];
#pragma unroll
  for (int r = 0; r < 16; ++r) rli[r] = __builtin_amdgcn_rcpf(li_l[crow(r, hi)]);
  bf16_t* Ow = Ob + (size_t)(wid * QBLK) * LDO;
#pragma unroll
  for (int r = 0; r < 16; ++r) { const int orow = crow(r, hi);
#pragma unroll
    for (int d0 = 0; d0 < 4; ++d0) Ow[(size_t)orow * LDO + d0 * 32 + r32] = f2bf(o[d0][r] * rli[r]); }
#undef SLOAD
#undef SWRITE
#undef RESC
}
}

__device__ __forceinline__ void phase_attn(const Params& p, LAS unsigned char* lds) {
    char* ws = p.ws; const bf16_t* Q = (const bf16_t*)(ws + OFF_Q); const bf16_t* Kb = (const bf16_t*)(ws + OFF_K); const bf16_t* Vb = (const bf16_t*)(ws + OFF_V); bf16_t* Y = (bf16_t*)(ws + OFF_H);
    const int G = gridDim.x;
    for (int it = 0;; ++it) {
        int u;
        if (G == 256) { const int c = blockIdx.x, xcd = c & 7, j = c >> 3; if (it >= 4) break; u = ((it * 32 + xcd * 4 + (j >> 3)) << 3) | (j & 7); }
        else { u = it * G + blockIdx.x; if (u >= 1024) break; }
        const int bh = u >> 3, qb = u & 7, b = bh >> 3, h = bh & 7;
        at::attn_unit(Q + ((size_t)(b * SEQ + qb * 256)) * 1536 + h * 192, Kb + (size_t)bh * NKEY * 192, Vb + (size_t)bh * NKEY * 128, Y + ((size_t)(b * SEQ + qb * 256)) * D + h * 128, qb * 256, (const float*)(ws + OFF_ROPE), (LAS char*)lds);
        __syncthreads();
    }
}

namespace sc {
using f32x16 = __attribute__((ext_vector_type(16))) float;
constexpr int O_QI = 0, O_QG = 16384, O_KT = 32768, O_KE = 73728, O_VT = 90112, O_AT = 106496, O_SC = 114688, O_DEC = 147456, LDS_SCAN = 147456 + 512;
__device__ __forceinline__ int sw256(int row, int cb) { return row * 256 + (cb ^ ((row & 15) << 4)); }
__device__ __forceinline__ int sw128(int row, int cb) { return row * 128 + (cb ^ (((row >> 1) & 7) << 4)); }
__device__ __forceinline__ int crow(int r, int hi) { return (r & 3) + 8 * (r >> 2) + 4 * hi; }
__device__ __forceinline__ int grow_of(int n, int b, int dir) { if (n < CTXL) { const int s = dir ? (CTXL - 1 - n) : n; return L + b * CTXL + s; } const int m = n - CTXL; return b * SEQ + (dir ? (SEQ - 1 - m) : m); }

__device__ __forceinline__ void scan_unit(const Params& p, int unit, LAS unsigned char* lds) {
    char* ws = p.ws; const int dir = unit & 1, h = (unit >> 1) & 7, b = unit >> 4;
    const bf16_t* hq = (const bf16_t*)(ws + OFF_HQ); const bf16_t* fz = (const bf16_t*)(ws + (dir ? OFF_FB : OFF_FF)); const bf16_t* iv = (const bf16_t*)(ws + OFF_IV);
    bf16_t* outp = (bf16_t*)(ws + (dir ? OFF_OB : OFF_OF)); const float* lb = (const float*)(ws + OFF_LB);
    const int tid = otid(), wid = tid >> 6, lane = tid & 63, r32 = lane & 31, hi = lane >> 5;
    const int col = tid >> 2, J = tid & 3;
    const float lbv = lb[dir * 1024 + h * 128 + col];
    const int hc = h * 128 + col;
    LAS unsigned char* QI = lds + O_QI; LAS unsigned char* QG = lds + O_QG; LAS unsigned char* KT = lds + O_KT; LAS unsigned char* KE = lds + O_KE; LAS unsigned char* VT = lds + O_VT;
    LAS unsigned char* AT = lds + O_AT; LAS unsigned char* SCp = lds + O_SC; LAS float* DEC = (LAS float*)(lds + O_DEC);
    for (int i = tid; i < (8192 + 32768) / 16; i += 512) *(LAS u32x4*)(lds + O_AT + i * 16) = (u32x4){0u, 0u, 0u, 0u};
    f32x16 S0 = {}, S1 = {};
    const int tb = wid & 1, dvb = wid >> 1;
    unsigned short zr[16], vr[16], qr[16];
#define SC_LOAD(c) do { _Pragma("unroll") for (int i = 0; i < 16; ++i) { const int row = grow_of((c) * 64 + 16 * J + i, b, dir); zr[i] = fz[(size_t)row * D + hc]; vr[i] = iv[(size_t)row * D + hc]; \
        qr[i] = ((c) >= 4) ? hq[(size_t)row * D + hc] : (unsigned short)0; } } while (0)
    SC_LOAD(0);
    __syncthreads();
    for (int c = 0; c < 36; ++c) {
        const bool lat = c >= 4;
        {
            float kk[16], lcum[16]; float run = 0.f;
#pragma unroll
            for (int i = 0; i < 16; ++i) { const float z = bf2f(zr[i]); const float f = lbv + (1.0f - lbv) * sigmoidf_(z); kk[i] = 1.0f - f; run += __logf(f); lcum[i] = run; }
            const int l4 = lane & ~3;
            const float ta = __shfl(run, l4 + 0), tbv = __shfl(run, l4 + 1), tc = __shfl(run, l4 + 2), td = __shfl(run, l4 + 3);
            const float c0J = J == 0 ? 0.f : (J == 1 ? ta : (J == 2 ? ta + tbv : ta + tbv + tc));
            const float lastv = (ta + tbv) + (tc + td);
            const float egJ = __expf(c0J), eend = __expf(lastv - c0J);
            const float c01 = ta, c02 = ta + tbv, c03 = ta + tbv + tc;
            const float e1 = __expf(c01 - c0J), e2 = __expf(c02 - c0J), e3 = __expf(c03 - c0J);
            if (J == 0) DEC[col] = __expf(lastv);
            unsigned kev[8], vtv[8];
#pragma unroll
            for (int i = 0; i < 16; i += 2) {
                float kd[2], vv[2];
#pragma unroll
                for (int u = 0; u < 2; ++u) { const int ii = i + u; const float eq = __expf(lcum[ii]), ek = __expf(fminf(-lcum[ii], 80.0f)); const float kdv = kk[ii] * ek; kd[u] = kdv; vv[u] = bf2f(vr[ii]);
                    const int t = 16 * J + ii;
                    if (lat) { const float q = siluf_(bf2f(qr[ii])) * 0.08838834764831845f; const float qi = q * eq;
                        *(LAS bf16_t*)(QI + sw256(t, col * 2)) = f2bf(qi); *(LAS bf16_t*)(QG + sw256(t, col * 2)) = f2bf(qi * egJ);
                        if (J == 0) { *(LAS bf16_t*)(KT + sw256(0 + t, col * 2)) = f2bf(kdv); *(LAS bf16_t*)(KT + sw256(16 + t, col * 2)) = f2bf(kdv * e1); *(LAS bf16_t*)(KT + sw256(48 + t, col * 2)) = f2bf(kdv * e2); *(LAS bf16_t*)(KT + sw256(96 + t, col * 2)) = f2bf(kdv * e3); }
                        else if (J == 1) { *(LAS bf16_t*)(KT + sw256(16 + t, col * 2)) = f2bf(kdv); *(LAS bf16_t*)(KT + sw256(48 + t, col * 2)) = f2bf(kdv * e2); *(LAS bf16_t*)(KT + sw256(96 + t, col * 2)) = f2bf(kdv * e3); }
                        else if (J == 2) { *(LAS bf16_t*)(KT + sw256(48 + t, col * 2)) = f2bf(kdv); *(LAS bf16_t*)(KT + sw256(96 + t, col * 2)) = f2bf(kdv * e3); }
                        else { *(LAS bf16_t*)(KT + sw256(96 + t, col * 2)) = f2bf(kdv); } } }
                kev[i >> 1] = cvt_pk_bf16(kd[0] * eend, kd[1] * eend); vtv[i >> 1] = cvt_pk_bf16(vv[0], vv[1]);
            }
            *(LAS u32x4*)(KE + sw128(col, 32 * J)) = (u32x4){kev[0], kev[1], kev[2], kev[3]}; *(LAS u32x4*)(KE + sw128(col, 32 * J + 16)) = (u32x4){kev[4], kev[5], kev[6], kev[7]};
            *(LAS u32x4*)(VT + sw128(col, 32 * J)) = (u32x4){vtv[0], vtv[1], vtv[2], vtv[3]}; *(LAS u32x4*)(VT + sw128(col, 32 * J + 16)) = (u32x4){vtv[4], vtv[5], vtv[6], vtv[7]};
        }
        if (c + 1 < 36) SC_LOAD(c + 1);
        __syncthreads();
        if (lat) {
#pragma unroll
            for (int rep = 0; rep < 2; ++rep) { const int ti = wid + 8 * rep; if (ti < 10) {
                const int I = ti < 1 ? 0 : (ti < 3 ? 1 : (ti < 6 ? 2 : 3)); const int Jt = ti - (I * (I + 1)) / 2; const int kbase = I == 0 ? 0 : (I == 1 ? 16 : (I == 2 ? 48 : 96));
                const int l15 = lane & 15, lq = lane >> 4; f32x4 a = {0.f, 0.f, 0.f, 0.f};
#pragma unroll
                for (int ks = 0; ks < 4; ++ks) { const bf16x8 av = *(const LAS bf16x8*)(QI + sw256(16 * I + l15, (32 * ks + 8 * lq) * 2)); const bf16x8 bv = *(const LAS bf16x8*)(KT + sw256(kbase + 16 * Jt + l15, (32 * ks + 8 * lq) * 2));
                    a = __builtin_amdgcn_mfma_f32_16x16x32_bf16(av, bv, a, 0, 0, 0); }
#pragma unroll
                for (int r = 0; r < 4; ++r) { const int tl = 4 * lq + r; float v = a[r]; if (I == Jt && l15 > tl) v = 0.f; *(LAS bf16_t*)(AT + sw128(16 * I + tl, (16 * Jt + l15) * 2)) = f2bf(v); } } }
        }
        __syncthreads();
        {
            if (lat) {
                f32x16 o = {};
#pragma unroll
                for (int ks = 0; ks < 8; ++ks) { const bf16x8 av = *(const LAS bf16x8*)(QG + sw256(32 * tb + r32, (16 * ks + 8 * hi) * 2)); const bf16x8 bv = *(const LAS bf16x8*)(SCp + sw256(32 * dvb + r32, (16 * ks + 8 * hi) * 2));
                    o = __builtin_amdgcn_mfma_f32_32x32x16_bf16(av, bv, o, 0, 0, 0); }
#pragma unroll
                for (int ks = 0; ks < 4; ++ks) { if (ks < 2 || tb == 1) { const bf16x8 av = *(const LAS bf16x8*)(AT + sw128(32 * tb + r32, (16 * ks + 8 * hi) * 2)); const bf16x8 bv = *(const LAS bf16x8*)(VT + sw128(32 * dvb + r32, (16 * ks + 8 * hi) * 2));
                    o = __builtin_amdgcn_mfma_f32_32x32x16_bf16(av, bv, o, 0, 0, 0); } }
#pragma unroll
                for (int r = 0; r < 16; ++r) { const int t = 32 * tb + crow(r, hi); const int row = grow_of(c * 64 + t, b, dir); outp[(size_t)row * D + h * 128 + 32 * dvb + r32] = f2bf(o[r]); }
            }
#pragma unroll
            for (int r = 0; r < 16; ++r) { S0[r] *= DEC[64 * tb + crow(r, hi)]; S1[r] *= DEC[64 * tb + 32 + crow(r, hi)]; }
#pragma unroll
            for (int ks = 0; ks < 4; ++ks) { const bf16x8 bv = *(const LAS bf16x8*)(VT + sw128(32 * dvb + r32, (16 * ks + 8 * hi) * 2));
                const bf16x8 a0 = *(const LAS bf16x8*)(KE + sw128(64 * tb + r32, (16 * ks + 8 * hi) * 2)), a1 = *(const LAS bf16x8*)(KE + sw128(64 * tb + 32 + r32, (16 * ks + 8 * hi) * 2));
                S0 = __builtin_amdgcn_mfma_f32_32x32x16_bf16(a0, bv, S0, 0, 0, 0); S1 = __builtin_amdgcn_mfma_f32_32x32x16_bf16(a1, bv, S1, 0, 0, 0); }
        }
        __syncthreads();
#pragma unroll
        for (int g = 0; g < 4; ++g) { const int dv = 32 * dvb + r32; const int dk0 = 64 * tb + 8 * g + 4 * hi;
            u32x2 w0; w0.x = cvt_pk_bf16(S0[4 * g], S0[4 * g + 1]); w0.y = cvt_pk_bf16(S0[4 * g + 2], S0[4 * g + 3]); *(LAS u32x2*)(SCp + sw256(dv, dk0 * 2)) = w0;
            u32x2 w1; w1.x = cvt_pk_bf16(S1[4 * g], S1[4 * g + 1]); w1.y = cvt_pk_bf16(S1[4 * g + 2], S1[4 * g + 3]); *(LAS u32x2*)(SCp + sw256(dv, (dk0 + 32) * 2)) = w1; }
    }
    __syncthreads();
#undef SC_LOAD
}
}
__device__ __forceinline__ void phase_scan(const Params& p, LAS unsigned char* lds) {
    for (int u = blockIdx.x; u < 256; u += gridDim.x) sc::scan_unit(p, u, lds);
}

constexpr int LDS_BYTES = 155648;
template <int PH> __global__ void __launch_bounds__(512, 2) k_phase(Params p) {
    extern __shared__ __attribute__((aligned(16))) unsigned char smem[];
    LAS unsigned char* lds = (LAS unsigned char*)smem;
    if constexpr (PH == 0) phase0(p, lds);
    if constexpr (PH == 1) phase1(p, lds);
    if constexpr (PH == 2) phase2(p, lds);
    if constexpr (PH == 3) phase3(p, lds);
    if constexpr (PH == 4) phase4(p, lds);
    if constexpr (PH == 5) phase5(p, lds);
    if constexpr (PH == 6) phase6(p, lds);
    if constexpr (PH == 7) phase7(p, lds);
    if constexpr (PH == 8) phase8(p, lds);
    if constexpr (PH == 9) phase9(p, lds);
    if constexpr (PH == 10) phase_attn(p, lds);
    if constexpr (PH == 11) phase_scan(p, lds);
}

#include <cstdint>
#include <cstdlib>
#include <vector>

#define XB_TMO      128
#define XB_XCNT(j)  (256  + 64 * (j))
#define XB_XSUB(j)  (1280 + 64 * (j))
#define XB_XGEN(j)  (2304 + 64 * (j))
#define XB_TOP      3328
#define XB_TOPGEN   3392
#define XCD_BAR_WORDS 3456
#define XB_SPIN_CAP (1u << 18)

__device__ __forceinline__ unsigned xb_ld(unsigned* p)              { return __hip_atomic_load(p, __ATOMIC_RELAXED, __HIP_MEMORY_SCOPE_AGENT); }
__device__ __forceinline__ unsigned xb_add(unsigned* p, unsigned v) { return __hip_atomic_fetch_add(p, v, __ATOMIC_RELAXED, __HIP_MEMORY_SCOPE_AGENT); }
__device__ __forceinline__ unsigned xb_xcc_id() { return (unsigned)__builtin_amdgcn_s_getreg((3 << 11) | 20) & 0xFu; }
#define XB_SPIN(cond, bar) do { unsigned _sp = 0; while (cond) { __builtin_amdgcn_s_sleep(1); \
    if ((++_sp & 255u) == 0u) { if (xb_ld(&(bar)[XB_TMO])) break; if (_sp > XB_SPIN_CAP) { atomicAdd(&(bar)[XB_TMO], 1u); break; } } } } while (0)

struct XcdBarrier {
    unsigned* bar; unsigned x;
    volatile LAS unsigned* st;
};

__device__ __forceinline__ XcdBarrier xcd_barrier_post(unsigned* bar, volatile LAS unsigned* st) {
    XcdBarrier b; b.bar = bar; b.x = xb_xcc_id(); b.st = st;
    if (threadIdx.x == 0) (void)xb_add(&bar[XB_XCNT(b.x)], 1u);
    return b;
}
__device__ __forceinline__ void xcd_barrier_complete(unsigned* bar, unsigned x, unsigned& nloc, unsigned& nx) {
    const unsigned G = gridDim.x * gridDim.y * gridDim.z;
    unsigned sum, cnt, mine, sp = 0u;
    for (;;) {
        sum = 0u; cnt = 0u; mine = 0u;
#pragma unroll
        for (unsigned j = 0; j < 16; ++j) { const unsigned c = xb_ld(&bar[XB_XCNT(j)]); sum += c; cnt += (c > 0u) ? 1u : 0u; mine = (j == x) ? c : mine; }
        if (sum == G) break;
        __builtin_amdgcn_s_sleep(1);
        if ((++sp & 255u) == 0u) { if (xb_ld(&bar[XB_TMO])) break; if (sp > XB_SPIN_CAP) { atomicAdd(&bar[XB_TMO], 1u); break; } }
    }
    nloc = mine > 0u ? mine : 1u; nx = cnt > 0u ? cnt : 1u;
}

__device__ __forceinline__ void xcd_barrier(const XcdBarrier& b) {
    asm volatile("s_waitcnt vmcnt(0)" ::: "memory");
    __syncthreads();
    if (threadIdx.x == 0) {
        unsigned* bar = b.bar;
        __builtin_amdgcn_s_waitcnt(0);
        unsigned nloc = b.st[0], nx = b.st[1];
        if (nloc == 0u) { xcd_barrier_complete(bar, b.x, nloc, nx); b.st[0] = nloc; b.st[1] = nx; }
        const unsigned old = xb_add(&bar[XB_XSUB(b.x)], 1u);
        const unsigned gen = old / nloc;
        if (old + 1u == (gen + 1u) * nloc) {
            __builtin_amdgcn_fence(__ATOMIC_RELEASE, "agent");
            asm volatile("s_waitcnt vmcnt(0)" ::: "memory");
            const unsigned og = xb_add(&bar[XB_TOP], 1u);
            const unsigned tg = og / nx;
            if (og + 1u == (tg + 1u) * nx) xb_add(&bar[XB_TOPGEN], 1u);
            else XB_SPIN(xb_ld(&bar[XB_TOPGEN]) == tg, bar);
            __builtin_amdgcn_fence(__ATOMIC_ACQUIRE, "agent");
            xb_add(&bar[XB_XGEN(b.x)], 1u);
            asm volatile("s_waitcnt vmcnt(0)" ::: "memory");
        } else {
            XB_SPIN(xb_ld(&bar[XB_XGEN(b.x)]) == gen, bar);
            __builtin_amdgcn_fence(__ATOMIC_ACQUIRE, "agent");
            asm volatile("s_waitcnt vmcnt(0)" ::: "memory");
        }
    }
    __syncthreads();
}

__global__ void __launch_bounds__(512, 2) k_mega(Params p) {
    extern __shared__ __attribute__((aligned(16))) unsigned char smem[];
    LAS unsigned char* lds = (LAS unsigned char*)smem;
    volatile LAS unsigned* xbw = (volatile LAS unsigned*)(lds + LDS_BYTES - 16);
    if (threadIdx.x == 0) { xbw[0] = 0u; xbw[1] = 0u; xbw[2] = 0u; xbw[3] = 0u; }
    __syncthreads();
    XcdBarrier bar = xcd_barrier_post((unsigned*)(p.ws + OFF_BAR), xbw);
    phase0(p, lds);      xcd_barrier(bar);
    phase1(p, lds);      xcd_barrier(bar);
    phase2(p, lds);      xcd_barrier(bar);
    phase3(p, lds);      xcd_barrier(bar);
    phase_attn(p, lds);
    phase_scan(p, lds);  xcd_barrier(bar);
    phase4(p, lds);      xcd_barrier(bar);
    phase5(p, lds);      xcd_barrier(bar);
    phase6(p, lds);      xcd_barrier(bar);
    phase7(p, lds);      xcd_barrier(bar);
    phase8(p, lds);      xcd_barrier(bar);
    phase9(p, lds);
}
extern "C" void kernel_launch(void* const* d_in, const int* in_sizes, int n_in, void* d_out, int out_size, void* d_ws, size_t ws_size, hipStream_t stream) {
    static int grid = 0;
    if (grid == 0) {
        int dev = 0, cus = 0, per_cu = 0;
        if (hipGetDevice(&dev) != hipSuccess || hipDeviceGetAttribute(&cus, hipDeviceAttributeMultiprocessorCount, dev) != hipSuccess) { grid = -1; return; }
        if (hipFuncSetAttribute((const void*)k_mega, hipFuncAttributeMaxDynamicSharedMemorySize, LDS_BYTES) != hipSuccess) { grid = -1; return; }
        (void)hipOccupancyMaxActiveBlocksPerMultiprocessor(&per_cu, (const void*)k_mega, 512, LDS_BYTES);
        (void)hipGetLastError();
        grid = cus;
    }
    if (grid < 0) return;
    Params p{};
    p.x = (const float*)d_in[0]; p.c = (const float*)d_in[1]; p.ctx = (const float*)d_in[2]; p.cctx = (const float*)d_in[3]; p.w_mod = (const float*)d_in[4]; p.b_mod = (const float*)d_in[5];
    p.g_mix = (const float*)d_in[6]; p.w_in = (const float*)d_in[7]; p.g_q = (const float*)d_in[8]; p.w_qb = (const float*)d_in[9]; p.g_kv = (const float*)d_in[10]; p.w_kvb = (const float*)d_in[11];
    p.lbl = (const float*)d_in[12]; p.g_hg = (const float*)d_in[13]; p.w_out = (const float*)d_in[14]; p.g_ffn = (const float*)d_in[15]; p.w_r = (const float*)d_in[16]; p.b_r = (const float*)d_in[17];
    p.w_gu = (const float*)d_in[18]; p.b_gu = (const float*)d_in[19]; p.w_dn = (const float*)d_in[20]; p.b_dn = (const float*)d_in[21]; p.g_fin = (const float*)d_in[22];
    p.out = (float*)d_out; p.ws = (char*)d_ws;
    (void)hipMemsetAsync((char*)d_ws + OFF_BAR, 0, 16384, stream);
    hipLaunchKernelGGL(k_mega, dim3(grid), dim3(512), LDS_BYTES, stream, p);
}
```

```cpp
#include <hip/hip_runtime.h>
#include <stdint.h>

typedef unsigned short bf16_t;
__device__ __forceinline__ float bf2f(bf16_t v) { return __uint_as_float(((unsigned)v) << 16); }
__device__ __forceinline__ bf16_t f2bf(float f) { unsigned u = __float_as_uint(f); u += 0x7FFFu + ((u >> 16) & 1u); return (bf16_t)(u >> 16); }
__device__ __forceinline__ float sigmoidf_(float x) { return 1.0f / (1.0f + __expf(-x)); }
__device__ __forceinline__ float siluf_(float x) { return x / (1.0f + __expf(-x)); }

constexpr int D = 1024, NB = 16, SEQ = 2048, CTXL = 256;
constexpr int L = NB * SEQ;
constexpr int RC = NB * CTXL;
constexpr int R = L + RC;
constexpr int NKEY = SEQ + CTXL;
constexpr float EPS = 1e-6f;
constexpr int NE = 32, CAP = 32768;
constexpr int MAXROWS = 131072 + NE * 256;

constexpr size_t MiB = 1048576;
constexpr size_t OFF_SMALL = 0;
constexpr size_t OFF_BAR = 0;
constexpr size_t OFF_CNT = 16384;
constexpr size_t OFF_OFFS = 16384 + 1024;
constexpr size_t OFF_TILEE = 16384 + 2048;
constexpr size_t OFF_LB = 24576;
constexpr size_t OFF_MOD = 32768;
constexpr size_t OFF_SSQQ = 512 * 1024;
constexpr size_t OFF_SSQKV = 768 * 1024;
constexpr size_t OFF_TOPI = 1 * MiB;
constexpr size_t OFF_TOPP = 1 * MiB + 512 * 1024;
constexpr size_t OFF_ROWPAIR = 2 * MiB;
constexpr size_t OFF_LIST = 3 * MiB;
constexpr size_t OFF_H = 32 * MiB;
constexpr size_t OFF_QA = 104 * MiB;
constexpr size_t OFF_CKV = 152 * MiB;
constexpr size_t OFF_KR = 170 * MiB;
constexpr size_t OFF_OF = 104 * MiB;
constexpr size_t OFF_HQ = 175 * MiB;
constexpr size_t SEG_STRIDE = 72 * MiB;
constexpr size_t OFF_FF = OFF_HQ + 1 * SEG_STRIDE;
constexpr size_t OFF_FB = OFF_HQ + 2 * SEG_STRIDE;
constexpr size_t OFF_IV = OFF_HQ + 3 * SEG_STRIDE;
constexpr size_t OFF_OG = OFF_HQ + 4 * SEG_STRIDE;
constexpr size_t OFF_GM = OFF_HQ + 5 * SEG_STRIDE;
constexpr size_t OFF_GH = OFF_HQ + 6 * SEG_STRIDE;
constexpr size_t OFF_Q = 679 * MiB;
constexpr size_t OFF_K = 775 * MiB;
constexpr size_t OFF_V = 883 * MiB;
constexpr size_t OFF_OB = 955 * MiB;
constexpr size_t OFF_YP = 296 * MiB;
constexpr size_t OFF_ACT = 568 * MiB;

struct SegOut { bf16_t *qa, *ckv, *kr, *hq, *ff, *fb, *iv, *og, *gm, *gh; };

__global__ void k_init(const float* __restrict__ lbl, float* lb, int* cnt) {
    int i = blockIdx.x * blockDim.x + threadIdx.x;
    if (i < 2048) { int d = i >> 10, j = i & 1023; float a = lbl[(d * 2 + 0) * 1024 + j], b = lbl[(d * 2 + 1) * 1024 + j]; lb[i] = 1.0f / (1.0f + __expf(b - a)); }
    if (i < 32) cnt[i] = 0;
}

__global__ __launch_bounds__(256) void k_mod(const float* __restrict__ c, const float* __restrict__ cctx, const float* __restrict__ wmod, const float* __restrict__ bmod, float* modv) {
    __shared__ float s[1024];
    int r = blockIdx.y; const float* src = r < 16 ? c + r * 1024 : cctx;
    for (int k = threadIdx.x; k < 1024; k += 256) s[k] = siluf_(src[k]);
    __syncthreads();
    int j = blockIdx.x * 256 + threadIdx.x; float acc = 0.f;
    for (int k = 0; k < 1024; ++k) acc += s[k] * wmod[(size_t)k * 6144 + j];
    modv[r * 6144 + j] = acc + bmod[j];
}

__device__ __forceinline__ float block_sum256(float v, float* red) {
    for (int o = 32; o > 0; o >>= 1) v += __shfl_xor(v, o);
    int w = threadIdx.x >> 6; if ((threadIdx.x & 63) == 0) red[w] = v; __syncthreads();
    float t = red[0] + red[1] + red[2] + red[3]; __syncthreads(); return t;
}

__global__ __launch_bounds__(256) void k_norm1(const float* __restrict__ x, const float* __restrict__ ctx, const float* __restrict__ g, const float* __restrict__ modv, bf16_t* h) {
    __shared__ float red[4];
    int row = blockIdx.x; const float* src = row < L ? x + (size_t)row * D : ctx + (size_t)(row - L) * D;
    const float* mod = modv + (row < L ? row / SEQ : 16) * 6144;
    int c = threadIdx.x * 4; float4 v = *(const float4*)(src + c);
    float ss = block_sum256(v.x * v.x + v.y * v.y + v.z * v.z + v.w * v.w, red);
    float rs = rsqrtf(ss * (1.0f / D) + EPS);
    float o[4] = {v.x, v.y, v.z, v.w}; ushort4 w; bf16_t* wp = (bf16_t*)&w;
    for (int i = 0; i < 4; ++i) wp[i] = f2bf(o[i] * rs * g[c + i] * (1.0f + mod[1024 + c + i]) + mod[c + i]);
    *(ushort4*)(h + (size_t)row * D + c) = w;
}

__global__ __launch_bounds__(256) void k_rowssq(const bf16_t* __restrict__ buf, int width, int nrows, float* ssq) {
    int row = blockIdx.x * 4 + (threadIdx.x >> 6), lane = threadIdx.x & 63; if (row >= nrows) return;
    float s = 0.f; for (int k = lane; k < width; k += 64) { float v = bf2f(buf[(size_t)row * width + k]); s += v * v; }
    for (int o = 32; o > 0; o >>= 1) s += __shfl_xor(s, o);
    if (lane == 0) ssq[row] = s;
}

__device__ __forceinline__ void rope_cs(int t, int i, float& cs, float& sn) {
    int j = i & 15; float inv = __expf(-(float)j * (9.210340371976184f / 16.0f)); float pos = (i < 16) ? (float)(t >> 6) : (float)(t & 63);
    float ang = pos * inv; cs = cosf(ang); sn = sinf(ang);
}

__global__ __launch_bounds__(256) void k_krope(const bf16_t* __restrict__ kr, bf16_t* Kb) {
    int gid = blockIdx.x * 256 + threadIdx.x; int row = gid >> 5, i = gid & 31; if (row >= R) return;
    float x1 = bf2f(kr[(size_t)row * 64 + i]), x2 = bf2f(kr[(size_t)row * 64 + 32 + i]); float o1 = x1, o2 = x2; int b, pos;
    if (row < L) { b = row / SEQ; pos = row % SEQ; float cs, sn; rope_cs(pos, i, cs, sn); o1 = x1 * cs - x2 * sn; o2 = x1 * sn + x2 * cs; }
    else { b = (row - L) / CTXL; pos = SEQ + (row - L) % CTXL; }
    bf16_t w1 = f2bf(o1), w2 = f2bf(o2);
    for (int h = 0; h < 8; ++h) { bf16_t* p = Kb + ((size_t)(b * 8 + h) * NKEY + pos) * 192 + 128; p[i] = w1; p[32 + i] = w2; }
}

template <class AL, class EP>
__global__ __launch_bounds__(256) void k_ngemm(int K, const float* __restrict__ W, int ldw, size_t wzstride, AL al, EP ep) {
    __shared__ float As[16][68]; __shared__ float Bs[16][64];
    const int z = blockIdx.z, row0 = blockIdx.y * 64, col0 = blockIdx.x * 64, tid = threadIdx.x;
    const int mvalid = al.rows(z); if (row0 >= mvalid) return;
    const float* Wz = W + (size_t)z * wzstride;
    const int ar = tid >> 2, ak = (tid & 3) * 4; const bf16_t* arow = (row0 + ar < mvalid) ? al.rowptr(z, row0 + ar) : nullptr;
    const int bk = tid >> 4, bn = (tid & 15) * 4;
    const int ty = tid >> 4, tx = tid & 15;
    float acc[4][4] = {};
    for (int k0 = 0; k0 < K; k0 += 16) {
        float a4[4] = {0.f, 0.f, 0.f, 0.f};
        if (arow) { ushort4 u = *(const ushort4*)(arow + k0 + ak); const bf16_t* up = (const bf16_t*)&u; for (int i = 0; i < 4; ++i) a4[i] = bf2f(up[i]) * al.kscale(k0 + ak + i); }
        float4 b4 = *(const float4*)(Wz + (size_t)(k0 + bk) * ldw + col0 + bn);
        __syncthreads();
        for (int i = 0; i < 4; ++i) As[ak + i][ar] = a4[i];
        *(float4*)&Bs[bk][bn] = b4;
        __syncthreads();
#pragma unroll
        for (int kk = 0; kk < 16; ++kk) {
            float4 av = *(const float4*)&As[kk][ty * 4]; float4 bv = *(const float4*)&Bs[kk][tx * 4];
            float a[4] = {av.x, av.y, av.z, av.w}, b[4] = {bv.x, bv.y, bv.z, bv.w};
#pragma unroll
            for (int i = 0; i < 4; ++i)
#pragma unroll
                for (int j = 0; j < 4; ++j) acc[i][j] += a[i] * b[j];
        }
    }
    for (int i = 0; i < 4; ++i) { int row = row0 + ty * 4 + i; if (row < mvalid) ep.store(z, row, col0 + tx * 4, acc[i]); }
}

__device__ __forceinline__ void st4bf(bf16_t* dst, const float* v) { ushort4 w; bf16_t* wp = (bf16_t*)&w; for (int i = 0; i < 4; ++i) wp[i] = f2bf(v[i]); *(ushort4*)dst = w; }

struct ALDense { const bf16_t* A; int lda; int nrows; const float* ks;
    __device__ int rows(int) const { return nrows; }
    __device__ const bf16_t* rowptr(int, int row) const { return A + (size_t)row * lda; }
    __device__ float kscale(int k) const { return ks ? ks[k] : 1.0f; } };

struct EpiInN { SegOut s;
    __device__ void store(int, int row, int col, const float* v) const {
        bf16_t* dst;
        if (col < 768) { if (row >= L) return; dst = s.qa + (size_t)row * 768 + col; }
        else if (col < 1024) dst = s.ckv + (size_t)row * 256 + (col - 768);
        else if (col < 1088) dst = s.kr + (size_t)row * 64 + (col - 1024);
        else { int c = col - 1088, seg = c >> 10, cc = c & 1023; bool latonly = (seg == 0 || seg >= 4); if (latonly && row >= L) return;
            bf16_t* base = seg == 0 ? s.hq : seg == 1 ? s.ff : seg == 2 ? s.fb : seg == 3 ? s.iv : seg == 4 ? s.og : seg == 5 ? s.gm : s.gh;
            dst = base + (size_t)row * 1024 + cc; }
        st4bf(dst, v);
    } };

struct EpiQN { bf16_t* q; const float* ssq;
    __device__ void store(int, int row, int col, const float* v) const { float rs = rsqrtf(ssq[row] * (1.0f / 768.0f) + EPS); float o[4]; for (int i = 0; i < 4; ++i) o[i] = v[i] * rs; st4bf(q + (size_t)row * 1536 + col, o); } };

struct EpiKVN { bf16_t *Kb, *Vb; const float* ssq;
    __device__ void store(int, int row, int col, const float* v) const {
        float rs = rsqrtf(ssq[row] * (1.0f / 256.0f) + EPS); float o[4]; for (int i = 0; i < 4; ++i) o[i] = v[i] * rs;
        int b, pos; if (row < L) { b = row / SEQ; pos = row % SEQ; } else { b = (row - L) / CTXL; pos = SEQ + (row - L) % CTXL; }
        int h = col >> 8, w = col & 255; size_t kvrow = (size_t)(b * 8 + h) * NKEY + pos;
        if (w < 128) st4bf(Kb + kvrow * 192 + w, o); else st4bf(Vb + kvrow * 128 + (w - 128), o);
    } };

struct EpiOutN { float* x1; const float* x; const float* modv;
    __device__ void store(int, int row, int col, const float* v) const {
        const float* gate = modv + (row / SEQ) * 6144 + 2 * 1024; float4 xv = *(const float4*)(x + (size_t)row * D + col);
        float4 o; o.x = xv.x + gate[col] * v[0]; o.y = xv.y + gate[col + 1] * v[1]; o.z = xv.z + gate[col + 2] * v[2]; o.w = xv.w + gate[col + 3] * v[3];
        *(float4*)(x1 + (size_t)row * D + col) = o;
    } };

struct ALMoe1 { const bf16_t* h2; const int* cnt; const int* list;
    __device__ int rows(int z) const { return cnt[z]; }
    __device__ const bf16_t* rowptr(int z, int row) const { return h2 + (size_t)(list[z * CAP + row] >> 2) * D; }
    __device__ float kscale(int) const { return 1.0f; } };
struct EpiMoe1N { bf16_t* act; const int* offs; const float* bgu;
    __device__ void store(int z, int row, int col, const float* v) const {
        const float* bb = bgu + z * 2048 + col; ushort2 w; bf16_t* wp = (bf16_t*)&w;
        for (int p = 0; p < 2; ++p) { float glu = fminf(v[2 * p] + bb[2 * p], 7.0f); float lin = fminf(fmaxf(v[2 * p + 1] + bb[2 * p + 1], -7.0f), 7.0f);
            wp[p] = f2bf(glu * sigmoidf_(1.702f * glu) * (lin + 1.0f)); }
        *(ushort2*)(act + (size_t)(offs[z] + row) * D + (col >> 1)) = w;
    } };
struct ALMoe2 { const bf16_t* act; const int* cnt; const int* offs;
    __device__ int rows(int z) const { return cnt[z]; }
    __device__ const bf16_t* rowptr(int z, int row) const { return act + (size_t)(offs[z] + row) * D; }
    __device__ float kscale(int) const { return 1.0f; } };
struct EpiMoe2N { bf16_t* yp; const int* list; const float* bd;
    __device__ void store(int z, int row, int col, const float* v) const {
        int pair = list[z * CAP + row]; const float* bb = bd + z * 1024 + col; float o[4]; for (int i = 0; i < 4; ++i) o[i] = v[i] + bb[i];
        st4bf(yp + (size_t)pair * D + col, o);
    } };

__global__ __launch_bounds__(256) void k_nattn(const bf16_t* __restrict__ Q, const bf16_t* __restrict__ Kb, const bf16_t* __restrict__ Vb, bf16_t* Y) {
    __shared__ float qs[4][192]; __shared__ float sc[4][NKEY];
    const int tid = threadIdx.x, blk = blockIdx.x, qg = blk & 511, h = (blk >> 9) & 7, b = blk >> 12;
    for (int idx = tid; idx < 4 * 192; idx += 256) { int qi = idx / 192, d = idx % 192; int row = b * SEQ + qg * 4 + qi; qs[qi][d] = bf2f(Q[(size_t)row * 1536 + h * 192 + d]); }
    __syncthreads();
    float n1 = 0.f, n2 = 0.f;
    if (tid < 128) { int qi = tid >> 5, i = tid & 31; int t = qg * 4 + qi; float cs, sn; rope_cs(t, i, cs, sn); float x1 = qs[qi][128 + i], x2 = qs[qi][160 + i]; n1 = x1 * cs - x2 * sn; n2 = x1 * sn + x2 * cs; }
    __syncthreads();
    if (tid < 128) { int qi = tid >> 5, i = tid & 31; qs[qi][128 + i] = n1; qs[qi][160 + i] = n2; }
    __syncthreads();
    const bf16_t* Kp = Kb + (size_t)(b * 8 + h) * NKEY * 192; const bf16_t* Vp = Vb + (size_t)(b * 8 + h) * NKEY * 128;
    const float scale = 0.07216878364870322f;
    for (int key = tid; key < NKEY; key += 256) {
        const bf16_t* kr = Kp + (size_t)key * 192; float s0 = 0.f, s1 = 0.f, s2 = 0.f, s3 = 0.f;
        for (int d = 0; d < 192; d += 8) { uint4 u = *(const uint4*)(kr + d); const bf16_t* up = (const bf16_t*)&u;
            for (int j = 0; j < 8; ++j) { float kv = bf2f(up[j]); s0 += qs[0][d + j] * kv; s1 += qs[1][d + j] * kv; s2 += qs[2][d + j] * kv; s3 += qs[3][d + j] * kv; } }
        sc[0][key] = s0 * scale; sc[1][key] = s1 * scale; sc[2][key] = s2 * scale; sc[3][key] = s3 * scale;
    }
    __syncthreads();
    { int w = tid >> 6, lane = tid & 63; float m = -1e30f; for (int k = lane; k < NKEY; k += 64) m = fmaxf(m, sc[w][k]);
      for (int o = 32; o > 0; o >>= 1) m = fmaxf(m, __shfl_xor(m, o));
      float s = 0.f; for (int k = lane; k < NKEY; k += 64) { float e = __expf(sc[w][k] - m); sc[w][k] = e; s += e; }
      for (int o = 32; o > 0; o >>= 1) s += __shfl_xor(s, o);
      float inv = 1.0f / s; for (int k = lane; k < NKEY; k += 64) sc[w][k] *= inv; }
    __syncthreads();
    { int dv = tid & 127, qh = tid >> 7; float o0 = 0.f, o1 = 0.f;
      for (int k = 0; k < NKEY; ++k) { float v = bf2f(Vp[(size_t)k * 128 + dv]); o0 += sc[qh * 2][k] * v; o1 += sc[qh * 2 + 1][k] * v; }
      int row = b * SEQ + qg * 4 + qh * 2; Y[(size_t)row * D + h * 128 + dv] = f2bf(o0); Y[(size_t)(row + 1) * D + h * 128 + dv] = f2bf(o1); }
}

__global__ __launch_bounds__(256) void k_nscan(const bf16_t* __restrict__ hq, const bf16_t* __restrict__ ff, const bf16_t* __restrict__ fb, const bf16_t* __restrict__ iv, const float* __restrict__ lb, bf16_t* of, bf16_t* ob) {
    __shared__ float sf[128], sk[128], sq[128], so[2][128];
    const int tid = threadIdx.x, blk = blockIdx.x, dir = blk & 1, h = (blk >> 1) & 7, b = blk >> 4;
    const bf16_t* fz = dir ? fb : ff; bf16_t* out = dir ? ob : of;
    const int dv = tid & 127, half = tid >> 7;
    float S[64];
#pragma unroll
    for (int j = 0; j < 64; ++j) S[j] = 0.f;
    const float lbv = lb[dir * 1024 + h * 128 + (tid & 127)];
    for (int step = 0; step < NKEY; ++step) {
        int row; bool islat;
        if (step < CTXL) { int s = dir ? (CTXL - 1 - step) : step; row = L + b * CTXL + s; islat = false; }
        else { int t = step - CTXL; t = dir ? (SEQ - 1 - t) : t; row = b * SEQ + t; islat = true; }
        if (tid < 128) { float z = bf2f(fz[(size_t)row * D + h * 128 + tid]); float f = lbv + (1.0f - lbv) * sigmoidf_(z); sf[tid] = f; sk[tid] = 1.0f - f;
            if (islat) { float zq = bf2f(hq[(size_t)row * D + h * 128 + tid]); sq[tid] = siluf_(zq) * 0.08838834764831845f; } }
        float v = bf2f(iv[(size_t)row * D + h * 128 + dv]);
        __syncthreads();
        float o = 0.f;
#pragma unroll
        for (int j = 0; j < 64; ++j) { int dk = half * 64 + j; S[j] = sf[dk] * S[j] + sk[dk] * v; o += S[j] * sq[dk]; }
        if (islat) so[half][dv] = o;
        __syncthreads();
        if (islat && half == 0) out[(size_t)row * D + h * 128 + dv] = f2bf(so[0][dv] + so[1][dv]);
    }
}

__global__ __launch_bounds__(256) void k_merge(bf16_t* y, const bf16_t* __restrict__ of, const bf16_t* __restrict__ ob, const bf16_t* __restrict__ og, const bf16_t* __restrict__ gm, const bf16_t* __restrict__ gh, const float* __restrict__ ghg) {
    int row = blockIdx.x, c = threadIdx.x * 4; size_t off = (size_t)row * D + c;
    ushort4 a = *(const ushort4*)(of + off), bb = *(const ushort4*)(ob + off), g1 = *(const ushort4*)(og + off), g2 = *(const ushort4*)(gm + off), g3 = *(const ushort4*)(gh + off), ym = *(const ushort4*)(y + off);
    const bf16_t *ap = (const bf16_t*)&a, *bp = (const bf16_t*)&bb, *p1 = (const bf16_t*)&g1, *p2 = (const bf16_t*)&g2, *p3 = (const bf16_t*)&g3, *pm = (const bf16_t*)&ym;
    float o[4], ss = 0.f; for (int i = 0; i < 4; ++i) { o[i] = bf2f(ap[i]) + bf2f(bp[i]); ss += o[i] * o[i]; }
    for (int m = 16; m > 0; m >>= 1) ss += __shfl_xor(ss, m);
    float rs = rsqrtf(ss * (1.0f / 128.0f) + EPS); float r[4];
    for (int i = 0; i < 4; ++i) { float yh = o[i] * rs * ghg[(c + i) & 127] * siluf_(bf2f(p1[i])); r[i] = sigmoidf_(bf2f(p2[i])) * bf2f(pm[i]) + sigmoidf_(bf2f(p3[i])) * yh; }
    st4bf(y + off, r);
}

__global__ __launch_bounds__(256) void k_norm2_router(const float* __restrict__ x1, const float* __restrict__ g, const float* __restrict__ modv, const float* __restrict__ wr, const float* __restrict__ br, bf16_t* h2, int* topi, float* topp, int* cnt, int* list) {
    __shared__ float red[4]; __shared__ float hs[1024]; __shared__ float part[8][32];
    int row = blockIdx.x, tid = threadIdx.x, c = tid * 4; const float* mod = modv + (row / SEQ) * 6144;
    float4 v = *(const float4*)(x1 + (size_t)row * D + c);
    float ss = block_sum256(v.x * v.x + v.y * v.y + v.z * v.z + v.w * v.w, red); float rs = rsqrtf(ss * (1.0f / D) + EPS);
    float xv[4] = {v.x, v.y, v.z, v.w}, o[4];
    for (int i = 0; i < 4; ++i) { o[i] = xv[i] * rs * g[c + i] * (1.0f + mod[4 * 1024 + c + i]) + mod[3 * 1024 + c + i]; hs[c + i] = o[i]; }
    st4bf(h2 + (size_t)row * D + c, o);
    __syncthreads();
    { int e = tid & 31, p = tid >> 5; float a = 0.f; for (int j = p * 128; j < p * 128 + 128; ++j) a += hs[j] * wr[j * 32 + e]; part[p][e] = a; }
    __syncthreads();
    if (tid < 64) {
        int e = tid & 31; float cur = br[e];
#pragma unroll
        for (int p = 0; p < 8; ++p) cur += part[p][e];
        float tv0 = 0.f, sum = 0.f; float myp = 0.f; int myk = -1;
        int sel_i[4]; float sel_e[4];
#pragma unroll
        for (int k = 0; k < 4; ++k) {
            float m = cur; int mi = e;
#pragma unroll
            for (int o = 16; o > 0; o >>= 1) { float om = __shfl_xor(m, o); int oi = __shfl_xor(mi, o); if (om > m || (om == m && oi < mi)) { m = om; mi = oi; } }
            if (k == 0) tv0 = m;
            sel_i[k] = mi; sel_e[k] = __expf(m - tv0); sum += sel_e[k];
            if (e == mi) cur = -3.0e38f;
        }
#pragma unroll
        for (int k = 0; k < 4; ++k) if (tid == k) { myk = sel_i[k]; myp = sel_e[k] / sum; }
        if (tid < 4) { int pair = row * 4 + tid; topi[pair] = myk; topp[pair] = myp; int pos = atomicAdd(&cnt[myk], 1); list[myk * CAP + pos] = pair; }
    }
}

__global__ void k_moe_offs(const int* cnt, int* offs, int* tilee) {
    if (threadIdx.x == 0 && blockIdx.x == 0) { int o = 0, t = 0; for (int e = 0; e < NE; ++e) { offs[e] = o; int nt = (cnt[e] + 255) >> 8; for (int i = 0; i < nt; ++i) tilee[t++] = e; o += nt * 256; } offs[NE] = o; offs[NE + 1] = t; }
}

__global__ __launch_bounds__(256) void k_final(float* out, const bf16_t* __restrict__ yp, const float* __restrict__ topp, const float* __restrict__ modv, const float* __restrict__ fg) {
    __shared__ float red[4];
    int row = blockIdx.x, c = threadIdx.x * 4; const float* gate = modv + (row / SEQ) * 6144 + 5 * 1024;
    float4 v = *(const float4*)(out + (size_t)row * D + c); float xv[4] = {v.x, v.y, v.z, v.w}; float m[4] = {0.f, 0.f, 0.f, 0.f};
    for (int k = 0; k < 4; ++k) { float p = topp[row * 4 + k]; ushort4 u = *(const ushort4*)(yp + (size_t)(row * 4 + k) * D + c); const bf16_t* up = (const bf16_t*)&u; for (int i = 0; i < 4; ++i) m[i] += p * bf2f(up[i]); }
    float ss = 0.f; for (int i = 0; i < 4; ++i) { xv[i] += gate[c + i] * m[i]; ss += xv[i] * xv[i]; }
    ss = block_sum256(ss, red); float rs = rsqrtf(ss * (1.0f / D) + EPS);
    float4 o; o.x = xv[0] * rs * fg[c]; o.y = xv[1] * rs * fg[c + 1]; o.z = xv[2] * rs * fg[c + 2]; o.w = xv[3] * rs * fg[c + 3];
    *(float4*)(out + (size_t)row * D + c) = o;
}

#define LAS __attribute__((address_space(3)))
__device__ __forceinline__ int otid() { int t = threadIdx.x; asm volatile("" : "+v"(t)); return t; }
typedef short bf16x8 __attribute__((ext_vector_type(8)));
typedef float f32x4 __attribute__((ext_vector_type(4)));
typedef unsigned u32x4 __attribute__((ext_vector_type(4)));
typedef unsigned u32x2 __attribute__((ext_vector_type(2)));

constexpr size_t OFF_ROPE = 7 * MiB;
constexpr size_t OFF_WT_IN = 8 * MiB;
constexpr size_t OFF_WT_QB = 25 * MiB;
constexpr size_t OFF_WT_KVB = 28 * MiB;
constexpr size_t OFF_WT_OUT = 29 * MiB;
constexpr size_t OFF_WT_GU = 104 * MiB;
constexpr size_t OFF_WT_DN = 232 * MiB;

struct Params {
    const float *x, *c, *ctx, *cctx, *w_mod, *b_mod, *g_mix, *w_in, *g_q, *w_qb, *g_kv, *w_kvb, *lbl, *g_hg, *w_out, *g_ffn, *w_r, *b_r, *w_gu, *b_gu, *w_dn, *b_dn, *g_fin;
    float* out; char* ws;
};

typedef __bf16 bf16v2_t __attribute__((ext_vector_type(2)));
__device__ __forceinline__ unsigned cvt_pk_bf16(float lo, float hi) { bf16v2_t v = {(__bf16)lo, (__bf16)hi}; return __builtin_bit_cast(unsigned, v); }

namespace pg8 {
constexpr int BM = 256, BK = 64, HALF = 128, HTB = HALF * BK * 2, STAGE_BYTES = 8 * HTB, NXCD = 8, WGM = 8;
__device__ __forceinline__ int lds_byte(int r, int c) { const int st = (r >> 4) * 2 + (c >> 5), rr = r & 15, cc = c & 31, ob = rr * 64 + cc * 2; return st * 1024 + (ob ^ (((ob >> 9) & 1) << 5)); }
__device__ __forceinline__ void stage_rc(int b, int& R, int& C) { const int st = b / 1024, sb = b % 1024, swz = sb ^ (((sb >> 9) & 1) << 5); R = (st >> 1) * 16 + swz / 64; C = (st & 1) * 32 + (swz % 64) / 2; }
__device__ __forceinline__ int perm32(int rho) { const int n = rho >> 4, i = rho & 15; return 8 * (i >> 2) + 4 * n + (i & 3); }
struct Unit { int pm, pn; const char* b; int e, pos0, cnt; };

__device__ __forceinline__ int xcd_remap(int L, int nwg) { const int q = nwg / NXCD, r = nwg % NXCD, xcd = L % NXCD, off = L / NXCD; return (xcd < r ? xcd * (q + 1) : r * (q + 1) + (xcd - r) * q) + off; }

struct DenseSched {
    int nM, nN, nwg, G, c, lda; const char* Bt; size_t btile;
    __device__ void init(int M, int N, int K, int lda_, const void* Bt_, int G_, int c_) { nM = M / BM; nN = N / BM; nwg = nM * nN; G = G_; c = c_; lda = lda_; Bt = (const char*)Bt_; btile = (size_t)BM * K * 2; }
    __device__ __forceinline__ void tile(int wgid, int& pm, int& pn) const { const int nig = WGM * nN, gid = wgid / nig, fm = gid * WGM, gsz = (nM - fm) < WGM ? (nM - fm) : WGM; pm = fm + ((wgid % nig) % gsz); pn = (wgid % nig) / gsz; }
    __device__ __forceinline__ bool next(int i, Unit& u) const { const int Lx = i * G + c; if (Lx >= nwg) return false; tile(xcd_remap(Lx, nwg), u.pm, u.pn); u.b = Bt + (size_t)u.pn * btile; u.e = 0; u.pos0 = 0; u.cnt = 0; return true; }
    __device__ __forceinline__ void aoff(const Unit& u, const int (&Rr)[2], const int (&Cc)[2], unsigned (&va)[2][2]) const {
#pragma unroll
        for (int h = 0; h < 2; ++h)
#pragma unroll
            for (int i = 0; i < 2; ++i) va[h][i] = (unsigned)((u.pm * BM + h * HALF + Rr[i]) * lda + Cc[i]) * 2u; }
};
struct InSched : DenseSched {
    __device__ void init2(const void* Bt_, int G_, int c_) { init(L, 8448, 1024, 1024, Bt_, G_, c_); }
    __device__ __forceinline__ bool next(int i, Unit& u) const {
        const int Lx = i * G + c; const int nlat = nwg;
        if (Lx < nlat) { tile(xcd_remap(Lx, nlat), u.pm, u.pn); }
        else { const int j = Lx - nlat; if (j >= 16 * 14) return false; const int q = j >> 4; u.pm = 128 + (j & 15); u.pn = q == 0 ? 3 : (q <= 12 ? 7 + q : 32); }
        u.b = Bt + (size_t)u.pn * btile; u.e = 0; u.pos0 = 0; u.cnt = 0; return true; }
};
template <bool GATHER> struct MoeSched {
    int nN, G, c; const char* Wt; size_t wexp, btile; const LAS int* tab; const int* list;
    __device__ __forceinline__ bool next(int i, Unit& u) const {
        const int nwg = tab[33] * nN; const int Lx = i * G + c; if (Lx >= nwg) return false;
        const int w = xcd_remap(Lx, nwg); const int rt = w / nN; u.pn = w % nN; u.pm = rt;
        int e = 0; while (tab[e + 1] <= rt) ++e;
        u.e = e; u.pos0 = (rt - tab[e]) * BM; u.cnt = tab[64 + e]; u.b = Wt + (size_t)e * wexp + (size_t)u.pn * btile; return true; }
    __device__ __forceinline__ void aoff(const Unit& u, const int (&Rr)[2], const int (&Cc)[2], unsigned (&va)[2][2]) const {
#pragma unroll
        for (int h = 0; h < 2; ++h)
#pragma unroll
            for (int i = 0; i < 2; ++i) {
                if (GATHER) { const int pos = u.pos0 + h * HALF + Rr[i]; const int pair = pos < u.cnt ? list[u.e * CAP + pos] : 0; va[h][i] = (unsigned)((pair >> 2) * D + Cc[i]) * 2u; }
                else va[h][i] = (unsigned)((u.pm * BM + h * HALF + Rr[i]) * D + Cc[i]) * 2u; } }
};

template <class Epi, class Sched>
__device__ __forceinline__ void gemm_phase(LAS unsigned char* lds, const char* Abase, const int K, const Sched& S, const Epi& E) {
    const int tid = otid(), wid = __builtin_amdgcn_readfirstlane(tid >> 6), lane = tid & 63, wr = wid >> 2, wc = wid & 3, fr = lane & 15, fq = lane >> 4;
    const int nt = K / BK;
    int Rr[2], Cc[2]; unsigned voffB[2];
#pragma unroll
    for (int i = 0; i < 2; ++i) { int R_, C_; stage_rc(tid * 16 + i * 8192, R_, C_); Rr[i] = R_; Cc[i] = C_; const int Rb = Epi::PERM ? ((R_ & ~31) + perm32(R_ & 31)) : R_; voffB[i] = (unsigned)(Rb * K + C_) * 2u; }
    const size_t kstep = (size_t)(BK * 2);
    const size_t hstep = (size_t)HALF * K * 2;
    const unsigned ldsw = (unsigned)wid * 1024u;
    const int aoff = lds_byte(wr * 64 + fr, fq * 8), boff = lds_byte(wc * 32 + fr, fq * 8);
#define PG8_SA(b, h) (((b) * 2 + (h)) * HTB)
#define PG8_SB(b, h) ((4 + (b) * 2 + (h)) * HTB)
#define PG8_STAGE_B(bufoff, gbase) do { _Pragma("unroll") for (int _i = 0; _i < 2; ++_i) \
        __builtin_amdgcn_global_load_lds((const unsigned*)((const char*)(gbase) + voffB[_i]), (LAS unsigned*)(lds + (bufoff) + ldsw + _i * 8192), 16, 0, 0); } while (0)
#define PG8_STAGE_A(bufoff, v0, v1, kb) do { \
        __builtin_amdgcn_global_load_lds((const unsigned*)(Abase + (kb) + (v0)), (LAS unsigned*)(lds + (bufoff) + ldsw), 16, 0, 0); \
        __builtin_amdgcn_global_load_lds((const unsigned*)(Abase + (kb) + (v1)), (LAS unsigned*)(lds + (bufoff) + ldsw + 8192), 16, 0, 0); } while (0)
#define PG8_LDA(dst, b, h) do { _Pragma("unroll") for (int m = 0; m < 4; ++m) _Pragma("unroll") for (int k = 0; k < 2; ++k) dst[m][k] = *(const LAS bf16x8*)(lds + PG8_SA(b, h) + aoff + m * 2048 + k * 1024); } while (0)
#define PG8_LDB(dst, b, h) do { _Pragma("unroll") for (int n = 0; n < 2; ++n) _Pragma("unroll") for (int k = 0; k < 2; ++k) dst[n][k] = *(const LAS bf16x8*)(lds + PG8_SB(b, h) + boff + n * 2048 + k * 1024); } while (0)
#define PG8_MMA(ai, bj, At, Bt) do { __builtin_amdgcn_s_setprio(1); _Pragma("unroll") for (int m = 0; m < 4; ++m) _Pragma("unroll") for (int n = 0; n < 2; ++n) _Pragma("unroll") for (int k = 0; k < 2; ++k) \
        acc[ai][bj][m][n] = __builtin_amdgcn_mfma_f32_16x16x32_bf16(Bt[n][k], At[m][k], acc[ai][bj][m][n], 0, 0, 0); __builtin_amdgcn_s_setprio(0); } while (0)
#define PG8_WAIT_V(n) asm volatile("s_waitcnt vmcnt(" #n ")" ::: "memory")
#define PG8_WAIT_L(n) asm volatile("s_waitcnt lgkmcnt(" #n ")" ::: "memory")
#define PG8_BAR __builtin_amdgcn_s_barrier()
#define PG8_SCHED __builtin_amdgcn_sched_barrier(0)
    Unit cur, nxt; int ui = 0;
    if (!S.next(0, cur)) return;
    f32x4 acc[2][2][4][2];
#pragma unroll
    for (int a = 0; a < 2; ++a)
#pragma unroll
        for (int b = 0; b < 2; ++b)
#pragma unroll
            for (int m = 0; m < 4; ++m)
#pragma unroll
                for (int n = 0; n < 2; ++n) acc[a][b][m][n] = (f32x4){0.f, 0.f, 0.f, 0.f};
    bf16x8 At[4][2], B0[2][2], B1[2][2];
    unsigned vc[2][2], vn[2][2];
    S.aoff(cur, Rr, Cc, vc);
    const char* cB = cur.b;
    PG8_STAGE_B(PG8_SB(0, 0), cB); PG8_STAGE_A(PG8_SA(0, 0), vc[0][0], vc[0][1], 0); PG8_STAGE_B(PG8_SB(0, 1), cB + hstep); PG8_STAGE_A(PG8_SA(0, 1), vc[1][0], vc[1][1], 0);
    if (wr == 1) PG8_BAR;
    PG8_WAIT_V(4); PG8_BAR;
    PG8_STAGE_B(PG8_SB(1, 0), cB + kstep); PG8_STAGE_A(PG8_SA(1, 0), vc[0][0], vc[0][1], kstep); PG8_STAGE_B(PG8_SB(1, 1), cB + hstep + kstep);
    PG8_WAIT_V(6); PG8_BAR;
    for (;;) {
        const bool has_next = S.next(ui + 1, nxt);
        if (has_next) S.aoff(nxt, Rr, Cc, vn);
        else {
#pragma unroll
            for (int h = 0; h < 2; ++h)
#pragma unroll
                for (int i = 0; i < 2; ++i) vn[h][i] = vc[h][i]; }
        const char* nB = has_next ? nxt.b : cB;
        for (int t = 0; t < nt; t += 2) {
            const bool last = (t == nt - 2);
            const size_t k1 = (size_t)(t + 1) * kstep;
            const size_t k2 = last ? 0 : (size_t)(t + 2) * kstep;
            const unsigned s00 = last ? vn[0][0] : vc[0][0], s01 = last ? vn[0][1] : vc[0][1], s10 = last ? vn[1][0] : vc[1][0], s11 = last ? vn[1][1] : vc[1][1];
            const char* b2 = last ? nB : cB + (size_t)(t + 2) * kstep; const char* b3 = b2 + kstep;
            PG8_LDB(B0, 0, 0); PG8_SCHED; PG8_LDA(At, 0, 0); PG8_STAGE_A(PG8_SA(1, 1), vc[1][0], vc[1][1], k1);
            PG8_WAIT_L(8); PG8_BAR; PG8_WAIT_L(0); PG8_MMA(0, 0, At, B0); PG8_BAR; PG8_SCHED;
            PG8_LDB(B1, 0, 1); PG8_STAGE_B(PG8_SB(0, 0), b2);
            PG8_BAR; PG8_WAIT_L(0); PG8_MMA(0, 1, At, B1); PG8_BAR;
            PG8_LDA(At, 0, 1); PG8_STAGE_A(PG8_SA(0, 0), s00, s01, k2);
            PG8_BAR; PG8_WAIT_L(0); PG8_MMA(1, 0, At, B0); PG8_BAR; PG8_SCHED;
            PG8_STAGE_B(PG8_SB(0, 1), b2 + hstep);
            PG8_WAIT_V(6); PG8_BAR; PG8_MMA(1, 1, At, B1); PG8_BAR;
            PG8_LDB(B0, 1, 0); PG8_SCHED; PG8_LDA(At, 1, 0); PG8_STAGE_A(PG8_SA(0, 1), s10, s11, k2);
            PG8_WAIT_L(8); PG8_BAR; PG8_WAIT_L(0); PG8_MMA(0, 0, At, B0); PG8_BAR; PG8_SCHED;
            PG8_LDB(B1, 1, 1); PG8_STAGE_B(PG8_SB(1, 0), b3);
            PG8_BAR; PG8_WAIT_L(0); PG8_MMA(0, 1, At, B1); PG8_BAR;
            PG8_LDA(At, 1, 1); PG8_STAGE_A(PG8_SA(1, 0), s00, s01, k2 + kstep);
            PG8_BAR; PG8_WAIT_L(0); PG8_MMA(1, 0, At, B0); PG8_BAR; PG8_SCHED;
            PG8_STAGE_B(PG8_SB(1, 1), b3 + hstep);
            PG8_WAIT_V(6); PG8_BAR; PG8_MMA(1, 1, At, B1); PG8_BAR;
        }
        E(acc, cur, wr, wc, fr, fq);
        if (!has_next) break;
#pragma unroll
        for (int a = 0; a < 2; ++a)
#pragma unroll
            for (int b = 0; b < 2; ++b)
#pragma unroll
                for (int m = 0; m < 4; ++m)
#pragma unroll
                    for (int n = 0; n < 2; ++n) acc[a][b][m][n] = (f32x4){0.f, 0.f, 0.f, 0.f};
        cur = nxt; cB = nB; ++ui;
#pragma unroll
        for (int h = 0; h < 2; ++h)
#pragma unroll
            for (int i = 0; i < 2; ++i) vc[h][i] = vn[h][i];
    }
    PG8_WAIT_V(0);
    if (wr == 0) PG8_BAR;
    PG8_BAR;
#undef PG8_SA
#undef PG8_SB
#undef PG8_STAGE_A
#undef PG8_STAGE_B
#undef PG8_LDA
#undef PG8_LDB
#undef PG8_MMA
#undef PG8_WAIT_V
#undef PG8_WAIT_L
#undef PG8_BAR
#undef PG8_SCHED
}

typedef f32x4 Acc[2][2][4][2];
__device__ __forceinline__ u32x4 pack8(const f32x4 v0, const f32x4 v1) { u32x4 w; w.x = cvt_pk_bf16(v0[0], v0[1]); w.y = cvt_pk_bf16(v0[2], v0[3]); w.z = cvt_pk_bf16(v1[0], v1[1]); w.w = cvt_pk_bf16(v1[2], v1[3]); return w; }

struct EpiIn { static constexpr bool PERM = true; char* ws;
    __device__ __forceinline__ void operator()(const Acc& acc, const Unit& u, int wr, int wc, int fr, int fq) const {
        const int pn = u.pn; size_t boff; int ld, cb;
        if (pn < 3) { boff = OFF_QA; ld = 768; cb = pn * 256; } else if (pn == 3) { boff = OFF_CKV; ld = 256; cb = 0; }
        else if (pn < 32) { boff = OFF_HQ + (size_t)((pn - 4) >> 2) * SEG_STRIDE; ld = 1024; cb = ((pn - 4) & 3) * 256; }
        else { boff = OFF_KR; ld = 64; cb = 0; }
        bf16_t* base = (bf16_t*)(ws + boff);
        const int row0 = u.pm * BM + wr * 64 + fr, col0 = wc * 32 + 8 * fq;
        if (pn == 32 && wc >= 2) return;
        float* ssq = (float*)(ws + (pn < 3 ? OFF_SSQQ : OFF_SSQKV));
#pragma unroll
        for (int ai = 0; ai < 2; ++ai)
#pragma unroll
            for (int m = 0; m < 4; ++m) { const int row = row0 + ai * HALF + m * 16; bf16_t* rowp = base + (size_t)row * ld + cb + col0;
                const f32x4 v0 = acc[ai][0][m][0], v1 = acc[ai][0][m][1];
                *(u32x4*)rowp = pack8(v0, v1);
                if (pn != 32) { const f32x4 w0 = acc[ai][1][m][0], w1 = acc[ai][1][m][1]; *(u32x4*)(rowp + HALF) = pack8(w0, w1);
                    if (pn <= 3) { float ss = (v0[0] * v0[0] + v0[1] * v0[1]) + (v0[2] * v0[2] + v0[3] * v0[3]) + (v1[0] * v1[0] + v1[1] * v1[1]) + (v1[2] * v1[2] + v1[3] * v1[3])
                                          + (w0[0] * w0[0] + w0[1] * w0[1]) + (w0[2] * w0[2] + w0[3] * w0[3]) + (w1[0] * w1[0] + w1[1] * w1[1]) + (w1[2] * w1[2] + w1[3] * w1[3]);
                        ss += __shfl_xor(ss, 16); ss += __shfl_xor(ss, 32); if (fq == 0) atomicAdd(ssq + row, ss); } } }
    } };

struct EpiQ { static constexpr bool PERM = true; bf16_t* q; const float* ssq;
    __device__ __forceinline__ void operator()(const Acc& acc, const Unit& u, int wr, int wc, int fr, int fq) const {
        const int row0 = u.pm * BM + wr * 64 + fr, col0 = u.pn * BM + wc * 32 + 8 * fq;
#pragma unroll
        for (int ai = 0; ai < 2; ++ai)
#pragma unroll
            for (int m = 0; m < 4; ++m) { const int row = row0 + ai * HALF + m * 16; const float rs = rsqrtf(ssq[row] * (1.0f / 768.0f) + EPS); bf16_t* rowp = q + (size_t)row * 1536 + col0;
#pragma unroll
                for (int bj = 0; bj < 2; ++bj) *(u32x4*)(rowp + bj * HALF) = pack8(acc[ai][bj][m][0] * rs, acc[ai][bj][m][1] * rs); }
    } };

struct EpiKV { static constexpr bool PERM = true; bf16_t *Kb, *Vb; const float* ssq;
    __device__ __forceinline__ void operator()(const Acc& acc, const Unit& u, int wr, int wc, int fr, int fq) const {
        const int row0 = u.pm * BM + wr * 64 + fr, col0 = wc * 32 + 8 * fq;
#pragma unroll
        for (int ai = 0; ai < 2; ++ai)
#pragma unroll
            for (int m = 0; m < 4; ++m) { const int row = row0 + ai * HALF + m * 16; const float rs = rsqrtf(ssq[row] * (1.0f / 256.0f) + EPS);
                int b, pos; if (row < L) { b = row >> 11; pos = row & 2047; } else { b = (row - L) >> 8; pos = SEQ + ((row - L) & 255); }
                const size_t kvrow = (size_t)(b * 8 + u.pn) * NKEY + pos;
                *(u32x4*)(Kb + kvrow * 192 + col0) = pack8(acc[ai][0][m][0] * rs, acc[ai][0][m][1] * rs);
                *(u32x4*)(Vb + kvrow * 128 + col0) = pack8(acc[ai][1][m][0] * rs, acc[ai][1][m][1] * rs); }
    } };

struct EpiOut { static constexpr bool PERM = false; float* x1; const float* x; const float* modv;
    __device__ __forceinline__ void operator()(const Acc& acc, const Unit& u, int wr, int wc, int fr, int fq) const {
        const int row0 = u.pm * BM + wr * 64 + fr, col0 = u.pn * BM + wc * 32 + 4 * fq;
#pragma unroll
        for (int ai = 0; ai < 2; ++ai)
#pragma unroll
            for (int m = 0; m < 4; ++m) { const int row = row0 + ai * HALF + m * 16; const float* gate = modv + (row >> 11) * 6144 + 2 * 1024 + col0; const float* xr = x + (size_t)row * D + col0; float* o = x1 + (size_t)row * D + col0;
#pragma unroll
                for (int bj = 0; bj < 2; ++bj)
#pragma unroll
                    for (int n = 0; n < 2; ++n) { const int co = bj * HALF + n * 16; const f32x4 g = *(const f32x4*)(gate + co), xv = *(const f32x4*)(xr + co); *(f32x4*)(o + co) = xv + g * acc[ai][bj][m][n]; } }
    } };

struct EpiMoe1 { static constexpr bool PERM = true; bf16_t* act; const float* bgu;
    __device__ __forceinline__ void operator()(const Acc& acc, const Unit& u, int wr, int wc, int fr, int fq) const {
        const int row0 = u.pm * BM + wr * 64 + fr, o0 = u.pn * 128 + wc * 16 + 4 * fq;
        f32x4 bg[2], bl[2];
#pragma unroll
        for (int bj = 0; bj < 2; ++bj) { const float* bp = bgu + u.e * 2048 + 2 * (o0 + bj * 64); const f32x4 t0 = *(const f32x4*)bp, t1 = *(const f32x4*)(bp + 4);
            bg[bj] = (f32x4){t0[0], t0[2], t1[0], t1[2]}; bl[bj] = (f32x4){t0[1], t0[3], t1[1], t1[3]}; }
#pragma unroll
        for (int ai = 0; ai < 2; ++ai)
#pragma unroll
            for (int m = 0; m < 4; ++m) { const int row = row0 + ai * HALF + m * 16; bf16_t* rowp = act + (size_t)row * D + o0;
#pragma unroll
                for (int bj = 0; bj < 2; ++bj) { const f32x4 g4 = acc[ai][bj][m][0] + bg[bj], l4 = acc[ai][bj][m][1] + bl[bj]; float r[4];
#pragma unroll
                    for (int j = 0; j < 4; ++j) { const float glu = fminf(g4[j], 7.0f), lin = fminf(fmaxf(l4[j], -7.0f), 7.0f); r[j] = glu * sigmoidf_(1.702f * glu) * (lin + 1.0f); }
                    u32x2 w; w.x = cvt_pk_bf16(r[0], r[1]); w.y = cvt_pk_bf16(r[2], r[3]); *(u32x2*)(rowp + bj * 64) = w; } }
    } };

struct EpiMoe2 { static constexpr bool PERM = true; bf16_t* yp; const float* bd; const int* list;
    __device__ __forceinline__ void operator()(const Acc& acc, const Unit& u, int wr, int wc, int fr, int fq) const {
        const int r0 = wr * 64 + fr, col0 = u.pn * BM + wc * 32 + 8 * fq;
        f32x4 bv[2][2];
#pragma unroll
        for (int bj = 0; bj < 2; ++bj)
#pragma unroll
            for (int n = 0; n < 2; ++n) bv[bj][n] = *(const f32x4*)(bd + u.e * 1024 + col0 + bj * HALF + 4 * n);
#pragma unroll
        for (int ai = 0; ai < 2; ++ai)
#pragma unroll
            for (int m = 0; m < 4; ++m) { const int pos = u.pos0 + r0 + ai * HALF + m * 16; if (pos < u.cnt) { const int pair = list[u.e * CAP + pos]; bf16_t* rowp = yp + (size_t)pair * D + col0;
#pragma unroll
                for (int bj = 0; bj < 2; ++bj) *(u32x4*)(rowp + bj * HALF) = pack8(acc[ai][bj][m][0] + bv[bj][0], acc[ai][bj][m][1] + bv[bj][1]); } }
    } };
}

__device__ __forceinline__ int conv_src_col(int kind, int c) {
    if (kind == 0) return c;
    if (kind == 1) { if (c < 1024) return c; if (c < 8192) return c + 64; if (c < 8256) return c - 8192 + 1024; return -1; }
    const int pn = c >> 8, p = c & 255, bj = p >> 7, wc = (p >> 5) & 3, fq = (p >> 3) & 3, n = (p >> 2) & 1, i = p & 3; const int o = 128 * pn + 64 * bj + 16 * wc + 4 * fq + i; return 2 * o + n;
}
__device__ __forceinline__ void conv_tile(LAS float* tl, const float* __restrict__ W, int ldw, bf16_t* Wt, int K, int kind, const float* __restrict__ kscale, int k0, int c0) {
    const int tid = otid(); const int cc = tid & 127, kq = tid >> 7, sc = conv_src_col(kind, c0 + cc);
    float v[32];
#pragma unroll
    for (int i = 0; i < 32; ++i) { const int kk = kq + 4 * i; v[i] = sc >= 0 ? W[(size_t)(k0 + kk) * ldw + sc] : 0.f; }
    if (kscale) {
#pragma unroll
        for (int i = 0; i < 32; ++i) v[i] *= kscale[k0 + kq + 4 * i]; }
#pragma unroll
    for (int i = 0; i < 32; ++i) tl[(kq + 4 * i) * 129 + cc] = v[i];
    __syncthreads();
    { const int c2 = tid >> 2, kb = (tid & 3) * 8; bf16_t* dst = Wt + (size_t)(c0 + c2) * K + k0 + kb;
#pragma unroll
      for (int q = 0; q < 4; ++q) { float t[8];
#pragma unroll
          for (int j = 0; j < 8; ++j) t[j] = tl[(q * 32 + kb + j) * 129 + c2];
          u32x4 w; w.x = cvt_pk_bf16(t[0], t[1]); w.y = cvt_pk_bf16(t[2], t[3]); w.z = cvt_pk_bf16(t[4], t[5]); w.w = cvt_pk_bf16(t[6], t[7]);
          *(u32x4*)(dst + q * 32) = w; } }
    __syncthreads();
}
__device__ __forceinline__ void conv_matrix(LAS float* tl, const float* W, int ldw, bf16_t* Wt, int K, int Nout, int kind, const float* kscale, int& tctr) {
    const int nk = K / 128, ntile = nk * (Nout / 128);
    int t = ((int)blockIdx.x - tctr) % (int)gridDim.x; if (t < 0) t += gridDim.x;
    for (; t < ntile; t += gridDim.x) conv_tile(tl, W, ldw, Wt, K, kind, kscale, (t % nk) * 128, (t / nk) * 128);
    tctr = (tctr + ntile) % (int)gridDim.x;
}

__device__ __forceinline__ float half_sum256(float v, LAS float* red) {
    for (int o = 32; o > 0; o >>= 1) v += __shfl_xor(v, o);
    const int w = otid() >> 6, hb = (otid() >> 8) * 4; if ((otid() & 63) == 0) red[w] = v; __syncthreads();
    const float t = red[hb] + red[hb + 1] + red[hb + 2] + red[hb + 3]; __syncthreads(); return t;
}

__device__ __forceinline__ void phase0(const Params& p, LAS unsigned char* lds) {
    char* ws = p.ws; const int tid = otid(), gsz = gridDim.x * 512, gid = blockIdx.x * 512 + tid;
    float* lb = (float*)(ws + OFF_LB); int* cnt = (int*)(ws + OFF_CNT); float* ssqq = (float*)(ws + OFF_SSQQ); float* ssqkv = (float*)(ws + OFF_SSQKV); float* modv = (float*)(ws + OFF_MOD);
    for (int i = gid; i < 2048; i += gsz) { const int d = i >> 10, j = i & 1023; const float a = p.lbl[(d * 2 + 0) * 1024 + j], b = p.lbl[(d * 2 + 1) * 1024 + j]; lb[i] = 1.0f / (1.0f + __expf(b - a)); }
    for (int i = gid; i < 32; i += gsz) cnt[i] = 0;
    { float* ropet = (float*)(ws + OFF_ROPE); for (int i = gid; i < SEQ * 32; i += gsz) { const int t = i >> 5, j = i & 31; float cs, sn; rope_cs(t, j, cs, sn); ropet[t * 64 + j] = cs; ropet[t * 64 + 32 + j] = sn; } }
    for (int i = gid; i < L; i += gsz) ssqq[i] = 0.f;
    for (int i = gid; i < R; i += gsz) ssqkv[i] = 0.f;
    { LAS float* sil = (LAS float*)lds;
      LAS float* part = (LAS float*)(lds + 17 * 1024 * 4);
      bool loaded = false;
      for (int item = blockIdx.x; item < 96; item += gridDim.x) {
          if (!loaded) { for (int i = tid; i < 17 * 1024; i += 512) { const int r = i >> 10, k = i & 1023; sil[i] = siluf_(r < 16 ? p.c[r * 1024 + k] : p.cctx[k]); } loaded = true; __syncthreads(); }
          const int j = tid & 63, ks = tid >> 6; float a[17];
#pragma unroll
          for (int r = 0; r < 17; ++r) a[r] = 0.f;
          for (int k = ks * 128; k < ks * 128 + 128; ++k) { const float w = p.w_mod[(size_t)k * 6144 + item * 64 + j];
#pragma unroll
              for (int r = 0; r < 17; ++r) a[r] += sil[r * 1024 + k] * w; }
#pragma unroll
          for (int r = 0; r < 17; ++r) part[(ks * 17 + r) * 64 + j] = a[r];
          __syncthreads();
          for (int i = tid; i < 17 * 64; i += 512) { const int r = i >> 6, jj = i & 63; float s = p.b_mod[item * 64 + jj]; for (int q = 0; q < 8; ++q) s += part[(q * 17 + r) * 64 + jj]; modv[r * 6144 + item * 64 + jj] = s; }
          __syncthreads();
      } }
    __syncthreads();
    { LAS float* tl = (LAS float*)lds; int tctr = 0;
      conv_matrix(tl, p.w_in, 8256, (bf16_t*)(ws + OFF_WT_IN), 1024, 8448, 1, nullptr, tctr);
      conv_matrix(tl, p.w_qb, 1536, (bf16_t*)(ws + OFF_WT_QB), 768, 1536, 0, p.g_q, tctr);
      conv_matrix(tl, p.w_kvb, 2048, (bf16_t*)(ws + OFF_WT_KVB), 256, 2048, 0, p.g_kv, tctr);
      conv_matrix(tl, p.w_out, 1024, (bf16_t*)(ws + OFF_WT_OUT), 1024, 1024, 0, nullptr, tctr); }
}

__device__ __forceinline__ float wave_sum(float v) {
#pragma unroll
    for (int o = 32; o > 0; o >>= 1) v += __shfl_xor(v, o);
    return v; }
__device__ __forceinline__ void phase1(const Params& p, LAS unsigned char* lds) {
    const float* modv = (const float*)(p.ws + OFF_MOD); bf16_t* h = (bf16_t*)(p.ws + OFF_H);
    const int tid = otid(), lane = tid & 63, gw = blockIdx.x * 8 + (tid >> 6), nw = gridDim.x * 8, c0 = lane * 8;
    f32x4 g[4];
#pragma unroll
    for (int q = 0; q < 4; ++q) g[q] = *(const f32x4*)(p.g_mix + (q >> 1) * 512 + c0 + (q & 1) * 4);
    for (int row0 = gw; row0 < R; row0 += 2 * nw) {
        f32x4 v[2][4]; const bool two = row0 + nw < R;
#pragma unroll
        for (int u = 0; u < 2; ++u) { const int row = (u == 0 || two) ? row0 + u * nw : row0; const float* src = row < L ? p.x + (size_t)row * D : p.ctx + (size_t)(row - L) * D;
#pragma unroll
            for (int q = 0; q < 4; ++q) v[u][q] = *(const f32x4*)(src + (q >> 1) * 512 + c0 + (q & 1) * 4); }
#pragma unroll
        for (int u = 0; u < 2; ++u) { if (u == 1 && !two) break; const int row = row0 + u * nw; const float* mod = modv + (row < L ? row / SEQ : 16) * 6144;
            float ss = 0.f;
#pragma unroll
            for (int q = 0; q < 4; ++q) ss += (v[u][q][0] * v[u][q][0] + v[u][q][1] * v[u][q][1]) + (v[u][q][2] * v[u][q][2] + v[u][q][3] * v[u][q][3]);
            const float rs = rsqrtf(wave_sum(ss) * (1.0f / D) + EPS);
#pragma unroll
            for (int j = 0; j < 2; ++j) { f32x4 o[2];
#pragma unroll
                for (int e = 0; e < 2; ++e) { const int cc = j * 512 + c0 + e * 4; const f32x4 sc = *(const f32x4*)(mod + 1024 + cc), sh = *(const f32x4*)(mod + cc); o[e] = v[u][j * 2 + e] * rs * g[j * 2 + e] * (sc + 1.0f) + sh; }
                u32x4 w; w.x = cvt_pk_bf16(o[0][0], o[0][1]); w.y = cvt_pk_bf16(o[0][2], o[0][3]); w.z = cvt_pk_bf16(o[1][0], o[1][1]); w.w = cvt_pk_bf16(o[1][2], o[1][3]);
                *(u32x4*)(h + (size_t)row * D + j * 512 + c0) = w; } }
    }
}

__device__ __forceinline__ SegOut make_seg(char* ws) { SegOut so; so.qa = (bf16_t*)(ws + OFF_QA); so.ckv = (bf16_t*)(ws + OFF_CKV); so.kr = (bf16_t*)(ws + OFF_KR); so.hq = (bf16_t*)(ws + OFF_HQ); so.ff = (bf16_t*)(ws + OFF_FF);
    so.fb = (bf16_t*)(ws + OFF_FB); so.iv = (bf16_t*)(ws + OFF_IV); so.og = (bf16_t*)(ws + OFF_OG); so.gm = (bf16_t*)(ws + OFF_GM); so.gh = (bf16_t*)(ws + OFF_GH); return so; }

__device__ __forceinline__ void phase2(const Params& p, LAS unsigned char* lds) {
    pg8::InSched S; S.init2(p.ws + OFF_WT_IN, gridDim.x, blockIdx.x);
    pg8::EpiIn E{p.ws};
    pg8::gemm_phase(lds, (const char*)(p.ws + OFF_H), 1024, S, E);
}
__device__ __forceinline__ void phase3(const Params& p, LAS unsigned char* lds) {
    char* ws = p.ws;
    { pg8::DenseSched S; S.init(L, 1536, 768, 768, ws + OFF_WT_QB, gridDim.x, blockIdx.x); pg8::EpiQ E{(bf16_t*)(ws + OFF_Q), (const float*)(ws + OFF_SSQQ)}; pg8::gemm_phase(lds, (const char*)(ws + OFF_QA), 768, S, E); }
    { pg8::DenseSched S; S.init(R, 2048, 256, 256, ws + OFF_WT_KVB, gridDim.x, blockIdx.x); pg8::EpiKV E{(bf16_t*)(ws + OFF_K), (bf16_t*)(ws + OFF_V), (const float*)(ws + OFF_SSQKV)}; pg8::gemm_phase(lds, (const char*)(ws + OFF_CKV), 256, S, E); }
    { const bf16_t* kr = (const bf16_t*)(ws + OFF_KR); bf16_t* Kb = (bf16_t*)(ws + OFF_K); const float* ropet = (const float*)(ws + OFF_ROPE);
      for (int gid = blockIdx.x * 512 + otid(); gid < R * 32; gid += gridDim.x * 512) { const int row = gid >> 5, i = gid & 31;
          const float x1 = bf2f(kr[(size_t)row * 64 + i]), x2 = bf2f(kr[(size_t)row * 64 + 32 + i]); float o1 = x1, o2 = x2; int b, pos;
          if (row < L) { b = row / SEQ; pos = row % SEQ; const float cs = ropet[pos * 64 + i], sn = ropet[pos * 64 + 32 + i]; o1 = x1 * cs - x2 * sn; o2 = x1 * sn + x2 * cs; } else { b = (row - L) / CTXL; pos = SEQ + (row - L) % CTXL; }
          const bf16_t w1 = f2bf(o1), w2 = f2bf(o2);
          for (int h = 0; h < 8; ++h) { bf16_t* q = Kb + ((size_t)(b * 8 + h) * NKEY + pos) * 192 + 128; q[i] = w1; q[32 + i] = w2; } } }
}
__device__ __forceinline__ void unpack8(const u32x4 w, float (&o)[8]) {
    o[0] = __uint_as_float(w.x << 16); o[1] = __uint_as_float(w.x & 0xffff0000u); o[2] = __uint_as_float(w.y << 16); o[3] = __uint_as_float(w.y & 0xffff0000u);
    o[4] = __uint_as_float(w.z << 16); o[5] = __uint_as_float(w.z & 0xffff0000u); o[6] = __uint_as_float(w.w << 16); o[7] = __uint_as_float(w.w & 0xffff0000u); }
__device__ __forceinline__ void phase4(const Params& p, LAS unsigned char*) {
    char* ws = p.ws; bf16_t* y = (bf16_t*)(ws + OFF_H); const bf16_t* of = (const bf16_t*)(ws + OFF_OF); const bf16_t* ob = (const bf16_t*)(ws + OFF_OB);
    const bf16_t* og = (const bf16_t*)(ws + OFF_OG); const bf16_t* gm = (const bf16_t*)(ws + OFF_GM); const bf16_t* gh = (const bf16_t*)(ws + OFF_GH);
    const int tid = otid(), lane = tid & 63, gw = blockIdx.x * 8 + (tid >> 6), nw = gridDim.x * 8, c0 = lane * 8;
    float gg[8];
#pragma unroll
    for (int i = 0; i < 8; ++i) gg[i] = p.g_hg[(c0 + i) & 127];
    for (int row = gw; row < L; row += nw) {
        u32x4 ra[2], rb[2], r1[2], r2[2], r3[2], rm[2];
#pragma unroll
        for (int j = 0; j < 2; ++j) { const size_t off = (size_t)row * D + j * 512 + c0; ra[j] = *(const u32x4*)(of + off); rb[j] = *(const u32x4*)(ob + off); r1[j] = *(const u32x4*)(og + off); r2[j] = *(const u32x4*)(gm + off); r3[j] = *(const u32x4*)(gh + off); rm[j] = *(const u32x4*)(y + off); }
#pragma unroll
        for (int j = 0; j < 2; ++j) { float a[8], b[8], g1[8], g2[8], g3[8], ym[8], o[8]; unpack8(ra[j], a); unpack8(rb[j], b); unpack8(r1[j], g1); unpack8(r2[j], g2); unpack8(r3[j], g3); unpack8(rm[j], ym);
            float ss = 0.f;
#pragma unroll
            for (int i = 0; i < 8; ++i) { o[i] = a[i] + b[i]; ss += o[i] * o[i]; }
            ss += __shfl_xor(ss, 1); ss += __shfl_xor(ss, 2); ss += __shfl_xor(ss, 4); ss += __shfl_xor(ss, 8);
            const float rs = rsqrtf(ss * (1.0f / 128.0f) + EPS); float r[8];
#pragma unroll
            for (int i = 0; i < 8; ++i) { const float yh = o[i] * rs * gg[i] * siluf_(g1[i]); r[i] = sigmoidf_(g2[i]) * ym[i] + sigmoidf_(g3[i]) * yh; }
            u32x4 w; w.x = cvt_pk_bf16(r[0], r[1]); w.y = cvt_pk_bf16(r[2], r[3]); w.z = cvt_pk_bf16(r[4], r[5]); w.w = cvt_pk_bf16(r[6], r[7]);
            *(u32x4*)(y + (size_t)row * D + j * 512 + c0) = w; }
    }
}
__device__ __forceinline__ void phase5(const Params& p, LAS unsigned char* lds) {
    char* ws = p.ws;
    { pg8::DenseSched S; S.init(L, 1024, 1024, 1024, ws + OFF_WT_OUT, gridDim.x, blockIdx.x); pg8::EpiOut E{p.out, p.x, (const float*)(ws + OFF_MOD)}; pg8::gemm_phase(lds, (const char*)(ws + OFF_H), 1024, S, E); }
    { LAS float* tl = (LAS float*)lds; int tctr = 0;
      for (int e = 0; e < NE; ++e) conv_matrix(tl, p.w_gu + (size_t)e * 1024 * 2048, 2048, (bf16_t*)(ws + OFF_WT_GU) + (size_t)e * 2048 * 1024, 1024, 2048, 2, nullptr, tctr);
      for (int e = 0; e < NE; ++e) conv_matrix(tl, p.w_dn + (size_t)e * 1024 * 1024, 1024, (bf16_t*)(ws + OFF_WT_DN) + (size_t)e * 1024 * 1024, 1024, 1024, 0, nullptr, tctr); }
}
__device__ __forceinline__ void phase6(const Params& p, LAS unsigned char* lds) {
    char* ws = p.ws; const float* modv = (const float*)(ws + OFF_MOD); bf16_t* h2 = (bf16_t*)(ws + OFF_H); int* topi = (int*)(ws + OFF_TOPI); float* topp = (float*)(ws + OFF_TOPP); int* cnt = (int*)(ws + OFF_CNT); int* list = (int*)(ws + OFF_LIST);
    LAS float* hs = (LAS float*)lds;
    LAS float* lg = (LAS float*)(lds + 131072);
    LAS int* lcnt = (LAS int*)(lds + 131072 + 4096);
    LAS int* lent = (LAS int*)(lds + 131072 + 4096 + 512);
    const int tid = otid(), lane = tid & 63, wid = tid >> 6, c0 = lane * 8;
    if (tid < 96) lcnt[tid] = 0;
    f32x4 g[4];
#pragma unroll
    for (int q = 0; q < 4; ++q) g[q] = *(const f32x4*)(p.g_ffn + (q >> 1) * 512 + c0 + (q & 1) * 4);
    __syncthreads();
    int it = 0;
    for (int tile = blockIdx.x; tile < L / 32; tile += gridDim.x, ++it) {
        const int rbase = tile * 32;
        f32x4 v[4][4];
#pragma unroll
        for (int u = 0; u < 4; ++u)
#pragma unroll
            for (int q = 0; q < 4; ++q) v[u][q] = *(const f32x4*)(p.out + (size_t)(rbase + wid * 4 + u) * D + (q >> 1) * 512 + c0 + (q & 1) * 4);
#pragma unroll
        for (int u = 0; u < 4; ++u) { const int rl = wid * 4 + u, row = rbase + rl; const float* mod = modv + (row / SEQ) * 6144; float ss = 0.f;
#pragma unroll
            for (int q = 0; q < 4; ++q) ss += (v[u][q][0] * v[u][q][0] + v[u][q][1] * v[u][q][1]) + (v[u][q][2] * v[u][q][2] + v[u][q][3] * v[u][q][3]);
            const float rs = rsqrtf(wave_sum(ss) * (1.0f / D) + EPS);
#pragma unroll
            for (int j = 0; j < 2; ++j) { f32x4 o[2];
#pragma unroll
                for (int e = 0; e < 2; ++e) { const int cc = j * 512 + c0 + e * 4; const f32x4 sc = *(const f32x4*)(mod + 4 * 1024 + cc), sh = *(const f32x4*)(mod + 3 * 1024 + cc); o[e] = v[u][j * 2 + e] * rs * g[j * 2 + e] * (sc + 1.0f) + sh;
                    *(LAS f32x4*)(hs + rl * 1024 + cc) = o[e]; }
                u32x4 w; w.x = cvt_pk_bf16(o[0][0], o[0][1]); w.y = cvt_pk_bf16(o[0][2], o[0][3]); w.z = cvt_pk_bf16(o[1][0], o[1][1]); w.w = cvt_pk_bf16(o[1][2], o[1][3]);
                *(u32x4*)(h2 + (size_t)row * D + j * 512 + c0) = w; } }
        __syncthreads();
        { const int e = tid & 31, rg = tid >> 5; const LAS float* h0 = hs + (2 * rg) * 1024; const LAS float* h1 = h0 + 1024; float a0 = 0.f, a1 = 0.f;
          for (int j = 0; j < 1024; j += 8) { float w[8];
#pragma unroll
              for (int q = 0; q < 8; ++q) w[q] = p.w_r[(j + q) * 32 + e];
              const f32x4 x0 = *(const LAS f32x4*)(h0 + j), x1 = *(const LAS f32x4*)(h0 + j + 4), y0 = *(const LAS f32x4*)(h1 + j), y1 = *(const LAS f32x4*)(h1 + j + 4);
              a0 += x0[0] * w[0]; a0 += x0[1] * w[1]; a0 += x0[2] * w[2]; a0 += x0[3] * w[3]; a0 += x1[0] * w[4]; a0 += x1[1] * w[5]; a0 += x1[2] * w[6]; a0 += x1[3] * w[7];
              a1 += y0[0] * w[0]; a1 += y0[1] * w[1]; a1 += y0[2] * w[2]; a1 += y0[3] * w[3]; a1 += y1[0] * w[4]; a1 += y1[1] * w[5]; a1 += y1[2] * w[6]; a1 += y1[3] * w[7]; }
          const float be = p.b_r[e]; lg[(2 * rg) * 32 + e] = a0 + be; lg[(2 * rg + 1) * 32 + e] = a1 + be; }
        __syncthreads();
#pragma unroll
        for (int rep = 0; rep < 2; ++rep) { const int rl = wid * 4 + rep * 2 + (lane >> 5), row = rbase + rl, e = lane & 31; float cur = lg[rl * 32 + e];
            float tv0 = 0.f, sum = 0.f; int sel_i[4]; float sel_e[4];
#pragma unroll
            for (int k = 0; k < 4; ++k) { float m = cur; int mi = e;
#pragma unroll
                for (int o2 = 16; o2 > 0; o2 >>= 1) { const float om = __shfl_xor(m, o2); const int oi = __shfl_xor(mi, o2); if (om > m || (om == m && oi < mi)) { m = om; mi = oi; } }
                if (k == 0) tv0 = m; sel_i[k] = mi; sel_e[k] = __expf(m - tv0); sum += sel_e[k]; if (e == mi) cur = -3.0e38f; }
            int myk = 0; float myp = 0.f;
#pragma unroll
            for (int k = 0; k < 4; ++k) if (e == k) { myk = sel_i[k]; myp = sel_e[k] / sum; }
            if (e < 4) { const int pair = row * 4 + e; topi[pair] = myk; topp[pair] = myp; __hip_atomic_fetch_add(&lcnt[myk], 1, __ATOMIC_RELAXED, __HIP_MEMORY_SCOPE_WORKGROUP); lent[(it * 32 + rl) * 4 + e] = myk; } }
        __syncthreads();
    }
    if (tid < 32) { const int n = lcnt[tid]; lcnt[32 + tid] = n > 0 ? atomicAdd(&cnt[tid], n) : 0; lcnt[64 + tid] = 0; }
    __syncthreads();
    const int nent = it * 128;
    for (int s = tid; s < nent; s += 512) { const int e = lent[s]; const int ii = s >> 7, rl = (s >> 2) & 31, k = s & 3; const int row = (blockIdx.x + ii * gridDim.x) * 32 + rl;
        const int pos = lcnt[32 + e] + __hip_atomic_fetch_add(&lcnt[64 + e], 1, __ATOMIC_RELAXED, __HIP_MEMORY_SCOPE_WORKGROUP); list[e * CAP + pos] = row * 4 + k; }
}
__device__ __forceinline__ void moe_table(const int* cnt, LAS int* tab) {
    if (otid() == 0) { int t = 0; for (int e = 0; e < NE; ++e) { tab[e] = t; const int n = cnt[e]; tab[64 + e] = n; t += (n + 255) >> 8; } tab[32] = t; tab[33] = t; }
    __syncthreads();
}
constexpr int LDS_TAB = pg8::STAGE_BYTES;
__device__ __forceinline__ void phase7(const Params& p, LAS unsigned char* lds) {
    char* ws = p.ws; LAS int* tab = (LAS int*)(lds + LDS_TAB); moe_table((const int*)(ws + OFF_CNT), tab);
    pg8::MoeSched<true> S; S.nN = 8; S.G = gridDim.x; S.c = blockIdx.x; S.Wt = ws + OFF_WT_GU; S.wexp = (size_t)2048 * 1024 * 2; S.btile = (size_t)256 * 1024 * 2; S.tab = tab; S.list = (const int*)(ws + OFF_LIST);
    pg8::EpiMoe1 E{(bf16_t*)(ws + OFF_ACT), p.b_gu};
    pg8::gemm_phase(lds, (const char*)(ws + OFF_H), 1024, S, E);
}
__device__ __forceinline__ void phase8(const Params& p, LAS unsigned char* lds) {
    char* ws = p.ws; LAS int* tab = (LAS int*)(lds + LDS_TAB); moe_table((const int*)(ws + OFF_CNT), tab);
    pg8::MoeSched<false> S; S.nN = 4; S.G = gridDim.x; S.c = blockIdx.x; S.Wt = ws + OFF_WT_DN; S.wexp = (size_t)1024 * 1024 * 2; S.btile = (size_t)256 * 1024 * 2; S.tab = tab; S.list = (const int*)(ws + OFF_LIST);
    pg8::EpiMoe2 E{(bf16_t*)(ws + OFF_YP), p.b_dn, (const int*)(ws + OFF_LIST)};
    pg8::gemm_phase(lds, (const char*)(ws + OFF_ACT), 1024, S, E);
}
__device__ __forceinline__ void phase9(const Params& p, LAS unsigned char* lds) {
    char* ws = p.ws; const float* modv = (const float*)(ws + OFF_MOD); const bf16_t* yp = (const bf16_t*)(ws + OFF_YP); const float* topp = (const float*)(ws + OFF_TOPP);
    const int tid = otid(), lane = tid & 63, gw = blockIdx.x * 8 + (tid >> 6), nw = gridDim.x * 8, c0 = lane * 8;
    f32x4 fg[4];
#pragma unroll
    for (int q = 0; q < 4; ++q) fg[q] = *(const f32x4*)(p.g_fin + (q >> 1) * 512 + c0 + (q & 1) * 4);
    for (int row = gw; row < L; row += nw) {
        const float* gate = modv + (row / SEQ) * 6144 + 5 * 1024; f32x4 v[4]; u32x4 yr[4][2];
#pragma unroll
        for (int q = 0; q < 4; ++q) v[q] = *(const f32x4*)(p.out + (size_t)row * D + (q >> 1) * 512 + c0 + (q & 1) * 4);
#pragma unroll
        for (int k = 0; k < 4; ++k)
#pragma unroll
            for (int j = 0; j < 2; ++j) yr[k][j] = *(const u32x4*)(yp + (size_t)(row * 4 + k) * D + j * 512 + c0);
        const f32x4 pk = *(const f32x4*)(topp + row * 4);
        float m[16];
#pragma unroll
        for (int i = 0; i < 16; ++i) m[i] = 0.f;
#pragma unroll
        for (int k = 0; k < 4; ++k)
#pragma unroll
            for (int j = 0; j < 2; ++j) { float t[8]; unpack8(yr[k][j], t);
#pragma unroll
                for (int i = 0; i < 8; ++i) m[j * 8 + i] += pk[k] * t[i]; }
        float ss = 0.f;
#pragma unroll
        for (int q = 0; q < 4; ++q) { const f32x4 gt = *(const f32x4*)(gate + (q >> 1) * 512 + c0 + (q & 1) * 4);
#pragma unroll
            for (int i = 0; i < 4; ++i) { v[q][i] += gt[i] * m[q * 4 + i]; ss += v[q][i] * v[q][i]; } }
        const float rs = rsqrtf(wave_sum(ss) * (1.0f / D) + EPS);
#pragma unroll
        for (int q = 0; q < 4; ++q) *(f32x4*)(p.out + (size_t)row * D + (q >> 1) * 512 + c0 + (q & 1) * 4) = v[q] * rs * fg[q];
    }
}

namespace at {
using s16x4  = __attribute__((ext_vector_type(4))) short;
using f32x16 = __attribute__((ext_vector_type(16))) float;
constexpr int NW = 8, QBLK = 32, KVBLK = 64, DK = 192, DV = 128;
constexpr float SCALE = 0.07216878364870322f;
constexpr float THR = 8.f;
constexpr int SHM_V = KVBLK * DV * 2, SHM_K = KVBLK * DK * 2, SHM_ATTN = 2 * SHM_V + 2 * SHM_K + NW * 64 * 4;
#define KSWZ(row, colB) ((row) * 384 + ((colB) ^ (((row) & 7) << 4)))
#define SBAR() __builtin_amdgcn_sched_barrier(0)
__device__ __forceinline__ int crow(int r, int hi) { return (r & 3) + 8 * (r >> 2) + 4 * hi; }
__device__ __forceinline__ unsigned cvtpk(float lo, float hi) { return cvt_pk_bf16(lo, hi); }

__device__ __forceinline__ void partialSM(f32x16& p0, f32x16& p1, float& m_reg, float& mn, float& alpha) {
  constexpr float C = SCALE * 1.4426950408889634f;
  float pmax = p0[0];
#pragma unroll
  for (int r = 1; r < 16; ++r) pmax = fmaxf(pmax, p0[r]);
#pragma unroll
  for (int r = 0; r < 16; ++r) pmax = fmaxf(pmax, p1[r]);
  { auto rr = __builtin_amdgcn_permlane32_swap(__float_as_uint(pmax), __float_as_uint(pmax), false, false);
    pmax = fmaxf(__uint_as_float(rr[0]), __uint_as_float(rr[1])); }
  if (__builtin_expect(__all(pmax - m_reg <= THR / SCALE), 1)) { mn = m_reg; alpha = 1.f; }
  else { mn = fmaxf(m_reg, pmax); alpha = __builtin_amdgcn_exp2f((m_reg - mn) * C); m_reg = mn; }
  float mnC = -mn * C;
#pragma unroll
  for (int r = 0; r < 16; ++r) p0[r] = fmaf(p0[r], C, mnC);
#pragma unroll
  for (int r = 0; r < 16; ++r) p1[r] = fmaf(p1[r], C, mnC);
#pragma unroll
  for (int r = 0; r < 16; ++r) p0[r] = __builtin_amdgcn_exp2f(p0[r]);
}
__device__ __forceinline__ void finishSM(f32x16& p0, f32x16& p1, float alpha, float& l_reg, bf16x8& pa0, bf16x8& pa1, bf16x8& pa2, bf16x8& pa3) {
#pragma unroll
  for (int r = 0; r < 16; ++r) p1[r] = __builtin_amdgcn_exp2f(p1[r]);
  float ps = 0;
#pragma unroll
  for (int r = 0; r < 16; ++r) ps += p0[r];
#pragma unroll
  for (int r = 0; r < 16; ++r) ps += p1[r];
  { auto rr = __builtin_amdgcn_permlane32_swap(__float_as_uint(ps), __float_as_uint(ps), false, false);
    ps = __uint_as_float(rr[0]) + __uint_as_float(rr[1]); }
  l_reg = l_reg * alpha + ps;
#define PK4(P, BASE, OUT) do { unsigned a0 = cvtpk(P[BASE + 0], P[BASE + 1]), a1 = cvtpk(P[BASE + 2], P[BASE + 3]);   \
    unsigned b0 = cvtpk(P[BASE + 4], P[BASE + 5]), b1 = cvtpk(P[BASE + 6], P[BASE + 7]);                              \
    auto r0 = __builtin_amdgcn_permlane32_swap(a0, b0, false, false); auto r1 = __builtin_amdgcn_permlane32_swap(a1, b1, false, false); \
    u32x4 w = {r0[0], r1[0], r0[1], r1[1]}; OUT = *reinterpret_cast<bf16x8*>(&w); } while (0)
  PK4(p0, 0, pa0); PK4(p0, 8, pa1); PK4(p1, 0, pa2); PK4(p1, 8, pa3);
#undef PK4
}
__device__ __forceinline__ void qkt(f32x16& p0, f32x16& p1, const LAS char* Ks, const bf16x8 (&qr)[12], int r32, int hi) {
  p0 = f32x16{}; p1 = f32x16{};
#pragma unroll
  for (int d0 = 0; d0 < 12; ++d0) { const int cb = (d0 * 16 + hi * 8) * 2;
    const bf16x8 b0 = *reinterpret_cast<const LAS bf16x8*>(Ks + KSWZ(r32, cb));
    const bf16x8 b1 = *reinterpret_cast<const LAS bf16x8*>(Ks + KSWZ(32 + r32, cb));
    p0 = __builtin_amdgcn_mfma_f32_32x32x16_bf16(b0, qr[d0], p0, 0, 0, 0);
    p1 = __builtin_amdgcn_mfma_f32_32x32x16_bf16(b1, qr[d0], p1, 0, 0, 0); }
}
__device__ __forceinline__ int v_st(int k, int c) { const int kk = (k & ~0xC) | ((k & 4) << 1) | ((k & 8) >> 1); return ((kk >> 3) * 4 + (c >> 5)) * 512 + ((kk & 7) * 32 + (c & 31)) * 2; }
__device__ __forceinline__ int v_rd_base(int lane) { return ((lane & 3) << 3) | (((lane >> 2) & 3) << 6) | (((lane >> 4) & 1) << 5) | (((lane >> 5) & 1) << 8); }
constexpr int v_rd_off(int d0, int ks, int half) { return d0 * 512 + ks * 4096 + half * 2048; }
template <int OFF> __device__ __forceinline__ s16x4 tr_read(int vb) { s16x4 r; asm volatile("ds_read_b64_tr_b16 %0, %1 offset:%2" : "=&v"(r) : "v"(vb), "i"(OFF) : "memory"); return r; }
template <int D0> __device__ __forceinline__ void pv_one(f32x16& od, int vb, bf16x8 pa0, bf16x8 pa1, bf16x8 pa2, bf16x8 pa3) {
  const s16x4 l0 = tr_read<v_rd_off(D0, 0, 0)>(vb), h0 = tr_read<v_rd_off(D0, 0, 1)>(vb), l1 = tr_read<v_rd_off(D0, 1, 0)>(vb), h1 = tr_read<v_rd_off(D0, 1, 1)>(vb);
  const s16x4 l2 = tr_read<v_rd_off(D0, 2, 0)>(vb), h2 = tr_read<v_rd_off(D0, 2, 1)>(vb), l3 = tr_read<v_rd_off(D0, 3, 0)>(vb), h3 = tr_read<v_rd_off(D0, 3, 1)>(vb);
  asm volatile("s_waitcnt lgkmcnt(0)" ::: "memory"); SBAR();
#define PK(Lo, Hi) (bf16x8){Lo[0], Lo[1], Lo[2], Lo[3], Hi[0], Hi[1], Hi[2], Hi[3]}
  od = __builtin_amdgcn_mfma_f32_32x32x16_bf16(pa0, PK(l0, h0), od, 0, 0, 0);
  od = __builtin_amdgcn_mfma_f32_32x32x16_bf16(pa1, PK(l1, h1), od, 0, 0, 0);
  od = __builtin_amdgcn_mfma_f32_32x32x16_bf16(pa2, PK(l2, h2), od, 0, 0, 0);
  od = __builtin_amdgcn_mfma_f32_32x32x16_bf16(pa3, PK(l3, h3), od, 0, 0, 0);
#undef PK
}
__device__ __forceinline__ void pv_d0(f32x16 (&o)[4], int vb, bf16x8 pa0, bf16x8 pa1, bf16x8 pa2, bf16x8 pa3) {
  pv_one<0>(o[0], vb, pa0, pa1, pa2, pa3); pv_one<1>(o[1], vb, pa0, pa1, pa2, pa3); pv_one<2>(o[2], vb, pa0, pa1, pa2, pa3); pv_one<3>(o[3], vb, pa0, pa1, pa2, pa3);
}

__device__ __forceinline__ void attn_unit(const bf16_t* __restrict__ Qb, const bf16_t* __restrict__ Kh, const bf16_t* __restrict__ Vh, bf16_t* __restrict__ Ob, int t0, const float* __restrict__ ropet, LAS char* lds) {
  constexpr int LDQ = 1536, LDO = 1024, NT = NKEY / KVBLK;
  const int tid = otid(), wid = tid >> 6, lane = tid & 63, r32 = lane & 31, hi = lane >> 5;
  LAS char* V_lds = lds; LAS char* K_lds = lds + 2 * SHM_V;
  LAS float* wsl = (LAS float*)(lds + 2 * SHM_V + 2 * SHM_K) + wid * 64; LAS float* li_l = wsl; LAS float* al_l = wsl + 32;
  float m_reg = -1e30f, l_reg = 0; f32x16 o[4] = {}; bf16x8 qr[12];
  { const bf16_t* Qw = Qb + (size_t)(wid * QBLK + r32) * LDQ + hi * 8;
#pragma unroll
    for (int d0 = 0; d0 < 12; ++d0) qr[d0] = *reinterpret_cast<const bf16x8*>(Qw + d0 * 16);
    const float* rt = ropet + (size_t)(t0 + wid * QBLK + r32) * 64 + 8 * hi;
#pragma unroll
    for (int g = 0; g < 2; ++g) {
      const f32x4 c0 = *(const f32x4*)(rt + 16 * g), c1 = *(const f32x4*)(rt + 16 * g + 4), s0 = *(const f32x4*)(rt + 32 + 16 * g), s1 = *(const f32x4*)(rt + 32 + 16 * g + 4);
      float n1[8], n2[8];
#pragma unroll
      for (int j = 0; j < 8; ++j) { const float cs = j < 4 ? c0[j & 3] : c1[j & 3], sn = j < 4 ? s0[j & 3] : s1[j & 3];
        const float x1 = bf2f((bf16_t)qr[8 + g][j]), x2 = bf2f((bf16_t)qr[10 + g][j]); n1[j] = x1 * cs - x2 * sn; n2[j] = x1 * sn + x2 * cs; }
      u32x4 w1 = {cvtpk(n1[0], n1[1]), cvtpk(n1[2], n1[3]), cvtpk(n1[4], n1[5]), cvtpk(n1[6], n1[7])}; u32x4 w2 = {cvtpk(n2[0], n2[1]), cvtpk(n2[2], n2[3]), cvtpk(n2[4], n2[5]), cvtpk(n2[6], n2[7])};
      qr[8 + g] = *reinterpret_cast<bf16x8*>(&w1); qr[10 + g] = *reinterpret_cast<bf16x8*>(&w2); } }
  const int sr = tid >> 4, sc = (tid & 15) * 8, vst0 = v_st(sr, sc), vst1 = v_st(32 + sr, sc);
  int kgo[3], kst[3];
#pragma unroll
  for (int i = 0; i < 3; ++i) { const int c = tid + 512 * i, row = c / 24, c8 = (c % 24) * 8; kgo[i] = row * DK + c8; kst[i] = KSWZ(row, c8 * 2); }
  const int vb0 = (int)(uintptr_t)V_lds + v_rd_base(lane);
  bf16x8 sv0, sv1, sk0, sk1, sk2;
#define SLOAD(k0) do { sv0 = *reinterpret_cast<const bf16x8*>(&Vh[(size_t)((k0) + sr) * DV + sc]); sv1 = *reinterpret_cast<const bf16x8*>(&Vh[(size_t)((k0) + 32 + sr) * DV + sc]); \
    sk0 = *reinterpret_cast<const bf16x8*>(&Kh[(size_t)(k0) * DK + kgo[0]]); sk1 = *reinterpret_cast<const bf16x8*>(&Kh[(size_t)(k0) * DK + kgo[1]]); sk2 = *reinterpret_cast<const bf16x8*>(&Kh[(size_t)(k0) * DK + kgo[2]]); } while (0)
#define SWRITE(b) do { *(LAS bf16x8*)(V_lds + (b) * SHM_V + vst0) = sv0; *(LAS bf16x8*)(V_lds + (b) * SHM_V + vst1) = sv1; \
    *(LAS bf16x8*)(K_lds + (b) * SHM_K + kst[0]) = sk0; *(LAS bf16x8*)(K_lds + (b) * SHM_K + kst[1]) = sk1; *(LAS bf16x8*)(K_lds + (b) * SHM_K + kst[2]) = sk2; } while (0)
#define RESC(a) do { if (__any((a) < 1.f)) { if (hi == 0) al_l[r32] = (a); asm volatile("s_waitcnt lgkmcnt(0)" ::: "memory"); \
    _Pragma("unroll") for (int d = 0; d < 4; ++d) _Pragma("unroll") for (int r = 0; r < 16; ++r) o[d][r] *= al_l[crow(r, hi)]; } } while (0)
  f32x16 p0, p1; float mn, al; bf16x8 pa0, pa1, pa2, pa3;
  SLOAD(0); asm volatile("s_waitcnt vmcnt(0)" ::: "memory"); SWRITE(0); __syncthreads();
  for (int j = 0; j < NT; ++j) {
    const int bsel = j & 1;
    if (j + 1 < NT) SLOAD((j + 1) * KVBLK);
    SBAR(); qkt(p0, p1, K_lds + bsel * SHM_K, qr, r32, hi);
    partialSM(p0, p1, m_reg, mn, al);
    RESC(al);
    finishSM(p0, p1, al, l_reg, pa0, pa1, pa2, pa3); SBAR();
    pv_d0(o, vb0 + bsel * SHM_V, pa0, pa1, pa2, pa3);
    if (j + 1 < NT) { asm volatile("s_waitcnt vmcnt(0)" ::: "memory"); SWRITE(bsel ^ 1); }
    __syncthreads();
  }
  if (hi == 0) li_l[r32] = l_reg; asm volatile("s_waitcnt lgkmcnt(0)" ::: "memory");
  float rli[16];
#pragma unroll
  for (int r = 0; r < 16; ++r) rli[r] = __builtin_amdgcn_rcpf(li_l[crow(r, hi)]);
  bf16_t* Ow = Ob + (size_t)(wid * QBLK) * LDO;
#pragma unroll
  for (int r = 0; r < 16; ++r) { const int orow = crow(r, hi);
#pragma unroll
    for (int d0 = 0; d0 < 4; ++d0) Ow[(size_t)orow * LDO + d0 * 32 + r32] = f2bf(o[d0][r] * rli[r]); }
#undef SLOAD
#undef SWRITE
#undef RESC
}
}

__device__ __forceinline__ void phase_attn(const Params& p, LAS unsigned char* lds) {
    char* ws = p.ws; const bf16_t* Q = (const bf16_t*)(ws + OFF_Q); const bf16_t* Kb = (const bf16_t*)(ws + OFF_K); const bf16_t* Vb = (const bf16_t*)(ws + OFF_V); bf16_t* Y = (bf16_t*)(ws + OFF_H);
    const int G = gridDim.x;
    for (int it = 0;; ++it) {
        int u;
        if (G == 256) { const int c = blockIdx.x, xcd = c & 7, j = c >> 3; if (it >= 4) break; u = ((it * 32 + xcd * 4 + (j >> 3)) << 3) | (j & 7); }
        else { u = it * G + blockIdx.x; if (u >= 1024) break; }
        const int bh = u >> 3, qb = u & 7, b = bh >> 3, h = bh & 7;
        at::attn_unit(Q + ((size_t)(b * SEQ + qb * 256)) * 1536 + h * 192, Kb + (size_t)bh * NKEY * 192, Vb + (size_t)bh * NKEY * 128, Y + ((size_t)(b * SEQ + qb * 256)) * D + h * 128, qb * 256, (const float*)(ws + OFF_ROPE), (LAS char*)lds);
        __syncthreads();
    }
}

namespace sc {
using f32x16 = __attribute__((ext_vector_type(16))) float;
constexpr int O_QI = 0, O_QG = 16384, O_KT = 32768, O_KE = 73728, O_VT = 90112, O_AT = 106496, O_SC = 114688, O_DEC = 147456, LDS_SCAN = 147456 + 512;
__device__ __forceinline__ int sw256(int row, int cb) { return row * 256 + (cb ^ ((row & 15) << 4)); }
__device__ __forceinline__ int sw128(int row, int cb) { return row * 128 + (cb ^ (((row >> 1) & 7) << 4)); }
__device__ __forceinline__ int crow(int r, int hi) { return (r & 3) + 8 * (r >> 2) + 4 * hi; }
__device__ __forceinline__ int grow_of(int n, int b, int dir) { if (n < CTXL) { const int s = dir ? (CTXL - 1 - n) : n; return L + b * CTXL + s; } const int m = n - CTXL; return b * SEQ + (dir ? (SEQ - 1 - m) : m); }

__device__ __forceinline__ void scan_unit(const Params& p, int unit, LAS unsigned char* lds) {
    char* ws = p.ws; const int dir = unit & 1, h = (unit >> 1) & 7, b = unit >> 4;
    const bf16_t* hq = (const bf16_t*)(ws + OFF_HQ); const bf16_t* fz = (const bf16_t*)(ws + (dir ? OFF_FB : OFF_FF)); const bf16_t* iv = (const bf16_t*)(ws + OFF_IV);
    bf16_t* outp = (bf16_t*)(ws + (dir ? OFF_OB : OFF_OF)); const float* lb = (const float*)(ws + OFF_LB);
    const int tid = otid(), wid = tid >> 6, lane = tid & 63, r32 = lane & 31, hi = lane >> 5;
    const int col = tid >> 2, J = tid & 3;
    const float lbv = lb[dir * 1024 + h * 128 + col];
    const int hc = h * 128 + col;
    LAS unsigned char* QI = lds + O_QI; LAS unsigned char* QG = lds + O_QG; LAS unsigned char* KT = lds + O_KT; LAS unsigned char* KE = lds + O_KE; LAS unsigned char* VT = lds + O_VT;
    LAS unsigned char* AT = lds + O_AT; LAS unsigned char* SCp = lds + O_SC; LAS float* DEC = (LAS float*)(lds + O_DEC);
    for (int i = tid; i < (8192 + 32768) / 16; i += 512) *(LAS u32x4*)(lds + O_AT + i * 16) = (u32x4){0u, 0u, 0u, 0u};
    f32x16 S0 = {}, S1 = {};
    const int tb = wid & 1, dvb = wid >> 1;
    unsigned short zr[16], vr[16], qr[16];
#define SC_LOAD(c) do { _Pragma("unroll") for (int i = 0; i < 16; ++i) { const int row = grow_of((c) * 64 + 16 * J + i, b, dir); zr[i] = fz[(size_t)row * D + hc]; vr[i] = iv[(size_t)row * D + hc]; \
        qr[i] = ((c) >= 4) ? hq[(size_t)row * D + hc] : (unsigned short)0; } } while (0)
    SC_LOAD(0);
    __syncthreads();
    for (int c = 0; c < 36; ++c) {
        const bool lat = c >= 4;
        {
            float kk[16], lcum[16]; float run = 0.f;
#pragma unroll
            for (int i = 0; i < 16; ++i) { const float z = bf2f(zr[i]); const float f = lbv + (1.0f - lbv) * sigmoidf_(z); kk[i] = 1.0f - f; run += __logf(f); lcum[i] = run; }
            const int l4 = lane & ~3;
            const float ta = __shfl(run, l4 + 0), tbv = __shfl(run, l4 + 1), tc = __shfl(run, l4 + 2), td = __shfl(run, l4 + 3);
            const float c0J = J == 0 ? 0.f : (J == 1 ? ta : (J == 2 ? ta + tbv : ta + tbv + tc));
            const float lastv = (ta + tbv) + (tc + td);
            const float egJ = __expf(c0J), eend = __expf(lastv - c0J);
            const float c01 = ta, c02 = ta + tbv, c03 = ta + tbv + tc;
            const float e1 = __expf(c01 - c0J), e2 = __expf(c02 - c0J), e3 = __expf(c03 - c0J);
            if (J == 0) DEC[col] = __expf(lastv);
            unsigned kev[8], vtv[8];
#pragma unroll
            for (int i = 0; i < 16; i += 2) {
                float kd[2], vv[2];
#pragma unroll
                for (int u = 0; u < 2; ++u) { const int ii = i + u; const float eq = __expf(lcum[ii]), ek = __expf(fminf(-lcum[ii], 80.0f)); const float kdv = kk[ii] * ek; kd[u] = kdv; vv[u] = bf2f(vr[ii]);
                    const int t = 16 * J + ii;
                    if (lat) { const float q = siluf_(bf2f(qr[ii])) * 0.08838834764831845f; const float qi = q * eq;
                        *(LAS bf16_t*)(QI + sw256(t, col * 2)) = f2bf(qi); *(LAS bf16_t*)(QG + sw256(t, col * 2)) = f2bf(qi * egJ);
                        if (J == 0) { *(LAS bf16_t*)(KT + sw256(0 + t, col * 2)) = f2bf(kdv); *(LAS bf16_t*)(KT + sw256(16 + t, col * 2)) = f2bf(kdv * e1); *(LAS bf16_t*)(KT + sw256(48 + t, col * 2)) = f2bf(kdv * e2); *(LAS bf16_t*)(KT + sw256(96 + t, col * 2)) = f2bf(kdv * e3); }
                        else if (J == 1) { *(LAS bf16_t*)(KT + sw256(16 + t, col * 2)) = f2bf(kdv); *(LAS bf16_t*)(KT + sw256(48 + t, col * 2)) = f2bf(kdv * e2); *(LAS bf16_t*)(KT + sw256(96 + t, col * 2)) = f2bf(kdv * e3); }
                        else if (J == 2) { *(LAS bf16_t*)(KT + sw256(48 + t, col * 2)) = f2bf(kdv); *(LAS bf16_t*)(KT + sw256(96 + t, col * 2)) = f2bf(kdv * e3); }
                        else { *(LAS bf16_t*)(KT + sw256(96 + t, col * 2)) = f2bf(kdv); } } }
                kev[i >> 1] = cvt_pk_bf16(kd[0] * eend, kd[1] * eend); vtv[i >> 1] = cvt_pk_bf16(vv[0], vv[1]);
            }
            *(LAS u32x4*)(KE + sw128(col, 32 * J)) = (u32x4){kev[0], kev[1], kev[2], kev[3]}; *(LAS u32x4*)(KE + sw128(col, 32 * J + 16)) = (u32x4){kev[4], kev[5], kev[6], kev[7]};
            *(LAS u32x4*)(VT + sw128(col, 32 * J)) = (u32x4){vtv[0], vtv[1], vtv[2], vtv[3]}; *(LAS u32x4*)(VT + sw128(col, 32 * J + 16)) = (u32x4){vtv[4], vtv[5], vtv[6], vtv[7]};
        }
        if (c + 1 < 36) SC_LOAD(c + 1);
        __syncthreads();
        if (lat) {
#pragma unroll
            for (int rep = 0; rep < 2; ++rep) { const int ti = wid + 8 * rep; if (ti < 10) {
                const int I = ti < 1 ? 0 : (ti < 3 ? 1 : (ti < 6 ? 2 : 3)); const int Jt = ti - (I * (I + 1)) / 2; const int kbase = I == 0 ? 0 : (I == 1 ? 16 : (I == 2 ? 48 : 96));
                const int l15 = lane & 15, lq = lane >> 4; f32x4 a = {0.f, 0.f, 0.f, 0.f};
#pragma unroll
                for (int ks = 0; ks < 4; ++ks) { const bf16x8 av = *(const LAS bf16x8*)(QI + sw256(16 * I + l15, (32 * ks + 8 * lq) * 2)); const bf16x8 bv = *(const LAS bf16x8*)(KT + sw256(kbase + 16 * Jt + l15, (32 * ks + 8 * lq) * 2));
                    a = __builtin_amdgcn_mfma_f32_16x16x32_bf16(av, bv, a, 0, 0, 0); }
#pragma unroll
                for (int r = 0; r < 4; ++r) { const int tl = 4 * lq + r; float v = a[r]; if (I == Jt && l15 > tl) v = 0.f; *(LAS bf16_t*)(AT + sw128(16 * I + tl, (16 * Jt + l15) * 2)) = f2bf(v); } } }
        }
        __syncthreads();
        {
            if (lat) {
                f32x16 o = {};
#pragma unroll
                for (int ks = 0; ks < 8; ++ks) { const bf16x8 av = *(const LAS bf16x8*)(QG + sw256(32 * tb + r32, (16 * ks + 8 * hi) * 2)); const bf16x8 bv = *(const LAS bf16x8*)(SCp + sw256(32 * dvb + r32, (16 * ks + 8 * hi) * 2));
                    o = __builtin_amdgcn_mfma_f32_32x32x16_bf16(av, bv, o, 0, 0, 0); }
#pragma unroll
                for (int ks = 0; ks < 4; ++ks) { if (ks < 2 || tb == 1) { const bf16x8 av = *(const LAS bf16x8*)(AT + sw128(32 * tb + r32, (16 * ks + 8 * hi) * 2)); const bf16x8 bv = *(const LAS bf16x8*)(VT + sw128(32 * dvb + r32, (16 * ks + 8 * hi) * 2));
                    o = __builtin_amdgcn_mfma_f32_32x32x16_bf16(av, bv, o, 0, 0, 0); } }
#pragma unroll
                for (int r = 0; r < 16; ++r) { const int t = 32 * tb + crow(r, hi); const int row = grow_of(c * 64 + t, b, dir); outp[(size_t)row * D + h * 128 + 32 * dvb + r32] = f2bf(o[r]); }
            }
#pragma unroll
            for (int r = 0; r < 16; ++r) { S0[r] *= DEC[64 * tb + crow(r, hi)]; S1[r] *= DEC[64 * tb + 32 + crow(r, hi)]; }
#pragma unroll
            for (int ks = 0; ks < 4; ++ks) { const bf16x8 bv = *(const LAS bf16x8*)(VT + sw128(32 * dvb + r32, (16 * ks + 8 * hi) * 2));
                const bf16x8 a0 = *(const LAS bf16x8*)(KE + sw128(64 * tb + r32, (16 * ks + 8 * hi) * 2)), a1 = *(const LAS bf16x8*)(KE + sw128(64 * tb + 32 + r32, (16 * ks + 8 * hi) * 2));
                S0 = __builtin_amdgcn_mfma_f32_32x32x16_bf16(a0, bv, S0, 0, 0, 0); S1 = __builtin_amdgcn_mfma_f32_32x32x16_bf16(a1, bv, S1, 0, 0, 0); }
        }
        __syncthreads();
#pragma unroll
        for (int g = 0; g < 4; ++g) { const int dv = 32 * dvb + r32; const int dk0 = 64 * tb + 8 * g + 4 * hi;
            u32x2 w0; w0.x = cvt_pk_bf16(S0[4 * g], S0[4 * g + 1]); w0.y = cvt_pk_bf16(S0[4 * g + 2], S0[4 * g + 3]); *(LAS u32x2*)(SCp + sw256(dv, dk0 * 2)) = w0;
            u32x2 w1; w1.x = cvt_pk_bf16(S1[4 * g], S1[4 * g + 1]); w1.y = cvt_pk_bf16(S1[4 * g + 2], S1[4 * g + 3]); *(LAS u32x2*)(SCp + sw256(dv, (dk0 + 32) * 2)) = w1; }
    }
    __syncthreads();
#undef SC_LOAD
}
}
__device__ __forceinline__ void phase_scan(const Params& p, LAS unsigned char* lds) {
    for (int u = blockIdx.x; u < 256; u += gridDim.x) sc::scan_unit(p, u, lds);
}

constexpr int LDS_BYTES = 155648;
template <int PH> __global__ void __launch_bounds__(512, 2) k_phase(Params p) {
    extern __shared__ __attribute__((aligned(16))) unsigned char smem[];
    LAS unsigned char* lds = (LAS unsigned char*)smem;
    if constexpr (PH == 0) phase0(p, lds);
    if constexpr (PH == 1) phase1(p, lds);
    if constexpr (PH == 2) phase2(p, lds);
    if constexpr (PH == 3) phase3(p, lds);
    if constexpr (PH == 4) phase4(p, lds);
    if constexpr (PH == 5) phase5(p, lds);
    if constexpr (PH == 6) phase6(p, lds);
    if constexpr (PH == 7) phase7(p, lds);
    if constexpr (PH == 8) phase8(p, lds);
    if constexpr (PH == 9) phase9(p, lds);
    if constexpr (PH == 10) phase_attn(p, lds);
    if constexpr (PH == 11) phase_scan(p, lds);
}

#include <cstdint>
#include <cstdlib>
#include <vector>

#define XB_TMO      128
#define XB_XCNT(j)  (256  + 64 * (j))
#define XB_XSUB(j)  (1280 + 64 * (j))
#define XB_XGEN(j)  (2304 + 64 * (j))
#define XB_TOP      3328
#define XB_TOPGEN   3392
#define XCD_BAR_WORDS 3456
#define XB_SPIN_CAP (1u << 18)

__device__ __forceinline__ unsigned xb_ld(unsigned* p)              { return __hip_atomic_load(p, __ATOMIC_RELAXED, __HIP_MEMORY_SCOPE_AGENT); }
__device__ __forceinline__ unsigned xb_add(unsigned* p, unsigned v) { return __hip_atomic_fetch_add(p, v, __ATOMIC_RELAXED, __HIP_MEMORY_SCOPE_AGENT); }
__device__ __forceinline__ unsigned xb_xcc_id() { return (unsigned)__builtin_amdgcn_s_getreg((3 << 11) | 20) & 0xFu; }
#define XB_SPIN(cond, bar) do { unsigned _sp = 0; while (cond) { __builtin_amdgcn_s_sleep(1); \
    if ((++_sp & 255u) == 0u) { if (xb_ld(&(bar)[XB_TMO])) break; if (_sp > XB_SPIN_CAP) { atomicAdd(&(bar)[XB_TMO], 1u); break; } } } } while (0)

struct XcdBarrier {
    unsigned* bar; unsigned x;
    volatile LAS unsigned* st;
};

__device__ __forceinline__ XcdBarrier xcd_barrier_post(unsigned* bar, volatile LAS unsigned* st) {
    XcdBarrier b; b.bar = bar; b.x = xb_xcc_id(); b.st = st;
    if (threadIdx.x == 0) (void)xb_add(&bar[XB_XCNT(b.x)], 1u);
    return b;
}
__device__ __forceinline__ void xcd_barrier_complete(unsigned* bar, unsigned x, unsigned& nloc, unsigned& nx) {
    const unsigned G = gridDim.x * gridDim.y * gridDim.z;
    unsigned sum, cnt, mine, sp = 0u;
    for (;;) {
        sum = 0u; cnt = 0u; mine = 0u;
#pragma unroll
        for (unsigned j = 0; j < 16; ++j) { const unsigned c = xb_ld(&bar[XB_XCNT(j)]); sum += c; cnt += (c > 0u) ? 1u : 0u; mine = (j == x) ? c : mine; }
        if (sum == G) break;
        __builtin_amdgcn_s_sleep(1);
        if ((++sp & 255u) == 0u) { if (xb_ld(&bar[XB_TMO])) break; if (sp > XB_SPIN_CAP) { atomicAdd(&bar[XB_TMO], 1u); break; } }
    }
    nloc = mine > 0u ? mine : 1u; nx = cnt > 0u ? cnt : 1u;
}

__device__ __forceinline__ void xcd_barrier(const XcdBarrier& b) {
    asm volatile("s_waitcnt vmcnt(0)" ::: "memory");
    __syncthreads();
    if (threadIdx.x == 0) {
        unsigned* bar = b.bar;
        __builtin_amdgcn_s_waitcnt(0);
        unsigned nloc = b.st[0], nx = b.st[1];
        if (nloc == 0u) { xcd_barrier_complete(bar, b.x, nloc, nx); b.st[0] = nloc; b.st[1] = nx; }
        const unsigned old = xb_add(&bar[XB_XSUB(b.x)], 1u);
        const unsigned gen = old / nloc;
        if (old + 1u == (gen + 1u) * nloc) {
            __builtin_amdgcn_fence(__ATOMIC_RELEASE, "agent");
            asm volatile("s_waitcnt vmcnt(0)" ::: "memory");
            const unsigned og = xb_add(&bar[XB_TOP], 1u);
            const unsigned tg = og / nx;
            if (og + 1u == (tg + 1u) * nx) xb_add(&bar[XB_TOPGEN], 1u);
            else XB_SPIN(xb_ld(&bar[XB_TOPGEN]) == tg, bar);
            __builtin_amdgcn_fence(__ATOMIC_ACQUIRE, "agent");
            xb_add(&bar[XB_XGEN(b.x)], 1u);
            asm volatile("s_waitcnt vmcnt(0)" ::: "memory");
        } else {
            XB_SPIN(xb_ld(&bar[XB_XGEN(b.x)]) == gen, bar);
            __builtin_amdgcn_fence(__ATOMIC_ACQUIRE, "agent");
            asm volatile("s_waitcnt vmcnt(0)" ::: "memory");
        }
    }
    __syncthreads();
}

__global__ void __launch_bounds__(512, 2) k_mega(Params p) {
    extern __shared__ __attribute__((aligned(16))) unsigned char smem[];
    LAS unsigned char* lds = (LAS unsigned char*)smem;
    volatile LAS unsigned* xbw = (volatile LAS unsigned*)(lds + LDS_BYTES - 16);
    if (threadIdx.x == 0) { xbw[0] = 0u; xbw[1] = 0u; xbw[2] = 0u; xbw[3] = 0u; }
    __syncthreads();
    XcdBarrier bar = xcd_barrier_post((unsigned*)(p.ws + OFF_BAR), xbw);
    phase0(p, lds);      xcd_barrier(bar);
    phase1(p, lds);      xcd_barrier(bar);
    phase2(p, lds);      xcd_barrier(bar);
    phase3(p, lds);      xcd_barrier(bar);
    phase_attn(p, lds);
    phase_scan(p, lds);  xcd_barrier(bar);
    phase4(p, lds);      xcd_barrier(bar);
    phase5(p, lds);      xcd_barrier(bar);
    phase6(p, lds);      xcd_barrier(bar);
    phase7(p, lds);      xcd_barrier(bar);
    phase8(p, lds);      xcd_barrier(bar);
    phase9(p, lds);
}
extern "C" void kernel_launch(void* const* d_in, const int* in_sizes, int n_in, void* d_out, int out_size, void* d_ws, size_t ws_size, hipStream_t stream) {
    static int grid = 0;
    if (grid == 0) {
        int dev = 0, cus = 0, per_cu = 0;
        if (hipGetDevice(&dev) != hipSuccess || hipDeviceGetAttribute(&cus, hipDeviceAttributeMultiprocessorCount, dev) != hipSuccess) { grid = -1; return; }
        if (hipFuncSetAttribute((const void*)k_mega, hipFuncAttributeMaxDynamicSharedMemorySize, LDS_BYTES) != hipSuccess) { grid = -1; return; }
        (void)hipOccupancyMaxActiveBlocksPerMultiprocessor(&per_cu, (const void*)k_mega, 512, LDS_BYTES);
        (void)hipGetLastError();
        grid = cus;
    }
    if (grid < 0) return;
    Params p{};
    p.x = (const float*)d_in[0]; p.c = (const float*)d_in[1]; p.ctx = (const float*)d_in[2]; p.cctx = (const float*)d_in[3]; p.w_mod = (const float*)d_in[4]; p.b_mod = (const float*)d_in[5];
    p.g_mix = (const float*)d_in[6]; p.w_in = (const float*)d_in[7]; p.g_q = (const float*)d_in[8]; p.w_qb = (const float*)d_in[9]; p.g_kv = (const float*)d_in[10]; p.w_kvb = (const float*)d_in[11];
    p.lbl = (const float*)d_in[12]; p.g_hg = (const float*)d_in[13]; p.w_out = (const float*)d_in[14]; p.g_ffn = (const float*)d_in[15]; p.w_r = (const float*)d_in[16]; p.b_r = (const float*)d_in[17];
    p.w_gu = (const float*)d_in[18]; p.b_gu = (const float*)d_in[19]; p.w_dn = (const float*)d_in[20]; p.b_dn = (const float*)d_in[21]; p.g_fin = (const float*)d_in[22];
    p.out = (float*)d_out; p.ws = (char*)d_ws;
    (void)hipMemsetAsync((char*)d_ws + OFF_BAR, 0, 16384, stream);
    hipLaunchKernelGGL(k_mega, dim3(grid), dim3(512), LDS_BYTES, stream, p);
}
```

```cpp
#include <hip/hip_runtime.h>
#include <stdint.h>

typedef unsigned short bf16_t;
__device__ __forceinline__ float bf2f(bf16_t v) { return __uint_as_float(((unsigned)v) << 16); }
__device__ __forceinline__ bf16_t f2bf(float f) { unsigned u = __float_as_uint(f); u += 0x7FFFu + ((u >> 16) & 1u); return (bf16_t)(u >> 16); }
__device__ __forceinline__ float sigmoidf_(float x) { return __builtin_amdgcn_rcpf(1.0f + __builtin_amdgcn_exp2f(-1.4426950408889634f * x)); }
__device__ __forceinline__ float siluf_(float x) { return x * __builtin_amdgcn_rcpf(1.0f + __builtin_amdgcn_exp2f(-1.4426950408889634f * x)); }

constexpr int D = 1024, NB = 16, SEQ = 2048, CTXL = 256;
constexpr int L = NB * SEQ;
constexpr int RC = NB * CTXL;
constexpr int R = L + RC;
constexpr int NKEY = SEQ + CTXL;
constexpr float EPS = 1e-6f;
constexpr int NE = 32, CAP = 32768;
constexpr int MAXROWS = 131072 + NE * 256;

constexpr size_t MiB = 1048576;
constexpr size_t OFF_SMALL = 0;
constexpr size_t OFF_BAR = 0;
constexpr size_t OFF_CNT = 16384;
constexpr size_t OFF_OFFS = 16384 + 1024;
constexpr size_t OFF_TILEE = 16384 + 2048;
constexpr size_t OFF_LB = 24576;
constexpr size_t OFF_MOD = 32768;
constexpr size_t OFF_SSQQ = 512 * 1024;
constexpr size_t OFF_SSQKV = 768 * 1024;
constexpr size_t OFF_TOPI = 1 * MiB;
constexpr size_t OFF_TOPP = 1 * MiB + 512 * 1024;
constexpr size_t OFF_ROWPAIR = 2 * MiB;
constexpr size_t OFF_LIST = 3 * MiB;
constexpr size_t OFF_H = 32 * MiB;
constexpr size_t OFF_QA = 104 * MiB;
constexpr size_t OFF_CKV = 152 * MiB;
constexpr size_t OFF_KR = 170 * MiB;
constexpr size_t OFF_OF = 104 * MiB;
constexpr size_t OFF_HQ = 175 * MiB;
constexpr size_t SEG_STRIDE = 72 * MiB;
constexpr size_t OFF_FF = OFF_HQ + 1 * SEG_STRIDE;
constexpr size_t OFF_FB = OFF_HQ + 2 * SEG_STRIDE;
constexpr size_t OFF_IV = OFF_HQ + 3 * SEG_STRIDE;
constexpr size_t OFF_OG = OFF_HQ + 4 * SEG_STRIDE;
constexpr size_t OFF_GM = OFF_HQ + 5 * SEG_STRIDE;
constexpr size_t OFF_GH = OFF_HQ + 6 * SEG_STRIDE;
constexpr size_t OFF_Q = 679 * MiB;
constexpr size_t OFF_K = 775 * MiB;
constexpr size_t OFF_V = 883 * MiB;
constexpr size_t OFF_OB = 955 * MiB;
constexpr size_t OFF_YP = 296 * MiB;
constexpr size_t OFF_ACT = 568 * MiB;

struct SegOut { bf16_t *qa, *ckv, *kr, *hq, *ff, *fb, *iv, *og, *gm, *gh; };

__global__ void k_init(const float* __restrict__ lbl, float* lb, int* cnt) {
    int i = blockIdx.x * blockDim.x + threadIdx.x;
    if (i < 2048) { int d = i >> 10, j = i & 1023; float a = lbl[(d * 2 + 0) * 1024 + j], b = lbl[(d * 2 + 1) * 1024 + j]; lb[i] = 1.0f / (1.0f + __expf(b - a)); }
    if (i < 32) cnt[i] = 0;
}

__global__ __launch_bounds__(256) void k_mod(const float* __restrict__ c, const float* __restrict__ cctx, const float* __restrict__ wmod, const float* __restrict__ bmod, float* modv) {
    __shared__ float s[1024];
    int r = blockIdx.y; const float* src = r < 16 ? c + r * 1024 : cctx;
    for (int k = threadIdx.x; k < 1024; k += 256) s[k] = siluf_(src[k]);
    __syncthreads();
    int j = blockIdx.x * 256 + threadIdx.x; float acc = 0.f;
    for (int k = 0; k < 1024; ++k) acc += s[k] * wmod[(size_t)k * 6144 + j];
    modv[r * 6144 + j] = acc + bmod[j];
}

__device__ __forceinline__ float block_sum256(float v, float* red) {
    for (int o = 32; o > 0; o >>= 1) v += __shfl_xor(v, o);
    int w = threadIdx.x >> 6; if ((threadIdx.x & 63) == 0) red[w] = v; __syncthreads();
    float t = red[0] + red[1] + red[2] + red[3]; __syncthreads(); return t;
}

__global__ __launch_bounds__(256) void k_norm1(const float* __restrict__ x, const float* __restrict__ ctx, const float* __restrict__ g, const float* __restrict__ modv, bf16_t* h) {
    __shared__ float red[4];
    int row = blockIdx.x; const float* src = row < L ? x + (size_t)row * D : ctx + (size_t)(row - L) * D;
    const float* mod = modv + (row < L ? row / SEQ : 16) * 6144;
    int c = threadIdx.x * 4; float4 v = *(const float4*)(src + c);
    float ss = block_sum256(v.x * v.x + v.y * v.y + v.z * v.z + v.w * v.w, red);
    float rs = rsqrtf(ss * (1.0f / D) + EPS);
    float o[4] = {v.x, v.y, v.z, v.w}; ushort4 w; bf16_t* wp = (bf16_t*)&w;
    for (int i = 0; i < 4; ++i) wp[i] = f2bf(o[i] * rs * g[c + i] * (1.0f + mod[1024 + c + i]) + mod[c + i]);
    *(ushort4*)(h + (size_t)row * D + c) = w;
}

__global__ __launch_bounds__(256) void k_rowssq(const bf16_t* __restrict__ buf, int width, int nrows, float* ssq) {
    int row = blockIdx.x * 4 + (threadIdx.x >> 6), lane = threadIdx.x & 63; if (row >= nrows) return;
    float s = 0.f; for (int k = lane; k < width; k += 64) { float v = bf2f(buf[(size_t)row * width + k]); s += v * v; }
    for (int o = 32; o > 0; o >>= 1) s += __shfl_xor(s, o);
    if (lane == 0) ssq[row] = s;
}

__device__ __forceinline__ void rope_cs(int t, int i, float& cs, float& sn) {
    int j = i & 15; float inv = __expf(-(float)j * (9.210340371976184f / 16.0f)); float pos = (i < 16) ? (float)(t >> 6) : (float)(t & 63);
    float ang = pos * inv; cs = cosf(ang); sn = sinf(ang);
}

__global__ __launch_bounds__(256) void k_krope(const bf16_t* __restrict__ kr, bf16_t* Kb) {
    int gid = blockIdx.x * 256 + threadIdx.x; int row = gid >> 5, i = gid & 31; if (row >= R) return;
    float x1 = bf2f(kr[(size_t)row * 64 + i]), x2 = bf2f(kr[(size_t)row * 64 + 32 + i]); float o1 = x1, o2 = x2; int b, pos;
    if (row < L) { b = row / SEQ; pos = row % SEQ; float cs, sn; rope_cs(pos, i, cs, sn); o1 = x1 * cs - x2 * sn; o2 = x1 * sn + x2 * cs; }
    else { b = (row - L) / CTXL; pos = SEQ + (row - L) % CTXL; }
    bf16_t w1 = f2bf(o1), w2 = f2bf(o2);
    for (int h = 0; h < 8; ++h) { bf16_t* p = Kb + ((size_t)(b * 8 + h) * NKEY + pos) * 192 + 128; p[i] = w1; p[32 + i] = w2; }
}

template <class AL, class EP>
__global__ __launch_bounds__(256) void k_ngemm(int K, const float* __restrict__ W, int ldw, size_t wzstride, AL al, EP ep) {
    __shared__ float As[16][68]; __shared__ float Bs[16][64];
    const int z = blockIdx.z, row0 = blockIdx.y * 64, col0 = blockIdx.x * 64, tid = threadIdx.x;
    const int mvalid = al.rows(z); if (row0 >= mvalid) return;
    const float* Wz = W + (size_t)z * wzstride;
    const int ar = tid >> 2, ak = (tid & 3) * 4; const bf16_t* arow = (row0 + ar < mvalid) ? al.rowptr(z, row0 + ar) : nullptr;
    const int bk = tid >> 4, bn = (tid & 15) * 4;
    const int ty = tid >> 4, tx = tid & 15;
    float acc[4][4] = {};
    for (int k0 = 0; k0 < K; k0 += 16) {
        float a4[4] = {0.f, 0.f, 0.f, 0.f};
        if (arow) { ushort4 u = *(const ushort4*)(arow + k0 + ak); const bf16_t* up = (const bf16_t*)&u; for (int i = 0; i < 4; ++i) a4[i] = bf2f(up[i]) * al.kscale(k0 + ak + i); }
        float4 b4 = *(const float4*)(Wz + (size_t)(k0 + bk) * ldw + col0 + bn);
        __syncthreads();
        for (int i = 0; i < 4; ++i) As[ak + i][ar] = a4[i];
        *(float4*)&Bs[bk][bn] = b4;
        __syncthreads();
#pragma unroll
        for (int kk = 0; kk < 16; ++kk) {
            float4 av = *(const float4*)&As[kk][ty * 4]; float4 bv = *(const float4*)&Bs[kk][tx * 4];
            float a[4] = {av.x, av.y, av.z, av.w}, b[4] = {bv.x, bv.y, bv.z, bv.w};
#pragma unroll
            for (int i = 0; i < 4; ++i)
#pragma unroll
                for (int j = 0; j < 4; ++j) acc[i][j] += a[i] * b[j];
        }
    }
    for (int i = 0; i < 4; ++i) { int row = row0 + ty * 4 + i; if (row < mvalid) ep.store(z, row, col0 + tx * 4, acc[i]); }
}

__device__ __forceinline__ void st4bf(bf16_t* dst, const float* v) { ushort4 w; bf16_t* wp = (bf16_t*)&w; for (int i = 0; i < 4; ++i) wp[i] = f2bf(v[i]); *(ushort4*)dst = w; }

struct ALDense { const bf16_t* A; int lda; int nrows; const float* ks;
    __device__ int rows(int) const { return nrows; }
    __device__ const bf16_t* rowptr(int, int row) const { return A + (size_t)row * lda; }
    __device__ float kscale(int k) const { return ks ? ks[k] : 1.0f; } };

struct EpiInN { SegOut s;
    __device__ void store(int, int row, int col, const float* v) const {
        bf16_t* dst;
        if (col < 768) { if (row >= L) return; dst = s.qa + (size_t)row * 768 + col; }
        else if (col < 1024) dst = s.ckv + (size_t)row * 256 + (col - 768);
        else if (col < 1088) dst = s.kr + (size_t)row * 64 + (col - 1024);
        else { int c = col - 1088, seg = c >> 10, cc = c & 1023; bool latonly = (seg == 0 || seg >= 4); if (latonly && row >= L) return;
            bf16_t* base = seg == 0 ? s.hq : seg == 1 ? s.ff : seg == 2 ? s.fb : seg == 3 ? s.iv : seg == 4 ? s.og : seg == 5 ? s.gm : s.gh;
            dst = base + (size_t)row * 1024 + cc; }
        st4bf(dst, v);
    } };

struct EpiQN { bf16_t* q; const float* ssq;
    __device__ void store(int, int row, int col, const float* v) const { float rs = rsqrtf(ssq[row] * (1.0f / 768.0f) + EPS); float o[4]; for (int i = 0; i < 4; ++i) o[i] = v[i] * rs; st4bf(q + (size_t)row * 1536 + col, o); } };

struct EpiKVN { bf16_t *Kb, *Vb; const float* ssq;
    __device__ void store(int, int row, int col, const float* v) const {
        float rs = rsqrtf(ssq[row] * (1.0f / 256.0f) + EPS); float o[4]; for (int i = 0; i < 4; ++i) o[i] = v[i] * rs;
        int b, pos; if (row < L) { b = row / SEQ; pos = row % SEQ; } else { b = (row - L) / CTXL; pos = SEQ + (row - L) % CTXL; }
        int h = col >> 8, w = col & 255; size_t kvrow = (size_t)(b * 8 + h) * NKEY + pos;
        if (w < 128) st4bf(Kb + kvrow * 192 + w, o); else st4bf(Vb + kvrow * 128 + (w - 128), o);
    } };

struct EpiOutN { float* x1; const float* x; const float* modv;
    __device__ void store(int, int row, int col, const float* v) const {
        const float* gate = modv + (row / SEQ) * 6144 + 2 * 1024; float4 xv = *(const float4*)(x + (size_t)row * D + col);
        float4 o; o.x = xv.x + gate[col] * v[0]; o.y = xv.y + gate[col + 1] * v[1]; o.z = xv.z + gate[col + 2] * v[2]; o.w = xv.w + gate[col + 3] * v[3];
        *(float4*)(x1 + (size_t)row * D + col) = o;
    } };

struct ALMoe1 { const bf16_t* h2; const int* cnt; const int* list;
    __device__ int rows(int z) const { return cnt[z]; }
    __device__ const bf16_t* rowptr(int z, int row) const { return h2 + (size_t)(list[z * CAP + row] >> 2) * D; }
    __device__ float kscale(int) const { return 1.0f; } };
struct EpiMoe1N { bf16_t* act; const int* offs; const float* bgu;
    __device__ void store(int z, int row, int col, const float* v) const {
        const float* bb = bgu + z * 2048 + col; ushort2 w; bf16_t* wp = (bf16_t*)&w;
        for (int p = 0; p < 2; ++p) { float glu = fminf(v[2 * p] + bb[2 * p], 7.0f); float lin = fminf(fmaxf(v[2 * p + 1] + bb[2 * p + 1], -7.0f), 7.0f);
            wp[p] = f2bf(glu * sigmoidf_(1.702f * glu) * (lin + 1.0f)); }
        *(ushort2*)(act + (size_t)(offs[z] + row) * D + (col >> 1)) = w;
    } };
struct ALMoe2 { const bf16_t* act; const int* cnt; const int* offs;
    __device__ int rows(int z) const { return cnt[z]; }
    __device__ const bf16_t* rowptr(int z, int row) const { return act + (size_t)(offs[z] + row) * D; }
    __device__ float kscale(int) const { return 1.0f; } };
struct EpiMoe2N { bf16_t* yp; const int* list; const float* bd;
    __device__ void store(int z, int row, int col, const float* v) const {
        int pair = list[z * CAP + row]; const float* bb = bd + z * 1024 + col; float o[4]; for (int i = 0; i < 4; ++i) o[i] = v[i] + bb[i];
        st4bf(yp + (size_t)pair * D + col, o);
    } };

__global__ __launch_bounds__(256) void k_nattn(const bf16_t* __restrict__ Q, const bf16_t* __restrict__ Kb, const bf16_t* __restrict__ Vb, bf16_t* Y) {
    __shared__ float qs[4][192]; __shared__ float sc[4][NKEY];
    const int tid = threadIdx.x, blk = blockIdx.x, qg = blk & 511, h = (blk >> 9) & 7, b = blk >> 12;
    for (int idx = tid; idx < 4 * 192; idx += 256) { int qi = idx / 192, d = idx % 192; int row = b * SEQ + qg * 4 + qi; qs[qi][d] = bf2f(Q[(size_t)row * 1536 + h * 192 + d]); }
    __syncthreads();
    float n1 = 0.f, n2 = 0.f;
    if (tid < 128) { int qi = tid >> 5, i = tid & 31; int t = qg * 4 + qi; float cs, sn; rope_cs(t, i, cs, sn); float x1 = qs[qi][128 + i], x2 = qs[qi][160 + i]; n1 = x1 * cs - x2 * sn; n2 = x1 * sn + x2 * cs; }
    __syncthreads();
    if (tid < 128) { int qi = tid >> 5, i = tid & 31; qs[qi][128 + i] = n1; qs[qi][160 + i] = n2; }
    __syncthreads();
    const bf16_t* Kp = Kb + (size_t)(b * 8 + h) * NKEY * 192; const bf16_t* Vp = Vb + (size_t)(b * 8 + h) * NKEY * 128;
    const float scale = 0.07216878364870322f;
    for (int key = tid; key < NKEY; key += 256) {
        const bf16_t* kr = Kp + (size_t)key * 192; float s0 = 0.f, s1 = 0.f, s2 = 0.f, s3 = 0.f;
        for (int d = 0; d < 192; d += 8) { uint4 u = *(const uint4*)(kr + d); const bf16_t* up = (const bf16_t*)&u;
            for (int j = 0; j < 8; ++j) { float kv = bf2f(up[j]); s0 += qs[0][d + j] * kv; s1 += qs[1][d + j] * kv; s2 += qs[2][d + j] * kv; s3 += qs[3][d + j] * kv; } }
        sc[0][key] = s0 * scale; sc[1][key] = s1 * scale; sc[2][key] = s2 * scale; sc[3][key] = s3 * scale;
    }
    __syncthreads();
    { int w = tid >> 6, lane = tid & 63; float m = -1e30f; for (int k = lane; k < NKEY; k += 64) m = fmaxf(m, sc[w][k]);
      for (int o = 32; o > 0; o >>= 1) m = fmaxf(m, __shfl_xor(m, o));
      float s = 0.f; for (int k = lane; k < NKEY; k += 64) { float e = __expf(sc[w][k] - m); sc[w][k] = e; s += e; }
      for (int o = 32; o > 0; o >>= 1) s += __shfl_xor(s, o);
      float inv = 1.0f / s; for (int k = lane; k < NKEY; k += 64) sc[w][k] *= inv; }
    __syncthreads();
    { int dv = tid & 127, qh = tid >> 7; float o0 = 0.f, o1 = 0.f;
      for (int k = 0; k < NKEY; ++k) { float v = bf2f(Vp[(size_t)k * 128 + dv]); o0 += sc[qh * 2][k] * v; o1 += sc[qh * 2 + 1][k] * v; }
      int row = b * SEQ + qg * 4 + qh * 2; Y[(size_t)row * D + h * 128 + dv] = f2bf(o0); Y[(size_t)(row + 1) * D + h * 128 + dv] = f2bf(o1); }
}

__global__ __launch_bounds__(256) void k_nscan(const bf16_t* __restrict__ hq, const bf16_t* __restrict__ ff, const bf16_t* __restrict__ fb, const bf16_t* __restrict__ iv, const float* __restrict__ lb, bf16_t* of, bf16_t* ob) {
    __shared__ float sf[128], sk[128], sq[128], so[2][128];
    const int tid = threadIdx.x, blk = blockIdx.x, dir = blk & 1, h = (blk >> 1) & 7, b = blk >> 4;
    const bf16_t* fz = dir ? fb : ff; bf16_t* out = dir ? ob : of;
    const int dv = tid & 127, half = tid >> 7;
    float S[64];
#pragma unroll
    for (int j = 0; j < 64; ++j) S[j] = 0.f;
    const float lbv = lb[dir * 1024 + h * 128 + (tid & 127)];
    for (int step = 0; step < NKEY; ++step) {
        int row; bool islat;
        if (step < CTXL) { int s = dir ? (CTXL - 1 - step) : step; row = L + b * CTXL + s; islat = false; }
        else { int t = step - CTXL; t = dir ? (SEQ - 1 - t) : t; row = b * SEQ + t; islat = true; }
        if (tid < 128) { float z = bf2f(fz[(size_t)row * D + h * 128 + tid]); float f = lbv + (1.0f - lbv) * sigmoidf_(z); sf[tid] = f; sk[tid] = 1.0f - f;
            if (islat) { float zq = bf2f(hq[(size_t)row * D + h * 128 + tid]); sq[tid] = siluf_(zq) * 0.08838834764831845f; } }
        float v = bf2f(iv[(size_t)row * D + h * 128 + dv]);
        __syncthreads();
        float o = 0.f;
#pragma unroll
        for (int j = 0; j < 64; ++j) { int dk = half * 64 + j; S[j] = sf[dk] * S[j] + sk[dk] * v; o += S[j] * sq[dk]; }
        if (islat) so[half][dv] = o;
        __syncthreads();
        if (islat && half == 0) out[(size_t)row * D + h * 128 + dv] = f2bf(so[0][dv] + so[1][dv]);
    }
}

__global__ __launch_bounds__(256) void k_merge(bf16_t* y, const bf16_t* __restrict__ of, const bf16_t* __restrict__ ob, const bf16_t* __restrict__ og, const bf16_t* __restrict__ gm, const bf16_t* __restrict__ gh, const float* __restrict__ ghg) {
    int row = blockIdx.x, c = threadIdx.x * 4; size_t off = (size_t)row * D + c;
    ushort4 a = *(const ushort4*)(of + off), bb = *(const ushort4*)(ob + off), g1 = *(const ushort4*)(og + off), g2 = *(const ushort4*)(gm + off), g3 = *(const ushort4*)(gh + off), ym = *(const ushort4*)(y + off);
    const bf16_t *ap = (const bf16_t*)&a, *bp = (const bf16_t*)&bb, *p1 = (const bf16_t*)&g1, *p2 = (const bf16_t*)&g2, *p3 = (const bf16_t*)&g3, *pm = (const bf16_t*)&ym;
    float o[4], ss = 0.f; for (int i = 0; i < 4; ++i) { o[i] = bf2f(ap[i]) + bf2f(bp[i]); ss += o[i] * o[i]; }
    for (int m = 16; m > 0; m >>= 1) ss += __shfl_xor(ss, m);
    float rs = rsqrtf(ss * (1.0f / 128.0f) + EPS); float r[4];
    for (int i = 0; i < 4; ++i) { float yh = o[i] * rs * ghg[(c + i) & 127] * siluf_(bf2f(p1[i])); r[i] = sigmoidf_(bf2f(p2[i])) * bf2f(pm[i]) + sigmoidf_(bf2f(p3[i])) * yh; }
    st4bf(y + off, r);
}

__global__ __launch_bounds__(256) void k_norm2_router(const float* __restrict__ x1, const float* __restrict__ g, const float* __restrict__ modv, const float* __restrict__ wr, const float* __restrict__ br, bf16_t* h2, int* topi, float* topp, int* cnt, int* list) {
    __shared__ float red[4]; __shared__ float hs[1024]; __shared__ float part[8][32];
    int row = blockIdx.x, tid = threadIdx.x, c = tid * 4; const float* mod = modv + (row / SEQ) * 6144;
    float4 v = *(const float4*)(x1 + (size_t)row * D + c);
    float ss = block_sum256(v.x * v.x + v.y * v.y + v.z * v.z + v.w * v.w, red); float rs = rsqrtf(ss * (1.0f / D) + EPS);
    float xv[4] = {v.x, v.y, v.z, v.w}, o[4];
    for (int i = 0; i < 4; ++i) { o[i] = xv[i] * rs * g[c + i] * (1.0f + mod[4 * 1024 + c + i]) + mod[3 * 1024 + c + i]; hs[c + i] = o[i]; }
    st4bf(h2 + (size_t)row * D + c, o);
    __syncthreads();
    { int e = tid & 31, p = tid >> 5; float a = 0.f; for (int j = p * 128; j < p * 128 + 128; ++j) a += hs[j] * wr[j * 32 + e]; part[p][e] = a; }
    __syncthreads();
    if (tid < 64) {
        int e = tid & 31; float cur = br[e];
#pragma unroll
        for (int p = 0; p < 8; ++p) cur += part[p][e];
        float tv0 = 0.f, sum = 0.f; float myp = 0.f; int myk = -1;
        int sel_i[4]; float sel_e[4];
#pragma unroll
        for (int k = 0; k < 4; ++k) {
            float m = cur; int mi = e;
#pragma unroll
            for (int o = 16; o > 0; o >>= 1) { float om = __shfl_xor(m, o); int oi = __shfl_xor(mi, o); if (om > m || (om == m && oi < mi)) { m = om; mi = oi; } }
            if (k == 0) tv0 = m;
            sel_i[k] = mi; sel_e[k] = __expf(m - tv0); sum += sel_e[k];
            if (e == mi) cur = -3.0e38f;
        }
#pragma unroll
        for (int k = 0; k < 4; ++k) if (tid == k) { myk = sel_i[k]; myp = sel_e[k] / sum; }
        if (tid < 4) { int pair = row * 4 + tid; topi[pair] = myk; topp[pair] = myp; int pos = atomicAdd(&cnt[myk], 1); list[myk * CAP + pos] = pair; }
    }
}

__global__ void k_moe_offs(const int* cnt, int* offs, int* tilee) {
    if (threadIdx.x == 0 && blockIdx.x == 0) { int o = 0, t = 0; for (int e = 0; e < NE; ++e) { offs[e] = o; int nt = (cnt[e] + 255) >> 8; for (int i = 0; i < nt; ++i) tilee[t++] = e; o += nt * 256; } offs[NE] = o; offs[NE + 1] = t; }
}

__global__ __launch_bounds__(256) void k_final(float* out, const bf16_t* __restrict__ yp, const float* __restrict__ topp, const float* __restrict__ modv, const float* __restrict__ fg) {
    __shared__ float red[4];
    int row = blockIdx.x, c = threadIdx.x * 4; const float* gate = modv + (row / SEQ) * 6144 + 5 * 1024;
    float4 v = *(const float4*)(out + (size_t)row * D + c); float xv[4] = {v.x, v.y, v.z, v.w}; float m[4] = {0.f, 0.f, 0.f, 0.f};
    for (int k = 0; k < 4; ++k) { float p = topp[row * 4 + k]; ushort4 u = *(const ushort4*)(yp + (size_t)(row * 4 + k) * D + c); const bf16_t* up = (const bf16_t*)&u; for (int i = 0; i < 4; ++i) m[i] += p * bf2f(up[i]); }
    float ss = 0.f; for (int i = 0; i < 4; ++i) { xv[i] += gate[c + i] * m[i]; ss += xv[i] * xv[i]; }
    ss = block_sum256(ss, red); float rs = rsqrtf(ss * (1.0f / D) + EPS);
    float4 o; o.x = xv[0] * rs * fg[c]; o.y = xv[1] * rs * fg[c + 1]; o.z = xv[2] * rs * fg[c + 2]; o.w = xv[3] * rs * fg[c + 3];
    *(float4*)(out + (size_t)row * D + c) = o;
}

#define LAS __attribute__((address_space(3)))
__device__ __forceinline__ int otid() { int t = threadIdx.x; asm volatile("" : "+v"(t)); return t; }
typedef short bf16x8 __attribute__((ext_vector_type(8)));
typedef float f32x4 __attribute__((ext_vector_type(4)));
typedef unsigned u32x4 __attribute__((ext_vector_type(4)));
typedef unsigned u32x2 __attribute__((ext_vector_type(2)));
typedef float f32x2 __attribute__((ext_vector_type(2)));

constexpr size_t OFF_ROPE = 7 * MiB;
constexpr size_t OFF_WT_IN = 8 * MiB;
constexpr size_t OFF_WT_QB = 25 * MiB;
constexpr size_t OFF_WT_KVB = 28 * MiB;
constexpr size_t OFF_WT_OUT = 29 * MiB;
constexpr size_t OFF_WT_GU = 104 * MiB;
constexpr size_t OFF_WT_DN = 232 * MiB;

struct Params {
    const float *x, *c, *ctx, *cctx, *w_mod, *b_mod, *g_mix, *w_in, *g_q, *w_qb, *g_kv, *w_kvb, *lbl, *g_hg, *w_out, *g_ffn, *w_r, *b_r, *w_gu, *b_gu, *w_dn, *b_dn, *g_fin;
    float* out; char* ws;
};

typedef __bf16 bf16v2_t __attribute__((ext_vector_type(2)));
__device__ __forceinline__ unsigned cvt_pk_bf16(float lo, float hi) { bf16v2_t v = {(__bf16)lo, (__bf16)hi}; return __builtin_bit_cast(unsigned, v); }

namespace pg8 {
constexpr int BM = 256, BK = 64, HALF = 128, HTB = HALF * BK * 2, STAGE_BYTES = 8 * HTB, NXCD = 8, WGM = 8;
__device__ __forceinline__ int lds_byte(int r, int c) { const int st = (r >> 4) * 2 + (c >> 5), rr = r & 15, cc = c & 31, ob = rr * 64 + cc * 2; return st * 1024 + (ob ^ (((ob >> 9) & 1) << 5)); }
__device__ __forceinline__ void stage_rc(int b, int& R, int& C) { const int st = b / 1024, sb = b % 1024, swz = sb ^ (((sb >> 9) & 1) << 5); R = (st >> 1) * 16 + swz / 64; C = (st & 1) * 32 + (swz % 64) / 2; }
__device__ __forceinline__ int perm32(int rho) { const int n = rho >> 4, i = rho & 15; return 8 * (i >> 2) + 4 * n + (i & 3); }
struct Unit { int pm, pn; const char* b; int e, pos0, cnt; };

__device__ __forceinline__ int xcd_remap(int L, int nwg) { const int q = nwg / NXCD, r = nwg % NXCD, xcd = L % NXCD, off = L / NXCD; return (xcd < r ? xcd * (q + 1) : r * (q + 1) + (xcd - r) * q) + off; }

struct DenseSched {
    int nM, nN, nwg, G, c, lda; const char* Bt; size_t btile;
    __device__ void init(int M, int N, int K, int lda_, const void* Bt_, int G_, int c_) { nM = M / BM; nN = N / BM; nwg = nM * nN; G = G_; c = c_; lda = lda_; Bt = (const char*)Bt_; btile = (size_t)BM * K * 2; }
    __device__ __forceinline__ void tile(int wgid, int& pm, int& pn) const { const int nig = WGM * nN, gid = wgid / nig, fm = gid * WGM, gsz = (nM - fm) < WGM ? (nM - fm) : WGM; pm = fm + ((wgid % nig) % gsz); pn = (wgid % nig) / gsz; }
    __device__ __forceinline__ bool next(int i, Unit& u) const { const int Lx = i * G + c; if (Lx >= nwg) return false; tile(xcd_remap(Lx, nwg), u.pm, u.pn); u.b = Bt + (size_t)u.pn * btile; u.e = 0; u.pos0 = 0; u.cnt = 0; return true; }
    __device__ __forceinline__ void aoff(const Unit& u, const int (&Rr)[2], const int (&Cc)[2], unsigned (&va)[2][2]) const {
#pragma unroll
        for (int h = 0; h < 2; ++h)
#pragma unroll
            for (int i = 0; i < 2; ++i) va[h][i] = (unsigned)((u.pm * BM + h * HALF + Rr[i]) * lda + Cc[i]) * 2u; }
};
struct InSched : DenseSched {
    __device__ void init2(const void* Bt_, int G_, int c_) { init(L, 8448, 1024, 1024, Bt_, G_, c_); }
    __device__ __forceinline__ bool next(int i, Unit& u) const {
        const int Lx = i * G + c; const int nlat = nwg;
        if (Lx < nlat) { tile(xcd_remap(Lx, nlat), u.pm, u.pn); }
        else { const int j = Lx - nlat; if (j >= 16 * 14) return false; const int q = j >> 4; u.pm = 128 + (j & 15); u.pn = q == 0 ? 3 : (q <= 12 ? 7 + q : 32); }
        u.b = Bt + (size_t)u.pn * btile; u.e = 0; u.pos0 = 0; u.cnt = 0; return true; }
};
template <bool GATHER> struct MoeSched {
    int nN, G, c; const char* Wt; size_t wexp, btile; const LAS int* tab; const int* list;
    __device__ __forceinline__ bool next(int i, Unit& u) const {
        const int nwg = tab[33] * nN; const int Lx = i * G + c; if (Lx >= nwg) return false;
        const int w = xcd_remap(Lx, nwg); const int rt = w / nN; u.pn = w % nN; u.pm = rt;
        int e = 0; while (tab[e + 1] <= rt) ++e;
        u.e = e; u.pos0 = (rt - tab[e]) * BM; u.cnt = tab[64 + e]; u.b = Wt + (size_t)e * wexp + (size_t)u.pn * btile; return true; }
    __device__ __forceinline__ void aoff(const Unit& u, const int (&Rr)[2], const int (&Cc)[2], unsigned (&va)[2][2]) const {
#pragma unroll
        for (int h = 0; h < 2; ++h)
#pragma unroll
            for (int i = 0; i < 2; ++i) {
                if (GATHER) { const int pos = u.pos0 + h * HALF + Rr[i]; const int pair = pos < u.cnt ? list[u.e * CAP + pos] : 0; va[h][i] = (unsigned)((pair >> 2) * D + Cc[i]) * 2u; }
                else va[h][i] = (unsigned)((u.pm * BM + h * HALF + Rr[i]) * D + Cc[i]) * 2u; } }
};

template <class Epi, class Sched>
__device__ __forceinline__ void gemm_phase(LAS unsigned char* lds, const char* Abase, const int K, const Sched& S, const Epi& E) {
    const int tid = otid(), wid = __builtin_amdgcn_readfirstlane(tid >> 6), lane = tid & 63, wr = wid >> 2, wc = wid & 3, fr = lane & 15, fq = lane >> 4;
    const int nt = K / BK;
    int Rr[2], Cc[2]; unsigned voffB[2];
#pragma unroll
    for (int i = 0; i < 2; ++i) { int R_, C_; stage_rc(tid * 16 + i * 8192, R_, C_); Rr[i] = R_; Cc[i] = C_; const int Rb = Epi::PERM ? ((R_ & ~31) + perm32(R_ & 31)) : R_; voffB[i] = (unsigned)(Rb * K + C_) * 2u; }
    const size_t kstep = (size_t)(BK * 2);
    const size_t hstep = (size_t)HALF * K * 2;
    const unsigned ldsw = (unsigned)wid * 1024u;
    const int aoff = lds_byte(wr * 64 + fr, fq * 8), boff = lds_byte(wc * 32 + fr, fq * 8);
#define PG8_SA(b, h) (((b) * 2 + (h)) * HTB)
#define PG8_SB(b, h) ((4 + (b) * 2 + (h)) * HTB)
#define PG8_STAGE_B(bufoff, gbase) do { _Pragma("unroll") for (int _i = 0; _i < 2; ++_i) \
        __builtin_amdgcn_global_load_lds((const unsigned*)((const char*)(gbase) + voffB[_i]), (LAS unsigned*)(lds + (bufoff) + ldsw + _i * 8192), 16, 0, 0); } while (0)
#define PG8_STAGE_A(bufoff, v0, v1, kb) do { \
        __builtin_amdgcn_global_load_lds((const unsigned*)(Abase + (kb) + (v0)), (LAS unsigned*)(lds + (bufoff) + ldsw), 16, 0, 0); \
        __builtin_amdgcn_global_load_lds((const unsigned*)(Abase + (kb) + (v1)), (LAS unsigned*)(lds + (bufoff) + ldsw + 8192), 16, 0, 0); } while (0)
#define PG8_LDA(dst, b, h) do { _Pragma("unroll") for (int m = 0; m < 4; ++m) _Pragma("unroll") for (int k = 0; k < 2; ++k) dst[m][k] = *(const LAS bf16x8*)(lds + PG8_SA(b, h) + aoff + m * 2048 + k * 1024); } while (0)
#define PG8_LDB(dst, b, h) do { _Pragma("unroll") for (int n = 0; n < 2; ++n) _Pragma("unroll") for (int k = 0; k < 2; ++k) dst[n][k] = *(const LAS bf16x8*)(lds + PG8_SB(b, h) + boff + n * 2048 + k * 1024); } while (0)
#define PG8_MMA(ai, bj, At, Bt) do { __builtin_amdgcn_s_setprio(1); _Pragma("unroll") for (int m = 0; m < 4; ++m) _Pragma("unroll") for (int n = 0; n < 2; ++n) _Pragma("unroll") for (int k = 0; k < 2; ++k) \
        acc[ai][bj][m][n] = __builtin_amdgcn_mfma_f32_16x16x32_bf16(Bt[n][k], At[m][k], acc[ai][bj][m][n], 0, 0, 0); __builtin_amdgcn_s_setprio(0); } while (0)
#define PG8_WAIT_V(n) asm volatile("s_waitcnt vmcnt(" #n ")" ::: "memory")
#define PG8_WAIT_L(n) asm volatile("s_waitcnt lgkmcnt(" #n ")" ::: "memory")
#define PG8_BAR __builtin_amdgcn_s_barrier()
#define PG8_SCHED __builtin_amdgcn_sched_barrier(0)
    Unit cur, nxt; int ui = 0;
    if (!S.next(0, cur)) return;
    f32x4 acc[2][2][4][2];
#pragma unroll
    for (int a = 0; a < 2; ++a)
#pragma unroll
        for (int b = 0; b < 2; ++b)
#pragma unroll
            for (int m = 0; m < 4; ++m)
#pragma unroll
                for (int n = 0; n < 2; ++n) acc[a][b][m][n] = (f32x4){0.f, 0.f, 0.f, 0.f};
    bf16x8 At[4][2], B0[2][2], B1[2][2];
    unsigned vc[2][2], vn[2][2];
    S.aoff(cur, Rr, Cc, vc);
    const char* cB = cur.b;
    PG8_STAGE_B(PG8_SB(0, 0), cB); PG8_STAGE_A(PG8_SA(0, 0), vc[0][0], vc[0][1], 0); PG8_STAGE_B(PG8_SB(0, 1), cB + hstep); PG8_STAGE_A(PG8_SA(0, 1), vc[1][0], vc[1][1], 0);
    if (wr == 1) PG8_BAR;
    PG8_WAIT_V(4); PG8_BAR;
    PG8_STAGE_B(PG8_SB(1, 0), cB + kstep); PG8_STAGE_A(PG8_SA(1, 0), vc[0][0], vc[0][1], kstep); PG8_STAGE_B(PG8_SB(1, 1), cB + hstep + kstep);
    PG8_WAIT_V(6); PG8_BAR;
    for (;;) {
        const bool has_next = S.next(ui + 1, nxt);
        if (has_next) S.aoff(nxt, Rr, Cc, vn);
        else {
#pragma unroll
            for (int h = 0; h < 2; ++h)
#pragma unroll
                for (int i = 0; i < 2; ++i) vn[h][i] = vc[h][i]; }
        const char* nB = has_next ? nxt.b : cB;
        for (int t = 0; t < nt; t += 2) {
            const bool last = (t == nt - 2);
            const size_t k1 = (size_t)(t + 1) * kstep;
            const size_t k2 = last ? 0 : (size_t)(t + 2) * kstep;
            const unsigned s00 = last ? vn[0][0] : vc[0][0], s01 = last ? vn[0][1] : vc[0][1], s10 = last ? vn[1][0] : vc[1][0], s11 = last ? vn[1][1] : vc[1][1];
            const char* b2 = last ? nB : cB + (size_t)(t + 2) * kstep; const char* b3 = b2 + kstep;
            PG8_LDB(B0, 0, 0); PG8_SCHED; PG8_LDA(At, 0, 0); PG8_STAGE_A(PG8_SA(1, 1), vc[1][0], vc[1][1], k1);
            PG8_WAIT_L(8); PG8_BAR; PG8_WAIT_L(0); PG8_MMA(0, 0, At, B0); PG8_BAR; PG8_SCHED;
            PG8_LDB(B1, 0, 1); PG8_STAGE_B(PG8_SB(0, 0), b2);
            PG8_BAR; PG8_WAIT_L(0); PG8_MMA(0, 1, At, B1); PG8_BAR;
            PG8_LDA(At, 0, 1); PG8_STAGE_A(PG8_SA(0, 0), s00, s01, k2);
            PG8_BAR; PG8_WAIT_L(0); PG8_MMA(1, 0, At, B0); PG8_BAR; PG8_SCHED;
            PG8_STAGE_B(PG8_SB(0, 1), b2 + hstep);
            PG8_WAIT_V(6); PG8_BAR; PG8_MMA(1, 1, At, B1); PG8_BAR;
            PG8_LDB(B0, 1, 0); PG8_SCHED; PG8_LDA(At, 1, 0); PG8_STAGE_A(PG8_SA(0, 1), s10, s11, k2);
            PG8_WAIT_L(8); PG8_BAR; PG8_WAIT_L(0); PG8_MMA(0, 0, At, B0); PG8_BAR; PG8_SCHED;
            PG8_LDB(B1, 1, 1); PG8_STAGE_B(PG8_SB(1, 0), b3);
            PG8_BAR; PG8_WAIT_L(0); PG8_MMA(0, 1, At, B1); PG8_BAR;
            PG8_LDA(At, 1, 1); PG8_STAGE_A(PG8_SA(1, 0), s00, s01, k2 + kstep);
            PG8_BAR; PG8_WAIT_L(0); PG8_MMA(1, 0, At, B0); PG8_BAR; PG8_SCHED;
            PG8_STAGE_B(PG8_SB(1, 1), b3 + hstep);
            PG8_WAIT_V(6); PG8_BAR; PG8_MMA(1, 1, At, B1); PG8_BAR;
        }
        E(acc, cur, wr, wc, fr, fq);
        if (!has_next) break;
#pragma unroll
        for (int a = 0; a < 2; ++a)
#pragma unroll
            for (int b = 0; b < 2; ++b)
#pragma unroll
                for (int m = 0; m < 4; ++m)
#pragma unroll
                    for (int n = 0; n < 2; ++n) acc[a][b][m][n] = (f32x4){0.f, 0.f, 0.f, 0.f};
        cur = nxt; cB = nB; ++ui;
#pragma unroll
        for (int h = 0; h < 2; ++h)
#pragma unroll
            for (int i = 0; i < 2; ++i) vc[h][i] = vn[h][i];
    }
    PG8_WAIT_V(0);
    if (wr == 0) PG8_BAR;
    PG8_BAR;
#undef PG8_SA
#undef PG8_SB
#undef PG8_STAGE_A
#undef PG8_STAGE_B
#undef PG8_LDA
#undef PG8_LDB
#undef PG8_MMA
#undef PG8_WAIT_V
#undef PG8_WAIT_L
#undef PG8_BAR
#undef PG8_SCHED
}

typedef f32x4 Acc[2][2][4][2];
__device__ __forceinline__ u32x4 pack8(const f32x4 v0, const f32x4 v1) { u32x4 w; w.x = cvt_pk_bf16(v0[0], v0[1]); w.y = cvt_pk_bf16(v0[2], v0[3]); w.z = cvt_pk_bf16(v1[0], v1[1]); w.w = cvt_pk_bf16(v1[2], v1[3]); return w; }

struct EpiIn { static constexpr bool PERM = true; char* ws;
    __device__ __forceinline__ void operator()(const Acc& acc, const Unit& u, int wr, int wc, int fr, int fq) const {
        const int pn = u.pn; size_t boff; int ld, cb;
        if (pn < 3) { boff = OFF_QA; ld = 768; cb = pn * 256; } else if (pn == 3) { boff = OFF_CKV; ld = 256; cb = 0; }
        else if (pn < 32) { boff = OFF_HQ + (size_t)((pn - 4) >> 2) * SEG_STRIDE; ld = 1024; cb = ((pn - 4) & 3) * 256; }
        else { boff = OFF_KR; ld = 64; cb = 0; }
        bf16_t* base = (bf16_t*)(ws + boff);
        const int row0 = u.pm * BM + wr * 64 + fr, col0 = wc * 32 + 8 * fq;
        if (pn == 32 && wc >= 2) return;
        float* ssq = (float*)(ws + (pn < 3 ? OFF_SSQQ : OFF_SSQKV));
#pragma unroll
        for (int ai = 0; ai < 2; ++ai)
#pragma unroll
            for (int m = 0; m < 4; ++m) { const int row = row0 + ai * HALF + m * 16; bf16_t* rowp = base + (size_t)row * ld + cb + col0;
                f32x4 v0 = acc[ai][0][m][0], v1 = acc[ai][0][m][1];
                if (pn >= 4 && pn < 8) { f32x4 w0 = acc[ai][1][m][0], w1 = acc[ai][1][m][1];
#pragma unroll
                    for (int j = 0; j < 4; ++j) { v0[j] = siluf_(v0[j]) * 0.08838834764831845f; v1[j] = siluf_(v1[j]) * 0.08838834764831845f; w0[j] = siluf_(w0[j]) * 0.08838834764831845f; w1[j] = siluf_(w1[j]) * 0.08838834764831845f; }
                    *(u32x4*)rowp = pack8(v0, v1); *(u32x4*)(rowp + HALF) = pack8(w0, w1); continue; }
                *(u32x4*)rowp = pack8(v0, v1);
                if (pn != 32) { const f32x4 w0 = acc[ai][1][m][0], w1 = acc[ai][1][m][1]; *(u32x4*)(rowp + HALF) = pack8(w0, w1);
                    if (pn <= 3) { float ss = (v0[0] * v0[0] + v0[1] * v0[1]) + (v0[2] * v0[2] + v0[3] * v0[3]) + (v1[0] * v1[0] + v1[1] * v1[1]) + (v1[2] * v1[2] + v1[3] * v1[3])
                                          + (w0[0] * w0[0] + w0[1] * w0[1]) + (w0[2] * w0[2] + w0[3] * w0[3]) + (w1[0] * w1[0] + w1[1] * w1[1]) + (w1[2] * w1[2] + w1[3] * w1[3]);
                        ss += __shfl_xor(ss, 16); ss += __shfl_xor(ss, 32); if (fq == 0) atomicAdd(ssq + row, ss); } } }
    } };

struct EpiQ { static constexpr bool PERM = true; bf16_t* q; const float* ssq;
    __device__ __forceinline__ void operator()(const Acc& acc, const Unit& u, int wr, int wc, int fr, int fq) const {
        const int row0 = u.pm * BM + wr * 64 + fr, col0 = u.pn * BM + wc * 32 + 8 * fq;
#pragma unroll
        for (int ai = 0; ai < 2; ++ai)
#pragma unroll
            for (int m = 0; m < 4; ++m) { const int row = row0 + ai * HALF + m * 16; const float rs = rsqrtf(ssq[row] * (1.0f / 768.0f) + EPS); bf16_t* rowp = q + (size_t)row * 1536 + col0;
#pragma unroll
                for (int bj = 0; bj < 2; ++bj) *(u32x4*)(rowp + bj * HALF) = pack8(acc[ai][bj][m][0] * rs, acc[ai][bj][m][1] * rs); }
    } };

struct EpiKV { static constexpr bool PERM = true; bf16_t *Kb, *Vb; const float* ssq;
    __device__ __forceinline__ void operator()(const Acc& acc, const Unit& u, int wr, int wc, int fr, int fq) const {
        const int row0 = u.pm * BM + wr * 64 + fr, col0 = wc * 32 + 8 * fq;
#pragma unroll
        for (int ai = 0; ai < 2; ++ai)
#pragma unroll
            for (int m = 0; m < 4; ++m) { const int row = row0 + ai * HALF + m * 16; const float rs = rsqrtf(ssq[row] * (1.0f / 256.0f) + EPS);
                int b, pos; if (row < L) { b = row >> 11; pos = row & 2047; } else { b = (row - L) >> 8; pos = SEQ + ((row - L) & 255); }
                const size_t kvrow = (size_t)(b * 8 + u.pn) * NKEY + pos;
                *(u32x4*)(Kb + kvrow * 192 + col0) = pack8(acc[ai][0][m][0] * rs, acc[ai][0][m][1] * rs);
                *(u32x4*)(Vb + kvrow * 128 + col0) = pack8(acc[ai][1][m][0] * rs, acc[ai][1][m][1] * rs); }
    } };

struct EpiOut { static constexpr bool PERM = false; float* x1; const float* x; const float* modv;
    __device__ __forceinline__ void operator()(const Acc& acc, const Unit& u, int wr, int wc, int fr, int fq) const {
        const int row0 = u.pm * BM + wr * 64 + fr, col0 = u.pn * BM + wc * 32 + 4 * fq;
#pragma unroll
        for (int ai = 0; ai < 2; ++ai)
#pragma unroll
            for (int m = 0; m < 4; ++m) { const int row = row0 + ai * HALF + m * 16; const float* gate = modv + (row >> 11) * 6144 + 2 * 1024 + col0; const float* xr = x + (size_t)row * D + col0; float* o = x1 + (size_t)row * D + col0;
#pragma unroll
                for (int bj = 0; bj < 2; ++bj)
#pragma unroll
                    for (int n = 0; n < 2; ++n) { const int co = bj * HALF + n * 16; const f32x4 g = *(const f32x4*)(gate + co), xv = *(const f32x4*)(xr + co); *(f32x4*)(o + co) = xv + g * acc[ai][bj][m][n]; } }
    } };

struct EpiMoe1 { static constexpr bool PERM = true; bf16_t* act; const float* bgu;
    __device__ __forceinline__ void operator()(const Acc& acc, const Unit& u, int wr, int wc, int fr, int fq) const {
        const int row0 = u.pm * BM + wr * 64 + fr, o0 = u.pn * 128 + wc * 16 + 4 * fq;
        f32x4 bg[2], bl[2];
#pragma unroll
        for (int bj = 0; bj < 2; ++bj) { const float* bp = bgu + u.e * 2048 + 2 * (o0 + bj * 64); const f32x4 t0 = *(const f32x4*)bp, t1 = *(const f32x4*)(bp + 4);
            bg[bj] = (f32x4){t0[0], t0[2], t1[0], t1[2]}; bl[bj] = (f32x4){t0[1], t0[3], t1[1], t1[3]}; }
#pragma unroll
        for (int ai = 0; ai < 2; ++ai)
#pragma unroll
            for (int m = 0; m < 4; ++m) { const int row = row0 + ai * HALF + m * 16; bf16_t* rowp = act + (size_t)row * D + o0;
#pragma unroll
                for (int bj = 0; bj < 2; ++bj) { const f32x4 g4 = acc[ai][bj][m][0] + bg[bj], l4 = acc[ai][bj][m][1] + bl[bj]; float r[4];
#pragma unroll
                    for (int j = 0; j < 4; ++j) { const float glu = fminf(g4[j], 7.0f), lin = __builtin_amdgcn_fmed3f(l4[j], -7.0f, 7.0f); r[j] = glu * __builtin_amdgcn_rcpf(1.0f + __builtin_amdgcn_exp2f(-2.4554669595930157f * glu)) * (lin + 1.0f); }
                    u32x2 w; w.x = cvt_pk_bf16(r[0], r[1]); w.y = cvt_pk_bf16(r[2], r[3]); *(u32x2*)(rowp + bj * 64) = w; } }
    } };

struct EpiMoe2 { static constexpr bool PERM = true; bf16_t* yp; const float* bd; const int* list;
    __device__ __forceinline__ void operator()(const Acc& acc, const Unit& u, int wr, int wc, int fr, int fq) const {
        const int r0 = wr * 64 + fr, col0 = u.pn * BM + wc * 32 + 8 * fq;
        f32x4 bv[2][2];
#pragma unroll
        for (int bj = 0; bj < 2; ++bj)
#pragma unroll
            for (int n = 0; n < 2; ++n) bv[bj][n] = *(const f32x4*)(bd + u.e * 1024 + col0 + bj * HALF + 4 * n);
#pragma unroll
        for (int ai = 0; ai < 2; ++ai)
#pragma unroll
            for (int m = 0; m < 4; ++m) { const int pos = u.pos0 + r0 + ai * HALF + m * 16; if (pos < u.cnt) { const int pair = list[u.e * CAP + pos]; bf16_t* rowp = yp + (size_t)pair * D + col0;
#pragma unroll
                for (int bj = 0; bj < 2; ++bj) *(u32x4*)(rowp + bj * HALF) = pack8(acc[ai][bj][m][0] + bv[bj][0], acc[ai][bj][m][1] + bv[bj][1]); } }
    } };
}

__device__ __forceinline__ int conv_src_col(int kind, int c) {
    if (kind == 0) return c;
    if (kind == 1) { if (c < 1024) return c; if (c < 8192) return c + 64; if (c < 8256) return c - 8192 + 1024; return -1; }
    const int pn = c >> 8, p = c & 255, bj = p >> 7, wc = (p >> 5) & 3, fq = (p >> 3) & 3, n = (p >> 2) & 1, i = p & 3; const int o = 128 * pn + 64 * bj + 16 * wc + 4 * fq + i; return 2 * o + n;
}
__device__ __forceinline__ void conv_tile(LAS float* tl, const float* __restrict__ W, int ldw, bf16_t* Wt, int K, int kind, const float* __restrict__ kscale, int k0, int c0) {
    const int tid = otid(); const int cc = tid & 127, kq = tid >> 7, sc = conv_src_col(kind, c0 + cc);
    float v[32];
#pragma unroll
    for (int i = 0; i < 32; ++i) { const int kk = kq + 4 * i; v[i] = sc >= 0 ? W[(size_t)(k0 + kk) * ldw + sc] : 0.f; }
    if (kscale) {
#pragma unroll
        for (int i = 0; i < 32; ++i) v[i] *= kscale[k0 + kq + 4 * i]; }
#pragma unroll
    for (int i = 0; i < 32; ++i) tl[(kq + 4 * i) * 129 + cc] = v[i];
    __syncthreads();
    { const int c2 = tid >> 2, kb = (tid & 3) * 8; bf16_t* dst = Wt + (size_t)(c0 + c2) * K + k0 + kb;
#pragma unroll
      for (int q = 0; q < 4; ++q) { float t[8];
#pragma unroll
          for (int j = 0; j < 8; ++j) t[j] = tl[(q * 32 + kb + j) * 129 + c2];
          u32x4 w; w.x = cvt_pk_bf16(t[0], t[1]); w.y = cvt_pk_bf16(t[2], t[3]); w.z = cvt_pk_bf16(t[4], t[5]); w.w = cvt_pk_bf16(t[6], t[7]);
          *(u32x4*)(dst + q * 32) = w; } }
    __syncthreads();
}
__device__ __forceinline__ void conv_matrix(LAS float* tl, const float* W, int ldw, bf16_t* Wt, int K, int Nout, int kind, const float* kscale, int& tctr) {
    const int nk = K / 128, ntile = nk * (Nout / 128);
    int t = ((int)blockIdx.x - tctr) % (int)gridDim.x; if (t < 0) t += gridDim.x;
    for (; t < ntile; t += gridDim.x) conv_tile(tl, W, ldw, Wt, K, kind, kscale, (t % nk) * 128, (t / nk) * 128);
    tctr = (tctr + ntile) % (int)gridDim.x;
}

__device__ __forceinline__ float half_sum256(float v, LAS float* red) {
    for (int o = 32; o > 0; o >>= 1) v += __shfl_xor(v, o);
    const int w = otid() >> 6, hb = (otid() >> 8) * 4; if ((otid() & 63) == 0) red[w] = v; __syncthreads();
    const float t = red[hb] + red[hb + 1] + red[hb + 2] + red[hb + 3]; __syncthreads(); return t;
}

__device__ __forceinline__ void phase0(const Params& p, LAS unsigned char* lds) {
    char* ws = p.ws; const int tid = otid(), gsz = gridDim.x * 512, gid = blockIdx.x * 512 + tid;
    float* lb = (float*)(ws + OFF_LB); int* cnt = (int*)(ws + OFF_CNT); float* ssqq = (float*)(ws + OFF_SSQQ); float* ssqkv = (float*)(ws + OFF_SSQKV); float* modv = (float*)(ws + OFF_MOD);
    for (int i = gid; i < 2048; i += gsz) { const int d = i >> 10, j = i & 1023; const float a = p.lbl[(d * 2 + 0) * 1024 + j], b = p.lbl[(d * 2 + 1) * 1024 + j]; lb[i] = 1.0f / (1.0f + __expf(b - a)); }
    for (int i = gid; i < 32; i += gsz) cnt[i] = 0;
    { float* ropet = (float*)(ws + OFF_ROPE); for (int i = gid; i < SEQ * 32; i += gsz) { const int t = i >> 5, j = i & 31; float cs, sn; rope_cs(t, j, cs, sn); ropet[t * 64 + j] = cs; ropet[t * 64 + 32 + j] = sn; } }
    for (int i = gid; i < L; i += gsz) ssqq[i] = 0.f;
    for (int i = gid; i < R; i += gsz) ssqkv[i] = 0.f;
    { LAS float* sil = (LAS float*)lds;
      LAS float* part = (LAS float*)(lds + 17 * 1024 * 4);
      bool loaded = false;
      for (int item = blockIdx.x; item < 96; item += gridDim.x) {
          if (!loaded) { for (int i = tid; i < 17 * 1024; i += 512) { const int r = i >> 10, k = i & 1023; sil[i] = siluf_(r < 16 ? p.c[r * 1024 + k] : p.cctx[k]); } loaded = true; __syncthreads(); }
          const int j = tid & 63, ks = tid >> 6; float a[17];
#pragma unroll
          for (int r = 0; r < 17; ++r) a[r] = 0.f;
          for (int k = ks * 128; k < ks * 128 + 128; ++k) { const float w = p.w_mod[(size_t)k * 6144 + item * 64 + j];
#pragma unroll
              for (int r = 0; r < 17; ++r) a[r] += sil[r * 1024 + k] * w; }
#pragma unroll
          for (int r = 0; r < 17; ++r) part[(ks * 17 + r) * 64 + j] = a[r];
          __syncthreads();
          for (int i = tid; i < 17 * 64; i += 512) { const int r = i >> 6, jj = i & 63; float s = p.b_mod[item * 64 + jj]; for (int q = 0; q < 8; ++q) s += part[(q * 17 + r) * 64 + jj]; modv[r * 6144 + item * 64 + jj] = s; }
          __syncthreads();
      } }
    __syncthreads();
    { LAS float* tl = (LAS float*)lds; int tctr = 0;
      conv_matrix(tl, p.w_in, 8256, (bf16_t*)(ws + OFF_WT_IN), 1024, 8448, 1, nullptr, tctr);
      conv_matrix(tl, p.w_qb, 1536, (bf16_t*)(ws + OFF_WT_QB), 768, 1536, 0, p.g_q, tctr);
      conv_matrix(tl, p.w_kvb, 2048, (bf16_t*)(ws + OFF_WT_KVB), 256, 2048, 0, p.g_kv, tctr);
      conv_matrix(tl, p.w_out, 1024, (bf16_t*)(ws + OFF_WT_OUT), 1024, 1024, 0, nullptr, tctr); }
}

__device__ __forceinline__ float wave_sum(float v) {
#pragma unroll
    for (int o = 32; o > 0; o >>= 1) v += __shfl_xor(v, o);
    return v; }
__device__ __forceinline__ void phase1(const Params& p, LAS unsigned char* lds) {
    const float* modv = (const float*)(p.ws + OFF_MOD); bf16_t* h = (bf16_t*)(p.ws + OFF_H);
    const int tid = otid(), lane = tid & 63, gw = blockIdx.x * 8 + (tid >> 6), nw = gridDim.x * 8, c0 = lane * 8;
    f32x4 g[4];
#pragma unroll
    for (int q = 0; q < 4; ++q) g[q] = *(const f32x4*)(p.g_mix + (q >> 1) * 512 + c0 + (q & 1) * 4);
    for (int row0 = gw; row0 < R; row0 += 2 * nw) {
        f32x4 v[2][4]; const bool two = row0 + nw < R;
#pragma unroll
        for (int u = 0; u < 2; ++u) { const int row = (u == 0 || two) ? row0 + u * nw : row0; const float* src = row < L ? p.x + (size_t)row * D : p.ctx + (size_t)(row - L) * D;
#pragma unroll
            for (int q = 0; q < 4; ++q) v[u][q] = *(const f32x4*)(src + (q >> 1) * 512 + c0 + (q & 1) * 4); }
#pragma unroll
        for (int u = 0; u < 2; ++u) { if (u == 1 && !two) break; const int row = row0 + u * nw; const float* mod = modv + (row < L ? row / SEQ : 16) * 6144;
            float ss = 0.f;
#pragma unroll
            for (int q = 0; q < 4; ++q) ss += (v[u][q][0] * v[u][q][0] + v[u][q][1] * v[u][q][1]) + (v[u][q][2] * v[u][q][2] + v[u][q][3] * v[u][q][3]);
            const float rs = rsqrtf(wave_sum(ss) * (1.0f / D) + EPS);
#pragma unroll
            for (int j = 0; j < 2; ++j) { f32x4 o[2];
#pragma unroll
                for (int e = 0; e < 2; ++e) { const int cc = j * 512 + c0 + e * 4; const f32x4 sc = *(const f32x4*)(mod + 1024 + cc), sh = *(const f32x4*)(mod + cc); o[e] = v[u][j * 2 + e] * rs * g[j * 2 + e] * (sc + 1.0f) + sh; }
                u32x4 w; w.x = cvt_pk_bf16(o[0][0], o[0][1]); w.y = cvt_pk_bf16(o[0][2], o[0][3]); w.z = cvt_pk_bf16(o[1][0], o[1][1]); w.w = cvt_pk_bf16(o[1][2], o[1][3]);
                *(u32x4*)(h + (size_t)row * D + j * 512 + c0) = w; } }
    }
}

__device__ __forceinline__ SegOut make_seg(char* ws) { SegOut so; so.qa = (bf16_t*)(ws + OFF_QA); so.ckv = (bf16_t*)(ws + OFF_CKV); so.kr = (bf16_t*)(ws + OFF_KR); so.hq = (bf16_t*)(ws + OFF_HQ); so.ff = (bf16_t*)(ws + OFF_FF);
    so.fb = (bf16_t*)(ws + OFF_FB); so.iv = (bf16_t*)(ws + OFF_IV); so.og = (bf16_t*)(ws + OFF_OG); so.gm = (bf16_t*)(ws + OFF_GM); so.gh = (bf16_t*)(ws + OFF_GH); return so; }

__device__ __forceinline__ void phase2(const Params& p, LAS unsigned char* lds) {
    pg8::InSched S; S.init2(p.ws + OFF_WT_IN, gridDim.x, blockIdx.x);
    pg8::EpiIn E{p.ws};
    pg8::gemm_phase(lds, (const char*)(p.ws + OFF_H), 1024, S, E);
}
__device__ __forceinline__ void phase3(const Params& p, LAS unsigned char* lds) {
    char* ws = p.ws;
    { pg8::DenseSched S; S.init(L, 1536, 768, 768, ws + OFF_WT_QB, gridDim.x, blockIdx.x); pg8::EpiQ E{(bf16_t*)(ws + OFF_Q), (const float*)(ws + OFF_SSQQ)}; pg8::gemm_phase(lds, (const char*)(ws + OFF_QA), 768, S, E); }
    { pg8::DenseSched S; S.init(R, 2048, 256, 256, ws + OFF_WT_KVB, gridDim.x, blockIdx.x); pg8::EpiKV E{(bf16_t*)(ws + OFF_K), (bf16_t*)(ws + OFF_V), (const float*)(ws + OFF_SSQKV)}; pg8::gemm_phase(lds, (const char*)(ws + OFF_CKV), 256, S, E); }
    { const bf16_t* kr = (const bf16_t*)(ws + OFF_KR); bf16_t* Kb = (bf16_t*)(ws + OFF_K); const float* ropet = (const float*)(ws + OFF_ROPE);
      for (int gid = blockIdx.x * 512 + otid(); gid < R * 32; gid += gridDim.x * 512) { const int row = gid >> 5, i = gid & 31;
          const float x1 = bf2f(kr[(size_t)row * 64 + i]), x2 = bf2f(kr[(size_t)row * 64 + 32 + i]); float o1 = x1, o2 = x2; int b, pos;
          if (row < L) { b = row / SEQ; pos = row % SEQ; const float cs = ropet[pos * 64 + i], sn = ropet[pos * 64 + 32 + i]; o1 = x1 * cs - x2 * sn; o2 = x1 * sn + x2 * cs; } else { b = (row - L) / CTXL; pos = SEQ + (row - L) % CTXL; }
          const bf16_t w1 = f2bf(o1), w2 = f2bf(o2);
          for (int h = 0; h < 8; ++h) { bf16_t* q = Kb + ((size_t)(b * 8 + h) * NKEY + pos) * 192 + 128; q[i] = w1; q[32 + i] = w2; } } }
}
__device__ __forceinline__ void unpack8(const u32x4 w, float (&o)[8]) {
    o[0] = __uint_as_float(w.x << 16); o[1] = __uint_as_float(w.x & 0xffff0000u); o[2] = __uint_as_float(w.y << 16); o[3] = __uint_as_float(w.y & 0xffff0000u);
    o[4] = __uint_as_float(w.z << 16); o[5] = __uint_as_float(w.z & 0xffff0000u); o[6] = __uint_as_float(w.w << 16); o[7] = __uint_as_float(w.w & 0xffff0000u); }
__device__ __forceinline__ void phase4(const Params& p, LAS unsigned char*) {
    char* ws = p.ws; bf16_t* y = (bf16_t*)(ws + OFF_H); const bf16_t* of = (const bf16_t*)(ws + OFF_OF); const bf16_t* ob = (const bf16_t*)(ws + OFF_OB);
    const bf16_t* og = (const bf16_t*)(ws + OFF_OG); const bf16_t* gm = (const bf16_t*)(ws + OFF_GM); const bf16_t* gh = (const bf16_t*)(ws + OFF_GH);
    const int tid = otid(), lane = tid & 63, gw = blockIdx.x * 8 + (tid >> 6), nw = gridDim.x * 8, c0 = lane * 8;
    float gg[8];
#pragma unroll
    for (int i = 0; i < 8; ++i) gg[i] = p.g_hg[(c0 + i) & 127];
    for (int row = gw; row < L; row += nw) {
        u32x4 ra[2], rb[2], r1[2], r2[2], r3[2], rm[2];
#pragma unroll
        for (int j = 0; j < 2; ++j) { const size_t off = (size_t)row * D + j * 512 + c0; ra[j] = *(const u32x4*)(of + off); rb[j] = *(const u32x4*)(ob + off); r1[j] = *(const u32x4*)(og + off); r2[j] = *(const u32x4*)(gm + off); r3[j] = *(const u32x4*)(gh + off); rm[j] = *(const u32x4*)(y + off); }
#pragma unroll
        for (int j = 0; j < 2; ++j) { float a[8], b[8], g1[8], g2[8], g3[8], ym[8], o[8]; unpack8(ra[j], a); unpack8(rb[j], b); unpack8(r1[j], g1); unpack8(r2[j], g2); unpack8(r3[j], g3); unpack8(rm[j], ym);
            float ss = 0.f;
#pragma unroll
            for (int i = 0; i < 8; ++i) { o[i] = a[i] + b[i]; ss += o[i] * o[i]; }
            ss += __shfl_xor(ss, 1); ss += __shfl_xor(ss, 2); ss += __shfl_xor(ss, 4); ss += __shfl_xor(ss, 8);
            const float rs = rsqrtf(ss * (1.0f / 128.0f) + EPS); float r[8];
#pragma unroll
            for (int i = 0; i < 8; ++i) { const float yh = o[i] * rs * gg[i] * siluf_(g1[i]); r[i] = sigmoidf_(g2[i]) * ym[i] + sigmoidf_(g3[i]) * yh; }
            u32x4 w; w.x = cvt_pk_bf16(r[0], r[1]); w.y = cvt_pk_bf16(r[2], r[3]); w.z = cvt_pk_bf16(r[4], r[5]); w.w = cvt_pk_bf16(r[6], r[7]);
            *(u32x4*)(y + (size_t)row * D + j * 512 + c0) = w; }
    }
}
__device__ __forceinline__ void phase5(const Params& p, LAS unsigned char* lds) {
    char* ws = p.ws;
    { pg8::DenseSched S; S.init(L, 1024, 1024, 1024, ws + OFF_WT_OUT, gridDim.x, blockIdx.x); pg8::EpiOut E{p.out, p.x, (const float*)(ws + OFF_MOD)}; pg8::gemm_phase(lds, (const char*)(ws + OFF_H), 1024, S, E); }
    { LAS float* tl = (LAS float*)lds; int tctr = 0;
      for (int e = 0; e < NE; ++e) conv_matrix(tl, p.w_gu + (size_t)e * 1024 * 2048, 2048, (bf16_t*)(ws + OFF_WT_GU) + (size_t)e * 2048 * 1024, 1024, 2048, 2, nullptr, tctr);
      for (int e = 0; e < NE; ++e) conv_matrix(tl, p.w_dn + (size_t)e * 1024 * 1024, 1024, (bf16_t*)(ws + OFF_WT_DN) + (size_t)e * 1024 * 1024, 1024, 1024, 0, nullptr, tctr); }
}
__device__ __forceinline__ void phase6(const Params& p, LAS unsigned char* lds) {
    char* ws = p.ws; const float* modv = (const float*)(ws + OFF_MOD); bf16_t* h2 = (bf16_t*)(ws + OFF_H); int* topi = (int*)(ws + OFF_TOPI); float* topp = (float*)(ws + OFF_TOPP); int* cnt = (int*)(ws + OFF_CNT); int* list = (int*)(ws + OFF_LIST);
    LAS float* hs = (LAS float*)lds;
    LAS float* lg = (LAS float*)(lds + 131072);
    LAS int* lcnt = (LAS int*)(lds + 131072 + 4096);
    LAS int* lent = (LAS int*)(lds + 131072 + 4096 + 512);
    const int tid = otid(), lane = tid & 63, wid = tid >> 6, c0 = lane * 8;
    if (tid < 96) lcnt[tid] = 0;
    f32x4 g[4];
#pragma unroll
    for (int q = 0; q < 4; ++q) g[q] = *(const f32x4*)(p.g_ffn + (q >> 1) * 512 + c0 + (q & 1) * 4);
    __syncthreads();
    int it = 0;
    for (int tile = blockIdx.x; tile < L / 32; tile += gridDim.x, ++it) {
        const int rbase = tile * 32;
        f32x4 v[4][4];
#pragma unroll
        for (int u = 0; u < 4; ++u)
#pragma unroll
            for (int q = 0; q < 4; ++q) v[u][q] = *(const f32x4*)(p.out + (size_t)(rbase + wid * 4 + u) * D + (q >> 1) * 512 + c0 + (q & 1) * 4);
#pragma unroll
        for (int u = 0; u < 4; ++u) { const int rl = wid * 4 + u, row = rbase + rl; const float* mod = modv + (row / SEQ) * 6144; float ss = 0.f;
#pragma unroll
            for (int q = 0; q < 4; ++q) ss += (v[u][q][0] * v[u][q][0] + v[u][q][1] * v[u][q][1]) + (v[u][q][2] * v[u][q][2] + v[u][q][3] * v[u][q][3]);
            const float rs = rsqrtf(wave_sum(ss) * (1.0f / D) + EPS);
#pragma unroll
            for (int j = 0; j < 2; ++j) { f32x4 o[2];
#pragma unroll
                for (int e = 0; e < 2; ++e) { const int cc = j * 512 + c0 + e * 4; const f32x4 sc = *(const f32x4*)(mod + 4 * 1024 + cc), sh = *(const f32x4*)(mod + 3 * 1024 + cc); o[e] = v[u][j * 2 + e] * rs * g[j * 2 + e] * (sc + 1.0f) + sh;
                    *(LAS f32x4*)(hs + rl * 1024 + cc) = o[e]; }
                u32x4 w; w.x = cvt_pk_bf16(o[0][0], o[0][1]); w.y = cvt_pk_bf16(o[0][2], o[0][3]); w.z = cvt_pk_bf16(o[1][0], o[1][1]); w.w = cvt_pk_bf16(o[1][2], o[1][3]);
                *(u32x4*)(h2 + (size_t)row * D + j * 512 + c0) = w; } }
        __syncthreads();
        { const int e = tid & 31, rg = tid >> 5; const LAS float* h0 = hs + (2 * rg) * 1024; const LAS float* h1 = h0 + 1024; float a0 = 0.f, a1 = 0.f;
          for (int j = 0; j < 1024; j += 8) { float w[8];
#pragma unroll
              for (int q = 0; q < 8; ++q) w[q] = p.w_r[(j + q) * 32 + e];
              const f32x4 x0 = *(const LAS f32x4*)(h0 + j), x1 = *(const LAS f32x4*)(h0 + j + 4), y0 = *(const LAS f32x4*)(h1 + j), y1 = *(const LAS f32x4*)(h1 + j + 4);
              a0 += x0[0] * w[0]; a0 += x0[1] * w[1]; a0 += x0[2] * w[2]; a0 += x0[3] * w[3]; a0 += x1[0] * w[4]; a0 += x1[1] * w[5]; a0 += x1[2] * w[6]; a0 += x1[3] * w[7];
              a1 += y0[0] * w[0]; a1 += y0[1] * w[1]; a1 += y0[2] * w[2]; a1 += y0[3] * w[3]; a1 += y1[0] * w[4]; a1 += y1[1] * w[5]; a1 += y1[2] * w[6]; a1 += y1[3] * w[7]; }
          const float be = p.b_r[e]; lg[(2 * rg) * 32 + e] = a0 + be; lg[(2 * rg + 1) * 32 + e] = a1 + be; }
        __syncthreads();
#pragma unroll
        for (int rep = 0; rep < 2; ++rep) { const int rl = wid * 4 + rep * 2 + (lane >> 5), row = rbase + rl, e = lane & 31; float cur = lg[rl * 32 + e];
            float tv0 = 0.f, sum = 0.f; int sel_i[4]; float sel_e[4];
#pragma unroll
            for (int k = 0; k < 4; ++k) { float m = cur; int mi = e;
#pragma unroll
                for (int o2 = 16; o2 > 0; o2 >>= 1) { const float om = __shfl_xor(m, o2); const int oi = __shfl_xor(mi, o2); if (om > m || (om == m && oi < mi)) { m = om; mi = oi; } }
                if (k == 0) tv0 = m; sel_i[k] = mi; sel_e[k] = __expf(m - tv0); sum += sel_e[k]; if (e == mi) cur = -3.0e38f; }
            int myk = 0; float myp = 0.f;
#pragma unroll
            for (int k = 0; k < 4; ++k) if (e == k) { myk = sel_i[k]; myp = sel_e[k] / sum; }
            if (e < 4) { const int pair = row * 4 + e; topi[pair] = myk; topp[pair] = myp; __hip_atomic_fetch_add(&lcnt[myk], 1, __ATOMIC_RELAXED, __HIP_MEMORY_SCOPE_WORKGROUP); lent[(it * 32 + rl) * 4 + e] = myk; } }
        __syncthreads();
    }
    if (tid < 32) { const int n = lcnt[tid]; lcnt[32 + tid] = n > 0 ? atomicAdd(&cnt[tid], n) : 0; lcnt[64 + tid] = 0; }
    __syncthreads();
    const int nent = it * 128;
    for (int s = tid; s < nent; s += 512) { const int e = lent[s]; const int ii = s >> 7, rl = (s >> 2) & 31, k = s & 3; const int row = (blockIdx.x + ii * gridDim.x) * 32 + rl;
        const int pos = lcnt[32 + e] + __hip_atomic_fetch_add(&lcnt[64 + e], 1, __ATOMIC_RELAXED, __HIP_MEMORY_SCOPE_WORKGROUP); list[e * CAP + pos] = row * 4 + k; }
}
__device__ __forceinline__ void moe_table(const int* cnt, LAS int* tab) {
    if (otid() == 0) { int t = 0; for (int e = 0; e < NE; ++e) { tab[e] = t; const int n = cnt[e]; tab[64 + e] = n; t += (n + 255) >> 8; } tab[32] = t; tab[33] = t; }
    __syncthreads();
}
constexpr int LDS_TAB = pg8::STAGE_BYTES;
__device__ __forceinline__ void phase7(const Params& p, LAS unsigned char* lds) {
    char* ws = p.ws; LAS int* tab = (LAS int*)(lds + LDS_TAB); moe_table((const int*)(ws + OFF_CNT), tab);
    pg8::MoeSched<true> S; S.nN = 8; S.G = gridDim.x; S.c = blockIdx.x; S.Wt = ws + OFF_WT_GU; S.wexp = (size_t)2048 * 1024 * 2; S.btile = (size_t)256 * 1024 * 2; S.tab = tab; S.list = (const int*)(ws + OFF_LIST);
    pg8::EpiMoe1 E{(bf16_t*)(ws + OFF_ACT), p.b_gu};
    pg8::gemm_phase(lds, (const char*)(ws + OFF_H), 1024, S, E);
}
__device__ __forceinline__ void phase8(const Params& p, LAS unsigned char* lds) {
    char* ws = p.ws; LAS int* tab = (LAS int*)(lds + LDS_TAB); moe_table((const int*)(ws + OFF_CNT), tab);
    pg8::MoeSched<false> S; S.nN = 4; S.G = gridDim.x; S.c = blockIdx.x; S.Wt = ws + OFF_WT_DN; S.wexp = (size_t)1024 * 1024 * 2; S.btile = (size_t)256 * 1024 * 2; S.tab = tab; S.list = (const int*)(ws + OFF_LIST);
    pg8::EpiMoe2 E{(bf16_t*)(ws + OFF_YP), p.b_dn, (const int*)(ws + OFF_LIST)};
    pg8::gemm_phase(lds, (const char*)(ws + OFF_ACT), 1024, S, E);
}
__device__ __forceinline__ void phase9(const Params& p, LAS unsigned char* lds) {
    char* ws = p.ws; const float* modv = (const float*)(ws + OFF_MOD); const bf16_t* yp = (const bf16_t*)(ws + OFF_YP); const float* topp = (const float*)(ws + OFF_TOPP);
    const int tid = otid(), lane = tid & 63, gw = blockIdx.x * 8 + (tid >> 6), nw = gridDim.x * 8, c0 = lane * 8;
    f32x4 fg[4];
#pragma unroll
    for (int q = 0; q < 4; ++q) fg[q] = *(const f32x4*)(p.g_fin + (q >> 1) * 512 + c0 + (q & 1) * 4);
    for (int row = gw; row < L; row += nw) {
        const float* gate = modv + (row / SEQ) * 6144 + 5 * 1024; f32x4 v[4]; u32x4 yr[4][2];
#pragma unroll
        for (int q = 0; q < 4; ++q) v[q] = *(const f32x4*)(p.out + (size_t)row * D + (q >> 1) * 512 + c0 + (q & 1) * 4);
#pragma unroll
        for (int k = 0; k < 4; ++k)
#pragma unroll
            for (int j = 0; j < 2; ++j) yr[k][j] = *(const u32x4*)(yp + (size_t)(row * 4 + k) * D + j * 512 + c0);
        const f32x4 pk = *(const f32x4*)(topp + row * 4);
        float m[16];
#pragma unroll
        for (int i = 0; i < 16; ++i) m[i] = 0.f;
#pragma unroll
        for (int k = 0; k < 4; ++k)
#pragma unroll
            for (int j = 0; j < 2; ++j) { float t[8]; unpack8(yr[k][j], t);
#pragma unroll
                for (int i = 0; i < 8; ++i) m[j * 8 + i] += pk[k] * t[i]; }
        float ss = 0.f;
#pragma unroll
        for (int q = 0; q < 4; ++q) { const f32x4 gt = *(const f32x4*)(gate + (q >> 1) * 512 + c0 + (q & 1) * 4);
#pragma unroll
            for (int i = 0; i < 4; ++i) { v[q][i] += gt[i] * m[q * 4 + i]; ss += v[q][i] * v[q][i]; } }
        const float rs = rsqrtf(wave_sum(ss) * (1.0f / D) + EPS);
#pragma unroll
        for (int q = 0; q < 4; ++q) *(f32x4*)(p.out + (size_t)row * D + (q >> 1) * 512 + c0 + (q & 1) * 4) = v[q] * rs * fg[q];
    }
}

namespace at {
using s16x4  = __attribute__((ext_vector_type(4))) short;
using f32x16 = __attribute__((ext_vector_type(16))) float;
constexpr int NW = 8, QBLK = 32, KVBLK = 64, DK = 192, DV = 128;
constexpr float SCALE = 0.07216878364870322f;
constexpr float THR = 8.f;
constexpr int SHM_V = KVBLK * DV * 2, SHM_K = KVBLK * DK * 2, SHM_ATTN = 2 * SHM_V + 2 * SHM_K + NW * 64 * 4;
#define KSWZ(row, colB) ((row) * 384 + ((colB) ^ (((row) & 7) << 4)))
#define SBAR() __builtin_amdgcn_sched_barrier(0)
__device__ __forceinline__ int crow(int r, int hi) { return (r & 3) + 8 * (r >> 2) + 4 * hi; }
__device__ __forceinline__ unsigned cvtpk(float lo, float hi) { return cvt_pk_bf16(lo, hi); }

__device__ __forceinline__ void partialSM(f32x16& p0, f32x16& p1, float& m_reg, float& mn, float& alpha) {
  constexpr float C = SCALE * 1.4426950408889634f;
  float pmax = p0[0];
#pragma unroll
  for (int r = 1; r < 16; ++r) pmax = fmaxf(pmax, p0[r]);
#pragma unroll
  for (int r = 0; r < 16; ++r) pmax = fmaxf(pmax, p1[r]);
  { auto rr = __builtin_amdgcn_permlane32_swap(__float_as_uint(pmax), __float_as_uint(pmax), false, false);
    pmax = fmaxf(__uint_as_float(rr[0]), __uint_as_float(rr[1])); }
  if (__builtin_expect(__all(pmax - m_reg <= THR / SCALE), 1)) { mn = m_reg; alpha = 1.f; }
  else { mn = fmaxf(m_reg, pmax); alpha = __builtin_amdgcn_exp2f((m_reg - mn) * C); m_reg = mn; }
  float mnC = -mn * C;
#pragma unroll
  for (int r = 0; r < 16; ++r) p0[r] = fmaf(p0[r], C, mnC);
#pragma unroll
  for (int r = 0; r < 16; ++r) p1[r] = fmaf(p1[r], C, mnC);
#pragma unroll
  for (int r = 0; r < 16; ++r) p0[r] = __builtin_amdgcn_exp2f(p0[r]);
}
__device__ __forceinline__ void finishSM(f32x16& p0, f32x16& p1, float alpha, float& l_reg, bf16x8& pa0, bf16x8& pa1, bf16x8& pa2, bf16x8& pa3) {
#pragma unroll
  for (int r = 0; r < 16; ++r) p1[r] = __builtin_amdgcn_exp2f(p1[r]);
  float ps = 0;
#pragma unroll
  for (int r = 0; r < 16; ++r) ps += p0[r];
#pragma unroll
  for (int r = 0; r < 16; ++r) ps += p1[r];
  { auto rr = __builtin_amdgcn_permlane32_swap(__float_as_uint(ps), __float_as_uint(ps), false, false);
    ps = __uint_as_float(rr[0]) + __uint_as_float(rr[1]); }
  l_reg = l_reg * alpha + ps;
#define PK4(P, BASE, OUT) do { unsigned a0 = cvtpk(P[BASE + 0], P[BASE + 1]), a1 = cvtpk(P[BASE + 2], P[BASE + 3]);   \
    unsigned b0 = cvtpk(P[BASE + 4], P[BASE + 5]), b1 = cvtpk(P[BASE + 6], P[BASE + 7]);                              \
    auto r0 = __builtin_amdgcn_permlane32_swap(a0, b0, false, false); auto r1 = __builtin_amdgcn_permlane32_swap(a1, b1, false, false); \
    u32x4 w = {r0[0], r1[0], r0[1], r1[1]}; OUT = *reinterpret_cast<bf16x8*>(&w); } while (0)
  PK4(p0, 0, pa0); PK4(p0, 8, pa1); PK4(p1, 0, pa2); PK4(p1, 8, pa3);
#undef PK4
}
__device__ __forceinline__ void qkt(f32x16& p0, f32x16& p1, const LAS char* Ks, const bf16x8 (&qr)[12], int r32, int hi) {
  p0 = f32x16{}; p1 = f32x16{};
#pragma unroll
  for (int d0 = 0; d0 < 12; ++d0) { const int cb = (d0 * 16 + hi * 8) * 2;
    const bf16x8 b0 = *reinterpret_cast<const LAS bf16x8*>(Ks + KSWZ(r32, cb));
    const bf16x8 b1 = *reinterpret_cast<const LAS bf16x8*>(Ks + KSWZ(32 + r32, cb));
    p0 = __builtin_amdgcn_mfma_f32_32x32x16_bf16(b0, qr[d0], p0, 0, 0, 0);
    p1 = __builtin_amdgcn_mfma_f32_32x32x16_bf16(b1, qr[d0], p1, 0, 0, 0); }
}
__device__ __forceinline__ int v_st(int k, int c) { const int kk = (k & ~0xC) | ((k & 4) << 1) | ((k & 8) >> 1); return ((kk >> 3) * 4 + (c >> 5)) * 512 + ((kk & 7) * 32 + (c & 31)) * 2; }
__device__ __forceinline__ int v_rd_base(int lane) { return ((lane & 3) << 3) | (((lane >> 2) & 3) << 6) | (((lane >> 4) & 1) << 5) | (((lane >> 5) & 1) << 8); }
constexpr int v_rd_off(int d0, int ks, int half) { return d0 * 512 + ks * 4096 + half * 2048; }
template <int OFF> __device__ __forceinline__ s16x4 tr_read(int vb) { s16x4 r; asm volatile("ds_read_b64_tr_b16 %0, %1 offset:%2" : "=&v"(r) : "v"(vb), "i"(OFF) : "memory"); return r; }
template <int D0> __device__ __forceinline__ void pv_one(f32x16& od, int vb, bf16x8 pa0, bf16x8 pa1, bf16x8 pa2, bf16x8 pa3) {
  const s16x4 l0 = tr_read<v_rd_off(D0, 0, 0)>(vb), h0 = tr_read<v_rd_off(D0, 0, 1)>(vb), l1 = tr_read<v_rd_off(D0, 1, 0)>(vb), h1 = tr_read<v_rd_off(D0, 1, 1)>(vb);
  const s16x4 l2 = tr_read<v_rd_off(D0, 2, 0)>(vb), h2 = tr_read<v_rd_off(D0, 2, 1)>(vb), l3 = tr_read<v_rd_off(D0, 3, 0)>(vb), h3 = tr_read<v_rd_off(D0, 3, 1)>(vb);
  asm volatile("s_waitcnt lgkmcnt(0)" ::: "memory"); SBAR();
#define PK(Lo, Hi) (bf16x8){Lo[0], Lo[1], Lo[2], Lo[3], Hi[0], Hi[1], Hi[2], Hi[3]}
  od = __builtin_amdgcn_mfma_f32_32x32x16_bf16(pa0, PK(l0, h0), od, 0, 0, 0);
  od = __builtin_amdgcn_mfma_f32_32x32x16_bf16(pa1, PK(l1, h1), od, 0, 0, 0);
  od = __builtin_amdgcn_mfma_f32_32x32x16_bf16(pa2, PK(l2, h2), od, 0, 0, 0);
  od = __builtin_amdgcn_mfma_f32_32x32x16_bf16(pa3, PK(l3, h3), od, 0, 0, 0);
#undef PK
}
__device__ __forceinline__ void pv_d0(f32x16 (&o)[4], int vb, bf16x8 pa0, bf16x8 pa1, bf16x8 pa2, bf16x8 pa3) {
  pv_one<0>(o[0], vb, pa0, pa1, pa2, pa3); pv_one<1>(o[1], vb, pa0, pa1, pa2, pa3); pv_one<2>(o[2], vb, pa0, pa1, pa2, pa3); pv_one<3>(o[3], vb, pa0, pa1, pa2, pa3);
}

__device__ __forceinline__ void attn_unit(const bf16_t* __restrict__ Qb, const bf16_t* __restrict__ Kh, const bf16_t* __restrict__ Vh, bf16_t* __restrict__ Ob, int t0, const float* __restrict__ ropet, LAS char* lds) {
  constexpr int LDQ = 1536, LDO = 1024, NT = NKEY / KVBLK;
  const int tid = otid(), wid = tid >> 6, lane = tid & 63, r32 = lane & 31, hi = lane >> 5;
  LAS char* V_lds = lds; LAS char* K_lds = lds + 2 * SHM_V;
  LAS float* wsl = (LAS float*)(lds + 2 * SHM_V + 2 * SHM_K) + wid * 64; LAS float* li_l = wsl; LAS float* al_l = wsl + 32;
  float m_reg = -1e30f, l_reg = 0; f32x16 o[4] = {}; bf16x8 qr[12];
  { const bf16_t* Qw = Qb + (size_t)(wid * QBLK + r32) * LDQ + hi * 8;
#pragma unroll
    for (int d0 = 0; d0 < 12; ++d0) qr[d0] = *reinterpret_cast<const bf16x8*>(Qw + d0 * 16);
    const float* rt = ropet + (size_t)(t0 + wid * QBLK + r32) * 64 + 8 * hi;
#pragma unroll
    for (int g = 0; g < 2; ++g) {
      const f32x4 c0 = *(const f32x4*)(rt + 16 * g), c1 = *(const f32x4*)(rt + 16 * g + 4), s0 = *(const f32x4*)(rt + 32 + 16 * g), s1 = *(const f32x4*)(rt + 32 + 16 * g + 4);
      float n1[8], n2[8];
#pragma unroll
      for (int j = 0; j < 8; ++j) { const float cs = j < 4 ? c0[j & 3] : c1[j & 3], sn = j < 4 ? s0[j & 3] : s1[j & 3];
        const float x1 = bf2f((bf16_t)qr[8 + g][j]), x2 = bf2f((bf16_t)qr[10 + g][j]); n1[j] = x1 * cs - x2 * sn; n2[j] = x1 * sn + x2 * cs; }
      u32x4 w1 = {cvtpk(n1[0], n1[1]), cvtpk(n1[2], n1[3]), cvtpk(n1[4], n1[5]), cvtpk(n1[6], n1[7])}; u32x4 w2 = {cvtpk(n2[0], n2[1]), cvtpk(n2[2], n2[3]), cvtpk(n2[4], n2[5]), cvtpk(n2[6], n2[7])};
      qr[8 + g] = *reinterpret_cast<bf16x8*>(&w1); qr[10 + g] = *reinterpret_cast<bf16x8*>(&w2); } }
  const int sr = tid >> 4, sc = (tid & 15) * 8, vst0 = v_st(sr, sc), vst1 = v_st(32 + sr, sc);
  int kgo[3], kst[3];
#pragma unroll
  for (int i = 0; i < 3; ++i) { const int c = tid + 512 * i, row = c / 24, c8 = (c % 24) * 8; kgo[i] = row * DK + c8; kst[i] = KSWZ(row, c8 * 2); }
  const int vb0 = (int)(uintptr_t)V_lds + v_rd_base(lane);
  bf16x8 sv0, sv1, sk0, sk1, sk2;
#define SLOAD(k0) do { sv0 = *reinterpret_cast<const bf16x8*>(&Vh[(size_t)((k0) + sr) * DV + sc]); sv1 = *reinterpret_cast<const bf16x8*>(&Vh[(size_t)((k0) + 32 + sr) * DV + sc]); \
    sk0 = *reinterpret_cast<const bf16x8*>(&Kh[(size_t)(k0) * DK + kgo[0]]); sk1 = *reinterpret_cast<const bf16x8*>(&Kh[(size_t)(k0) * DK + kgo[1]]); sk2 = *reinterpret_cast<const bf16x8*>(&Kh[(size_t)(k0) * DK + kgo[2]]); } while (0)
#define SWRITE(b) do { *(LAS bf16x8*)(V_lds + (b) * SHM_V + vst0) = sv0; *(LAS bf16x8*)(V_lds + (b) * SHM_V + vst1) = sv1; \
    *(LAS bf16x8*)(K_lds + (b) * SHM_K + kst[0]) = sk0; *(LAS bf16x8*)(K_lds + (b) * SHM_K + kst[1]) = sk1; *(LAS bf16x8*)(K_lds + (b) * SHM_K + kst[2]) = sk2; } while (0)
#define RESC(a) do { if (__any((a) < 1.f)) { if (hi == 0) al_l[r32] = (a); asm volatile("s_waitcnt lgkmcnt(0)" ::: "memory"); \
    _Pragma("unroll") for (int d = 0; d < 4; ++d) _Pragma("unroll") for (int r = 0; r < 16; ++r) o[d][r] *= al_l[crow(r, hi)]; } } while (0)
  f32x16 p0, p1; float mn, al; bf16x8 pa0, pa1, pa2, pa3;
  SLOAD(0); asm volatile("s_waitcnt vmcnt(0)" ::: "memory"); SWRITE(0); __syncthreads();
  for (int j = 0; j < NT; ++j) {
    const int bsel = j & 1;
    if (j + 1 < NT) SLOAD((j + 1) * KVBLK);
    SBAR(); qkt(p0, p1, K_lds + bsel * SHM_K, qr, r32, hi);
    partialSM(p0, p1, m_reg, mn, al);
    RESC(al);
    finishSM(p0, p1, al, l_reg, pa0, pa1, pa2, pa3); SBAR();
    pv_d0(o, vb0 + bsel * SHM_V, pa0, pa1, pa2, pa3);
    if (j + 1 < NT) { asm volatile("s_waitcnt vmcnt(0)" ::: "memory"); SWRITE(bsel ^ 1); }
    __syncthreads();
  }
  if (hi == 0) li_l[r32] = l_reg; asm volatile("s_waitcnt lgkmcnt(0)" ::: "memory");
  float rli[16];
#pragma unroll
  for (int r = 0; r < 16; ++r) rli[r] = __builtin_amdgcn_rcpf(li_l[crow(r, hi)]);
  bf16_t* Ow = Ob + (size_t)(wid * QBLK) * LDO;
#pragma unroll
  for (int r = 0; r < 16; ++r) { const int orow = crow(r, hi);
#pragma unroll
    for (int d0 = 0; d0 < 4; ++d0) Ow[(size_t)orow * LDO + d0 * 32 + r32] = f2bf(o[d0][r] * rli[r]); }
#undef SLOAD
#undef SWRITE
#undef RESC
}
}

__device__ __forceinline__ void phase_attn(const Params& p, LAS unsigned char* lds) {
    char* ws = p.ws; const bf16_t* Q = (const bf16_t*)(ws + OFF_Q); const bf16_t* Kb = (const bf16_t*)(ws + OFF_K); const bf16_t* Vb = (const bf16_t*)(ws + OFF_V); bf16_t* Y = (bf16_t*)(ws + OFF_H);
    const int G = gridDim.x;
    for (int it = 0;; ++it) {
        int u;
        if (G == 256) { const int c = blockIdx.x, xcd = c & 7, j = c >> 3; if (it >= 4) break; u = ((it * 32 + xcd * 4 + (j >> 3)) << 3) | (j & 7); }
        else { u = it * G + blockIdx.x; if (u >= 1024) break; }
        const int bh = u >> 3, qb = u & 7, b = bh >> 3, h = bh & 7;
        at::attn_unit(Q + ((size_t)(b * SEQ + qb * 256)) * 1536 + h * 192, Kb + (size_t)bh * NKEY * 192, Vb + (size_t)bh * NKEY * 128, Y + ((size_t)(b * SEQ + qb * 256)) * D + h * 128, qb * 256, (const float*)(ws + OFF_ROPE), (LAS char*)lds);
        __syncthreads();
    }
}

namespace sc {
using f32x16 = __attribute__((ext_vector_type(16))) float;
constexpr int O_QI = 0, O_QG = 16384, O_KT = 32768, O_KE = 73728, O_VT = 90112, O_AT = 106496, O_SC = 114688, O_DEC = 147456, O_TOT = 147456 + 512, LDS_SCAN = 147456 + 512 + 4096;
__device__ __forceinline__ int sw256(int row, int cb) { return row * 256 + (cb ^ ((row & 15) << 4)); }
__device__ __forceinline__ int sw128(int row, int cb) { return row * 128 + (cb ^ (((row >> 1) & 7) << 4)); }
__device__ __forceinline__ int crow(int r, int hi) { return (r & 3) + 8 * (r >> 2) + 4 * hi; }
__device__ __forceinline__ int grow_of(int n, int b, int dir) { if (n < CTXL) { const int s = dir ? (CTXL - 1 - n) : n; return L + b * CTXL + s; } const int m = n - CTXL; return b * SEQ + (dir ? (SEQ - 1 - m) : m); }

__device__ __forceinline__ void scan_unit(const Params& p, int unit, LAS unsigned char* lds) {
    char* ws = p.ws; const int dir = unit & 1, h = (unit >> 1) & 7, b = unit >> 4;
    const bf16_t* hq = (const bf16_t*)(ws + OFF_HQ); const bf16_t* fz = (const bf16_t*)(ws + (dir ? OFF_FB : OFF_FF)); const bf16_t* iv = (const bf16_t*)(ws + OFF_IV);
    bf16_t* outp = (bf16_t*)(ws + (dir ? OFF_OB : OFF_OF)); const float* lb = (const float*)(ws + OFF_LB);
    const int tid = otid(), wid = tid >> 6, lane = tid & 63, r32 = lane & 31, hi = lane >> 5;
    const int cp = lane, sb = __builtin_amdgcn_readfirstlane(wid), J = sb >> 1;
    const float lbv0 = lb[dir * 1024 + h * 128 + 2 * cp], lbv1 = lb[dir * 1024 + h * 128 + 2 * cp + 1];
    const int hc = h * 128 + 2 * cp; const int sgn = dir ? -1 : 1; const long rstep = (long)sgn * D;
    LAS unsigned char* QI = lds + O_QI; LAS unsigned char* QG = lds + O_QG; LAS unsigned char* KT = lds + O_KT; LAS unsigned char* KE = lds + O_KE; LAS unsigned char* VT = lds + O_VT;
    LAS unsigned char* AT = lds + O_AT; LAS unsigned char* SCp = lds + O_SC; LAS float* DEC = (LAS float*)(lds + O_DEC); LAS float* TOT = (LAS float*)(lds + O_TOT);
    for (int i = tid; i < (8192 + 32768) / 16; i += 512) *(LAS u32x4*)(lds + O_AT + i * 16) = (u32x4){0u, 0u, 0u, 0u};
    f32x16 S0 = {}, S1 = {};
    const int tb = wid & 1, dvb = wid >> 1;
    unsigned zr[8], vr[8], qr[8];
#define SC_LOAD_Z(c) do { const bf16_t* pz_ = fz + (size_t)(grow_of((c) * 64, b, dir) + sgn * (8 * sb)) * D + hc; _Pragma("unroll") for (int i = 0; i < 8; ++i) { zr[i] = *(const unsigned*)pz_; pz_ += rstep; } } while (0)
#define SC_LOAD_VQ(c) do { const size_t o0_ = (size_t)(grow_of((c) * 64, b, dir) + sgn * (8 * sb)) * D + hc; const bf16_t* pv_ = iv + o0_; const bf16_t* pq_ = hq + o0_; \
        _Pragma("unroll") for (int i = 0; i < 8; ++i) { vr[i] = *(const unsigned*)pv_; pv_ += rstep; if ((c) >= 4) { qr[i] = *(const unsigned*)pq_; pq_ += rstep; } } } while (0)
    SC_LOAD_Z(0); SC_LOAD_VQ(0);
    __syncthreads();
    for (int c = 0; c < 36; ++c) {
        const bool lat = c >= 4;
        {
            float kk0[8], kk1[8], lc0[8], lc1[8]; float run0 = 0.f, run1 = 0.f;
#pragma unroll
            for (int i = 0; i < 8; ++i) { const float z0 = __uint_as_float(zr[i] << 16), z1 = __uint_as_float(zr[i] & 0xffff0000u);
                const float f0 = lbv0 + (1.0f - lbv0) * sigmoidf_(z0), f1 = lbv1 + (1.0f - lbv1) * sigmoidf_(z1); kk0[i] = 1.0f - f0; kk1[i] = 1.0f - f1;
                run0 += __builtin_amdgcn_logf(f0) * 0.6931471805599453f; run1 += __builtin_amdgcn_logf(f1) * 0.6931471805599453f; lc0[i] = run0; lc1[i] = run1; }
            if (c + 1 < 36) SC_LOAD_Z(c + 1);
            *(LAS f32x2*)(TOT + sb * 128 + 2 * cp) = (f32x2){run0, run1};
            __syncthreads();
            float P0 = 0.f, P1 = 0.f, c0J0 = 0.f, c0J1 = 0.f, c010 = 0.f, c011 = 0.f, c020 = 0.f, c021 = 0.f, c030 = 0.f, c031 = 0.f, last0 = 0.f, last1 = 0.f;
            { float a0 = 0.f, a1 = 0.f;
#pragma unroll
              for (int q = 0; q < 8; ++q) { if (q == sb) { P0 = a0; P1 = a1; } if (q == 2 * J) { c0J0 = a0; c0J1 = a1; } if (q == 2) { c010 = a0; c011 = a1; } if (q == 4) { c020 = a0; c021 = a1; } if (q == 6) { c030 = a0; c031 = a1; }
                  const f32x2 tq = *(const LAS f32x2*)(TOT + q * 128 + 2 * cp); a0 += tq[0]; a1 += tq[1]; }
              last0 = a0; last1 = a1; }
            const float off0 = P0 - c0J0, off1 = P1 - c0J1;
            const float eg0 = __expf(c0J0), eg1 = __expf(c0J1), ee0 = __expf(last0 - c0J0), ee1 = __expf(last1 - c0J1);
            const float e10 = __expf(c010 - c0J0), e11 = __expf(c011 - c0J1), e20 = __expf(c020 - c0J0), e21 = __expf(c021 - c0J1), e30 = __expf(c030 - c0J0), e31 = __expf(c031 - c0J1);
            if (sb == 0) *(LAS f32x2*)(DEC + 2 * cp) = (f32x2){__expf(last0), __expf(last1)};
            unsigned ke0[4], ke1[4], vt0[4], vt1[4];
#pragma unroll
            for (int i = 0; i < 8; ++i) { const int t = 8 * sb + i; const float l0 = lc0[i] + off0, l1 = lc1[i] + off1;
                const float kd0 = kk0[i] * __expf(fminf(-l0, 80.0f)), kd1 = kk1[i] * __expf(fminf(-l1, 80.0f));
                if (lat) { const float q0 = __uint_as_float(qr[i] << 16), q1 = __uint_as_float(qr[i] & 0xffff0000u); const float qi0 = q0 * __expf(l0), qi1 = q1 * __expf(l1);
                    *(LAS unsigned*)(QI + sw256(t, 4 * cp)) = cvt_pk_bf16(qi0, qi1); *(LAS unsigned*)(QG + sw256(t, 4 * cp)) = cvt_pk_bf16(qi0 * eg0, qi1 * eg1);
                    if (J == 0) { *(LAS unsigned*)(KT + sw256(0 + t, 4 * cp)) = cvt_pk_bf16(kd0, kd1); *(LAS unsigned*)(KT + sw256(16 + t, 4 * cp)) = cvt_pk_bf16(kd0 * e10, kd1 * e11);
                                  *(LAS unsigned*)(KT + sw256(48 + t, 4 * cp)) = cvt_pk_bf16(kd0 * e20, kd1 * e21); *(LAS unsigned*)(KT + sw256(96 + t, 4 * cp)) = cvt_pk_bf16(kd0 * e30, kd1 * e31); }
                    else if (J == 1) { *(LAS unsigned*)(KT + sw256(16 + t, 4 * cp)) = cvt_pk_bf16(kd0, kd1); *(LAS unsigned*)(KT + sw256(48 + t, 4 * cp)) = cvt_pk_bf16(kd0 * e20, kd1 * e21); *(LAS unsigned*)(KT + sw256(96 + t, 4 * cp)) = cvt_pk_bf16(kd0 * e30, kd1 * e31); }
                    else if (J == 2) { *(LAS unsigned*)(KT + sw256(48 + t, 4 * cp)) = cvt_pk_bf16(kd0, kd1); *(LAS unsigned*)(KT + sw256(96 + t, 4 * cp)) = cvt_pk_bf16(kd0 * e30, kd1 * e31); }
                    else { *(LAS unsigned*)(KT + sw256(96 + t, 4 * cp)) = cvt_pk_bf16(kd0, kd1); } }
                const float kf0 = kd0 * ee0, kf1 = kd1 * ee1;
                if (i & 1) { ke0[i >> 1] = cvt_pk_bf16(__uint_as_float(ke0[i >> 1]), kf0); ke1[i >> 1] = cvt_pk_bf16(__uint_as_float(ke1[i >> 1]), kf1); vt0[i >> 1] = (vt0[i >> 1] >> 16) | (vr[i] << 16); vt1[i >> 1] = (vt1[i >> 1] >> 16) | (vr[i] & 0xffff0000u); }
                else { ke0[i >> 1] = __float_as_uint(kf0); ke1[i >> 1] = __float_as_uint(kf1); vt0[i >> 1] = vr[i] << 16; vt1[i >> 1] = vr[i] & 0xffff0000u; }
            }
            *(LAS u32x4*)(KE + sw128(2 * cp, 16 * sb)) = (u32x4){ke0[0], ke0[1], ke0[2], ke0[3]}; *(LAS u32x4*)(KE + sw128(2 * cp + 1, 16 * sb)) = (u32x4){ke1[0], ke1[1], ke1[2], ke1[3]};
            *(LAS u32x4*)(VT + sw128(2 * cp, 16 * sb)) = (u32x4){vt0[0], vt0[1], vt0[2], vt0[3]}; *(LAS u32x4*)(VT + sw128(2 * cp + 1, 16 * sb)) = (u32x4){vt1[0], vt1[1], vt1[2], vt1[3]};
        }
        if (c + 1 < 36) SC_LOAD_VQ(c + 1);
        __syncthreads();
        if (lat) {
#pragma unroll
            for (int rep = 0; rep < 2; ++rep) { const int ti = wid + 8 * rep; if (ti < 10) {
                const int I = ti < 1 ? 0 : (ti < 3 ? 1 : (ti < 6 ? 2 : 3)); const int Jt = ti - (I * (I + 1)) / 2; const int kbase = I == 0 ? 0 : (I == 1 ? 16 : (I == 2 ? 48 : 96));
                const int l15 = lane & 15, lq = lane >> 4; f32x4 a = {0.f, 0.f, 0.f, 0.f};
#pragma unroll
                for (int ks = 0; ks < 4; ++ks) { const bf16x8 av = *(const LAS bf16x8*)(QI + sw256(16 * I + l15, (32 * ks + 8 * lq) * 2)); const bf16x8 bv = *(const LAS bf16x8*)(KT + sw256(kbase + 16 * Jt + l15, (32 * ks + 8 * lq) * 2));
                    a = __builtin_amdgcn_mfma_f32_16x16x32_bf16(av, bv, a, 0, 0, 0); }
#pragma unroll
                for (int r = 0; r < 4; ++r) { const int tl = 4 * lq + r; float v = a[r]; if (I == Jt && l15 > tl) v = 0.f; *(LAS bf16_t*)(AT + sw128(16 * I + tl, (16 * Jt + l15) * 2)) = f2bf(v); } } }
        }
        __syncthreads();
        {
            if (lat) {
                f32x16 o = {};
#pragma unroll
                for (int ks = 0; ks < 8; ++ks) { const bf16x8 av = *(const LAS bf16x8*)(QG + sw256(32 * tb + r32, (16 * ks + 8 * hi) * 2)); const bf16x8 bv = *(const LAS bf16x8*)(SCp + sw256(32 * dvb + r32, (16 * ks + 8 * hi) * 2));
                    o = __builtin_amdgcn_mfma_f32_32x32x16_bf16(av, bv, o, 0, 0, 0); }
#pragma unroll
                for (int ks = 0; ks < 4; ++ks) { if (ks < 2 || tb == 1) { const bf16x8 av = *(const LAS bf16x8*)(AT + sw128(32 * tb + r32, (16 * ks + 8 * hi) * 2)); const bf16x8 bv = *(const LAS bf16x8*)(VT + sw128(32 * dvb + r32, (16 * ks + 8 * hi) * 2));
                    o = __builtin_amdgcn_mfma_f32_32x32x16_bf16(av, bv, o, 0, 0, 0); } }
                bf16_t* po = outp + (size_t)(grow_of(c * 64, b, dir) + sgn * (32 * tb + 4 * hi)) * D + h * 128 + 32 * dvb + r32;
#pragma unroll
                for (int r = 0; r < 16; ++r) po[(long)((r & 3) + 8 * (r >> 2)) * rstep] = f2bf(o[r]);
            }
#pragma unroll
            for (int r = 0; r < 16; ++r) { S0[r] *= DEC[64 * tb + crow(r, hi)]; S1[r] *= DEC[64 * tb + 32 + crow(r, hi)]; }
#pragma unroll
            for (int ks = 0; ks < 4; ++ks) { const bf16x8 bv = *(const LAS bf16x8*)(VT + sw128(32 * dvb + r32, (16 * ks + 8 * hi) * 2));
                const bf16x8 a0 = *(const LAS bf16x8*)(KE + sw128(64 * tb + r32, (16 * ks + 8 * hi) * 2)), a1 = *(const LAS bf16x8*)(KE + sw128(64 * tb + 32 + r32, (16 * ks + 8 * hi) * 2));
                S0 = __builtin_amdgcn_mfma_f32_32x32x16_bf16(a0, bv, S0, 0, 0, 0); S1 = __builtin_amdgcn_mfma_f32_32x32x16_bf16(a1, bv, S1, 0, 0, 0); }
        }
        __syncthreads();
#pragma unroll
        for (int g = 0; g < 4; ++g) { const int dv = 32 * dvb + r32; const int dk0 = 64 * tb + 8 * g + 4 * hi;
            u32x2 w0; w0.x = cvt_pk_bf16(S0[4 * g], S0[4 * g + 1]); w0.y = cvt_pk_bf16(S0[4 * g + 2], S0[4 * g + 3]); *(LAS u32x2*)(SCp + sw256(dv, dk0 * 2)) = w0;
            u32x2 w1; w1.x = cvt_pk_bf16(S1[4 * g], S1[4 * g + 1]); w1.y = cvt_pk_bf16(S1[4 * g + 2], S1[4 * g + 3]); *(LAS u32x2*)(SCp + sw256(dv, (dk0 + 32) * 2)) = w1; }
    }
    __syncthreads();
#undef SC_LOAD_Z
#undef SC_LOAD_VQ
}
}
__device__ __forceinline__ void phase_scan(const Params& p, LAS unsigned char* lds) {
    for (int u = blockIdx.x; u < 256; u += gridDim.x) sc::scan_unit(p, u, lds);
}

constexpr int LDS_BYTES = 155648;
template <int PH> __global__ void __launch_bounds__(512, 2) k_phase(Params p) {
    extern __shared__ __attribute__((aligned(16))) unsigned char smem[];
    LAS unsigned char* lds = (LAS unsigned char*)smem;
    if constexpr (PH == 0) phase0(p, lds);
    if constexpr (PH == 1) phase1(p, lds);
    if constexpr (PH == 2) phase2(p, lds);
    if constexpr (PH == 3) phase3(p, lds);
    if constexpr (PH == 4) phase4(p, lds);
    if constexpr (PH == 5) phase5(p, lds);
    if constexpr (PH == 6) phase6(p, lds);
    if constexpr (PH == 7) phase7(p, lds);
    if constexpr (PH == 8) phase8(p, lds);
    if constexpr (PH == 9) phase9(p, lds);
    if constexpr (PH == 10) phase_attn(p, lds);
    if constexpr (PH == 11) phase_scan(p, lds);
}

#include <cstdint>
#include <cstdlib>
#include <vector>

#define XB_TMO      128
#define XB_XCNT(j)  (256  + 64 * (j))
#define XB_XSUB(j)  (1280 + 64 * (j))
#define XB_XGEN(j)  (2304 + 64 * (j))
#define XB_TOP      3328
#define XB_TOPGEN   3392
#define XCD_BAR_WORDS 3456
#define XB_SPIN_CAP (1u << 18)

__device__ __forceinline__ unsigned xb_ld(unsigned* p)              { return __hip_atomic_load(p, __ATOMIC_RELAXED, __HIP_MEMORY_SCOPE_AGENT); }
__device__ __forceinline__ unsigned xb_add(unsigned* p, unsigned v) { return __hip_atomic_fetch_add(p, v, __ATOMIC_RELAXED, __HIP_MEMORY_SCOPE_AGENT); }
__device__ __forceinline__ unsigned xb_xcc_id() { return (unsigned)__builtin_amdgcn_s_getreg((3 << 11) | 20) & 0xFu; }
#define XB_SPIN(cond, bar) do { unsigned _sp = 0; while (cond) { __builtin_amdgcn_s_sleep(1); \
    if ((++_sp & 255u) == 0u) { if (xb_ld(&(bar)[XB_TMO])) break; if (_sp > XB_SPIN_CAP) { atomicAdd(&(bar)[XB_TMO], 1u); break; } } } } while (0)

struct XcdBarrier {
    unsigned* bar; unsigned x;
    volatile LAS unsigned* st;
};

__device__ __forceinline__ XcdBarrier xcd_barrier_post(unsigned* bar, volatile LAS unsigned* st) {
    XcdBarrier b; b.bar = bar; b.x = xb_xcc_id(); b.st = st;
    if (threadIdx.x == 0) (void)xb_add(&bar[XB_XCNT(b.x)], 1u);
    return b;
}
__device__ __forceinline__ void xcd_barrier_complete(unsigned* bar, unsigned x, unsigned& nloc, unsigned& nx) {
    const unsigned G = gridDim.x * gridDim.y * gridDim.z;
    unsigned sum, cnt, mine, sp = 0u;
    for (;;) {
        sum = 0u; cnt = 0u; mine = 0u;
#pragma unroll
        for (unsigned j = 0; j < 16; ++j) { const unsigned c = xb_ld(&bar[XB_XCNT(j)]); sum += c; cnt += (c > 0u) ? 1u : 0u; mine = (j == x) ? c : mine; }
        if (sum == G) break;
        __builtin_amdgcn_s_sleep(1);
        if ((++sp & 255u) == 0u) { if (xb_ld(&bar[XB_TMO])) break; if (sp > XB_SPIN_CAP) { atomicAdd(&bar[XB_TMO], 1u); break; } }
    }
    nloc = mine > 0u ? mine : 1u; nx = cnt > 0u ? cnt : 1u;
}

__device__ __forceinline__ void xcd_barrier(const XcdBarrier& b) {
    asm volatile("s_waitcnt vmcnt(0)" ::: "memory");
    __syncthreads();
    if (threadIdx.x == 0) {
        unsigned* bar = b.bar;
        __builtin_amdgcn_s_waitcnt(0);
        unsigned nloc = b.st[0], nx = b.st[1];
        if (nloc == 0u) { xcd_barrier_complete(bar, b.x, nloc, nx); b.st[0] = nloc; b.st[1] = nx; }
        const unsigned old = xb_add(&bar[XB_XSUB(b.x)], 1u);
        const unsigned gen = old / nloc;
        if (old + 1u == (gen + 1u) * nloc) {
            __builtin_amdgcn_fence(__ATOMIC_RELEASE, "agent");
            asm volatile("s_waitcnt vmcnt(0)" ::: "memory");
            const unsigned og = xb_add(&bar[XB_TOP], 1u);
            const unsigned tg = og / nx;
            if (og + 1u == (tg + 1u) * nx) xb_add(&bar[XB_TOPGEN], 1u);
            else XB_SPIN(xb_ld(&bar[XB_TOPGEN]) == tg, bar);
            __builtin_amdgcn_fence(__ATOMIC_ACQUIRE, "agent");
            xb_add(&bar[XB_XGEN(b.x)], 1u);
            asm volatile("s_waitcnt vmcnt(0)" ::: "memory");
        } else {
            XB_SPIN(xb_ld(&bar[XB_XGEN(b.x)]) == gen, bar);
            __builtin_amdgcn_fence(__ATOMIC_ACQUIRE, "agent");
            asm volatile("s_waitcnt vmcnt(0)" ::: "memory");
        }
    }
    __syncthreads();
}

__global__ void __launch_bounds__(512, 2) k_mega(Params p) {
    extern __shared__ __attribute__((aligned(16))) unsigned char smem[];
    LAS unsigned char* lds = (LAS unsigned char*)smem;
    volatile LAS unsigned* xbw = (volatile LAS unsigned*)(lds + LDS_BYTES - 16);
    if (threadIdx.x == 0) { xbw[0] = 0u; xbw[1] = 0u; xbw[2] = 0u; xbw[3] = 0u; }
    __syncthreads();
    XcdBarrier bar = xcd_barrier_post((unsigned*)(p.ws + OFF_BAR), xbw);
    phase0(p, lds);      xcd_barrier(bar);
    phase1(p, lds);      xcd_barrier(bar);
    phase2(p, lds);      xcd_barrier(bar);
    phase3(p, lds);      xcd_barrier(bar);
    phase_attn(p, lds);
    phase_scan(p, lds);  xcd_barrier(bar);
    phase4(p, lds);      xcd_barrier(bar);
    phase5(p, lds);      xcd_barrier(bar);
    phase6(p, lds);      xcd_barrier(bar);
    phase7(p, lds);      xcd_barrier(bar);
    phase8(p, lds);      xcd_barrier(bar);
    phase9(p, lds);
}
extern "C" void kernel_launch(void* const* d_in, const int* in_sizes, int n_in, void* d_out, int out_size, void* d_ws, size_t ws_size, hipStream_t stream) {
    static int grid = 0;
    if (grid == 0) {
        int dev = 0, cus = 0, per_cu = 0;
        if (hipGetDevice(&dev) != hipSuccess || hipDeviceGetAttribute(&cus, hipDeviceAttributeMultiprocessorCount, dev) != hipSuccess) { grid = -1; return; }
        if (hipFuncSetAttribute((const void*)k_mega, hipFuncAttributeMaxDynamicSharedMemorySize, LDS_BYTES) != hipSuccess) { grid = -1; return; }
        (void)hipOccupancyMaxActiveBlocksPerMultiprocessor(&per_cu, (const void*)k_mega, 512, LDS_BYTES);
        (void)hipGetLastError();
        grid = cus;
    }
    if (grid < 0) return;
    Params p{};
    p.x = (const float*)d_in[0]; p.c = (const float*)d_in[1]; p.ctx = (const float*)d_in[2]; p.cctx = (const float*)d_in[3]; p.w_mod = (const float*)d_in[4]; p.b_mod = (const float*)d_in[5];
    p.g_mix = (const float*)d_in[6]; p.w_in = (const float*)d_in[7]; p.g_q = (const float*)d_in[8]; p.w_qb = (const float*)d_in[9]; p.g_kv = (const float*)d_in[10]; p.w_kvb = (const float*)d_in[11];
    p.lbl = (const float*)d_in[12]; p.g_hg = (const float*)d_in[13]; p.w_out = (const float*)d_in[14]; p.g_ffn = (const float*)d_in[15]; p.w_r = (const float*)d_in[16]; p.b_r = (const float*)d_in[17];
    p.w_gu = (const float*)d_in[18]; p.b_gu = (const float*)d_in[19]; p.w_dn = (const float*)d_in[20]; p.b_dn = (const float*)d_in[21]; p.g_fin = (const float*)d_in[22];
    p.out = (float*)d_out; p.ws = (char*)d_ws;
    (void)hipMemsetAsync((char*)d_ws + OFF_BAR, 0, 16384, stream);
    hipLaunchKernelGGL(k_mega, dim3(grid), dim3(512), LDS_BYTES, stream, p);
}
```

```cpp
#include <hip/hip_runtime.h>
#include <stdint.h>

typedef unsigned short bf16_t;
__device__ __forceinline__ float bf2f(bf16_t v) { return __uint_as_float(((unsigned)v) << 16); }
__device__ __forceinline__ bf16_t f2bf(float f) { unsigned u = __float_as_uint(f); u += 0x7FFFu + ((u >> 16) & 1u); return (bf16_t)(u >> 16); }
__device__ __forceinline__ float sigmoidf_(float x) { return __builtin_amdgcn_rcpf(1.0f + __builtin_amdgcn_exp2f(-1.4426950408889634f * x)); }
__device__ __forceinline__ float siluf_(float x) { return x * __builtin_amdgcn_rcpf(1.0f + __builtin_amdgcn_exp2f(-1.4426950408889634f * x)); }

constexpr int D = 1024, NB = 16, SEQ = 2048, CTXL = 256;
constexpr int L = NB * SEQ;
constexpr int RC = NB * CTXL;
constexpr int R = L + RC;
constexpr int NKEY = SEQ + CTXL;
constexpr float EPS = 1e-6f;
constexpr int NE = 32, CAP = 32768;
constexpr int MAXROWS = 131072 + NE * 256;

constexpr size_t MiB = 1048576;
constexpr size_t OFF_SMALL = 0;
constexpr size_t OFF_BAR = 0;
constexpr size_t OFF_CNT = 16384;
constexpr size_t OFF_OFFS = 16384 + 1024;
constexpr size_t OFF_TILEE = 16384 + 2048;
constexpr size_t OFF_LB = 24576;
constexpr size_t OFF_MOD = 32768;
constexpr size_t OFF_SSQQ = 512 * 1024;
constexpr size_t OFF_SSQKV = 768 * 1024;
constexpr size_t OFF_TOPI = 1 * MiB;
constexpr size_t OFF_TOPP = 1 * MiB + 512 * 1024;
constexpr size_t OFF_ROWPAIR = 2 * MiB;
constexpr size_t OFF_LIST = 3 * MiB;
constexpr size_t OFF_H = 32 * MiB;
constexpr size_t OFF_QA = 104 * MiB;
constexpr size_t OFF_CKV = 152 * MiB;
constexpr size_t OFF_KR = 170 * MiB;
constexpr size_t OFF_OF = 104 * MiB;
constexpr size_t OFF_HQ = 175 * MiB;
constexpr size_t SEG_STRIDE = 72 * MiB;
constexpr size_t OFF_FF = OFF_HQ + 1 * SEG_STRIDE;
constexpr size_t OFF_FB = OFF_HQ + 2 * SEG_STRIDE;
constexpr size_t OFF_IV = OFF_HQ + 3 * SEG_STRIDE;
constexpr size_t OFF_OG = OFF_HQ + 4 * SEG_STRIDE;
constexpr size_t OFF_GM = OFF_HQ + 5 * SEG_STRIDE;
constexpr size_t OFF_GH = OFF_HQ + 6 * SEG_STRIDE;
constexpr size_t OFF_Q = 679 * MiB;
constexpr size_t OFF_K = 775 * MiB;
constexpr size_t OFF_V = 883 * MiB;
constexpr size_t OFF_OB = 955 * MiB;
constexpr size_t OFF_YP = 296 * MiB;
constexpr size_t OFF_ACT = 568 * MiB;

struct SegOut { bf16_t *qa, *ckv, *kr, *hq, *ff, *fb, *iv, *og, *gm, *gh; };

__global__ void k_init(const float* __restrict__ lbl, float* lb, int* cnt) {
    int i = blockIdx.x * blockDim.x + threadIdx.x;
    if (i < 2048) { int d = i >> 10, j = i & 1023; float a = lbl[(d * 2 + 0) * 1024 + j], b = lbl[(d * 2 + 1) * 1024 + j]; lb[i] = 1.0f / (1.0f + __expf(b - a)); }
    if (i < 32) cnt[i] = 0;
}

__global__ __launch_bounds__(256) void k_mod(const float* __restrict__ c, const float* __restrict__ cctx, const float* __restrict__ wmod, const float* __restrict__ bmod, float* modv) {
    __shared__ float s[1024];
    int r = blockIdx.y; const float* src = r < 16 ? c + r * 1024 : cctx;
    for (int k = threadIdx.x; k < 1024; k += 256) s[k] = siluf_(src[k]);
    __syncthreads();
    int j = blockIdx.x * 256 + threadIdx.x; float acc = 0.f;
    for (int k = 0; k < 1024; ++k) acc += s[k] * wmod[(size_t)k * 6144 + j];
    modv[r * 6144 + j] = acc + bmod[j];
}

__device__ __forceinline__ float block_sum256(float v, float* red) {
    for (int o = 32; o > 0; o >>= 1) v += __shfl_xor(v, o);
    int w = threadIdx.x >> 6; if ((threadIdx.x & 63) == 0) red[w] = v; __syncthreads();
    float t = red[0] + red[1] + red[2] + red[3]; __syncthreads(); return t;
}

__global__ __launch_bounds__(256) void k_norm1(const float* __restrict__ x, const float* __restrict__ ctx, const float* __restrict__ g, const float* __restrict__ modv, bf16_t* h) {
    __shared__ float red[4];
    int row = blockIdx.x; const float* src = row < L ? x + (size_t)row * D : ctx + (size_t)(row - L) * D;
    const float* mod = modv + (row < L ? row / SEQ : 16) * 6144;
    int c = threadIdx.x * 4; float4 v = *(const float4*)(src + c);
    float ss = block_sum256(v.x * v.x + v.y * v.y + v.z * v.z + v.w * v.w, red);
    float rs = rsqrtf(ss * (1.0f / D) + EPS);
    float o[4] = {v.x, v.y, v.z, v.w}; ushort4 w; bf16_t* wp = (bf16_t*)&w;
    for (int i = 0; i < 4; ++i) wp[i] = f2bf(o[i] * rs * g[c + i] * (1.0f + mod[1024 + c + i]) + mod[c + i]);
    *(ushort4*)(h + (size_t)row * D + c) = w;
}

__global__ __launch_bounds__(256) void k_rowssq(const bf16_t* __restrict__ buf, int width, int nrows, float* ssq) {
    int row = blockIdx.x * 4 + (threadIdx.x >> 6), lane = threadIdx.x & 63; if (row >= nrows) return;
    float s = 0.f; for (int k = lane; k < width; k += 64) { float v = bf2f(buf[(size_t)row * width + k]); s += v * v; }
    for (int o = 32; o > 0; o >>= 1) s += __shfl_xor(s, o);
    if (lane == 0) ssq[row] = s;
}

__device__ __forceinline__ void rope_cs(int t, int i, float& cs, float& sn) {
    int j = i & 15; float inv = __expf(-(float)j * (9.210340371976184f / 16.0f)); float pos = (i < 16) ? (float)(t >> 6) : (float)(t & 63);
    float ang = pos * inv; cs = cosf(ang); sn = sinf(ang);
}

__global__ __launch_bounds__(256) void k_krope(const bf16_t* __restrict__ kr, bf16_t* Kb) {
    int gid = blockIdx.x * 256 + threadIdx.x; int row = gid >> 5, i = gid & 31; if (row >= R) return;
    float x1 = bf2f(kr[(size_t)row * 64 + i]), x2 = bf2f(kr[(size_t)row * 64 + 32 + i]); float o1 = x1, o2 = x2; int b, pos;
    if (row < L) { b = row / SEQ; pos = row % SEQ; float cs, sn; rope_cs(pos, i, cs, sn); o1 = x1 * cs - x2 * sn; o2 = x1 * sn + x2 * cs; }
    else { b = (row - L) / CTXL; pos = SEQ + (row - L) % CTXL; }
    bf16_t w1 = f2bf(o1), w2 = f2bf(o2);
    for (int h = 0; h < 8; ++h) { bf16_t* p = Kb + ((size_t)(b * 8 + h) * NKEY + pos) * 192 + 128; p[i] = w1; p[32 + i] = w2; }
}

template <class AL, class EP>
__global__ __launch_bounds__(256) void k_ngemm(int K, const float* __restrict__ W, int ldw, size_t wzstride, AL al, EP ep) {
    __shared__ float As[16][68]; __shared__ float Bs[16][64];
    const int z = blockIdx.z, row0 = blockIdx.y * 64, col0 = blockIdx.x * 64, tid = threadIdx.x;
    const int mvalid = al.rows(z); if (row0 >= mvalid) return;
    const float* Wz = W + (size_t)z * wzstride;
    const int ar = tid >> 2, ak = (tid & 3) * 4; const bf16_t* arow = (row0 + ar < mvalid) ? al.rowptr(z, row0 + ar) : nullptr;
    const int bk = tid >> 4, bn = (tid & 15) * 4;
    const int ty = tid >> 4, tx = tid & 15;
    float acc[4][4] = {};
    for (int k0 = 0; k0 < K; k0 += 16) {
        float a4[4] = {0.f, 0.f, 0.f, 0.f};
        if (arow) { ushort4 u = *(const ushort4*)(arow + k0 + ak); const bf16_t* up = (const bf16_t*)&u; for (int i = 0; i < 4; ++i) a4[i] = bf2f(up[i]) * al.kscale(k0 + ak + i); }
        float4 b4 = *(const float4*)(Wz + (size_t)(k0 + bk) * ldw + col0 + bn);
        __syncthreads();
        for (int i = 0; i < 4; ++i) As[ak + i][ar] = a4[i];
        *(float4*)&Bs[bk][bn] = b4;
        __syncthreads();
#pragma unroll
        for (int kk = 0; kk < 16; ++kk) {
            float4 av = *(const float4*)&As[kk][ty * 4]; float4 bv = *(const float4*)&Bs[kk][tx * 4];
            float a[4] = {av.x, av.y, av.z, av.w}, b[4] = {bv.x, bv.y, bv.z, bv.w};
#pragma unroll
            for (int i = 0; i < 4; ++i)
#pragma unroll
                for (int j = 0; j < 4; ++j) acc[i][j] += a[i] * b[j];
        }
    }
    for (int i = 0; i < 4; ++i) { int row = row0 + ty * 4 + i; if (row < mvalid) ep.store(z, row, col0 + tx * 4, acc[i]); }
}

__device__ __forceinline__ void st4bf(bf16_t* dst, const float* v) { ushort4 w; bf16_t* wp = (bf16_t*)&w; for (int i = 0; i < 4; ++i) wp[i] = f2bf(v[i]); *(ushort4*)dst = w; }

struct ALDense { const bf16_t* A; int lda; int nrows; const float* ks;
    __device__ int rows(int) const { return nrows; }
    __device__ const bf16_t* rowptr(int, int row) const { return A + (size_t)row * lda; }
    __device__ float kscale(int k) const { return ks ? ks[k] : 1.0f; } };

struct EpiInN { SegOut s;
    __device__ void store(int, int row, int col, const float* v) const {
        bf16_t* dst;
        if (col < 768) { if (row >= L) return; dst = s.qa + (size_t)row * 768 + col; }
        else if (col < 1024) dst = s.ckv + (size_t)row * 256 + (col - 768);
        else if (col < 1088) dst = s.kr + (size_t)row * 64 + (col - 1024);
        else { int c = col - 1088, seg = c >> 10, cc = c & 1023; bool latonly = (seg == 0 || seg >= 4); if (latonly && row >= L) return;
            bf16_t* base = seg == 0 ? s.hq : seg == 1 ? s.ff : seg == 2 ? s.fb : seg == 3 ? s.iv : seg == 4 ? s.og : seg == 5 ? s.gm : s.gh;
            dst = base + (size_t)row * 1024 + cc; }
        st4bf(dst, v);
    } };

struct EpiQN { bf16_t* q; const float* ssq;
    __device__ void store(int, int row, int col, const float* v) const { float rs = rsqrtf(ssq[row] * (1.0f / 768.0f) + EPS); float o[4]; for (int i = 0; i < 4; ++i) o[i] = v[i] * rs; st4bf(q + (size_t)row * 1536 + col, o); } };

struct EpiKVN { bf16_t *Kb, *Vb; const float* ssq;
    __device__ void store(int, int row, int col, const float* v) const {
        float rs = rsqrtf(ssq[row] * (1.0f / 256.0f) + EPS); float o[4]; for (int i = 0; i < 4; ++i) o[i] = v[i] * rs;
        int b, pos; if (row < L) { b = row / SEQ; pos = row % SEQ; } else { b = (row - L) / CTXL; pos = SEQ + (row - L) % CTXL; }
        int h = col >> 8, w = col & 255; size_t kvrow = (size_t)(b * 8 + h) * NKEY + pos;
        if (w < 128) st4bf(Kb + kvrow * 192 + w, o); else st4bf(Vb + kvrow * 128 + (w - 128), o);
    } };

struct EpiOutN { float* x1; const float* x; const float* modv;
    __device__ void store(int, int row, int col, const float* v) const {
        const float* gate = modv + (row / SEQ) * 6144 + 2 * 1024; float4 xv = *(const float4*)(x + (size_t)row * D + col);
        float4 o; o.x = xv.x + gate[col] * v[0]; o.y = xv.y + gate[col + 1] * v[1]; o.z = xv.z + gate[col + 2] * v[2]; o.w = xv.w + gate[col + 3] * v[3];
        *(float4*)(x1 + (size_t)row * D + col) = o;
    } };

struct ALMoe1 { const bf16_t* h2; const int* cnt; const int* list;
    __device__ int rows(int z) const { return cnt[z]; }
    __device__ const bf16_t* rowptr(int z, int row) const { return h2 + (size_t)(list[z * CAP + row] >> 2) * D; }
    __device__ float kscale(int) const { return 1.0f; } };
struct EpiMoe1N { bf16_t* act; const int* offs; const float* bgu;
    __device__ void store(int z, int row, int col, const float* v) const {
        const float* bb = bgu + z * 2048 + col; ushort2 w; bf16_t* wp = (bf16_t*)&w;
        for (int p = 0; p < 2; ++p) { float glu = fminf(v[2 * p] + bb[2 * p], 7.0f); float lin = fminf(fmaxf(v[2 * p + 1] + bb[2 * p + 1], -7.0f), 7.0f);
            wp[p] = f2bf(glu * sigmoidf_(1.702f * glu) * (lin + 1.0f)); }
        *(ushort2*)(act + (size_t)(offs[z] + row) * D + (col >> 1)) = w;
    } };
struct ALMoe2 { const bf16_t* act; const int* cnt; const int* offs;
    __device__ int rows(int z) const { return cnt[z]; }
    __device__ const bf16_t* rowptr(int z, int row) const { return act + (size_t)(offs[z] + row) * D; }
    __device__ float kscale(int) const { return 1.0f; } };
struct EpiMoe2N { bf16_t* yp; const int* list; const float* bd;
    __device__ void store(int z, int row, int col, const float* v) const {
        int pair = list[z * CAP + row]; const float* bb = bd + z * 1024 + col; float o[4]; for (int i = 0; i < 4; ++i) o[i] = v[i] + bb[i];
        st4bf(yp + (size_t)pair * D + col, o);
    } };

__global__ __launch_bounds__(256) void k_nattn(const bf16_t* __restrict__ Q, const bf16_t* __restrict__ Kb, const bf16_t* __restrict__ Vb, bf16_t* Y) {
    __shared__ float qs[4][192]; __shared__ float sc[4][NKEY];
    const int tid = threadIdx.x, blk = blockIdx.x, qg = blk & 511, h = (blk >> 9) & 7, b = blk >> 12;
    for (int idx = tid; idx < 4 * 192; idx += 256) { int qi = idx / 192, d = idx % 192; int row = b * SEQ + qg * 4 + qi; qs[qi][d] = bf2f(Q[(size_t)row * 1536 + h * 192 + d]); }
    __syncthreads();
    float n1 = 0.f, n2 = 0.f;
    if (tid < 128) { int qi = tid >> 5, i = tid & 31; int t = qg * 4 + qi; float cs, sn; rope_cs(t, i, cs, sn); float x1 = qs[qi][128 + i], x2 = qs[qi][160 + i]; n1 = x1 * cs - x2 * sn; n2 = x1 * sn + x2 * cs; }
    __syncthreads();
    if (tid < 128) { int qi = tid >> 5, i = tid & 31; qs[qi][128 + i] = n1; qs[qi][160 + i] = n2; }
    __syncthreads();
    const bf16_t* Kp = Kb + (size_t)(b * 8 + h) * NKEY * 192; const bf16_t* Vp = Vb + (size_t)(b * 8 + h) * NKEY * 128;
    const float scale = 0.07216878364870322f;
    for (int key = tid; key < NKEY; key += 256) {
        const bf16_t* kr = Kp + (size_t)key * 192; float s0 = 0.f, s1 = 0.f, s2 = 0.f, s3 = 0.f;
        for (int d = 0; d < 192; d += 8) { uint4 u = *(const uint4*)(kr + d); const bf16_t* up = (const bf16_t*)&u;
            for (int j = 0; j < 8; ++j) { float kv = bf2f(up[j]); s0 += qs[0][d + j] * kv; s1 += qs[1][d + j] * kv; s2 += qs[2][d + j] * kv; s3 += qs[3][d + j] * kv; } }
        sc[0][key] = s0 * scale; sc[1][key] = s1 * scale; sc[2][key] = s2 * scale; sc[3][key] = s3 * scale;
    }
    __syncthreads();
    { int w = tid >> 6, lane = tid & 63; float m = -1e30f; for (int k = lane; k < NKEY; k += 64) m = fmaxf(m, sc[w][k]);
      for (int o = 32; o > 0; o >>= 1) m = fmaxf(m, __shfl_xor(m, o));
      float s = 0.f; for (int k = lane; k < NKEY; k += 64) { float e = __expf(sc[w][k] - m); sc[w][k] = e; s += e; }
      for (int o = 32; o > 0; o >>= 1) s += __shfl_xor(s, o);
      float inv = 1.0f / s; for (int k = lane; k < NKEY; k += 64) sc[w][k] *= inv; }
    __syncthreads();
    { int dv = tid & 127, qh = tid >> 7; float o0 = 0.f, o1 = 0.f;
      for (int k = 0; k < NKEY; ++k) { float v = bf2f(Vp[(size_t)k * 128 + dv]); o0 += sc[qh * 2][k] * v; o1 += sc[qh * 2 + 1][k] * v; }
      int row = b * SEQ + qg * 4 + qh * 2; Y[(size_t)row * D + h * 128 + dv] = f2bf(o0); Y[(size_t)(row + 1) * D + h * 128 + dv] = f2bf(o1); }
}

__global__ __launch_bounds__(256) void k_nscan(const bf16_t* __restrict__ hq, const bf16_t* __restrict__ ff, const bf16_t* __restrict__ fb, const bf16_t* __restrict__ iv, const float* __restrict__ lb, bf16_t* of, bf16_t* ob) {
    __shared__ float sf[128], sk[128], sq[128], so[2][128];
    const int tid = threadIdx.x, blk = blockIdx.x, dir = blk & 1, h = (blk >> 1) & 7, b = blk >> 4;
    const bf16_t* fz = dir ? fb : ff; bf16_t* out = dir ? ob : of;
    const int dv = tid & 127, half = tid >> 7;
    float S[64];
#pragma unroll
    for (int j = 0; j < 64; ++j) S[j] = 0.f;
    const float lbv = lb[dir * 1024 + h * 128 + (tid & 127)];
    for (int step = 0; step < NKEY; ++step) {
        int row; bool islat;
        if (step < CTXL) { int s = dir ? (CTXL - 1 - step) : step; row = L + b * CTXL + s; islat = false; }
        else { int t = step - CTXL; t = dir ? (SEQ - 1 - t) : t; row = b * SEQ + t; islat = true; }
        if (tid < 128) { float z = bf2f(fz[(size_t)row * D + h * 128 + tid]); float f = lbv + (1.0f - lbv) * sigmoidf_(z); sf[tid] = f; sk[tid] = 1.0f - f;
            if (islat) { float zq = bf2f(hq[(size_t)row * D + h * 128 + tid]); sq[tid] = siluf_(zq) * 0.08838834764831845f; } }
        float v = bf2f(iv[(size_t)row * D + h * 128 + dv]);
        __syncthreads();
        float o = 0.f;
#pragma unroll
        for (int j = 0; j < 64; ++j) { int dk = half * 64 + j; S[j] = sf[dk] * S[j] + sk[dk] * v; o += S[j] * sq[dk]; }
        if (islat) so[half][dv] = o;
        __syncthreads();
        if (islat && half == 0) out[(size_t)row * D + h * 128 + dv] = f2bf(so[0][dv] + so[1][dv]);
    }
}

__global__ __launch_bounds__(256) void k_merge(bf16_t* y, const bf16_t* __restrict__ of, const bf16_t* __restrict__ ob, const bf16_t* __restrict__ og, const bf16_t* __restrict__ gm, const bf16_t* __restrict__ gh, const float* __restrict__ ghg) {
    int row = blockIdx.x, c = threadIdx.x * 4; size_t off = (size_t)row * D + c;
    ushort4 a = *(const ushort4*)(of + off), bb = *(const ushort4*)(ob + off), g1 = *(const ushort4*)(og + off), g2 = *(const ushort4*)(gm + off), g3 = *(const ushort4*)(gh + off), ym = *(const ushort4*)(y + off);
    const bf16_t *ap = (const bf16_t*)&a, *bp = (const bf16_t*)&bb, *p1 = (const bf16_t*)&g1, *p2 = (const bf16_t*)&g2, *p3 = (const bf16_t*)&g3, *pm = (const bf16_t*)&ym;
    float o[4], ss = 0.f; for (int i = 0; i < 4; ++i) { o[i] = bf2f(ap[i]) + bf2f(bp[i]); ss += o[i] * o[i]; }
    for (int m = 16; m > 0; m >>= 1) ss += __shfl_xor(ss, m);
    float rs = rsqrtf(ss * (1.0f / 128.0f) + EPS); float r[4];
    for (int i = 0; i < 4; ++i) { float yh = o[i] * rs * ghg[(c + i) & 127] * siluf_(bf2f(p1[i])); r[i] = sigmoidf_(bf2f(p2[i])) * bf2f(pm[i]) + sigmoidf_(bf2f(p3[i])) * yh; }
    st4bf(y + off, r);
}

__global__ __launch_bounds__(256) void k_norm2_router(const float* __restrict__ x1, const float* __restrict__ g, const float* __restrict__ modv, const float* __restrict__ wr, const float* __restrict__ br, bf16_t* h2, int* topi, float* topp, int* cnt, int* list) {
    __shared__ float red[4]; __shared__ float hs[1024]; __shared__ float part[8][32];
    int row = blockIdx.x, tid = threadIdx.x, c = tid * 4; const float* mod = modv + (row / SEQ) * 6144;
    float4 v = *(const float4*)(x1 + (size_t)row * D + c);
    float ss = block_sum256(v.x * v.x + v.y * v.y + v.z * v.z + v.w * v.w, red); float rs = rsqrtf(ss * (1.0f / D) + EPS);
    float xv[4] = {v.x, v.y, v.z, v.w}, o[4];
    for (int i = 0; i < 4; ++i) { o[i] = xv[i] * rs * g[c + i] * (1.0f + mod[4 * 1024 + c + i]) + mod[3 * 1024 + c + i]; hs[c + i] = o[i]; }
    st4bf(h2 + (size_t)row * D + c, o);
    __syncthreads();
    { int e = tid & 31, p = tid >> 5; float a = 0.f; for (int j = p * 128; j < p * 128 + 128; ++j) a += hs[j] * wr[j * 32 + e]; part[p][e] = a; }
    __syncthreads();
    if (tid < 64) {
        int e = tid & 31; float cur = br[e];
#pragma unroll
        for (int p = 0; p < 8; ++p) cur += part[p][e];
        float tv0 = 0.f, sum = 0.f; float myp = 0.f; int myk = -1;
        int sel_i[4]; float sel_e[4];
#pragma unroll
        for (int k = 0; k < 4; ++k) {
            float m = cur; int mi = e;
#pragma unroll
            for (int o = 16; o > 0; o >>= 1) { float om = __shfl_xor(m, o); int oi = __shfl_xor(mi, o); if (om > m || (om == m && oi < mi)) { m = om; mi = oi; } }
            if (k == 0) tv0 = m;
            sel_i[k] = mi; sel_e[k] = __expf(m - tv0); sum += sel_e[k];
            if (e == mi) cur = -3.0e38f;
        }
#pragma unroll
        for (int k = 0; k < 4; ++k) if (tid == k) { myk = sel_i[k]; myp = sel_e[k] / sum; }
        if (tid < 4) { int pair = row * 4 + tid; topi[pair] = myk; topp[pair] = myp; int pos = atomicAdd(&cnt[myk], 1); list[myk * CAP + pos] = pair; }
    }
}

__global__ void k_moe_offs(const int* cnt, int* offs, int* tilee) {
    if (threadIdx.x == 0 && blockIdx.x == 0) { int o = 0, t = 0; for (int e = 0; e < NE; ++e) { offs[e] = o; int nt = (cnt[e] + 255) >> 8; for (int i = 0; i < nt; ++i) tilee[t++] = e; o += nt * 256; } offs[NE] = o; offs[NE + 1] = t; }
}

__global__ __launch_bounds__(256) void k_final(float* out, const bf16_t* __restrict__ yp, const float* __restrict__ topp, const float* __restrict__ modv, const float* __restrict__ fg) {
    __shared__ float red[4];
    int row = blockIdx.x, c = threadIdx.x * 4; const float* gate = modv + (row / SEQ) * 6144 + 5 * 1024;
    float4 v = *(const float4*)(out + (size_t)row * D + c); float xv[4] = {v.x, v.y, v.z, v.w}; float m[4] = {0.f, 0.f, 0.f, 0.f};
    for (int k = 0; k < 4; ++k) { float p = topp[row * 4 + k]; ushort4 u = *(const ushort4*)(yp + (size_t)(row * 4 + k) * D + c); const bf16_t* up = (const bf16_t*)&u; for (int i = 0; i < 4; ++i) m[i] += p * bf2f(up[i]); }
    float ss = 0.f; for (int i = 0; i < 4; ++i) { xv[i] += gate[c + i] * m[i]; ss += xv[i] * xv[i]; }
    ss = block_sum256(ss, red); float rs = rsqrtf(ss * (1.0f / D) + EPS);
    float4 o; o.x = xv[0] * rs * fg[c]; o.y = xv[1] * rs * fg[c + 1]; o.z = xv[2] * rs * fg[c + 2]; o.w = xv[3] * rs * fg[c + 3];
    *(float4*)(out + (size_t)row * D + c) = o;
}

#define LAS __attribute__((address_space(3)))
__device__ __forceinline__ int otid() { int t = threadIdx.x; asm volatile("" : "+v"(t)); return t; }
typedef short bf16x8 __attribute__((ext_vector_type(8)));
typedef float f32x4 __attribute__((ext_vector_type(4)));
typedef unsigned u32x4 __attribute__((ext_vector_type(4)));
typedef unsigned u32x2 __attribute__((ext_vector_type(2)));
typedef float f32x2 __attribute__((ext_vector_type(2)));

constexpr size_t OFF_ROPE = 7 * MiB;
constexpr size_t OFF_WT_IN = 8 * MiB;
constexpr size_t OFF_WT_QB = 25 * MiB;
constexpr size_t OFF_WT_KVB = 28 * MiB;
constexpr size_t OFF_WT_OUT = 29 * MiB;
constexpr size_t OFF_WT_GU = 104 * MiB;
constexpr size_t OFF_WT_DN = 232 * MiB;

struct Params {
    const float *x, *c, *ctx, *cctx, *w_mod, *b_mod, *g_mix, *w_in, *g_q, *w_qb, *g_kv, *w_kvb, *lbl, *g_hg, *w_out, *g_ffn, *w_r, *b_r, *w_gu, *b_gu, *w_dn, *b_dn, *g_fin;
    float* out; char* ws;
};

typedef __bf16 bf16v2_t __attribute__((ext_vector_type(2)));
__device__ __forceinline__ unsigned cvt_pk_bf16(float lo, float hi) { bf16v2_t v = {(__bf16)lo, (__bf16)hi}; return __builtin_bit_cast(unsigned, v); }

__device__ __forceinline__ unsigned pack4_fp8(float a, float b, float c, float d) {
    a = __builtin_amdgcn_fmed3f(a, -448.f, 448.f); b = __builtin_amdgcn_fmed3f(b, -448.f, 448.f); c = __builtin_amdgcn_fmed3f(c, -448.f, 448.f); d = __builtin_amdgcn_fmed3f(d, -448.f, 448.f);
    unsigned w = 0; w = __builtin_amdgcn_cvt_pk_fp8_f32(a, b, w, false); w = __builtin_amdgcn_cvt_pk_fp8_f32(c, d, w, true); return w; }

namespace pg8 {
constexpr int BM = 256, BK = 64, HALF = 128, HTB = HALF * BK * 2, STAGE_BYTES = 8 * HTB, NXCD = 8, WGM = 8;
__device__ __forceinline__ int lds_byte(int r, int c) { const int st = (r >> 4) * 2 + (c >> 5), rr = r & 15, cc = c & 31, ob = rr * 64 + cc * 2; return st * 1024 + (ob ^ (((ob >> 9) & 1) << 5)); }
__device__ __forceinline__ void stage_rc(int b, int& R, int& C) { const int st = b / 1024, sb = b % 1024, swz = sb ^ (((sb >> 9) & 1) << 5); R = (st >> 1) * 16 + swz / 64; C = (st & 1) * 32 + (swz % 64) / 2; }
__device__ __forceinline__ int perm32(int rho) { const int n = rho >> 4, i = rho & 15; return 8 * (i >> 2) + 4 * n + (i & 3); }
struct Unit { int pm, pn; const char* b; int e, pos0, cnt; };

__device__ __forceinline__ int xcd_remap(int L, int nwg) { const int q = nwg / NXCD, r = nwg % NXCD, xcd = L % NXCD, off = L / NXCD; return (xcd < r ? xcd * (q + 1) : r * (q + 1) + (xcd - r) * q) + off; }

struct DenseSched {
    int nM, nN, nwg, G, c, lda; const char* Bt; size_t btile;
    __device__ void init(int M, int N, int K, int lda_, const void* Bt_, int G_, int c_) { nM = M / BM; nN = N / BM; nwg = nM * nN; G = G_; c = c_; lda = lda_; Bt = (const char*)Bt_; btile = (size_t)BM * K * 2; }
    __device__ __forceinline__ void tile(int wgid, int& pm, int& pn) const { const int nig = WGM * nN, gid = wgid / nig, fm = gid * WGM, gsz = (nM - fm) < WGM ? (nM - fm) : WGM; pm = fm + ((wgid % nig) % gsz); pn = (wgid % nig) / gsz; }
    __device__ __forceinline__ bool next(int i, Unit& u) const { const int Lx = i * G + c; if (Lx >= nwg) return false; tile(xcd_remap(Lx, nwg), u.pm, u.pn); u.b = Bt + (size_t)u.pn * btile; u.e = 0; u.pos0 = 0; u.cnt = 0; return true; }
    __device__ __forceinline__ void aoff(const Unit& u, const int (&Rr)[2], const int (&Cc)[2], unsigned (&va)[2][2]) const {
#pragma unroll
        for (int h = 0; h < 2; ++h)
#pragma unroll
            for (int i = 0; i < 2; ++i) va[h][i] = (unsigned)((u.pm * BM + h * HALF + Rr[i]) * lda + Cc[i]) * 2u; }
};
struct InSched : DenseSched {
    __device__ void init2(const void* Bt_, int G_, int c_) { init(L, 8448, 1024, 1024, Bt_, G_, c_); }
    __device__ __forceinline__ bool next(int i, Unit& u) const {
        const int Lx = i * G + c; const int nlat = nwg;
        if (Lx < nlat) { tile(xcd_remap(Lx, nlat), u.pm, u.pn); }
        else { const int j = Lx - nlat; if (j >= 16 * 14) return false; const int q = j >> 4; u.pm = 128 + (j & 15); u.pn = q == 0 ? 3 : (q <= 12 ? 7 + q : 32); }
        u.b = Bt + (size_t)u.pn * btile; u.e = 0; u.pos0 = 0; u.cnt = 0; return true; }
};
template <bool GATHER> struct MoeSched {
    int nN, G, c, rowb; const char* Wt; size_t wexp, btile; const LAS int* tab; const int* list;
    __device__ __forceinline__ bool next(int i, Unit& u) const {
        const int nwg = tab[33] * nN; const int Lx = i * G + c; if (Lx >= nwg) return false;
        const int w = xcd_remap(Lx, nwg); const int rt = w / nN; u.pn = w % nN; u.pm = rt;
        int e = 0; while (tab[e + 1] <= rt) ++e;
        u.e = e; u.pos0 = (rt - tab[e]) * BM; u.cnt = tab[64 + e]; u.b = Wt + (size_t)e * wexp + (size_t)u.pn * btile; return true; }
    __device__ __forceinline__ void aoff(const Unit& u, const int (&Rr)[2], const int (&Cc)[2], unsigned (&va)[2][2]) const {
#pragma unroll
        for (int h = 0; h < 2; ++h)
#pragma unroll
            for (int i = 0; i < 2; ++i) {
                if (GATHER) { const int pos = u.pos0 + h * HALF + Rr[i]; const int pair = pos < u.cnt ? list[u.e * CAP + pos] : 0; va[h][i] = (unsigned)((pair >> 2) * rowb + Cc[i] * 2); }
                else va[h][i] = (unsigned)((u.pm * BM + h * HALF + Rr[i]) * rowb + Cc[i] * 2); } }
};

typedef int v8i_t __attribute__((ext_vector_type(8)));
typedef int i32x4_t __attribute__((ext_vector_type(4)));
template <class Epi, class Sched, bool FP8 = false, int SCA = 127, int SCB = 127>
__device__ __forceinline__ void gemm_phase(LAS unsigned char* lds, const char* Abase, const int K, const Sched& S, const Epi& E) {
    const int tid = otid(), wid = __builtin_amdgcn_readfirstlane(tid >> 6), lane = tid & 63, wr = wid >> 2, wc = wid & 3, fr = lane & 15, fq = lane >> 4;
    const int Kb = FP8 ? K : 2 * K;
    const int nt = Kb / (BK * 2);
    int Rr[2], Cc[2]; unsigned voffB[2];
#pragma unroll
    for (int i = 0; i < 2; ++i) { int R_, C_; stage_rc(tid * 16 + i * 8192, R_, C_); Rr[i] = R_; Cc[i] = C_; const int Rb = Epi::PERM ? ((R_ & ~31) + perm32(R_ & 31)) : R_; voffB[i] = (unsigned)(Rb * Kb + C_ * 2); }
    const size_t kstep = (size_t)(BK * 2);
    const size_t hstep = (size_t)HALF * Kb;
    const unsigned ldsw = (unsigned)wid * 1024u;
    const int aoff = lds_byte(wr * 64 + fr, fq * 8), boff = lds_byte(wc * 32 + fr, fq * 8);
#define PG8_SA(b, h) (((b) * 2 + (h)) * HTB)
#define PG8_SB(b, h) ((4 + (b) * 2 + (h)) * HTB)
#define PG8_STAGE_B(bufoff, gbase) do { _Pragma("unroll") for (int _i = 0; _i < 2; ++_i) \
        __builtin_amdgcn_global_load_lds((const unsigned*)((const char*)(gbase) + voffB[_i]), (LAS unsigned*)(lds + (bufoff) + ldsw + _i * 8192), 16, 0, 0); } while (0)
#define PG8_STAGE_A(bufoff, v0, v1, kb) do { \
        __builtin_amdgcn_global_load_lds((const unsigned*)(Abase + (kb) + (v0)), (LAS unsigned*)(lds + (bufoff) + ldsw), 16, 0, 0); \
        __builtin_amdgcn_global_load_lds((const unsigned*)(Abase + (kb) + (v1)), (LAS unsigned*)(lds + (bufoff) + ldsw + 8192), 16, 0, 0); } while (0)
#define PG8_LD16(addr) (*(const LAS i32x4_t*)(addr))
#define PG8_LDA(dst, b, h) do { _Pragma("unroll") for (int m = 0; m < 4; ++m) { if constexpr (FP8) dst##8[m] = __builtin_shufflevector(PG8_LD16(lds + PG8_SA(b, h) + aoff + m * 2048), PG8_LD16(lds + PG8_SA(b, h) + aoff + m * 2048 + 1024), 0, 1, 2, 3, 4, 5, 6, 7); \
        else { _Pragma("unroll") for (int k = 0; k < 2; ++k) dst[m][k] = *(const LAS bf16x8*)(lds + PG8_SA(b, h) + aoff + m * 2048 + k * 1024); } } } while (0)
#define PG8_LDB(dst, b, h) do { _Pragma("unroll") for (int n = 0; n < 2; ++n) { if constexpr (FP8) dst##8[n] = __builtin_shufflevector(PG8_LD16(lds + PG8_SB(b, h) + boff + n * 2048), PG8_LD16(lds + PG8_SB(b, h) + boff + n * 2048 + 1024), 0, 1, 2, 3, 4, 5, 6, 7); \
        else { _Pragma("unroll") for (int k = 0; k < 2; ++k) dst[n][k] = *(const LAS bf16x8*)(lds + PG8_SB(b, h) + boff + n * 2048 + k * 1024); } } } while (0)
#define PG8_MMA(ai, bj, At, Bt) do { __builtin_amdgcn_s_setprio(1); _Pragma("unroll") for (int m = 0; m < 4; ++m) _Pragma("unroll") for (int n = 0; n < 2; ++n) { \
        if constexpr (FP8) asm volatile("v_mfma_scale_f32_16x16x128_f8f6f4 %0, %1, %2, %0, %3, %4 op_sel_hi:[0,0,0]" : "+v"(acc[ai][bj][m][n]) : "v"(Bt##8[n]), "v"(At##8[m]), "v"(scb_), "v"(sca_)); \
        else { _Pragma("unroll") for (int k = 0; k < 2; ++k) acc[ai][bj][m][n] = __builtin_amdgcn_mfma_f32_16x16x32_bf16(Bt[n][k], At[m][k], acc[ai][bj][m][n], 0, 0, 0); } } \
        __builtin_amdgcn_s_setprio(0); } while (0)
#define PG8_WAIT_V(n) asm volatile("s_waitcnt vmcnt(" #n ")" ::: "memory")
#define PG8_WAIT_L(n) asm volatile("s_waitcnt lgkmcnt(" #n ")" ::: "memory")
#define PG8_BAR __builtin_amdgcn_s_barrier()
#define PG8_SCHED __builtin_amdgcn_sched_barrier(0)
    Unit cur, nxt; int ui = 0;
    if (!S.next(0, cur)) return;
    f32x4 acc[2][2][4][2];
#pragma unroll
    for (int a = 0; a < 2; ++a)
#pragma unroll
        for (int b = 0; b < 2; ++b)
#pragma unroll
            for (int m = 0; m < 4; ++m)
#pragma unroll
                for (int n = 0; n < 2; ++n) acc[a][b][m][n] = (f32x4){0.f, 0.f, 0.f, 0.f};
    const int sca_ = SCA, scb_ = SCB;
    bf16x8 At[4][2], B0[2][2], B1[2][2]; v8i_t At8[4], B08[2], B18[2];
    unsigned vc[2][2], vn[2][2];
    S.aoff(cur, Rr, Cc, vc);
    const char* cB = cur.b;
    PG8_STAGE_B(PG8_SB(0, 0), cB); PG8_STAGE_A(PG8_SA(0, 0), vc[0][0], vc[0][1], 0); PG8_STAGE_B(PG8_SB(0, 1), cB + hstep); PG8_STAGE_A(PG8_SA(0, 1), vc[1][0], vc[1][1], 0);
    if (wr == 1) PG8_BAR;
    PG8_WAIT_V(4); PG8_BAR;
    PG8_STAGE_B(PG8_SB(1, 0), cB + kstep); PG8_STAGE_A(PG8_SA(1, 0), vc[0][0], vc[0][1], kstep); PG8_STAGE_B(PG8_SB(1, 1), cB + hstep + kstep);
    PG8_WAIT_V(6); PG8_BAR;
    for (;;) {
        const bool has_next = S.next(ui + 1, nxt);
        if (has_next) S.aoff(nxt, Rr, Cc, vn);
        else {
#pragma unroll
            for (int h = 0; h < 2; ++h)
#pragma unroll
                for (int i = 0; i < 2; ++i) vn[h][i] = vc[h][i]; }
        const char* nB = has_next ? nxt.b : cB;
#pragma unroll 1
        for (int t = 0; t < nt; t += 2) {
            const bool last = (t == nt - 2);
            const size_t k1 = (size_t)(t + 1) * kstep;
            const size_t k2 = last ? 0 : (size_t)(t + 2) * kstep;
            const unsigned s00 = last ? vn[0][0] : vc[0][0], s01 = last ? vn[0][1] : vc[0][1], s10 = last ? vn[1][0] : vc[1][0], s11 = last ? vn[1][1] : vc[1][1];
            const char* b2 = last ? nB : cB + (size_t)(t + 2) * kstep; const char* b3 = b2 + kstep;
            PG8_LDB(B0, 0, 0); PG8_SCHED; PG8_LDA(At, 0, 0); PG8_STAGE_A(PG8_SA(1, 1), vc[1][0], vc[1][1], k1);
            PG8_WAIT_L(8); PG8_BAR; PG8_WAIT_L(0); PG8_MMA(0, 0, At, B0); PG8_BAR; PG8_SCHED;
            PG8_LDB(B1, 0, 1); PG8_STAGE_B(PG8_SB(0, 0), b2);
            PG8_BAR; PG8_WAIT_L(0); PG8_MMA(0, 1, At, B1); PG8_BAR; if constexpr (FP8) PG8_SCHED;
            PG8_LDA(At, 0, 1); PG8_STAGE_A(PG8_SA(0, 0), s00, s01, k2);
            PG8_BAR; PG8_WAIT_L(0); PG8_MMA(1, 0, At, B0); PG8_BAR; PG8_SCHED;
            PG8_STAGE_B(PG8_SB(0, 1), b2 + hstep);
            PG8_WAIT_V(6); PG8_BAR; PG8_MMA(1, 1, At, B1); PG8_BAR; if constexpr (FP8) PG8_SCHED;
            PG8_LDB(B0, 1, 0); PG8_SCHED; PG8_LDA(At, 1, 0); PG8_STAGE_A(PG8_SA(0, 1), s10, s11, k2);
            PG8_WAIT_L(8); PG8_BAR; PG8_WAIT_L(0); PG8_MMA(0, 0, At, B0); PG8_BAR; PG8_SCHED;
            PG8_LDB(B1, 1, 1); PG8_STAGE_B(PG8_SB(1, 0), b3);
            PG8_BAR; PG8_WAIT_L(0); PG8_MMA(0, 1, At, B1); PG8_BAR; if constexpr (FP8) PG8_SCHED;
            PG8_LDA(At, 1, 1); PG8_STAGE_A(PG8_SA(1, 0), s00, s01, k2 + kstep);
            PG8_BAR; PG8_WAIT_L(0); PG8_MMA(1, 0, At, B0); PG8_BAR; PG8_SCHED;
            PG8_STAGE_B(PG8_SB(1, 1), b3 + hstep);
            PG8_WAIT_V(6); PG8_BAR; PG8_MMA(1, 1, At, B1); PG8_BAR; if constexpr (FP8) PG8_SCHED;
        }
        if constexpr (FP8) asm volatile("s_nop 15\n\ts_nop 15" ::: "memory");
        E(acc, cur, wr, wc, fr, fq);
        if (!has_next) break;
#pragma unroll
        for (int a = 0; a < 2; ++a)
#pragma unroll
            for (int b = 0; b < 2; ++b)
#pragma unroll
                for (int m = 0; m < 4; ++m)
#pragma unroll
                    for (int n = 0; n < 2; ++n) acc[a][b][m][n] = (f32x4){0.f, 0.f, 0.f, 0.f};
        cur = nxt; cB = nB; ++ui;
#pragma unroll
        for (int h = 0; h < 2; ++h)
#pragma unroll
            for (int i = 0; i < 2; ++i) vc[h][i] = vn[h][i];
    }
    PG8_WAIT_V(0);
    if (wr == 0) PG8_BAR;
    PG8_BAR;
#undef PG8_SA
#undef PG8_SB
#undef PG8_STAGE_A
#undef PG8_STAGE_B
#undef PG8_LDA
#undef PG8_LDB
#undef PG8_MMA
#undef PG8_WAIT_V
#undef PG8_WAIT_L
#undef PG8_BAR
#undef PG8_SCHED
}

typedef f32x4 Acc[2][2][4][2];
__device__ __forceinline__ u32x4 pack8(const f32x4 v0, const f32x4 v1) { u32x4 w; w.x = cvt_pk_bf16(v0[0], v0[1]); w.y = cvt_pk_bf16(v0[2], v0[3]); w.z = cvt_pk_bf16(v1[0], v1[1]); w.w = cvt_pk_bf16(v1[2], v1[3]); return w; }

struct EpiIn { static constexpr bool PERM = true; char* ws;
    __device__ __forceinline__ void operator()(const Acc& acc, const Unit& u, int wr, int wc, int fr, int fq) const {
        const int pn = u.pn; size_t boff; int ld, cb;
        if (pn < 3) { boff = OFF_QA; ld = 768; cb = pn * 256; } else if (pn == 3) { boff = OFF_CKV; ld = 256; cb = 0; }
        else if (pn < 32) { boff = OFF_HQ + (size_t)((pn - 4) >> 2) * SEG_STRIDE; ld = 1024; cb = ((pn - 4) & 3) * 256; }
        else { boff = OFF_KR; ld = 64; cb = 0; }
        bf16_t* base = (bf16_t*)(ws + boff);
        const int row0 = u.pm * BM + wr * 64 + fr, col0 = wc * 32 + 8 * fq;
        if (pn == 32 && wc >= 2) return;
        float* ssq = (float*)(ws + (pn < 3 ? OFF_SSQQ : OFF_SSQKV));
#pragma unroll
        for (int ai = 0; ai < 2; ++ai)
#pragma unroll
            for (int m = 0; m < 4; ++m) { const int row = row0 + ai * HALF + m * 16; bf16_t* rowp = base + (size_t)row * ld + cb + col0;
                f32x4 v0 = acc[ai][0][m][0], v1 = acc[ai][0][m][1];
                if (pn >= 4 && pn < 8) { f32x4 w0 = acc[ai][1][m][0], w1 = acc[ai][1][m][1];
#pragma unroll
                    for (int j = 0; j < 4; ++j) { v0[j] = siluf_(v0[j]) * 0.08838834764831845f; v1[j] = siluf_(v1[j]) * 0.08838834764831845f; w0[j] = siluf_(w0[j]) * 0.08838834764831845f; w1[j] = siluf_(w1[j]) * 0.08838834764831845f; }
                    *(u32x4*)rowp = pack8(v0, v1); *(u32x4*)(rowp + HALF) = pack8(w0, w1); continue; }
                *(u32x4*)rowp = pack8(v0, v1);
                if (pn != 32) { const f32x4 w0 = acc[ai][1][m][0], w1 = acc[ai][1][m][1]; *(u32x4*)(rowp + HALF) = pack8(w0, w1);
                    if (pn <= 3) { float ss = (v0[0] * v0[0] + v0[1] * v0[1]) + (v0[2] * v0[2] + v0[3] * v0[3]) + (v1[0] * v1[0] + v1[1] * v1[1]) + (v1[2] * v1[2] + v1[3] * v1[3])
                                          + (w0[0] * w0[0] + w0[1] * w0[1]) + (w0[2] * w0[2] + w0[3] * w0[3]) + (w1[0] * w1[0] + w1[1] * w1[1]) + (w1[2] * w1[2] + w1[3] * w1[3]);
                        ss += __shfl_xor(ss, 16); ss += __shfl_xor(ss, 32); if (fq == 0) atomicAdd(ssq + row, ss); } } }
    } };

struct EpiQ { static constexpr bool PERM = true; bf16_t* q; const float* ssq;
    __device__ __forceinline__ void operator()(const Acc& acc, const Unit& u, int wr, int wc, int fr, int fq) const {
        const int row0 = u.pm * BM + wr * 64 + fr, col0 = u.pn * BM + wc * 32 + 8 * fq;
#pragma unroll
        for (int ai = 0; ai < 2; ++ai)
#pragma unroll
            for (int m = 0; m < 4; ++m) { const int row = row0 + ai * HALF + m * 16; const float rs = rsqrtf(ssq[row] * (1.0f / 768.0f) + EPS); bf16_t* rowp = q + (size_t)row * 1536 + col0;
#pragma unroll
                for (int bj = 0; bj < 2; ++bj) *(u32x4*)(rowp + bj * HALF) = pack8(acc[ai][bj][m][0] * rs, acc[ai][bj][m][1] * rs); }
    } };

struct EpiKV { static constexpr bool PERM = true; bf16_t *Kb, *Vb; const float* ssq;
    __device__ __forceinline__ void operator()(const Acc& acc, const Unit& u, int wr, int wc, int fr, int fq) const {
        const int row0 = u.pm * BM + wr * 64 + fr, col0 = wc * 32 + 8 * fq;
#pragma unroll
        for (int ai = 0; ai < 2; ++ai)
#pragma unroll
            for (int m = 0; m < 4; ++m) { const int row = row0 + ai * HALF + m * 16; const float rs = rsqrtf(ssq[row] * (1.0f / 256.0f) + EPS);
                int b, pos; if (row < L) { b = row >> 11; pos = row & 2047; } else { b = (row - L) >> 8; pos = SEQ + ((row - L) & 255); }
                const size_t kvrow = (size_t)(b * 8 + u.pn) * NKEY + pos;
                *(u32x4*)(Kb + kvrow * 192 + col0) = pack8(acc[ai][0][m][0] * rs, acc[ai][0][m][1] * rs);
                *(u32x4*)(Vb + kvrow * 128 + col0) = pack8(acc[ai][1][m][0] * rs, acc[ai][1][m][1] * rs); }
    } };

struct EpiOut { static constexpr bool PERM = false; float* x1; const float* x; const float* modv;
    __device__ __forceinline__ void operator()(const Acc& acc, const Unit& u, int wr, int wc, int fr, int fq) const {
        const int row0 = u.pm * BM + wr * 64 + fr, col0 = u.pn * BM + wc * 32 + 4 * fq;
#pragma unroll
        for (int ai = 0; ai < 2; ++ai)
#pragma unroll
            for (int m = 0; m < 4; ++m) { const int row = row0 + ai * HALF + m * 16; const float* gate = modv + (row >> 11) * 6144 + 2 * 1024 + col0; const float* xr = x + (size_t)row * D + col0; float* o = x1 + (size_t)row * D + col0;
#pragma unroll
                for (int bj = 0; bj < 2; ++bj)
#pragma unroll
                    for (int n = 0; n < 2; ++n) { const int co = bj * HALF + n * 16; const f32x4 g = *(const f32x4*)(gate + co), xv = *(const f32x4*)(xr + co); *(f32x4*)(o + co) = xv + g * acc[ai][bj][m][n]; } }
    } };

struct EpiMoe1 { static constexpr bool PERM = true; unsigned char* act; const float* bgu;
    __device__ __forceinline__ void operator()(const Acc& acc, const Unit& u, int wr, int wc, int fr, int fq) const {
        const int row0 = u.pm * BM + wr * 64 + fr, o0 = u.pn * 128 + wc * 16 + 4 * fq;
        f32x4 bg[2], bl[2];
#pragma unroll
        for (int bj = 0; bj < 2; ++bj) { const float* bp = bgu + u.e * 2048 + 2 * (o0 + bj * 64); const f32x4 t0 = *(const f32x4*)bp, t1 = *(const f32x4*)(bp + 4);
            bg[bj] = (f32x4){t0[0], t0[2], t1[0], t1[2]}; bl[bj] = (f32x4){t0[1], t0[3], t1[1], t1[3]}; }
#pragma unroll
        for (int ai = 0; ai < 2; ++ai)
#pragma unroll
            for (int m = 0; m < 4; ++m) { const int row = row0 + ai * HALF + m * 16; unsigned char* rowp = act + (size_t)row * D + o0;
#pragma unroll
                for (int bj = 0; bj < 2; ++bj) { const f32x4 g4 = acc[ai][bj][m][0] + bg[bj], l4 = acc[ai][bj][m][1] + bl[bj]; float r[4];
#pragma unroll
                    for (int j = 0; j < 4; ++j) { const float glu = fminf(g4[j], 7.0f), lin = __builtin_amdgcn_fmed3f(l4[j], -7.0f, 7.0f); r[j] = 4.0f * glu * __builtin_amdgcn_rcpf(1.0f + __builtin_amdgcn_exp2f(-2.4554669595930157f * glu)) * (lin + 1.0f); }
                    *(unsigned*)(rowp + bj * 64) = pack4_fp8(r[0], r[1], r[2], r[3]); } }
    } };

struct EpiMoe2 { static constexpr bool PERM = true; bf16_t* yp; const float* bd; const int* list;
    __device__ __forceinline__ void operator()(const Acc& acc, const Unit& u, int wr, int wc, int fr, int fq) const {
        const int r0 = wr * 64 + fr, col0 = u.pn * BM + wc * 32 + 8 * fq;
        f32x4 bv[2][2];
#pragma unroll
        for (int bj = 0; bj < 2; ++bj)
#pragma unroll
            for (int n = 0; n < 2; ++n) bv[bj][n] = *(const f32x4*)(bd + u.e * 1024 + col0 + bj * HALF + 4 * n);
#pragma unroll
        for (int ai = 0; ai < 2; ++ai)
#pragma unroll
            for (int m = 0; m < 4; ++m) { const int pos = u.pos0 + r0 + ai * HALF + m * 16; if (pos < u.cnt) { const int pair = list[u.e * CAP + pos]; bf16_t* rowp = yp + (size_t)pair * D + col0;
#pragma unroll
                for (int bj = 0; bj < 2; ++bj) *(u32x4*)(rowp + bj * HALF) = pack8(acc[ai][bj][m][0] + bv[bj][0], acc[ai][bj][m][1] + bv[bj][1]); } }
    } };
}

__device__ __forceinline__ int conv_src_col(int kind, int c) {
    if (kind == 0) return c;
    if (kind == 1) { if (c < 1024) return c; if (c < 8192) return c + 64; if (c < 8256) return c - 8192 + 1024; return -1; }
    const int pn = c >> 8, p = c & 255, bj = p >> 7, wc = (p >> 5) & 3, fq = (p >> 3) & 3, n = (p >> 2) & 1, i = p & 3; const int o = 128 * pn + 64 * bj + 16 * wc + 4 * fq + i; return 2 * o + n;
}
template <bool F8>
__device__ __forceinline__ void conv_tile(LAS float* tl, const float* __restrict__ W, int ldw, void* Wtv, int K, int kind, const float* __restrict__ kscale, int k0, int c0) {
    const int tid = otid(); const int cc = tid & 127, kq = tid >> 7, sc = conv_src_col(kind, c0 + cc);
    float v[32];
#pragma unroll
    for (int i = 0; i < 32; ++i) { const int kk = kq + 4 * i; v[i] = sc >= 0 ? W[(size_t)(k0 + kk) * ldw + sc] : 0.f; }
    if (kscale) {
#pragma unroll
        for (int i = 0; i < 32; ++i) v[i] *= kscale[k0 + kq + 4 * i]; }
#pragma unroll
    for (int i = 0; i < 32; ++i) tl[(kq + 4 * i) * 129 + cc] = v[i];
    __syncthreads();
    { const int c2 = tid >> 2, kb = (tid & 3) * 8;
#pragma unroll
      for (int q = 0; q < 4; ++q) { float t[8];
#pragma unroll
          for (int j = 0; j < 8; ++j) t[j] = tl[(q * 32 + kb + j) * 129 + c2];
          if constexpr (F8) { unsigned char* dst = (unsigned char*)Wtv + (size_t)(c0 + c2) * K + k0 + kb + q * 32;
              u32x2 w; w.x = pack4_fp8(t[0] * 32.f, t[1] * 32.f, t[2] * 32.f, t[3] * 32.f); w.y = pack4_fp8(t[4] * 32.f, t[5] * 32.f, t[6] * 32.f, t[7] * 32.f); *(u32x2*)dst = w; }
          else { bf16_t* dst = (bf16_t*)Wtv + (size_t)(c0 + c2) * K + k0 + kb + q * 32;
              u32x4 w; w.x = cvt_pk_bf16(t[0], t[1]); w.y = cvt_pk_bf16(t[2], t[3]); w.z = cvt_pk_bf16(t[4], t[5]); w.w = cvt_pk_bf16(t[6], t[7]); *(u32x4*)dst = w; } } }
    __syncthreads();
}
template <bool F8 = false>
__device__ __forceinline__ void conv_matrix(LAS float* tl, const float* W, int ldw, void* Wt, int K, int Nout, int kind, const float* kscale, int& tctr) {
    const int nk = K / 128, ntile = nk * (Nout / 128);
    int t = ((int)blockIdx.x - tctr) % (int)gridDim.x; if (t < 0) t += gridDim.x;
    for (; t < ntile; t += gridDim.x) conv_tile<F8>(tl, W, ldw, Wt, K, kind, kscale, (t % nk) * 128, (t / nk) * 128);
    tctr = (tctr + ntile) % (int)gridDim.x;
}

__device__ __forceinline__ float half_sum256(float v, LAS float* red) {
    for (int o = 32; o > 0; o >>= 1) v += __shfl_xor(v, o);
    const int w = otid() >> 6, hb = (otid() >> 8) * 4; if ((otid() & 63) == 0) red[w] = v; __syncthreads();
    const float t = red[hb] + red[hb + 1] + red[hb + 2] + red[hb + 3]; __syncthreads(); return t;
}

__device__ __forceinline__ void phase0(const Params& p, LAS unsigned char* lds) {
    char* ws = p.ws; const int tid = otid(), gsz = gridDim.x * 512, gid = blockIdx.x * 512 + tid;
    float* lb = (float*)(ws + OFF_LB); int* cnt = (int*)(ws + OFF_CNT); float* ssqq = (float*)(ws + OFF_SSQQ); float* ssqkv = (float*)(ws + OFF_SSQKV); float* modv = (float*)(ws + OFF_MOD);
    for (int i = gid; i < 2048; i += gsz) { const int d = i >> 10, j = i & 1023; const float a = p.lbl[(d * 2 + 0) * 1024 + j], b = p.lbl[(d * 2 + 1) * 1024 + j]; lb[i] = 1.0f / (1.0f + __expf(b - a)); }
    for (int i = gid; i < 32; i += gsz) cnt[i] = 0;
    { float* ropet = (float*)(ws + OFF_ROPE); for (int i = gid; i < SEQ * 32; i += gsz) { const int t = i >> 5, j = i & 31; float cs, sn; rope_cs(t, j, cs, sn); ropet[t * 64 + j] = cs; ropet[t * 64 + 32 + j] = sn; } }
    for (int i = gid; i < L; i += gsz) ssqq[i] = 0.f;
    for (int i = gid; i < R; i += gsz) ssqkv[i] = 0.f;
    { LAS float* sil = (LAS float*)lds;
      LAS float* part = (LAS float*)(lds + 17 * 1024 * 4);
      bool loaded = false;
      for (int item = blockIdx.x; item < 96; item += gridDim.x) {
          if (!loaded) { for (int i = tid; i < 17 * 1024; i += 512) { const int r = i >> 10, k = i & 1023; sil[i] = siluf_(r < 16 ? p.c[r * 1024 + k] : p.cctx[k]); } loaded = true; __syncthreads(); }
          const int j = tid & 63, ks = tid >> 6; float a[17];
#pragma unroll
          for (int r = 0; r < 17; ++r) a[r] = 0.f;
          for (int k = ks * 128; k < ks * 128 + 128; ++k) { const float w = p.w_mod[(size_t)k * 6144 + item * 64 + j];
#pragma unroll
              for (int r = 0; r < 17; ++r) a[r] += sil[r * 1024 + k] * w; }
#pragma unroll
          for (int r = 0; r < 17; ++r) part[(ks * 17 + r) * 64 + j] = a[r];
          __syncthreads();
          for (int i = tid; i < 17 * 64; i += 512) { const int r = i >> 6, jj = i & 63; float s = p.b_mod[item * 64 + jj]; for (int q = 0; q < 8; ++q) s += part[(q * 17 + r) * 64 + jj]; modv[r * 6144 + item * 64 + jj] = s; }
          __syncthreads();
      } }
    __syncthreads();
    { LAS float* tl = (LAS float*)lds; int tctr = 0;
      conv_matrix(tl, p.w_in, 8256, (bf16_t*)(ws + OFF_WT_IN), 1024, 8448, 1, nullptr, tctr);
      conv_matrix(tl, p.w_qb, 1536, (bf16_t*)(ws + OFF_WT_QB), 768, 1536, 0, p.g_q, tctr);
      conv_matrix(tl, p.w_kvb, 2048, (bf16_t*)(ws + OFF_WT_KVB), 256, 2048, 0, p.g_kv, tctr);
      conv_matrix(tl, p.w_out, 1024, (bf16_t*)(ws + OFF_WT_OUT), 1024, 1024, 0, nullptr, tctr); }
}

__device__ __forceinline__ float wave_sum(float v) {
#pragma unroll
    for (int o = 32; o > 0; o >>= 1) v += __shfl_xor(v, o);
    return v; }
__device__ __forceinline__ void phase1(const Params& p, LAS unsigned char* lds) {
    const float* modv = (const float*)(p.ws + OFF_MOD); bf16_t* h = (bf16_t*)(p.ws + OFF_H);
    const int tid = otid(), lane = tid & 63, gw = blockIdx.x * 8 + (tid >> 6), nw = gridDim.x * 8, c0 = lane * 8;
    f32x4 g[4];
#pragma unroll
    for (int q = 0; q < 4; ++q) g[q] = *(const f32x4*)(p.g_mix + (q >> 1) * 512 + c0 + (q & 1) * 4);
    for (int row0 = gw; row0 < R; row0 += 2 * nw) {
        f32x4 v[2][4]; const bool two = row0 + nw < R;
#pragma unroll
        for (int u = 0; u < 2; ++u) { const int row = (u == 0 || two) ? row0 + u * nw : row0; const float* src = row < L ? p.x + (size_t)row * D : p.ctx + (size_t)(row - L) * D;
#pragma unroll
            for (int q = 0; q < 4; ++q) v[u][q] = *(const f32x4*)(src + (q >> 1) * 512 + c0 + (q & 1) * 4); }
#pragma unroll
        for (int u = 0; u < 2; ++u) { if (u == 1 && !two) break; const int row = row0 + u * nw; const float* mod = modv + (row < L ? row / SEQ : 16) * 6144;
            float ss = 0.f;
#pragma unroll
            for (int q = 0; q < 4; ++q) ss += (v[u][q][0] * v[u][q][0] + v[u][q][1] * v[u][q][1]) + (v[u][q][2] * v[u][q][2] + v[u][q][3] * v[u][q][3]);
            const float rs = rsqrtf(wave_sum(ss) * (1.0f / D) + EPS);
#pragma unroll
            for (int j = 0; j < 2; ++j) { f32x4 o[2];
#pragma unroll
                for (int e = 0; e < 2; ++e) { const int cc = j * 512 + c0 + e * 4; const f32x4 sc = *(const f32x4*)(mod + 1024 + cc), sh = *(const f32x4*)(mod + cc); o[e] = v[u][j * 2 + e] * rs * g[j * 2 + e] * (sc + 1.0f) + sh; }
                u32x4 w; w.x = cvt_pk_bf16(o[0][0], o[0][1]); w.y = cvt_pk_bf16(o[0][2], o[0][3]); w.z = cvt_pk_bf16(o[1][0], o[1][1]); w.w = cvt_pk_bf16(o[1][2], o[1][3]);
                *(u32x4*)(h + (size_t)row * D + j * 512 + c0) = w; } }
    }
}

__device__ __forceinline__ SegOut make_seg(char* ws) { SegOut so; so.qa = (bf16_t*)(ws + OFF_QA); so.ckv = (bf16_t*)(ws + OFF_CKV); so.kr = (bf16_t*)(ws + OFF_KR); so.hq = (bf16_t*)(ws + OFF_HQ); so.ff = (bf16_t*)(ws + OFF_FF);
    so.fb = (bf16_t*)(ws + OFF_FB); so.iv = (bf16_t*)(ws + OFF_IV); so.og = (bf16_t*)(ws + OFF_OG); so.gm = (bf16_t*)(ws + OFF_GM); so.gh = (bf16_t*)(ws + OFF_GH); return so; }

__device__ __forceinline__ void phase2(const Params& p, LAS unsigned char* lds) {
    pg8::InSched S; S.init2(p.ws + OFF_WT_IN, gridDim.x, blockIdx.x);
    pg8::EpiIn E{p.ws};
    pg8::gemm_phase(lds, (const char*)(p.ws + OFF_H), 1024, S, E);
}
__device__ __forceinline__ void phase3(const Params& p, LAS unsigned char* lds) {
    char* ws = p.ws;
    { pg8::DenseSched S; S.init(L, 1536, 768, 768, ws + OFF_WT_QB, gridDim.x, blockIdx.x); pg8::EpiQ E{(bf16_t*)(ws + OFF_Q), (const float*)(ws + OFF_SSQQ)}; pg8::gemm_phase(lds, (const char*)(ws + OFF_QA), 768, S, E); }
    { pg8::DenseSched S; S.init(R, 2048, 256, 256, ws + OFF_WT_KVB, gridDim.x, blockIdx.x); pg8::EpiKV E{(bf16_t*)(ws + OFF_K), (bf16_t*)(ws + OFF_V), (const float*)(ws + OFF_SSQKV)}; pg8::gemm_phase(lds, (const char*)(ws + OFF_CKV), 256, S, E); }
    { const bf16_t* kr = (const bf16_t*)(ws + OFF_KR); bf16_t* Kb = (bf16_t*)(ws + OFF_K); const float* ropet = (const float*)(ws + OFF_ROPE);
      for (int gid = blockIdx.x * 512 + otid(); gid < R * 32; gid += gridDim.x * 512) { const int row = gid >> 5, i = gid & 31;
          const float x1 = bf2f(kr[(size_t)row * 64 + i]), x2 = bf2f(kr[(size_t)row * 64 + 32 + i]); float o1 = x1, o2 = x2; int b, pos;
          if (row < L) { b = row / SEQ; pos = row % SEQ; const float cs = ropet[pos * 64 + i], sn = ropet[pos * 64 + 32 + i]; o1 = x1 * cs - x2 * sn; o2 = x1 * sn + x2 * cs; } else { b = (row - L) / CTXL; pos = SEQ + (row - L) % CTXL; }
          const bf16_t w1 = f2bf(o1), w2 = f2bf(o2);
          for (int h = 0; h < 8; ++h) { bf16_t* q = Kb + ((size_t)(b * 8 + h) * NKEY + pos) * 192 + 128; q[i] = w1; q[32 + i] = w2; } } }
}
__device__ __forceinline__ void unpack8(const u32x4 w, float (&o)[8]) {
    o[0] = __uint_as_float(w.x << 16); o[1] = __uint_as_float(w.x & 0xffff0000u); o[2] = __uint_as_float(w.y << 16); o[3] = __uint_as_float(w.y & 0xffff0000u);
    o[4] = __uint_as_float(w.z << 16); o[5] = __uint_as_float(w.z & 0xffff0000u); o[6] = __uint_as_float(w.w << 16); o[7] = __uint_as_float(w.w & 0xffff0000u); }
__device__ __forceinline__ void phase4(const Params& p, LAS unsigned char*) {
    char* ws = p.ws; bf16_t* y = (bf16_t*)(ws + OFF_H); const bf16_t* of = (const bf16_t*)(ws + OFF_OF); const bf16_t* ob = (const bf16_t*)(ws + OFF_OB);
    const bf16_t* og = (const bf16_t*)(ws + OFF_OG); const bf16_t* gm = (const bf16_t*)(ws + OFF_GM); const bf16_t* gh = (const bf16_t*)(ws + OFF_GH);
    const int tid = otid(), lane = tid & 63, gw = blockIdx.x * 8 + (tid >> 6), nw = gridDim.x * 8, c0 = lane * 8;
    float gg[8];
#pragma unroll
    for (int i = 0; i < 8; ++i) gg[i] = p.g_hg[(c0 + i) & 127];
    for (int row = gw; row < L; row += nw) {
        u32x4 ra[2], rb[2], r1[2], r2[2], r3[2], rm[2];
#pragma unroll
        for (int j = 0; j < 2; ++j) { const size_t off = (size_t)row * D + j * 512 + c0; ra[j] = *(const u32x4*)(of + off); rb[j] = *(const u32x4*)(ob + off); r1[j] = *(const u32x4*)(og + off); r2[j] = *(const u32x4*)(gm + off); r3[j] = *(const u32x4*)(gh + off); rm[j] = *(const u32x4*)(y + off); }
#pragma unroll
        for (int j = 0; j < 2; ++j) { float a[8], b[8], g1[8], g2[8], g3[8], ym[8], o[8]; unpack8(ra[j], a); unpack8(rb[j], b); unpack8(r1[j], g1); unpack8(r2[j], g2); unpack8(r3[j], g3); unpack8(rm[j], ym);
            float ss = 0.f;
#pragma unroll
            for (int i = 0; i < 8; ++i) { o[i] = a[i] + b[i]; ss += o[i] * o[i]; }
            ss += __shfl_xor(ss, 1); ss += __shfl_xor(ss, 2); ss += __shfl_xor(ss, 4); ss += __shfl_xor(ss, 8);
            const float rs = rsqrtf(ss * (1.0f / 128.0f) + EPS); float r[8];
#pragma unroll
            for (int i = 0; i < 8; ++i) { const float yh = o[i] * rs * gg[i] * siluf_(g1[i]); r[i] = sigmoidf_(g2[i]) * ym[i] + sigmoidf_(g3[i]) * yh; }
            u32x4 w; w.x = cvt_pk_bf16(r[0], r[1]); w.y = cvt_pk_bf16(r[2], r[3]); w.z = cvt_pk_bf16(r[4], r[5]); w.w = cvt_pk_bf16(r[6], r[7]);
            *(u32x4*)(y + (size_t)row * D + j * 512 + c0) = w; }
    }
}
__device__ __forceinline__ void phase5(const Params& p, LAS unsigned char* lds) {
    char* ws = p.ws;
    { pg8::DenseSched S; S.init(L, 1024, 1024, 1024, ws + OFF_WT_OUT, gridDim.x, blockIdx.x); pg8::EpiOut E{p.out, p.x, (const float*)(ws + OFF_MOD)}; pg8::gemm_phase(lds, (const char*)(ws + OFF_H), 1024, S, E); }
    { LAS float* tl = (LAS float*)lds; int tctr = 0;
      for (int e = 0; e < NE; ++e) conv_matrix<true>(tl, p.w_gu + (size_t)e * 1024 * 2048, 2048, (unsigned char*)(ws + OFF_WT_GU) + (size_t)e * 2048 * 1024, 1024, 2048, 2, nullptr, tctr);
      for (int e = 0; e < NE; ++e) conv_matrix<true>(tl, p.w_dn + (size_t)e * 1024 * 1024, 1024, (unsigned char*)(ws + OFF_WT_DN) + (size_t)e * 1024 * 1024, 1024, 1024, 0, nullptr, tctr); }
}
__device__ __forceinline__ void phase6(const Params& p, LAS unsigned char* lds) {
    char* ws = p.ws; const float* modv = (const float*)(ws + OFF_MOD); unsigned char* h2 = (unsigned char*)(ws + OFF_H); int* topi = (int*)(ws + OFF_TOPI); float* topp = (float*)(ws + OFF_TOPP); int* cnt = (int*)(ws + OFF_CNT); int* list = (int*)(ws + OFF_LIST);
    LAS float* hs = (LAS float*)lds;
    LAS float* lg = (LAS float*)(lds + 131072);
    LAS int* lcnt = (LAS int*)(lds + 131072 + 4096);
    LAS int* lent = (LAS int*)(lds + 131072 + 4096 + 512);
    const int tid = otid(), lane = tid & 63, wid = tid >> 6, c0 = lane * 8;
    if (tid < 96) lcnt[tid] = 0;
    f32x4 g[4];
#pragma unroll
    for (int q = 0; q < 4; ++q) g[q] = *(const f32x4*)(p.g_ffn + (q >> 1) * 512 + c0 + (q & 1) * 4);
    __syncthreads();
    int it = 0;
    for (int tile = blockIdx.x; tile < L / 32; tile += gridDim.x, ++it) {
        const int rbase = tile * 32;
        f32x4 v[4][4];
#pragma unroll
        for (int u = 0; u < 4; ++u)
#pragma unroll
            for (int q = 0; q < 4; ++q) v[u][q] = *(const f32x4*)(p.out + (size_t)(rbase + wid * 4 + u) * D + (q >> 1) * 512 + c0 + (q & 1) * 4);
#pragma unroll
        for (int u = 0; u < 4; ++u) { const int rl = wid * 4 + u, row = rbase + rl; const float* mod = modv + (row / SEQ) * 6144; float ss = 0.f;
#pragma unroll
            for (int q = 0; q < 4; ++q) ss += (v[u][q][0] * v[u][q][0] + v[u][q][1] * v[u][q][1]) + (v[u][q][2] * v[u][q][2] + v[u][q][3] * v[u][q][3]);
            const float rs = rsqrtf(wave_sum(ss) * (1.0f / D) + EPS);
#pragma unroll
            for (int j = 0; j < 2; ++j) { f32x4 o[2];
#pragma unroll
                for (int e = 0; e < 2; ++e) { const int cc = j * 512 + c0 + e * 4; const f32x4 sc = *(const f32x4*)(mod + 4 * 1024 + cc), sh = *(const f32x4*)(mod + 3 * 1024 + cc); o[e] = v[u][j * 2 + e] * rs * g[j * 2 + e] * (sc + 1.0f) + sh;
                    *(LAS f32x4*)(hs + rl * 1024 + cc) = o[e]; }
                u32x2 w; w.x = pack4_fp8(o[0][0], o[0][1], o[0][2], o[0][3]); w.y = pack4_fp8(o[1][0], o[1][1], o[1][2], o[1][3]);
                *(u32x2*)(h2 + (size_t)row * D + j * 512 + c0) = w; } }
        __syncthreads();
        { const int e = tid & 31, rg = tid >> 5; const LAS float* h0 = hs + (2 * rg) * 1024; const LAS float* h1 = h0 + 1024; float a0 = 0.f, a1 = 0.f;
          for (int j = 0; j < 1024; j += 8) { float w[8];
#pragma unroll
              for (int q = 0; q < 8; ++q) w[q] = p.w_r[(j + q) * 32 + e];
              const f32x4 x0 = *(const LAS f32x4*)(h0 + j), x1 = *(const LAS f32x4*)(h0 + j + 4), y0 = *(const LAS f32x4*)(h1 + j), y1 = *(const LAS f32x4*)(h1 + j + 4);
              a0 += x0[0] * w[0]; a0 += x0[1] * w[1]; a0 += x0[2] * w[2]; a0 += x0[3] * w[3]; a0 += x1[0] * w[4]; a0 += x1[1] * w[5]; a0 += x1[2] * w[6]; a0 += x1[3] * w[7];
              a1 += y0[0] * w[0]; a1 += y0[1] * w[1]; a1 += y0[2] * w[2]; a1 += y0[3] * w[3]; a1 += y1[0] * w[4]; a1 += y1[1] * w[5]; a1 += y1[2] * w[6]; a1 += y1[3] * w[7]; }
          const float be = p.b_r[e]; lg[(2 * rg) * 32 + e] = a0 + be; lg[(2 * rg + 1) * 32 + e] = a1 + be; }
        __syncthreads();
#pragma unroll
        for (int rep = 0; rep < 2; ++rep) { const int rl = wid * 4 + rep * 2 + (lane >> 5), row = rbase + rl, e = lane & 31; float cur = lg[rl * 32 + e];
            float tv0 = 0.f, sum = 0.f; int sel_i[4]; float sel_e[4];
#pragma unroll
            for (int k = 0; k < 4; ++k) { float m = cur; int mi = e;
#pragma unroll
                for (int o2 = 16; o2 > 0; o2 >>= 1) { const float om = __shfl_xor(m, o2); const int oi = __shfl_xor(mi, o2); if (om > m || (om == m && oi < mi)) { m = om; mi = oi; } }
                if (k == 0) tv0 = m; sel_i[k] = mi; sel_e[k] = __expf(m - tv0); sum += sel_e[k]; if (e == mi) cur = -3.0e38f; }
            int myk = 0; float myp = 0.f;
#pragma unroll
            for (int k = 0; k < 4; ++k) if (e == k) { myk = sel_i[k]; myp = sel_e[k] / sum; }
            if (e < 4) { const int pair = row * 4 + e; topi[pair] = myk; topp[pair] = myp; __hip_atomic_fetch_add(&lcnt[myk], 1, __ATOMIC_RELAXED, __HIP_MEMORY_SCOPE_WORKGROUP); lent[(it * 32 + rl) * 4 + e] = myk; } }
        __syncthreads();
    }
    if (tid < 32) { const int n = lcnt[tid]; lcnt[32 + tid] = n > 0 ? atomicAdd(&cnt[tid], n) : 0; lcnt[64 + tid] = 0; }
    __syncthreads();
    const int nent = it * 128;
    for (int s = tid; s < nent; s += 512) { const int e = lent[s]; const int ii = s >> 7, rl = (s >> 2) & 31, k = s & 3; const int row = (blockIdx.x + ii * gridDim.x) * 32 + rl;
        const int pos = lcnt[32 + e] + __hip_atomic_fetch_add(&lcnt[64 + e], 1, __ATOMIC_RELAXED, __HIP_MEMORY_SCOPE_WORKGROUP); list[e * CAP + pos] = row * 4 + k; }
}
__device__ __forceinline__ void moe_table(const int* cnt, LAS int* tab) {
    if (otid() == 0) { int t = 0; for (int e = 0; e < NE; ++e) { tab[e] = t; const int n = cnt[e]; tab[64 + e] = n; t += (n + 255) >> 8; } tab[32] = t; tab[33] = t; }
    __syncthreads();
}
constexpr int LDS_TAB = pg8::STAGE_BYTES;
__device__ __forceinline__ void phase7(const Params& p, LAS unsigned char* lds) {
    char* ws = p.ws; LAS int* tab = (LAS int*)(lds + LDS_TAB); moe_table((const int*)(ws + OFF_CNT), tab);
    pg8::MoeSched<true> S; S.nN = 8; S.G = gridDim.x; S.c = blockIdx.x; S.rowb = 1024; S.Wt = ws + OFF_WT_GU; S.wexp = (size_t)2048 * 1024; S.btile = (size_t)256 * 1024; S.tab = tab; S.list = (const int*)(ws + OFF_LIST);
    pg8::EpiMoe1 E{(unsigned char*)(ws + OFF_ACT), p.b_gu};
    pg8::gemm_phase<pg8::EpiMoe1, pg8::MoeSched<true>, true, 127, 122>(lds, (const char*)(ws + OFF_H), 1024, S, E);
}
__device__ __forceinline__ void phase8(const Params& p, LAS unsigned char* lds) {
    char* ws = p.ws; LAS int* tab = (LAS int*)(lds + LDS_TAB); moe_table((const int*)(ws + OFF_CNT), tab);
    pg8::MoeSched<false> S; S.nN = 4; S.G = gridDim.x; S.c = blockIdx.x; S.rowb = 1024; S.Wt = ws + OFF_WT_DN; S.wexp = (size_t)1024 * 1024; S.btile = (size_t)256 * 1024; S.tab = tab; S.list = (const int*)(ws + OFF_LIST);
    pg8::EpiMoe2 E{(bf16_t*)(ws + OFF_YP), p.b_dn, (const int*)(ws + OFF_LIST)};
    pg8::gemm_phase<pg8::EpiMoe2, pg8::MoeSched<false>, true, 125, 122>(lds, (const char*)(ws + OFF_ACT), 1024, S, E);
}
__device__ __forceinline__ void phase9(const Params& p, LAS unsigned char* lds) {
    char* ws = p.ws; const float* modv = (const float*)(ws + OFF_MOD); const bf16_t* yp = (const bf16_t*)(ws + OFF_YP); const float* topp = (const float*)(ws + OFF_TOPP);
    const int tid = otid(), lane = tid & 63, gw = blockIdx.x * 8 + (tid >> 6), nw = gridDim.x * 8, c0 = lane * 8;
    f32x4 fg[4];
#pragma unroll
    for (int q = 0; q < 4; ++q) fg[q] = *(const f32x4*)(p.g_fin + (q >> 1) * 512 + c0 + (q & 1) * 4);
    for (int row = gw; row < L; row += nw) {
        const float* gate = modv + (row / SEQ) * 6144 + 5 * 1024; f32x4 v[4]; u32x4 yr[4][2];
#pragma unroll
        for (int q = 0; q < 4; ++q) v[q] = *(const f32x4*)(p.out + (size_t)row * D + (q >> 1) * 512 + c0 + (q & 1) * 4);
#pragma unroll
        for (int k = 0; k < 4; ++k)
#pragma unroll
            for (int j = 0; j < 2; ++j) yr[k][j] = *(const u32x4*)(yp + (size_t)(row * 4 + k) * D + j * 512 + c0);
        const f32x4 pk = *(const f32x4*)(topp + row * 4);
        float m[16];
#pragma unroll
        for (int i = 0; i < 16; ++i) m[i] = 0.f;
#pragma unroll
        for (int k = 0; k < 4; ++k)
#pragma unroll
            for (int j = 0; j < 2; ++j) { float t[8]; unpack8(yr[k][j], t);
#pragma unroll
                for (int i = 0; i < 8; ++i) m[j * 8 + i] += pk[k] * t[i]; }
        float ss = 0.f;
#pragma unroll
        for (int q = 0; q < 4; ++q) { const f32x4 gt = *(const f32x4*)(gate + (q >> 1) * 512 + c0 + (q & 1) * 4);
#pragma unroll
            for (int i = 0; i < 4; ++i) { v[q][i] += gt[i] * m[q * 4 + i]; ss += v[q][i] * v[q][i]; } }
        const float rs = rsqrtf(wave_sum(ss) * (1.0f / D) + EPS);
#pragma unroll
        for (int q = 0; q < 4; ++q) *(f32x4*)(p.out + (size_t)row * D + (q >> 1) * 512 + c0 + (q & 1) * 4) = v[q] * rs * fg[q];
    }
}

namespace at {
using s16x4  = __attribute__((ext_vector_type(4))) short;
using f32x16 = __attribute__((ext_vector_type(16))) float;
constexpr int NW = 8, QBLK = 32, KVBLK = 64, DK = 192, DV = 128;
constexpr float SCALE = 0.07216878364870322f;
constexpr float THR = 8.f;
constexpr int SHM_V = KVBLK * DV * 2, SHM_K = KVBLK * DK * 2, SHM_ATTN = 2 * SHM_V + 2 * SHM_K + NW * 64 * 4;
#define KSWZ(row, colB) ((row) * 384 + ((colB) ^ (((row) & 7) << 4)))
#define SBAR() __builtin_amdgcn_sched_barrier(0)
__device__ __forceinline__ int crow(int r, int hi) { return (r & 3) + 8 * (r >> 2) + 4 * hi; }
__device__ __forceinline__ unsigned cvtpk(float lo, float hi) { return cvt_pk_bf16(lo, hi); }

__device__ __forceinline__ void partialSM(f32x16& p0, f32x16& p1, float& m_reg, float& mn, float& alpha) {
  constexpr float C = SCALE * 1.4426950408889634f;
  float pmax = p0[0];
#pragma unroll
  for (int r = 1; r < 16; ++r) pmax = fmaxf(pmax, p0[r]);
#pragma unroll
  for (int r = 0; r < 16; ++r) pmax = fmaxf(pmax, p1[r]);
  { auto rr = __builtin_amdgcn_permlane32_swap(__float_as_uint(pmax), __float_as_uint(pmax), false, false);
    pmax = fmaxf(__uint_as_float(rr[0]), __uint_as_float(rr[1])); }
  if (__builtin_expect(__all(pmax - m_reg <= THR / SCALE), 1)) { mn = m_reg; alpha = 1.f; }
  else { mn = fmaxf(m_reg, pmax); alpha = __builtin_amdgcn_exp2f((m_reg - mn) * C); m_reg = mn; }
  float mnC = -mn * C;
#pragma unroll
  for (int r = 0; r < 16; ++r) p0[r] = fmaf(p0[r], C, mnC);
#pragma unroll
  for (int r = 0; r < 16; ++r) p1[r] = fmaf(p1[r], C, mnC);
#pragma unroll
  for (int r = 0; r < 16; ++r) p0[r] = __builtin_amdgcn_exp2f(p0[r]);
}
__device__ __forceinline__ void finishSM(f32x16& p0, f32x16& p1, float alpha, float& l_reg, bf16x8& pa0, bf16x8& pa1, bf16x8& pa2, bf16x8& pa3) {
#pragma unroll
  for (int r = 0; r < 16; ++r) p1[r] = __builtin_amdgcn_exp2f(p1[r]);
  float ps = 0;
#pragma unroll
  for (int r = 0; r < 16; ++r) ps += p0[r];
#pragma unroll
  for (int r = 0; r < 16; ++r) ps += p1[r];
  { auto rr = __builtin_amdgcn_permlane32_swap(__float_as_uint(ps), __float_as_uint(ps), false, false);
    ps = __uint_as_float(rr[0]) + __uint_as_float(rr[1]); }
  l_reg = l_reg * alpha + ps;
#define PK4(P, BASE, OUT) do { unsigned a0 = cvtpk(P[BASE + 0], P[BASE + 1]), a1 = cvtpk(P[BASE + 2], P[BASE + 3]);   \
    unsigned b0 = cvtpk(P[BASE + 4], P[BASE + 5]), b1 = cvtpk(P[BASE + 6], P[BASE + 7]);                              \
    auto r0 = __builtin_amdgcn_permlane32_swap(a0, b0, false, false); auto r1 = __builtin_amdgcn_permlane32_swap(a1, b1, false, false); \
    u32x4 w = {r0[0], r1[0], r0[1], r1[1]}; OUT = *reinterpret_cast<bf16x8*>(&w); } while (0)
  PK4(p0, 0, pa0); PK4(p0, 8, pa1); PK4(p1, 0, pa2); PK4(p1, 8, pa3);
#undef PK4
}
__device__ __forceinline__ void qkt(f32x16& p0, f32x16& p1, const LAS char* Ks, const bf16x8 (&qr)[12], int r32, int hi) {
  p0 = f32x16{}; p1 = f32x16{};
#pragma unroll
  for (int d0 = 0; d0 < 12; ++d0) { const int cb = (d0 * 16 + hi * 8) * 2;
    const bf16x8 b0 = *reinterpret_cast<const LAS bf16x8*>(Ks + KSWZ(r32, cb));
    const bf16x8 b1 = *reinterpret_cast<const LAS bf16x8*>(Ks + KSWZ(32 + r32, cb));
    p0 = __builtin_amdgcn_mfma_f32_32x32x16_bf16(b0, qr[d0], p0, 0, 0, 0);
    p1 = __builtin_amdgcn_mfma_f32_32x32x16_bf16(b1, qr[d0], p1, 0, 0, 0); }
}
__device__ __forceinline__ int v_st(int k, int c) { const int kk = (k & ~0xC) | ((k & 4) << 1) | ((k & 8) >> 1); return ((kk >> 3) * 4 + (c >> 5)) * 512 + ((kk & 7) * 32 + (c & 31)) * 2; }
__device__ __forceinline__ int v_rd_base(int lane) { return ((lane & 3) << 3) | (((lane >> 2) & 3) << 6) | (((lane >> 4) & 1) << 5) | (((lane >> 5) & 1) << 8); }
constexpr int v_rd_off(int d0, int ks, int half) { return d0 * 512 + ks * 4096 + half * 2048; }
template <int OFF> __device__ __forceinline__ s16x4 tr_read(int vb) { s16x4 r; asm volatile("ds_read_b64_tr_b16 %0, %1 offset:%2" : "=&v"(r) : "v"(vb), "i"(OFF) : "memory"); return r; }
template <int D0> __device__ __forceinline__ void pv_one(f32x16& od, int vb, bf16x8 pa0, bf16x8 pa1, bf16x8 pa2, bf16x8 pa3) {
  const s16x4 l0 = tr_read<v_rd_off(D0, 0, 0)>(vb), h0 = tr_read<v_rd_off(D0, 0, 1)>(vb), l1 = tr_read<v_rd_off(D0, 1, 0)>(vb), h1 = tr_read<v_rd_off(D0, 1, 1)>(vb);
  const s16x4 l2 = tr_read<v_rd_off(D0, 2, 0)>(vb), h2 = tr_read<v_rd_off(D0, 2, 1)>(vb), l3 = tr_read<v_rd_off(D0, 3, 0)>(vb), h3 = tr_read<v_rd_off(D0, 3, 1)>(vb);
  asm volatile("s_waitcnt lgkmcnt(0)" ::: "memory"); SBAR();
#define PK(Lo, Hi) (bf16x8){Lo[0], Lo[1], Lo[2], Lo[3], Hi[0], Hi[1], Hi[2], Hi[3]}
  od = __builtin_amdgcn_mfma_f32_32x32x16_bf16(pa0, PK(l0, h0), od, 0, 0, 0);
  od = __builtin_amdgcn_mfma_f32_32x32x16_bf16(pa1, PK(l1, h1), od, 0, 0, 0);
  od = __builtin_amdgcn_mfma_f32_32x32x16_bf16(pa2, PK(l2, h2), od, 0, 0, 0);
  od = __builtin_amdgcn_mfma_f32_32x32x16_bf16(pa3, PK(l3, h3), od, 0, 0, 0);
#undef PK
}
__device__ __forceinline__ void pv_d0(f32x16 (&o)[4], int vb, bf16x8 pa0, bf16x8 pa1, bf16x8 pa2, bf16x8 pa3) {
  pv_one<0>(o[0], vb, pa0, pa1, pa2, pa3); pv_one<1>(o[1], vb, pa0, pa1, pa2, pa3); pv_one<2>(o[2], vb, pa0, pa1, pa2, pa3); pv_one<3>(o[3], vb, pa0, pa1, pa2, pa3);
}

__device__ __forceinline__ void attn_unit(const bf16_t* __restrict__ Qb, const bf16_t* __restrict__ Kh, const bf16_t* __restrict__ Vh, bf16_t* __restrict__ Ob, int t0, const float* __restrict__ ropet, LAS char* lds) {
  constexpr int LDQ = 1536, LDO = 1024, NT = NKEY / KVBLK;
  const int tid = otid(), wid = tid >> 6, lane = tid & 63, r32 = lane & 31, hi = lane >> 5;
  LAS char* V_lds = lds; LAS char* K_lds = lds + 2 * SHM_V;
  LAS float* wsl = (LAS float*)(lds + 2 * SHM_V + 2 * SHM_K) + wid * 64; LAS float* li_l = wsl; LAS float* al_l = wsl + 32;
  float m_reg = -1e30f, l_reg = 0; f32x16 o[4] = {}; bf16x8 qr[12];
  { const bf16_t* Qw = Qb + (size_t)(wid * QBLK + r32) * LDQ + hi * 8;
#pragma unroll
    for (int d0 = 0; d0 < 12; ++d0) qr[d0] = *reinterpret_cast<const bf16x8*>(Qw + d0 * 16);
    const float* rt = ropet + (size_t)(t0 + wid * QBLK + r32) * 64 + 8 * hi;
#pragma unroll
    for (int g = 0; g < 2; ++g) {
      const f32x4 c0 = *(const f32x4*)(rt + 16 * g), c1 = *(const f32x4*)(rt + 16 * g + 4), s0 = *(const f32x4*)(rt + 32 + 16 * g), s1 = *(const f32x4*)(rt + 32 + 16 * g + 4);
      float n1[8], n2[8];
#pragma unroll
      for (int j = 0; j < 8; ++j) { const float cs = j < 4 ? c0[j & 3] : c1[j & 3], sn = j < 4 ? s0[j & 3] : s1[j & 3];
        const float x1 = bf2f((bf16_t)qr[8 + g][j]), x2 = bf2f((bf16_t)qr[10 + g][j]); n1[j] = x1 * cs - x2 * sn; n2[j] = x1 * sn + x2 * cs; }
      u32x4 w1 = {cvtpk(n1[0], n1[1]), cvtpk(n1[2], n1[3]), cvtpk(n1[4], n1[5]), cvtpk(n1[6], n1[7])}; u32x4 w2 = {cvtpk(n2[0], n2[1]), cvtpk(n2[2], n2[3]), cvtpk(n2[4], n2[5]), cvtpk(n2[6], n2[7])};
      qr[8 + g] = *reinterpret_cast<bf16x8*>(&w1); qr[10 + g] = *reinterpret_cast<bf16x8*>(&w2); } }
  const int sr = tid >> 4, sc = (tid & 15) * 8, vst0 = v_st(sr, sc), vst1 = v_st(32 + sr, sc);
  int kgo[3], kst[3];
#pragma unroll
  for (int i = 0; i < 3; ++i) { const int c = tid + 512 * i, row = c / 24, c8 = (c % 24) * 8; kgo[i] = row * DK + c8; kst[i] = KSWZ(row, c8 * 2); }
  const int vb0 = (int)(uintptr_t)V_lds + v_rd_base(lane);
  bf16x8 sv0, sv1, sk0, sk1, sk2;
#define SLOAD(k0) do { sv0 = *reinterpret_cast<const bf16x8*>(&Vh[(size_t)((k0) + sr) * DV + sc]); sv1 = *reinterpret_cast<const bf16x8*>(&Vh[(size_t)((k0) + 32 + sr) * DV + sc]); \
    sk0 = *reinterpret_cast<const bf16x8*>(&Kh[(size_t)(k0) * DK + kgo[0]]); sk1 = *reinterpret_cast<const bf16x8*>(&Kh[(size_t)(k0) * DK + kgo[1]]); sk2 = *reinterpret_cast<const bf16x8*>(&Kh[(size_t)(k0) * DK + kgo[2]]); } while (0)
#define SWRITE(b) do { *(LAS bf16x8*)(V_lds + (b) * SHM_V + vst0) = sv0; *(LAS bf16x8*)(V_lds + (b) * SHM_V + vst1) = sv1; \
    *(LAS bf16x8*)(K_lds + (b) * SHM_K + kst[0]) = sk0; *(LAS bf16x8*)(K_lds + (b) * SHM_K + kst[1]) = sk1; *(LAS bf16x8*)(K_lds + (b) * SHM_K + kst[2]) = sk2; } while (0)
#define RESC(a) do { if (__any((a) < 1.f)) { if (hi == 0) al_l[r32] = (a); asm volatile("s_waitcnt lgkmcnt(0)" ::: "memory"); \
    _Pragma("unroll") for (int d = 0; d < 4; ++d) _Pragma("unroll") for (int r = 0; r < 16; ++r) o[d][r] *= al_l[crow(r, hi)]; } } while (0)
  f32x16 p0, p1; float mn, al; bf16x8 pa0, pa1, pa2, pa3;
  SLOAD(0); asm volatile("s_waitcnt vmcnt(0)" ::: "memory"); SWRITE(0); __syncthreads();
  for (int j = 0; j < NT; ++j) {
    const int bsel = j & 1;
    if (j + 1 < NT) SLOAD((j + 1) * KVBLK);
    SBAR(); qkt(p0, p1, K_lds + bsel * SHM_K, qr, r32, hi);
    partialSM(p0, p1, m_reg, mn, al);
    RESC(al);
    finishSM(p0, p1, al, l_reg, pa0, pa1, pa2, pa3); SBAR();
    pv_d0(o, vb0 + bsel * SHM_V, pa0, pa1, pa2, pa3);
    if (j + 1 < NT) { asm volatile("s_waitcnt vmcnt(0)" ::: "memory"); SWRITE(bsel ^ 1); }
    __syncthreads();
  }
  if (hi == 0) li_l[r32] = l_reg; asm volatile("s_waitcnt lgkmcnt(0)" ::: "memory");
  float rli[16];
#pragma unroll
  for (int r = 0; r < 16; ++r) rli[r] = __builtin_amdgcn_rcpf(li_l[crow(r, hi)]);
  bf16_t* Ow = Ob + (size_t)(wid * QBLK) * LDO;
#pragma unroll
  for (int r = 0; r < 16; ++r) { const int orow = crow(r, hi);
#pragma unroll
    for (int d0 = 0; d0 < 4; ++d0) Ow[(size_t)orow * LDO + d0 * 32 + r32] = f2bf(o[d0][r] * rli[r]); }
#undef SLOAD
#undef SWRITE
#undef RESC
}
}

__device__ __forceinline__ void phase_attn(const Params& p, LAS unsigned char* lds) {
    char* ws = p.ws; const bf16_t* Q = (const bf16_t*)(ws + OFF_Q); const bf16_t* Kb = (const bf16_t*)(ws + OFF_K); const bf16_t* Vb = (const bf16_t*)(ws + OFF_V); bf16_t* Y = (bf16_t*)(ws + OFF_H);
    const int G = gridDim.x;
    for (int it = 0;; ++it) {
        int u;
        if (G == 256) { const int c = blockIdx.x, xcd = c & 7, j = c >> 3; if (it >= 4) break; u = ((it * 32 + xcd * 4 + (j >> 3)) << 3) | (j & 7); }
        else { u = it * G + blockIdx.x; if (u >= 1024) break; }
        const int bh = u >> 3, qb = u & 7, b = bh >> 3, h = bh & 7;
        at::attn_unit(Q + ((size_t)(b * SEQ + qb * 256)) * 1536 + h * 192, Kb + (size_t)bh * NKEY * 192, Vb + (size_t)bh * NKEY * 128, Y + ((size_t)(b * SEQ + qb * 256)) * D + h * 128, qb * 256, (const float*)(ws + OFF_ROPE), (LAS char*)lds);
        __syncthreads();
    }
}

namespace sc {
using f32x16 = __attribute__((ext_vector_type(16))) float;
constexpr int O_QI = 0, O_QG = 16384, O_KT = 32768, O_KE = 73728, O_VT = 90112, O_AT = 106496, O_SC = 114688, O_DEC = 147456, O_TOT = 147456 + 512, LDS_SCAN = 147456 + 512 + 4096;
__device__ __forceinline__ int sw256(int row, int cb) { return row * 256 + (cb ^ ((row & 15) << 4)); }
__device__ __forceinline__ int sw128(int row, int cb) { return row * 128 + (cb ^ (((row >> 1) & 7) << 4)); }
__device__ __forceinline__ int crow(int r, int hi) { return (r & 3) + 8 * (r >> 2) + 4 * hi; }
__device__ __forceinline__ int grow_of(int n, int b, int dir) { if (n < CTXL) { const int s = dir ? (CTXL - 1 - n) : n; return L + b * CTXL + s; } const int m = n - CTXL; return b * SEQ + (dir ? (SEQ - 1 - m) : m); }

__device__ __forceinline__ void scan_unit(const Params& p, int unit, LAS unsigned char* lds) {
    char* ws = p.ws; const int dir = unit & 1, h = (unit >> 1) & 7, b = unit >> 4;
    const bf16_t* hq = (const bf16_t*)(ws + OFF_HQ); const bf16_t* fz = (const bf16_t*)(ws + (dir ? OFF_FB : OFF_FF)); const bf16_t* iv = (const bf16_t*)(ws + OFF_IV);
    bf16_t* outp = (bf16_t*)(ws + (dir ? OFF_OB : OFF_OF)); const float* lb = (const float*)(ws + OFF_LB);
    const int tid = otid(), wid = tid >> 6, lane = tid & 63, r32 = lane & 31, hi = lane >> 5;
    const int cp = lane, sb = __builtin_amdgcn_readfirstlane(wid), J = sb >> 1;
    const float lbv0 = lb[dir * 1024 + h * 128 + 2 * cp], lbv1 = lb[dir * 1024 + h * 128 + 2 * cp + 1];
    const int hc = h * 128 + 2 * cp; const int sgn = dir ? -1 : 1; const long rstep = (long)sgn * D;
    LAS unsigned char* QI = lds + O_QI; LAS unsigned char* QG = lds + O_QG; LAS unsigned char* KT = lds + O_KT; LAS unsigned char* KE = lds + O_KE; LAS unsigned char* VT = lds + O_VT;
    LAS unsigned char* AT = lds + O_AT; LAS unsigned char* SCp = lds + O_SC; LAS float* DEC = (LAS float*)(lds + O_DEC); LAS float* TOT = (LAS float*)(lds + O_TOT);
    for (int i = tid; i < (8192 + 32768) / 16; i += 512) *(LAS u32x4*)(lds + O_AT + i * 16) = (u32x4){0u, 0u, 0u, 0u};
    f32x16 S0 = {}, S1 = {};
    const int tb = wid & 1, dvb = wid >> 1;
    unsigned zr[8], vr[8], qr[8];
#define SC_LOAD_Z(c) do { const bf16_t* pz_ = fz + (size_t)(grow_of((c) * 64, b, dir) + sgn * (8 * sb)) * D + hc; _Pragma("unroll") for (int i = 0; i < 8; ++i) { zr[i] = *(const unsigned*)pz_; pz_ += rstep; } } while (0)
#define SC_LOAD_VQ(c) do { const size_t o0_ = (size_t)(grow_of((c) * 64, b, dir) + sgn * (8 * sb)) * D + hc; const bf16_t* pv_ = iv + o0_; const bf16_t* pq_ = hq + o0_; \
        _Pragma("unroll") for (int i = 0; i < 8; ++i) { vr[i] = *(const unsigned*)pv_; pv_ += rstep; if ((c) >= 4) { qr[i] = *(const unsigned*)pq_; pq_ += rstep; } } } while (0)
    SC_LOAD_Z(0); SC_LOAD_VQ(0);
    __syncthreads();
    for (int c = 0; c < 36; ++c) {
        const bool lat = c >= 4;
        {
            float kk0[8], kk1[8], lc0[8], lc1[8]; float run0 = 0.f, run1 = 0.f;
#pragma unroll
            for (int i = 0; i < 8; ++i) { const float z0 = __uint_as_float(zr[i] << 16), z1 = __uint_as_float(zr[i] & 0xffff0000u);
                const float f0 = lbv0 + (1.0f - lbv0) * sigmoidf_(z0), f1 = lbv1 + (1.0f - lbv1) * sigmoidf_(z1); kk0[i] = 1.0f - f0; kk1[i] = 1.0f - f1;
                run0 += __builtin_amdgcn_logf(f0) * 0.6931471805599453f; run1 += __builtin_amdgcn_logf(f1) * 0.6931471805599453f; lc0[i] = run0; lc1[i] = run1; }
            if (c + 1 < 36) SC_LOAD_Z(c + 1);
            *(LAS f32x2*)(TOT + sb * 128 + 2 * cp) = (f32x2){run0, run1};
            __syncthreads();
            float P0 = 0.f, P1 = 0.f, c0J0 = 0.f, c0J1 = 0.f, c010 = 0.f, c011 = 0.f, c020 = 0.f, c021 = 0.f, c030 = 0.f, c031 = 0.f, last0 = 0.f, last1 = 0.f;
            { float a0 = 0.f, a1 = 0.f;
#pragma unroll
              for (int q = 0; q < 8; ++q) { if (q == sb) { P0 = a0; P1 = a1; } if (q == 2 * J) { c0J0 = a0; c0J1 = a1; } if (q == 2) { c010 = a0; c011 = a1; } if (q == 4) { c020 = a0; c021 = a1; } if (q == 6) { c030 = a0; c031 = a1; }
                  const f32x2 tq = *(const LAS f32x2*)(TOT + q * 128 + 2 * cp); a0 += tq[0]; a1 += tq[1]; }
              last0 = a0; last1 = a1; }
            const float off0 = P0 - c0J0, off1 = P1 - c0J1;
            const float eg0 = __expf(c0J0), eg1 = __expf(c0J1), ee0 = __expf(last0 - c0J0), ee1 = __expf(last1 - c0J1);
            const float e10 = __expf(c010 - c0J0), e11 = __expf(c011 - c0J1), e20 = __expf(c020 - c0J0), e21 = __expf(c021 - c0J1), e30 = __expf(c030 - c0J0), e31 = __expf(c031 - c0J1);
            if (sb == 0) *(LAS f32x2*)(DEC + 2 * cp) = (f32x2){__expf(last0), __expf(last1)};
            unsigned ke0[4], ke1[4], vt0[4], vt1[4];
#pragma unroll
            for (int i = 0; i < 8; ++i) { const int t = 8 * sb + i; const float l0 = lc0[i] + off0, l1 = lc1[i] + off1;
                const float kd0 = kk0[i] * __expf(fminf(-l0, 80.0f)), kd1 = kk1[i] * __expf(fminf(-l1, 80.0f));
                if (lat) { const float q0 = __uint_as_float(qr[i] << 16), q1 = __uint_as_float(qr[i] & 0xffff0000u); const float qi0 = q0 * __expf(l0), qi1 = q1 * __expf(l1);
                    *(LAS unsigned*)(QI + sw256(t, 4 * cp)) = cvt_pk_bf16(qi0, qi1); *(LAS unsigned*)(QG + sw256(t, 4 * cp)) = cvt_pk_bf16(qi0 * eg0, qi1 * eg1);
                    if (J == 0) { *(LAS unsigned*)(KT + sw256(0 + t, 4 * cp)) = cvt_pk_bf16(kd0, kd1); *(LAS unsigned*)(KT + sw256(16 + t, 4 * cp)) = cvt_pk_bf16(kd0 * e10, kd1 * e11);
                                  *(LAS unsigned*)(KT + sw256(48 + t, 4 * cp)) = cvt_pk_bf16(kd0 * e20, kd1 * e21); *(LAS unsigned*)(KT + sw256(96 + t, 4 * cp)) = cvt_pk_bf16(kd0 * e30, kd1 * e31); }
                    else if (J == 1) { *(LAS unsigned*)(KT + sw256(16 + t, 4 * cp)) = cvt_pk_bf16(kd0, kd1); *(LAS unsigned*)(KT + sw256(48 + t, 4 * cp)) = cvt_pk_bf16(kd0 * e20, kd1 * e21); *(LAS unsigned*)(KT + sw256(96 + t, 4 * cp)) = cvt_pk_bf16(kd0 * e30, kd1 * e31); }
                    else if (J == 2) { *(LAS unsigned*)(KT + sw256(48 + t, 4 * cp)) = cvt_pk_bf16(kd0, kd1); *(LAS unsigned*)(KT + sw256(96 + t, 4 * cp)) = cvt_pk_bf16(kd0 * e30, kd1 * e31); }
                    else { *(LAS unsigned*)(KT + sw256(96 + t, 4 * cp)) = cvt_pk_bf16(kd0, kd1); } }
                const float kf0 = kd0 * ee0, kf1 = kd1 * ee1;
                if (i & 1) { ke0[i >> 1] = cvt_pk_bf16(__uint_as_float(ke0[i >> 1]), kf0); ke1[i >> 1] = cvt_pk_bf16(__uint_as_float(ke1[i >> 1]), kf1); vt0[i >> 1] = (vt0[i >> 1] >> 16) | (vr[i] << 16); vt1[i >> 1] = (vt1[i >> 1] >> 16) | (vr[i] & 0xffff0000u); }
                else { ke0[i >> 1] = __float_as_uint(kf0); ke1[i >> 1] = __float_as_uint(kf1); vt0[i >> 1] = vr[i] << 16; vt1[i >> 1] = vr[i] & 0xffff0000u; }
            }
            *(LAS u32x4*)(KE + sw128(2 * cp, 16 * sb)) = (u32x4){ke0[0], ke0[1], ke0[2], ke0[3]}; *(LAS u32x4*)(KE + sw128(2 * cp + 1, 16 * sb)) = (u32x4){ke1[0], ke1[1], ke1[2], ke1[3]};
            *(LAS u32x4*)(VT + sw128(2 * cp, 16 * sb)) = (u32x4){vt0[0], vt0[1], vt0[2], vt0[3]}; *(LAS u32x4*)(VT + sw128(2 * cp + 1, 16 * sb)) = (u32x4){vt1[0], vt1[1], vt1[2], vt1[3]};
        }
        if (c + 1 < 36) SC_LOAD_VQ(c + 1);
        __syncthreads();
        if (lat) {
#pragma unroll
            for (int rep = 0; rep < 2; ++rep) { const int ti = wid + 8 * rep; if (ti < 10) {
                const int I = ti < 1 ? 0 : (ti < 3 ? 1 : (ti < 6 ? 2 : 3)); const int Jt = ti - (I * (I + 1)) / 2; const int kbase = I == 0 ? 0 : (I == 1 ? 16 : (I == 2 ? 48 : 96));
                const int l15 = lane & 15, lq = lane >> 4; f32x4 a = {0.f, 0.f, 0.f, 0.f};
#pragma unroll
                for (int ks = 0; ks < 4; ++ks) { const bf16x8 av = *(const LAS bf16x8*)(QI + sw256(16 * I + l15, (32 * ks + 8 * lq) * 2)); const bf16x8 bv = *(const LAS bf16x8*)(KT + sw256(kbase + 16 * Jt + l15, (32 * ks + 8 * lq) * 2));
                    a = __builtin_amdgcn_mfma_f32_16x16x32_bf16(av, bv, a, 0, 0, 0); }
#pragma unroll
                for (int r = 0; r < 4; ++r) { const int tl = 4 * lq + r; float v = a[r]; if (I == Jt && l15 > tl) v = 0.f; *(LAS bf16_t*)(AT + sw128(16 * I + tl, (16 * Jt + l15) * 2)) = f2bf(v); } } }
        }
        __syncthreads();
        {
            if (lat) {
                f32x16 o = {};
#pragma unroll
                for (int ks = 0; ks < 8; ++ks) { const bf16x8 av = *(const LAS bf16x8*)(QG + sw256(32 * tb + r32, (16 * ks + 8 * hi) * 2)); const bf16x8 bv = *(const LAS bf16x8*)(SCp + sw256(32 * dvb + r32, (16 * ks + 8 * hi) * 2));
                    o = __builtin_amdgcn_mfma_f32_32x32x16_bf16(av, bv, o, 0, 0, 0); }
#pragma unroll
                for (int ks = 0; ks < 4; ++ks) { if (ks < 2 || tb == 1) { const bf16x8 av = *(const LAS bf16x8*)(AT + sw128(32 * tb + r32, (16 * ks + 8 * hi) * 2)); const bf16x8 bv = *(const LAS bf16x8*)(VT + sw128(32 * dvb + r32, (16 * ks + 8 * hi) * 2));
                    o = __builtin_amdgcn_mfma_f32_32x32x16_bf16(av, bv, o, 0, 0, 0); } }
                bf16_t* po = outp + (size_t)(grow_of(c * 64, b, dir) + sgn * (32 * tb + 4 * hi)) * D + h * 128 + 32 * dvb + r32;
#pragma unroll
                for (int r = 0; r < 16; ++r) po[(long)((r & 3) + 8 * (r >> 2)) * rstep] = f2bf(o[r]);
            }
#pragma unroll
            for (int r = 0; r < 16; ++r) { S0[r] *= DEC[64 * tb + crow(r, hi)]; S1[r] *= DEC[64 * tb + 32 + crow(r, hi)]; }
#pragma unroll
            for (int ks = 0; ks < 4; ++ks) { const bf16x8 bv = *(const LAS bf16x8*)(VT + sw128(32 * dvb + r32, (16 * ks + 8 * hi) * 2));
                const bf16x8 a0 = *(const LAS bf16x8*)(KE + sw128(64 * tb + r32, (16 * ks + 8 * hi) * 2)), a1 = *(const LAS bf16x8*)(KE + sw128(64 * tb + 32 + r32, (16 * ks + 8 * hi) * 2));
                S0 = __builtin_amdgcn_mfma_f32_32x32x16_bf16(a0, bv, S0, 0, 0, 0); S1 = __builtin_amdgcn_mfma_f32_32x32x16_bf16(a1, bv, S1, 0, 0, 0); }
        }
        __syncthreads();
#pragma unroll
        for (int g = 0; g < 4; ++g) { const int dv = 32 * dvb + r32; const int dk0 = 64 * tb + 8 * g + 4 * hi;
            u32x2 w0; w0.x = cvt_pk_bf16(S0[4 * g], S0[4 * g + 1]); w0.y = cvt_pk_bf16(S0[4 * g + 2], S0[4 * g + 3]); *(LAS u32x2*)(SCp + sw256(dv, dk0 * 2)) = w0;
            u32x2 w1; w1.x = cvt_pk_bf16(S1[4 * g], S1[4 * g + 1]); w1.y = cvt_pk_bf16(S1[4 * g + 2], S1[4 * g + 3]); *(LAS u32x2*)(SCp + sw256(dv, (dk0 + 32) * 2)) = w1; }
    }
    __syncthreads();
#undef SC_LOAD_Z
#undef SC_LOAD_VQ
}
}
__device__ __forceinline__ void phase_scan(const Params& p, LAS unsigned char* lds) {
    for (int u = blockIdx.x; u < 256; u += gridDim.x) sc::scan_unit(p, u, lds);
}

constexpr int LDS_BYTES = 155648;
template <int PH> __global__ void __launch_bounds__(512, 2) k_phase(Params p) {
    extern __shared__ __attribute__((aligned(16))) unsigned char smem[];
    LAS unsigned char* lds = (LAS unsigned char*)smem;
    if constexpr (PH == 0) phase0(p, lds);
    if constexpr (PH == 1) phase1(p, lds);
    if constexpr (PH == 2) phase2(p, lds);
    if constexpr (PH == 3) phase3(p, lds);
    if constexpr (PH == 4) phase4(p, lds);
    if constexpr (PH == 5) phase5(p, lds);
    if constexpr (PH == 6) phase6(p, lds);
    if constexpr (PH == 7) phase7(p, lds);
    if constexpr (PH == 8) phase8(p, lds);
    if constexpr (PH == 9) phase9(p, lds);
    if constexpr (PH == 10) phase_attn(p, lds);
    if constexpr (PH == 11) phase_scan(p, lds);
}

#include <cstdint>
#include <cstdlib>
#include <vector>

#define XB_TMO      128
#define XB_XCNT(j)  (256  + 64 * (j))
#define XB_XSUB(j)  (1280 + 64 * (j))
#define XB_XGEN(j)  (2304 + 64 * (j))
#define XB_TOP      3328
#define XB_TOPGEN   3392
#define XCD_BAR_WORDS 3456
#define XB_SPIN_CAP (1u << 18)

__device__ __forceinline__ unsigned xb_ld(unsigned* p)              { return __hip_atomic_load(p, __ATOMIC_RELAXED, __HIP_MEMORY_SCOPE_AGENT); }
__device__ __forceinline__ unsigned xb_add(unsigned* p, unsigned v) { return __hip_atomic_fetch_add(p, v, __ATOMIC_RELAXED, __HIP_MEMORY_SCOPE_AGENT); }
__device__ __forceinline__ unsigned xb_xcc_id() { return (unsigned)__builtin_amdgcn_s_getreg((3 << 11) | 20) & 0xFu; }
#define XB_SPIN(cond, bar) do { unsigned _sp = 0; while (cond) { __builtin_amdgcn_s_sleep(1); \
    if ((++_sp & 255u) == 0u) { if (xb_ld(&(bar)[XB_TMO])) break; if (_sp > XB_SPIN_CAP) { atomicAdd(&(bar)[XB_TMO], 1u); break; } } } } while (0)

struct XcdBarrier {
    unsigned* bar; unsigned x;
    volatile LAS unsigned* st;
};

__device__ __forceinline__ XcdBarrier xcd_barrier_post(unsigned* bar, volatile LAS unsigned* st) {
    XcdBarrier b; b.bar = bar; b.x = xb_xcc_id(); b.st = st;
    if (threadIdx.x == 0) (void)xb_add(&bar[XB_XCNT(b.x)], 1u);
    return b;
}
__device__ __forceinline__ void xcd_barrier_complete(unsigned* bar, unsigned x, unsigned& nloc, unsigned& nx) {
    const unsigned G = gridDim.x * gridDim.y * gridDim.z;
    unsigned sum, cnt, mine, sp = 0u;
    for (;;) {
        sum = 0u; cnt = 0u; mine = 0u;
#pragma unroll
        for (unsigned j = 0; j < 16; ++j) { const unsigned c = xb_ld(&bar[XB_XCNT(j)]); sum += c; cnt += (c > 0u) ? 1u : 0u; mine = (j == x) ? c : mine; }
        if (sum == G) break;
        __builtin_amdgcn_s_sleep(1);
        if ((++sp & 255u) == 0u) { if (xb_ld(&bar[XB_TMO])) break; if (sp > XB_SPIN_CAP) { atomicAdd(&bar[XB_TMO], 1u); break; } }
    }
    nloc = mine > 0u ? mine : 1u; nx = cnt > 0u ? cnt : 1u;
}

__device__ __forceinline__ void xcd_barrier(const XcdBarrier& b) {
    asm volatile("s_waitcnt vmcnt(0)" ::: "memory");
    __syncthreads();
    if (threadIdx.x == 0) {
        unsigned* bar = b.bar;
        __builtin_amdgcn_s_waitcnt(0);
        unsigned nloc = b.st[0], nx = b.st[1];
        if (nloc == 0u) { xcd_barrier_complete(bar, b.x, nloc, nx); b.st[0] = nloc; b.st[1] = nx; }
        const unsigned old = xb_add(&bar[XB_XSUB(b.x)], 1u);
        const unsigned gen = old / nloc;
        if (old + 1u == (gen + 1u) * nloc) {
            __builtin_amdgcn_fence(__ATOMIC_RELEASE, "agent");
            asm volatile("s_waitcnt vmcnt(0)" ::: "memory");
            const unsigned og = xb_add(&bar[XB_TOP], 1u);
            const unsigned tg = og / nx;
            if (og + 1u == (tg + 1u) * nx) xb_add(&bar[XB_TOPGEN], 1u);
            else XB_SPIN(xb_ld(&bar[XB_TOPGEN]) == tg, bar);
            __builtin_amdgcn_fence(__ATOMIC_ACQUIRE, "agent");
            xb_add(&bar[XB_XGEN(b.x)], 1u);
            asm volatile("s_waitcnt vmcnt(0)" ::: "memory");
        } else {
            XB_SPIN(xb_ld(&bar[XB_XGEN(b.x)]) == gen, bar);
            __builtin_amdgcn_fence(__ATOMIC_ACQUIRE, "agent");
            asm volatile("s_waitcnt vmcnt(0)" ::: "memory");
        }
    }
    __syncthreads();
}

__global__ void __launch_bounds__(512, 2) k_mega(Params p) {
    extern __shared__ __attribute__((aligned(16))) unsigned char smem[];
    LAS unsigned char* lds = (LAS unsigned char*)smem;
    volatile LAS unsigned* xbw = (volatile LAS unsigned*)(lds + LDS_BYTES - 16);
    if (threadIdx.x == 0) { xbw[0] = 0u; xbw[1] = 0u; xbw[2] = 0u; xbw[3] = 0u; }
    __syncthreads();
    XcdBarrier bar = xcd_barrier_post((unsigned*)(p.ws + OFF_BAR), xbw);
    phase0(p, lds);      xcd_barrier(bar);
    phase1(p, lds);      xcd_barrier(bar);
    phase2(p, lds);      xcd_barrier(bar);
    phase3(p, lds);      xcd_barrier(bar);
    phase_attn(p, lds);
    phase_scan(p, lds);  xcd_barrier(bar);
    phase4(p, lds);      xcd_barrier(bar);
    phase5(p, lds);      xcd_barrier(bar);
    phase6(p, lds);      xcd_barrier(bar);
    phase7(p, lds);      xcd_barrier(bar);
    phase8(p, lds);      xcd_barrier(bar);
    phase9(p, lds);
}
extern "C" void kernel_launch(void* const* d_in, const int* in_sizes, int n_in, void* d_out, int out_size, void* d_ws, size_t ws_size, hipStream_t stream) {
    static int grid = 0;
    if (grid == 0) {
        int dev = 0, cus = 0, per_cu = 0;
        if (hipGetDevice(&dev) != hipSuccess || hipDeviceGetAttribute(&cus, hipDeviceAttributeMultiprocessorCount, dev) != hipSuccess) { grid = -1; return; }
        if (hipFuncSetAttribute((const void*)k_mega, hipFuncAttributeMaxDynamicSharedMemorySize, LDS_BYTES) != hipSuccess) { grid = -1; return; }
        (void)hipOccupancyMaxActiveBlocksPerMultiprocessor(&per_cu, (const void*)k_mega, 512, LDS_BYTES);
        (void)hipGetLastError();
        grid = cus;
    }
    if (grid < 0) return;
    Params p{};
    p.x = (const float*)d_in[0]; p.c = (const float*)d_in[1]; p.ctx = (const float*)d_in[2]; p.cctx = (const float*)d_in[3]; p.w_mod = (const float*)d_in[4]; p.b_mod = (const float*)d_in[5];
    p.g_mix = (const float*)d_in[6]; p.w_in = (const float*)d_in[7]; p.g_q = (const float*)d_in[8]; p.w_qb = (const float*)d_in[9]; p.g_kv = (const float*)d_in[10]; p.w_kvb = (const float*)d_in[11];
    p.lbl = (const float*)d_in[12]; p.g_hg = (const float*)d_in[13]; p.w_out = (const float*)d_in[14]; p.g_ffn = (const float*)d_in[15]; p.w_r = (const float*)d_in[16]; p.b_r = (const float*)d_in[17];
    p.w_gu = (const float*)d_in[18]; p.b_gu = (const float*)d_in[19]; p.w_dn = (const float*)d_in[20]; p.b_dn = (const float*)d_in[21]; p.g_fin = (const float*)d_in[22];
    p.out = (float*)d_out; p.ws = (char*)d_ws;
    (void)hipMemsetAsync((char*)d_ws + OFF_BAR, 0, 16384, stream);
    hipLaunchKernelGGL(k_mega, dim3(grid), dim3(512), LDS_BYTES, stream, p);
}
```

```cpp
#include <hip/hip_runtime.h>
#include <stdint.h>

typedef unsigned short bf16_t;
__device__ __forceinline__ float bf2f(bf16_t v) { return __uint_as_float(((unsigned)v) << 16); }
__device__ __forceinline__ bf16_t f2bf(float f) { unsigned u = __float_as_uint(f); u += 0x7FFFu + ((u >> 16) & 1u); return (bf16_t)(u >> 16); }
__device__ __forceinline__ float sigmoidf_(float x) { return __builtin_amdgcn_rcpf(1.0f + __builtin_amdgcn_exp2f(-1.4426950408889634f * x)); }
__device__ __forceinline__ float siluf_(float x) { return x * __builtin_amdgcn_rcpf(1.0f + __builtin_amdgcn_exp2f(-1.4426950408889634f * x)); }

constexpr int D = 1024, NB = 16, SEQ = 2048, CTXL = 256;
constexpr int L = NB * SEQ;
constexpr int RC = NB * CTXL;
constexpr int R = L + RC;
constexpr int NKEY = SEQ + CTXL;
constexpr float EPS = 1e-6f;
constexpr int NE = 32, CAP = 32768;
constexpr int MAXROWS = 131072 + NE * 256;

constexpr size_t MiB = 1048576;
constexpr size_t OFF_SMALL = 0;
constexpr size_t OFF_BAR = 0;
constexpr size_t OFF_CNT = 16384;
constexpr size_t OFF_OFFS = 16384 + 1024;
constexpr size_t OFF_TILEE = 16384 + 2048;
constexpr size_t OFF_LB = 24576;
constexpr size_t OFF_MOD = 32768;
constexpr size_t OFF_SSQQ = 512 * 1024;
constexpr size_t OFF_SSQKV = 768 * 1024;
constexpr size_t OFF_TOPI = 1 * MiB;
constexpr size_t OFF_TOPP = 1 * MiB + 512 * 1024;
constexpr size_t OFF_ROWPAIR = 2 * MiB;
constexpr size_t OFF_LIST = 3 * MiB;
constexpr size_t OFF_H = 32 * MiB;
constexpr size_t OFF_QA = 104 * MiB;
constexpr size_t OFF_CKV = 152 * MiB;
constexpr size_t OFF_KR = 170 * MiB;
constexpr size_t OFF_OF = 104 * MiB;
constexpr size_t OFF_HQ = 175 * MiB;
constexpr size_t SEG_STRIDE = 72 * MiB;
constexpr size_t OFF_FF = OFF_HQ + 1 * SEG_STRIDE;
constexpr size_t OFF_FB = OFF_HQ + 2 * SEG_STRIDE;
constexpr size_t OFF_IV = OFF_HQ + 3 * SEG_STRIDE;
constexpr size_t OFF_OG = OFF_HQ + 4 * SEG_STRIDE;
constexpr size_t OFF_GM = OFF_HQ + 5 * SEG_STRIDE;
constexpr size_t OFF_GH = OFF_HQ + 6 * SEG_STRIDE;
constexpr size_t OFF_Q = 679 * MiB;
constexpr size_t OFF_K = 775 * MiB;
constexpr size_t OFF_V = 883 * MiB;
constexpr size_t OFF_OB = 955 * MiB;
constexpr size_t OFF_YP = 296 * MiB;
constexpr size_t OFF_ACT = 568 * MiB;

struct SegOut { bf16_t *qa, *ckv, *kr, *hq, *ff, *fb, *iv, *og, *gm, *gh; };

__global__ void k_init(const float* __restrict__ lbl, float* lb, int* cnt) {
    int i = blockIdx.x * blockDim.x + threadIdx.x;
    if (i < 2048) { int d = i >> 10, j = i & 1023; float a = lbl[(d * 2 + 0) * 1024 + j], b = lbl[(d * 2 + 1) * 1024 + j]; lb[i] = 1.0f / (1.0f + __expf(b - a)); }
    if (i < 32) cnt[i] = 0;
}

__global__ __launch_bounds__(256) void k_mod(const float* __restrict__ c, const float* __restrict__ cctx, const float* __restrict__ wmod, const float* __restrict__ bmod, float* modv) {
    __shared__ float s[1024];
    int r = blockIdx.y; const float* src = r < 16 ? c + r * 1024 : cctx;
    for (int k = threadIdx.x; k < 1024; k += 256) s[k] = siluf_(src[k]);
    __syncthreads();
    int j = blockIdx.x * 256 + threadIdx.x; float acc = 0.f;
    for (int k = 0; k < 1024; ++k) acc += s[k] * wmod[(size_t)k * 6144 + j];
    modv[r * 6144 + j] = acc + bmod[j];
}

__device__ __forceinline__ float block_sum256(float v, float* red) {
    for (int o = 32; o > 0; o >>= 1) v += __shfl_xor(v, o);
    int w = threadIdx.x >> 6; if ((threadIdx.x & 63) == 0) red[w] = v; __syncthreads();
    float t = red[0] + red[1] + red[2] + red[3]; __syncthreads(); return t;
}

__global__ __launch_bounds__(256) void k_norm1(const float* __restrict__ x, const float* __restrict__ ctx, const float* __restrict__ g, const float* __restrict__ modv, bf16_t* h) {
    __shared__ float red[4];
    int row = blockIdx.x; const float* src = row < L ? x + (size_t)row * D : ctx + (size_t)(row - L) * D;
    const float* mod = modv + (row < L ? row / SEQ : 16) * 6144;
    int c = threadIdx.x * 4; float4 v = *(const float4*)(src + c);
    float ss = block_sum256(v.x * v.x + v.y * v.y + v.z * v.z + v.w * v.w, red);
    float rs = rsqrtf(ss * (1.0f / D) + EPS);
    float o[4] = {v.x, v.y, v.z, v.w}; ushort4 w; bf16_t* wp = (bf16_t*)&w;
    for (int i = 0; i < 4; ++i) wp[i] = f2bf(o[i] * rs * g[c + i] * (1.0f + mod[1024 + c + i]) + mod[c + i]);
    *(ushort4*)(h + (size_t)row * D + c) = w;
}

__global__ __launch_bounds__(256) void k_rowssq(const bf16_t* __restrict__ buf, int width, int nrows, float* ssq) {
    int row = blockIdx.x * 4 + (threadIdx.x >> 6), lane = threadIdx.x & 63; if (row >= nrows) return;
    float s = 0.f; for (int k = lane; k < width; k += 64) { float v = bf2f(buf[(size_t)row * width + k]); s += v * v; }
    for (int o = 32; o > 0; o >>= 1) s += __shfl_xor(s, o);
    if (lane == 0) ssq[row] = s;
}

__device__ __forceinline__ void rope_cs(int t, int i, float& cs, float& sn) {
    int j = i & 15; float inv = __expf(-(float)j * (9.210340371976184f / 16.0f)); float pos = (i < 16) ? (float)(t >> 6) : (float)(t & 63);
    float ang = pos * inv; cs = cosf(ang); sn = sinf(ang);
}

__global__ __launch_bounds__(256) void k_krope(const bf16_t* __restrict__ kr, bf16_t* Kb) {
    int gid = blockIdx.x * 256 + threadIdx.x; int row = gid >> 5, i = gid & 31; if (row >= R) return;
    float x1 = bf2f(kr[(size_t)row * 64 + i]), x2 = bf2f(kr[(size_t)row * 64 + 32 + i]); float o1 = x1, o2 = x2; int b, pos;
    if (row < L) { b = row / SEQ; pos = row % SEQ; float cs, sn; rope_cs(pos, i, cs, sn); o1 = x1 * cs - x2 * sn; o2 = x1 * sn + x2 * cs; }
    else { b = (row - L) / CTXL; pos = SEQ + (row - L) % CTXL; }
    bf16_t w1 = f2bf(o1), w2 = f2bf(o2);
    for (int h = 0; h < 8; ++h) { bf16_t* p = Kb + ((size_t)(b * 8 + h) * NKEY + pos) * 192 + 128; p[i] = w1; p[32 + i] = w2; }
}

template <class AL, class EP>
__global__ __launch_bounds__(256) void k_ngemm(int K, const float* __restrict__ W, int ldw, size_t wzstride, AL al, EP ep) {
    __shared__ float As[16][68]; __shared__ float Bs[16][64];
    const int z = blockIdx.z, row0 = blockIdx.y * 64, col0 = blockIdx.x * 64, tid = threadIdx.x;
    const int mvalid = al.rows(z); if (row0 >= mvalid) return;
    const float* Wz = W + (size_t)z * wzstride;
    const int ar = tid >> 2, ak = (tid & 3) * 4; const bf16_t* arow = (row0 + ar < mvalid) ? al.rowptr(z, row0 + ar) : nullptr;
    const int bk = tid >> 4, bn = (tid & 15) * 4;
    const int ty = tid >> 4, tx = tid & 15;
    float acc[4][4] = {};
    for (int k0 = 0; k0 < K; k0 += 16) {
        float a4[4] = {0.f, 0.f, 0.f, 0.f};
        if (arow) { ushort4 u = *(const ushort4*)(arow + k0 + ak); const bf16_t* up = (const bf16_t*)&u; for (int i = 0; i < 4; ++i) a4[i] = bf2f(up[i]) * al.kscale(k0 + ak + i); }
        float4 b4 = *(const float4*)(Wz + (size_t)(k0 + bk) * ldw + col0 + bn);
        __syncthreads();
        for (int i = 0; i < 4; ++i) As[ak + i][ar] = a4[i];
        *(float4*)&Bs[bk][bn] = b4;
        __syncthreads();
#pragma unroll
        for (int kk = 0; kk < 16; ++kk) {
            float4 av = *(const float4*)&As[kk][ty * 4]; float4 bv = *(const float4*)&Bs[kk][tx * 4];
            float a[4] = {av.x, av.y, av.z, av.w}, b[4] = {bv.x, bv.y, bv.z, bv.w};
#pragma unroll
            for (int i = 0; i < 4; ++i)
#pragma unroll
                for (int j = 0; j < 4; ++j) acc[i][j] += a[i] * b[j];
        }
    }
    for (int i = 0; i < 4; ++i) { int row = row0 + ty * 4 + i; if (row < mvalid) ep.store(z, row, col0 + tx * 4, acc[i]); }
}

__device__ __forceinline__ void st4bf(bf16_t* dst, const float* v) { ushort4 w; bf16_t* wp = (bf16_t*)&w; for (int i = 0; i < 4; ++i) wp[i] = f2bf(v[i]); *(ushort4*)dst = w; }

struct ALDense { const bf16_t* A; int lda; int nrows; const float* ks;
    __device__ int rows(int) const { return nrows; }
    __device__ const bf16_t* rowptr(int, int row) const { return A + (size_t)row * lda; }
    __device__ float kscale(int k) const { return ks ? ks[k] : 1.0f; } };

struct EpiInN { SegOut s;
    __device__ void store(int, int row, int col, const float* v) const {
        bf16_t* dst;
        if (col < 768) { if (row >= L) return; dst = s.qa + (size_t)row * 768 + col; }
        else if (col < 1024) dst = s.ckv + (size_t)row * 256 + (col - 768);
        else if (col < 1088) dst = s.kr + (size_t)row * 64 + (col - 1024);
        else { int c = col - 1088, seg = c >> 10, cc = c & 1023; bool latonly = (seg == 0 || seg >= 4); if (latonly && row >= L) return;
            bf16_t* base = seg == 0 ? s.hq : seg == 1 ? s.ff : seg == 2 ? s.fb : seg == 3 ? s.iv : seg == 4 ? s.og : seg == 5 ? s.gm : s.gh;
            dst = base + (size_t)row * 1024 + cc; }
        st4bf(dst, v);
    } };

struct EpiQN { bf16_t* q; const float* ssq;
    __device__ void store(int, int row, int col, const float* v) const { float rs = rsqrtf(ssq[row] * (1.0f / 768.0f) + EPS); float o[4]; for (int i = 0; i < 4; ++i) o[i] = v[i] * rs; st4bf(q + (size_t)row * 1536 + col, o); } };

struct EpiKVN { bf16_t *Kb, *Vb; const float* ssq;
    __device__ void store(int, int row, int col, const float* v) const {
        float rs = rsqrtf(ssq[row] * (1.0f / 256.0f) + EPS); float o[4]; for (int i = 0; i < 4; ++i) o[i] = v[i] * rs;
        int b, pos; if (row < L) { b = row / SEQ; pos = row % SEQ; } else { b = (row - L) / CTXL; pos = SEQ + (row - L) % CTXL; }
        int h = col >> 8, w = col & 255; size_t kvrow = (size_t)(b * 8 + h) * NKEY + pos;
        if (w < 128) st4bf(Kb + kvrow * 192 + w, o); else st4bf(Vb + kvrow * 128 + (w - 128), o);
    } };

struct EpiOutN { float* x1; const float* x; const float* modv;
    __device__ void store(int, int row, int col, const float* v) const {
        const float* gate = modv + (row / SEQ) * 6144 + 2 * 1024; float4 xv = *(const float4*)(x + (size_t)row * D + col);
        float4 o; o.x = xv.x + gate[col] * v[0]; o.y = xv.y + gate[col + 1] * v[1]; o.z = xv.z + gate[col + 2] * v[2]; o.w = xv.w + gate[col + 3] * v[3];
        *(float4*)(x1 + (size_t)row * D + col) = o;
    } };

struct ALMoe1 { const bf16_t* h2; const int* cnt; const int* list;
    __device__ int rows(int z) const { return cnt[z]; }
    __device__ const bf16_t* rowptr(int z, int row) const { return h2 + (size_t)(list[z * CAP + row] >> 2) * D; }
    __device__ float kscale(int) const { return 1.0f; } };
struct EpiMoe1N { bf16_t* act; const int* offs; const float* bgu;
    __device__ void store(int z, int row, int col, const float* v) const {
        const float* bb = bgu + z * 2048 + col; ushort2 w; bf16_t* wp = (bf16_t*)&w;
        for (int p = 0; p < 2; ++p) { float glu = fminf(v[2 * p] + bb[2 * p], 7.0f); float lin = fminf(fmaxf(v[2 * p + 1] + bb[2 * p + 1], -7.0f), 7.0f);
            wp[p] = f2bf(glu * sigmoidf_(1.702f * glu) * (lin + 1.0f)); }
        *(ushort2*)(act + (size_t)(offs[z] + row) * D + (col >> 1)) = w;
    } };
struct ALMoe2 { const bf16_t* act; const int* cnt; const int* offs;
    __device__ int rows(int z) const { return cnt[z]; }
    __device__ const bf16_t* rowptr(int z, int row) const { return act + (size_t)(offs[z] + row) * D; }
    __device__ float kscale(int) const { return 1.0f; } };
struct EpiMoe2N { bf16_t* yp; const int* list; const float* bd;
    __device__ void store(int z, int row, int col, const float* v) const {
        int pair = list[z * CAP + row]; const float* bb = bd + z * 1024 + col; float o[4]; for (int i = 0; i < 4; ++i) o[i] = v[i] + bb[i];
        st4bf(yp + (size_t)pair * D + col, o);
    } };

__global__ __launch_bounds__(256) void k_nattn(const bf16_t* __restrict__ Q, const bf16_t* __restrict__ Kb, const bf16_t* __restrict__ Vb, bf16_t* Y) {
    __shared__ float qs[4][192]; __shared__ float sc[4][NKEY];
    const int tid = threadIdx.x, blk = blockIdx.x, qg = blk & 511, h = (blk >> 9) & 7, b = blk >> 12;
    for (int idx = tid; idx < 4 * 192; idx += 256) { int qi = idx / 192, d = idx % 192; int row = b * SEQ + qg * 4 + qi; qs[qi][d] = bf2f(Q[(size_t)row * 1536 + h * 192 + d]); }
    __syncthreads();
    float n1 = 0.f, n2 = 0.f;
    if (tid < 128) { int qi = tid >> 5, i = tid & 31; int t = qg * 4 + qi; float cs, sn; rope_cs(t, i, cs, sn); float x1 = qs[qi][128 + i], x2 = qs[qi][160 + i]; n1 = x1 * cs - x2 * sn; n2 = x1 * sn + x2 * cs; }
    __syncthreads();
    if (tid < 128) { int qi = tid >> 5, i = tid & 31; qs[qi][128 + i] = n1; qs[qi][160 + i] = n2; }
    __syncthreads();
    const bf16_t* Kp = Kb + (size_t)(b * 8 + h) * NKEY * 192; const bf16_t* Vp = Vb + (size_t)(b * 8 + h) * NKEY * 128;
    const float scale = 0.07216878364870322f;
    for (int key = tid; key < NKEY; key += 256) {
        const bf16_t* kr = Kp + (size_t)key * 192; float s0 = 0.f, s1 = 0.f, s2 = 0.f, s3 = 0.f;
        for (int d = 0; d < 192; d += 8) { uint4 u = *(const uint4*)(kr + d); const bf16_t* up = (const bf16_t*)&u;
            for (int j = 0; j < 8; ++j) { float kv = bf2f(up[j]); s0 += qs[0][d + j] * kv; s1 += qs[1][d + j] * kv; s2 += qs[2][d + j] * kv; s3 += qs[3][d + j] * kv; } }
        sc[0][key] = s0 * scale; sc[1][key] = s1 * scale; sc[2][key] = s2 * scale; sc[3][key] = s3 * scale;
    }
    __syncthreads();
    { int w = tid >> 6, lane = tid & 63; float m = -1e30f; for (int k = lane; k < NKEY; k += 64) m = fmaxf(m, sc[w][k]);
      for (int o = 32; o > 0; o >>= 1) m = fmaxf(m, __shfl_xor(m, o));
      float s = 0.f; for (int k = lane; k < NKEY; k += 64) { float e = __expf(sc[w][k] - m); sc[w][k] = e; s += e; }
      for (int o = 32; o > 0; o >>= 1) s += __shfl_xor(s, o);
      float inv = 1.0f / s; for (int k = lane; k < NKEY; k += 64) sc[w][k] *= inv; }
    __syncthreads();
    { int dv = tid & 127, qh = tid >> 7; float o0 = 0.f, o1 = 0.f;
      for (int k = 0; k < NKEY; ++k) { float v = bf2f(Vp[(size_t)k * 128 + dv]); o0 += sc[qh * 2][k] * v; o1 += sc[qh * 2 + 1][k] * v; }
      int row = b * SEQ + qg * 4 + qh * 2; Y[(size_t)row * D + h * 128 + dv] = f2bf(o0); Y[(size_t)(row + 1) * D + h * 128 + dv] = f2bf(o1); }
}

__global__ __launch_bounds__(256) void k_nscan(const bf16_t* __restrict__ hq, const bf16_t* __restrict__ ff, const bf16_t* __restrict__ fb, const bf16_t* __restrict__ iv, const float* __restrict__ lb, bf16_t* of, bf16_t* ob) {
    __shared__ float sf[128], sk[128], sq[128], so[2][128];
    const int tid = threadIdx.x, blk = blockIdx.x, dir = blk & 1, h = (blk >> 1) & 7, b = blk >> 4;
    const bf16_t* fz = dir ? fb : ff; bf16_t* out = dir ? ob : of;
    const int dv = tid & 127, half = tid >> 7;
    float S[64];
#pragma unroll
    for (int j = 0; j < 64; ++j) S[j] = 0.f;
    const float lbv = lb[dir * 1024 + h * 128 + (tid & 127)];
    for (int step = 0; step < NKEY; ++step) {
        int row; bool islat;
        if (step < CTXL) { int s = dir ? (CTXL - 1 - step) : step; row = L + b * CTXL + s; islat = false; }
        else { int t = step - CTXL; t = dir ? (SEQ - 1 - t) : t; row = b * SEQ + t; islat = true; }
        if (tid < 128) { float z = bf2f(fz[(size_t)row * D + h * 128 + tid]); float f = lbv + (1.0f - lbv) * sigmoidf_(z); sf[tid] = f; sk[tid] = 1.0f - f;
            if (islat) { float zq = bf2f(hq[(size_t)row * D + h * 128 + tid]); sq[tid] = siluf_(zq) * 0.08838834764831845f; } }
        float v = bf2f(iv[(size_t)row * D + h * 128 + dv]);
        __syncthreads();
        float o = 0.f;
#pragma unroll
        for (int j = 0; j < 64; ++j) { int dk = half * 64 + j; S[j] = sf[dk] * S[j] + sk[dk] * v; o += S[j] * sq[dk]; }
        if (islat) so[half][dv] = o;
        __syncthreads();
        if (islat && half == 0) out[(size_t)row * D + h * 128 + dv] = f2bf(so[0][dv] + so[1][dv]);
    }
}

__global__ __launch_bounds__(256) void k_merge(bf16_t* y, const bf16_t* __restrict__ of, const bf16_t* __restrict__ ob, const bf16_t* __restrict__ og, const bf16_t* __restrict__ gm, const bf16_t* __restrict__ gh, const float* __restrict__ ghg) {
    int row = blockIdx.x, c = threadIdx.x * 4; size_t off = (size_t)row * D + c;
    ushort4 a = *(const ushort4*)(of + off), bb = *(const ushort4*)(ob + off), g1 = *(const ushort4*)(og + off), g2 = *(const ushort4*)(gm + off), g3 = *(const ushort4*)(gh + off), ym = *(const ushort4*)(y + off);
    const bf16_t *ap = (const bf16_t*)&a, *bp = (const bf16_t*)&bb, *p1 = (const bf16_t*)&g1, *p2 = (const bf16_t*)&g2, *p3 = (const bf16_t*)&g3, *pm = (const bf16_t*)&ym;
    float o[4], ss = 0.f; for (int i = 0; i < 4; ++i) { o[i] = bf2f(ap[i]) + bf2f(bp[i]); ss += o[i] * o[i]; }
    for (int m = 16; m > 0; m >>= 1) ss += __shfl_xor(ss, m);
    float rs = rsqrtf(ss * (1.0f / 128.0f) + EPS); float r[4];
    for (int i = 0; i < 4; ++i) { float yh = o[i] * rs * ghg[(c + i) & 127] * siluf_(bf2f(p1[i])); r[i] = sigmoidf_(bf2f(p2[i])) * bf2f(pm[i]) + sigmoidf_(bf2f(p3[i])) * yh; }
    st4bf(y + off, r);
}

__global__ __launch_bounds__(256) void k_norm2_router(const float* __restrict__ x1, const float* __restrict__ g, const float* __restrict__ modv, const float* __restrict__ wr, const float* __restrict__ br, bf16_t* h2, int* topi, float* topp, int* cnt, int* list) {
    __shared__ float red[4]; __shared__ float hs[1024]; __shared__ float part[8][32];
    int row = blockIdx.x, tid = threadIdx.x, c = tid * 4; const float* mod = modv + (row / SEQ) * 6144;
    float4 v = *(const float4*)(x1 + (size_t)row * D + c);
    float ss = block_sum256(v.x * v.x + v.y * v.y + v.z * v.z + v.w * v.w, red); float rs = rsqrtf(ss * (1.0f / D) + EPS);
    float xv[4] = {v.x, v.y, v.z, v.w}, o[4];
    for (int i = 0; i < 4; ++i) { o[i] = xv[i] * rs * g[c + i] * (1.0f + mod[4 * 1024 + c + i]) + mod[3 * 1024 + c + i]; hs[c + i] = o[i]; }
    st4bf(h2 + (size_t)row * D + c, o);
    __syncthreads();
    { int e = tid & 31, p = tid >> 5; float a = 0.f; for (int j = p * 128; j < p * 128 + 128; ++j) a += hs[j] * wr[j * 32 + e]; part[p][e] = a; }
    __syncthreads();
    if (tid < 64) {
        int e = tid & 31; float cur = br[e];
#pragma unroll
        for (int p = 0; p < 8; ++p) cur += part[p][e];
        float tv0 = 0.f, sum = 0.f; float myp = 0.f; int myk = -1;
        int sel_i[4]; float sel_e[4];
#pragma unroll
        for (int k = 0; k < 4; ++k) {
            float m = cur; int mi = e;
#pragma unroll
            for (int o = 16; o > 0; o >>= 1) { float om = __shfl_xor(m, o); int oi = __shfl_xor(mi, o); if (om > m || (om == m && oi < mi)) { m = om; mi = oi; } }
            if (k == 0) tv0 = m;
            sel_i[k] = mi; sel_e[k] = __expf(m - tv0); sum += sel_e[k];
            if (e == mi) cur = -3.0e38f;
        }
#pragma unroll
        for (int k = 0; k < 4; ++k) if (tid == k) { myk = sel_i[k]; myp = sel_e[k] / sum; }
        if (tid < 4) { int pair = row * 4 + tid; topi[pair] = myk; topp[pair] = myp; int pos = atomicAdd(&cnt[myk], 1); list[myk * CAP + pos] = pair; }
    }
}

__global__ void k_moe_offs(const int* cnt, int* offs, int* tilee) {
    if (threadIdx.x == 0 && blockIdx.x == 0) { int o = 0, t = 0; for (int e = 0; e < NE; ++e) { offs[e] = o; int nt = (cnt[e] + 255) >> 8; for (int i = 0; i < nt; ++i) tilee[t++] = e; o += nt * 256; } offs[NE] = o; offs[NE + 1] = t; }
}

__global__ __launch_bounds__(256) void k_final(float* out, const bf16_t* __restrict__ yp, const float* __restrict__ topp, const float* __restrict__ modv, const float* __restrict__ fg) {
    __shared__ float red[4];
    int row = blockIdx.x, c = threadIdx.x * 4; const float* gate = modv + (row / SEQ) * 6144 + 5 * 1024;
    float4 v = *(const float4*)(out + (size_t)row * D + c); float xv[4] = {v.x, v.y, v.z, v.w}; float m[4] = {0.f, 0.f, 0.f, 0.f};
    for (int k = 0; k < 4; ++k) { float p = topp[row * 4 + k]; ushort4 u = *(const ushort4*)(yp + (size_t)(row * 4 + k) * D + c); const bf16_t* up = (const bf16_t*)&u; for (int i = 0; i < 4; ++i) m[i] += p * bf2f(up[i]); }
    float ss = 0.f; for (int i = 0; i < 4; ++i) { xv[i] += gate[c + i] * m[i]; ss += xv[i] * xv[i]; }
    ss = block_sum256(ss, red); float rs = rsqrtf(ss * (1.0f / D) + EPS);
    float4 o; o.x = xv[0] * rs * fg[c]; o.y = xv[1] * rs * fg[c + 1]; o.z = xv[2] * rs * fg[c + 2]; o.w = xv[3] * rs * fg[c + 3];
    *(float4*)(out + (size_t)row * D + c) = o;
}

#define LAS __attribute__((address_space(3)))
__device__ __forceinline__ int otid() { int t = threadIdx.x; asm volatile("" : "+v"(t)); return t; }
typedef short bf16x8 __attribute__((ext_vector_type(8)));
typedef float f32x4 __attribute__((ext_vector_type(4)));
typedef unsigned u32x4 __attribute__((ext_vector_type(4)));
typedef unsigned u32x2 __attribute__((ext_vector_type(2)));
typedef float f32x2 __attribute__((ext_vector_type(2)));

constexpr size_t OFF_ROPE = 7 * MiB;
constexpr size_t OFF_WT_IN = 8 * MiB;
constexpr size_t OFF_WT_QB = 25 * MiB;
constexpr size_t OFF_WT_KVB = 28 * MiB;
constexpr size_t OFF_WT_OUT = 29 * MiB;
constexpr size_t OFF_WT_GU = 104 * MiB;
constexpr size_t OFF_WT_DN = 232 * MiB;

struct Params {
    const float *x, *c, *ctx, *cctx, *w_mod, *b_mod, *g_mix, *w_in, *g_q, *w_qb, *g_kv, *w_kvb, *lbl, *g_hg, *w_out, *g_ffn, *w_r, *b_r, *w_gu, *b_gu, *w_dn, *b_dn, *g_fin;
    float* out; char* ws;
};

typedef __bf16 bf16v2_t __attribute__((ext_vector_type(2)));
__device__ __forceinline__ unsigned cvt_pk_bf16(float lo, float hi) { bf16v2_t v = {(__bf16)lo, (__bf16)hi}; return __builtin_bit_cast(unsigned, v); }

__device__ __forceinline__ unsigned pack4_fp8(float a, float b, float c, float d) {
    a = __builtin_amdgcn_fmed3f(a, -448.f, 448.f); b = __builtin_amdgcn_fmed3f(b, -448.f, 448.f); c = __builtin_amdgcn_fmed3f(c, -448.f, 448.f); d = __builtin_amdgcn_fmed3f(d, -448.f, 448.f);
    unsigned w = 0; w = __builtin_amdgcn_cvt_pk_fp8_f32(a, b, w, false); w = __builtin_amdgcn_cvt_pk_fp8_f32(c, d, w, true); return w; }

namespace pg8 {
constexpr int BM = 256, BK = 64, HALF = 128, HTB = HALF * BK * 2, STAGE_BYTES = 8 * HTB, NXCD = 8, WGM = 8;
__device__ __forceinline__ int lds_byte(int r, int c) { const int st = (r >> 4) * 2 + (c >> 5), rr = r & 15, cc = c & 31, ob = rr * 64 + cc * 2; return st * 1024 + (ob ^ (((ob >> 9) & 1) << 5)); }
__device__ __forceinline__ void stage_rc(int b, int& R, int& C) { const int st = b / 1024, sb = b % 1024, swz = sb ^ (((sb >> 9) & 1) << 5); R = (st >> 1) * 16 + swz / 64; C = (st & 1) * 32 + (swz % 64) / 2; }
__device__ __forceinline__ int perm32(int rho) { const int n = rho >> 4, i = rho & 15; return 8 * (i >> 2) + 4 * n + (i & 3); }
struct Unit { int pm, pn; const char* b; int e, pos0, cnt; };

__device__ __forceinline__ int xcd_remap(int L, int nwg) { const int q = nwg / NXCD, r = nwg % NXCD, xcd = L % NXCD, off = L / NXCD; return (xcd < r ? xcd * (q + 1) : r * (q + 1) + (xcd - r) * q) + off; }

struct DenseSched {
    int nM, nN, nwg, G, c, rowb; const char* Bt; size_t btile;
    __device__ void init(int M, int N, int kbytes, int rowb_, const void* Bt_, int G_, int c_) { nM = M / BM; nN = N / BM; nwg = nM * nN; G = G_; c = c_; rowb = rowb_; Bt = (const char*)Bt_; btile = (size_t)BM * kbytes; }
    __device__ __forceinline__ int kstepA() const { return 128; }
    __device__ __forceinline__ void tile(int wgid, int& pm, int& pn) const { const int nig = WGM * nN, gid = wgid / nig, fm = gid * WGM, gsz = (nM - fm) < WGM ? (nM - fm) : WGM; pm = fm + ((wgid % nig) % gsz); pn = (wgid % nig) / gsz; }
    __device__ __forceinline__ bool next(int i, Unit& u) const { const int Lx = i * G + c; if (Lx >= nwg) return false; tile(xcd_remap(Lx, nwg), u.pm, u.pn); u.b = Bt + (size_t)u.pn * btile; u.e = 0; u.pos0 = 0; u.cnt = 0; return true; }
    __device__ __forceinline__ void aoff(const Unit& u, const int (&Rr)[2], const int (&Cc)[2], unsigned (&va)[2][2]) const {
#pragma unroll
        for (int h = 0; h < 2; ++h)
#pragma unroll
            for (int i = 0; i < 2; ++i) va[h][i] = (unsigned)((u.pm * BM + h * HALF + Rr[i]) * rowb + Cc[i] * 2); }
};
struct InSched : DenseSched {
    __device__ void init2(const void* Bt_, int G_, int c_) { init(L, 8448, 1024, 1024, Bt_, G_, c_); }
    __device__ __forceinline__ bool next(int i, Unit& u) const {
        const int Lx = i * G + c; const int nlat = nwg;
        if (Lx < nlat) { tile(xcd_remap(Lx, nlat), u.pm, u.pn); }
        else { const int j = Lx - nlat; if (j >= 16 * 14) return false; const int q = j >> 4; u.pm = 128 + (j & 15); u.pn = q == 0 ? 3 : (q <= 12 ? 7 + q : 32); }
        u.b = Bt + (size_t)u.pn * btile; u.e = 0; u.pos0 = 0; u.cnt = 0; return true; }
};
__device__ __forceinline__ unsigned act_piece_off(int r, int c16) { const int s = 2 * (r >> 7) + (c16 >> 2), w = 4 * ((r >> 6) & 1) + (c16 & 3), l = 16 * ((r >> 4) & 3) + (r & 15); return (unsigned)(((s * 8 + w) * 64 + l) * 16); }
template <bool GATHER> struct MoeSched {
    int nN, G, c, rowb; const char* Wt; size_t wexp, btile; const LAS int* tab; const int* list;
    __device__ __forceinline__ int kstepA() const { return GATHER ? 128 : 32768; }
    __device__ __forceinline__ bool next(int i, Unit& u) const {
        const int nwg = tab[33] * nN; const int Lx = i * G + c; if (Lx >= nwg) return false;
        const int w = xcd_remap(Lx, nwg); const int rt = w / nN; u.pn = w % nN; u.pm = rt;
        int e = 0; while (tab[e + 1] <= rt) ++e;
        u.e = e; u.pos0 = (rt - tab[e]) * BM; u.cnt = tab[64 + e]; u.b = Wt + (size_t)e * wexp + (size_t)u.pn * btile; return true; }
    __device__ __forceinline__ void aoff(const Unit& u, const int (&Rr)[2], const int (&Cc)[2], unsigned (&va)[2][2]) const {
#pragma unroll
        for (int h = 0; h < 2; ++h)
#pragma unroll
            for (int i = 0; i < 2; ++i) {
                if (GATHER) { const int pos = u.pos0 + h * HALF + Rr[i]; const int pair = pos < u.cnt ? list[u.e * CAP + pos] : 0; va[h][i] = (unsigned)((pair >> 2) * rowb + Cc[i] * 2); }
                else va[h][i] = (unsigned)u.pm * 262144u + act_piece_off(h * HALF + Rr[i], Cc[i] >> 3); } }
};

typedef int v8i_t __attribute__((ext_vector_type(8)));
typedef int i32x4_t __attribute__((ext_vector_type(4)));
template <class Epi, class Sched, bool FP8 = false, int SCA = 127, int SCB = 127>
__device__ __forceinline__ void gemm_phase(LAS unsigned char* lds, const char* Abase, const int K, const Sched& S, const Epi& E) {
    const int tid = otid(), wid = __builtin_amdgcn_readfirstlane(tid >> 6), lane = tid & 63, wr = wid >> 2, wc = wid & 3, fr = lane & 15, fq = lane >> 4;
    const int Kb = FP8 ? K : 2 * K;
    const int nt = Kb / (BK * 2);
    int Rr[2], Cc[2]; unsigned voffB[2];
#pragma unroll
    for (int i = 0; i < 2; ++i) { int R_, C_; stage_rc(tid * 16 + i * 8192, R_, C_); Rr[i] = R_; Cc[i] = C_; const int Rb = 64 * (R_ >> 5) + (Epi::PERM ? perm32(R_ & 31) : (R_ & 31)); voffB[i] = (unsigned)(Rb * Kb + C_ * 2); }
    const size_t kstep = (size_t)(BK * 2);
    const size_t kstepA = (size_t)S.kstepA();
    const size_t hstep = (size_t)32 * Kb;
    const unsigned ldsw = (unsigned)wid * 1024u;
    const int aoff = lds_byte(wr * 64 + fr, fq * 8), boff = lds_byte(wc * 32 + fr, fq * 8);
#define PG8_SA(b, h) (((b) * 2 + (h)) * HTB)
#define PG8_SB(b, h) ((4 + (b) * 2 + (h)) * HTB)
#define PG8_STAGE_B(bufoff, gbase) do { _Pragma("unroll") for (int _i = 0; _i < 2; ++_i) \
        __builtin_amdgcn_global_load_lds((const unsigned*)((const char*)(gbase) + voffB[_i]), (LAS unsigned*)(lds + (bufoff) + ldsw + _i * 8192), 16, 0, 0); } while (0)
#define PG8_STAGE_A(bufoff, v0, v1, kb) do { \
        __builtin_amdgcn_global_load_lds((const unsigned*)(Abase + (kb) + (v0)), (LAS unsigned*)(lds + (bufoff) + ldsw), 16, 0, 0); \
        __builtin_amdgcn_global_load_lds((const unsigned*)(Abase + (kb) + (v1)), (LAS unsigned*)(lds + (bufoff) + ldsw + 8192), 16, 0, 0); } while (0)
#define PG8_LD16(addr) (*(const LAS i32x4_t*)(addr))
#define PG8_LDA(dst, b, h) do { _Pragma("unroll") for (int m = 0; m < 4; ++m) { if constexpr (FP8) dst##8[m] = __builtin_shufflevector(PG8_LD16(lds + PG8_SA(b, h) + aoff + m * 2048), PG8_LD16(lds + PG8_SA(b, h) + aoff + m * 2048 + 1024), 0, 1, 2, 3, 4, 5, 6, 7); \
        else { _Pragma("unroll") for (int k = 0; k < 2; ++k) dst[m][k] = *(const LAS bf16x8*)(lds + PG8_SA(b, h) + aoff + m * 2048 + k * 1024); } } } while (0)
#define PG8_LDB(dst, b, h) do { _Pragma("unroll") for (int n = 0; n < 2; ++n) { if constexpr (FP8) dst##8[n] = __builtin_shufflevector(PG8_LD16(lds + PG8_SB(b, h) + boff + n * 2048), PG8_LD16(lds + PG8_SB(b, h) + boff + n * 2048 + 1024), 0, 1, 2, 3, 4, 5, 6, 7); \
        else { _Pragma("unroll") for (int k = 0; k < 2; ++k) dst[n][k] = *(const LAS bf16x8*)(lds + PG8_SB(b, h) + boff + n * 2048 + k * 1024); } } } while (0)
#define PG8_MMA(ai, bj, At, Bt) do { __builtin_amdgcn_s_setprio(1); _Pragma("unroll") for (int m = 0; m < 4; ++m) _Pragma("unroll") for (int n = 0; n < 2; ++n) { \
        if constexpr (FP8) asm volatile("v_mfma_scale_f32_16x16x128_f8f6f4 %0, %1, %2, %0, %3, %4 op_sel_hi:[0,0,0]" : "+v"(acc[ai][bj][m][n]) : "v"(Bt##8[n]), "v"(At##8[m]), "v"(scb_), "v"(sca_)); \
        else { _Pragma("unroll") for (int k = 0; k < 2; ++k) acc[ai][bj][m][n] = __builtin_amdgcn_mfma_f32_16x16x32_bf16(Bt[n][k], At[m][k], acc[ai][bj][m][n], 0, 0, 0); } } \
        __builtin_amdgcn_s_setprio(0); } while (0)
#define PG8_WAIT_V(n) asm volatile("s_waitcnt vmcnt(" #n ")" ::: "memory")
#define PG8_WAIT_L(n) asm volatile("s_waitcnt lgkmcnt(" #n ")" ::: "memory")
#define PG8_BAR __builtin_amdgcn_s_barrier()
#define PG8_SCHED __builtin_amdgcn_sched_barrier(0)
    Unit cur, nxt; int ui = 0;
    if (!S.next(0, cur)) return;
    f32x4 acc[2][2][4][2];
#pragma unroll
    for (int a = 0; a < 2; ++a)
#pragma unroll
        for (int b = 0; b < 2; ++b)
#pragma unroll
            for (int m = 0; m < 4; ++m)
#pragma unroll
                for (int n = 0; n < 2; ++n) acc[a][b][m][n] = (f32x4){0.f, 0.f, 0.f, 0.f};
    const int sca_ = SCA, scb_ = SCB;
    bf16x8 At[4][2], B0[2][2], B1[2][2]; v8i_t At8[4], B08[2], B18[2];
    unsigned vc[2][2], vn[2][2];
    S.aoff(cur, Rr, Cc, vc);
    const char* cB = cur.b;
    PG8_STAGE_B(PG8_SB(0, 0), cB); PG8_STAGE_A(PG8_SA(0, 0), vc[0][0], vc[0][1], 0); PG8_STAGE_B(PG8_SB(0, 1), cB + hstep); PG8_STAGE_A(PG8_SA(0, 1), vc[1][0], vc[1][1], 0);
    if (wr == 1) PG8_BAR;
    PG8_WAIT_V(4); PG8_BAR;
    PG8_STAGE_B(PG8_SB(1, 0), cB + kstep); PG8_STAGE_A(PG8_SA(1, 0), vc[0][0], vc[0][1], kstepA); PG8_STAGE_B(PG8_SB(1, 1), cB + hstep + kstep);
    PG8_WAIT_V(6); PG8_BAR;
    for (;;) {
        const bool has_next = S.next(ui + 1, nxt);
        if (has_next) S.aoff(nxt, Rr, Cc, vn);
        else {
#pragma unroll
            for (int h = 0; h < 2; ++h)
#pragma unroll
                for (int i = 0; i < 2; ++i) vn[h][i] = vc[h][i]; }
        const char* nB = has_next ? nxt.b : cB;
#pragma unroll 1
        for (int t = 0; t < nt; t += 2) {
            const bool last = (t == nt - 2);
            const size_t k1 = (size_t)(t + 1) * kstepA;
            const size_t k2 = last ? 0 : (size_t)(t + 2) * kstepA;
            const unsigned s00 = last ? vn[0][0] : vc[0][0], s01 = last ? vn[0][1] : vc[0][1], s10 = last ? vn[1][0] : vc[1][0], s11 = last ? vn[1][1] : vc[1][1];
            const char* b2 = last ? nB : cB + (size_t)(t + 2) * kstep; const char* b3 = b2 + kstep;
            PG8_LDB(B0, 0, 0); PG8_SCHED; PG8_LDA(At, 0, 0); PG8_STAGE_A(PG8_SA(1, 1), vc[1][0], vc[1][1], k1);
            PG8_WAIT_L(8); PG8_BAR; PG8_WAIT_L(0); PG8_MMA(0, 0, At, B0); PG8_BAR; PG8_SCHED;
            PG8_LDB(B1, 0, 1); PG8_STAGE_B(PG8_SB(0, 0), b2);
            PG8_BAR; PG8_WAIT_L(0); PG8_MMA(0, 1, At, B1); PG8_BAR; if constexpr (FP8) PG8_SCHED;
            PG8_LDA(At, 0, 1); PG8_STAGE_A(PG8_SA(0, 0), s00, s01, k2);
            PG8_BAR; PG8_WAIT_L(0); PG8_MMA(1, 0, At, B0); PG8_BAR; PG8_SCHED;
            PG8_STAGE_B(PG8_SB(0, 1), b2 + hstep);
            PG8_WAIT_V(6); PG8_BAR; PG8_MMA(1, 1, At, B1); PG8_BAR; if constexpr (FP8) PG8_SCHED;
            PG8_LDB(B0, 1, 0); PG8_SCHED; PG8_LDA(At, 1, 0); PG8_STAGE_A(PG8_SA(0, 1), s10, s11, k2);
            PG8_WAIT_L(8); PG8_BAR; PG8_WAIT_L(0); PG8_MMA(0, 0, At, B0); PG8_BAR; PG8_SCHED;
            PG8_LDB(B1, 1, 1); PG8_STAGE_B(PG8_SB(1, 0), b3);
            PG8_BAR; PG8_WAIT_L(0); PG8_MMA(0, 1, At, B1); PG8_BAR; if constexpr (FP8) PG8_SCHED;
            PG8_LDA(At, 1, 1); PG8_STAGE_A(PG8_SA(1, 0), s00, s01, k2 + kstepA);
            PG8_BAR; PG8_WAIT_L(0); PG8_MMA(1, 0, At, B0); PG8_BAR; PG8_SCHED;
            PG8_STAGE_B(PG8_SB(1, 1), b3 + hstep);
            PG8_WAIT_V(6); PG8_BAR; PG8_MMA(1, 1, At, B1); PG8_BAR; if constexpr (FP8) PG8_SCHED;
        }
        if constexpr (FP8) asm volatile("s_nop 15\n\ts_nop 15" ::: "memory");
        E(acc, cur, wr, wc, fr, fq);
        if (!has_next) break;
#pragma unroll
        for (int a = 0; a < 2; ++a)
#pragma unroll
            for (int b = 0; b < 2; ++b)
#pragma unroll
                for (int m = 0; m < 4; ++m)
#pragma unroll
                    for (int n = 0; n < 2; ++n) acc[a][b][m][n] = (f32x4){0.f, 0.f, 0.f, 0.f};
        cur = nxt; cB = nB; ++ui;
#pragma unroll
        for (int h = 0; h < 2; ++h)
#pragma unroll
            for (int i = 0; i < 2; ++i) vc[h][i] = vn[h][i];
    }
    PG8_WAIT_V(0);
    if (wr == 0) PG8_BAR;
    PG8_BAR;
#undef PG8_SA
#undef PG8_SB
#undef PG8_STAGE_A
#undef PG8_STAGE_B
#undef PG8_LDA
#undef PG8_LDB
#undef PG8_MMA
#undef PG8_WAIT_V
#undef PG8_WAIT_L
#undef PG8_BAR
#undef PG8_SCHED
}

typedef f32x4 Acc[2][2][4][2];
__device__ __forceinline__ unsigned dpp_ror8(unsigned x) { return (unsigned)__builtin_amdgcn_update_dpp(0, (int)x, 0x128, 0xf, 0xf, false); }
__device__ __forceinline__ u32x4 ror8_4(const u32x4 v) { u32x4 r; r.x = dpp_ror8(v.x); r.y = dpp_ror8(v.y); r.z = dpp_ror8(v.z); r.w = dpp_ror8(v.w); return r; }
__device__ __forceinline__ void line_xy(const u32x4 a, const u32x4 b, bool lo, u32x4& X, u32x4& Y) { const u32x4 ra = ror8_4(a), rb = ror8_4(b); X = lo ? a : rb; Y = lo ? ra : b; }
__device__ __forceinline__ u32x4 pack8(const f32x4 v0, const f32x4 v1) { u32x4 w; w.x = cvt_pk_bf16(v0[0], v0[1]); w.y = cvt_pk_bf16(v0[2], v0[3]); w.z = cvt_pk_bf16(v1[0], v1[1]); w.w = cvt_pk_bf16(v1[2], v1[3]); return w; }

struct EpiIn { static constexpr bool PERM = true; char* ws;
    __device__ __forceinline__ void operator()(const Acc& acc, const Unit& u, int wr, int wc, int fr, int fq) const {
        const int pn = u.pn; size_t boff; int ld, cb;
        if (pn < 3) { boff = OFF_QA; ld = 768; cb = pn * 256; } else if (pn == 3) { boff = OFF_CKV; ld = 256; cb = 0; }
        else if (pn < 32) { boff = OFF_HQ + (size_t)((pn - 4) >> 2) * SEG_STRIDE; ld = 1024; cb = ((pn - 4) & 3) * 256; }
        else { boff = OFF_KR; ld = 64; cb = 0; }
        bf16_t* base = (bf16_t*)(ws + boff);
        if (pn == 32 && wc != 0) return;
        const bool lo = fr < 8; const int rowb0 = u.pm * BM + wr * 64, rx = fr & 7, colx = cb + wc * 64 + (fr >> 3) * 32 + 8 * fq;
        float* ssq = (float*)(ws + (pn < 3 ? OFF_SSQQ : OFF_SSQKV));
#pragma unroll
        for (int ai = 0; ai < 2; ++ai)
#pragma unroll
            for (int m = 0; m < 4; ++m) { const int rg = rowb0 + ai * HALF + m * 16;
                f32x4 v0 = acc[ai][0][m][0], v1 = acc[ai][0][m][1], w0 = acc[ai][1][m][0], w1 = acc[ai][1][m][1];
                if (pn >= 4 && pn < 8) {
#pragma unroll
                    for (int j = 0; j < 4; ++j) { v0[j] = siluf_(v0[j]) * 0.08838834764831845f; v1[j] = siluf_(v1[j]) * 0.08838834764831845f; w0[j] = siluf_(w0[j]) * 0.08838834764831845f; w1[j] = siluf_(w1[j]) * 0.08838834764831845f; } }
                u32x4 X, Y; line_xy(pack8(v0, v1), pack8(w0, w1), lo, X, Y);
                *(u32x4*)(base + (size_t)(rg + rx) * ld + colx) = X; *(u32x4*)(base + (size_t)(rg + 8 + rx) * ld + colx) = Y;
                if (pn <= 3) { float ss = (v0[0] * v0[0] + v0[1] * v0[1]) + (v0[2] * v0[2] + v0[3] * v0[3]) + (v1[0] * v1[0] + v1[1] * v1[1]) + (v1[2] * v1[2] + v1[3] * v1[3])
                                        + (w0[0] * w0[0] + w0[1] * w0[1]) + (w0[2] * w0[2] + w0[3] * w0[3]) + (w1[0] * w1[0] + w1[1] * w1[1]) + (w1[2] * w1[2] + w1[3] * w1[3]);
                    ss += __shfl_xor(ss, 16); ss += __shfl_xor(ss, 32); if (fq == 0) atomicAdd(ssq + rg + fr, ss); } }
    } };

struct EpiQ { static constexpr bool PERM = true; bf16_t* q; const float* ssq;
    __device__ __forceinline__ void operator()(const Acc& acc, const Unit& u, int wr, int wc, int fr, int fq) const {
        const bool lo = fr < 8; const int rowb0 = u.pm * BM + wr * 64, rx = fr & 7, colx = u.pn * BM + wc * 64 + (fr >> 3) * 32 + 8 * fq;
#pragma unroll
        for (int ai = 0; ai < 2; ++ai)
#pragma unroll
            for (int m = 0; m < 4; ++m) { const int rg = rowb0 + ai * HALF + m * 16; const float rs = rsqrtf(ssq[rg + fr] * (1.0f / 768.0f) + EPS);
                u32x4 X, Y; line_xy(pack8(acc[ai][0][m][0] * rs, acc[ai][0][m][1] * rs), pack8(acc[ai][1][m][0] * rs, acc[ai][1][m][1] * rs), lo, X, Y);
                *(u32x4*)(q + (size_t)(rg + rx) * 1536 + colx) = X; *(u32x4*)(q + (size_t)(rg + 8 + rx) * 1536 + colx) = Y; }
    } };

struct EpiKV { static constexpr bool PERM = true; bf16_t *Kb, *Vb; const float* ssq;
    __device__ __forceinline__ size_t kvrow(int row, int h) const { int b, pos; if (row < L) { b = row >> 11; pos = row & 2047; } else { b = (row - L) >> 8; pos = SEQ + ((row - L) & 255); } return (size_t)(b * 8 + h) * NKEY + pos; }
    __device__ __forceinline__ void operator()(const Acc& acc, const Unit& u, int wr, int wc, int fr, int fq) const {
        const bool lo = fr < 8; const int rowb0 = u.pm * BM + wr * 64, rx = fr & 7, colx = (wc & 1) * 64 + (fr >> 3) * 32 + 8 * fq;
        bf16_t* dst = wc < 2 ? Kb : Vb; const int ld = wc < 2 ? 192 : 128;
#pragma unroll
        for (int ai = 0; ai < 2; ++ai)
#pragma unroll
            for (int m = 0; m < 4; ++m) { const int rg = rowb0 + ai * HALF + m * 16; const float rs = rsqrtf(ssq[rg + fr] * (1.0f / 256.0f) + EPS);
                u32x4 X, Y; line_xy(pack8(acc[ai][0][m][0] * rs, acc[ai][0][m][1] * rs), pack8(acc[ai][1][m][0] * rs, acc[ai][1][m][1] * rs), lo, X, Y);
                *(u32x4*)(dst + kvrow(rg + rx, u.pn) * ld + colx) = X; *(u32x4*)(dst + kvrow(rg + 8 + rx, u.pn) * ld + colx) = Y; }
    } };

struct EpiOut { static constexpr bool PERM = false; float* x1; const float* x; const float* modv;
    __device__ __forceinline__ void operator()(const Acc& acc, const Unit& u, int wr, int wc, int fr, int fq) const {
        const bool lo = fr < 8; const int rowb0 = u.pm * BM + wr * 64, rx = fr & 7, colx = u.pn * BM + wc * 64 + (fr >> 3) * 16 + 4 * fq;
#pragma unroll
        for (int ai = 0; ai < 2; ++ai)
#pragma unroll
            for (int m = 0; m < 4; ++m) { const int rg = rowb0 + ai * HALF + m * 16;
#pragma unroll
                for (int bj = 0; bj < 2; ++bj) { u32x4 X, Y; line_xy(__builtin_bit_cast(u32x4, acc[ai][bj][m][0]), __builtin_bit_cast(u32x4, acc[ai][bj][m][1]), lo, X, Y);
                    const int co = colx + bj * 32;
#pragma unroll
                    for (int half = 0; half < 2; ++half) { const int row = rg + half * 8 + rx; const f32x4 av = __builtin_bit_cast(f32x4, half ? Y : X);
                        const f32x4 g = *(const f32x4*)(modv + (row >> 11) * 6144 + 2 * 1024 + co), xv = *(const f32x4*)(x + (size_t)row * D + co); *(f32x4*)(x1 + (size_t)row * D + co) = xv + g * av; } } }
    } };

struct EpiMoe1 { static constexpr bool PERM = true; unsigned char* act; const float* bgu;
    __device__ __forceinline__ void operator()(const Acc& acc, const Unit& u, int wr, int wc, int fr, int fq) const {
        const int o0 = u.pn * 128 + wc * 16 + 4 * fq;
        f32x4 bg[2], bl[2];
#pragma unroll
        for (int bj = 0; bj < 2; ++bj) { const float* bp = bgu + u.e * 2048 + 2 * (o0 + bj * 64); const f32x4 t0 = *(const f32x4*)bp, t1 = *(const f32x4*)(bp + 4);
            bg[bj] = (f32x4){t0[0], t0[2], t1[0], t1[2]}; bl[bj] = (f32x4){t0[1], t0[3], t1[1], t1[3]}; }
        unsigned char* blk = act + ((size_t)u.pm * 8 + u.pn) * 32768 + (size_t)(wr * 4 + wc) * 1024 + (size_t)(fq * 16 + fr) * 16;
#pragma unroll
        for (int ai = 0; ai < 2; ++ai)
#pragma unroll
            for (int bj = 0; bj < 2; ++bj) { unsigned d[4];
#pragma unroll
                for (int m = 0; m < 4; ++m) { const f32x4 g4 = acc[ai][bj][m][0] + bg[bj], l4 = acc[ai][bj][m][1] + bl[bj]; float r[4];
#pragma unroll
                    for (int j = 0; j < 4; ++j) { const float glu = fminf(g4[j], 7.0f), lin = __builtin_amdgcn_fmed3f(l4[j], -7.0f, 7.0f); r[j] = 4.0f * glu * __builtin_amdgcn_rcpf(1.0f + __builtin_amdgcn_exp2f(-2.4554669595930157f * glu)) * (lin + 1.0f); }
                    d[m] = pack4_fp8(r[0], r[1], r[2], r[3]); }
                const auto s01 = __builtin_amdgcn_permlane16_swap(d[0], d[1], false, false); const auto s23 = __builtin_amdgcn_permlane16_swap(d[2], d[3], false, false);
                const auto t02 = __builtin_amdgcn_permlane32_swap(s01[0], s23[0], false, false); const auto t13 = __builtin_amdgcn_permlane32_swap(s01[1], s23[1], false, false);
                *(u32x4*)(blk + (size_t)(ai * 2 + bj) * 8192) = (u32x4){t02[0], t13[0], t02[1], t13[1]}; }
    } };

struct EpiMoe2 { static constexpr bool PERM = true; bf16_t* yp; const float* bd;
    __device__ __forceinline__ void operator()(const Acc& acc, const Unit& u, int wr, int wc, int fr, int fq) const {
        const bool lo = fr < 8; const int rowb0 = u.pm * BM + wr * 64, rx = fr & 7, colx = u.pn * BM + wc * 64 + (fr >> 3) * 32 + 8 * fq, cown = u.pn * BM + wc * 64 + 8 * fq;
        f32x4 bv[2][2];
#pragma unroll
        for (int bj = 0; bj < 2; ++bj)
#pragma unroll
            for (int n = 0; n < 2; ++n) bv[bj][n] = *(const f32x4*)(bd + u.e * 1024 + cown + bj * 32 + 4 * n);
#pragma unroll
        for (int ai = 0; ai < 2; ++ai)
#pragma unroll
            for (int m = 0; m < 4; ++m) { const int rg = rowb0 + ai * HALF + m * 16;
                u32x4 X, Y; line_xy(pack8(acc[ai][0][m][0] + bv[0][0], acc[ai][0][m][1] + bv[0][1]), pack8(acc[ai][1][m][0] + bv[1][0], acc[ai][1][m][1] + bv[1][1]), lo, X, Y);
                *(u32x4*)(yp + (size_t)(rg + rx) * D + colx) = X; *(u32x4*)(yp + (size_t)(rg + 8 + rx) * D + colx) = Y; }
    } };
}

__device__ __forceinline__ int conv_src_col(int kind, int c) {
    if (kind == 0) return c;
    if (kind == 1) { if (c < 1024) return c; if (c < 8192) return c + 64; if (c < 8256) return c - 8192 + 1024; return -1; }
    const int pn = c >> 8, p = c & 255, wc = p >> 6, bj = (p >> 5) & 1, fq = (p >> 3) & 3, n = (p >> 2) & 1, i = p & 3; const int o = 128 * pn + 64 * bj + 16 * wc + 4 * fq + i; return 2 * o + n;
}
template <bool F8>
__device__ __forceinline__ void conv_tile(LAS float* tl, const float* __restrict__ W, int ldw, void* Wtv, int K, int kind, const float* __restrict__ kscale, int k0, int c0) {
    const int tid = otid(); const int cc = tid & 127, kq = tid >> 7, sc = conv_src_col(kind, c0 + cc);
    float v[32];
#pragma unroll
    for (int i = 0; i < 32; ++i) { const int kk = kq + 4 * i; v[i] = sc >= 0 ? W[(size_t)(k0 + kk) * ldw + sc] : 0.f; }
    if (kscale) {
#pragma unroll
        for (int i = 0; i < 32; ++i) v[i] *= kscale[k0 + kq + 4 * i]; }
#pragma unroll
    for (int i = 0; i < 32; ++i) tl[(kq + 4 * i) * 129 + cc] = v[i];
    __syncthreads();
    { const int c2 = tid >> 2, kb = (tid & 3) * 8;
#pragma unroll
      for (int q = 0; q < 4; ++q) { float t[8];
#pragma unroll
          for (int j = 0; j < 8; ++j) t[j] = tl[(q * 32 + kb + j) * 129 + c2];
          if constexpr (F8) { unsigned char* dst = (unsigned char*)Wtv + (size_t)(c0 + c2) * K + k0 + kb + q * 32;
              u32x2 w; w.x = pack4_fp8(t[0] * 32.f, t[1] * 32.f, t[2] * 32.f, t[3] * 32.f); w.y = pack4_fp8(t[4] * 32.f, t[5] * 32.f, t[6] * 32.f, t[7] * 32.f); *(u32x2*)dst = w; }
          else { bf16_t* dst = (bf16_t*)Wtv + (size_t)(c0 + c2) * K + k0 + kb + q * 32;
              u32x4 w; w.x = cvt_pk_bf16(t[0], t[1]); w.y = cvt_pk_bf16(t[2], t[3]); w.z = cvt_pk_bf16(t[4], t[5]); w.w = cvt_pk_bf16(t[6], t[7]); *(u32x4*)dst = w; } } }
    __syncthreads();
}
template <bool F8 = false>
__device__ __forceinline__ void conv_matrix(LAS float* tl, const float* W, int ldw, void* Wt, int K, int Nout, int kind, const float* kscale, int& tctr) {
    const int nk = K / 128, ntile = nk * (Nout / 128);
    int t = ((int)blockIdx.x - tctr) % (int)gridDim.x; if (t < 0) t += gridDim.x;
    for (; t < ntile; t += gridDim.x) conv_tile<F8>(tl, W, ldw, Wt, K, kind, kscale, (t % nk) * 128, (t / nk) * 128);
    tctr = (tctr + ntile) % (int)gridDim.x;
}

__device__ __forceinline__ float half_sum256(float v, LAS float* red) {
    for (int o = 32; o > 0; o >>= 1) v += __shfl_xor(v, o);
    const int w = otid() >> 6, hb = (otid() >> 8) * 4; if ((otid() & 63) == 0) red[w] = v; __syncthreads();
    const float t = red[hb] + red[hb + 1] + red[hb + 2] + red[hb + 3]; __syncthreads(); return t;
}

__device__ __forceinline__ void phase0(const Params& p, LAS unsigned char* lds) {
    char* ws = p.ws; const int tid = otid(), gsz = gridDim.x * 512, gid = blockIdx.x * 512 + tid;
    float* lb = (float*)(ws + OFF_LB); int* cnt = (int*)(ws + OFF_CNT); float* ssqq = (float*)(ws + OFF_SSQQ); float* ssqkv = (float*)(ws + OFF_SSQKV); float* modv = (float*)(ws + OFF_MOD);
    for (int i = gid; i < 2048; i += gsz) { const int d = i >> 10, j = i & 1023; const float a = p.lbl[(d * 2 + 0) * 1024 + j], b = p.lbl[(d * 2 + 1) * 1024 + j]; lb[i] = 1.0f / (1.0f + __expf(b - a)); }
    for (int i = gid; i < 32; i += gsz) cnt[i] = 0;
    { float* ropet = (float*)(ws + OFF_ROPE); for (int i = gid; i < SEQ * 32; i += gsz) { const int t = i >> 5, j = i & 31; float cs, sn; rope_cs(t, j, cs, sn); ropet[t * 64 + j] = cs; ropet[t * 64 + 32 + j] = sn; } }
    for (int i = gid; i < L; i += gsz) ssqq[i] = 0.f;
    for (int i = gid; i < R; i += gsz) ssqkv[i] = 0.f;
    { LAS float* sil = (LAS float*)lds;
      LAS float* part = (LAS float*)(lds + 17 * 1024 * 4);
      bool loaded = false;
      for (int item = blockIdx.x; item < 96; item += gridDim.x) {
          if (!loaded) { for (int i = tid; i < 17 * 1024; i += 512) { const int r = i >> 10, k = i & 1023; sil[i] = siluf_(r < 16 ? p.c[r * 1024 + k] : p.cctx[k]); } loaded = true; __syncthreads(); }
          const int j = tid & 63, ks = tid >> 6; float a[17];
#pragma unroll
          for (int r = 0; r < 17; ++r) a[r] = 0.f;
          for (int k = ks * 128; k < ks * 128 + 128; ++k) { const float w = p.w_mod[(size_t)k * 6144 + item * 64 + j];
#pragma unroll
              for (int r = 0; r < 17; ++r) a[r] += sil[r * 1024 + k] * w; }
#pragma unroll
          for (int r = 0; r < 17; ++r) part[(ks * 17 + r) * 64 + j] = a[r];
          __syncthreads();
          for (int i = tid; i < 17 * 64; i += 512) { const int r = i >> 6, jj = i & 63; float s = p.b_mod[item * 64 + jj]; for (int q = 0; q < 8; ++q) s += part[(q * 17 + r) * 64 + jj]; modv[r * 6144 + item * 64 + jj] = s; }
          __syncthreads();
      } }
    __syncthreads();
    { LAS float* tl = (LAS float*)lds; int tctr = 0;
      conv_matrix<true>(tl, p.w_in, 8256, (unsigned char*)(ws + OFF_WT_IN), 1024, 8448, 1, nullptr, tctr);
      conv_matrix(tl, p.w_qb, 1536, (bf16_t*)(ws + OFF_WT_QB), 768, 1536, 0, p.g_q, tctr);
      conv_matrix(tl, p.w_kvb, 2048, (bf16_t*)(ws + OFF_WT_KVB), 256, 2048, 0, p.g_kv, tctr);
      conv_matrix(tl, p.w_out, 1024, (bf16_t*)(ws + OFF_WT_OUT), 1024, 1024, 0, nullptr, tctr); }
}

__device__ __forceinline__ float wave_sum(float v) {
#pragma unroll
    for (int o = 32; o > 0; o >>= 1) v += __shfl_xor(v, o);
    return v; }
__device__ __forceinline__ void phase1(const Params& p, LAS unsigned char* lds) {
    const float* modv = (const float*)(p.ws + OFF_MOD); unsigned char* h = (unsigned char*)(p.ws + OFF_H);
    const int tid = otid(), lane = tid & 63, gw = blockIdx.x * 8 + (tid >> 6), nw = gridDim.x * 8, c0 = lane * 8;
    f32x4 g[4];
#pragma unroll
    for (int q = 0; q < 4; ++q) g[q] = *(const f32x4*)(p.g_mix + (q >> 1) * 512 + c0 + (q & 1) * 4);
    for (int row0 = gw; row0 < R; row0 += 2 * nw) {
        f32x4 v[2][4]; const bool two = row0 + nw < R;
#pragma unroll
        for (int u = 0; u < 2; ++u) { const int row = (u == 0 || two) ? row0 + u * nw : row0; const float* src = row < L ? p.x + (size_t)row * D : p.ctx + (size_t)(row - L) * D;
#pragma unroll
            for (int q = 0; q < 4; ++q) v[u][q] = *(const f32x4*)(src + (q >> 1) * 512 + c0 + (q & 1) * 4); }
#pragma unroll
        for (int u = 0; u < 2; ++u) { if (u == 1 && !two) break; const int row = row0 + u * nw; const float* mod = modv + (row < L ? row / SEQ : 16) * 6144;
            float ss = 0.f;
#pragma unroll
            for (int q = 0; q < 4; ++q) ss += (v[u][q][0] * v[u][q][0] + v[u][q][1] * v[u][q][1]) + (v[u][q][2] * v[u][q][2] + v[u][q][3] * v[u][q][3]);
            const float rs = rsqrtf(wave_sum(ss) * (1.0f / D) + EPS);
#pragma unroll
            for (int j = 0; j < 2; ++j) { f32x4 o[2];
#pragma unroll
                for (int e = 0; e < 2; ++e) { const int cc = j * 512 + c0 + e * 4; const f32x4 sc = *(const f32x4*)(mod + 1024 + cc), sh = *(const f32x4*)(mod + cc); o[e] = v[u][j * 2 + e] * rs * g[j * 2 + e] * (sc + 1.0f) + sh; }
                u32x2 w; w.x = pack4_fp8(o[0][0], o[0][1], o[0][2], o[0][3]); w.y = pack4_fp8(o[1][0], o[1][1], o[1][2], o[1][3]);
                *(u32x2*)(h + (size_t)row * D + j * 512 + c0) = w; } }
    }
}

__device__ __forceinline__ SegOut make_seg(char* ws) { SegOut so; so.qa = (bf16_t*)(ws + OFF_QA); so.ckv = (bf16_t*)(ws + OFF_CKV); so.kr = (bf16_t*)(ws + OFF_KR); so.hq = (bf16_t*)(ws + OFF_HQ); so.ff = (bf16_t*)(ws + OFF_FF);
    so.fb = (bf16_t*)(ws + OFF_FB); so.iv = (bf16_t*)(ws + OFF_IV); so.og = (bf16_t*)(ws + OFF_OG); so.gm = (bf16_t*)(ws + OFF_GM); so.gh = (bf16_t*)(ws + OFF_GH); return so; }

__device__ __forceinline__ void phase2(const Params& p, LAS unsigned char* lds) {
    pg8::InSched S; S.init2(p.ws + OFF_WT_IN, gridDim.x, blockIdx.x);
    pg8::EpiIn E{p.ws};
    pg8::gemm_phase<pg8::EpiIn, pg8::InSched, true, 127, 122>(lds, (const char*)(p.ws + OFF_H), 1024, S, E);
}
__device__ __forceinline__ void phase3(const Params& p, LAS unsigned char* lds) {
    char* ws = p.ws;
    { pg8::DenseSched S; S.init(L, 1536, 768 * 2, 768 * 2, ws + OFF_WT_QB, gridDim.x, blockIdx.x); pg8::EpiQ E{(bf16_t*)(ws + OFF_Q), (const float*)(ws + OFF_SSQQ)}; pg8::gemm_phase(lds, (const char*)(ws + OFF_QA), 768, S, E); }
    { pg8::DenseSched S; S.init(R, 2048, 256 * 2, 256 * 2, ws + OFF_WT_KVB, gridDim.x, blockIdx.x); pg8::EpiKV E{(bf16_t*)(ws + OFF_K), (bf16_t*)(ws + OFF_V), (const float*)(ws + OFF_SSQKV)}; pg8::gemm_phase(lds, (const char*)(ws + OFF_CKV), 256, S, E); }
    { const bf16_t* kr = (const bf16_t*)(ws + OFF_KR); bf16_t* Kb = (bf16_t*)(ws + OFF_K); const float* ropet = (const float*)(ws + OFF_ROPE);
      for (int gid = blockIdx.x * 512 + otid(); gid < R * 32; gid += gridDim.x * 512) { const int row = gid >> 5, i = gid & 31;
          const float x1 = bf2f(kr[(size_t)row * 64 + i]), x2 = bf2f(kr[(size_t)row * 64 + 32 + i]); float o1 = x1, o2 = x2; int b, pos;
          if (row < L) { b = row / SEQ; pos = row % SEQ; const float cs = ropet[pos * 64 + i], sn = ropet[pos * 64 + 32 + i]; o1 = x1 * cs - x2 * sn; o2 = x1 * sn + x2 * cs; } else { b = (row - L) / CTXL; pos = SEQ + (row - L) % CTXL; }
          const bf16_t w1 = f2bf(o1), w2 = f2bf(o2);
          for (int h = 0; h < 8; ++h) { bf16_t* q = Kb + ((size_t)(b * 8 + h) * NKEY + pos) * 192 + 128; q[i] = w1; q[32 + i] = w2; } } }
}
__device__ __forceinline__ void unpack8(const u32x4 w, float (&o)[8]) {
    o[0] = __uint_as_float(w.x << 16); o[1] = __uint_as_float(w.x & 0xffff0000u); o[2] = __uint_as_float(w.y << 16); o[3] = __uint_as_float(w.y & 0xffff0000u);
    o[4] = __uint_as_float(w.z << 16); o[5] = __uint_as_float(w.z & 0xffff0000u); o[6] = __uint_as_float(w.w << 16); o[7] = __uint_as_float(w.w & 0xffff0000u); }
__device__ __forceinline__ void phase4(const Params& p, LAS unsigned char*) {
    char* ws = p.ws; bf16_t* y = (bf16_t*)(ws + OFF_H); const bf16_t* of = (const bf16_t*)(ws + OFF_OF); const bf16_t* ob = (const bf16_t*)(ws + OFF_OB);
    const bf16_t* og = (const bf16_t*)(ws + OFF_OG); const bf16_t* gm = (const bf16_t*)(ws + OFF_GM); const bf16_t* gh = (const bf16_t*)(ws + OFF_GH);
    const int tid = otid(), lane = tid & 63, gw = blockIdx.x * 8 + (tid >> 6), nw = gridDim.x * 8, c0 = lane * 8;
    float gg[8];
#pragma unroll
    for (int i = 0; i < 8; ++i) gg[i] = p.g_hg[(c0 + i) & 127];
    for (int row = gw; row < L; row += nw) {
        u32x4 ra[2], rb[2], r1[2], r2[2], r3[2], rm[2];
#pragma unroll
        for (int j = 0; j < 2; ++j) { const size_t off = (size_t)row * D + j * 512 + c0; ra[j] = *(const u32x4*)(of + off); rb[j] = *(const u32x4*)(ob + off); r1[j] = *(const u32x4*)(og + off); r2[j] = *(const u32x4*)(gm + off); r3[j] = *(const u32x4*)(gh + off); rm[j] = *(const u32x4*)(y + off); }
#pragma unroll
        for (int j = 0; j < 2; ++j) { float a[8], b[8], g1[8], g2[8], g3[8], ym[8], o[8]; unpack8(ra[j], a); unpack8(rb[j], b); unpack8(r1[j], g1); unpack8(r2[j], g2); unpack8(r3[j], g3); unpack8(rm[j], ym);
            float ss = 0.f;
#pragma unroll
            for (int i = 0; i < 8; ++i) { o[i] = a[i] + b[i]; ss += o[i] * o[i]; }
            ss += __shfl_xor(ss, 1); ss += __shfl_xor(ss, 2); ss += __shfl_xor(ss, 4); ss += __shfl_xor(ss, 8);
            const float rs = rsqrtf(ss * (1.0f / 128.0f) + EPS); float r[8];
#pragma unroll
            for (int i = 0; i < 8; ++i) { const float yh = o[i] * rs * gg[i] * siluf_(g1[i]); r[i] = sigmoidf_(g2[i]) * ym[i] + sigmoidf_(g3[i]) * yh; }
            u32x4 w; w.x = cvt_pk_bf16(r[0], r[1]); w.y = cvt_pk_bf16(r[2], r[3]); w.z = cvt_pk_bf16(r[4], r[5]); w.w = cvt_pk_bf16(r[6], r[7]);
            *(u32x4*)(y + (size_t)row * D + j * 512 + c0) = w; }
    }
}
__device__ __forceinline__ void phase5(const Params& p, LAS unsigned char* lds) {
    char* ws = p.ws;
    { pg8::DenseSched S; S.init(L, 1024, 1024 * 2, 1024 * 2, ws + OFF_WT_OUT, gridDim.x, blockIdx.x); pg8::EpiOut E{p.out, p.x, (const float*)(ws + OFF_MOD)}; pg8::gemm_phase(lds, (const char*)(ws + OFF_H), 1024, S, E); }
    { LAS float* tl = (LAS float*)lds; int tctr = 0;
      for (int e = 0; e < NE; ++e) conv_matrix<true>(tl, p.w_gu + (size_t)e * 1024 * 2048, 2048, (unsigned char*)(ws + OFF_WT_GU) + (size_t)e * 2048 * 1024, 1024, 2048, 2, nullptr, tctr);
      for (int e = 0; e < NE; ++e) conv_matrix<true>(tl, p.w_dn + (size_t)e * 1024 * 1024, 1024, (unsigned char*)(ws + OFF_WT_DN) + (size_t)e * 1024 * 1024, 1024, 1024, 0, nullptr, tctr); }
}
__device__ __forceinline__ void phase6(const Params& p, LAS unsigned char* lds) {
    char* ws = p.ws; const float* modv = (const float*)(ws + OFF_MOD); unsigned char* h2 = (unsigned char*)(ws + OFF_H); int* topi = (int*)(ws + OFF_TOPI); float* topp = (float*)(ws + OFF_TOPP); int* cnt = (int*)(ws + OFF_CNT); int* list = (int*)(ws + OFF_LIST); int* pairpos = (int*)(ws + OFF_ROWPAIR);
    LAS float* hs = (LAS float*)lds;
    LAS float* lg = (LAS float*)(lds + 131072);
    LAS int* lcnt = (LAS int*)(lds + 131072 + 4096);
    LAS int* lent = (LAS int*)(lds + 131072 + 4096 + 512);
    const int tid = otid(), lane = tid & 63, wid = tid >> 6, c0 = lane * 8;
    if (tid < 96) lcnt[tid] = 0;
    f32x4 g[4];
#pragma unroll
    for (int q = 0; q < 4; ++q) g[q] = *(const f32x4*)(p.g_ffn + (q >> 1) * 512 + c0 + (q & 1) * 4);
    __syncthreads();
    int it = 0;
    for (int tile = blockIdx.x; tile < L / 32; tile += gridDim.x, ++it) {
        const int rbase = tile * 32;
        f32x4 v[4][4];
#pragma unroll
        for (int u = 0; u < 4; ++u)
#pragma unroll
            for (int q = 0; q < 4; ++q) v[u][q] = *(const f32x4*)(p.out + (size_t)(rbase + wid * 4 + u) * D + (q >> 1) * 512 + c0 + (q & 1) * 4);
#pragma unroll
        for (int u = 0; u < 4; ++u) { const int rl = wid * 4 + u, row = rbase + rl; const float* mod = modv + (row / SEQ) * 6144; float ss = 0.f;
#pragma unroll
            for (int q = 0; q < 4; ++q) ss += (v[u][q][0] * v[u][q][0] + v[u][q][1] * v[u][q][1]) + (v[u][q][2] * v[u][q][2] + v[u][q][3] * v[u][q][3]);
            const float rs = rsqrtf(wave_sum(ss) * (1.0f / D) + EPS);
#pragma unroll
            for (int j = 0; j < 2; ++j) { f32x4 o[2];
#pragma unroll
                for (int e = 0; e < 2; ++e) { const int cc = j * 512 + c0 + e * 4; const f32x4 sc = *(const f32x4*)(mod + 4 * 1024 + cc), sh = *(const f32x4*)(mod + 3 * 1024 + cc); o[e] = v[u][j * 2 + e] * rs * g[j * 2 + e] * (sc + 1.0f) + sh;
                    *(LAS f32x4*)(hs + rl * 1024 + cc) = o[e]; }
                u32x2 w; w.x = pack4_fp8(o[0][0], o[0][1], o[0][2], o[0][3]); w.y = pack4_fp8(o[1][0], o[1][1], o[1][2], o[1][3]);
                *(u32x2*)(h2 + (size_t)row * D + j * 512 + c0) = w; } }
        __syncthreads();
        { const int e = tid & 31, rg = tid >> 5; const LAS float* h0 = hs + (2 * rg) * 1024; const LAS float* h1 = h0 + 1024; float a0 = 0.f, a1 = 0.f;
          for (int j = 0; j < 1024; j += 8) { float w[8];
#pragma unroll
              for (int q = 0; q < 8; ++q) w[q] = p.w_r[(j + q) * 32 + e];
              const f32x4 x0 = *(const LAS f32x4*)(h0 + j), x1 = *(const LAS f32x4*)(h0 + j + 4), y0 = *(const LAS f32x4*)(h1 + j), y1 = *(const LAS f32x4*)(h1 + j + 4);
              a0 += x0[0] * w[0]; a0 += x0[1] * w[1]; a0 += x0[2] * w[2]; a0 += x0[3] * w[3]; a0 += x1[0] * w[4]; a0 += x1[1] * w[5]; a0 += x1[2] * w[6]; a0 += x1[3] * w[7];
              a1 += y0[0] * w[0]; a1 += y0[1] * w[1]; a1 += y0[2] * w[2]; a1 += y0[3] * w[3]; a1 += y1[0] * w[4]; a1 += y1[1] * w[5]; a1 += y1[2] * w[6]; a1 += y1[3] * w[7]; }
          const float be = p.b_r[e]; lg[(2 * rg) * 32 + e] = a0 + be; lg[(2 * rg + 1) * 32 + e] = a1 + be; }
        __syncthreads();
#pragma unroll
        for (int rep = 0; rep < 2; ++rep) { const int rl = wid * 4 + rep * 2 + (lane >> 5), row = rbase + rl, e = lane & 31; float cur = lg[rl * 32 + e];
            float tv0 = 0.f, sum = 0.f; int sel_i[4]; float sel_e[4];
#pragma unroll
            for (int k = 0; k < 4; ++k) { float m = cur; int mi = e;
#pragma unroll
                for (int o2 = 16; o2 > 0; o2 >>= 1) { const float om = __shfl_xor(m, o2); const int oi = __shfl_xor(mi, o2); if (om > m || (om == m && oi < mi)) { m = om; mi = oi; } }
                if (k == 0) tv0 = m; sel_i[k] = mi; sel_e[k] = __expf(m - tv0); sum += sel_e[k]; if (e == mi) cur = -3.0e38f; }
            int myk = 0; float myp = 0.f;
#pragma unroll
            for (int k = 0; k < 4; ++k) if (e == k) { myk = sel_i[k]; myp = sel_e[k] / sum; }
            if (e < 4) { const int pair = row * 4 + e; topi[pair] = myk; topp[pair] = myp; __hip_atomic_fetch_add(&lcnt[myk], 1, __ATOMIC_RELAXED, __HIP_MEMORY_SCOPE_WORKGROUP); lent[(it * 32 + rl) * 4 + e] = myk; } }
        __syncthreads();
    }
    if (tid < 32) { const int n = lcnt[tid]; lcnt[32 + tid] = n > 0 ? atomicAdd(&cnt[tid], n) : 0; lcnt[64 + tid] = 0; }
    __syncthreads();
    const int nent = it * 128;
    for (int s = tid; s < nent; s += 512) { const int e = lent[s]; const int ii = s >> 7, rl = (s >> 2) & 31, k = s & 3; const int row = (blockIdx.x + ii * gridDim.x) * 32 + rl;
        const int pos = lcnt[32 + e] + __hip_atomic_fetch_add(&lcnt[64 + e], 1, __ATOMIC_RELAXED, __HIP_MEMORY_SCOPE_WORKGROUP); list[e * CAP + pos] = row * 4 + k; pairpos[row * 4 + k] = pos; }
}
__device__ __forceinline__ void moe_table(const int* cnt, LAS int* tab) {
    if (otid() == 0) { int t = 0; for (int e = 0; e < NE; ++e) { tab[e] = t; const int n = cnt[e]; tab[64 + e] = n; t += (n + 255) >> 8; } tab[32] = t; tab[33] = t; }
    __syncthreads();
}
constexpr int LDS_TAB = pg8::STAGE_BYTES;
__device__ __forceinline__ void phase7(const Params& p, LAS unsigned char* lds) {
    char* ws = p.ws; LAS int* tab = (LAS int*)(lds + LDS_TAB); moe_table((const int*)(ws + OFF_CNT), tab);
    pg8::MoeSched<true> S; S.nN = 8; S.G = gridDim.x; S.c = blockIdx.x; S.rowb = 1024; S.Wt = ws + OFF_WT_GU; S.wexp = (size_t)2048 * 1024; S.btile = (size_t)256 * 1024; S.tab = tab; S.list = (const int*)(ws + OFF_LIST);
    pg8::EpiMoe1 E{(unsigned char*)(ws + OFF_ACT), p.b_gu};
    pg8::gemm_phase<pg8::EpiMoe1, pg8::MoeSched<true>, true, 127, 122>(lds, (const char*)(ws + OFF_H), 1024, S, E);
}
__device__ __forceinline__ void phase8(const Params& p, LAS unsigned char* lds) {
    char* ws = p.ws; LAS int* tab = (LAS int*)(lds + LDS_TAB); moe_table((const int*)(ws + OFF_CNT), tab);
    pg8::MoeSched<false> S; S.nN = 4; S.G = gridDim.x; S.c = blockIdx.x; S.rowb = 1024; S.Wt = ws + OFF_WT_DN; S.wexp = (size_t)1024 * 1024; S.btile = (size_t)256 * 1024; S.tab = tab; S.list = (const int*)(ws + OFF_LIST);
    pg8::EpiMoe2 E{(bf16_t*)(ws + OFF_YP), p.b_dn};
    pg8::gemm_phase<pg8::EpiMoe2, pg8::MoeSched<false>, true, 125, 122>(lds, (const char*)(ws + OFF_ACT), 1024, S, E);
}
__device__ __forceinline__ void phase9(const Params& p, LAS unsigned char* lds) {
    char* ws = p.ws; const float* modv = (const float*)(ws + OFF_MOD); const bf16_t* yp = (const bf16_t*)(ws + OFF_YP); const float* topp = (const float*)(ws + OFF_TOPP);
    const int* topi = (const int*)(ws + OFF_TOPI); const int* pairpos = (const int*)(ws + OFF_ROWPAIR);
    LAS int* tab = (LAS int*)lds; moe_table((const int*)(ws + OFF_CNT), tab);
    const int tid = otid(), lane = tid & 63, gw = blockIdx.x * 8 + (tid >> 6), nw = gridDim.x * 8, c0 = lane * 8;
    f32x4 fg[4];
#pragma unroll
    for (int q = 0; q < 4; ++q) fg[q] = *(const f32x4*)(p.g_fin + (q >> 1) * 512 + c0 + (q & 1) * 4);
    for (int row = gw; row < L; row += nw) {
        const float* gate = modv + (row / SEQ) * 6144 + 5 * 1024; f32x4 v[4]; u32x4 yr[4][2];
        const pg8::i32x4_t ek = *(const pg8::i32x4_t*)(topi + row * 4), pk4 = *(const pg8::i32x4_t*)(pairpos + row * 4);
#pragma unroll
        for (int q = 0; q < 4; ++q) v[q] = *(const f32x4*)(p.out + (size_t)row * D + (q >> 1) * 512 + c0 + (q & 1) * 4);
#pragma unroll
        for (int k = 0; k < 4; ++k) { const size_t yrow = (size_t)tab[ek[k]] * 256 + pk4[k];
#pragma unroll
            for (int j = 0; j < 2; ++j) yr[k][j] = *(const u32x4*)(yp + yrow * D + j * 512 + c0); }
        const f32x4 pk = *(const f32x4*)(topp + row * 4);
        float m[16];
#pragma unroll
        for (int i = 0; i < 16; ++i) m[i] = 0.f;
#pragma unroll
        for (int k = 0; k < 4; ++k)
#pragma unroll
            for (int j = 0; j < 2; ++j) { float t[8]; unpack8(yr[k][j], t);
#pragma unroll
                for (int i = 0; i < 8; ++i) m[j * 8 + i] += pk[k] * t[i]; }
        float ss = 0.f;
#pragma unroll
        for (int q = 0; q < 4; ++q) { const f32x4 gt = *(const f32x4*)(gate + (q >> 1) * 512 + c0 + (q & 1) * 4);
#pragma unroll
            for (int i = 0; i < 4; ++i) { v[q][i] += gt[i] * m[q * 4 + i]; ss += v[q][i] * v[q][i]; } }
        const float rs = rsqrtf(wave_sum(ss) * (1.0f / D) + EPS);
#pragma unroll
        for (int q = 0; q < 4; ++q) *(f32x4*)(p.out + (size_t)row * D + (q >> 1) * 512 + c0 + (q & 1) * 4) = v[q] * rs * fg[q];
    }
}

namespace at {
using s16x4  = __attribute__((ext_vector_type(4))) short;
using f32x16 = __attribute__((ext_vector_type(16))) float;
constexpr int NW = 8, QBLK = 32, KVBLK = 64, DK = 192, DV = 128;
constexpr float SCALE = 0.07216878364870322f;
constexpr float THR = 8.f;
constexpr int SHM_V = KVBLK * DV * 2, SHM_K = KVBLK * DK * 2, SHM_ATTN = 2 * SHM_V + 2 * SHM_K + NW * 64 * 4;
#define KSWZ(row, colB) ((row) * 384 + ((colB) ^ (((row) & 7) << 4)))
#define SBAR() __builtin_amdgcn_sched_barrier(0)
__device__ __forceinline__ int crow(int r, int hi) { return (r & 3) + 8 * (r >> 2) + 4 * hi; }
__device__ __forceinline__ unsigned cvtpk(float lo, float hi) { return cvt_pk_bf16(lo, hi); }

__device__ __forceinline__ void partialSM(f32x16& p0, f32x16& p1, float& m_reg, float& mn, float& alpha) {
  constexpr float C = SCALE * 1.4426950408889634f;
  float pmax = p0[0];
#pragma unroll
  for (int r = 1; r < 16; ++r) pmax = fmaxf(pmax, p0[r]);
#pragma unroll
  for (int r = 0; r < 16; ++r) pmax = fmaxf(pmax, p1[r]);
  { auto rr = __builtin_amdgcn_permlane32_swap(__float_as_uint(pmax), __float_as_uint(pmax), false, false);
    pmax = fmaxf(__uint_as_float(rr[0]), __uint_as_float(rr[1])); }
  if (__builtin_expect(__all(pmax - m_reg <= THR / SCALE), 1)) { mn = m_reg; alpha = 1.f; }
  else { mn = fmaxf(m_reg, pmax); alpha = __builtin_amdgcn_exp2f((m_reg - mn) * C); m_reg = mn; }
  float mnC = -mn * C;
#pragma unroll
  for (int r = 0; r < 16; ++r) p0[r] = fmaf(p0[r], C, mnC);
#pragma unroll
  for (int r = 0; r < 16; ++r) p1[r] = fmaf(p1[r], C, mnC);
#pragma unroll
  for (int r = 0; r < 16; ++r) p0[r] = __builtin_amdgcn_exp2f(p0[r]);
}
__device__ __forceinline__ void finishSM(f32x16& p0, f32x16& p1, float alpha, float& l_reg, bf16x8& pa0, bf16x8& pa1, bf16x8& pa2, bf16x8& pa3) {
#pragma unroll
  for (int r = 0; r < 16; ++r) p1[r] = __builtin_amdgcn_exp2f(p1[r]);
  float ps = 0;
#pragma unroll
  for (int r = 0; r < 16; ++r) ps += p0[r];
#pragma unroll
  for (int r = 0; r < 16; ++r) ps += p1[r];
  { auto rr = __builtin_amdgcn_permlane32_swap(__float_as_uint(ps), __float_as_uint(ps), false, false);
    ps = __uint_as_float(rr[0]) + __uint_as_float(rr[1]); }
  l_reg = l_reg * alpha + ps;
#define PK4(P, BASE, OUT) do { unsigned a0 = cvtpk(P[BASE + 0], P[BASE + 1]), a1 = cvtpk(P[BASE + 2], P[BASE + 3]);   \
    unsigned b0 = cvtpk(P[BASE + 4], P[BASE + 5]), b1 = cvtpk(P[BASE + 6], P[BASE + 7]);                              \
    auto r0 = __builtin_amdgcn_permlane32_swap(a0, b0, false, false); auto r1 = __builtin_amdgcn_permlane32_swap(a1, b1, false, false); \
    u32x4 w = {r0[0], r1[0], r0[1], r1[1]}; OUT = *reinterpret_cast<bf16x8*>(&w); } while (0)
  PK4(p0, 0, pa0); PK4(p0, 8, pa1); PK4(p1, 0, pa2); PK4(p1, 8, pa3);
#undef PK4
}
__device__ __forceinline__ void qkt(f32x16& p0, f32x16& p1, const LAS char* Ks, const bf16x8 (&qr)[12], int r32, int hi) {
  p0 = f32x16{}; p1 = f32x16{};
#pragma unroll
  for (int d0 = 0; d0 < 12; ++d0) { const int cb = (d0 * 16 + hi * 8) * 2;
    const bf16x8 b0 = *reinterpret_cast<const LAS bf16x8*>(Ks + KSWZ(r32, cb));
    const bf16x8 b1 = *reinterpret_cast<const LAS bf16x8*>(Ks + KSWZ(32 + r32, cb));
    p0 = __builtin_amdgcn_mfma_f32_32x32x16_bf16(b0, qr[d0], p0, 0, 0, 0);
    p1 = __builtin_amdgcn_mfma_f32_32x32x16_bf16(b1, qr[d0], p1, 0, 0, 0); }
}
__device__ __forceinline__ int v_st(int k, int c) { const int kk = (k & ~0xC) | ((k & 4) << 1) | ((k & 8) >> 1); return ((kk >> 3) * 4 + (c >> 5)) * 512 + ((kk & 7) * 32 + (c & 31)) * 2; }
__device__ __forceinline__ int v_rd_base(int lane) { return ((lane & 3) << 3) | (((lane >> 2) & 3) << 6) | (((lane >> 4) & 1) << 5) | (((lane >> 5) & 1) << 8); }
constexpr int v_rd_off(int d0, int ks, int half) { return d0 * 512 + ks * 4096 + half * 2048; }
template <int OFF> __device__ __forceinline__ s16x4 tr_read(int vb) { s16x4 r; asm volatile("ds_read_b64_tr_b16 %0, %1 offset:%2" : "=&v"(r) : "v"(vb), "i"(OFF) : "memory"); return r; }
template <int D0> __device__ __forceinline__ void pv_one(f32x16& od, int vb, bf16x8 pa0, bf16x8 pa1, bf16x8 pa2, bf16x8 pa3) {
  const s16x4 l0 = tr_read<v_rd_off(D0, 0, 0)>(vb), h0 = tr_read<v_rd_off(D0, 0, 1)>(vb), l1 = tr_read<v_rd_off(D0, 1, 0)>(vb), h1 = tr_read<v_rd_off(D0, 1, 1)>(vb);
  const s16x4 l2 = tr_read<v_rd_off(D0, 2, 0)>(vb), h2 = tr_read<v_rd_off(D0, 2, 1)>(vb), l3 = tr_read<v_rd_off(D0, 3, 0)>(vb), h3 = tr_read<v_rd_off(D0, 3, 1)>(vb);
  asm volatile("s_waitcnt lgkmcnt(0)" ::: "memory"); SBAR();
#define PK(Lo, Hi) (bf16x8){Lo[0], Lo[1], Lo[2], Lo[3], Hi[0], Hi[1], Hi[2], Hi[3]}
  od = __builtin_amdgcn_mfma_f32_32x32x16_bf16(pa0, PK(l0, h0), od, 0, 0, 0);
  od = __builtin_amdgcn_mfma_f32_32x32x16_bf16(pa1, PK(l1, h1), od, 0, 0, 0);
  od = __builtin_amdgcn_mfma_f32_32x32x16_bf16(pa2, PK(l2, h2), od, 0, 0, 0);
  od = __builtin_amdgcn_mfma_f32_32x32x16_bf16(pa3, PK(l3, h3), od, 0, 0, 0);
#undef PK
}
__device__ __forceinline__ void pv_d0(f32x16 (&o)[4], int vb, bf16x8 pa0, bf16x8 pa1, bf16x8 pa2, bf16x8 pa3) {
  pv_one<0>(o[0], vb, pa0, pa1, pa2, pa3); pv_one<1>(o[1], vb, pa0, pa1, pa2, pa3); pv_one<2>(o[2], vb, pa0, pa1, pa2, pa3); pv_one<3>(o[3], vb, pa0, pa1, pa2, pa3);
}

__device__ __forceinline__ void attn_unit(const bf16_t* __restrict__ Qb, const bf16_t* __restrict__ Kh, const bf16_t* __restrict__ Vh, bf16_t* __restrict__ Ob, int t0, const float* __restrict__ ropet, LAS char* lds) {
  constexpr int LDQ = 1536, LDO = 1024, NT = NKEY / KVBLK;
  const int tid = otid(), wid = tid >> 6, lane = tid & 63, r32 = lane & 31, hi = lane >> 5;
  LAS char* V_lds = lds; LAS char* K_lds = lds + 2 * SHM_V;
  LAS float* wsl = (LAS float*)(lds + 2 * SHM_V + 2 * SHM_K) + wid * 64; LAS float* li_l = wsl; LAS float* al_l = wsl + 32;
  float m_reg = -1e30f, l_reg = 0; f32x16 o[4] = {}; bf16x8 qr[12];
  { const bf16_t* Qw = Qb + (size_t)(wid * QBLK + r32) * LDQ + hi * 8;
#pragma unroll
    for (int d0 = 0; d0 < 12; ++d0) qr[d0] = *reinterpret_cast<const bf16x8*>(Qw + d0 * 16);
    const float* rt = ropet + (size_t)(t0 + wid * QBLK + r32) * 64 + 8 * hi;
#pragma unroll
    for (int g = 0; g < 2; ++g) {
      const f32x4 c0 = *(const f32x4*)(rt + 16 * g), c1 = *(const f32x4*)(rt + 16 * g + 4), s0 = *(const f32x4*)(rt + 32 + 16 * g), s1 = *(const f32x4*)(rt + 32 + 16 * g + 4);
      float n1[8], n2[8];
#pragma unroll
      for (int j = 0; j < 8; ++j) { const float cs = j < 4 ? c0[j & 3] : c1[j & 3], sn = j < 4 ? s0[j & 3] : s1[j & 3];
        const float x1 = bf2f((bf16_t)qr[8 + g][j]), x2 = bf2f((bf16_t)qr[10 + g][j]); n1[j] = x1 * cs - x2 * sn; n2[j] = x1 * sn + x2 * cs; }
      u32x4 w1 = {cvtpk(n1[0], n1[1]), cvtpk(n1[2], n1[3]), cvtpk(n1[4], n1[5]), cvtpk(n1[6], n1[7])}; u32x4 w2 = {cvtpk(n2[0], n2[1]), cvtpk(n2[2], n2[3]), cvtpk(n2[4], n2[5]), cvtpk(n2[6], n2[7])};
      qr[8 + g] = *reinterpret_cast<bf16x8*>(&w1); qr[10 + g] = *reinterpret_cast<bf16x8*>(&w2); } }
  const int sr = tid >> 4, sc = (tid & 15) * 8, vst0 = v_st(sr, sc), vst1 = v_st(32 + sr, sc);
  int kgo[3], kst[3];
#pragma unroll
  for (int i = 0; i < 3; ++i) { const int c = tid + 512 * i, row = c / 24, c8 = (c % 24) * 8; kgo[i] = row * DK + c8; kst[i] = KSWZ(row, c8 * 2); }
  const int vb0 = (int)(uintptr_t)V_lds + v_rd_base(lane);
  bf16x8 sv0, sv1, sk0, sk1, sk2;
#define SLOAD(k0) do { sv0 = *reinterpret_cast<const bf16x8*>(&Vh[(size_t)((k0) + sr) * DV + sc]); sv1 = *reinterpret_cast<const bf16x8*>(&Vh[(size_t)((k0) + 32 + sr) * DV + sc]); \
    sk0 = *reinterpret_cast<const bf16x8*>(&Kh[(size_t)(k0) * DK + kgo[0]]); sk1 = *reinterpret_cast<const bf16x8*>(&Kh[(size_t)(k0) * DK + kgo[1]]); sk2 = *reinterpret_cast<const bf16x8*>(&Kh[(size_t)(k0) * DK + kgo[2]]); } while (0)
#define SWRITE(b) do { *(LAS bf16x8*)(V_lds + (b) * SHM_V + vst0) = sv0; *(LAS bf16x8*)(V_lds + (b) * SHM_V + vst1) = sv1; \
    *(LAS bf16x8*)(K_lds + (b) * SHM_K + kst[0]) = sk0; *(LAS bf16x8*)(K_lds + (b) * SHM_K + kst[1]) = sk1; *(LAS bf16x8*)(K_lds + (b) * SHM_K + kst[2]) = sk2; } while (0)
#define RESC(a) do { if (__any((a) < 1.f)) { if (hi == 0) al_l[r32] = (a); asm volatile("s_waitcnt lgkmcnt(0)" ::: "memory"); \
    _Pragma("unroll") for (int d = 0; d < 4; ++d) _Pragma("unroll") for (int r = 0; r < 16; ++r) o[d][r] *= al_l[crow(r, hi)]; } } while (0)
  f32x16 p0, p1; float mn, al; bf16x8 pa0, pa1, pa2, pa3;
  SLOAD(0); asm volatile("s_waitcnt vmcnt(0)" ::: "memory"); SWRITE(0); __syncthreads();
  for (int j = 0; j < NT; ++j) {
    const int bsel = j & 1;
    if (j + 1 < NT) SLOAD((j + 1) * KVBLK);
    SBAR(); qkt(p0, p1, K_lds + bsel * SHM_K, qr, r32, hi);
    partialSM(p0, p1, m_reg, mn, al);
    RESC(al);
    finishSM(p0, p1, al, l_reg, pa0, pa1, pa2, pa3); SBAR();
    pv_d0(o, vb0 + bsel * SHM_V, pa0, pa1, pa2, pa3);
    if (j + 1 < NT) { asm volatile("s_waitcnt vmcnt(0)" ::: "memory"); SWRITE(bsel ^ 1); }
    __syncthreads();
  }
  if (hi == 0) li_l[r32] = l_reg; asm volatile("s_waitcnt lgkmcnt(0)" ::: "memory");
  float rli[16];
#pragma unroll
  for (int r = 0; r < 16; ++r) rli[r] = __builtin_amdgcn_rcpf(li_l[crow(r, hi)]);
  bf16_t* Ow = Ob + (size_t)(wid * QBLK) * LDO;
#pragma unroll
  for (int r = 0; r < 16; ++r) { const int orow = crow(r, hi);
#pragma unroll
    for (int d0 = 0; d0 < 4; ++d0) Ow[(size_t)orow * LDO + d0 * 32 + r32] = f2bf(o[d0][r] * rli[r]); }
#undef SLOAD
#undef SWRITE
#undef RESC
}
}

__device__ __forceinline__ void phase_attn(const Params& p, LAS unsigned char* lds) {
    char* ws = p.ws; const bf16_t* Q = (const bf16_t*)(ws + OFF_Q); const bf16_t* Kb = (const bf16_t*)(ws + OFF_K); const bf16_t* Vb = (const bf16_t*)(ws + OFF_V); bf16_t* Y = (bf16_t*)(ws + OFF_H);
    const int G = gridDim.x;
    for (int it = 0;; ++it) {
        int u;
        if (G == 256) { const int c = blockIdx.x, xcd = c & 7, j = c >> 3; if (it >= 4) break; u = ((it * 32 + xcd * 4 + (j >> 3)) << 3) | (j & 7); }
        else { u = it * G + blockIdx.x; if (u >= 1024) break; }
        const int bh = u >> 3, qb = u & 7, b = bh >> 3, h = bh & 7;
        at::attn_unit(Q + ((size_t)(b * SEQ + qb * 256)) * 1536 + h * 192, Kb + (size_t)bh * NKEY * 192, Vb + (size_t)bh * NKEY * 128, Y + ((size_t)(b * SEQ + qb * 256)) * D + h * 128, qb * 256, (const float*)(ws + OFF_ROPE), (LAS char*)lds);
        __syncthreads();
    }
}

namespace sc {
using f32x16 = __attribute__((ext_vector_type(16))) float;
constexpr int O_QI = 0, O_QG = 16384, O_KT = 32768, O_KE = 73728, O_VT = 90112, O_AT = 106496, O_SC = 114688, O_DEC = 147456, O_TOT = 147456 + 512, LDS_SCAN = 147456 + 512 + 4096;
__device__ __forceinline__ int sw256(int row, int cb) { return row * 256 + (cb ^ ((row & 15) << 4)); }
__device__ __forceinline__ int sw128(int row, int cb) { return row * 128 + (cb ^ (((row >> 1) & 7) << 4)); }
__device__ __forceinline__ int crow(int r, int hi) { return (r & 3) + 8 * (r >> 2) + 4 * hi; }
__device__ __forceinline__ int grow_of(int n, int b, int dir) { if (n < CTXL) { const int s = dir ? (CTXL - 1 - n) : n; return L + b * CTXL + s; } const int m = n - CTXL; return b * SEQ + (dir ? (SEQ - 1 - m) : m); }

__device__ __forceinline__ void scan_unit(const Params& p, int unit, LAS unsigned char* lds) {
    char* ws = p.ws; const int dir = unit & 1, h = (unit >> 1) & 7, b = unit >> 4;
    const bf16_t* hq = (const bf16_t*)(ws + OFF_HQ); const bf16_t* fz = (const bf16_t*)(ws + (dir ? OFF_FB : OFF_FF)); const bf16_t* iv = (const bf16_t*)(ws + OFF_IV);
    bf16_t* outp = (bf16_t*)(ws + (dir ? OFF_OB : OFF_OF)); const float* lb = (const float*)(ws + OFF_LB);
    const int tid = otid(), wid = tid >> 6, lane = tid & 63, r32 = lane & 31, hi = lane >> 5;
    const int cp = lane, sb = __builtin_amdgcn_readfirstlane(wid), J = sb >> 1;
    const float lbv0 = lb[dir * 1024 + h * 128 + 2 * cp], lbv1 = lb[dir * 1024 + h * 128 + 2 * cp + 1];
    const int hc = h * 128 + 2 * cp; const int sgn = dir ? -1 : 1; const long rstep = (long)sgn * D;
    LAS unsigned char* QI = lds + O_QI; LAS unsigned char* QG = lds + O_QG; LAS unsigned char* KT = lds + O_KT; LAS unsigned char* KE = lds + O_KE; LAS unsigned char* VT = lds + O_VT;
    LAS unsigned char* AT = lds + O_AT; LAS unsigned char* SCp = lds + O_SC; LAS float* DEC = (LAS float*)(lds + O_DEC); LAS float* TOT = (LAS float*)(lds + O_TOT);
    for (int i = tid; i < (8192 + 32768) / 16; i += 512) *(LAS u32x4*)(lds + O_AT + i * 16) = (u32x4){0u, 0u, 0u, 0u};
    f32x16 S0 = {}, S1 = {};
    const int tb = wid & 1, dvb = wid >> 1;
    unsigned zr[8], vr[8], qr[8];
#define SC_LOAD_Z(c) do { const bf16_t* pz_ = fz + (size_t)(grow_of((c) * 64, b, dir) + sgn * (8 * sb)) * D + hc; _Pragma("unroll") for (int i = 0; i < 8; ++i) { zr[i] = *(const unsigned*)pz_; pz_ += rstep; } } while (0)
#define SC_LOAD_VQ(c) do { const size_t o0_ = (size_t)(grow_of((c) * 64, b, dir) + sgn * (8 * sb)) * D + hc; const bf16_t* pv_ = iv + o0_; const bf16_t* pq_ = hq + o0_; \
        _Pragma("unroll") for (int i = 0; i < 8; ++i) { vr[i] = *(const unsigned*)pv_; pv_ += rstep; if ((c) >= 4) { qr[i] = *(const unsigned*)pq_; pq_ += rstep; } } } while (0)
    SC_LOAD_Z(0); SC_LOAD_VQ(0);
    __syncthreads();
    for (int c = 0; c < 36; ++c) {
        const bool lat = c >= 4;
        {
            float kk0[8], kk1[8], lc0[8], lc1[8]; float run0 = 0.f, run1 = 0.f;
#pragma unroll
            for (int i = 0; i < 8; ++i) { const float z0 = __uint_as_float(zr[i] << 16), z1 = __uint_as_float(zr[i] & 0xffff0000u);
                const float f0 = lbv0 + (1.0f - lbv0) * sigmoidf_(z0), f1 = lbv1 + (1.0f - lbv1) * sigmoidf_(z1); kk0[i] = 1.0f - f0; kk1[i] = 1.0f - f1;
                run0 += __builtin_amdgcn_logf(f0) * 0.6931471805599453f; run1 += __builtin_amdgcn_logf(f1) * 0.6931471805599453f; lc0[i] = run0; lc1[i] = run1; }
            if (c + 1 < 36) SC_LOAD_Z(c + 1);
            *(LAS f32x2*)(TOT + sb * 128 + 2 * cp) = (f32x2){run0, run1};
            __syncthreads();
            float P0 = 0.f, P1 = 0.f, c0J0 = 0.f, c0J1 = 0.f, c010 = 0.f, c011 = 0.f, c020 = 0.f, c021 = 0.f, c030 = 0.f, c031 = 0.f, last0 = 0.f, last1 = 0.f;
            { float a0 = 0.f, a1 = 0.f;
#pragma unroll
              for (int q = 0; q < 8; ++q) { if (q == sb) { P0 = a0; P1 = a1; } if (q == 2 * J) { c0J0 = a0; c0J1 = a1; } if (q == 2) { c010 = a0; c011 = a1; } if (q == 4) { c020 = a0; c021 = a1; } if (q == 6) { c030 = a0; c031 = a1; }
                  const f32x2 tq = *(const LAS f32x2*)(TOT + q * 128 + 2 * cp); a0 += tq[0]; a1 += tq[1]; }
              last0 = a0; last1 = a1; }
            const float off0 = P0 - c0J0, off1 = P1 - c0J1;
            const float eg0 = __expf(c0J0), eg1 = __expf(c0J1), ee0 = __expf(last0 - c0J0), ee1 = __expf(last1 - c0J1);
            const float e10 = __expf(c010 - c0J0), e11 = __expf(c011 - c0J1), e20 = __expf(c020 - c0J0), e21 = __expf(c021 - c0J1), e30 = __expf(c030 - c0J0), e31 = __expf(c031 - c0J1);
            if (sb == 0) *(LAS f32x2*)(DEC + 2 * cp) = (f32x2){__expf(last0), __expf(last1)};
            unsigned ke0[4], ke1[4], vt0[4], vt1[4];
#pragma unroll
            for (int i = 0; i < 8; ++i) { const int t = 8 * sb + i; const float l0 = lc0[i] + off0, l1 = lc1[i] + off1;
                const float kd0 = kk0[i] * __expf(fminf(-l0, 80.0f)), kd1 = kk1[i] * __expf(fminf(-l1, 80.0f));
                if (lat) { const float q0 = __uint_as_float(qr[i] << 16), q1 = __uint_as_float(qr[i] & 0xffff0000u); const float qi0 = q0 * __expf(l0), qi1 = q1 * __expf(l1);
                    *(LAS unsigned*)(QI + sw256(t, 4 * cp)) = cvt_pk_bf16(qi0, qi1); *(LAS unsigned*)(QG + sw256(t, 4 * cp)) = cvt_pk_bf16(qi0 * eg0, qi1 * eg1);
                    if (J == 0) { *(LAS unsigned*)(KT + sw256(0 + t, 4 * cp)) = cvt_pk_bf16(kd0, kd1); *(LAS unsigned*)(KT + sw256(16 + t, 4 * cp)) = cvt_pk_bf16(kd0 * e10, kd1 * e11);
                                  *(LAS unsigned*)(KT + sw256(48 + t, 4 * cp)) = cvt_pk_bf16(kd0 * e20, kd1 * e21); *(LAS unsigned*)(KT + sw256(96 + t, 4 * cp)) = cvt_pk_bf16(kd0 * e30, kd1 * e31); }
                    else if (J == 1) { *(LAS unsigned*)(KT + sw256(16 + t, 4 * cp)) = cvt_pk_bf16(kd0, kd1); *(LAS unsigned*)(KT + sw256(48 + t, 4 * cp)) = cvt_pk_bf16(kd0 * e20, kd1 * e21); *(LAS unsigned*)(KT + sw256(96 + t, 4 * cp)) = cvt_pk_bf16(kd0 * e30, kd1 * e31); }
                    else if (J == 2) { *(LAS unsigned*)(KT + sw256(48 + t, 4 * cp)) = cvt_pk_bf16(kd0, kd1); *(LAS unsigned*)(KT + sw256(96 + t, 4 * cp)) = cvt_pk_bf16(kd0 * e30, kd1 * e31); }
                    else { *(LAS unsigned*)(KT + sw256(96 + t, 4 * cp)) = cvt_pk_bf16(kd0, kd1); } }
                const float kf0 = kd0 * ee0, kf1 = kd1 * ee1;
                if (i & 1) { ke0[i >> 1] = cvt_pk_bf16(__uint_as_float(ke0[i >> 1]), kf0); ke1[i >> 1] = cvt_pk_bf16(__uint_as_float(ke1[i >> 1]), kf1); vt0[i >> 1] = (vt0[i >> 1] >> 16) | (vr[i] << 16); vt1[i >> 1] = (vt1[i >> 1] >> 16) | (vr[i] & 0xffff0000u); }
                else { ke0[i >> 1] = __float_as_uint(kf0); ke1[i >> 1] = __float_as_uint(kf1); vt0[i >> 1] = vr[i] << 16; vt1[i >> 1] = vr[i] & 0xffff0000u; }
            }
            *(LAS u32x4*)(KE + sw128(2 * cp, 16 * sb)) = (u32x4){ke0[0], ke0[1], ke0[2], ke0[3]}; *(LAS u32x4*)(KE + sw128(2 * cp + 1, 16 * sb)) = (u32x4){ke1[0], ke1[1], ke1[2], ke1[3]};
            *(LAS u32x4*)(VT + sw128(2 * cp, 16 * sb)) = (u32x4){vt0[0], vt0[1], vt0[2], vt0[3]}; *(LAS u32x4*)(VT + sw128(2 * cp + 1, 16 * sb)) = (u32x4){vt1[0], vt1[1], vt1[2], vt1[3]};
        }
        if (c + 1 < 36) SC_LOAD_VQ(c + 1);
        __syncthreads();
        if (lat) {
#pragma unroll
            for (int rep = 0; rep < 2; ++rep) { const int ti = wid + 8 * rep; if (ti < 10) {
                const int I = ti < 1 ? 0 : (ti < 3 ? 1 : (ti < 6 ? 2 : 3)); const int Jt = ti - (I * (I + 1)) / 2; const int kbase = I == 0 ? 0 : (I == 1 ? 16 : (I == 2 ? 48 : 96));
                const int l15 = lane & 15, lq = lane >> 4; f32x4 a = {0.f, 0.f, 0.f, 0.f};
#pragma unroll
                for (int ks = 0; ks < 4; ++ks) { const bf16x8 av = *(const LAS bf16x8*)(QI + sw256(16 * I + l15, (32 * ks + 8 * lq) * 2)); const bf16x8 bv = *(const LAS bf16x8*)(KT + sw256(kbase + 16 * Jt + l15, (32 * ks + 8 * lq) * 2));
                    a = __builtin_amdgcn_mfma_f32_16x16x32_bf16(av, bv, a, 0, 0, 0); }
#pragma unroll
                for (int r = 0; r < 4; ++r) { const int tl = 4 * lq + r; float v = a[r]; if (I == Jt && l15 > tl) v = 0.f; *(LAS bf16_t*)(AT + sw128(16 * I + tl, (16 * Jt + l15) * 2)) = f2bf(v); } } }
        }
        __syncthreads();
        {
            if (lat) {
                f32x16 o = {};
#pragma unroll
                for (int ks = 0; ks < 8; ++ks) { const bf16x8 av = *(const LAS bf16x8*)(QG + sw256(32 * tb + r32, (16 * ks + 8 * hi) * 2)); const bf16x8 bv = *(const LAS bf16x8*)(SCp + sw256(32 * dvb + r32, (16 * ks + 8 * hi) * 2));
                    o = __builtin_amdgcn_mfma_f32_32x32x16_bf16(av, bv, o, 0, 0, 0); }
#pragma unroll
                for (int ks = 0; ks < 4; ++ks) { if (ks < 2 || tb == 1) { const bf16x8 av = *(const LAS bf16x8*)(AT + sw128(32 * tb + r32, (16 * ks + 8 * hi) * 2)); const bf16x8 bv = *(const LAS bf16x8*)(VT + sw128(32 * dvb + r32, (16 * ks + 8 * hi) * 2));
                    o = __builtin_amdgcn_mfma_f32_32x32x16_bf16(av, bv, o, 0, 0, 0); } }
                bf16_t* po = outp + (size_t)(grow_of(c * 64, b, dir) + sgn * (32 * tb + 4 * hi)) * D + h * 128 + 32 * dvb + r32;
#pragma unroll
                for (int r = 0; r < 16; ++r) po[(long)((r & 3) + 8 * (r >> 2)) * rstep] = f2bf(o[r]);
            }
#pragma unroll
            for (int r = 0; r < 16; ++r) { S0[r] *= DEC[64 * tb + crow(r, hi)]; S1[r] *= DEC[64 * tb + 32 + crow(r, hi)]; }
#pragma unroll
            for (int ks = 0; ks < 4; ++ks) { const bf16x8 bv = *(const LAS bf16x8*)(VT + sw128(32 * dvb + r32, (16 * ks + 8 * hi) * 2));
                const bf16x8 a0 = *(const LAS bf16x8*)(KE + sw128(64 * tb + r32, (16 * ks + 8 * hi) * 2)), a1 = *(const LAS bf16x8*)(KE + sw128(64 * tb + 32 + r32, (16 * ks + 8 * hi) * 2));
                S0 = __builtin_amdgcn_mfma_f32_32x32x16_bf16(a0, bv, S0, 0, 0, 0); S1 = __builtin_amdgcn_mfma_f32_32x32x16_bf16(a1, bv, S1, 0, 0, 0); }
        }
        __syncthreads();
#pragma unroll
        for (int g = 0; g < 4; ++g) { const int dv = 32 * dvb + r32; const int dk0 = 64 * tb + 8 * g + 4 * hi;
            u32x2 w0; w0.x = cvt_pk_bf16(S0[4 * g], S0[4 * g + 1]); w0.y = cvt_pk_bf16(S0[4 * g + 2], S0[4 * g + 3]); *(LAS u32x2*)(SCp + sw256(dv, dk0 * 2)) = w0;
            u32x2 w1; w1.x = cvt_pk_bf16(S1[4 * g], S1[4 * g + 1]); w1.y = cvt_pk_bf16(S1[4 * g + 2], S1[4 * g + 3]); *(LAS u32x2*)(SCp + sw256(dv, (dk0 + 32) * 2)) = w1; }
    }
    __syncthreads();
#undef SC_LOAD_Z
#undef SC_LOAD_VQ
}
}
__device__ __forceinline__ void phase_scan(const Params& p, LAS unsigned char* lds) {
    for (int u = blockIdx.x; u < 256; u += gridDim.x) sc::scan_unit(p, u, lds);
}

constexpr int LDS_BYTES = 155648;
template <int PH> __global__ void __launch_bounds__(512, 2) k_phase(Params p) {
    extern __shared__ __attribute__((aligned(16))) unsigned char smem[];
    LAS unsigned char* lds = (LAS unsigned char*)smem;
    if constexpr (PH == 0) phase0(p, lds);
    if constexpr (PH == 1) phase1(p, lds);
    if constexpr (PH == 2) phase2(p, lds);
    if constexpr (PH == 3) phase3(p, lds);
    if constexpr (PH == 4) phase4(p, lds);
    if constexpr (PH == 5) phase5(p, lds);
    if constexpr (PH == 6) phase6(p, lds);
    if constexpr (PH == 7) phase7(p, lds);
    if constexpr (PH == 8) phase8(p, lds);
    if constexpr (PH == 9) phase9(p, lds);
    if constexpr (PH == 10) phase_attn(p, lds);
    if constexpr (PH == 11) phase_scan(p, lds);
}

#include <cstdint>
#include <cstdlib>
#include <vector>

#define XB_TMO      128
#define XB_XCNT(j)  (256  + 64 * (j))
#define XB_XSUB(j)  (1280 + 64 * (j))
#define XB_XGEN(j)  (2304 + 64 * (j))
#define XB_TOP      3328
#define XB_TOPGEN   3392
#define XCD_BAR_WORDS 3456
#define XB_SPIN_CAP (1u << 18)

__device__ __forceinline__ unsigned xb_ld(unsigned* p)              { return __hip_atomic_load(p, __ATOMIC_RELAXED, __HIP_MEMORY_SCOPE_AGENT); }
__device__ __forceinline__ unsigned xb_add(unsigned* p, unsigned v) { return __hip_atomic_fetch_add(p, v, __ATOMIC_RELAXED, __HIP_MEMORY_SCOPE_AGENT); }
__device__ __forceinline__ unsigned xb_xcc_id() { return (unsigned)__builtin_amdgcn_s_getreg((3 << 11) | 20) & 0xFu; }
#define XB_SPIN(cond, bar) do { unsigned _sp = 0; while (cond) { __builtin_amdgcn_s_sleep(1); \
    if ((++_sp & 255u) == 0u) { if (xb_ld(&(bar)[XB_TMO])) break; if (_sp > XB_SPIN_CAP) { atomicAdd(&(bar)[XB_TMO], 1u); break; } } } } while (0)

struct XcdBarrier {
    unsigned* bar; unsigned x;
    volatile LAS unsigned* st;
};

__device__ __forceinline__ XcdBarrier xcd_barrier_post(unsigned* bar, volatile LAS unsigned* st) {
    XcdBarrier b; b.bar = bar; b.x = xb_xcc_id(); b.st = st;
    if (threadIdx.x == 0) (void)xb_add(&bar[XB_XCNT(b.x)], 1u);
    return b;
}
__device__ __forceinline__ void xcd_barrier_complete(unsigned* bar, unsigned x, unsigned& nloc, unsigned& nx) {
    const unsigned G = gridDim.x * gridDim.y * gridDim.z;
    unsigned sum, cnt, mine, sp = 0u;
    for (;;) {
        sum = 0u; cnt = 0u; mine = 0u;
#pragma unroll
        for (unsigned j = 0; j < 16; ++j) { const unsigned c = xb_ld(&bar[XB_XCNT(j)]); sum += c; cnt += (c > 0u) ? 1u : 0u; mine = (j == x) ? c : mine; }
        if (sum == G) break;
        __builtin_amdgcn_s_sleep(1);
        if ((++sp & 255u) == 0u) { if (xb_ld(&bar[XB_TMO])) break; if (sp > XB_SPIN_CAP) { atomicAdd(&bar[XB_TMO], 1u); break; } }
    }
    nloc = mine > 0u ? mine : 1u; nx = cnt > 0u ? cnt : 1u;
}

__device__ __forceinline__ void xcd_barrier(const XcdBarrier& b) {
    asm volatile("s_waitcnt vmcnt(0)" ::: "memory");
    __syncthreads();
    if (threadIdx.x == 0) {
        unsigned* bar = b.bar;
        __builtin_amdgcn_s_waitcnt(0);
        unsigned nloc = b.st[0], nx = b.st[1];
        if (nloc == 0u) { xcd_barrier_complete(bar, b.x, nloc, nx); b.st[0] = nloc; b.st[1] = nx; }
        const unsigned old = xb_add(&bar[XB_XSUB(b.x)], 1u);
        const unsigned gen = old / nloc;
        if (old + 1u == (gen + 1u) * nloc) {
            __builtin_amdgcn_fence(__ATOMIC_RELEASE, "agent");
            asm volatile("s_waitcnt vmcnt(0)" ::: "memory");
            const unsigned og = xb_add(&bar[XB_TOP], 1u);
            const unsigned tg = og / nx;
            if (og + 1u == (tg + 1u) * nx) xb_add(&bar[XB_TOPGEN], 1u);
            else XB_SPIN(xb_ld(&bar[XB_TOPGEN]) == tg, bar);
            __builtin_amdgcn_fence(__ATOMIC_ACQUIRE, "agent");
            xb_add(&bar[XB_XGEN(b.x)], 1u);
            asm volatile("s_waitcnt vmcnt(0)" ::: "memory");
        } else {
            XB_SPIN(xb_ld(&bar[XB_XGEN(b.x)]) == gen, bar);
            __builtin_amdgcn_fence(__ATOMIC_ACQUIRE, "agent");
            asm volatile("s_waitcnt vmcnt(0)" ::: "memory");
        }
    }
    __syncthreads();
}

__global__ void __launch_bounds__(512, 2) k_mega(Params p) {
    extern __shared__ __attribute__((aligned(16))) unsigned char smem[];
    LAS unsigned char* lds = (LAS unsigned char*)smem;
    volatile LAS unsigned* xbw = (volatile LAS unsigned*)(lds + LDS_BYTES - 16);
    if (threadIdx.x == 0) { xbw[0] = 0u; xbw[1] = 0u; xbw[2] = 0u; xbw[3] = 0u; }
    __syncthreads();
    XcdBarrier bar = xcd_barrier_post((unsigned*)(p.ws + OFF_BAR), xbw);
    phase0(p, lds);      xcd_barrier(bar);
    phase1(p, lds);      xcd_barrier(bar);
    phase2(p, lds);      xcd_barrier(bar);
    phase3(p, lds);      xcd_barrier(bar);
    phase_attn(p, lds);
    phase_scan(p, lds);  xcd_barrier(bar);
    phase4(p, lds);      xcd_barrier(bar);
    phase5(p, lds);      xcd_barrier(bar);
    phase6(p, lds);      xcd_barrier(bar);
    phase7(p, lds);      xcd_barrier(bar);
    phase8(p, lds);      xcd_barrier(bar);
    phase9(p, lds);
}
extern "C" void kernel_launch(void* const* d_in, const int* in_sizes, int n_in, void* d_out, int out_size, void* d_ws, size_t ws_size, hipStream_t stream) {
    static int grid = 0;
    if (grid == 0) {
        int dev = 0, cus = 0, per_cu = 0;
        if (hipGetDevice(&dev) != hipSuccess || hipDeviceGetAttribute(&cus, hipDeviceAttributeMultiprocessorCount, dev) != hipSuccess) { grid = -1; return; }
        if (hipFuncSetAttribute((const void*)k_mega, hipFuncAttributeMaxDynamicSharedMemorySize, LDS_BYTES) != hipSuccess) { grid = -1; return; }
        (void)hipOccupancyMaxActiveBlocksPerMultiprocessor(&per_cu, (const void*)k_mega, 512, LDS_BYTES);
        (void)hipGetLastError();
        grid = cus;
    }
    if (grid < 0) return;
    Params p{};
    p.x = (const float*)d_in[0]; p.c = (const float*)d_in[1]; p.ctx = (const float*)d_in[2]; p.cctx = (const float*)d_in[3]; p.w_mod = (const float*)d_in[4]; p.b_mod = (const float*)d_in[5];
    p.g_mix = (const float*)d_in[6]; p.w_in = (const float*)d_in[7]; p.g_q = (const float*)d_in[8]; p.w_qb = (const float*)d_in[9]; p.g_kv = (const float*)d_in[10]; p.w_kvb = (const float*)d_in[11];
    p.lbl = (const float*)d_in[12]; p.g_hg = (const float*)d_in[13]; p.w_out = (const float*)d_in[14]; p.g_ffn = (const float*)d_in[15]; p.w_r = (const float*)d_in[16]; p.b_r = (const float*)d_in[17];
    p.w_gu = (const float*)d_in[18]; p.b_gu = (const float*)d_in[19]; p.w_dn = (const float*)d_in[20]; p.b_dn = (const float*)d_in[21]; p.g_fin = (const float*)d_in[22];
    p.out = (float*)d_out; p.ws = (char*)d_ws;
    (void)hipMemsetAsync((char*)d_ws + OFF_BAR, 0, 16384, stream);
    hipLaunchKernelGGL(k_mega, dim3(grid), dim3(512), LDS_BYTES, stream, p);
}
```

```cpp
#include <hip/hip_runtime.h>
#include <stdint.h>

typedef unsigned short bf16_t;
__device__ __forceinline__ float bf2f(bf16_t v) { return __uint_as_float(((unsigned)v) << 16); }
__device__ __forceinline__ bf16_t f2bf(float f) { unsigned u = __float_as_uint(f); u += 0x7FFFu + ((u >> 16) & 1u); return (bf16_t)(u >> 16); }
__device__ __forceinline__ float sigmoidf_(float x) { return __builtin_amdgcn_rcpf(1.0f + __builtin_amdgcn_exp2f(-1.4426950408889634f * x)); }
__device__ __forceinline__ float siluf_(float x) { return x * __builtin_amdgcn_rcpf(1.0f + __builtin_amdgcn_exp2f(-1.4426950408889634f * x)); }

constexpr int D = 1024, NB = 16, SEQ = 2048, CTXL = 256;
constexpr int L = NB * SEQ;
constexpr int RC = NB * CTXL;
constexpr int R = L + RC;
constexpr int NKEY = SEQ + CTXL;
constexpr float EPS = 1e-6f;
constexpr int NE = 32, CAP = 32768;
constexpr int MAXROWS = 131072 + NE * 256;

constexpr size_t MiB = 1048576;
constexpr size_t OFF_SMALL = 0;
constexpr size_t OFF_BAR = 0;
constexpr size_t OFF_CNT = 16384;
constexpr size_t OFF_OFFS = 16384 + 1024;
constexpr size_t OFF_TILEE = 16384 + 2048;
constexpr size_t OFF_LB = 24576;
constexpr size_t OFF_MOD = 32768;
constexpr size_t OFF_SSQQ = 512 * 1024;
constexpr size_t OFF_SSQKV = 768 * 1024;
constexpr size_t OFF_TOPI = 1 * MiB;
constexpr size_t OFF_TOPP = 1 * MiB + 512 * 1024;
constexpr size_t OFF_ROWPAIR = 2 * MiB;
constexpr size_t OFF_LIST = 3 * MiB;
constexpr size_t OFF_H = 32 * MiB;
constexpr size_t OFF_QA = 104 * MiB;
constexpr size_t OFF_CKV = 152 * MiB;
constexpr size_t OFF_KR = 170 * MiB;
constexpr size_t OFF_OF = 104 * MiB;
constexpr size_t OFF_HQ = 175 * MiB;
constexpr size_t SEG_STRIDE = 72 * MiB;
constexpr size_t OFF_FF = OFF_HQ + 1 * SEG_STRIDE;
constexpr size_t OFF_FB = OFF_HQ + 2 * SEG_STRIDE;
constexpr size_t OFF_IV = OFF_HQ + 3 * SEG_STRIDE;
constexpr size_t OFF_OG = OFF_HQ + 4 * SEG_STRIDE;
constexpr size_t OFF_GM = OFF_HQ + 5 * SEG_STRIDE;
constexpr size_t OFF_GH = OFF_HQ + 6 * SEG_STRIDE;
constexpr size_t OFF_Q = 679 * MiB;
constexpr size_t OFF_K = 775 * MiB;
constexpr size_t OFF_V = 883 * MiB;
constexpr size_t OFF_OB = 955 * MiB;
constexpr size_t OFF_YP = 296 * MiB;
constexpr size_t OFF_ACT = 568 * MiB;

struct SegOut { bf16_t *qa, *ckv, *kr, *hq, *ff, *fb, *iv, *og, *gm, *gh; };

__global__ void k_init(const float* __restrict__ lbl, float* lb, int* cnt) {
    int i = blockIdx.x * blockDim.x + threadIdx.x;
    if (i < 2048) { int d = i >> 10, j = i & 1023; float a = lbl[(d * 2 + 0) * 1024 + j], b = lbl[(d * 2 + 1) * 1024 + j]; lb[i] = 1.0f / (1.0f + __expf(b - a)); }
    if (i < 32) cnt[i] = 0;
}

__global__ __launch_bounds__(256) void k_mod(const float* __restrict__ c, const float* __restrict__ cctx, const float* __restrict__ wmod, const float* __restrict__ bmod, float* modv) {
    __shared__ float s[1024];
    int r = blockIdx.y; const float* src = r < 16 ? c + r * 1024 : cctx;
    for (int k = threadIdx.x; k < 1024; k += 256) s[k] = siluf_(src[k]);
    __syncthreads();
    int j = blockIdx.x * 256 + threadIdx.x; float acc = 0.f;
    for (int k = 0; k < 1024; ++k) acc += s[k] * wmod[(size_t)k * 6144 + j];
    modv[r * 6144 + j] = acc + bmod[j];
}

__device__ __forceinline__ float block_sum256(float v, float* red) {
    for (int o = 32; o > 0; o >>= 1) v += __shfl_xor(v, o);
    int w = threadIdx.x >> 6; if ((threadIdx.x & 63) == 0) red[w] = v; __syncthreads();
    float t = red[0] + red[1] + red[2] + red[3]; __syncthreads(); return t;
}

__global__ __launch_bounds__(256) void k_norm1(const float* __restrict__ x, const float* __restrict__ ctx, const float* __restrict__ g, const float* __restrict__ modv, bf16_t* h) {
    __shared__ float red[4];
    int row = blockIdx.x; const float* src = row < L ? x + (size_t)row * D : ctx + (size_t)(row - L) * D;
    const float* mod = modv + (row < L ? row / SEQ : 16) * 6144;
    int c = threadIdx.x * 4; float4 v = *(const float4*)(src + c);
    float ss = block_sum256(v.x * v.x + v.y * v.y + v.z * v.z + v.w * v.w, red);
    float rs = rsqrtf(ss * (1.0f / D) + EPS);
    float o[4] = {v.x, v.y, v.z, v.w}; ushort4 w; bf16_t* wp = (bf16_t*)&w;
    for (int i = 0; i < 4; ++i) wp[i] = f2bf(o[i] * rs * g[c + i] * (1.0f + mod[1024 + c + i]) + mod[c + i]);
    *(ushort4*)(h + (size_t)row * D + c) = w;
}

__global__ __launch_bounds__(256) void k_rowssq(const bf16_t* __restrict__ buf, int width, int nrows, float* ssq) {
    int row = blockIdx.x * 4 + (threadIdx.x >> 6), lane = threadIdx.x & 63; if (row >= nrows) return;
    float s = 0.f; for (int k = lane; k < width; k += 64) { float v = bf2f(buf[(size_t)row * width + k]); s += v * v; }
    for (int o = 32; o > 0; o >>= 1) s += __shfl_xor(s, o);
    if (lane == 0) ssq[row] = s;
}

__device__ __forceinline__ void rope_cs(int t, int i, float& cs, float& sn) {
    int j = i & 15; float inv = __expf(-(float)j * (9.210340371976184f / 16.0f)); float pos = (i < 16) ? (float)(t >> 6) : (float)(t & 63);
    float ang = pos * inv; cs = cosf(ang); sn = sinf(ang);
}

__global__ __launch_bounds__(256) void k_krope(const bf16_t* __restrict__ kr, bf16_t* Kb) {
    int gid = blockIdx.x * 256 + threadIdx.x; int row = gid >> 5, i = gid & 31; if (row >= R) return;
    float x1 = bf2f(kr[(size_t)row * 64 + i]), x2 = bf2f(kr[(size_t)row * 64 + 32 + i]); float o1 = x1, o2 = x2; int b, pos;
    if (row < L) { b = row / SEQ; pos = row % SEQ; float cs, sn; rope_cs(pos, i, cs, sn); o1 = x1 * cs - x2 * sn; o2 = x1 * sn + x2 * cs; }
    else { b = (row - L) / CTXL; pos = SEQ + (row - L) % CTXL; }
    bf16_t w1 = f2bf(o1), w2 = f2bf(o2);
    for (int h = 0; h < 8; ++h) { bf16_t* p = Kb + ((size_t)(b * 8 + h) * NKEY + pos) * 192 + 128; p[i] = w1; p[32 + i] = w2; }
}

template <class AL, class EP>
__global__ __launch_bounds__(256) void k_ngemm(int K, const float* __restrict__ W, int ldw, size_t wzstride, AL al, EP ep) {
    __shared__ float As[16][68]; __shared__ float Bs[16][64];
    const int z = blockIdx.z, row0 = blockIdx.y * 64, col0 = blockIdx.x * 64, tid = threadIdx.x;
    const int mvalid = al.rows(z); if (row0 >= mvalid) return;
    const float* Wz = W + (size_t)z * wzstride;
    const int ar = tid >> 2, ak = (tid & 3) * 4; const bf16_t* arow = (row0 + ar < mvalid) ? al.rowptr(z, row0 + ar) : nullptr;
    const int bk = tid >> 4, bn = (tid & 15) * 4;
    const int ty = tid >> 4, tx = tid & 15;
    float acc[4][4] = {};
    for (int k0 = 0; k0 < K; k0 += 16) {
        float a4[4] = {0.f, 0.f, 0.f, 0.f};
        if (arow) { ushort4 u = *(const ushort4*)(arow + k0 + ak); const bf16_t* up = (const bf16_t*)&u; for (int i = 0; i < 4; ++i) a4[i] = bf2f(up[i]) * al.kscale(k0 + ak + i); }
        float4 b4 = *(const float4*)(Wz + (size_t)(k0 + bk) * ldw + col0 + bn);
        __syncthreads();
        for (int i = 0; i < 4; ++i) As[ak + i][ar] = a4[i];
        *(float4*)&Bs[bk][bn] = b4;
        __syncthreads();
#pragma unroll
        for (int kk = 0; kk < 16; ++kk) {
            float4 av = *(const float4*)&As[kk][ty * 4]; float4 bv = *(const float4*)&Bs[kk][tx * 4];
            float a[4] = {av.x, av.y, av.z, av.w}, b[4] = {bv.x, bv.y, bv.z, bv.w};
#pragma unroll
            for (int i = 0; i < 4; ++i)
#pragma unroll
                for (int j = 0; j < 4; ++j) acc[i][j] += a[i] * b[j];
        }
    }
    for (int i = 0; i < 4; ++i) { int row = row0 + ty * 4 + i; if (row < mvalid) ep.store(z, row, col0 + tx * 4, acc[i]); }
}

__device__ __forceinline__ void st4bf(bf16_t* dst, const float* v) { ushort4 w; bf16_t* wp = (bf16_t*)&w; for (int i = 0; i < 4; ++i) wp[i] = f2bf(v[i]); *(ushort4*)dst = w; }

struct ALDense { const bf16_t* A; int lda; int nrows; const float* ks;
    __device__ int rows(int) const { return nrows; }
    __device__ const bf16_t* rowptr(int, int row) const { return A + (size_t)row * lda; }
    __device__ float kscale(int k) const { return ks ? ks[k] : 1.0f; } };

struct EpiInN { SegOut s;
    __device__ void store(int, int row, int col, const float* v) const {
        bf16_t* dst;
        if (col < 768) { if (row >= L) return; dst = s.qa + (size_t)row * 768 + col; }
        else if (col < 1024) dst = s.ckv + (size_t)row * 256 + (col - 768);
        else if (col < 1088) dst = s.kr + (size_t)row * 64 + (col - 1024);
        else { int c = col - 1088, seg = c >> 10, cc = c & 1023; bool latonly = (seg == 0 || seg >= 4); if (latonly && row >= L) return;
            bf16_t* base = seg == 0 ? s.hq : seg == 1 ? s.ff : seg == 2 ? s.fb : seg == 3 ? s.iv : seg == 4 ? s.og : seg == 5 ? s.gm : s.gh;
            dst = base + (size_t)row * 1024 + cc; }
        st4bf(dst, v);
    } };

struct EpiQN { bf16_t* q; const float* ssq;
    __device__ void store(int, int row, int col, const float* v) const { float rs = rsqrtf(ssq[row] * (1.0f / 768.0f) + EPS); float o[4]; for (int i = 0; i < 4; ++i) o[i] = v[i] * rs; st4bf(q + (size_t)row * 1536 + col, o); } };

struct EpiKVN { bf16_t *Kb, *Vb; const float* ssq;
    __device__ void store(int, int row, int col, const float* v) const {
        float rs = rsqrtf(ssq[row] * (1.0f / 256.0f) + EPS); float o[4]; for (int i = 0; i < 4; ++i) o[i] = v[i] * rs;
        int b, pos; if (row < L) { b = row / SEQ; pos = row % SEQ; } else { b = (row - L) / CTXL; pos = SEQ + (row - L) % CTXL; }
        int h = col >> 8, w = col & 255; size_t kvrow = (size_t)(b * 8 + h) * NKEY + pos;
        if (w < 128) st4bf(Kb + kvrow * 192 + w, o); else st4bf(Vb + kvrow * 128 + (w - 128), o);
    } };

struct EpiOutN { float* x1; const float* x; const float* modv;
    __device__ void store(int, int row, int col, const float* v) const {
        const float* gate = modv + (row / SEQ) * 6144 + 2 * 1024; float4 xv = *(const float4*)(x + (size_t)row * D + col);
        float4 o; o.x = xv.x + gate[col] * v[0]; o.y = xv.y + gate[col + 1] * v[1]; o.z = xv.z + gate[col + 2] * v[2]; o.w = xv.w + gate[col + 3] * v[3];
        *(float4*)(x1 + (size_t)row * D + col) = o;
    } };

struct ALMoe1 { const bf16_t* h2; const int* cnt; const int* list;
    __device__ int rows(int z) const { return cnt[z]; }
    __device__ const bf16_t* rowptr(int z, int row) const { return h2 + (size_t)(list[z * CAP + row] >> 2) * D; }
    __device__ float kscale(int) const { return 1.0f; } };
struct EpiMoe1N { bf16_t* act; const int* offs; const float* bgu;
    __device__ void store(int z, int row, int col, const float* v) const {
        const float* bb = bgu + z * 2048 + col; ushort2 w; bf16_t* wp = (bf16_t*)&w;
        for (int p = 0; p < 2; ++p) { float glu = fminf(v[2 * p] + bb[2 * p], 7.0f); float lin = fminf(fmaxf(v[2 * p + 1] + bb[2 * p + 1], -7.0f), 7.0f);
            wp[p] = f2bf(glu * sigmoidf_(1.702f * glu) * (lin + 1.0f)); }
        *(ushort2*)(act + (size_t)(offs[z] + row) * D + (col >> 1)) = w;
    } };
struct ALMoe2 { const bf16_t* act; const int* cnt; const int* offs;
    __device__ int rows(int z) const { return cnt[z]; }
    __device__ const bf16_t* rowptr(int z, int row) const { return act + (size_t)(offs[z] + row) * D; }
    __device__ float kscale(int) const { return 1.0f; } };
struct EpiMoe2N { bf16_t* yp; const int* list; const float* bd;
    __device__ void store(int z, int row, int col, const float* v) const {
        int pair = list[z * CAP + row]; const float* bb = bd + z * 1024 + col; float o[4]; for (int i = 0; i < 4; ++i) o[i] = v[i] + bb[i];
        st4bf(yp + (size_t)pair * D + col, o);
    } };

__global__ __launch_bounds__(256) void k_nattn(const bf16_t* __restrict__ Q, const bf16_t* __restrict__ Kb, const bf16_t* __restrict__ Vb, bf16_t* Y) {
    __shared__ float qs[4][192]; __shared__ float sc[4][NKEY];
    const int tid = threadIdx.x, blk = blockIdx.x, qg = blk & 511, h = (blk >> 9) & 7, b = blk >> 12;
    for (int idx = tid; idx < 4 * 192; idx += 256) { int qi = idx / 192, d = idx % 192; int row = b * SEQ + qg * 4 + qi; qs[qi][d] = bf2f(Q[(size_t)row * 1536 + h * 192 + d]); }
    __syncthreads();
    float n1 = 0.f, n2 = 0.f;
    if (tid < 128) { int qi = tid >> 5, i = tid & 31; int t = qg * 4 + qi; float cs, sn; rope_cs(t, i, cs, sn); float x1 = qs[qi][128 + i], x2 = qs[qi][160 + i]; n1 = x1 * cs - x2 * sn; n2 = x1 * sn + x2 * cs; }
    __syncthreads();
    if (tid < 128) { int qi = tid >> 5, i = tid & 31; qs[qi][128 + i] = n1; qs[qi][160 + i] = n2; }
    __syncthreads();
    const bf16_t* Kp = Kb + (size_t)(b * 8 + h) * NKEY * 192; const bf16_t* Vp = Vb + (size_t)(b * 8 + h) * NKEY * 128;
    const float scale = 0.07216878364870322f;
    for (int key = tid; key < NKEY; key += 256) {
        const bf16_t* kr = Kp + (size_t)key * 192; float s0 = 0.f, s1 = 0.f, s2 = 0.f, s3 = 0.f;
        for (int d = 0; d < 192; d += 8) { uint4 u = *(const uint4*)(kr + d); const bf16_t* up = (const bf16_t*)&u;
            for (int j = 0; j < 8; ++j) { float kv = bf2f(up[j]); s0 += qs[0][d + j] * kv; s1 += qs[1][d + j] * kv; s2 += qs[2][d + j] * kv; s3 += qs[3][d + j] * kv; } }
        sc[0][key] = s0 * scale; sc[1][key] = s1 * scale; sc[2][key] = s2 * scale; sc[3][key] = s3 * scale;
    }
    __syncthreads();
    { int w = tid >> 6, lane = tid & 63; float m = -1e30f; for (int k = lane; k < NKEY; k += 64) m = fmaxf(m, sc[w][k]);
      for (int o = 32; o > 0; o >>= 1) m = fmaxf(m, __shfl_xor(m, o));
      float s = 0.f; for (int k = lane; k < NKEY; k += 64) { float e = __expf(sc[w][k] - m); sc[w][k] = e; s += e; }
      for (int o = 32; o > 0; o >>= 1) s += __shfl_xor(s, o);
      float inv = 1.0f / s; for (int k = lane; k < NKEY; k += 64) sc[w][k] *= inv; }
    __syncthreads();
    { int dv = tid & 127, qh = tid >> 7; float o0 = 0.f, o1 = 0.f;
      for (int k = 0; k < NKEY; ++k) { float v = bf2f(Vp[(size_t)k * 128 + dv]); o0 += sc[qh * 2][k] * v; o1 += sc[qh * 2 + 1][k] * v; }
      int row = b * SEQ + qg * 4 + qh * 2; Y[(size_t)row * D + h * 128 + dv] = f2bf(o0); Y[(size_t)(row + 1) * D + h * 128 + dv] = f2bf(o1); }
}

__global__ __launch_bounds__(256) void k_nscan(const bf16_t* __restrict__ hq, const bf16_t* __restrict__ ff, const bf16_t* __restrict__ fb, const bf16_t* __restrict__ iv, const float* __restrict__ lb, bf16_t* of, bf16_t* ob) {
    __shared__ float sf[128], sk[128], sq[128], so[2][128];
    const int tid = threadIdx.x, blk = blockIdx.x, dir = blk & 1, h = (blk >> 1) & 7, b = blk >> 4;
    const bf16_t* fz = dir ? fb : ff; bf16_t* out = dir ? ob : of;
    const int dv = tid & 127, half = tid >> 7;
    float S[64];
#pragma unroll
    for (int j = 0; j < 64; ++j) S[j] = 0.f;
    const float lbv = lb[dir * 1024 + h * 128 + (tid & 127)];
    for (int step = 0; step < NKEY; ++step) {
        int row; bool islat;
        if (step < CTXL) { int s = dir ? (CTXL - 1 - step) : step; row = L + b * CTXL + s; islat = false; }
        else { int t = step - CTXL; t = dir ? (SEQ - 1 - t) : t; row = b * SEQ + t; islat = true; }
        if (tid < 128) { float z = bf2f(fz[(size_t)row * D + h * 128 + tid]); float f = lbv + (1.0f - lbv) * sigmoidf_(z); sf[tid] = f; sk[tid] = 1.0f - f;
            if (islat) { float zq = bf2f(hq[(size_t)row * D + h * 128 + tid]); sq[tid] = siluf_(zq) * 0.08838834764831845f; } }
        float v = bf2f(iv[(size_t)row * D + h * 128 + dv]);
        __syncthreads();
        float o = 0.f;
#pragma unroll
        for (int j = 0; j < 64; ++j) { int dk = half * 64 + j; S[j] = sf[dk] * S[j] + sk[dk] * v; o += S[j] * sq[dk]; }
        if (islat) so[half][dv] = o;
        __syncthreads();
        if (islat && half == 0) out[(size_t)row * D + h * 128 + dv] = f2bf(so[0][dv] + so[1][dv]);
    }
}

__global__ __launch_bounds__(256) void k_merge(bf16_t* y, const bf16_t* __restrict__ of, const bf16_t* __restrict__ ob, const bf16_t* __restrict__ og, const bf16_t* __restrict__ gm, const bf16_t* __restrict__ gh, const float* __restrict__ ghg) {
    int row = blockIdx.x, c = threadIdx.x * 4; size_t off = (size_t)row * D + c;
    ushort4 a = *(const ushort4*)(of + off), bb = *(const ushort4*)(ob + off), g1 = *(const ushort4*)(og + off), g2 = *(const ushort4*)(gm + off), g3 = *(const ushort4*)(gh + off), ym = *(const ushort4*)(y + off);
    const bf16_t *ap = (const bf16_t*)&a, *bp = (const bf16_t*)&bb, *p1 = (const bf16_t*)&g1, *p2 = (const bf16_t*)&g2, *p3 = (const bf16_t*)&g3, *pm = (const bf16_t*)&ym;
    float o[4], ss = 0.f; for (int i = 0; i < 4; ++i) { o[i] = bf2f(ap[i]) + bf2f(bp[i]); ss += o[i] * o[i]; }
    for (int m = 16; m > 0; m >>= 1) ss += __shfl_xor(ss, m);
    float rs = rsqrtf(ss * (1.0f / 128.0f) + EPS); float r[4];
    for (int i = 0; i < 4; ++i) { float yh = o[i] * rs * ghg[(c + i) & 127] * siluf_(bf2f(p1[i])); r[i] = sigmoidf_(bf2f(p2[i])) * bf2f(pm[i]) + sigmoidf_(bf2f(p3[i])) * yh; }
    st4bf(y + off, r);
}

__global__ __launch_bounds__(256) void k_norm2_router(const float* __restrict__ x1, const float* __restrict__ g, const float* __restrict__ modv, const float* __restrict__ wr, const float* __restrict__ br, bf16_t* h2, int* topi, float* topp, int* cnt, int* list) {
    __shared__ float red[4]; __shared__ float hs[1024]; __shared__ float part[8][32];
    int row = blockIdx.x, tid = threadIdx.x, c = tid * 4; const float* mod = modv + (row / SEQ) * 6144;
    float4 v = *(const float4*)(x1 + (size_t)row * D + c);
    float ss = block_sum256(v.x * v.x + v.y * v.y + v.z * v.z + v.w * v.w, red); float rs = rsqrtf(ss * (1.0f / D) + EPS);
    float xv[4] = {v.x, v.y, v.z, v.w}, o[4];
    for (int i = 0; i < 4; ++i) { o[i] = xv[i] * rs * g[c + i] * (1.0f + mod[4 * 1024 + c + i]) + mod[3 * 1024 + c + i]; hs[c + i] = o[i]; }
    st4bf(h2 + (size_t)row * D + c, o);
    __syncthreads();
    { int e = tid & 31, p = tid >> 5; float a = 0.f; for (int j = p * 128; j < p * 128 + 128; ++j) a += hs[j] * wr[j * 32 + e]; part[p][e] = a; }
    __syncthreads();
    if (tid < 64) {
        int e = tid & 31; float cur = br[e];
#pragma unroll
        for (int p = 0; p < 8; ++p) cur += part[p][e];
        float tv0 = 0.f, sum = 0.f; float myp = 0.f; int myk = -1;
        int sel_i[4]; float sel_e[4];
#pragma unroll
        for (int k = 0; k < 4; ++k) {
            float m = cur; int mi = e;
#pragma unroll
            for (int o = 16; o > 0; o >>= 1) { float om = __shfl_xor(m, o); int oi = __shfl_xor(mi, o); if (om > m || (om == m && oi < mi)) { m = om; mi = oi; } }
            if (k == 0) tv0 = m;
            sel_i[k] = mi; sel_e[k] = __expf(m - tv0); sum += sel_e[k];
            if (e == mi) cur = -3.0e38f;
        }
#pragma unroll
        for (int k = 0; k < 4; ++k) if (tid == k) { myk = sel_i[k]; myp = sel_e[k] / sum; }
        if (tid < 4) { int pair = row * 4 + tid; topi[pair] = myk; topp[pair] = myp; int pos = atomicAdd(&cnt[myk], 1); list[myk * CAP + pos] = pair; }
    }
}

__global__ void k_moe_offs(const int* cnt, int* offs, int* tilee) {
    if (threadIdx.x == 0 && blockIdx.x == 0) { int o = 0, t = 0; for (int e = 0; e < NE; ++e) { offs[e] = o; int nt = (cnt[e] + 255) >> 8; for (int i = 0; i < nt; ++i) tilee[t++] = e; o += nt * 256; } offs[NE] = o; offs[NE + 1] = t; }
}

__global__ __launch_bounds__(256) void k_final(float* out, const bf16_t* __restrict__ yp, const float* __restrict__ topp, const float* __restrict__ modv, const float* __restrict__ fg) {
    __shared__ float red[4];
    int row = blockIdx.x, c = threadIdx.x * 4; const float* gate = modv + (row / SEQ) * 6144 + 5 * 1024;
    float4 v = *(const float4*)(out + (size_t)row * D + c); float xv[4] = {v.x, v.y, v.z, v.w}; float m[4] = {0.f, 0.f, 0.f, 0.f};
    for (int k = 0; k < 4; ++k) { float p = topp[row * 4 + k]; ushort4 u = *(const ushort4*)(yp + (size_t)(row * 4 + k) * D + c); const bf16_t* up = (const bf16_t*)&u; for (int i = 0; i < 4; ++i) m[i] += p * bf2f(up[i]); }
    float ss = 0.f; for (int i = 0; i < 4; ++i) { xv[i] += gate[c + i] * m[i]; ss += xv[i] * xv[i]; }
    ss = block_sum256(ss, red); float rs = rsqrtf(ss * (1.0f / D) + EPS);
    float4 o; o.x = xv[0] * rs * fg[c]; o.y = xv[1] * rs * fg[c + 1]; o.z = xv[2] * rs * fg[c + 2]; o.w = xv[3] * rs * fg[c + 3];
    *(float4*)(out + (size_t)row * D + c) = o;
}

#define LAS __attribute__((address_space(3)))
__device__ __forceinline__ int otid() { int t = threadIdx.x; asm volatile("" : "+v"(t)); return t; }
typedef short bf16x8 __attribute__((ext_vector_type(8)));
typedef float f32x4 __attribute__((ext_vector_type(4)));
typedef unsigned u32x4 __attribute__((ext_vector_type(4)));
typedef unsigned u32x2 __attribute__((ext_vector_type(2)));
typedef float f32x2 __attribute__((ext_vector_type(2)));

constexpr size_t OFF_ROPE = 7 * MiB;
constexpr size_t OFF_WT_IN = 8 * MiB;
constexpr size_t OFF_WT_QB = 25 * MiB;
constexpr size_t OFF_WT_KVB = 28 * MiB;
constexpr size_t OFF_WT_OUT = 29 * MiB;
constexpr size_t OFF_WT_GU = 104 * MiB;
constexpr size_t OFF_WT_DN = 232 * MiB;
constexpr size_t OFF_X1 = 704 * MiB;

struct Params {
    const float *x, *c, *ctx, *cctx, *w_mod, *b_mod, *g_mix, *w_in, *g_q, *w_qb, *g_kv, *w_kvb, *lbl, *g_hg, *w_out, *g_ffn, *w_r, *b_r, *w_gu, *b_gu, *w_dn, *b_dn, *g_fin;
    float* out; char* ws;
};

typedef __bf16 bf16v2_t __attribute__((ext_vector_type(2)));
__device__ __forceinline__ unsigned cvt_pk_bf16(float lo, float hi) { bf16v2_t v = {(__bf16)lo, (__bf16)hi}; return __builtin_bit_cast(unsigned, v); }

__device__ __forceinline__ unsigned pack4_fp8(float a, float b, float c, float d) {
    a = __builtin_amdgcn_fmed3f(a, -448.f, 448.f); b = __builtin_amdgcn_fmed3f(b, -448.f, 448.f); c = __builtin_amdgcn_fmed3f(c, -448.f, 448.f); d = __builtin_amdgcn_fmed3f(d, -448.f, 448.f);
    unsigned w = 0; w = __builtin_amdgcn_cvt_pk_fp8_f32(a, b, w, false); w = __builtin_amdgcn_cvt_pk_fp8_f32(c, d, w, true); return w; }

namespace pg8 {
constexpr int BM = 256, BK = 64, HALF = 128, HTB = HALF * BK * 2, STAGE_BYTES = 8 * HTB, NXCD = 8, WGM = 8;
constexpr int LDS_IDX = STAGE_BYTES + 8192;
__device__ __forceinline__ int lds_byte(int r, int c) { const int st = (r >> 4) * 2 + (c >> 5), rr = r & 15, cc = c & 31, ob = rr * 64 + cc * 2; return st * 1024 + (ob ^ (((ob >> 9) & 1) << 5)); }
__device__ __forceinline__ void stage_rc(int b, int& R, int& C) { const int st = b / 1024, sb = b % 1024, swz = sb ^ (((sb >> 9) & 1) << 5); R = (st >> 1) * 16 + swz / 64; C = (st & 1) * 32 + (swz % 64) / 2; }
__device__ __forceinline__ int perm32(int rho) { const int n = rho >> 4, i = rho & 15; return 8 * (i >> 2) + 4 * n + (i & 3); }
struct Unit { int pm, pn; const char* b; int e, pos0, cnt; };

__device__ __forceinline__ int xcd_remap(int L, int nwg) { const int q = nwg / NXCD, r = nwg % NXCD, xcd = L % NXCD, off = L / NXCD; return (xcd < r ? xcd * (q + 1) : r * (q + 1) + (xcd - r) * q) + off; }

struct DenseSched {
    int nM, nN, nwg, G, c, rowb; const char* Bt; size_t btile;
    __device__ void init(int M, int N, int kbytes, int rowb_, const void* Bt_, int G_, int c_) { nM = M / BM; nN = N / BM; nwg = nM * nN; G = G_; c = c_; rowb = rowb_; Bt = (const char*)Bt_; btile = (size_t)BM * kbytes; }
    static constexpr bool GATHER_LDS = false;
    __device__ __forceinline__ int kstepA() const { return 128; }
    __device__ __forceinline__ void tile(int wgid, int& pm, int& pn) const { const int nig = WGM * nN, gid = wgid / nig, fm = gid * WGM, gsz = (nM - fm) < WGM ? (nM - fm) : WGM; pm = fm + ((wgid % nig) % gsz); pn = (wgid % nig) / gsz; }
    __device__ __forceinline__ bool next(int i, Unit& u) const { const int Lx = i * G + c; if (Lx >= nwg) return false; tile(xcd_remap(Lx, nwg), u.pm, u.pn); u.b = Bt + (size_t)u.pn * btile; u.e = 0; u.pos0 = 0; u.cnt = 0; return true; }
    __device__ __forceinline__ void aoff(const Unit& u, const int (&Rr)[2], const int (&Cc)[2], unsigned (&va)[2][2]) const {
#pragma unroll
        for (int h = 0; h < 2; ++h)
#pragma unroll
            for (int i = 0; i < 2; ++i) va[h][i] = (unsigned)((u.pm * BM + h * HALF + Rr[i]) * rowb + Cc[i] * 2); }
};
struct InSched : DenseSched {
    __device__ void init2(const void* Bt_, int G_, int c_) { init(L, 8448, 1024, 1024, Bt_, G_, c_); }
    __device__ __forceinline__ bool next(int i, Unit& u) const {
        const int Lx = i * G + c; const int nlat = nwg;
        if (Lx < nlat) { tile(xcd_remap(Lx, nlat), u.pm, u.pn); }
        else { const int j = Lx - nlat; if (j >= 16 * 14) return false; const int q = j >> 4; u.pm = 128 + (j & 15); u.pn = q == 0 ? 3 : (q <= 12 ? 7 + q : 32); }
        u.b = Bt + (size_t)u.pn * btile; u.e = 0; u.pos0 = 0; u.cnt = 0; return true; }
};
__device__ __forceinline__ unsigned act_piece_off(int r, int c16) { const int s = 2 * (r >> 7) + (c16 >> 2), w = 4 * ((r >> 6) & 1) + (c16 & 3), l = 16 * ((r >> 4) & 3) + (r & 15); return (unsigned)(((s * 8 + w) * 64 + l) * 16); }
template <bool GATHER> struct MoeSched {
    int nN, G, c, rowb; const char* Wt; size_t wexp, btile; const LAS int* tab; const int* list;
    static constexpr bool GATHER_LDS = GATHER;
    __device__ __forceinline__ int kstepA() const { return GATHER ? 128 : 32768; }
    __device__ __forceinline__ bool next(int i, Unit& u) const {
        const int nwg = tab[33] * nN; const int Lx = i * G + c; if (Lx >= nwg) return false;
        const int w = xcd_remap(Lx, nwg); const int rt = w / nN; u.pn = w % nN; u.pm = rt;
        const int e = tab[128 + rt];
        u.e = e; u.pos0 = (rt - tab[e]) * BM; u.cnt = tab[64 + e]; u.b = Wt + (size_t)e * wexp + (size_t)u.pn * btile; return true; }
    __device__ __forceinline__ void aoff(const Unit& u, const int (&Rr)[2], const int (&Cc)[2], unsigned (&va)[2][2]) const {
#pragma unroll
        for (int h = 0; h < 2; ++h)
#pragma unroll
            for (int i = 0; i < 2; ++i) {
                if (GATHER) { const int pos = u.pos0 + h * HALF + Rr[i]; const int pair = pos < u.cnt ? list[u.e * CAP + pos] : 0; va[h][i] = (unsigned)((pair >> 2) * rowb + Cc[i] * 2); }
                else va[h][i] = (unsigned)u.pm * 262144u + act_piece_off(h * HALF + Rr[i], Cc[i] >> 3); } }
};

typedef int v8i_t __attribute__((ext_vector_type(8)));
typedef int i32x4_t __attribute__((ext_vector_type(4)));
template <class Epi, class Sched, bool FP8 = false, int SCA = 127, int SCB = 127>
__device__ __forceinline__ void gemm_phase(LAS unsigned char* lds, const char* Abase, const int K, const Sched& S, const Epi& E) {
    const int tid = otid(), wid = __builtin_amdgcn_readfirstlane(tid >> 6), lane = tid & 63, wr = wid >> 2, wc = wid & 3, fr = lane & 15, fq = lane >> 4;
    const int Kb = FP8 ? K : 2 * K;
    const int nt = Kb / (BK * 2);
    int Rr[2], Cc[2]; unsigned voffB[2];
#pragma unroll
    for (int i = 0; i < 2; ++i) { int R_, C_; stage_rc(tid * 16 + i * 8192, R_, C_); Rr[i] = R_; Cc[i] = C_; const int Rb = 64 * (R_ >> 5) + (Epi::PERM ? perm32(R_ & 31) : (R_ & 31)); voffB[i] = (unsigned)(Rb * Kb + C_ * 2); }
    const size_t kstep = (size_t)(BK * 2);
    const size_t kstepA = (size_t)S.kstepA();
    const size_t hstep = (size_t)32 * Kb;
    const unsigned ldsw = (unsigned)wid * 1024u;
    const int aoff = lds_byte(wr * 64 + fr, fq * 8), boff = lds_byte(wc * 32 + fr, fq * 8);
#define PG8_SA(b, h) (((b) * 2 + (h)) * HTB)
#define PG8_SB(b, h) ((4 + (b) * 2 + (h)) * HTB)
#define PG8_STAGE_B(bufoff, gbase) do { _Pragma("unroll") for (int _i = 0; _i < 2; ++_i) \
        __builtin_amdgcn_global_load_lds((const unsigned*)((const char*)(gbase) + voffB[_i]), (LAS unsigned*)(lds + (bufoff) + ldsw + _i * 8192), 16, 0, 0); } while (0)
#define PG8_STAGE_A(bufoff, v0, v1, kb) do { \
        __builtin_amdgcn_global_load_lds((const unsigned*)(Abase + (kb) + (v0)), (LAS unsigned*)(lds + (bufoff) + ldsw), 16, 0, 0); \
        __builtin_amdgcn_global_load_lds((const unsigned*)(Abase + (kb) + (v1)), (LAS unsigned*)(lds + (bufoff) + ldsw + 8192), 16, 0, 0); } while (0)
#define PG8_LD16(addr) (*(const LAS i32x4_t*)(addr))
#define PG8_LDA(dst, b, h) do { _Pragma("unroll") for (int m = 0; m < 4; ++m) { if constexpr (FP8) dst##8[m] = __builtin_shufflevector(PG8_LD16(lds + PG8_SA(b, h) + aoff + m * 2048), PG8_LD16(lds + PG8_SA(b, h) + aoff + m * 2048 + 1024), 0, 1, 2, 3, 4, 5, 6, 7); \
        else { _Pragma("unroll") for (int k = 0; k < 2; ++k) dst[m][k] = *(const LAS bf16x8*)(lds + PG8_SA(b, h) + aoff + m * 2048 + k * 1024); } } } while (0)
#define PG8_LDB(dst, b, h) do { _Pragma("unroll") for (int n = 0; n < 2; ++n) { if constexpr (FP8) dst##8[n] = __builtin_shufflevector(PG8_LD16(lds + PG8_SB(b, h) + boff + n * 2048), PG8_LD16(lds + PG8_SB(b, h) + boff + n * 2048 + 1024), 0, 1, 2, 3, 4, 5, 6, 7); \
        else { _Pragma("unroll") for (int k = 0; k < 2; ++k) dst[n][k] = *(const LAS bf16x8*)(lds + PG8_SB(b, h) + boff + n * 2048 + k * 1024); } } } while (0)
#define PG8_MMA(ai, bj, At, Bt) do { __builtin_amdgcn_s_setprio(1); _Pragma("unroll") for (int m = 0; m < 4; ++m) _Pragma("unroll") for (int n = 0; n < 2; ++n) { \
        if constexpr (FP8) asm volatile("v_mfma_scale_f32_16x16x128_f8f6f4 %0, %1, %2, %0, %3, %4 op_sel_hi:[0,0,0]" : "+v"(acc[ai][bj][m][n]) : "v"(Bt##8[n]), "v"(At##8[m]), "v"(scb_), "v"(sca_)); \
        else { _Pragma("unroll") for (int k = 0; k < 2; ++k) acc[ai][bj][m][n] = __builtin_amdgcn_mfma_f32_16x16x32_bf16(Bt[n][k], At[m][k], acc[ai][bj][m][n], 0, 0, 0); } } \
        __builtin_amdgcn_s_setprio(0); } while (0)
#define PG8_WAIT_V(n) asm volatile("s_waitcnt vmcnt(" #n ")" ::: "memory")
#define PG8_WAIT_L(n) asm volatile("s_waitcnt lgkmcnt(" #n ")" ::: "memory")
#define PG8_BAR __builtin_amdgcn_s_barrier()
#define PG8_SCHED __builtin_amdgcn_sched_barrier(0)
    Unit cur, nxt; int ui = 0;
    if (!S.next(0, cur)) return;
    f32x4 acc[2][2][4][2];
#pragma unroll
    for (int a = 0; a < 2; ++a)
#pragma unroll
        for (int b = 0; b < 2; ++b)
#pragma unroll
            for (int m = 0; m < 4; ++m)
#pragma unroll
                for (int n = 0; n < 2; ++n) acc[a][b][m][n] = (f32x4){0.f, 0.f, 0.f, 0.f};
    const int sca_ = SCA, scb_ = SCB;
    bf16x8 At[4][2], B0[2][2], B1[2][2]; v8i_t At8[4], B08[2], B18[2];
    unsigned vc[2][2], vn[2][2];
    S.aoff(cur, Rr, Cc, vc);
    const char* cB = cur.b;
    PG8_STAGE_B(PG8_SB(0, 0), cB); PG8_STAGE_A(PG8_SA(0, 0), vc[0][0], vc[0][1], 0); PG8_STAGE_B(PG8_SB(0, 1), cB + hstep); PG8_STAGE_A(PG8_SA(0, 1), vc[1][0], vc[1][1], 0);
    if (wr == 1) PG8_BAR;
    PG8_WAIT_V(4); PG8_BAR;
    PG8_STAGE_B(PG8_SB(1, 0), cB + kstep); PG8_STAGE_A(PG8_SA(1, 0), vc[0][0], vc[0][1], kstepA); PG8_STAGE_B(PG8_SB(1, 1), cB + hstep + kstep);
    PG8_WAIT_V(6); PG8_BAR;
    for (;;) {
        const bool has_next = S.next(ui + 1, nxt);
        if constexpr (Sched::GATHER_LDS) {
            if (has_next && wid < 4) __builtin_amdgcn_global_load_lds((const unsigned*)(S.list + nxt.e * CAP + nxt.pos0 + tid), (LAS unsigned*)(lds + LDS_IDX + wid * 256), 4, 0, 0);
        } else if (has_next) S.aoff(nxt, Rr, Cc, vn);
        if (!has_next) {
#pragma unroll
            for (int h = 0; h < 2; ++h)
#pragma unroll
                for (int i = 0; i < 2; ++i) vn[h][i] = vc[h][i]; }
        const char* nB = has_next ? nxt.b : cB;
#pragma unroll 1
        for (int t = 0; t < nt; t += 2) {
            const bool last = (t == nt - 2);
            if constexpr (Sched::GATHER_LDS) { if (last && has_next) {
#pragma unroll
                for (int h = 0; h < 2; ++h)
#pragma unroll
                    for (int i = 0; i < 2; ++i) { const int rr = h * HALF + Rr[i]; const int pair = (nxt.pos0 + rr) < nxt.cnt ? ((const LAS int*)(lds + LDS_IDX))[rr] : 0; vn[h][i] = (unsigned)((pair >> 2) * S.rowb + Cc[i] * 2); } } }
            const size_t k1 = (size_t)(t + 1) * kstepA;
            const size_t k2 = last ? 0 : (size_t)(t + 2) * kstepA;
            const unsigned s00 = last ? vn[0][0] : vc[0][0], s01 = last ? vn[0][1] : vc[0][1], s10 = last ? vn[1][0] : vc[1][0], s11 = last ? vn[1][1] : vc[1][1];
            const char* b2 = last ? nB : cB + (size_t)(t + 2) * kstep; const char* b3 = b2 + kstep;
            PG8_LDB(B0, 0, 0); PG8_SCHED; PG8_LDA(At, 0, 0); PG8_STAGE_A(PG8_SA(1, 1), vc[1][0], vc[1][1], k1);
            PG8_WAIT_L(8); PG8_BAR; PG8_WAIT_L(0); PG8_MMA(0, 0, At, B0); PG8_BAR; PG8_SCHED;
            PG8_LDB(B1, 0, 1); PG8_STAGE_B(PG8_SB(0, 0), b2);
            PG8_BAR; PG8_WAIT_L(0); PG8_MMA(0, 1, At, B1); PG8_BAR; if constexpr (FP8) PG8_SCHED;
            PG8_LDA(At, 0, 1); PG8_STAGE_A(PG8_SA(0, 0), s00, s01, k2);
            PG8_BAR; PG8_WAIT_L(0); PG8_MMA(1, 0, At, B0); PG8_BAR; PG8_SCHED;
            PG8_STAGE_B(PG8_SB(0, 1), b2 + hstep);
            PG8_WAIT_V(6); PG8_BAR; PG8_MMA(1, 1, At, B1); PG8_BAR; if constexpr (FP8) PG8_SCHED;
            PG8_LDB(B0, 1, 0); PG8_SCHED; PG8_LDA(At, 1, 0); PG8_STAGE_A(PG8_SA(0, 1), s10, s11, k2);
            PG8_WAIT_L(8); PG8_BAR; PG8_WAIT_L(0); PG8_MMA(0, 0, At, B0); PG8_BAR; PG8_SCHED;
            PG8_LDB(B1, 1, 1); PG8_STAGE_B(PG8_SB(1, 0), b3);
            PG8_BAR; PG8_WAIT_L(0); PG8_MMA(0, 1, At, B1); PG8_BAR; if constexpr (FP8) PG8_SCHED;
            PG8_LDA(At, 1, 1); PG8_STAGE_A(PG8_SA(1, 0), s00, s01, k2 + kstepA);
            PG8_BAR; PG8_WAIT_L(0); PG8_MMA(1, 0, At, B0); PG8_BAR; PG8_SCHED;
            PG8_STAGE_B(PG8_SB(1, 1), b3 + hstep);
            PG8_WAIT_V(6); PG8_BAR; PG8_MMA(1, 1, At, B1); PG8_BAR; if constexpr (FP8) PG8_SCHED;
        }
        if constexpr (FP8) asm volatile("s_nop 15\n\ts_nop 15" ::: "memory");
        E(acc, cur, wr, wc, fr, fq);
        if (!has_next) break;
#pragma unroll
        for (int a = 0; a < 2; ++a)
#pragma unroll
            for (int b = 0; b < 2; ++b)
#pragma unroll
                for (int m = 0; m < 4; ++m)
#pragma unroll
                    for (int n = 0; n < 2; ++n) acc[a][b][m][n] = (f32x4){0.f, 0.f, 0.f, 0.f};
        cur = nxt; cB = nB; ++ui;
#pragma unroll
        for (int h = 0; h < 2; ++h)
#pragma unroll
            for (int i = 0; i < 2; ++i) vc[h][i] = vn[h][i];
    }
    PG8_WAIT_V(0);
    if (wr == 0) PG8_BAR;
    PG8_BAR;
#undef PG8_SA
#undef PG8_SB
#undef PG8_STAGE_A
#undef PG8_STAGE_B
#undef PG8_LDA
#undef PG8_LDB
#undef PG8_MMA
#undef PG8_WAIT_V
#undef PG8_WAIT_L
#undef PG8_BAR
#undef PG8_SCHED
}

typedef f32x4 Acc[2][2][4][2];
__device__ __forceinline__ unsigned dpp_ror8(unsigned x) { return (unsigned)__builtin_amdgcn_update_dpp(0, (int)x, 0x128, 0xf, 0xf, false); }
__device__ __forceinline__ u32x4 ror8_4(const u32x4 v) { u32x4 r; r.x = dpp_ror8(v.x); r.y = dpp_ror8(v.y); r.z = dpp_ror8(v.z); r.w = dpp_ror8(v.w); return r; }
__device__ __forceinline__ void line_xy(const u32x4 a, const u32x4 b, bool lo, u32x4& X, u32x4& Y) { const u32x4 ra = ror8_4(a), rb = ror8_4(b); X = lo ? a : rb; Y = lo ? ra : b; }
__device__ __forceinline__ u32x4 pack8(const f32x4 v0, const f32x4 v1) { u32x4 w; w.x = cvt_pk_bf16(v0[0], v0[1]); w.y = cvt_pk_bf16(v0[2], v0[3]); w.z = cvt_pk_bf16(v1[0], v1[1]); w.w = cvt_pk_bf16(v1[2], v1[3]); return w; }

struct EpiIn { static constexpr bool PERM = true; char* ws;
    __device__ __forceinline__ void operator()(const Acc& acc, const Unit& u, int wr, int wc, int fr, int fq) const {
        const int pn = u.pn; size_t boff; int ld, cb;
        if (pn < 3) { boff = OFF_QA; ld = 768; cb = pn * 256; } else if (pn == 3) { boff = OFF_CKV; ld = 256; cb = 0; }
        else if (pn < 32) { boff = OFF_HQ + (size_t)((pn - 4) >> 2) * SEG_STRIDE; ld = 1024; cb = ((pn - 4) & 3) * 256; }
        else { boff = OFF_KR; ld = 64; cb = 0; }
        bf16_t* base = (bf16_t*)(ws + boff);
        if (pn == 32 && wc != 0) return;
        const bool lo = fr < 8; const int rowb0 = u.pm * BM + wr * 64, rx = fr & 7, colx = cb + wc * 64 + (fr >> 3) * 32 + 8 * fq;
        float* ssq = (float*)(ws + (pn < 3 ? OFF_SSQQ : OFF_SSQKV));
#pragma unroll
        for (int ai = 0; ai < 2; ++ai)
#pragma unroll
            for (int m = 0; m < 4; ++m) { const int rg = rowb0 + ai * HALF + m * 16;
                f32x4 v0 = acc[ai][0][m][0], v1 = acc[ai][0][m][1], w0 = acc[ai][1][m][0], w1 = acc[ai][1][m][1];
                if (pn >= 4 && pn < 8) {
#pragma unroll
                    for (int j = 0; j < 4; ++j) { v0[j] = siluf_(v0[j]) * 0.08838834764831845f; v1[j] = siluf_(v1[j]) * 0.08838834764831845f; w0[j] = siluf_(w0[j]) * 0.08838834764831845f; w1[j] = siluf_(w1[j]) * 0.08838834764831845f; } }
                u32x4 X, Y; line_xy(pack8(v0, v1), pack8(w0, w1), lo, X, Y);
                *(u32x4*)(base + (size_t)(rg + rx) * ld + colx) = X; *(u32x4*)(base + (size_t)(rg + 8 + rx) * ld + colx) = Y;
                if (pn <= 3) { float ss = (v0[0] * v0[0] + v0[1] * v0[1]) + (v0[2] * v0[2] + v0[3] * v0[3]) + (v1[0] * v1[0] + v1[1] * v1[1]) + (v1[2] * v1[2] + v1[3] * v1[3])
                                        + (w0[0] * w0[0] + w0[1] * w0[1]) + (w0[2] * w0[2] + w0[3] * w0[3]) + (w1[0] * w1[0] + w1[1] * w1[1]) + (w1[2] * w1[2] + w1[3] * w1[3]);
                    ss += __shfl_xor(ss, 16); ss += __shfl_xor(ss, 32); if (fq == 0) atomicAdd(ssq + rg + fr, ss); } }
    } };

struct EpiQ { static constexpr bool PERM = true; bf16_t* q; const float* ssq;
    __device__ __forceinline__ void operator()(const Acc& acc, const Unit& u, int wr, int wc, int fr, int fq) const {
        const bool lo = fr < 8; const int rowb0 = u.pm * BM + wr * 64, rx = fr & 7, colx = u.pn * BM + wc * 64 + (fr >> 3) * 32 + 8 * fq;
#pragma unroll
        for (int ai = 0; ai < 2; ++ai)
#pragma unroll
            for (int m = 0; m < 4; ++m) { const int rg = rowb0 + ai * HALF + m * 16; const float rs = rsqrtf(ssq[rg + fr] * (1.0f / 768.0f) + EPS);
                u32x4 X, Y; line_xy(pack8(acc[ai][0][m][0] * rs, acc[ai][0][m][1] * rs), pack8(acc[ai][1][m][0] * rs, acc[ai][1][m][1] * rs), lo, X, Y);
                *(u32x4*)(q + (size_t)(rg + rx) * 1536 + colx) = X; *(u32x4*)(q + (size_t)(rg + 8 + rx) * 1536 + colx) = Y; }
    } };

struct EpiKV { static constexpr bool PERM = true; bf16_t *Kb, *Vb; const float* ssq;
    __device__ __forceinline__ size_t kvrow(int row, int h) const { int b, pos; if (row < L) { b = row >> 11; pos = row & 2047; } else { b = (row - L) >> 8; pos = SEQ + ((row - L) & 255); } return (size_t)(b * 8 + h) * NKEY + pos; }
    __device__ __forceinline__ void operator()(const Acc& acc, const Unit& u, int wr, int wc, int fr, int fq) const {
        const bool lo = fr < 8; const int rowb0 = u.pm * BM + wr * 64, rx = fr & 7, colx = (wc & 1) * 64 + (fr >> 3) * 32 + 8 * fq;
        bf16_t* dst = wc < 2 ? Kb : Vb; const int ld = wc < 2 ? 192 : 128;
#pragma unroll
        for (int ai = 0; ai < 2; ++ai)
#pragma unroll
            for (int m = 0; m < 4; ++m) { const int rg = rowb0 + ai * HALF + m * 16; const float rs = rsqrtf(ssq[rg + fr] * (1.0f / 256.0f) + EPS);
                u32x4 X, Y; line_xy(pack8(acc[ai][0][m][0] * rs, acc[ai][0][m][1] * rs), pack8(acc[ai][1][m][0] * rs, acc[ai][1][m][1] * rs), lo, X, Y);
                *(u32x4*)(dst + kvrow(rg + rx, u.pn) * ld + colx) = X; *(u32x4*)(dst + kvrow(rg + 8 + rx, u.pn) * ld + colx) = Y; }
    } };

struct EpiOut { static constexpr bool PERM = true; bf16_t* x1; const float* x; const float* modv;
    __device__ __forceinline__ void operator()(const Acc& acc, const Unit& u, int wr, int wc, int fr, int fq) const {
        const bool lo = fr < 8; const int rowb0 = u.pm * BM + wr * 64, rx = fr & 7, colx = u.pn * BM + wc * 64 + (fr >> 3) * 32 + 8 * fq, cown = u.pn * BM + wc * 64 + 8 * fq;
#pragma unroll
        for (int ai = 0; ai < 2; ++ai)
#pragma unroll
            for (int m = 0; m < 4; ++m) { const int rg = rowb0 + ai * HALF + m * 16, row = rg + fr; const float* gate = modv + (row >> 11) * 6144 + 2 * 1024 + cown; const float* xr = x + (size_t)row * D + cown;
                f32x4 r[2][2];
#pragma unroll
                for (int bj = 0; bj < 2; ++bj)
#pragma unroll
                    for (int n = 0; n < 2; ++n) r[bj][n] = *(const f32x4*)(xr + bj * 32 + 4 * n) + *(const f32x4*)(gate + bj * 32 + 4 * n) * acc[ai][bj][m][n];
                u32x4 X, Y; line_xy(pack8(r[0][0], r[0][1]), pack8(r[1][0], r[1][1]), lo, X, Y);
                *(u32x4*)(x1 + (size_t)(rg + rx) * D + colx) = X; *(u32x4*)(x1 + (size_t)(rg + 8 + rx) * D + colx) = Y; }
    } };

struct EpiMoe1 { static constexpr bool PERM = true; unsigned char* act; const float* bgu;
    __device__ __forceinline__ void operator()(const Acc& acc, const Unit& u, int wr, int wc, int fr, int fq) const {
        const int o0 = u.pn * 128 + wc * 16 + 4 * fq;
        f32x4 bg[2], bl[2];
#pragma unroll
        for (int bj = 0; bj < 2; ++bj) { const float* bp = bgu + u.e * 2048 + 2 * (o0 + bj * 64); const f32x4 t0 = *(const f32x4*)bp, t1 = *(const f32x4*)(bp + 4);
            bg[bj] = (f32x4){t0[0], t0[2], t1[0], t1[2]}; bl[bj] = (f32x4){t0[1], t0[3], t1[1], t1[3]}; }
        unsigned char* blk = act + ((size_t)u.pm * 8 + u.pn) * 32768 + (size_t)(wr * 4 + wc) * 1024 + (size_t)(fq * 16 + fr) * 16;
#pragma unroll
        for (int ai = 0; ai < 2; ++ai)
#pragma unroll
            for (int bj = 0; bj < 2; ++bj) { unsigned d[4];
#pragma unroll
                for (int m = 0; m < 4; ++m) { const f32x4 g4 = acc[ai][bj][m][0] + bg[bj], l4 = acc[ai][bj][m][1] + bl[bj]; float r[4];
#pragma unroll
                    for (int j = 0; j < 4; ++j) { const float glu = fminf(g4[j], 7.0f), lin = __builtin_amdgcn_fmed3f(l4[j], -7.0f, 7.0f); r[j] = 4.0f * glu * __builtin_amdgcn_rcpf(1.0f + __builtin_amdgcn_exp2f(-2.4554669595930157f * glu)) * (lin + 1.0f); }
                    d[m] = pack4_fp8(r[0], r[1], r[2], r[3]); }
                const auto s01 = __builtin_amdgcn_permlane16_swap(d[0], d[1], false, false); const auto s23 = __builtin_amdgcn_permlane16_swap(d[2], d[3], false, false);
                const auto t02 = __builtin_amdgcn_permlane32_swap(s01[0], s23[0], false, false); const auto t13 = __builtin_amdgcn_permlane32_swap(s01[1], s23[1], false, false);
                *(u32x4*)(blk + (size_t)(ai * 2 + bj) * 8192) = (u32x4){t02[0], t13[0], t02[1], t13[1]}; }
    } };

struct EpiMoe2 { static constexpr bool PERM = true; bf16_t* yp; const float* bd;
    __device__ __forceinline__ void operator()(const Acc& acc, const Unit& u, int wr, int wc, int fr, int fq) const {
        const bool lo = fr < 8; const int rowb0 = u.pm * BM + wr * 64, rx = fr & 7, colx = u.pn * BM + wc * 64 + (fr >> 3) * 32 + 8 * fq, cown = u.pn * BM + wc * 64 + 8 * fq;
        f32x4 bv[2][2];
#pragma unroll
        for (int bj = 0; bj < 2; ++bj)
#pragma unroll
            for (int n = 0; n < 2; ++n) bv[bj][n] = *(const f32x4*)(bd + u.e * 1024 + cown + bj * 32 + 4 * n);
#pragma unroll
        for (int ai = 0; ai < 2; ++ai)
#pragma unroll
            for (int m = 0; m < 4; ++m) { const int rg = rowb0 + ai * HALF + m * 16;
                u32x4 X, Y; line_xy(pack8(acc[ai][0][m][0] + bv[0][0], acc[ai][0][m][1] + bv[0][1]), pack8(acc[ai][1][m][0] + bv[1][0], acc[ai][1][m][1] + bv[1][1]), lo, X, Y);
                *(u32x4*)(yp + (size_t)(rg + rx) * D + colx) = X; *(u32x4*)(yp + (size_t)(rg + 8 + rx) * D + colx) = Y; }
    } };
}

__device__ __forceinline__ int conv_src_col(int kind, int c) {
    if (kind == 0) return c;
    if (kind == 1) { if (c < 1024) return c; if (c < 8192) return c + 64; if (c < 8256) return c - 8192 + 1024; return -1; }
    const int pn = c >> 8, p = c & 255, wc = p >> 6, bj = (p >> 5) & 1, fq = (p >> 3) & 3, n = (p >> 2) & 1, i = p & 3; const int o = 128 * pn + 64 * bj + 16 * wc + 4 * fq + i; return 2 * o + n;
}
template <bool F8> struct ConvPipe {
    float v[32]; bool have; bf16_t* dummy;
    int K, kind, k0, c0; void* Wt;
    __device__ __forceinline__ void issue(const float* __restrict__ W, int ldw, void* Wt_, int K_, int kind_, const float* __restrict__ kscale, int k0_, int c0_) {
        const int tid = otid(); const int cc = tid & 127, kq = tid >> 7, sc = conv_src_col(kind_, c0_ + cc);
#pragma unroll
        for (int i = 0; i < 32; ++i) { const int kk = kq + 4 * i; v[i] = sc >= 0 ? W[(size_t)(k0_ + kk) * ldw + sc] : 0.f; }
        if (kscale) {
#pragma unroll
            for (int i = 0; i < 32; ++i) v[i] *= kscale[k0_ + kq + 4 * i]; }
        K = K_; kind = kind_; k0 = k0_; c0 = c0_; Wt = Wt_; have = true;
    }
    __device__ __forceinline__ void flush(LAS float* tl) {
        if (!have) return; have = false;
        const int tid = otid(); const int cc = tid & 127, kq = tid >> 7;
        __syncthreads();
#pragma unroll
        for (int i = 0; i < 32; ++i) tl[(kq + 4 * i) * 129 + cc] = v[i];
        __syncthreads();
        stash(tl, tid);
    }
    __device__ __forceinline__ void to_lds(LAS float* tl) { const int tid = otid(); const int cc = tid & 127, kq = tid >> 7; __syncthreads();
#pragma unroll
        for (int i = 0; i < 32; ++i) tl[(kq + 4 * i) * 129 + cc] = v[i];
        __syncthreads(); }
    __device__ __forceinline__ void stash(LAS float* tl, int tid) const {
        const int c2 = tid >> 2, kb = (tid & 3) * 8;
#pragma unroll
        for (int q = 0; q < 4; ++q) { float t[8];
#pragma unroll
            for (int j = 0; j < 8; ++j) t[j] = tl[(q * 32 + kb + j) * 129 + c2];
            if constexpr (F8) { unsigned char* dst = (unsigned char*)Wt + (size_t)(c0 + c2) * K + k0 + kb + q * 32;
                u32x2 w; w.x = pack4_fp8(t[0] * 32.f, t[1] * 32.f, t[2] * 32.f, t[3] * 32.f); w.y = pack4_fp8(t[4] * 32.f, t[5] * 32.f, t[6] * 32.f, t[7] * 32.f); *(u32x2*)dst = w; }
            else { bf16_t* dst = (bf16_t*)Wt + (size_t)(c0 + c2) * K + k0 + kb + q * 32;
                u32x4 w; w.x = cvt_pk_bf16(t[0], t[1]); w.y = cvt_pk_bf16(t[2], t[3]); w.z = cvt_pk_bf16(t[4], t[5]); w.w = cvt_pk_bf16(t[6], t[7]); *(u32x4*)dst = w; } }
    }
};
template <bool F8>
__device__ __forceinline__ void conv_matrix(LAS float* tl, ConvPipe<F8>& pipe, const float* W, int ldw, void* Wt, int K, int Nout, int kind, const float* kscale, int& tctr) {
    const int nk = K / 128, ntile = nk * (Nout / 128);
    int t = ((int)blockIdx.x - tctr) % (int)gridDim.x; if (t < 0) t += gridDim.x;
    for (; t < ntile; t += gridDim.x) {
        if (pipe.have) { pipe.to_lds(tl); const int K0 = pipe.K, k00 = pipe.k0, c00 = pipe.c0; void* W0 = pipe.Wt; ConvPipe<F8> done = pipe; (void)K0; (void)k00; (void)c00; (void)W0;
            pipe.issue(W, ldw, Wt, K, kind, kscale, (t % nk) * 128, (t / nk) * 128); done.stash(tl, otid()); }
        else pipe.issue(W, ldw, Wt, K, kind, kscale, (t % nk) * 128, (t / nk) * 128);
    }
    tctr = (tctr + ntile) % (int)gridDim.x;
}
template <bool F8> __device__ __forceinline__ void conv_finish(LAS float* tl, ConvPipe<F8>& pipe) { if (pipe.have) { pipe.to_lds(tl); pipe.stash(tl, otid()); pipe.have = false; } __syncthreads(); }

__device__ __forceinline__ float half_sum256(float v, LAS float* red) {
    for (int o = 32; o > 0; o >>= 1) v += __shfl_xor(v, o);
    const int w = otid() >> 6, hb = (otid() >> 8) * 4; if ((otid() & 63) == 0) red[w] = v; __syncthreads();
    const float t = red[hb] + red[hb + 1] + red[hb + 2] + red[hb + 3]; __syncthreads(); return t;
}

__device__ __forceinline__ void phase0(const Params& p, LAS unsigned char* lds) {
    char* ws = p.ws; const int tid = otid(), gsz = gridDim.x * 512, gid = blockIdx.x * 512 + tid;
    float* lb = (float*)(ws + OFF_LB); int* cnt = (int*)(ws + OFF_CNT); float* ssqq = (float*)(ws + OFF_SSQQ); float* ssqkv = (float*)(ws + OFF_SSQKV); float* modv = (float*)(ws + OFF_MOD);
    for (int i = gid; i < 2048; i += gsz) { const int d = i >> 10, j = i & 1023; const float a = p.lbl[(d * 2 + 0) * 1024 + j], b = p.lbl[(d * 2 + 1) * 1024 + j]; lb[i] = 1.0f / (1.0f + __expf(b - a)); }
    for (int i = gid; i < 32; i += gsz) cnt[i] = 0;
    { float* ropet = (float*)(ws + OFF_ROPE); for (int i = gid; i < SEQ * 32; i += gsz) { const int t = i >> 5, j = i & 31; float cs, sn; rope_cs(t, j, cs, sn); ropet[t * 64 + j] = cs; ropet[t * 64 + 32 + j] = sn; } }
    for (int i = gid; i < L; i += gsz) ssqq[i] = 0.f;
    for (int i = gid; i < R; i += gsz) ssqkv[i] = 0.f;
    { LAS float* sil = (LAS float*)lds;
      LAS float* part = (LAS float*)(lds + 17 * 1024 * 4);
      bool loaded = false;
      for (int item = blockIdx.x; item < 96; item += gridDim.x) {
          if (!loaded) { for (int i = tid; i < 17 * 1024; i += 512) { const int r = i >> 10, k = i & 1023; sil[i] = siluf_(r < 16 ? p.c[r * 1024 + k] : p.cctx[k]); } loaded = true; __syncthreads(); }
          const int j = tid & 63, ks = tid >> 6; float a[17];
#pragma unroll
          for (int r = 0; r < 17; ++r) a[r] = 0.f;
          for (int k = ks * 128; k < ks * 128 + 128; ++k) { const float w = p.w_mod[(size_t)k * 6144 + item * 64 + j];
#pragma unroll
              for (int r = 0; r < 17; ++r) a[r] += sil[r * 1024 + k] * w; }
#pragma unroll
          for (int r = 0; r < 17; ++r) part[(ks * 17 + r) * 64 + j] = a[r];
          __syncthreads();
          for (int i = tid; i < 17 * 64; i += 512) { const int r = i >> 6, jj = i & 63; float s = p.b_mod[item * 64 + jj]; for (int q = 0; q < 8; ++q) s += part[(q * 17 + r) * 64 + jj]; modv[r * 6144 + item * 64 + jj] = s; }
          __syncthreads();
      } }
    __syncthreads();
    { LAS float* tl = (LAS float*)lds; int tctr = 0;
      { ConvPipe<true> pp; pp.have = false; conv_matrix<true>(tl, pp, p.w_in, 8256, (unsigned char*)(ws + OFF_WT_IN), 1024, 8448, 1, nullptr, tctr); conv_finish<true>(tl, pp); }
      { ConvPipe<false> pp; pp.have = false;
        conv_matrix<false>(tl, pp, p.w_qb, 1536, (bf16_t*)(ws + OFF_WT_QB), 768, 1536, 0, p.g_q, tctr);
        conv_matrix<false>(tl, pp, p.w_kvb, 2048, (bf16_t*)(ws + OFF_WT_KVB), 256, 2048, 0, p.g_kv, tctr);
        conv_matrix<false>(tl, pp, p.w_out, 1024, (bf16_t*)(ws + OFF_WT_OUT), 1024, 1024, 0, nullptr, tctr); conv_finish<false>(tl, pp); } }
}

__device__ __forceinline__ float wave_sum(float v) {
#pragma unroll
    for (int o = 32; o > 0; o >>= 1) v += __shfl_xor(v, o);
    return v; }
__device__ __forceinline__ void phase1(const Params& p, LAS unsigned char* lds) {
    const float* modv = (const float*)(p.ws + OFF_MOD); unsigned char* h = (unsigned char*)(p.ws + OFF_H);
    const int tid = otid(), lane = tid & 63, gw = blockIdx.x * 8 + (tid >> 6), nw = gridDim.x * 8, c0 = lane * 8;
    f32x4 g[4];
#pragma unroll
    for (int q = 0; q < 4; ++q) g[q] = *(const f32x4*)(p.g_mix + (q >> 1) * 512 + c0 + (q & 1) * 4);
    for (int row0 = gw; row0 < R; row0 += 2 * nw) {
        f32x4 v[2][4]; const bool two = row0 + nw < R;
#pragma unroll
        for (int u = 0; u < 2; ++u) { const int row = (u == 0 || two) ? row0 + u * nw : row0; const float* src = row < L ? p.x + (size_t)row * D : p.ctx + (size_t)(row - L) * D;
#pragma unroll
            for (int q = 0; q < 4; ++q) v[u][q] = *(const f32x4*)(src + (q >> 1) * 512 + c0 + (q & 1) * 4); }
#pragma unroll
        for (int u = 0; u < 2; ++u) { if (u == 1 && !two) break; const int row = row0 + u * nw; const float* mod = modv + (row < L ? row / SEQ : 16) * 6144;
            float ss = 0.f;
#pragma unroll
            for (int q = 0; q < 4; ++q) ss += (v[u][q][0] * v[u][q][0] + v[u][q][1] * v[u][q][1]) + (v[u][q][2] * v[u][q][2] + v[u][q][3] * v[u][q][3]);
            const float rs = rsqrtf(wave_sum(ss) * (1.0f / D) + EPS);
#pragma unroll
            for (int j = 0; j < 2; ++j) { f32x4 o[2];
#pragma unroll
                for (int e = 0; e < 2; ++e) { const int cc = j * 512 + c0 + e * 4; const f32x4 sc = *(const f32x4*)(mod + 1024 + cc), sh = *(const f32x4*)(mod + cc); o[e] = v[u][j * 2 + e] * rs * g[j * 2 + e] * (sc + 1.0f) + sh; }
                u32x2 w; w.x = pack4_fp8(o[0][0], o[0][1], o[0][2], o[0][3]); w.y = pack4_fp8(o[1][0], o[1][1], o[1][2], o[1][3]);
                *(u32x2*)(h + (size_t)row * D + j * 512 + c0) = w; } }
    }
}

__device__ __forceinline__ SegOut make_seg(char* ws) { SegOut so; so.qa = (bf16_t*)(ws + OFF_QA); so.ckv = (bf16_t*)(ws + OFF_CKV); so.kr = (bf16_t*)(ws + OFF_KR); so.hq = (bf16_t*)(ws + OFF_HQ); so.ff = (bf16_t*)(ws + OFF_FF);
    so.fb = (bf16_t*)(ws + OFF_FB); so.iv = (bf16_t*)(ws + OFF_IV); so.og = (bf16_t*)(ws + OFF_OG); so.gm = (bf16_t*)(ws + OFF_GM); so.gh = (bf16_t*)(ws + OFF_GH); return so; }

__device__ __forceinline__ void phase2(const Params& p, LAS unsigned char* lds) {
    pg8::InSched S; S.init2(p.ws + OFF_WT_IN, gridDim.x, blockIdx.x);
    pg8::EpiIn E{p.ws};
    pg8::gemm_phase<pg8::EpiIn, pg8::InSched, true, 127, 122>(lds, (const char*)(p.ws + OFF_H), 1024, S, E);
}
__device__ __forceinline__ void phase3(const Params& p, LAS unsigned char* lds) {
    char* ws = p.ws;
    { pg8::DenseSched S; S.init(L, 1536, 768 * 2, 768 * 2, ws + OFF_WT_QB, gridDim.x, blockIdx.x); pg8::EpiQ E{(bf16_t*)(ws + OFF_Q), (const float*)(ws + OFF_SSQQ)}; pg8::gemm_phase(lds, (const char*)(ws + OFF_QA), 768, S, E); }
    { pg8::DenseSched S; S.init(R, 2048, 256 * 2, 256 * 2, ws + OFF_WT_KVB, gridDim.x, blockIdx.x); pg8::EpiKV E{(bf16_t*)(ws + OFF_K), (bf16_t*)(ws + OFF_V), (const float*)(ws + OFF_SSQKV)}; pg8::gemm_phase(lds, (const char*)(ws + OFF_CKV), 256, S, E); }
    { const bf16_t* kr = (const bf16_t*)(ws + OFF_KR); bf16_t* Kb = (bf16_t*)(ws + OFF_K); const float* ropet = (const float*)(ws + OFF_ROPE);
      for (int gid = blockIdx.x * 512 + otid(); gid < R * 32; gid += gridDim.x * 512) { const int row = gid >> 5, i = gid & 31;
          const float x1 = bf2f(kr[(size_t)row * 64 + i]), x2 = bf2f(kr[(size_t)row * 64 + 32 + i]); float o1 = x1, o2 = x2; int b, pos;
          if (row < L) { b = row / SEQ; pos = row % SEQ; const float cs = ropet[pos * 64 + i], sn = ropet[pos * 64 + 32 + i]; o1 = x1 * cs - x2 * sn; o2 = x1 * sn + x2 * cs; } else { b = (row - L) / CTXL; pos = SEQ + (row - L) % CTXL; }
          const bf16_t w1 = f2bf(o1), w2 = f2bf(o2);
          for (int h = 0; h < 8; ++h) { bf16_t* q = Kb + ((size_t)(b * 8 + h) * NKEY + pos) * 192 + 128; q[i] = w1; q[32 + i] = w2; } } }
}
__device__ __forceinline__ void unpack8(const u32x4 w, float (&o)[8]) {
    o[0] = __uint_as_float(w.x << 16); o[1] = __uint_as_float(w.x & 0xffff0000u); o[2] = __uint_as_float(w.y << 16); o[3] = __uint_as_float(w.y & 0xffff0000u);
    o[4] = __uint_as_float(w.z << 16); o[5] = __uint_as_float(w.z & 0xffff0000u); o[6] = __uint_as_float(w.w << 16); o[7] = __uint_as_float(w.w & 0xffff0000u); }
__device__ __forceinline__ void phase4(const Params& p, LAS unsigned char*) {
    char* ws = p.ws; bf16_t* y = (bf16_t*)(ws + OFF_H); const bf16_t* of = (const bf16_t*)(ws + OFF_OF); const bf16_t* ob = (const bf16_t*)(ws + OFF_OB);
    const bf16_t* og = (const bf16_t*)(ws + OFF_OG); const bf16_t* gm = (const bf16_t*)(ws + OFF_GM); const bf16_t* gh = (const bf16_t*)(ws + OFF_GH);
    const int tid = otid(), lane = tid & 63, gw = blockIdx.x * 8 + (tid >> 6), nw = gridDim.x * 8, c0 = lane * 8;
    float gg[8];
#pragma unroll
    for (int i = 0; i < 8; ++i) gg[i] = p.g_hg[(c0 + i) & 127];
    for (int row = gw; row < L; row += nw) {
        u32x4 ra[2], rb[2], r1[2], r2[2], r3[2], rm[2];
#pragma unroll
        for (int j = 0; j < 2; ++j) { const size_t off = (size_t)row * D + j * 512 + c0; ra[j] = *(const u32x4*)(of + off); rb[j] = *(const u32x4*)(ob + off); r1[j] = *(const u32x4*)(og + off); r2[j] = *(const u32x4*)(gm + off); r3[j] = *(const u32x4*)(gh + off); rm[j] = *(const u32x4*)(y + off); }
#pragma unroll
        for (int j = 0; j < 2; ++j) { float a[8], b[8], g1[8], g2[8], g3[8], ym[8], o[8]; unpack8(ra[j], a); unpack8(rb[j], b); unpack8(r1[j], g1); unpack8(r2[j], g2); unpack8(r3[j], g3); unpack8(rm[j], ym);
            float ss = 0.f;
#pragma unroll
            for (int i = 0; i < 8; ++i) { o[i] = a[i] + b[i]; ss += o[i] * o[i]; }
            ss += __shfl_xor(ss, 1); ss += __shfl_xor(ss, 2); ss += __shfl_xor(ss, 4); ss += __shfl_xor(ss, 8);
            const float rs = rsqrtf(ss * (1.0f / 128.0f) + EPS); float r[8];
#pragma unroll
            for (int i = 0; i < 8; ++i) { const float yh = o[i] * rs * gg[i] * siluf_(g1[i]); r[i] = sigmoidf_(g2[i]) * ym[i] + sigmoidf_(g3[i]) * yh; }
            u32x4 w; w.x = cvt_pk_bf16(r[0], r[1]); w.y = cvt_pk_bf16(r[2], r[3]); w.z = cvt_pk_bf16(r[4], r[5]); w.w = cvt_pk_bf16(r[6], r[7]);
            *(u32x4*)(y + (size_t)row * D + j * 512 + c0) = w; }
    }
}
__device__ __forceinline__ void phase5(const Params& p, LAS unsigned char* lds) {
    char* ws = p.ws;
    { pg8::DenseSched S; S.init(L, 1024, 1024 * 2, 1024 * 2, ws + OFF_WT_OUT, gridDim.x, blockIdx.x); pg8::EpiOut E{(bf16_t*)(ws + OFF_X1), p.x, (const float*)(ws + OFF_MOD)}; pg8::gemm_phase(lds, (const char*)(ws + OFF_H), 1024, S, E); }
    { LAS float* tl = (LAS float*)lds; int tctr = 0; ConvPipe<true> pp; pp.have = false;
      for (int e = 0; e < NE; ++e) conv_matrix<true>(tl, pp, p.w_gu + (size_t)e * 1024 * 2048, 2048, (unsigned char*)(ws + OFF_WT_GU) + (size_t)e * 2048 * 1024, 1024, 2048, 2, nullptr, tctr);
      for (int e = 0; e < NE; ++e) conv_matrix<true>(tl, pp, p.w_dn + (size_t)e * 1024 * 1024, 1024, (unsigned char*)(ws + OFF_WT_DN) + (size_t)e * 1024 * 1024, 1024, 1024, 0, nullptr, tctr);
      conv_finish<true>(tl, pp); }
}
__device__ __forceinline__ void phase6(const Params& p, LAS unsigned char* lds) {
    char* ws = p.ws; const float* modv = (const float*)(ws + OFF_MOD); unsigned char* h2 = (unsigned char*)(ws + OFF_H); int* topi = (int*)(ws + OFF_TOPI); float* topp = (float*)(ws + OFF_TOPP); int* cnt = (int*)(ws + OFF_CNT); int* list = (int*)(ws + OFF_LIST); int* pairpos = (int*)(ws + OFF_ROWPAIR);
    LAS float* hs = (LAS float*)lds;
    LAS float* lg = (LAS float*)(lds + 131072);
    LAS int* lcnt = (LAS int*)(lds + 131072 + 4096);
    LAS int* lent = (LAS int*)(lds + 131072 + 4096 + 512);
    const int tid = otid(), lane = tid & 63, wid = tid >> 6, c0 = lane * 8;
    if (tid < 96) lcnt[tid] = 0;
    f32x4 g[4];
#pragma unroll
    for (int q = 0; q < 4; ++q) g[q] = *(const f32x4*)(p.g_ffn + (q >> 1) * 512 + c0 + (q & 1) * 4);
    __syncthreads();
    int it = 0;
    for (int tile = blockIdx.x; tile < L / 32; tile += gridDim.x, ++it) {
        const int rbase = tile * 32;
        f32x4 v[4][4];
#pragma unroll
        for (int u = 0; u < 4; ++u)
#pragma unroll
            for (int j = 0; j < 2; ++j) { float t8[8]; unpack8(*(const u32x4*)((const bf16_t*)(ws + OFF_X1) + (size_t)(rbase + wid * 4 + u) * D + j * 512 + c0), t8); v[u][2 * j] = (f32x4){t8[0], t8[1], t8[2], t8[3]}; v[u][2 * j + 1] = (f32x4){t8[4], t8[5], t8[6], t8[7]}; }
#pragma unroll
        for (int u = 0; u < 4; ++u) { const int rl = wid * 4 + u, row = rbase + rl; const float* mod = modv + (row / SEQ) * 6144; float ss = 0.f;
#pragma unroll
            for (int q = 0; q < 4; ++q) ss += (v[u][q][0] * v[u][q][0] + v[u][q][1] * v[u][q][1]) + (v[u][q][2] * v[u][q][2] + v[u][q][3] * v[u][q][3]);
            const float rs = rsqrtf(wave_sum(ss) * (1.0f / D) + EPS);
#pragma unroll
            for (int j = 0; j < 2; ++j) { f32x4 o[2];
#pragma unroll
                for (int e = 0; e < 2; ++e) { const int cc = j * 512 + c0 + e * 4; const f32x4 sc = *(const f32x4*)(mod + 4 * 1024 + cc), sh = *(const f32x4*)(mod + 3 * 1024 + cc); o[e] = v[u][j * 2 + e] * rs * g[j * 2 + e] * (sc + 1.0f) + sh;
                    *(LAS f32x4*)(hs + rl * 1024 + cc) = o[e]; }
                u32x2 w; w.x = pack4_fp8(o[0][0], o[0][1], o[0][2], o[0][3]); w.y = pack4_fp8(o[1][0], o[1][1], o[1][2], o[1][3]);
                *(u32x2*)(h2 + (size_t)row * D + j * 512 + c0) = w; } }
        __syncthreads();
        { const int e = tid & 31, rg = tid >> 5; const LAS float* h0 = hs + (2 * rg) * 1024; const LAS float* h1 = h0 + 1024; float a0 = 0.f, a1 = 0.f;
          for (int j = 0; j < 1024; j += 8) { float w[8];
#pragma unroll
              for (int q = 0; q < 8; ++q) w[q] = p.w_r[(j + q) * 32 + e];
              const f32x4 x0 = *(const LAS f32x4*)(h0 + j), x1 = *(const LAS f32x4*)(h0 + j + 4), y0 = *(const LAS f32x4*)(h1 + j), y1 = *(const LAS f32x4*)(h1 + j + 4);
              a0 += x0[0] * w[0]; a0 += x0[1] * w[1]; a0 += x0[2] * w[2]; a0 += x0[3] * w[3]; a0 += x1[0] * w[4]; a0 += x1[1] * w[5]; a0 += x1[2] * w[6]; a0 += x1[3] * w[7];
              a1 += y0[0] * w[0]; a1 += y0[1] * w[1]; a1 += y0[2] * w[2]; a1 += y0[3] * w[3]; a1 += y1[0] * w[4]; a1 += y1[1] * w[5]; a1 += y1[2] * w[6]; a1 += y1[3] * w[7]; }
          const float be = p.b_r[e]; lg[(2 * rg) * 32 + e] = a0 + be; lg[(2 * rg + 1) * 32 + e] = a1 + be; }
        __syncthreads();
#pragma unroll
        for (int rep = 0; rep < 2; ++rep) { const int rl = wid * 4 + rep * 2 + (lane >> 5), row = rbase + rl, e = lane & 31; float cur = lg[rl * 32 + e];
            float tv0 = 0.f, sum = 0.f; int sel_i[4]; float sel_e[4];
#pragma unroll
            for (int k = 0; k < 4; ++k) { float m = cur; int mi = e;
#pragma unroll
                for (int o2 = 16; o2 > 0; o2 >>= 1) { const float om = __shfl_xor(m, o2); const int oi = __shfl_xor(mi, o2); if (om > m || (om == m && oi < mi)) { m = om; mi = oi; } }
                if (k == 0) tv0 = m; sel_i[k] = mi; sel_e[k] = __expf(m - tv0); sum += sel_e[k]; if (e == mi) cur = -3.0e38f; }
            int myk = 0; float myp = 0.f;
#pragma unroll
            for (int k = 0; k < 4; ++k) if (e == k) { myk = sel_i[k]; myp = sel_e[k] / sum; }
            if (e < 4) { const int pair = row * 4 + e; topi[pair] = myk; topp[pair] = myp; __hip_atomic_fetch_add(&lcnt[myk], 1, __ATOMIC_RELAXED, __HIP_MEMORY_SCOPE_WORKGROUP); lent[(it * 32 + rl) * 4 + e] = myk; } }
        __syncthreads();
    }
    if (tid < 32) { const int n = lcnt[tid]; lcnt[32 + tid] = n > 0 ? atomicAdd(&cnt[tid], n) : 0; lcnt[64 + tid] = 0; }
    __syncthreads();
    const int nent = it * 128;
    for (int s = tid; s < nent; s += 512) { const int e = lent[s]; const int ii = s >> 7, rl = (s >> 2) & 31, k = s & 3; const int row = (blockIdx.x + ii * gridDim.x) * 32 + rl;
        const int pos = lcnt[32 + e] + __hip_atomic_fetch_add(&lcnt[64 + e], 1, __ATOMIC_RELAXED, __HIP_MEMORY_SCOPE_WORKGROUP); list[e * CAP + pos] = row * 4 + k; pairpos[row * 4 + k] = pos; }
}
__device__ __forceinline__ void moe_table(const int* cnt, LAS int* tab) {
    if (otid() == 0) { int t = 0; for (int e = 0; e < NE; ++e) { tab[e] = t; const int n = cnt[e]; tab[64 + e] = n; t += (n + 255) >> 8; } tab[32] = t; tab[33] = t; }
    __syncthreads();
    for (int rt = otid(); rt < tab[33]; rt += 512) { int e = 0; while (tab[e + 1] <= rt) ++e; tab[128 + rt] = e; }
    __syncthreads();
}
constexpr int LDS_TAB = pg8::STAGE_BYTES;
__device__ __forceinline__ void phase7(const Params& p, LAS unsigned char* lds) {
    char* ws = p.ws; LAS int* tab = (LAS int*)(lds + LDS_TAB); moe_table((const int*)(ws + OFF_CNT), tab);
    pg8::MoeSched<true> S; S.nN = 8; S.G = gridDim.x; S.c = blockIdx.x; S.rowb = 1024; S.Wt = ws + OFF_WT_GU; S.wexp = (size_t)2048 * 1024; S.btile = (size_t)256 * 1024; S.tab = tab; S.list = (const int*)(ws + OFF_LIST);
    pg8::EpiMoe1 E{(unsigned char*)(ws + OFF_ACT), p.b_gu};
    pg8::gemm_phase<pg8::EpiMoe1, pg8::MoeSched<true>, true, 127, 122>(lds, (const char*)(ws + OFF_H), 1024, S, E);
}
__device__ __forceinline__ void phase8(const Params& p, LAS unsigned char* lds) {
    char* ws = p.ws; LAS int* tab = (LAS int*)(lds + LDS_TAB); moe_table((const int*)(ws + OFF_CNT), tab);
    pg8::MoeSched<false> S; S.nN = 4; S.G = gridDim.x; S.c = blockIdx.x; S.rowb = 1024; S.Wt = ws + OFF_WT_DN; S.wexp = (size_t)1024 * 1024; S.btile = (size_t)256 * 1024; S.tab = tab; S.list = (const int*)(ws + OFF_LIST);
    pg8::EpiMoe2 E{(bf16_t*)(ws + OFF_YP), p.b_dn};
    pg8::gemm_phase<pg8::EpiMoe2, pg8::MoeSched<false>, true, 125, 122>(lds, (const char*)(ws + OFF_ACT), 1024, S, E);
}
__device__ __forceinline__ void phase9(const Params& p, LAS unsigned char* lds) {
    char* ws = p.ws; const float* modv = (const float*)(ws + OFF_MOD); const bf16_t* yp = (const bf16_t*)(ws + OFF_YP); const float* topp = (const float*)(ws + OFF_TOPP);
    const int* topi = (const int*)(ws + OFF_TOPI); const int* pairpos = (const int*)(ws + OFF_ROWPAIR);
    LAS int* tab = (LAS int*)lds; moe_table((const int*)(ws + OFF_CNT), tab);
    const int tid = otid(), lane = tid & 63, gw = blockIdx.x * 8 + (tid >> 6), nw = gridDim.x * 8, c0 = lane * 8;
    f32x4 fg[4];
#pragma unroll
    for (int q = 0; q < 4; ++q) fg[q] = *(const f32x4*)(p.g_fin + (q >> 1) * 512 + c0 + (q & 1) * 4);
    for (int row = gw; row < L; row += nw) {
        const float* gate = modv + (row / SEQ) * 6144 + 5 * 1024; f32x4 v[4]; u32x4 yr[4][2];
        const pg8::i32x4_t ek = *(const pg8::i32x4_t*)(topi + row * 4), pk4 = *(const pg8::i32x4_t*)(pairpos + row * 4);
#pragma unroll
        for (int j = 0; j < 2; ++j) { float t8[8]; unpack8(*(const u32x4*)((const bf16_t*)(ws + OFF_X1) + (size_t)row * D + j * 512 + c0), t8); v[2 * j] = (f32x4){t8[0], t8[1], t8[2], t8[3]}; v[2 * j + 1] = (f32x4){t8[4], t8[5], t8[6], t8[7]}; }
#pragma unroll
        for (int k = 0; k < 4; ++k) { const size_t yrow = (size_t)tab[ek[k]] * 256 + pk4[k];
#pragma unroll
            for (int j = 0; j < 2; ++j) yr[k][j] = *(const u32x4*)(yp + yrow * D + j * 512 + c0); }
        const f32x4 pk = *(const f32x4*)(topp + row * 4);
        float m[16];
#pragma unroll
        for (int i = 0; i < 16; ++i) m[i] = 0.f;
#pragma unroll
        for (int k = 0; k < 4; ++k)
#pragma unroll
            for (int j = 0; j < 2; ++j) { float t[8]; unpack8(yr[k][j], t);
#pragma unroll
                for (int i = 0; i < 8; ++i) m[j * 8 + i] += pk[k] * t[i]; }
        float ss = 0.f;
#pragma unroll
        for (int q = 0; q < 4; ++q) { const f32x4 gt = *(const f32x4*)(gate + (q >> 1) * 512 + c0 + (q & 1) * 4);
#pragma unroll
            for (int i = 0; i < 4; ++i) { v[q][i] += gt[i] * m[q * 4 + i]; ss += v[q][i] * v[q][i]; } }
        const float rs = rsqrtf(wave_sum(ss) * (1.0f / D) + EPS);
#pragma unroll
        for (int q = 0; q < 4; ++q) *(f32x4*)(p.out + (size_t)row * D + (q >> 1) * 512 + c0 + (q & 1) * 4) = v[q] * rs * fg[q];
    }
}

namespace at {
using s16x4  = __attribute__((ext_vector_type(4))) short;
using f32x16 = __attribute__((ext_vector_type(16))) float;
constexpr int NW = 8, QBLK = 32, KVBLK = 64, DK = 192, DV = 128;
constexpr float SCALE = 0.07216878364870322f;
constexpr float THR = 8.f;
constexpr int SHM_V = KVBLK * DV * 2, SHM_K = KVBLK * DK * 2, SHM_ATTN = 2 * SHM_V + 2 * SHM_K + NW * 64 * 4;
#define KSWZ(row, colB) ((row) * 384 + ((colB) ^ (((row) & 7) << 4)))
#define SBAR() __builtin_amdgcn_sched_barrier(0)
__device__ __forceinline__ int crow(int r, int hi) { return (r & 3) + 8 * (r >> 2) + 4 * hi; }
__device__ __forceinline__ unsigned cvtpk(float lo, float hi) { return cvt_pk_bf16(lo, hi); }

__device__ __forceinline__ void partialSM(f32x16& p0, f32x16& p1, float& m_reg, float& mn, float& alpha) {
  constexpr float C = SCALE * 1.4426950408889634f;
  float pmax = p0[0];
#pragma unroll
  for (int r = 1; r < 16; ++r) pmax = fmaxf(pmax, p0[r]);
#pragma unroll
  for (int r = 0; r < 16; ++r) pmax = fmaxf(pmax, p1[r]);
  { auto rr = __builtin_amdgcn_permlane32_swap(__float_as_uint(pmax), __float_as_uint(pmax), false, false);
    pmax = fmaxf(__uint_as_float(rr[0]), __uint_as_float(rr[1])); }
  if (__builtin_expect(__all(pmax - m_reg <= THR / SCALE), 1)) { mn = m_reg; alpha = 1.f; }
  else { mn = fmaxf(m_reg, pmax); alpha = __builtin_amdgcn_exp2f((m_reg - mn) * C); m_reg = mn; }
  float mnC = -mn * C;
#pragma unroll
  for (int r = 0; r < 16; ++r) p0[r] = fmaf(p0[r], C, mnC);
#pragma unroll
  for (int r = 0; r < 16; ++r) p1[r] = fmaf(p1[r], C, mnC);
#pragma unroll
  for (int r = 0; r < 16; ++r) p0[r] = __builtin_amdgcn_exp2f(p0[r]);
}
__device__ __forceinline__ void finishSM(f32x16& p0, f32x16& p1, float alpha, float& l_reg, bf16x8& pa0, bf16x8& pa1, bf16x8& pa2, bf16x8& pa3) {
#pragma unroll
  for (int r = 0; r < 16; ++r) p1[r] = __builtin_amdgcn_exp2f(p1[r]);
  float ps = 0;
#pragma unroll
  for (int r = 0; r < 16; ++r) ps += p0[r];
#pragma unroll
  for (int r = 0; r < 16; ++r) ps += p1[r];
  { auto rr = __builtin_amdgcn_permlane32_swap(__float_as_uint(ps), __float_as_uint(ps), false, false);
    ps = __uint_as_float(rr[0]) + __uint_as_float(rr[1]); }
  l_reg = l_reg * alpha + ps;
#define PK4(P, BASE, OUT) do { unsigned a0 = cvtpk(P[BASE + 0], P[BASE + 1]), a1 = cvtpk(P[BASE + 2], P[BASE + 3]);   \
    unsigned b0 = cvtpk(P[BASE + 4], P[BASE + 5]), b1 = cvtpk(P[BASE + 6], P[BASE + 7]);                              \
    auto r0 = __builtin_amdgcn_permlane32_swap(a0, b0, false, false); auto r1 = __builtin_amdgcn_permlane32_swap(a1, b1, false, false); \
    u32x4 w = {r0[0], r1[0], r0[1], r1[1]}; OUT = *reinterpret_cast<bf16x8*>(&w); } while (0)
  PK4(p0, 0, pa0); PK4(p0, 8, pa1); PK4(p1, 0, pa2); PK4(p1, 8, pa3);
#undef PK4
}
__device__ __forceinline__ void qkt(f32x16& p0, f32x16& p1, const LAS char* Ks, const bf16x8 (&qr)[12], int r32, int hi) {
  p0 = f32x16{}; p1 = f32x16{};
#pragma unroll
  for (int d0 = 0; d0 < 12; ++d0) { const int cb = (d0 * 16 + hi * 8) * 2;
    const bf16x8 b0 = *reinterpret_cast<const LAS bf16x8*>(Ks + KSWZ(r32, cb));
    const bf16x8 b1 = *reinterpret_cast<const LAS bf16x8*>(Ks + KSWZ(32 + r32, cb));
    p0 = __builtin_amdgcn_mfma_f32_32x32x16_bf16(b0, qr[d0], p0, 0, 0, 0);
    p1 = __builtin_amdgcn_mfma_f32_32x32x16_bf16(b1, qr[d0], p1, 0, 0, 0); }
}
__device__ __forceinline__ int v_st(int k, int c) { const int kk = (k & ~0xC) | ((k & 4) << 1) | ((k & 8) >> 1); return ((kk >> 3) * 4 + (c >> 5)) * 512 + ((kk & 7) * 32 + (c & 31)) * 2; }
__device__ __forceinline__ int v_rd_base(int lane) { return ((lane & 3) << 3) | (((lane >> 2) & 3) << 6) | (((lane >> 4) & 1) << 5) | (((lane >> 5) & 1) << 8); }
constexpr int v_rd_off(int d0, int ks, int half) { return d0 * 512 + ks * 4096 + half * 2048; }
template <int OFF> __device__ __forceinline__ s16x4 tr_read(int vb) { s16x4 r; asm volatile("ds_read_b64_tr_b16 %0, %1 offset:%2" : "=&v"(r) : "v"(vb), "i"(OFF) : "memory"); return r; }
template <int D0> __device__ __forceinline__ void pv_one(f32x16& od, int vb, bf16x8 pa0, bf16x8 pa1, bf16x8 pa2, bf16x8 pa3) {
  const s16x4 l0 = tr_read<v_rd_off(D0, 0, 0)>(vb), h0 = tr_read<v_rd_off(D0, 0, 1)>(vb), l1 = tr_read<v_rd_off(D0, 1, 0)>(vb), h1 = tr_read<v_rd_off(D0, 1, 1)>(vb);
  const s16x4 l2 = tr_read<v_rd_off(D0, 2, 0)>(vb), h2 = tr_read<v_rd_off(D0, 2, 1)>(vb), l3 = tr_read<v_rd_off(D0, 3, 0)>(vb), h3 = tr_read<v_rd_off(D0, 3, 1)>(vb);
  asm volatile("s_waitcnt lgkmcnt(0)" ::: "memory"); SBAR();
#define PK(Lo, Hi) (bf16x8){Lo[0], Lo[1], Lo[2], Lo[3], Hi[0], Hi[1], Hi[2], Hi[3]}
  od = __builtin_amdgcn_mfma_f32_32x32x16_bf16(pa0, PK(l0, h0), od, 0, 0, 0);
  od = __builtin_amdgcn_mfma_f32_32x32x16_bf16(pa1, PK(l1, h1), od, 0, 0, 0);
  od = __builtin_amdgcn_mfma_f32_32x32x16_bf16(pa2, PK(l2, h2), od, 0, 0, 0);
  od = __builtin_amdgcn_mfma_f32_32x32x16_bf16(pa3, PK(l3, h3), od, 0, 0, 0);
#undef PK
}
__device__ __forceinline__ void pv_d0(f32x16 (&o)[4], int vb, bf16x8 pa0, bf16x8 pa1, bf16x8 pa2, bf16x8 pa3) {
  pv_one<0>(o[0], vb, pa0, pa1, pa2, pa3); pv_one<1>(o[1], vb, pa0, pa1, pa2, pa3); pv_one<2>(o[2], vb, pa0, pa1, pa2, pa3); pv_one<3>(o[3], vb, pa0, pa1, pa2, pa3);
}

__device__ __forceinline__ void attn_unit(const bf16_t* __restrict__ Qb, const bf16_t* __restrict__ Kh, const bf16_t* __restrict__ Vh, bf16_t* __restrict__ Ob, int t0, const float* __restrict__ ropet, LAS char* lds) {
  constexpr int LDQ = 1536, LDO = 1024, NT = NKEY / KVBLK;
  const int tid = otid(), wid = tid >> 6, lane = tid & 63, r32 = lane & 31, hi = lane >> 5;
  LAS char* V_lds = lds; LAS char* K_lds = lds + 2 * SHM_V;
  LAS float* wsl = (LAS float*)(lds + 2 * SHM_V + 2 * SHM_K) + wid * 64; LAS float* li_l = wsl; LAS float* al_l = wsl + 32;
  float m_reg = -1e30f, l_reg = 0; f32x16 o[4] = {}; bf16x8 qr[12];
  { const bf16_t* Qw = Qb + (size_t)(wid * QBLK + r32) * LDQ + hi * 8;
#pragma unroll
    for (int d0 = 0; d0 < 12; ++d0) qr[d0] = *reinterpret_cast<const bf16x8*>(Qw + d0 * 16);
    const float* rt = ropet + (size_t)(t0 + wid * QBLK + r32) * 64 + 8 * hi;
#pragma unroll
    for (int g = 0; g < 2; ++g) {
      const f32x4 c0 = *(const f32x4*)(rt + 16 * g), c1 = *(const f32x4*)(rt + 16 * g + 4), s0 = *(const f32x4*)(rt + 32 + 16 * g), s1 = *(const f32x4*)(rt + 32 + 16 * g + 4);
      float n1[8], n2[8];
#pragma unroll
      for (int j = 0; j < 8; ++j) { const float cs = j < 4 ? c0[j & 3] : c1[j & 3], sn = j < 4 ? s0[j & 3] : s1[j & 3];
        const float x1 = bf2f((bf16_t)qr[8 + g][j]), x2 = bf2f((bf16_t)qr[10 + g][j]); n1[j] = x1 * cs - x2 * sn; n2[j] = x1 * sn + x2 * cs; }
      u32x4 w1 = {cvtpk(n1[0], n1[1]), cvtpk(n1[2], n1[3]), cvtpk(n1[4], n1[5]), cvtpk(n1[6], n1[7])}; u32x4 w2 = {cvtpk(n2[0], n2[1]), cvtpk(n2[2], n2[3]), cvtpk(n2[4], n2[5]), cvtpk(n2[6], n2[7])};
      qr[8 + g] = *reinterpret_cast<bf16x8*>(&w1); qr[10 + g] = *reinterpret_cast<bf16x8*>(&w2); } }
  const int sr = tid >> 4, sc = (tid & 15) * 8, vst0 = v_st(sr, sc), vst1 = v_st(32 + sr, sc);
  int kgo[3], kst[3];
#pragma unroll
  for (int i = 0; i < 3; ++i) { const int c = tid + 512 * i, row = c / 24, c8 = (c % 24) * 8; kgo[i] = row * DK + c8; kst[i] = KSWZ(row, c8 * 2); }
  const int vb0 = (int)(uintptr_t)V_lds + v_rd_base(lane);
  bf16x8 sv0, sv1, sk0, sk1, sk2;
#define SLOAD(k0) do { sv0 = *reinterpret_cast<const bf16x8*>(&Vh[(size_t)((k0) + sr) * DV + sc]); sv1 = *reinterpret_cast<const bf16x8*>(&Vh[(size_t)((k0) + 32 + sr) * DV + sc]); \
    sk0 = *reinterpret_cast<const bf16x8*>(&Kh[(size_t)(k0) * DK + kgo[0]]); sk1 = *reinterpret_cast<const bf16x8*>(&Kh[(size_t)(k0) * DK + kgo[1]]); sk2 = *reinterpret_cast<const bf16x8*>(&Kh[(size_t)(k0) * DK + kgo[2]]); } while (0)
#define SWRITE(b) do { *(LAS bf16x8*)(V_lds + (b) * SHM_V + vst0) = sv0; *(LAS bf16x8*)(V_lds + (b) * SHM_V + vst1) = sv1; \
    *(LAS bf16x8*)(K_lds + (b) * SHM_K + kst[0]) = sk0; *(LAS bf16x8*)(K_lds + (b) * SHM_K + kst[1]) = sk1; *(LAS bf16x8*)(K_lds + (b) * SHM_K + kst[2]) = sk2; } while (0)
#define RESC(a) do { if (__any((a) < 1.f)) { if (hi == 0) al_l[r32] = (a); asm volatile("s_waitcnt lgkmcnt(0)" ::: "memory"); \
    _Pragma("unroll") for (int d = 0; d < 4; ++d) _Pragma("unroll") for (int r = 0; r < 16; ++r) o[d][r] *= al_l[crow(r, hi)]; } } while (0)
  f32x16 p0, p1; float mn, al; bf16x8 pa0, pa1, pa2, pa3;
  SLOAD(0); asm volatile("s_waitcnt vmcnt(0)" ::: "memory"); SWRITE(0); __syncthreads();
  for (int j = 0; j < NT; ++j) {
    const int bsel = j & 1;
    if (j + 1 < NT) SLOAD((j + 1) * KVBLK);
    SBAR(); qkt(p0, p1, K_lds + bsel * SHM_K, qr, r32, hi);
    partialSM(p0, p1, m_reg, mn, al);
    RESC(al);
    finishSM(p0, p1, al, l_reg, pa0, pa1, pa2, pa3); SBAR();
    pv_d0(o, vb0 + bsel * SHM_V, pa0, pa1, pa2, pa3);
    if (j + 1 < NT) { asm volatile("s_waitcnt vmcnt(0)" ::: "memory"); SWRITE(bsel ^ 1); }
    __syncthreads();
  }
  if (hi == 0) li_l[r32] = l_reg; asm volatile("s_waitcnt lgkmcnt(0)" ::: "memory");
  float rli[16];
#pragma unroll
  for (int r = 0; r < 16; ++r) rli[r] = __builtin_amdgcn_rcpf(li_l[crow(r, hi)]);
  { LAS bf16_t* ot = (LAS bf16_t*)(lds + wid * 8192);
#pragma unroll
    for (int r = 0; r < 16; ++r) { const int orow = crow(r, hi);
#pragma unroll
      for (int d0 = 0; d0 < 4; ++d0) ot[orow * 128 + d0 * 32 + r32] = f2bf(o[d0][r] * rli[r]); }
    asm volatile("s_waitcnt lgkmcnt(0)" ::: "memory");
    bf16_t* Ow = Ob + (size_t)(wid * QBLK) * LDO;
#pragma unroll
    for (int i = 0; i < 8; ++i) { const int q = lane + 64 * i, row = q >> 4, ch = q & 15; const u32x4 w = *(const LAS u32x4*)(ot + row * 128 + ch * 8); *(u32x4*)(Ow + (size_t)row * LDO + ch * 8) = w; } }
#undef SLOAD
#undef SWRITE
#undef RESC
}
}

__device__ __forceinline__ void phase_attn(const Params& p, LAS unsigned char* lds) {
    char* ws = p.ws; const bf16_t* Q = (const bf16_t*)(ws + OFF_Q); const bf16_t* Kb = (const bf16_t*)(ws + OFF_K); const bf16_t* Vb = (const bf16_t*)(ws + OFF_V); bf16_t* Y = (bf16_t*)(ws + OFF_H);
    const int G = gridDim.x;
    for (int it = 0;; ++it) {
        int u;
        if (G == 256) { const int c = blockIdx.x, xcd = c & 7, j = c >> 3; if (it >= 4) break; u = ((it * 32 + xcd * 4 + (j >> 3)) << 3) | (j & 7); }
        else { u = it * G + blockIdx.x; if (u >= 1024) break; }
        const int bh = u >> 3, qb = u & 7, b = bh >> 3, h = bh & 7;
        at::attn_unit(Q + ((size_t)(b * SEQ + qb * 256)) * 1536 + h * 192, Kb + (size_t)bh * NKEY * 192, Vb + (size_t)bh * NKEY * 128, Y + ((size_t)(b * SEQ + qb * 256)) * D + h * 128, qb * 256, (const float*)(ws + OFF_ROPE), (LAS char*)lds);
        __syncthreads();
    }
}

namespace sc {
using f32x16 = __attribute__((ext_vector_type(16))) float;
constexpr int O_QI = 0, O_QG = 16384, O_KT = 32768, O_KE = 73728, O_VT = 90112, O_AT = 106496, O_SC = 114688, O_DEC = 147456, O_TOT = 147456 + 512, LDS_SCAN = 147456 + 512 + 4096;
__device__ __forceinline__ int sw256(int row, int cb) { return row * 256 + (cb ^ ((row & 15) << 4)); }
__device__ __forceinline__ int sw128(int row, int cb) { return row * 128 + (cb ^ (((row >> 1) & 7) << 4)); }
__device__ __forceinline__ int crow(int r, int hi) { return (r & 3) + 8 * (r >> 2) + 4 * hi; }
__device__ __forceinline__ int grow_of(int n, int b, int dir) { if (n < CTXL) { const int s = dir ? (CTXL - 1 - n) : n; return L + b * CTXL + s; } const int m = n - CTXL; return b * SEQ + (dir ? (SEQ - 1 - m) : m); }

__device__ __forceinline__ void scan_unit(const Params& p, int unit, LAS unsigned char* lds) {
    char* ws = p.ws; const int dir = unit & 1, h = (unit >> 1) & 7, b = unit >> 4;
    const bf16_t* hq = (const bf16_t*)(ws + OFF_HQ); const bf16_t* fz = (const bf16_t*)(ws + (dir ? OFF_FB : OFF_FF)); const bf16_t* iv = (const bf16_t*)(ws + OFF_IV);
    bf16_t* outp = (bf16_t*)(ws + (dir ? OFF_OB : OFF_OF)); const float* lb = (const float*)(ws + OFF_LB);
    const int tid = otid(), wid = tid >> 6, lane = tid & 63, r32 = lane & 31, hi = lane >> 5;
    const int cp = lane, sb = __builtin_amdgcn_readfirstlane(wid), J = sb >> 1;
    const float lbv0 = lb[dir * 1024 + h * 128 + 2 * cp], lbv1 = lb[dir * 1024 + h * 128 + 2 * cp + 1];
    const int hc = h * 128 + 2 * cp; const int sgn = dir ? -1 : 1; const long rstep = (long)sgn * D;
    LAS unsigned char* QI = lds + O_QI; LAS unsigned char* QG = lds + O_QG; LAS unsigned char* KT = lds + O_KT; LAS unsigned char* KE = lds + O_KE; LAS unsigned char* VT = lds + O_VT;
    LAS unsigned char* AT = lds + O_AT; LAS unsigned char* SCp = lds + O_SC; LAS float* DEC = (LAS float*)(lds + O_DEC); LAS float* TOT = (LAS float*)(lds + O_TOT);
    for (int i = tid; i < (8192 + 32768) / 16; i += 512) *(LAS u32x4*)(lds + O_AT + i * 16) = (u32x4){0u, 0u, 0u, 0u};
    f32x16 S0 = {}, S1 = {};
    const int tb = wid & 1, dvb = wid >> 1;
    unsigned zr[8], vr[8], qr[8];
#define SC_LOAD_Z(c) do { const bf16_t* pz_ = fz + (size_t)(grow_of((c) * 64, b, dir) + sgn * (8 * sb)) * D + hc; _Pragma("unroll") for (int i = 0; i < 8; ++i) { zr[i] = *(const unsigned*)pz_; pz_ += rstep; } } while (0)
#define SC_LOAD_VQ(c) do { const size_t o0_ = (size_t)(grow_of((c) * 64, b, dir) + sgn * (8 * sb)) * D + hc; const bf16_t* pv_ = iv + o0_; const bf16_t* pq_ = hq + o0_; \
        _Pragma("unroll") for (int i = 0; i < 8; ++i) { vr[i] = *(const unsigned*)pv_; pv_ += rstep; if ((c) >= 4) { qr[i] = *(const unsigned*)pq_; pq_ += rstep; } } } while (0)
    SC_LOAD_Z(0); SC_LOAD_VQ(0);
    __syncthreads();
    for (int c = 0; c < 36; ++c) {
        const bool lat = c >= 4;
        {
            float kk0[8], kk1[8], lc0[8], lc1[8]; float run0 = 0.f, run1 = 0.f;
#pragma unroll
            for (int i = 0; i < 8; ++i) { const float z0 = __uint_as_float(zr[i] << 16), z1 = __uint_as_float(zr[i] & 0xffff0000u);
                const float f0 = lbv0 + (1.0f - lbv0) * sigmoidf_(z0), f1 = lbv1 + (1.0f - lbv1) * sigmoidf_(z1); kk0[i] = 1.0f - f0; kk1[i] = 1.0f - f1;
                run0 += __builtin_amdgcn_logf(f0) * 0.6931471805599453f; run1 += __builtin_amdgcn_logf(f1) * 0.6931471805599453f; lc0[i] = run0; lc1[i] = run1; }
            if (c + 1 < 36) SC_LOAD_Z(c + 1);
            *(LAS f32x2*)(TOT + sb * 128 + 2 * cp) = (f32x2){run0, run1};
            __syncthreads();
            float P0 = 0.f, P1 = 0.f, c0J0 = 0.f, c0J1 = 0.f, c010 = 0.f, c011 = 0.f, c020 = 0.f, c021 = 0.f, c030 = 0.f, c031 = 0.f, last0 = 0.f, last1 = 0.f;
            { float a0 = 0.f, a1 = 0.f;
#pragma unroll
              for (int q = 0; q < 8; ++q) { if (q == sb) { P0 = a0; P1 = a1; } if (q == 2 * J) { c0J0 = a0; c0J1 = a1; } if (q == 2) { c010 = a0; c011 = a1; } if (q == 4) { c020 = a0; c021 = a1; } if (q == 6) { c030 = a0; c031 = a1; }
                  const f32x2 tq = *(const LAS f32x2*)(TOT + q * 128 + 2 * cp); a0 += tq[0]; a1 += tq[1]; }
              last0 = a0; last1 = a1; }
            const float off0 = P0 - c0J0, off1 = P1 - c0J1;
            const float eg0 = __expf(c0J0), eg1 = __expf(c0J1), ee0 = __expf(last0 - c0J0), ee1 = __expf(last1 - c0J1);
            const float e10 = __expf(c010 - c0J0), e11 = __expf(c011 - c0J1), e20 = __expf(c020 - c0J0), e21 = __expf(c021 - c0J1), e30 = __expf(c030 - c0J0), e31 = __expf(c031 - c0J1);
            if (sb == 0) *(LAS f32x2*)(DEC + 2 * cp) = (f32x2){__expf(last0), __expf(last1)};
            unsigned ke0[4], ke1[4], vt0[4], vt1[4];
#pragma unroll
            for (int i = 0; i < 8; ++i) { const int t = 8 * sb + i; const float l0 = lc0[i] + off0, l1 = lc1[i] + off1;
                const float kd0 = kk0[i] * __expf(fminf(-l0, 80.0f)), kd1 = kk1[i] * __expf(fminf(-l1, 80.0f));
                if (lat) { const float q0 = __uint_as_float(qr[i] << 16), q1 = __uint_as_float(qr[i] & 0xffff0000u); const float qi0 = q0 * __expf(l0), qi1 = q1 * __expf(l1);
                    *(LAS unsigned*)(QI + sw256(t, 4 * cp)) = cvt_pk_bf16(qi0, qi1); *(LAS unsigned*)(QG + sw256(t, 4 * cp)) = cvt_pk_bf16(qi0 * eg0, qi1 * eg1);
                    if (J == 0) { *(LAS unsigned*)(KT + sw256(0 + t, 4 * cp)) = cvt_pk_bf16(kd0, kd1); *(LAS unsigned*)(KT + sw256(16 + t, 4 * cp)) = cvt_pk_bf16(kd0 * e10, kd1 * e11);
                                  *(LAS unsigned*)(KT + sw256(48 + t, 4 * cp)) = cvt_pk_bf16(kd0 * e20, kd1 * e21); *(LAS unsigned*)(KT + sw256(96 + t, 4 * cp)) = cvt_pk_bf16(kd0 * e30, kd1 * e31); }
                    else if (J == 1) { *(LAS unsigned*)(KT + sw256(16 + t, 4 * cp)) = cvt_pk_bf16(kd0, kd1); *(LAS unsigned*)(KT + sw256(48 + t, 4 * cp)) = cvt_pk_bf16(kd0 * e20, kd1 * e21); *(LAS unsigned*)(KT + sw256(96 + t, 4 * cp)) = cvt_pk_bf16(kd0 * e30, kd1 * e31); }
                    else if (J == 2) { *(LAS unsigned*)(KT + sw256(48 + t, 4 * cp)) = cvt_pk_bf16(kd0, kd1); *(LAS unsigned*)(KT + sw256(96 + t, 4 * cp)) = cvt_pk_bf16(kd0 * e30, kd1 * e31); }
                    else { *(LAS unsigned*)(KT + sw256(96 + t, 4 * cp)) = cvt_pk_bf16(kd0, kd1); } }
                const float kf0 = kd0 * ee0, kf1 = kd1 * ee1;
                if (i & 1) { ke0[i >> 1] = cvt_pk_bf16(__uint_as_float(ke0[i >> 1]), kf0); ke1[i >> 1] = cvt_pk_bf16(__uint_as_float(ke1[i >> 1]), kf1); vt0[i >> 1] = (vt0[i >> 1] >> 16) | (vr[i] << 16); vt1[i >> 1] = (vt1[i >> 1] >> 16) | (vr[i] & 0xffff0000u); }
                else { ke0[i >> 1] = __float_as_uint(kf0); ke1[i >> 1] = __float_as_uint(kf1); vt0[i >> 1] = vr[i] << 16; vt1[i >> 1] = vr[i] & 0xffff0000u; }
            }
            *(LAS u32x4*)(KE + sw128(2 * cp, 16 * sb)) = (u32x4){ke0[0], ke0[1], ke0[2], ke0[3]}; *(LAS u32x4*)(KE + sw128(2 * cp + 1, 16 * sb)) = (u32x4){ke1[0], ke1[1], ke1[2], ke1[3]};
            *(LAS u32x4*)(VT + sw128(2 * cp, 16 * sb)) = (u32x4){vt0[0], vt0[1], vt0[2], vt0[3]}; *(LAS u32x4*)(VT + sw128(2 * cp + 1, 16 * sb)) = (u32x4){vt1[0], vt1[1], vt1[2], vt1[3]};
        }
        if (c + 1 < 36) SC_LOAD_VQ(c + 1);
        __syncthreads();
        if (lat) {
#pragma unroll
            for (int rep = 0; rep < 2; ++rep) { const int ti = wid + 8 * rep; if (ti < 10) {
                const int I = ti < 1 ? 0 : (ti < 3 ? 1 : (ti < 6 ? 2 : 3)); const int Jt = ti - (I * (I + 1)) / 2; const int kbase = I == 0 ? 0 : (I == 1 ? 16 : (I == 2 ? 48 : 96));
                const int l15 = lane & 15, lq = lane >> 4; f32x4 a = {0.f, 0.f, 0.f, 0.f};
#pragma unroll
                for (int ks = 0; ks < 4; ++ks) { const bf16x8 av = *(const LAS bf16x8*)(QI + sw256(16 * I + l15, (32 * ks + 8 * lq) * 2)); const bf16x8 bv = *(const LAS bf16x8*)(KT + sw256(kbase + 16 * Jt + l15, (32 * ks + 8 * lq) * 2));
                    a = __builtin_amdgcn_mfma_f32_16x16x32_bf16(av, bv, a, 0, 0, 0); }
#pragma unroll
                for (int r = 0; r < 4; ++r) { const int tl = 4 * lq + r; float v = a[r]; if (I == Jt && l15 > tl) v = 0.f; *(LAS bf16_t*)(AT + sw128(16 * I + tl, (16 * Jt + l15) * 2)) = f2bf(v); } } }
        }
        __syncthreads();
        {
            if (lat) {
                f32x16 o = {};
#pragma unroll
                for (int ks = 0; ks < 8; ++ks) { const bf16x8 av = *(const LAS bf16x8*)(QG + sw256(32 * tb + r32, (16 * ks + 8 * hi) * 2)); const bf16x8 bv = *(const LAS bf16x8*)(SCp + sw256(32 * dvb + r32, (16 * ks + 8 * hi) * 2));
                    o = __builtin_amdgcn_mfma_f32_32x32x16_bf16(av, bv, o, 0, 0, 0); }
#pragma unroll
                for (int ks = 0; ks < 4; ++ks) { if (ks < 2 || tb == 1) { const bf16x8 av = *(const LAS bf16x8*)(AT + sw128(32 * tb + r32, (16 * ks + 8 * hi) * 2)); const bf16x8 bv = *(const LAS bf16x8*)(VT + sw128(32 * dvb + r32, (16 * ks + 8 * hi) * 2));
                    o = __builtin_amdgcn_mfma_f32_32x32x16_bf16(av, bv, o, 0, 0, 0); } }
                bf16_t* po = outp + (size_t)(grow_of(c * 64, b, dir) + sgn * (32 * tb + 4 * hi)) * D + h * 128 + 32 * dvb + r32;
#pragma unroll
                for (int r = 0; r < 16; ++r) po[(long)((r & 3) + 8 * (r >> 2)) * rstep] = f2bf(o[r]);
            }
#pragma unroll
            for (int r = 0; r < 16; ++r) { S0[r] *= DEC[64 * tb + crow(r, hi)]; S1[r] *= DEC[64 * tb + 32 + crow(r, hi)]; }
#pragma unroll
            for (int ks = 0; ks < 4; ++ks) { const bf16x8 bv = *(const LAS bf16x8*)(VT + sw128(32 * dvb + r32, (16 * ks + 8 * hi) * 2));
                const bf16x8 a0 = *(const LAS bf16x8*)(KE + sw128(64 * tb + r32, (16 * ks + 8 * hi) * 2)), a1 = *(const LAS bf16x8*)(KE + sw128(64 * tb + 32 + r32, (16 * ks + 8 * hi) * 2));
                S0 = __builtin_amdgcn_mfma_f32_32x32x16_bf16(a0, bv, S0, 0, 0, 0); S1 = __builtin_amdgcn_mfma_f32_32x32x16_bf16(a1, bv, S1, 0, 0, 0); }
        }
        __syncthreads();
#pragma unroll
        for (int g = 0; g < 4; ++g) { const int dv = 32 * dvb + r32; const int dk0 = 64 * tb + 8 * g + 4 * hi;
            u32x2 w0; w0.x = cvt_pk_bf16(S0[4 * g], S0[4 * g + 1]); w0.y = cvt_pk_bf16(S0[4 * g + 2], S0[4 * g + 3]); *(LAS u32x2*)(SCp + sw256(dv, dk0 * 2)) = w0;
            u32x2 w1; w1.x = cvt_pk_bf16(S1[4 * g], S1[4 * g + 1]); w1.y = cvt_pk_bf16(S1[4 * g + 2], S1[4 * g + 3]); *(LAS u32x2*)(SCp + sw256(dv, (dk0 + 32) * 2)) = w1; }
    }
    __syncthreads();
#undef SC_LOAD_Z
#undef SC_LOAD_VQ
}
}
__device__ __forceinline__ void phase_scan(const Params& p, LAS unsigned char* lds) {
    for (int u = blockIdx.x; u < 256; u += gridDim.x) sc::scan_unit(p, u, lds);
}

constexpr int LDS_BYTES = 155648;
template <int PH> __global__ void __launch_bounds__(512, 2) k_phase(Params p) {
    extern __shared__ __attribute__((aligned(16))) unsigned char smem[];
    LAS unsigned char* lds = (LAS unsigned char*)smem;
    if constexpr (PH == 0) phase0(p, lds);
    if constexpr (PH == 1) phase1(p, lds);
    if constexpr (PH == 2) phase2(p, lds);
    if constexpr (PH == 3) phase3(p, lds);
    if constexpr (PH == 4) phase4(p, lds);
    if constexpr (PH == 5) phase5(p, lds);
    if constexpr (PH == 6) phase6(p, lds);
    if constexpr (PH == 7) phase7(p, lds);
    if constexpr (PH == 8) phase8(p, lds);
    if constexpr (PH == 9) phase9(p, lds);
    if constexpr (PH == 10) phase_attn(p, lds);
    if constexpr (PH == 11) phase_scan(p, lds);
}

#include <cstdint>
#include <cstdlib>
#include <vector>

#define XB_TMO      128
#define XB_XCNT(j)  (256  + 64 * (j))
#define XB_XSUB(j)  (1280 + 64 * (j))
#define XB_XGEN(j)  (2304 + 64 * (j))
#define XB_TOP      3328
#define XB_TOPGEN   3392
#define XCD_BAR_WORDS 3456
#define XB_SPIN_CAP (1u << 18)

__device__ __forceinline__ unsigned xb_ld(unsigned* p)              { return __hip_atomic_load(p, __ATOMIC_RELAXED, __HIP_MEMORY_SCOPE_AGENT); }
__device__ __forceinline__ unsigned xb_add(unsigned* p, unsigned v) { return __hip_atomic_fetch_add(p, v, __ATOMIC_RELAXED, __HIP_MEMORY_SCOPE_AGENT); }
__device__ __forceinline__ unsigned xb_xcc_id() { return (unsigned)__builtin_amdgcn_s_getreg((3 << 11) | 20) & 0xFu; }
#define XB_SPIN(cond, bar) do { unsigned _sp = 0; while (cond) { __builtin_amdgcn_s_sleep(1); \
    if ((++_sp & 255u) == 0u) { if (xb_ld(&(bar)[XB_TMO])) break; if (_sp > XB_SPIN_CAP) { atomicAdd(&(bar)[XB_TMO], 1u); break; } } } } while (0)

struct XcdBarrier {
    unsigned* bar; unsigned x;
    volatile LAS unsigned* st;
};

__device__ __forceinline__ XcdBarrier xcd_barrier_post(unsigned* bar, volatile LAS unsigned* st) {
    XcdBarrier b; b.bar = bar; b.x = xb_xcc_id(); b.st = st;
    if (threadIdx.x == 0) (void)xb_add(&bar[XB_XCNT(b.x)], 1u);
    return b;
}
__device__ __forceinline__ void xcd_barrier_complete(unsigned* bar, unsigned x, unsigned& nloc, unsigned& nx) {
    const unsigned G = gridDim.x * gridDim.y * gridDim.z;
    unsigned sum, cnt, mine, sp = 0u;
    for (;;) {
        sum = 0u; cnt = 0u; mine = 0u;
#pragma unroll
        for (unsigned j = 0; j < 16; ++j) { const unsigned c = xb_ld(&bar[XB_XCNT(j)]); sum += c; cnt += (c > 0u) ? 1u : 0u; mine = (j == x) ? c : mine; }
        if (sum == G) break;
        __builtin_amdgcn_s_sleep(1);
        if ((++sp & 255u) == 0u) { if (xb_ld(&bar[XB_TMO])) break; if (sp > XB_SPIN_CAP) { atomicAdd(&bar[XB_TMO], 1u); break; } }
    }
    nloc = mine > 0u ? mine : 1u; nx = cnt > 0u ? cnt : 1u;
}

__device__ __forceinline__ void xcd_barrier(const XcdBarrier& b) {
    asm volatile("s_waitcnt vmcnt(0)" ::: "memory");
    __syncthreads();
    if (threadIdx.x == 0) {
        unsigned* bar = b.bar;
        __builtin_amdgcn_s_waitcnt(0);
        unsigned nloc = b.st[0], nx = b.st[1];
        if (nloc == 0u) { xcd_barrier_complete(bar, b.x, nloc, nx); b.st[0] = nloc; b.st[1] = nx; }
        const unsigned old = xb_add(&bar[XB_XSUB(b.x)], 1u);
        const unsigned gen = old / nloc;
        if (old + 1u == (gen + 1u) * nloc) {
            __builtin_amdgcn_fence(__ATOMIC_RELEASE, "agent");
            asm volatile("s_waitcnt vmcnt(0)" ::: "memory");
            const unsigned og = xb_add(&bar[XB_TOP], 1u);
            const unsigned tg = og / nx;
            if (og + 1u == (tg + 1u) * nx) xb_add(&bar[XB_TOPGEN], 1u);
            else XB_SPIN(xb_ld(&bar[XB_TOPGEN]) == tg, bar);
            __builtin_amdgcn_fence(__ATOMIC_ACQUIRE, "agent");
            xb_add(&bar[XB_XGEN(b.x)], 1u);
            asm volatile("s_waitcnt vmcnt(0)" ::: "memory");
        } else {
            XB_SPIN(xb_ld(&bar[XB_XGEN(b.x)]) == gen, bar);
            __builtin_amdgcn_fence(__ATOMIC_ACQUIRE, "agent");
            asm volatile("s_waitcnt vmcnt(0)" ::: "memory");
        }
    }
    __syncthreads();
}

__global__ void __launch_bounds__(512, 2) k_mega(Params p) {
    extern __shared__ __attribute__((aligned(16))) unsigned char smem[];
    LAS unsigned char* lds = (LAS unsigned char*)smem;
    volatile LAS unsigned* xbw = (volatile LAS unsigned*)(lds + LDS_BYTES - 16);
    if (threadIdx.x == 0) { xbw[0] = 0u; xbw[1] = 0u; xbw[2] = 0u; xbw[3] = 0u; }
    __syncthreads();
    XcdBarrier bar = xcd_barrier_post((unsigned*)(p.ws + OFF_BAR), xbw);
    phase0(p, lds);      xcd_barrier(bar);
    phase1(p, lds);      xcd_barrier(bar);
    phase2(p, lds);      xcd_barrier(bar);
    phase3(p, lds);      xcd_barrier(bar);
    phase_attn(p, lds);
    phase_scan(p, lds);  xcd_barrier(bar);
    phase4(p, lds);      xcd_barrier(bar);
    phase5(p, lds);      xcd_barrier(bar);
    phase6(p, lds);      xcd_barrier(bar);
    phase7(p, lds);      xcd_barrier(bar);
    phase8(p, lds);      xcd_barrier(bar);
    phase9(p, lds);
}
extern "C" void kernel_launch(void* const* d_in, const int* in_sizes, int n_in, void* d_out, int out_size, void* d_ws, size_t ws_size, hipStream_t stream) {
    static int grid = 0;
    if (grid == 0) {
        int dev = 0, cus = 0, per_cu = 0;
        if (hipGetDevice(&dev) != hipSuccess || hipDeviceGetAttribute(&cus, hipDeviceAttributeMultiprocessorCount, dev) != hipSuccess) { grid = -1; return; }
        if (hipFuncSetAttribute((const void*)k_mega, hipFuncAttributeMaxDynamicSharedMemorySize, LDS_BYTES) != hipSuccess) { grid = -1; return; }
        (void)hipOccupancyMaxActiveBlocksPerMultiprocessor(&per_cu, (const void*)k_mega, 512, LDS_BYTES);
        (void)hipGetLastError();
        grid = cus;
    }
    if (grid < 0) return;
    Params p{};
    p.x = (const float*)d_in[0]; p.c = (const float*)d_in[1]; p.ctx = (const float*)d_in[2]; p.cctx = (const float*)d_in[3]; p.w_mod = (const float*)d_in[4]; p.b_mod = (const float*)d_in[5];
    p.g_mix = (const float*)d_in[6]; p.w_in = (const float*)d_in[7]; p.g_q = (const float*)d_in[8]; p.w_qb = (const float*)d_in[9]; p.g_kv = (const float*)d_in[10]; p.w_kvb = (const float*)d_in[11];
    p.lbl = (const float*)d_in[12]; p.g_hg = (const float*)d_in[13]; p.w_out = (const float*)d_in[14]; p.g_ffn = (const float*)d_in[15]; p.w_r = (const float*)d_in[16]; p.b_r = (const float*)d_in[17];
    p.w_gu = (const float*)d_in[18]; p.b_gu = (const float*)d_in[19]; p.w_dn = (const float*)d_in[20]; p.b_dn = (const float*)d_in[21]; p.g_fin = (const float*)d_in[22];
    p.out = (float*)d_out; p.ws = (char*)d_ws;
    (void)hipMemsetAsync((char*)d_ws + OFF_BAR, 0, 16384, stream);
    hipLaunchKernelGGL(k_mega, dim3(grid), dim3(512), LDS_BYTES, stream, p);
}
```

```cpp
#include <hip/hip_runtime.h>
#include <stdint.h>

typedef unsigned short bf16_t;
__device__ __forceinline__ float bf2f(bf16_t v) { return __uint_as_float(((unsigned)v) << 16); }
__device__ __forceinline__ bf16_t f2bf(float f) { unsigned u = __float_as_uint(f); u += 0x7FFFu + ((u >> 16) & 1u); return (bf16_t)(u >> 16); }
__device__ __forceinline__ float sigmoidf_(float x) { return __builtin_amdgcn_rcpf(1.0f + __builtin_amdgcn_exp2f(-1.4426950408889634f * x)); }
__device__ __forceinline__ float siluf_(float x) { return x * __builtin_amdgcn_rcpf(1.0f + __builtin_amdgcn_exp2f(-1.4426950408889634f * x)); }

constexpr int D = 1024, NB = 16, SEQ = 2048, CTXL = 256;
constexpr int L = NB * SEQ;
constexpr int RC = NB * CTXL;
constexpr int R = L + RC;
constexpr int NKEY = SEQ + CTXL;
constexpr float EPS = 1e-6f;
constexpr int NE = 32, CAP = 32768;
constexpr int MAXROWS = 131072 + NE * 256;

constexpr size_t MiB = 1048576;
constexpr size_t OFF_SMALL = 0;
constexpr size_t OFF_BAR = 0;
constexpr size_t OFF_CNT = 16384;
constexpr size_t OFF_OFFS = 16384 + 1024;
constexpr size_t OFF_TILEE = 16384 + 2048;
constexpr size_t OFF_LB = 24576;
constexpr size_t OFF_MOD = 32768;
constexpr size_t OFF_SSQQ = 512 * 1024;
constexpr size_t OFF_SSQKV = 768 * 1024;
constexpr size_t OFF_TOPI = 1 * MiB;
constexpr size_t OFF_TOPP = 1 * MiB + 512 * 1024;
constexpr size_t OFF_ROWPAIR = 2 * MiB;
constexpr size_t OFF_LIST = 3 * MiB;
constexpr size_t OFF_H = 32 * MiB;
constexpr size_t OFF_QA = 104 * MiB;
constexpr size_t OFF_CKV = 152 * MiB;
constexpr size_t OFF_KR = 170 * MiB;
constexpr size_t OFF_OF = 104 * MiB;
constexpr size_t OFF_HQ = 175 * MiB;
constexpr size_t SEG_STRIDE = 72 * MiB;
constexpr size_t OFF_FF = OFF_HQ + 1 * SEG_STRIDE;
constexpr size_t OFF_FB = OFF_HQ + 2 * SEG_STRIDE;
constexpr size_t OFF_IV = OFF_HQ + 3 * SEG_STRIDE;
constexpr size_t OFF_OG = OFF_HQ + 4 * SEG_STRIDE;
constexpr size_t OFF_GM = OFF_HQ + 5 * SEG_STRIDE;
constexpr size_t OFF_GH = OFF_HQ + 6 * SEG_STRIDE;
constexpr size_t OFF_Q = 679 * MiB;
constexpr size_t OFF_K = 775 * MiB;
constexpr size_t OFF_V = 883 * MiB;
constexpr size_t OFF_OB = 955 * MiB;
constexpr size_t OFF_YP = 296 * MiB;
constexpr size_t OFF_ACT = 568 * MiB;

struct SegOut { bf16_t *qa, *ckv, *kr, *hq, *ff, *fb, *iv, *og, *gm, *gh; };

__global__ void k_init(const float* __restrict__ lbl, float* lb, int* cnt) {
    int i = blockIdx.x * blockDim.x + threadIdx.x;
    if (i < 2048) { int d = i >> 10, j = i & 1023; float a = lbl[(d * 2 + 0) * 1024 + j], b = lbl[(d * 2 + 1) * 1024 + j]; lb[i] = 1.0f / (1.0f + __expf(b - a)); }
    if (i < 32) cnt[i] = 0;
}

__global__ __launch_bounds__(256) void k_mod(const float* __restrict__ c, const float* __restrict__ cctx, const float* __restrict__ wmod, const float* __restrict__ bmod, float* modv) {
    __shared__ float s[1024];
    int r = blockIdx.y; const float* src = r < 16 ? c + r * 1024 : cctx;
    for (int k = threadIdx.x; k < 1024; k += 256) s[k] = siluf_(src[k]);
    __syncthreads();
    int j = blockIdx.x * 256 + threadIdx.x; float acc = 0.f;
    for (int k = 0; k < 1024; ++k) acc += s[k] * wmod[(size_t)k * 6144 + j];
    modv[r * 6144 + j] = acc + bmod[j];
}

__device__ __forceinline__ float block_sum256(float v, float* red) {
    for (int o = 32; o > 0; o >>= 1) v += __shfl_xor(v, o);
    int w = threadIdx.x >> 6; if ((threadIdx.x & 63) == 0) red[w] = v; __syncthreads();
    float t = red[0] + red[1] + red[2] + red[3]; __syncthreads(); return t;
}

__global__ __launch_bounds__(256) void k_norm1(const float* __restrict__ x, const float* __restrict__ ctx, const float* __restrict__ g, const float* __restrict__ modv, bf16_t* h) {
    __shared__ float red[4];
    int row = blockIdx.x; const float* src = row < L ? x + (size_t)row * D : ctx + (size_t)(row - L) * D;
    const float* mod = modv + (row < L ? row / SEQ : 16) * 6144;
    int c = threadIdx.x * 4; float4 v = *(const float4*)(src + c);
    float ss = block_sum256(v.x * v.x + v.y * v.y + v.z * v.z + v.w * v.w, red);
    float rs = rsqrtf(ss * (1.0f / D) + EPS);
    float o[4] = {v.x, v.y, v.z, v.w}; ushort4 w; bf16_t* wp = (bf16_t*)&w;
    for (int i = 0; i < 4; ++i) wp[i] = f2bf(o[i] * rs * g[c + i] * (1.0f + mod[1024 + c + i]) + mod[c + i]);
    *(ushort4*)(h + (size_t)row * D + c) = w;
}

__global__ __launch_bounds__(256) void k_rowssq(const bf16_t* __restrict__ buf, int width, int nrows, float* ssq) {
    int row = blockIdx.x * 4 + (threadIdx.x >> 6), lane = threadIdx.x & 63; if (row >= nrows) return;
    float s = 0.f; for (int k = lane; k < width; k += 64) { float v = bf2f(buf[(size_t)row * width + k]); s += v * v; }
    for (int o = 32; o > 0; o >>= 1) s += __shfl_xor(s, o);
    if (lane == 0) ssq[row] = s;
}

__device__ __forceinline__ void rope_cs(int t, int i, float& cs, float& sn) {
    int j = i & 15; float inv = __expf(-(float)j * (9.210340371976184f / 16.0f)); float pos = (i < 16) ? (float)(t >> 6) : (float)(t & 63);
    float ang = pos * inv; cs = cosf(ang); sn = sinf(ang);
}

__global__ __launch_bounds__(256) void k_krope(const bf16_t* __restrict__ kr, bf16_t* Kb) {
    int gid = blockIdx.x * 256 + threadIdx.x; int row = gid >> 5, i = gid & 31; if (row >= R) return;
    float x1 = bf2f(kr[(size_t)row * 64 + i]), x2 = bf2f(kr[(size_t)row * 64 + 32 + i]); float o1 = x1, o2 = x2; int b, pos;
    if (row < L) { b = row / SEQ; pos = row % SEQ; float cs, sn; rope_cs(pos, i, cs, sn); o1 = x1 * cs - x2 * sn; o2 = x1 * sn + x2 * cs; }
    else { b = (row - L) / CTXL; pos = SEQ + (row - L) % CTXL; }
    bf16_t w1 = f2bf(o1), w2 = f2bf(o2);
    for (int h = 0; h < 8; ++h) { bf16_t* p = Kb + ((size_t)(b * 8 + h) * NKEY + pos) * 192 + 128; p[i] = w1; p[32 + i] = w2; }
}

template <class AL, class EP>
__global__ __launch_bounds__(256) void k_ngemm(int K, const float* __restrict__ W, int ldw, size_t wzstride, AL al, EP ep) {
    __shared__ float As[16][68]; __shared__ float Bs[16][64];
    const int z = blockIdx.z, row0 = blockIdx.y * 64, col0 = blockIdx.x * 64, tid = threadIdx.x;
    const int mvalid = al.rows(z); if (row0 >= mvalid) return;
    const float* Wz = W + (size_t)z * wzstride;
    const int ar = tid >> 2, ak = (tid & 3) * 4; const bf16_t* arow = (row0 + ar < mvalid) ? al.rowptr(z, row0 + ar) : nullptr;
    const int bk = tid >> 4, bn = (tid & 15) * 4;
    const int ty = tid >> 4, tx = tid & 15;
    float acc[4][4] = {};
    for (int k0 = 0; k0 < K; k0 += 16) {
        float a4[4] = {0.f, 0.f, 0.f, 0.f};
        if (arow) { ushort4 u = *(const ushort4*)(arow + k0 + ak); const bf16_t* up = (const bf16_t*)&u; for (int i = 0; i < 4; ++i) a4[i] = bf2f(up[i]) * al.kscale(k0 + ak + i); }
        float4 b4 = *(const float4*)(Wz + (size_t)(k0 + bk) * ldw + col0 + bn);
        __syncthreads();
        for (int i = 0; i < 4; ++i) As[ak + i][ar] = a4[i];
        *(float4*)&Bs[bk][bn] = b4;
        __syncthreads();
#pragma unroll
        for (int kk = 0; kk < 16; ++kk) {
            float4 av = *(const float4*)&As[kk][ty * 4]; float4 bv = *(const float4*)&Bs[kk][tx * 4];
            float a[4] = {av.x, av.y, av.z, av.w}, b[4] = {bv.x, bv.y, bv.z, bv.w};
#pragma unroll
            for (int i = 0; i < 4; ++i)
#pragma unroll
                for (int j = 0; j < 4; ++j) acc[i][j] += a[i] * b[j];
        }
    }
    for (int i = 0; i < 4; ++i) { int row = row0 + ty * 4 + i; if (row < mvalid) ep.store(z, row, col0 + tx * 4, acc[i]); }
}

__device__ __forceinline__ void st4bf(bf16_t* dst, const float* v) { ushort4 w; bf16_t* wp = (bf16_t*)&w; for (int i = 0; i < 4; ++i) wp[i] = f2bf(v[i]); *(ushort4*)dst = w; }

struct ALDense { const bf16_t* A; int lda; int nrows; const float* ks;
    __device__ int rows(int) const { return nrows; }
    __device__ const bf16_t* rowptr(int, int row) const { return A + (size_t)row * lda; }
    __device__ float kscale(int k) const { return ks ? ks[k] : 1.0f; } };

struct EpiInN { SegOut s;
    __device__ void store(int, int row, int col, const float* v) const {
        bf16_t* dst;
        if (col < 768) { if (row >= L) return; dst = s.qa + (size_t)row * 768 + col; }
        else if (col < 1024) dst = s.ckv + (size_t)row * 256 + (col - 768);
        else if (col < 1088) dst = s.kr + (size_t)row * 64 + (col - 1024);
        else { int c = col - 1088, seg = c >> 10, cc = c & 1023; bool latonly = (seg == 0 || seg >= 4); if (latonly && row >= L) return;
            bf16_t* base = seg == 0 ? s.hq : seg == 1 ? s.ff : seg == 2 ? s.fb : seg == 3 ? s.iv : seg == 4 ? s.og : seg == 5 ? s.gm : s.gh;
            dst = base + (size_t)row * 1024 + cc; }
        st4bf(dst, v);
    } };

struct EpiQN { bf16_t* q; const float* ssq;
    __device__ void store(int, int row, int col, const float* v) const { float rs = rsqrtf(ssq[row] * (1.0f / 768.0f) + EPS); float o[4]; for (int i = 0; i < 4; ++i) o[i] = v[i] * rs; st4bf(q + (size_t)row * 1536 + col, o); } };

struct EpiKVN { bf16_t *Kb, *Vb; const float* ssq;
    __device__ void store(int, int row, int col, const float* v) const {
        float rs = rsqrtf(ssq[row] * (1.0f / 256.0f) + EPS); float o[4]; for (int i = 0; i < 4; ++i) o[i] = v[i] * rs;
        int b, pos; if (row < L) { b = row / SEQ; pos = row % SEQ; } else { b = (row - L) / CTXL; pos = SEQ + (row - L) % CTXL; }
        int h = col >> 8, w = col & 255; size_t kvrow = (size_t)(b * 8 + h) * NKEY + pos;
        if (w < 128) st4bf(Kb + kvrow * 192 + w, o); else st4bf(Vb + kvrow * 128 + (w - 128), o);
    } };

struct EpiOutN { float* x1; const float* x; const float* modv;
    __device__ void store(int, int row, int col, const float* v) const {
        const float* gate = modv + (row / SEQ) * 6144 + 2 * 1024; float4 xv = *(const float4*)(x + (size_t)row * D + col);
        float4 o; o.x = xv.x + gate[col] * v[0]; o.y = xv.y + gate[col + 1] * v[1]; o.z = xv.z + gate[col + 2] * v[2]; o.w = xv.w + gate[col + 3] * v[3];
        *(float4*)(x1 + (size_t)row * D + col) = o;
    } };

struct ALMoe1 { const bf16_t* h2; const int* cnt; const int* list;
    __device__ int rows(int z) const { return cnt[z]; }
    __device__ const bf16_t* rowptr(int z, int row) const { return h2 + (size_t)(list[z * CAP + row] >> 2) * D; }
    __device__ float kscale(int) const { return 1.0f; } };
struct EpiMoe1N { bf16_t* act; const int* offs; const float* bgu;
    __device__ void store(int z, int row, int col, const float* v) const {
        const float* bb = bgu + z * 2048 + col; ushort2 w; bf16_t* wp = (bf16_t*)&w;
        for (int p = 0; p < 2; ++p) { float glu = fminf(v[2 * p] + bb[2 * p], 7.0f); float lin = fminf(fmaxf(v[2 * p + 1] + bb[2 * p + 1], -7.0f), 7.0f);
            wp[p] = f2bf(glu * sigmoidf_(1.702f * glu) * (lin + 1.0f)); }
        *(ushort2*)(act + (size_t)(offs[z] + row) * D + (col >> 1)) = w;
    } };
struct ALMoe2 { const bf16_t* act; const int* cnt; const int* offs;
    __device__ int rows(int z) const { return cnt[z]; }
    __device__ const bf16_t* rowptr(int z, int row) const { return act + (size_t)(offs[z] + row) * D; }
    __device__ float kscale(int) const { return 1.0f; } };
struct EpiMoe2N { bf16_t* yp; const int* list; const float* bd;
    __device__ void store(int z, int row, int col, const float* v) const {
        int pair = list[z * CAP + row]; const float* bb = bd + z * 1024 + col; float o[4]; for (int i = 0; i < 4; ++i) o[i] = v[i] + bb[i];
        st4bf(yp + (size_t)pair * D + col, o);
    } };

__global__ __launch_bounds__(256) void k_nattn(const bf16_t* __restrict__ Q, const bf16_t* __restrict__ Kb, const bf16_t* __restrict__ Vb, bf16_t* Y) {
    __shared__ float qs[4][192]; __shared__ float sc[4][NKEY];
    const int tid = threadIdx.x, blk = blockIdx.x, qg = blk & 511, h = (blk >> 9) & 7, b = blk >> 12;
    for (int idx = tid; idx < 4 * 192; idx += 256) { int qi = idx / 192, d = idx % 192; int row = b * SEQ + qg * 4 + qi; qs[qi][d] = bf2f(Q[(size_t)row * 1536 + h * 192 + d]); }
    __syncthreads();
    float n1 = 0.f, n2 = 0.f;
    if (tid < 128) { int qi = tid >> 5, i = tid & 31; int t = qg * 4 + qi; float cs, sn; rope_cs(t, i, cs, sn); float x1 = qs[qi][128 + i], x2 = qs[qi][160 + i]; n1 = x1 * cs - x2 * sn; n2 = x1 * sn + x2 * cs; }
    __syncthreads();
    if (tid < 128) { int qi = tid >> 5, i = tid & 31; qs[qi][128 + i] = n1; qs[qi][160 + i] = n2; }
    __syncthreads();
    const bf16_t* Kp = Kb + (size_t)(b * 8 + h) * NKEY * 192; const bf16_t* Vp = Vb + (size_t)(b * 8 + h) * NKEY * 128;
    const float scale = 0.07216878364870322f;
    for (int key = tid; key < NKEY; key += 256) {
        const bf16_t* kr = Kp + (size_t)key * 192; float s0 = 0.f, s1 = 0.f, s2 = 0.f, s3 = 0.f;
        for (int d = 0; d < 192; d += 8) { uint4 u = *(const uint4*)(kr + d); const bf16_t* up = (const bf16_t*)&u;
            for (int j = 0; j < 8; ++j) { float kv = bf2f(up[j]); s0 += qs[0][d + j] * kv; s1 += qs[1][d + j] * kv; s2 += qs[2][d + j] * kv; s3 += qs[3][d + j] * kv; } }
        sc[0][key] = s0 * scale; sc[1][key] = s1 * scale; sc[2][key] = s2 * scale; sc[3][key] = s3 * scale;
    }
    __syncthreads();
    { int w = tid >> 6, lane = tid & 63; float m = -1e30f; for (int k = lane; k < NKEY; k += 64) m = fmaxf(m, sc[w][k]);
      for (int o = 32; o > 0; o >>= 1) m = fmaxf(m, __shfl_xor(m, o));
      float s = 0.f; for (int k = lane; k < NKEY; k += 64) { float e = __expf(sc[w][k] - m); sc[w][k] = e; s += e; }
      for (int o = 32; o > 0; o >>= 1) s += __shfl_xor(s, o);
      float inv = 1.0f / s; for (int k = lane; k < NKEY; k += 64) sc[w][k] *= inv; }
    __syncthreads();
    { int dv = tid & 127, qh = tid >> 7; float o0 = 0.f, o1 = 0.f;
      for (int k = 0; k < NKEY; ++k) { float v = bf2f(Vp[(size_t)k * 128 + dv]); o0 += sc[qh * 2][k] * v; o1 += sc[qh * 2 + 1][k] * v; }
      int row = b * SEQ + qg * 4 + qh * 2; Y[(size_t)row * D + h * 128 + dv] = f2bf(o0); Y[(size_t)(row + 1) * D + h * 128 + dv] = f2bf(o1); }
}

__global__ __launch_bounds__(256) void k_nscan(const bf16_t* __restrict__ hq, const bf16_t* __restrict__ ff, const bf16_t* __restrict__ fb, const bf16_t* __restrict__ iv, const float* __restrict__ lb, bf16_t* of, bf16_t* ob) {
    __shared__ float sf[128], sk[128], sq[128], so[2][128];
    const int tid = threadIdx.x, blk = blockIdx.x, dir = blk & 1, h = (blk >> 1) & 7, b = blk >> 4;
    const bf16_t* fz = dir ? fb : ff; bf16_t* out = dir ? ob : of;
    const int dv = tid & 127, half = tid >> 7;
    float S[64];
#pragma unroll
    for (int j = 0; j < 64; ++j) S[j] = 0.f;
    const float lbv = lb[dir * 1024 + h * 128 + (tid & 127)];
    for (int step = 0; step < NKEY; ++step) {
        int row; bool islat;
        if (step < CTXL) { int s = dir ? (CTXL - 1 - step) : step; row = L + b * CTXL + s; islat = false; }
        else { int t = step - CTXL; t = dir ? (SEQ - 1 - t) : t; row = b * SEQ + t; islat = true; }
        if (tid < 128) { float z = bf2f(fz[(size_t)row * D + h * 128 + tid]); float f = lbv + (1.0f - lbv) * sigmoidf_(z); sf[tid] = f; sk[tid] = 1.0f - f;
            if (islat) { float zq = bf2f(hq[(size_t)row * D + h * 128 + tid]); sq[tid] = siluf_(zq) * 0.08838834764831845f; } }
        float v = bf2f(iv[(size_t)row * D + h * 128 + dv]);
        __syncthreads();
        float o = 0.f;
#pragma unroll
        for (int j = 0; j < 64; ++j) { int dk = half * 64 + j; S[j] = sf[dk] * S[j] + sk[dk] * v; o += S[j] * sq[dk]; }
        if (islat) so[half][dv] = o;
        __syncthreads();
        if (islat && half == 0) out[(size_t)row * D + h * 128 + dv] = f2bf(so[0][dv] + so[1][dv]);
    }
}

__global__ __launch_bounds__(256) void k_merge(bf16_t* y, const bf16_t* __restrict__ of, const bf16_t* __restrict__ ob, const bf16_t* __restrict__ og, const bf16_t* __restrict__ gm, const bf16_t* __restrict__ gh, const float* __restrict__ ghg) {
    int row = blockIdx.x, c = threadIdx.x * 4; size_t off = (size_t)row * D + c;
    ushort4 a = *(const ushort4*)(of + off), bb = *(const ushort4*)(ob + off), g1 = *(const ushort4*)(og + off), g2 = *(const ushort4*)(gm + off), g3 = *(const ushort4*)(gh + off), ym = *(const ushort4*)(y + off);
    const bf16_t *ap = (const bf16_t*)&a, *bp = (const bf16_t*)&bb, *p1 = (const bf16_t*)&g1, *p2 = (const bf16_t*)&g2, *p3 = (const bf16_t*)&g3, *pm = (const bf16_t*)&ym;
    float o[4], ss = 0.f; for (int i = 0; i < 4; ++i) { o[i] = bf2f(ap[i]) + bf2f(bp[i]); ss += o[i] * o[i]; }
    for (int m = 16; m > 0; m >>= 1) ss += __shfl_xor(ss, m);
    float rs = rsqrtf(ss * (1.0f / 128.0f) + EPS); float r[4];
    for (int i = 0; i < 4; ++i) { float yh = o[i] * rs * ghg[(c + i) & 127] * siluf_(bf2f(p1[i])); r[i] = sigmoidf_(bf2f(p2[i])) * bf2f(pm[i]) + sigmoidf_(bf2f(p3[i])) * yh; }
    st4bf(y + off, r);
}

__global__ __launch_bounds__(256) void k_norm2_router(const float* __restrict__ x1, const float* __restrict__ g, const float* __restrict__ modv, const float* __restrict__ wr, const float* __restrict__ br, bf16_t* h2, int* topi, float* topp, int* cnt, int* list) {
    __shared__ float red[4]; __shared__ float hs[1024]; __shared__ float part[8][32];
    int row = blockIdx.x, tid = threadIdx.x, c = tid * 4; const float* mod = modv + (row / SEQ) * 6144;
    float4 v = *(const float4*)(x1 + (size_t)row * D + c);
    float ss = block_sum256(v.x * v.x + v.y * v.y + v.z * v.z + v.w * v.w, red); float rs = rsqrtf(ss * (1.0f / D) + EPS);
    float xv[4] = {v.x, v.y, v.z, v.w}, o[4];
    for (int i = 0; i < 4; ++i) { o[i] = xv[i] * rs * g[c + i] * (1.0f + mod[4 * 1024 + c + i]) + mod[3 * 1024 + c + i]; hs[c + i] = o[i]; }
    st4bf(h2 + (size_t)row * D + c, o);
    __syncthreads();
    { int e = tid & 31, p = tid >> 5; float a = 0.f; for (int j = p * 128; j < p * 128 + 128; ++j) a += hs[j] * wr[j * 32 + e]; part[p][e] = a; }
    __syncthreads();
    if (tid < 64) {
        int e = tid & 31; float cur = br[e];
#pragma unroll
        for (int p = 0; p < 8; ++p) cur += part[p][e];
        float tv0 = 0.f, sum = 0.f; float myp = 0.f; int myk = -1;
        int sel_i[4]; float sel_e[4];
#pragma unroll
        for (int k = 0; k < 4; ++k) {
            float m = cur; int mi = e;
#pragma unroll
            for (int o = 16; o > 0; o >>= 1) { float om = __shfl_xor(m, o); int oi = __shfl_xor(mi, o); if (om > m || (om == m && oi < mi)) { m = om; mi = oi; } }
            if (k == 0) tv0 = m;
            sel_i[k] = mi; sel_e[k] = __expf(m - tv0); sum += sel_e[k];
            if (e == mi) cur = -3.0e38f;
        }
#pragma unroll
        for (int k = 0; k < 4; ++k) if (tid == k) { myk = sel_i[k]; myp = sel_e[k] / sum; }
        if (tid < 4) { int pair = row * 4 + tid; topi[pair] = myk; topp[pair] = myp; int pos = atomicAdd(&cnt[myk], 1); list[myk * CAP + pos] = pair; }
    }
}

__global__ void k_moe_offs(const int* cnt, int* offs, int* tilee) {
    if (threadIdx.x == 0 && blockIdx.x == 0) { int o = 0, t = 0; for (int e = 0; e < NE; ++e) { offs[e] = o; int nt = (cnt[e] + 255) >> 8; for (int i = 0; i < nt; ++i) tilee[t++] = e; o += nt * 256; } offs[NE] = o; offs[NE + 1] = t; }
}

__global__ __launch_bounds__(256) void k_final(float* out, const bf16_t* __restrict__ yp, const float* __restrict__ topp, const float* __restrict__ modv, const float* __restrict__ fg) {
    __shared__ float red[4];
    int row = blockIdx.x, c = threadIdx.x * 4; const float* gate = modv + (row / SEQ) * 6144 + 5 * 1024;
    float4 v = *(const float4*)(out + (size_t)row * D + c); float xv[4] = {v.x, v.y, v.z, v.w}; float m[4] = {0.f, 0.f, 0.f, 0.f};
    for (int k = 0; k < 4; ++k) { float p = topp[row * 4 + k]; ushort4 u = *(const ushort4*)(yp + (size_t)(row * 4 + k) * D + c); const bf16_t* up = (const bf16_t*)&u; for (int i = 0; i < 4; ++i) m[i] += p * bf2f(up[i]); }
    float ss = 0.f; for (int i = 0; i < 4; ++i) { xv[i] += gate[c + i] * m[i]; ss += xv[i] * xv[i]; }
    ss = block_sum256(ss, red); float rs = rsqrtf(ss * (1.0f / D) + EPS);
    float4 o; o.x = xv[0] * rs * fg[c]; o.y = xv[1] * rs * fg[c + 1]; o.z = xv[2] * rs * fg[c + 2]; o.w = xv[3] * rs * fg[c + 3];
    *(float4*)(out + (size_t)row * D + c) = o;
}

#define LAS __attribute__((address_space(3)))
__device__ __forceinline__ int otid() { int t = threadIdx.x; asm volatile("" : "+v"(t)); return t; }
typedef short bf16x8 __attribute__((ext_vector_type(8)));
typedef float f32x4 __attribute__((ext_vector_type(4)));
typedef unsigned u32x4 __attribute__((ext_vector_type(4)));
typedef unsigned u32x2 __attribute__((ext_vector_type(2)));
typedef float f32x2 __attribute__((ext_vector_type(2)));

constexpr size_t OFF_ROPE = 7 * MiB;
constexpr size_t OFF_WT_IN = 8 * MiB;
constexpr size_t OFF_WT_QB = 25 * MiB;
constexpr size_t OFF_WT_KVB = 28 * MiB;
constexpr size_t OFF_WT_OUT = 29 * MiB;
constexpr size_t OFF_WT_GU = 104 * MiB;
constexpr size_t OFF_WT_DN = 232 * MiB;
constexpr size_t OFF_X1 = 704 * MiB;

struct Params {
    const float *x, *c, *ctx, *cctx, *w_mod, *b_mod, *g_mix, *w_in, *g_q, *w_qb, *g_kv, *w_kvb, *lbl, *g_hg, *w_out, *g_ffn, *w_r, *b_r, *w_gu, *b_gu, *w_dn, *b_dn, *g_fin;
    float* out; char* ws;
};

typedef __bf16 bf16v2_t __attribute__((ext_vector_type(2)));
__device__ __forceinline__ unsigned cvt_pk_bf16(float lo, float hi) { bf16v2_t v = {(__bf16)lo, (__bf16)hi}; return __builtin_bit_cast(unsigned, v); }

__device__ __forceinline__ unsigned pack4_fp8(float a, float b, float c, float d) {
    a = __builtin_amdgcn_fmed3f(a, -448.f, 448.f); b = __builtin_amdgcn_fmed3f(b, -448.f, 448.f); c = __builtin_amdgcn_fmed3f(c, -448.f, 448.f); d = __builtin_amdgcn_fmed3f(d, -448.f, 448.f);
    unsigned w = 0; w = __builtin_amdgcn_cvt_pk_fp8_f32(a, b, w, false); w = __builtin_amdgcn_cvt_pk_fp8_f32(c, d, w, true); return w; }

namespace pg8 {
constexpr int BM = 256, BK = 64, HALF = 128, HTB = HALF * BK * 2, STAGE_BYTES = 8 * HTB, NXCD = 8, WGM = 8;
constexpr int LDS_IDX = STAGE_BYTES + 8192;
__device__ __forceinline__ int lds_byte(int r, int c) { const int st = (r >> 4) * 2 + (c >> 5), rr = r & 15, cc = c & 31, ob = rr * 64 + cc * 2; return st * 1024 + (ob ^ (((ob >> 9) & 1) << 5)); }
__device__ __forceinline__ void stage_rc(int b, int& R, int& C) { const int st = b / 1024, sb = b % 1024, swz = sb ^ (((sb >> 9) & 1) << 5); R = (st >> 1) * 16 + swz / 64; C = (st & 1) * 32 + (swz % 64) / 2; }
__device__ __forceinline__ int perm32(int rho) { const int n = rho >> 4, i = rho & 15; return 8 * (i >> 2) + 4 * n + (i & 3); }
struct Unit { int pm, pn; const char* b; int e, pos0, cnt; };

__device__ __forceinline__ int xcd_remap(int L, int nwg) { const int q = nwg / NXCD, r = nwg % NXCD, xcd = L % NXCD, off = L / NXCD; return (xcd < r ? xcd * (q + 1) : r * (q + 1) + (xcd - r) * q) + off; }

struct DenseSched {
    int nM, nN, nwg, G, c, rowb; const char* Bt; size_t btile;
    __device__ void init(int M, int N, int kbytes, int rowb_, const void* Bt_, int G_, int c_) { nM = M / BM; nN = N / BM; nwg = nM * nN; G = G_; c = c_; rowb = rowb_; Bt = (const char*)Bt_; btile = (size_t)BM * kbytes; }
    static constexpr bool GATHER_LDS = false;
    __device__ __forceinline__ int kstepA() const { return 128; }
    __device__ __forceinline__ void tile(int wgid, int& pm, int& pn) const { const int nig = WGM * nN, gid = wgid / nig, fm = gid * WGM, gsz = (nM - fm) < WGM ? (nM - fm) : WGM; pm = fm + ((wgid % nig) % gsz); pn = (wgid % nig) / gsz; }
    __device__ __forceinline__ bool next(int i, Unit& u) const { const int Lx = i * G + c; if (Lx >= nwg) return false; tile(xcd_remap(Lx, nwg), u.pm, u.pn); u.b = Bt + (size_t)u.pn * btile; u.e = 0; u.pos0 = 0; u.cnt = 0; return true; }
    __device__ __forceinline__ void aoff(const Unit& u, const int (&Rr)[2], const int (&Cc)[2], unsigned (&va)[2][2]) const {
#pragma unroll
        for (int h = 0; h < 2; ++h)
#pragma unroll
            for (int i = 0; i < 2; ++i) va[h][i] = (unsigned)((u.pm * BM + h * HALF + Rr[i]) * rowb + Cc[i] * 2); }
};
struct InSched : DenseSched {
    __device__ void init2(const void* Bt_, int G_, int c_) { init(L, 8448, 1024, 1024, Bt_, G_, c_); }
    __device__ __forceinline__ bool next(int i, Unit& u) const {
        const int Lx = i * G + c; const int nlat = nwg;
        if (Lx < nlat) { tile(xcd_remap(Lx, nlat), u.pm, u.pn); }
        else { const int j = Lx - nlat; if (j >= 16 * 14) return false; const int q = j >> 4; u.pm = 128 + (j & 15); u.pn = q == 0 ? 3 : (q <= 12 ? 7 + q : 32); }
        u.b = Bt + (size_t)u.pn * btile; u.e = 0; u.pos0 = 0; u.cnt = 0; return true; }
};
__device__ __forceinline__ unsigned act_piece_off(int r, int c16) { const int s = 2 * (r >> 7) + (c16 >> 2), w = 4 * ((r >> 6) & 1) + (c16 & 3), l = 16 * ((r >> 4) & 3) + (r & 15); return (unsigned)(((s * 8 + w) * 64 + l) * 16); }
template <bool GATHER> struct MoeSched {
    int nN, G, c, rowb; const char* Wt; size_t wexp, btile; const LAS int* tab; const int* list;
    static constexpr bool GATHER_LDS = GATHER;
    __device__ __forceinline__ int kstepA() const { return GATHER ? 128 : 32768; }
    __device__ __forceinline__ bool next(int i, Unit& u) const {
        const int nwg = tab[33] * nN; const int Lx = i * G + c; if (Lx >= nwg) return false;
        const int w = xcd_remap(Lx, nwg); const int rt = w / nN; u.pn = w % nN; u.pm = rt;
        const int e = tab[128 + rt];
        u.e = e; u.pos0 = (rt - tab[e]) * BM; u.cnt = tab[64 + e]; u.b = Wt + (size_t)e * wexp + (size_t)u.pn * btile; return true; }
    __device__ __forceinline__ void aoff(const Unit& u, const int (&Rr)[2], const int (&Cc)[2], unsigned (&va)[2][2]) const {
#pragma unroll
        for (int h = 0; h < 2; ++h)
#pragma unroll
            for (int i = 0; i < 2; ++i) {
                if (GATHER) { const int pos = u.pos0 + h * HALF + Rr[i]; const int pair = pos < u.cnt ? list[u.e * CAP + pos] : 0; va[h][i] = (unsigned)((pair >> 2) * rowb + Cc[i] * 2); }
                else va[h][i] = (unsigned)u.pm * 262144u + act_piece_off(h * HALF + Rr[i], Cc[i] >> 3); } }
};

typedef int v8i_t __attribute__((ext_vector_type(8)));
typedef int i32x4_t __attribute__((ext_vector_type(4)));
template <class Epi, class Sched, bool FP8 = false, int SCA = 127, int SCB = 127>
__device__ __forceinline__ void gemm_phase(LAS unsigned char* lds, const char* Abase, const int K, const Sched& S, const Epi& E) {
    const int tid = otid(), wid = __builtin_amdgcn_readfirstlane(tid >> 6), lane = tid & 63, wr = wid >> 2, wc = wid & 3, fr = lane & 15, fq = lane >> 4;
    const int Kb = FP8 ? K : 2 * K;
    const int nt = Kb / (BK * 2);
    int Rr[2], Cc[2]; unsigned voffB[2];
#pragma unroll
    for (int i = 0; i < 2; ++i) { int R_, C_; stage_rc(tid * 16 + i * 8192, R_, C_); Rr[i] = R_; Cc[i] = C_; const int Rb = 64 * (R_ >> 5) + (Epi::PERM ? perm32(R_ & 31) : (R_ & 31)); voffB[i] = (unsigned)(Rb * Kb + C_ * 2); }
    const size_t kstep = (size_t)(BK * 2);
    const size_t kstepA = (size_t)S.kstepA();
    const size_t hstep = (size_t)32 * Kb;
    const unsigned ldsw = (unsigned)wid * 1024u;
    const int aoff = lds_byte(wr * 64 + fr, fq * 8), boff = lds_byte(wc * 32 + fr, fq * 8);
#define PG8_SA(b, h) (((b) * 2 + (h)) * HTB)
#define PG8_SB(b, h) ((4 + (b) * 2 + (h)) * HTB)
#define PG8_STAGE_B(bufoff, gbase) do { _Pragma("unroll") for (int _i = 0; _i < 2; ++_i) \
        __builtin_amdgcn_global_load_lds((const unsigned*)((const char*)(gbase) + voffB[_i]), (LAS unsigned*)(lds + (bufoff) + ldsw + _i * 8192), 16, 0, 0); } while (0)
#define PG8_STAGE_A(bufoff, v0, v1, kb) do { \
        __builtin_amdgcn_global_load_lds((const unsigned*)(Abase + (kb) + (v0)), (LAS unsigned*)(lds + (bufoff) + ldsw), 16, 0, 0); \
        __builtin_amdgcn_global_load_lds((const unsigned*)(Abase + (kb) + (v1)), (LAS unsigned*)(lds + (bufoff) + ldsw + 8192), 16, 0, 0); } while (0)
#define PG8_LD16(addr) (*(const LAS i32x4_t*)(addr))
#define PG8_LDA(dst, b, h) do { _Pragma("unroll") for (int m = 0; m < 4; ++m) { if constexpr (FP8) dst##8[m] = __builtin_shufflevector(PG8_LD16(lds + PG8_SA(b, h) + aoff + m * 2048), PG8_LD16(lds + PG8_SA(b, h) + aoff + m * 2048 + 1024), 0, 1, 2, 3, 4, 5, 6, 7); \
        else { _Pragma("unroll") for (int k = 0; k < 2; ++k) dst[m][k] = *(const LAS bf16x8*)(lds + PG8_SA(b, h) + aoff + m * 2048 + k * 1024); } } } while (0)
#define PG8_LDB(dst, b, h) do { _Pragma("unroll") for (int n = 0; n < 2; ++n) { if constexpr (FP8) dst##8[n] = __builtin_shufflevector(PG8_LD16(lds + PG8_SB(b, h) + boff + n * 2048), PG8_LD16(lds + PG8_SB(b, h) + boff + n * 2048 + 1024), 0, 1, 2, 3, 4, 5, 6, 7); \
        else { _Pragma("unroll") for (int k = 0; k < 2; ++k) dst[n][k] = *(const LAS bf16x8*)(lds + PG8_SB(b, h) + boff + n * 2048 + k * 1024); } } } while (0)
#define PG8_MMA(ai, bj, At, Bt) do { __builtin_amdgcn_s_setprio(1); _Pragma("unroll") for (int m = 0; m < 4; ++m) _Pragma("unroll") for (int n = 0; n < 2; ++n) { \
        if constexpr (FP8) asm volatile("v_mfma_scale_f32_16x16x128_f8f6f4 %0, %1, %2, %0, %3, %4 op_sel_hi:[0,0,0]" : "+v"(acc[ai][bj][m][n]) : "v"(Bt##8[n]), "v"(At##8[m]), "v"(scb_), "v"(sca_)); \
        else { _Pragma("unroll") for (int k = 0; k < 2; ++k) acc[ai][bj][m][n] = __builtin_amdgcn_mfma_f32_16x16x32_bf16(Bt[n][k], At[m][k], acc[ai][bj][m][n], 0, 0, 0); } } \
        __builtin_amdgcn_s_setprio(0); } while (0)
#define PG8_WAIT_V(n) asm volatile("s_waitcnt vmcnt(" #n ")" ::: "memory")
#define PG8_WAIT_L(n) asm volatile("s_waitcnt lgkmcnt(" #n ")" ::: "memory")
#define PG8_BAR __builtin_amdgcn_s_barrier()
#define PG8_SCHED __builtin_amdgcn_sched_barrier(0)
    Unit cur, nxt; int ui = 0;
    if (!S.next(0, cur)) return;
    f32x4 acc[2][2][4][2];
#pragma unroll
    for (int a = 0; a < 2; ++a)
#pragma unroll
        for (int b = 0; b < 2; ++b)
#pragma unroll
            for (int m = 0; m < 4; ++m)
#pragma unroll
                for (int n = 0; n < 2; ++n) acc[a][b][m][n] = (f32x4){0.f, 0.f, 0.f, 0.f};
    const int sca_ = SCA, scb_ = SCB;
    bf16x8 At[4][2], B0[2][2], B1[2][2]; v8i_t At8[4], B08[2], B18[2];
    unsigned vc[2][2], vn[2][2];
    S.aoff(cur, Rr, Cc, vc);
    const char* cB = cur.b;
    PG8_STAGE_B(PG8_SB(0, 0), cB); PG8_STAGE_A(PG8_SA(0, 0), vc[0][0], vc[0][1], 0); PG8_STAGE_B(PG8_SB(0, 1), cB + hstep); PG8_STAGE_A(PG8_SA(0, 1), vc[1][0], vc[1][1], 0);
    if (wr == 1) PG8_BAR;
    PG8_WAIT_V(4); PG8_BAR;
    PG8_STAGE_B(PG8_SB(1, 0), cB + kstep); PG8_STAGE_A(PG8_SA(1, 0), vc[0][0], vc[0][1], kstepA); PG8_STAGE_B(PG8_SB(1, 1), cB + hstep + kstep);
    PG8_WAIT_V(6); PG8_BAR;
    for (;;) {
        const bool has_next = S.next(ui + 1, nxt);
        if constexpr (Sched::GATHER_LDS) {
            if (has_next && wid < 4) __builtin_amdgcn_global_load_lds((const unsigned*)(S.list + nxt.e * CAP + nxt.pos0 + tid), (LAS unsigned*)(lds + LDS_IDX + wid * 256), 4, 0, 0);
        } else if (has_next) S.aoff(nxt, Rr, Cc, vn);
        if (!has_next) {
#pragma unroll
            for (int h = 0; h < 2; ++h)
#pragma unroll
                for (int i = 0; i < 2; ++i) vn[h][i] = vc[h][i]; }
        const char* nB = has_next ? nxt.b : cB;
#pragma unroll 1
        for (int t = 0; t < nt; t += 2) {
            const bool last = (t == nt - 2);
            if constexpr (Sched::GATHER_LDS) { if (last && has_next) {
#pragma unroll
                for (int h = 0; h < 2; ++h)
#pragma unroll
                    for (int i = 0; i < 2; ++i) { const int rr = h * HALF + Rr[i]; const int pair = (nxt.pos0 + rr) < nxt.cnt ? ((const LAS int*)(lds + LDS_IDX))[rr] : 0; vn[h][i] = (unsigned)((pair >> 2) * S.rowb + Cc[i] * 2); } } }
            const size_t k1 = (size_t)(t + 1) * kstepA;
            const size_t k2 = last ? 0 : (size_t)(t + 2) * kstepA;
            const unsigned s00 = last ? vn[0][0] : vc[0][0], s01 = last ? vn[0][1] : vc[0][1], s10 = last ? vn[1][0] : vc[1][0], s11 = last ? vn[1][1] : vc[1][1];
            const char* b2 = last ? nB : cB + (size_t)(t + 2) * kstep; const char* b3 = b2 + kstep;
            PG8_LDB(B0, 0, 0); PG8_SCHED; PG8_LDA(At, 0, 0); PG8_STAGE_A(PG8_SA(1, 1), vc[1][0], vc[1][1], k1);
            PG8_WAIT_L(8); PG8_BAR; PG8_WAIT_L(0); PG8_MMA(0, 0, At, B0); PG8_BAR; PG8_SCHED;
            PG8_LDB(B1, 0, 1); PG8_STAGE_B(PG8_SB(0, 0), b2);
            PG8_BAR; PG8_WAIT_L(0); PG8_MMA(0, 1, At, B1); PG8_BAR; if constexpr (FP8) PG8_SCHED;
            PG8_LDA(At, 0, 1); PG8_STAGE_A(PG8_SA(0, 0), s00, s01, k2);
            PG8_BAR; PG8_WAIT_L(0); PG8_MMA(1, 0, At, B0); PG8_BAR; PG8_SCHED;
            PG8_STAGE_B(PG8_SB(0, 1), b2 + hstep);
            PG8_WAIT_V(6); PG8_BAR; PG8_MMA(1, 1, At, B1); PG8_BAR; if constexpr (FP8) PG8_SCHED;
            PG8_LDB(B0, 1, 0); PG8_SCHED; PG8_LDA(At, 1, 0); PG8_STAGE_A(PG8_SA(0, 1), s10, s11, k2);
            PG8_WAIT_L(8); PG8_BAR; PG8_WAIT_L(0); PG8_MMA(0, 0, At, B0); PG8_BAR; PG8_SCHED;
            PG8_LDB(B1, 1, 1); PG8_STAGE_B(PG8_SB(1, 0), b3);
            PG8_BAR; PG8_WAIT_L(0); PG8_MMA(0, 1, At, B1); PG8_BAR; if constexpr (FP8) PG8_SCHED;
            PG8_LDA(At, 1, 1); PG8_STAGE_A(PG8_SA(1, 0), s00, s01, k2 + kstepA);
            PG8_BAR; PG8_WAIT_L(0); PG8_MMA(1, 0, At, B0); PG8_BAR; PG8_SCHED;
            PG8_STAGE_B(PG8_SB(1, 1), b3 + hstep);
            PG8_WAIT_V(6); PG8_BAR; PG8_MMA(1, 1, At, B1); PG8_BAR; if constexpr (FP8) PG8_SCHED;
        }
        if constexpr (FP8) asm volatile("s_nop 15\n\ts_nop 15" ::: "memory");
        E(acc, cur, wr, wc, fr, fq);
        if (!has_next) break;
#pragma unroll
        for (int a = 0; a < 2; ++a)
#pragma unroll
            for (int b = 0; b < 2; ++b)
#pragma unroll
                for (int m = 0; m < 4; ++m)
#pragma unroll
                    for (int n = 0; n < 2; ++n) acc[a][b][m][n] = (f32x4){0.f, 0.f, 0.f, 0.f};
        cur = nxt; cB = nB; ++ui;
#pragma unroll
        for (int h = 0; h < 2; ++h)
#pragma unroll
            for (int i = 0; i < 2; ++i) vc[h][i] = vn[h][i];
    }
    PG8_WAIT_V(0);
    if (wr == 0) PG8_BAR;
    PG8_BAR;
#undef PG8_SA
#undef PG8_SB
#undef PG8_STAGE_A
#undef PG8_STAGE_B
#undef PG8_LDA
#undef PG8_LDB
#undef PG8_MMA
#undef PG8_WAIT_V
#undef PG8_WAIT_L
#undef PG8_BAR
#undef PG8_SCHED
}

typedef f32x4 Acc[2][2][4][2];
__device__ __forceinline__ unsigned dpp_ror8(unsigned x) { return (unsigned)__builtin_amdgcn_update_dpp(0, (int)x, 0x128, 0xf, 0xf, false); }
__device__ __forceinline__ u32x4 ror8_4(const u32x4 v) { u32x4 r; r.x = dpp_ror8(v.x); r.y = dpp_ror8(v.y); r.z = dpp_ror8(v.z); r.w = dpp_ror8(v.w); return r; }
__device__ __forceinline__ void line_xy(const u32x4 a, const u32x4 b, bool lo, u32x4& X, u32x4& Y) { const u32x4 ra = ror8_4(a), rb = ror8_4(b); X = lo ? a : rb; Y = lo ? ra : b; }
__device__ __forceinline__ u32x4 pack8(const f32x4 v0, const f32x4 v1) { u32x4 w; w.x = cvt_pk_bf16(v0[0], v0[1]); w.y = cvt_pk_bf16(v0[2], v0[3]); w.z = cvt_pk_bf16(v1[0], v1[1]); w.w = cvt_pk_bf16(v1[2], v1[3]); return w; }

struct EpiIn { static constexpr bool PERM = true; char* ws;
    __device__ __forceinline__ void operator()(const Acc& acc, const Unit& u, int wr, int wc, int fr, int fq) const {
        const int pn = u.pn; size_t boff; int ld, cb;
        if (pn < 3) { boff = OFF_QA; ld = 768; cb = pn * 256; } else if (pn == 3) { boff = OFF_CKV; ld = 256; cb = 0; }
        else if (pn < 32) { boff = OFF_HQ + (size_t)((pn - 4) >> 2) * SEG_STRIDE; ld = 1024; cb = ((pn - 4) & 3) * 256; }
        else { boff = OFF_KR; ld = 64; cb = 0; }
        bf16_t* base = (bf16_t*)(ws + boff);
        if (pn == 32 && wc != 0) return;
        const bool lo = fr < 8; const int rowb0 = u.pm * BM + wr * 64, rx = fr & 7, colx = cb + wc * 64 + (fr >> 3) * 32 + 8 * fq;
        float* ssq = (float*)(ws + (pn < 3 ? OFF_SSQQ : OFF_SSQKV));
#pragma unroll
        for (int ai = 0; ai < 2; ++ai)
#pragma unroll
            for (int m = 0; m < 4; ++m) { const int rg = rowb0 + ai * HALF + m * 16;
                f32x4 v0 = acc[ai][0][m][0], v1 = acc[ai][0][m][1], w0 = acc[ai][1][m][0], w1 = acc[ai][1][m][1];
                if (pn >= 4 && pn < 8) {
#pragma unroll
                    for (int j = 0; j < 4; ++j) { v0[j] = siluf_(v0[j]) * 0.08838834764831845f; v1[j] = siluf_(v1[j]) * 0.08838834764831845f; w0[j] = siluf_(w0[j]) * 0.08838834764831845f; w1[j] = siluf_(w1[j]) * 0.08838834764831845f; } }
                u32x4 X, Y; line_xy(pack8(v0, v1), pack8(w0, w1), lo, X, Y);
                *(u32x4*)(base + (size_t)(rg + rx) * ld + colx) = X; *(u32x4*)(base + (size_t)(rg + 8 + rx) * ld + colx) = Y;
                if (pn <= 3) { float ss = (v0[0] * v0[0] + v0[1] * v0[1]) + (v0[2] * v0[2] + v0[3] * v0[3]) + (v1[0] * v1[0] + v1[1] * v1[1]) + (v1[2] * v1[2] + v1[3] * v1[3])
                                        + (w0[0] * w0[0] + w0[1] * w0[1]) + (w0[2] * w0[2] + w0[3] * w0[3]) + (w1[0] * w1[0] + w1[1] * w1[1]) + (w1[2] * w1[2] + w1[3] * w1[3]);
                    ss += __shfl_xor(ss, 16); ss += __shfl_xor(ss, 32); if (fq == 0) atomicAdd(ssq + rg + fr, ss); } }
    } };

struct EpiQ { static constexpr bool PERM = true; bf16_t* q; const float* ssq;
    __device__ __forceinline__ void operator()(const Acc& acc, const Unit& u, int wr, int wc, int fr, int fq) const {
        const bool lo = fr < 8; const int rowb0 = u.pm * BM + wr * 64, rx = fr & 7, colx = u.pn * BM + wc * 64 + (fr >> 3) * 32 + 8 * fq;
#pragma unroll
        for (int ai = 0; ai < 2; ++ai)
#pragma unroll
            for (int m = 0; m < 4; ++m) { const int rg = rowb0 + ai * HALF + m * 16; const float rs = rsqrtf(ssq[rg + fr] * (1.0f / 768.0f) + EPS);
                u32x4 X, Y; line_xy(pack8(acc[ai][0][m][0] * rs, acc[ai][0][m][1] * rs), pack8(acc[ai][1][m][0] * rs, acc[ai][1][m][1] * rs), lo, X, Y);
                *(u32x4*)(q + (size_t)(rg + rx) * 1536 + colx) = X; *(u32x4*)(q + (size_t)(rg + 8 + rx) * 1536 + colx) = Y; }
    } };

struct EpiKV { static constexpr bool PERM = true; bf16_t *Kb, *Vb; const float* ssq;
    __device__ __forceinline__ size_t kvrow(int row, int h) const { int b, pos; if (row < L) { b = row >> 11; pos = row & 2047; } else { b = (row - L) >> 8; pos = SEQ + ((row - L) & 255); } return (size_t)(b * 8 + h) * NKEY + pos; }
    __device__ __forceinline__ void operator()(const Acc& acc, const Unit& u, int wr, int wc, int fr, int fq) const {
        const bool lo = fr < 8; const int rowb0 = u.pm * BM + wr * 64, rx = fr & 7, colx = (wc & 1) * 64 + (fr >> 3) * 32 + 8 * fq;
        bf16_t* dst = wc < 2 ? Kb : Vb; const int ld = wc < 2 ? 192 : 128;
#pragma unroll
        for (int ai = 0; ai < 2; ++ai)
#pragma unroll
            for (int m = 0; m < 4; ++m) { const int rg = rowb0 + ai * HALF + m * 16; const float rs = rsqrtf(ssq[rg + fr] * (1.0f / 256.0f) + EPS);
                u32x4 X, Y; line_xy(pack8(acc[ai][0][m][0] * rs, acc[ai][0][m][1] * rs), pack8(acc[ai][1][m][0] * rs, acc[ai][1][m][1] * rs), lo, X, Y);
                *(u32x4*)(dst + kvrow(rg + rx, u.pn) * ld + colx) = X; *(u32x4*)(dst + kvrow(rg + 8 + rx, u.pn) * ld + colx) = Y; }
    } };

struct EpiOut { static constexpr bool PERM = true; bf16_t* x1; const float* x; const float* modv;
    __device__ __forceinline__ void operator()(const Acc& acc, const Unit& u, int wr, int wc, int fr, int fq) const {
        const bool lo = fr < 8; const int rowb0 = u.pm * BM + wr * 64, rx = fr & 7, colx = u.pn * BM + wc * 64 + (fr >> 3) * 32 + 8 * fq, cown = u.pn * BM + wc * 64 + 8 * fq;
#pragma unroll
        for (int ai = 0; ai < 2; ++ai)
#pragma unroll
            for (int m = 0; m < 4; ++m) { const int rg = rowb0 + ai * HALF + m * 16, row = rg + fr; const float* gate = modv + (row >> 11) * 6144 + 2 * 1024 + cown; const float* xr = x + (size_t)row * D + cown;
                f32x4 r[2][2];
#pragma unroll
                for (int bj = 0; bj < 2; ++bj)
#pragma unroll
                    for (int n = 0; n < 2; ++n) r[bj][n] = *(const f32x4*)(xr + bj * 32 + 4 * n) + *(const f32x4*)(gate + bj * 32 + 4 * n) * acc[ai][bj][m][n];
                u32x4 X, Y; line_xy(pack8(r[0][0], r[0][1]), pack8(r[1][0], r[1][1]), lo, X, Y);
                *(u32x4*)(x1 + (size_t)(rg + rx) * D + colx) = X; *(u32x4*)(x1 + (size_t)(rg + 8 + rx) * D + colx) = Y; }
    } };

struct EpiMoe1 { static constexpr bool PERM = true; unsigned char* act; const float* bgu;
    __device__ __forceinline__ void operator()(const Acc& acc, const Unit& u, int wr, int wc, int fr, int fq) const {
        const int o0 = u.pn * 128 + wc * 16 + 4 * fq;
        f32x4 bg[2], bl[2];
#pragma unroll
        for (int bj = 0; bj < 2; ++bj) { const float* bp = bgu + u.e * 2048 + 2 * (o0 + bj * 64); const f32x4 t0 = *(const f32x4*)bp, t1 = *(const f32x4*)(bp + 4);
            bg[bj] = (f32x4){t0[0], t0[2], t1[0], t1[2]}; bl[bj] = (f32x4){t0[1], t0[3], t1[1], t1[3]}; }
        unsigned char* blk = act + ((size_t)u.pm * 8 + u.pn) * 32768 + (size_t)(wr * 4 + wc) * 1024 + (size_t)(fq * 16 + fr) * 16;
#pragma unroll
        for (int ai = 0; ai < 2; ++ai)
#pragma unroll
            for (int bj = 0; bj < 2; ++bj) { unsigned d[4];
#pragma unroll
                for (int m = 0; m < 4; ++m) { const f32x4 g4 = acc[ai][bj][m][0] + bg[bj], l4 = acc[ai][bj][m][1] + bl[bj]; float r[4];
#pragma unroll
                    for (int j = 0; j < 4; ++j) { const float glu = fminf(g4[j], 7.0f), lin = __builtin_amdgcn_fmed3f(l4[j], -7.0f, 7.0f); r[j] = 4.0f * glu * __builtin_amdgcn_rcpf(1.0f + __builtin_amdgcn_exp2f(-2.4554669595930157f * glu)) * (lin + 1.0f); }
                    d[m] = pack4_fp8(r[0], r[1], r[2], r[3]); }
                const auto s01 = __builtin_amdgcn_permlane16_swap(d[0], d[1], false, false); const auto s23 = __builtin_amdgcn_permlane16_swap(d[2], d[3], false, false);
                const auto t02 = __builtin_amdgcn_permlane32_swap(s01[0], s23[0], false, false); const auto t13 = __builtin_amdgcn_permlane32_swap(s01[1], s23[1], false, false);
                *(u32x4*)(blk + (size_t)(ai * 2 + bj) * 8192) = (u32x4){t02[0], t13[0], t02[1], t13[1]}; }
    } };

struct EpiMoe2 { static constexpr bool PERM = true; bf16_t* yp; const float* bd;
    __device__ __forceinline__ void operator()(const Acc& acc, const Unit& u, int wr, int wc, int fr, int fq) const {
        const bool lo = fr < 8; const int rowb0 = u.pm * BM + wr * 64, rx = fr & 7, colx = u.pn * BM + wc * 64 + (fr >> 3) * 32 + 8 * fq, cown = u.pn * BM + wc * 64 + 8 * fq;
        f32x4 bv[2][2];
#pragma unroll
        for (int bj = 0; bj < 2; ++bj)
#pragma unroll
            for (int n = 0; n < 2; ++n) bv[bj][n] = *(const f32x4*)(bd + u.e * 1024 + cown + bj * 32 + 4 * n);
#pragma unroll
        for (int ai = 0; ai < 2; ++ai)
#pragma unroll
            for (int m = 0; m < 4; ++m) { const int rg = rowb0 + ai * HALF + m * 16;
                u32x4 X, Y; line_xy(pack8(acc[ai][0][m][0] + bv[0][0], acc[ai][0][m][1] + bv[0][1]), pack8(acc[ai][1][m][0] + bv[1][0], acc[ai][1][m][1] + bv[1][1]), lo, X, Y);
                *(u32x4*)(yp + (size_t)(rg + rx) * D + colx) = X; *(u32x4*)(yp + (size_t)(rg + 8 + rx) * D + colx) = Y; }
    } };
}

__device__ __forceinline__ int conv_src_col(int kind, int c) {
    if (kind == 0) return c;
    if (kind == 1) { if (c < 1024) return c; if (c < 8192) return c + 64; if (c < 8256) return c - 8192 + 1024; return -1; }
    const int pn = c >> 8, p = c & 255, wc = p >> 6, bj = (p >> 5) & 1, fq = (p >> 3) & 3, n = (p >> 2) & 1, i = p & 3; const int o = 128 * pn + 64 * bj + 16 * wc + 4 * fq + i; return 2 * o + n;
}
template <bool F8> struct ConvPipe {
    float v[32]; bool have; bf16_t* dummy;
    int K, kind, k0, c0; void* Wt;
    __device__ __forceinline__ void issue(const float* __restrict__ W, int ldw, void* Wt_, int K_, int kind_, const float* __restrict__ kscale, int k0_, int c0_) {
        const int tid = otid(); const int cc = tid & 127, kq = tid >> 7, sc = conv_src_col(kind_, c0_ + cc);
        const int scc = sc < 0 ? 0 : sc; const float* wp = W + (size_t)(k0_ + kq) * ldw + scc;
#pragma unroll
        for (int i = 0; i < 32; ++i) v[i] = wp[(size_t)(4 * i) * ldw];
        if (sc < 0) {
#pragma unroll
            for (int i = 0; i < 32; ++i) v[i] = 0.f; }
        if (kscale) {
#pragma unroll
            for (int i = 0; i < 32; ++i) v[i] *= kscale[k0_ + kq + 4 * i]; }
        K = K_; kind = kind_; k0 = k0_; c0 = c0_; Wt = Wt_; have = true;
    }
    __device__ __forceinline__ void flush(LAS float* tl) {
        if (!have) return; have = false;
        const int tid = otid(); const int cc = tid & 127, kq = tid >> 7;
        __syncthreads();
#pragma unroll
        for (int i = 0; i < 32; ++i) tl[(kq + 4 * i) * 129 + cc] = v[i];
        __syncthreads();
        stash(tl, tid);
    }
    __device__ __forceinline__ void to_lds(LAS float* tl) { const int tid = otid(); const int cc = tid & 127, kq = tid >> 7; __syncthreads();
#pragma unroll
        for (int i = 0; i < 32; ++i) tl[(kq + 4 * i) * 129 + cc] = v[i];
        __syncthreads(); }
    __device__ __forceinline__ void stash(LAS float* tl, int tid) const {
        if constexpr (F8) {
#pragma unroll
            for (int pss = 0; pss < 2; ++pss) { const int item = tid + 512 * pss, c2 = item >> 3, ch = item & 7; float t[16];
#pragma unroll
                for (int j = 0; j < 16; ++j) t[j] = tl[(16 * ch + j) * 129 + c2] * 32.f;
                u32x4 w; w.x = pack4_fp8(t[0], t[1], t[2], t[3]); w.y = pack4_fp8(t[4], t[5], t[6], t[7]); w.z = pack4_fp8(t[8], t[9], t[10], t[11]); w.w = pack4_fp8(t[12], t[13], t[14], t[15]);
                *(u32x4*)((unsigned char*)Wt + (size_t)(c0 + c2) * K + k0 + 16 * ch) = w; }
        } else {
#pragma unroll
            for (int pss = 0; pss < 4; ++pss) { const int item = tid + 512 * pss, c2 = item >> 4, ch = item & 15; float t[8];
#pragma unroll
                for (int j = 0; j < 8; ++j) t[j] = tl[(8 * ch + j) * 129 + c2];
                u32x4 w; w.x = cvt_pk_bf16(t[0], t[1]); w.y = cvt_pk_bf16(t[2], t[3]); w.z = cvt_pk_bf16(t[4], t[5]); w.w = cvt_pk_bf16(t[6], t[7]);
                *(u32x4*)((bf16_t*)Wt + (size_t)(c0 + c2) * K + k0 + 8 * ch) = w; }
        }
    }
};
template <bool F8>
__device__ __forceinline__ void conv_matrix(LAS float* tl, ConvPipe<F8>& pipe, const float* W, int ldw, void* Wt, int K, int Nout, int kind, const float* kscale, int& tctr) {
    const int nk = K / 128, ntile = nk * (Nout / 128);
    int t = ((int)blockIdx.x - tctr) % (int)gridDim.x; if (t < 0) t += gridDim.x;
    for (; t < ntile; t += gridDim.x) {
        if (pipe.have) { pipe.to_lds(tl); const int K0 = pipe.K, k00 = pipe.k0, c00 = pipe.c0; void* W0 = pipe.Wt; ConvPipe<F8> done = pipe; (void)K0; (void)k00; (void)c00; (void)W0;
            pipe.issue(W, ldw, Wt, K, kind, kscale, (t % nk) * 128, (t / nk) * 128); done.stash(tl, otid()); }
        else pipe.issue(W, ldw, Wt, K, kind, kscale, (t % nk) * 128, (t / nk) * 128);
    }
    tctr = (tctr + ntile) % (int)gridDim.x;
}
template <bool F8> __device__ __forceinline__ void conv_finish(LAS float* tl, ConvPipe<F8>& pipe) { if (pipe.have) { pipe.to_lds(tl); pipe.stash(tl, otid()); pipe.have = false; } __syncthreads(); }

__device__ __forceinline__ float half_sum256(float v, LAS float* red) {
    for (int o = 32; o > 0; o >>= 1) v += __shfl_xor(v, o);
    const int w = otid() >> 6, hb = (otid() >> 8) * 4; if ((otid() & 63) == 0) red[w] = v; __syncthreads();
    const float t = red[hb] + red[hb + 1] + red[hb + 2] + red[hb + 3]; __syncthreads(); return t;
}

__device__ __forceinline__ void phase0(const Params& p, LAS unsigned char* lds) {
    char* ws = p.ws; const int tid = otid(), gsz = gridDim.x * 512, gid = blockIdx.x * 512 + tid;
    float* lb = (float*)(ws + OFF_LB); int* cnt = (int*)(ws + OFF_CNT); float* ssqq = (float*)(ws + OFF_SSQQ); float* ssqkv = (float*)(ws + OFF_SSQKV); float* modv = (float*)(ws + OFF_MOD);
    for (int i = gid; i < 2048; i += gsz) { const int d = i >> 10, j = i & 1023; const float a = p.lbl[(d * 2 + 0) * 1024 + j], b = p.lbl[(d * 2 + 1) * 1024 + j]; lb[i] = 1.0f / (1.0f + __expf(b - a)); }
    for (int i = gid; i < 32; i += gsz) cnt[i] = 0;
    { float* ropet = (float*)(ws + OFF_ROPE); for (int i = gid; i < SEQ * 32; i += gsz) { const int t = i >> 5, j = i & 31; float cs, sn; rope_cs(t, j, cs, sn); ropet[t * 64 + j] = cs; ropet[t * 64 + 32 + j] = sn; } }
    for (int i = gid; i < L; i += gsz) ssqq[i] = 0.f;
    for (int i = gid; i < R; i += gsz) ssqkv[i] = 0.f;
    { LAS float* sil = (LAS float*)lds;
      LAS float* part = (LAS float*)(lds + 17 * 1024 * 4);
      bool loaded = false;
      for (int item = blockIdx.x; item < 96; item += gridDim.x) {
          if (!loaded) { for (int i = tid; i < 17 * 1024; i += 512) { const int r = i >> 10, k = i & 1023; sil[i] = siluf_(r < 16 ? p.c[r * 1024 + k] : p.cctx[k]); } loaded = true; __syncthreads(); }
          const int j = tid & 63, ks = tid >> 6; float a[17];
#pragma unroll
          for (int r = 0; r < 17; ++r) a[r] = 0.f;
          for (int k = ks * 128; k < ks * 128 + 128; ++k) { const float w = p.w_mod[(size_t)k * 6144 + item * 64 + j];
#pragma unroll
              for (int r = 0; r < 17; ++r) a[r] += sil[r * 1024 + k] * w; }
#pragma unroll
          for (int r = 0; r < 17; ++r) part[(ks * 17 + r) * 64 + j] = a[r];
          __syncthreads();
          for (int i = tid; i < 17 * 64; i += 512) { const int r = i >> 6, jj = i & 63; float s = p.b_mod[item * 64 + jj]; for (int q = 0; q < 8; ++q) s += part[(q * 17 + r) * 64 + jj]; modv[r * 6144 + item * 64 + jj] = s; }
          __syncthreads();
      } }
    __syncthreads();
    { LAS float* tl = (LAS float*)lds; int tctr = 0;
      { ConvPipe<true> pp; pp.have = false; conv_matrix<true>(tl, pp, p.w_in, 8256, (unsigned char*)(ws + OFF_WT_IN), 1024, 8448, 1, nullptr, tctr); conv_finish<true>(tl, pp); }
      { ConvPipe<false> pp; pp.have = false;
        conv_matrix<false>(tl, pp, p.w_qb, 1536, (bf16_t*)(ws + OFF_WT_QB), 768, 1536, 0, p.g_q, tctr);
        conv_matrix<false>(tl, pp, p.w_kvb, 2048, (bf16_t*)(ws + OFF_WT_KVB), 256, 2048, 0, p.g_kv, tctr);
        conv_matrix<false>(tl, pp, p.w_out, 1024, (bf16_t*)(ws + OFF_WT_OUT), 1024, 1024, 0, nullptr, tctr); conv_finish<false>(tl, pp); } }
}

__device__ __forceinline__ float wave_sum(float v) {
#pragma unroll
    for (int o = 32; o > 0; o >>= 1) v += __shfl_xor(v, o);
    return v; }
__device__ __forceinline__ void phase1(const Params& p, LAS unsigned char* lds) {
    const float* modv = (const float*)(p.ws + OFF_MOD); unsigned char* h = (unsigned char*)(p.ws + OFF_H);
    const int tid = otid(), lane = tid & 63, gw = blockIdx.x * 8 + (tid >> 6), nw = gridDim.x * 8, c0 = lane * 8;
    f32x4 g[4];
#pragma unroll
    for (int q = 0; q < 4; ++q) g[q] = *(const f32x4*)(p.g_mix + (q >> 1) * 512 + c0 + (q & 1) * 4);
    for (int row0 = gw; row0 < R; row0 += 2 * nw) {
        f32x4 v[2][4]; const bool two = row0 + nw < R;
#pragma unroll
        for (int u = 0; u < 2; ++u) { const int row = (u == 0 || two) ? row0 + u * nw : row0; const float* src = row < L ? p.x + (size_t)row * D : p.ctx + (size_t)(row - L) * D;
#pragma unroll
            for (int q = 0; q < 4; ++q) v[u][q] = *(const f32x4*)(src + (q >> 1) * 512 + c0 + (q & 1) * 4); }
#pragma unroll
        for (int u = 0; u < 2; ++u) { if (u == 1 && !two) break; const int row = row0 + u * nw; const float* mod = modv + (row < L ? row / SEQ : 16) * 6144;
            float ss = 0.f;
#pragma unroll
            for (int q = 0; q < 4; ++q) ss += (v[u][q][0] * v[u][q][0] + v[u][q][1] * v[u][q][1]) + (v[u][q][2] * v[u][q][2] + v[u][q][3] * v[u][q][3]);
            const float rs = rsqrtf(wave_sum(ss) * (1.0f / D) + EPS);
#pragma unroll
            for (int j = 0; j < 2; ++j) { f32x4 o[2];
#pragma unroll
                for (int e = 0; e < 2; ++e) { const int cc = j * 512 + c0 + e * 4; const f32x4 sc = *(const f32x4*)(mod + 1024 + cc), sh = *(const f32x4*)(mod + cc); o[e] = v[u][j * 2 + e] * rs * g[j * 2 + e] * (sc + 1.0f) + sh; }
                u32x2 w; w.x = pack4_fp8(o[0][0], o[0][1], o[0][2], o[0][3]); w.y = pack4_fp8(o[1][0], o[1][1], o[1][2], o[1][3]);
                *(u32x2*)(h + (size_t)row * D + j * 512 + c0) = w; } }
    }
}

__device__ __forceinline__ SegOut make_seg(char* ws) { SegOut so; so.qa = (bf16_t*)(ws + OFF_QA); so.ckv = (bf16_t*)(ws + OFF_CKV); so.kr = (bf16_t*)(ws + OFF_KR); so.hq = (bf16_t*)(ws + OFF_HQ); so.ff = (bf16_t*)(ws + OFF_FF);
    so.fb = (bf16_t*)(ws + OFF_FB); so.iv = (bf16_t*)(ws + OFF_IV); so.og = (bf16_t*)(ws + OFF_OG); so.gm = (bf16_t*)(ws + OFF_GM); so.gh = (bf16_t*)(ws + OFF_GH); return so; }

__device__ __forceinline__ void phase2(const Params& p, LAS unsigned char* lds) {
    pg8::InSched S; S.init2(p.ws + OFF_WT_IN, gridDim.x, blockIdx.x);
    pg8::EpiIn E{p.ws};
    pg8::gemm_phase<pg8::EpiIn, pg8::InSched, true, 127, 122>(lds, (const char*)(p.ws + OFF_H), 1024, S, E);
}
__device__ __forceinline__ void phase3(const Params& p, LAS unsigned char* lds) {
    char* ws = p.ws;
    { pg8::DenseSched S; S.init(L, 1536, 768 * 2, 768 * 2, ws + OFF_WT_QB, gridDim.x, blockIdx.x); pg8::EpiQ E{(bf16_t*)(ws + OFF_Q), (const float*)(ws + OFF_SSQQ)}; pg8::gemm_phase(lds, (const char*)(ws + OFF_QA), 768, S, E); }
    { pg8::DenseSched S; S.init(R, 2048, 256 * 2, 256 * 2, ws + OFF_WT_KVB, gridDim.x, blockIdx.x); pg8::EpiKV E{(bf16_t*)(ws + OFF_K), (bf16_t*)(ws + OFF_V), (const float*)(ws + OFF_SSQKV)}; pg8::gemm_phase(lds, (const char*)(ws + OFF_CKV), 256, S, E); }
    { const bf16_t* kr = (const bf16_t*)(ws + OFF_KR); bf16_t* Kb = (bf16_t*)(ws + OFF_K); const float* ropet = (const float*)(ws + OFF_ROPE);
      for (int gid = blockIdx.x * 512 + otid(); gid < R * 32; gid += gridDim.x * 512) { const int row = gid >> 5, i = gid & 31;
          const float x1 = bf2f(kr[(size_t)row * 64 + i]), x2 = bf2f(kr[(size_t)row * 64 + 32 + i]); float o1 = x1, o2 = x2; int b, pos;
          if (row < L) { b = row / SEQ; pos = row % SEQ; const float cs = ropet[pos * 64 + i], sn = ropet[pos * 64 + 32 + i]; o1 = x1 * cs - x2 * sn; o2 = x1 * sn + x2 * cs; } else { b = (row - L) / CTXL; pos = SEQ + (row - L) % CTXL; }
          const bf16_t w1 = f2bf(o1), w2 = f2bf(o2);
          for (int h = 0; h < 8; ++h) { bf16_t* q = Kb + ((size_t)(b * 8 + h) * NKEY + pos) * 192 + 128; q[i] = w1; q[32 + i] = w2; } } }
}
__device__ __forceinline__ void unpack8(const u32x4 w, float (&o)[8]) {
    o[0] = __uint_as_float(w.x << 16); o[1] = __uint_as_float(w.x & 0xffff0000u); o[2] = __uint_as_float(w.y << 16); o[3] = __uint_as_float(w.y & 0xffff0000u);
    o[4] = __uint_as_float(w.z << 16); o[5] = __uint_as_float(w.z & 0xffff0000u); o[6] = __uint_as_float(w.w << 16); o[7] = __uint_as_float(w.w & 0xffff0000u); }
__device__ __forceinline__ void phase4(const Params& p, LAS unsigned char*) {
    char* ws = p.ws; bf16_t* y = (bf16_t*)(ws + OFF_H); const bf16_t* of = (const bf16_t*)(ws + OFF_OF); const bf16_t* ob = (const bf16_t*)(ws + OFF_OB);
    const bf16_t* og = (const bf16_t*)(ws + OFF_OG); const bf16_t* gm = (const bf16_t*)(ws + OFF_GM); const bf16_t* gh = (const bf16_t*)(ws + OFF_GH);
    const int tid = otid(), lane = tid & 63, gw = blockIdx.x * 8 + (tid >> 6), nw = gridDim.x * 8, c0 = lane * 8;
    float gg[8];
#pragma unroll
    for (int i = 0; i < 8; ++i) gg[i] = p.g_hg[(c0 + i) & 127];
    for (int row = gw; row < L; row += nw) {
        u32x4 ra[2], rb[2], r1[2], r2[2], r3[2], rm[2];
#pragma unroll
        for (int j = 0; j < 2; ++j) { const size_t off = (size_t)row * D + j * 512 + c0; ra[j] = *(const u32x4*)(of + off); rb[j] = *(const u32x4*)(ob + off); r1[j] = *(const u32x4*)(og + off); r2[j] = *(const u32x4*)(gm + off); r3[j] = *(const u32x4*)(gh + off); rm[j] = *(const u32x4*)(y + off); }
#pragma unroll
        for (int j = 0; j < 2; ++j) { float a[8], b[8], g1[8], g2[8], g3[8], ym[8], o[8]; unpack8(ra[j], a); unpack8(rb[j], b); unpack8(r1[j], g1); unpack8(r2[j], g2); unpack8(r3[j], g3); unpack8(rm[j], ym);
            float ss = 0.f;
#pragma unroll
            for (int i = 0; i < 8; ++i) { o[i] = a[i] + b[i]; ss += o[i] * o[i]; }
            ss += __shfl_xor(ss, 1); ss += __shfl_xor(ss, 2); ss += __shfl_xor(ss, 4); ss += __shfl_xor(ss, 8);
            const float rs = rsqrtf(ss * (1.0f / 128.0f) + EPS); float r[8];
#pragma unroll
            for (int i = 0; i < 8; ++i) { const float yh = o[i] * rs * gg[i] * siluf_(g1[i]); r[i] = sigmoidf_(g2[i]) * ym[i] + sigmoidf_(g3[i]) * yh; }
            u32x4 w; w.x = cvt_pk_bf16(r[0], r[1]); w.y = cvt_pk_bf16(r[2], r[3]); w.z = cvt_pk_bf16(r[4], r[5]); w.w = cvt_pk_bf16(r[6], r[7]);
            *(u32x4*)(y + (size_t)row * D + j * 512 + c0) = w; }
    }
}
__device__ __forceinline__ void phase5(const Params& p, LAS unsigned char* lds) {
    char* ws = p.ws;
    { pg8::DenseSched S; S.init(L, 1024, 1024 * 2, 1024 * 2, ws + OFF_WT_OUT, gridDim.x, blockIdx.x); pg8::EpiOut E{(bf16_t*)(ws + OFF_X1), p.x, (const float*)(ws + OFF_MOD)}; pg8::gemm_phase(lds, (const char*)(ws + OFF_H), 1024, S, E); }
    { LAS float* tl = (LAS float*)lds; int tctr = 0; ConvPipe<true> pp; pp.have = false;
      for (int e = 0; e < NE; ++e) conv_matrix<true>(tl, pp, p.w_gu + (size_t)e * 1024 * 2048, 2048, (unsigned char*)(ws + OFF_WT_GU) + (size_t)e * 2048 * 1024, 1024, 2048, 2, nullptr, tctr);
      for (int e = 0; e < NE; ++e) conv_matrix<true>(tl, pp, p.w_dn + (size_t)e * 1024 * 1024, 1024, (unsigned char*)(ws + OFF_WT_DN) + (size_t)e * 1024 * 1024, 1024, 1024, 0, nullptr, tctr);
      conv_finish<true>(tl, pp); }
}
__device__ __forceinline__ void phase6(const Params& p, LAS unsigned char* lds) {
    char* ws = p.ws; const float* modv = (const float*)(ws + OFF_MOD); unsigned char* h2 = (unsigned char*)(ws + OFF_H); int* topi = (int*)(ws + OFF_TOPI); float* topp = (float*)(ws + OFF_TOPP); int* cnt = (int*)(ws + OFF_CNT); int* list = (int*)(ws + OFF_LIST); int* pairpos = (int*)(ws + OFF_ROWPAIR);
    LAS float* hs = (LAS float*)lds;
    LAS float* lg = (LAS float*)(lds + 131072);
    LAS int* lcnt = (LAS int*)(lds + 131072 + 4096);
    LAS int* lent = (LAS int*)(lds + 131072 + 4096 + 512);
    const int tid = otid(), lane = tid & 63, wid = tid >> 6, c0 = lane * 8;
    if (tid < 96) lcnt[tid] = 0;
    f32x4 g[4];
#pragma unroll
    for (int q = 0; q < 4; ++q) g[q] = *(const f32x4*)(p.g_ffn + (q >> 1) * 512 + c0 + (q & 1) * 4);
    __syncthreads();
    int it = 0;
    for (int tile = blockIdx.x; tile < L / 32; tile += gridDim.x, ++it) {
        const int rbase = tile * 32;
        f32x4 v[4][4];
#pragma unroll
        for (int u = 0; u < 4; ++u)
#pragma unroll
            for (int j = 0; j < 2; ++j) { float t8[8]; unpack8(*(const u32x4*)((const bf16_t*)(ws + OFF_X1) + (size_t)(rbase + wid * 4 + u) * D + j * 512 + c0), t8); v[u][2 * j] = (f32x4){t8[0], t8[1], t8[2], t8[3]}; v[u][2 * j + 1] = (f32x4){t8[4], t8[5], t8[6], t8[7]}; }
#pragma unroll
        for (int u = 0; u < 4; ++u) { const int rl = wid * 4 + u, row = rbase + rl; const float* mod = modv + (row / SEQ) * 6144; float ss = 0.f;
#pragma unroll
            for (int q = 0; q < 4; ++q) ss += (v[u][q][0] * v[u][q][0] + v[u][q][1] * v[u][q][1]) + (v[u][q][2] * v[u][q][2] + v[u][q][3] * v[u][q][3]);
            const float rs = rsqrtf(wave_sum(ss) * (1.0f / D) + EPS);
#pragma unroll
            for (int j = 0; j < 2; ++j) { f32x4 o[2];
#pragma unroll
                for (int e = 0; e < 2; ++e) { const int cc = j * 512 + c0 + e * 4; const f32x4 sc = *(const f32x4*)(mod + 4 * 1024 + cc), sh = *(const f32x4*)(mod + 3 * 1024 + cc); o[e] = v[u][j * 2 + e] * rs * g[j * 2 + e] * (sc + 1.0f) + sh;
                    *(LAS f32x4*)(hs + rl * 1024 + cc) = o[e]; }
                u32x2 w; w.x = pack4_fp8(o[0][0], o[0][1], o[0][2], o[0][3]); w.y = pack4_fp8(o[1][0], o[1][1], o[1][2], o[1][3]);
                *(u32x2*)(h2 + (size_t)row * D + j * 512 + c0) = w; } }
        __syncthreads();
        { const int e = tid & 31, rg = tid >> 5; const LAS float* h0 = hs + (2 * rg) * 1024; const LAS float* h1 = h0 + 1024; float a0 = 0.f, a1 = 0.f;
          for (int j = 0; j < 1024; j += 8) { float w[8];
#pragma unroll
              for (int q = 0; q < 8; ++q) w[q] = p.w_r[(j + q) * 32 + e];
              const f32x4 x0 = *(const LAS f32x4*)(h0 + j), x1 = *(const LAS f32x4*)(h0 + j + 4), y0 = *(const LAS f32x4*)(h1 + j), y1 = *(const LAS f32x4*)(h1 + j + 4);
              a0 += x0[0] * w[0]; a0 += x0[1] * w[1]; a0 += x0[2] * w[2]; a0 += x0[3] * w[3]; a0 += x1[0] * w[4]; a0 += x1[1] * w[5]; a0 += x1[2] * w[6]; a0 += x1[3] * w[7];
              a1 += y0[0] * w[0]; a1 += y0[1] * w[1]; a1 += y0[2] * w[2]; a1 += y0[3] * w[3]; a1 += y1[0] * w[4]; a1 += y1[1] * w[5]; a1 += y1[2] * w[6]; a1 += y1[3] * w[7]; }
          const float be = p.b_r[e]; lg[(2 * rg) * 32 + e] = a0 + be; lg[(2 * rg + 1) * 32 + e] = a1 + be; }
        __syncthreads();
#pragma unroll
        for (int rep = 0; rep < 2; ++rep) { const int rl = wid * 4 + rep * 2 + (lane >> 5), row = rbase + rl, e = lane & 31; float cur = lg[rl * 32 + e];
            float tv0 = 0.f, sum = 0.f; int sel_i[4]; float sel_e[4];
#pragma unroll
            for (int k = 0; k < 4; ++k) { float m = cur; int mi = e;
#pragma unroll
                for (int o2 = 16; o2 > 0; o2 >>= 1) { const float om = __shfl_xor(m, o2); const int oi = __shfl_xor(mi, o2); if (om > m || (om == m && oi < mi)) { m = om; mi = oi; } }
                if (k == 0) tv0 = m; sel_i[k] = mi; sel_e[k] = __expf(m - tv0); sum += sel_e[k]; if (e == mi) cur = -3.0e38f; }
            int myk = 0; float myp = 0.f;
#pragma unroll
            for (int k = 0; k < 4; ++k) if (e == k) { myk = sel_i[k]; myp = sel_e[k] / sum; }
            if (e < 4) { const int pair = row * 4 + e; topi[pair] = myk; topp[pair] = myp; __hip_atomic_fetch_add(&lcnt[myk], 1, __ATOMIC_RELAXED, __HIP_MEMORY_SCOPE_WORKGROUP); lent[(it * 32 + rl) * 4 + e] = myk; } }
        __syncthreads();
    }
    if (tid < 32) { const int n = lcnt[tid]; lcnt[32 + tid] = n > 0 ? atomicAdd(&cnt[tid], n) : 0; lcnt[64 + tid] = 0; }
    __syncthreads();
    const int nent = it * 128;
    for (int s = tid; s < nent; s += 512) { const int e = lent[s]; const int ii = s >> 7, rl = (s >> 2) & 31, k = s & 3; const int row = (blockIdx.x + ii * gridDim.x) * 32 + rl;
        const int pos = lcnt[32 + e] + __hip_atomic_fetch_add(&lcnt[64 + e], 1, __ATOMIC_RELAXED, __HIP_MEMORY_SCOPE_WORKGROUP); list[e * CAP + pos] = row * 4 + k; pairpos[row * 4 + k] = pos; }
}
__device__ __forceinline__ void moe_table(const int* cnt, LAS int* tab) {
    if (otid() == 0) { int t = 0; for (int e = 0; e < NE; ++e) { tab[e] = t; const int n = cnt[e]; tab[64 + e] = n; t += (n + 255) >> 8; } tab[32] = t; tab[33] = t; }
    __syncthreads();
    for (int rt = otid(); rt < tab[33]; rt += 512) { int e = 0; while (tab[e + 1] <= rt) ++e; tab[128 + rt] = e; }
    __syncthreads();
}
constexpr int LDS_TAB = pg8::STAGE_BYTES;
__device__ __forceinline__ void phase7(const Params& p, LAS unsigned char* lds) {
    char* ws = p.ws; LAS int* tab = (LAS int*)(lds + LDS_TAB); moe_table((const int*)(ws + OFF_CNT), tab);
    pg8::MoeSched<true> S; S.nN = 8; S.G = gridDim.x; S.c = blockIdx.x; S.rowb = 1024; S.Wt = ws + OFF_WT_GU; S.wexp = (size_t)2048 * 1024; S.btile = (size_t)256 * 1024; S.tab = tab; S.list = (const int*)(ws + OFF_LIST);
    pg8::EpiMoe1 E{(unsigned char*)(ws + OFF_ACT), p.b_gu};
    pg8::gemm_phase<pg8::EpiMoe1, pg8::MoeSched<true>, true, 127, 122>(lds, (const char*)(ws + OFF_H), 1024, S, E);
}
__device__ __forceinline__ void phase8(const Params& p, LAS unsigned char* lds) {
    char* ws = p.ws; LAS int* tab = (LAS int*)(lds + LDS_TAB); moe_table((const int*)(ws + OFF_CNT), tab);
    pg8::MoeSched<false> S; S.nN = 4; S.G = gridDim.x; S.c = blockIdx.x; S.rowb = 1024; S.Wt = ws + OFF_WT_DN; S.wexp = (size_t)1024 * 1024; S.btile = (size_t)256 * 1024; S.tab = tab; S.list = (const int*)(ws + OFF_LIST);
    pg8::EpiMoe2 E{(bf16_t*)(ws + OFF_YP), p.b_dn};
    pg8::gemm_phase<pg8::EpiMoe2, pg8::MoeSched<false>, true, 125, 122>(lds, (const char*)(ws + OFF_ACT), 1024, S, E);
}
__device__ __forceinline__ void phase9(const Params& p, LAS unsigned char* lds) {
    char* ws = p.ws; const float* modv = (const float*)(ws + OFF_MOD); const bf16_t* yp = (const bf16_t*)(ws + OFF_YP); const float* topp = (const float*)(ws + OFF_TOPP);
    const int* topi = (const int*)(ws + OFF_TOPI); const int* pairpos = (const int*)(ws + OFF_ROWPAIR);
    LAS int* tab = (LAS int*)lds; moe_table((const int*)(ws + OFF_CNT), tab);
    const int tid = otid(), lane = tid & 63, gw = blockIdx.x * 8 + (tid >> 6), nw = gridDim.x * 8, c0 = lane * 8;
    f32x4 fg[4];
#pragma unroll
    for (int q = 0; q < 4; ++q) fg[q] = *(const f32x4*)(p.g_fin + (q >> 1) * 512 + c0 + (q & 1) * 4);
    for (int row = gw; row < L; row += nw) {
        const float* gate = modv + (row / SEQ) * 6144 + 5 * 1024; f32x4 v[4]; u32x4 yr[4][2];
        const pg8::i32x4_t ek = *(const pg8::i32x4_t*)(topi + row * 4), pk4 = *(const pg8::i32x4_t*)(pairpos + row * 4);
#pragma unroll
        for (int j = 0; j < 2; ++j) { float t8[8]; unpack8(*(const u32x4*)((const bf16_t*)(ws + OFF_X1) + (size_t)row * D + j * 512 + c0), t8); v[2 * j] = (f32x4){t8[0], t8[1], t8[2], t8[3]}; v[2 * j + 1] = (f32x4){t8[4], t8[5], t8[6], t8[7]}; }
#pragma unroll
        for (int k = 0; k < 4; ++k) { const size_t yrow = (size_t)tab[ek[k]] * 256 + pk4[k];
#pragma unroll
            for (int j = 0; j < 2; ++j) yr[k][j] = *(const u32x4*)(yp + yrow * D + j * 512 + c0); }
        const f32x4 pk = *(const f32x4*)(topp + row * 4);
        float m[16];
#pragma unroll
        for (int i = 0; i < 16; ++i) m[i] = 0.f;
#pragma unroll
        for (int k = 0; k < 4; ++k)
#pragma unroll
            for (int j = 0; j < 2; ++j) { float t[8]; unpack8(yr[k][j], t);
#pragma unroll
                for (int i = 0; i < 8; ++i) m[j * 8 + i] += pk[k] * t[i]; }
        float ss = 0.f;
#pragma unroll
        for (int q = 0; q < 4; ++q) { const f32x4 gt = *(const f32x4*)(gate + (q >> 1) * 512 + c0 + (q & 1) * 4);
#pragma unroll
            for (int i = 0; i < 4; ++i) { v[q][i] += gt[i] * m[q * 4 + i]; ss += v[q][i] * v[q][i]; } }
        const float rs = rsqrtf(wave_sum(ss) * (1.0f / D) + EPS);
#pragma unroll
        for (int q = 0; q < 4; ++q) *(f32x4*)(p.out + (size_t)row * D + (q >> 1) * 512 + c0 + (q & 1) * 4) = v[q] * rs * fg[q];
    }
}

namespace at {
using s16x4  = __attribute__((ext_vector_type(4))) short;
using f32x16 = __attribute__((ext_vector_type(16))) float;
constexpr int NW = 8, QBLK = 32, KVBLK = 64, DK = 192, DV = 128;
constexpr float SCALE = 0.07216878364870322f;
constexpr float THR = 8.f;
constexpr int SHM_V = KVBLK * DV * 2, SHM_K = KVBLK * DK * 2, SHM_ATTN = 2 * SHM_V + 2 * SHM_K + NW * 64 * 4;
#define KSWZ(row, colB) ((row) * 384 + ((colB) ^ (((row) & 7) << 4)))
#define SBAR() __builtin_amdgcn_sched_barrier(0)
__device__ __forceinline__ int crow(int r, int hi) { return (r & 3) + 8 * (r >> 2) + 4 * hi; }
__device__ __forceinline__ unsigned cvtpk(float lo, float hi) { return cvt_pk_bf16(lo, hi); }

__device__ __forceinline__ void partialSM(f32x16& p0, f32x16& p1, float& m_reg, float& mn, float& alpha) {
  constexpr float C = SCALE * 1.4426950408889634f;
  float pmax = p0[0];
#pragma unroll
  for (int r = 1; r < 16; ++r) pmax = fmaxf(pmax, p0[r]);
#pragma unroll
  for (int r = 0; r < 16; ++r) pmax = fmaxf(pmax, p1[r]);
  { auto rr = __builtin_amdgcn_permlane32_swap(__float_as_uint(pmax), __float_as_uint(pmax), false, false);
    pmax = fmaxf(__uint_as_float(rr[0]), __uint_as_float(rr[1])); }
  if (__builtin_expect(__all(pmax - m_reg <= THR / SCALE), 1)) { mn = m_reg; alpha = 1.f; }
  else { mn = fmaxf(m_reg, pmax); alpha = __builtin_amdgcn_exp2f((m_reg - mn) * C); m_reg = mn; }
  float mnC = -mn * C;
#pragma unroll
  for (int r = 0; r < 16; ++r) p0[r] = fmaf(p0[r], C, mnC);
#pragma unroll
  for (int r = 0; r < 16; ++r) p1[r] = fmaf(p1[r], C, mnC);
#pragma unroll
  for (int r = 0; r < 16; ++r) p0[r] = __builtin_amdgcn_exp2f(p0[r]);
}
__device__ __forceinline__ void finishSM(f32x16& p0, f32x16& p1, float alpha, float& l_reg, bf16x8& pa0, bf16x8& pa1, bf16x8& pa2, bf16x8& pa3) {
#pragma unroll
  for (int r = 0; r < 16; ++r) p1[r] = __builtin_amdgcn_exp2f(p1[r]);
  float ps = 0;
#pragma unroll
  for (int r = 0; r < 16; ++r) ps += p0[r];
#pragma unroll
  for (int r = 0; r < 16; ++r) ps += p1[r];
  { auto rr = __builtin_amdgcn_permlane32_swap(__float_as_uint(ps), __float_as_uint(ps), false, false);
    ps = __uint_as_float(rr[0]) + __uint_as_float(rr[1]); }
  l_reg = l_reg * alpha + ps;
#define PK4(P, BASE, OUT) do { unsigned a0 = cvtpk(P[BASE + 0], P[BASE + 1]), a1 = cvtpk(P[BASE + 2], P[BASE + 3]);   \
    unsigned b0 = cvtpk(P[BASE + 4], P[BASE + 5]), b1 = cvtpk(P[BASE + 6], P[BASE + 7]);                              \
    auto r0 = __builtin_amdgcn_permlane32_swap(a0, b0, false, false); auto r1 = __builtin_amdgcn_permlane32_swap(a1, b1, false, false); \
    u32x4 w = {r0[0], r1[0], r0[1], r1[1]}; OUT = *reinterpret_cast<bf16x8*>(&w); } while (0)
  PK4(p0, 0, pa0); PK4(p0, 8, pa1); PK4(p1, 0, pa2); PK4(p1, 8, pa3);
#undef PK4
}
__device__ __forceinline__ void qkt(f32x16& p0, f32x16& p1, const LAS char* Ks, const bf16x8 (&qr)[12], int r32, int hi) {
  p0 = f32x16{}; p1 = f32x16{};
#pragma unroll
  for (int d0 = 0; d0 < 12; ++d0) { const int cb = (d0 * 16 + hi * 8) * 2;
    const bf16x8 b0 = *reinterpret_cast<const LAS bf16x8*>(Ks + KSWZ(r32, cb));
    const bf16x8 b1 = *reinterpret_cast<const LAS bf16x8*>(Ks + KSWZ(32 + r32, cb));
    p0 = __builtin_amdgcn_mfma_f32_32x32x16_bf16(b0, qr[d0], p0, 0, 0, 0);
    p1 = __builtin_amdgcn_mfma_f32_32x32x16_bf16(b1, qr[d0], p1, 0, 0, 0); }
}
__device__ __forceinline__ int v_st(int k, int c) { const int kk = (k & ~0xC) | ((k & 4) << 1) | ((k & 8) >> 1); return ((kk >> 3) * 4 + (c >> 5)) * 512 + ((kk & 7) * 32 + (c & 31)) * 2; }
__device__ __forceinline__ int v_rd_base(int lane) { return ((lane & 3) << 3) | (((lane >> 2) & 3) << 6) | (((lane >> 4) & 1) << 5) | (((lane >> 5) & 1) << 8); }
constexpr int v_rd_off(int d0, int ks, int half) { return d0 * 512 + ks * 4096 + half * 2048; }
template <int OFF> __device__ __forceinline__ s16x4 tr_read(int vb) { s16x4 r; asm volatile("ds_read_b64_tr_b16 %0, %1 offset:%2" : "=&v"(r) : "v"(vb), "i"(OFF) : "memory"); return r; }
template <int D0> __device__ __forceinline__ void pv_one(f32x16& od, int vb, bf16x8 pa0, bf16x8 pa1, bf16x8 pa2, bf16x8 pa3) {
  const s16x4 l0 = tr_read<v_rd_off(D0, 0, 0)>(vb), h0 = tr_read<v_rd_off(D0, 0, 1)>(vb), l1 = tr_read<v_rd_off(D0, 1, 0)>(vb), h1 = tr_read<v_rd_off(D0, 1, 1)>(vb);
  const s16x4 l2 = tr_read<v_rd_off(D0, 2, 0)>(vb), h2 = tr_read<v_rd_off(D0, 2, 1)>(vb), l3 = tr_read<v_rd_off(D0, 3, 0)>(vb), h3 = tr_read<v_rd_off(D0, 3, 1)>(vb);
  asm volatile("s_waitcnt lgkmcnt(0)" ::: "memory"); SBAR();
#define PK(Lo, Hi) (bf16x8){Lo[0], Lo[1], Lo[2], Lo[3], Hi[0], Hi[1], Hi[2], Hi[3]}
  od = __builtin_amdgcn_mfma_f32_32x32x16_bf16(pa0, PK(l0, h0), od, 0, 0, 0);
  od = __builtin_amdgcn_mfma_f32_32x32x16_bf16(pa1, PK(l1, h1), od, 0, 0, 0);
  od = __builtin_amdgcn_mfma_f32_32x32x16_bf16(pa2, PK(l2, h2), od, 0, 0, 0);
  od = __builtin_amdgcn_mfma_f32_32x32x16_bf16(pa3, PK(l3, h3), od, 0, 0, 0);
#undef PK
}
__device__ __forceinline__ void pv_d0(f32x16 (&o)[4], int vb, bf16x8 pa0, bf16x8 pa1, bf16x8 pa2, bf16x8 pa3) {
  pv_one<0>(o[0], vb, pa0, pa1, pa2, pa3); pv_one<1>(o[1], vb, pa0, pa1, pa2, pa3); pv_one<2>(o[2], vb, pa0, pa1, pa2, pa3); pv_one<3>(o[3], vb, pa0, pa1, pa2, pa3);
}

__device__ __forceinline__ void attn_unit(const bf16_t* __restrict__ Qb, const bf16_t* __restrict__ Kh, const bf16_t* __restrict__ Vh, bf16_t* __restrict__ Ob, int t0, const float* __restrict__ ropet, LAS char* lds) {
  constexpr int LDQ = 1536, LDO = 1024, NT = NKEY / KVBLK;
  const int tid = otid(), wid = tid >> 6, lane = tid & 63, r32 = lane & 31, hi = lane >> 5;
  LAS char* V_lds = lds; LAS char* K_lds = lds + 2 * SHM_V;
  LAS float* wsl = (LAS float*)(lds + 2 * SHM_V + 2 * SHM_K) + wid * 64; LAS float* li_l = wsl; LAS float* al_l = wsl + 32;
  float m_reg = -1e30f, l_reg = 0; f32x16 o[4] = {}; bf16x8 qr[12];
  { const bf16_t* Qw = Qb + (size_t)(wid * QBLK + r32) * LDQ + hi * 8;
#pragma unroll
    for (int d0 = 0; d0 < 12; ++d0) qr[d0] = *reinterpret_cast<const bf16x8*>(Qw + d0 * 16);
    const float* rt = ropet + (size_t)(t0 + wid * QBLK + r32) * 64 + 8 * hi;
#pragma unroll
    for (int g = 0; g < 2; ++g) {
      const f32x4 c0 = *(const f32x4*)(rt + 16 * g), c1 = *(const f32x4*)(rt + 16 * g + 4), s0 = *(const f32x4*)(rt + 32 + 16 * g), s1 = *(const f32x4*)(rt + 32 + 16 * g + 4);
      float n1[8], n2[8];
#pragma unroll
      for (int j = 0; j < 8; ++j) { const float cs = j < 4 ? c0[j & 3] : c1[j & 3], sn = j < 4 ? s0[j & 3] : s1[j & 3];
        const float x1 = bf2f((bf16_t)qr[8 + g][j]), x2 = bf2f((bf16_t)qr[10 + g][j]); n1[j] = x1 * cs - x2 * sn; n2[j] = x1 * sn + x2 * cs; }
      u32x4 w1 = {cvtpk(n1[0], n1[1]), cvtpk(n1[2], n1[3]), cvtpk(n1[4], n1[5]), cvtpk(n1[6], n1[7])}; u32x4 w2 = {cvtpk(n2[0], n2[1]), cvtpk(n2[2], n2[3]), cvtpk(n2[4], n2[5]), cvtpk(n2[6], n2[7])};
      qr[8 + g] = *reinterpret_cast<bf16x8*>(&w1); qr[10 + g] = *reinterpret_cast<bf16x8*>(&w2); } }
  const int sr = tid >> 4, sc = (tid & 15) * 8, vst0 = v_st(sr, sc), vst1 = v_st(32 + sr, sc);
  int kgo[3], kst[3];
#pragma unroll
  for (int i = 0; i < 3; ++i) { const int c = tid + 512 * i, row = c / 24, c8 = (c % 24) * 8; kgo[i] = row * DK + c8; kst[i] = KSWZ(row, c8 * 2); }
  const int vb0 = (int)(uintptr_t)V_lds + v_rd_base(lane);
  bf16x8 sv0, sv1, sk0, sk1, sk2;
#define SLOAD(k0) do { sv0 = *reinterpret_cast<const bf16x8*>(&Vh[(size_t)((k0) + sr) * DV + sc]); sv1 = *reinterpret_cast<const bf16x8*>(&Vh[(size_t)((k0) + 32 + sr) * DV + sc]); \
    sk0 = *reinterpret_cast<const bf16x8*>(&Kh[(size_t)(k0) * DK + kgo[0]]); sk1 = *reinterpret_cast<const bf16x8*>(&Kh[(size_t)(k0) * DK + kgo[1]]); sk2 = *reinterpret_cast<const bf16x8*>(&Kh[(size_t)(k0) * DK + kgo[2]]); } while (0)
#define SWRITE(b) do { *(LAS bf16x8*)(V_lds + (b) * SHM_V + vst0) = sv0; *(LAS bf16x8*)(V_lds + (b) * SHM_V + vst1) = sv1; \
    *(LAS bf16x8*)(K_lds + (b) * SHM_K + kst[0]) = sk0; *(LAS bf16x8*)(K_lds + (b) * SHM_K + kst[1]) = sk1; *(LAS bf16x8*)(K_lds + (b) * SHM_K + kst[2]) = sk2; } while (0)
#define RESC(a) do { if (__any((a) < 1.f)) { if (hi == 0) al_l[r32] = (a); asm volatile("s_waitcnt lgkmcnt(0)" ::: "memory"); \
    _Pragma("unroll") for (int d = 0; d < 4; ++d) _Pragma("unroll") for (int r = 0; r < 16; ++r) o[d][r] *= al_l[crow(r, hi)]; } } while (0)
  f32x16 p0, p1; float mn, al; bf16x8 pa0, pa1, pa2, pa3;
  SLOAD(0); asm volatile("s_waitcnt vmcnt(0)" ::: "memory"); SWRITE(0); __syncthreads();
  for (int j = 0; j < NT; ++j) {
    const int bsel = j & 1;
    if (j + 1 < NT) SLOAD((j + 1) * KVBLK);
    SBAR(); qkt(p0, p1, K_lds + bsel * SHM_K, qr, r32, hi);
    partialSM(p0, p1, m_reg, mn, al);
    RESC(al);
    finishSM(p0, p1, al, l_reg, pa0, pa1, pa2, pa3); SBAR();
    pv_d0(o, vb0 + bsel * SHM_V, pa0, pa1, pa2, pa3);
    if (j + 1 < NT) { asm volatile("s_waitcnt vmcnt(0)" ::: "memory"); SWRITE(bsel ^ 1); }
    __syncthreads();
  }
  if (hi == 0) li_l[r32] = l_reg; asm volatile("s_waitcnt lgkmcnt(0)" ::: "memory");
  float rli[16];
#pragma unroll
  for (int r = 0; r < 16; ++r) rli[r] = __builtin_amdgcn_rcpf(li_l[crow(r, hi)]);
  { LAS bf16_t* ot = (LAS bf16_t*)(lds + wid * 8192);
#pragma unroll
    for (int r = 0; r < 16; ++r) { const int orow = crow(r, hi);
#pragma unroll
      for (int d0 = 0; d0 < 4; ++d0) ot[orow * 128 + d0 * 32 + r32] = f2bf(o[d0][r] * rli[r]); }
    asm volatile("s_waitcnt lgkmcnt(0)" ::: "memory");
    bf16_t* Ow = Ob + (size_t)(wid * QBLK) * LDO;
#pragma unroll
    for (int i = 0; i < 8; ++i) { const int q = lane + 64 * i, row = q >> 4, ch = q & 15; const u32x4 w = *(const LAS u32x4*)(ot + row * 128 + ch * 8); *(u32x4*)(Ow + (size_t)row * LDO + ch * 8) = w; } }
#undef SLOAD
#undef SWRITE
#undef RESC
}
}

__device__ __forceinline__ void phase_attn(const Params& p, LAS unsigned char* lds) {
    char* ws = p.ws; const bf16_t* Q = (const bf16_t*)(ws + OFF_Q); const bf16_t* Kb = (const bf16_t*)(ws + OFF_K); const bf16_t* Vb = (const bf16_t*)(ws + OFF_V); bf16_t* Y = (bf16_t*)(ws + OFF_H);
    const int G = gridDim.x;
    for (int it = 0;; ++it) {
        int u;
        if (G == 256) { const int c = blockIdx.x, xcd = c & 7, j = c >> 3; if (it >= 4) break; u = ((it * 32 + xcd * 4 + (j >> 3)) << 3) | (j & 7); }
        else { u = it * G + blockIdx.x; if (u >= 1024) break; }
        const int bh = u >> 3, qb = u & 7, b = bh >> 3, h = bh & 7;
        at::attn_unit(Q + ((size_t)(b * SEQ + qb * 256)) * 1536 + h * 192, Kb + (size_t)bh * NKEY * 192, Vb + (size_t)bh * NKEY * 128, Y + ((size_t)(b * SEQ + qb * 256)) * D + h * 128, qb * 256, (const float*)(ws + OFF_ROPE), (LAS char*)lds);
        __syncthreads();
    }
}

namespace sc {
using f32x16 = __attribute__((ext_vector_type(16))) float;
constexpr int BUFB = 53248, O_QT = 0, O_KH = 16384, O_VT = 32768, O_AT = 49152, O_DEC = 51200, O_KD = 2 * BUFB, LDS_SCAN = 2 * BUFB + 16384;
__device__ __forceinline__ int sw256(int row, int cb) { return row * 256 + (cb ^ ((row & 15) << 4)); }
__device__ __forceinline__ int sw128(int row, int cb) { return row * 128 + (cb ^ (((row >> 1) & 7) << 4)); }
__device__ __forceinline__ int grow_of(int n, int b, int dir) { if (n < CTXL) { const int s = dir ? (CTXL - 1 - n) : n; return L + b * CTXL + s; } const int m = n - CTXL; return b * SEQ + (dir ? (SEQ - 1 - m) : m); }
__device__ __forceinline__ bf16x8 pack_acc8(const f32x16& x, int s) { u32x4 p; p.x = cvt_pk_bf16(x[8 * s], x[8 * s + 1]); p.y = cvt_pk_bf16(x[8 * s + 2], x[8 * s + 3]); p.z = cvt_pk_bf16(x[8 * s + 4], x[8 * s + 5]); p.w = cvt_pk_bf16(x[8 * s + 6], x[8 * s + 7]); return __builtin_bit_cast(bf16x8, p); }

__device__ __forceinline__ void scan_unit(const Params& p, int unit, LAS unsigned char* lds) {
    char* ws = p.ws; const int dir = unit & 1, h = (unit >> 1) & 7, b = unit >> 4;
    const bf16_t* hq = (const bf16_t*)(ws + OFF_HQ); const bf16_t* fz = (const bf16_t*)(ws + (dir ? OFF_FB : OFF_FF)); const bf16_t* iv = (const bf16_t*)(ws + OFF_IV);
    bf16_t* outp = (bf16_t*)(ws + (dir ? OFF_OB : OFF_OF)); const float* lb = (const float*)(ws + OFF_LB);
    const int tid = otid(), wid = __builtin_amdgcn_readfirstlane(tid >> 6), lane = tid & 63, r32 = lane & 31, hi = lane >> 5;
    const int sgn = dir ? -1 : 1; const long rstep = (long)sgn * D;
    __syncthreads();
    if (wid >= 4) {
        const int I = wid - 4, cp = lane, hc = h * 128 + 2 * cp;
        const float lbv0 = lb[dir * 1024 + hc], lbv1 = lb[dir * 1024 + hc + 1];
        unsigned zr[16], vr[16], qr[16];
#define SC_LOAD(c) do { const size_t o0_ = (size_t)(grow_of((c) * 64, b, dir) + sgn * (16 * I)) * D + hc; const bf16_t* pz_ = fz + o0_; const bf16_t* pv_ = iv + o0_; const bf16_t* pq_ = hq + o0_; \
        _Pragma("unroll") for (int i = 0; i < 16; ++i) { zr[i] = *(const unsigned*)pz_; pz_ += rstep; vr[i] = *(const unsigned*)pv_; pv_ += rstep; if ((c) >= 4) { qr[i] = *(const unsigned*)pq_; pq_ += rstep; } } } while (0)
        SC_LOAD(0);
        for (int it = 0; it <= 36; ++it) {
            if (it < 36) {
                const int c = it; const bool lat = c >= 4; LAS unsigned char* B = lds + (c & 1) * BUFB; LAS unsigned char* KD = lds + O_KD;
                float kk0[16], kk1[16], lc0[16], lc1[16]; float run0 = 0.f, run1 = 0.f;
#pragma unroll
                for (int i = 0; i < 16; ++i) { const float z0 = __uint_as_float(zr[i] << 16), z1 = __uint_as_float(zr[i] & 0xffff0000u);
                    const float f0 = lbv0 + (1.0f - lbv0) * sigmoidf_(z0), f1 = lbv1 + (1.0f - lbv1) * sigmoidf_(z1); kk0[i] = 1.0f - f0; kk1[i] = 1.0f - f1;
                    run0 += __builtin_amdgcn_logf(f0) * 0.6931471805599453f; run1 += __builtin_amdgcn_logf(f1) * 0.6931471805599453f; lc0[i] = run0; lc1[i] = run1; }
                *(LAS f32x2*)(B + O_DEC + (I * 128 + 2 * cp) * 4) = (f32x2){__expf(run0), __expf(run1)};
                unsigned kh0[8], kh1[8], vt0[8], vt1[8];
#pragma unroll
                for (int i = 0; i < 16; ++i) { const int t = 16 * I + i; const float l0 = lc0[i], l1 = lc1[i];
                    const float kd0 = kk0[i] * __expf(fminf(-l0, 80.0f)), kd1 = kk1[i] * __expf(fminf(-l1, 80.0f));
                    const float kf0 = kk0[i] * __expf(run0 - l0), kf1 = kk1[i] * __expf(run1 - l1);
                    if (lat) { const float q0 = __uint_as_float(qr[i] << 16), q1 = __uint_as_float(qr[i] & 0xffff0000u);
                        *(LAS unsigned*)(B + O_QT + sw256(t, 4 * cp)) = cvt_pk_bf16(q0 * __expf(l0), q1 * __expf(l1)); *(LAS unsigned*)(KD + sw256(t, 4 * cp)) = cvt_pk_bf16(kd0, kd1); }
                    if (i & 1) { kh0[i >> 1] = cvt_pk_bf16(__uint_as_float(kh0[i >> 1]), kf0); kh1[i >> 1] = cvt_pk_bf16(__uint_as_float(kh1[i >> 1]), kf1); vt0[i >> 1] = (vt0[i >> 1] >> 16) | (vr[i] << 16); vt1[i >> 1] = (vt1[i >> 1] >> 16) | (vr[i] & 0xffff0000u); }
                    else { kh0[i >> 1] = __float_as_uint(kf0); kh1[i >> 1] = __float_as_uint(kf1); vt0[i >> 1] = vr[i] << 16; vt1[i >> 1] = vr[i] & 0xffff0000u; } }
#pragma unroll
                for (int q = 0; q < 2; ++q) {
                    *(LAS u32x4*)(B + O_KH + sw128(2 * cp, 32 * I + 16 * q)) = (u32x4){kh0[4 * q], kh0[4 * q + 1], kh0[4 * q + 2], kh0[4 * q + 3]}; *(LAS u32x4*)(B + O_KH + sw128(2 * cp + 1, 32 * I + 16 * q)) = (u32x4){kh1[4 * q], kh1[4 * q + 1], kh1[4 * q + 2], kh1[4 * q + 3]};
                    *(LAS u32x4*)(B + O_VT + sw128(2 * cp, 32 * I + 16 * q)) = (u32x4){vt0[4 * q], vt0[4 * q + 1], vt0[4 * q + 2], vt0[4 * q + 3]}; *(LAS u32x4*)(B + O_VT + sw128(2 * cp + 1, 32 * I + 16 * q)) = (u32x4){vt1[4 * q], vt1[4 * q + 1], vt1[4 * q + 2], vt1[4 * q + 3]}; }
                if (it + 1 < 36) SC_LOAD(it + 1);
                if (lat) {
                    const int l15 = lane & 15, lq = lane >> 4; f32x4 a = {0.f, 0.f, 0.f, 0.f};
#pragma unroll
                    for (int ks = 0; ks < 4; ++ks) { const bf16x8 av = *(const LAS bf16x8*)(B + O_QT + sw256(16 * I + l15, (32 * ks + 8 * lq) * 2)); const bf16x8 bv = *(const LAS bf16x8*)(KD + sw256(16 * I + l15, (32 * ks + 8 * lq) * 2));
                        a = __builtin_amdgcn_mfma_f32_16x16x32_bf16(av, bv, a, 0, 0, 0); }
#pragma unroll
                    for (int r = 0; r < 4; ++r) { const int tl = 4 * lq + r; float v = a[r]; if (l15 > tl) v = 0.f; *(LAS bf16_t*)(B + O_AT + ((I * 16 + tl) * 16 + l15) * 2) = f2bf(v); }
                }
            }
            __syncthreads();
        }
#undef SC_LOAD
    } else {
        const int bq = wid; f32x16 S[4];
#pragma unroll
        for (int a = 0; a < 4; ++a) S[a] = f32x16{};
        for (int it = 0; it <= 36; ++it) {
            if (it >= 1) {
                const int c = it - 1; const bool lat = c >= 4; LAS unsigned char* B = lds + (c & 1) * BUFB;
                bf16_t* po = outp + (size_t)(grow_of(c * 64, b, dir) + sgn * (4 * hi)) * D + h * 128 + 32 * bq + r32;
#pragma unroll
                for (int I = 0; I < 4; ++I) {
                    const bf16x8 vtf = *(const LAS bf16x8*)(B + O_VT + sw128(32 * bq + r32, (16 * I + 8 * hi) * 2));
                    if (lat) {
                        f32x16 o = f32x16{};
#pragma unroll
                        for (int a = 0; a < 4; ++a)
#pragma unroll
                            for (int s = 0; s < 2; ++s) { const int dk0 = 32 * a + 16 * s + 4 * hi; const int row = 16 * I + (r32 & 15);
                                const u32x2 lo2 = *(const LAS u32x2*)(B + O_QT + sw256(row, dk0 * 2)), hi2 = *(const LAS u32x2*)(B + O_QT + sw256(row, (dk0 + 8) * 2));
                                const u32x4 av = {lo2.x, lo2.y, hi2.x, hi2.y};
                                o = __builtin_amdgcn_mfma_f32_32x32x16_bf16(__builtin_bit_cast(bf16x8, av), pack_acc8(S[a], s), o, 0, 0, 0); }
                        { const bf16x8 af = *(const LAS bf16x8*)(B + O_AT + ((I * 16 + (r32 & 15)) * 16 + 8 * hi) * 2); o = __builtin_amdgcn_mfma_f32_32x32x16_bf16(af, vtf, o, 0, 0, 0); }
#pragma unroll
                        for (int r = 0; r < 8; ++r) po[(long)(16 * I + (r & 3) + 8 * (r >> 2)) * rstep] = f2bf(o[r]);
                    }
#pragma unroll
                    for (int a = 0; a < 4; ++a) {
#pragma unroll
                        for (int g = 0; g < 4; ++g) { const f32x4 dc = *(const LAS f32x4*)(B + O_DEC + (I * 128 + 32 * a + 8 * g + 4 * hi) * 4); S[a][4 * g] *= dc[0]; S[a][4 * g + 1] *= dc[1]; S[a][4 * g + 2] *= dc[2]; S[a][4 * g + 3] *= dc[3]; }
                        const bf16x8 kf = *(const LAS bf16x8*)(B + O_KH + sw128(32 * a + r32, (16 * I + 8 * hi) * 2));
                        S[a] = __builtin_amdgcn_mfma_f32_32x32x16_bf16(kf, vtf, S[a], 0, 0, 0); }
                }
            }
            __syncthreads();
        }
    }
    __syncthreads();
}
}
__device__ __forceinline__ void phase_scan(const Params& p, LAS unsigned char* lds) {
    for (int u = blockIdx.x; u < 256; u += gridDim.x) sc::scan_unit(p, u, lds);
}

constexpr int LDS_BYTES = 155648;
template <int PH> __global__ void __launch_bounds__(512, 2) k_phase(Params p) {
    extern __shared__ __attribute__((aligned(16))) unsigned char smem[];
    LAS unsigned char* lds = (LAS unsigned char*)smem;
    if constexpr (PH == 0) phase0(p, lds);
    if constexpr (PH == 1) phase1(p, lds);
    if constexpr (PH == 2) phase2(p, lds);
    if constexpr (PH == 3) phase3(p, lds);
    if constexpr (PH == 4) phase4(p, lds);
    if constexpr (PH == 5) phase5(p, lds);
    if constexpr (PH == 6) phase6(p, lds);
    if constexpr (PH == 7) phase7(p, lds);
    if constexpr (PH == 8) phase8(p, lds);
    if constexpr (PH == 9) phase9(p, lds);
    if constexpr (PH == 10) phase_attn(p, lds);
    if constexpr (PH == 11) phase_scan(p, lds);
}

#include <cstdint>
#include <cstdlib>
#include <vector>

#define XB_TMO      128
#define XB_XCNT(j)  (256  + 64 * (j))
#define XB_XSUB(j)  (1280 + 64 * (j))
#define XB_XGEN(j)  (2304 + 64 * (j))
#define XB_TOP      3328
#define XB_TOPGEN   3392
#define XCD_BAR_WORDS 3456
#define XB_SPIN_CAP (1u << 18)

__device__ __forceinline__ unsigned xb_ld(unsigned* p)              { return __hip_atomic_load(p, __ATOMIC_RELAXED, __HIP_MEMORY_SCOPE_AGENT); }
__device__ __forceinline__ unsigned xb_add(unsigned* p, unsigned v) { return __hip_atomic_fetch_add(p, v, __ATOMIC_RELAXED, __HIP_MEMORY_SCOPE_AGENT); }
__device__ __forceinline__ unsigned xb_xcc_id() { return (unsigned)__builtin_amdgcn_s_getreg((3 << 11) | 20) & 0xFu; }
#define XB_SPIN(cond, bar) do { unsigned _sp = 0; while (cond) { __builtin_amdgcn_s_sleep(1); \
    if ((++_sp & 255u) == 0u) { if (xb_ld(&(bar)[XB_TMO])) break; if (_sp > XB_SPIN_CAP) { atomicAdd(&(bar)[XB_TMO], 1u); break; } } } } while (0)

struct XcdBarrier {
    unsigned* bar; unsigned x;
    volatile LAS unsigned* st;
};

__device__ __forceinline__ XcdBarrier xcd_barrier_post(unsigned* bar, volatile LAS unsigned* st) {
    XcdBarrier b; b.bar = bar; b.x = xb_xcc_id(); b.st = st;
    if (threadIdx.x == 0) (void)xb_add(&bar[XB_XCNT(b.x)], 1u);
    return b;
}
__device__ __forceinline__ void xcd_barrier_complete(unsigned* bar, unsigned x, unsigned& nloc, unsigned& nx) {
    const unsigned G = gridDim.x * gridDim.y * gridDim.z;
    unsigned sum, cnt, mine, sp = 0u;
    for (;;) {
        sum = 0u; cnt = 0u; mine = 0u;
#pragma unroll
        for (unsigned j = 0; j < 16; ++j) { const unsigned c = xb_ld(&bar[XB_XCNT(j)]); sum += c; cnt += (c > 0u) ? 1u : 0u; mine = (j == x) ? c : mine; }
        if (sum == G) break;
        __builtin_amdgcn_s_sleep(1);
        if ((++sp & 255u) == 0u) { if (xb_ld(&bar[XB_TMO])) break; if (sp > XB_SPIN_CAP) { atomicAdd(&bar[XB_TMO], 1u); break; } }
    }
    nloc = mine > 0u ? mine : 1u; nx = cnt > 0u ? cnt : 1u;
}

__device__ __forceinline__ void xcd_barrier(const XcdBarrier& b) {
    asm volatile("s_waitcnt vmcnt(0)" ::: "memory");
    __syncthreads();
    if (threadIdx.x == 0) {
        unsigned* bar = b.bar;
        __builtin_amdgcn_s_waitcnt(0);
        unsigned nloc = b.st[0], nx = b.st[1];
        if (nloc == 0u) { xcd_barrier_complete(bar, b.x, nloc, nx); b.st[0] = nloc; b.st[1] = nx; }
        const unsigned old = xb_add(&bar[XB_XSUB(b.x)], 1u);
        const unsigned gen = old / nloc;
        if (old + 1u == (gen + 1u) * nloc) {
            __builtin_amdgcn_fence(__ATOMIC_RELEASE, "agent");
            asm volatile("s_waitcnt vmcnt(0)" ::: "memory");
            const unsigned og = xb_add(&bar[XB_TOP], 1u);
            const unsigned tg = og / nx;
            if (og + 1u == (tg + 1u) * nx) xb_add(&bar[XB_TOPGEN], 1u);
            else XB_SPIN(xb_ld(&bar[XB_TOPGEN]) == tg, bar);
            __builtin_amdgcn_fence(__ATOMIC_ACQUIRE, "agent");
            xb_add(&bar[XB_XGEN(b.x)], 1u);
            asm volatile("s_waitcnt vmcnt(0)" ::: "memory");
        } else {
            XB_SPIN(xb_ld(&bar[XB_XGEN(b.x)]) == gen, bar);
            __builtin_amdgcn_fence(__ATOMIC_ACQUIRE, "agent");
            asm volatile("s_waitcnt vmcnt(0)" ::: "memory");
        }
    }
    __syncthreads();
}

__global__ void __launch_bounds__(512, 2) k_mega(Params p) {
    extern __shared__ __attribute__((aligned(16))) unsigned char smem[];
    LAS unsigned char* lds = (LAS unsigned char*)smem;
    volatile LAS unsigned* xbw = (volatile LAS unsigned*)(lds + LDS_BYTES - 16);
    if (threadIdx.x == 0) { xbw[0] = 0u; xbw[1] = 0u; xbw[2] = 0u; xbw[3] = 0u; }
    __syncthreads();
    XcdBarrier bar = xcd_barrier_post((unsigned*)(p.ws + OFF_BAR), xbw);
    phase0(p, lds);      xcd_barrier(bar);
    phase1(p, lds);      xcd_barrier(bar);
    phase2(p, lds);      xcd_barrier(bar);
    phase3(p, lds);      xcd_barrier(bar);
    phase_attn(p, lds);
    phase_scan(p, lds);  xcd_barrier(bar);
    phase4(p, lds);      xcd_barrier(bar);
    phase5(p, lds);      xcd_barrier(bar);
    phase6(p, lds);      xcd_barrier(bar);
    phase7(p, lds);      xcd_barrier(bar);
    phase8(p, lds);      xcd_barrier(bar);
    phase9(p, lds);
}
extern "C" void kernel_launch(void* const* d_in, const int* in_sizes, int n_in, void* d_out, int out_size, void* d_ws, size_t ws_size, hipStream_t stream) {
    static int grid = 0;
    if (grid == 0) {
        int dev = 0, cus = 0, per_cu = 0;
        if (hipGetDevice(&dev) != hipSuccess || hipDeviceGetAttribute(&cus, hipDeviceAttributeMultiprocessorCount, dev) != hipSuccess) { grid = -1; return; }
        if (hipFuncSetAttribute((const void*)k_mega, hipFuncAttributeMaxDynamicSharedMemorySize, LDS_BYTES) != hipSuccess) { grid = -1; return; }
        (void)hipOccupancyMaxActiveBlocksPerMultiprocessor(&per_cu, (const void*)k_mega, 512, LDS_BYTES);
        (void)hipGetLastError();
        grid = cus;
    }
    if (grid < 0) return;
    Params p{};
    p.x = (const float*)d_in[0]; p.c = (const float*)d_in[1]; p.ctx = (const float*)d_in[2]; p.cctx = (const float*)d_in[3]; p.w_mod = (const float*)d_in[4]; p.b_mod = (const float*)d_in[5];
    p.g_mix = (const float*)d_in[6]; p.w_in = (const float*)d_in[7]; p.g_q = (const float*)d_in[8]; p.w_qb = (const float*)d_in[9]; p.g_kv = (const float*)d_in[10]; p.w_kvb = (const float*)d_in[11];
    p.lbl = (const float*)d_in[12]; p.g_hg = (const float*)d_in[13]; p.w_out = (const float*)d_in[14]; p.g_ffn = (const float*)d_in[15]; p.w_r = (const float*)d_in[16]; p.b_r = (const float*)d_in[17];
    p.w_gu = (const float*)d_in[18]; p.b_gu = (const float*)d_in[19]; p.w_dn = (const float*)d_in[20]; p.b_dn = (const float*)d_in[21]; p.g_fin = (const float*)d_in[22];
    p.out = (float*)d_out; p.ws = (char*)d_ws;
    (void)hipMemsetAsync((char*)d_ws + OFF_BAR, 0, 16384, stream);
    hipLaunchKernelGGL(k_mega, dim3(grid), dim3(512), LDS_BYTES, stream, p);
}
```

```cpp
#include <hip/hip_runtime.h>
#include <stdint.h>

typedef unsigned short bf16_t;
__device__ __forceinline__ float bf2f(bf16_t v) { return __uint_as_float(((unsigned)v) << 16); }
__device__ __forceinline__ bf16_t f2bf(float f) { unsigned u = __float_as_uint(f); u += 0x7FFFu + ((u >> 16) & 1u); return (bf16_t)(u >> 16); }
__device__ __forceinline__ float sigmoidf_(float x) { return __builtin_amdgcn_rcpf(1.0f + __builtin_amdgcn_exp2f(-1.4426950408889634f * x)); }
__device__ __forceinline__ float siluf_(float x) { return x * __builtin_amdgcn_rcpf(1.0f + __builtin_amdgcn_exp2f(-1.4426950408889634f * x)); }

constexpr int D = 1024, NB = 16, SEQ = 2048, CTXL = 256;
constexpr int L = NB * SEQ;
constexpr int RC = NB * CTXL;
constexpr int R = L + RC;
constexpr int NKEY = SEQ + CTXL;
constexpr float EPS = 1e-6f;
constexpr int NE = 32, CAP = 32768;
constexpr int MAXROWS = 131072 + NE * 256;

constexpr size_t MiB = 1048576;
constexpr size_t OFF_SMALL = 0;
constexpr size_t OFF_BAR = 0;
constexpr size_t OFF_CNT = 16384;
constexpr size_t OFF_OFFS = 16384 + 1024;
constexpr size_t OFF_TILEE = 16384 + 2048;
constexpr size_t OFF_LB = 24576;
constexpr size_t OFF_MOD = 32768;
constexpr size_t OFF_SSQQ = 512 * 1024;
constexpr size_t OFF_SSQKV = 768 * 1024;
constexpr size_t OFF_TOPI = 1 * MiB;
constexpr size_t OFF_TOPP = 1 * MiB + 512 * 1024;
constexpr size_t OFF_ROWPAIR = 2 * MiB;
constexpr size_t OFF_LIST = 3 * MiB;
constexpr size_t OFF_H = 32 * MiB;
constexpr size_t OFF_QA = 104 * MiB;
constexpr size_t OFF_CKV = 152 * MiB;
constexpr size_t OFF_KR = 170 * MiB;
constexpr size_t OFF_OF = 104 * MiB;
constexpr size_t OFF_HQ = 175 * MiB;
constexpr size_t SEG_STRIDE = 72 * MiB;
constexpr size_t OFF_FF = OFF_HQ + 1 * SEG_STRIDE;
constexpr size_t OFF_FB = OFF_HQ + 2 * SEG_STRIDE;
constexpr size_t OFF_IV = OFF_HQ + 3 * SEG_STRIDE;
constexpr size_t OFF_OG = OFF_HQ + 4 * SEG_STRIDE;
constexpr size_t OFF_GM = OFF_HQ + 5 * SEG_STRIDE;
constexpr size_t OFF_GH = OFF_HQ + 6 * SEG_STRIDE;
constexpr size_t OFF_Q = 679 * MiB;
constexpr size_t OFF_K = 775 * MiB;
constexpr size_t OFF_V = 883 * MiB;
constexpr size_t OFF_OB = 955 * MiB;
constexpr size_t OFF_YP = 296 * MiB;
constexpr size_t OFF_ACT = 568 * MiB;

struct SegOut { bf16_t *qa, *ckv, *kr, *hq, *ff, *fb, *iv, *og, *gm, *gh; };

__global__ void k_init(const float* __restrict__ lbl, float* lb, int* cnt) {
    int i = blockIdx.x * blockDim.x + threadIdx.x;
    if (i < 2048) { int d = i >> 10, j = i & 1023; float a = lbl[(d * 2 + 0) * 1024 + j], b = lbl[(d * 2 + 1) * 1024 + j]; lb[i] = 1.0f / (1.0f + __expf(b - a)); }
    if (i < 32) cnt[i] = 0;
}

__global__ __launch_bounds__(256) void k_mod(const float* __restrict__ c, const float* __restrict__ cctx, const float* __restrict__ wmod, const float* __restrict__ bmod, float* modv) {
    __shared__ float s[1024];
    int r = blockIdx.y; const float* src = r < 16 ? c + r * 1024 : cctx;
    for (int k = threadIdx.x; k < 1024; k += 256) s[k] = siluf_(src[k]);
    __syncthreads();
    int j = blockIdx.x * 256 + threadIdx.x; float acc = 0.f;
    for (int k = 0; k < 1024; ++k) acc += s[k] * wmod[(size_t)k * 6144 + j];
    modv[r * 6144 + j] = acc + bmod[j];
}

__device__ __forceinline__ float block_sum256(float v, float* red) {
    for (int o = 32; o > 0; o >>= 1) v += __shfl_xor(v, o);
    int w = threadIdx.x >> 6; if ((threadIdx.x & 63) == 0) red[w] = v; __syncthreads();
    float t = red[0] + red[1] + red[2] + red[3]; __syncthreads(); return t;
}

__global__ __launch_bounds__(256) void k_norm1(const float* __restrict__ x, const float* __restrict__ ctx, const float* __restrict__ g, const float* __restrict__ modv, bf16_t* h) {
    __shared__ float red[4];
    int row = blockIdx.x; const float* src = row < L ? x + (size_t)row * D : ctx + (size_t)(row - L) * D;
    const float* mod = modv + (row < L ? row / SEQ : 16) * 6144;
    int c = threadIdx.x * 4; float4 v = *(const float4*)(src + c);
    float ss = block_sum256(v.x * v.x + v.y * v.y + v.z * v.z + v.w * v.w, red);
    float rs = rsqrtf(ss * (1.0f / D) + EPS);
    float o[4] = {v.x, v.y, v.z, v.w}; ushort4 w; bf16_t* wp = (bf16_t*)&w;
    for (int i = 0; i < 4; ++i) wp[i] = f2bf(o[i] * rs * g[c + i] * (1.0f + mod[1024 + c + i]) + mod[c + i]);
    *(ushort4*)(h + (size_t)row * D + c) = w;
}

__global__ __launch_bounds__(256) void k_rowssq(const bf16_t* __restrict__ buf, int width, int nrows, float* ssq) {
    int row = blockIdx.x * 4 + (threadIdx.x >> 6), lane = threadIdx.x & 63; if (row >= nrows) return;
    float s = 0.f; for (int k = lane; k < width; k += 64) { float v = bf2f(buf[(size_t)row * width + k]); s += v * v; }
    for (int o = 32; o > 0; o >>= 1) s += __shfl_xor(s, o);
    if (lane == 0) ssq[row] = s;
}

__device__ __forceinline__ void rope_cs(int t, int i, float& cs, float& sn) {
    int j = i & 15; float inv = __expf(-(float)j * (9.210340371976184f / 16.0f)); float pos = (i < 16) ? (float)(t >> 6) : (float)(t & 63);
    float ang = pos * inv; cs = cosf(ang); sn = sinf(ang);
}

__global__ __launch_bounds__(256) void k_krope(const bf16_t* __restrict__ kr, bf16_t* Kb) {
    int gid = blockIdx.x * 256 + threadIdx.x; int row = gid >> 5, i = gid & 31; if (row >= R) return;
    float x1 = bf2f(kr[(size_t)row * 64 + i]), x2 = bf2f(kr[(size_t)row * 64 + 32 + i]); float o1 = x1, o2 = x2; int b, pos;
    if (row < L) { b = row / SEQ; pos = row % SEQ; float cs, sn; rope_cs(pos, i, cs, sn); o1 = x1 * cs - x2 * sn; o2 = x1 * sn + x2 * cs; }
    else { b = (row - L) / CTXL; pos = SEQ + (row - L) % CTXL; }
    bf16_t w1 = f2bf(o1), w2 = f2bf(o2);
    for (int h = 0; h < 8; ++h) { bf16_t* p = Kb + ((size_t)(b * 8 + h) * NKEY + pos) * 192 + 128; p[i] = w1; p[32 + i] = w2; }
}

template <class AL, class EP>
__global__ __launch_bounds__(256) void k_ngemm(int K, const float* __restrict__ W, int ldw, size_t wzstride, AL al, EP ep) {
    __shared__ float As[16][68]; __shared__ float Bs[16][64];
    const int z = blockIdx.z, row0 = blockIdx.y * 64, col0 = blockIdx.x * 64, tid = threadIdx.x;
    const int mvalid = al.rows(z); if (row0 >= mvalid) return;
    const float* Wz = W + (size_t)z * wzstride;
    const int ar = tid >> 2, ak = (tid & 3) * 4; const bf16_t* arow = (row0 + ar < mvalid) ? al.rowptr(z, row0 + ar) : nullptr;
    const int bk = tid >> 4, bn = (tid & 15) * 4;
    const int ty = tid >> 4, tx = tid & 15;
    float acc[4][4] = {};
    for (int k0 = 0; k0 < K; k0 += 16) {
        float a4[4] = {0.f, 0.f, 0.f, 0.f};
        if (arow) { ushort4 u = *(const ushort4*)(arow + k0 + ak); const bf16_t* up = (const bf16_t*)&u; for (int i = 0; i < 4; ++i) a4[i] = bf2f(up[i]) * al.kscale(k0 + ak + i); }
        float4 b4 = *(const float4*)(Wz + (size_t)(k0 + bk) * ldw + col0 + bn);
        __syncthreads();
        for (int i = 0; i < 4; ++i) As[ak + i][ar] = a4[i];
        *(float4*)&Bs[bk][bn] = b4;
        __syncthreads();
#pragma unroll
        for (int kk = 0; kk < 16; ++kk) {
            float4 av = *(const float4*)&As[kk][ty * 4]; float4 bv = *(const float4*)&Bs[kk][tx * 4];
            float a[4] = {av.x, av.y, av.z, av.w}, b[4] = {bv.x, bv.y, bv.z, bv.w};
#pragma unroll
            for (int i = 0; i < 4; ++i)
#pragma unroll
                for (int j = 0; j < 4; ++j) acc[i][j] += a[i] * b[j];
        }
    }
    for (int i = 0; i < 4; ++i) { int row = row0 + ty * 4 + i; if (row < mvalid) ep.store(z, row, col0 + tx * 4, acc[i]); }
}

__device__ __forceinline__ void st4bf(bf16_t* dst, const float* v) { ushort4 w; bf16_t* wp = (bf16_t*)&w; for (int i = 0; i < 4; ++i) wp[i] = f2bf(v[i]); *(ushort4*)dst = w; }

struct ALDense { const bf16_t* A; int lda; int nrows; const float* ks;
    __device__ int rows(int) const { return nrows; }
    __device__ const bf16_t* rowptr(int, int row) const { return A + (size_t)row * lda; }
    __device__ float kscale(int k) const { return ks ? ks[k] : 1.0f; } };

struct EpiInN { SegOut s;
    __device__ void store(int, int row, int col, const float* v) const {
        bf16_t* dst;
        if (col < 768) { if (row >= L) return; dst = s.qa + (size_t)row * 768 + col; }
        else if (col < 1024) dst = s.ckv + (size_t)row * 256 + (col - 768);
        else if (col < 1088) dst = s.kr + (size_t)row * 64 + (col - 1024);
        else { int c = col - 1088, seg = c >> 10, cc = c & 1023; bool latonly = (seg == 0 || seg >= 4); if (latonly && row >= L) return;
            bf16_t* base = seg == 0 ? s.hq : seg == 1 ? s.ff : seg == 2 ? s.fb : seg == 3 ? s.iv : seg == 4 ? s.og : seg == 5 ? s.gm : s.gh;
            dst = base + (size_t)row * 1024 + cc; }
        st4bf(dst, v);
    } };

struct EpiQN { bf16_t* q; const float* ssq;
    __device__ void store(int, int row, int col, const float* v) const { float rs = rsqrtf(ssq[row] * (1.0f / 768.0f) + EPS); float o[4]; for (int i = 0; i < 4; ++i) o[i] = v[i] * rs; st4bf(q + (size_t)row * 1536 + col, o); } };

struct EpiKVN { bf16_t *Kb, *Vb; const float* ssq;
    __device__ void store(int, int row, int col, const float* v) const {
        float rs = rsqrtf(ssq[row] * (1.0f / 256.0f) + EPS); float o[4]; for (int i = 0; i < 4; ++i) o[i] = v[i] * rs;
        int b, pos; if (row < L) { b = row / SEQ; pos = row % SEQ; } else { b = (row - L) / CTXL; pos = SEQ + (row - L) % CTXL; }
        int h = col >> 8, w = col & 255; size_t kvrow = (size_t)(b * 8 + h) * NKEY + pos;
        if (w < 128) st4bf(Kb + kvrow * 192 + w, o); else st4bf(Vb + kvrow * 128 + (w - 128), o);
    } };

struct EpiOutN { float* x1; const float* x; const float* modv;
    __device__ void store(int, int row, int col, const float* v) const {
        const float* gate = modv + (row / SEQ) * 6144 + 2 * 1024; float4 xv = *(const float4*)(x + (size_t)row * D + col);
        float4 o; o.x = xv.x + gate[col] * v[0]; o.y = xv.y + gate[col + 1] * v[1]; o.z = xv.z + gate[col + 2] * v[2]; o.w = xv.w + gate[col + 3] * v[3];
        *(float4*)(x1 + (size_t)row * D + col) = o;
    } };

struct ALMoe1 { const bf16_t* h2; const int* cnt; const int* list;
    __device__ int rows(int z) const { return cnt[z]; }
    __device__ const bf16_t* rowptr(int z, int row) const { return h2 + (size_t)(list[z * CAP + row] >> 2) * D; }
    __device__ float kscale(int) const { return 1.0f; } };
struct EpiMoe1N { bf16_t* act; const int* offs; const float* bgu;
    __device__ void store(int z, int row, int col, const float* v) const {
        const float* bb = bgu + z * 2048 + col; ushort2 w; bf16_t* wp = (bf16_t*)&w;
        for (int p = 0; p < 2; ++p) { float glu = fminf(v[2 * p] + bb[2 * p], 7.0f); float lin = fminf(fmaxf(v[2 * p + 1] + bb[2 * p + 1], -7.0f), 7.0f);
            wp[p] = f2bf(glu * sigmoidf_(1.702f * glu) * (lin + 1.0f)); }
        *(ushort2*)(act + (size_t)(offs[z] + row) * D + (col >> 1)) = w;
    } };
struct ALMoe2 { const bf16_t* act; const int* cnt; const int* offs;
    __device__ int rows(int z) const { return cnt[z]; }
    __device__ const bf16_t* rowptr(int z, int row) const { return act + (size_t)(offs[z] + row) * D; }
    __device__ float kscale(int) const { return 1.0f; } };
struct EpiMoe2N { bf16_t* yp; const int* list; const float* bd;
    __device__ void store(int z, int row, int col, const float* v) const {
        int pair = list[z * CAP + row]; const float* bb = bd + z * 1024 + col; float o[4]; for (int i = 0; i < 4; ++i) o[i] = v[i] + bb[i];
        st4bf(yp + (size_t)pair * D + col, o);
    } };

__global__ __launch_bounds__(256) void k_nattn(const bf16_t* __restrict__ Q, const bf16_t* __restrict__ Kb, const bf16_t* __restrict__ Vb, bf16_t* Y) {
    __shared__ float qs[4][192]; __shared__ float sc[4][NKEY];
    const int tid = threadIdx.x, blk = blockIdx.x, qg = blk & 511, h = (blk >> 9) & 7, b = blk >> 12;
    for (int idx = tid; idx < 4 * 192; idx += 256) { int qi = idx / 192, d = idx % 192; int row = b * SEQ + qg * 4 + qi; qs[qi][d] = bf2f(Q[(size_t)row * 1536 + h * 192 + d]); }
    __syncthreads();
    float n1 = 0.f, n2 = 0.f;
    if (tid < 128) { int qi = tid >> 5, i = tid & 31; int t = qg * 4 + qi; float cs, sn; rope_cs(t, i, cs, sn); float x1 = qs[qi][128 + i], x2 = qs[qi][160 + i]; n1 = x1 * cs - x2 * sn; n2 = x1 * sn + x2 * cs; }
    __syncthreads();
    if (tid < 128) { int qi = tid >> 5, i = tid & 31; qs[qi][128 + i] = n1; qs[qi][160 + i] = n2; }
    __syncthreads();
    const bf16_t* Kp = Kb + (size_t)(b * 8 + h) * NKEY * 192; const bf16_t* Vp = Vb + (size_t)(b * 8 + h) * NKEY * 128;
    const float scale = 0.07216878364870322f;
    for (int key = tid; key < NKEY; key += 256) {
        const bf16_t* kr = Kp + (size_t)key * 192; float s0 = 0.f, s1 = 0.f, s2 = 0.f, s3 = 0.f;
        for (int d = 0; d < 192; d += 8) { uint4 u = *(const uint4*)(kr + d); const bf16_t* up = (const bf16_t*)&u;
            for (int j = 0; j < 8; ++j) { float kv = bf2f(up[j]); s0 += qs[0][d + j] * kv; s1 += qs[1][d + j] * kv; s2 += qs[2][d + j] * kv; s3 += qs[3][d + j] * kv; } }
        sc[0][key] = s0 * scale; sc[1][key] = s1 * scale; sc[2][key] = s2 * scale; sc[3][key] = s3 * scale;
    }
    __syncthreads();
    { int w = tid >> 6, lane = tid & 63; float m = -1e30f; for (int k = lane; k < NKEY; k += 64) m = fmaxf(m, sc[w][k]);
      for (int o = 32; o > 0; o >>= 1) m = fmaxf(m, __shfl_xor(m, o));
      float s = 0.f; for (int k = lane; k < NKEY; k += 64) { float e = __expf(sc[w][k] - m); sc[w][k] = e; s += e; }
      for (int o = 32; o > 0; o >>= 1) s += __shfl_xor(s, o);
      float inv = 1.0f / s; for (int k = lane; k < NKEY; k += 64) sc[w][k] *= inv; }
    __syncthreads();
    { int dv = tid & 127, qh = tid >> 7; float o0 = 0.f, o1 = 0.f;
      for (int k = 0; k < NKEY; ++k) { float v = bf2f(Vp[(size_t)k * 128 + dv]); o0 += sc[qh * 2][k] * v; o1 += sc[qh * 2 + 1][k] * v; }
      int row = b * SEQ + qg * 4 + qh * 2; Y[(size_t)row * D + h * 128 + dv] = f2bf(o0); Y[(size_t)(row + 1) * D + h * 128 + dv] = f2bf(o1); }
}

__global__ __launch_bounds__(256) void k_nscan(const bf16_t* __restrict__ hq, const bf16_t* __restrict__ ff, const bf16_t* __restrict__ fb, const bf16_t* __restrict__ iv, const float* __restrict__ lb, bf16_t* of, bf16_t* ob) {
    __shared__ float sf[128], sk[128], sq[128], so[2][128];
    const int tid = threadIdx.x, blk = blockIdx.x, dir = blk & 1, h = (blk >> 1) & 7, b = blk >> 4;
    const bf16_t* fz = dir ? fb : ff; bf16_t* out = dir ? ob : of;
    const int dv = tid & 127, half = tid >> 7;
    float S[64];
#pragma unroll
    for (int j = 0; j < 64; ++j) S[j] = 0.f;
    const float lbv = lb[dir * 1024 + h * 128 + (tid & 127)];
    for (int step = 0; step < NKEY; ++step) {
        int row; bool islat;
        if (step < CTXL) { int s = dir ? (CTXL - 1 - step) : step; row = L + b * CTXL + s; islat = false; }
        else { int t = step - CTXL; t = dir ? (SEQ - 1 - t) : t; row = b * SEQ + t; islat = true; }
        if (tid < 128) { float z = bf2f(fz[(size_t)row * D + h * 128 + tid]); float f = lbv + (1.0f - lbv) * sigmoidf_(z); sf[tid] = f; sk[tid] = 1.0f - f;
            if (islat) { float zq = bf2f(hq[(size_t)row * D + h * 128 + tid]); sq[tid] = siluf_(zq) * 0.08838834764831845f; } }
        float v = bf2f(iv[(size_t)row * D + h * 128 + dv]);
        __syncthreads();
        float o = 0.f;
#pragma unroll
        for (int j = 0; j < 64; ++j) { int dk = half * 64 + j; S[j] = sf[dk] * S[j] + sk[dk] * v; o += S[j] * sq[dk]; }
        if (islat) so[half][dv] = o;
        __syncthreads();
        if (islat && half == 0) out[(size_t)row * D + h * 128 + dv] = f2bf(so[0][dv] + so[1][dv]);
    }
}

__global__ __launch_bounds__(256) void k_merge(bf16_t* y, const bf16_t* __restrict__ of, const bf16_t* __restrict__ ob, const bf16_t* __restrict__ og, const bf16_t* __restrict__ gm, const bf16_t* __restrict__ gh, const float* __restrict__ ghg) {
    int row = blockIdx.x, c = threadIdx.x * 4; size_t off = (size_t)row * D + c;
    ushort4 a = *(const ushort4*)(of + off), bb = *(const ushort4*)(ob + off), g1 = *(const ushort4*)(og + off), g2 = *(const ushort4*)(gm + off), g3 = *(const ushort4*)(gh + off), ym = *(const ushort4*)(y + off);
    const bf16_t *ap = (const bf16_t*)&a, *bp = (const bf16_t*)&bb, *p1 = (const bf16_t*)&g1, *p2 = (const bf16_t*)&g2, *p3 = (const bf16_t*)&g3, *pm = (const bf16_t*)&ym;
    float o[4], ss = 0.f; for (int i = 0; i < 4; ++i) { o[i] = bf2f(ap[i]) + bf2f(bp[i]); ss += o[i] * o[i]; }
    for (int m = 16; m > 0; m >>= 1) ss += __shfl_xor(ss, m);
    float rs = rsqrtf(ss * (1.0f / 128.0f) + EPS); float r[4];
    for (int i = 0; i < 4; ++i) { float yh = o[i] * rs * ghg[(c + i) & 127] * siluf_(bf2f(p1[i])); r[i] = sigmoidf_(bf2f(p2[i])) * bf2f(pm[i]) + sigmoidf_(bf2f(p3[i])) * yh; }
    st4bf(y + off, r);
}

__global__ __launch_bounds__(256) void k_norm2_router(const float* __restrict__ x1, const float* __restrict__ g, const float* __restrict__ modv, const float* __restrict__ wr, const float* __restrict__ br, bf16_t* h2, int* topi, float* topp, int* cnt, int* list) {
    __shared__ float red[4]; __shared__ float hs[1024]; __shared__ float part[8][32];
    int row = blockIdx.x, tid = threadIdx.x, c = tid * 4; const float* mod = modv + (row / SEQ) * 6144;
    float4 v = *(const float4*)(x1 + (size_t)row * D + c);
    float ss = block_sum256(v.x * v.x + v.y * v.y + v.z * v.z + v.w * v.w, red); float rs = rsqrtf(ss * (1.0f / D) + EPS);
    float xv[4] = {v.x, v.y, v.z, v.w}, o[4];
    for (int i = 0; i < 4; ++i) { o[i] = xv[i] * rs * g[c + i] * (1.0f + mod[4 * 1024 + c + i]) + mod[3 * 1024 + c + i]; hs[c + i] = o[i]; }
    st4bf(h2 + (size_t)row * D + c, o);
    __syncthreads();
    { int e = tid & 31, p = tid >> 5; float a = 0.f; for (int j = p * 128; j < p * 128 + 128; ++j) a += hs[j] * wr[j * 32 + e]; part[p][e] = a; }
    __syncthreads();
    if (tid < 64) {
        int e = tid & 31; float cur = br[e];
#pragma unroll
        for (int p = 0; p < 8; ++p) cur += part[p][e];
        float tv0 = 0.f, sum = 0.f; float myp = 0.f; int myk = -1;
        int sel_i[4]; float sel_e[4];
#pragma unroll
        for (int k = 0; k < 4; ++k) {
            float m = cur; int mi = e;
#pragma unroll
            for (int o = 16; o > 0; o >>= 1) { float om = __shfl_xor(m, o); int oi = __shfl_xor(mi, o); if (om > m || (om == m && oi < mi)) { m = om; mi = oi; } }
            if (k == 0) tv0 = m;
            sel_i[k] = mi; sel_e[k] = __expf(m - tv0); sum += sel_e[k];
            if (e == mi) cur = -3.0e38f;
        }
#pragma unroll
        for (int k = 0; k < 4; ++k) if (tid == k) { myk = sel_i[k]; myp = sel_e[k] / sum; }
        if (tid < 4) { int pair = row * 4 + tid; topi[pair] = myk; topp[pair] = myp; int pos = atomicAdd(&cnt[myk], 1); list[myk * CAP + pos] = pair; }
    }
}

__global__ void k_moe_offs(const int* cnt, int* offs, int* tilee) {
    if (threadIdx.x == 0 && blockIdx.x == 0) { int o = 0, t = 0; for (int e = 0; e < NE; ++e) { offs[e] = o; int nt = (cnt[e] + 255) >> 8; for (int i = 0; i < nt; ++i) tilee[t++] = e; o += nt * 256; } offs[NE] = o; offs[NE + 1] = t; }
}

__global__ __launch_bounds__(256) void k_final(float* out, const bf16_t* __restrict__ yp, const float* __restrict__ topp, const float* __restrict__ modv, const float* __restrict__ fg) {
    __shared__ float red[4];
    int row = blockIdx.x, c = threadIdx.x * 4; const float* gate = modv + (row / SEQ) * 6144 + 5 * 1024;
    float4 v = *(const float4*)(out + (size_t)row * D + c); float xv[4] = {v.x, v.y, v.z, v.w}; float m[4] = {0.f, 0.f, 0.f, 0.f};
    for (int k = 0; k < 4; ++k) { float p = topp[row * 4 + k]; ushort4 u = *(const ushort4*)(yp + (size_t)(row * 4 + k) * D + c); const bf16_t* up = (const bf16_t*)&u; for (int i = 0; i < 4; ++i) m[i] += p * bf2f(up[i]); }
    float ss = 0.f; for (int i = 0; i < 4; ++i) { xv[i] += gate[c + i] * m[i]; ss += xv[i] * xv[i]; }
    ss = block_sum256(ss, red); float rs = rsqrtf(ss * (1.0f / D) + EPS);
    float4 o; o.x = xv[0] * rs * fg[c]; o.y = xv[1] * rs * fg[c + 1]; o.z = xv[2] * rs * fg[c + 2]; o.w = xv[3] * rs * fg[c + 3];
    *(float4*)(out + (size_t)row * D + c) = o;
}

#define LAS __attribute__((address_space(3)))
__device__ __forceinline__ int otid() { int t = threadIdx.x; asm volatile("" : "+v"(t)); return t; }
typedef short bf16x8 __attribute__((ext_vector_type(8)));
typedef float f32x4 __attribute__((ext_vector_type(4)));
typedef unsigned u32x4 __attribute__((ext_vector_type(4)));
typedef unsigned u32x2 __attribute__((ext_vector_type(2)));
typedef float f32x2 __attribute__((ext_vector_type(2)));

constexpr size_t OFF_ROPE = 7 * MiB;
constexpr size_t OFF_WT_IN = 8 * MiB;
constexpr size_t OFF_WT_QB = 25 * MiB;
constexpr size_t OFF_WT_KVB = 28 * MiB;
constexpr size_t OFF_WT_OUT = 29 * MiB;
constexpr size_t OFF_WT_GU = 104 * MiB;
constexpr size_t OFF_WT_DN = 232 * MiB;
constexpr size_t OFF_X1 = 704 * MiB;

struct Params {
    const float *x, *c, *ctx, *cctx, *w_mod, *b_mod, *g_mix, *w_in, *g_q, *w_qb, *g_kv, *w_kvb, *lbl, *g_hg, *w_out, *g_ffn, *w_r, *b_r, *w_gu, *b_gu, *w_dn, *b_dn, *g_fin;
    float* out; char* ws;
};

typedef __bf16 bf16v2_t __attribute__((ext_vector_type(2)));
__device__ __forceinline__ unsigned cvt_pk_bf16(float lo, float hi) { bf16v2_t v = {(__bf16)lo, (__bf16)hi}; return __builtin_bit_cast(unsigned, v); }

__device__ __forceinline__ unsigned pack4_fp8(float a, float b, float c, float d) {
    a = __builtin_amdgcn_fmed3f(a, -448.f, 448.f); b = __builtin_amdgcn_fmed3f(b, -448.f, 448.f); c = __builtin_amdgcn_fmed3f(c, -448.f, 448.f); d = __builtin_amdgcn_fmed3f(d, -448.f, 448.f);
    unsigned w = 0; w = __builtin_amdgcn_cvt_pk_fp8_f32(a, b, w, false); w = __builtin_amdgcn_cvt_pk_fp8_f32(c, d, w, true); return w; }

namespace pg8 {
constexpr int BM = 256, BK = 64, HALF = 128, HTB = HALF * BK * 2, STAGE_BYTES = 8 * HTB, NXCD = 8, WGM = 8;
constexpr int LDS_IDX = STAGE_BYTES + 8192;
__device__ __forceinline__ int lds_byte(int r, int c) { const int st = (r >> 4) * 2 + (c >> 5), rr = r & 15, cc = c & 31, ob = rr * 64 + cc * 2; return st * 1024 + (ob ^ (((ob >> 9) & 1) << 5)); }
__device__ __forceinline__ void stage_rc(int b, int& R, int& C) { const int st = b / 1024, sb = b % 1024, swz = sb ^ (((sb >> 9) & 1) << 5); R = (st >> 1) * 16 + swz / 64; C = (st & 1) * 32 + (swz % 64) / 2; }
__device__ __forceinline__ int perm32(int rho) { const int n = rho >> 4, i = rho & 15; return 8 * (i >> 2) + 4 * n + (i & 3); }
struct Unit { int pm, pn; const char* b; int e, pos0, cnt; };

__device__ __forceinline__ int xcd_remap(int L, int nwg) { const int q = nwg / NXCD, r = nwg % NXCD, xcd = L % NXCD, off = L / NXCD; return (xcd < r ? xcd * (q + 1) : r * (q + 1) + (xcd - r) * q) + off; }

struct DenseSched {
    int nM, nN, nwg, G, c, rowb; const char* Bt; size_t btile;
    __device__ void init(int M, int N, int kbytes, int rowb_, const void* Bt_, int G_, int c_) { nM = M / BM; nN = N / BM; nwg = nM * nN; G = G_; c = c_; rowb = rowb_; Bt = (const char*)Bt_; btile = (size_t)BM * kbytes; }
    static constexpr bool GATHER_LDS = false;
    __device__ __forceinline__ int kstepA() const { return 128; }
    __device__ __forceinline__ void tile(int wgid, int& pm, int& pn) const { const int nig = WGM * nN, gid = wgid / nig, fm = gid * WGM, gsz = (nM - fm) < WGM ? (nM - fm) : WGM; pm = fm + ((wgid % nig) % gsz); pn = (wgid % nig) / gsz; }
    __device__ __forceinline__ bool next(int i, Unit& u) const { const int Lx = i * G + c; if (Lx >= nwg) return false; tile(xcd_remap(Lx, nwg), u.pm, u.pn); u.b = Bt + (size_t)u.pn * btile; u.e = 0; u.pos0 = 0; u.cnt = 0; return true; }
    __device__ __forceinline__ void aoff(const Unit& u, const int (&Rr)[2], const int (&Cc)[2], unsigned (&va)[2][2]) const {
#pragma unroll
        for (int h = 0; h < 2; ++h)
#pragma unroll
            for (int i = 0; i < 2; ++i) va[h][i] = (unsigned)((u.pm * BM + h * HALF + Rr[i]) * rowb + Cc[i] * 2); }
};
struct InSched : DenseSched {
    __device__ void init2(const void* Bt_, int G_, int c_) { init(L, 8448, 1024, 1024, Bt_, G_, c_); }
    __device__ __forceinline__ bool next(int i, Unit& u) const {
        const int Lx = i * G + c; const int nlat = nwg;
        if (Lx < nlat) { tile(xcd_remap(Lx, nlat), u.pm, u.pn); }
        else { const int j = Lx - nlat; if (j >= 16 * 14) return false; const int q = j >> 4; u.pm = 128 + (j & 15); u.pn = q == 0 ? 3 : (q <= 12 ? 7 + q : 32); }
        u.b = Bt + (size_t)u.pn * btile; u.e = 0; u.pos0 = 0; u.cnt = 0; return true; }
};
__device__ __forceinline__ unsigned act_piece_off(int r, int c16) { const int s = 2 * (r >> 7) + (c16 >> 2), w = 4 * ((r >> 6) & 1) + (c16 & 3), l = 16 * ((r >> 4) & 3) + (r & 15); return (unsigned)(((s * 8 + w) * 64 + l) * 16); }
template <bool GATHER> struct MoeSched {
    int nN, G, c, rowb; const char* Wt; size_t wexp, btile; const LAS int* tab; const int* list;
    static constexpr bool GATHER_LDS = GATHER;
    __device__ __forceinline__ int kstepA() const { return GATHER ? 128 : 32768; }
    __device__ __forceinline__ bool next(int i, Unit& u) const {
        const int nwg = tab[33] * nN; const int Lx = i * G + c; if (Lx >= nwg) return false;
        const int w = xcd_remap(Lx, nwg); const int rt = w / nN; u.pn = w % nN; u.pm = rt;
        const int e = tab[128 + rt];
        u.e = e; u.pos0 = (rt - tab[e]) * BM; u.cnt = tab[64 + e]; u.b = Wt + (size_t)e * wexp + (size_t)u.pn * btile; return true; }
    __device__ __forceinline__ void aoff(const Unit& u, const int (&Rr)[2], const int (&Cc)[2], unsigned (&va)[2][2]) const {
#pragma unroll
        for (int h = 0; h < 2; ++h)
#pragma unroll
            for (int i = 0; i < 2; ++i) {
                if (GATHER) { const int pos = u.pos0 + h * HALF + Rr[i]; const int pair = pos < u.cnt ? list[u.e * CAP + pos] : 0; va[h][i] = (unsigned)((pair >> 2) * rowb + Cc[i] * 2); }
                else va[h][i] = (unsigned)u.pm * 262144u + act_piece_off(h * HALF + Rr[i], Cc[i] >> 3); } }
};

typedef int v8i_t __attribute__((ext_vector_type(8)));
typedef int i32x4_t __attribute__((ext_vector_type(4)));
template <class Epi, class Sched, bool FP8 = false, int SCA = 127, int SCB = 127>
__device__ __forceinline__ void gemm_phase(LAS unsigned char* lds, const char* Abase, const int K, const Sched& S, const Epi& E) {
    const int tid = otid(), wid = __builtin_amdgcn_readfirstlane(tid >> 6), lane = tid & 63, wr = wid >> 2, wc = wid & 3, fr = lane & 15, fq = lane >> 4;
    const int Kb = FP8 ? K : 2 * K;
    const int nt = Kb / (BK * 2);
    int Rr[2], Cc[2]; unsigned voffB[2];
#pragma unroll
    for (int i = 0; i < 2; ++i) { int R_, C_; stage_rc(tid * 16 + i * 8192, R_, C_); Rr[i] = R_; Cc[i] = C_; const int Rb = 64 * (R_ >> 5) + (Epi::PERM ? perm32(R_ & 31) : (R_ & 31)); voffB[i] = (unsigned)(Rb * Kb + C_ * 2); }
    const size_t kstep = (size_t)(BK * 2);
    const size_t kstepA = (size_t)S.kstepA();
    const size_t hstep = (size_t)32 * Kb;
    const unsigned ldsw = (unsigned)wid * 1024u;
    const int aoff = lds_byte(wr * 64 + fr, fq * 8), boff = lds_byte(wc * 32 + fr, fq * 8);
#define PG8_SA(b, h) (((b) * 2 + (h)) * HTB)
#define PG8_SB(b, h) ((4 + (b) * 2 + (h)) * HTB)
#define PG8_STAGE_B(bufoff, gbase) do { _Pragma("unroll") for (int _i = 0; _i < 2; ++_i) \
        __builtin_amdgcn_global_load_lds((const unsigned*)((const char*)(gbase) + voffB[_i]), (LAS unsigned*)(lds + (bufoff) + ldsw + _i * 8192), 16, 0, 0); } while (0)
#define PG8_STAGE_A(bufoff, v0, v1, kb) do { \
        __builtin_amdgcn_global_load_lds((const unsigned*)(Abase + (kb) + (v0)), (LAS unsigned*)(lds + (bufoff) + ldsw), 16, 0, 0); \
        __builtin_amdgcn_global_load_lds((const unsigned*)(Abase + (kb) + (v1)), (LAS unsigned*)(lds + (bufoff) + ldsw + 8192), 16, 0, 0); } while (0)
#define PG8_LD16(addr) (*(const LAS i32x4_t*)(addr))
#define PG8_LDA(dst, b, h) do { _Pragma("unroll") for (int m = 0; m < 4; ++m) { if constexpr (FP8) dst##8[m] = __builtin_shufflevector(PG8_LD16(lds + PG8_SA(b, h) + aoff + m * 2048), PG8_LD16(lds + PG8_SA(b, h) + aoff + m * 2048 + 1024), 0, 1, 2, 3, 4, 5, 6, 7); \
        else { _Pragma("unroll") for (int k = 0; k < 2; ++k) dst[m][k] = *(const LAS bf16x8*)(lds + PG8_SA(b, h) + aoff + m * 2048 + k * 1024); } } } while (0)
#define PG8_LDB(dst, b, h) do { _Pragma("unroll") for (int n = 0; n < 2; ++n) { if constexpr (FP8) dst##8[n] = __builtin_shufflevector(PG8_LD16(lds + PG8_SB(b, h) + boff + n * 2048), PG8_LD16(lds + PG8_SB(b, h) + boff + n * 2048 + 1024), 0, 1, 2, 3, 4, 5, 6, 7); \
        else { _Pragma("unroll") for (int k = 0; k < 2; ++k) dst[n][k] = *(const LAS bf16x8*)(lds + PG8_SB(b, h) + boff + n * 2048 + k * 1024); } } } while (0)
#define PG8_MMA(ai, bj, At, Bt) do { __builtin_amdgcn_s_setprio(1); _Pragma("unroll") for (int m = 0; m < 4; ++m) _Pragma("unroll") for (int n = 0; n < 2; ++n) { \
        if constexpr (FP8) asm volatile("v_mfma_scale_f32_16x16x128_f8f6f4 %0, %1, %2, %0, %3, %4 op_sel_hi:[0,0,0]" : "+v"(acc[ai][bj][m][n]) : "v"(Bt##8[n]), "v"(At##8[m]), "v"(scb_), "v"(sca_)); \
        else { _Pragma("unroll") for (int k = 0; k < 2; ++k) acc[ai][bj][m][n] = __builtin_amdgcn_mfma_f32_16x16x32_bf16(Bt[n][k], At[m][k], acc[ai][bj][m][n], 0, 0, 0); } } \
        __builtin_amdgcn_s_setprio(0); } while (0)
#define PG8_WAIT_V(n) asm volatile("s_waitcnt vmcnt(" #n ")" ::: "memory")
#define PG8_WAIT_L(n) asm volatile("s_waitcnt lgkmcnt(" #n ")" ::: "memory")
#define PG8_BAR __builtin_amdgcn_s_barrier()
#define PG8_SCHED __builtin_amdgcn_sched_barrier(0)
    Unit cur, nxt; int ui = 0;
    if (!S.next(0, cur)) return;
    f32x4 acc[2][2][4][2];
#pragma unroll
    for (int a = 0; a < 2; ++a)
#pragma unroll
        for (int b = 0; b < 2; ++b)
#pragma unroll
            for (int m = 0; m < 4; ++m)
#pragma unroll
                for (int n = 0; n < 2; ++n) acc[a][b][m][n] = (f32x4){0.f, 0.f, 0.f, 0.f};
    const int sca_ = SCA, scb_ = SCB;
    bf16x8 At[4][2], B0[2][2], B1[2][2]; v8i_t At8[4], B08[2], B18[2];
    unsigned vc[2][2], vn[2][2];
    S.aoff(cur, Rr, Cc, vc);
    const char* cB = cur.b;
    PG8_STAGE_B(PG8_SB(0, 0), cB); PG8_STAGE_A(PG8_SA(0, 0), vc[0][0], vc[0][1], 0); PG8_STAGE_B(PG8_SB(0, 1), cB + hstep); PG8_STAGE_A(PG8_SA(0, 1), vc[1][0], vc[1][1], 0);
    if (wr == 1) PG8_BAR;
    PG8_WAIT_V(4); PG8_BAR;
    PG8_STAGE_B(PG8_SB(1, 0), cB + kstep); PG8_STAGE_A(PG8_SA(1, 0), vc[0][0], vc[0][1], kstepA); PG8_STAGE_B(PG8_SB(1, 1), cB + hstep + kstep);
    PG8_WAIT_V(6); PG8_BAR;
    for (;;) {
        const bool has_next = S.next(ui + 1, nxt);
        if constexpr (Sched::GATHER_LDS) {
            if (has_next && wid < 4) __builtin_amdgcn_global_load_lds((const unsigned*)(S.list + nxt.e * CAP + nxt.pos0 + tid), (LAS unsigned*)(lds + LDS_IDX + wid * 256), 4, 0, 0);
        } else if (has_next) S.aoff(nxt, Rr, Cc, vn);
        if (!has_next) {
#pragma unroll
            for (int h = 0; h < 2; ++h)
#pragma unroll
                for (int i = 0; i < 2; ++i) vn[h][i] = vc[h][i]; }
        const char* nB = has_next ? nxt.b : cB;
#pragma unroll 1
        for (int t = 0; t < nt; t += 2) {
            const bool last = (t == nt - 2);
            if constexpr (Sched::GATHER_LDS) { if (last && has_next) {
#pragma unroll
                for (int h = 0; h < 2; ++h)
#pragma unroll
                    for (int i = 0; i < 2; ++i) { const int rr = h * HALF + Rr[i]; const int pair = (nxt.pos0 + rr) < nxt.cnt ? ((const LAS int*)(lds + LDS_IDX))[rr] : 0; vn[h][i] = (unsigned)((pair >> 2) * S.rowb + Cc[i] * 2); } } }
            const size_t k1 = (size_t)(t + 1) * kstepA;
            const size_t k2 = last ? 0 : (size_t)(t + 2) * kstepA;
            const unsigned s00 = last ? vn[0][0] : vc[0][0], s01 = last ? vn[0][1] : vc[0][1], s10 = last ? vn[1][0] : vc[1][0], s11 = last ? vn[1][1] : vc[1][1];
            const char* b2 = last ? nB : cB + (size_t)(t + 2) * kstep; const char* b3 = b2 + kstep;
            PG8_LDB(B0, 0, 0); PG8_SCHED; PG8_LDA(At, 0, 0); PG8_STAGE_A(PG8_SA(1, 1), vc[1][0], vc[1][1], k1);
            PG8_WAIT_L(8); PG8_BAR; PG8_WAIT_L(0); PG8_MMA(0, 0, At, B0); PG8_BAR; PG8_SCHED;
            PG8_LDB(B1, 0, 1); PG8_STAGE_B(PG8_SB(0, 0), b2);
            PG8_BAR; PG8_WAIT_L(0); PG8_MMA(0, 1, At, B1); PG8_BAR; if constexpr (FP8) PG8_SCHED;
            PG8_LDA(At, 0, 1); PG8_STAGE_A(PG8_SA(0, 0), s00, s01, k2);
            PG8_BAR; PG8_WAIT_L(0); PG8_MMA(1, 0, At, B0); PG8_BAR; PG8_SCHED;
            PG8_STAGE_B(PG8_SB(0, 1), b2 + hstep);
            PG8_WAIT_V(6); PG8_BAR; PG8_MMA(1, 1, At, B1); PG8_BAR; if constexpr (FP8) PG8_SCHED;
            PG8_LDB(B0, 1, 0); PG8_SCHED; PG8_LDA(At, 1, 0); PG8_STAGE_A(PG8_SA(0, 1), s10, s11, k2);
            PG8_WAIT_L(8); PG8_BAR; PG8_WAIT_L(0); PG8_MMA(0, 0, At, B0); PG8_BAR; PG8_SCHED;
            PG8_LDB(B1, 1, 1); PG8_STAGE_B(PG8_SB(1, 0), b3);
            PG8_BAR; PG8_WAIT_L(0); PG8_MMA(0, 1, At, B1); PG8_BAR; if constexpr (FP8) PG8_SCHED;
            PG8_LDA(At, 1, 1); PG8_STAGE_A(PG8_SA(1, 0), s00, s01, k2 + kstepA);
            PG8_BAR; PG8_WAIT_L(0); PG8_MMA(1, 0, At, B0); PG8_BAR; PG8_SCHED;
            PG8_STAGE_B(PG8_SB(1, 1), b3 + hstep);
            PG8_WAIT_V(6); PG8_BAR; PG8_MMA(1, 1, At, B1); PG8_BAR; if constexpr (FP8) PG8_SCHED;
        }
        if constexpr (FP8) asm volatile("s_nop 15\n\ts_nop 15" ::: "memory");
        E(acc, cur, wr, wc, fr, fq);
        if (!has_next) break;
#pragma unroll
        for (int a = 0; a < 2; ++a)
#pragma unroll
            for (int b = 0; b < 2; ++b)
#pragma unroll
                for (int m = 0; m < 4; ++m)
#pragma unroll
                    for (int n = 0; n < 2; ++n) acc[a][b][m][n] = (f32x4){0.f, 0.f, 0.f, 0.f};
        cur = nxt; cB = nB; ++ui;
#pragma unroll
        for (int h = 0; h < 2; ++h)
#pragma unroll
            for (int i = 0; i < 2; ++i) vc[h][i] = vn[h][i];
    }
    PG8_WAIT_V(0);
    if (wr == 0) PG8_BAR;
    PG8_BAR;
#undef PG8_SA
#undef PG8_SB
#undef PG8_STAGE_A
#undef PG8_STAGE_B
#undef PG8_LDA
#undef PG8_LDB
#undef PG8_MMA
#undef PG8_WAIT_V
#undef PG8_WAIT_L
#undef PG8_BAR
#undef PG8_SCHED
}

typedef f32x4 Acc[2][2][4][2];
__device__ __forceinline__ unsigned dpp_ror8(unsigned x) { return (unsigned)__builtin_amdgcn_update_dpp(0, (int)x, 0x128, 0xf, 0xf, false); }
__device__ __forceinline__ u32x4 ror8_4(const u32x4 v) { u32x4 r; r.x = dpp_ror8(v.x); r.y = dpp_ror8(v.y); r.z = dpp_ror8(v.z); r.w = dpp_ror8(v.w); return r; }
__device__ __forceinline__ void line_xy(const u32x4 a, const u32x4 b, bool lo, u32x4& X, u32x4& Y) { const u32x4 ra = ror8_4(a), rb = ror8_4(b); X = lo ? a : rb; Y = lo ? ra : b; }
__device__ __forceinline__ u32x4 pack8(const f32x4 v0, const f32x4 v1) { u32x4 w; w.x = cvt_pk_bf16(v0[0], v0[1]); w.y = cvt_pk_bf16(v0[2], v0[3]); w.z = cvt_pk_bf16(v1[0], v1[1]); w.w = cvt_pk_bf16(v1[2], v1[3]); return w; }

struct EpiIn { static constexpr bool PERM = true; char* ws;
    __device__ __forceinline__ void operator()(const Acc& acc, const Unit& u, int wr, int wc, int fr, int fq) const {
        const int pn = u.pn; size_t boff; int ld, cb;
        if (pn < 3) { boff = OFF_QA; ld = 768; cb = pn * 256; } else if (pn == 3) { boff = OFF_CKV; ld = 256; cb = 0; }
        else if (pn < 32) { boff = OFF_HQ + (size_t)((pn - 4) >> 2) * SEG_STRIDE; ld = 1024; cb = ((pn - 4) & 3) * 256; }
        else { boff = OFF_KR; ld = 64; cb = 0; }
        bf16_t* base = (bf16_t*)(ws + boff);
        if (pn == 32 && wc != 0) return;
        const bool lo = fr < 8; const int rowb0 = u.pm * BM + wr * 64, rx = fr & 7, colx = cb + wc * 64 + (fr >> 3) * 32 + 8 * fq;
        float* ssq = (float*)(ws + (pn < 3 ? OFF_SSQQ : OFF_SSQKV));
#pragma unroll
        for (int ai = 0; ai < 2; ++ai)
#pragma unroll
            for (int m = 0; m < 4; ++m) { const int rg = rowb0 + ai * HALF + m * 16;
                f32x4 v0 = acc[ai][0][m][0], v1 = acc[ai][0][m][1], w0 = acc[ai][1][m][0], w1 = acc[ai][1][m][1];
                if (pn >= 4 && pn < 8) {
#pragma unroll
                    for (int j = 0; j < 4; ++j) { v0[j] = siluf_(v0[j]) * 0.08838834764831845f; v1[j] = siluf_(v1[j]) * 0.08838834764831845f; w0[j] = siluf_(w0[j]) * 0.08838834764831845f; w1[j] = siluf_(w1[j]) * 0.08838834764831845f; } }
                u32x4 X, Y; line_xy(pack8(v0, v1), pack8(w0, w1), lo, X, Y);
                __builtin_nontemporal_store(X, (u32x4*)(base + (size_t)(rg + rx) * ld + colx)); __builtin_nontemporal_store(Y, (u32x4*)(base + (size_t)(rg + 8 + rx) * ld + colx));
                if (pn <= 3) { float ss = (v0[0] * v0[0] + v0[1] * v0[1]) + (v0[2] * v0[2] + v0[3] * v0[3]) + (v1[0] * v1[0] + v1[1] * v1[1]) + (v1[2] * v1[2] + v1[3] * v1[3])
                                        + (w0[0] * w0[0] + w0[1] * w0[1]) + (w0[2] * w0[2] + w0[3] * w0[3]) + (w1[0] * w1[0] + w1[1] * w1[1]) + (w1[2] * w1[2] + w1[3] * w1[3]);
                    ss += __shfl_xor(ss, 16); ss += __shfl_xor(ss, 32); if (fq == 0) atomicAdd(ssq + rg + fr, ss); } }
    } };

struct EpiQ { static constexpr bool PERM = true; bf16_t* q; const float* ssq;
    __device__ __forceinline__ void operator()(const Acc& acc, const Unit& u, int wr, int wc, int fr, int fq) const {
        const bool lo = fr < 8; const int rowb0 = u.pm * BM + wr * 64, rx = fr & 7, colx = u.pn * BM + wc * 64 + (fr >> 3) * 32 + 8 * fq;
#pragma unroll
        for (int ai = 0; ai < 2; ++ai)
#pragma unroll
            for (int m = 0; m < 4; ++m) { const int rg = rowb0 + ai * HALF + m * 16; const float rs = rsqrtf(ssq[rg + fr] * (1.0f / 768.0f) + EPS);
                u32x4 X, Y; line_xy(pack8(acc[ai][0][m][0] * rs, acc[ai][0][m][1] * rs), pack8(acc[ai][1][m][0] * rs, acc[ai][1][m][1] * rs), lo, X, Y);
                *(u32x4*)(q + (size_t)(rg + rx) * 1536 + colx) = X; *(u32x4*)(q + (size_t)(rg + 8 + rx) * 1536 + colx) = Y; }
    } };

struct EpiKV { static constexpr bool PERM = true; bf16_t *Kb, *Vb; const float* ssq;
    __device__ __forceinline__ size_t kvrow(int row, int h) const { int b, pos; if (row < L) { b = row >> 11; pos = row & 2047; } else { b = (row - L) >> 8; pos = SEQ + ((row - L) & 255); } return (size_t)(b * 8 + h) * NKEY + pos; }
    __device__ __forceinline__ void operator()(const Acc& acc, const Unit& u, int wr, int wc, int fr, int fq) const {
        const bool lo = fr < 8; const int rowb0 = u.pm * BM + wr * 64, rx = fr & 7, colx = (wc & 1) * 64 + (fr >> 3) * 32 + 8 * fq;
        bf16_t* dst = wc < 2 ? Kb : Vb; const int ld = wc < 2 ? 192 : 128;
#pragma unroll
        for (int ai = 0; ai < 2; ++ai)
#pragma unroll
            for (int m = 0; m < 4; ++m) { const int rg = rowb0 + ai * HALF + m * 16; const float rs = rsqrtf(ssq[rg + fr] * (1.0f / 256.0f) + EPS);
                u32x4 X, Y; line_xy(pack8(acc[ai][0][m][0] * rs, acc[ai][0][m][1] * rs), pack8(acc[ai][1][m][0] * rs, acc[ai][1][m][1] * rs), lo, X, Y);
                *(u32x4*)(dst + kvrow(rg + rx, u.pn) * ld + colx) = X; *(u32x4*)(dst + kvrow(rg + 8 + rx, u.pn) * ld + colx) = Y; }
    } };

struct EpiOut { static constexpr bool PERM = true; bf16_t* x1; const float* x; const float* modv;
    __device__ __forceinline__ void operator()(const Acc& acc, const Unit& u, int wr, int wc, int fr, int fq) const {
        const bool lo = fr < 8; const int rowb0 = u.pm * BM + wr * 64, rx = fr & 7, colx = u.pn * BM + wc * 64 + (fr >> 3) * 32 + 8 * fq, cown = u.pn * BM + wc * 64 + 8 * fq;
#pragma unroll
        for (int ai = 0; ai < 2; ++ai)
#pragma unroll
            for (int m = 0; m < 4; ++m) { const int rg = rowb0 + ai * HALF + m * 16, row = rg + fr; const float* gate = modv + (row >> 11) * 6144 + 2 * 1024 + cown; const float* xr = x + (size_t)row * D + cown;
                f32x4 r[2][2];
#pragma unroll
                for (int bj = 0; bj < 2; ++bj)
#pragma unroll
                    for (int n = 0; n < 2; ++n) r[bj][n] = *(const f32x4*)(xr + bj * 32 + 4 * n) + *(const f32x4*)(gate + bj * 32 + 4 * n) * acc[ai][bj][m][n];
                u32x4 X, Y; line_xy(pack8(r[0][0], r[0][1]), pack8(r[1][0], r[1][1]), lo, X, Y);
                *(u32x4*)(x1 + (size_t)(rg + rx) * D + colx) = X; *(u32x4*)(x1 + (size_t)(rg + 8 + rx) * D + colx) = Y; }
    } };

struct EpiMoe1 { static constexpr bool PERM = true; unsigned char* act; const float* bgu;
    __device__ __forceinline__ void operator()(const Acc& acc, const Unit& u, int wr, int wc, int fr, int fq) const {
        const int o0 = u.pn * 128 + wc * 16 + 4 * fq;
        f32x4 bg[2], bl[2];
#pragma unroll
        for (int bj = 0; bj < 2; ++bj) { const float* bp = bgu + u.e * 2048 + 2 * (o0 + bj * 64); const f32x4 t0 = *(const f32x4*)bp, t1 = *(const f32x4*)(bp + 4);
            bg[bj] = (f32x4){t0[0], t0[2], t1[0], t1[2]}; bl[bj] = (f32x4){t0[1], t0[3], t1[1], t1[3]}; }
        unsigned char* blk = act + ((size_t)u.pm * 8 + u.pn) * 32768 + (size_t)(wr * 4 + wc) * 1024 + (size_t)(fq * 16 + fr) * 16;
#pragma unroll
        for (int ai = 0; ai < 2; ++ai)
#pragma unroll
            for (int bj = 0; bj < 2; ++bj) { unsigned d[4];
#pragma unroll
                for (int m = 0; m < 4; ++m) { const f32x4 g4 = acc[ai][bj][m][0] + bg[bj], l4 = acc[ai][bj][m][1] + bl[bj]; float r[4];
#pragma unroll
                    for (int j = 0; j < 4; ++j) { const float glu = fminf(g4[j], 7.0f), lin = __builtin_amdgcn_fmed3f(l4[j], -7.0f, 7.0f); r[j] = 4.0f * glu * __builtin_amdgcn_rcpf(1.0f + __builtin_amdgcn_exp2f(-2.4554669595930157f * glu)) * (lin + 1.0f); }
                    d[m] = pack4_fp8(r[0], r[1], r[2], r[3]); }
                const auto s01 = __builtin_amdgcn_permlane16_swap(d[0], d[1], false, false); const auto s23 = __builtin_amdgcn_permlane16_swap(d[2], d[3], false, false);
                const auto t02 = __builtin_amdgcn_permlane32_swap(s01[0], s23[0], false, false); const auto t13 = __builtin_amdgcn_permlane32_swap(s01[1], s23[1], false, false);
                *(u32x4*)(blk + (size_t)(ai * 2 + bj) * 8192) = (u32x4){t02[0], t13[0], t02[1], t13[1]}; }
    } };

struct EpiMoe2 { static constexpr bool PERM = true; bf16_t* yp; const float* bd;
    __device__ __forceinline__ void operator()(const Acc& acc, const Unit& u, int wr, int wc, int fr, int fq) const {
        const bool lo = fr < 8; const int rowb0 = u.pm * BM + wr * 64, rx = fr & 7, colx = u.pn * BM + wc * 64 + (fr >> 3) * 32 + 8 * fq, cown = u.pn * BM + wc * 64 + 8 * fq;
        f32x4 bv[2][2];
#pragma unroll
        for (int bj = 0; bj < 2; ++bj)
#pragma unroll
            for (int n = 0; n < 2; ++n) bv[bj][n] = *(const f32x4*)(bd + u.e * 1024 + cown + bj * 32 + 4 * n);
#pragma unroll
        for (int ai = 0; ai < 2; ++ai)
#pragma unroll
            for (int m = 0; m < 4; ++m) { const int rg = rowb0 + ai * HALF + m * 16;
                u32x4 X, Y; line_xy(pack8(acc[ai][0][m][0] + bv[0][0], acc[ai][0][m][1] + bv[0][1]), pack8(acc[ai][1][m][0] + bv[1][0], acc[ai][1][m][1] + bv[1][1]), lo, X, Y);
                __builtin_nontemporal_store(X, (u32x4*)(yp + (size_t)(rg + rx) * D + colx)); __builtin_nontemporal_store(Y, (u32x4*)(yp + (size_t)(rg + 8 + rx) * D + colx)); }
    } };
}

__device__ __forceinline__ int conv_src_col(int kind, int c) {
    if (kind == 0) return c;
    if (kind == 1) { if (c < 1024) return c; if (c < 8192) return c + 64; if (c < 8256) return c - 8192 + 1024; return -1; }
    const int pn = c >> 8, p = c & 255, wc = p >> 6, bj = (p >> 5) & 1, fq = (p >> 3) & 3, n = (p >> 2) & 1, i = p & 3; const int o = 128 * pn + 64 * bj + 16 * wc + 4 * fq + i; return 2 * o + n;
}
template <bool F8> struct ConvPipe {
    float v[32]; bool have; bf16_t* dummy;
    int K, kind, k0, c0; void* Wt;
    __device__ __forceinline__ void issue(const float* __restrict__ W, int ldw, void* Wt_, int K_, int kind_, const float* __restrict__ kscale, int k0_, int c0_) {
        const int tid = otid(); const int cc = tid & 127, kq = tid >> 7, sc = conv_src_col(kind_, c0_ + cc);
        const int scc = sc < 0 ? 0 : sc; const float* wp = W + (size_t)(k0_ + kq) * ldw + scc;
#pragma unroll
        for (int i = 0; i < 32; ++i) v[i] = __builtin_nontemporal_load(wp + (size_t)(4 * i) * ldw);
        if (sc < 0) {
#pragma unroll
            for (int i = 0; i < 32; ++i) v[i] = 0.f; }
        if (kscale) {
#pragma unroll
            for (int i = 0; i < 32; ++i) v[i] *= kscale[k0_ + kq + 4 * i]; }
        K = K_; kind = kind_; k0 = k0_; c0 = c0_; Wt = Wt_; have = true;
    }
    __device__ __forceinline__ void flush(LAS float* tl) {
        if (!have) return; have = false;
        const int tid = otid(); const int cc = tid & 127, kq = tid >> 7;
        __syncthreads();
#pragma unroll
        for (int i = 0; i < 32; ++i) tl[(kq + 4 * i) * 129 + cc] = v[i];
        __syncthreads();
        stash(tl, tid);
    }
    __device__ __forceinline__ void to_lds(LAS float* tl) { const int tid = otid(); const int cc = tid & 127, kq = tid >> 7; __syncthreads();
#pragma unroll
        for (int i = 0; i < 32; ++i) tl[(kq + 4 * i) * 129 + cc] = v[i];
        __syncthreads(); }
    __device__ __forceinline__ void stash(LAS float* tl, int tid) const {
        if constexpr (F8) {
#pragma unroll
            for (int pss = 0; pss < 2; ++pss) { const int item = tid + 512 * pss, c2 = item >> 3, ch = item & 7; float t[16];
#pragma unroll
                for (int j = 0; j < 16; ++j) t[j] = tl[(16 * ch + j) * 129 + c2] * 32.f;
                u32x4 w; w.x = pack4_fp8(t[0], t[1], t[2], t[3]); w.y = pack4_fp8(t[4], t[5], t[6], t[7]); w.z = pack4_fp8(t[8], t[9], t[10], t[11]); w.w = pack4_fp8(t[12], t[13], t[14], t[15]);
                *(u32x4*)((unsigned char*)Wt + (size_t)(c0 + c2) * K + k0 + 16 * ch) = w; }
        } else {
#pragma unroll
            for (int pss = 0; pss < 4; ++pss) { const int item = tid + 512 * pss, c2 = item >> 4, ch = item & 15; float t[8];
#pragma unroll
                for (int j = 0; j < 8; ++j) t[j] = tl[(8 * ch + j) * 129 + c2];
                u32x4 w; w.x = cvt_pk_bf16(t[0], t[1]); w.y = cvt_pk_bf16(t[2], t[3]); w.z = cvt_pk_bf16(t[4], t[5]); w.w = cvt_pk_bf16(t[6], t[7]);
                *(u32x4*)((bf16_t*)Wt + (size_t)(c0 + c2) * K + k0 + 8 * ch) = w; }
        }
    }
};
template <bool F8>
__device__ __forceinline__ void conv_matrix(LAS float* tl, ConvPipe<F8>& pipe, const float* W, int ldw, void* Wt, int K, int Nout, int kind, const float* kscale, int& tctr) {
    const int nk = K / 128, ntile = nk * (Nout / 128);
    int t = ((int)blockIdx.x - tctr) % (int)gridDim.x; if (t < 0) t += gridDim.x;
    for (; t < ntile; t += gridDim.x) {
        if (pipe.have) { pipe.to_lds(tl); const int K0 = pipe.K, k00 = pipe.k0, c00 = pipe.c0; void* W0 = pipe.Wt; ConvPipe<F8> done = pipe; (void)K0; (void)k00; (void)c00; (void)W0;
            pipe.issue(W, ldw, Wt, K, kind, kscale, (t % nk) * 128, (t / nk) * 128); done.stash(tl, otid()); }
        else pipe.issue(W, ldw, Wt, K, kind, kscale, (t % nk) * 128, (t / nk) * 128);
    }
    tctr = (tctr + ntile) % (int)gridDim.x;
}
template <bool F8> __device__ __forceinline__ void conv_finish(LAS float* tl, ConvPipe<F8>& pipe) { if (pipe.have) { pipe.to_lds(tl); pipe.stash(tl, otid()); pipe.have = false; } __syncthreads(); }

__device__ __forceinline__ float half_sum256(float v, LAS float* red) {
    for (int o = 32; o > 0; o >>= 1) v += __shfl_xor(v, o);
    const int w = otid() >> 6, hb = (otid() >> 8) * 4; if ((otid() & 63) == 0) red[w] = v; __syncthreads();
    const float t = red[hb] + red[hb + 1] + red[hb + 2] + red[hb + 3]; __syncthreads(); return t;
}

__device__ __forceinline__ void phase0(const Params& p, LAS unsigned char* lds) {
    char* ws = p.ws; const int tid = otid(), gsz = gridDim.x * 512, gid = blockIdx.x * 512 + tid;
    float* lb = (float*)(ws + OFF_LB); int* cnt = (int*)(ws + OFF_CNT); float* ssqq = (float*)(ws + OFF_SSQQ); float* ssqkv = (float*)(ws + OFF_SSQKV); float* modv = (float*)(ws + OFF_MOD);
    for (int i = gid; i < 2048; i += gsz) { const int d = i >> 10, j = i & 1023; const float a = p.lbl[(d * 2 + 0) * 1024 + j], b = p.lbl[(d * 2 + 1) * 1024 + j]; lb[i] = 1.0f / (1.0f + __expf(b - a)); }
    for (int i = gid; i < 32; i += gsz) cnt[i] = 0;
    { float* ropet = (float*)(ws + OFF_ROPE); for (int i = gid; i < SEQ * 32; i += gsz) { const int t = i >> 5, j = i & 31; float cs, sn; rope_cs(t, j, cs, sn); ropet[t * 64 + j] = cs; ropet[t * 64 + 32 + j] = sn; } }
    for (int i = gid; i < L; i += gsz) ssqq[i] = 0.f;
    for (int i = gid; i < R; i += gsz) ssqkv[i] = 0.f;
    { LAS float* sil = (LAS float*)lds;
      LAS float* part = (LAS float*)(lds + 17 * 1024 * 4);
      bool loaded = false;
      for (int item = blockIdx.x; item < 96; item += gridDim.x) {
          if (!loaded) { for (int i = tid; i < 17 * 1024; i += 512) { const int r = i >> 10, k = i & 1023; sil[i] = siluf_(r < 16 ? p.c[r * 1024 + k] : p.cctx[k]); } loaded = true; __syncthreads(); }
          const int j = tid & 63, ks = tid >> 6; float a[17];
#pragma unroll
          for (int r = 0; r < 17; ++r) a[r] = 0.f;
          for (int k = ks * 128; k < ks * 128 + 128; ++k) { const float w = p.w_mod[(size_t)k * 6144 + item * 64 + j];
#pragma unroll
              for (int r = 0; r < 17; ++r) a[r] += sil[r * 1024 + k] * w; }
#pragma unroll
          for (int r = 0; r < 17; ++r) part[(ks * 17 + r) * 64 + j] = a[r];
          __syncthreads();
          for (int i = tid; i < 17 * 64; i += 512) { const int r = i >> 6, jj = i & 63; float s = p.b_mod[item * 64 + jj]; for (int q = 0; q < 8; ++q) s += part[(q * 17 + r) * 64 + jj]; modv[r * 6144 + item * 64 + jj] = s; }
          __syncthreads();
      } }
    __syncthreads();
    { LAS float* tl = (LAS float*)lds; int tctr = 0;
      { ConvPipe<true> pp; pp.have = false; conv_matrix<true>(tl, pp, p.w_in, 8256, (unsigned char*)(ws + OFF_WT_IN), 1024, 8448, 1, nullptr, tctr); conv_finish<true>(tl, pp); }
      { ConvPipe<false> pp; pp.have = false;
        conv_matrix<false>(tl, pp, p.w_qb, 1536, (bf16_t*)(ws + OFF_WT_QB), 768, 1536, 0, p.g_q, tctr);
        conv_matrix<false>(tl, pp, p.w_kvb, 2048, (bf16_t*)(ws + OFF_WT_KVB), 256, 2048, 0, p.g_kv, tctr);
        conv_matrix<false>(tl, pp, p.w_out, 1024, (bf16_t*)(ws + OFF_WT_OUT), 1024, 1024, 0, nullptr, tctr); conv_finish<false>(tl, pp); } }
}

__device__ __forceinline__ float wave_sum(float v) {
#pragma unroll
    for (int o = 32; o > 0; o >>= 1) v += __shfl_xor(v, o);
    return v; }
__device__ __forceinline__ void phase1(const Params& p, LAS unsigned char* lds) {
    const float* modv = (const float*)(p.ws + OFF_MOD); unsigned char* h = (unsigned char*)(p.ws + OFF_H);
    const int tid = otid(), lane = tid & 63, gw = blockIdx.x * 8 + (tid >> 6), nw = gridDim.x * 8, c0 = lane * 8;
    f32x4 g[4];
#pragma unroll
    for (int q = 0; q < 4; ++q) g[q] = *(const f32x4*)(p.g_mix + (q >> 1) * 512 + c0 + (q & 1) * 4);
    for (int row0 = gw; row0 < R; row0 += 2 * nw) {
        f32x4 v[2][4]; const bool two = row0 + nw < R;
#pragma unroll
        for (int u = 0; u < 2; ++u) { const int row = (u == 0 || two) ? row0 + u * nw : row0; const float* src = row < L ? p.x + (size_t)row * D : p.ctx + (size_t)(row - L) * D;
#pragma unroll
            for (int q = 0; q < 4; ++q) v[u][q] = __builtin_nontemporal_load((const f32x4*)(src + (q >> 1) * 512 + c0 + (q & 1) * 4)); }
#pragma unroll
        for (int u = 0; u < 2; ++u) { if (u == 1 && !two) break; const int row = row0 + u * nw; const float* mod = modv + (row < L ? row / SEQ : 16) * 6144;
            float ss = 0.f;
#pragma unroll
            for (int q = 0; q < 4; ++q) ss += (v[u][q][0] * v[u][q][0] + v[u][q][1] * v[u][q][1]) + (v[u][q][2] * v[u][q][2] + v[u][q][3] * v[u][q][3]);
            const float rs = rsqrtf(wave_sum(ss) * (1.0f / D) + EPS);
#pragma unroll
            for (int j = 0; j < 2; ++j) { f32x4 o[2];
#pragma unroll
                for (int e = 0; e < 2; ++e) { const int cc = j * 512 + c0 + e * 4; const f32x4 sc = *(const f32x4*)(mod + 1024 + cc), sh = *(const f32x4*)(mod + cc); o[e] = v[u][j * 2 + e] * rs * g[j * 2 + e] * (sc + 1.0f) + sh; }
                u32x2 w; w.x = pack4_fp8(o[0][0], o[0][1], o[0][2], o[0][3]); w.y = pack4_fp8(o[1][0], o[1][1], o[1][2], o[1][3]);
                *(u32x2*)(h + (size_t)row * D + j * 512 + c0) = w; } }
    }
}

__device__ __forceinline__ SegOut make_seg(char* ws) { SegOut so; so.qa = (bf16_t*)(ws + OFF_QA); so.ckv = (bf16_t*)(ws + OFF_CKV); so.kr = (bf16_t*)(ws + OFF_KR); so.hq = (bf16_t*)(ws + OFF_HQ); so.ff = (bf16_t*)(ws + OFF_FF);
    so.fb = (bf16_t*)(ws + OFF_FB); so.iv = (bf16_t*)(ws + OFF_IV); so.og = (bf16_t*)(ws + OFF_OG); so.gm = (bf16_t*)(ws + OFF_GM); so.gh = (bf16_t*)(ws + OFF_GH); return so; }

__device__ __forceinline__ void phase2(const Params& p, LAS unsigned char* lds) {
    pg8::InSched S; S.init2(p.ws + OFF_WT_IN, gridDim.x, blockIdx.x);
    pg8::EpiIn E{p.ws};
    pg8::gemm_phase<pg8::EpiIn, pg8::InSched, true, 127, 122>(lds, (const char*)(p.ws + OFF_H), 1024, S, E);
}
__device__ __forceinline__ void phase3(const Params& p, LAS unsigned char* lds) {
    char* ws = p.ws;
    { pg8::DenseSched S; S.init(L, 1536, 768 * 2, 768 * 2, ws + OFF_WT_QB, gridDim.x, blockIdx.x); pg8::EpiQ E{(bf16_t*)(ws + OFF_Q), (const float*)(ws + OFF_SSQQ)}; pg8::gemm_phase(lds, (const char*)(ws + OFF_QA), 768, S, E); }
    { pg8::DenseSched S; S.init(R, 2048, 256 * 2, 256 * 2, ws + OFF_WT_KVB, gridDim.x, blockIdx.x); pg8::EpiKV E{(bf16_t*)(ws + OFF_K), (bf16_t*)(ws + OFF_V), (const float*)(ws + OFF_SSQKV)}; pg8::gemm_phase(lds, (const char*)(ws + OFF_CKV), 256, S, E); }
    { const bf16_t* kr = (const bf16_t*)(ws + OFF_KR); bf16_t* Kb = (bf16_t*)(ws + OFF_K); const float* ropet = (const float*)(ws + OFF_ROPE);
      for (int gid = blockIdx.x * 512 + otid(); gid < R * 32; gid += gridDim.x * 512) { const int row = gid >> 5, i = gid & 31;
          const float x1 = bf2f(kr[(size_t)row * 64 + i]), x2 = bf2f(kr[(size_t)row * 64 + 32 + i]); float o1 = x1, o2 = x2; int b, pos;
          if (row < L) { b = row / SEQ; pos = row % SEQ; const float cs = ropet[pos * 64 + i], sn = ropet[pos * 64 + 32 + i]; o1 = x1 * cs - x2 * sn; o2 = x1 * sn + x2 * cs; } else { b = (row - L) / CTXL; pos = SEQ + (row - L) % CTXL; }
          const bf16_t w1 = f2bf(o1), w2 = f2bf(o2);
          for (int h = 0; h < 8; ++h) { bf16_t* q = Kb + ((size_t)(b * 8 + h) * NKEY + pos) * 192 + 128; q[i] = w1; q[32 + i] = w2; } } }
}
__device__ __forceinline__ void unpack8(const u32x4 w, float (&o)[8]) {
    o[0] = __uint_as_float(w.x << 16); o[1] = __uint_as_float(w.x & 0xffff0000u); o[2] = __uint_as_float(w.y << 16); o[3] = __uint_as_float(w.y & 0xffff0000u);
    o[4] = __uint_as_float(w.z << 16); o[5] = __uint_as_float(w.z & 0xffff0000u); o[6] = __uint_as_float(w.w << 16); o[7] = __uint_as_float(w.w & 0xffff0000u); }
__device__ __forceinline__ void phase4(const Params& p, LAS unsigned char*) {
    char* ws = p.ws; bf16_t* y = (bf16_t*)(ws + OFF_H); const bf16_t* of = (const bf16_t*)(ws + OFF_OF); const bf16_t* ob = (const bf16_t*)(ws + OFF_OB);
    const bf16_t* og = (const bf16_t*)(ws + OFF_OG); const bf16_t* gm = (const bf16_t*)(ws + OFF_GM); const bf16_t* gh = (const bf16_t*)(ws + OFF_GH);
    const int tid = otid(), lane = tid & 63, gw = blockIdx.x * 8 + (tid >> 6), nw = gridDim.x * 8, c0 = lane * 8;
    float gg[8];
#pragma unroll
    for (int i = 0; i < 8; ++i) gg[i] = p.g_hg[(c0 + i) & 127];
    for (int row = gw; row < L; row += nw) {
        u32x4 ra[2], rb[2], r1[2], r2[2], r3[2], rm[2];
#pragma unroll
        for (int j = 0; j < 2; ++j) { const size_t off = (size_t)row * D + j * 512 + c0; ra[j] = __builtin_nontemporal_load((const u32x4*)(of + off)); rb[j] = __builtin_nontemporal_load((const u32x4*)(ob + off)); r1[j] = __builtin_nontemporal_load((const u32x4*)(og + off)); r2[j] = __builtin_nontemporal_load((const u32x4*)(gm + off)); r3[j] = __builtin_nontemporal_load((const u32x4*)(gh + off)); rm[j] = __builtin_nontemporal_load((const u32x4*)(y + off)); }
#pragma unroll
        for (int j = 0; j < 2; ++j) { float a[8], b[8], g1[8], g2[8], g3[8], ym[8], o[8]; unpack8(ra[j], a); unpack8(rb[j], b); unpack8(r1[j], g1); unpack8(r2[j], g2); unpack8(r3[j], g3); unpack8(rm[j], ym);
            float ss = 0.f;
#pragma unroll
            for (int i = 0; i < 8; ++i) { o[i] = a[i] + b[i]; ss += o[i] * o[i]; }
            ss += __shfl_xor(ss, 1); ss += __shfl_xor(ss, 2); ss += __shfl_xor(ss, 4); ss += __shfl_xor(ss, 8);
            const float rs = rsqrtf(ss * (1.0f / 128.0f) + EPS); float r[8];
#pragma unroll
            for (int i = 0; i < 8; ++i) { const float yh = o[i] * rs * gg[i] * siluf_(g1[i]); r[i] = sigmoidf_(g2[i]) * ym[i] + sigmoidf_(g3[i]) * yh; }
            u32x4 w; w.x = cvt_pk_bf16(r[0], r[1]); w.y = cvt_pk_bf16(r[2], r[3]); w.z = cvt_pk_bf16(r[4], r[5]); w.w = cvt_pk_bf16(r[6], r[7]);
            *(u32x4*)(y + (size_t)row * D + j * 512 + c0) = w; }
    }
}
__device__ __forceinline__ void phase5(const Params& p, LAS unsigned char* lds) {
    char* ws = p.ws;
    { pg8::DenseSched S; S.init(L, 1024, 1024 * 2, 1024 * 2, ws + OFF_WT_OUT, gridDim.x, blockIdx.x); pg8::EpiOut E{(bf16_t*)(ws + OFF_X1), p.x, (const float*)(ws + OFF_MOD)}; pg8::gemm_phase(lds, (const char*)(ws + OFF_H), 1024, S, E); }
    { LAS float* tl = (LAS float*)lds; int tctr = 0; ConvPipe<true> pp; pp.have = false;
      for (int e = 0; e < NE; ++e) conv_matrix<true>(tl, pp, p.w_gu + (size_t)e * 1024 * 2048, 2048, (unsigned char*)(ws + OFF_WT_GU) + (size_t)e * 2048 * 1024, 1024, 2048, 2, nullptr, tctr);
      for (int e = 0; e < NE; ++e) conv_matrix<true>(tl, pp, p.w_dn + (size_t)e * 1024 * 1024, 1024, (unsigned char*)(ws + OFF_WT_DN) + (size_t)e * 1024 * 1024, 1024, 1024, 0, nullptr, tctr);
      conv_finish<true>(tl, pp); }
}
__device__ __forceinline__ void phase6(const Params& p, LAS unsigned char* lds) {
    char* ws = p.ws; const float* modv = (const float*)(ws + OFF_MOD); unsigned char* h2 = (unsigned char*)(ws + OFF_H); int* topi = (int*)(ws + OFF_TOPI); float* topp = (float*)(ws + OFF_TOPP); int* cnt = (int*)(ws + OFF_CNT); int* list = (int*)(ws + OFF_LIST); int* pairpos = (int*)(ws + OFF_ROWPAIR);
    LAS float* hs = (LAS float*)lds;
    LAS float* lg = (LAS float*)(lds + 131072);
    LAS int* lcnt = (LAS int*)(lds + 131072 + 4096);
    LAS int* lent = (LAS int*)(lds + 131072 + 4096 + 512);
    const int tid = otid(), lane = tid & 63, wid = tid >> 6, c0 = lane * 8;
    if (tid < 96) lcnt[tid] = 0;
    f32x4 g[4];
#pragma unroll
    for (int q = 0; q < 4; ++q) g[q] = *(const f32x4*)(p.g_ffn + (q >> 1) * 512 + c0 + (q & 1) * 4);
    __syncthreads();
    int it = 0;
    for (int tile = blockIdx.x; tile < L / 32; tile += gridDim.x, ++it) {
        const int rbase = tile * 32;
        f32x4 v[4][4];
#pragma unroll
        for (int u = 0; u < 4; ++u)
#pragma unroll
            for (int j = 0; j < 2; ++j) { float t8[8]; unpack8(*(const u32x4*)((const bf16_t*)(ws + OFF_X1) + (size_t)(rbase + wid * 4 + u) * D + j * 512 + c0), t8); v[u][2 * j] = (f32x4){t8[0], t8[1], t8[2], t8[3]}; v[u][2 * j + 1] = (f32x4){t8[4], t8[5], t8[6], t8[7]}; }
#pragma unroll
        for (int u = 0; u < 4; ++u) { const int rl = wid * 4 + u, row = rbase + rl; const float* mod = modv + (row / SEQ) * 6144; float ss = 0.f;
#pragma unroll
            for (int q = 0; q < 4; ++q) ss += (v[u][q][0] * v[u][q][0] + v[u][q][1] * v[u][q][1]) + (v[u][q][2] * v[u][q][2] + v[u][q][3] * v[u][q][3]);
            const float rs = rsqrtf(wave_sum(ss) * (1.0f / D) + EPS);
#pragma unroll
            for (int j = 0; j < 2; ++j) { f32x4 o[2];
#pragma unroll
                for (int e = 0; e < 2; ++e) { const int cc = j * 512 + c0 + e * 4; const f32x4 sc = *(const f32x4*)(mod + 4 * 1024 + cc), sh = *(const f32x4*)(mod + 3 * 1024 + cc); o[e] = v[u][j * 2 + e] * rs * g[j * 2 + e] * (sc + 1.0f) + sh;
                    *(LAS f32x4*)(hs + rl * 1024 + cc) = o[e]; }
                u32x2 w; w.x = pack4_fp8(o[0][0], o[0][1], o[0][2], o[0][3]); w.y = pack4_fp8(o[1][0], o[1][1], o[1][2], o[1][3]);
                *(u32x2*)(h2 + (size_t)row * D + j * 512 + c0) = w; } }
        __syncthreads();
        { const int e = tid & 31, rg = tid >> 5; const LAS float* h0 = hs + (2 * rg) * 1024; const LAS float* h1 = h0 + 1024; float a0 = 0.f, a1 = 0.f;
          for (int j = 0; j < 1024; j += 8) { float w[8];
#pragma unroll
              for (int q = 0; q < 8; ++q) w[q] = p.w_r[(j + q) * 32 + e];
              const f32x4 x0 = *(const LAS f32x4*)(h0 + j), x1 = *(const LAS f32x4*)(h0 + j + 4), y0 = *(const LAS f32x4*)(h1 + j), y1 = *(const LAS f32x4*)(h1 + j + 4);
              a0 += x0[0] * w[0]; a0 += x0[1] * w[1]; a0 += x0[2] * w[2]; a0 += x0[3] * w[3]; a0 += x1[0] * w[4]; a0 += x1[1] * w[5]; a0 += x1[2] * w[6]; a0 += x1[3] * w[7];
              a1 += y0[0] * w[0]; a1 += y0[1] * w[1]; a1 += y0[2] * w[2]; a1 += y0[3] * w[3]; a1 += y1[0] * w[4]; a1 += y1[1] * w[5]; a1 += y1[2] * w[6]; a1 += y1[3] * w[7]; }
          const float be = p.b_r[e]; lg[(2 * rg) * 32 + e] = a0 + be; lg[(2 * rg + 1) * 32 + e] = a1 + be; }
        __syncthreads();
#pragma unroll
        for (int rep = 0; rep < 2; ++rep) { const int rl = wid * 4 + rep * 2 + (lane >> 5), row = rbase + rl, e = lane & 31; float cur = lg[rl * 32 + e];
            float tv0 = 0.f, sum = 0.f; int sel_i[4]; float sel_e[4];
#pragma unroll
            for (int k = 0; k < 4; ++k) { float m = cur; int mi = e;
#pragma unroll
                for (int o2 = 16; o2 > 0; o2 >>= 1) { const float om = __shfl_xor(m, o2); const int oi = __shfl_xor(mi, o2); if (om > m || (om == m && oi < mi)) { m = om; mi = oi; } }
                if (k == 0) tv0 = m; sel_i[k] = mi; sel_e[k] = __expf(m - tv0); sum += sel_e[k]; if (e == mi) cur = -3.0e38f; }
            int myk = 0; float myp = 0.f;
#pragma unroll
            for (int k = 0; k < 4; ++k) if (e == k) { myk = sel_i[k]; myp = sel_e[k] / sum; }
            if (e < 4) { const int pair = row * 4 + e; topi[pair] = myk; topp[pair] = myp; __hip_atomic_fetch_add(&lcnt[myk], 1, __ATOMIC_RELAXED, __HIP_MEMORY_SCOPE_WORKGROUP); lent[(it * 32 + rl) * 4 + e] = myk; } }
        __syncthreads();
    }
    if (tid < 32) { const int n = lcnt[tid]; lcnt[32 + tid] = n > 0 ? atomicAdd(&cnt[tid], n) : 0; lcnt[64 + tid] = 0; }
    __syncthreads();
    const int nent = it * 128;
    for (int s = tid; s < nent; s += 512) { const int e = lent[s]; const int ii = s >> 7, rl = (s >> 2) & 31, k = s & 3; const int row = (blockIdx.x + ii * gridDim.x) * 32 + rl;
        const int pos = lcnt[32 + e] + __hip_atomic_fetch_add(&lcnt[64 + e], 1, __ATOMIC_RELAXED, __HIP_MEMORY_SCOPE_WORKGROUP); list[e * CAP + pos] = row * 4 + k; pairpos[row * 4 + k] = pos; }
}
__device__ __forceinline__ void moe_table(const int* cnt, LAS int* tab) {
    if (otid() == 0) { int t = 0; for (int e = 0; e < NE; ++e) { tab[e] = t; const int n = cnt[e]; tab[64 + e] = n; t += (n + 255) >> 8; } tab[32] = t; tab[33] = t; }
    __syncthreads();
    for (int rt = otid(); rt < tab[33]; rt += 512) { int e = 0; while (tab[e + 1] <= rt) ++e; tab[128 + rt] = e; }
    __syncthreads();
}
constexpr int LDS_TAB = pg8::STAGE_BYTES;
__device__ __forceinline__ void phase7(const Params& p, LAS unsigned char* lds) {
    char* ws = p.ws; LAS int* tab = (LAS int*)(lds + LDS_TAB); moe_table((const int*)(ws + OFF_CNT), tab);
    pg8::MoeSched<true> S; S.nN = 8; S.G = gridDim.x; S.c = blockIdx.x; S.rowb = 1024; S.Wt = ws + OFF_WT_GU; S.wexp = (size_t)2048 * 1024; S.btile = (size_t)256 * 1024; S.tab = tab; S.list = (const int*)(ws + OFF_LIST);
    pg8::EpiMoe1 E{(unsigned char*)(ws + OFF_ACT), p.b_gu};
    pg8::gemm_phase<pg8::EpiMoe1, pg8::MoeSched<true>, true, 127, 122>(lds, (const char*)(ws + OFF_H), 1024, S, E);
}
__device__ __forceinline__ void phase8(const Params& p, LAS unsigned char* lds) {
    char* ws = p.ws; LAS int* tab = (LAS int*)(lds + LDS_TAB); moe_table((const int*)(ws + OFF_CNT), tab);
    pg8::MoeSched<false> S; S.nN = 4; S.G = gridDim.x; S.c = blockIdx.x; S.rowb = 1024; S.Wt = ws + OFF_WT_DN; S.wexp = (size_t)1024 * 1024; S.btile = (size_t)256 * 1024; S.tab = tab; S.list = (const int*)(ws + OFF_LIST);
    pg8::EpiMoe2 E{(bf16_t*)(ws + OFF_YP), p.b_dn};
    pg8::gemm_phase<pg8::EpiMoe2, pg8::MoeSched<false>, true, 125, 122>(lds, (const char*)(ws + OFF_ACT), 1024, S, E);
}
__device__ __forceinline__ void phase9(const Params& p, LAS unsigned char* lds) {
    char* ws = p.ws; const float* modv = (const float*)(ws + OFF_MOD); const bf16_t* yp = (const bf16_t*)(ws + OFF_YP); const float* topp = (const float*)(ws + OFF_TOPP);
    const int* topi = (const int*)(ws + OFF_TOPI); const int* pairpos = (const int*)(ws + OFF_ROWPAIR);
    LAS int* tab = (LAS int*)lds; moe_table((const int*)(ws + OFF_CNT), tab);
    const int tid = otid(), lane = tid & 63, gw = blockIdx.x * 8 + (tid >> 6), nw = gridDim.x * 8, c0 = lane * 8;
    f32x4 fg[4];
#pragma unroll
    for (int q = 0; q < 4; ++q) fg[q] = *(const f32x4*)(p.g_fin + (q >> 1) * 512 + c0 + (q & 1) * 4);
    for (int row = gw; row < L; row += nw) {
        const float* gate = modv + (row / SEQ) * 6144 + 5 * 1024; f32x4 v[4]; u32x4 yr[4][2];
        const pg8::i32x4_t ek = *(const pg8::i32x4_t*)(topi + row * 4), pk4 = *(const pg8::i32x4_t*)(pairpos + row * 4);
#pragma unroll
        for (int j = 0; j < 2; ++j) { float t8[8]; unpack8(*(const u32x4*)((const bf16_t*)(ws + OFF_X1) + (size_t)row * D + j * 512 + c0), t8); v[2 * j] = (f32x4){t8[0], t8[1], t8[2], t8[3]}; v[2 * j + 1] = (f32x4){t8[4], t8[5], t8[6], t8[7]}; }
#pragma unroll
        for (int k = 0; k < 4; ++k) { const size_t yrow = (size_t)tab[ek[k]] * 256 + pk4[k];
#pragma unroll
            for (int j = 0; j < 2; ++j) yr[k][j] = __builtin_nontemporal_load((const u32x4*)(yp + yrow * D + j * 512 + c0)); }
        const f32x4 pk = *(const f32x4*)(topp + row * 4);
        float m[16];
#pragma unroll
        for (int i = 0; i < 16; ++i) m[i] = 0.f;
#pragma unroll
        for (int k = 0; k < 4; ++k)
#pragma unroll
            for (int j = 0; j < 2; ++j) { float t[8]; unpack8(yr[k][j], t);
#pragma unroll
                for (int i = 0; i < 8; ++i) m[j * 8 + i] += pk[k] * t[i]; }
        float ss = 0.f;
#pragma unroll
        for (int q = 0; q < 4; ++q) { const f32x4 gt = *(const f32x4*)(gate + (q >> 1) * 512 + c0 + (q & 1) * 4);
#pragma unroll
            for (int i = 0; i < 4; ++i) { v[q][i] += gt[i] * m[q * 4 + i]; ss += v[q][i] * v[q][i]; } }
        const float rs = rsqrtf(wave_sum(ss) * (1.0f / D) + EPS);
#pragma unroll
        for (int q = 0; q < 4; ++q) __builtin_nontemporal_store(v[q] * rs * fg[q], (f32x4*)(p.out + (size_t)row * D + (q >> 1) * 512 + c0 + (q & 1) * 4));
    }
}

namespace at {
using s16x4  = __attribute__((ext_vector_type(4))) short;
using f32x16 = __attribute__((ext_vector_type(16))) float;
constexpr int NW = 8, QBLK = 32, KVBLK = 64, DK = 192, DV = 128;
constexpr float SCALE = 0.07216878364870322f;
constexpr float THR = 8.f;
constexpr int SHM_V = KVBLK * DV * 2, SHM_K = KVBLK * DK * 2, SHM_ATTN = 2 * SHM_V + 2 * SHM_K + NW * 64 * 4;
#define KSWZ(row, colB) ((row) * 384 + ((colB) ^ (((row) & 7) << 4)))
#define SBAR() __builtin_amdgcn_sched_barrier(0)
__device__ __forceinline__ int crow(int r, int hi) { return (r & 3) + 8 * (r >> 2) + 4 * hi; }
__device__ __forceinline__ unsigned cvtpk(float lo, float hi) { return cvt_pk_bf16(lo, hi); }

__device__ __forceinline__ void partialSM(f32x16& p0, f32x16& p1, float& m_reg, float& mn, float& alpha) {
  constexpr float C = SCALE * 1.4426950408889634f;
  float pmax = p0[0];
#pragma unroll
  for (int r = 1; r < 16; ++r) pmax = fmaxf(pmax, p0[r]);
#pragma unroll
  for (int r = 0; r < 16; ++r) pmax = fmaxf(pmax, p1[r]);
  { auto rr = __builtin_amdgcn_permlane32_swap(__float_as_uint(pmax), __float_as_uint(pmax), false, false);
    pmax = fmaxf(__uint_as_float(rr[0]), __uint_as_float(rr[1])); }
  if (__builtin_expect(__all(pmax - m_reg <= THR / SCALE), 1)) { mn = m_reg; alpha = 1.f; }
  else { mn = fmaxf(m_reg, pmax); alpha = __builtin_amdgcn_exp2f((m_reg - mn) * C); m_reg = mn; }
  float mnC = -mn * C;
#pragma unroll
  for (int r = 0; r < 16; ++r) p0[r] = fmaf(p0[r], C, mnC);
#pragma unroll
  for (int r = 0; r < 16; ++r) p1[r] = fmaf(p1[r], C, mnC);
#pragma unroll
  for (int r = 0; r < 16; ++r) p0[r] = __builtin_amdgcn_exp2f(p0[r]);
}
__device__ __forceinline__ void finishSM(f32x16& p0, f32x16& p1, float alpha, float& l_reg, bf16x8& pa0, bf16x8& pa1, bf16x8& pa2, bf16x8& pa3) {
#pragma unroll
  for (int r = 0; r < 16; ++r) p1[r] = __builtin_amdgcn_exp2f(p1[r]);
  float ps = 0;
#pragma unroll
  for (int r = 0; r < 16; ++r) ps += p0[r];
#pragma unroll
  for (int r = 0; r < 16; ++r) ps += p1[r];
  { auto rr = __builtin_amdgcn_permlane32_swap(__float_as_uint(ps), __float_as_uint(ps), false, false);
    ps = __uint_as_float(rr[0]) + __uint_as_float(rr[1]); }
  l_reg = l_reg * alpha + ps;
#define PK4(P, BASE, OUT) do { unsigned a0 = cvtpk(P[BASE + 0], P[BASE + 1]), a1 = cvtpk(P[BASE + 2], P[BASE + 3]);   \
    unsigned b0 = cvtpk(P[BASE + 4], P[BASE + 5]), b1 = cvtpk(P[BASE + 6], P[BASE + 7]);                              \
    auto r0 = __builtin_amdgcn_permlane32_swap(a0, b0, false, false); auto r1 = __builtin_amdgcn_permlane32_swap(a1, b1, false, false); \
    u32x4 w = {r0[0], r1[0], r0[1], r1[1]}; OUT = *reinterpret_cast<bf16x8*>(&w); } while (0)
  PK4(p0, 0, pa0); PK4(p0, 8, pa1); PK4(p1, 0, pa2); PK4(p1, 8, pa3);
#undef PK4
}
__device__ __forceinline__ void qkt(f32x16& p0, f32x16& p1, const LAS char* Ks, const bf16x8 (&qr)[12], int r32, int hi) {
  p0 = f32x16{}; p1 = f32x16{};
#pragma unroll
  for (int d0 = 0; d0 < 12; ++d0) { const int cb = (d0 * 16 + hi * 8) * 2;
    const bf16x8 b0 = *reinterpret_cast<const LAS bf16x8*>(Ks + KSWZ(r32, cb));
    const bf16x8 b1 = *reinterpret_cast<const LAS bf16x8*>(Ks + KSWZ(32 + r32, cb));
    p0 = __builtin_amdgcn_mfma_f32_32x32x16_bf16(b0, qr[d0], p0, 0, 0, 0);
    p1 = __builtin_amdgcn_mfma_f32_32x32x16_bf16(b1, qr[d0], p1, 0, 0, 0); }
}
__device__ __forceinline__ int v_st(int k, int c) { const int kk = (k & ~0xC) | ((k & 4) << 1) | ((k & 8) >> 1); return ((kk >> 3) * 4 + (c >> 5)) * 512 + ((kk & 7) * 32 + (c & 31)) * 2; }
__device__ __forceinline__ int v_rd_base(int lane) { return ((lane & 3) << 3) | (((lane >> 2) & 3) << 6) | (((lane >> 4) & 1) << 5) | (((lane >> 5) & 1) << 8); }
constexpr int v_rd_off(int d0, int ks, int half) { return d0 * 512 + ks * 4096 + half * 2048; }
template <int OFF> __device__ __forceinline__ s16x4 tr_read(int vb) { s16x4 r; asm volatile("ds_read_b64_tr_b16 %0, %1 offset:%2" : "=&v"(r) : "v"(vb), "i"(OFF) : "memory"); return r; }
template <int D0> __device__ __forceinline__ void pv_one(f32x16& od, int vb, bf16x8 pa0, bf16x8 pa1, bf16x8 pa2, bf16x8 pa3) {
  const s16x4 l0 = tr_read<v_rd_off(D0, 0, 0)>(vb), h0 = tr_read<v_rd_off(D0, 0, 1)>(vb), l1 = tr_read<v_rd_off(D0, 1, 0)>(vb), h1 = tr_read<v_rd_off(D0, 1, 1)>(vb);
  const s16x4 l2 = tr_read<v_rd_off(D0, 2, 0)>(vb), h2 = tr_read<v_rd_off(D0, 2, 1)>(vb), l3 = tr_read<v_rd_off(D0, 3, 0)>(vb), h3 = tr_read<v_rd_off(D0, 3, 1)>(vb);
  asm volatile("s_waitcnt lgkmcnt(0)" ::: "memory"); SBAR();
#define PK(Lo, Hi) (bf16x8){Lo[0], Lo[1], Lo[2], Lo[3], Hi[0], Hi[1], Hi[2], Hi[3]}
  od = __builtin_amdgcn_mfma_f32_32x32x16_bf16(pa0, PK(l0, h0), od, 0, 0, 0);
  od = __builtin_amdgcn_mfma_f32_32x32x16_bf16(pa1, PK(l1, h1), od, 0, 0, 0);
  od = __builtin_amdgcn_mfma_f32_32x32x16_bf16(pa2, PK(l2, h2), od, 0, 0, 0);
  od = __builtin_amdgcn_mfma_f32_32x32x16_bf16(pa3, PK(l3, h3), od, 0, 0, 0);
#undef PK
}
__device__ __forceinline__ void pv_d0(f32x16 (&o)[4], int vb, bf16x8 pa0, bf16x8 pa1, bf16x8 pa2, bf16x8 pa3) {
  pv_one<0>(o[0], vb, pa0, pa1, pa2, pa3); pv_one<1>(o[1], vb, pa0, pa1, pa2, pa3); pv_one<2>(o[2], vb, pa0, pa1, pa2, pa3); pv_one<3>(o[3], vb, pa0, pa1, pa2, pa3);
}

__device__ __forceinline__ void attn_unit(const bf16_t* __restrict__ Qb, const bf16_t* __restrict__ Kh, const bf16_t* __restrict__ Vh, bf16_t* __restrict__ Ob, int t0, const float* __restrict__ ropet, LAS char* lds) {
  constexpr int LDQ = 1536, LDO = 1024, NT = NKEY / KVBLK;
  const int tid = otid(), wid = tid >> 6, lane = tid & 63, r32 = lane & 31, hi = lane >> 5;
  LAS char* V_lds = lds; LAS char* K_lds = lds + 2 * SHM_V;
  LAS float* wsl = (LAS float*)(lds + 2 * SHM_V + 2 * SHM_K) + wid * 64; LAS float* li_l = wsl; LAS float* al_l = wsl + 32;
  float m_reg = -1e30f, l_reg = 0; f32x16 o[4] = {}; bf16x8 qr[12];
  { const bf16_t* Qw = Qb + (size_t)(wid * QBLK + r32) * LDQ + hi * 8;
#pragma unroll
    for (int d0 = 0; d0 < 12; ++d0) qr[d0] = *reinterpret_cast<const bf16x8*>(Qw + d0 * 16);
    const float* rt = ropet + (size_t)(t0 + wid * QBLK + r32) * 64 + 8 * hi;
#pragma unroll
    for (int g = 0; g < 2; ++g) {
      const f32x4 c0 = *(const f32x4*)(rt + 16 * g), c1 = *(const f32x4*)(rt + 16 * g + 4), s0 = *(const f32x4*)(rt + 32 + 16 * g), s1 = *(const f32x4*)(rt + 32 + 16 * g + 4);
      float n1[8], n2[8];
#pragma unroll
      for (int j = 0; j < 8; ++j) { const float cs = j < 4 ? c0[j & 3] : c1[j & 3], sn = j < 4 ? s0[j & 3] : s1[j & 3];
        const float x1 = bf2f((bf16_t)qr[8 + g][j]), x2 = bf2f((bf16_t)qr[10 + g][j]); n1[j] = x1 * cs - x2 * sn; n2[j] = x1 * sn + x2 * cs; }
      u32x4 w1 = {cvtpk(n1[0], n1[1]), cvtpk(n1[2], n1[3]), cvtpk(n1[4], n1[5]), cvtpk(n1[6], n1[7])}; u32x4 w2 = {cvtpk(n2[0], n2[1]), cvtpk(n2[2], n2[3]), cvtpk(n2[4], n2[5]), cvtpk(n2[6], n2[7])};
      qr[8 + g] = *reinterpret_cast<bf16x8*>(&w1); qr[10 + g] = *reinterpret_cast<bf16x8*>(&w2); } }
  const int sr = tid >> 4, sc = (tid & 15) * 8, vst0 = v_st(sr, sc), vst1 = v_st(32 + sr, sc);
  int kgo[3], kst[3];
#pragma unroll
  for (int i = 0; i < 3; ++i) { const int c = tid + 512 * i, row = c / 24, c8 = (c % 24) * 8; kgo[i] = row * DK + c8; kst[i] = KSWZ(row, c8 * 2); }
  const int vb0 = (int)(uintptr_t)V_lds + v_rd_base(lane);
  bf16x8 sv0, sv1, sk0, sk1, sk2;
#define SLOAD(k0) do { sv0 = *reinterpret_cast<const bf16x8*>(&Vh[(size_t)((k0) + sr) * DV + sc]); sv1 = *reinterpret_cast<const bf16x8*>(&Vh[(size_t)((k0) + 32 + sr) * DV + sc]); \
    sk0 = *reinterpret_cast<const bf16x8*>(&Kh[(size_t)(k0) * DK + kgo[0]]); sk1 = *reinterpret_cast<const bf16x8*>(&Kh[(size_t)(k0) * DK + kgo[1]]); sk2 = *reinterpret_cast<const bf16x8*>(&Kh[(size_t)(k0) * DK + kgo[2]]); } while (0)
#define SWRITE(b) do { *(LAS bf16x8*)(V_lds + (b) * SHM_V + vst0) = sv0; *(LAS bf16x8*)(V_lds + (b) * SHM_V + vst1) = sv1; \
    *(LAS bf16x8*)(K_lds + (b) * SHM_K + kst[0]) = sk0; *(LAS bf16x8*)(K_lds + (b) * SHM_K + kst[1]) = sk1; *(LAS bf16x8*)(K_lds + (b) * SHM_K + kst[2]) = sk2; } while (0)
#define RESC(a) do { if (__any((a) < 1.f)) { if (hi == 0) al_l[r32] = (a); asm volatile("s_waitcnt lgkmcnt(0)" ::: "memory"); \
    _Pragma("unroll") for (int d = 0; d < 4; ++d) _Pragma("unroll") for (int r = 0; r < 16; ++r) o[d][r] *= al_l[crow(r, hi)]; } } while (0)
  f32x16 p0, p1; float mn, al; bf16x8 pa0, pa1, pa2, pa3;
  SLOAD(0); asm volatile("s_waitcnt vmcnt(0)" ::: "memory"); SWRITE(0); __syncthreads();
  for (int j = 0; j < NT; ++j) {
    const int bsel = j & 1;
    if (j + 1 < NT) SLOAD((j + 1) * KVBLK);
    SBAR(); qkt(p0, p1, K_lds + bsel * SHM_K, qr, r32, hi);
    partialSM(p0, p1, m_reg, mn, al);
    RESC(al);
    finishSM(p0, p1, al, l_reg, pa0, pa1, pa2, pa3); SBAR();
    pv_d0(o, vb0 + bsel * SHM_V, pa0, pa1, pa2, pa3);
    if (j + 1 < NT) { asm volatile("s_waitcnt vmcnt(0)" ::: "memory"); SWRITE(bsel ^ 1); }
    __syncthreads();
  }
  if (hi == 0) li_l[r32] = l_reg; asm volatile("s_waitcnt lgkmcnt(0)" ::: "memory");
  float rli[16];
#pragma unroll
  for (int r = 0; r < 16; ++r) rli[r] = __builtin_amdgcn_rcpf(li_l[crow(r, hi)]);
  { LAS bf16_t* ot = (LAS bf16_t*)(lds + wid * 8192);
#pragma unroll
    for (int r = 0; r < 16; ++r) { const int orow = crow(r, hi);
#pragma unroll
      for (int d0 = 0; d0 < 4; ++d0) ot[orow * 128 + d0 * 32 + r32] = f2bf(o[d0][r] * rli[r]); }
    asm volatile("s_waitcnt lgkmcnt(0)" ::: "memory");
    bf16_t* Ow = Ob + (size_t)(wid * QBLK) * LDO;
#pragma unroll
    for (int i = 0; i < 8; ++i) { const int q = lane + 64 * i, row = q >> 4, ch = q & 15; const u32x4 w = *(const LAS u32x4*)(ot + row * 128 + ch * 8); *(u32x4*)(Ow + (size_t)row * LDO + ch * 8) = w; } }
#undef SLOAD
#undef SWRITE
#undef RESC
}
}

__device__ __forceinline__ void phase_attn(const Params& p, LAS unsigned char* lds) {
    char* ws = p.ws; const bf16_t* Q = (const bf16_t*)(ws + OFF_Q); const bf16_t* Kb = (const bf16_t*)(ws + OFF_K); const bf16_t* Vb = (const bf16_t*)(ws + OFF_V); bf16_t* Y = (bf16_t*)(ws + OFF_H);
    const int G = gridDim.x;
    for (int it = 0;; ++it) {
        int u;
        if (G == 256) { const int c = blockIdx.x, xcd = c & 7, j = c >> 3; if (it >= 4) break; u = ((it * 32 + xcd * 4 + (j >> 3)) << 3) | (j & 7); }
        else { u = it * G + blockIdx.x; if (u >= 1024) break; }
        const int bh = u >> 3, qb = u & 7, b = bh >> 3, h = bh & 7;
        at::attn_unit(Q + ((size_t)(b * SEQ + qb * 256)) * 1536 + h * 192, Kb + (size_t)bh * NKEY * 192, Vb + (size_t)bh * NKEY * 128, Y + ((size_t)(b * SEQ + qb * 256)) * D + h * 128, qb * 256, (const float*)(ws + OFF_ROPE), (LAS char*)lds);
        __syncthreads();
    }
}

namespace sc {
using f32x16 = __attribute__((ext_vector_type(16))) float;
constexpr int BUFB = 53248, O_QT = 0, O_KH = 16384, O_VT = 32768, O_AT = 49152, O_DEC = 51200, O_KD = 2 * BUFB, LDS_SCAN = 2 * BUFB + 16384;
__device__ __forceinline__ int sw256(int row, int cb) { return row * 256 + (cb ^ ((row & 15) << 4)); }
__device__ __forceinline__ int sw128(int row, int cb) { return row * 128 + (cb ^ (((row >> 1) & 7) << 4)); }
__device__ __forceinline__ int grow_of(int n, int b, int dir) { if (n < CTXL) { const int s = dir ? (CTXL - 1 - n) : n; return L + b * CTXL + s; } const int m = n - CTXL; return b * SEQ + (dir ? (SEQ - 1 - m) : m); }
__device__ __forceinline__ bf16x8 pack_acc8(const f32x16& x, int s) { u32x4 p; p.x = cvt_pk_bf16(x[8 * s], x[8 * s + 1]); p.y = cvt_pk_bf16(x[8 * s + 2], x[8 * s + 3]); p.z = cvt_pk_bf16(x[8 * s + 4], x[8 * s + 5]); p.w = cvt_pk_bf16(x[8 * s + 6], x[8 * s + 7]); return __builtin_bit_cast(bf16x8, p); }

__device__ __forceinline__ void scan_unit(const Params& p, int unit, LAS unsigned char* lds) {
    char* ws = p.ws; const int dir = unit & 1, h = (unit >> 1) & 7, b = unit >> 4;
    const bf16_t* hq = (const bf16_t*)(ws + OFF_HQ); const bf16_t* fz = (const bf16_t*)(ws + (dir ? OFF_FB : OFF_FF)); const bf16_t* iv = (const bf16_t*)(ws + OFF_IV);
    bf16_t* outp = (bf16_t*)(ws + (dir ? OFF_OB : OFF_OF)); const float* lb = (const float*)(ws + OFF_LB);
    const int tid = otid(), wid = __builtin_amdgcn_readfirstlane(tid >> 6), lane = tid & 63, r32 = lane & 31, hi = lane >> 5;
    const int sgn = dir ? -1 : 1; const long rstep = (long)sgn * D;
    __syncthreads();
    if (wid >= 4) {
        const int I = wid - 4, cp = lane, hc = h * 128 + 2 * cp;
        const float lbv0 = lb[dir * 1024 + hc], lbv1 = lb[dir * 1024 + hc + 1];
        unsigned zr[16], vr[16], qr[16];
#define SC_LOAD(c) do { const size_t o0_ = (size_t)(grow_of((c) * 64, b, dir) + sgn * (16 * I)) * D + hc; const bf16_t* pz_ = fz + o0_; const bf16_t* pv_ = iv + o0_; const bf16_t* pq_ = hq + o0_; \
        _Pragma("unroll") for (int i = 0; i < 16; ++i) { zr[i] = *(const unsigned*)pz_; pz_ += rstep; vr[i] = *(const unsigned*)pv_; pv_ += rstep; if ((c) >= 4) { qr[i] = *(const unsigned*)pq_; pq_ += rstep; } } } while (0)
        SC_LOAD(0);
        for (int it = 0; it <= 36; ++it) {
            if (it < 36) {
                const int c = it; const bool lat = c >= 4; LAS unsigned char* B = lds + (c & 1) * BUFB; LAS unsigned char* KD = lds + O_KD;
                float kk0[16], kk1[16], lc0[16], lc1[16]; float run0 = 0.f, run1 = 0.f;
#pragma unroll
                for (int i = 0; i < 16; ++i) { const float z0 = __uint_as_float(zr[i] << 16), z1 = __uint_as_float(zr[i] & 0xffff0000u);
                    const float f0 = lbv0 + (1.0f - lbv0) * sigmoidf_(z0), f1 = lbv1 + (1.0f - lbv1) * sigmoidf_(z1); kk0[i] = 1.0f - f0; kk1[i] = 1.0f - f1;
                    run0 += __builtin_amdgcn_logf(f0) * 0.6931471805599453f; run1 += __builtin_amdgcn_logf(f1) * 0.6931471805599453f; lc0[i] = run0; lc1[i] = run1; }
                *(LAS f32x2*)(B + O_DEC + (I * 128 + 2 * cp) * 4) = (f32x2){__expf(run0), __expf(run1)};
                unsigned kh0[8], kh1[8], vt0[8], vt1[8];
#pragma unroll
                for (int i = 0; i < 16; ++i) { const int t = 16 * I + i; const float l0 = lc0[i], l1 = lc1[i];
                    const float kd0 = kk0[i] * __expf(fminf(-l0, 80.0f)), kd1 = kk1[i] * __expf(fminf(-l1, 80.0f));
                    const float kf0 = kk0[i] * __expf(run0 - l0), kf1 = kk1[i] * __expf(run1 - l1);
                    if (lat) { const float q0 = __uint_as_float(qr[i] << 16), q1 = __uint_as_float(qr[i] & 0xffff0000u);
                        *(LAS unsigned*)(B + O_QT + sw256(t, 4 * cp)) = cvt_pk_bf16(q0 * __expf(l0), q1 * __expf(l1)); *(LAS unsigned*)(KD + sw256(t, 4 * cp)) = cvt_pk_bf16(kd0, kd1); }
                    if (i & 1) { kh0[i >> 1] = cvt_pk_bf16(__uint_as_float(kh0[i >> 1]), kf0); kh1[i >> 1] = cvt_pk_bf16(__uint_as_float(kh1[i >> 1]), kf1); vt0[i >> 1] = (vt0[i >> 1] >> 16) | (vr[i] << 16); vt1[i >> 1] = (vt1[i >> 1] >> 16) | (vr[i] & 0xffff0000u); }
                    else { kh0[i >> 1] = __float_as_uint(kf0); kh1[i >> 1] = __float_as_uint(kf1); vt0[i >> 1] = vr[i] << 16; vt1[i >> 1] = vr[i] & 0xffff0000u; } }
#pragma unroll
                for (int q = 0; q < 2; ++q) {
                    *(LAS u32x4*)(B + O_KH + sw128(2 * cp, 32 * I + 16 * q)) = (u32x4){kh0[4 * q], kh0[4 * q + 1], kh0[4 * q + 2], kh0[4 * q + 3]}; *(LAS u32x4*)(B + O_KH + sw128(2 * cp + 1, 32 * I + 16 * q)) = (u32x4){kh1[4 * q], kh1[4 * q + 1], kh1[4 * q + 2], kh1[4 * q + 3]};
                    *(LAS u32x4*)(B + O_VT + sw128(2 * cp, 32 * I + 16 * q)) = (u32x4){vt0[4 * q], vt0[4 * q + 1], vt0[4 * q + 2], vt0[4 * q + 3]}; *(LAS u32x4*)(B + O_VT + sw128(2 * cp + 1, 32 * I + 16 * q)) = (u32x4){vt1[4 * q], vt1[4 * q + 1], vt1[4 * q + 2], vt1[4 * q + 3]}; }
                if (it + 1 < 36) SC_LOAD(it + 1);
                if (lat) {
                    const int l15 = lane & 15, lq = lane >> 4; f32x4 a = {0.f, 0.f, 0.f, 0.f};
#pragma unroll
                    for (int ks = 0; ks < 4; ++ks) { const bf16x8 av = *(const LAS bf16x8*)(B + O_QT + sw256(16 * I + l15, (32 * ks + 8 * lq) * 2)); const bf16x8 bv = *(const LAS bf16x8*)(KD + sw256(16 * I + l15, (32 * ks + 8 * lq) * 2));
                        a = __builtin_amdgcn_mfma_f32_16x16x32_bf16(av, bv, a, 0, 0, 0); }
#pragma unroll
                    for (int r = 0; r < 4; ++r) { const int tl = 4 * lq + r; float v = a[r]; if (l15 > tl) v = 0.f; *(LAS bf16_t*)(B + O_AT + ((I * 16 + tl) * 16 + l15) * 2) = f2bf(v); }
                }
            }
            __syncthreads();
        }
#undef SC_LOAD
    } else {
        const int bq = wid; f32x16 S[4];
#pragma unroll
        for (int a = 0; a < 4; ++a) S[a] = f32x16{};
        for (int it = 0; it <= 36; ++it) {
            if (it >= 1) {
                const int c = it - 1; const bool lat = c >= 4; LAS unsigned char* B = lds + (c & 1) * BUFB;
                bf16_t* po = outp + (size_t)(grow_of(c * 64, b, dir) + sgn * (4 * hi)) * D + h * 128 + 32 * bq + r32;
#pragma unroll
                for (int I = 0; I < 4; ++I) {
                    const bf16x8 vtf = *(const LAS bf16x8*)(B + O_VT + sw128(32 * bq + r32, (16 * I + 8 * hi) * 2));
                    if (lat) {
                        f32x16 o = f32x16{};
#pragma unroll
                        for (int a = 0; a < 4; ++a)
#pragma unroll
                            for (int s = 0; s < 2; ++s) { const int dk0 = 32 * a + 16 * s + 4 * hi; const int row = 16 * I + (r32 & 15);
                                const u32x2 lo2 = *(const LAS u32x2*)(B + O_QT + sw256(row, dk0 * 2)), hi2 = *(const LAS u32x2*)(B + O_QT + sw256(row, (dk0 + 8) * 2));
                                const u32x4 av = {lo2.x, lo2.y, hi2.x, hi2.y};
                                o = __builtin_amdgcn_mfma_f32_32x32x16_bf16(__builtin_bit_cast(bf16x8, av), pack_acc8(S[a], s), o, 0, 0, 0); }
                        { const bf16x8 af = *(const LAS bf16x8*)(B + O_AT + ((I * 16 + (r32 & 15)) * 16 + 8 * hi) * 2); o = __builtin_amdgcn_mfma_f32_32x32x16_bf16(af, vtf, o, 0, 0, 0); }
#pragma unroll
                        for (int r = 0; r < 8; ++r) po[(long)(16 * I + (r & 3) + 8 * (r >> 2)) * rstep] = f2bf(o[r]);
                    }
#pragma unroll
                    for (int a = 0; a < 4; ++a) {
#pragma unroll
                        for (int g = 0; g < 4; ++g) { const f32x4 dc = *(const LAS f32x4*)(B + O_DEC + (I * 128 + 32 * a + 8 * g + 4 * hi) * 4); S[a][4 * g] *= dc[0]; S[a][4 * g + 1] *= dc[1]; S[a][4 * g + 2] *= dc[2]; S[a][4 * g + 3] *= dc[3]; }
                        const bf16x8 kf = *(const LAS bf16x8*)(B + O_KH + sw128(32 * a + r32, (16 * I + 8 * hi) * 2));
                        S[a] = __builtin_amdgcn_mfma_f32_32x32x16_bf16(kf, vtf, S[a], 0, 0, 0); }
                }
            }
            __syncthreads();
        }
    }
    __syncthreads();
}
}
__device__ __forceinline__ void phase_scan(const Params& p, LAS unsigned char* lds) {
    for (int u = blockIdx.x; u < 256; u += gridDim.x) sc::scan_unit(p, u, lds);
}

constexpr int LDS_BYTES = 155648;
template <int PH> __global__ void __launch_bounds__(512, 2) k_phase(Params p) {
    extern __shared__ __attribute__((aligned(16))) unsigned char smem[];
    LAS unsigned char* lds = (LAS unsigned char*)smem;
    if constexpr (PH == 0) phase0(p, lds);
    if constexpr (PH == 1) phase1(p, lds);
    if constexpr (PH == 2) phase2(p, lds);
    if constexpr (PH == 3) phase3(p, lds);
    if constexpr (PH == 4) phase4(p, lds);
    if constexpr (PH == 5) phase5(p, lds);
    if constexpr (PH == 6) phase6(p, lds);
    if constexpr (PH == 7) phase7(p, lds);
    if constexpr (PH == 8) phase8(p, lds);
    if constexpr (PH == 9) phase9(p, lds);
    if constexpr (PH == 10) phase_attn(p, lds);
    if constexpr (PH == 11) phase_scan(p, lds);
}

#include <cstdint>
#include <cstdlib>
#include <vector>

#define XB_TMO      128
#define XB_XCNT(j)  (256  + 64 * (j))
#define XB_XSUB(j)  (1280 + 64 * (j))
#define XB_XGEN(j)  (2304 + 64 * (j))
#define XB_TOP      3328
#define XB_TOPGEN   3392
#define XCD_BAR_WORDS 3456
#define XB_SPIN_CAP (1u << 18)

__device__ __forceinline__ unsigned xb_ld(unsigned* p)              { return __hip_atomic_load(p, __ATOMIC_RELAXED, __HIP_MEMORY_SCOPE_AGENT); }
__device__ __forceinline__ unsigned xb_add(unsigned* p, unsigned v) { return __hip_atomic_fetch_add(p, v, __ATOMIC_RELAXED, __HIP_MEMORY_SCOPE_AGENT); }
__device__ __forceinline__ unsigned xb_xcc_id() { return (unsigned)__builtin_amdgcn_s_getreg((3 << 11) | 20) & 0xFu; }
#define XB_SPIN(cond, bar) do { unsigned _sp = 0; while (cond) { __builtin_amdgcn_s_sleep(1); \
    if ((++_sp & 255u) == 0u) { if (xb_ld(&(bar)[XB_TMO])) break; if (_sp > XB_SPIN_CAP) { atomicAdd(&(bar)[XB_TMO], 1u); break; } } } } while (0)

struct XcdBarrier {
    unsigned* bar; unsigned x;
    volatile LAS unsigned* st;
};

__device__ __forceinline__ XcdBarrier xcd_barrier_post(unsigned* bar, volatile LAS unsigned* st) {
    XcdBarrier b; b.bar = bar; b.x = xb_xcc_id(); b.st = st;
    if (threadIdx.x == 0) (void)xb_add(&bar[XB_XCNT(b.x)], 1u);
    return b;
}
__device__ __forceinline__ void xcd_barrier_complete(unsigned* bar, unsigned x, unsigned& nloc, unsigned& nx) {
    const unsigned G = gridDim.x * gridDim.y * gridDim.z;
    unsigned sum, cnt, mine, sp = 0u;
    for (;;) {
        sum = 0u; cnt = 0u; mine = 0u;
#pragma unroll
        for (unsigned j = 0; j < 16; ++j) { const unsigned c = xb_ld(&bar[XB_XCNT(j)]); sum += c; cnt += (c > 0u) ? 1u : 0u; mine = (j == x) ? c : mine; }
        if (sum == G) break;
        __builtin_amdgcn_s_sleep(1);
        if ((++sp & 255u) == 0u) { if (xb_ld(&bar[XB_TMO])) break; if (sp > XB_SPIN_CAP) { atomicAdd(&bar[XB_TMO], 1u); break; } }
    }
    nloc = mine > 0u ? mine : 1u; nx = cnt > 0u ? cnt : 1u;
}

__device__ __forceinline__ void xcd_barrier(const XcdBarrier& b) {
    asm volatile("s_waitcnt vmcnt(0)" ::: "memory");
    __syncthreads();
    if (threadIdx.x == 0) {
        unsigned* bar = b.bar;
        __builtin_amdgcn_s_waitcnt(0);
        unsigned nloc = b.st[0], nx = b.st[1];
        if (nloc == 0u) { xcd_barrier_complete(bar, b.x, nloc, nx); b.st[0] = nloc; b.st[1] = nx; }
        const unsigned old = xb_add(&bar[XB_XSUB(b.x)], 1u);
        const unsigned gen = old / nloc;
        if (old + 1u == (gen + 1u) * nloc) {
            __builtin_amdgcn_fence(__ATOMIC_RELEASE, "agent");
            asm volatile("s_waitcnt vmcnt(0)" ::: "memory");
            const unsigned og = xb_add(&bar[XB_TOP], 1u);
            const unsigned tg = og / nx;
            if (og + 1u == (tg + 1u) * nx) xb_add(&bar[XB_TOPGEN], 1u);
            else XB_SPIN(xb_ld(&bar[XB_TOPGEN]) == tg, bar);
            __builtin_amdgcn_fence(__ATOMIC_ACQUIRE, "agent");
            xb_add(&bar[XB_XGEN(b.x)], 1u);
            asm volatile("s_waitcnt vmcnt(0)" ::: "memory");
        } else {
            XB_SPIN(xb_ld(&bar[XB_XGEN(b.x)]) == gen, bar);
            __builtin_amdgcn_fence(__ATOMIC_ACQUIRE, "agent");
            asm volatile("s_waitcnt vmcnt(0)" ::: "memory");
        }
    }
    __syncthreads();
}

__global__ void __launch_bounds__(512, 2) k_mega(Params p) {
    extern __shared__ __attribute__((aligned(16))) unsigned char smem[];
    LAS unsigned char* lds = (LAS unsigned char*)smem;
    volatile LAS unsigned* xbw = (volatile LAS unsigned*)(lds + LDS_BYTES - 16);
    if (threadIdx.x == 0) { xbw[0] = 0u; xbw[1] = 0u; xbw[2] = 0u; xbw[3] = 0u; }
    __syncthreads();
    XcdBarrier bar = xcd_barrier_post((unsigned*)(p.ws + OFF_BAR), xbw);
    phase0(p, lds);      xcd_barrier(bar);
    phase1(p, lds);      xcd_barrier(bar);
    phase2(p, lds);      xcd_barrier(bar);
    phase3(p, lds);      xcd_barrier(bar);
    phase_attn(p, lds);
    phase_scan(p, lds);  xcd_barrier(bar);
    phase4(p, lds);      xcd_barrier(bar);
    phase5(p, lds);      xcd_barrier(bar);
    phase6(p, lds);      xcd_barrier(bar);
    phase7(p, lds);      xcd_barrier(bar);
    phase8(p, lds);      xcd_barrier(bar);
    phase9(p, lds);
}
extern "C" void kernel_launch(void* const* d_in, const int* in_sizes, int n_in, void* d_out, int out_size, void* d_ws, size_t ws_size, hipStream_t stream) {
    static int grid = 0;
    if (grid == 0) {
        int dev = 0, cus = 0, per_cu = 0;
        if (hipGetDevice(&dev) != hipSuccess || hipDeviceGetAttribute(&cus, hipDeviceAttributeMultiprocessorCount, dev) != hipSuccess) { grid = -1; return; }
        if (hipFuncSetAttribute((const void*)k_mega, hipFuncAttributeMaxDynamicSharedMemorySize, LDS_BYTES) != hipSuccess) { grid = -1; return; }
        (void)hipOccupancyMaxActiveBlocksPerMultiprocessor(&per_cu, (const void*)k_mega, 512, LDS_BYTES);
        (void)hipGetLastError();
        grid = cus;
    }
    if (grid < 0) return;
    Params p{};
    p.x = (const float*)d_in[0]; p.c = (const float*)d_in[1]; p.ctx = (const float*)d_in[2]; p.cctx = (const float*)d_in[3]; p.w_mod = (const float*)d_in[4]; p.b_mod = (const float*)d_in[5];
    p.g_mix = (const float*)d_in[6]; p.w_in = (const float*)d_in[7]; p.g_q = (const float*)d_in[8]; p.w_qb = (const float*)d_in[9]; p.g_kv = (const float*)d_in[10]; p.w_kvb = (const float*)d_in[11];
    p.lbl = (const float*)d_in[12]; p.g_hg = (const float*)d_in[13]; p.w_out = (const float*)d_in[14]; p.g_ffn = (const float*)d_in[15]; p.w_r = (const float*)d_in[16]; p.b_r = (const float*)d_in[17];
    p.w_gu = (const float*)d_in[18]; p.b_gu = (const float*)d_in[19]; p.w_dn = (const float*)d_in[20]; p.b_dn = (const float*)d_in[21]; p.g_fin = (const float*)d_in[22];
    p.out = (float*)d_out; p.ws = (char*)d_ws;
    (void)hipMemsetAsync((char*)d_ws + OFF_BAR, 0, 16384, stream);
    hipLaunchKernelGGL(k_mega, dim3(grid), dim3(512), LDS_BYTES, stream, p);
}
```

```cpp
#include <hip/hip_runtime.h>
#include <stdint.h>

typedef unsigned short bf16_t;
__device__ __forceinline__ float bf2f(bf16_t v) { return __uint_as_float(((unsigned)v) << 16); }
__device__ __forceinline__ bf16_t f2bf(float f) { unsigned u = __float_as_uint(f); u += 0x7FFFu + ((u >> 16) & 1u); return (bf16_t)(u >> 16); }
__device__ __forceinline__ float sigmoidf_(float x) { return __builtin_amdgcn_rcpf(1.0f + __builtin_amdgcn_exp2f(-1.4426950408889634f * x)); }
__device__ __forceinline__ float siluf_(float x) { return x * __builtin_amdgcn_rcpf(1.0f + __builtin_amdgcn_exp2f(-1.4426950408889634f * x)); }

constexpr int D = 1024, NB = 16, SEQ = 2048, CTXL = 256;
constexpr int L = NB * SEQ;
constexpr int RC = NB * CTXL;
constexpr int R = L + RC;
constexpr int NKEY = SEQ + CTXL;
constexpr float EPS = 1e-6f;
constexpr int NE = 32, CAP = 32768;
constexpr int MAXROWS = 131072 + NE * 256;

constexpr size_t MiB = 1048576;
constexpr size_t OFF_SMALL = 0;
constexpr size_t OFF_BAR = 0;
constexpr size_t OFF_CNT = 16384;
constexpr size_t OFF_OFFS = 16384 + 1024;
constexpr size_t OFF_TILEE = 16384 + 2048;
constexpr size_t OFF_LB = 24576;
constexpr size_t OFF_MOD = 32768;
constexpr size_t OFF_SSQQ = 512 * 1024;
constexpr size_t OFF_SSQKV = 768 * 1024;
constexpr size_t OFF_TOPI = 1 * MiB;
constexpr size_t OFF_TOPP = 1 * MiB + 512 * 1024;
constexpr size_t OFF_ROWPAIR = 2 * MiB;
constexpr size_t OFF_LIST = 3 * MiB;
constexpr size_t OFF_H = 32 * MiB;
constexpr size_t OFF_QA = 104 * MiB;
constexpr size_t OFF_CKV = 152 * MiB;
constexpr size_t OFF_KR = 170 * MiB;
constexpr size_t OFF_OF = 104 * MiB;
constexpr size_t OFF_HQ = 175 * MiB;
constexpr size_t SEG_STRIDE = 72 * MiB;
constexpr size_t OFF_FF = OFF_HQ + 1 * SEG_STRIDE;
constexpr size_t OFF_FB = OFF_HQ + 2 * SEG_STRIDE;
constexpr size_t OFF_IV = OFF_HQ + 3 * SEG_STRIDE;
constexpr size_t OFF_OG = OFF_HQ + 4 * SEG_STRIDE;
constexpr size_t OFF_GM = OFF_HQ + 5 * SEG_STRIDE;
constexpr size_t OFF_GH = OFF_HQ + 6 * SEG_STRIDE;
constexpr size_t OFF_Q = 679 * MiB;
constexpr size_t OFF_K = 775 * MiB;
constexpr size_t OFF_V = 883 * MiB;
constexpr size_t OFF_OB = 955 * MiB;
constexpr size_t OFF_YP = 296 * MiB;
constexpr size_t OFF_ACT = 568 * MiB;

struct SegOut { bf16_t *qa, *ckv, *kr, *hq, *ff, *fb, *iv, *og, *gm, *gh; };

__global__ void k_init(const float* __restrict__ lbl, float* lb, int* cnt) {
    int i = blockIdx.x * blockDim.x + threadIdx.x;
    if (i < 2048) { int d = i >> 10, j = i & 1023; float a = lbl[(d * 2 + 0) * 1024 + j], b = lbl[(d * 2 + 1) * 1024 + j]; lb[i] = 1.0f / (1.0f + __expf(b - a)); }
    if (i < 32) cnt[i] = 0;
}

__global__ __launch_bounds__(256) void k_mod(const float* __restrict__ c, const float* __restrict__ cctx, const float* __restrict__ wmod, const float* __restrict__ bmod, float* modv) {
    __shared__ float s[1024];
    int r = blockIdx.y; const float* src = r < 16 ? c + r * 1024 : cctx;
    for (int k = threadIdx.x; k < 1024; k += 256) s[k] = siluf_(src[k]);
    __syncthreads();
    int j = blockIdx.x * 256 + threadIdx.x; float acc = 0.f;
    for (int k = 0; k < 1024; ++k) acc += s[k] * wmod[(size_t)k * 6144 + j];
    modv[r * 6144 + j] = acc + bmod[j];
}

__device__ __forceinline__ float block_sum256(float v, float* red) {
    for (int o = 32; o > 0; o >>= 1) v += __shfl_xor(v, o);
    int w = threadIdx.x >> 6; if ((threadIdx.x & 63) == 0) red[w] = v; __syncthreads();
    float t = red[0] + red[1] + red[2] + red[3]; __syncthreads(); return t;
}

__global__ __launch_bounds__(256) void k_norm1(const float* __restrict__ x, const float* __restrict__ ctx, const float* __restrict__ g, const float* __restrict__ modv, bf16_t* h) {
    __shared__ float red[4];
    int row = blockIdx.x; const float* src = row < L ? x + (size_t)row * D : ctx + (size_t)(row - L) * D;
    const float* mod = modv + (row < L ? row / SEQ : 16) * 6144;
    int c = threadIdx.x * 4; float4 v = *(const float4*)(src + c);
    float ss = block_sum256(v.x * v.x + v.y * v.y + v.z * v.z + v.w * v.w, red);
    float rs = rsqrtf(ss * (1.0f / D) + EPS);
    float o[4] = {v.x, v.y, v.z, v.w}; ushort4 w; bf16_t* wp = (bf16_t*)&w;
    for (int i = 0; i < 4; ++i) wp[i] = f2bf(o[i] * rs * g[c + i] * (1.0f + mod[1024 + c + i]) + mod[c + i]);
    *(ushort4*)(h + (size_t)row * D + c) = w;
}

__global__ __launch_bounds__(256) void k_rowssq(const bf16_t* __restrict__ buf, int width, int nrows, float* ssq) {
    int row = blockIdx.x * 4 + (threadIdx.x >> 6), lane = threadIdx.x & 63; if (row >= nrows) return;
    float s = 0.f; for (int k = lane; k < width; k += 64) { float v = bf2f(buf[(size_t)row * width + k]); s += v * v; }
    for (int o = 32; o > 0; o >>= 1) s += __shfl_xor(s, o);
    if (lane == 0) ssq[row] = s;
}

__device__ __forceinline__ void rope_cs(int t, int i, float& cs, float& sn) {
    int j = i & 15; float inv = __expf(-(float)j * (9.210340371976184f / 16.0f)); float pos = (i < 16) ? (float)(t >> 6) : (float)(t & 63);
    float ang = pos * inv; cs = cosf(ang); sn = sinf(ang);
}

__global__ __launch_bounds__(256) void k_krope(const bf16_t* __restrict__ kr, bf16_t* Kb) {
    int gid = blockIdx.x * 256 + threadIdx.x; int row = gid >> 5, i = gid & 31; if (row >= R) return;
    float x1 = bf2f(kr[(size_t)row * 64 + i]), x2 = bf2f(kr[(size_t)row * 64 + 32 + i]); float o1 = x1, o2 = x2; int b, pos;
    if (row < L) { b = row / SEQ; pos = row % SEQ; float cs, sn; rope_cs(pos, i, cs, sn); o1 = x1 * cs - x2 * sn; o2 = x1 * sn + x2 * cs; }
    else { b = (row - L) / CTXL; pos = SEQ + (row - L) % CTXL; }
    bf16_t w1 = f2bf(o1), w2 = f2bf(o2);
    for (int h = 0; h < 8; ++h) { bf16_t* p = Kb + ((size_t)(b * 8 + h) * NKEY + pos) * 192 + 128; p[i] = w1; p[32 + i] = w2; }
}

template <class AL, class EP>
__global__ __launch_bounds__(256) void k_ngemm(int K, const float* __restrict__ W, int ldw, size_t wzstride, AL al, EP ep) {
    __shared__ float As[16][68]; __shared__ float Bs[16][64];
    const int z = blockIdx.z, row0 = blockIdx.y * 64, col0 = blockIdx.x * 64, tid = threadIdx.x;
    const int mvalid = al.rows(z); if (row0 >= mvalid) return;
    const float* Wz = W + (size_t)z * wzstride;
    const int ar = tid >> 2, ak = (tid & 3) * 4; const bf16_t* arow = (row0 + ar < mvalid) ? al.rowptr(z, row0 + ar) : nullptr;
    const int bk = tid >> 4, bn = (tid & 15) * 4;
    const int ty = tid >> 4, tx = tid & 15;
    float acc[4][4] = {};
    for (int k0 = 0; k0 < K; k0 += 16) {
        float a4[4] = {0.f, 0.f, 0.f, 0.f};
        if (arow) { ushort4 u = *(const ushort4*)(arow + k0 + ak); const bf16_t* up = (const bf16_t*)&u; for (int i = 0; i < 4; ++i) a4[i] = bf2f(up[i]) * al.kscale(k0 + ak + i); }
        float4 b4 = *(const float4*)(Wz + (size_t)(k0 + bk) * ldw + col0 + bn);
        __syncthreads();
        for (int i = 0; i < 4; ++i) As[ak + i][ar] = a4[i];
        *(float4*)&Bs[bk][bn] = b4;
        __syncthreads();
#pragma unroll
        for (int kk = 0; kk < 16; ++kk) {
            float4 av = *(const float4*)&As[kk][ty * 4]; float4 bv = *(const float4*)&Bs[kk][tx * 4];
            float a[4] = {av.x, av.y, av.z, av.w}, b[4] = {bv.x, bv.y, bv.z, bv.w};
#pragma unroll
            for (int i = 0; i < 4; ++i)
#pragma unroll
                for (int j = 0; j < 4; ++j) acc[i][j] += a[i] * b[j];
        }
    }
    for (int i = 0; i < 4; ++i) { int row = row0 + ty * 4 + i; if (row < mvalid) ep.store(z, row, col0 + tx * 4, acc[i]); }
}

__device__ __forceinline__ void st4bf(bf16_t* dst, const float* v) { ushort4 w; bf16_t* wp = (bf16_t*)&w; for (int i = 0; i < 4; ++i) wp[i] = f2bf(v[i]); *(ushort4*)dst = w; }

struct ALDense { const bf16_t* A; int lda; int nrows; const float* ks;
    __device__ int rows(int) const { return nrows; }
    __device__ const bf16_t* rowptr(int, int row) const { return A + (size_t)row * lda; }
    __device__ float kscale(int k) const { return ks ? ks[k] : 1.0f; } };

struct EpiInN { SegOut s;
    __device__ void store(int, int row, int col, const float* v) const {
        bf16_t* dst;
        if (col < 768) { if (row >= L) return; dst = s.qa + (size_t)row * 768 + col; }
        else if (col < 1024) dst = s.ckv + (size_t)row * 256 + (col - 768);
        else if (col < 1088) dst = s.kr + (size_t)row * 64 + (col - 1024);
        else { int c = col - 1088, seg = c >> 10, cc = c & 1023; bool latonly = (seg == 0 || seg >= 4); if (latonly && row >= L) return;
            bf16_t* base = seg == 0 ? s.hq : seg == 1 ? s.ff : seg == 2 ? s.fb : seg == 3 ? s.iv : seg == 4 ? s.og : seg == 5 ? s.gm : s.gh;
            dst = base + (size_t)row * 1024 + cc; }
        st4bf(dst, v);
    } };

struct EpiQN { bf16_t* q; const float* ssq;
    __device__ void store(int, int row, int col, const float* v) const { float rs = rsqrtf(ssq[row] * (1.0f / 768.0f) + EPS); float o[4]; for (int i = 0; i < 4; ++i) o[i] = v[i] * rs; st4bf(q + (size_t)row * 1536 + col, o); } };

struct EpiKVN { bf16_t *Kb, *Vb; const float* ssq;
    __device__ void store(int, int row, int col, const float* v) const {
        float rs = rsqrtf(ssq[row] * (1.0f / 256.0f) + EPS); float o[4]; for (int i = 0; i < 4; ++i) o[i] = v[i] * rs;
        int b, pos; if (row < L) { b = row / SEQ; pos = row % SEQ; } else { b = (row - L) / CTXL; pos = SEQ + (row - L) % CTXL; }
        int h = col >> 8, w = col & 255; size_t kvrow = (size_t)(b * 8 + h) * NKEY + pos;
        if (w < 128) st4bf(Kb + kvrow * 192 + w, o); else st4bf(Vb + kvrow * 128 + (w - 128), o);
    } };

struct EpiOutN { float* x1; const float* x; const float* modv;
    __device__ void store(int, int row, int col, const float* v) const {
        const float* gate = modv + (row / SEQ) * 6144 + 2 * 1024; float4 xv = *(const float4*)(x + (size_t)row * D + col);
        float4 o; o.x = xv.x + gate[col] * v[0]; o.y = xv.y + gate[col + 1] * v[1]; o.z = xv.z + gate[col + 2] * v[2]; o.w = xv.w + gate[col + 3] * v[3];
        *(float4*)(x1 + (size_t)row * D + col) = o;
    } };

struct ALMoe1 { const bf16_t* h2; const int* cnt; const int* list;
    __device__ int rows(int z) const { return cnt[z]; }
    __device__ const bf16_t* rowptr(int z, int row) const { return h2 + (size_t)(list[z * CAP + row] >> 2) * D; }
    __device__ float kscale(int) const { return 1.0f; } };
struct EpiMoe1N { bf16_t* act; const int* offs; const float* bgu;
    __device__ void store(int z, int row, int col, const float* v) const {
        const float* bb = bgu + z * 2048 + col; ushort2 w; bf16_t* wp = (bf16_t*)&w;
        for (int p = 0; p < 2; ++p) { float glu = fminf(v[2 * p] + bb[2 * p], 7.0f); float lin = fminf(fmaxf(v[2 * p + 1] + bb[2 * p + 1], -7.0f), 7.0f);
            wp[p] = f2bf(glu * sigmoidf_(1.702f * glu) * (lin + 1.0f)); }
        *(ushort2*)(act + (size_t)(offs[z] + row) * D + (col >> 1)) = w;
    } };
struct ALMoe2 { const bf16_t* act; const int* cnt; const int* offs;
    __device__ int rows(int z) const { return cnt[z]; }
    __device__ const bf16_t* rowptr(int z, int row) const { return act + (size_t)(offs[z] + row) * D; }
    __device__ float kscale(int) const { return 1.0f; } };
struct EpiMoe2N { bf16_t* yp; const int* list; const float* bd;
    __device__ void store(int z, int row, int col, const float* v) const {
        int pair = list[z * CAP + row]; const float* bb = bd + z * 1024 + col; float o[4]; for (int i = 0; i < 4; ++i) o[i] = v[i] + bb[i];
        st4bf(yp + (size_t)pair * D + col, o);
    } };

__global__ __launch_bounds__(256) void k_nattn(const bf16_t* __restrict__ Q, const bf16_t* __restrict__ Kb, const bf16_t* __restrict__ Vb, bf16_t* Y) {
    __shared__ float qs[4][192]; __shared__ float sc[4][NKEY];
    const int tid = threadIdx.x, blk = blockIdx.x, qg = blk & 511, h = (blk >> 9) & 7, b = blk >> 12;
    for (int idx = tid; idx < 4 * 192; idx += 256) { int qi = idx / 192, d = idx % 192; int row = b * SEQ + qg * 4 + qi; qs[qi][d] = bf2f(Q[(size_t)row * 1536 + h * 192 + d]); }
    __syncthreads();
    float n1 = 0.f, n2 = 0.f;
    if (tid < 128) { int qi = tid >> 5, i = tid & 31; int t = qg * 4 + qi; float cs, sn; rope_cs(t, i, cs, sn); float x1 = qs[qi][128 + i], x2 = qs[qi][160 + i]; n1 = x1 * cs - x2 * sn; n2 = x1 * sn + x2 * cs; }
    __syncthreads();
    if (tid < 128) { int qi = tid >> 5, i = tid & 31; qs[qi][128 + i] = n1; qs[qi][160 + i] = n2; }
    __syncthreads();
    const bf16_t* Kp = Kb + (size_t)(b * 8 + h) * NKEY * 192; const bf16_t* Vp = Vb + (size_t)(b * 8 + h) * NKEY * 128;
    const float scale = 0.07216878364870322f;
    for (int key = tid; key < NKEY; key += 256) {
        const bf16_t* kr = Kp + (size_t)key * 192; float s0 = 0.f, s1 = 0.f, s2 = 0.f, s3 = 0.f;
        for (int d = 0; d < 192; d += 8) { uint4 u = *(const uint4*)(kr + d); const bf16_t* up = (const bf16_t*)&u;
            for (int j = 0; j < 8; ++j) { float kv = bf2f(up[j]); s0 += qs[0][d + j] * kv; s1 += qs[1][d + j] * kv; s2 += qs[2][d + j] * kv; s3 += qs[3][d + j] * kv; } }
        sc[0][key] = s0 * scale; sc[1][key] = s1 * scale; sc[2][key] = s2 * scale; sc[3][key] = s3 * scale;
    }
    __syncthreads();
    { int w = tid >> 6, lane = tid & 63; float m = -1e30f; for (int k = lane; k < NKEY; k += 64) m = fmaxf(m, sc[w][k]);
      for (int o = 32; o > 0; o >>= 1) m = fmaxf(m, __shfl_xor(m, o));
      float s = 0.f; for (int k = lane; k < NKEY; k += 64) { float e = __expf(sc[w][k] - m); sc[w][k] = e; s += e; }
      for (int o = 32; o > 0; o >>= 1) s += __shfl_xor(s, o);
      float inv = 1.0f / s; for (int k = lane; k < NKEY; k += 64) sc[w][k] *= inv; }
    __syncthreads();
    { int dv = tid & 127, qh = tid >> 7; float o0 = 0.f, o1 = 0.f;
      for (int k = 0; k < NKEY; ++k) { float v = bf2f(Vp[(size_t)k * 128 + dv]); o0 += sc[qh * 2][k] * v; o1 += sc[qh * 2 + 1][k] * v; }
      int row = b * SEQ + qg * 4 + qh * 2; Y[(size_t)row * D + h * 128 + dv] = f2bf(o0); Y[(size_t)(row + 1) * D + h * 128 + dv] = f2bf(o1); }
}

__global__ __launch_bounds__(256) void k_nscan(const bf16_t* __restrict__ hq, const bf16_t* __restrict__ ff, const bf16_t* __restrict__ fb, const bf16_t* __restrict__ iv, const float* __restrict__ lb, bf16_t* of, bf16_t* ob) {
    __shared__ float sf[128], sk[128], sq[128], so[2][128];
    const int tid = threadIdx.x, blk = blockIdx.x, dir = blk & 1, h = (blk >> 1) & 7, b = blk >> 4;
    const bf16_t* fz = dir ? fb : ff; bf16_t* out = dir ? ob : of;
    const int dv = tid & 127, half = tid >> 7;
    float S[64];
#pragma unroll
    for (int j = 0; j < 64; ++j) S[j] = 0.f;
    const float lbv = lb[dir * 1024 + h * 128 + (tid & 127)];
    for (int step = 0; step < NKEY; ++step) {
        int row; bool islat;
        if (step < CTXL) { int s = dir ? (CTXL - 1 - step) : step; row = L + b * CTXL + s; islat = false; }
        else { int t = step - CTXL; t = dir ? (SEQ - 1 - t) : t; row = b * SEQ + t; islat = true; }
        if (tid < 128) { float z = bf2f(fz[(size_t)row * D + h * 128 + tid]); float f = lbv + (1.0f - lbv) * sigmoidf_(z); sf[tid] = f; sk[tid] = 1.0f - f;
            if (islat) { float zq = bf2f(hq[(size_t)row * D + h * 128 + tid]); sq[tid] = siluf_(zq) * 0.08838834764831845f; } }
        float v = bf2f(iv[(size_t)row * D + h * 128 + dv]);
        __syncthreads();
        float o = 0.f;
#pragma unroll
        for (int j = 0; j < 64; ++j) { int dk = half * 64 + j; S[j] = sf[dk] * S[j] + sk[dk] * v; o += S[j] * sq[dk]; }
        if (islat) so[half][dv] = o;
        __syncthreads();
        if (islat && half == 0) out[(size_t)row * D + h * 128 + dv] = f2bf(so[0][dv] + so[1][dv]);
    }
}

__global__ __launch_bounds__(256) void k_merge(bf16_t* y, const bf16_t* __restrict__ of, const bf16_t* __restrict__ ob, const bf16_t* __restrict__ og, const bf16_t* __restrict__ gm, const bf16_t* __restrict__ gh, const float* __restrict__ ghg) {
    int row = blockIdx.x, c = threadIdx.x * 4; size_t off = (size_t)row * D + c;
    ushort4 a = *(const ushort4*)(of + off), bb = *(const ushort4*)(ob + off), g1 = *(const ushort4*)(og + off), g2 = *(const ushort4*)(gm + off), g3 = *(const ushort4*)(gh + off), ym = *(const ushort4*)(y + off);
    const bf16_t *ap = (const bf16_t*)&a, *bp = (const bf16_t*)&bb, *p1 = (const bf16_t*)&g1, *p2 = (const bf16_t*)&g2, *p3 = (const bf16_t*)&g3, *pm = (const bf16_t*)&ym;
    float o[4], ss = 0.f; for (int i = 0; i < 4; ++i) { o[i] = bf2f(ap[i]) + bf2f(bp[i]); ss += o[i] * o[i]; }
    for (int m = 16; m > 0; m >>= 1) ss += __shfl_xor(ss, m);
    float rs = rsqrtf(ss * (1.0f / 128.0f) + EPS); float r[4];
    for (int i = 0; i < 4; ++i) { float yh = o[i] * rs * ghg[(c + i) & 127] * siluf_(bf2f(p1[i])); r[i] = sigmoidf_(bf2f(p2[i])) * bf2f(pm[i]) + sigmoidf_(bf2f(p3[i])) * yh; }
    st4bf(y + off, r);
}

__global__ __launch_bounds__(256) void k_norm2_router(const float* __restrict__ x1, const float* __restrict__ g, const float* __restrict__ modv, const float* __restrict__ wr, const float* __restrict__ br, bf16_t* h2, int* topi, float* topp, int* cnt, int* list) {
    __shared__ float red[4]; __shared__ float hs[1024]; __shared__ float part[8][32];
    int row = blockIdx.x, tid = threadIdx.x, c = tid * 4; const float* mod = modv + (row / SEQ) * 6144;
    float4 v = *(const float4*)(x1 + (size_t)row * D + c);
    float ss = block_sum256(v.x * v.x + v.y * v.y + v.z * v.z + v.w * v.w, red); float rs = rsqrtf(ss * (1.0f / D) + EPS);
    float xv[4] = {v.x, v.y, v.z, v.w}, o[4];
    for (int i = 0; i < 4; ++i) { o[i] = xv[i] * rs * g[c + i] * (1.0f + mod[4 * 1024 + c + i]) + mod[3 * 1024 + c + i]; hs[c + i] = o[i]; }
    st4bf(h2 + (size_t)row * D + c, o);
    __syncthreads();
    { int e = tid & 31, p = tid >> 5; float a = 0.f; for (int j = p * 128; j < p * 128 + 128; ++j) a += hs[j] * wr[j * 32 + e]; part[p][e] = a; }
    __syncthreads();
    if (tid < 64) {
        int e = tid & 31; float cur = br[e];
#pragma unroll
        for (int p = 0; p < 8; ++p) cur += part[p][e];
        float tv0 = 0.f, sum = 0.f; float myp = 0.f; int myk = -1;
        int sel_i[4]; float sel_e[4];
#pragma unroll
        for (int k = 0; k < 4; ++k) {
            float m = cur; int mi = e;
#pragma unroll
            for (int o = 16; o > 0; o >>= 1) { float om = __shfl_xor(m, o); int oi = __shfl_xor(mi, o); if (om > m || (om == m && oi < mi)) { m = om; mi = oi; } }
            if (k == 0) tv0 = m;
            sel_i[k] = mi; sel_e[k] = __expf(m - tv0); sum += sel_e[k];
            if (e == mi) cur = -3.0e38f;
        }
#pragma unroll
        for (int k = 0; k < 4; ++k) if (tid == k) { myk = sel_i[k]; myp = sel_e[k] / sum; }
        if (tid < 4) { int pair = row * 4 + tid; topi[pair] = myk; topp[pair] = myp; int pos = atomicAdd(&cnt[myk], 1); list[myk * CAP + pos] = pair; }
    }
}

__global__ void k_moe_offs(const int* cnt, int* offs, int* tilee) {
    if (threadIdx.x == 0 && blockIdx.x == 0) { int o = 0, t = 0; for (int e = 0; e < NE; ++e) { offs[e] = o; int nt = (cnt[e] + 255) >> 8; for (int i = 0; i < nt; ++i) tilee[t++] = e; o += nt * 256; } offs[NE] = o; offs[NE + 1] = t; }
}

__global__ __launch_bounds__(256) void k_final(float* out, const bf16_t* __restrict__ yp, const float* __restrict__ topp, const float* __restrict__ modv, const float* __restrict__ fg) {
    __shared__ float red[4];
    int row = blockIdx.x, c = threadIdx.x * 4; const float* gate = modv + (row / SEQ) * 6144 + 5 * 1024;
    float4 v = *(const float4*)(out + (size_t)row * D + c); float xv[4] = {v.x, v.y, v.z, v.w}; float m[4] = {0.f, 0.f, 0.f, 0.f};
    for (int k = 0; k < 4; ++k) { float p = topp[row * 4 + k]; ushort4 u = *(const ushort4*)(yp + (size_t)(row * 4 + k) * D + c); const bf16_t* up = (const bf16_t*)&u; for (int i = 0; i < 4; ++i) m[i] += p * bf2f(up[i]); }
    float ss = 0.f; for (int i = 0; i < 4; ++i) { xv[i] += gate[c + i] * m[i]; ss += xv[i] * xv[i]; }
    ss = block_sum256(ss, red); float rs = rsqrtf(ss * (1.0f / D) + EPS);
    float4 o; o.x = xv[0] * rs * fg[c]; o.y = xv[1] * rs * fg[c + 1]; o.z = xv[2] * rs * fg[c + 2]; o.w = xv[3] * rs * fg[c + 3];
    *(float4*)(out + (size_t)row * D + c) = o;
}

#define LAS __attribute__((address_space(3)))
__device__ __forceinline__ int otid() { int t = threadIdx.x; asm volatile("" : "+v"(t)); return t; }
typedef short bf16x8 __attribute__((ext_vector_type(8)));
typedef float f32x4 __attribute__((ext_vector_type(4)));
typedef unsigned u32x4 __attribute__((ext_vector_type(4)));
typedef unsigned u32x2 __attribute__((ext_vector_type(2)));
typedef float f32x2 __attribute__((ext_vector_type(2)));

constexpr size_t OFF_ROPE = 7 * MiB;
constexpr size_t OFF_WT_IN = 8 * MiB;
constexpr size_t OFF_WT_QB = 25 * MiB;
constexpr size_t OFF_WT_KVB = 28 * MiB;
constexpr size_t OFF_WT_OUT = 29 * MiB;
constexpr size_t OFF_WT_GU = 104 * MiB;
constexpr size_t OFF_WT_DN = 232 * MiB;
constexpr size_t OFF_YF8 = 775 * MiB;
constexpr size_t OFF_X1 = 704 * MiB;

struct Params {
    const float *x, *c, *ctx, *cctx, *w_mod, *b_mod, *g_mix, *w_in, *g_q, *w_qb, *g_kv, *w_kvb, *lbl, *g_hg, *w_out, *g_ffn, *w_r, *b_r, *w_gu, *b_gu, *w_dn, *b_dn, *g_fin;
    float* out; char* ws;
};

typedef __bf16 bf16v2_t __attribute__((ext_vector_type(2)));
__device__ __forceinline__ unsigned cvt_pk_bf16(float lo, float hi) { bf16v2_t v = {(__bf16)lo, (__bf16)hi}; return __builtin_bit_cast(unsigned, v); }

__device__ __forceinline__ unsigned pack4_fp8(float a, float b, float c, float d) {
    a = __builtin_amdgcn_fmed3f(a, -448.f, 448.f); b = __builtin_amdgcn_fmed3f(b, -448.f, 448.f); c = __builtin_amdgcn_fmed3f(c, -448.f, 448.f); d = __builtin_amdgcn_fmed3f(d, -448.f, 448.f);
    unsigned w = 0; w = __builtin_amdgcn_cvt_pk_fp8_f32(a, b, w, false); w = __builtin_amdgcn_cvt_pk_fp8_f32(c, d, w, true); return w; }

namespace pg8 {
constexpr int BM = 256, BK = 64, HALF = 128, HTB = HALF * BK * 2, STAGE_BYTES = 8 * HTB, NXCD = 8, WGM = 8;
constexpr int LDS_IDX = STAGE_BYTES + 8192;
__device__ __forceinline__ int lds_byte(int r, int c) { const int st = (r >> 4) * 2 + (c >> 5), rr = r & 15, cc = c & 31, ob = rr * 64 + cc * 2; return st * 1024 + (ob ^ (((ob >> 9) & 1) << 5)); }
__device__ __forceinline__ void stage_rc(int b, int& R, int& C) { const int st = b / 1024, sb = b % 1024, swz = sb ^ (((sb >> 9) & 1) << 5); R = (st >> 1) * 16 + swz / 64; C = (st & 1) * 32 + (swz % 64) / 2; }
__device__ __forceinline__ int perm32(int rho) { const int n = rho >> 4, i = rho & 15; return 8 * (i >> 2) + 4 * n + (i & 3); }
struct Unit { int pm, pn; const char* b; int e, pos0, cnt; };

__device__ __forceinline__ int xcd_remap(int L, int nwg) { const int q = nwg / NXCD, r = nwg % NXCD, xcd = L % NXCD, off = L / NXCD; return (xcd < r ? xcd * (q + 1) : r * (q + 1) + (xcd - r) * q) + off; }

struct DenseSched {
    int nM, nN, nwg, G, c, rowb; const char* Bt; size_t btile;
    __device__ void init(int M, int N, int kbytes, int rowb_, const void* Bt_, int G_, int c_) { nM = M / BM; nN = N / BM; nwg = nM * nN; G = G_; c = c_; rowb = rowb_; Bt = (const char*)Bt_; btile = (size_t)BM * kbytes; }
    static constexpr bool GATHER_LDS = false;
    __device__ __forceinline__ int kstepA() const { return 128; }
    __device__ __forceinline__ void tile(int wgid, int& pm, int& pn) const { const int nig = WGM * nN, gid = wgid / nig, fm = gid * WGM, gsz = (nM - fm) < WGM ? (nM - fm) : WGM; pm = fm + ((wgid % nig) % gsz); pn = (wgid % nig) / gsz; }
    __device__ __forceinline__ bool next(int i, Unit& u) const { const int Lx = i * G + c; if (Lx >= nwg) return false; tile(xcd_remap(Lx, nwg), u.pm, u.pn); u.b = Bt + (size_t)u.pn * btile; u.e = 0; u.pos0 = 0; u.cnt = 0; return true; }
    __device__ __forceinline__ void aoff(const Unit& u, const int (&Rr)[2], const int (&Cc)[2], unsigned (&va)[2][2]) const {
#pragma unroll
        for (int h = 0; h < 2; ++h)
#pragma unroll
            for (int i = 0; i < 2; ++i) va[h][i] = (unsigned)((u.pm * BM + h * HALF + Rr[i]) * rowb + Cc[i] * 2); }
};
struct InSched : DenseSched {
    __device__ void init2(const void* Bt_, int G_, int c_) { init(L, 8448, 1024, 1024, Bt_, G_, c_); }
    __device__ __forceinline__ bool next(int i, Unit& u) const {
        const int Lx = i * G + c; const int nlat = nwg;
        if (Lx < nlat) { tile(xcd_remap(Lx, nlat), u.pm, u.pn); }
        else { const int j = Lx - nlat; if (j >= 16 * 14) return false; const int q = j >> 4; u.pm = 128 + (j & 15); u.pn = q == 0 ? 3 : (q <= 12 ? 7 + q : 32); }
        u.b = Bt + (size_t)u.pn * btile; u.e = 0; u.pos0 = 0; u.cnt = 0; return true; }
};
__device__ __forceinline__ unsigned act_piece_off(int r, int c16) { const int s = 2 * (r >> 7) + (c16 >> 2), w = 4 * ((r >> 6) & 1) + (c16 & 3), l = 16 * ((r >> 4) & 3) + (r & 15); return (unsigned)(((s * 8 + w) * 64 + l) * 16); }
template <bool GATHER> struct MoeSched {
    int nN, G, c, rowb; const char* Wt; size_t wexp, btile; const LAS int* tab; const int* list;
    static constexpr bool GATHER_LDS = GATHER;
    __device__ __forceinline__ int kstepA() const { return GATHER ? 128 : 32768; }
    __device__ __forceinline__ bool next(int i, Unit& u) const {
        const int nwg = tab[33] * nN; const int Lx = i * G + c; if (Lx >= nwg) return false;
        const int w = xcd_remap(Lx, nwg); const int rt = w / nN; u.pn = w % nN; u.pm = rt;
        const int e = tab[128 + rt];
        u.e = e; u.pos0 = (rt - tab[e]) * BM; u.cnt = tab[64 + e]; u.b = Wt + (size_t)e * wexp + (size_t)u.pn * btile; return true; }
    __device__ __forceinline__ void aoff(const Unit& u, const int (&Rr)[2], const int (&Cc)[2], unsigned (&va)[2][2]) const {
#pragma unroll
        for (int h = 0; h < 2; ++h)
#pragma unroll
            for (int i = 0; i < 2; ++i) {
                if (GATHER) { const int pos = u.pos0 + h * HALF + Rr[i]; const int pair = pos < u.cnt ? list[u.e * CAP + pos] : 0; va[h][i] = (unsigned)((pair >> 2) * rowb + Cc[i] * 2); }
                else va[h][i] = (unsigned)u.pm * 262144u + act_piece_off(h * HALF + Rr[i], Cc[i] >> 3); } }
};

typedef int v8i_t __attribute__((ext_vector_type(8)));
typedef int i32x4_t __attribute__((ext_vector_type(4)));
template <class Epi, class Sched, bool FP8 = false, int SCA = 127, int SCB = 127>
__device__ __forceinline__ void gemm_phase(LAS unsigned char* lds, const char* Abase, const int K, const Sched& S, const Epi& E) {
    const int tid = otid(), wid = __builtin_amdgcn_readfirstlane(tid >> 6), lane = tid & 63, wr = wid >> 2, wc = wid & 3, fr = lane & 15, fq = lane >> 4;
    const int Kb = FP8 ? K : 2 * K;
    const int nt = Kb / (BK * 2);
    int Rr[2], Cc[2]; unsigned voffB[2];
#pragma unroll
    for (int i = 0; i < 2; ++i) { int R_, C_; stage_rc(tid * 16 + i * 8192, R_, C_); Rr[i] = R_; Cc[i] = C_; const int Rb = 64 * (R_ >> 5) + (Epi::PERM ? perm32(R_ & 31) : (R_ & 31)); voffB[i] = (unsigned)(Rb * Kb + C_ * 2); }
    const size_t kstep = (size_t)(BK * 2);
    const size_t kstepA = (size_t)S.kstepA();
    const size_t hstep = (size_t)32 * Kb;
    const unsigned ldsw = (unsigned)wid * 1024u;
    const int aoff = lds_byte(wr * 64 + fr, fq * 8), boff = lds_byte(wc * 32 + fr, fq * 8);
#define PG8_SA(b, h) (((b) * 2 + (h)) * HTB)
#define PG8_SB(b, h) ((4 + (b) * 2 + (h)) * HTB)
#define PG8_STAGE_B(bufoff, gbase) do { _Pragma("unroll") for (int _i = 0; _i < 2; ++_i) \
        __builtin_amdgcn_global_load_lds((const unsigned*)((const char*)(gbase) + voffB[_i]), (LAS unsigned*)(lds + (bufoff) + ldsw + _i * 8192), 16, 0, 0); } while (0)
#define PG8_STAGE_A(bufoff, v0, v1, kb) do { \
        __builtin_amdgcn_global_load_lds((const unsigned*)(Abase + (kb) + (v0)), (LAS unsigned*)(lds + (bufoff) + ldsw), 16, 0, 0); \
        __builtin_amdgcn_global_load_lds((const unsigned*)(Abase + (kb) + (v1)), (LAS unsigned*)(lds + (bufoff) + ldsw + 8192), 16, 0, 0); } while (0)
#define PG8_LD16(addr) (*(const LAS i32x4_t*)(addr))
#define PG8_LDA(dst, b, h) do { _Pragma("unroll") for (int m = 0; m < 4; ++m) { if constexpr (FP8) dst##8[m] = __builtin_shufflevector(PG8_LD16(lds + PG8_SA(b, h) + aoff + m * 2048), PG8_LD16(lds + PG8_SA(b, h) + aoff + m * 2048 + 1024), 0, 1, 2, 3, 4, 5, 6, 7); \
        else { _Pragma("unroll") for (int k = 0; k < 2; ++k) dst[m][k] = *(const LAS bf16x8*)(lds + PG8_SA(b, h) + aoff + m * 2048 + k * 1024); } } } while (0)
#define PG8_LDB(dst, b, h) do { _Pragma("unroll") for (int n = 0; n < 2; ++n) { if constexpr (FP8) dst##8[n] = __builtin_shufflevector(PG8_LD16(lds + PG8_SB(b, h) + boff + n * 2048), PG8_LD16(lds + PG8_SB(b, h) + boff + n * 2048 + 1024), 0, 1, 2, 3, 4, 5, 6, 7); \
        else { _Pragma("unroll") for (int k = 0; k < 2; ++k) dst[n][k] = *(const LAS bf16x8*)(lds + PG8_SB(b, h) + boff + n * 2048 + k * 1024); } } } while (0)
#define PG8_MMA(ai, bj, At, Bt) do { __builtin_amdgcn_s_setprio(1); _Pragma("unroll") for (int m = 0; m < 4; ++m) _Pragma("unroll") for (int n = 0; n < 2; ++n) { \
        if constexpr (FP8) asm volatile("v_mfma_scale_f32_16x16x128_f8f6f4 %0, %1, %2, %0, %3, %4 op_sel_hi:[0,0,0]" : "+v"(acc[ai][bj][m][n]) : "v"(Bt##8[n]), "v"(At##8[m]), "v"(scb_), "v"(sca_)); \
        else { _Pragma("unroll") for (int k = 0; k < 2; ++k) acc[ai][bj][m][n] = __builtin_amdgcn_mfma_f32_16x16x32_bf16(Bt[n][k], At[m][k], acc[ai][bj][m][n], 0, 0, 0); } } \
        __builtin_amdgcn_s_setprio(0); } while (0)
#define PG8_WAIT_V(n) asm volatile("s_waitcnt vmcnt(" #n ")" ::: "memory")
#define PG8_WAIT_L(n) asm volatile("s_waitcnt lgkmcnt(" #n ")" ::: "memory")
#define PG8_BAR __builtin_amdgcn_s_barrier()
#define PG8_SCHED __builtin_amdgcn_sched_barrier(0)
    Unit cur, nxt; int ui = 0;
    if (!S.next(0, cur)) return;
    f32x4 acc[2][2][4][2];
#pragma unroll
    for (int a = 0; a < 2; ++a)
#pragma unroll
        for (int b = 0; b < 2; ++b)
#pragma unroll
            for (int m = 0; m < 4; ++m)
#pragma unroll
                for (int n = 0; n < 2; ++n) acc[a][b][m][n] = (f32x4){0.f, 0.f, 0.f, 0.f};
    const int sca_ = SCA, scb_ = SCB;
    bf16x8 At[4][2], B0[2][2], B1[2][2]; v8i_t At8[4], B08[2], B18[2];
    unsigned vc[2][2], vn[2][2];
    S.aoff(cur, Rr, Cc, vc);
    const char* cB = cur.b;
    PG8_STAGE_B(PG8_SB(0, 0), cB); PG8_STAGE_A(PG8_SA(0, 0), vc[0][0], vc[0][1], 0); PG8_STAGE_B(PG8_SB(0, 1), cB + hstep); PG8_STAGE_A(PG8_SA(0, 1), vc[1][0], vc[1][1], 0);
    if (wr == 1) PG8_BAR;
    PG8_WAIT_V(4); PG8_BAR;
    PG8_STAGE_B(PG8_SB(1, 0), cB + kstep); PG8_STAGE_A(PG8_SA(1, 0), vc[0][0], vc[0][1], kstepA); PG8_STAGE_B(PG8_SB(1, 1), cB + hstep + kstep);
    PG8_WAIT_V(6); PG8_BAR;
    for (;;) {
        const bool has_next = S.next(ui + 1, nxt);
        if constexpr (Sched::GATHER_LDS) {
            if (has_next && wid < 4) __builtin_amdgcn_global_load_lds((const unsigned*)(S.list + nxt.e * CAP + nxt.pos0 + tid), (LAS unsigned*)(lds + LDS_IDX + wid * 256), 4, 0, 0);
        } else if (has_next) S.aoff(nxt, Rr, Cc, vn);
        if (!has_next) {
#pragma unroll
            for (int h = 0; h < 2; ++h)
#pragma unroll
                for (int i = 0; i < 2; ++i) vn[h][i] = vc[h][i]; }
        const char* nB = has_next ? nxt.b : cB;
#pragma unroll 1
        for (int t = 0; t < nt; t += 2) {
            const bool last = (t == nt - 2);
            if constexpr (Sched::GATHER_LDS) { if (last && has_next) {
#pragma unroll
                for (int h = 0; h < 2; ++h)
#pragma unroll
                    for (int i = 0; i < 2; ++i) { const int rr = h * HALF + Rr[i]; const int pair = (nxt.pos0 + rr) < nxt.cnt ? ((const LAS int*)(lds + LDS_IDX))[rr] : 0; vn[h][i] = (unsigned)((pair >> 2) * S.rowb + Cc[i] * 2); } } }
            const size_t k1 = (size_t)(t + 1) * kstepA;
            const size_t k2 = last ? 0 : (size_t)(t + 2) * kstepA;
            const unsigned s00 = last ? vn[0][0] : vc[0][0], s01 = last ? vn[0][1] : vc[0][1], s10 = last ? vn[1][0] : vc[1][0], s11 = last ? vn[1][1] : vc[1][1];
            const char* b2 = last ? nB : cB + (size_t)(t + 2) * kstep; const char* b3 = b2 + kstep;
            PG8_LDB(B0, 0, 0); PG8_SCHED; PG8_LDA(At, 0, 0); PG8_STAGE_A(PG8_SA(1, 1), vc[1][0], vc[1][1], k1);
            PG8_WAIT_L(8); PG8_BAR; PG8_WAIT_L(0); PG8_MMA(0, 0, At, B0); PG8_BAR; PG8_SCHED;
            PG8_LDB(B1, 0, 1); PG8_STAGE_B(PG8_SB(0, 0), b2);
            PG8_BAR; PG8_WAIT_L(0); PG8_MMA(0, 1, At, B1); PG8_BAR; if constexpr (FP8) PG8_SCHED;
            PG8_LDA(At, 0, 1); PG8_STAGE_A(PG8_SA(0, 0), s00, s01, k2);
            PG8_BAR; PG8_WAIT_L(0); PG8_MMA(1, 0, At, B0); PG8_BAR; PG8_SCHED;
            PG8_STAGE_B(PG8_SB(0, 1), b2 + hstep);
            PG8_WAIT_V(6); PG8_BAR; PG8_MMA(1, 1, At, B1); PG8_BAR; if constexpr (FP8) PG8_SCHED;
            PG8_LDB(B0, 1, 0); PG8_SCHED; PG8_LDA(At, 1, 0); PG8_STAGE_A(PG8_SA(0, 1), s10, s11, k2);
            PG8_WAIT_L(8); PG8_BAR; PG8_WAIT_L(0); PG8_MMA(0, 0, At, B0); PG8_BAR; PG8_SCHED;
            PG8_LDB(B1, 1, 1); PG8_STAGE_B(PG8_SB(1, 0), b3);
            PG8_BAR; PG8_WAIT_L(0); PG8_MMA(0, 1, At, B1); PG8_BAR; if constexpr (FP8) PG8_SCHED;
            PG8_LDA(At, 1, 1); PG8_STAGE_A(PG8_SA(1, 0), s00, s01, k2 + kstepA);
            PG8_BAR; PG8_WAIT_L(0); PG8_MMA(1, 0, At, B0); PG8_BAR; PG8_SCHED;
            PG8_STAGE_B(PG8_SB(1, 1), b3 + hstep);
            PG8_WAIT_V(6); PG8_BAR; PG8_MMA(1, 1, At, B1); PG8_BAR; if constexpr (FP8) PG8_SCHED;
        }
        if constexpr (FP8) asm volatile("s_nop 15\n\ts_nop 15" ::: "memory");
        E(acc, cur, wr, wc, fr, fq);
        if (!has_next) break;
#pragma unroll
        for (int a = 0; a < 2; ++a)
#pragma unroll
            for (int b = 0; b < 2; ++b)
#pragma unroll
                for (int m = 0; m < 4; ++m)
#pragma unroll
                    for (int n = 0; n < 2; ++n) acc[a][b][m][n] = (f32x4){0.f, 0.f, 0.f, 0.f};
        cur = nxt; cB = nB; ++ui;
#pragma unroll
        for (int h = 0; h < 2; ++h)
#pragma unroll
            for (int i = 0; i < 2; ++i) vc[h][i] = vn[h][i];
    }
    PG8_WAIT_V(0);
    if (wr == 0) PG8_BAR;
    PG8_BAR;
#undef PG8_SA
#undef PG8_SB
#undef PG8_STAGE_A
#undef PG8_STAGE_B
#undef PG8_LDA
#undef PG8_LDB
#undef PG8_MMA
#undef PG8_WAIT_V
#undef PG8_WAIT_L
#undef PG8_BAR
#undef PG8_SCHED
}

typedef f32x4 Acc[2][2][4][2];
__device__ __forceinline__ unsigned dpp_ror8(unsigned x) { return (unsigned)__builtin_amdgcn_update_dpp(0, (int)x, 0x128, 0xf, 0xf, false); }
__device__ __forceinline__ u32x4 ror8_4(const u32x4 v) { u32x4 r; r.x = dpp_ror8(v.x); r.y = dpp_ror8(v.y); r.z = dpp_ror8(v.z); r.w = dpp_ror8(v.w); return r; }
__device__ __forceinline__ void line_xy(const u32x4 a, const u32x4 b, bool lo, u32x4& X, u32x4& Y) { const u32x4 ra = ror8_4(a), rb = ror8_4(b); X = lo ? a : rb; Y = lo ? ra : b; }
__device__ __forceinline__ u32x4 pack8(const f32x4 v0, const f32x4 v1) { u32x4 w; w.x = cvt_pk_bf16(v0[0], v0[1]); w.y = cvt_pk_bf16(v0[2], v0[3]); w.z = cvt_pk_bf16(v1[0], v1[1]); w.w = cvt_pk_bf16(v1[2], v1[3]); return w; }

struct EpiIn { static constexpr bool PERM = true; char* ws;
    __device__ __forceinline__ void operator()(const Acc& acc, const Unit& u, int wr, int wc, int fr, int fq) const {
        const int pn = u.pn; size_t boff; int ld, cb;
        if (pn < 3) { boff = OFF_QA; ld = 384; cb = pn * 128; } else if (pn == 3) { boff = OFF_CKV; ld = 256; cb = 0; }
        else if (pn < 32) { boff = OFF_HQ + (size_t)((pn - 4) >> 2) * SEG_STRIDE; ld = 1024; cb = ((pn - 4) & 3) * 256; }
        else { boff = OFF_KR; ld = 64; cb = 0; }
        bf16_t* base = (bf16_t*)(ws + boff);
        if (pn == 32 && wc != 0) return;
        const bool lo = fr < 8; const int rowb0 = u.pm * BM + wr * 64, rx = fr & 7, colx = cb + wc * 64 + (fr >> 3) * 32 + 8 * fq;
        float* ssq = (float*)(ws + (pn < 3 ? OFF_SSQQ : OFF_SSQKV));
#pragma unroll
        for (int ai = 0; ai < 2; ++ai)
#pragma unroll
            for (int m = 0; m < 4; ++m) { const int rg = rowb0 + ai * HALF + m * 16;
                f32x4 v0 = acc[ai][0][m][0], v1 = acc[ai][0][m][1], w0 = acc[ai][1][m][0], w1 = acc[ai][1][m][1];
                if (pn >= 4 && pn < 8) {
#pragma unroll
                    for (int j = 0; j < 4; ++j) { v0[j] = siluf_(v0[j]) * 0.08838834764831845f; v1[j] = siluf_(v1[j]) * 0.08838834764831845f; w0[j] = siluf_(w0[j]) * 0.08838834764831845f; w1[j] = siluf_(w1[j]) * 0.08838834764831845f; } }
                if (pn < 3) { unsigned char* qrow = (unsigned char*)base + (size_t)(rg + fr) * 768 + pn * 256 + wc * 64 + 8 * fq;
                    u32x2 a8; a8.x = pack4_fp8(v0[0], v0[1], v0[2], v0[3]); a8.y = pack4_fp8(v1[0], v1[1], v1[2], v1[3]); u32x2 b8; b8.x = pack4_fp8(w0[0], w0[1], w0[2], w0[3]); b8.y = pack4_fp8(w1[0], w1[1], w1[2], w1[3]);
                    *(u32x2*)qrow = a8; *(u32x2*)(qrow + 32) = b8; }
                else { u32x4 X, Y; line_xy(pack8(v0, v1), pack8(w0, w1), lo, X, Y);
                    __builtin_nontemporal_store(X, (u32x4*)(base + (size_t)(rg + rx) * ld + colx)); __builtin_nontemporal_store(Y, (u32x4*)(base + (size_t)(rg + 8 + rx) * ld + colx)); }
                if (pn <= 3) { float ss = (v0[0] * v0[0] + v0[1] * v0[1]) + (v0[2] * v0[2] + v0[3] * v0[3]) + (v1[0] * v1[0] + v1[1] * v1[1]) + (v1[2] * v1[2] + v1[3] * v1[3])
                                        + (w0[0] * w0[0] + w0[1] * w0[1]) + (w0[2] * w0[2] + w0[3] * w0[3]) + (w1[0] * w1[0] + w1[1] * w1[1]) + (w1[2] * w1[2] + w1[3] * w1[3]);
                    ss += __shfl_xor(ss, 16); ss += __shfl_xor(ss, 32); if (fq == 0) atomicAdd(ssq + rg + fr, ss); } }
    } };

struct EpiQ { static constexpr bool PERM = true; bf16_t* q; const float* ssq;
    __device__ __forceinline__ void operator()(const Acc& acc, const Unit& u, int wr, int wc, int fr, int fq) const {
        const bool lo = fr < 8; const int rowb0 = u.pm * BM + wr * 64, rx = fr & 7, colx = u.pn * BM + wc * 64 + (fr >> 3) * 32 + 8 * fq;
#pragma unroll
        for (int ai = 0; ai < 2; ++ai)
#pragma unroll
            for (int m = 0; m < 4; ++m) { const int rg = rowb0 + ai * HALF + m * 16; const float rs = rsqrtf(ssq[rg + fr] * (1.0f / 768.0f) + EPS);
                u32x4 X, Y; line_xy(pack8(acc[ai][0][m][0] * rs, acc[ai][0][m][1] * rs), pack8(acc[ai][1][m][0] * rs, acc[ai][1][m][1] * rs), lo, X, Y);
                *(u32x4*)(q + (size_t)(rg + rx) * 1536 + colx) = X; *(u32x4*)(q + (size_t)(rg + 8 + rx) * 1536 + colx) = Y; }
    } };

struct EpiKV { static constexpr bool PERM = true; bf16_t *Kb, *Vb; const float* ssq;
    __device__ __forceinline__ size_t kvrow(int row, int h) const { int b, pos; if (row < L) { b = row >> 11; pos = row & 2047; } else { b = (row - L) >> 8; pos = SEQ + ((row - L) & 255); } return (size_t)(b * 8 + h) * NKEY + pos; }
    __device__ __forceinline__ void operator()(const Acc& acc, const Unit& u, int wr, int wc, int fr, int fq) const {
        const bool lo = fr < 8; const int rowb0 = u.pm * BM + wr * 64, rx = fr & 7, colx = (wc & 1) * 64 + (fr >> 3) * 32 + 8 * fq;
        bf16_t* dst = wc < 2 ? Kb : Vb; const int ld = wc < 2 ? 192 : 128;
#pragma unroll
        for (int ai = 0; ai < 2; ++ai)
#pragma unroll
            for (int m = 0; m < 4; ++m) { const int rg = rowb0 + ai * HALF + m * 16; const float rs = rsqrtf(ssq[rg + fr] * (1.0f / 256.0f) + EPS);
                u32x4 X, Y; line_xy(pack8(acc[ai][0][m][0] * rs, acc[ai][0][m][1] * rs), pack8(acc[ai][1][m][0] * rs, acc[ai][1][m][1] * rs), lo, X, Y);
                *(u32x4*)(dst + kvrow(rg + rx, u.pn) * ld + colx) = X; *(u32x4*)(dst + kvrow(rg + 8 + rx, u.pn) * ld + colx) = Y; }
    } };

struct EpiOut { static constexpr bool PERM = true; bf16_t* x1; const float* x; const float* modv;
    __device__ __forceinline__ void operator()(const Acc& acc, const Unit& u, int wr, int wc, int fr, int fq) const {
        const bool lo = fr < 8; const int rowb0 = u.pm * BM + wr * 64, rx = fr & 7, colx = u.pn * BM + wc * 64 + (fr >> 3) * 32 + 8 * fq, cown = u.pn * BM + wc * 64 + 8 * fq;
#pragma unroll
        for (int ai = 0; ai < 2; ++ai)
#pragma unroll
            for (int m = 0; m < 4; ++m) { const int rg = rowb0 + ai * HALF + m * 16, row = rg + fr; const float* gate = modv + (row >> 11) * 6144 + 2 * 1024 + cown; const float* xr = x + (size_t)row * D + cown;
                f32x4 r[2][2];
#pragma unroll
                for (int bj = 0; bj < 2; ++bj)
#pragma unroll
                    for (int n = 0; n < 2; ++n) r[bj][n] = *(const f32x4*)(xr + bj * 32 + 4 * n) + *(const f32x4*)(gate + bj * 32 + 4 * n) * acc[ai][bj][m][n];
                u32x4 X, Y; line_xy(pack8(r[0][0], r[0][1]), pack8(r[1][0], r[1][1]), lo, X, Y);
                *(u32x4*)(x1 + (size_t)(rg + rx) * D + colx) = X; *(u32x4*)(x1 + (size_t)(rg + 8 + rx) * D + colx) = Y; }
    } };

struct EpiMoe1 { static constexpr bool PERM = true; unsigned char* act; const float* bgu;
    __device__ __forceinline__ void operator()(const Acc& acc, const Unit& u, int wr, int wc, int fr, int fq) const {
        const int o0 = u.pn * 128 + wc * 16 + 4 * fq;
        f32x4 bg[2], bl[2];
#pragma unroll
        for (int bj = 0; bj < 2; ++bj) { const float* bp = bgu + u.e * 2048 + 2 * (o0 + bj * 64); const f32x4 t0 = *(const f32x4*)bp, t1 = *(const f32x4*)(bp + 4);
            bg[bj] = (f32x4){t0[0], t0[2], t1[0], t1[2]}; bl[bj] = (f32x4){t0[1], t0[3], t1[1], t1[3]}; }
        unsigned char* blk = act + ((size_t)u.pm * 8 + u.pn) * 32768 + (size_t)(wr * 4 + wc) * 1024 + (size_t)(fq * 16 + fr) * 16;
#pragma unroll
        for (int ai = 0; ai < 2; ++ai)
#pragma unroll
            for (int bj = 0; bj < 2; ++bj) { unsigned d[4];
#pragma unroll
                for (int m = 0; m < 4; ++m) { const f32x4 g4 = acc[ai][bj][m][0] + bg[bj], l4 = acc[ai][bj][m][1] + bl[bj]; float r[4];
#pragma unroll
                    for (int j = 0; j < 4; ++j) { const float glu = fminf(g4[j], 7.0f), lin = __builtin_amdgcn_fmed3f(l4[j], -7.0f, 7.0f); r[j] = 4.0f * glu * __builtin_amdgcn_rcpf(1.0f + __builtin_amdgcn_exp2f(-2.4554669595930157f * glu)) * (lin + 1.0f); }
                    d[m] = pack4_fp8(r[0], r[1], r[2], r[3]); }
                const auto s01 = __builtin_amdgcn_permlane16_swap(d[0], d[1], false, false); const auto s23 = __builtin_amdgcn_permlane16_swap(d[2], d[3], false, false);
                const auto t02 = __builtin_amdgcn_permlane32_swap(s01[0], s23[0], false, false); const auto t13 = __builtin_amdgcn_permlane32_swap(s01[1], s23[1], false, false);
                *(u32x4*)(blk + (size_t)(ai * 2 + bj) * 8192) = (u32x4){t02[0], t13[0], t02[1], t13[1]}; }
    } };

struct EpiMoe2 { static constexpr bool PERM = true; bf16_t* yp; const float* bd;
    __device__ __forceinline__ void operator()(const Acc& acc, const Unit& u, int wr, int wc, int fr, int fq) const {
        const bool lo = fr < 8; const int rowb0 = u.pm * BM + wr * 64, rx = fr & 7, colx = u.pn * BM + wc * 64 + (fr >> 3) * 32 + 8 * fq, cown = u.pn * BM + wc * 64 + 8 * fq;
        f32x4 bv[2][2];
#pragma unroll
        for (int bj = 0; bj < 2; ++bj)
#pragma unroll
            for (int n = 0; n < 2; ++n) bv[bj][n] = *(const f32x4*)(bd + u.e * 1024 + cown + bj * 32 + 4 * n);
#pragma unroll
        for (int ai = 0; ai < 2; ++ai)
#pragma unroll
            for (int m = 0; m < 4; ++m) { const int rg = rowb0 + ai * HALF + m * 16;
                u32x4 X, Y; line_xy(pack8(acc[ai][0][m][0] + bv[0][0], acc[ai][0][m][1] + bv[0][1]), pack8(acc[ai][1][m][0] + bv[1][0], acc[ai][1][m][1] + bv[1][1]), lo, X, Y);
                __builtin_nontemporal_store(X, (u32x4*)(yp + (size_t)(rg + rx) * D + colx)); __builtin_nontemporal_store(Y, (u32x4*)(yp + (size_t)(rg + 8 + rx) * D + colx)); }
    } };
}

__device__ __forceinline__ int conv_src_col(int kind, int c) {
    if (kind == 0) return c;
    if (kind == 1) { if (c < 1024) return c; if (c < 8192) return c + 64; if (c < 8256) return c - 8192 + 1024; return -1; }
    const int pn = c >> 8, p = c & 255, wc = p >> 6, bj = (p >> 5) & 1, fq = (p >> 3) & 3, n = (p >> 2) & 1, i = p & 3; const int o = 128 * pn + 64 * bj + 16 * wc + 4 * fq + i; return 2 * o + n;
}
template <bool F8> struct ConvPipe {
    float v[32]; bool have; bf16_t* dummy;
    int K, kind, k0, c0; void* Wt;
    __device__ __forceinline__ void issue(const float* __restrict__ W, int ldw, void* Wt_, int K_, int kind_, const float* __restrict__ kscale, int k0_, int c0_) {
        const int tid = otid(); const int cc = tid & 127, kq = tid >> 7, sc = conv_src_col(kind_, c0_ + cc);
        const int scc = sc < 0 ? 0 : sc; const float* wp = W + (size_t)(k0_ + kq) * ldw + scc;
#pragma unroll
        for (int i = 0; i < 32; ++i) v[i] = __builtin_nontemporal_load(wp + (size_t)(4 * i) * ldw);
        if (sc < 0) {
#pragma unroll
            for (int i = 0; i < 32; ++i) v[i] = 0.f; }
        if (kscale) {
#pragma unroll
            for (int i = 0; i < 32; ++i) v[i] *= kscale[k0_ + kq + 4 * i]; }
        K = K_; kind = kind_; k0 = k0_; c0 = c0_; Wt = Wt_; have = true;
    }
    __device__ __forceinline__ void flush(LAS float* tl) {
        if (!have) return; have = false;
        const int tid = otid(); const int cc = tid & 127, kq = tid >> 7;
        __syncthreads();
#pragma unroll
        for (int i = 0; i < 32; ++i) tl[(kq + 4 * i) * 129 + cc] = v[i];
        __syncthreads();
        stash(tl, tid);
    }
    __device__ __forceinline__ void to_lds(LAS float* tl) { const int tid = otid(); const int cc = tid & 127, kq = tid >> 7; __syncthreads();
#pragma unroll
        for (int i = 0; i < 32; ++i) tl[(kq + 4 * i) * 129 + cc] = v[i];
        __syncthreads(); }
    __device__ __forceinline__ void stash(LAS float* tl, int tid) const {
        if constexpr (F8) {
#pragma unroll
            for (int pss = 0; pss < 2; ++pss) { const int item = tid + 512 * pss, c2 = item >> 3, ch = item & 7; float t[16];
#pragma unroll
                for (int j = 0; j < 16; ++j) t[j] = tl[(16 * ch + j) * 129 + c2] * 32.f;
                u32x4 w; w.x = pack4_fp8(t[0], t[1], t[2], t[3]); w.y = pack4_fp8(t[4], t[5], t[6], t[7]); w.z = pack4_fp8(t[8], t[9], t[10], t[11]); w.w = pack4_fp8(t[12], t[13], t[14], t[15]);
                *(u32x4*)((unsigned char*)Wt + (size_t)(c0 + c2) * K + k0 + 16 * ch) = w; }
        } else {
#pragma unroll
            for (int pss = 0; pss < 4; ++pss) { const int item = tid + 512 * pss, c2 = item >> 4, ch = item & 15; float t[8];
#pragma unroll
                for (int j = 0; j < 8; ++j) t[j] = tl[(8 * ch + j) * 129 + c2];
                u32x4 w; w.x = cvt_pk_bf16(t[0], t[1]); w.y = cvt_pk_bf16(t[2], t[3]); w.z = cvt_pk_bf16(t[4], t[5]); w.w = cvt_pk_bf16(t[6], t[7]);
                *(u32x4*)((bf16_t*)Wt + (size_t)(c0 + c2) * K + k0 + 8 * ch) = w; }
        }
    }
};
template <bool F8>
__device__ __forceinline__ void conv_matrix(LAS float* tl, ConvPipe<F8>& pipe, const float* W, int ldw, void* Wt, int K, int Nout, int kind, const float* kscale, int& tctr) {
    const int nk = K / 128, ntile = nk * (Nout / 128);
    int t = ((int)blockIdx.x - tctr) % (int)gridDim.x; if (t < 0) t += gridDim.x;
    for (; t < ntile; t += gridDim.x) {
        if (pipe.have) { pipe.to_lds(tl); const int K0 = pipe.K, k00 = pipe.k0, c00 = pipe.c0; void* W0 = pipe.Wt; ConvPipe<F8> done = pipe; (void)K0; (void)k00; (void)c00; (void)W0;
            pipe.issue(W, ldw, Wt, K, kind, kscale, (t % nk) * 128, (t / nk) * 128); done.stash(tl, otid()); }
        else pipe.issue(W, ldw, Wt, K, kind, kscale, (t % nk) * 128, (t / nk) * 128);
    }
    tctr = (tctr + ntile) % (int)gridDim.x;
}
template <bool F8> __device__ __forceinline__ void conv_finish(LAS float* tl, ConvPipe<F8>& pipe) { if (pipe.have) { pipe.to_lds(tl); pipe.stash(tl, otid()); pipe.have = false; } __syncthreads(); }

__device__ __forceinline__ float half_sum256(float v, LAS float* red) {
    for (int o = 32; o > 0; o >>= 1) v += __shfl_xor(v, o);
    const int w = otid() >> 6, hb = (otid() >> 8) * 4; if ((otid() & 63) == 0) red[w] = v; __syncthreads();
    const float t = red[hb] + red[hb + 1] + red[hb + 2] + red[hb + 3]; __syncthreads(); return t;
}

__device__ __forceinline__ void phase0(const Params& p, LAS unsigned char* lds) {
    char* ws = p.ws; const int tid = otid(), gsz = gridDim.x * 512, gid = blockIdx.x * 512 + tid;
    float* lb = (float*)(ws + OFF_LB); int* cnt = (int*)(ws + OFF_CNT); float* ssqq = (float*)(ws + OFF_SSQQ); float* ssqkv = (float*)(ws + OFF_SSQKV); float* modv = (float*)(ws + OFF_MOD);
    for (int i = gid; i < 2048; i += gsz) { const int d = i >> 10, j = i & 1023; const float a = p.lbl[(d * 2 + 0) * 1024 + j], b = p.lbl[(d * 2 + 1) * 1024 + j]; lb[i] = 1.0f / (1.0f + __expf(b - a)); }
    for (int i = gid; i < 32; i += gsz) cnt[i] = 0;
    { float* ropet = (float*)(ws + OFF_ROPE); for (int i = gid; i < SEQ * 32; i += gsz) { const int t = i >> 5, j = i & 31; float cs, sn; rope_cs(t, j, cs, sn); ropet[t * 64 + j] = cs; ropet[t * 64 + 32 + j] = sn; } }
    for (int i = gid; i < L; i += gsz) ssqq[i] = 0.f;
    for (int i = gid; i < R; i += gsz) ssqkv[i] = 0.f;
    { LAS float* sil = (LAS float*)lds;
      LAS float* part = (LAS float*)(lds + 17 * 1024 * 4);
      bool loaded = false;
      for (int item = blockIdx.x; item < 96; item += gridDim.x) {
          if (!loaded) { for (int i = tid; i < 17 * 1024; i += 512) { const int r = i >> 10, k = i & 1023; sil[i] = siluf_(r < 16 ? p.c[r * 1024 + k] : p.cctx[k]); } loaded = true; __syncthreads(); }
          const int j = tid & 63, ks = tid >> 6; float a[17];
#pragma unroll
          for (int r = 0; r < 17; ++r) a[r] = 0.f;
          for (int k = ks * 128; k < ks * 128 + 128; ++k) { const float w = p.w_mod[(size_t)k * 6144 + item * 64 + j];
#pragma unroll
              for (int r = 0; r < 17; ++r) a[r] += sil[r * 1024 + k] * w; }
#pragma unroll
          for (int r = 0; r < 17; ++r) part[(ks * 17 + r) * 64 + j] = a[r];
          __syncthreads();
          for (int i = tid; i < 17 * 64; i += 512) { const int r = i >> 6, jj = i & 63; float s = p.b_mod[item * 64 + jj]; for (int q = 0; q < 8; ++q) s += part[(q * 17 + r) * 64 + jj]; modv[r * 6144 + item * 64 + jj] = s; }
          __syncthreads();
      } }
    __syncthreads();
    { LAS float* tl = (LAS float*)lds; int tctr = 0;
      { ConvPipe<true> pp; pp.have = false; conv_matrix<true>(tl, pp, p.w_in, 8256, (unsigned char*)(ws + OFF_WT_IN), 1024, 8448, 1, nullptr, tctr); conv_finish<true>(tl, pp); }
      { ConvPipe<true> pp; pp.have = false;
        conv_matrix<true>(tl, pp, p.w_qb, 1536, (unsigned char*)(ws + OFF_WT_QB), 768, 1536, 0, p.g_q, tctr);
        conv_matrix<true>(tl, pp, p.w_out, 1024, (unsigned char*)(ws + OFF_WT_OUT), 1024, 1024, 0, nullptr, tctr); conv_finish<true>(tl, pp); }
      { ConvPipe<false> pp; pp.have = false;
        conv_matrix<false>(tl, pp, p.w_kvb, 2048, (bf16_t*)(ws + OFF_WT_KVB), 256, 2048, 0, p.g_kv, tctr); conv_finish<false>(tl, pp); } }
}

__device__ __forceinline__ float wave_sum(float v) {
#pragma unroll
    for (int o = 32; o > 0; o >>= 1) v += __shfl_xor(v, o);
    return v; }
__device__ __forceinline__ void phase1(const Params& p, LAS unsigned char* lds) {
    const float* modv = (const float*)(p.ws + OFF_MOD); unsigned char* h = (unsigned char*)(p.ws + OFF_H);
    const int tid = otid(), lane = tid & 63, gw = blockIdx.x * 8 + (tid >> 6), nw = gridDim.x * 8, c0 = lane * 8;
    f32x4 g[4];
#pragma unroll
    for (int q = 0; q < 4; ++q) g[q] = *(const f32x4*)(p.g_mix + (q >> 1) * 512 + c0 + (q & 1) * 4);
    for (int row0 = gw; row0 < R; row0 += 2 * nw) {
        f32x4 v[2][4]; const bool two = row0 + nw < R;
#pragma unroll
        for (int u = 0; u < 2; ++u) { const int row = (u == 0 || two) ? row0 + u * nw : row0; const float* src = row < L ? p.x + (size_t)row * D : p.ctx + (size_t)(row - L) * D;
#pragma unroll
            for (int q = 0; q < 4; ++q) v[u][q] = __builtin_nontemporal_load((const f32x4*)(src + (q >> 1) * 512 + c0 + (q & 1) * 4)); }
#pragma unroll
        for (int u = 0; u < 2; ++u) { if (u == 1 && !two) break; const int row = row0 + u * nw; const float* mod = modv + (row < L ? row / SEQ : 16) * 6144;
            float ss = 0.f;
#pragma unroll
            for (int q = 0; q < 4; ++q) ss += (v[u][q][0] * v[u][q][0] + v[u][q][1] * v[u][q][1]) + (v[u][q][2] * v[u][q][2] + v[u][q][3] * v[u][q][3]);
            const float rs = rsqrtf(wave_sum(ss) * (1.0f / D) + EPS);
#pragma unroll
            for (int j = 0; j < 2; ++j) { f32x4 o[2];
#pragma unroll
                for (int e = 0; e < 2; ++e) { const int cc = j * 512 + c0 + e * 4; const f32x4 sc = *(const f32x4*)(mod + 1024 + cc), sh = *(const f32x4*)(mod + cc); o[e] = v[u][j * 2 + e] * rs * g[j * 2 + e] * (sc + 1.0f) + sh; }
                u32x2 w; w.x = pack4_fp8(o[0][0], o[0][1], o[0][2], o[0][3]); w.y = pack4_fp8(o[1][0], o[1][1], o[1][2], o[1][3]);
                *(u32x2*)(h + (size_t)row * D + j * 512 + c0) = w; } }
    }
}

__device__ __forceinline__ SegOut make_seg(char* ws) { SegOut so; so.qa = (bf16_t*)(ws + OFF_QA); so.ckv = (bf16_t*)(ws + OFF_CKV); so.kr = (bf16_t*)(ws + OFF_KR); so.hq = (bf16_t*)(ws + OFF_HQ); so.ff = (bf16_t*)(ws + OFF_FF);
    so.fb = (bf16_t*)(ws + OFF_FB); so.iv = (bf16_t*)(ws + OFF_IV); so.og = (bf16_t*)(ws + OFF_OG); so.gm = (bf16_t*)(ws + OFF_GM); so.gh = (bf16_t*)(ws + OFF_GH); return so; }

__device__ __forceinline__ void phase2(const Params& p, LAS unsigned char* lds) {
    pg8::InSched S; S.init2(p.ws + OFF_WT_IN, gridDim.x, blockIdx.x);
    pg8::EpiIn E{p.ws};
    pg8::gemm_phase<pg8::EpiIn, pg8::InSched, true, 127, 122>(lds, (const char*)(p.ws + OFF_H), 1024, S, E);
}
__device__ __forceinline__ void phase3(const Params& p, LAS unsigned char* lds) {
    char* ws = p.ws;
    { pg8::DenseSched S; S.init(L, 1536, 768, 768, ws + OFF_WT_QB, gridDim.x, blockIdx.x); pg8::EpiQ E{(bf16_t*)(ws + OFF_Q), (const float*)(ws + OFF_SSQQ)}; pg8::gemm_phase<pg8::EpiQ, pg8::DenseSched, true, 127, 122>(lds, (const char*)(ws + OFF_QA), 768, S, E); }
    { pg8::DenseSched S; S.init(R, 2048, 256 * 2, 256 * 2, ws + OFF_WT_KVB, gridDim.x, blockIdx.x); pg8::EpiKV E{(bf16_t*)(ws + OFF_K), (bf16_t*)(ws + OFF_V), (const float*)(ws + OFF_SSQKV)}; pg8::gemm_phase(lds, (const char*)(ws + OFF_CKV), 256, S, E); }
    { const bf16_t* kr = (const bf16_t*)(ws + OFF_KR); bf16_t* Kb = (bf16_t*)(ws + OFF_K); const float* ropet = (const float*)(ws + OFF_ROPE);
      for (int gid = blockIdx.x * 512 + otid(); gid < R * 32; gid += gridDim.x * 512) { const int row = gid >> 5, i = gid & 31;
          const float x1 = bf2f(kr[(size_t)row * 64 + i]), x2 = bf2f(kr[(size_t)row * 64 + 32 + i]); float o1 = x1, o2 = x2; int b, pos;
          if (row < L) { b = row / SEQ; pos = row % SEQ; const float cs = ropet[pos * 64 + i], sn = ropet[pos * 64 + 32 + i]; o1 = x1 * cs - x2 * sn; o2 = x1 * sn + x2 * cs; } else { b = (row - L) / CTXL; pos = SEQ + (row - L) % CTXL; }
          const bf16_t w1 = f2bf(o1), w2 = f2bf(o2);
          for (int h = 0; h < 8; ++h) { bf16_t* q = Kb + ((size_t)(b * 8 + h) * NKEY + pos) * 192 + 128; q[i] = w1; q[32 + i] = w2; } } }
}
__device__ __forceinline__ void unpack8(const u32x4 w, float (&o)[8]) {
    o[0] = __uint_as_float(w.x << 16); o[1] = __uint_as_float(w.x & 0xffff0000u); o[2] = __uint_as_float(w.y << 16); o[3] = __uint_as_float(w.y & 0xffff0000u);
    o[4] = __uint_as_float(w.z << 16); o[5] = __uint_as_float(w.z & 0xffff0000u); o[6] = __uint_as_float(w.w << 16); o[7] = __uint_as_float(w.w & 0xffff0000u); }
__device__ __forceinline__ void phase4(const Params& p, LAS unsigned char*) {
    char* ws = p.ws; bf16_t* y = (bf16_t*)(ws + OFF_H); const bf16_t* of = (const bf16_t*)(ws + OFF_OF); const bf16_t* ob = (const bf16_t*)(ws + OFF_OB);
    const bf16_t* og = (const bf16_t*)(ws + OFF_OG); const bf16_t* gm = (const bf16_t*)(ws + OFF_GM); const bf16_t* gh = (const bf16_t*)(ws + OFF_GH);
    const int tid = otid(), lane = tid & 63, gw = blockIdx.x * 8 + (tid >> 6), nw = gridDim.x * 8, c0 = lane * 8;
    float gg[8];
#pragma unroll
    for (int i = 0; i < 8; ++i) gg[i] = p.g_hg[(c0 + i) & 127];
    for (int row = gw; row < L; row += nw) {
        u32x4 ra[2], rb[2], r1[2], r2[2], r3[2], rm[2];
#pragma unroll
        for (int j = 0; j < 2; ++j) { const size_t off = (size_t)row * D + j * 512 + c0; ra[j] = __builtin_nontemporal_load((const u32x4*)(of + off)); rb[j] = __builtin_nontemporal_load((const u32x4*)(ob + off)); r1[j] = __builtin_nontemporal_load((const u32x4*)(og + off)); r2[j] = __builtin_nontemporal_load((const u32x4*)(gm + off)); r3[j] = __builtin_nontemporal_load((const u32x4*)(gh + off)); rm[j] = __builtin_nontemporal_load((const u32x4*)(y + off)); }
#pragma unroll
        for (int j = 0; j < 2; ++j) { float a[8], b[8], g1[8], g2[8], g3[8], ym[8], o[8]; unpack8(ra[j], a); unpack8(rb[j], b); unpack8(r1[j], g1); unpack8(r2[j], g2); unpack8(r3[j], g3); unpack8(rm[j], ym);
            float ss = 0.f;
#pragma unroll
            for (int i = 0; i < 8; ++i) { o[i] = a[i] + b[i]; ss += o[i] * o[i]; }
            ss += __shfl_xor(ss, 1); ss += __shfl_xor(ss, 2); ss += __shfl_xor(ss, 4); ss += __shfl_xor(ss, 8);
            const float rs = rsqrtf(ss * (1.0f / 128.0f) + EPS); float r[8];
#pragma unroll
            for (int i = 0; i < 8; ++i) { const float yh = o[i] * rs * gg[i] * siluf_(g1[i]); r[i] = sigmoidf_(g2[i]) * ym[i] + sigmoidf_(g3[i]) * yh; }
            u32x2 w; w.x = pack4_fp8(r[0], r[1], r[2], r[3]); w.y = pack4_fp8(r[4], r[5], r[6], r[7]);
            *(u32x2*)((unsigned char*)(ws + OFF_YF8) + (size_t)row * D + j * 512 + c0) = w; }
    }
}
__device__ __forceinline__ void phase5(const Params& p, LAS unsigned char* lds) {
    char* ws = p.ws;
    { pg8::DenseSched S; S.init(L, 1024, 1024, 1024, ws + OFF_WT_OUT, gridDim.x, blockIdx.x); pg8::EpiOut E{(bf16_t*)(ws + OFF_X1), p.x, (const float*)(ws + OFF_MOD)}; pg8::gemm_phase<pg8::EpiOut, pg8::DenseSched, true, 127, 122>(lds, (const char*)(ws + OFF_YF8), 1024, S, E); }
    { LAS float* tl = (LAS float*)lds; int tctr = 0; ConvPipe<true> pp; pp.have = false;
      for (int e = 0; e < NE; ++e) conv_matrix<true>(tl, pp, p.w_gu + (size_t)e * 1024 * 2048, 2048, (unsigned char*)(ws + OFF_WT_GU) + (size_t)e * 2048 * 1024, 1024, 2048, 2, nullptr, tctr);
      for (int e = 0; e < NE; ++e) conv_matrix<true>(tl, pp, p.w_dn + (size_t)e * 1024 * 1024, 1024, (unsigned char*)(ws + OFF_WT_DN) + (size_t)e * 1024 * 1024, 1024, 1024, 0, nullptr, tctr);
      conv_finish<true>(tl, pp); }
}
__device__ __forceinline__ void phase6(const Params& p, LAS unsigned char* lds) {
    char* ws = p.ws; const float* modv = (const float*)(ws + OFF_MOD); unsigned char* h2 = (unsigned char*)(ws + OFF_H); int* topi = (int*)(ws + OFF_TOPI); float* topp = (float*)(ws + OFF_TOPP); int* cnt = (int*)(ws + OFF_CNT); int* list = (int*)(ws + OFF_LIST); int* pairpos = (int*)(ws + OFF_ROWPAIR);
    LAS float* hs = (LAS float*)lds;
    LAS float* lg = (LAS float*)(lds + 131072);
    LAS int* lcnt = (LAS int*)(lds + 131072 + 4096);
    LAS int* lent = (LAS int*)(lds + 131072 + 4096 + 512);
    const int tid = otid(), lane = tid & 63, wid = tid >> 6, c0 = lane * 8;
    if (tid < 96) lcnt[tid] = 0;
    f32x4 g[4];
#pragma unroll
    for (int q = 0; q < 4; ++q) g[q] = *(const f32x4*)(p.g_ffn + (q >> 1) * 512 + c0 + (q & 1) * 4);
    __syncthreads();
    int it = 0;
    for (int tile = blockIdx.x; tile < L / 32; tile += gridDim.x, ++it) {
        const int rbase = tile * 32;
        f32x4 v[4][4];
#pragma unroll
        for (int u = 0; u < 4; ++u)
#pragma unroll
            for (int j = 0; j < 2; ++j) { float t8[8]; unpack8(*(const u32x4*)((const bf16_t*)(ws + OFF_X1) + (size_t)(rbase + wid * 4 + u) * D + j * 512 + c0), t8); v[u][2 * j] = (f32x4){t8[0], t8[1], t8[2], t8[3]}; v[u][2 * j + 1] = (f32x4){t8[4], t8[5], t8[6], t8[7]}; }
#pragma unroll
        for (int u = 0; u < 4; ++u) { const int rl = wid * 4 + u, row = rbase + rl; const float* mod = modv + (row / SEQ) * 6144; float ss = 0.f;
#pragma unroll
            for (int q = 0; q < 4; ++q) ss += (v[u][q][0] * v[u][q][0] + v[u][q][1] * v[u][q][1]) + (v[u][q][2] * v[u][q][2] + v[u][q][3] * v[u][q][3]);
            const float rs = rsqrtf(wave_sum(ss) * (1.0f / D) + EPS);
#pragma unroll
            for (int j = 0; j < 2; ++j) { f32x4 o[2];
#pragma unroll
                for (int e = 0; e < 2; ++e) { const int cc = j * 512 + c0 + e * 4; const f32x4 sc = *(const f32x4*)(mod + 4 * 1024 + cc), sh = *(const f32x4*)(mod + 3 * 1024 + cc); o[e] = v[u][j * 2 + e] * rs * g[j * 2 + e] * (sc + 1.0f) + sh;
                    *(LAS f32x4*)(hs + rl * 1024 + cc) = o[e]; }
                u32x2 w; w.x = pack4_fp8(o[0][0], o[0][1], o[0][2], o[0][3]); w.y = pack4_fp8(o[1][0], o[1][1], o[1][2], o[1][3]);
                *(u32x2*)(h2 + (size_t)row * D + j * 512 + c0) = w; } }
        __syncthreads();
        { const int e = tid & 31, rg = tid >> 5; const LAS float* h0 = hs + (2 * rg) * 1024; const LAS float* h1 = h0 + 1024; float a0 = 0.f, a1 = 0.f;
          for (int j = 0; j < 1024; j += 8) { float w[8];
#pragma unroll
              for (int q = 0; q < 8; ++q) w[q] = p.w_r[(j + q) * 32 + e];
              const f32x4 x0 = *(const LAS f32x4*)(h0 + j), x1 = *(const LAS f32x4*)(h0 + j + 4), y0 = *(const LAS f32x4*)(h1 + j), y1 = *(const LAS f32x4*)(h1 + j + 4);
              a0 += x0[0] * w[0]; a0 += x0[1] * w[1]; a0 += x0[2] * w[2]; a0 += x0[3] * w[3]; a0 += x1[0] * w[4]; a0 += x1[1] * w[5]; a0 += x1[2] * w[6]; a0 += x1[3] * w[7];
              a1 += y0[0] * w[0]; a1 += y0[1] * w[1]; a1 += y0[2] * w[2]; a1 += y0[3] * w[3]; a1 += y1[0] * w[4]; a1 += y1[1] * w[5]; a1 += y1[2] * w[6]; a1 += y1[3] * w[7]; }
          const float be = p.b_r[e]; lg[(2 * rg) * 32 + e] = a0 + be; lg[(2 * rg + 1) * 32 + e] = a1 + be; }
        __syncthreads();
#pragma unroll
        for (int rep = 0; rep < 2; ++rep) { const int rl = wid * 4 + rep * 2 + (lane >> 5), row = rbase + rl, e = lane & 31; float cur = lg[rl * 32 + e];
            float tv0 = 0.f, sum = 0.f; int sel_i[4]; float sel_e[4];
#pragma unroll
            for (int k = 0; k < 4; ++k) { float m = cur; int mi = e;
#pragma unroll
                for (int o2 = 16; o2 > 0; o2 >>= 1) { const float om = __shfl_xor(m, o2); const int oi = __shfl_xor(mi, o2); if (om > m || (om == m && oi < mi)) { m = om; mi = oi; } }
                if (k == 0) tv0 = m; sel_i[k] = mi; sel_e[k] = __expf(m - tv0); sum += sel_e[k]; if (e == mi) cur = -3.0e38f; }
            int myk = 0; float myp = 0.f;
#pragma unroll
            for (int k = 0; k < 4; ++k) if (e == k) { myk = sel_i[k]; myp = sel_e[k] / sum; }
            if (e < 4) { const int pair = row * 4 + e; topi[pair] = myk; topp[pair] = myp; __hip_atomic_fetch_add(&lcnt[myk], 1, __ATOMIC_RELAXED, __HIP_MEMORY_SCOPE_WORKGROUP); lent[(it * 32 + rl) * 4 + e] = myk; } }
        __syncthreads();
    }
    if (tid < 32) { const int n = lcnt[tid]; lcnt[32 + tid] = n > 0 ? atomicAdd(&cnt[tid], n) : 0; lcnt[64 + tid] = 0; }
    __syncthreads();
    const int nent = it * 128;
    for (int s = tid; s < nent; s += 512) { const int e = lent[s]; const int ii = s >> 7, rl = (s >> 2) & 31, k = s & 3; const int row = (blockIdx.x + ii * gridDim.x) * 32 + rl;
        const int pos = lcnt[32 + e] + __hip_atomic_fetch_add(&lcnt[64 + e], 1, __ATOMIC_RELAXED, __HIP_MEMORY_SCOPE_WORKGROUP); list[e * CAP + pos] = row * 4 + k; pairpos[row * 4 + k] = pos; }
}
__device__ __forceinline__ void moe_table(const int* cnt, LAS int* tab) {
    if (otid() == 0) { int t = 0; for (int e = 0; e < NE; ++e) { tab[e] = t; const int n = cnt[e]; tab[64 + e] = n; t += (n + 255) >> 8; } tab[32] = t; tab[33] = t; }
    __syncthreads();
    for (int rt = otid(); rt < tab[33]; rt += 512) { int e = 0; while (tab[e + 1] <= rt) ++e; tab[128 + rt] = e; }
    __syncthreads();
}
constexpr int LDS_TAB = pg8::STAGE_BYTES;
__device__ __forceinline__ void phase7(const Params& p, LAS unsigned char* lds) {
    char* ws = p.ws; LAS int* tab = (LAS int*)(lds + LDS_TAB); moe_table((const int*)(ws + OFF_CNT), tab);
    pg8::MoeSched<true> S; S.nN = 8; S.G = gridDim.x; S.c = blockIdx.x; S.rowb = 1024; S.Wt = ws + OFF_WT_GU; S.wexp = (size_t)2048 * 1024; S.btile = (size_t)256 * 1024; S.tab = tab; S.list = (const int*)(ws + OFF_LIST);
    pg8::EpiMoe1 E{(unsigned char*)(ws + OFF_ACT), p.b_gu};
    pg8::gemm_phase<pg8::EpiMoe1, pg8::MoeSched<true>, true, 127, 122>(lds, (const char*)(ws + OFF_H), 1024, S, E);
}
__device__ __forceinline__ void phase8(const Params& p, LAS unsigned char* lds) {
    char* ws = p.ws; LAS int* tab = (LAS int*)(lds + LDS_TAB); moe_table((const int*)(ws + OFF_CNT), tab);
    pg8::MoeSched<false> S; S.nN = 4; S.G = gridDim.x; S.c = blockIdx.x; S.rowb = 1024; S.Wt = ws + OFF_WT_DN; S.wexp = (size_t)1024 * 1024; S.btile = (size_t)256 * 1024; S.tab = tab; S.list = (const int*)(ws + OFF_LIST);
    pg8::EpiMoe2 E{(bf16_t*)(ws + OFF_YP), p.b_dn};
    pg8::gemm_phase<pg8::EpiMoe2, pg8::MoeSched<false>, true, 125, 122>(lds, (const char*)(ws + OFF_ACT), 1024, S, E);
}
__device__ __forceinline__ void phase9(const Params& p, LAS unsigned char* lds) {
    char* ws = p.ws; const float* modv = (const float*)(ws + OFF_MOD); const bf16_t* yp = (const bf16_t*)(ws + OFF_YP); const float* topp = (const float*)(ws + OFF_TOPP);
    const int* topi = (const int*)(ws + OFF_TOPI); const int* pairpos = (const int*)(ws + OFF_ROWPAIR);
    LAS int* tab = (LAS int*)lds; moe_table((const int*)(ws + OFF_CNT), tab);
    const int tid = otid(), lane = tid & 63, gw = blockIdx.x * 8 + (tid >> 6), nw = gridDim.x * 8, c0 = lane * 8;
    f32x4 fg[4];
#pragma unroll
    for (int q = 0; q < 4; ++q) fg[q] = *(const f32x4*)(p.g_fin + (q >> 1) * 512 + c0 + (q & 1) * 4);
    for (int row = gw; row < L; row += nw) {
        const float* gate = modv + (row / SEQ) * 6144 + 5 * 1024; f32x4 v[4]; u32x4 yr[4][2];
        const pg8::i32x4_t ek = *(const pg8::i32x4_t*)(topi + row * 4), pk4 = *(const pg8::i32x4_t*)(pairpos + row * 4);
#pragma unroll
        for (int j = 0; j < 2; ++j) { float t8[8]; unpack8(*(const u32x4*)((const bf16_t*)(ws + OFF_X1) + (size_t)row * D + j * 512 + c0), t8); v[2 * j] = (f32x4){t8[0], t8[1], t8[2], t8[3]}; v[2 * j + 1] = (f32x4){t8[4], t8[5], t8[6], t8[7]}; }
#pragma unroll
        for (int k = 0; k < 4; ++k) { const size_t yrow = (size_t)tab[ek[k]] * 256 + pk4[k];
#pragma unroll
            for (int j = 0; j < 2; ++j) yr[k][j] = __builtin_nontemporal_load((const u32x4*)(yp + yrow * D + j * 512 + c0)); }
        const f32x4 pk = *(const f32x4*)(topp + row * 4);
        float m[16];
#pragma unroll
        for (int i = 0; i < 16; ++i) m[i] = 0.f;
#pragma unroll
        for (int k = 0; k < 4; ++k)
#pragma unroll
            for (int j = 0; j < 2; ++j) { float t[8]; unpack8(yr[k][j], t);
#pragma unroll
                for (int i = 0; i < 8; ++i) m[j * 8 + i] += pk[k] * t[i]; }
        float ss = 0.f;
#pragma unroll
        for (int q = 0; q < 4; ++q) { const f32x4 gt = *(const f32x4*)(gate + (q >> 1) * 512 + c0 + (q & 1) * 4);
#pragma unroll
            for (int i = 0; i < 4; ++i) { v[q][i] += gt[i] * m[q * 4 + i]; ss += v[q][i] * v[q][i]; } }
        const float rs = rsqrtf(wave_sum(ss) * (1.0f / D) + EPS);
#pragma unroll
        for (int q = 0; q < 4; ++q) __builtin_nontemporal_store(v[q] * rs * fg[q], (f32x4*)(p.out + (size_t)row * D + (q >> 1) * 512 + c0 + (q & 1) * 4));
    }
}

namespace at {
using s16x4  = __attribute__((ext_vector_type(4))) short;
using f32x16 = __attribute__((ext_vector_type(16))) float;
constexpr int NW = 8, QBLK = 32, KVBLK = 64, DK = 192, DV = 128;
constexpr float SCALE = 0.07216878364870322f;
constexpr float THR = 8.f;
constexpr int SHM_V = KVBLK * DV * 2, SHM_K = KVBLK * DK * 2, SHM_ATTN = 2 * SHM_V + 2 * SHM_K + NW * 64 * 4;
#define KSWZ(row, colB) ((row) * 384 + ((colB) ^ (((row) & 7) << 4)))
#define SBAR() __builtin_amdgcn_sched_barrier(0)
__device__ __forceinline__ int crow(int r, int hi) { return (r & 3) + 8 * (r >> 2) + 4 * hi; }
__device__ __forceinline__ unsigned cvtpk(float lo, float hi) { return cvt_pk_bf16(lo, hi); }

__device__ __forceinline__ void partialSM(f32x16& p0, f32x16& p1, float& m_reg, float& mn, float& alpha) {
  constexpr float C = SCALE * 1.4426950408889634f;
  float pmax = p0[0];
#pragma unroll
  for (int r = 1; r < 16; ++r) pmax = fmaxf(pmax, p0[r]);
#pragma unroll
  for (int r = 0; r < 16; ++r) pmax = fmaxf(pmax, p1[r]);
  { auto rr = __builtin_amdgcn_permlane32_swap(__float_as_uint(pmax), __float_as_uint(pmax), false, false);
    pmax = fmaxf(__uint_as_float(rr[0]), __uint_as_float(rr[1])); }
  if (__builtin_expect(__all(pmax - m_reg <= THR / SCALE), 1)) { mn = m_reg; alpha = 1.f; }
  else { mn = fmaxf(m_reg, pmax); alpha = __builtin_amdgcn_exp2f((m_reg - mn) * C); m_reg = mn; }
  float mnC = -mn * C;
#pragma unroll
  for (int r = 0; r < 16; ++r) p0[r] = fmaf(p0[r], C, mnC);
#pragma unroll
  for (int r = 0; r < 16; ++r) p1[r] = fmaf(p1[r], C, mnC);
#pragma unroll
  for (int r = 0; r < 16; ++r) p0[r] = __builtin_amdgcn_exp2f(p0[r]);
}
__device__ __forceinline__ void finishSM(f32x16& p0, f32x16& p1, float alpha, float& l_reg, bf16x8& pa0, bf16x8& pa1, bf16x8& pa2, bf16x8& pa3) {
#pragma unroll
  for (int r = 0; r < 16; ++r) p1[r] = __builtin_amdgcn_exp2f(p1[r]);
  float ps = 0;
#pragma unroll
  for (int r = 0; r < 16; ++r) ps += p0[r];
#pragma unroll
  for (int r = 0; r < 16; ++r) ps += p1[r];
  { auto rr = __builtin_amdgcn_permlane32_swap(__float_as_uint(ps), __float_as_uint(ps), false, false);
    ps = __uint_as_float(rr[0]) + __uint_as_float(rr[1]); }
  l_reg = l_reg * alpha + ps;
#define PK4(P, BASE, OUT) do { unsigned a0 = cvtpk(P[BASE + 0], P[BASE + 1]), a1 = cvtpk(P[BASE + 2], P[BASE + 3]);   \
    unsigned b0 = cvtpk(P[BASE + 4], P[BASE + 5]), b1 = cvtpk(P[BASE + 6], P[BASE + 7]);                              \
    auto r0 = __builtin_amdgcn_permlane32_swap(a0, b0, false, false); auto r1 = __builtin_amdgcn_permlane32_swap(a1, b1, false, false); \
    u32x4 w = {r0[0], r1[0], r0[1], r1[1]}; OUT = *reinterpret_cast<bf16x8*>(&w); } while (0)
  PK4(p0, 0, pa0); PK4(p0, 8, pa1); PK4(p1, 0, pa2); PK4(p1, 8, pa3);
#undef PK4
}
__device__ __forceinline__ void qkt(f32x16& p0, f32x16& p1, const LAS char* Ks, const bf16x8 (&qr)[12], int r32, int hi) {
  p0 = f32x16{}; p1 = f32x16{};
#pragma unroll
  for (int d0 = 0; d0 < 12; ++d0) { const int cb = (d0 * 16 + hi * 8) * 2;
    const bf16x8 b0 = *reinterpret_cast<const LAS bf16x8*>(Ks + KSWZ(r32, cb));
    const bf16x8 b1 = *reinterpret_cast<const LAS bf16x8*>(Ks + KSWZ(32 + r32, cb));
    p0 = __builtin_amdgcn_mfma_f32_32x32x16_bf16(b0, qr[d0], p0, 0, 0, 0);
    p1 = __builtin_amdgcn_mfma_f32_32x32x16_bf16(b1, qr[d0], p1, 0, 0, 0); }
}
__device__ __forceinline__ int v_st(int k, int c) { const int kk = (k & ~0xC) | ((k & 4) << 1) | ((k & 8) >> 1); return ((kk >> 3) * 4 + (c >> 5)) * 512 + ((kk & 7) * 32 + (c & 31)) * 2; }
__device__ __forceinline__ int v_rd_base(int lane) { return ((lane & 3) << 3) | (((lane >> 2) & 3) << 6) | (((lane >> 4) & 1) << 5) | (((lane >> 5) & 1) << 8); }
constexpr int v_rd_off(int d0, int ks, int half) { return d0 * 512 + ks * 4096 + half * 2048; }
template <int OFF> __device__ __forceinline__ s16x4 tr_read(int vb) { s16x4 r; asm volatile("ds_read_b64_tr_b16 %0, %1 offset:%2" : "=&v"(r) : "v"(vb), "i"(OFF) : "memory"); return r; }
template <int D0> __device__ __forceinline__ void pv_one(f32x16& od, int vb, bf16x8 pa0, bf16x8 pa1, bf16x8 pa2, bf16x8 pa3) {
  const s16x4 l0 = tr_read<v_rd_off(D0, 0, 0)>(vb), h0 = tr_read<v_rd_off(D0, 0, 1)>(vb), l1 = tr_read<v_rd_off(D0, 1, 0)>(vb), h1 = tr_read<v_rd_off(D0, 1, 1)>(vb);
  const s16x4 l2 = tr_read<v_rd_off(D0, 2, 0)>(vb), h2 = tr_read<v_rd_off(D0, 2, 1)>(vb), l3 = tr_read<v_rd_off(D0, 3, 0)>(vb), h3 = tr_read<v_rd_off(D0, 3, 1)>(vb);
  asm volatile("s_waitcnt lgkmcnt(0)" ::: "memory"); SBAR();
#define PK(Lo, Hi) (bf16x8){Lo[0], Lo[1], Lo[2], Lo[3], Hi[0], Hi[1], Hi[2], Hi[3]}
  od = __builtin_amdgcn_mfma_f32_32x32x16_bf16(pa0, PK(l0, h0), od, 0, 0, 0);
  od = __builtin_amdgcn_mfma_f32_32x32x16_bf16(pa1, PK(l1, h1), od, 0, 0, 0);
  od = __builtin_amdgcn_mfma_f32_32x32x16_bf16(pa2, PK(l2, h2), od, 0, 0, 0);
  od = __builtin_amdgcn_mfma_f32_32x32x16_bf16(pa3, PK(l3, h3), od, 0, 0, 0);
#undef PK
}
__device__ __forceinline__ void pv_d0(f32x16 (&o)[4], int vb, bf16x8 pa0, bf16x8 pa1, bf16x8 pa2, bf16x8 pa3) {
  pv_one<0>(o[0], vb, pa0, pa1, pa2, pa3); pv_one<1>(o[1], vb, pa0, pa1, pa2, pa3); pv_one<2>(o[2], vb, pa0, pa1, pa2, pa3); pv_one<3>(o[3], vb, pa0, pa1, pa2, pa3);
}

__device__ __forceinline__ void attn_unit(const bf16_t* __restrict__ Qb, const bf16_t* __restrict__ Kh, const bf16_t* __restrict__ Vh, bf16_t* __restrict__ Ob, int t0, const float* __restrict__ ropet, LAS char* lds) {
  constexpr int LDQ = 1536, LDO = 1024, NT = NKEY / KVBLK;
  const int tid = otid(), wid = tid >> 6, lane = tid & 63, r32 = lane & 31, hi = lane >> 5;
  LAS char* V_lds = lds; LAS char* K_lds = lds + 2 * SHM_V;
  LAS float* wsl = (LAS float*)(lds + 2 * SHM_V + 2 * SHM_K) + wid * 64; LAS float* li_l = wsl; LAS float* al_l = wsl + 32;
  float m_reg = -1e30f, l_reg = 0; f32x16 o[4] = {}; bf16x8 qr[12];
  { const bf16_t* Qw = Qb + (size_t)(wid * QBLK + r32) * LDQ + hi * 8;
#pragma unroll
    for (int d0 = 0; d0 < 12; ++d0) qr[d0] = *reinterpret_cast<const bf16x8*>(Qw + d0 * 16);
    const float* rt = ropet + (size_t)(t0 + wid * QBLK + r32) * 64 + 8 * hi;
#pragma unroll
    for (int g = 0; g < 2; ++g) {
      const f32x4 c0 = *(const f32x4*)(rt + 16 * g), c1 = *(const f32x4*)(rt + 16 * g + 4), s0 = *(const f32x4*)(rt + 32 + 16 * g), s1 = *(const f32x4*)(rt + 32 + 16 * g + 4);
      float n1[8], n2[8];
#pragma unroll
      for (int j = 0; j < 8; ++j) { const float cs = j < 4 ? c0[j & 3] : c1[j & 3], sn = j < 4 ? s0[j & 3] : s1[j & 3];
        const float x1 = bf2f((bf16_t)qr[8 + g][j]), x2 = bf2f((bf16_t)qr[10 + g][j]); n1[j] = x1 * cs - x2 * sn; n2[j] = x1 * sn + x2 * cs; }
      u32x4 w1 = {cvtpk(n1[0], n1[1]), cvtpk(n1[2], n1[3]), cvtpk(n1[4], n1[5]), cvtpk(n1[6], n1[7])}; u32x4 w2 = {cvtpk(n2[0], n2[1]), cvtpk(n2[2], n2[3]), cvtpk(n2[4], n2[5]), cvtpk(n2[6], n2[7])};
      qr[8 + g] = *reinterpret_cast<bf16x8*>(&w1); qr[10 + g] = *reinterpret_cast<bf16x8*>(&w2); } }
  const int sr = tid >> 4, sc = (tid & 15) * 8, vst0 = v_st(sr, sc), vst1 = v_st(32 + sr, sc);
  int kgo[3], kst[3];
#pragma unroll
  for (int i = 0; i < 3; ++i) { const int c = tid + 512 * i, row = c / 24, c8 = (c % 24) * 8; kgo[i] = row * DK + c8; kst[i] = KSWZ(row, c8 * 2); }
  const int vb0 = (int)(uintptr_t)V_lds + v_rd_base(lane);
  bf16x8 sv0, sv1, sk0, sk1, sk2;
#define SLOAD(k0) do { sv0 = *reinterpret_cast<const bf16x8*>(&Vh[(size_t)((k0) + sr) * DV + sc]); sv1 = *reinterpret_cast<const bf16x8*>(&Vh[(size_t)((k0) + 32 + sr) * DV + sc]); \
    sk0 = *reinterpret_cast<const bf16x8*>(&Kh[(size_t)(k0) * DK + kgo[0]]); sk1 = *reinterpret_cast<const bf16x8*>(&Kh[(size_t)(k0) * DK + kgo[1]]); sk2 = *reinterpret_cast<const bf16x8*>(&Kh[(size_t)(k0) * DK + kgo[2]]); } while (0)
#define SWRITE(b) do { *(LAS bf16x8*)(V_lds + (b) * SHM_V + vst0) = sv0; *(LAS bf16x8*)(V_lds + (b) * SHM_V + vst1) = sv1; \
    *(LAS bf16x8*)(K_lds + (b) * SHM_K + kst[0]) = sk0; *(LAS bf16x8*)(K_lds + (b) * SHM_K + kst[1]) = sk1; *(LAS bf16x8*)(K_lds + (b) * SHM_K + kst[2]) = sk2; } while (0)
#define RESC(a) do { if (__any((a) < 1.f)) { if (hi == 0) al_l[r32] = (a); asm volatile("s_waitcnt lgkmcnt(0)" ::: "memory"); \
    _Pragma("unroll") for (int d = 0; d < 4; ++d) _Pragma("unroll") for (int r = 0; r < 16; ++r) o[d][r] *= al_l[crow(r, hi)]; } } while (0)
  f32x16 p0, p1; float mn, al; bf16x8 pa0, pa1, pa2, pa3;
  SLOAD(0); asm volatile("s_waitcnt vmcnt(0)" ::: "memory"); SWRITE(0); __syncthreads();
  for (int j = 0; j < NT; ++j) {
    const int bsel = j & 1;
    if (j + 1 < NT) SLOAD((j + 1) * KVBLK);
    SBAR(); qkt(p0, p1, K_lds + bsel * SHM_K, qr, r32, hi);
    partialSM(p0, p1, m_reg, mn, al);
    RESC(al);
    finishSM(p0, p1, al, l_reg, pa0, pa1, pa2, pa3); SBAR();
    pv_d0(o, vb0 + bsel * SHM_V, pa0, pa1, pa2, pa3);
    if (j + 1 < NT) { asm volatile("s_waitcnt vmcnt(0)" ::: "memory"); SWRITE(bsel ^ 1); }
    __syncthreads();
  }
  if (hi == 0) li_l[r32] = l_reg; asm volatile("s_waitcnt lgkmcnt(0)" ::: "memory");
  float rli[16];
#pragma unroll
  for (int r = 0; r < 16; ++r) rli[r] = __builtin_amdgcn_rcpf(li_l[crow(r, hi)]);
  { LAS bf16_t* ot = (LAS bf16_t*)(lds + wid * 8192);
#pragma unroll
    for (int r = 0; r < 16; ++r) { const int orow = crow(r, hi);
#pragma unroll
      for (int d0 = 0; d0 < 4; ++d0) ot[orow * 128 + d0 * 32 + r32] = f2bf(o[d0][r] * rli[r]); }
    asm volatile("s_waitcnt lgkmcnt(0)" ::: "memory");
    bf16_t* Ow = Ob + (size_t)(wid * QBLK) * LDO;
#pragma unroll
    for (int i = 0; i < 8; ++i) { const int q = lane + 64 * i, row = q >> 4, ch = q & 15; const u32x4 w = *(const LAS u32x4*)(ot + row * 128 + ch * 8); *(u32x4*)(Ow + (size_t)row * LDO + ch * 8) = w; } }
#undef SLOAD
#undef SWRITE
#undef RESC
}
}

__device__ __forceinline__ void phase_attn(const Params& p, LAS unsigned char* lds) {
    char* ws = p.ws; const bf16_t* Q = (const bf16_t*)(ws + OFF_Q); const bf16_t* Kb = (const bf16_t*)(ws + OFF_K); const bf16_t* Vb = (const bf16_t*)(ws + OFF_V); bf16_t* Y = (bf16_t*)(ws + OFF_H);
    const int G = gridDim.x;
    for (int it = 0;; ++it) {
        int u;
        if (G == 256) { const int c = blockIdx.x, xcd = c & 7, j = c >> 3; if (it >= 4) break; u = ((it * 32 + xcd * 4 + (j >> 3)) << 3) | (j & 7); }
        else { u = it * G + blockIdx.x; if (u >= 1024) break; }
        const int bh = u >> 3, qb = u & 7, b = bh >> 3, h = bh & 7;
        at::attn_unit(Q + ((size_t)(b * SEQ + qb * 256)) * 1536 + h * 192, Kb + (size_t)bh * NKEY * 192, Vb + (size_t)bh * NKEY * 128, Y + ((size_t)(b * SEQ + qb * 256)) * D + h * 128, qb * 256, (const float*)(ws + OFF_ROPE), (LAS char*)lds);
        __syncthreads();
    }
}

namespace sc {
using f32x16 = __attribute__((ext_vector_type(16))) float;
constexpr int BUFB = 53248, O_QT = 0, O_KH = 16384, O_VT = 32768, O_AT = 49152, O_DEC = 51200, O_KD = 2 * BUFB, LDS_SCAN = 2 * BUFB + 16384;
__device__ __forceinline__ int sw256(int row, int cb) { return row * 256 + (cb ^ ((row & 15) << 4)); }
__device__ __forceinline__ int sw128(int row, int cb) { return row * 128 + (cb ^ (((row >> 1) & 7) << 4)); }
__device__ __forceinline__ int grow_of(int n, int b, int dir) { if (n < CTXL) { const int s = dir ? (CTXL - 1 - n) : n; return L + b * CTXL + s; } const int m = n - CTXL; return b * SEQ + (dir ? (SEQ - 1 - m) : m); }
__device__ __forceinline__ bf16x8 pack_acc8(const f32x16& x, int s) { u32x4 p; p.x = cvt_pk_bf16(x[8 * s], x[8 * s + 1]); p.y = cvt_pk_bf16(x[8 * s + 2], x[8 * s + 3]); p.z = cvt_pk_bf16(x[8 * s + 4], x[8 * s + 5]); p.w = cvt_pk_bf16(x[8 * s + 6], x[8 * s + 7]); return __builtin_bit_cast(bf16x8, p); }

__device__ __forceinline__ void scan_unit(const Params& p, int unit, LAS unsigned char* lds) {
    char* ws = p.ws; const int dir = unit & 1, h = (unit >> 1) & 7, b = unit >> 4;
    const bf16_t* hq = (const bf16_t*)(ws + OFF_HQ); const bf16_t* fz = (const bf16_t*)(ws + (dir ? OFF_FB : OFF_FF)); const bf16_t* iv = (const bf16_t*)(ws + OFF_IV);
    bf16_t* outp = (bf16_t*)(ws + (dir ? OFF_OB : OFF_OF)); const float* lb = (const float*)(ws + OFF_LB);
    const int tid = otid(), wid = __builtin_amdgcn_readfirstlane(tid >> 6), lane = tid & 63, r32 = lane & 31, hi = lane >> 5;
    const int sgn = dir ? -1 : 1; const long rstep = (long)sgn * D;
    __syncthreads();
    if (wid >= 4) {
        const int I = wid - 4, cp = lane, hc = h * 128 + 2 * cp;
        const float lbv0 = lb[dir * 1024 + hc], lbv1 = lb[dir * 1024 + hc + 1];
        unsigned zr[16], vr[16], qr[16];
#define SC_LOAD(c) do { const size_t o0_ = (size_t)(grow_of((c) * 64, b, dir) + sgn * (16 * I)) * D + hc; const bf16_t* pz_ = fz + o0_; const bf16_t* pv_ = iv + o0_; const bf16_t* pq_ = hq + o0_; \
        _Pragma("unroll") for (int i = 0; i < 16; ++i) { zr[i] = *(const unsigned*)pz_; pz_ += rstep; vr[i] = *(const unsigned*)pv_; pv_ += rstep; if ((c) >= 4) { qr[i] = *(const unsigned*)pq_; pq_ += rstep; } } } while (0)
        SC_LOAD(0);
        for (int it = 0; it <= 36; ++it) {
            if (it < 36) {
                const int c = it; const bool lat = c >= 4; LAS unsigned char* B = lds + (c & 1) * BUFB; LAS unsigned char* KD = lds + O_KD;
                float kk0[16], kk1[16], lc0[16], lc1[16]; float run0 = 0.f, run1 = 0.f;
#pragma unroll
                for (int i = 0; i < 16; ++i) { const float z0 = __uint_as_float(zr[i] << 16), z1 = __uint_as_float(zr[i] & 0xffff0000u);
                    const float f0 = lbv0 + (1.0f - lbv0) * sigmoidf_(z0), f1 = lbv1 + (1.0f - lbv1) * sigmoidf_(z1); kk0[i] = 1.0f - f0; kk1[i] = 1.0f - f1;
                    run0 += __builtin_amdgcn_logf(f0) * 0.6931471805599453f; run1 += __builtin_amdgcn_logf(f1) * 0.6931471805599453f; lc0[i] = run0; lc1[i] = run1; }
                *(LAS f32x2*)(B + O_DEC + (I * 128 + 2 * cp) * 4) = (f32x2){__expf(run0), __expf(run1)};
                unsigned kh0[8], kh1[8], vt0[8], vt1[8];
#pragma unroll
                for (int i = 0; i < 16; ++i) { const int t = 16 * I + i; const float l0 = lc0[i], l1 = lc1[i];
                    const float kd0 = kk0[i] * __expf(fminf(-l0, 80.0f)), kd1 = kk1[i] * __expf(fminf(-l1, 80.0f));
                    const float kf0 = kk0[i] * __expf(run0 - l0), kf1 = kk1[i] * __expf(run1 - l1);
                    if (lat) { const float q0 = __uint_as_float(qr[i] << 16), q1 = __uint_as_float(qr[i] & 0xffff0000u);
                        *(LAS unsigned*)(B + O_QT + sw256(t, 4 * cp)) = cvt_pk_bf16(q0 * __expf(l0), q1 * __expf(l1)); *(LAS unsigned*)(KD + sw256(t, 4 * cp)) = cvt_pk_bf16(kd0, kd1); }
                    if (i & 1) { kh0[i >> 1] = cvt_pk_bf16(__uint_as_float(kh0[i >> 1]), kf0); kh1[i >> 1] = cvt_pk_bf16(__uint_as_float(kh1[i >> 1]), kf1); vt0[i >> 1] = (vt0[i >> 1] >> 16) | (vr[i] << 16); vt1[i >> 1] = (vt1[i >> 1] >> 16) | (vr[i] & 0xffff0000u); }
                    else { kh0[i >> 1] = __float_as_uint(kf0); kh1[i >> 1] = __float_as_uint(kf1); vt0[i >> 1] = vr[i] << 16; vt1[i >> 1] = vr[i] & 0xffff0000u; } }
#pragma unroll
                for (int q = 0; q < 2; ++q) {
                    *(LAS u32x4*)(B + O_KH + sw128(2 * cp, 32 * I + 16 * q)) = (u32x4){kh0[4 * q], kh0[4 * q + 1], kh0[4 * q + 2], kh0[4 * q + 3]}; *(LAS u32x4*)(B + O_KH + sw128(2 * cp + 1, 32 * I + 16 * q)) = (u32x4){kh1[4 * q], kh1[4 * q + 1], kh1[4 * q + 2], kh1[4 * q + 3]};
                    *(LAS u32x4*)(B + O_VT + sw128(2 * cp, 32 * I + 16 * q)) = (u32x4){vt0[4 * q], vt0[4 * q + 1], vt0[4 * q + 2], vt0[4 * q + 3]}; *(LAS u32x4*)(B + O_VT + sw128(2 * cp + 1, 32 * I + 16 * q)) = (u32x4){vt1[4 * q], vt1[4 * q + 1], vt1[4 * q + 2], vt1[4 * q + 3]}; }
                if (it + 1 < 36) SC_LOAD(it + 1);
                if (lat) {
                    const int l15 = lane & 15, lq = lane >> 4; f32x4 a = {0.f, 0.f, 0.f, 0.f};
#pragma unroll
                    for (int ks = 0; ks < 4; ++ks) { const bf16x8 av = *(const LAS bf16x8*)(B + O_QT + sw256(16 * I + l15, (32 * ks + 8 * lq) * 2)); const bf16x8 bv = *(const LAS bf16x8*)(KD + sw256(16 * I + l15, (32 * ks + 8 * lq) * 2));
                        a = __builtin_amdgcn_mfma_f32_16x16x32_bf16(av, bv, a, 0, 0, 0); }
#pragma unroll
                    for (int r = 0; r < 4; ++r) { const int tl = 4 * lq + r; float v = a[r]; if (l15 > tl) v = 0.f; *(LAS bf16_t*)(B + O_AT + ((I * 16 + tl) * 16 + l15) * 2) = f2bf(v); }
                }
            }
            __syncthreads();
        }
#undef SC_LOAD
    } else {
        const int bq = wid; f32x16 S[4];
#pragma unroll
        for (int a = 0; a < 4; ++a) S[a] = f32x16{};
        for (int it = 0; it <= 36; ++it) {
            if (it >= 1) {
                const int c = it - 1; const bool lat = c >= 4; LAS unsigned char* B = lds + (c & 1) * BUFB;
                bf16_t* po = outp + (size_t)(grow_of(c * 64, b, dir) + sgn * (4 * hi)) * D + h * 128 + 32 * bq + r32;
#pragma unroll
                for (int I = 0; I < 4; ++I) {
                    const bf16x8 vtf = *(const LAS bf16x8*)(B + O_VT + sw128(32 * bq + r32, (16 * I + 8 * hi) * 2));
                    if (lat) {
                        f32x16 o = f32x16{};
#pragma unroll
                        for (int a = 0; a < 4; ++a)
#pragma unroll
                            for (int s = 0; s < 2; ++s) { const int dk0 = 32 * a + 16 * s + 4 * hi; const int row = 16 * I + (r32 & 15);
                                const u32x2 lo2 = *(const LAS u32x2*)(B + O_QT + sw256(row, dk0 * 2)), hi2 = *(const LAS u32x2*)(B + O_QT + sw256(row, (dk0 + 8) * 2));
                                const u32x4 av = {lo2.x, lo2.y, hi2.x, hi2.y};
                                o = __builtin_amdgcn_mfma_f32_32x32x16_bf16(__builtin_bit_cast(bf16x8, av), pack_acc8(S[a], s), o, 0, 0, 0); }
                        { const bf16x8 af = *(const LAS bf16x8*)(B + O_AT + ((I * 16 + (r32 & 15)) * 16 + 8 * hi) * 2); o = __builtin_amdgcn_mfma_f32_32x32x16_bf16(af, vtf, o, 0, 0, 0); }
#pragma unroll
                        for (int r = 0; r < 8; ++r) po[(long)(16 * I + (r & 3) + 8 * (r >> 2)) * rstep] = f2bf(o[r]);
                    }
#pragma unroll
                    for (int a = 0; a < 4; ++a) {
#pragma unroll
                        for (int g = 0; g < 4; ++g) { const f32x4 dc = *(const LAS f32x4*)(B + O_DEC + (I * 128 + 32 * a + 8 * g + 4 * hi) * 4); S[a][4 * g] *= dc[0]; S[a][4 * g + 1] *= dc[1]; S[a][4 * g + 2] *= dc[2]; S[a][4 * g + 3] *= dc[3]; }
                        const bf16x8 kf = *(const LAS bf16x8*)(B + O_KH + sw128(32 * a + r32, (16 * I + 8 * hi) * 2));
                        S[a] = __builtin_amdgcn_mfma_f32_32x32x16_bf16(kf, vtf, S[a], 0, 0, 0); }
                }
            }
            __syncthreads();
        }
    }
    __syncthreads();
}
}
__device__ __forceinline__ void phase_scan(const Params& p, LAS unsigned char* lds) {
    for (int u = blockIdx.x; u < 256; u += gridDim.x) sc::scan_unit(p, u, lds);
}

constexpr int LDS_BYTES = 155648;
template <int PH> __global__ void __launch_bounds__(512, 2) k_phase(Params p) {
    extern __shared__ __attribute__((aligned(16))) unsigned char smem[];
    LAS unsigned char* lds = (LAS unsigned char*)smem;
    if constexpr (PH == 0) phase0(p, lds);
    if constexpr (PH == 1) phase1(p, lds);
    if constexpr (PH == 2) phase2(p, lds);
    if constexpr (PH == 3) phase3(p, lds);
    if constexpr (PH == 4) phase4(p, lds);
    if constexpr (PH == 5) phase5(p, lds);
    if constexpr (PH == 6) phase6(p, lds);
    if constexpr (PH == 7) phase7(p, lds);
    if constexpr (PH == 8) phase8(p, lds);
    if constexpr (PH == 9) phase9(p, lds);
    if constexpr (PH == 10) phase_attn(p, lds);
    if constexpr (PH == 11) phase_scan(p, lds);
}

#include <cstdint>
#include <cstdlib>
#include <vector>

#define XB_TMO      128
#define XB_XCNT(j)  (256  + 64 * (j))
#define XB_XSUB(j)  (1280 + 64 * (j))
#define XB_XGEN(j)  (2304 + 64 * (j))
#define XB_TOP      3328
#define XB_TOPGEN   3392
#define XCD_BAR_WORDS 3456
#define XB_SPIN_CAP (1u << 18)

__device__ __forceinline__ unsigned xb_ld(unsigned* p)              { return __hip_atomic_load(p, __ATOMIC_RELAXED, __HIP_MEMORY_SCOPE_AGENT); }
__device__ __forceinline__ unsigned xb_add(unsigned* p, unsigned v) { return __hip_atomic_fetch_add(p, v, __ATOMIC_RELAXED, __HIP_MEMORY_SCOPE_AGENT); }
__device__ __forceinline__ unsigned xb_xcc_id() { return (unsigned)__builtin_amdgcn_s_getreg((3 << 11) | 20) & 0xFu; }
#define XB_SPIN(cond, bar) do { unsigned _sp = 0; while (cond) { __builtin_amdgcn_s_sleep(1); \
    if ((++_sp & 255u) == 0u) { if (xb_ld(&(bar)[XB_TMO])) break; if (_sp > XB_SPIN_CAP) { atomicAdd(&(bar)[XB_TMO], 1u); break; } } } } while (0)

struct XcdBarrier {
    unsigned* bar; unsigned x;
    volatile LAS unsigned* st;
};

__device__ __forceinline__ XcdBarrier xcd_barrier_post(unsigned* bar, volatile LAS unsigned* st) {
    XcdBarrier b; b.bar = bar; b.x = xb_xcc_id(); b.st = st;
    if (threadIdx.x == 0) (void)xb_add(&bar[XB_XCNT(b.x)], 1u);
    return b;
}
__device__ __forceinline__ void xcd_barrier_complete(unsigned* bar, unsigned x, unsigned& nloc, unsigned& nx) {
    const unsigned G = gridDim.x * gridDim.y * gridDim.z;
    unsigned sum, cnt, mine, sp = 0u;
    for (;;) {
        sum = 0u; cnt = 0u; mine = 0u;
#pragma unroll
        for (unsigned j = 0; j < 16; ++j) { const unsigned c = xb_ld(&bar[XB_XCNT(j)]); sum += c; cnt += (c > 0u) ? 1u : 0u; mine = (j == x) ? c : mine; }
        if (sum == G) break;
        __builtin_amdgcn_s_sleep(1);
        if ((++sp & 255u) == 0u) { if (xb_ld(&bar[XB_TMO])) break; if (sp > XB_SPIN_CAP) { atomicAdd(&bar[XB_TMO], 1u); break; } }
    }
    nloc = mine > 0u ? mine : 1u; nx = cnt > 0u ? cnt : 1u;
}

__device__ __forceinline__ void xcd_barrier(const XcdBarrier& b) {
    asm volatile("s_waitcnt vmcnt(0)" ::: "memory");
    __syncthreads();
    if (threadIdx.x == 0) {
        unsigned* bar = b.bar;
        __builtin_amdgcn_s_waitcnt(0);
        unsigned nloc = b.st[0], nx = b.st[1];
        if (nloc == 0u) { xcd_barrier_complete(bar, b.x, nloc, nx); b.st[0] = nloc; b.st[1] = nx; }
        const unsigned old = xb_add(&bar[XB_XSUB(b.x)], 1u);
        const unsigned gen = old / nloc;
        if (old + 1u == (gen + 1u) * nloc) {
            __builtin_amdgcn_fence(__ATOMIC_RELEASE, "agent");
            asm volatile("s_waitcnt vmcnt(0)" ::: "memory");
            const unsigned og = xb_add(&bar[XB_TOP], 1u);
            const unsigned tg = og / nx;
            if (og + 1u == (tg + 1u) * nx) xb_add(&bar[XB_TOPGEN], 1u);
            else XB_SPIN(xb_ld(&bar[XB_TOPGEN]) == tg, bar);
            __builtin_amdgcn_fence(__ATOMIC_ACQUIRE, "agent");
            xb_add(&bar[XB_XGEN(b.x)], 1u);
            asm volatile("s_waitcnt vmcnt(0)" ::: "memory");
        } else {
            XB_SPIN(xb_ld(&bar[XB_XGEN(b.x)]) == gen, bar);
            __builtin_amdgcn_fence(__ATOMIC_ACQUIRE, "agent");
            asm volatile("s_waitcnt vmcnt(0)" ::: "memory");
        }
    }
    __syncthreads();
}

__global__ void __launch_bounds__(512, 2) k_mega(Params p) {
    extern __shared__ __attribute__((aligned(16))) unsigned char smem[];
    LAS unsigned char* lds = (LAS unsigned char*)smem;
    volatile LAS unsigned* xbw = (volatile LAS unsigned*)(lds + LDS_BYTES - 16);
    if (threadIdx.x == 0) { xbw[0] = 0u; xbw[1] = 0u; xbw[2] = 0u; xbw[3] = 0u; }
    __syncthreads();
    XcdBarrier bar = xcd_barrier_post((unsigned*)(p.ws + OFF_BAR), xbw);
    phase0(p, lds);      xcd_barrier(bar);
    phase1(p, lds);      xcd_barrier(bar);
    phase2(p, lds);      xcd_barrier(bar);
    phase3(p, lds);      xcd_barrier(bar);
    phase_attn(p, lds);
    phase_scan(p, lds);  xcd_barrier(bar);
    phase4(p, lds);      xcd_barrier(bar);
    phase5(p, lds);      xcd_barrier(bar);
    phase6(p, lds);      xcd_barrier(bar);
    phase7(p, lds);      xcd_barrier(bar);
    phase8(p, lds);      xcd_barrier(bar);
    phase9(p, lds);
}
extern "C" void kernel_launch(void* const* d_in, const int* in_sizes, int n_in, void* d_out, int out_size, void* d_ws, size_t ws_size, hipStream_t stream) {
    static int grid = 0;
    if (grid == 0) {
        int dev = 0, cus = 0, per_cu = 0;
        if (hipGetDevice(&dev) != hipSuccess || hipDeviceGetAttribute(&cus, hipDeviceAttributeMultiprocessorCount, dev) != hipSuccess) { grid = -1; return; }
        if (hipFuncSetAttribute((const void*)k_mega, hipFuncAttributeMaxDynamicSharedMemorySize, LDS_BYTES) != hipSuccess) { grid = -1; return; }
        (void)hipOccupancyMaxActiveBlocksPerMultiprocessor(&per_cu, (const void*)k_mega, 512, LDS_BYTES);
        (void)hipGetLastError();
        grid = cus;
    }
    if (grid < 0) return;
    Params p{};
    p.x = (const float*)d_in[0]; p.c = (const float*)d_in[1]; p.ctx = (const float*)d_in[2]; p.cctx = (const float*)d_in[3]; p.w_mod = (const float*)d_in[4]; p.b_mod = (const float*)d_in[5];
    p.g_mix = (const float*)d_in[6]; p.w_in = (const float*)d_in[7]; p.g_q = (const float*)d_in[8]; p.w_qb = (const float*)d_in[9]; p.g_kv = (const float*)d_in[10]; p.w_kvb = (const float*)d_in[11];
    p.lbl = (const float*)d_in[12]; p.g_hg = (const float*)d_in[13]; p.w_out = (const float*)d_in[14]; p.g_ffn = (const float*)d_in[15]; p.w_r = (const float*)d_in[16]; p.b_r = (const float*)d_in[17];
    p.w_gu = (const float*)d_in[18]; p.b_gu = (const float*)d_in[19]; p.w_dn = (const float*)d_in[20]; p.b_dn = (const float*)d_in[21]; p.g_fin = (const float*)d_in[22];
    p.out = (float*)d_out; p.ws = (char*)d_ws;
    (void)hipMemsetAsync((char*)d_ws + OFF_BAR, 0, 16384, stream);
    hipLaunchKernelGGL(k_mega, dim3(grid), dim3(512), LDS_BYTES, stream, p);
}
```

```cpp
#include <hip/hip_runtime.h>
#include <stdint.h>

typedef unsigned short bf16_t;
__device__ __forceinline__ float bf2f(bf16_t v) { return __uint_as_float(((unsigned)v) << 16); }
__device__ __forceinline__ bf16_t f2bf(float f) { unsigned u = __float_as_uint(f); u += 0x7FFFu + ((u >> 16) & 1u); return (bf16_t)(u >> 16); }
__device__ __forceinline__ float sigmoidf_(float x) { return __builtin_amdgcn_rcpf(1.0f + __builtin_amdgcn_exp2f(-1.4426950408889634f * x)); }
__device__ __forceinline__ float siluf_(float x) { return x * __builtin_amdgcn_rcpf(1.0f + __builtin_amdgcn_exp2f(-1.4426950408889634f * x)); }

constexpr int D = 1024, NB = 16, SEQ = 2048, CTXL = 256;
constexpr int L = NB * SEQ;
constexpr int RC = NB * CTXL;
constexpr int R = L + RC;
constexpr int NKEY = SEQ + CTXL;
constexpr float EPS = 1e-6f;
constexpr int NE = 32, CAP = 32768;
constexpr int MAXROWS = 131072 + NE * 256;

constexpr size_t MiB = 1048576;
constexpr size_t OFF_SMALL = 0;
constexpr size_t OFF_BAR = 0;
constexpr size_t OFF_CNT = 16384;
constexpr size_t OFF_OFFS = 16384 + 1024;
constexpr size_t OFF_TILEE = 16384 + 2048;
constexpr size_t OFF_LB = 24576;
constexpr size_t OFF_MOD = 32768;
constexpr size_t OFF_SSQQ = 512 * 1024;
constexpr size_t OFF_SSQKV = 768 * 1024;
constexpr size_t OFF_TOPI = 1 * MiB;
constexpr size_t OFF_TOPP = 1 * MiB + 512 * 1024;
constexpr size_t OFF_ROWPAIR = 2 * MiB;
constexpr size_t OFF_LIST = 3 * MiB;
constexpr size_t OFF_H = 32 * MiB;
constexpr size_t OFF_QA = 104 * MiB;
constexpr size_t OFF_CKV = 152 * MiB;
constexpr size_t OFF_KR = 170 * MiB;
constexpr size_t OFF_OF = 104 * MiB;
constexpr size_t OFF_HQ = 175 * MiB;
constexpr size_t SEG_STRIDE = 72 * MiB;
constexpr size_t OFF_FF = OFF_HQ + 1 * SEG_STRIDE;
constexpr size_t OFF_FB = OFF_HQ + 2 * SEG_STRIDE;
constexpr size_t OFF_IV = OFF_HQ + 3 * SEG_STRIDE;
constexpr size_t OFF_OG = OFF_HQ + 4 * SEG_STRIDE;
constexpr size_t OFF_GM = OFF_HQ + 5 * SEG_STRIDE;
constexpr size_t OFF_GH = OFF_HQ + 6 * SEG_STRIDE;
constexpr size_t OFF_Q = 679 * MiB;
constexpr size_t OFF_K = 775 * MiB;
constexpr size_t OFF_V = 883 * MiB;
constexpr size_t OFF_OB = 955 * MiB;
constexpr size_t OFF_YP = 296 * MiB;
constexpr size_t OFF_ACT = 568 * MiB;

struct SegOut { bf16_t *qa, *ckv, *kr, *hq, *ff, *fb, *iv, *og, *gm, *gh; };

__global__ void k_init(const float* __restrict__ lbl, float* lb, int* cnt) {
    int i = blockIdx.x * blockDim.x + threadIdx.x;
    if (i < 2048) { int d = i >> 10, j = i & 1023; float a = lbl[(d * 2 + 0) * 1024 + j], b = lbl[(d * 2 + 1) * 1024 + j]; lb[i] = 1.0f / (1.0f + __expf(b - a)); }
    if (i < 32) cnt[i] = 0;
}

__global__ __launch_bounds__(256) void k_mod(const float* __restrict__ c, const float* __restrict__ cctx, const float* __restrict__ wmod, const float* __restrict__ bmod, float* modv) {
    __shared__ float s[1024];
    int r = blockIdx.y; const float* src = r < 16 ? c + r * 1024 : cctx;
    for (int k = threadIdx.x; k < 1024; k += 256) s[k] = siluf_(src[k]);
    __syncthreads();
    int j = blockIdx.x * 256 + threadIdx.x; float acc = 0.f;
    for (int k = 0; k < 1024; ++k) acc += s[k] * wmod[(size_t)k * 6144 + j];
    modv[r * 6144 + j] = acc + bmod[j];
}

__device__ __forceinline__ float block_sum256(float v, float* red) {
    for (int o = 32; o > 0; o >>= 1) v += __shfl_xor(v, o);
    int w = threadIdx.x >> 6; if ((threadIdx.x & 63) == 0) red[w] = v; __syncthreads();
    float t = red[0] + red[1] + red[2] + red[3]; __syncthreads(); return t;
}

__global__ __launch_bounds__(256) void k_norm1(const float* __restrict__ x, const float* __restrict__ ctx, const float* __restrict__ g, const float* __restrict__ modv, bf16_t* h) {
    __shared__ float red[4];
    int row = blockIdx.x; const float* src = row < L ? x + (size_t)row * D : ctx + (size_t)(row - L) * D;
    const float* mod = modv + (row < L ? row / SEQ : 16) * 6144;
    int c = threadIdx.x * 4; float4 v = *(const float4*)(src + c);
    float ss = block_sum256(v.x * v.x + v.y * v.y + v.z * v.z + v.w * v.w, red);
    float rs = rsqrtf(ss * (1.0f / D) + EPS);
    float o[4] = {v.x, v.y, v.z, v.w}; ushort4 w; bf16_t* wp = (bf16_t*)&w;
    for (int i = 0; i < 4; ++i) wp[i] = f2bf(o[i] * rs * g[c + i] * (1.0f + mod[1024 + c + i]) + mod[c + i]);
    *(ushort4*)(h + (size_t)row * D + c) = w;
}

__global__ __launch_bounds__(256) void k_rowssq(const bf16_t* __restrict__ buf, int width, int nrows, float* ssq) {
    int row = blockIdx.x * 4 + (threadIdx.x >> 6), lane = threadIdx.x & 63; if (row >= nrows) return;
    float s = 0.f; for (int k = lane; k < width; k += 64) { float v = bf2f(buf[(size_t)row * width + k]); s += v * v; }
    for (int o = 32; o > 0; o >>= 1) s += __shfl_xor(s, o);
    if (lane == 0) ssq[row] = s;
}

__device__ __forceinline__ void rope_cs(int t, int i, float& cs, float& sn) {
    int j = i & 15; float inv = __expf(-(float)j * (9.210340371976184f / 16.0f)); float pos = (i < 16) ? (float)(t >> 6) : (float)(t & 63);
    float ang = pos * inv; cs = cosf(ang); sn = sinf(ang);
}

__global__ __launch_bounds__(256) void k_krope(const bf16_t* __restrict__ kr, bf16_t* Kb) {
    int gid = blockIdx.x * 256 + threadIdx.x; int row = gid >> 5, i = gid & 31; if (row >= R) return;
    float x1 = bf2f(kr[(size_t)row * 64 + i]), x2 = bf2f(kr[(size_t)row * 64 + 32 + i]); float o1 = x1, o2 = x2; int b, pos;
    if (row < L) { b = row / SEQ; pos = row % SEQ; float cs, sn; rope_cs(pos, i, cs, sn); o1 = x1 * cs - x2 * sn; o2 = x1 * sn + x2 * cs; }
    else { b = (row - L) / CTXL; pos = SEQ + (row - L) % CTXL; }
    bf16_t w1 = f2bf(o1), w2 = f2bf(o2);
    for (int h = 0; h < 8; ++h) { bf16_t* p = Kb + ((size_t)(b * 8 + h) * NKEY + pos) * 192 + 128; p[i] = w1; p[32 + i] = w2; }
}

template <class AL, class EP>
__global__ __launch_bounds__(256) void k_ngemm(int K, const float* __restrict__ W, int ldw, size_t wzstride, AL al, EP ep) {
    __shared__ float As[16][68]; __shared__ float Bs[16][64];
    const int z = blockIdx.z, row0 = blockIdx.y * 64, col0 = blockIdx.x * 64, tid = threadIdx.x;
    const int mvalid = al.rows(z); if (row0 >= mvalid) return;
    const float* Wz = W + (size_t)z * wzstride;
    const int ar = tid >> 2, ak = (tid & 3) * 4; const bf16_t* arow = (row0 + ar < mvalid) ? al.rowptr(z, row0 + ar) : nullptr;
    const int bk = tid >> 4, bn = (tid & 15) * 4;
    const int ty = tid >> 4, tx = tid & 15;
    float acc[4][4] = {};
    for (int k0 = 0; k0 < K; k0 += 16) {
        float a4[4] = {0.f, 0.f, 0.f, 0.f};
        if (arow) { ushort4 u = *(const ushort4*)(arow + k0 + ak); const bf16_t* up = (const bf16_t*)&u; for (int i = 0; i < 4; ++i) a4[i] = bf2f(up[i]) * al.kscale(k0 + ak + i); }
        float4 b4 = *(const float4*)(Wz + (size_t)(k0 + bk) * ldw + col0 + bn);
        __syncthreads();
        for (int i = 0; i < 4; ++i) As[ak + i][ar] = a4[i];
        *(float4*)&Bs[bk][bn] = b4;
        __syncthreads();
#pragma unroll
        for (int kk = 0; kk < 16; ++kk) {
            float4 av = *(const float4*)&As[kk][ty * 4]; float4 bv = *(const float4*)&Bs[kk][tx * 4];
            float a[4] = {av.x, av.y, av.z, av.w}, b[4] = {bv.x, bv.y, bv.z, bv.w};
#pragma unroll
            for (int i = 0; i < 4; ++i)
#pragma unroll
                for (int j = 0; j < 4; ++j) acc[i][j] += a[i] * b[j];
        }
    }
    for (int i = 0; i < 4; ++i) { int row = row0 + ty * 4 + i; if (row < mvalid) ep.store(z, row, col0 + tx * 4, acc[i]); }
}

__device__ __forceinline__ void st4bf(bf16_t* dst, const float* v) { ushort4 w; bf16_t* wp = (bf16_t*)&w; for (int i = 0; i < 4; ++i) wp[i] = f2bf(v[i]); *(ushort4*)dst = w; }

struct ALDense { const bf16_t* A; int lda; int nrows; const float* ks;
    __device__ int rows(int) const { return nrows; }
    __device__ const bf16_t* rowptr(int, int row) const { return A + (size_t)row * lda; }
    __device__ float kscale(int k) const { return ks ? ks[k] : 1.0f; } };

struct EpiInN { SegOut s;
    __device__ void store(int, int row, int col, const float* v) const {
        bf16_t* dst;
        if (col < 768) { if (row >= L) return; dst = s.qa + (size_t)row * 768 + col; }
        else if (col < 1024) dst = s.ckv + (size_t)row * 256 + (col - 768);
        else if (col < 1088) dst = s.kr + (size_t)row * 64 + (col - 1024);
        else { int c = col - 1088, seg = c >> 10, cc = c & 1023; bool latonly = (seg == 0 || seg >= 4); if (latonly && row >= L) return;
            bf16_t* base = seg == 0 ? s.hq : seg == 1 ? s.ff : seg == 2 ? s.fb : seg == 3 ? s.iv : seg == 4 ? s.og : seg == 5 ? s.gm : s.gh;
            dst = base + (size_t)row * 1024 + cc; }
        st4bf(dst, v);
    } };

struct EpiQN { bf16_t* q; const float* ssq;
    __device__ void store(int, int row, int col, const float* v) const { float rs = rsqrtf(ssq[row] * (1.0f / 768.0f) + EPS); float o[4]; for (int i = 0; i < 4; ++i) o[i] = v[i] * rs; st4bf(q + (size_t)row * 1536 + col, o); } };

struct EpiKVN { bf16_t *Kb, *Vb; const float* ssq;
    __device__ void store(int, int row, int col, const float* v) const {
        float rs = rsqrtf(ssq[row] * (1.0f / 256.0f) + EPS); float o[4]; for (int i = 0; i < 4; ++i) o[i] = v[i] * rs;
        int b, pos; if (row < L) { b = row / SEQ; pos = row % SEQ; } else { b = (row - L) / CTXL; pos = SEQ + (row - L) % CTXL; }
        int h = col >> 8, w = col & 255; size_t kvrow = (size_t)(b * 8 + h) * NKEY + pos;
        if (w < 128) st4bf(Kb + kvrow * 192 + w, o); else st4bf(Vb + kvrow * 128 + (w - 128), o);
    } };

struct EpiOutN { float* x1; const float* x; const float* modv;
    __device__ void store(int, int row, int col, const float* v) const {
        const float* gate = modv + (row / SEQ) * 6144 + 2 * 1024; float4 xv = *(const float4*)(x + (size_t)row * D + col);
        float4 o; o.x = xv.x + gate[col] * v[0]; o.y = xv.y + gate[col + 1] * v[1]; o.z = xv.z + gate[col + 2] * v[2]; o.w = xv.w + gate[col + 3] * v[3];
        *(float4*)(x1 + (size_t)row * D + col) = o;
    } };

struct ALMoe1 { const bf16_t* h2; const int* cnt; const int* list;
    __device__ int rows(int z) const { return cnt[z]; }
    __device__ const bf16_t* rowptr(int z, int row) const { return h2 + (size_t)(list[z * CAP + row] >> 2) * D; }
    __device__ float kscale(int) const { return 1.0f; } };
struct EpiMoe1N { bf16_t* act; const int* offs; const float* bgu;
    __device__ void store(int z, int row, int col, const float* v) const {
        const float* bb = bgu + z * 2048 + col; ushort2 w; bf16_t* wp = (bf16_t*)&w;
        for (int p = 0; p < 2; ++p) { float glu = fminf(v[2 * p] + bb[2 * p], 7.0f); float lin = fminf(fmaxf(v[2 * p + 1] + bb[2 * p + 1], -7.0f), 7.0f);
            wp[p] = f2bf(glu * sigmoidf_(1.702f * glu) * (lin + 1.0f)); }
        *(ushort2*)(act + (size_t)(offs[z] + row) * D + (col >> 1)) = w;
    } };
struct ALMoe2 { const bf16_t* act; const int* cnt; const int* offs;
    __device__ int rows(int z) const { return cnt[z]; }
    __device__ const bf16_t* rowptr(int z, int row) const { return act + (size_t)(offs[z] + row) * D; }
    __device__ float kscale(int) const { return 1.0f; } };
struct EpiMoe2N { bf16_t* yp; const int* list; const float* bd;
    __device__ void store(int z, int row, int col, const float* v) const {
        int pair = list[z * CAP + row]; const float* bb = bd + z * 1024 + col; float o[4]; for (int i = 0; i < 4; ++i) o[i] = v[i] + bb[i];
        st4bf(yp + (size_t)pair * D + col, o);
    } };

__global__ __launch_bounds__(256) void k_nattn(const bf16_t* __restrict__ Q, const bf16_t* __restrict__ Kb, const bf16_t* __restrict__ Vb, bf16_t* Y) {
    __shared__ float qs[4][192]; __shared__ float sc[4][NKEY];
    const int tid = threadIdx.x, blk = blockIdx.x, qg = blk & 511, h = (blk >> 9) & 7, b = blk >> 12;
    for (int idx = tid; idx < 4 * 192; idx += 256) { int qi = idx / 192, d = idx % 192; int row = b * SEQ + qg * 4 + qi; qs[qi][d] = bf2f(Q[(size_t)row * 1536 + h * 192 + d]); }
    __syncthreads();
    float n1 = 0.f, n2 = 0.f;
    if (tid < 128) { int qi = tid >> 5, i = tid & 31; int t = qg * 4 + qi; float cs, sn; rope_cs(t, i, cs, sn); float x1 = qs[qi][128 + i], x2 = qs[qi][160 + i]; n1 = x1 * cs - x2 * sn; n2 = x1 * sn + x2 * cs; }
    __syncthreads();
    if (tid < 128) { int qi = tid >> 5, i = tid & 31; qs[qi][128 + i] = n1; qs[qi][160 + i] = n2; }
    __syncthreads();
    const bf16_t* Kp = Kb + (size_t)(b * 8 + h) * NKEY * 192; const bf16_t* Vp = Vb + (size_t)(b * 8 + h) * NKEY * 128;
    const float scale = 0.07216878364870322f;
    for (int key = tid; key < NKEY; key += 256) {
        const bf16_t* kr = Kp + (size_t)key * 192; float s0 = 0.f, s1 = 0.f, s2 = 0.f, s3 = 0.f;
        for (int d = 0; d < 192; d += 8) { uint4 u = *(const uint4*)(kr + d); const bf16_t* up = (const bf16_t*)&u;
            for (int j = 0; j < 8; ++j) { float kv = bf2f(up[j]); s0 += qs[0][d + j] * kv; s1 += qs[1][d + j] * kv; s2 += qs[2][d + j] * kv; s3 += qs[3][d + j] * kv; } }
        sc[0][key] = s0 * scale; sc[1][key] = s1 * scale; sc[2][key] = s2 * scale; sc[3][key] = s3 * scale;
    }
    __syncthreads();
    { int w = tid >> 6, lane = tid & 63; float m = -1e30f; for (int k = lane; k < NKEY; k += 64) m = fmaxf(m, sc[w][k]);
      for (int o = 32; o > 0; o >>= 1) m = fmaxf(m, __shfl_xor(m, o));
      float s = 0.f; for (int k = lane; k < NKEY; k += 64) { float e = __expf(sc[w][k] - m); sc[w][k] = e; s += e; }
      for (int o = 32; o > 0; o >>= 1) s += __shfl_xor(s, o);
      float inv = 1.0f / s; for (int k = lane; k < NKEY; k += 64) sc[w][k] *= inv; }
    __syncthreads();
    { int dv = tid & 127, qh = tid >> 7; float o0 = 0.f, o1 = 0.f;
      for (int k = 0; k < NKEY; ++k) { float v = bf2f(Vp[(size_t)k * 128 + dv]); o0 += sc[qh * 2][k] * v; o1 += sc[qh * 2 + 1][k] * v; }
      int row = b * SEQ + qg * 4 + qh * 2; Y[(size_t)row * D + h * 128 + dv] = f2bf(o0); Y[(size_t)(row + 1) * D + h * 128 + dv] = f2bf(o1); }
}

__global__ __launch_bounds__(256) void k_nscan(const bf16_t* __restrict__ hq, const bf16_t* __restrict__ ff, const bf16_t* __restrict__ fb, const bf16_t* __restrict__ iv, const float* __restrict__ lb, bf16_t* of, bf16_t* ob) {
    __shared__ float sf[128], sk[128], sq[128], so[2][128];
    const int tid = threadIdx.x, blk = blockIdx.x, dir = blk & 1, h = (blk >> 1) & 7, b = blk >> 4;
    const bf16_t* fz = dir ? fb : ff; bf16_t* out = dir ? ob : of;
    const int dv = tid & 127, half = tid >> 7;
    float S[64];
#pragma unroll
    for (int j = 0; j < 64; ++j) S[j] = 0.f;
    const float lbv = lb[dir * 1024 + h * 128 + (tid & 127)];
    for (int step = 0; step < NKEY; ++step) {
        int row; bool islat;
        if (step < CTXL) { int s = dir ? (CTXL - 1 - step) : step; row = L + b * CTXL + s; islat = false; }
        else { int t = step - CTXL; t = dir ? (SEQ - 1 - t) : t; row = b * SEQ + t; islat = true; }
        if (tid < 128) { float z = bf2f(fz[(size_t)row * D + h * 128 + tid]); float f = lbv + (1.0f - lbv) * sigmoidf_(z); sf[tid] = f; sk[tid] = 1.0f - f;
            if (islat) { float zq = bf2f(hq[(size_t)row * D + h * 128 + tid]); sq[tid] = siluf_(zq) * 0.08838834764831845f; } }
        float v = bf2f(iv[(size_t)row * D + h * 128 + dv]);
        __syncthreads();
        float o = 0.f;
#pragma unroll
        for (int j = 0; j < 64; ++j) { int dk = half * 64 + j; S[j] = sf[dk] * S[j] + sk[dk] * v; o += S[j] * sq[dk]; }
        if (islat) so[half][dv] = o;
        __syncthreads();
        if (islat && half == 0) out[(size_t)row * D + h * 128 + dv] = f2bf(so[0][dv] + so[1][dv]);
    }
}

__global__ __launch_bounds__(256) void k_merge(bf16_t* y, const bf16_t* __restrict__ of, const bf16_t* __restrict__ ob, const bf16_t* __restrict__ og, const bf16_t* __restrict__ gm, const bf16_t* __restrict__ gh, const float* __restrict__ ghg) {
    int row = blockIdx.x, c = threadIdx.x * 4; size_t off = (size_t)row * D + c;
    ushort4 a = *(const ushort4*)(of + off), bb = *(const ushort4*)(ob + off), g1 = *(const ushort4*)(og + off), g2 = *(const ushort4*)(gm + off), g3 = *(const ushort4*)(gh + off), ym = *(const ushort4*)(y + off);
    const bf16_t *ap = (const bf16_t*)&a, *bp = (const bf16_t*)&bb, *p1 = (const bf16_t*)&g1, *p2 = (const bf16_t*)&g2, *p3 = (const bf16_t*)&g3, *pm = (const bf16_t*)&ym;
    float o[4], ss = 0.f; for (int i = 0; i < 4; ++i) { o[i] = bf2f(ap[i]) + bf2f(bp[i]); ss += o[i] * o[i]; }
    for (int m = 16; m > 0; m >>= 1) ss += __shfl_xor(ss, m);
    float rs = rsqrtf(ss * (1.0f / 128.0f) + EPS); float r[4];
    for (int i = 0; i < 4; ++i) { float yh = o[i] * rs * ghg[(c + i) & 127] * siluf_(bf2f(p1[i])); r[i] = sigmoidf_(bf2f(p2[i])) * bf2f(pm[i]) + sigmoidf_(bf2f(p3[i])) * yh; }
    st4bf(y + off, r);
}

__global__ __launch_bounds__(256) void k_norm2_router(const float* __restrict__ x1, const float* __restrict__ g, const float* __restrict__ modv, const float* __restrict__ wr, const float* __restrict__ br, bf16_t* h2, int* topi, float* topp, int* cnt, int* list) {
    __shared__ float red[4]; __shared__ float hs[1024]; __shared__ float part[8][32];
    int row = blockIdx.x, tid = threadIdx.x, c = tid * 4; const float* mod = modv + (row / SEQ) * 6144;
    float4 v = *(const float4*)(x1 + (size_t)row * D + c);
    float ss = block_sum256(v.x * v.x + v.y * v.y + v.z * v.z + v.w * v.w, red); float rs = rsqrtf(ss * (1.0f / D) + EPS);
    float xv[4] = {v.x, v.y, v.z, v.w}, o[4];
    for (int i = 0; i < 4; ++i) { o[i] = xv[i] * rs * g[c + i] * (1.0f + mod[4 * 1024 + c + i]) + mod[3 * 1024 + c + i]; hs[c + i] = o[i]; }
    st4bf(h2 + (size_t)row * D + c, o);
    __syncthreads();
    { int e = tid & 31, p = tid >> 5; float a = 0.f; for (int j = p * 128; j < p * 128 + 128; ++j) a += hs[j] * wr[j * 32 + e]; part[p][e] = a; }
    __syncthreads();
    if (tid < 64) {
        int e = tid & 31; float cur = br[e];
#pragma unroll
        for (int p = 0; p < 8; ++p) cur += part[p][e];
        float tv0 = 0.f, sum = 0.f; float myp = 0.f; int myk = -1;
        int sel_i[4]; float sel_e[4];
#pragma unroll
        for (int k = 0; k < 4; ++k) {
            float m = cur; int mi = e;
#pragma unroll
            for (int o = 16; o > 0; o >>= 1) { float om = __shfl_xor(m, o); int oi = __shfl_xor(mi, o); if (om > m || (om == m && oi < mi)) { m = om; mi = oi; } }
            if (k == 0) tv0 = m;
            sel_i[k] = mi; sel_e[k] = __expf(m - tv0); sum += sel_e[k];
            if (e == mi) cur = -3.0e38f;
        }
#pragma unroll
        for (int k = 0; k < 4; ++k) if (tid == k) { myk = sel_i[k]; myp = sel_e[k] / sum; }
        if (tid < 4) { int pair = row * 4 + tid; topi[pair] = myk; topp[pair] = myp; int pos = atomicAdd(&cnt[myk], 1); list[myk * CAP + pos] = pair; }
    }
}

__global__ void k_moe_offs(const int* cnt, int* offs, int* tilee) {
    if (threadIdx.x == 0 && blockIdx.x == 0) { int o = 0, t = 0; for (int e = 0; e < NE; ++e) { offs[e] = o; int nt = (cnt[e] + 255) >> 8; for (int i = 0; i < nt; ++i) tilee[t++] = e; o += nt * 256; } offs[NE] = o; offs[NE + 1] = t; }
}

__global__ __launch_bounds__(256) void k_final(float* out, const bf16_t* __restrict__ yp, const float* __restrict__ topp, const float* __restrict__ modv, const float* __restrict__ fg) {
    __shared__ float red[4];
    int row = blockIdx.x, c = threadIdx.x * 4; const float* gate = modv + (row / SEQ) * 6144 + 5 * 1024;
    float4 v = *(const float4*)(out + (size_t)row * D + c); float xv[4] = {v.x, v.y, v.z, v.w}; float m[4] = {0.f, 0.f, 0.f, 0.f};
    for (int k = 0; k < 4; ++k) { float p = topp[row * 4 + k]; ushort4 u = *(const ushort4*)(yp + (size_t)(row * 4 + k) * D + c); const bf16_t* up = (const bf16_t*)&u; for (int i = 0; i < 4; ++i) m[i] += p * bf2f(up[i]); }
    float ss = 0.f; for (int i = 0; i < 4; ++i) { xv[i] += gate[c + i] * m[i]; ss += xv[i] * xv[i]; }
    ss = block_sum256(ss, red); float rs = rsqrtf(ss * (1.0f / D) + EPS);
    float4 o; o.x = xv[0] * rs * fg[c]; o.y = xv[1] * rs * fg[c + 1]; o.z = xv[2] * rs * fg[c + 2]; o.w = xv[3] * rs * fg[c + 3];
    *(float4*)(out + (size_t)row * D + c) = o;
}

#define LAS __attribute__((address_space(3)))
__device__ __forceinline__ int otid() { int t = threadIdx.x; asm volatile("" : "+v"(t)); return t; }
typedef short bf16x8 __attribute__((ext_vector_type(8)));
typedef float f32x4 __attribute__((ext_vector_type(4)));
typedef unsigned u32x4 __attribute__((ext_vector_type(4)));
typedef unsigned u32x2 __attribute__((ext_vector_type(2)));
typedef float f32x2 __attribute__((ext_vector_type(2)));

constexpr size_t OFF_ROPE = 7 * MiB;
constexpr size_t OFF_WT_IN = 8 * MiB;
constexpr size_t OFF_WT_QB = 25 * MiB;
constexpr size_t OFF_WT_KVB = 28 * MiB;
constexpr size_t OFF_WT_OUT = 29 * MiB;
constexpr size_t OFF_WT_GU = 104 * MiB;
constexpr size_t OFF_WT_DN = 232 * MiB;
constexpr size_t OFF_YF8 = 775 * MiB;
constexpr size_t OFF_X1 = 704 * MiB;

struct Params {
    const float *x, *c, *ctx, *cctx, *w_mod, *b_mod, *g_mix, *w_in, *g_q, *w_qb, *g_kv, *w_kvb, *lbl, *g_hg, *w_out, *g_ffn, *w_r, *b_r, *w_gu, *b_gu, *w_dn, *b_dn, *g_fin;
    float* out; char* ws;
};

typedef __bf16 bf16v2_t __attribute__((ext_vector_type(2)));
__device__ __forceinline__ unsigned cvt_pk_bf16(float lo, float hi) { bf16v2_t v = {(__bf16)lo, (__bf16)hi}; return __builtin_bit_cast(unsigned, v); }

__device__ __forceinline__ unsigned pack4_fp8(float a, float b, float c, float d) {
    a = __builtin_amdgcn_fmed3f(a, -448.f, 448.f); b = __builtin_amdgcn_fmed3f(b, -448.f, 448.f); c = __builtin_amdgcn_fmed3f(c, -448.f, 448.f); d = __builtin_amdgcn_fmed3f(d, -448.f, 448.f);
    unsigned w = 0; w = __builtin_amdgcn_cvt_pk_fp8_f32(a, b, w, false); w = __builtin_amdgcn_cvt_pk_fp8_f32(c, d, w, true); return w; }

namespace pg8 {
constexpr int BM = 256, BK = 64, HALF = 128, HTB = HALF * BK * 2, STAGE_BYTES = 8 * HTB, NXCD = 8, WGM = 8;
constexpr int LDS_IDX = STAGE_BYTES + 8192;
__device__ __forceinline__ int lds_byte(int r, int c) { const int st = (r >> 4) * 2 + (c >> 5), rr = r & 15, cc = c & 31, ob = rr * 64 + cc * 2; return st * 1024 + (ob ^ (((ob >> 9) & 1) << 5)); }
__device__ __forceinline__ void stage_rc(int b, int& R, int& C) { const int st = b / 1024, sb = b % 1024, swz = sb ^ (((sb >> 9) & 1) << 5); R = (st >> 1) * 16 + swz / 64; C = (st & 1) * 32 + (swz % 64) / 2; }
__device__ __forceinline__ int perm32(int rho) { const int n = rho >> 4, i = rho & 15; return 8 * (i >> 2) + 4 * n + (i & 3); }
struct Unit { int pm, pn; const char* b; int e, pos0, cnt; };

__device__ __forceinline__ int xcd_remap(int L, int nwg) { const int q = nwg / NXCD, r = nwg % NXCD, xcd = L % NXCD, off = L / NXCD; return (xcd < r ? xcd * (q + 1) : r * (q + 1) + (xcd - r) * q) + off; }

struct DenseSched {
    int nM, nN, nwg, G, c, rowb; const char* Bt; size_t btile;
    __device__ void init(int M, int N, int kbytes, int rowb_, const void* Bt_, int G_, int c_) { nM = M / BM; nN = N / BM; nwg = nM * nN; G = G_; c = c_; rowb = rowb_; Bt = (const char*)Bt_; btile = (size_t)BM * kbytes; }
    static constexpr bool GATHER_LDS = false;
    __device__ __forceinline__ int kstepA() const { return 128; }
    __device__ __forceinline__ void tile(int wgid, int& pm, int& pn) const { const int nig = WGM * nN, gid = wgid / nig, fm = gid * WGM, gsz = (nM - fm) < WGM ? (nM - fm) : WGM; pm = fm + ((wgid % nig) % gsz); pn = (wgid % nig) / gsz; }
    __device__ __forceinline__ bool next(int i, Unit& u) const { const int Lx = i * G + c; if (Lx >= nwg) return false; tile(xcd_remap(Lx, nwg), u.pm, u.pn); u.b = Bt + (size_t)u.pn * btile; u.e = 0; u.pos0 = 0; u.cnt = 0; return true; }
    __device__ __forceinline__ void aoff(const Unit& u, const int (&Rr)[2], const int (&Cc)[2], unsigned (&va)[2][2]) const {
#pragma unroll
        for (int h = 0; h < 2; ++h)
#pragma unroll
            for (int i = 0; i < 2; ++i) va[h][i] = (unsigned)((u.pm * BM + h * HALF + Rr[i]) * rowb + Cc[i] * 2); }
};
struct InSched : DenseSched {
    __device__ void init2(const void* Bt_, int G_, int c_) { init(L, 8448, 1024, 1024, Bt_, G_, c_); }
    __device__ __forceinline__ bool next(int i, Unit& u) const {
        const int Lx = i * G + c; const int nlat = nwg;
        if (Lx < nlat) { tile(xcd_remap(Lx, nlat), u.pm, u.pn); }
        else { const int j = Lx - nlat; if (j >= 16 * 14) return false; const int q = j >> 4; u.pm = 128 + (j & 15); u.pn = q == 0 ? 3 : (q <= 12 ? 7 + q : 32); }
        u.b = Bt + (size_t)u.pn * btile; u.e = 0; u.pos0 = 0; u.cnt = 0; return true; }
};
__device__ __forceinline__ unsigned act_piece_off(int r, int c16) { const int s = 2 * (r >> 7) + (c16 >> 2), w = 4 * ((r >> 6) & 1) + (c16 & 3), l = 16 * ((r >> 4) & 3) + (r & 15); return (unsigned)(((s * 8 + w) * 64 + l) * 16); }
template <bool GATHER> struct MoeSched {
    int nN, G, c, rowb; const char* Wt; size_t wexp, btile; const LAS int* tab; const int* list;
    static constexpr bool GATHER_LDS = GATHER;
    __device__ __forceinline__ int kstepA() const { return GATHER ? 128 : 32768; }
    __device__ __forceinline__ bool next(int i, Unit& u) const {
        const int nwg = tab[33] * nN; const int Lx = i * G + c; if (Lx >= nwg) return false;
        const int w = xcd_remap(Lx, nwg); const int rt = w / nN; u.pn = w % nN; u.pm = rt;
        const int e = tab[128 + rt];
        u.e = e; u.pos0 = (rt - tab[e]) * BM; u.cnt = tab[64 + e]; u.b = Wt + (size_t)e * wexp + (size_t)u.pn * btile; return true; }
    __device__ __forceinline__ void aoff(const Unit& u, const int (&Rr)[2], const int (&Cc)[2], unsigned (&va)[2][2]) const {
#pragma unroll
        for (int h = 0; h < 2; ++h)
#pragma unroll
            for (int i = 0; i < 2; ++i) {
                if (GATHER) { const int pos = u.pos0 + h * HALF + Rr[i]; const int pair = pos < u.cnt ? list[u.e * CAP + pos] : 0; va[h][i] = (unsigned)((pair >> 2) * rowb + Cc[i] * 2); }
                else va[h][i] = (unsigned)u.pm * 262144u + act_piece_off(h * HALF + Rr[i], Cc[i] >> 3); } }
};

typedef int v8i_t __attribute__((ext_vector_type(8)));
typedef int i32x4_t __attribute__((ext_vector_type(4)));
template <class Epi, class Sched, bool FP8 = false, int SCA = 127, int SCB = 127>
__device__ __forceinline__ void gemm_phase(LAS unsigned char* lds, const char* Abase, const int K, const Sched& S, const Epi& E) {
    const int tid = otid(), wid = __builtin_amdgcn_readfirstlane(tid >> 6), lane = tid & 63, wr = wid >> 2, wc = wid & 3, fr = lane & 15, fq = lane >> 4;
    const int Kb = FP8 ? K : 2 * K;
    const int nt = Kb / (BK * 2);
    int Rr[2], Cc[2]; unsigned voffB[2];
#pragma unroll
    for (int i = 0; i < 2; ++i) { int R_, C_; stage_rc(tid * 16 + i * 8192, R_, C_); Rr[i] = R_; Cc[i] = C_; const int Rb = 64 * (R_ >> 5) + (Epi::PERM ? perm32(R_ & 31) : (R_ & 31)); voffB[i] = (unsigned)(Rb * Kb + C_ * 2); }
    const size_t kstep = (size_t)(BK * 2);
    const size_t kstepA = (size_t)S.kstepA();
    const size_t hstep = (size_t)32 * Kb;
    const unsigned ldsw = (unsigned)wid * 1024u;
    const int aoff = lds_byte(wr * 64 + fr, fq * 8), boff = lds_byte(wc * 32 + fr, fq * 8);
#define PG8_SA(b, h) (((b) * 2 + (h)) * HTB)
#define PG8_SB(b, h) ((4 + (b) * 2 + (h)) * HTB)
#define PG8_STAGE_B(bufoff, gbase) do { _Pragma("unroll") for (int _i = 0; _i < 2; ++_i) \
        __builtin_amdgcn_global_load_lds((const unsigned*)((const char*)(gbase) + voffB[_i]), (LAS unsigned*)(lds + (bufoff) + ldsw + _i * 8192), 16, 0, 0); } while (0)
#define PG8_STAGE_A(bufoff, v0, v1, kb) do { \
        __builtin_amdgcn_global_load_lds((const unsigned*)(Abase + (kb) + (v0)), (LAS unsigned*)(lds + (bufoff) + ldsw), 16, 0, 0); \
        __builtin_amdgcn_global_load_lds((const unsigned*)(Abase + (kb) + (v1)), (LAS unsigned*)(lds + (bufoff) + ldsw + 8192), 16, 0, 0); } while (0)
#define PG8_LD16(addr) (*(const LAS i32x4_t*)(addr))
#define PG8_LDA(dst, b, h) do { _Pragma("unroll") for (int m = 0; m < 4; ++m) { if constexpr (FP8) dst##8[m] = __builtin_shufflevector(PG8_LD16(lds + PG8_SA(b, h) + aoff + m * 2048), PG8_LD16(lds + PG8_SA(b, h) + aoff + m * 2048 + 1024), 0, 1, 2, 3, 4, 5, 6, 7); \
        else { _Pragma("unroll") for (int k = 0; k < 2; ++k) dst[m][k] = *(const LAS bf16x8*)(lds + PG8_SA(b, h) + aoff + m * 2048 + k * 1024); } } } while (0)
#define PG8_LDB(dst, b, h) do { _Pragma("unroll") for (int n = 0; n < 2; ++n) { if constexpr (FP8) dst##8[n] = __builtin_shufflevector(PG8_LD16(lds + PG8_SB(b, h) + boff + n * 2048), PG8_LD16(lds + PG8_SB(b, h) + boff + n * 2048 + 1024), 0, 1, 2, 3, 4, 5, 6, 7); \
        else { _Pragma("unroll") for (int k = 0; k < 2; ++k) dst[n][k] = *(const LAS bf16x8*)(lds + PG8_SB(b, h) + boff + n * 2048 + k * 1024); } } } while (0)
#define PG8_MMA(ai, bj, At, Bt) do { __builtin_amdgcn_s_setprio(1); _Pragma("unroll") for (int m = 0; m < 4; ++m) _Pragma("unroll") for (int n = 0; n < 2; ++n) { \
        if constexpr (FP8) asm volatile("v_mfma_scale_f32_16x16x128_f8f6f4 %0, %1, %2, %0, %3, %4 op_sel_hi:[0,0,0]" : "+v"(acc[ai][bj][m][n]) : "v"(Bt##8[n]), "v"(At##8[m]), "v"(scb_), "v"(sca_)); \
        else { _Pragma("unroll") for (int k = 0; k < 2; ++k) acc[ai][bj][m][n] = __builtin_amdgcn_mfma_f32_16x16x32_bf16(Bt[n][k], At[m][k], acc[ai][bj][m][n], 0, 0, 0); } } \
        __builtin_amdgcn_s_setprio(0); } while (0)
#define PG8_WAIT_V(n) asm volatile("s_waitcnt vmcnt(" #n ")" ::: "memory")
#define PG8_WAIT_L(n) asm volatile("s_waitcnt lgkmcnt(" #n ")" ::: "memory")
#define PG8_BAR __builtin_amdgcn_s_barrier()
#define PG8_SCHED __builtin_amdgcn_sched_barrier(0)
    Unit cur, nxt; int ui = 0;
    if (!S.next(0, cur)) return;
    f32x4 acc[2][2][4][2];
#pragma unroll
    for (int a = 0; a < 2; ++a)
#pragma unroll
        for (int b = 0; b < 2; ++b)
#pragma unroll
            for (int m = 0; m < 4; ++m)
#pragma unroll
                for (int n = 0; n < 2; ++n) acc[a][b][m][n] = (f32x4){0.f, 0.f, 0.f, 0.f};
    const int sca_ = SCA, scb_ = SCB;
    bf16x8 At[4][2], B0[2][2], B1[2][2]; v8i_t At8[4], B08[2], B18[2];
    unsigned vc[2][2], vn[2][2];
    S.aoff(cur, Rr, Cc, vc);
    const char* cB = cur.b;
    PG8_STAGE_B(PG8_SB(0, 0), cB); PG8_STAGE_A(PG8_SA(0, 0), vc[0][0], vc[0][1], 0); PG8_STAGE_B(PG8_SB(0, 1), cB + hstep); PG8_STAGE_A(PG8_SA(0, 1), vc[1][0], vc[1][1], 0);
    if (wr == 1) PG8_BAR;
    PG8_WAIT_V(4); PG8_BAR;
    PG8_STAGE_B(PG8_SB(1, 0), cB + kstep); PG8_STAGE_A(PG8_SA(1, 0), vc[0][0], vc[0][1], kstepA); PG8_STAGE_B(PG8_SB(1, 1), cB + hstep + kstep);
    PG8_WAIT_V(6); PG8_BAR;
    for (;;) {
        const bool has_next = S.next(ui + 1, nxt);
        if constexpr (Sched::GATHER_LDS) {
            if (has_next && wid < 4) __builtin_amdgcn_global_load_lds((const unsigned*)(S.list + nxt.e * CAP + nxt.pos0 + tid), (LAS unsigned*)(lds + LDS_IDX + wid * 256), 4, 0, 0);
        } else if (has_next) S.aoff(nxt, Rr, Cc, vn);
        if (!has_next) {
#pragma unroll
            for (int h = 0; h < 2; ++h)
#pragma unroll
                for (int i = 0; i < 2; ++i) vn[h][i] = vc[h][i]; }
        const char* nB = has_next ? nxt.b : cB;
#pragma unroll 1
        for (int t = 0; t < nt; t += 2) {
            const bool last = (t == nt - 2);
            if constexpr (Sched::GATHER_LDS) { if (last && has_next) {
#pragma unroll
                for (int h = 0; h < 2; ++h)
#pragma unroll
                    for (int i = 0; i < 2; ++i) { const int rr = h * HALF + Rr[i]; const int pair = (nxt.pos0 + rr) < nxt.cnt ? ((const LAS int*)(lds + LDS_IDX))[rr] : 0; vn[h][i] = (unsigned)((pair >> 2) * S.rowb + Cc[i] * 2); } } }
            const size_t k1 = (size_t)(t + 1) * kstepA;
            const size_t k2 = last ? 0 : (size_t)(t + 2) * kstepA;
            const unsigned s00 = last ? vn[0][0] : vc[0][0], s01 = last ? vn[0][1] : vc[0][1], s10 = last ? vn[1][0] : vc[1][0], s11 = last ? vn[1][1] : vc[1][1];
            const char* b2 = last ? nB : cB + (size_t)(t + 2) * kstep; const char* b3 = b2 + kstep;
            PG8_LDB(B0, 0, 0); PG8_SCHED; PG8_LDA(At, 0, 0); PG8_STAGE_A(PG8_SA(1, 1), vc[1][0], vc[1][1], k1);
            PG8_WAIT_L(8); PG8_BAR; PG8_WAIT_L(0); PG8_MMA(0, 0, At, B0); PG8_BAR; PG8_SCHED;
            PG8_LDB(B1, 0, 1); PG8_STAGE_B(PG8_SB(0, 0), b2);
            PG8_BAR; PG8_WAIT_L(0); PG8_MMA(0, 1, At, B1); PG8_BAR; if constexpr (FP8) PG8_SCHED;
            PG8_LDA(At, 0, 1); PG8_STAGE_A(PG8_SA(0, 0), s00, s01, k2);
            PG8_BAR; PG8_WAIT_L(0); PG8_MMA(1, 0, At, B0); PG8_BAR; PG8_SCHED;
            PG8_STAGE_B(PG8_SB(0, 1), b2 + hstep);
            PG8_WAIT_V(6); PG8_BAR; PG8_MMA(1, 1, At, B1); PG8_BAR; if constexpr (FP8) PG8_SCHED;
            PG8_LDB(B0, 1, 0); PG8_SCHED; PG8_LDA(At, 1, 0); PG8_STAGE_A(PG8_SA(0, 1), s10, s11, k2);
            PG8_WAIT_L(8); PG8_BAR; PG8_WAIT_L(0); PG8_MMA(0, 0, At, B0); PG8_BAR; PG8_SCHED;
            PG8_LDB(B1, 1, 1); PG8_STAGE_B(PG8_SB(1, 0), b3);
            PG8_BAR; PG8_WAIT_L(0); PG8_MMA(0, 1, At, B1); PG8_BAR; if constexpr (FP8) PG8_SCHED;
            PG8_LDA(At, 1, 1); PG8_STAGE_A(PG8_SA(1, 0), s00, s01, k2 + kstepA);
            PG8_BAR; PG8_WAIT_L(0); PG8_MMA(1, 0, At, B0); PG8_BAR; PG8_SCHED;
            PG8_STAGE_B(PG8_SB(1, 1), b3 + hstep);
            PG8_WAIT_V(6); PG8_BAR; PG8_MMA(1, 1, At, B1); PG8_BAR; if constexpr (FP8) PG8_SCHED;
        }
        if constexpr (FP8) asm volatile("s_nop 15\n\ts_nop 15" ::: "memory");
        E(acc, cur, wr, wc, fr, fq);
        if (!has_next) break;
#pragma unroll
        for (int a = 0; a < 2; ++a)
#pragma unroll
            for (int b = 0; b < 2; ++b)
#pragma unroll
                for (int m = 0; m < 4; ++m)
#pragma unroll
                    for (int n = 0; n < 2; ++n) acc[a][b][m][n] = (f32x4){0.f, 0.f, 0.f, 0.f};
        cur = nxt; cB = nB; ++ui;
#pragma unroll
        for (int h = 0; h < 2; ++h)
#pragma unroll
            for (int i = 0; i < 2; ++i) vc[h][i] = vn[h][i];
    }
    PG8_WAIT_V(0);
    if (wr == 0) PG8_BAR;
    PG8_BAR;
#undef PG8_SA
#undef PG8_SB
#undef PG8_STAGE_A
#undef PG8_STAGE_B
#undef PG8_LDA
#undef PG8_LDB
#undef PG8_MMA
#undef PG8_WAIT_V
#undef PG8_WAIT_L
#undef PG8_BAR
#undef PG8_SCHED
}

typedef f32x4 Acc[2][2][4][2];
__device__ __forceinline__ unsigned dpp_ror8(unsigned x) { return (unsigned)__builtin_amdgcn_update_dpp(0, (int)x, 0x128, 0xf, 0xf, false); }
__device__ __forceinline__ u32x4 ror8_4(const u32x4 v) { u32x4 r; r.x = dpp_ror8(v.x); r.y = dpp_ror8(v.y); r.z = dpp_ror8(v.z); r.w = dpp_ror8(v.w); return r; }
__device__ __forceinline__ void line_xy(const u32x4 a, const u32x4 b, bool lo, u32x4& X, u32x4& Y) { const u32x4 ra = ror8_4(a), rb = ror8_4(b); X = lo ? a : rb; Y = lo ? ra : b; }
__device__ __forceinline__ u32x4 pack8(const f32x4 v0, const f32x4 v1) { u32x4 w; w.x = cvt_pk_bf16(v0[0], v0[1]); w.y = cvt_pk_bf16(v0[2], v0[3]); w.z = cvt_pk_bf16(v1[0], v1[1]); w.w = cvt_pk_bf16(v1[2], v1[3]); return w; }

struct EpiIn { static constexpr bool PERM = true; char* ws;
    __device__ __forceinline__ void operator()(const Acc& acc, const Unit& u, int wr, int wc, int fr, int fq) const {
        const int pn = u.pn; size_t boff; int ld, cb;
        if (pn < 3) { boff = OFF_QA; ld = 384; cb = pn * 128; } else if (pn == 3) { boff = OFF_CKV; ld = 256; cb = 0; }
        else if (pn < 32) { boff = OFF_HQ + (size_t)((pn - 4) >> 2) * SEG_STRIDE; ld = 1024; cb = ((pn - 4) & 3) * 256; }
        else { boff = OFF_KR; ld = 64; cb = 0; }
        bf16_t* base = (bf16_t*)(ws + boff);
        if (pn == 32 && wc != 0) return;
        const bool lo = fr < 8; const int rowb0 = u.pm * BM + wr * 64, rx = fr & 7, colx = cb + wc * 64 + (fr >> 3) * 32 + 8 * fq;
        float* ssq = (float*)(ws + (pn < 3 ? OFF_SSQQ : OFF_SSQKV));
#pragma unroll
        for (int ai = 0; ai < 2; ++ai)
#pragma unroll
            for (int m = 0; m < 4; ++m) { const int rg = rowb0 + ai * HALF + m * 16;
                f32x4 v0 = acc[ai][0][m][0], v1 = acc[ai][0][m][1], w0 = acc[ai][1][m][0], w1 = acc[ai][1][m][1];
                if (pn >= 4 && pn < 8) {
#pragma unroll
                    for (int j = 0; j < 4; ++j) { v0[j] = siluf_(v0[j]) * 0.08838834764831845f; v1[j] = siluf_(v1[j]) * 0.08838834764831845f; w0[j] = siluf_(w0[j]) * 0.08838834764831845f; w1[j] = siluf_(w1[j]) * 0.08838834764831845f; } }
                if (pn < 3 || (pn >= 20 && pn < 32)) { unsigned char* qrow = pn < 3 ? (unsigned char*)base + (size_t)(rg + fr) * 768 + pn * 256 + wc * 64 + 8 * fq : (unsigned char*)base + (size_t)(rg + fr) * 1024 + (pn & 3) * 256 + wc * 64 + 8 * fq;
                    u32x2 a8; a8.x = pack4_fp8(v0[0], v0[1], v0[2], v0[3]); a8.y = pack4_fp8(v1[0], v1[1], v1[2], v1[3]); u32x2 b8; b8.x = pack4_fp8(w0[0], w0[1], w0[2], w0[3]); b8.y = pack4_fp8(w1[0], w1[1], w1[2], w1[3]);
                    *(u32x2*)qrow = a8; *(u32x2*)(qrow + 32) = b8; }
                else { u32x4 X, Y; line_xy(pack8(v0, v1), pack8(w0, w1), lo, X, Y);
                    __builtin_nontemporal_store(X, (u32x4*)(base + (size_t)(rg + rx) * ld + colx)); __builtin_nontemporal_store(Y, (u32x4*)(base + (size_t)(rg + 8 + rx) * ld + colx)); }
                if (pn <= 3) { float ss = (v0[0] * v0[0] + v0[1] * v0[1]) + (v0[2] * v0[2] + v0[3] * v0[3]) + (v1[0] * v1[0] + v1[1] * v1[1]) + (v1[2] * v1[2] + v1[3] * v1[3])
                                        + (w0[0] * w0[0] + w0[1] * w0[1]) + (w0[2] * w0[2] + w0[3] * w0[3]) + (w1[0] * w1[0] + w1[1] * w1[1]) + (w1[2] * w1[2] + w1[3] * w1[3]);
                    ss += __shfl_xor(ss, 16); ss += __shfl_xor(ss, 32); if (fq == 0) atomicAdd(ssq + rg + fr, ss); } }
    } };

struct EpiQ { static constexpr bool PERM = true; bf16_t* q; const float* ssq;
    __device__ __forceinline__ void operator()(const Acc& acc, const Unit& u, int wr, int wc, int fr, int fq) const {
        const bool lo = fr < 8; const int rowb0 = u.pm * BM + wr * 64, rx = fr & 7, colx = u.pn * BM + wc * 64 + (fr >> 3) * 32 + 8 * fq;
#pragma unroll
        for (int ai = 0; ai < 2; ++ai)
#pragma unroll
            for (int m = 0; m < 4; ++m) { const int rg = rowb0 + ai * HALF + m * 16; const float rs = rsqrtf(ssq[rg + fr] * (1.0f / 768.0f) + EPS);
                u32x4 X, Y; line_xy(pack8(acc[ai][0][m][0] * rs, acc[ai][0][m][1] * rs), pack8(acc[ai][1][m][0] * rs, acc[ai][1][m][1] * rs), lo, X, Y);
                *(u32x4*)(q + (size_t)(rg + rx) * 1536 + colx) = X; *(u32x4*)(q + (size_t)(rg + 8 + rx) * 1536 + colx) = Y; }
    } };

struct EpiKV { static constexpr bool PERM = true; bf16_t *Kb, *Vb; const float* ssq;
    __device__ __forceinline__ size_t kvrow(int row, int h) const { int b, pos; if (row < L) { b = row >> 11; pos = row & 2047; } else { b = (row - L) >> 8; pos = SEQ + ((row - L) & 255); } return (size_t)(b * 8 + h) * NKEY + pos; }
    __device__ __forceinline__ void operator()(const Acc& acc, const Unit& u, int wr, int wc, int fr, int fq) const {
        const bool lo = fr < 8; const int rowb0 = u.pm * BM + wr * 64, rx = fr & 7, colx = (wc & 1) * 64 + (fr >> 3) * 32 + 8 * fq;
        bf16_t* dst = wc < 2 ? Kb : Vb; const int ld = wc < 2 ? 192 : 128;
#pragma unroll
        for (int ai = 0; ai < 2; ++ai)
#pragma unroll
            for (int m = 0; m < 4; ++m) { const int rg = rowb0 + ai * HALF + m * 16; const float rs = rsqrtf(ssq[rg + fr] * (1.0f / 256.0f) + EPS);
                u32x4 X, Y; line_xy(pack8(acc[ai][0][m][0] * rs, acc[ai][0][m][1] * rs), pack8(acc[ai][1][m][0] * rs, acc[ai][1][m][1] * rs), lo, X, Y);
                *(u32x4*)(dst + kvrow(rg + rx, u.pn) * ld + colx) = X; *(u32x4*)(dst + kvrow(rg + 8 + rx, u.pn) * ld + colx) = Y; }
    } };

struct EpiOut { static constexpr bool PERM = true; bf16_t* x1; const float* x; const float* modv;
    __device__ __forceinline__ void operator()(const Acc& acc, const Unit& u, int wr, int wc, int fr, int fq) const {
        const bool lo = fr < 8; const int rowb0 = u.pm * BM + wr * 64, rx = fr & 7, colx = u.pn * BM + wc * 64 + (fr >> 3) * 32 + 8 * fq, cown = u.pn * BM + wc * 64 + 8 * fq;
#pragma unroll
        for (int ai = 0; ai < 2; ++ai)
#pragma unroll
            for (int m = 0; m < 4; ++m) { const int rg = rowb0 + ai * HALF + m * 16, row = rg + fr; const float* gate = modv + (row >> 11) * 6144 + 2 * 1024 + cown; const float* xr = x + (size_t)row * D + cown;
                f32x4 r[2][2];
#pragma unroll
                for (int bj = 0; bj < 2; ++bj)
#pragma unroll
                    for (int n = 0; n < 2; ++n) r[bj][n] = *(const f32x4*)(xr + bj * 32 + 4 * n) + *(const f32x4*)(gate + bj * 32 + 4 * n) * acc[ai][bj][m][n];
                u32x4 X, Y; line_xy(pack8(r[0][0], r[0][1]), pack8(r[1][0], r[1][1]), lo, X, Y);
                *(u32x4*)(x1 + (size_t)(rg + rx) * D + colx) = X; *(u32x4*)(x1 + (size_t)(rg + 8 + rx) * D + colx) = Y; }
    } };

struct EpiMoe1 { static constexpr bool PERM = true; unsigned char* act; const float* bgu;
    __device__ __forceinline__ void operator()(const Acc& acc, const Unit& u, int wr, int wc, int fr, int fq) const {
        const int o0 = u.pn * 128 + wc * 16 + 4 * fq;
        f32x4 bg[2], bl[2];
#pragma unroll
        for (int bj = 0; bj < 2; ++bj) { const float* bp = bgu + u.e * 2048 + 2 * (o0 + bj * 64); const f32x4 t0 = *(const f32x4*)bp, t1 = *(const f32x4*)(bp + 4);
            bg[bj] = (f32x4){t0[0], t0[2], t1[0], t1[2]}; bl[bj] = (f32x4){t0[1], t0[3], t1[1], t1[3]}; }
        unsigned char* blk = act + ((size_t)u.pm * 8 + u.pn) * 32768 + (size_t)(wr * 4 + wc) * 1024 + (size_t)(fq * 16 + fr) * 16;
#pragma unroll
        for (int ai = 0; ai < 2; ++ai)
#pragma unroll
            for (int bj = 0; bj < 2; ++bj) { unsigned d[4];
#pragma unroll
                for (int m = 0; m < 4; ++m) { const f32x4 g4 = acc[ai][bj][m][0] + bg[bj], l4 = acc[ai][bj][m][1] + bl[bj]; float r[4];
#pragma unroll
                    for (int j = 0; j < 4; ++j) { const float glu = fminf(g4[j], 7.0f), lin = __builtin_amdgcn_fmed3f(l4[j], -7.0f, 7.0f); r[j] = 4.0f * glu * __builtin_amdgcn_rcpf(1.0f + __builtin_amdgcn_exp2f(-2.4554669595930157f * glu)) * (lin + 1.0f); }
                    d[m] = pack4_fp8(r[0], r[1], r[2], r[3]); }
                const auto s01 = __builtin_amdgcn_permlane16_swap(d[0], d[1], false, false); const auto s23 = __builtin_amdgcn_permlane16_swap(d[2], d[3], false, false);
                const auto t02 = __builtin_amdgcn_permlane32_swap(s01[0], s23[0], false, false); const auto t13 = __builtin_amdgcn_permlane32_swap(s01[1], s23[1], false, false);
                *(u32x4*)(blk + (size_t)(ai * 2 + bj) * 8192) = (u32x4){t02[0], t13[0], t02[1], t13[1]}; }
    } };

struct EpiMoe2 { static constexpr bool PERM = true; bf16_t* yp; const float* bd;
    __device__ __forceinline__ void operator()(const Acc& acc, const Unit& u, int wr, int wc, int fr, int fq) const {
        const bool lo = fr < 8; const int rowb0 = u.pm * BM + wr * 64, rx = fr & 7, colx = u.pn * BM + wc * 64 + (fr >> 3) * 32 + 8 * fq, cown = u.pn * BM + wc * 64 + 8 * fq;
        f32x4 bv[2][2];
#pragma unroll
        for (int bj = 0; bj < 2; ++bj)
#pragma unroll
            for (int n = 0; n < 2; ++n) bv[bj][n] = *(const f32x4*)(bd + u.e * 1024 + cown + bj * 32 + 4 * n);
#pragma unroll
        for (int ai = 0; ai < 2; ++ai)
#pragma unroll
            for (int m = 0; m < 4; ++m) { const int rg = rowb0 + ai * HALF + m * 16;
                u32x4 X, Y; line_xy(pack8(acc[ai][0][m][0] + bv[0][0], acc[ai][0][m][1] + bv[0][1]), pack8(acc[ai][1][m][0] + bv[1][0], acc[ai][1][m][1] + bv[1][1]), lo, X, Y);
                __builtin_nontemporal_store(X, (u32x4*)(yp + (size_t)(rg + rx) * D + colx)); __builtin_nontemporal_store(Y, (u32x4*)(yp + (size_t)(rg + 8 + rx) * D + colx)); }
    } };
}

__device__ __forceinline__ int conv_src_col(int kind, int c) {
    if (kind == 0) return c;
    if (kind == 1) { if (c < 1024) return c; if (c < 8192) return c + 64; if (c < 8256) return c - 8192 + 1024; return -1; }
    const int pn = c >> 8, p = c & 255, wc = p >> 6, bj = (p >> 5) & 1, fq = (p >> 3) & 3, n = (p >> 2) & 1, i = p & 3; const int o = 128 * pn + 64 * bj + 16 * wc + 4 * fq + i; return 2 * o + n;
}
template <bool F8> struct ConvPipe {
    float v[32]; bool have; bf16_t* dummy;
    int K, kind, k0, c0; void* Wt;
    __device__ __forceinline__ void issue(const float* __restrict__ W, int ldw, void* Wt_, int K_, int kind_, const float* __restrict__ kscale, int k0_, int c0_) {
        const int tid = otid(); const int cc = tid & 127, kq = tid >> 7, sc = conv_src_col(kind_, c0_ + cc);
        const int scc = sc < 0 ? 0 : sc; const float* wp = W + (size_t)(k0_ + kq) * ldw + scc;
#pragma unroll
        for (int i = 0; i < 32; ++i) v[i] = __builtin_nontemporal_load(wp + (size_t)(4 * i) * ldw);
        if (sc < 0) {
#pragma unroll
            for (int i = 0; i < 32; ++i) v[i] = 0.f; }
        if (kscale) {
#pragma unroll
            for (int i = 0; i < 32; ++i) v[i] *= kscale[k0_ + kq + 4 * i]; }
        K = K_; kind = kind_; k0 = k0_; c0 = c0_; Wt = Wt_; have = true;
    }
    __device__ __forceinline__ void flush(LAS float* tl) {
        if (!have) return; have = false;
        const int tid = otid(); const int cc = tid & 127, kq = tid >> 7;
        __syncthreads();
#pragma unroll
        for (int i = 0; i < 32; ++i) tl[(kq + 4 * i) * 129 + cc] = v[i];
        __syncthreads();
        stash(tl, tid);
    }
    __device__ __forceinline__ void to_lds(LAS float* tl) { const int tid = otid(); const int cc = tid & 127, kq = tid >> 7; __syncthreads();
#pragma unroll
        for (int i = 0; i < 32; ++i) tl[(kq + 4 * i) * 129 + cc] = v[i];
        __syncthreads(); }
    __device__ __forceinline__ void stash(LAS float* tl, int tid) const {
        if constexpr (F8) {
#pragma unroll
            for (int pss = 0; pss < 2; ++pss) { const int item = tid + 512 * pss, c2 = item >> 3, ch = item & 7; float t[16];
#pragma unroll
                for (int j = 0; j < 16; ++j) t[j] = tl[(16 * ch + j) * 129 + c2] * 32.f;
                u32x4 w; w.x = pack4_fp8(t[0], t[1], t[2], t[3]); w.y = pack4_fp8(t[4], t[5], t[6], t[7]); w.z = pack4_fp8(t[8], t[9], t[10], t[11]); w.w = pack4_fp8(t[12], t[13], t[14], t[15]);
                *(u32x4*)((unsigned char*)Wt + (size_t)(c0 + c2) * K + k0 + 16 * ch) = w; }
        } else {
#pragma unroll
            for (int pss = 0; pss < 4; ++pss) { const int item = tid + 512 * pss, c2 = item >> 4, ch = item & 15; float t[8];
#pragma unroll
                for (int j = 0; j < 8; ++j) t[j] = tl[(8 * ch + j) * 129 + c2];
                u32x4 w; w.x = cvt_pk_bf16(t[0], t[1]); w.y = cvt_pk_bf16(t[2], t[3]); w.z = cvt_pk_bf16(t[4], t[5]); w.w = cvt_pk_bf16(t[6], t[7]);
                *(u32x4*)((bf16_t*)Wt + (size_t)(c0 + c2) * K + k0 + 8 * ch) = w; }
        }
    }
};
template <bool F8>
__device__ __forceinline__ void conv_matrix(LAS float* tl, ConvPipe<F8>& pipe, const float* W, int ldw, void* Wt, int K, int Nout, int kind, const float* kscale, int& tctr) {
    const int nk = K / 128, ntile = nk * (Nout / 128);
    int t = ((int)blockIdx.x - tctr) % (int)gridDim.x; if (t < 0) t += gridDim.x;
    for (; t < ntile; t += gridDim.x) {
        if (pipe.have) { pipe.to_lds(tl); const int K0 = pipe.K, k00 = pipe.k0, c00 = pipe.c0; void* W0 = pipe.Wt; ConvPipe<F8> done = pipe; (void)K0; (void)k00; (void)c00; (void)W0;
            pipe.issue(W, ldw, Wt, K, kind, kscale, (t % nk) * 128, (t / nk) * 128); done.stash(tl, otid()); }
        else pipe.issue(W, ldw, Wt, K, kind, kscale, (t % nk) * 128, (t / nk) * 128);
    }
    tctr = (tctr + ntile) % (int)gridDim.x;
}
template <bool F8> __device__ __forceinline__ void conv_finish(LAS float* tl, ConvPipe<F8>& pipe) { if (pipe.have) { pipe.to_lds(tl); pipe.stash(tl, otid()); pipe.have = false; } __syncthreads(); }

__device__ __forceinline__ float half_sum256(float v, LAS float* red) {
    for (int o = 32; o > 0; o >>= 1) v += __shfl_xor(v, o);
    const int w = otid() >> 6, hb = (otid() >> 8) * 4; if ((otid() & 63) == 0) red[w] = v; __syncthreads();
    const float t = red[hb] + red[hb + 1] + red[hb + 2] + red[hb + 3]; __syncthreads(); return t;
}

__device__ __forceinline__ void phase0(const Params& p, LAS unsigned char* lds) {
    char* ws = p.ws; const int tid = otid(), gsz = gridDim.x * 512, gid = blockIdx.x * 512 + tid;
    float* lb = (float*)(ws + OFF_LB); int* cnt = (int*)(ws + OFF_CNT); float* ssqq = (float*)(ws + OFF_SSQQ); float* ssqkv = (float*)(ws + OFF_SSQKV); float* modv = (float*)(ws + OFF_MOD);
    for (int i = gid; i < 2048; i += gsz) { const int d = i >> 10, j = i & 1023; const float a = p.lbl[(d * 2 + 0) * 1024 + j], b = p.lbl[(d * 2 + 1) * 1024 + j]; lb[i] = 1.0f / (1.0f + __expf(b - a)); }
    for (int i = gid; i < 32; i += gsz) cnt[i] = 0;
    { float* ropet = (float*)(ws + OFF_ROPE); for (int i = gid; i < SEQ * 32; i += gsz) { const int t = i >> 5, j = i & 31; float cs, sn; rope_cs(t, j, cs, sn); ropet[t * 64 + j] = cs; ropet[t * 64 + 32 + j] = sn; } }
    for (int i = gid; i < L; i += gsz) ssqq[i] = 0.f;
    for (int i = gid; i < R; i += gsz) ssqkv[i] = 0.f;
    { LAS float* sil = (LAS float*)lds;
      LAS float* part = (LAS float*)(lds + 17 * 1024 * 4);
      bool loaded = false;
      for (int item = blockIdx.x; item < 96; item += gridDim.x) {
          if (!loaded) { for (int i = tid; i < 17 * 1024; i += 512) { const int r = i >> 10, k = i & 1023; sil[i] = siluf_(r < 16 ? p.c[r * 1024 + k] : p.cctx[k]); } loaded = true; __syncthreads(); }
          const int j = tid & 63, ks = tid >> 6; float a[17];
#pragma unroll
          for (int r = 0; r < 17; ++r) a[r] = 0.f;
          for (int k = ks * 128; k < ks * 128 + 128; ++k) { const float w = p.w_mod[(size_t)k * 6144 + item * 64 + j];
#pragma unroll
              for (int r = 0; r < 17; ++r) a[r] += sil[r * 1024 + k] * w; }
#pragma unroll
          for (int r = 0; r < 17; ++r) part[(ks * 17 + r) * 64 + j] = a[r];
          __syncthreads();
          for (int i = tid; i < 17 * 64; i += 512) { const int r = i >> 6, jj = i & 63; float s = p.b_mod[item * 64 + jj]; for (int q = 0; q < 8; ++q) s += part[(q * 17 + r) * 64 + jj]; modv[r * 6144 + item * 64 + jj] = s; }
          __syncthreads();
      } }
    __syncthreads();
    { LAS float* tl = (LAS float*)lds; int tctr = 0;
      { ConvPipe<true> pp; pp.have = false; conv_matrix<true>(tl, pp, p.w_in, 8256, (unsigned char*)(ws + OFF_WT_IN), 1024, 8448, 1, nullptr, tctr); conv_finish<true>(tl, pp); }
      { ConvPipe<true> pp; pp.have = false;
        conv_matrix<true>(tl, pp, p.w_qb, 1536, (unsigned char*)(ws + OFF_WT_QB), 768, 1536, 0, p.g_q, tctr);
        conv_matrix<true>(tl, pp, p.w_out, 1024, (unsigned char*)(ws + OFF_WT_OUT), 1024, 1024, 0, nullptr, tctr); conv_finish<true>(tl, pp); }
      { ConvPipe<false> pp; pp.have = false;
        conv_matrix<false>(tl, pp, p.w_kvb, 2048, (bf16_t*)(ws + OFF_WT_KVB), 256, 2048, 0, p.g_kv, tctr); conv_finish<false>(tl, pp); } }
}

__device__ __forceinline__ float wave_sum(float v) {
#pragma unroll
    for (int o = 32; o > 0; o >>= 1) v += __shfl_xor(v, o);
    return v; }
__device__ __forceinline__ void phase1(const Params& p, LAS unsigned char* lds) {
    const float* modv = (const float*)(p.ws + OFF_MOD); unsigned char* h = (unsigned char*)(p.ws + OFF_H);
    const int tid = otid(), lane = tid & 63, gw = blockIdx.x * 8 + (tid >> 6), nw = gridDim.x * 8, c0 = lane * 8;
    f32x4 g[4];
#pragma unroll
    for (int q = 0; q < 4; ++q) g[q] = *(const f32x4*)(p.g_mix + (q >> 1) * 512 + c0 + (q & 1) * 4);
    for (int row0 = gw; row0 < R; row0 += 2 * nw) {
        f32x4 v[2][4]; const bool two = row0 + nw < R;
#pragma unroll
        for (int u = 0; u < 2; ++u) { const int row = (u == 0 || two) ? row0 + u * nw : row0; const float* src = row < L ? p.x + (size_t)row * D : p.ctx + (size_t)(row - L) * D;
#pragma unroll
            for (int q = 0; q < 4; ++q) v[u][q] = __builtin_nontemporal_load((const f32x4*)(src + (q >> 1) * 512 + c0 + (q & 1) * 4)); }
#pragma unroll
        for (int u = 0; u < 2; ++u) { if (u == 1 && !two) break; const int row = row0 + u * nw; const float* mod = modv + (row < L ? row / SEQ : 16) * 6144;
            float ss = 0.f;
#pragma unroll
            for (int q = 0; q < 4; ++q) ss += (v[u][q][0] * v[u][q][0] + v[u][q][1] * v[u][q][1]) + (v[u][q][2] * v[u][q][2] + v[u][q][3] * v[u][q][3]);
            const float rs = rsqrtf(wave_sum(ss) * (1.0f / D) + EPS);
#pragma unroll
            for (int j = 0; j < 2; ++j) { f32x4 o[2];
#pragma unroll
                for (int e = 0; e < 2; ++e) { const int cc = j * 512 + c0 + e * 4; const f32x4 sc = *(const f32x4*)(mod + 1024 + cc), sh = *(const f32x4*)(mod + cc); o[e] = v[u][j * 2 + e] * rs * g[j * 2 + e] * (sc + 1.0f) + sh; }
                u32x2 w; w.x = pack4_fp8(o[0][0], o[0][1], o[0][2], o[0][3]); w.y = pack4_fp8(o[1][0], o[1][1], o[1][2], o[1][3]);
                *(u32x2*)(h + (size_t)row * D + j * 512 + c0) = w; } }
    }
}

__device__ __forceinline__ SegOut make_seg(char* ws) { SegOut so; so.qa = (bf16_t*)(ws + OFF_QA); so.ckv = (bf16_t*)(ws + OFF_CKV); so.kr = (bf16_t*)(ws + OFF_KR); so.hq = (bf16_t*)(ws + OFF_HQ); so.ff = (bf16_t*)(ws + OFF_FF);
    so.fb = (bf16_t*)(ws + OFF_FB); so.iv = (bf16_t*)(ws + OFF_IV); so.og = (bf16_t*)(ws + OFF_OG); so.gm = (bf16_t*)(ws + OFF_GM); so.gh = (bf16_t*)(ws + OFF_GH); return so; }

__device__ __forceinline__ void phase2(const Params& p, LAS unsigned char* lds) {
    pg8::InSched S; S.init2(p.ws + OFF_WT_IN, gridDim.x, blockIdx.x);
    pg8::EpiIn E{p.ws};
    pg8::gemm_phase<pg8::EpiIn, pg8::InSched, true, 127, 122>(lds, (const char*)(p.ws + OFF_H), 1024, S, E);
}
__device__ __forceinline__ void phase3(const Params& p, LAS unsigned char* lds) {
    char* ws = p.ws;
    { pg8::DenseSched S; S.init(L, 1536, 768, 768, ws + OFF_WT_QB, gridDim.x, blockIdx.x); pg8::EpiQ E{(bf16_t*)(ws + OFF_Q), (const float*)(ws + OFF_SSQQ)}; pg8::gemm_phase<pg8::EpiQ, pg8::DenseSched, true, 127, 122>(lds, (const char*)(ws + OFF_QA), 768, S, E); }
    { pg8::DenseSched S; S.init(R, 2048, 256 * 2, 256 * 2, ws + OFF_WT_KVB, gridDim.x, blockIdx.x); pg8::EpiKV E{(bf16_t*)(ws + OFF_K), (bf16_t*)(ws + OFF_V), (const float*)(ws + OFF_SSQKV)}; pg8::gemm_phase(lds, (const char*)(ws + OFF_CKV), 256, S, E); }
    { const bf16_t* kr = (const bf16_t*)(ws + OFF_KR); bf16_t* Kb = (bf16_t*)(ws + OFF_K); const float* ropet = (const float*)(ws + OFF_ROPE);
      for (int gid = blockIdx.x * 512 + otid(); gid < R * 32; gid += gridDim.x * 512) { const int row = gid >> 5, i = gid & 31;
          const float x1 = bf2f(kr[(size_t)row * 64 + i]), x2 = bf2f(kr[(size_t)row * 64 + 32 + i]); float o1 = x1, o2 = x2; int b, pos;
          if (row < L) { b = row / SEQ; pos = row % SEQ; const float cs = ropet[pos * 64 + i], sn = ropet[pos * 64 + 32 + i]; o1 = x1 * cs - x2 * sn; o2 = x1 * sn + x2 * cs; } else { b = (row - L) / CTXL; pos = SEQ + (row - L) % CTXL; }
          const bf16_t w1 = f2bf(o1), w2 = f2bf(o2);
          for (int h = 0; h < 8; ++h) { bf16_t* q = Kb + ((size_t)(b * 8 + h) * NKEY + pos) * 192 + 128; q[i] = w1; q[32 + i] = w2; } } }
}
__device__ __forceinline__ void unpack8_fp8(const u32x2 w, float (&o)[8]) {
    o[0] = __builtin_amdgcn_cvt_f32_fp8((int)w.x, 0); o[1] = __builtin_amdgcn_cvt_f32_fp8((int)w.x, 1); o[2] = __builtin_amdgcn_cvt_f32_fp8((int)w.x, 2); o[3] = __builtin_amdgcn_cvt_f32_fp8((int)w.x, 3);
    o[4] = __builtin_amdgcn_cvt_f32_fp8((int)w.y, 0); o[5] = __builtin_amdgcn_cvt_f32_fp8((int)w.y, 1); o[6] = __builtin_amdgcn_cvt_f32_fp8((int)w.y, 2); o[7] = __builtin_amdgcn_cvt_f32_fp8((int)w.y, 3); }
__device__ __forceinline__ void unpack8(const u32x4 w, float (&o)[8]) {
    o[0] = __uint_as_float(w.x << 16); o[1] = __uint_as_float(w.x & 0xffff0000u); o[2] = __uint_as_float(w.y << 16); o[3] = __uint_as_float(w.y & 0xffff0000u);
    o[4] = __uint_as_float(w.z << 16); o[5] = __uint_as_float(w.z & 0xffff0000u); o[6] = __uint_as_float(w.w << 16); o[7] = __uint_as_float(w.w & 0xffff0000u); }
__device__ __forceinline__ void phase4(const Params& p, LAS unsigned char*) {
    char* ws = p.ws; bf16_t* y = (bf16_t*)(ws + OFF_H); const bf16_t* of = (const bf16_t*)(ws + OFF_OF); const bf16_t* ob = (const bf16_t*)(ws + OFF_OB);
    const unsigned char* og = (const unsigned char*)(ws + OFF_OG); const unsigned char* gm = (const unsigned char*)(ws + OFF_GM); const unsigned char* gh = (const unsigned char*)(ws + OFF_GH);
    const int tid = otid(), lane = tid & 63, gw = blockIdx.x * 8 + (tid >> 6), nw = gridDim.x * 8, c0 = lane * 8;
    float gg[8];
#pragma unroll
    for (int i = 0; i < 8; ++i) gg[i] = p.g_hg[(c0 + i) & 127];
    for (int row = gw; row < L; row += nw) {
        u32x4 ra[2], rb[2], rm[2]; u32x2 r1[2], r2[2], r3[2];
#pragma unroll
        for (int j = 0; j < 2; ++j) { const size_t off = (size_t)row * D + j * 512 + c0; ra[j] = __builtin_nontemporal_load((const u32x4*)(of + off)); rb[j] = __builtin_nontemporal_load((const u32x4*)(ob + off)); r1[j] = __builtin_nontemporal_load((const u32x2*)(og + off)); r2[j] = __builtin_nontemporal_load((const u32x2*)(gm + off)); r3[j] = __builtin_nontemporal_load((const u32x2*)(gh + off)); rm[j] = __builtin_nontemporal_load((const u32x4*)(y + off)); }
#pragma unroll
        for (int j = 0; j < 2; ++j) { float a[8], b[8], g1[8], g2[8], g3[8], ym[8], o[8]; unpack8(ra[j], a); unpack8(rb[j], b); unpack8_fp8(r1[j], g1); unpack8_fp8(r2[j], g2); unpack8_fp8(r3[j], g3); unpack8(rm[j], ym);
            float ss = 0.f;
#pragma unroll
            for (int i = 0; i < 8; ++i) { o[i] = a[i] + b[i]; ss += o[i] * o[i]; }
            ss += __shfl_xor(ss, 1); ss += __shfl_xor(ss, 2); ss += __shfl_xor(ss, 4); ss += __shfl_xor(ss, 8);
            const float rs = rsqrtf(ss * (1.0f / 128.0f) + EPS); float r[8];
#pragma unroll
            for (int i = 0; i < 8; ++i) { const float yh = o[i] * rs * gg[i] * siluf_(g1[i]); r[i] = sigmoidf_(g2[i]) * ym[i] + sigmoidf_(g3[i]) * yh; }
            u32x2 w; w.x = pack4_fp8(r[0], r[1], r[2], r[3]); w.y = pack4_fp8(r[4], r[5], r[6], r[7]);
            *(u32x2*)((unsigned char*)(ws + OFF_YF8) + (size_t)row * D + j * 512 + c0) = w; }
    }
}
__device__ __forceinline__ void phase5(const Params& p, LAS unsigned char* lds) {
    char* ws = p.ws;
    { pg8::DenseSched S; S.init(L, 1024, 1024, 1024, ws + OFF_WT_OUT, gridDim.x, blockIdx.x); pg8::EpiOut E{(bf16_t*)(ws + OFF_X1), p.x, (const float*)(ws + OFF_MOD)}; pg8::gemm_phase<pg8::EpiOut, pg8::DenseSched, true, 127, 122>(lds, (const char*)(ws + OFF_YF8), 1024, S, E); }
    { LAS float* tl = (LAS float*)lds; int tctr = 0; ConvPipe<true> pp; pp.have = false;
      for (int e = 0; e < NE; ++e) conv_matrix<true>(tl, pp, p.w_gu + (size_t)e * 1024 * 2048, 2048, (unsigned char*)(ws + OFF_WT_GU) + (size_t)e * 2048 * 1024, 1024, 2048, 2, nullptr, tctr);
      for (int e = 0; e < NE; ++e) conv_matrix<true>(tl, pp, p.w_dn + (size_t)e * 1024 * 1024, 1024, (unsigned char*)(ws + OFF_WT_DN) + (size_t)e * 1024 * 1024, 1024, 1024, 0, nullptr, tctr);
      conv_finish<true>(tl, pp); }
}
__device__ __forceinline__ void phase6(const Params& p, LAS unsigned char* lds) {
    char* ws = p.ws; const float* modv = (const float*)(ws + OFF_MOD); unsigned char* h2 = (unsigned char*)(ws + OFF_H); int* topi = (int*)(ws + OFF_TOPI); float* topp = (float*)(ws + OFF_TOPP); int* cnt = (int*)(ws + OFF_CNT); int* list = (int*)(ws + OFF_LIST); int* pairpos = (int*)(ws + OFF_ROWPAIR);
    LAS float* hs = (LAS float*)lds;
    LAS float* lg = (LAS float*)(lds + 131072);
    LAS int* lcnt = (LAS int*)(lds + 131072 + 4096);
    LAS int* lent = (LAS int*)(lds + 131072 + 4096 + 512);
    const int tid = otid(), lane = tid & 63, wid = tid >> 6, c0 = lane * 8;
    if (tid < 96) lcnt[tid] = 0;
    f32x4 g[4];
#pragma unroll
    for (int q = 0; q < 4; ++q) g[q] = *(const f32x4*)(p.g_ffn + (q >> 1) * 512 + c0 + (q & 1) * 4);
    __syncthreads();
    int it = 0;
    for (int tile = blockIdx.x; tile < L / 32; tile += gridDim.x, ++it) {
        const int rbase = tile * 32;
        f32x4 v[4][4];
#pragma unroll
        for (int u = 0; u < 4; ++u)
#pragma unroll
            for (int j = 0; j < 2; ++j) { float t8[8]; unpack8(*(const u32x4*)((const bf16_t*)(ws + OFF_X1) + (size_t)(rbase + wid * 4 + u) * D + j * 512 + c0), t8); v[u][2 * j] = (f32x4){t8[0], t8[1], t8[2], t8[3]}; v[u][2 * j + 1] = (f32x4){t8[4], t8[5], t8[6], t8[7]}; }
#pragma unroll
        for (int u = 0; u < 4; ++u) { const int rl = wid * 4 + u, row = rbase + rl; const float* mod = modv + (row / SEQ) * 6144; float ss = 0.f;
#pragma unroll
            for (int q = 0; q < 4; ++q) ss += (v[u][q][0] * v[u][q][0] + v[u][q][1] * v[u][q][1]) + (v[u][q][2] * v[u][q][2] + v[u][q][3] * v[u][q][3]);
            const float rs = rsqrtf(wave_sum(ss) * (1.0f / D) + EPS);
#pragma unroll
            for (int j = 0; j < 2; ++j) { f32x4 o[2];
#pragma unroll
                for (int e = 0; e < 2; ++e) { const int cc = j * 512 + c0 + e * 4; const f32x4 sc = *(const f32x4*)(mod + 4 * 1024 + cc), sh = *(const f32x4*)(mod + 3 * 1024 + cc); o[e] = v[u][j * 2 + e] * rs * g[j * 2 + e] * (sc + 1.0f) + sh;
                    *(LAS f32x4*)(hs + rl * 1024 + cc) = o[e]; }
                u32x2 w; w.x = pack4_fp8(o[0][0], o[0][1], o[0][2], o[0][3]); w.y = pack4_fp8(o[1][0], o[1][1], o[1][2], o[1][3]);
                *(u32x2*)(h2 + (size_t)row * D + j * 512 + c0) = w; } }
        __syncthreads();
        { const int e = tid & 31, rg = tid >> 5; const LAS float* h0 = hs + (2 * rg) * 1024; const LAS float* h1 = h0 + 1024; float a0 = 0.f, a1 = 0.f;
          for (int j = 0; j < 1024; j += 8) { float w[8];
#pragma unroll
              for (int q = 0; q < 8; ++q) w[q] = p.w_r[(j + q) * 32 + e];
              const f32x4 x0 = *(const LAS f32x4*)(h0 + j), x1 = *(const LAS f32x4*)(h0 + j + 4), y0 = *(const LAS f32x4*)(h1 + j), y1 = *(const LAS f32x4*)(h1 + j + 4);
              a0 += x0[0] * w[0]; a0 += x0[1] * w[1]; a0 += x0[2] * w[2]; a0 += x0[3] * w[3]; a0 += x1[0] * w[4]; a0 += x1[1] * w[5]; a0 += x1[2] * w[6]; a0 += x1[3] * w[7];
              a1 += y0[0] * w[0]; a1 += y0[1] * w[1]; a1 += y0[2] * w[2]; a1 += y0[3] * w[3]; a1 += y1[0] * w[4]; a1 += y1[1] * w[5]; a1 += y1[2] * w[6]; a1 += y1[3] * w[7]; }
          const float be = p.b_r[e]; lg[(2 * rg) * 32 + e] = a0 + be; lg[(2 * rg + 1) * 32 + e] = a1 + be; }
        __syncthreads();
#pragma unroll
        for (int rep = 0; rep < 2; ++rep) { const int rl = wid * 4 + rep * 2 + (lane >> 5), row = rbase + rl, e = lane & 31; float cur = lg[rl * 32 + e];
            float tv0 = 0.f, sum = 0.f; int sel_i[4]; float sel_e[4];
#pragma unroll
            for (int k = 0; k < 4; ++k) { float m = cur; int mi = e;
#pragma unroll
                for (int o2 = 16; o2 > 0; o2 >>= 1) { const float om = __shfl_xor(m, o2); const int oi = __shfl_xor(mi, o2); if (om > m || (om == m && oi < mi)) { m = om; mi = oi; } }
                if (k == 0) tv0 = m; sel_i[k] = mi; sel_e[k] = __expf(m - tv0); sum += sel_e[k]; if (e == mi) cur = -3.0e38f; }
            int myk = 0; float myp = 0.f;
#pragma unroll
            for (int k = 0; k < 4; ++k) if (e == k) { myk = sel_i[k]; myp = sel_e[k] / sum; }
            if (e < 4) { const int pair = row * 4 + e; topi[pair] = myk; topp[pair] = myp; __hip_atomic_fetch_add(&lcnt[myk], 1, __ATOMIC_RELAXED, __HIP_MEMORY_SCOPE_WORKGROUP); lent[(it * 32 + rl) * 4 + e] = myk; } }
        __syncthreads();
    }
    if (tid < 32) { const int n = lcnt[tid]; lcnt[32 + tid] = n > 0 ? atomicAdd(&cnt[tid], n) : 0; lcnt[64 + tid] = 0; }
    __syncthreads();
    const int nent = it * 128;
    for (int s = tid; s < nent; s += 512) { const int e = lent[s]; const int ii = s >> 7, rl = (s >> 2) & 31, k = s & 3; const int row = (blockIdx.x + ii * gridDim.x) * 32 + rl;
        const int pos = lcnt[32 + e] + __hip_atomic_fetch_add(&lcnt[64 + e], 1, __ATOMIC_RELAXED, __HIP_MEMORY_SCOPE_WORKGROUP); list[e * CAP + pos] = row * 4 + k; pairpos[row * 4 + k] = pos; }
}
__device__ __forceinline__ void moe_table(const int* cnt, LAS int* tab) {
    if (otid() == 0) { int t = 0; for (int e = 0; e < NE; ++e) { tab[e] = t; const int n = cnt[e]; tab[64 + e] = n; t += (n + 255) >> 8; } tab[32] = t; tab[33] = t; }
    __syncthreads();
    for (int rt = otid(); rt < tab[33]; rt += 512) { int e = 0; while (tab[e + 1] <= rt) ++e; tab[128 + rt] = e; }
    __syncthreads();
}
constexpr int LDS_TAB = pg8::STAGE_BYTES;
__device__ __forceinline__ void phase7(const Params& p, LAS unsigned char* lds) {
    char* ws = p.ws; LAS int* tab = (LAS int*)(lds + LDS_TAB); moe_table((const int*)(ws + OFF_CNT), tab);
    pg8::MoeSched<true> S; S.nN = 8; S.G = gridDim.x; S.c = blockIdx.x; S.rowb = 1024; S.Wt = ws + OFF_WT_GU; S.wexp = (size_t)2048 * 1024; S.btile = (size_t)256 * 1024; S.tab = tab; S.list = (const int*)(ws + OFF_LIST);
    pg8::EpiMoe1 E{(unsigned char*)(ws + OFF_ACT), p.b_gu};
    pg8::gemm_phase<pg8::EpiMoe1, pg8::MoeSched<true>, true, 127, 122>(lds, (const char*)(ws + OFF_H), 1024, S, E);
}
__device__ __forceinline__ void phase8(const Params& p, LAS unsigned char* lds) {
    char* ws = p.ws; LAS int* tab = (LAS int*)(lds + LDS_TAB); moe_table((const int*)(ws + OFF_CNT), tab);
    pg8::MoeSched<false> S; S.nN = 4; S.G = gridDim.x; S.c = blockIdx.x; S.rowb = 1024; S.Wt = ws + OFF_WT_DN; S.wexp = (size_t)1024 * 1024; S.btile = (size_t)256 * 1024; S.tab = tab; S.list = (const int*)(ws + OFF_LIST);
    pg8::EpiMoe2 E{(bf16_t*)(ws + OFF_YP), p.b_dn};
    pg8::gemm_phase<pg8::EpiMoe2, pg8::MoeSched<false>, true, 125, 122>(lds, (const char*)(ws + OFF_ACT), 1024, S, E);
}
__device__ __forceinline__ void phase9(const Params& p, LAS unsigned char* lds) {
    char* ws = p.ws; const float* modv = (const float*)(ws + OFF_MOD); const bf16_t* yp = (const bf16_t*)(ws + OFF_YP); const float* topp = (const float*)(ws + OFF_TOPP);
    const int* topi = (const int*)(ws + OFF_TOPI); const int* pairpos = (const int*)(ws + OFF_ROWPAIR);
    LAS int* tab = (LAS int*)lds; moe_table((const int*)(ws + OFF_CNT), tab);
    const int tid = otid(), lane = tid & 63, gw = blockIdx.x * 8 + (tid >> 6), nw = gridDim.x * 8, c0 = lane * 8;
    f32x4 fg[4];
#pragma unroll
    for (int q = 0; q < 4; ++q) fg[q] = *(const f32x4*)(p.g_fin + (q >> 1) * 512 + c0 + (q & 1) * 4);
    for (int row = gw; row < L; row += nw) {
        const float* gate = modv + (row / SEQ) * 6144 + 5 * 1024; f32x4 v[4]; u32x4 yr[4][2];
        const pg8::i32x4_t ek = *(const pg8::i32x4_t*)(topi + row * 4), pk4 = *(const pg8::i32x4_t*)(pairpos + row * 4);
#pragma unroll
        for (int j = 0; j < 2; ++j) { float t8[8]; unpack8(*(const u32x4*)((const bf16_t*)(ws + OFF_X1) + (size_t)row * D + j * 512 + c0), t8); v[2 * j] = (f32x4){t8[0], t8[1], t8[2], t8[3]}; v[2 * j + 1] = (f32x4){t8[4], t8[5], t8[6], t8[7]}; }
#pragma unroll
        for (int k = 0; k < 4; ++k) { const size_t yrow = (size_t)tab[ek[k]] * 256 + pk4[k];
#pragma unroll
            for (int j = 0; j < 2; ++j) yr[k][j] = __builtin_nontemporal_load((const u32x4*)(yp + yrow * D + j * 512 + c0)); }
        const f32x4 pk = *(const f32x4*)(topp + row * 4);
        float m[16];
#pragma unroll
        for (int i = 0; i < 16; ++i) m[i] = 0.f;
#pragma unroll
        for (int k = 0; k < 4; ++k)
#pragma unroll
            for (int j = 0; j < 2; ++j) { float t[8]; unpack8(yr[k][j], t);
#pragma unroll
                for (int i = 0; i < 8; ++i) m[j * 8 + i] += pk[k] * t[i]; }
        float ss = 0.f;
#pragma unroll
        for (int q = 0; q < 4; ++q) { const f32x4 gt = *(const f32x4*)(gate + (q >> 1) * 512 + c0 + (q & 1) * 4);
#pragma unroll
            for (int i = 0; i < 4; ++i) { v[q][i] += gt[i] * m[q * 4 + i]; ss += v[q][i] * v[q][i]; } }
        const float rs = rsqrtf(wave_sum(ss) * (1.0f / D) + EPS);
#pragma unroll
        for (int q = 0; q < 4; ++q) __builtin_nontemporal_store(v[q] * rs * fg[q], (f32x4*)(p.out + (size_t)row * D + (q >> 1) * 512 + c0 + (q & 1) * 4));
    }
}

namespace at {
using s16x4  = __attribute__((ext_vector_type(4))) short;
using f32x16 = __attribute__((ext_vector_type(16))) float;
constexpr int NW = 8, QBLK = 32, KVBLK = 64, DK = 192, DV = 128;
constexpr float SCALE = 0.07216878364870322f;
constexpr float THR = 8.f;
constexpr int SHM_V = KVBLK * DV * 2, SHM_K = KVBLK * DK * 2, SHM_ATTN = 2 * SHM_V + 2 * SHM_K + NW * 64 * 4;
#define KSWZ(row, colB) ((row) * 384 + ((colB) ^ (((row) & 7) << 4)))
#define SBAR() __builtin_amdgcn_sched_barrier(0)
__device__ __forceinline__ int crow(int r, int hi) { return (r & 3) + 8 * (r >> 2) + 4 * hi; }
__device__ __forceinline__ unsigned cvtpk(float lo, float hi) { return cvt_pk_bf16(lo, hi); }

__device__ __forceinline__ void partialSM(f32x16& p0, f32x16& p1, float& m_reg, float& mn, float& alpha) {
  constexpr float C = SCALE * 1.4426950408889634f;
  float pmax = p0[0];
#pragma unroll
  for (int r = 1; r < 16; ++r) pmax = fmaxf(pmax, p0[r]);
#pragma unroll
  for (int r = 0; r < 16; ++r) pmax = fmaxf(pmax, p1[r]);
  { auto rr = __builtin_amdgcn_permlane32_swap(__float_as_uint(pmax), __float_as_uint(pmax), false, false);
    pmax = fmaxf(__uint_as_float(rr[0]), __uint_as_float(rr[1])); }
  if (__builtin_expect(__all(pmax - m_reg <= THR / SCALE), 1)) { mn = m_reg; alpha = 1.f; }
  else { mn = fmaxf(m_reg, pmax); alpha = __builtin_amdgcn_exp2f((m_reg - mn) * C); m_reg = mn; }
  float mnC = -mn * C;
#pragma unroll
  for (int r = 0; r < 16; ++r) p0[r] = fmaf(p0[r], C, mnC);
#pragma unroll
  for (int r = 0; r < 16; ++r) p1[r] = fmaf(p1[r], C, mnC);
#pragma unroll
  for (int r = 0; r < 16; ++r) p0[r] = __builtin_amdgcn_exp2f(p0[r]);
}
__device__ __forceinline__ void finishSM(f32x16& p0, f32x16& p1, float alpha, float& l_reg, bf16x8& pa0, bf16x8& pa1, bf16x8& pa2, bf16x8& pa3) {
#pragma unroll
  for (int r = 0; r < 16; ++r) p1[r] = __builtin_amdgcn_exp2f(p1[r]);
  float ps = 0;
#pragma unroll
  for (int r = 0; r < 16; ++r) ps += p0[r];
#pragma unroll
  for (int r = 0; r < 16; ++r) ps += p1[r];
  { auto rr = __builtin_amdgcn_permlane32_swap(__float_as_uint(ps), __float_as_uint(ps), false, false);
    ps = __uint_as_float(rr[0]) + __uint_as_float(rr[1]); }
  l_reg = l_reg * alpha + ps;
#define PK4(P, BASE, OUT) do { unsigned a0 = cvtpk(P[BASE + 0], P[BASE + 1]), a1 = cvtpk(P[BASE + 2], P[BASE + 3]);   \
    unsigned b0 = cvtpk(P[BASE + 4], P[BASE + 5]), b1 = cvtpk(P[BASE + 6], P[BASE + 7]);                              \
    auto r0 = __builtin_amdgcn_permlane32_swap(a0, b0, false, false); auto r1 = __builtin_amdgcn_permlane32_swap(a1, b1, false, false); \
    u32x4 w = {r0[0], r1[0], r0[1], r1[1]}; OUT = *reinterpret_cast<bf16x8*>(&w); } while (0)
  PK4(p0, 0, pa0); PK4(p0, 8, pa1); PK4(p1, 0, pa2); PK4(p1, 8, pa3);
#undef PK4
}
__device__ __forceinline__ void qkt(f32x16& p0, f32x16& p1, const LAS char* Ks, const bf16x8 (&qr)[12], int r32, int hi) {
  p0 = f32x16{}; p1 = f32x16{};
#pragma unroll
  for (int d0 = 0; d0 < 12; ++d0) { const int cb = (d0 * 16 + hi * 8) * 2;
    const bf16x8 b0 = *reinterpret_cast<const LAS bf16x8*>(Ks + KSWZ(r32, cb));
    const bf16x8 b1 = *reinterpret_cast<const LAS bf16x8*>(Ks + KSWZ(32 + r32, cb));
    p0 = __builtin_amdgcn_mfma_f32_32x32x16_bf16(b0, qr[d0], p0, 0, 0, 0);
    p1 = __builtin_amdgcn_mfma_f32_32x32x16_bf16(b1, qr[d0], p1, 0, 0, 0); }
}
__device__ __forceinline__ int v_st(int k, int c) { const int kk = (k & ~0xC) | ((k & 4) << 1) | ((k & 8) >> 1); return ((kk >> 3) * 4 + (c >> 5)) * 512 + ((kk & 7) * 32 + (c & 31)) * 2; }
__device__ __forceinline__ int v_rd_base(int lane) { return ((lane & 3) << 3) | (((lane >> 2) & 3) << 6) | (((lane >> 4) & 1) << 5) | (((lane >> 5) & 1) << 8); }
constexpr int v_rd_off(int d0, int ks, int half) { return d0 * 512 + ks * 4096 + half * 2048; }
template <int OFF> __device__ __forceinline__ s16x4 tr_read(int vb) { s16x4 r; asm volatile("ds_read_b64_tr_b16 %0, %1 offset:%2" : "=&v"(r) : "v"(vb), "i"(OFF) : "memory"); return r; }
template <int D0> __device__ __forceinline__ void pv_one(f32x16& od, int vb, bf16x8 pa0, bf16x8 pa1, bf16x8 pa2, bf16x8 pa3) {
  const s16x4 l0 = tr_read<v_rd_off(D0, 0, 0)>(vb), h0 = tr_read<v_rd_off(D0, 0, 1)>(vb), l1 = tr_read<v_rd_off(D0, 1, 0)>(vb), h1 = tr_read<v_rd_off(D0, 1, 1)>(vb);
  const s16x4 l2 = tr_read<v_rd_off(D0, 2, 0)>(vb), h2 = tr_read<v_rd_off(D0, 2, 1)>(vb), l3 = tr_read<v_rd_off(D0, 3, 0)>(vb), h3 = tr_read<v_rd_off(D0, 3, 1)>(vb);
  asm volatile("s_waitcnt lgkmcnt(0)" ::: "memory"); SBAR();
#define PK(Lo, Hi) (bf16x8){Lo[0], Lo[1], Lo[2], Lo[3], Hi[0], Hi[1], Hi[2], Hi[3]}
  od = __builtin_amdgcn_mfma_f32_32x32x16_bf16(pa0, PK(l0, h0), od, 0, 0, 0);
  od = __builtin_amdgcn_mfma_f32_32x32x16_bf16(pa1, PK(l1, h1), od, 0, 0, 0);
  od = __builtin_amdgcn_mfma_f32_32x32x16_bf16(pa2, PK(l2, h2), od, 0, 0, 0);
  od = __builtin_amdgcn_mfma_f32_32x32x16_bf16(pa3, PK(l3, h3), od, 0, 0, 0);
#undef PK
}
__device__ __forceinline__ void pv_d0(f32x16 (&o)[4], int vb, bf16x8 pa0, bf16x8 pa1, bf16x8 pa2, bf16x8 pa3) {
  pv_one<0>(o[0], vb, pa0, pa1, pa2, pa3); pv_one<1>(o[1], vb, pa0, pa1, pa2, pa3); pv_one<2>(o[2], vb, pa0, pa1, pa2, pa3); pv_one<3>(o[3], vb, pa0, pa1, pa2, pa3);
}

__device__ __forceinline__ void attn_unit(const bf16_t* __restrict__ Qb, const bf16_t* __restrict__ Kh, const bf16_t* __restrict__ Vh, bf16_t* __restrict__ Ob, int t0, const float* __restrict__ ropet, LAS char* lds) {
  constexpr int LDQ = 1536, LDO = 1024, NT = NKEY / KVBLK;
  const int tid = otid(), wid = tid >> 6, lane = tid & 63, r32 = lane & 31, hi = lane >> 5;
  LAS char* V_lds = lds; LAS char* K_lds = lds + 2 * SHM_V;
  LAS float* wsl = (LAS float*)(lds + 2 * SHM_V + 2 * SHM_K) + wid * 64; LAS float* li_l = wsl; LAS float* al_l = wsl + 32;
  float m_reg = -1e30f, l_reg = 0; f32x16 o[4] = {}; bf16x8 qr[12];
  { const bf16_t* Qw = Qb + (size_t)(wid * QBLK + r32) * LDQ + hi * 8;
#pragma unroll
    for (int d0 = 0; d0 < 12; ++d0) qr[d0] = *reinterpret_cast<const bf16x8*>(Qw + d0 * 16);
    const float* rt = ropet + (size_t)(t0 + wid * QBLK + r32) * 64 + 8 * hi;
#pragma unroll
    for (int g = 0; g < 2; ++g) {
      const f32x4 c0 = *(const f32x4*)(rt + 16 * g), c1 = *(const f32x4*)(rt + 16 * g + 4), s0 = *(const f32x4*)(rt + 32 + 16 * g), s1 = *(const f32x4*)(rt + 32 + 16 * g + 4);
      float n1[8], n2[8];
#pragma unroll
      for (int j = 0; j < 8; ++j) { const float cs = j < 4 ? c0[j & 3] : c1[j & 3], sn = j < 4 ? s0[j & 3] : s1[j & 3];
        const float x1 = bf2f((bf16_t)qr[8 + g][j]), x2 = bf2f((bf16_t)qr[10 + g][j]); n1[j] = x1 * cs - x2 * sn; n2[j] = x1 * sn + x2 * cs; }
      u32x4 w1 = {cvtpk(n1[0], n1[1]), cvtpk(n1[2], n1[3]), cvtpk(n1[4], n1[5]), cvtpk(n1[6], n1[7])}; u32x4 w2 = {cvtpk(n2[0], n2[1]), cvtpk(n2[2], n2[3]), cvtpk(n2[4], n2[5]), cvtpk(n2[6], n2[7])};
      qr[8 + g] = *reinterpret_cast<bf16x8*>(&w1); qr[10 + g] = *reinterpret_cast<bf16x8*>(&w2); } }
  const int sr = tid >> 4, sc = (tid & 15) * 8, vst0 = v_st(sr, sc), vst1 = v_st(32 + sr, sc);
  int kgo[3], kst[3];
#pragma unroll
  for (int i = 0; i < 3; ++i) { const int c = tid + 512 * i, row = c / 24, c8 = (c % 24) * 8; kgo[i] = row * DK + c8; kst[i] = KSWZ(row, c8 * 2); }
  const int vb0 = (int)(uintptr_t)V_lds + v_rd_base(lane);
  bf16x8 sv0, sv1, sk0, sk1, sk2;
#define SLOAD(k0) do { sv0 = *reinterpret_cast<const bf16x8*>(&Vh[(size_t)((k0) + sr) * DV + sc]); sv1 = *reinterpret_cast<const bf16x8*>(&Vh[(size_t)((k0) + 32 + sr) * DV + sc]); \
    sk0 = *reinterpret_cast<const bf16x8*>(&Kh[(size_t)(k0) * DK + kgo[0]]); sk1 = *reinterpret_cast<const bf16x8*>(&Kh[(size_t)(k0) * DK + kgo[1]]); sk2 = *reinterpret_cast<const bf16x8*>(&Kh[(size_t)(k0) * DK + kgo[2]]); } while (0)
#define SWRITE(b) do { *(LAS bf16x8*)(V_lds + (b) * SHM_V + vst0) = sv0; *(LAS bf16x8*)(V_lds + (b) * SHM_V + vst1) = sv1; \
    *(LAS bf16x8*)(K_lds + (b) * SHM_K + kst[0]) = sk0; *(LAS bf16x8*)(K_lds + (b) * SHM_K + kst[1]) = sk1; *(LAS bf16x8*)(K_lds + (b) * SHM_K + kst[2]) = sk2; } while (0)
#define RESC(a) do { if (__any((a) < 1.f)) { if (hi == 0) al_l[r32] = (a); asm volatile("s_waitcnt lgkmcnt(0)" ::: "memory"); \
    _Pragma("unroll") for (int d = 0; d < 4; ++d) _Pragma("unroll") for (int r = 0; r < 16; ++r) o[d][r] *= al_l[crow(r, hi)]; } } while (0)
  f32x16 p0, p1; float mn, al; bf16x8 pa0, pa1, pa2, pa3;
  SLOAD(0); asm volatile("s_waitcnt vmcnt(0)" ::: "memory"); SWRITE(0); __syncthreads();
  for (int j = 0; j < NT; ++j) {
    const int bsel = j & 1;
    if (j + 1 < NT) SLOAD((j + 1) * KVBLK);
    SBAR(); qkt(p0, p1, K_lds + bsel * SHM_K, qr, r32, hi);
    partialSM(p0, p1, m_reg, mn, al);
    RESC(al);
    finishSM(p0, p1, al, l_reg, pa0, pa1, pa2, pa3); SBAR();
    pv_d0(o, vb0 + bsel * SHM_V, pa0, pa1, pa2, pa3);
    if (j + 1 < NT) { asm volatile("s_waitcnt vmcnt(0)" ::: "memory"); SWRITE(bsel ^ 1); }
    __syncthreads();
  }
  if (hi == 0) li_l[r32] = l_reg; asm volatile("s_waitcnt lgkmcnt(0)" ::: "memory");
  float rli[16];
#pragma unroll
  for (int r = 0; r < 16; ++r) rli[r] = __builtin_amdgcn_rcpf(li_l[crow(r, hi)]);
  { LAS bf16_t* ot = (LAS bf16_t*)(lds + wid * 8192);
#pragma unroll
    for (int r = 0; r < 16; ++r) { const int orow = crow(r, hi);
#pragma unroll
      for (int d0 = 0; d0 < 4; ++d0) ot[orow * 128 + d0 * 32 + r32] = f2bf(o[d0][r] * rli[r]); }
    asm volatile("s_waitcnt lgkmcnt(0)" ::: "memory");
    bf16_t* Ow = Ob + (size_t)(wid * QBLK) * LDO;
#pragma unroll
    for (int i = 0; i < 8; ++i) { const int q = lane + 64 * i, row = q >> 4, ch = q & 15; const u32x4 w = *(const LAS u32x4*)(ot + row * 128 + ch * 8); *(u32x4*)(Ow + (size_t)row * LDO + ch * 8) = w; } }
#undef SLOAD
#undef SWRITE
#undef RESC
}
}

__device__ __forceinline__ void phase_attn(const Params& p, LAS unsigned char* lds) {
    char* ws = p.ws; const bf16_t* Q = (const bf16_t*)(ws + OFF_Q); const bf16_t* Kb = (const bf16_t*)(ws + OFF_K); const bf16_t* Vb = (const bf16_t*)(ws + OFF_V); bf16_t* Y = (bf16_t*)(ws + OFF_H);
    const int G = gridDim.x;
    for (int it = 0;; ++it) {
        int u;
        if (G == 256) { const int c = blockIdx.x, xcd = c & 7, j = c >> 3; if (it >= 4) break; u = ((it * 32 + xcd * 4 + (j >> 3)) << 3) | (j & 7); }
        else { u = it * G + blockIdx.x; if (u >= 1024) break; }
        const int bh = u >> 3, qb = u & 7, b = bh >> 3, h = bh & 7;
        at::attn_unit(Q + ((size_t)(b * SEQ + qb * 256)) * 1536 + h * 192, Kb + (size_t)bh * NKEY * 192, Vb + (size_t)bh * NKEY * 128, Y + ((size_t)(b * SEQ + qb * 256)) * D + h * 128, qb * 256, (const float*)(ws + OFF_ROPE), (LAS char*)lds);
        __syncthreads();
    }
}

namespace sc {
using f32x16 = __attribute__((ext_vector_type(16))) float;
constexpr int BUFB = 53248, O_QT = 0, O_KH = 16384, O_VT = 32768, O_AT = 49152, O_DEC = 51200, O_KD = 2 * BUFB, LDS_SCAN = 2 * BUFB + 16384;
__device__ __forceinline__ int sw256(int row, int cb) { return row * 256 + (cb ^ ((row & 15) << 4)); }
__device__ __forceinline__ int sw128(int row, int cb) { return row * 128 + (cb ^ (((row >> 1) & 7) << 4)); }
__device__ __forceinline__ int grow_of(int n, int b, int dir) { if (n < CTXL) { const int s = dir ? (CTXL - 1 - n) : n; return L + b * CTXL + s; } const int m = n - CTXL; return b * SEQ + (dir ? (SEQ - 1 - m) : m); }
__device__ __forceinline__ bf16x8 pack_acc8(const f32x16& x, int s) { u32x4 p; p.x = cvt_pk_bf16(x[8 * s], x[8 * s + 1]); p.y = cvt_pk_bf16(x[8 * s + 2], x[8 * s + 3]); p.z = cvt_pk_bf16(x[8 * s + 4], x[8 * s + 5]); p.w = cvt_pk_bf16(x[8 * s + 6], x[8 * s + 7]); return __builtin_bit_cast(bf16x8, p); }

__device__ __forceinline__ void scan_unit(const Params& p, int unit, LAS unsigned char* lds) {
    char* ws = p.ws; const int dir = unit & 1, h = (unit >> 1) & 7, b = unit >> 4;
    const bf16_t* hq = (const bf16_t*)(ws + OFF_HQ); const bf16_t* fz = (const bf16_t*)(ws + (dir ? OFF_FB : OFF_FF)); const bf16_t* iv = (const bf16_t*)(ws + OFF_IV);
    bf16_t* outp = (bf16_t*)(ws + (dir ? OFF_OB : OFF_OF)); const float* lb = (const float*)(ws + OFF_LB);
    const int tid = otid(), wid = __builtin_amdgcn_readfirstlane(tid >> 6), lane = tid & 63, r32 = lane & 31, hi = lane >> 5;
    const int sgn = dir ? -1 : 1; const long rstep = (long)sgn * D;
    __syncthreads();
    if (wid >= 4) {
        const int I = wid - 4, cp = lane, hc = h * 128 + 2 * cp;
        const float lbv0 = lb[dir * 1024 + hc], lbv1 = lb[dir * 1024 + hc + 1];
        unsigned zr[16], vr[16], qr[16];
#define SC_LOAD(c) do { const size_t o0_ = (size_t)(grow_of((c) * 64, b, dir) + sgn * (16 * I)) * D + hc; const bf16_t* pz_ = fz + o0_; const bf16_t* pv_ = iv + o0_; const bf16_t* pq_ = hq + o0_; \
        _Pragma("unroll") for (int i = 0; i < 16; ++i) { zr[i] = *(const unsigned*)pz_; pz_ += rstep; vr[i] = *(const unsigned*)pv_; pv_ += rstep; if ((c) >= 4) { qr[i] = *(const unsigned*)pq_; pq_ += rstep; } } } while (0)
        SC_LOAD(0);
        for (int it = 0; it <= 36; ++it) {
            if (it < 36) {
                const int c = it; const bool lat = c >= 4; LAS unsigned char* B = lds + (c & 1) * BUFB; LAS unsigned char* KD = lds + O_KD;
                float kk0[16], kk1[16], lc0[16], lc1[16]; float run0 = 0.f, run1 = 0.f;
#pragma unroll
                for (int i = 0; i < 16; ++i) { const float z0 = __uint_as_float(zr[i] << 16), z1 = __uint_as_float(zr[i] & 0xffff0000u);
                    const float f0 = lbv0 + (1.0f - lbv0) * sigmoidf_(z0), f1 = lbv1 + (1.0f - lbv1) * sigmoidf_(z1); kk0[i] = 1.0f - f0; kk1[i] = 1.0f - f1;
                    run0 += __builtin_amdgcn_logf(f0) * 0.6931471805599453f; run1 += __builtin_amdgcn_logf(f1) * 0.6931471805599453f; lc0[i] = run0; lc1[i] = run1; }
                *(LAS f32x2*)(B + O_DEC + (I * 128 + 2 * cp) * 4) = (f32x2){__expf(run0), __expf(run1)};
                unsigned kh0[8], kh1[8], vt0[8], vt1[8];
#pragma unroll
                for (int i = 0; i < 16; ++i) { const int t = 16 * I + i; const float l0 = lc0[i], l1 = lc1[i];
                    const float kd0 = kk0[i] * __expf(fminf(-l0, 80.0f)), kd1 = kk1[i] * __expf(fminf(-l1, 80.0f));
                    const float kf0 = kk0[i] * __expf(run0 - l0), kf1 = kk1[i] * __expf(run1 - l1);
                    if (lat) { const float q0 = __uint_as_float(qr[i] << 16), q1 = __uint_as_float(qr[i] & 0xffff0000u);
                        *(LAS unsigned*)(B + O_QT + sw256(t, 4 * cp)) = cvt_pk_bf16(q0 * __expf(l0), q1 * __expf(l1)); *(LAS unsigned*)(KD + sw256(t, 4 * cp)) = cvt_pk_bf16(kd0, kd1); }
                    if (i & 1) { kh0[i >> 1] = cvt_pk_bf16(__uint_as_float(kh0[i >> 1]), kf0); kh1[i >> 1] = cvt_pk_bf16(__uint_as_float(kh1[i >> 1]), kf1); vt0[i >> 1] = (vt0[i >> 1] >> 16) | (vr[i] << 16); vt1[i >> 1] = (vt1[i >> 1] >> 16) | (vr[i] & 0xffff0000u); }
                    else { kh0[i >> 1] = __float_as_uint(kf0); kh1[i >> 1] = __float_as_uint(kf1); vt0[i >> 1] = vr[i] << 16; vt1[i >> 1] = vr[i] & 0xffff0000u; } }
#pragma unroll
                for (int q = 0; q < 2; ++q) {
                    *(LAS u32x4*)(B + O_KH + sw128(2 * cp, 32 * I + 16 * q)) = (u32x4){kh0[4 * q], kh0[4 * q + 1], kh0[4 * q + 2], kh0[4 * q + 3]}; *(LAS u32x4*)(B + O_KH + sw128(2 * cp + 1, 32 * I + 16 * q)) = (u32x4){kh1[4 * q], kh1[4 * q + 1], kh1[4 * q + 2], kh1[4 * q + 3]};
                    *(LAS u32x4*)(B + O_VT + sw128(2 * cp, 32 * I + 16 * q)) = (u32x4){vt0[4 * q], vt0[4 * q + 1], vt0[4 * q + 2], vt0[4 * q + 3]}; *(LAS u32x4*)(B + O_VT + sw128(2 * cp + 1, 32 * I + 16 * q)) = (u32x4){vt1[4 * q], vt1[4 * q + 1], vt1[4 * q + 2], vt1[4 * q + 3]}; }
                if (it + 1 < 36) SC_LOAD(it + 1);
                if (lat) {
                    const int l15 = lane & 15, lq = lane >> 4; f32x4 a = {0.f, 0.f, 0.f, 0.f};
#pragma unroll
                    for (int ks = 0; ks < 4; ++ks) { const bf16x8 av = *(const LAS bf16x8*)(B + O_QT + sw256(16 * I + l15, (32 * ks + 8 * lq) * 2)); const bf16x8 bv = *(const LAS bf16x8*)(KD + sw256(16 * I + l15, (32 * ks + 8 * lq) * 2));
                        a = __builtin_amdgcn_mfma_f32_16x16x32_bf16(av, bv, a, 0, 0, 0); }
#pragma unroll
                    for (int r = 0; r < 4; ++r) { const int tl = 4 * lq + r; float v = a[r]; if (l15 > tl) v = 0.f; *(LAS bf16_t*)(B + O_AT + ((I * 16 + tl) * 16 + l15) * 2) = f2bf(v); }
                }
            }
            __syncthreads();
        }
#undef SC_LOAD
    } else {
        const int bq = wid; f32x16 S[4];
#pragma unroll
        for (int a = 0; a < 4; ++a) S[a] = f32x16{};
        for (int it = 0; it <= 36; ++it) {
            if (it >= 1) {
                const int c = it - 1; const bool lat = c >= 4; LAS unsigned char* B = lds + (c & 1) * BUFB;
                bf16_t* po = outp + (size_t)(grow_of(c * 64, b, dir) + sgn * (4 * hi)) * D + h * 128 + 32 * bq + r32;
#pragma unroll
                for (int I = 0; I < 4; ++I) {
                    const bf16x8 vtf = *(const LAS bf16x8*)(B + O_VT + sw128(32 * bq + r32, (16 * I + 8 * hi) * 2));
                    if (lat) {
                        f32x16 o = f32x16{};
#pragma unroll
                        for (int a = 0; a < 4; ++a)
#pragma unroll
                            for (int s = 0; s < 2; ++s) { const int dk0 = 32 * a + 16 * s + 4 * hi; const int row = 16 * I + (r32 & 15);
                                const u32x2 lo2 = *(const LAS u32x2*)(B + O_QT + sw256(row, dk0 * 2)), hi2 = *(const LAS u32x2*)(B + O_QT + sw256(row, (dk0 + 8) * 2));
                                const u32x4 av = {lo2.x, lo2.y, hi2.x, hi2.y};
                                o = __builtin_amdgcn_mfma_f32_32x32x16_bf16(__builtin_bit_cast(bf16x8, av), pack_acc8(S[a], s), o, 0, 0, 0); }
                        { const bf16x8 af = *(const LAS bf16x8*)(B + O_AT + ((I * 16 + (r32 & 15)) * 16 + 8 * hi) * 2); o = __builtin_amdgcn_mfma_f32_32x32x16_bf16(af, vtf, o, 0, 0, 0); }
#pragma unroll
                        for (int r = 0; r < 8; ++r) po[(long)(16 * I + (r & 3) + 8 * (r >> 2)) * rstep] = f2bf(o[r]);
                    }
#pragma unroll
                    for (int a = 0; a < 4; ++a) {
#pragma unroll
                        for (int g = 0; g < 4; ++g) { const f32x4 dc = *(const LAS f32x4*)(B + O_DEC + (I * 128 + 32 * a + 8 * g + 4 * hi) * 4); S[a][4 * g] *= dc[0]; S[a][4 * g + 1] *= dc[1]; S[a][4 * g + 2] *= dc[2]; S[a][4 * g + 3] *= dc[3]; }
                        const bf16x8 kf = *(const LAS bf16x8*)(B + O_KH + sw128(32 * a + r32, (16 * I + 8 * hi) * 2));
                        S[a] = __builtin_amdgcn_mfma_f32_32x32x16_bf16(kf, vtf, S[a], 0, 0, 0); }
                }
            }
            __syncthreads();
        }
    }
    __syncthreads();
}
}
__device__ __forceinline__ void phase_scan(const Params& p, LAS unsigned char* lds) {
    for (int u = blockIdx.x; u < 256; u += gridDim.x) sc::scan_unit(p, u, lds);
}

constexpr int LDS_BYTES = 155648;
template <int PH> __global__ void __launch_bounds__(512, 2) k_phase(Params p) {
    extern __shared__ __attribute__((aligned(16))) unsigned char smem[];
    LAS unsigned char* lds = (LAS unsigned char*)smem;
    if constexpr (PH == 0) phase0(p, lds);
    if constexpr (PH == 1) phase1(p, lds);
    if constexpr (PH == 2) phase2(p, lds);
    if constexpr (PH == 3) phase3(p, lds);
    if constexpr (PH == 4) phase4(p, lds);
    if constexpr (PH == 5) phase5(p, lds);
    if constexpr (PH == 6) phase6(p, lds);
    if constexpr (PH == 7) phase7(p, lds);
    if constexpr (PH == 8) phase8(p, lds);
    if constexpr (PH == 9) phase9(p, lds);
    if constexpr (PH == 10) phase_attn(p, lds);
    if constexpr (PH == 11) phase_scan(p, lds);
}

#include <cstdint>
#include <cstdlib>
#include <vector>

#define XB_TMO      128
#define XB_XCNT(j)  (256  + 64 * (j))
#define XB_XSUB(j)  (1280 + 64 * (j))
#define XB_XGEN(j)  (2304 + 64 * (j))
#define XB_TOP      3328
#define XB_TOPGEN   3392
#define XCD_BAR_WORDS 3456
#define XB_SPIN_CAP (1u << 18)

__device__ __forceinline__ unsigned xb_ld(unsigned* p)              { return __hip_atomic_load(p, __ATOMIC_RELAXED, __HIP_MEMORY_SCOPE_AGENT); }
__device__ __forceinline__ unsigned xb_add(unsigned* p, unsigned v) { return __hip_atomic_fetch_add(p, v, __ATOMIC_RELAXED, __HIP_MEMORY_SCOPE_AGENT); }
__device__ __forceinline__ unsigned xb_xcc_id() { return (unsigned)__builtin_amdgcn_s_getreg((3 << 11) | 20) & 0xFu; }
#define XB_SPIN(cond, bar) do { unsigned _sp = 0; while (cond) { __builtin_amdgcn_s_sleep(1); \
    if ((++_sp & 255u) == 0u) { if (xb_ld(&(bar)[XB_TMO])) break; if (_sp > XB_SPIN_CAP) { atomicAdd(&(bar)[XB_TMO], 1u); break; } } } } while (0)

struct XcdBarrier {
    unsigned* bar; unsigned x;
    volatile LAS unsigned* st;
};

__device__ __forceinline__ XcdBarrier xcd_barrier_post(unsigned* bar, volatile LAS unsigned* st) {
    XcdBarrier b; b.bar = bar; b.x = xb_xcc_id(); b.st = st;
    if (threadIdx.x == 0) (void)xb_add(&bar[XB_XCNT(b.x)], 1u);
    return b;
}
__device__ __forceinline__ void xcd_barrier_complete(unsigned* bar, unsigned x, unsigned& nloc, unsigned& nx) {
    const unsigned G = gridDim.x * gridDim.y * gridDim.z;
    unsigned sum, cnt, mine, sp = 0u;
    for (;;) {
        sum = 0u; cnt = 0u; mine = 0u;
#pragma unroll
        for (unsigned j = 0; j < 16; ++j) { const unsigned c = xb_ld(&bar[XB_XCNT(j)]); sum += c; cnt += (c > 0u) ? 1u : 0u; mine = (j == x) ? c : mine; }
        if (sum == G) break;
        __builtin_amdgcn_s_sleep(1);
        if ((++sp & 255u) == 0u) { if (xb_ld(&bar[XB_TMO])) break; if (sp > XB_SPIN_CAP) { atomicAdd(&bar[XB_TMO], 1u); break; } }
    }
    nloc = mine > 0u ? mine : 1u; nx = cnt > 0u ? cnt : 1u;
}

__device__ __forceinline__ void xcd_barrier(const XcdBarrier& b) {
    asm volatile("s_waitcnt vmcnt(0)" ::: "memory");
    __syncthreads();
    if (threadIdx.x == 0) {
        unsigned* bar = b.bar;
        __builtin_amdgcn_s_waitcnt(0);
        unsigned nloc = b.st[0], nx = b.st[1];
        if (nloc == 0u) { xcd_barrier_complete(bar, b.x, nloc, nx); b.st[0] = nloc; b.st[1] = nx; }
        const unsigned old = xb_add(&bar[XB_XSUB(b.x)], 1u);
        const unsigned gen = old / nloc;
        if (old + 1u == (gen + 1u) * nloc) {
            __builtin_amdgcn_fence(__ATOMIC_RELEASE, "agent");
            asm volatile("s_waitcnt vmcnt(0)" ::: "memory");
            const unsigned og = xb_add(&bar[XB_TOP], 1u);
            const unsigned tg = og / nx;
            if (og + 1u == (tg + 1u) * nx) xb_add(&bar[XB_TOPGEN], 1u);
            else XB_SPIN(xb_ld(&bar[XB_TOPGEN]) == tg, bar);
            __builtin_amdgcn_fence(__ATOMIC_ACQUIRE, "agent");
            xb_add(&bar[XB_XGEN(b.x)], 1u);
            asm volatile("s_waitcnt vmcnt(0)" ::: "memory");
        } else {
            XB_SPIN(xb_ld(&bar[XB_XGEN(b.x)]) == gen, bar);
            __builtin_amdgcn_fence(__ATOMIC_ACQUIRE, "agent");
            asm volatile("s_waitcnt vmcnt(0)" ::: "memory");
        }
    }
    __syncthreads();
}

__global__ void __launch_bounds__(512, 2) k_mega(Params p) {
    extern __shared__ __attribute__((aligned(16))) unsigned char smem[];
    LAS unsigned char* lds = (LAS unsigned char*)smem;
    volatile LAS unsigned* xbw = (volatile LAS unsigned*)(lds + LDS_BYTES - 16);
    if (threadIdx.x == 0) { xbw[0] = 0u; xbw[1] = 0u; xbw[2] = 0u; xbw[3] = 0u; }
    __syncthreads();
    XcdBarrier bar = xcd_barrier_post((unsigned*)(p.ws + OFF_BAR), xbw);
    phase0(p, lds);      xcd_barrier(bar);
    phase1(p, lds);      xcd_barrier(bar);
    phase2(p, lds);      xcd_barrier(bar);
    phase3(p, lds);      xcd_barrier(bar);
    phase_attn(p, lds);
    phase_scan(p, lds);  xcd_barrier(bar);
    phase4(p, lds);      xcd_barrier(bar);
    phase5(p, lds);      xcd_barrier(bar);
    phase6(p, lds);      xcd_barrier(bar);
    phase7(p, lds);      xcd_barrier(bar);
    phase8(p, lds);      xcd_barrier(bar);
    phase9(p, lds);
}
extern "C" void kernel_launch(void* const* d_in, const int* in_sizes, int n_in, void* d_out, int out_size, void* d_ws, size_t ws_size, hipStream_t stream) {
    static int grid = 0;
    if (grid == 0) {
        int dev = 0, cus = 0, per_cu = 0;
        if (hipGetDevice(&dev) != hipSuccess || hipDeviceGetAttribute(&cus, hipDeviceAttributeMultiprocessorCount, dev) != hipSuccess) { grid = -1; return; }
        if (hipFuncSetAttribute((const void*)k_mega, hipFuncAttributeMaxDynamicSharedMemorySize, LDS_BYTES) != hipSuccess) { grid = -1; return; }
        (void)hipOccupancyMaxActiveBlocksPerMultiprocessor(&per_cu, (const void*)k_mega, 512, LDS_BYTES);
        (void)hipGetLastError();
        grid = cus;
    }
    if (grid < 0) return;
    Params p{};
    p.x = (const float*)d_in[0]; p.c = (const float*)d_in[1]; p.ctx = (const float*)d_in[2]; p.cctx = (const float*)d_in[3]; p.w_mod = (const float*)d_in[4]; p.b_mod = (const float*)d_in[5];
    p.g_mix = (const float*)d_in[6]; p.w_in = (const float*)d_in[7]; p.g_q = (const float*)d_in[8]; p.w_qb = (const float*)d_in[9]; p.g_kv = (const float*)d_in[10]; p.w_kvb = (const float*)d_in[11];
    p.lbl = (const float*)d_in[12]; p.g_hg = (const float*)d_in[13]; p.w_out = (const float*)d_in[14]; p.g_ffn = (const float*)d_in[15]; p.w_r = (const float*)d_in[16]; p.b_r = (const float*)d_in[17];
    p.w_gu = (const float*)d_in[18]; p.b_gu = (const float*)d_in[19]; p.w_dn = (const float*)d_in[20]; p.b_dn = (const float*)d_in[21]; p.g_fin = (const float*)d_in[22];
    p.out = (float*)d_out; p.ws = (char*)d_ws;
    (void)hipMemsetAsync((char*)d_ws + OFF_BAR, 0, 16384, stream);
    hipLaunchKernelGGL(k_mega, dim3(grid), dim3(512), LDS_BYTES, stream, p);
}
```

```cpp
#include <hip/hip_runtime.h>
#include <stdint.h>

typedef unsigned short bf16_t;
__device__ __forceinline__ float bf2f(bf16_t v) { return __uint_as_float(((unsigned)v) << 16); }
__device__ __forceinline__ bf16_t f2bf(float f) { unsigned u = __float_as_uint(f); u += 0x7FFFu + ((u >> 16) & 1u); return (bf16_t)(u >> 16); }
__device__ __forceinline__ float sigmoidf_(float x) { return __builtin_amdgcn_rcpf(1.0f + __builtin_amdgcn_exp2f(-1.4426950408889634f * x)); }
__device__ __forceinline__ float siluf_(float x) { return x * __builtin_amdgcn_rcpf(1.0f + __builtin_amdgcn_exp2f(-1.4426950408889634f * x)); }

constexpr int D = 1024, NB = 16, SEQ = 2048, CTXL = 256;
constexpr int L = NB * SEQ;
constexpr int RC = NB * CTXL;
constexpr int R = L + RC;
constexpr int NKEY = SEQ + CTXL;
constexpr float EPS = 1e-6f;
constexpr int NE = 32, CAP = 32768;
constexpr int MAXROWS = 131072 + NE * 256;

constexpr size_t MiB = 1048576;
constexpr size_t OFF_SMALL = 0;
constexpr size_t OFF_BAR = 0;
constexpr size_t OFF_CNT = 16384;
constexpr size_t OFF_OFFS = 16384 + 1024;
constexpr size_t OFF_TILEE = 16384 + 2048;
constexpr size_t OFF_LB = 24576;
constexpr size_t OFF_MOD = 32768;
constexpr size_t OFF_SSQQ = 512 * 1024;
constexpr size_t OFF_SSQKV = 768 * 1024;
constexpr size_t OFF_TOPI = 1 * MiB;
constexpr size_t OFF_TOPP = 1 * MiB + 512 * 1024;
constexpr size_t OFF_ROWPAIR = 2 * MiB;
constexpr size_t OFF_LIST = 3 * MiB;
constexpr size_t OFF_H = 32 * MiB;
constexpr size_t OFF_QA = 104 * MiB;
constexpr size_t OFF_CKV = 152 * MiB;
constexpr size_t OFF_KR = 170 * MiB;
constexpr size_t OFF_OF = 104 * MiB;
constexpr size_t OFF_HQ = 175 * MiB;
constexpr size_t SEG_STRIDE = 72 * MiB;
constexpr size_t OFF_FF = OFF_HQ + 1 * SEG_STRIDE;
constexpr size_t OFF_FB = OFF_HQ + 2 * SEG_STRIDE;
constexpr size_t OFF_IV = OFF_HQ + 3 * SEG_STRIDE;
constexpr size_t OFF_OG = OFF_HQ + 4 * SEG_STRIDE;
constexpr size_t OFF_GM = OFF_HQ + 5 * SEG_STRIDE;
constexpr size_t OFF_GH = OFF_HQ + 6 * SEG_STRIDE;
constexpr size_t OFF_Q = 679 * MiB;
constexpr size_t OFF_K = 775 * MiB;
constexpr size_t OFF_V = 883 * MiB;
constexpr size_t OFF_OB = 955 * MiB;
constexpr size_t OFF_YP = 296 * MiB;
constexpr size_t OFF_ACT = 568 * MiB;


__device__ __forceinline__ void rope_cs(int t, int i, float& cs, float& sn) {
    int j = i & 15; float inv = __expf(-(float)j * (9.210340371976184f / 16.0f)); float pos = (i < 16) ? (float)(t >> 6) : (float)(t & 63);
    float ang = pos * inv; cs = cosf(ang); sn = sinf(ang);
}

#define LAS __attribute__((address_space(3)))
__device__ __forceinline__ int otid() { int t = threadIdx.x; asm volatile("" : "+v"(t)); return t; }
typedef short bf16x8 __attribute__((ext_vector_type(8)));
typedef float f32x4 __attribute__((ext_vector_type(4)));
typedef unsigned u32x4 __attribute__((ext_vector_type(4)));
typedef unsigned u32x2 __attribute__((ext_vector_type(2)));
typedef float f32x2 __attribute__((ext_vector_type(2)));

constexpr size_t OFF_ROPE = 7 * MiB;
constexpr size_t OFF_WT_IN = 8 * MiB;
constexpr size_t OFF_WT_QB = 25 * MiB;
constexpr size_t OFF_WT_KVB = 28 * MiB;
constexpr size_t OFF_WT_OUT = 29 * MiB;
constexpr size_t OFF_WT_GU = 104 * MiB;
constexpr size_t OFF_WT_DN = 232 * MiB;
constexpr size_t OFF_YF8 = 775 * MiB;
constexpr size_t OFF_X1 = 704 * MiB;

struct Params {
    const float *x, *c, *ctx, *cctx, *w_mod, *b_mod, *g_mix, *w_in, *g_q, *w_qb, *g_kv, *w_kvb, *lbl, *g_hg, *w_out, *g_ffn, *w_r, *b_r, *w_gu, *b_gu, *w_dn, *b_dn, *g_fin;
    float* out; char* ws;
};

typedef __bf16 bf16v2_t __attribute__((ext_vector_type(2)));
__device__ __forceinline__ unsigned cvt_pk_bf16(float lo, float hi) { bf16v2_t v = {(__bf16)lo, (__bf16)hi}; return __builtin_bit_cast(unsigned, v); }

__device__ __forceinline__ unsigned pack4_fp8(float a, float b, float c, float d) {
    a = __builtin_amdgcn_fmed3f(a, -448.f, 448.f); b = __builtin_amdgcn_fmed3f(b, -448.f, 448.f); c = __builtin_amdgcn_fmed3f(c, -448.f, 448.f); d = __builtin_amdgcn_fmed3f(d, -448.f, 448.f);
    unsigned w = 0; w = __builtin_amdgcn_cvt_pk_fp8_f32(a, b, w, false); w = __builtin_amdgcn_cvt_pk_fp8_f32(c, d, w, true); return w; }

namespace pg8 {
constexpr int BM = 256, BK = 64, HALF = 128, HTB = HALF * BK * 2, STAGE_BYTES = 8 * HTB, NXCD = 8, WGM = 8;
constexpr int LDS_IDX = STAGE_BYTES + 8192;
__device__ __forceinline__ int lds_byte(int r, int c) { const int st = (r >> 4) * 2 + (c >> 5), rr = r & 15, cc = c & 31, ob = rr * 64 + cc * 2; return st * 1024 + (ob ^ (((ob >> 9) & 1) << 5)); }
__device__ __forceinline__ void stage_rc(int b, int& R, int& C) { const int st = b / 1024, sb = b % 1024, swz = sb ^ (((sb >> 9) & 1) << 5); R = (st >> 1) * 16 + swz / 64; C = (st & 1) * 32 + (swz % 64) / 2; }
__device__ __forceinline__ int perm32(int rho) { const int n = rho >> 4, i = rho & 15; return 8 * (i >> 2) + 4 * n + (i & 3); }
struct Unit { int pm, pn; const char* b; int e, pos0, cnt; };

__device__ __forceinline__ int xcd_remap(int L, int nwg) { const int q = nwg / NXCD, r = nwg % NXCD, xcd = L % NXCD, off = L / NXCD; return (xcd < r ? xcd * (q + 1) : r * (q + 1) + (xcd - r) * q) + off; }

struct DenseSched {
    int nM, nN, nwg, G, c, rowb; const char* Bt; size_t btile;
    __device__ void init(int M, int N, int kbytes, int rowb_, const void* Bt_, int G_, int c_) { nM = M / BM; nN = N / BM; nwg = nM * nN; G = G_; c = c_; rowb = rowb_; Bt = (const char*)Bt_; btile = (size_t)BM * kbytes; }
    static constexpr bool GATHER_LDS = false;
    __device__ __forceinline__ int kstepA() const { return 128; }
    __device__ __forceinline__ void tile(int wgid, int& pm, int& pn) const { const int nig = WGM * nN, gid = wgid / nig, fm = gid * WGM, gsz = (nM - fm) < WGM ? (nM - fm) : WGM; pm = fm + ((wgid % nig) % gsz); pn = (wgid % nig) / gsz; }
    __device__ __forceinline__ bool next(int i, Unit& u) const { const int Lx = i * G + c; if (Lx >= nwg) return false; tile(xcd_remap(Lx, nwg), u.pm, u.pn); u.b = Bt + (size_t)u.pn * btile; u.e = 0; u.pos0 = 0; u.cnt = 0; return true; }
    __device__ __forceinline__ void aoff(const Unit& u, const int (&Rr)[2], const int (&Cc)[2], unsigned (&va)[2][2]) const {
#pragma unroll
        for (int h = 0; h < 2; ++h)
#pragma unroll
            for (int i = 0; i < 2; ++i) va[h][i] = (unsigned)((u.pm * BM + h * HALF + Rr[i]) * rowb + Cc[i] * 2); }
};
struct InSched : DenseSched {
    __device__ void init2(const void* Bt_, int G_, int c_) { init(L, 8448, 1024, 1024, Bt_, G_, c_); }
    __device__ __forceinline__ bool next(int i, Unit& u) const {
        const int Lx = i * G + c; const int nlat = nwg;
        if (Lx < nlat) { tile(xcd_remap(Lx, nlat), u.pm, u.pn); }
        else { const int j = Lx - nlat; if (j >= 16 * 14) return false; const int q = j >> 4; u.pm = 128 + (j & 15); u.pn = q == 0 ? 3 : (q <= 12 ? 7 + q : 32); }
        u.b = Bt + (size_t)u.pn * btile; u.e = 0; u.pos0 = 0; u.cnt = 0; return true; }
};
__device__ __forceinline__ unsigned act_piece_off(int r, int c16) { const int s = 2 * (r >> 7) + (c16 >> 2), w = 4 * ((r >> 6) & 1) + (c16 & 3), l = 16 * ((r >> 4) & 3) + (r & 15); return (unsigned)(((s * 8 + w) * 64 + l) * 16); }
template <bool GATHER> struct MoeSched {
    int nN, G, c, rowb; const char* Wt; size_t wexp, btile; const LAS int* tab; const int* list;
    static constexpr bool GATHER_LDS = GATHER;
    __device__ __forceinline__ int kstepA() const { return GATHER ? 128 : 32768; }
    __device__ __forceinline__ bool next(int i, Unit& u) const {
        const int nwg = tab[33] * nN; const int Lx = i * G + c; if (Lx >= nwg) return false;
        const int w = xcd_remap(Lx, nwg); const int rt = w / nN; u.pn = w % nN; u.pm = rt;
        const int e = tab[128 + rt];
        u.e = e; u.pos0 = (rt - tab[e]) * BM; u.cnt = tab[64 + e]; u.b = Wt + (size_t)e * wexp + (size_t)u.pn * btile; return true; }
    __device__ __forceinline__ void aoff(const Unit& u, const int (&Rr)[2], const int (&Cc)[2], unsigned (&va)[2][2]) const {
#pragma unroll
        for (int h = 0; h < 2; ++h)
#pragma unroll
            for (int i = 0; i < 2; ++i) {
                if (GATHER) { const int pos = u.pos0 + h * HALF + Rr[i]; const int pair = pos < u.cnt ? list[u.e * CAP + pos] : 0; va[h][i] = (unsigned)((pair >> 2) * rowb + Cc[i] * 2); }
                else va[h][i] = (unsigned)u.pm * 262144u + act_piece_off(h * HALF + Rr[i], Cc[i] >> 3); } }
};

typedef int v8i_t __attribute__((ext_vector_type(8)));
typedef int i32x4_t __attribute__((ext_vector_type(4)));
template <class Epi, class Sched, bool FP8 = false, int SCA = 127, int SCB = 127>
__device__ __forceinline__ void gemm_phase(LAS unsigned char* lds, const char* Abase, const int K, const Sched& S, const Epi& E) {
    const int tid = otid(), wid = __builtin_amdgcn_readfirstlane(tid >> 6), lane = tid & 63, wr = wid >> 2, wc = wid & 3, fr = lane & 15, fq = lane >> 4;
    const int Kb = FP8 ? K : 2 * K;
    const int nt = Kb / (BK * 2);
    int Rr[2], Cc[2]; unsigned voffB[2];
#pragma unroll
    for (int i = 0; i < 2; ++i) { int R_, C_; stage_rc(tid * 16 + i * 8192, R_, C_); Rr[i] = R_; Cc[i] = C_; const int Rb = 64 * (R_ >> 5) + (Epi::PERM ? perm32(R_ & 31) : (R_ & 31)); voffB[i] = (unsigned)(Rb * Kb + C_ * 2); }
    const size_t kstep = (size_t)(BK * 2);
    const size_t kstepA = (size_t)S.kstepA();
    const size_t hstep = (size_t)32 * Kb;
    const unsigned ldsw = (unsigned)wid * 1024u;
    const int aoff = lds_byte(wr * 64 + fr, fq * 8), boff = lds_byte(wc * 32 + fr, fq * 8);
#define PG8_SA(b, h) (((b) * 2 + (h)) * HTB)
#define PG8_SB(b, h) ((4 + (b) * 2 + (h)) * HTB)
#define PG8_STAGE_B(bufoff, gbase) do { _Pragma("unroll") for (int _i = 0; _i < 2; ++_i) \
        __builtin_amdgcn_global_load_lds((const unsigned*)((const char*)(gbase) + voffB[_i]), (LAS unsigned*)(lds + (bufoff) + ldsw + _i * 8192), 16, 0, 0); } while (0)
#define PG8_STAGE_A(bufoff, v0, v1, kb) do { \
        __builtin_amdgcn_global_load_lds((const unsigned*)(Abase + (kb) + (v0)), (LAS unsigned*)(lds + (bufoff) + ldsw), 16, 0, 0); \
        __builtin_amdgcn_global_load_lds((const unsigned*)(Abase + (kb) + (v1)), (LAS unsigned*)(lds + (bufoff) + ldsw + 8192), 16, 0, 0); } while (0)
#define PG8_LD16(addr) (*(const LAS i32x4_t*)(addr))
#define PG8_LDA(dst, b, h) do { _Pragma("unroll") for (int m = 0; m < 4; ++m) { if constexpr (FP8) dst##8[m] = __builtin_shufflevector(PG8_LD16(lds + PG8_SA(b, h) + aoff + m * 2048), PG8_LD16(lds + PG8_SA(b, h) + aoff + m * 2048 + 1024), 0, 1, 2, 3, 4, 5, 6, 7); \
        else { _Pragma("unroll") for (int k = 0; k < 2; ++k) dst[m][k] = *(const LAS bf16x8*)(lds + PG8_SA(b, h) + aoff + m * 2048 + k * 1024); } } } while (0)
#define PG8_LDB(dst, b, h) do { _Pragma("unroll") for (int n = 0; n < 2; ++n) { if constexpr (FP8) dst##8[n] = __builtin_shufflevector(PG8_LD16(lds + PG8_SB(b, h) + boff + n * 2048), PG8_LD16(lds + PG8_SB(b, h) + boff + n * 2048 + 1024), 0, 1, 2, 3, 4, 5, 6, 7); \
        else { _Pragma("unroll") for (int k = 0; k < 2; ++k) dst[n][k] = *(const LAS bf16x8*)(lds + PG8_SB(b, h) + boff + n * 2048 + k * 1024); } } } while (0)
#define PG8_MMA(ai, bj, At, Bt) do { __builtin_amdgcn_s_setprio(1); _Pragma("unroll") for (int m = 0; m < 4; ++m) _Pragma("unroll") for (int n = 0; n < 2; ++n) { \
        if constexpr (FP8) asm volatile("v_mfma_scale_f32_16x16x128_f8f6f4 %0, %1, %2, %0, %3, %4 op_sel_hi:[0,0,0]" : "+v"(acc[ai][bj][m][n]) : "v"(Bt##8[n]), "v"(At##8[m]), "v"(scb_), "v"(sca_)); \
        else { _Pragma("unroll") for (int k = 0; k < 2; ++k) acc[ai][bj][m][n] = __builtin_amdgcn_mfma_f32_16x16x32_bf16(Bt[n][k], At[m][k], acc[ai][bj][m][n], 0, 0, 0); } } \
        __builtin_amdgcn_s_setprio(0); } while (0)
#define PG8_WAIT_V(n) asm volatile("s_waitcnt vmcnt(" #n ")" ::: "memory")
#define PG8_WAIT_L(n) asm volatile("s_waitcnt lgkmcnt(" #n ")" ::: "memory")
#define PG8_BAR __builtin_amdgcn_s_barrier()
#define PG8_SCHED __builtin_amdgcn_sched_barrier(0)
    Unit cur, nxt; int ui = 0;
    if (!S.next(0, cur)) return;
    f32x4 acc[2][2][4][2];
#pragma unroll
    for (int a = 0; a < 2; ++a)
#pragma unroll
        for (int b = 0; b < 2; ++b)
#pragma unroll
            for (int m = 0; m < 4; ++m)
#pragma unroll
                for (int n = 0; n < 2; ++n) acc[a][b][m][n] = (f32x4){0.f, 0.f, 0.f, 0.f};
    const int sca_ = SCA, scb_ = SCB;
    bf16x8 At[4][2], B0[2][2], B1[2][2]; v8i_t At8[4], B08[2], B18[2];
    unsigned vc[2][2], vn[2][2];
    S.aoff(cur, Rr, Cc, vc);
    const char* cB = cur.b;
    PG8_STAGE_B(PG8_SB(0, 0), cB); PG8_STAGE_A(PG8_SA(0, 0), vc[0][0], vc[0][1], 0); PG8_STAGE_B(PG8_SB(0, 1), cB + hstep); PG8_STAGE_A(PG8_SA(0, 1), vc[1][0], vc[1][1], 0);
    if (wr == 1) PG8_BAR;
    PG8_WAIT_V(4); PG8_BAR;
    PG8_STAGE_B(PG8_SB(1, 0), cB + kstep); PG8_STAGE_A(PG8_SA(1, 0), vc[0][0], vc[0][1], kstepA); PG8_STAGE_B(PG8_SB(1, 1), cB + hstep + kstep);
    PG8_WAIT_V(6); PG8_BAR;
    for (;;) {
        const bool has_next = S.next(ui + 1, nxt);
        if constexpr (Sched::GATHER_LDS) {
            if (has_next && wid < 4) __builtin_amdgcn_global_load_lds((const unsigned*)(S.list + nxt.e * CAP + nxt.pos0 + tid), (LAS unsigned*)(lds + LDS_IDX + wid * 256), 4, 0, 0);
        } else if (has_next) S.aoff(nxt, Rr, Cc, vn);
        if (!has_next) {
#pragma unroll
            for (int h = 0; h < 2; ++h)
#pragma unroll
                for (int i = 0; i < 2; ++i) vn[h][i] = vc[h][i]; }
        const char* nB = has_next ? nxt.b : cB;
#pragma unroll 1
        for (int t = 0; t < nt; t += 2) {
            const bool last = (t == nt - 2);
            if constexpr (Sched::GATHER_LDS) { if (last && has_next) {
#pragma unroll
                for (int h = 0; h < 2; ++h)
#pragma unroll
                    for (int i = 0; i < 2; ++i) { const int rr = h * HALF + Rr[i]; const int pair = (nxt.pos0 + rr) < nxt.cnt ? ((const LAS int*)(lds + LDS_IDX))[rr] : 0; vn[h][i] = (unsigned)((pair >> 2) * S.rowb + Cc[i] * 2); } } }
            const size_t k1 = (size_t)(t + 1) * kstepA;
            const size_t k2 = last ? 0 : (size_t)(t + 2) * kstepA;
            const unsigned s00 = last ? vn[0][0] : vc[0][0], s01 = last ? vn[0][1] : vc[0][1], s10 = last ? vn[1][0] : vc[1][0], s11 = last ? vn[1][1] : vc[1][1];
            const char* b2 = last ? nB : cB + (size_t)(t + 2) * kstep; const char* b3 = b2 + kstep;
            PG8_LDB(B0, 0, 0); PG8_SCHED; PG8_LDA(At, 0, 0); PG8_STAGE_A(PG8_SA(1, 1), vc[1][0], vc[1][1], k1);
            PG8_WAIT_L(8); PG8_BAR; PG8_WAIT_L(0); PG8_MMA(0, 0, At, B0); PG8_BAR; PG8_SCHED;
            PG8_LDB(B1, 0, 1); PG8_STAGE_B(PG8_SB(0, 0), b2);
            PG8_BAR; PG8_WAIT_L(0); PG8_MMA(0, 1, At, B1); PG8_BAR; if constexpr (FP8) PG8_SCHED;
            PG8_LDA(At, 0, 1); PG8_STAGE_A(PG8_SA(0, 0), s00, s01, k2);
            PG8_BAR; PG8_WAIT_L(0); PG8_MMA(1, 0, At, B0); PG8_BAR; PG8_SCHED;
            PG8_STAGE_B(PG8_SB(0, 1), b2 + hstep);
            PG8_WAIT_V(6); PG8_BAR; PG8_MMA(1, 1, At, B1); PG8_BAR; if constexpr (FP8) PG8_SCHED;
            PG8_LDB(B0, 1, 0); PG8_SCHED; PG8_LDA(At, 1, 0); PG8_STAGE_A(PG8_SA(0, 1), s10, s11, k2);
            PG8_WAIT_L(8); PG8_BAR; PG8_WAIT_L(0); PG8_MMA(0, 0, At, B0); PG8_BAR; PG8_SCHED;
            PG8_LDB(B1, 1, 1); PG8_STAGE_B(PG8_SB(1, 0), b3);
            PG8_BAR; PG8_WAIT_L(0); PG8_MMA(0, 1, At, B1); PG8_BAR; if constexpr (FP8) PG8_SCHED;
            PG8_LDA(At, 1, 1); PG8_STAGE_A(PG8_SA(1, 0), s00, s01, k2 + kstepA);
            PG8_BAR; PG8_WAIT_L(0); PG8_MMA(1, 0, At, B0); PG8_BAR; PG8_SCHED;
            PG8_STAGE_B(PG8_SB(1, 1), b3 + hstep);
            PG8_WAIT_V(6); PG8_BAR; PG8_MMA(1, 1, At, B1); PG8_BAR; if constexpr (FP8) PG8_SCHED;
        }
        if constexpr (FP8) asm volatile("s_nop 15\n\ts_nop 15" ::: "memory");
        E(acc, cur, wr, wc, fr, fq);
        if (!has_next) break;
#pragma unroll
        for (int a = 0; a < 2; ++a)
#pragma unroll
            for (int b = 0; b < 2; ++b)
#pragma unroll
                for (int m = 0; m < 4; ++m)
#pragma unroll
                    for (int n = 0; n < 2; ++n) acc[a][b][m][n] = (f32x4){0.f, 0.f, 0.f, 0.f};
        cur = nxt; cB = nB; ++ui;
#pragma unroll
        for (int h = 0; h < 2; ++h)
#pragma unroll
            for (int i = 0; i < 2; ++i) vc[h][i] = vn[h][i];
    }
    PG8_WAIT_V(0);
    if (wr == 0) PG8_BAR;
    PG8_BAR;
#undef PG8_SA
#undef PG8_SB
#undef PG8_STAGE_A
#undef PG8_STAGE_B
#undef PG8_LDA
#undef PG8_LDB
#undef PG8_MMA
#undef PG8_WAIT_V
#undef PG8_WAIT_L
#undef PG8_BAR
#undef PG8_SCHED
}

typedef f32x4 Acc[2][2][4][2];
__device__ __forceinline__ unsigned dpp_ror8(unsigned x) { return (unsigned)__builtin_amdgcn_update_dpp(0, (int)x, 0x128, 0xf, 0xf, false); }
__device__ __forceinline__ u32x4 ror8_4(const u32x4 v) { u32x4 r; r.x = dpp_ror8(v.x); r.y = dpp_ror8(v.y); r.z = dpp_ror8(v.z); r.w = dpp_ror8(v.w); return r; }
__device__ __forceinline__ void line_xy(const u32x4 a, const u32x4 b, bool lo, u32x4& X, u32x4& Y) { const u32x4 ra = ror8_4(a), rb = ror8_4(b); X = lo ? a : rb; Y = lo ? ra : b; }
__device__ __forceinline__ u32x4 pack8(const f32x4 v0, const f32x4 v1) { u32x4 w; w.x = cvt_pk_bf16(v0[0], v0[1]); w.y = cvt_pk_bf16(v0[2], v0[3]); w.z = cvt_pk_bf16(v1[0], v1[1]); w.w = cvt_pk_bf16(v1[2], v1[3]); return w; }

struct EpiIn { static constexpr bool PERM = true; char* ws;
    __device__ __forceinline__ void operator()(const Acc& acc, const Unit& u, int wr, int wc, int fr, int fq) const {
        const int pn = u.pn; size_t boff; int ld, cb;
        if (pn < 3) { boff = OFF_QA; ld = 384; cb = pn * 128; } else if (pn == 3) { boff = OFF_CKV; ld = 256; cb = 0; }
        else if (pn < 32) { boff = OFF_HQ + (size_t)((pn - 4) >> 2) * SEG_STRIDE; ld = 1024; cb = ((pn - 4) & 3) * 256; }
        else { boff = OFF_KR; ld = 64; cb = 0; }
        bf16_t* base = (bf16_t*)(ws + boff);
        if (pn == 32 && wc != 0) return;
        const bool lo = fr < 8; const int rowb0 = u.pm * BM + wr * 64, rx = fr & 7, colx = cb + wc * 64 + (fr >> 3) * 32 + 8 * fq;
        float* ssq = (float*)(ws + (pn < 3 ? OFF_SSQQ : OFF_SSQKV));
#pragma unroll
        for (int ai = 0; ai < 2; ++ai)
#pragma unroll
            for (int m = 0; m < 4; ++m) { const int rg = rowb0 + ai * HALF + m * 16;
                f32x4 v0 = acc[ai][0][m][0], v1 = acc[ai][0][m][1], w0 = acc[ai][1][m][0], w1 = acc[ai][1][m][1];
                if (pn >= 4 && pn < 8) {
#pragma unroll
                    for (int j = 0; j < 4; ++j) { v0[j] = siluf_(v0[j]) * 0.08838834764831845f; v1[j] = siluf_(v1[j]) * 0.08838834764831845f; w0[j] = siluf_(w0[j]) * 0.08838834764831845f; w1[j] = siluf_(w1[j]) * 0.08838834764831845f; } }
                if (pn < 3 || (pn >= 20 && pn < 32)) { unsigned char* qrow = pn < 3 ? (unsigned char*)base + (size_t)(rg + fr) * 768 + pn * 256 + wc * 64 + 8 * fq : (unsigned char*)base + (size_t)(rg + fr) * 1024 + (pn & 3) * 256 + wc * 64 + 8 * fq;
                    u32x2 a8; a8.x = pack4_fp8(v0[0], v0[1], v0[2], v0[3]); a8.y = pack4_fp8(v1[0], v1[1], v1[2], v1[3]); u32x2 b8; b8.x = pack4_fp8(w0[0], w0[1], w0[2], w0[3]); b8.y = pack4_fp8(w1[0], w1[1], w1[2], w1[3]);
                    *(u32x2*)qrow = a8; *(u32x2*)(qrow + 32) = b8; }
                else { u32x4 X, Y; line_xy(pack8(v0, v1), pack8(w0, w1), lo, X, Y);
                    __builtin_nontemporal_store(X, (u32x4*)(base + (size_t)(rg + rx) * ld + colx)); __builtin_nontemporal_store(Y, (u32x4*)(base + (size_t)(rg + 8 + rx) * ld + colx)); }
                if (pn <= 3) { float ss = (v0[0] * v0[0] + v0[1] * v0[1]) + (v0[2] * v0[2] + v0[3] * v0[3]) + (v1[0] * v1[0] + v1[1] * v1[1]) + (v1[2] * v1[2] + v1[3] * v1[3])
                                        + (w0[0] * w0[0] + w0[1] * w0[1]) + (w0[2] * w0[2] + w0[3] * w0[3]) + (w1[0] * w1[0] + w1[1] * w1[1]) + (w1[2] * w1[2] + w1[3] * w1[3]);
                    ss += __shfl_xor(ss, 16); ss += __shfl_xor(ss, 32); if (fq == 0) atomicAdd(ssq + rg + fr, ss); } }
    } };

struct EpiQ { static constexpr bool PERM = true; bf16_t* q; const float* ssq;
    __device__ __forceinline__ void operator()(const Acc& acc, const Unit& u, int wr, int wc, int fr, int fq) const {
        const bool lo = fr < 8; const int rowb0 = u.pm * BM + wr * 64, rx = fr & 7, colx = u.pn * BM + wc * 64 + (fr >> 3) * 32 + 8 * fq;
#pragma unroll
        for (int ai = 0; ai < 2; ++ai)
#pragma unroll
            for (int m = 0; m < 4; ++m) { const int rg = rowb0 + ai * HALF + m * 16; const float rs = rsqrtf(ssq[rg + fr] * (1.0f / 768.0f) + EPS);
                u32x4 X, Y; line_xy(pack8(acc[ai][0][m][0] * rs, acc[ai][0][m][1] * rs), pack8(acc[ai][1][m][0] * rs, acc[ai][1][m][1] * rs), lo, X, Y);
                *(u32x4*)(q + (size_t)(rg + rx) * 1536 + colx) = X; *(u32x4*)(q + (size_t)(rg + 8 + rx) * 1536 + colx) = Y; }
    } };

struct EpiKV { static constexpr bool PERM = true; bf16_t *Kb, *Vb; const float* ssq;
    __device__ __forceinline__ size_t kvrow(int row, int h) const { int b, pos; if (row < L) { b = row >> 11; pos = row & 2047; } else { b = (row - L) >> 8; pos = SEQ + ((row - L) & 255); } return (size_t)(b * 8 + h) * NKEY + pos; }
    __device__ __forceinline__ void operator()(const Acc& acc, const Unit& u, int wr, int wc, int fr, int fq) const {
        const bool lo = fr < 8; const int rowb0 = u.pm * BM + wr * 64, rx = fr & 7, colx = (wc & 1) * 64 + (fr >> 3) * 32 + 8 * fq;
        bf16_t* dst = wc < 2 ? Kb : Vb; const int ld = wc < 2 ? 192 : 128;
#pragma unroll
        for (int ai = 0; ai < 2; ++ai)
#pragma unroll
            for (int m = 0; m < 4; ++m) { const int rg = rowb0 + ai * HALF + m * 16; const float rs = rsqrtf(ssq[rg + fr] * (1.0f / 256.0f) + EPS);
                u32x4 X, Y; line_xy(pack8(acc[ai][0][m][0] * rs, acc[ai][0][m][1] * rs), pack8(acc[ai][1][m][0] * rs, acc[ai][1][m][1] * rs), lo, X, Y);
                *(u32x4*)(dst + kvrow(rg + rx, u.pn) * ld + colx) = X; *(u32x4*)(dst + kvrow(rg + 8 + rx, u.pn) * ld + colx) = Y; }
    } };

struct EpiOut { static constexpr bool PERM = true; bf16_t* x1; const float* x; const float* modv;
    __device__ __forceinline__ void operator()(const Acc& acc, const Unit& u, int wr, int wc, int fr, int fq) const {
        const bool lo = fr < 8; const int rowb0 = u.pm * BM + wr * 64, rx = fr & 7, colx = u.pn * BM + wc * 64 + (fr >> 3) * 32 + 8 * fq, cown = u.pn * BM + wc * 64 + 8 * fq;
#pragma unroll
        for (int ai = 0; ai < 2; ++ai)
#pragma unroll
            for (int m = 0; m < 4; ++m) { const int rg = rowb0 + ai * HALF + m * 16, row = rg + fr; const float* gate = modv + (row >> 11) * 6144 + 2 * 1024 + cown; const float* xr = x + (size_t)row * D + cown;
                f32x4 r[2][2];
#pragma unroll
                for (int bj = 0; bj < 2; ++bj)
#pragma unroll
                    for (int n = 0; n < 2; ++n) r[bj][n] = *(const f32x4*)(xr + bj * 32 + 4 * n) + *(const f32x4*)(gate + bj * 32 + 4 * n) * acc[ai][bj][m][n];
                u32x4 X, Y; line_xy(pack8(r[0][0], r[0][1]), pack8(r[1][0], r[1][1]), lo, X, Y);
                *(u32x4*)(x1 + (size_t)(rg + rx) * D + colx) = X; *(u32x4*)(x1 + (size_t)(rg + 8 + rx) * D + colx) = Y; }
    } };

struct EpiMoe1 { static constexpr bool PERM = true; unsigned char* act; const float* bgu;
    __device__ __forceinline__ void operator()(const Acc& acc, const Unit& u, int wr, int wc, int fr, int fq) const {
        const int o0 = u.pn * 128 + wc * 16 + 4 * fq;
        f32x4 bg[2], bl[2];
#pragma unroll
        for (int bj = 0; bj < 2; ++bj) { const float* bp = bgu + u.e * 2048 + 2 * (o0 + bj * 64); const f32x4 t0 = *(const f32x4*)bp, t1 = *(const f32x4*)(bp + 4);
            bg[bj] = (f32x4){t0[0], t0[2], t1[0], t1[2]}; bl[bj] = (f32x4){t0[1], t0[3], t1[1], t1[3]}; }
        unsigned char* blk = act + ((size_t)u.pm * 8 + u.pn) * 32768 + (size_t)(wr * 4 + wc) * 1024 + (size_t)(fq * 16 + fr) * 16;
#pragma unroll
        for (int ai = 0; ai < 2; ++ai)
#pragma unroll
            for (int bj = 0; bj < 2; ++bj) { unsigned d[4];
#pragma unroll
                for (int m = 0; m < 4; ++m) { const f32x4 g4 = acc[ai][bj][m][0] + bg[bj], l4 = acc[ai][bj][m][1] + bl[bj]; float r[4];
#pragma unroll
                    for (int j = 0; j < 4; ++j) { const float glu = fminf(g4[j], 7.0f), lin = __builtin_amdgcn_fmed3f(l4[j], -7.0f, 7.0f); r[j] = 4.0f * glu * __builtin_amdgcn_rcpf(1.0f + __builtin_amdgcn_exp2f(-2.4554669595930157f * glu)) * (lin + 1.0f); }
                    d[m] = pack4_fp8(r[0], r[1], r[2], r[3]); }
                const auto s01 = __builtin_amdgcn_permlane16_swap(d[0], d[1], false, false); const auto s23 = __builtin_amdgcn_permlane16_swap(d[2], d[3], false, false);
                const auto t02 = __builtin_amdgcn_permlane32_swap(s01[0], s23[0], false, false); const auto t13 = __builtin_amdgcn_permlane32_swap(s01[1], s23[1], false, false);
                *(u32x4*)(blk + (size_t)(ai * 2 + bj) * 8192) = (u32x4){t02[0], t13[0], t02[1], t13[1]}; }
    } };

struct EpiMoe2 { static constexpr bool PERM = true; bf16_t* yp; const float* bd;
    __device__ __forceinline__ void operator()(const Acc& acc, const Unit& u, int wr, int wc, int fr, int fq) const {
        const bool lo = fr < 8; const int rowb0 = u.pm * BM + wr * 64, rx = fr & 7, colx = u.pn * BM + wc * 64 + (fr >> 3) * 32 + 8 * fq, cown = u.pn * BM + wc * 64 + 8 * fq;
        f32x4 bv[2][2];
#pragma unroll
        for (int bj = 0; bj < 2; ++bj)
#pragma unroll
            for (int n = 0; n < 2; ++n) bv[bj][n] = *(const f32x4*)(bd + u.e * 1024 + cown + bj * 32 + 4 * n);
#pragma unroll
        for (int ai = 0; ai < 2; ++ai)
#pragma unroll
            for (int m = 0; m < 4; ++m) { const int rg = rowb0 + ai * HALF + m * 16;
                u32x4 X, Y; line_xy(pack8(acc[ai][0][m][0] + bv[0][0], acc[ai][0][m][1] + bv[0][1]), pack8(acc[ai][1][m][0] + bv[1][0], acc[ai][1][m][1] + bv[1][1]), lo, X, Y);
                __builtin_nontemporal_store(X, (u32x4*)(yp + (size_t)(rg + rx) * D + colx)); __builtin_nontemporal_store(Y, (u32x4*)(yp + (size_t)(rg + 8 + rx) * D + colx)); }
    } };
}

__device__ __forceinline__ int conv_src_col(int kind, int c) {
    if (kind == 0) return c;
    if (kind == 1) { if (c < 1024) return c; if (c < 8192) return c + 64; if (c < 8256) return c - 8192 + 1024; return -1; }
    const int pn = c >> 8, p = c & 255, wc = p >> 6, bj = (p >> 5) & 1, fq = (p >> 3) & 3, n = (p >> 2) & 1, i = p & 3; const int o = 128 * pn + 64 * bj + 16 * wc + 4 * fq + i; return 2 * o + n;
}
template <bool F8> struct ConvPipe {
    float v[32]; bool have; bf16_t* dummy;
    int K, kind, k0, c0; void* Wt;
    __device__ __forceinline__ void issue(const float* __restrict__ W, int ldw, void* Wt_, int K_, int kind_, const float* __restrict__ kscale, int k0_, int c0_) {
        const int tid = otid(); const int cc = tid & 127, kq = tid >> 7, sc = conv_src_col(kind_, c0_ + cc);
        const int scc = sc < 0 ? 0 : sc; const float* wp = W + (size_t)(k0_ + kq) * ldw + scc;
#pragma unroll
        for (int i = 0; i < 32; ++i) v[i] = __builtin_nontemporal_load(wp + (size_t)(4 * i) * ldw);
        if (sc < 0) {
#pragma unroll
            for (int i = 0; i < 32; ++i) v[i] = 0.f; }
        if (kscale) {
#pragma unroll
            for (int i = 0; i < 32; ++i) v[i] *= kscale[k0_ + kq + 4 * i]; }
        K = K_; kind = kind_; k0 = k0_; c0 = c0_; Wt = Wt_; have = true;
    }
    __device__ __forceinline__ void flush(LAS float* tl) {
        if (!have) return; have = false;
        const int tid = otid(); const int cc = tid & 127, kq = tid >> 7;
        __syncthreads();
#pragma unroll
        for (int i = 0; i < 32; ++i) tl[(kq + 4 * i) * 129 + cc] = v[i];
        __syncthreads();
        stash(tl, tid);
    }
    __device__ __forceinline__ void to_lds(LAS float* tl) { const int tid = otid(); const int cc = tid & 127, kq = tid >> 7; __syncthreads();
#pragma unroll
        for (int i = 0; i < 32; ++i) tl[(kq + 4 * i) * 129 + cc] = v[i];
        __syncthreads(); }
    __device__ __forceinline__ void stash(LAS float* tl, int tid) const {
        if constexpr (F8) {
#pragma unroll
            for (int pss = 0; pss < 2; ++pss) { const int item = tid + 512 * pss, c2 = item >> 3, ch = item & 7; float t[16];
#pragma unroll
                for (int j = 0; j < 16; ++j) t[j] = tl[(16 * ch + j) * 129 + c2] * 32.f;
                u32x4 w; w.x = pack4_fp8(t[0], t[1], t[2], t[3]); w.y = pack4_fp8(t[4], t[5], t[6], t[7]); w.z = pack4_fp8(t[8], t[9], t[10], t[11]); w.w = pack4_fp8(t[12], t[13], t[14], t[15]);
                *(u32x4*)((unsigned char*)Wt + (size_t)(c0 + c2) * K + k0 + 16 * ch) = w; }
        } else {
#pragma unroll
            for (int pss = 0; pss < 4; ++pss) { const int item = tid + 512 * pss, c2 = item >> 4, ch = item & 15; float t[8];
#pragma unroll
                for (int j = 0; j < 8; ++j) t[j] = tl[(8 * ch + j) * 129 + c2];
                u32x4 w; w.x = cvt_pk_bf16(t[0], t[1]); w.y = cvt_pk_bf16(t[2], t[3]); w.z = cvt_pk_bf16(t[4], t[5]); w.w = cvt_pk_bf16(t[6], t[7]);
                *(u32x4*)((bf16_t*)Wt + (size_t)(c0 + c2) * K + k0 + 8 * ch) = w; }
        }
    }
};
template <bool F8>
__device__ __forceinline__ void conv_matrix(LAS float* tl, ConvPipe<F8>& pipe, const float* W, int ldw, void* Wt, int K, int Nout, int kind, const float* kscale, int& tctr) {
    const int nk = K / 128, ntile = nk * (Nout / 128);
    int t = ((int)blockIdx.x - tctr) % (int)gridDim.x; if (t < 0) t += gridDim.x;
    for (; t < ntile; t += gridDim.x) {
        if (pipe.have) { pipe.to_lds(tl); const int K0 = pipe.K, k00 = pipe.k0, c00 = pipe.c0; void* W0 = pipe.Wt; ConvPipe<F8> done = pipe; (void)K0; (void)k00; (void)c00; (void)W0;
            pipe.issue(W, ldw, Wt, K, kind, kscale, (t % nk) * 128, (t / nk) * 128); done.stash(tl, otid()); }
        else pipe.issue(W, ldw, Wt, K, kind, kscale, (t % nk) * 128, (t / nk) * 128);
    }
    tctr = (tctr + ntile) % (int)gridDim.x;
}
template <bool F8> __device__ __forceinline__ void conv_finish(LAS float* tl, ConvPipe<F8>& pipe) { if (pipe.have) { pipe.to_lds(tl); pipe.stash(tl, otid()); pipe.have = false; } __syncthreads(); }

__device__ __forceinline__ float half_sum256(float v, LAS float* red) {
    for (int o = 32; o > 0; o >>= 1) v += __shfl_xor(v, o);
    const int w = otid() >> 6, hb = (otid() >> 8) * 4; if ((otid() & 63) == 0) red[w] = v; __syncthreads();
    const float t = red[hb] + red[hb + 1] + red[hb + 2] + red[hb + 3]; __syncthreads(); return t;
}

__device__ __forceinline__ void phase0(const Params& p, LAS unsigned char* lds) {
    char* ws = p.ws; const int tid = otid(), gsz = gridDim.x * 512, gid = blockIdx.x * 512 + tid;
    float* lb = (float*)(ws + OFF_LB); int* cnt = (int*)(ws + OFF_CNT); float* ssqq = (float*)(ws + OFF_SSQQ); float* ssqkv = (float*)(ws + OFF_SSQKV); float* modv = (float*)(ws + OFF_MOD);
    for (int i = gid; i < 2048; i += gsz) { const int d = i >> 10, j = i & 1023; const float a = p.lbl[(d * 2 + 0) * 1024 + j], b = p.lbl[(d * 2 + 1) * 1024 + j]; lb[i] = 1.0f / (1.0f + __expf(b - a)); }
    for (int i = gid; i < 32; i += gsz) cnt[i] = 0;
    { float* ropet = (float*)(ws + OFF_ROPE); for (int i = gid; i < SEQ * 32; i += gsz) { const int t = i >> 5, j = i & 31; float cs, sn; rope_cs(t, j, cs, sn); ropet[t * 64 + j] = cs; ropet[t * 64 + 32 + j] = sn; } }
    for (int i = gid; i < L; i += gsz) ssqq[i] = 0.f;
    for (int i = gid; i < R; i += gsz) ssqkv[i] = 0.f;
    { LAS float* sil = (LAS float*)lds;
      LAS float* part = (LAS float*)(lds + 17 * 1024 * 4);
      bool loaded = false;
      for (int item = blockIdx.x; item < 96; item += gridDim.x) {
          if (!loaded) { for (int i = tid; i < 17 * 1024; i += 512) { const int r = i >> 10, k = i & 1023; sil[i] = siluf_(r < 16 ? p.c[r * 1024 + k] : p.cctx[k]); } loaded = true; __syncthreads(); }
          const int j = tid & 63, ks = tid >> 6; float a[17];
#pragma unroll
          for (int r = 0; r < 17; ++r) a[r] = 0.f;
          for (int k = ks * 128; k < ks * 128 + 128; ++k) { const float w = p.w_mod[(size_t)k * 6144 + item * 64 + j];
#pragma unroll
              for (int r = 0; r < 17; ++r) a[r] += sil[r * 1024 + k] * w; }
#pragma unroll
          for (int r = 0; r < 17; ++r) part[(ks * 17 + r) * 64 + j] = a[r];
          __syncthreads();
          for (int i = tid; i < 17 * 64; i += 512) { const int r = i >> 6, jj = i & 63; float s = p.b_mod[item * 64 + jj]; for (int q = 0; q < 8; ++q) s += part[(q * 17 + r) * 64 + jj]; modv[r * 6144 + item * 64 + jj] = s; }
          __syncthreads();
      } }
    __syncthreads();
    { LAS float* tl = (LAS float*)lds; int tctr = 0;
      { ConvPipe<true> pp; pp.have = false; conv_matrix<true>(tl, pp, p.w_in, 8256, (unsigned char*)(ws + OFF_WT_IN), 1024, 8448, 1, nullptr, tctr); conv_finish<true>(tl, pp); }
      { ConvPipe<true> pp; pp.have = false;
        conv_matrix<true>(tl, pp, p.w_qb, 1536, (unsigned char*)(ws + OFF_WT_QB), 768, 1536, 0, p.g_q, tctr);
        conv_matrix<true>(tl, pp, p.w_out, 1024, (unsigned char*)(ws + OFF_WT_OUT), 1024, 1024, 0, nullptr, tctr); conv_finish<true>(tl, pp); }
      { ConvPipe<false> pp; pp.have = false;
        conv_matrix<false>(tl, pp, p.w_kvb, 2048, (bf16_t*)(ws + OFF_WT_KVB), 256, 2048, 0, p.g_kv, tctr); conv_finish<false>(tl, pp); } }
}

__device__ __forceinline__ float wave_sum(float v) {
#pragma unroll
    for (int o = 32; o > 0; o >>= 1) v += __shfl_xor(v, o);
    return v; }
__device__ __forceinline__ void phase1(const Params& p, LAS unsigned char* lds) {
    const float* modv = (const float*)(p.ws + OFF_MOD); unsigned char* h = (unsigned char*)(p.ws + OFF_H);
    const int tid = otid(), lane = tid & 63, gw = blockIdx.x * 8 + (tid >> 6), nw = gridDim.x * 8, c0 = lane * 8;
    f32x4 g[4];
#pragma unroll
    for (int q = 0; q < 4; ++q) g[q] = *(const f32x4*)(p.g_mix + (q >> 1) * 512 + c0 + (q & 1) * 4);
    for (int row0 = gw; row0 < R; row0 += 2 * nw) {
        f32x4 v[2][4]; const bool two = row0 + nw < R;
#pragma unroll
        for (int u = 0; u < 2; ++u) { const int row = (u == 0 || two) ? row0 + u * nw : row0; const float* src = row < L ? p.x + (size_t)row * D : p.ctx + (size_t)(row - L) * D;
#pragma unroll
            for (int q = 0; q < 4; ++q) v[u][q] = __builtin_nontemporal_load((const f32x4*)(src + (q >> 1) * 512 + c0 + (q & 1) * 4)); }
#pragma unroll
        for (int u = 0; u < 2; ++u) { if (u == 1 && !two) break; const int row = row0 + u * nw; const float* mod = modv + (row < L ? row / SEQ : 16) * 6144;
            float ss = 0.f;
#pragma unroll
            for (int q = 0; q < 4; ++q) ss += (v[u][q][0] * v[u][q][0] + v[u][q][1] * v[u][q][1]) + (v[u][q][2] * v[u][q][2] + v[u][q][3] * v[u][q][3]);
            const float rs = rsqrtf(wave_sum(ss) * (1.0f / D) + EPS);
#pragma unroll
            for (int j = 0; j < 2; ++j) { f32x4 o[2];
#pragma unroll
                for (int e = 0; e < 2; ++e) { const int cc = j * 512 + c0 + e * 4; const f32x4 sc = *(const f32x4*)(mod + 1024 + cc), sh = *(const f32x4*)(mod + cc); o[e] = v[u][j * 2 + e] * rs * g[j * 2 + e] * (sc + 1.0f) + sh; }
                u32x2 w; w.x = pack4_fp8(o[0][0], o[0][1], o[0][2], o[0][3]); w.y = pack4_fp8(o[1][0], o[1][1], o[1][2], o[1][3]);
                *(u32x2*)(h + (size_t)row * D + j * 512 + c0) = w; } }
    }
}


__device__ __forceinline__ void phase2(const Params& p, LAS unsigned char* lds) {
    pg8::InSched S; S.init2(p.ws + OFF_WT_IN, gridDim.x, blockIdx.x);
    pg8::EpiIn E{p.ws};
    pg8::gemm_phase<pg8::EpiIn, pg8::InSched, true, 127, 122>(lds, (const char*)(p.ws + OFF_H), 1024, S, E);
}
__device__ __forceinline__ void phase3(const Params& p, LAS unsigned char* lds) {
    char* ws = p.ws;
    { pg8::DenseSched S; S.init(L, 1536, 768, 768, ws + OFF_WT_QB, gridDim.x, blockIdx.x); pg8::EpiQ E{(bf16_t*)(ws + OFF_Q), (const float*)(ws + OFF_SSQQ)}; pg8::gemm_phase<pg8::EpiQ, pg8::DenseSched, true, 127, 122>(lds, (const char*)(ws + OFF_QA), 768, S, E); }
    { pg8::DenseSched S; S.init(R, 2048, 256 * 2, 256 * 2, ws + OFF_WT_KVB, gridDim.x, blockIdx.x); pg8::EpiKV E{(bf16_t*)(ws + OFF_K), (bf16_t*)(ws + OFF_V), (const float*)(ws + OFF_SSQKV)}; pg8::gemm_phase(lds, (const char*)(ws + OFF_CKV), 256, S, E); }
    { const bf16_t* kr = (const bf16_t*)(ws + OFF_KR); bf16_t* Kb = (bf16_t*)(ws + OFF_K); const float* ropet = (const float*)(ws + OFF_ROPE);
      for (int gid = blockIdx.x * 512 + otid(); gid < R * 32; gid += gridDim.x * 512) { const int row = gid >> 5, i = gid & 31;
          const float x1 = bf2f(kr[(size_t)row * 64 + i]), x2 = bf2f(kr[(size_t)row * 64 + 32 + i]); float o1 = x1, o2 = x2; int b, pos;
          if (row < L) { b = row / SEQ; pos = row % SEQ; const float cs = ropet[pos * 64 + i], sn = ropet[pos * 64 + 32 + i]; o1 = x1 * cs - x2 * sn; o2 = x1 * sn + x2 * cs; } else { b = (row - L) / CTXL; pos = SEQ + (row - L) % CTXL; }
          const bf16_t w1 = f2bf(o1), w2 = f2bf(o2);
          for (int h = 0; h < 8; ++h) { bf16_t* q = Kb + ((size_t)(b * 8 + h) * NKEY + pos) * 192 + 128; q[i] = w1; q[32 + i] = w2; } } }
}
__device__ __forceinline__ void unpack8_fp8(const u32x2 w, float (&o)[8]) {
    o[0] = __builtin_amdgcn_cvt_f32_fp8((int)w.x, 0); o[1] = __builtin_amdgcn_cvt_f32_fp8((int)w.x, 1); o[2] = __builtin_amdgcn_cvt_f32_fp8((int)w.x, 2); o[3] = __builtin_amdgcn_cvt_f32_fp8((int)w.x, 3);
    o[4] = __builtin_amdgcn_cvt_f32_fp8((int)w.y, 0); o[5] = __builtin_amdgcn_cvt_f32_fp8((int)w.y, 1); o[6] = __builtin_amdgcn_cvt_f32_fp8((int)w.y, 2); o[7] = __builtin_amdgcn_cvt_f32_fp8((int)w.y, 3); }
__device__ __forceinline__ void unpack8(const u32x4 w, float (&o)[8]) {
    o[0] = __uint_as_float(w.x << 16); o[1] = __uint_as_float(w.x & 0xffff0000u); o[2] = __uint_as_float(w.y << 16); o[3] = __uint_as_float(w.y & 0xffff0000u);
    o[4] = __uint_as_float(w.z << 16); o[5] = __uint_as_float(w.z & 0xffff0000u); o[6] = __uint_as_float(w.w << 16); o[7] = __uint_as_float(w.w & 0xffff0000u); }
__device__ __forceinline__ void phase4(const Params& p, LAS unsigned char*) {
    char* ws = p.ws; bf16_t* y = (bf16_t*)(ws + OFF_H); const bf16_t* of = (const bf16_t*)(ws + OFF_OF); const bf16_t* ob = (const bf16_t*)(ws + OFF_OB);
    const unsigned char* og = (const unsigned char*)(ws + OFF_OG); const unsigned char* gm = (const unsigned char*)(ws + OFF_GM); const unsigned char* gh = (const unsigned char*)(ws + OFF_GH);
    const int tid = otid(), lane = tid & 63, gw = blockIdx.x * 8 + (tid >> 6), nw = gridDim.x * 8, c0 = lane * 8;
    float gg[8];
#pragma unroll
    for (int i = 0; i < 8; ++i) gg[i] = p.g_hg[(c0 + i) & 127];
    for (int row = gw; row < L; row += nw) {
        u32x4 ra[2], rb[2], rm[2]; u32x2 r1[2], r2[2], r3[2];
#pragma unroll
        for (int j = 0; j < 2; ++j) { const size_t off = (size_t)row * D + j * 512 + c0; ra[j] = __builtin_nontemporal_load((const u32x4*)(of + off)); rb[j] = __builtin_nontemporal_load((const u32x4*)(ob + off)); r1[j] = __builtin_nontemporal_load((const u32x2*)(og + off)); r2[j] = __builtin_nontemporal_load((const u32x2*)(gm + off)); r3[j] = __builtin_nontemporal_load((const u32x2*)(gh + off)); rm[j] = __builtin_nontemporal_load((const u32x4*)(y + off)); }
#pragma unroll
        for (int j = 0; j < 2; ++j) { float a[8], b[8], g1[8], g2[8], g3[8], ym[8], o[8]; unpack8(ra[j], a); unpack8(rb[j], b); unpack8_fp8(r1[j], g1); unpack8_fp8(r2[j], g2); unpack8_fp8(r3[j], g3); unpack8(rm[j], ym);
            float ss = 0.f;
#pragma unroll
            for (int i = 0; i < 8; ++i) { o[i] = a[i] + b[i]; ss += o[i] * o[i]; }
            ss += __shfl_xor(ss, 1); ss += __shfl_xor(ss, 2); ss += __shfl_xor(ss, 4); ss += __shfl_xor(ss, 8);
            const float rs = rsqrtf(ss * (1.0f / 128.0f) + EPS); float r[8];
#pragma unroll
            for (int i = 0; i < 8; ++i) { const float yh = o[i] * rs * gg[i] * siluf_(g1[i]); r[i] = sigmoidf_(g2[i]) * ym[i] + sigmoidf_(g3[i]) * yh; }
            u32x2 w; w.x = pack4_fp8(r[0], r[1], r[2], r[3]); w.y = pack4_fp8(r[4], r[5], r[6], r[7]);
            *(u32x2*)((unsigned char*)(ws + OFF_YF8) + (size_t)row * D + j * 512 + c0) = w; }
    }
}
__device__ __forceinline__ void phase5(const Params& p, LAS unsigned char* lds) {
    char* ws = p.ws;
    { pg8::DenseSched S; S.init(L, 1024, 1024, 1024, ws + OFF_WT_OUT, gridDim.x, blockIdx.x); pg8::EpiOut E{(bf16_t*)(ws + OFF_X1), p.x, (const float*)(ws + OFF_MOD)}; pg8::gemm_phase<pg8::EpiOut, pg8::DenseSched, true, 127, 122>(lds, (const char*)(ws + OFF_YF8), 1024, S, E); }
    { LAS float* tl = (LAS float*)lds; int tctr = 0; ConvPipe<true> pp; pp.have = false;
      for (int e = 0; e < NE; ++e) conv_matrix<true>(tl, pp, p.w_gu + (size_t)e * 1024 * 2048, 2048, (unsigned char*)(ws + OFF_WT_GU) + (size_t)e * 2048 * 1024, 1024, 2048, 2, nullptr, tctr);
      for (int e = 0; e < NE; ++e) conv_matrix<true>(tl, pp, p.w_dn + (size_t)e * 1024 * 1024, 1024, (unsigned char*)(ws + OFF_WT_DN) + (size_t)e * 1024 * 1024, 1024, 1024, 0, nullptr, tctr);
      conv_finish<true>(tl, pp); }
}
__device__ __forceinline__ void phase6(const Params& p, LAS unsigned char* lds) {
    char* ws = p.ws; const float* modv = (const float*)(ws + OFF_MOD); unsigned char* h2 = (unsigned char*)(ws + OFF_H); int* topi = (int*)(ws + OFF_TOPI); float* topp = (float*)(ws + OFF_TOPP); int* cnt = (int*)(ws + OFF_CNT); int* list = (int*)(ws + OFF_LIST); int* pairpos = (int*)(ws + OFF_ROWPAIR);
    LAS float* hs = (LAS float*)lds;
    LAS float* lg = (LAS float*)(lds + 131072);
    LAS int* lcnt = (LAS int*)(lds + 131072 + 4096);
    LAS int* lent = (LAS int*)(lds + 131072 + 4096 + 512);
    const int tid = otid(), lane = tid & 63, wid = tid >> 6, c0 = lane * 8;
    if (tid < 96) lcnt[tid] = 0;
    f32x4 g[4];
#pragma unroll
    for (int q = 0; q < 4; ++q) g[q] = *(const f32x4*)(p.g_ffn + (q >> 1) * 512 + c0 + (q & 1) * 4);
    __syncthreads();
    int it = 0;
    for (int tile = blockIdx.x; tile < L / 32; tile += gridDim.x, ++it) {
        const int rbase = tile * 32;
        f32x4 v[4][4];
#pragma unroll
        for (int u = 0; u < 4; ++u)
#pragma unroll
            for (int j = 0; j < 2; ++j) { float t8[8]; unpack8(*(const u32x4*)((const bf16_t*)(ws + OFF_X1) + (size_t)(rbase + wid * 4 + u) * D + j * 512 + c0), t8); v[u][2 * j] = (f32x4){t8[0], t8[1], t8[2], t8[3]}; v[u][2 * j + 1] = (f32x4){t8[4], t8[5], t8[6], t8[7]}; }
#pragma unroll
        for (int u = 0; u < 4; ++u) { const int rl = wid * 4 + u, row = rbase + rl; const float* mod = modv + (row / SEQ) * 6144; float ss = 0.f;
#pragma unroll
            for (int q = 0; q < 4; ++q) ss += (v[u][q][0] * v[u][q][0] + v[u][q][1] * v[u][q][1]) + (v[u][q][2] * v[u][q][2] + v[u][q][3] * v[u][q][3]);
            const float rs = rsqrtf(wave_sum(ss) * (1.0f / D) + EPS);
#pragma unroll
            for (int j = 0; j < 2; ++j) { f32x4 o[2];
#pragma unroll
                for (int e = 0; e < 2; ++e) { const int cc = j * 512 + c0 + e * 4; const f32x4 sc = *(const f32x4*)(mod + 4 * 1024 + cc), sh = *(const f32x4*)(mod + 3 * 1024 + cc); o[e] = v[u][j * 2 + e] * rs * g[j * 2 + e] * (sc + 1.0f) + sh;
                    *(LAS f32x4*)(hs + rl * 1024 + cc) = o[e]; }
                u32x2 w; w.x = pack4_fp8(o[0][0], o[0][1], o[0][2], o[0][3]); w.y = pack4_fp8(o[1][0], o[1][1], o[1][2], o[1][3]);
                *(u32x2*)(h2 + (size_t)row * D + j * 512 + c0) = w; } }
        __syncthreads();
        { const int e = tid & 31, rg = tid >> 5; const LAS float* h0 = hs + (2 * rg) * 1024; const LAS float* h1 = h0 + 1024; float a0 = 0.f, a1 = 0.f;
          for (int j = 0; j < 1024; j += 8) { float w[8];
#pragma unroll
              for (int q = 0; q < 8; ++q) w[q] = p.w_r[(j + q) * 32 + e];
              const f32x4 x0 = *(const LAS f32x4*)(h0 + j), x1 = *(const LAS f32x4*)(h0 + j + 4), y0 = *(const LAS f32x4*)(h1 + j), y1 = *(const LAS f32x4*)(h1 + j + 4);
              a0 += x0[0] * w[0]; a0 += x0[1] * w[1]; a0 += x0[2] * w[2]; a0 += x0[3] * w[3]; a0 += x1[0] * w[4]; a0 += x1[1] * w[5]; a0 += x1[2] * w[6]; a0 += x1[3] * w[7];
              a1 += y0[0] * w[0]; a1 += y0[1] * w[1]; a1 += y0[2] * w[2]; a1 += y0[3] * w[3]; a1 += y1[0] * w[4]; a1 += y1[1] * w[5]; a1 += y1[2] * w[6]; a1 += y1[3] * w[7]; }
          const float be = p.b_r[e]; lg[(2 * rg) * 32 + e] = a0 + be; lg[(2 * rg + 1) * 32 + e] = a1 + be; }
        __syncthreads();
#pragma unroll
        for (int rep = 0; rep < 2; ++rep) { const int rl = wid * 4 + rep * 2 + (lane >> 5), row = rbase + rl, e = lane & 31; float cur = lg[rl * 32 + e];
            float tv0 = 0.f, sum = 0.f; int sel_i[4]; float sel_e[4];
#pragma unroll
            for (int k = 0; k < 4; ++k) { float m = cur; int mi = e;
#pragma unroll
                for (int o2 = 16; o2 > 0; o2 >>= 1) { const float om = __shfl_xor(m, o2); const int oi = __shfl_xor(mi, o2); if (om > m || (om == m && oi < mi)) { m = om; mi = oi; } }
                if (k == 0) tv0 = m; sel_i[k] = mi; sel_e[k] = __expf(m - tv0); sum += sel_e[k]; if (e == mi) cur = -3.0e38f; }
            int myk = 0; float myp = 0.f;
#pragma unroll
            for (int k = 0; k < 4; ++k) if (e == k) { myk = sel_i[k]; myp = sel_e[k] / sum; }
            if (e < 4) { const int pair = row * 4 + e; topi[pair] = myk; topp[pair] = myp; __hip_atomic_fetch_add(&lcnt[myk], 1, __ATOMIC_RELAXED, __HIP_MEMORY_SCOPE_WORKGROUP); lent[(it * 32 + rl) * 4 + e] = myk; } }
        __syncthreads();
    }
    if (tid < 32) { const int n = lcnt[tid]; lcnt[32 + tid] = n > 0 ? atomicAdd(&cnt[tid], n) : 0; lcnt[64 + tid] = 0; }
    __syncthreads();
    const int nent = it * 128;
    for (int s = tid; s < nent; s += 512) { const int e = lent[s]; const int ii = s >> 7, rl = (s >> 2) & 31, k = s & 3; const int row = (blockIdx.x + ii * gridDim.x) * 32 + rl;
        const int pos = lcnt[32 + e] + __hip_atomic_fetch_add(&lcnt[64 + e], 1, __ATOMIC_RELAXED, __HIP_MEMORY_SCOPE_WORKGROUP); list[e * CAP + pos] = row * 4 + k; pairpos[row * 4 + k] = pos; }
}
__device__ __forceinline__ void moe_table(const int* cnt, LAS int* tab) {
    if (otid() == 0) { int t = 0; for (int e = 0; e < NE; ++e) { tab[e] = t; const int n = cnt[e]; tab[64 + e] = n; t += (n + 255) >> 8; } tab[32] = t; tab[33] = t; }
    __syncthreads();
    for (int rt = otid(); rt < tab[33]; rt += 512) { int e = 0; while (tab[e + 1] <= rt) ++e; tab[128 + rt] = e; }
    __syncthreads();
}
constexpr int LDS_TAB = pg8::STAGE_BYTES;
__device__ __forceinline__ void phase7(const Params& p, LAS unsigned char* lds) {
    char* ws = p.ws; LAS int* tab = (LAS int*)(lds + LDS_TAB); moe_table((const int*)(ws + OFF_CNT), tab);
    pg8::MoeSched<true> S; S.nN = 8; S.G = gridDim.x; S.c = blockIdx.x; S.rowb = 1024; S.Wt = ws + OFF_WT_GU; S.wexp = (size_t)2048 * 1024; S.btile = (size_t)256 * 1024; S.tab = tab; S.list = (const int*)(ws + OFF_LIST);
    pg8::EpiMoe1 E{(unsigned char*)(ws + OFF_ACT), p.b_gu};
    pg8::gemm_phase<pg8::EpiMoe1, pg8::MoeSched<true>, true, 127, 122>(lds, (const char*)(ws + OFF_H), 1024, S, E);
}
__device__ __forceinline__ void phase8(const Params& p, LAS unsigned char* lds) {
    char* ws = p.ws; LAS int* tab = (LAS int*)(lds + LDS_TAB); moe_table((const int*)(ws + OFF_CNT), tab);
    pg8::MoeSched<false> S; S.nN = 4; S.G = gridDim.x; S.c = blockIdx.x; S.rowb = 1024; S.Wt = ws + OFF_WT_DN; S.wexp = (size_t)1024 * 1024; S.btile = (size_t)256 * 1024; S.tab = tab; S.list = (const int*)(ws + OFF_LIST);
    pg8::EpiMoe2 E{(bf16_t*)(ws + OFF_YP), p.b_dn};
    pg8::gemm_phase<pg8::EpiMoe2, pg8::MoeSched<false>, true, 125, 122>(lds, (const char*)(ws + OFF_ACT), 1024, S, E);
}
__device__ __forceinline__ void phase9(const Params& p, LAS unsigned char* lds) {
    char* ws = p.ws; const float* modv = (const float*)(ws + OFF_MOD); const bf16_t* yp = (const bf16_t*)(ws + OFF_YP); const float* topp = (const float*)(ws + OFF_TOPP);
    const int* topi = (const int*)(ws + OFF_TOPI); const int* pairpos = (const int*)(ws + OFF_ROWPAIR);
    LAS int* tab = (LAS int*)lds; moe_table((const int*)(ws + OFF_CNT), tab);
    const int tid = otid(), lane = tid & 63, gw = blockIdx.x * 8 + (tid >> 6), nw = gridDim.x * 8, c0 = lane * 8;
    f32x4 fg[4];
#pragma unroll
    for (int q = 0; q < 4; ++q) fg[q] = *(const f32x4*)(p.g_fin + (q >> 1) * 512 + c0 + (q & 1) * 4);
    for (int row = gw; row < L; row += nw) {
        const float* gate = modv + (row / SEQ) * 6144 + 5 * 1024; f32x4 v[4]; u32x4 yr[4][2];
        const pg8::i32x4_t ek = *(const pg8::i32x4_t*)(topi + row * 4), pk4 = *(const pg8::i32x4_t*)(pairpos + row * 4);
#pragma unroll
        for (int j = 0; j < 2; ++j) { float t8[8]; unpack8(*(const u32x4*)((const bf16_t*)(ws + OFF_X1) + (size_t)row * D + j * 512 + c0), t8); v[2 * j] = (f32x4){t8[0], t8[1], t8[2], t8[3]}; v[2 * j + 1] = (f32x4){t8[4], t8[5], t8[6], t8[7]}; }
#pragma unroll
        for (int k = 0; k < 4; ++k) { const size_t yrow = (size_t)tab[ek[k]] * 256 + pk4[k];
#pragma unroll
            for (int j = 0; j < 2; ++j) yr[k][j] = __builtin_nontemporal_load((const u32x4*)(yp + yrow * D + j * 512 + c0)); }
        const f32x4 pk = *(const f32x4*)(topp + row * 4);
        float m[16];
#pragma unroll
        for (int i = 0; i < 16; ++i) m[i] = 0.f;
#pragma unroll
        for (int k = 0; k < 4; ++k)
#pragma unroll
            for (int j = 0; j < 2; ++j) { float t[8]; unpack8(yr[k][j], t);
#pragma unroll
                for (int i = 0; i < 8; ++i) m[j * 8 + i] += pk[k] * t[i]; }
        float ss = 0.f;
#pragma unroll
        for (int q = 0; q < 4; ++q) { const f32x4 gt = *(const f32x4*)(gate + (q >> 1) * 512 + c0 + (q & 1) * 4);
#pragma unroll
            for (int i = 0; i < 4; ++i) { v[q][i] += gt[i] * m[q * 4 + i]; ss += v[q][i] * v[q][i]; } }
        const float rs = rsqrtf(wave_sum(ss) * (1.0f / D) + EPS);
#pragma unroll
        for (int q = 0; q < 4; ++q) __builtin_nontemporal_store(v[q] * rs * fg[q], (f32x4*)(p.out + (size_t)row * D + (q >> 1) * 512 + c0 + (q & 1) * 4));
    }
}

namespace at {
using s16x4  = __attribute__((ext_vector_type(4))) short;
using f32x16 = __attribute__((ext_vector_type(16))) float;
constexpr int NW = 8, QBLK = 32, KVBLK = 64, DK = 192, DV = 128;
constexpr float SCALE = 0.07216878364870322f;
constexpr float THR = 8.f;
constexpr int SHM_V = KVBLK * DV * 2, SHM_K = KVBLK * DK * 2, SHM_ATTN = 2 * SHM_V + 2 * SHM_K + NW * 64 * 4;
#define KSWZ(row, colB) ((row) * 384 + ((colB) ^ (((row) & 7) << 4)))
#define SBAR() __builtin_amdgcn_sched_barrier(0)
__device__ __forceinline__ int crow(int r, int hi) { return (r & 3) + 8 * (r >> 2) + 4 * hi; }
__device__ __forceinline__ unsigned cvtpk(float lo, float hi) { return cvt_pk_bf16(lo, hi); }

__device__ __forceinline__ void partialSM(f32x16& p0, f32x16& p1, float& m_reg, float& mn, float& alpha) {
  constexpr float C = SCALE * 1.4426950408889634f;
  float pmax = p0[0];
#pragma unroll
  for (int r = 1; r < 16; ++r) pmax = fmaxf(pmax, p0[r]);
#pragma unroll
  for (int r = 0; r < 16; ++r) pmax = fmaxf(pmax, p1[r]);
  { auto rr = __builtin_amdgcn_permlane32_swap(__float_as_uint(pmax), __float_as_uint(pmax), false, false);
    pmax = fmaxf(__uint_as_float(rr[0]), __uint_as_float(rr[1])); }
  if (__builtin_expect(__all(pmax - m_reg <= THR / SCALE), 1)) { mn = m_reg; alpha = 1.f; }
  else { mn = fmaxf(m_reg, pmax); alpha = __builtin_amdgcn_exp2f((m_reg - mn) * C); m_reg = mn; }
  float mnC = -mn * C;
#pragma unroll
  for (int r = 0; r < 16; ++r) p0[r] = fmaf(p0[r], C, mnC);
#pragma unroll
  for (int r = 0; r < 16; ++r) p1[r] = fmaf(p1[r], C, mnC);
#pragma unroll
  for (int r = 0; r < 16; ++r) p0[r] = __builtin_amdgcn_exp2f(p0[r]);
}
__device__ __forceinline__ void finishSM(f32x16& p0, f32x16& p1, float alpha, float& l_reg, bf16x8& pa0, bf16x8& pa1, bf16x8& pa2, bf16x8& pa3) {
#pragma unroll
  for (int r = 0; r < 16; ++r) p1[r] = __builtin_amdgcn_exp2f(p1[r]);
  float ps = 0;
#pragma unroll
  for (int r = 0; r < 16; ++r) ps += p0[r];
#pragma unroll
  for (int r = 0; r < 16; ++r) ps += p1[r];
  { auto rr = __builtin_amdgcn_permlane32_swap(__float_as_uint(ps), __float_as_uint(ps), false, false);
    ps = __uint_as_float(rr[0]) + __uint_as_float(rr[1]); }
  l_reg = l_reg * alpha + ps;
#define PK4(P, BASE, OUT) do { unsigned a0 = cvtpk(P[BASE + 0], P[BASE + 1]), a1 = cvtpk(P[BASE + 2], P[BASE + 3]);   \
    unsigned b0 = cvtpk(P[BASE + 4], P[BASE + 5]), b1 = cvtpk(P[BASE + 6], P[BASE + 7]);                              \
    auto r0 = __builtin_amdgcn_permlane32_swap(a0, b0, false, false); auto r1 = __builtin_amdgcn_permlane32_swap(a1, b1, false, false); \
    u32x4 w = {r0[0], r1[0], r0[1], r1[1]}; OUT = *reinterpret_cast<bf16x8*>(&w); } while (0)
  PK4(p0, 0, pa0); PK4(p0, 8, pa1); PK4(p1, 0, pa2); PK4(p1, 8, pa3);
#undef PK4
}
__device__ __forceinline__ void qkt(f32x16& p0, f32x16& p1, const LAS char* Ks, const bf16x8 (&qr)[12], int r32, int hi) {
  p0 = f32x16{}; p1 = f32x16{};
#pragma unroll
  for (int d0 = 0; d0 < 12; ++d0) { const int cb = (d0 * 16 + hi * 8) * 2;
    const bf16x8 b0 = *reinterpret_cast<const LAS bf16x8*>(Ks + KSWZ(r32, cb));
    const bf16x8 b1 = *reinterpret_cast<const LAS bf16x8*>(Ks + KSWZ(32 + r32, cb));
    p0 = __builtin_amdgcn_mfma_f32_32x32x16_bf16(b0, qr[d0], p0, 0, 0, 0);
    p1 = __builtin_amdgcn_mfma_f32_32x32x16_bf16(b1, qr[d0], p1, 0, 0, 0); }
}
__device__ __forceinline__ int v_st(int k, int c) { const int kk = (k & ~0xC) | ((k & 4) << 1) | ((k & 8) >> 1); return ((kk >> 3) * 4 + (c >> 5)) * 512 + ((kk & 7) * 32 + (c & 31)) * 2; }
__device__ __forceinline__ int v_rd_base(int lane) { return ((lane & 3) << 3) | (((lane >> 2) & 3) << 6) | (((lane >> 4) & 1) << 5) | (((lane >> 5) & 1) << 8); }
constexpr int v_rd_off(int d0, int ks, int half) { return d0 * 512 + ks * 4096 + half * 2048; }
template <int OFF> __device__ __forceinline__ s16x4 tr_read(int vb) { s16x4 r; asm volatile("ds_read_b64_tr_b16 %0, %1 offset:%2" : "=&v"(r) : "v"(vb), "i"(OFF) : "memory"); return r; }
template <int D0> __device__ __forceinline__ void pv_one(f32x16& od, int vb, bf16x8 pa0, bf16x8 pa1, bf16x8 pa2, bf16x8 pa3) {
  const s16x4 l0 = tr_read<v_rd_off(D0, 0, 0)>(vb), h0 = tr_read<v_rd_off(D0, 0, 1)>(vb), l1 = tr_read<v_rd_off(D0, 1, 0)>(vb), h1 = tr_read<v_rd_off(D0, 1, 1)>(vb);
  const s16x4 l2 = tr_read<v_rd_off(D0, 2, 0)>(vb), h2 = tr_read<v_rd_off(D0, 2, 1)>(vb), l3 = tr_read<v_rd_off(D0, 3, 0)>(vb), h3 = tr_read<v_rd_off(D0, 3, 1)>(vb);
  asm volatile("s_waitcnt lgkmcnt(0)" ::: "memory"); SBAR();
#define PK(Lo, Hi) (bf16x8){Lo[0], Lo[1], Lo[2], Lo[3], Hi[0], Hi[1], Hi[2], Hi[3]}
  od = __builtin_amdgcn_mfma_f32_32x32x16_bf16(pa0, PK(l0, h0), od, 0, 0, 0);
  od = __builtin_amdgcn_mfma_f32_32x32x16_bf16(pa1, PK(l1, h1), od, 0, 0, 0);
  od = __builtin_amdgcn_mfma_f32_32x32x16_bf16(pa2, PK(l2, h2), od, 0, 0, 0);
  od = __builtin_amdgcn_mfma_f32_32x32x16_bf16(pa3, PK(l3, h3), od, 0, 0, 0);
#undef PK
}
__device__ __forceinline__ void pv_d0(f32x16 (&o)[4], int vb, bf16x8 pa0, bf16x8 pa1, bf16x8 pa2, bf16x8 pa3) {
  pv_one<0>(o[0], vb, pa0, pa1, pa2, pa3); pv_one<1>(o[1], vb, pa0, pa1, pa2, pa3); pv_one<2>(o[2], vb, pa0, pa1, pa2, pa3); pv_one<3>(o[3], vb, pa0, pa1, pa2, pa3);
}

__device__ __forceinline__ void attn_unit(const bf16_t* __restrict__ Qb, const bf16_t* __restrict__ Kh, const bf16_t* __restrict__ Vh, bf16_t* __restrict__ Ob, int t0, const float* __restrict__ ropet, LAS char* lds) {
  constexpr int LDQ = 1536, LDO = 1024, NT = NKEY / KVBLK;
  const int tid = otid(), wid = tid >> 6, lane = tid & 63, r32 = lane & 31, hi = lane >> 5;
  LAS char* V_lds = lds; LAS char* K_lds = lds + 2 * SHM_V;
  LAS float* wsl = (LAS float*)(lds + 2 * SHM_V + 2 * SHM_K) + wid * 64; LAS float* li_l = wsl; LAS float* al_l = wsl + 32;
  float m_reg = -1e30f, l_reg = 0; f32x16 o[4] = {}; bf16x8 qr[12];
  { const bf16_t* Qw = Qb + (size_t)(wid * QBLK + r32) * LDQ + hi * 8;
#pragma unroll
    for (int d0 = 0; d0 < 12; ++d0) qr[d0] = *reinterpret_cast<const bf16x8*>(Qw + d0 * 16);
    const float* rt = ropet + (size_t)(t0 + wid * QBLK + r32) * 64 + 8 * hi;
#pragma unroll
    for (int g = 0; g < 2; ++g) {
      const f32x4 c0 = *(const f32x4*)(rt + 16 * g), c1 = *(const f32x4*)(rt + 16 * g + 4), s0 = *(const f32x4*)(rt + 32 + 16 * g), s1 = *(const f32x4*)(rt + 32 + 16 * g + 4);
      float n1[8], n2[8];
#pragma unroll
      for (int j = 0; j < 8; ++j) { const float cs = j < 4 ? c0[j & 3] : c1[j & 3], sn = j < 4 ? s0[j & 3] : s1[j & 3];
        const float x1 = bf2f((bf16_t)qr[8 + g][j]), x2 = bf2f((bf16_t)qr[10 + g][j]); n1[j] = x1 * cs - x2 * sn; n2[j] = x1 * sn + x2 * cs; }
      u32x4 w1 = {cvtpk(n1[0], n1[1]), cvtpk(n1[2], n1[3]), cvtpk(n1[4], n1[5]), cvtpk(n1[6], n1[7])}; u32x4 w2 = {cvtpk(n2[0], n2[1]), cvtpk(n2[2], n2[3]), cvtpk(n2[4], n2[5]), cvtpk(n2[6], n2[7])};
      qr[8 + g] = *reinterpret_cast<bf16x8*>(&w1); qr[10 + g] = *reinterpret_cast<bf16x8*>(&w2); } }
  const int sr = tid >> 4, sc = (tid & 15) * 8, vst0 = v_st(sr, sc), vst1 = v_st(32 + sr, sc);
  int kgo[3], kst[3];
#pragma unroll
  for (int i = 0; i < 3; ++i) { const int c = tid + 512 * i, row = c / 24, c8 = (c % 24) * 8; kgo[i] = row * DK + c8; kst[i] = KSWZ(row, c8 * 2); }
  const int vb0 = (int)(uintptr_t)V_lds + v_rd_base(lane);
  bf16x8 sv0, sv1, sk0, sk1, sk2;
#define SLOAD(k0) do { sv0 = *reinterpret_cast<const bf16x8*>(&Vh[(size_t)((k0) + sr) * DV + sc]); sv1 = *reinterpret_cast<const bf16x8*>(&Vh[(size_t)((k0) + 32 + sr) * DV + sc]); \
    sk0 = *reinterpret_cast<const bf16x8*>(&Kh[(size_t)(k0) * DK + kgo[0]]); sk1 = *reinterpret_cast<const bf16x8*>(&Kh[(size_t)(k0) * DK + kgo[1]]); sk2 = *reinterpret_cast<const bf16x8*>(&Kh[(size_t)(k0) * DK + kgo[2]]); } while (0)
#define SWRITE(b) do { *(LAS bf16x8*)(V_lds + (b) * SHM_V + vst0) = sv0; *(LAS bf16x8*)(V_lds + (b) * SHM_V + vst1) = sv1; \
    *(LAS bf16x8*)(K_lds + (b) * SHM_K + kst[0]) = sk0; *(LAS bf16x8*)(K_lds + (b) * SHM_K + kst[1]) = sk1; *(LAS bf16x8*)(K_lds + (b) * SHM_K + kst[2]) = sk2; } while (0)
#define RESC(a) do { if (__any((a) < 1.f)) { if (hi == 0) al_l[r32] = (a); asm volatile("s_waitcnt lgkmcnt(0)" ::: "memory"); \
    _Pragma("unroll") for (int d = 0; d < 4; ++d) _Pragma("unroll") for (int r = 0; r < 16; ++r) o[d][r] *= al_l[crow(r, hi)]; } } while (0)
  f32x16 p0, p1; float mn, al; bf16x8 pa0, pa1, pa2, pa3;
  SLOAD(0); asm volatile("s_waitcnt vmcnt(0)" ::: "memory"); SWRITE(0); __syncthreads();
  for (int j = 0; j < NT; ++j) {
    const int bsel = j & 1;
    if (j + 1 < NT) SLOAD((j + 1) * KVBLK);
    SBAR(); qkt(p0, p1, K_lds + bsel * SHM_K, qr, r32, hi);
    partialSM(p0, p1, m_reg, mn, al);
    RESC(al);
    finishSM(p0, p1, al, l_reg, pa0, pa1, pa2, pa3); SBAR();
    pv_d0(o, vb0 + bsel * SHM_V, pa0, pa1, pa2, pa3);
    if (j + 1 < NT) { asm volatile("s_waitcnt vmcnt(0)" ::: "memory"); SWRITE(bsel ^ 1); }
    __syncthreads();
  }
  if (hi == 0) li_l[r32] = l_reg; asm volatile("s_waitcnt lgkmcnt(0)" ::: "memory");
  float rli[16];
#pragma unroll
  for (int r = 0; r < 16; ++r) rli[r] = __builtin_amdgcn_rcpf(li_l[crow(r, hi)]);
  { LAS bf16_t* ot = (LAS bf16_t*)(lds + wid * 8192);
#pragma unroll
    for (int r = 0; r < 16; ++r) { const int orow = crow(r, hi);
#pragma unroll
      for (int d0 = 0; d0 < 4; ++d0) ot[orow * 128 + d0 * 32 + r32] = f2bf(o[d0][r] * rli[r]); }
    asm volatile("s_waitcnt lgkmcnt(0)" ::: "memory");
    bf16_t* Ow = Ob + (size_t)(wid * QBLK) * LDO;
#pragma unroll
    for (int i = 0; i < 8; ++i) { const int q = lane + 64 * i, row = q >> 4, ch = q & 15; const u32x4 w = *(const LAS u32x4*)(ot + row * 128 + ch * 8); *(u32x4*)(Ow + (size_t)row * LDO + ch * 8) = w; } }
#undef SLOAD
#undef SWRITE
#undef RESC
}
}

__device__ __forceinline__ void phase_attn(const Params& p, LAS unsigned char* lds) {
    char* ws = p.ws; const bf16_t* Q = (const bf16_t*)(ws + OFF_Q); const bf16_t* Kb = (const bf16_t*)(ws + OFF_K); const bf16_t* Vb = (const bf16_t*)(ws + OFF_V); bf16_t* Y = (bf16_t*)(ws + OFF_H);
    const int G = gridDim.x;
    for (int it = 0;; ++it) {
        int u;
        if (G == 256) { const int c = blockIdx.x, xcd = c & 7, j = c >> 3; if (it >= 4) break; u = ((it * 32 + xcd * 4 + (j >> 3)) << 3) | (j & 7); }
        else { u = it * G + blockIdx.x; if (u >= 1024) break; }
        const int bh = u >> 3, qb = u & 7, b = bh >> 3, h = bh & 7;
        at::attn_unit(Q + ((size_t)(b * SEQ + qb * 256)) * 1536 + h * 192, Kb + (size_t)bh * NKEY * 192, Vb + (size_t)bh * NKEY * 128, Y + ((size_t)(b * SEQ + qb * 256)) * D + h * 128, qb * 256, (const float*)(ws + OFF_ROPE), (LAS char*)lds);
        __syncthreads();
    }
}

namespace sc {
using f32x16 = __attribute__((ext_vector_type(16))) float;
constexpr int BUFB = 53248, O_QT = 0, O_KH = 16384, O_VT = 32768, O_AT = 49152, O_DEC = 51200, O_KD = 2 * BUFB, LDS_SCAN = 2 * BUFB + 16384;
__device__ __forceinline__ int sw256(int row, int cb) { return row * 256 + (cb ^ ((row & 15) << 4)); }
__device__ __forceinline__ int sw128(int row, int cb) { return row * 128 + (cb ^ (((row >> 1) & 7) << 4)); }
__device__ __forceinline__ int grow_of(int n, int b, int dir) { if (n < CTXL) { const int s = dir ? (CTXL - 1 - n) : n; return L + b * CTXL + s; } const int m = n - CTXL; return b * SEQ + (dir ? (SEQ - 1 - m) : m); }
__device__ __forceinline__ bf16x8 pack_acc8(const f32x16& x, int s) { u32x4 p; p.x = cvt_pk_bf16(x[8 * s], x[8 * s + 1]); p.y = cvt_pk_bf16(x[8 * s + 2], x[8 * s + 3]); p.z = cvt_pk_bf16(x[8 * s + 4], x[8 * s + 5]); p.w = cvt_pk_bf16(x[8 * s + 6], x[8 * s + 7]); return __builtin_bit_cast(bf16x8, p); }

__device__ __forceinline__ void scan_unit(const Params& p, int unit, LAS unsigned char* lds) {
    char* ws = p.ws; const int dir = unit & 1, h = (unit >> 1) & 7, b = unit >> 4;
    const bf16_t* hq = (const bf16_t*)(ws + OFF_HQ); const bf16_t* fz = (const bf16_t*)(ws + (dir ? OFF_FB : OFF_FF)); const bf16_t* iv = (const bf16_t*)(ws + OFF_IV);
    bf16_t* outp = (bf16_t*)(ws + (dir ? OFF_OB : OFF_OF)); const float* lb = (const float*)(ws + OFF_LB);
    const int tid = otid(), wid = __builtin_amdgcn_readfirstlane(tid >> 6), lane = tid & 63, r32 = lane & 31, hi = lane >> 5;
    const int sgn = dir ? -1 : 1; const long rstep = (long)sgn * D;
    __syncthreads();
    if (wid >= 4) {
        const int I = wid - 4, cp = lane, hc = h * 128 + 2 * cp;
        const float lbv0 = lb[dir * 1024 + hc], lbv1 = lb[dir * 1024 + hc + 1];
        unsigned zr[16], vr[16], qr[16];
#define SC_LOAD(c) do { const size_t o0_ = (size_t)(grow_of((c) * 64, b, dir) + sgn * (16 * I)) * D + hc; const bf16_t* pz_ = fz + o0_; const bf16_t* pv_ = iv + o0_; const bf16_t* pq_ = hq + o0_; \
        _Pragma("unroll") for (int i = 0; i < 16; ++i) { zr[i] = *(const unsigned*)pz_; pz_ += rstep; vr[i] = *(const unsigned*)pv_; pv_ += rstep; if ((c) >= 4) { qr[i] = *(const unsigned*)pq_; pq_ += rstep; } } } while (0)
        SC_LOAD(0);
        for (int it = 0; it <= 36; ++it) {
            if (it < 36) {
                const int c = it; const bool lat = c >= 4; LAS unsigned char* B = lds + (c & 1) * BUFB; LAS unsigned char* KD = lds + O_KD;
                float kk0[16], kk1[16], lc0[16], lc1[16]; float run0 = 0.f, run1 = 0.f;
#pragma unroll
                for (int i = 0; i < 16; ++i) { const float z0 = __uint_as_float(zr[i] << 16), z1 = __uint_as_float(zr[i] & 0xffff0000u);
                    const float f0 = lbv0 + (1.0f - lbv0) * sigmoidf_(z0), f1 = lbv1 + (1.0f - lbv1) * sigmoidf_(z1); kk0[i] = 1.0f - f0; kk1[i] = 1.0f - f1;
                    run0 += __builtin_amdgcn_logf(f0) * 0.6931471805599453f; run1 += __builtin_amdgcn_logf(f1) * 0.6931471805599453f; lc0[i] = run0; lc1[i] = run1; }
                *(LAS f32x2*)(B + O_DEC + (I * 128 + 2 * cp) * 4) = (f32x2){__expf(run0), __expf(run1)};
                unsigned kh0[8], kh1[8], vt0[8], vt1[8];
#pragma unroll
                for (int i = 0; i < 16; ++i) { const int t = 16 * I + i; const float l0 = lc0[i], l1 = lc1[i];
                    const float kd0 = kk0[i] * __expf(fminf(-l0, 80.0f)), kd1 = kk1[i] * __expf(fminf(-l1, 80.0f));
                    const float kf0 = kk0[i] * __expf(run0 - l0), kf1 = kk1[i] * __expf(run1 - l1);
                    if (lat) { const float q0 = __uint_as_float(qr[i] << 16), q1 = __uint_as_float(qr[i] & 0xffff0000u);
                        *(LAS unsigned*)(B + O_QT + sw256(t, 4 * cp)) = cvt_pk_bf16(q0 * __expf(l0), q1 * __expf(l1)); *(LAS unsigned*)(KD + sw256(t, 4 * cp)) = cvt_pk_bf16(kd0, kd1); }
                    if (i & 1) { kh0[i >> 1] = cvt_pk_bf16(__uint_as_float(kh0[i >> 1]), kf0); kh1[i >> 1] = cvt_pk_bf16(__uint_as_float(kh1[i >> 1]), kf1); vt0[i >> 1] = (vt0[i >> 1] >> 16) | (vr[i] << 16); vt1[i >> 1] = (vt1[i >> 1] >> 16) | (vr[i] & 0xffff0000u); }
                    else { kh0[i >> 1] = __float_as_uint(kf0); kh1[i >> 1] = __float_as_uint(kf1); vt0[i >> 1] = vr[i] << 16; vt1[i >> 1] = vr[i] & 0xffff0000u; } }
#pragma unroll
                for (int q = 0; q < 2; ++q) {
                    *(LAS u32x4*)(B + O_KH + sw128(2 * cp, 32 * I + 16 * q)) = (u32x4){kh0[4 * q], kh0[4 * q + 1], kh0[4 * q + 2], kh0[4 * q + 3]}; *(LAS u32x4*)(B + O_KH + sw128(2 * cp + 1, 32 * I + 16 * q)) = (u32x4){kh1[4 * q], kh1[4 * q + 1], kh1[4 * q + 2], kh1[4 * q + 3]};
                    *(LAS u32x4*)(B + O_VT + sw128(2 * cp, 32 * I + 16 * q)) = (u32x4){vt0[4 * q], vt0[4 * q + 1], vt0[4 * q + 2], vt0[4 * q + 3]}; *(LAS u32x4*)(B + O_VT + sw128(2 * cp + 1, 32 * I + 16 * q)) = (u32x4){vt1[4 * q], vt1[4 * q + 1], vt1[4 * q + 2], vt1[4 * q + 3]}; }
                if (it + 1 < 36) SC_LOAD(it + 1);
                if (lat) {
                    const int l15 = lane & 15, lq = lane >> 4; f32x4 a = {0.f, 0.f, 0.f, 0.f};
#pragma unroll
                    for (int ks = 0; ks < 4; ++ks) { const bf16x8 av = *(const LAS bf16x8*)(B + O_QT + sw256(16 * I + l15, (32 * ks + 8 * lq) * 2)); const bf16x8 bv = *(const LAS bf16x8*)(KD + sw256(16 * I + l15, (32 * ks + 8 * lq) * 2));
                        a = __builtin_amdgcn_mfma_f32_16x16x32_bf16(av, bv, a, 0, 0, 0); }
#pragma unroll
                    for (int r = 0; r < 4; ++r) { const int tl = 4 * lq + r; float v = a[r]; if (l15 > tl) v = 0.f; *(LAS bf16_t*)(B + O_AT + ((I * 16 + tl) * 16 + l15) * 2) = f2bf(v); }
                }
            }
            __syncthreads();
        }
#undef SC_LOAD
    } else {
        const int bq = wid; f32x16 S[4];
#pragma unroll
        for (int a = 0; a < 4; ++a) S[a] = f32x16{};
        for (int it = 0; it <= 36; ++it) {
            if (it >= 1) {
                const int c = it - 1; const bool lat = c >= 4; LAS unsigned char* B = lds + (c & 1) * BUFB;
                bf16_t* po = outp + (size_t)(grow_of(c * 64, b, dir) + sgn * (4 * hi)) * D + h * 128 + 32 * bq + r32;
#pragma unroll
                for (int I = 0; I < 4; ++I) {
                    const bf16x8 vtf = *(const LAS bf16x8*)(B + O_VT + sw128(32 * bq + r32, (16 * I + 8 * hi) * 2));
                    if (lat) {
                        f32x16 o = f32x16{};
#pragma unroll
                        for (int a = 0; a < 4; ++a)
#pragma unroll
                            for (int s = 0; s < 2; ++s) { const int dk0 = 32 * a + 16 * s + 4 * hi; const int row = 16 * I + (r32 & 15);
                                const u32x2 lo2 = *(const LAS u32x2*)(B + O_QT + sw256(row, dk0 * 2)), hi2 = *(const LAS u32x2*)(B + O_QT + sw256(row, (dk0 + 8) * 2));
                                const u32x4 av = {lo2.x, lo2.y, hi2.x, hi2.y};
                                o = __builtin_amdgcn_mfma_f32_32x32x16_bf16(__builtin_bit_cast(bf16x8, av), pack_acc8(S[a], s), o, 0, 0, 0); }
                        { const bf16x8 af = *(const LAS bf16x8*)(B + O_AT + ((I * 16 + (r32 & 15)) * 16 + 8 * hi) * 2); o = __builtin_amdgcn_mfma_f32_32x32x16_bf16(af, vtf, o, 0, 0, 0); }
#pragma unroll
                        for (int r = 0; r < 8; ++r) po[(long)(16 * I + (r & 3) + 8 * (r >> 2)) * rstep] = f2bf(o[r]);
                    }
#pragma unroll
                    for (int a = 0; a < 4; ++a) {
#pragma unroll
                        for (int g = 0; g < 4; ++g) { const f32x4 dc = *(const LAS f32x4*)(B + O_DEC + (I * 128 + 32 * a + 8 * g + 4 * hi) * 4); S[a][4 * g] *= dc[0]; S[a][4 * g + 1] *= dc[1]; S[a][4 * g + 2] *= dc[2]; S[a][4 * g + 3] *= dc[3]; }
                        const bf16x8 kf = *(const LAS bf16x8*)(B + O_KH + sw128(32 * a + r32, (16 * I + 8 * hi) * 2));
                        S[a] = __builtin_amdgcn_mfma_f32_32x32x16_bf16(kf, vtf, S[a], 0, 0, 0); }
                }
            }
            __syncthreads();
        }
    }
    __syncthreads();
}
}
__device__ __forceinline__ void phase_scan(const Params& p, LAS unsigned char* lds) {
    for (int u = blockIdx.x; u < 256; u += gridDim.x) sc::scan_unit(p, u, lds);
}

constexpr int LDS_BYTES = 155648;
#include <cstdint>
#include <cstdlib>
#include <vector>

#define XB_TMO      128
#define XB_XCNT(j)  (256  + 64 * (j))
#define XB_XSUB(j)  (1280 + 64 * (j))
#define XB_XGEN(j)  (2304 + 64 * (j))
#define XB_TOP      3328
#define XB_TOPGEN   3392
#define XCD_BAR_WORDS 3456
#define XB_SPIN_CAP (1u << 18)

__device__ __forceinline__ unsigned xb_ld(unsigned* p)              { return __hip_atomic_load(p, __ATOMIC_RELAXED, __HIP_MEMORY_SCOPE_AGENT); }
__device__ __forceinline__ unsigned xb_add(unsigned* p, unsigned v) { return __hip_atomic_fetch_add(p, v, __ATOMIC_RELAXED, __HIP_MEMORY_SCOPE_AGENT); }
__device__ __forceinline__ unsigned xb_xcc_id() { return (unsigned)__builtin_amdgcn_s_getreg((3 << 11) | 20) & 0xFu; }
#define XB_SPIN(cond, bar) do { unsigned _sp = 0; while (cond) { __builtin_amdgcn_s_sleep(1); \
    if ((++_sp & 255u) == 0u) { if (xb_ld(&(bar)[XB_TMO])) break; if (_sp > XB_SPIN_CAP) { atomicAdd(&(bar)[XB_TMO], 1u); break; } } } } while (0)

struct XcdBarrier {
    unsigned* bar; unsigned x;
    volatile LAS unsigned* st;
};

__device__ __forceinline__ XcdBarrier xcd_barrier_post(unsigned* bar, volatile LAS unsigned* st) {
    XcdBarrier b; b.bar = bar; b.x = xb_xcc_id(); b.st = st;
    if (threadIdx.x == 0) (void)xb_add(&bar[XB_XCNT(b.x)], 1u);
    return b;
}
__device__ __forceinline__ void xcd_barrier_complete(unsigned* bar, unsigned x, unsigned& nloc, unsigned& nx) {
    const unsigned G = gridDim.x * gridDim.y * gridDim.z;
    unsigned sum, cnt, mine, sp = 0u;
    for (;;) {
        sum = 0u; cnt = 0u; mine = 0u;
#pragma unroll
        for (unsigned j = 0; j < 16; ++j) { const unsigned c = xb_ld(&bar[XB_XCNT(j)]); sum += c; cnt += (c > 0u) ? 1u : 0u; mine = (j == x) ? c : mine; }
        if (sum == G) break;
        __builtin_amdgcn_s_sleep(1);
        if ((++sp & 255u) == 0u) { if (xb_ld(&bar[XB_TMO])) break; if (sp > XB_SPIN_CAP) { atomicAdd(&bar[XB_TMO], 1u); break; } }
    }
    nloc = mine > 0u ? mine : 1u; nx = cnt > 0u ? cnt : 1u;
}

__device__ __forceinline__ void xcd_barrier(const XcdBarrier& b) {
    asm volatile("s_waitcnt vmcnt(0)" ::: "memory");
    __syncthreads();
    if (threadIdx.x == 0) {
        unsigned* bar = b.bar;
        __builtin_amdgcn_s_waitcnt(0);
        unsigned nloc = b.st[0], nx = b.st[1];
        if (nloc == 0u) { xcd_barrier_complete(bar, b.x, nloc, nx); b.st[0] = nloc; b.st[1] = nx; }
        const unsigned old = xb_add(&bar[XB_XSUB(b.x)], 1u);
        const unsigned gen = old / nloc;
        if (old + 1u == (gen + 1u) * nloc) {
            __builtin_amdgcn_fence(__ATOMIC_RELEASE, "agent");
            asm volatile("s_waitcnt vmcnt(0)" ::: "memory");
            const unsigned og = xb_add(&bar[XB_TOP], 1u);
            const unsigned tg = og / nx;
            if (og + 1u == (tg + 1u) * nx) xb_add(&bar[XB_TOPGEN], 1u);
            else XB_SPIN(xb_ld(&bar[XB_TOPGEN]) == tg, bar);
            __builtin_amdgcn_fence(__ATOMIC_ACQUIRE, "agent");
            xb_add(&bar[XB_XGEN(b.x)], 1u);
            asm volatile("s_waitcnt vmcnt(0)" ::: "memory");
        } else {
            XB_SPIN(xb_ld(&bar[XB_XGEN(b.x)]) == gen, bar);
            __builtin_amdgcn_fence(__ATOMIC_ACQUIRE, "agent");
            asm volatile("s_waitcnt vmcnt(0)" ::: "memory");
        }
    }
    __syncthreads();
}

__global__ void __launch_bounds__(512, 2) k_mega(Params p) {
    extern __shared__ __attribute__((aligned(16))) unsigned char smem[];
    LAS unsigned char* lds = (LAS unsigned char*)smem;
    volatile LAS unsigned* xbw = (volatile LAS unsigned*)(lds + LDS_BYTES - 16);
    if (threadIdx.x == 0) { xbw[0] = 0u; xbw[1] = 0u; xbw[2] = 0u; xbw[3] = 0u; }
    __syncthreads();
    XcdBarrier bar = xcd_barrier_post((unsigned*)(p.ws + OFF_BAR), xbw);
    phase0(p, lds);      xcd_barrier(bar);
    phase1(p, lds);      xcd_barrier(bar);
    phase2(p, lds);      xcd_barrier(bar);
    phase3(p, lds);      xcd_barrier(bar);
    phase_attn(p, lds);
    phase_scan(p, lds);  xcd_barrier(bar);
    phase4(p, lds);      xcd_barrier(bar);
    phase5(p, lds);      xcd_barrier(bar);
    phase6(p, lds);      xcd_barrier(bar);
    phase7(p, lds);      xcd_barrier(bar);
    phase8(p, lds);      xcd_barrier(bar);
    phase9(p, lds);
}
extern "C" void kernel_launch(void* const* d_in, const int* in_sizes, int n_in, void* d_out, int out_size, void* d_ws, size_t ws_size, hipStream_t stream) {
    static int grid = 0;
    if (grid == 0) {
        int dev = 0, cus = 0, per_cu = 0;
        if (hipGetDevice(&dev) != hipSuccess || hipDeviceGetAttribute(&cus, hipDeviceAttributeMultiprocessorCount, dev) != hipSuccess) { grid = -1; return; }
        if (hipFuncSetAttribute((const void*)k_mega, hipFuncAttributeMaxDynamicSharedMemorySize, LDS_BYTES) != hipSuccess) { grid = -1; return; }
        (void)hipOccupancyMaxActiveBlocksPerMultiprocessor(&per_cu, (const void*)k_mega, 512, LDS_BYTES);
        (void)hipGetLastError();
        grid = cus;
    }
    if (grid < 0) return;
    Params p{};
    p.x = (const float*)d_in[0]; p.c = (const float*)d_in[1]; p.ctx = (const float*)d_in[2]; p.cctx = (const float*)d_in[3]; p.w_mod = (const float*)d_in[4]; p.b_mod = (const float*)d_in[5];
    p.g_mix = (const float*)d_in[6]; p.w_in = (const float*)d_in[7]; p.g_q = (const float*)d_in[8]; p.w_qb = (const float*)d_in[9]; p.g_kv = (const float*)d_in[10]; p.w_kvb = (const float*)d_in[11];
    p.lbl = (const float*)d_in[12]; p.g_hg = (const float*)d_in[13]; p.w_out = (const float*)d_in[14]; p.g_ffn = (const float*)d_in[15]; p.w_r = (const float*)d_in[16]; p.b_r = (const float*)d_in[17];
    p.w_gu = (const float*)d_in[18]; p.b_gu = (const float*)d_in[19]; p.w_dn = (const float*)d_in[20]; p.b_dn = (const float*)d_in[21]; p.g_fin = (const float*)d_in[22];
    p.out = (float*)d_out; p.ws = (char*)d_ws;
    (void)hipMemsetAsync((char*)d_ws + OFF_BAR, 0, 16384, stream);
    hipLaunchKernelGGL(k_mega, dim3(grid), dim3(512), LDS_BYTES, stream, p);
}
```

```cpp
#include <hip/hip_runtime.h>
#include <stdint.h>

typedef unsigned short bf16_t;
__device__ __forceinline__ float bf2f(bf16_t v) { return __uint_as_float(((unsigned)v) << 16); }
__device__ __forceinline__ bf16_t f2bf(float f) { unsigned u = __float_as_uint(f); u += 0x7FFFu + ((u >> 16) & 1u); return (bf16_t)(u >> 16); }
__device__ __forceinline__ float sigmoidf_(float x) { return __builtin_amdgcn_rcpf(1.0f + __builtin_amdgcn_exp2f(-1.4426950408889634f * x)); }
__device__ __forceinline__ float siluf_(float x) { return x * __builtin_amdgcn_rcpf(1.0f + __builtin_amdgcn_exp2f(-1.4426950408889634f * x)); }

constexpr int D = 1024, NB = 16, SEQ = 2048, CTXL = 256;
constexpr int L = NB * SEQ;
constexpr int RC = NB * CTXL;
constexpr int R = L + RC;
constexpr int NKEY = SEQ + CTXL;
constexpr float EPS = 1e-6f;
constexpr int NE = 32, CAP = 32768;
constexpr int MAXROWS = 131072 + NE * 256;

constexpr size_t MiB = 1048576;
constexpr size_t OFF_SMALL = 0;
constexpr size_t OFF_BAR = 0;
constexpr size_t OFF_CNT = 16384;
constexpr size_t OFF_OFFS = 16384 + 1024;
constexpr size_t OFF_TILEE = 16384 + 2048;
constexpr size_t OFF_LB = 24576;
constexpr size_t OFF_MOD = 32768;
constexpr size_t OFF_SSQQ = 512 * 1024;
constexpr size_t OFF_SSQKV = 768 * 1024;
constexpr size_t OFF_TOPI = 1 * MiB;
constexpr size_t OFF_TOPP = 1 * MiB + 512 * 1024;
constexpr size_t OFF_ROWPAIR = 2 * MiB;
constexpr size_t OFF_LIST = 3 * MiB;
constexpr size_t OFF_H = 32 * MiB;
constexpr size_t OFF_QA = 104 * MiB;
constexpr size_t OFF_CKV = 152 * MiB;
constexpr size_t OFF_KR = 170 * MiB;
constexpr size_t OFF_OF = 104 * MiB;
constexpr size_t OFF_HQ = 175 * MiB;
constexpr size_t SEG_STRIDE = 72 * MiB;
constexpr size_t OFF_FF = OFF_HQ + 1 * SEG_STRIDE;
constexpr size_t OFF_FB = OFF_HQ + 2 * SEG_STRIDE;
constexpr size_t OFF_IV = OFF_HQ + 3 * SEG_STRIDE;
constexpr size_t OFF_OG = OFF_HQ + 4 * SEG_STRIDE;
constexpr size_t OFF_GM = OFF_HQ + 5 * SEG_STRIDE;
constexpr size_t OFF_GH = OFF_HQ + 6 * SEG_STRIDE;
constexpr size_t OFF_Q = 679 * MiB;
constexpr size_t OFF_K = 775 * MiB;
constexpr size_t OFF_V = 883 * MiB;
constexpr size_t OFF_OB = 955 * MiB;
constexpr size_t OFF_YP = 296 * MiB;
constexpr size_t OFF_ACT = 568 * MiB;


__device__ __forceinline__ void rope_cs(int t, int i, float& cs, float& sn) {
    int j = i & 15; float inv = __expf(-(float)j * (9.210340371976184f / 16.0f)); float pos = (i < 16) ? (float)(t >> 6) : (float)(t & 63);
    float ang = pos * inv; cs = cosf(ang); sn = sinf(ang);
}

#define LAS __attribute__((address_space(3)))
__device__ __forceinline__ int otid() { int t = threadIdx.x; asm volatile("" : "+v"(t)); return t; }
typedef short bf16x8 __attribute__((ext_vector_type(8)));
typedef float f32x4 __attribute__((ext_vector_type(4)));
typedef unsigned u32x4 __attribute__((ext_vector_type(4)));
typedef unsigned u32x2 __attribute__((ext_vector_type(2)));
typedef float f32x2 __attribute__((ext_vector_type(2)));

constexpr size_t OFF_ROPE = 7 * MiB;
constexpr size_t OFF_WT_IN = 8 * MiB;
constexpr size_t OFF_WT_QB = 25 * MiB;
constexpr size_t OFF_WT_KVB = 28 * MiB;
constexpr size_t OFF_WT_OUT = 29 * MiB;
constexpr size_t OFF_WT_GU = 104 * MiB;
constexpr size_t OFF_WT_DN = 232 * MiB;
constexpr size_t OFF_YF8 = 775 * MiB;
constexpr size_t OFF_X1 = 704 * MiB;

struct Params {
    const float *x, *c, *ctx, *cctx, *w_mod, *b_mod, *g_mix, *w_in, *g_q, *w_qb, *g_kv, *w_kvb, *lbl, *g_hg, *w_out, *g_ffn, *w_r, *b_r, *w_gu, *b_gu, *w_dn, *b_dn, *g_fin;
    float* out; char* ws;
};

typedef __bf16 bf16v2_t __attribute__((ext_vector_type(2)));
__device__ __forceinline__ unsigned cvt_pk_bf16(float lo, float hi) { bf16v2_t v = {(__bf16)lo, (__bf16)hi}; return __builtin_bit_cast(unsigned, v); }

__device__ __forceinline__ unsigned pack4_fp8(float a, float b, float c, float d) {
    a = __builtin_amdgcn_fmed3f(a, -448.f, 448.f); b = __builtin_amdgcn_fmed3f(b, -448.f, 448.f); c = __builtin_amdgcn_fmed3f(c, -448.f, 448.f); d = __builtin_amdgcn_fmed3f(d, -448.f, 448.f);
    unsigned w = 0; w = __builtin_amdgcn_cvt_pk_fp8_f32(a, b, w, false); w = __builtin_amdgcn_cvt_pk_fp8_f32(c, d, w, true); return w; }

namespace pg8 {
constexpr int BM = 256, BK = 64, HALF = 128, HTB = HALF * BK * 2, STAGE_BYTES = 8 * HTB, NXCD = 8, WGM = 8;
constexpr int LDS_IDX = STAGE_BYTES + 8192;
__device__ __forceinline__ int lds_byte(int r, int c) { const int st = (r >> 4) * 2 + (c >> 5), rr = r & 15, cc = c & 31, ob = rr * 64 + cc * 2; return st * 1024 + (ob ^ (((ob >> 9) & 1) << 5)); }
__device__ __forceinline__ void stage_rc(int b, int& R, int& C) { const int st = b / 1024, sb = b % 1024, swz = sb ^ (((sb >> 9) & 1) << 5); R = (st >> 1) * 16 + swz / 64; C = (st & 1) * 32 + (swz % 64) / 2; }
__device__ __forceinline__ int perm32(int rho) { const int n = rho >> 4, i = rho & 15; return 8 * (i >> 2) + 4 * n + (i & 3); }
struct Unit { int pm, pn; const char* b; int e, pos0, cnt; };

__device__ __forceinline__ int xcd_remap(int L, int nwg) { const int q = nwg / NXCD, r = nwg % NXCD, xcd = L % NXCD, off = L / NXCD; return (xcd < r ? xcd * (q + 1) : r * (q + 1) + (xcd - r) * q) + off; }

struct DenseSched {
    int nM, nN, nwg, G, c, rowb; const char* Bt; size_t btile;
    __device__ void init(int M, int N, int kbytes, int rowb_, const void* Bt_, int G_, int c_) { nM = M / BM; nN = N / BM; nwg = nM * nN; G = G_; c = c_; rowb = rowb_; Bt = (const char*)Bt_; btile = (size_t)BM * kbytes; }
    static constexpr bool GATHER_LDS = false;
    __device__ __forceinline__ int kstepA() const { return 128; }
    __device__ __forceinline__ void tile(int wgid, int& pm, int& pn) const { const int nig = WGM * nN, gid = wgid / nig, fm = gid * WGM, gsz = (nM - fm) < WGM ? (nM - fm) : WGM; pm = fm + ((wgid % nig) % gsz); pn = (wgid % nig) / gsz; }
    __device__ __forceinline__ bool next(int i, Unit& u) const { const int Lx = i * G + c; if (Lx >= nwg) return false; tile(xcd_remap(Lx, nwg), u.pm, u.pn); u.b = Bt + (size_t)u.pn * btile; u.e = 0; u.pos0 = 0; u.cnt = 0; return true; }
    __device__ __forceinline__ void aoff(const Unit& u, const int (&Rr)[2], const int (&Cc)[2], unsigned (&va)[2][2]) const {
#pragma unroll
        for (int h = 0; h < 2; ++h)
#pragma unroll
            for (int i = 0; i < 2; ++i) va[h][i] = (unsigned)((u.pm * BM + h * HALF + Rr[i]) * rowb + Cc[i] * 2); }
};
struct InSched : DenseSched {
    __device__ void init2(const void* Bt_, int G_, int c_) { init(L, 8448, 1024, 1024, Bt_, G_, c_); }
    __device__ __forceinline__ bool next(int i, Unit& u) const {
        const int Lx = i * G + c; const int nlat = nwg;
        if (Lx < nlat) { tile(xcd_remap(Lx, nlat), u.pm, u.pn); }
        else { const int j = Lx - nlat; if (j >= 16 * 14) return false; const int q = j >> 4; u.pm = 128 + (j & 15); u.pn = q == 0 ? 3 : (q <= 12 ? 7 + q : 32); }
        u.b = Bt + (size_t)u.pn * btile; u.e = 0; u.pos0 = 0; u.cnt = 0; return true; }
};
__device__ __forceinline__ unsigned act_piece_off(int r, int c16) { const int s = 2 * (r >> 7) + (c16 >> 2), w = 4 * ((r >> 6) & 1) + (c16 & 3), l = 16 * ((r >> 4) & 3) + (r & 15); return (unsigned)(((s * 8 + w) * 64 + l) * 16); }
template <bool GATHER> struct MoeSched {
    int nN, G, c, rowb; const char* Wt; size_t wexp, btile; const LAS int* tab; const int* list;
    static constexpr bool GATHER_LDS = GATHER;
    __device__ __forceinline__ int kstepA() const { return GATHER ? 128 : 32768; }
    __device__ __forceinline__ bool next(int i, Unit& u) const {
        const int nwg = tab[33] * nN; const int Lx = i * G + c; if (Lx >= nwg) return false;
        const int w = xcd_remap(Lx, nwg); const int rt = w / nN; u.pn = w % nN; u.pm = rt;
        const int e = tab[128 + rt];
        u.e = e; u.pos0 = (rt - tab[e]) * BM; u.cnt = tab[64 + e]; u.b = Wt + (size_t)e * wexp + (size_t)u.pn * btile; return true; }
    __device__ __forceinline__ void aoff(const Unit& u, const int (&Rr)[2], const int (&Cc)[2], unsigned (&va)[2][2]) const {
#pragma unroll
        for (int h = 0; h < 2; ++h)
#pragma unroll
            for (int i = 0; i < 2; ++i) {
                if (GATHER) { const int pos = u.pos0 + h * HALF + Rr[i]; const int pair = pos < u.cnt ? list[u.e * CAP + pos] : 0; va[h][i] = (unsigned)((pair >> 2) * rowb + Cc[i] * 2); }
                else va[h][i] = (unsigned)u.pm * 262144u + act_piece_off(h * HALF + Rr[i], Cc[i] >> 3); } }
};

typedef int v8i_t __attribute__((ext_vector_type(8)));
typedef int i32x4_t __attribute__((ext_vector_type(4)));
template <class Epi, class Sched, bool FP8 = false, int SCA = 127, int SCB = 127>
__device__ __forceinline__ void gemm_phase(LAS unsigned char* lds, const char* Abase, const int K, const Sched& S, const Epi& E) {
    const int tid = otid(), wid = __builtin_amdgcn_readfirstlane(tid >> 6), lane = tid & 63, wr = wid >> 2, wc = wid & 3, fr = lane & 15, fq = lane >> 4;
    const int Kb = FP8 ? K : 2 * K;
    const int nt = Kb / (BK * 2);
    int Rr[2], Cc[2]; unsigned voffB[2];
#pragma unroll
    for (int i = 0; i < 2; ++i) { int R_, C_; stage_rc(tid * 16 + i * 8192, R_, C_); Rr[i] = R_; Cc[i] = C_; const int Rb = 64 * (R_ >> 5) + (Epi::PERM ? perm32(R_ & 31) : (R_ & 31)); voffB[i] = (unsigned)(Rb * Kb + C_ * 2); }
    const size_t kstep = (size_t)(BK * 2);
    const size_t kstepA = (size_t)S.kstepA();
    const size_t hstep = (size_t)32 * Kb;
    const unsigned ldsw = (unsigned)wid * 1024u;
    const int aoff = lds_byte(wr * 64 + fr, fq * 8), boff = lds_byte(wc * 32 + fr, fq * 8);
#define PG8_SA(b, h) (((b) * 2 + (h)) * HTB)
#define PG8_SB(b, h) ((4 + (b) * 2 + (h)) * HTB)
#define PG8_STAGE_B(bufoff, gbase) do { _Pragma("unroll") for (int _i = 0; _i < 2; ++_i) \
        __builtin_amdgcn_global_load_lds((const unsigned*)((const char*)(gbase) + voffB[_i]), (LAS unsigned*)(lds + (bufoff) + ldsw + _i * 8192), 16, 0, 0); } while (0)
#define PG8_STAGE_A(bufoff, v0, v1, kb) do { \
        __builtin_amdgcn_global_load_lds((const unsigned*)(Abase + (kb) + (v0)), (LAS unsigned*)(lds + (bufoff) + ldsw), 16, 0, 0); \
        __builtin_amdgcn_global_load_lds((const unsigned*)(Abase + (kb) + (v1)), (LAS unsigned*)(lds + (bufoff) + ldsw + 8192), 16, 0, 0); } while (0)
#define PG8_LD16(addr) (*(const LAS i32x4_t*)(addr))
#define PG8_LDA(dst, b, h) do { _Pragma("unroll") for (int m = 0; m < 4; ++m) { if constexpr (FP8) dst##8[m] = __builtin_shufflevector(PG8_LD16(lds + PG8_SA(b, h) + aoff + m * 2048), PG8_LD16(lds + PG8_SA(b, h) + aoff + m * 2048 + 1024), 0, 1, 2, 3, 4, 5, 6, 7); \
        else { _Pragma("unroll") for (int k = 0; k < 2; ++k) dst[m][k] = *(const LAS bf16x8*)(lds + PG8_SA(b, h) + aoff + m * 2048 + k * 1024); } } } while (0)
#define PG8_LDB(dst, b, h) do { _Pragma("unroll") for (int n = 0; n < 2; ++n) { if constexpr (FP8) dst##8[n] = __builtin_shufflevector(PG8_LD16(lds + PG8_SB(b, h) + boff + n * 2048), PG8_LD16(lds + PG8_SB(b, h) + boff + n * 2048 + 1024), 0, 1, 2, 3, 4, 5, 6, 7); \
        else { _Pragma("unroll") for (int k = 0; k < 2; ++k) dst[n][k] = *(const LAS bf16x8*)(lds + PG8_SB(b, h) + boff + n * 2048 + k * 1024); } } } while (0)
#define PG8_MMA(ai, bj, At, Bt) do { __builtin_amdgcn_s_setprio(1); _Pragma("unroll") for (int m = 0; m < 4; ++m) _Pragma("unroll") for (int n = 0; n < 2; ++n) { \
        if constexpr (FP8) asm volatile("v_mfma_scale_f32_16x16x128_f8f6f4 %0, %1, %2, %0, %3, %4 op_sel_hi:[0,0,0]" : "+v"(acc[ai][bj][m][n]) : "v"(Bt##8[n]), "v"(At##8[m]), "v"(scb_), "v"(sca_)); \
        else { _Pragma("unroll") for (int k = 0; k < 2; ++k) acc[ai][bj][m][n] = __builtin_amdgcn_mfma_f32_16x16x32_bf16(Bt[n][k], At[m][k], acc[ai][bj][m][n], 0, 0, 0); } } \
        __builtin_amdgcn_s_setprio(0); } while (0)
#define PG8_WAIT_V(n) asm volatile("s_waitcnt vmcnt(" #n ")" ::: "memory")
#define PG8_WAIT_L(n) asm volatile("s_waitcnt lgkmcnt(" #n ")" ::: "memory")
#define PG8_BAR __builtin_amdgcn_s_barrier()
#define PG8_SCHED __builtin_amdgcn_sched_barrier(0)
    Unit cur, nxt; int ui = 0;
    if (!S.next(0, cur)) return;
    f32x4 acc[2][2][4][2];
#pragma unroll
    for (int a = 0; a < 2; ++a)
#pragma unroll
        for (int b = 0; b < 2; ++b)
#pragma unroll
            for (int m = 0; m < 4; ++m)
#pragma unroll
                for (int n = 0; n < 2; ++n) acc[a][b][m][n] = (f32x4){0.f, 0.f, 0.f, 0.f};
    const int sca_ = SCA, scb_ = SCB;
    bf16x8 At[4][2], B0[2][2], B1[2][2]; v8i_t At8[4], B08[2], B18[2];
    unsigned vc[2][2], vn[2][2];
    S.aoff(cur, Rr, Cc, vc);
    const char* cB = cur.b;
    PG8_STAGE_B(PG8_SB(0, 0), cB); PG8_STAGE_A(PG8_SA(0, 0), vc[0][0], vc[0][1], 0); PG8_STAGE_B(PG8_SB(0, 1), cB + hstep); PG8_STAGE_A(PG8_SA(0, 1), vc[1][0], vc[1][1], 0);
    if (wr == 1) PG8_BAR;
    PG8_WAIT_V(4); PG8_BAR;
    PG8_STAGE_B(PG8_SB(1, 0), cB + kstep); PG8_STAGE_A(PG8_SA(1, 0), vc[0][0], vc[0][1], kstepA); PG8_STAGE_B(PG8_SB(1, 1), cB + hstep + kstep);
    PG8_WAIT_V(6); PG8_BAR;
    for (;;) {
        const bool has_next = S.next(ui + 1, nxt);
        if constexpr (Sched::GATHER_LDS) {
            if (has_next && wid < 4) __builtin_amdgcn_global_load_lds((const unsigned*)(S.list + nxt.e * CAP + nxt.pos0 + tid), (LAS unsigned*)(lds + LDS_IDX + wid * 256), 4, 0, 0);
        } else if (has_next) S.aoff(nxt, Rr, Cc, vn);
        if (!has_next) {
#pragma unroll
            for (int h = 0; h < 2; ++h)
#pragma unroll
                for (int i = 0; i < 2; ++i) vn[h][i] = vc[h][i]; }
        const char* nB = has_next ? nxt.b : cB;
#pragma unroll 1
        for (int t = 0; t < nt; t += 2) {
            const bool last = (t == nt - 2);
            if constexpr (Sched::GATHER_LDS) { if (last && has_next) {
#pragma unroll
                for (int h = 0; h < 2; ++h)
#pragma unroll
                    for (int i = 0; i < 2; ++i) { const int rr = h * HALF + Rr[i]; const int pair = (nxt.pos0 + rr) < nxt.cnt ? ((const LAS int*)(lds + LDS_IDX))[rr] : 0; vn[h][i] = (unsigned)((pair >> 2) * S.rowb + Cc[i] * 2); } } }
            const size_t k1 = (size_t)(t + 1) * kstepA;
            const size_t k2 = last ? 0 : (size_t)(t + 2) * kstepA;
            const unsigned s00 = last ? vn[0][0] : vc[0][0], s01 = last ? vn[0][1] : vc[0][1], s10 = last ? vn[1][0] : vc[1][0], s11 = last ? vn[1][1] : vc[1][1];
            const char* b2 = last ? nB : cB + (size_t)(t + 2) * kstep; const char* b3 = b2 + kstep;
            PG8_LDB(B0, 0, 0); PG8_SCHED; PG8_LDA(At, 0, 0); PG8_STAGE_A(PG8_SA(1, 1), vc[1][0], vc[1][1], k1);
            PG8_WAIT_L(8); PG8_BAR; PG8_WAIT_L(0); PG8_MMA(0, 0, At, B0); PG8_BAR; PG8_SCHED;
            PG8_LDB(B1, 0, 1); PG8_STAGE_B(PG8_SB(0, 0), b2);
            PG8_BAR; PG8_WAIT_L(0); PG8_MMA(0, 1, At, B1); PG8_BAR; if constexpr (FP8) PG8_SCHED;
            PG8_LDA(At, 0, 1); PG8_STAGE_A(PG8_SA(0, 0), s00, s01, k2);
            PG8_BAR; PG8_WAIT_L(0); PG8_MMA(1, 0, At, B0); PG8_BAR; PG8_SCHED;
            PG8_STAGE_B(PG8_SB(0, 1), b2 + hstep);
            PG8_WAIT_V(6); PG8_BAR; PG8_MMA(1, 1, At, B1); PG8_BAR; if constexpr (FP8) PG8_SCHED;
            PG8_LDB(B0, 1, 0); PG8_SCHED; PG8_LDA(At, 1, 0); PG8_STAGE_A(PG8_SA(0, 1), s10, s11, k2);
            PG8_WAIT_L(8); PG8_BAR; PG8_WAIT_L(0); PG8_MMA(0, 0, At, B0); PG8_BAR; PG8_SCHED;
            PG8_LDB(B1, 1, 1); PG8_STAGE_B(PG8_SB(1, 0), b3);
            PG8_BAR; PG8_WAIT_L(0); PG8_MMA(0, 1, At, B1); PG8_BAR; if constexpr (FP8) PG8_SCHED;
            PG8_LDA(At, 1, 1); PG8_STAGE_A(PG8_SA(1, 0), s00, s01, k2 + kstepA);
            PG8_BAR; PG8_WAIT_L(0); PG8_MMA(1, 0, At, B0); PG8_BAR; PG8_SCHED;
            PG8_STAGE_B(PG8_SB(1, 1), b3 + hstep);
            PG8_WAIT_V(6); PG8_BAR; PG8_MMA(1, 1, At, B1); PG8_BAR; if constexpr (FP8) PG8_SCHED;
        }
        if constexpr (FP8) asm volatile("s_nop 15\n\ts_nop 15" ::: "memory");
        E(acc, cur, wr, wc, fr, fq);
        if (!has_next) break;
#pragma unroll
        for (int a = 0; a < 2; ++a)
#pragma unroll
            for (int b = 0; b < 2; ++b)
#pragma unroll
                for (int m = 0; m < 4; ++m)
#pragma unroll
                    for (int n = 0; n < 2; ++n) acc[a][b][m][n] = (f32x4){0.f, 0.f, 0.f, 0.f};
        cur = nxt; cB = nB; ++ui;
#pragma unroll
        for (int h = 0; h < 2; ++h)
#pragma unroll
            for (int i = 0; i < 2; ++i) vc[h][i] = vn[h][i];
    }
    PG8_WAIT_V(0);
    if (wr == 0) PG8_BAR;
    PG8_BAR;
#undef PG8_SA
#undef PG8_SB
#undef PG8_STAGE_A
#undef PG8_STAGE_B
#undef PG8_LDA
#undef PG8_LDB
#undef PG8_MMA
#undef PG8_WAIT_V
#undef PG8_WAIT_L
#undef PG8_BAR
#undef PG8_SCHED
}

typedef f32x4 Acc[2][2][4][2];
__device__ __forceinline__ unsigned dpp_ror8(unsigned x) { return (unsigned)__builtin_amdgcn_update_dpp(0, (int)x, 0x128, 0xf, 0xf, false); }
__device__ __forceinline__ u32x4 ror8_4(const u32x4 v) { u32x4 r; r.x = dpp_ror8(v.x); r.y = dpp_ror8(v.y); r.z = dpp_ror8(v.z); r.w = dpp_ror8(v.w); return r; }
__device__ __forceinline__ void line_xy(const u32x4 a, const u32x4 b, bool lo, u32x4& X, u32x4& Y) { const u32x4 ra = ror8_4(a), rb = ror8_4(b); X = lo ? a : rb; Y = lo ? ra : b; }
__device__ __forceinline__ u32x4 pack8(const f32x4 v0, const f32x4 v1) { u32x4 w; w.x = cvt_pk_bf16(v0[0], v0[1]); w.y = cvt_pk_bf16(v0[2], v0[3]); w.z = cvt_pk_bf16(v1[0], v1[1]); w.w = cvt_pk_bf16(v1[2], v1[3]); return w; }

struct EpiIn { static constexpr bool PERM = true; char* ws;
    __device__ __forceinline__ void operator()(const Acc& acc, const Unit& u, int wr, int wc, int fr, int fq) const {
        const int pn = u.pn; size_t boff; int ld, cb;
        if (pn < 3) { boff = OFF_QA; ld = 384; cb = pn * 128; } else if (pn == 3) { boff = OFF_CKV; ld = 256; cb = 0; }
        else if (pn < 32) { boff = OFF_HQ + (size_t)((pn - 4) >> 2) * SEG_STRIDE; ld = 1024; cb = ((pn - 4) & 3) * 256; }
        else { boff = OFF_KR; ld = 64; cb = 0; }
        bf16_t* base = (bf16_t*)(ws + boff);
        if (pn == 32 && wc != 0) return;
        const bool lo = fr < 8; const int rowb0 = u.pm * BM + wr * 64, rx = fr & 7, colx = cb + wc * 64 + (fr >> 3) * 32 + 8 * fq;
        float* ssq = (float*)(ws + (pn < 3 ? OFF_SSQQ : OFF_SSQKV));
#pragma unroll
        for (int ai = 0; ai < 2; ++ai)
#pragma unroll
            for (int m = 0; m < 4; ++m) { const int rg = rowb0 + ai * HALF + m * 16;
                f32x4 v0 = acc[ai][0][m][0], v1 = acc[ai][0][m][1], w0 = acc[ai][1][m][0], w1 = acc[ai][1][m][1];
                if (pn >= 4 && pn < 8) {
#pragma unroll
                    for (int j = 0; j < 4; ++j) { v0[j] = siluf_(v0[j]) * 0.08838834764831845f; v1[j] = siluf_(v1[j]) * 0.08838834764831845f; w0[j] = siluf_(w0[j]) * 0.08838834764831845f; w1[j] = siluf_(w1[j]) * 0.08838834764831845f; } }
                if (pn < 3 || (pn >= 20 && pn < 32)) { unsigned char* qrow = pn < 3 ? (unsigned char*)base + (size_t)(rg + fr) * 768 + pn * 256 + wc * 64 + 8 * fq : (unsigned char*)base + (size_t)(rg + fr) * 1024 + (pn & 3) * 256 + wc * 64 + 8 * fq;
                    u32x2 a8; a8.x = pack4_fp8(v0[0], v0[1], v0[2], v0[3]); a8.y = pack4_fp8(v1[0], v1[1], v1[2], v1[3]); u32x2 b8; b8.x = pack4_fp8(w0[0], w0[1], w0[2], w0[3]); b8.y = pack4_fp8(w1[0], w1[1], w1[2], w1[3]);
                    *(u32x2*)qrow = a8; *(u32x2*)(qrow + 32) = b8; }
                else { u32x4 X, Y; line_xy(pack8(v0, v1), pack8(w0, w1), lo, X, Y);
                    __builtin_nontemporal_store(X, (u32x4*)(base + (size_t)(rg + rx) * ld + colx)); __builtin_nontemporal_store(Y, (u32x4*)(base + (size_t)(rg + 8 + rx) * ld + colx)); }
                if (pn <= 3) { float ss = (v0[0] * v0[0] + v0[1] * v0[1]) + (v0[2] * v0[2] + v0[3] * v0[3]) + (v1[0] * v1[0] + v1[1] * v1[1]) + (v1[2] * v1[2] + v1[3] * v1[3])
                                        + (w0[0] * w0[0] + w0[1] * w0[1]) + (w0[2] * w0[2] + w0[3] * w0[3]) + (w1[0] * w1[0] + w1[1] * w1[1]) + (w1[2] * w1[2] + w1[3] * w1[3]);
                    ss += __shfl_xor(ss, 16); ss += __shfl_xor(ss, 32); if (fq == 0) atomicAdd(ssq + rg + fr, ss); } }
    } };

struct EpiQ { static constexpr bool PERM = true; bf16_t* q; const float* ssq;
    __device__ __forceinline__ void operator()(const Acc& acc, const Unit& u, int wr, int wc, int fr, int fq) const {
        const bool lo = fr < 8; const int rowb0 = u.pm * BM + wr * 64, rx = fr & 7, colx = u.pn * BM + wc * 64 + (fr >> 3) * 32 + 8 * fq;
#pragma unroll
        for (int ai = 0; ai < 2; ++ai)
#pragma unroll
            for (int m = 0; m < 4; ++m) { const int rg = rowb0 + ai * HALF + m * 16; const float rs = rsqrtf(ssq[rg + fr] * (1.0f / 768.0f) + EPS);
                u32x4 X, Y; line_xy(pack8(acc[ai][0][m][0] * rs, acc[ai][0][m][1] * rs), pack8(acc[ai][1][m][0] * rs, acc[ai][1][m][1] * rs), lo, X, Y);
                *(u32x4*)(q + (size_t)(rg + rx) * 1536 + colx) = X; *(u32x4*)(q + (size_t)(rg + 8 + rx) * 1536 + colx) = Y; }
    } };

struct EpiKV { static constexpr bool PERM = true; bf16_t *Kb, *Vb; const float* ssq;
    __device__ __forceinline__ size_t kvrow(int row, int h) const { int b, pos; if (row < L) { b = row >> 11; pos = row & 2047; } else { b = (row - L) >> 8; pos = SEQ + ((row - L) & 255); } return (size_t)(b * 8 + h) * NKEY + pos; }
    __device__ __forceinline__ void operator()(const Acc& acc, const Unit& u, int wr, int wc, int fr, int fq) const {
        const bool lo = fr < 8; const int rowb0 = u.pm * BM + wr * 64, rx = fr & 7, colx = (wc & 1) * 64 + (fr >> 3) * 32 + 8 * fq;
        bf16_t* dst = wc < 2 ? Kb : Vb; const int ld = wc < 2 ? 192 : 128;
#pragma unroll
        for (int ai = 0; ai < 2; ++ai)
#pragma unroll
            for (int m = 0; m < 4; ++m) { const int rg = rowb0 + ai * HALF + m * 16; const float rs = rsqrtf(ssq[rg + fr] * (1.0f / 256.0f) + EPS);
                u32x4 X, Y; line_xy(pack8(acc[ai][0][m][0] * rs, acc[ai][0][m][1] * rs), pack8(acc[ai][1][m][0] * rs, acc[ai][1][m][1] * rs), lo, X, Y);
                *(u32x4*)(dst + kvrow(rg + rx, u.pn) * ld + colx) = X; *(u32x4*)(dst + kvrow(rg + 8 + rx, u.pn) * ld + colx) = Y; }
    } };

struct EpiOut { static constexpr bool PERM = true; bf16_t* x1; const float* x; const float* modv;
    __device__ __forceinline__ void operator()(const Acc& acc, const Unit& u, int wr, int wc, int fr, int fq) const {
        const bool lo = fr < 8; const int rowb0 = u.pm * BM + wr * 64, rx = fr & 7, colx = u.pn * BM + wc * 64 + (fr >> 3) * 32 + 8 * fq, cown = u.pn * BM + wc * 64 + 8 * fq;
#pragma unroll
        for (int ai = 0; ai < 2; ++ai)
#pragma unroll
            for (int m = 0; m < 4; ++m) { const int rg = rowb0 + ai * HALF + m * 16, row = rg + fr; const float* gate = modv + (row >> 11) * 6144 + 2 * 1024 + cown; const float* xr = x + (size_t)row * D + cown;
                f32x4 r[2][2];
#pragma unroll
                for (int bj = 0; bj < 2; ++bj)
#pragma unroll
                    for (int n = 0; n < 2; ++n) r[bj][n] = *(const f32x4*)(xr + bj * 32 + 4 * n) + *(const f32x4*)(gate + bj * 32 + 4 * n) * acc[ai][bj][m][n];
                u32x4 X, Y; line_xy(pack8(r[0][0], r[0][1]), pack8(r[1][0], r[1][1]), lo, X, Y);
                *(u32x4*)(x1 + (size_t)(rg + rx) * D + colx) = X; *(u32x4*)(x1 + (size_t)(rg + 8 + rx) * D + colx) = Y; }
    } };

struct EpiMoe1 { static constexpr bool PERM = true; unsigned char* act; const float* bgu;
    __device__ __forceinline__ void operator()(const Acc& acc, const Unit& u, int wr, int wc, int fr, int fq) const {
        const int o0 = u.pn * 128 + wc * 16 + 4 * fq;
        f32x4 bg[2], bl[2];
#pragma unroll
        for (int bj = 0; bj < 2; ++bj) { const float* bp = bgu + u.e * 2048 + 2 * (o0 + bj * 64); const f32x4 t0 = *(const f32x4*)bp, t1 = *(const f32x4*)(bp + 4);
            bg[bj] = (f32x4){t0[0], t0[2], t1[0], t1[2]}; bl[bj] = (f32x4){t0[1], t0[3], t1[1], t1[3]}; }
        unsigned char* blk = act + ((size_t)u.pm * 8 + u.pn) * 32768 + (size_t)(wr * 4 + wc) * 1024 + (size_t)(fq * 16 + fr) * 16;
#pragma unroll
        for (int ai = 0; ai < 2; ++ai)
#pragma unroll
            for (int bj = 0; bj < 2; ++bj) { unsigned d[4];
#pragma unroll
                for (int m = 0; m < 4; ++m) { const f32x4 g4 = acc[ai][bj][m][0] + bg[bj], l4 = acc[ai][bj][m][1] + bl[bj]; float r[4];
#pragma unroll
                    for (int j = 0; j < 4; ++j) { const float glu = fminf(g4[j], 7.0f), lin = __builtin_amdgcn_fmed3f(l4[j], -7.0f, 7.0f); r[j] = 4.0f * glu * __builtin_amdgcn_rcpf(1.0f + __builtin_amdgcn_exp2f(-2.4554669595930157f * glu)) * (lin + 1.0f); }
                    d[m] = pack4_fp8(r[0], r[1], r[2], r[3]); }
                const auto s01 = __builtin_amdgcn_permlane16_swap(d[0], d[1], false, false); const auto s23 = __builtin_amdgcn_permlane16_swap(d[2], d[3], false, false);
                const auto t02 = __builtin_amdgcn_permlane32_swap(s01[0], s23[0], false, false); const auto t13 = __builtin_amdgcn_permlane32_swap(s01[1], s23[1], false, false);
                *(u32x4*)(blk + (size_t)(ai * 2 + bj) * 8192) = (u32x4){t02[0], t13[0], t02[1], t13[1]}; }
    } };

struct EpiMoe2 { static constexpr bool PERM = true; bf16_t* yp; const float* bd;
    __device__ __forceinline__ void operator()(const Acc& acc, const Unit& u, int wr, int wc, int fr, int fq) const {
        const bool lo = fr < 8; const int rowb0 = u.pm * BM + wr * 64, rx = fr & 7, colx = u.pn * BM + wc * 64 + (fr >> 3) * 32 + 8 * fq, cown = u.pn * BM + wc * 64 + 8 * fq;
        f32x4 bv[2][2];
#pragma unroll
        for (int bj = 0; bj < 2; ++bj)
#pragma unroll
            for (int n = 0; n < 2; ++n) bv[bj][n] = *(const f32x4*)(bd + u.e * 1024 + cown + bj * 32 + 4 * n);
#pragma unroll
        for (int ai = 0; ai < 2; ++ai)
#pragma unroll
            for (int m = 0; m < 4; ++m) { const int rg = rowb0 + ai * HALF + m * 16;
                u32x4 X, Y; line_xy(pack8(acc[ai][0][m][0] + bv[0][0], acc[ai][0][m][1] + bv[0][1]), pack8(acc[ai][1][m][0] + bv[1][0], acc[ai][1][m][1] + bv[1][1]), lo, X, Y);
                __builtin_nontemporal_store(X, (u32x4*)(yp + (size_t)(rg + rx) * D + colx)); __builtin_nontemporal_store(Y, (u32x4*)(yp + (size_t)(rg + 8 + rx) * D + colx)); }
    } };
}

__device__ __forceinline__ int conv_src_col(int kind, int c) {
    if (kind == 0) return c;
    if (kind == 1) { if (c < 1024) return c; if (c < 8192) return c + 64; if (c < 8256) return c - 8192 + 1024; return -1; }
    const int pn = c >> 8, p = c & 255, wc = p >> 6, bj = (p >> 5) & 1, fq = (p >> 3) & 3, n = (p >> 2) & 1, i = p & 3; const int o = 128 * pn + 64 * bj + 16 * wc + 4 * fq + i; return 2 * o + n;
}
template <bool F8> struct ConvPipe {
    float v[32]; bool have; bf16_t* dummy;
    int K, kind, k0, c0; void* Wt;
    __device__ __forceinline__ void issue(const float* __restrict__ W, int ldw, void* Wt_, int K_, int kind_, const float* __restrict__ kscale, int k0_, int c0_) {
        const int tid = otid(); const int cc = tid & 127, kq = tid >> 7, sc = conv_src_col(kind_, c0_ + cc);
        const int scc = sc < 0 ? 0 : sc; const float* wp = W + (size_t)(k0_ + kq) * ldw + scc;
#pragma unroll
        for (int i = 0; i < 32; ++i) v[i] = __builtin_nontemporal_load(wp + (size_t)(4 * i) * ldw);
        if (sc < 0) {
#pragma unroll
            for (int i = 0; i < 32; ++i) v[i] = 0.f; }
        if (kscale) {
#pragma unroll
            for (int i = 0; i < 32; ++i) v[i] *= kscale[k0_ + kq + 4 * i]; }
        K = K_; kind = kind_; k0 = k0_; c0 = c0_; Wt = Wt_; have = true;
    }
    __device__ __forceinline__ void flush(LAS float* tl) {
        if (!have) return; have = false;
        const int tid = otid(); const int cc = tid & 127, kq = tid >> 7;
        __syncthreads();
#pragma unroll
        for (int i = 0; i < 32; ++i) tl[(kq + 4 * i) * 129 + cc] = v[i];
        __syncthreads();
        stash(tl, tid);
    }
    __device__ __forceinline__ void to_lds(LAS float* tl) { const int tid = otid(); const int cc = tid & 127, kq = tid >> 7; __syncthreads();
#pragma unroll
        for (int i = 0; i < 32; ++i) tl[(kq + 4 * i) * 129 + cc] = v[i];
        __syncthreads(); }
    __device__ __forceinline__ void stash(LAS float* tl, int tid) const {
        if constexpr (F8) {
#pragma unroll
            for (int pss = 0; pss < 2; ++pss) { const int item = tid + 512 * pss, c2 = item >> 3, ch = item & 7; float t[16];
#pragma unroll
                for (int j = 0; j < 16; ++j) t[j] = tl[(16 * ch + j) * 129 + c2] * 32.f;
                u32x4 w; w.x = pack4_fp8(t[0], t[1], t[2], t[3]); w.y = pack4_fp8(t[4], t[5], t[6], t[7]); w.z = pack4_fp8(t[8], t[9], t[10], t[11]); w.w = pack4_fp8(t[12], t[13], t[14], t[15]);
                *(u32x4*)((unsigned char*)Wt + (size_t)(c0 + c2) * K + k0 + 16 * ch) = w; }
        } else {
#pragma unroll
            for (int pss = 0; pss < 4; ++pss) { const int item = tid + 512 * pss, c2 = item >> 4, ch = item & 15; float t[8];
#pragma unroll
                for (int j = 0; j < 8; ++j) t[j] = tl[(8 * ch + j) * 129 + c2];
                u32x4 w; w.x = cvt_pk_bf16(t[0], t[1]); w.y = cvt_pk_bf16(t[2], t[3]); w.z = cvt_pk_bf16(t[4], t[5]); w.w = cvt_pk_bf16(t[6], t[7]);
                *(u32x4*)((bf16_t*)Wt + (size_t)(c0 + c2) * K + k0 + 8 * ch) = w; }
        }
    }
};
template <bool F8>
__device__ __forceinline__ void conv_matrix(LAS float* tl, ConvPipe<F8>& pipe, const float* W, int ldw, void* Wt, int K, int Nout, int kind, const float* kscale, int& tctr) {
    const int nk = K / 128, ntile = nk * (Nout / 128);
    int t = ((int)blockIdx.x - tctr) % (int)gridDim.x; if (t < 0) t += gridDim.x;
    for (; t < ntile; t += gridDim.x) {
        if (pipe.have) { pipe.to_lds(tl); const int K0 = pipe.K, k00 = pipe.k0, c00 = pipe.c0; void* W0 = pipe.Wt; ConvPipe<F8> done = pipe; (void)K0; (void)k00; (void)c00; (void)W0;
            pipe.issue(W, ldw, Wt, K, kind, kscale, (t % nk) * 128, (t / nk) * 128); done.stash(tl, otid()); }
        else pipe.issue(W, ldw, Wt, K, kind, kscale, (t % nk) * 128, (t / nk) * 128);
    }
    tctr = (tctr + ntile) % (int)gridDim.x;
}
template <bool F8> __device__ __forceinline__ void conv_finish(LAS float* tl, ConvPipe<F8>& pipe) { if (pipe.have) { pipe.to_lds(tl); pipe.stash(tl, otid()); pipe.have = false; } __syncthreads(); }

__device__ __forceinline__ float half_sum256(float v, LAS float* red) {
    for (int o = 32; o > 0; o >>= 1) v += __shfl_xor(v, o);
    const int w = otid() >> 6, hb = (otid() >> 8) * 4; if ((otid() & 63) == 0) red[w] = v; __syncthreads();
    const float t = red[hb] + red[hb + 1] + red[hb + 2] + red[hb + 3]; __syncthreads(); return t;
}

__device__ __forceinline__ void phase0(const Params& p, LAS unsigned char* lds) {
    char* ws = p.ws; const int tid = otid(), gsz = gridDim.x * 512, gid = blockIdx.x * 512 + tid;
    float* lb = (float*)(ws + OFF_LB); int* cnt = (int*)(ws + OFF_CNT); float* ssqq = (float*)(ws + OFF_SSQQ); float* ssqkv = (float*)(ws + OFF_SSQKV); float* modv = (float*)(ws + OFF_MOD);
    for (int i = gid; i < 2048; i += gsz) { const int d = i >> 10, j = i & 1023; const float a = p.lbl[(d * 2 + 0) * 1024 + j], b = p.lbl[(d * 2 + 1) * 1024 + j]; lb[i] = 1.0f / (1.0f + __expf(b - a)); }
    for (int i = gid; i < 32; i += gsz) cnt[i] = 0;
    { float* ropet = (float*)(ws + OFF_ROPE); for (int i = gid; i < SEQ * 32; i += gsz) { const int t = i >> 5, j = i & 31; float cs, sn; rope_cs(t, j, cs, sn); ropet[t * 64 + j] = cs; ropet[t * 64 + 32 + j] = sn; } }
    for (int i = gid; i < L; i += gsz) ssqq[i] = 0.f;
    for (int i = gid; i < R; i += gsz) ssqkv[i] = 0.f;
    { LAS float* sil = (LAS float*)lds;
      LAS float* part = (LAS float*)(lds + 17 * 1024 * 4);
      bool loaded = false;
      for (int item = blockIdx.x; item < 192; item += gridDim.x) {
          if (!loaded) { for (int i = tid; i < 17 * 1024; i += 512) { const int r = i >> 10, k = i & 1023; sil[i] = siluf_(r < 16 ? p.c[r * 1024 + k] : p.cctx[k]); } loaded = true; __syncthreads(); }
          const int j = tid & 31, ks = tid >> 5; float a[17];
#pragma unroll
          for (int r = 0; r < 17; ++r) a[r] = 0.f;
#pragma unroll 4
          for (int k = ks * 64; k < ks * 64 + 64; ++k) { const float w = p.w_mod[(size_t)k * 6144 + item * 32 + j];
#pragma unroll
              for (int r = 0; r < 17; ++r) a[r] += sil[r * 1024 + k] * w; }
#pragma unroll
          for (int r = 0; r < 17; ++r) part[(ks * 17 + r) * 32 + j] = a[r];
          __syncthreads();
          for (int i = tid; i < 17 * 32; i += 512) { const int r = i >> 5, jj = i & 31; float s = p.b_mod[item * 32 + jj]; for (int q = 0; q < 16; ++q) s += part[(q * 17 + r) * 32 + jj]; modv[r * 6144 + item * 32 + jj] = s; }
          __syncthreads();
      } }
    __syncthreads();
    { LAS float* tl = (LAS float*)lds; int tctr = 0;
      { ConvPipe<true> pp; pp.have = false; conv_matrix<true>(tl, pp, p.w_in, 8256, (unsigned char*)(ws + OFF_WT_IN), 1024, 8448, 1, nullptr, tctr); conv_finish<true>(tl, pp); }
      { ConvPipe<true> pp; pp.have = false;
        conv_matrix<true>(tl, pp, p.w_qb, 1536, (unsigned char*)(ws + OFF_WT_QB), 768, 1536, 0, p.g_q, tctr);
        conv_matrix<true>(tl, pp, p.w_out, 1024, (unsigned char*)(ws + OFF_WT_OUT), 1024, 1024, 0, nullptr, tctr); conv_finish<true>(tl, pp); }
      { ConvPipe<false> pp; pp.have = false;
        conv_matrix<false>(tl, pp, p.w_kvb, 2048, (bf16_t*)(ws + OFF_WT_KVB), 256, 2048, 0, p.g_kv, tctr); conv_finish<false>(tl, pp); } }
}

__device__ __forceinline__ float wave_sum(float v) {
#pragma unroll
    for (int o = 32; o > 0; o >>= 1) v += __shfl_xor(v, o);
    return v; }
__device__ __forceinline__ void phase1(const Params& p, LAS unsigned char* lds) {
    const float* modv = (const float*)(p.ws + OFF_MOD); unsigned char* h = (unsigned char*)(p.ws + OFF_H);
    const int tid = otid(), lane = tid & 63, gw = blockIdx.x * 8 + (tid >> 6), nw = gridDim.x * 8, c0 = lane * 8;
    f32x4 g[4];
#pragma unroll
    for (int q = 0; q < 4; ++q) g[q] = *(const f32x4*)(p.g_mix + (q >> 1) * 512 + c0 + (q & 1) * 4);
    for (int row0 = gw; row0 < R; row0 += 2 * nw) {
        f32x4 v[2][4]; const bool two = row0 + nw < R;
#pragma unroll
        for (int u = 0; u < 2; ++u) { const int row = (u == 0 || two) ? row0 + u * nw : row0; const float* src = row < L ? p.x + (size_t)row * D : p.ctx + (size_t)(row - L) * D;
#pragma unroll
            for (int q = 0; q < 4; ++q) v[u][q] = __builtin_nontemporal_load((const f32x4*)(src + (q >> 1) * 512 + c0 + (q & 1) * 4)); }
#pragma unroll
        for (int u = 0; u < 2; ++u) { if (u == 1 && !two) break; const int row = row0 + u * nw; const float* mod = modv + (row < L ? row / SEQ : 16) * 6144;
            float ss = 0.f;
#pragma unroll
            for (int q = 0; q < 4; ++q) ss += (v[u][q][0] * v[u][q][0] + v[u][q][1] * v[u][q][1]) + (v[u][q][2] * v[u][q][2] + v[u][q][3] * v[u][q][3]);
            const float rs = rsqrtf(wave_sum(ss) * (1.0f / D) + EPS);
#pragma unroll
            for (int j = 0; j < 2; ++j) { f32x4 o[2];
#pragma unroll
                for (int e = 0; e < 2; ++e) { const int cc = j * 512 + c0 + e * 4; const f32x4 sc = *(const f32x4*)(mod + 1024 + cc), sh = *(const f32x4*)(mod + cc); o[e] = v[u][j * 2 + e] * rs * g[j * 2 + e] * (sc + 1.0f) + sh; }
                u32x2 w; w.x = pack4_fp8(o[0][0], o[0][1], o[0][2], o[0][3]); w.y = pack4_fp8(o[1][0], o[1][1], o[1][2], o[1][3]);
                *(u32x2*)(h + (size_t)row * D + j * 512 + c0) = w; } }
    }
}


__device__ __forceinline__ void phase2(const Params& p, LAS unsigned char* lds) {
    pg8::InSched S; S.init2(p.ws + OFF_WT_IN, gridDim.x, blockIdx.x);
    pg8::EpiIn E{p.ws};
    pg8::gemm_phase<pg8::EpiIn, pg8::InSched, true, 127, 122>(lds, (const char*)(p.ws + OFF_H), 1024, S, E);
}
__device__ __forceinline__ void phase3(const Params& p, LAS unsigned char* lds) {
    char* ws = p.ws;
    { pg8::DenseSched S; S.init(L, 1536, 768, 768, ws + OFF_WT_QB, gridDim.x, blockIdx.x); pg8::EpiQ E{(bf16_t*)(ws + OFF_Q), (const float*)(ws + OFF_SSQQ)}; pg8::gemm_phase<pg8::EpiQ, pg8::DenseSched, true, 127, 122>(lds, (const char*)(ws + OFF_QA), 768, S, E); }
    { pg8::DenseSched S; S.init(R, 2048, 256 * 2, 256 * 2, ws + OFF_WT_KVB, gridDim.x, blockIdx.x); pg8::EpiKV E{(bf16_t*)(ws + OFF_K), (bf16_t*)(ws + OFF_V), (const float*)(ws + OFF_SSQKV)}; pg8::gemm_phase(lds, (const char*)(ws + OFF_CKV), 256, S, E); }
    { const bf16_t* kr = (const bf16_t*)(ws + OFF_KR); bf16_t* Kb = (bf16_t*)(ws + OFF_K); const float* ropet = (const float*)(ws + OFF_ROPE);
      for (int gid = blockIdx.x * 512 + otid(); gid < R * 32; gid += gridDim.x * 512) { const int row = gid >> 5, i = gid & 31;
          const float x1 = bf2f(kr[(size_t)row * 64 + i]), x2 = bf2f(kr[(size_t)row * 64 + 32 + i]); float o1 = x1, o2 = x2; int b, pos;
          if (row < L) { b = row / SEQ; pos = row % SEQ; const float cs = ropet[pos * 64 + i], sn = ropet[pos * 64 + 32 + i]; o1 = x1 * cs - x2 * sn; o2 = x1 * sn + x2 * cs; } else { b = (row - L) / CTXL; pos = SEQ + (row - L) % CTXL; }
          const bf16_t w1 = f2bf(o1), w2 = f2bf(o2);
          for (int h = 0; h < 8; ++h) { bf16_t* q = Kb + ((size_t)(b * 8 + h) * NKEY + pos) * 192 + 128; q[i] = w1; q[32 + i] = w2; } } }
}
__device__ __forceinline__ void unpack8_fp8(const u32x2 w, float (&o)[8]) {
    o[0] = __builtin_amdgcn_cvt_f32_fp8((int)w.x, 0); o[1] = __builtin_amdgcn_cvt_f32_fp8((int)w.x, 1); o[2] = __builtin_amdgcn_cvt_f32_fp8((int)w.x, 2); o[3] = __builtin_amdgcn_cvt_f32_fp8((int)w.x, 3);
    o[4] = __builtin_amdgcn_cvt_f32_fp8((int)w.y, 0); o[5] = __builtin_amdgcn_cvt_f32_fp8((int)w.y, 1); o[6] = __builtin_amdgcn_cvt_f32_fp8((int)w.y, 2); o[7] = __builtin_amdgcn_cvt_f32_fp8((int)w.y, 3); }
__device__ __forceinline__ void unpack8(const u32x4 w, float (&o)[8]) {
    o[0] = __uint_as_float(w.x << 16); o[1] = __uint_as_float(w.x & 0xffff0000u); o[2] = __uint_as_float(w.y << 16); o[3] = __uint_as_float(w.y & 0xffff0000u);
    o[4] = __uint_as_float(w.z << 16); o[5] = __uint_as_float(w.z & 0xffff0000u); o[6] = __uint_as_float(w.w << 16); o[7] = __uint_as_float(w.w & 0xffff0000u); }
__device__ __forceinline__ void phase4(const Params& p, LAS unsigned char*) {
    char* ws = p.ws; bf16_t* y = (bf16_t*)(ws + OFF_H); const bf16_t* of = (const bf16_t*)(ws + OFF_OF); const bf16_t* ob = (const bf16_t*)(ws + OFF_OB);
    const unsigned char* og = (const unsigned char*)(ws + OFF_OG); const unsigned char* gm = (const unsigned char*)(ws + OFF_GM); const unsigned char* gh = (const unsigned char*)(ws + OFF_GH);
    const int tid = otid(), lane = tid & 63, gw = blockIdx.x * 8 + (tid >> 6), nw = gridDim.x * 8, c0 = lane * 8;
    float gg[8];
#pragma unroll
    for (int i = 0; i < 8; ++i) gg[i] = p.g_hg[(c0 + i) & 127];
    for (int row = gw; row < L; row += nw) {
        u32x4 ra[2], rb[2], rm[2]; u32x2 r1[2], r2[2], r3[2];
#pragma unroll
        for (int j = 0; j < 2; ++j) { const size_t off = (size_t)row * D + j * 512 + c0; ra[j] = __builtin_nontemporal_load((const u32x4*)(of + off)); rb[j] = __builtin_nontemporal_load((const u32x4*)(ob + off)); r1[j] = __builtin_nontemporal_load((const u32x2*)(og + off)); r2[j] = __builtin_nontemporal_load((const u32x2*)(gm + off)); r3[j] = __builtin_nontemporal_load((const u32x2*)(gh + off)); rm[j] = __builtin_nontemporal_load((const u32x4*)(y + off)); }
#pragma unroll
        for (int j = 0; j < 2; ++j) { float a[8], b[8], g1[8], g2[8], g3[8], ym[8], o[8]; unpack8(ra[j], a); unpack8(rb[j], b); unpack8_fp8(r1[j], g1); unpack8_fp8(r2[j], g2); unpack8_fp8(r3[j], g3); unpack8(rm[j], ym);
            float ss = 0.f;
#pragma unroll
            for (int i = 0; i < 8; ++i) { o[i] = a[i] + b[i]; ss += o[i] * o[i]; }
            ss += __shfl_xor(ss, 1); ss += __shfl_xor(ss, 2); ss += __shfl_xor(ss, 4); ss += __shfl_xor(ss, 8);
            const float rs = rsqrtf(ss * (1.0f / 128.0f) + EPS); float r[8];
#pragma unroll
            for (int i = 0; i < 8; ++i) { const float yh = o[i] * rs * gg[i] * siluf_(g1[i]); r[i] = sigmoidf_(g2[i]) * ym[i] + sigmoidf_(g3[i]) * yh; }
            u32x2 w; w.x = pack4_fp8(r[0], r[1], r[2], r[3]); w.y = pack4_fp8(r[4], r[5], r[6], r[7]);
            *(u32x2*)((unsigned char*)(ws + OFF_YF8) + (size_t)row * D + j * 512 + c0) = w; }
    }
}
__device__ __forceinline__ void phase5(const Params& p, LAS unsigned char* lds) {
    char* ws = p.ws;
    { pg8::DenseSched S; S.init(L, 1024, 1024, 1024, ws + OFF_WT_OUT, gridDim.x, blockIdx.x); pg8::EpiOut E{(bf16_t*)(ws + OFF_X1), p.x, (const float*)(ws + OFF_MOD)}; pg8::gemm_phase<pg8::EpiOut, pg8::DenseSched, true, 127, 122>(lds, (const char*)(ws + OFF_YF8), 1024, S, E); }
    { LAS float* tl = (LAS float*)lds; int tctr = 0; ConvPipe<true> pp; pp.have = false;
      for (int e = 0; e < NE; ++e) conv_matrix<true>(tl, pp, p.w_gu + (size_t)e * 1024 * 2048, 2048, (unsigned char*)(ws + OFF_WT_GU) + (size_t)e * 2048 * 1024, 1024, 2048, 2, nullptr, tctr);
      for (int e = 0; e < NE; ++e) conv_matrix<true>(tl, pp, p.w_dn + (size_t)e * 1024 * 1024, 1024, (unsigned char*)(ws + OFF_WT_DN) + (size_t)e * 1024 * 1024, 1024, 1024, 0, nullptr, tctr);
      conv_finish<true>(tl, pp); }
}
__device__ __forceinline__ void phase6(const Params& p, LAS unsigned char* lds) {
    char* ws = p.ws; const float* modv = (const float*)(ws + OFF_MOD); unsigned char* h2 = (unsigned char*)(ws + OFF_H); int* topi = (int*)(ws + OFF_TOPI); float* topp = (float*)(ws + OFF_TOPP); int* cnt = (int*)(ws + OFF_CNT); int* list = (int*)(ws + OFF_LIST); int* pairpos = (int*)(ws + OFF_ROWPAIR);
    LAS float* hs = (LAS float*)lds;
    LAS float* lg = (LAS float*)(lds + 131072);
    LAS int* lcnt = (LAS int*)(lds + 131072 + 4096);
    LAS int* lent = (LAS int*)(lds + 131072 + 4096 + 512);
    const int tid = otid(), lane = tid & 63, wid = tid >> 6, c0 = lane * 8;
    if (tid < 96) lcnt[tid] = 0;
    f32x4 g[4];
#pragma unroll
    for (int q = 0; q < 4; ++q) g[q] = *(const f32x4*)(p.g_ffn + (q >> 1) * 512 + c0 + (q & 1) * 4);
    __syncthreads();
    int it = 0;
    for (int tile = blockIdx.x; tile < L / 32; tile += gridDim.x, ++it) {
        const int rbase = tile * 32;
        f32x4 v[4][4];
#pragma unroll
        for (int u = 0; u < 4; ++u)
#pragma unroll
            for (int j = 0; j < 2; ++j) { float t8[8]; unpack8(*(const u32x4*)((const bf16_t*)(ws + OFF_X1) + (size_t)(rbase + wid * 4 + u) * D + j * 512 + c0), t8); v[u][2 * j] = (f32x4){t8[0], t8[1], t8[2], t8[3]}; v[u][2 * j + 1] = (f32x4){t8[4], t8[5], t8[6], t8[7]}; }
#pragma unroll
        for (int u = 0; u < 4; ++u) { const int rl = wid * 4 + u, row = rbase + rl; const float* mod = modv + (row / SEQ) * 6144; float ss = 0.f;
#pragma unroll
            for (int q = 0; q < 4; ++q) ss += (v[u][q][0] * v[u][q][0] + v[u][q][1] * v[u][q][1]) + (v[u][q][2] * v[u][q][2] + v[u][q][3] * v[u][q][3]);
            const float rs = rsqrtf(wave_sum(ss) * (1.0f / D) + EPS);
#pragma unroll
            for (int j = 0; j < 2; ++j) { f32x4 o[2];
#pragma unroll
                for (int e = 0; e < 2; ++e) { const int cc = j * 512 + c0 + e * 4; const f32x4 sc = *(const f32x4*)(mod + 4 * 1024 + cc), sh = *(const f32x4*)(mod + 3 * 1024 + cc); o[e] = v[u][j * 2 + e] * rs * g[j * 2 + e] * (sc + 1.0f) + sh;
                    *(LAS f32x4*)(hs + rl * 1024 + cc) = o[e]; }
                u32x2 w; w.x = pack4_fp8(o[0][0], o[0][1], o[0][2], o[0][3]); w.y = pack4_fp8(o[1][0], o[1][1], o[1][2], o[1][3]);
                *(u32x2*)(h2 + (size_t)row * D + j * 512 + c0) = w; } }
        __syncthreads();
        { const int e = tid & 31, rg = tid >> 5; const LAS float* h0 = hs + (2 * rg) * 1024; const LAS float* h1 = h0 + 1024; float a0 = 0.f, a1 = 0.f;
          for (int j = 0; j < 1024; j += 8) { float w[8];
#pragma unroll
              for (int q = 0; q < 8; ++q) w[q] = p.w_r[(j + q) * 32 + e];
              const f32x4 x0 = *(const LAS f32x4*)(h0 + j), x1 = *(const LAS f32x4*)(h0 + j + 4), y0 = *(const LAS f32x4*)(h1 + j), y1 = *(const LAS f32x4*)(h1 + j + 4);
              a0 += x0[0] * w[0]; a0 += x0[1] * w[1]; a0 += x0[2] * w[2]; a0 += x0[3] * w[3]; a0 += x1[0] * w[4]; a0 += x1[1] * w[5]; a0 += x1[2] * w[6]; a0 += x1[3] * w[7];
              a1 += y0[0] * w[0]; a1 += y0[1] * w[1]; a1 += y0[2] * w[2]; a1 += y0[3] * w[3]; a1 += y1[0] * w[4]; a1 += y1[1] * w[5]; a1 += y1[2] * w[6]; a1 += y1[3] * w[7]; }
          const float be = p.b_r[e]; lg[(2 * rg) * 32 + e] = a0 + be; lg[(2 * rg + 1) * 32 + e] = a1 + be; }
        __syncthreads();
#pragma unroll
        for (int rep = 0; rep < 2; ++rep) { const int rl = wid * 4 + rep * 2 + (lane >> 5), row = rbase + rl, e = lane & 31; float cur = lg[rl * 32 + e];
            float tv0 = 0.f, sum = 0.f; int sel_i[4]; float sel_e[4];
#pragma unroll
            for (int k = 0; k < 4; ++k) { float m = cur; int mi = e;
#pragma unroll
                for (int o2 = 16; o2 > 0; o2 >>= 1) { const float om = __shfl_xor(m, o2); const int oi = __shfl_xor(mi, o2); if (om > m || (om == m && oi < mi)) { m = om; mi = oi; } }
                if (k == 0) tv0 = m; sel_i[k] = mi; sel_e[k] = __expf(m - tv0); sum += sel_e[k]; if (e == mi) cur = -3.0e38f; }
            int myk = 0; float myp = 0.f;
#pragma unroll
            for (int k = 0; k < 4; ++k) if (e == k) { myk = sel_i[k]; myp = sel_e[k] / sum; }
            if (e < 4) { const int pair = row * 4 + e; topi[pair] = myk; topp[pair] = myp; __hip_atomic_fetch_add(&lcnt[myk], 1, __ATOMIC_RELAXED, __HIP_MEMORY_SCOPE_WORKGROUP); lent[(it * 32 + rl) * 4 + e] = myk; } }
        __syncthreads();
    }
    if (tid < 32) { const int n = lcnt[tid]; lcnt[32 + tid] = n > 0 ? atomicAdd(&cnt[tid], n) : 0; lcnt[64 + tid] = 0; }
    __syncthreads();
    const int nent = it * 128;
    for (int s = tid; s < nent; s += 512) { const int e = lent[s]; const int ii = s >> 7, rl = (s >> 2) & 31, k = s & 3; const int row = (blockIdx.x + ii * gridDim.x) * 32 + rl;
        const int pos = lcnt[32 + e] + __hip_atomic_fetch_add(&lcnt[64 + e], 1, __ATOMIC_RELAXED, __HIP_MEMORY_SCOPE_WORKGROUP); list[e * CAP + pos] = row * 4 + k; pairpos[row * 4 + k] = pos; }
}
__device__ __forceinline__ void moe_table(const int* cnt, LAS int* tab) {
    if (otid() == 0) { int t = 0; for (int e = 0; e < NE; ++e) { tab[e] = t; const int n = cnt[e]; tab[64 + e] = n; t += (n + 255) >> 8; } tab[32] = t; tab[33] = t; }
    __syncthreads();
    for (int rt = otid(); rt < tab[33]; rt += 512) { int e = 0; while (tab[e + 1] <= rt) ++e; tab[128 + rt] = e; }
    __syncthreads();
}
constexpr int LDS_TAB = pg8::STAGE_BYTES;
__device__ __forceinline__ void phase7(const Params& p, LAS unsigned char* lds) {
    char* ws = p.ws; LAS int* tab = (LAS int*)(lds + LDS_TAB); moe_table((const int*)(ws + OFF_CNT), tab);
    pg8::MoeSched<true> S; S.nN = 8; S.G = gridDim.x; S.c = blockIdx.x; S.rowb = 1024; S.Wt = ws + OFF_WT_GU; S.wexp = (size_t)2048 * 1024; S.btile = (size_t)256 * 1024; S.tab = tab; S.list = (const int*)(ws + OFF_LIST);
    pg8::EpiMoe1 E{(unsigned char*)(ws + OFF_ACT), p.b_gu};
    pg8::gemm_phase<pg8::EpiMoe1, pg8::MoeSched<true>, true, 127, 122>(lds, (const char*)(ws + OFF_H), 1024, S, E);
}
__device__ __forceinline__ void phase8(const Params& p, LAS unsigned char* lds) {
    char* ws = p.ws; LAS int* tab = (LAS int*)(lds + LDS_TAB); moe_table((const int*)(ws + OFF_CNT), tab);
    pg8::MoeSched<false> S; S.nN = 4; S.G = gridDim.x; S.c = blockIdx.x; S.rowb = 1024; S.Wt = ws + OFF_WT_DN; S.wexp = (size_t)1024 * 1024; S.btile = (size_t)256 * 1024; S.tab = tab; S.list = (const int*)(ws + OFF_LIST);
    pg8::EpiMoe2 E{(bf16_t*)(ws + OFF_YP), p.b_dn};
    pg8::gemm_phase<pg8::EpiMoe2, pg8::MoeSched<false>, true, 125, 122>(lds, (const char*)(ws + OFF_ACT), 1024, S, E);
}
__device__ __forceinline__ void phase9(const Params& p, LAS unsigned char* lds) {
    char* ws = p.ws; const float* modv = (const float*)(ws + OFF_MOD); const bf16_t* yp = (const bf16_t*)(ws + OFF_YP); const float* topp = (const float*)(ws + OFF_TOPP);
    const int* topi = (const int*)(ws + OFF_TOPI); const int* pairpos = (const int*)(ws + OFF_ROWPAIR);
    LAS int* tab = (LAS int*)lds; moe_table((const int*)(ws + OFF_CNT), tab);
    const int tid = otid(), lane = tid & 63, gw = blockIdx.x * 8 + (tid >> 6), nw = gridDim.x * 8, c0 = lane * 8;
    f32x4 fg[4];
#pragma unroll
    for (int q = 0; q < 4; ++q) fg[q] = *(const f32x4*)(p.g_fin + (q >> 1) * 512 + c0 + (q & 1) * 4);
    for (int row = gw; row < L; row += nw) {
        const float* gate = modv + (row / SEQ) * 6144 + 5 * 1024; f32x4 v[4]; u32x4 yr[4][2];
        const pg8::i32x4_t ek = *(const pg8::i32x4_t*)(topi + row * 4), pk4 = *(const pg8::i32x4_t*)(pairpos + row * 4);
#pragma unroll
        for (int j = 0; j < 2; ++j) { float t8[8]; unpack8(*(const u32x4*)((const bf16_t*)(ws + OFF_X1) + (size_t)row * D + j * 512 + c0), t8); v[2 * j] = (f32x4){t8[0], t8[1], t8[2], t8[3]}; v[2 * j + 1] = (f32x4){t8[4], t8[5], t8[6], t8[7]}; }
#pragma unroll
        for (int k = 0; k < 4; ++k) { const size_t yrow = (size_t)tab[ek[k]] * 256 + pk4[k];
#pragma unroll
            for (int j = 0; j < 2; ++j) yr[k][j] = __builtin_nontemporal_load((const u32x4*)(yp + yrow * D + j * 512 + c0)); }
        const f32x4 pk = *(const f32x4*)(topp + row * 4);
        float m[16];
#pragma unroll
        for (int i = 0; i < 16; ++i) m[i] = 0.f;
#pragma unroll
        for (int k = 0; k < 4; ++k)
#pragma unroll
            for (int j = 0; j < 2; ++j) { float t[8]; unpack8(yr[k][j], t);
#pragma unroll
                for (int i = 0; i < 8; ++i) m[j * 8 + i] += pk[k] * t[i]; }
        float ss = 0.f;
#pragma unroll
        for (int q = 0; q < 4; ++q) { const f32x4 gt = *(const f32x4*)(gate + (q >> 1) * 512 + c0 + (q & 1) * 4);
#pragma unroll
            for (int i = 0; i < 4; ++i) { v[q][i] += gt[i] * m[q * 4 + i]; ss += v[q][i] * v[q][i]; } }
        const float rs = rsqrtf(wave_sum(ss) * (1.0f / D) + EPS);
#pragma unroll
        for (int q = 0; q < 4; ++q) __builtin_nontemporal_store(v[q] * rs * fg[q], (f32x4*)(p.out + (size_t)row * D + (q >> 1) * 512 + c0 + (q & 1) * 4));
    }
}

namespace at {
using s16x4  = __attribute__((ext_vector_type(4))) short;
using f32x16 = __attribute__((ext_vector_type(16))) float;
constexpr int NW = 8, QBLK = 32, KVBLK = 64, DK = 192, DV = 128;
constexpr float SCALE = 0.07216878364870322f;
constexpr float THR = 8.f;
constexpr int SHM_V = KVBLK * DV * 2, SHM_K = KVBLK * DK * 2, SHM_ATTN = 2 * SHM_V + 2 * SHM_K + NW * 64 * 4;
#define KSWZ(row, colB) ((row) * 384 + ((colB) ^ ((((row) ^ ((row) >> 3)) & 7) << 4)))
#define SBAR() __builtin_amdgcn_sched_barrier(0)
__device__ __forceinline__ int crow(int r, int hi) { return (r & 3) + 8 * (r >> 2) + 4 * hi; }
__device__ __forceinline__ unsigned cvtpk(float lo, float hi) { return cvt_pk_bf16(lo, hi); }

__device__ __forceinline__ void partialSM(f32x16& p0, f32x16& p1, float& m_reg, float& mn, float& alpha) {
  constexpr float C = SCALE * 1.4426950408889634f;
  float pmax = p0[0];
#pragma unroll
  for (int r = 1; r < 16; ++r) pmax = fmaxf(pmax, p0[r]);
#pragma unroll
  for (int r = 0; r < 16; ++r) pmax = fmaxf(pmax, p1[r]);
  { auto rr = __builtin_amdgcn_permlane32_swap(__float_as_uint(pmax), __float_as_uint(pmax), false, false);
    pmax = fmaxf(__uint_as_float(rr[0]), __uint_as_float(rr[1])); }
  if (__builtin_expect(__all(pmax - m_reg <= THR / SCALE), 1)) { mn = m_reg; alpha = 1.f; }
  else { mn = fmaxf(m_reg, pmax); alpha = __builtin_amdgcn_exp2f((m_reg - mn) * C); m_reg = mn; }
  float mnC = -mn * C;
#pragma unroll
  for (int r = 0; r < 16; ++r) p0[r] = fmaf(p0[r], C, mnC);
#pragma unroll
  for (int r = 0; r < 16; ++r) p1[r] = fmaf(p1[r], C, mnC);
#pragma unroll
  for (int r = 0; r < 16; ++r) p0[r] = __builtin_amdgcn_exp2f(p0[r]);
}
__device__ __forceinline__ void finishSM(f32x16& p0, f32x16& p1, float alpha, float& l_reg, bf16x8& pa0, bf16x8& pa1, bf16x8& pa2, bf16x8& pa3) {
#pragma unroll
  for (int r = 0; r < 16; ++r) p1[r] = __builtin_amdgcn_exp2f(p1[r]);
  float ps = 0;
#pragma unroll
  for (int r = 0; r < 16; ++r) ps += p0[r];
#pragma unroll
  for (int r = 0; r < 16; ++r) ps += p1[r];
  { auto rr = __builtin_amdgcn_permlane32_swap(__float_as_uint(ps), __float_as_uint(ps), false, false);
    ps = __uint_as_float(rr[0]) + __uint_as_float(rr[1]); }
  l_reg = l_reg * alpha + ps;
#define PK4(P, BASE, OUT) do { unsigned a0 = cvtpk(P[BASE + 0], P[BASE + 1]), a1 = cvtpk(P[BASE + 2], P[BASE + 3]);   \
    unsigned b0 = cvtpk(P[BASE + 4], P[BASE + 5]), b1 = cvtpk(P[BASE + 6], P[BASE + 7]);                              \
    auto r0 = __builtin_amdgcn_permlane32_swap(a0, b0, false, false); auto r1 = __builtin_amdgcn_permlane32_swap(a1, b1, false, false); \
    u32x4 w = {r0[0], r1[0], r0[1], r1[1]}; OUT = *reinterpret_cast<bf16x8*>(&w); } while (0)
  PK4(p0, 0, pa0); PK4(p0, 8, pa1); PK4(p1, 0, pa2); PK4(p1, 8, pa3);
#undef PK4
}
__device__ __forceinline__ void qkt(f32x16& p0, f32x16& p1, const LAS char* Ks, const bf16x8 (&qr)[12], int r32, int hi) {
  p0 = f32x16{}; p1 = f32x16{};
#pragma unroll
  for (int d0 = 0; d0 < 12; ++d0) { const int cb = (d0 * 16 + hi * 8) * 2;
    const bf16x8 b0 = *reinterpret_cast<const LAS bf16x8*>(Ks + KSWZ(r32, cb));
    const bf16x8 b1 = *reinterpret_cast<const LAS bf16x8*>(Ks + KSWZ(32 + r32, cb));
    p0 = __builtin_amdgcn_mfma_f32_32x32x16_bf16(b0, qr[d0], p0, 0, 0, 0);
    p1 = __builtin_amdgcn_mfma_f32_32x32x16_bf16(b1, qr[d0], p1, 0, 0, 0); }
}
__device__ __forceinline__ int v_st(int k, int c) { const int kk = (k & ~0xC) | ((k & 4) << 1) | ((k & 8) >> 1); return ((kk >> 3) * 4 + (c >> 5)) * 512 + ((kk & 7) * 32 + (c & 31)) * 2; }
__device__ __forceinline__ int v_rd_base(int lane) { return ((lane & 3) << 3) | (((lane >> 2) & 3) << 6) | (((lane >> 4) & 1) << 5) | (((lane >> 5) & 1) << 8); }
constexpr int v_rd_off(int d0, int ks, int half) { return d0 * 512 + ks * 4096 + half * 2048; }
template <int OFF> __device__ __forceinline__ s16x4 tr_read(int vb) { s16x4 r; asm volatile("ds_read_b64_tr_b16 %0, %1 offset:%2" : "=&v"(r) : "v"(vb), "i"(OFF) : "memory"); return r; }
template <int D0> __device__ __forceinline__ void pv_one(f32x16& od, int vb, bf16x8 pa0, bf16x8 pa1, bf16x8 pa2, bf16x8 pa3) {
  const s16x4 l0 = tr_read<v_rd_off(D0, 0, 0)>(vb), h0 = tr_read<v_rd_off(D0, 0, 1)>(vb), l1 = tr_read<v_rd_off(D0, 1, 0)>(vb), h1 = tr_read<v_rd_off(D0, 1, 1)>(vb);
  const s16x4 l2 = tr_read<v_rd_off(D0, 2, 0)>(vb), h2 = tr_read<v_rd_off(D0, 2, 1)>(vb), l3 = tr_read<v_rd_off(D0, 3, 0)>(vb), h3 = tr_read<v_rd_off(D0, 3, 1)>(vb);
  asm volatile("s_waitcnt lgkmcnt(0)" ::: "memory"); SBAR();
#define PK(Lo, Hi) (bf16x8){Lo[0], Lo[1], Lo[2], Lo[3], Hi[0], Hi[1], Hi[2], Hi[3]}
  od = __builtin_amdgcn_mfma_f32_32x32x16_bf16(pa0, PK(l0, h0), od, 0, 0, 0);
  od = __builtin_amdgcn_mfma_f32_32x32x16_bf16(pa1, PK(l1, h1), od, 0, 0, 0);
  od = __builtin_amdgcn_mfma_f32_32x32x16_bf16(pa2, PK(l2, h2), od, 0, 0, 0);
  od = __builtin_amdgcn_mfma_f32_32x32x16_bf16(pa3, PK(l3, h3), od, 0, 0, 0);
#undef PK
}
__device__ __forceinline__ void pv_d0(f32x16 (&o)[4], int vb, bf16x8 pa0, bf16x8 pa1, bf16x8 pa2, bf16x8 pa3) {
  pv_one<0>(o[0], vb, pa0, pa1, pa2, pa3); pv_one<1>(o[1], vb, pa0, pa1, pa2, pa3); pv_one<2>(o[2], vb, pa0, pa1, pa2, pa3); pv_one<3>(o[3], vb, pa0, pa1, pa2, pa3);
}

__device__ __forceinline__ void attn_unit(const bf16_t* __restrict__ Qb, const bf16_t* __restrict__ Kh, const bf16_t* __restrict__ Vh, bf16_t* __restrict__ Ob, int t0, const float* __restrict__ ropet, LAS char* lds) {
  constexpr int LDQ = 1536, LDO = 1024, NT = NKEY / KVBLK;
  const int tid = otid(), wid = tid >> 6, lane = tid & 63, r32 = lane & 31, hi = lane >> 5;
  LAS char* V_lds = lds; LAS char* K_lds = lds + 2 * SHM_V;
  LAS float* wsl = (LAS float*)(lds + 2 * SHM_V + 2 * SHM_K) + wid * 64; LAS float* li_l = wsl; LAS float* al_l = wsl + 32;
  float m_reg = -1e30f, l_reg = 0; f32x16 o[4] = {}; bf16x8 qr[12];
  { const bf16_t* Qw = Qb + (size_t)(wid * QBLK + r32) * LDQ + hi * 8;
#pragma unroll
    for (int d0 = 0; d0 < 12; ++d0) qr[d0] = *reinterpret_cast<const bf16x8*>(Qw + d0 * 16);
    const float* rt = ropet + (size_t)(t0 + wid * QBLK + r32) * 64 + 8 * hi;
#pragma unroll
    for (int g = 0; g < 2; ++g) {
      const f32x4 c0 = *(const f32x4*)(rt + 16 * g), c1 = *(const f32x4*)(rt + 16 * g + 4), s0 = *(const f32x4*)(rt + 32 + 16 * g), s1 = *(const f32x4*)(rt + 32 + 16 * g + 4);
      float n1[8], n2[8];
#pragma unroll
      for (int j = 0; j < 8; ++j) { const float cs = j < 4 ? c0[j & 3] : c1[j & 3], sn = j < 4 ? s0[j & 3] : s1[j & 3];
        const float x1 = bf2f((bf16_t)qr[8 + g][j]), x2 = bf2f((bf16_t)qr[10 + g][j]); n1[j] = x1 * cs - x2 * sn; n2[j] = x1 * sn + x2 * cs; }
      u32x4 w1 = {cvtpk(n1[0], n1[1]), cvtpk(n1[2], n1[3]), cvtpk(n1[4], n1[5]), cvtpk(n1[6], n1[7])}; u32x4 w2 = {cvtpk(n2[0], n2[1]), cvtpk(n2[2], n2[3]), cvtpk(n2[4], n2[5]), cvtpk(n2[6], n2[7])};
      qr[8 + g] = *reinterpret_cast<bf16x8*>(&w1); qr[10 + g] = *reinterpret_cast<bf16x8*>(&w2); } }
  const int sr = tid >> 4, sc = (tid & 15) * 8, vst0 = v_st(sr, sc), vst1 = v_st(32 + sr, sc);
  int kgo[3], kst[3];
#pragma unroll
  for (int i = 0; i < 3; ++i) { const int c = tid + 512 * i, row = c / 24, c8 = (c % 24) * 8; kgo[i] = row * DK + c8; kst[i] = KSWZ(row, c8 * 2); }
  const int vb0 = (int)(uintptr_t)V_lds + v_rd_base(lane);
  bf16x8 sv0, sv1, sk0, sk1, sk2;
#define SLOAD(k0) do { sv0 = *reinterpret_cast<const bf16x8*>(&Vh[(size_t)((k0) + sr) * DV + sc]); sv1 = *reinterpret_cast<const bf16x8*>(&Vh[(size_t)((k0) + 32 + sr) * DV + sc]); \
    sk0 = *reinterpret_cast<const bf16x8*>(&Kh[(size_t)(k0) * DK + kgo[0]]); sk1 = *reinterpret_cast<const bf16x8*>(&Kh[(size_t)(k0) * DK + kgo[1]]); sk2 = *reinterpret_cast<const bf16x8*>(&Kh[(size_t)(k0) * DK + kgo[2]]); } while (0)
#define SWRITE(b) do { *(LAS bf16x8*)(V_lds + (b) * SHM_V + vst0) = sv0; *(LAS bf16x8*)(V_lds + (b) * SHM_V + vst1) = sv1; \
    *(LAS bf16x8*)(K_lds + (b) * SHM_K + kst[0]) = sk0; *(LAS bf16x8*)(K_lds + (b) * SHM_K + kst[1]) = sk1; *(LAS bf16x8*)(K_lds + (b) * SHM_K + kst[2]) = sk2; } while (0)
#define RESC(a) do { if (__any((a) < 1.f)) { if (hi == 0) al_l[r32] = (a); asm volatile("s_waitcnt lgkmcnt(0)" ::: "memory"); \
    _Pragma("unroll") for (int d = 0; d < 4; ++d) _Pragma("unroll") for (int r = 0; r < 16; ++r) o[d][r] *= al_l[crow(r, hi)]; } } while (0)
  f32x16 p0, p1; float mn, al; bf16x8 pa0, pa1, pa2, pa3;
  SLOAD(0); asm volatile("s_waitcnt vmcnt(0)" ::: "memory"); SWRITE(0); __syncthreads();
  for (int j = 0; j < NT; ++j) {
    const int bsel = j & 1;
    if (j + 1 < NT) SLOAD((j + 1) * KVBLK);
    SBAR(); qkt(p0, p1, K_lds + bsel * SHM_K, qr, r32, hi);
    partialSM(p0, p1, m_reg, mn, al);
    RESC(al);
    finishSM(p0, p1, al, l_reg, pa0, pa1, pa2, pa3); SBAR();
    pv_d0(o, vb0 + bsel * SHM_V, pa0, pa1, pa2, pa3);
    if (j + 1 < NT) { asm volatile("s_waitcnt vmcnt(0)" ::: "memory"); SWRITE(bsel ^ 1); }
    __syncthreads();
  }
  if (hi == 0) li_l[r32] = l_reg; asm volatile("s_waitcnt lgkmcnt(0)" ::: "memory");
  float rli[16];
#pragma unroll
  for (int r = 0; r < 16; ++r) rli[r] = __builtin_amdgcn_rcpf(li_l[crow(r, hi)]);
  { LAS bf16_t* ot = (LAS bf16_t*)(lds + wid * 8192);
#pragma unroll
    for (int r = 0; r < 16; ++r) { const int orow = crow(r, hi);
#pragma unroll
      for (int d0 = 0; d0 < 4; ++d0) ot[orow * 128 + d0 * 32 + r32] = f2bf(o[d0][r] * rli[r]); }
    asm volatile("s_waitcnt lgkmcnt(0)" ::: "memory");
    bf16_t* Ow = Ob + (size_t)(wid * QBLK) * LDO;
#pragma unroll
    for (int i = 0; i < 8; ++i) { const int q = lane + 64 * i, row = q >> 4, ch = q & 15; const u32x4 w = *(const LAS u32x4*)(ot + row * 128 + ch * 8); *(u32x4*)(Ow + (size_t)row * LDO + ch * 8) = w; } }
#undef SLOAD
#undef SWRITE
#undef RESC
}
}

__device__ __forceinline__ void phase_attn(const Params& p, LAS unsigned char* lds) {
    char* ws = p.ws; const bf16_t* Q = (const bf16_t*)(ws + OFF_Q); const bf16_t* Kb = (const bf16_t*)(ws + OFF_K); const bf16_t* Vb = (const bf16_t*)(ws + OFF_V); bf16_t* Y = (bf16_t*)(ws + OFF_H);
    const int G = gridDim.x;
    for (int it = 0;; ++it) {
        int u;
        if (G == 256) { const int c = blockIdx.x, xcd = c & 7, j = c >> 3; if (it >= 4) break; u = ((it * 32 + xcd * 4 + (j >> 3)) << 3) | (j & 7); }
        else { u = it * G + blockIdx.x; if (u >= 1024) break; }
        const int bh = u >> 3, qb = u & 7, b = bh >> 3, h = bh & 7;
        at::attn_unit(Q + ((size_t)(b * SEQ + qb * 256)) * 1536 + h * 192, Kb + (size_t)bh * NKEY * 192, Vb + (size_t)bh * NKEY * 128, Y + ((size_t)(b * SEQ + qb * 256)) * D + h * 128, qb * 256, (const float*)(ws + OFF_ROPE), (LAS char*)lds);
        __syncthreads();
    }
}

namespace sc {
using f32x16 = __attribute__((ext_vector_type(16))) float;
constexpr int BUFB = 53248, O_QT = 0, O_KH = 16384, O_VT = 32768, O_AT = 49152, O_DEC = 51200, O_KD = 2 * BUFB, LDS_SCAN = 2 * BUFB + 16384;
__device__ __forceinline__ int sw256(int row, int cb) { return row * 256 + (cb ^ ((row & 15) << 4)); }
__device__ __forceinline__ int sw128(int row, int cb) { return row * 128 + (cb ^ (((row >> 1) & 7) << 4)); }
__device__ __forceinline__ int grow_of(int n, int b, int dir) { if (n < CTXL) { const int s = dir ? (CTXL - 1 - n) : n; return L + b * CTXL + s; } const int m = n - CTXL; return b * SEQ + (dir ? (SEQ - 1 - m) : m); }
__device__ __forceinline__ bf16x8 pack_acc8(const f32x16& x, int s) { u32x4 p; p.x = cvt_pk_bf16(x[8 * s], x[8 * s + 1]); p.y = cvt_pk_bf16(x[8 * s + 2], x[8 * s + 3]); p.z = cvt_pk_bf16(x[8 * s + 4], x[8 * s + 5]); p.w = cvt_pk_bf16(x[8 * s + 6], x[8 * s + 7]); return __builtin_bit_cast(bf16x8, p); }

__device__ __forceinline__ void scan_unit(const Params& p, int unit, LAS unsigned char* lds) {
    char* ws = p.ws; const int dir = unit & 1, h = (unit >> 1) & 7, b = unit >> 4;
    const bf16_t* hq = (const bf16_t*)(ws + OFF_HQ); const bf16_t* fz = (const bf16_t*)(ws + (dir ? OFF_FB : OFF_FF)); const bf16_t* iv = (const bf16_t*)(ws + OFF_IV);
    bf16_t* outp = (bf16_t*)(ws + (dir ? OFF_OB : OFF_OF)); const float* lb = (const float*)(ws + OFF_LB);
    const int tid = otid(), wid = __builtin_amdgcn_readfirstlane(tid >> 6), lane = tid & 63, r32 = lane & 31, hi = lane >> 5;
    const int sgn = dir ? -1 : 1; const long rstep = (long)sgn * D;
    __syncthreads();
    if (wid >= 4) {
        const int I = wid - 4, cp = lane, hc = h * 128 + 2 * cp;
        const float lbv0 = lb[dir * 1024 + hc], lbv1 = lb[dir * 1024 + hc + 1];
        unsigned zr[16], vr[16], qr[16];
#define SC_LOAD(c) do { const size_t o0_ = (size_t)(grow_of((c) * 64, b, dir) + sgn * (16 * I)) * D + hc; const bf16_t* pz_ = fz + o0_; const bf16_t* pv_ = iv + o0_; const bf16_t* pq_ = hq + o0_; \
        _Pragma("unroll") for (int i = 0; i < 16; ++i) { zr[i] = *(const unsigned*)pz_; pz_ += rstep; vr[i] = *(const unsigned*)pv_; pv_ += rstep; if ((c) >= 4) { qr[i] = *(const unsigned*)pq_; pq_ += rstep; } } } while (0)
        SC_LOAD(0);
        for (int it = 0; it <= 36; ++it) {
            if (it < 36) {
                const int c = it; const bool lat = c >= 4; LAS unsigned char* B = lds + (c & 1) * BUFB; LAS unsigned char* KD = lds + O_KD;
                float kk0[16], kk1[16], lc0[16], lc1[16]; float run0 = 0.f, run1 = 0.f;
#pragma unroll
                for (int i = 0; i < 16; ++i) { const float z0 = __uint_as_float(zr[i] << 16), z1 = __uint_as_float(zr[i] & 0xffff0000u);
                    const float f0 = lbv0 + (1.0f - lbv0) * sigmoidf_(z0), f1 = lbv1 + (1.0f - lbv1) * sigmoidf_(z1); kk0[i] = 1.0f - f0; kk1[i] = 1.0f - f1;
                    run0 += __builtin_amdgcn_logf(f0) * 0.6931471805599453f; run1 += __builtin_amdgcn_logf(f1) * 0.6931471805599453f; lc0[i] = run0; lc1[i] = run1; }
                *(LAS f32x2*)(B + O_DEC + (I * 128 + 2 * cp) * 4) = (f32x2){__expf(run0), __expf(run1)};
                unsigned kh0[8], kh1[8], vt0[8], vt1[8];
#pragma unroll
                for (int i = 0; i < 16; ++i) { const int t = 16 * I + i; const float l0 = lc0[i], l1 = lc1[i];
                    const float kd0 = kk0[i] * __expf(fminf(-l0, 80.0f)), kd1 = kk1[i] * __expf(fminf(-l1, 80.0f));
                    const float kf0 = kk0[i] * __expf(run0 - l0), kf1 = kk1[i] * __expf(run1 - l1);
                    if (lat) { const float q0 = __uint_as_float(qr[i] << 16), q1 = __uint_as_float(qr[i] & 0xffff0000u);
                        *(LAS unsigned*)(B + O_QT + sw256(t, 4 * cp)) = cvt_pk_bf16(q0 * __expf(l0), q1 * __expf(l1)); *(LAS unsigned*)(KD + sw256(t, 4 * cp)) = cvt_pk_bf16(kd0, kd1); }
                    if (i & 1) { kh0[i >> 1] = cvt_pk_bf16(__uint_as_float(kh0[i >> 1]), kf0); kh1[i >> 1] = cvt_pk_bf16(__uint_as_float(kh1[i >> 1]), kf1); vt0[i >> 1] = (vt0[i >> 1] >> 16) | (vr[i] << 16); vt1[i >> 1] = (vt1[i >> 1] >> 16) | (vr[i] & 0xffff0000u); }
                    else { kh0[i >> 1] = __float_as_uint(kf0); kh1[i >> 1] = __float_as_uint(kf1); vt0[i >> 1] = vr[i] << 16; vt1[i >> 1] = vr[i] & 0xffff0000u; } }
#pragma unroll
                for (int q = 0; q < 2; ++q) {
                    *(LAS u32x4*)(B + O_KH + sw128(2 * cp, 32 * I + 16 * q)) = (u32x4){kh0[4 * q], kh0[4 * q + 1], kh0[4 * q + 2], kh0[4 * q + 3]}; *(LAS u32x4*)(B + O_KH + sw128(2 * cp + 1, 32 * I + 16 * q)) = (u32x4){kh1[4 * q], kh1[4 * q + 1], kh1[4 * q + 2], kh1[4 * q + 3]};
                    *(LAS u32x4*)(B + O_VT + sw128(2 * cp, 32 * I + 16 * q)) = (u32x4){vt0[4 * q], vt0[4 * q + 1], vt0[4 * q + 2], vt0[4 * q + 3]}; *(LAS u32x4*)(B + O_VT + sw128(2 * cp + 1, 32 * I + 16 * q)) = (u32x4){vt1[4 * q], vt1[4 * q + 1], vt1[4 * q + 2], vt1[4 * q + 3]}; }
                if (it + 1 < 36) SC_LOAD(it + 1);
                if (lat) {
                    const int l15 = lane & 15, lq = lane >> 4; f32x4 a = {0.f, 0.f, 0.f, 0.f};
#pragma unroll
                    for (int ks = 0; ks < 4; ++ks) { const bf16x8 av = *(const LAS bf16x8*)(B + O_QT + sw256(16 * I + l15, (32 * ks + 8 * lq) * 2)); const bf16x8 bv = *(const LAS bf16x8*)(KD + sw256(16 * I + l15, (32 * ks + 8 * lq) * 2));
                        a = __builtin_amdgcn_mfma_f32_16x16x32_bf16(av, bv, a, 0, 0, 0); }
#pragma unroll
                    for (int r = 0; r < 4; ++r) { const int tl = 4 * lq + r; float v = a[r]; if (l15 > tl) v = 0.f; *(LAS bf16_t*)(B + O_AT + ((I * 16 + tl) * 16 + l15) * 2) = f2bf(v); }
                }
            }
            __syncthreads();
        }
#undef SC_LOAD
    } else {
        const int bq = wid; f32x16 S[4];
#pragma unroll
        for (int a = 0; a < 4; ++a) S[a] = f32x16{};
        for (int it = 0; it <= 36; ++it) {
            if (it >= 1) {
                const int c = it - 1; const bool lat = c >= 4; LAS unsigned char* B = lds + (c & 1) * BUFB;
                bf16_t* po = outp + (size_t)(grow_of(c * 64, b, dir) + sgn * (4 * hi)) * D + h * 128 + 32 * bq + r32;
#pragma unroll
                for (int I = 0; I < 4; ++I) {
                    const bf16x8 vtf = *(const LAS bf16x8*)(B + O_VT + sw128(32 * bq + r32, (16 * I + 8 * hi) * 2));
                    if (lat) {
                        f32x16 o = f32x16{};
#pragma unroll
                        for (int a = 0; a < 4; ++a)
#pragma unroll
                            for (int s = 0; s < 2; ++s) { const int dk0 = 32 * a + 16 * s + 4 * hi; const int row = 16 * I + (r32 & 15);
                                const u32x2 lo2 = *(const LAS u32x2*)(B + O_QT + sw256(row, dk0 * 2)), hi2 = *(const LAS u32x2*)(B + O_QT + sw256(row, (dk0 + 8) * 2));
                                const u32x4 av = {lo2.x, lo2.y, hi2.x, hi2.y};
                                o = __builtin_amdgcn_mfma_f32_32x32x16_bf16(__builtin_bit_cast(bf16x8, av), pack_acc8(S[a], s), o, 0, 0, 0); }
                        { const bf16x8 af = *(const LAS bf16x8*)(B + O_AT + ((I * 16 + (r32 & 15)) * 16 + 8 * hi) * 2); o = __builtin_amdgcn_mfma_f32_32x32x16_bf16(af, vtf, o, 0, 0, 0); }
#pragma unroll
                        for (int r = 0; r < 8; ++r) po[(long)(16 * I + (r & 3) + 8 * (r >> 2)) * rstep] = f2bf(o[r]);
                    }
#pragma unroll
                    for (int a = 0; a < 4; ++a) {
#pragma unroll
                        for (int g = 0; g < 4; ++g) { const f32x4 dc = *(const LAS f32x4*)(B + O_DEC + (I * 128 + 32 * a + 8 * g + 4 * hi) * 4); S[a][4 * g] *= dc[0]; S[a][4 * g + 1] *= dc[1]; S[a][4 * g + 2] *= dc[2]; S[a][4 * g + 3] *= dc[3]; }
                        const bf16x8 kf = *(const LAS bf16x8*)(B + O_KH + sw128(32 * a + r32, (16 * I + 8 * hi) * 2));
                        S[a] = __builtin_amdgcn_mfma_f32_32x32x16_bf16(kf, vtf, S[a], 0, 0, 0); }
                }
            }
            __syncthreads();
        }
    }
    __syncthreads();
}
}
__device__ __forceinline__ void phase_scan(const Params& p, LAS unsigned char* lds) {
    for (int u = blockIdx.x; u < 256; u += gridDim.x) sc::scan_unit(p, u, lds);
}

constexpr int LDS_BYTES = 155648;
#include <cstdint>
#include <cstdlib>
#include <vector>

#define XB_TMO      128
#define XB_XCNT(j)  (256  + 64 * (j))
#define XB_XSUB(j)  (1280 + 64 * (j))
#define XB_XGEN(j)  (2304 + 64 * (j))
#define XB_TOP      3328
#define XB_TOPGEN   3392
#define XCD_BAR_WORDS 3456
#define XB_SPIN_CAP (1u << 18)

__device__ __forceinline__ unsigned xb_ld(unsigned* p)              { return __hip_atomic_load(p, __ATOMIC_RELAXED, __HIP_MEMORY_SCOPE_AGENT); }
__device__ __forceinline__ unsigned xb_add(unsigned* p, unsigned v) { return __hip_atomic_fetch_add(p, v, __ATOMIC_RELAXED, __HIP_MEMORY_SCOPE_AGENT); }
__device__ __forceinline__ unsigned xb_xcc_id() { return (unsigned)__builtin_amdgcn_s_getreg((3 << 11) | 20) & 0xFu; }
#define XB_SPIN(cond, bar) do { unsigned _sp = 0; while (cond) { __builtin_amdgcn_s_sleep(1); \
    if ((++_sp & 255u) == 0u) { if (xb_ld(&(bar)[XB_TMO])) break; if (_sp > XB_SPIN_CAP) { atomicAdd(&(bar)[XB_TMO], 1u); break; } } } } while (0)

struct XcdBarrier {
    unsigned* bar; unsigned x;
    volatile LAS unsigned* st;
};

__device__ __forceinline__ XcdBarrier xcd_barrier_post(unsigned* bar, volatile LAS unsigned* st) {
    XcdBarrier b; b.bar = bar; b.x = xb_xcc_id(); b.st = st;
    if (threadIdx.x == 0) (void)xb_add(&bar[XB_XCNT(b.x)], 1u);
    return b;
}
__device__ __forceinline__ void xcd_barrier_complete(unsigned* bar, unsigned x, unsigned& nloc, unsigned& nx) {
    const unsigned G = gridDim.x * gridDim.y * gridDim.z;
    unsigned sum, cnt, mine, sp = 0u;
    for (;;) {
        sum = 0u; cnt = 0u; mine = 0u;
#pragma unroll
        for (unsigned j = 0; j < 16; ++j) { const unsigned c = xb_ld(&bar[XB_XCNT(j)]); sum += c; cnt += (c > 0u) ? 1u : 0u; mine = (j == x) ? c : mine; }
        if (sum == G) break;
        __builtin_amdgcn_s_sleep(1);
        if ((++sp & 255u) == 0u) { if (xb_ld(&bar[XB_TMO])) break; if (sp > XB_SPIN_CAP) { atomicAdd(&bar[XB_TMO], 1u); break; } }
    }
    nloc = mine > 0u ? mine : 1u; nx = cnt > 0u ? cnt : 1u;
}

__device__ __forceinline__ void xcd_barrier(const XcdBarrier& b) {
    asm volatile("s_waitcnt vmcnt(0)" ::: "memory");
    __syncthreads();
    if (threadIdx.x == 0) {
        unsigned* bar = b.bar;
        __builtin_amdgcn_s_waitcnt(0);
        unsigned nloc = b.st[0], nx = b.st[1];
        if (nloc == 0u) { xcd_barrier_complete(bar, b.x, nloc, nx); b.st[0] = nloc; b.st[1] = nx; }
        const unsigned old = xb_add(&bar[XB_XSUB(b.x)], 1u);
        const unsigned gen = old / nloc;
        if (old + 1u == (gen + 1u) * nloc) {
            __builtin_amdgcn_fence(__ATOMIC_RELEASE, "agent");
            asm volatile("s_waitcnt vmcnt(0)" ::: "memory");
            const unsigned og = xb_add(&bar[XB_TOP], 1u);
            const unsigned tg = og / nx;
            if (og + 1u == (tg + 1u) * nx) xb_add(&bar[XB_TOPGEN], 1u);
            else XB_SPIN(xb_ld(&bar[XB_TOPGEN]) == tg, bar);
            __builtin_amdgcn_fence(__ATOMIC_ACQUIRE, "agent");
            xb_add(&bar[XB_XGEN(b.x)], 1u);
            asm volatile("s_waitcnt vmcnt(0)" ::: "memory");
        } else {
            XB_SPIN(xb_ld(&bar[XB_XGEN(b.x)]) == gen, bar);
            __builtin_amdgcn_fence(__ATOMIC_ACQUIRE, "agent");
            asm volatile("s_waitcnt vmcnt(0)" ::: "memory");
        }
    }
    __syncthreads();
}

__global__ void __launch_bounds__(512, 2) k_mega(Params p) {
    extern __shared__ __attribute__((aligned(16))) unsigned char smem[];
    LAS unsigned char* lds = (LAS unsigned char*)smem;
    volatile LAS unsigned* xbw = (volatile LAS unsigned*)(lds + LDS_BYTES - 16);
    if (threadIdx.x == 0) { xbw[0] = 0u; xbw[1] = 0u; xbw[2] = 0u; xbw[3] = 0u; }
    __syncthreads();
    XcdBarrier bar = xcd_barrier_post((unsigned*)(p.ws + OFF_BAR), xbw);
    phase0(p, lds);      xcd_barrier(bar);
    phase1(p, lds);      xcd_barrier(bar);
    phase2(p, lds);      xcd_barrier(bar);
    phase3(p, lds);      xcd_barrier(bar);
    phase_attn(p, lds);
    phase_scan(p, lds);  xcd_barrier(bar);
    phase4(p, lds);      xcd_barrier(bar);
    phase5(p, lds);      xcd_barrier(bar);
    phase6(p, lds);      xcd_barrier(bar);
    phase7(p, lds);      xcd_barrier(bar);
    phase8(p, lds);      xcd_barrier(bar);
    phase9(p, lds);
}
extern "C" void kernel_launch(void* const* d_in, const int* in_sizes, int n_in, void* d_out, int out_size, void* d_ws, size_t ws_size, hipStream_t stream) {
    static int grid = 0;
    if (grid == 0) {
        int dev = 0, cus = 0, per_cu = 0;
        if (hipGetDevice(&dev) != hipSuccess || hipDeviceGetAttribute(&cus, hipDeviceAttributeMultiprocessorCount, dev) != hipSuccess) { grid = -1; return; }
        if (hipFuncSetAttribute((const void*)k_mega, hipFuncAttributeMaxDynamicSharedMemorySize, LDS_BYTES) != hipSuccess) { grid = -1; return; }
        (void)hipOccupancyMaxActiveBlocksPerMultiprocessor(&per_cu, (const void*)k_mega, 512, LDS_BYTES);
        (void)hipGetLastError();
        grid = cus;
    }
    if (grid < 0) return;
    Params p{};
    p.x = (const float*)d_in[0]; p.c = (const float*)d_in[1]; p.ctx = (const float*)d_in[2]; p.cctx = (const float*)d_in[3]; p.w_mod = (const float*)d_in[4]; p.b_mod = (const float*)d_in[5];
    p.g_mix = (const float*)d_in[6]; p.w_in = (const float*)d_in[7]; p.g_q = (const float*)d_in[8]; p.w_qb = (const float*)d_in[9]; p.g_kv = (const float*)d_in[10]; p.w_kvb = (const float*)d_in[11];
    p.lbl = (const float*)d_in[12]; p.g_hg = (const float*)d_in[13]; p.w_out = (const float*)d_in[14]; p.g_ffn = (const float*)d_in[15]; p.w_r = (const float*)d_in[16]; p.b_r = (const float*)d_in[17];
    p.w_gu = (const float*)d_in[18]; p.b_gu = (const float*)d_in[19]; p.w_dn = (const float*)d_in[20]; p.b_dn = (const float*)d_in[21]; p.g_fin = (const float*)d_in[22];
    p.out = (float*)d_out; p.ws = (char*)d_ws;
    (void)hipMemsetAsync((char*)d_ws + OFF_BAR, 0, 16384, stream);
    hipLaunchKernelGGL(k_mega, dim3(grid), dim3(512), LDS_BYTES, stream, p);
}
```

```cpp
#include <hip/hip_runtime.h>
#include <stdint.h>

typedef unsigned short bf16_t;
__device__ __forceinline__ float bf2f(bf16_t v) { return __uint_as_float(((unsigned)v) << 16); }
__device__ __forceinline__ bf16_t f2bf(float f) { unsigned u = __float_as_uint(f); u += 0x7FFFu + ((u >> 16) & 1u); return (bf16_t)(u >> 16); }
__device__ __forceinline__ float sigmoidf_(float x) { return __builtin_amdgcn_rcpf(1.0f + __builtin_amdgcn_exp2f(-1.4426950408889634f * x)); }
__device__ __forceinline__ float siluf_(float x) { return x * __builtin_amdgcn_rcpf(1.0f + __builtin_amdgcn_exp2f(-1.4426950408889634f * x)); }

constexpr int D = 1024, NB = 16, SEQ = 2048, CTXL = 256;
constexpr int L = NB * SEQ;
constexpr int RC = NB * CTXL;
constexpr int R = L + RC;
constexpr int NKEY = SEQ + CTXL;
constexpr float EPS = 1e-6f;
constexpr int NE = 32, CAP = 32768;
constexpr int MAXROWS = 131072 + NE * 256;

constexpr size_t MiB = 1048576;
constexpr size_t OFF_SMALL = 0;
constexpr size_t OFF_BAR = 0;
constexpr size_t OFF_CNT = 16384;
constexpr size_t OFF_OFFS = 16384 + 1024;
constexpr size_t OFF_TILEE = 16384 + 2048;
constexpr size_t OFF_LB = 24576;
constexpr size_t OFF_MOD = 32768;
constexpr size_t OFF_SSQQ = 512 * 1024;
constexpr size_t OFF_SSQKV = 768 * 1024;
constexpr size_t OFF_TOPI = 1 * MiB;
constexpr size_t OFF_TOPP = 1 * MiB + 512 * 1024;
constexpr size_t OFF_ROWPAIR = 2 * MiB;
constexpr size_t OFF_LIST = 3 * MiB;
constexpr size_t OFF_H = 32 * MiB;
constexpr size_t OFF_QA = 104 * MiB;
constexpr size_t OFF_CKV = 152 * MiB;
constexpr size_t OFF_KR = 170 * MiB;
constexpr size_t OFF_OF = 104 * MiB;
constexpr size_t OFF_HQ = 175 * MiB;
constexpr size_t SEG_STRIDE = 72 * MiB;
constexpr size_t OFF_FF = OFF_HQ + 1 * SEG_STRIDE;
constexpr size_t OFF_FB = OFF_HQ + 2 * SEG_STRIDE;
constexpr size_t OFF_IV = OFF_HQ + 3 * SEG_STRIDE;
constexpr size_t OFF_OG = OFF_HQ + 4 * SEG_STRIDE;
constexpr size_t OFF_GM = OFF_HQ + 5 * SEG_STRIDE;
constexpr size_t OFF_GH = OFF_HQ + 6 * SEG_STRIDE;
constexpr size_t OFF_Q = 679 * MiB;
constexpr size_t OFF_K = 775 * MiB;
constexpr size_t OFF_V = 883 * MiB;
constexpr size_t OFF_OB = 955 * MiB;
constexpr size_t OFF_YP = 296 * MiB;
constexpr size_t OFF_ACT = 568 * MiB;


__device__ __forceinline__ void rope_cs(int t, int i, float& cs, float& sn) {
    int j = i & 15; float inv = __expf(-(float)j * (9.210340371976184f / 16.0f)); float pos = (i < 16) ? (float)(t >> 6) : (float)(t & 63);
    float ang = pos * inv; cs = cosf(ang); sn = sinf(ang);
}

#define LAS __attribute__((address_space(3)))
__device__ __forceinline__ int otid() { int t = threadIdx.x; asm volatile("" : "+v"(t)); return t; }
typedef short bf16x8 __attribute__((ext_vector_type(8)));
typedef float f32x4 __attribute__((ext_vector_type(4)));
typedef unsigned u32x4 __attribute__((ext_vector_type(4)));
typedef unsigned u32x2 __attribute__((ext_vector_type(2)));
typedef float f32x2 __attribute__((ext_vector_type(2)));
using f32x16 = __attribute__((ext_vector_type(16))) float;

constexpr size_t OFF_ROPE = 7 * MiB;
constexpr size_t OFF_WT_IN = 8 * MiB;
constexpr size_t OFF_WT_QB = 25 * MiB;
constexpr size_t OFF_WT_KVB = 28 * MiB;
constexpr size_t OFF_WT_OUT = 29 * MiB;
constexpr size_t OFF_WT_GU = 104 * MiB;
constexpr size_t OFF_WT_DN = 232 * MiB;
constexpr size_t OFF_YF8 = 775 * MiB;
constexpr size_t OFF_X1 = 704 * MiB;

struct Params {
    const float *x, *c, *ctx, *cctx, *w_mod, *b_mod, *g_mix, *w_in, *g_q, *w_qb, *g_kv, *w_kvb, *lbl, *g_hg, *w_out, *g_ffn, *w_r, *b_r, *w_gu, *b_gu, *w_dn, *b_dn, *g_fin;
    float* out; char* ws;
};

typedef __bf16 bf16v2_t __attribute__((ext_vector_type(2)));
__device__ __forceinline__ unsigned cvt_pk_bf16(float lo, float hi) { bf16v2_t v = {(__bf16)lo, (__bf16)hi}; return __builtin_bit_cast(unsigned, v); }

__device__ __forceinline__ unsigned pack4_fp8(float a, float b, float c, float d) {
    a = __builtin_amdgcn_fmed3f(a, -448.f, 448.f); b = __builtin_amdgcn_fmed3f(b, -448.f, 448.f); c = __builtin_amdgcn_fmed3f(c, -448.f, 448.f); d = __builtin_amdgcn_fmed3f(d, -448.f, 448.f);
    unsigned w = 0; w = __builtin_amdgcn_cvt_pk_fp8_f32(a, b, w, false); w = __builtin_amdgcn_cvt_pk_fp8_f32(c, d, w, true); return w; }

namespace pg8 {
constexpr int BM = 256, BK = 64, HALF = 128, HTB = HALF * BK * 2, STAGE_BYTES = 8 * HTB, NXCD = 8, WGM = 8;
constexpr int LDS_IDX = STAGE_BYTES + 8192;
__device__ __forceinline__ int lds_byte(int r, int c) { const int st = (r >> 4) * 2 + (c >> 5), rr = r & 15, cc = c & 31, ob = rr * 64 + cc * 2; return st * 1024 + (ob ^ (((ob >> 9) & 1) << 5)); }
__device__ __forceinline__ void stage_rc(int b, int& R, int& C) { const int st = b / 1024, sb = b % 1024, swz = sb ^ (((sb >> 9) & 1) << 5); R = (st >> 1) * 16 + swz / 64; C = (st & 1) * 32 + (swz % 64) / 2; }
__device__ __forceinline__ int perm32(int rho) { const int n = rho >> 4, i = rho & 15; return 8 * (i >> 2) + 4 * n + (i & 3); }
struct Unit { int pm, pn; const char* b; int e, pos0, cnt; };

__device__ __forceinline__ int xcd_remap(int L, int nwg) { const int q = nwg / NXCD, r = nwg % NXCD, xcd = L % NXCD, off = L / NXCD; return (xcd < r ? xcd * (q + 1) : r * (q + 1) + (xcd - r) * q) + off; }

struct DenseSched {
    int nM, nN, nwg, G, c, rowb; const char* Bt; size_t btile;
    __device__ void init(int M, int N, int kbytes, int rowb_, const void* Bt_, int G_, int c_) { nM = M / BM; nN = N / BM; nwg = nM * nN; G = G_; c = c_; rowb = rowb_; Bt = (const char*)Bt_; btile = (size_t)BM * kbytes; }
    static constexpr bool GATHER_LDS = false;
    __device__ __forceinline__ int kstepA() const { return 128; }
    __device__ __forceinline__ void tile(int wgid, int& pm, int& pn) const { const int nig = WGM * nN, gid = wgid / nig, fm = gid * WGM, gsz = (nM - fm) < WGM ? (nM - fm) : WGM; pm = fm + ((wgid % nig) % gsz); pn = (wgid % nig) / gsz; }
    __device__ __forceinline__ bool next(int i, Unit& u) const { const int Lx = i * G + c; if (Lx >= nwg) return false; tile(xcd_remap(Lx, nwg), u.pm, u.pn); u.b = Bt + (size_t)u.pn * btile; u.e = 0; u.pos0 = 0; u.cnt = 0; return true; }
    __device__ __forceinline__ void aoff(const Unit& u, const int (&Rr)[2], const int (&Cc)[2], unsigned (&va)[2][2]) const {
#pragma unroll
        for (int h = 0; h < 2; ++h)
#pragma unroll
            for (int i = 0; i < 2; ++i) va[h][i] = (unsigned)((u.pm * BM + h * HALF + Rr[i]) * rowb + Cc[i] * 2); }
};
struct InSched : DenseSched {
    __device__ void init2(const void* Bt_, int G_, int c_) { init(L, 8448, 1024, 1024, Bt_, G_, c_); }
    __device__ __forceinline__ bool next(int i, Unit& u) const {
        const int Lx = i * G + c; const int nlat = nwg;
        if (Lx < nlat) { tile(xcd_remap(Lx, nlat), u.pm, u.pn); }
        else { const int j = Lx - nlat; if (j >= 16 * 14) return false; const int q = j >> 4; u.pm = 128 + (j & 15); u.pn = q == 0 ? 3 : (q <= 12 ? 7 + q : 32); }
        u.b = Bt + (size_t)u.pn * btile; u.e = 0; u.pos0 = 0; u.cnt = 0; return true; }
};
__device__ __forceinline__ unsigned act_piece_off(int r, int c16) { const int s = 2 * (r >> 7) + (c16 >> 2), w = 4 * ((r >> 6) & 1) + (c16 & 3), l = 16 * ((r >> 4) & 3) + (r & 15); return (unsigned)(((s * 8 + w) * 64 + l) * 16); }
template <bool GATHER> struct MoeSched {
    int nN, G, c, rowb; const char* Wt; size_t wexp, btile; const LAS int* tab; const int* list;
    static constexpr bool GATHER_LDS = GATHER;
    __device__ __forceinline__ int kstepA() const { return GATHER ? 128 : 32768; }
    __device__ __forceinline__ bool next(int i, Unit& u) const {
        const int nwg = tab[33] * nN; const int Lx = i * G + c; if (Lx >= nwg) return false;
        const int w = xcd_remap(Lx, nwg); const int rt = w / nN; u.pn = w % nN; u.pm = rt;
        const int e = tab[128 + rt];
        u.e = e; u.pos0 = (rt - tab[e]) * BM; u.cnt = tab[64 + e]; u.b = Wt + (size_t)e * wexp + (size_t)u.pn * btile; return true; }
    __device__ __forceinline__ void aoff(const Unit& u, const int (&Rr)[2], const int (&Cc)[2], unsigned (&va)[2][2]) const {
#pragma unroll
        for (int h = 0; h < 2; ++h)
#pragma unroll
            for (int i = 0; i < 2; ++i) {
                if (GATHER) { const int pos = u.pos0 + h * HALF + Rr[i]; const int pair = pos < u.cnt ? list[u.e * CAP + pos] : 0; va[h][i] = (unsigned)((pair >> 2) * rowb + Cc[i] * 2); }
                else va[h][i] = (unsigned)u.pm * 262144u + act_piece_off(h * HALF + Rr[i], Cc[i] >> 3); } }
};

typedef int v8i_t __attribute__((ext_vector_type(8)));
typedef int i32x4_t __attribute__((ext_vector_type(4)));
template <class Epi, class Sched, bool FP8 = false, int SCA = 127, int SCB = 127>
__device__ __forceinline__ void gemm_phase(LAS unsigned char* lds, const char* Abase, const int K, const Sched& S, const Epi& E) {
    const int tid = otid(), wid = __builtin_amdgcn_readfirstlane(tid >> 6), lane = tid & 63, wr = wid >> 2, wc = wid & 3, fr = lane & 15, fq = lane >> 4;
    const int Kb = FP8 ? K : 2 * K;
    const int nt = Kb / (BK * 2);
    int Rr[2], Cc[2]; unsigned voffB[2];
#pragma unroll
    for (int i = 0; i < 2; ++i) { int R_, C_; stage_rc(tid * 16 + i * 8192, R_, C_); Rr[i] = R_; Cc[i] = C_; const int Rb = 64 * (R_ >> 5) + (Epi::PERM ? perm32(R_ & 31) : (R_ & 31)); voffB[i] = (unsigned)(Rb * Kb + C_ * 2); }
    const size_t kstep = (size_t)(BK * 2);
    const size_t kstepA = (size_t)S.kstepA();
    const size_t hstep = (size_t)32 * Kb;
    const unsigned ldsw = (unsigned)wid * 1024u;
    const int aoff = lds_byte(wr * 64 + fr, fq * 8), boff = lds_byte(wc * 32 + fr, fq * 8);
#define PG8_SA(b, h) (((b) * 2 + (h)) * HTB)
#define PG8_SB(b, h) ((4 + (b) * 2 + (h)) * HTB)
#define PG8_STAGE_B(bufoff, gbase) do { _Pragma("unroll") for (int _i = 0; _i < 2; ++_i) \
        __builtin_amdgcn_global_load_lds((const unsigned*)((const char*)(gbase) + voffB[_i]), (LAS unsigned*)(lds + (bufoff) + ldsw + _i * 8192), 16, 0, 0); } while (0)
#define PG8_STAGE_A(bufoff, v0, v1, kb) do { \
        __builtin_amdgcn_global_load_lds((const unsigned*)(Abase + (kb) + (v0)), (LAS unsigned*)(lds + (bufoff) + ldsw), 16, 0, 0); \
        __builtin_amdgcn_global_load_lds((const unsigned*)(Abase + (kb) + (v1)), (LAS unsigned*)(lds + (bufoff) + ldsw + 8192), 16, 0, 0); } while (0)
#define PG8_LD16(addr) (*(const LAS i32x4_t*)(addr))
#define PG8_LDA(dst, b, h) do { _Pragma("unroll") for (int m = 0; m < 4; ++m) { if constexpr (FP8) dst##8[m] = __builtin_shufflevector(PG8_LD16(lds + PG8_SA(b, h) + aoff + m * 2048), PG8_LD16(lds + PG8_SA(b, h) + aoff + m * 2048 + 1024), 0, 1, 2, 3, 4, 5, 6, 7); \
        else { _Pragma("unroll") for (int k = 0; k < 2; ++k) dst[m][k] = *(const LAS bf16x8*)(lds + PG8_SA(b, h) + aoff + m * 2048 + k * 1024); } } } while (0)
#define PG8_LDB(dst, b, h) do { _Pragma("unroll") for (int n = 0; n < 2; ++n) { if constexpr (FP8) dst##8[n] = __builtin_shufflevector(PG8_LD16(lds + PG8_SB(b, h) + boff + n * 2048), PG8_LD16(lds + PG8_SB(b, h) + boff + n * 2048 + 1024), 0, 1, 2, 3, 4, 5, 6, 7); \
        else { _Pragma("unroll") for (int k = 0; k < 2; ++k) dst[n][k] = *(const LAS bf16x8*)(lds + PG8_SB(b, h) + boff + n * 2048 + k * 1024); } } } while (0)
#define PG8_MMA(ai, bj, At, Bt) do { __builtin_amdgcn_s_setprio(1); _Pragma("unroll") for (int m = 0; m < 4; ++m) _Pragma("unroll") for (int n = 0; n < 2; ++n) { \
        if constexpr (FP8) asm volatile("v_mfma_scale_f32_16x16x128_f8f6f4 %0, %1, %2, %0, %3, %4 op_sel_hi:[0,0,0]" : "+v"(acc[ai][bj][m][n]) : "v"(Bt##8[n]), "v"(At##8[m]), "v"(scb_), "v"(sca_)); \
        else { _Pragma("unroll") for (int k = 0; k < 2; ++k) acc[ai][bj][m][n] = __builtin_amdgcn_mfma_f32_16x16x32_bf16(Bt[n][k], At[m][k], acc[ai][bj][m][n], 0, 0, 0); } } \
        __builtin_amdgcn_s_setprio(0); } while (0)
#define PG8_WAIT_V(n) asm volatile("s_waitcnt vmcnt(" #n ")" ::: "memory")
#define PG8_WAIT_L(n) asm volatile("s_waitcnt lgkmcnt(" #n ")" ::: "memory")
#define PG8_BAR __builtin_amdgcn_s_barrier()
#define PG8_SCHED __builtin_amdgcn_sched_barrier(0)
    Unit cur, nxt; int ui = 0;
    if (!S.next(0, cur)) return;
    f32x4 acc[2][2][4][2];
#pragma unroll
    for (int a = 0; a < 2; ++a)
#pragma unroll
        for (int b = 0; b < 2; ++b)
#pragma unroll
            for (int m = 0; m < 4; ++m)
#pragma unroll
                for (int n = 0; n < 2; ++n) acc[a][b][m][n] = (f32x4){0.f, 0.f, 0.f, 0.f};
    const int sca_ = SCA, scb_ = SCB;
    bf16x8 At[4][2], B0[2][2], B1[2][2]; v8i_t At8[4], B08[2], B18[2];
    unsigned vc[2][2], vn[2][2];
    S.aoff(cur, Rr, Cc, vc);
    const char* cB = cur.b;
    PG8_STAGE_B(PG8_SB(0, 0), cB); PG8_STAGE_A(PG8_SA(0, 0), vc[0][0], vc[0][1], 0); PG8_STAGE_B(PG8_SB(0, 1), cB + hstep); PG8_STAGE_A(PG8_SA(0, 1), vc[1][0], vc[1][1], 0);
    PG8_STAGE_B(PG8_SB(1, 0), cB + kstep); PG8_STAGE_A(PG8_SA(1, 0), vc[0][0], vc[0][1], kstepA); PG8_STAGE_B(PG8_SB(1, 1), cB + hstep + kstep);
    PG8_WAIT_V(6); PG8_BAR;
    if (wr == 1) PG8_BAR;
    for (;;) {
        const bool has_next = S.next(ui + 1, nxt);
        if constexpr (Sched::GATHER_LDS) {
            if (has_next && wid < 4) __builtin_amdgcn_global_load_lds((const unsigned*)(S.list + nxt.e * CAP + nxt.pos0 + otid()), (LAS unsigned*)(lds + LDS_IDX + wid * 256), 4, 0, 0);
        } else if (has_next) S.aoff(nxt, Rr, Cc, vn);
        if (!has_next) {
#pragma unroll
            for (int h = 0; h < 2; ++h)
#pragma unroll
                for (int i = 0; i < 2; ++i) vn[h][i] = vc[h][i]; }
        const char* nB = has_next ? nxt.b : cB;
#pragma unroll 1
        for (int t = 0; t < nt; t += 2) {
            const bool last = (t == nt - 2);
            if constexpr (Sched::GATHER_LDS) { if (last && has_next) {
#pragma unroll
                for (int h = 0; h < 2; ++h)
#pragma unroll
                    for (int i = 0; i < 2; ++i) { const int rr = h * HALF + Rr[i]; const int pair = (nxt.pos0 + rr) < nxt.cnt ? ((const LAS int*)(lds + LDS_IDX))[rr] : 0; vn[h][i] = (unsigned)((pair >> 2) * S.rowb + Cc[i] * 2); } } }
            const size_t k1 = (size_t)(t + 1) * kstepA;
            const size_t k2 = last ? 0 : (size_t)(t + 2) * kstepA;
            const unsigned s00 = last ? vn[0][0] : vc[0][0], s01 = last ? vn[0][1] : vc[0][1], s10 = last ? vn[1][0] : vc[1][0], s11 = last ? vn[1][1] : vc[1][1];
            const char* b2 = last ? nB : cB + (size_t)(t + 2) * kstep; const char* b3 = b2 + kstep;
            PG8_LDB(B0, 0, 0); PG8_LDB(B1, 0, 1); PG8_SCHED; PG8_LDA(At, 0, 0); PG8_STAGE_A(PG8_SA(1, 1), vc[1][0], vc[1][1], k1);
            PG8_WAIT_L(0); PG8_BAR; PG8_MMA(0, 0, At, B0); PG8_MMA(0, 1, At, B1); PG8_BAR; PG8_SCHED;
            PG8_LDA(At, 0, 1); PG8_SCHED; PG8_STAGE_B(PG8_SB(0, 0), b2); PG8_SCHED; PG8_STAGE_A(PG8_SA(0, 0), s00, s01, k2); PG8_SCHED; PG8_STAGE_B(PG8_SB(0, 1), b2 + hstep);
            PG8_WAIT_L(0); PG8_WAIT_V(6); PG8_BAR; PG8_MMA(1, 0, At, B0); PG8_MMA(1, 1, At, B1); PG8_BAR; PG8_SCHED;
            PG8_LDB(B0, 1, 0); PG8_LDB(B1, 1, 1); PG8_SCHED; PG8_LDA(At, 1, 0); PG8_STAGE_A(PG8_SA(0, 1), s10, s11, k2);
            PG8_WAIT_L(0); PG8_BAR; PG8_MMA(0, 0, At, B0); PG8_MMA(0, 1, At, B1); PG8_BAR; PG8_SCHED;
            PG8_LDA(At, 1, 1); PG8_SCHED; PG8_STAGE_B(PG8_SB(1, 0), b3); PG8_SCHED; PG8_STAGE_A(PG8_SA(1, 0), s00, s01, k2 + kstepA); PG8_SCHED; PG8_STAGE_B(PG8_SB(1, 1), b3 + hstep);
            PG8_WAIT_L(0); PG8_WAIT_V(6); PG8_BAR; PG8_MMA(1, 0, At, B0); PG8_MMA(1, 1, At, B1); PG8_BAR; PG8_SCHED;
        }
        if constexpr (FP8) asm volatile("s_nop 15\n\ts_nop 15" ::: "memory");
        E(acc, cur, wr, wc, fr, fq);
        if (!has_next) break;
#pragma unroll
        for (int a = 0; a < 2; ++a)
#pragma unroll
            for (int b = 0; b < 2; ++b)
#pragma unroll
                for (int m = 0; m < 4; ++m)
#pragma unroll
                    for (int n = 0; n < 2; ++n) acc[a][b][m][n] = (f32x4){0.f, 0.f, 0.f, 0.f};
        cur = nxt; cB = nB; ++ui;
#pragma unroll
        for (int h = 0; h < 2; ++h)
#pragma unroll
            for (int i = 0; i < 2; ++i) vc[h][i] = vn[h][i];
    }
    PG8_WAIT_V(0);
    if (wr == 0) PG8_BAR;
    PG8_BAR;
#undef PG8_SA
#undef PG8_SB
#undef PG8_STAGE_A
#undef PG8_STAGE_B
#undef PG8_LDA
#undef PG8_LDB
#undef PG8_MMA
#undef PG8_WAIT_V
#undef PG8_WAIT_L
#undef PG8_BAR
#undef PG8_SCHED
}

typedef f32x4 Acc[2][2][4][2];
__device__ __forceinline__ unsigned dpp_ror8(unsigned x) { return (unsigned)__builtin_amdgcn_update_dpp(0, (int)x, 0x128, 0xf, 0xf, false); }
__device__ __forceinline__ u32x4 ror8_4(const u32x4 v) { u32x4 r; r.x = dpp_ror8(v.x); r.y = dpp_ror8(v.y); r.z = dpp_ror8(v.z); r.w = dpp_ror8(v.w); return r; }
__device__ __forceinline__ void line_xy(const u32x4 a, const u32x4 b, bool lo, u32x4& X, u32x4& Y) { const u32x4 ra = ror8_4(a), rb = ror8_4(b); X = lo ? a : rb; Y = lo ? ra : b; }
__device__ __forceinline__ u32x4 pack8(const f32x4 v0, const f32x4 v1) { u32x4 w; w.x = cvt_pk_bf16(v0[0], v0[1]); w.y = cvt_pk_bf16(v0[2], v0[3]); w.z = cvt_pk_bf16(v1[0], v1[1]); w.w = cvt_pk_bf16(v1[2], v1[3]); return w; }

struct EpiIn { static constexpr bool PERM = true; char* ws;
    __device__ __forceinline__ void operator()(const Acc& acc, const Unit& u, int wr, int wc, int fr, int fq) const {
        const int pn = u.pn; size_t boff; int ld, cb;
        if (pn < 3) { boff = OFF_QA; ld = 384; cb = pn * 128; } else if (pn == 3) { boff = OFF_CKV; ld = 256; cb = 0; }
        else if (pn < 32) { boff = OFF_HQ + (size_t)((pn - 4) >> 2) * SEG_STRIDE; ld = 1024; cb = ((pn - 4) & 3) * 256; }
        else { boff = OFF_KR; ld = 64; cb = 0; }
        bf16_t* base = (bf16_t*)(ws + boff);
        if (pn == 32 && wc != 0) return;
        const bool lo = fr < 8; const int rowb0 = u.pm * BM + wr * 64, rx = fr & 7, colx = cb + wc * 64 + (fr >> 3) * 32 + 8 * fq;
        float* ssq = (float*)(ws + (pn < 3 ? OFF_SSQQ : OFF_SSQKV));
#pragma unroll
        for (int ai = 0; ai < 2; ++ai)
#pragma unroll
            for (int m = 0; m < 4; ++m) { const int rg = rowb0 + ai * HALF + m * 16;
                f32x4 v0 = acc[ai][0][m][0], v1 = acc[ai][0][m][1], w0 = acc[ai][1][m][0], w1 = acc[ai][1][m][1];
                if (pn >= 4 && pn < 8) {
#pragma unroll
                    for (int j = 0; j < 4; ++j) { v0[j] = siluf_(v0[j]) * 0.08838834764831845f; v1[j] = siluf_(v1[j]) * 0.08838834764831845f; w0[j] = siluf_(w0[j]) * 0.08838834764831845f; w1[j] = siluf_(w1[j]) * 0.08838834764831845f; } }
                if (pn < 3 || (pn >= 20 && pn < 32)) { unsigned char* qrow = pn < 3 ? (unsigned char*)base + (size_t)(rg + fr) * 768 + pn * 256 + wc * 64 + 8 * fq : (unsigned char*)base + (size_t)(rg + fr) * 1024 + (pn & 3) * 256 + wc * 64 + 8 * fq;
                    u32x2 a8; a8.x = pack4_fp8(v0[0], v0[1], v0[2], v0[3]); a8.y = pack4_fp8(v1[0], v1[1], v1[2], v1[3]); u32x2 b8; b8.x = pack4_fp8(w0[0], w0[1], w0[2], w0[3]); b8.y = pack4_fp8(w1[0], w1[1], w1[2], w1[3]);
                    *(u32x2*)qrow = a8; *(u32x2*)(qrow + 32) = b8; }
                else { u32x4 X, Y; line_xy(pack8(v0, v1), pack8(w0, w1), lo, X, Y);
                    __builtin_nontemporal_store(X, (u32x4*)(base + (size_t)(rg + rx) * ld + colx)); __builtin_nontemporal_store(Y, (u32x4*)(base + (size_t)(rg + 8 + rx) * ld + colx)); }
                if (pn <= 3) { float ss = (v0[0] * v0[0] + v0[1] * v0[1]) + (v0[2] * v0[2] + v0[3] * v0[3]) + (v1[0] * v1[0] + v1[1] * v1[1]) + (v1[2] * v1[2] + v1[3] * v1[3])
                                        + (w0[0] * w0[0] + w0[1] * w0[1]) + (w0[2] * w0[2] + w0[3] * w0[3]) + (w1[0] * w1[0] + w1[1] * w1[1]) + (w1[2] * w1[2] + w1[3] * w1[3]);
                    ss += __shfl_xor(ss, 16); ss += __shfl_xor(ss, 32); if (fq == 0) atomicAdd(ssq + rg + fr, ss); } }
    } };

struct EpiQ { static constexpr bool PERM = true; bf16_t* q; const float* ssq;
    __device__ __forceinline__ void operator()(const Acc& acc, const Unit& u, int wr, int wc, int fr, int fq) const {
        const bool lo = fr < 8; const int rowb0 = u.pm * BM + wr * 64, rx = fr & 7, colx = u.pn * BM + wc * 64 + (fr >> 3) * 32 + 8 * fq;
#pragma unroll
        for (int ai = 0; ai < 2; ++ai)
#pragma unroll
            for (int m = 0; m < 4; ++m) { const int rg = rowb0 + ai * HALF + m * 16; const float rs = rsqrtf(ssq[rg + fr] * (1.0f / 768.0f) + EPS);
                u32x4 X, Y; line_xy(pack8(acc[ai][0][m][0] * rs, acc[ai][0][m][1] * rs), pack8(acc[ai][1][m][0] * rs, acc[ai][1][m][1] * rs), lo, X, Y);
                *(u32x4*)(q + (size_t)(rg + rx) * 1536 + colx) = X; *(u32x4*)(q + (size_t)(rg + 8 + rx) * 1536 + colx) = Y; }
    } };

struct EpiKV { static constexpr bool PERM = true; bf16_t *Kb, *Vb; const float* ssq;
    __device__ __forceinline__ size_t kvrow(int row, int h) const { int b, pos; if (row < L) { b = row >> 11; pos = row & 2047; } else { b = (row - L) >> 8; pos = SEQ + ((row - L) & 255); } return (size_t)(b * 8 + h) * NKEY + pos; }
    __device__ __forceinline__ void operator()(const Acc& acc, const Unit& u, int wr, int wc, int fr, int fq) const {
        const bool lo = fr < 8; const int rowb0 = u.pm * BM + wr * 64, rx = fr & 7, colx = (wc & 1) * 64 + (fr >> 3) * 32 + 8 * fq;
        bf16_t* dst = wc < 2 ? Kb : Vb; const int ld = wc < 2 ? 192 : 128;
#pragma unroll
        for (int ai = 0; ai < 2; ++ai)
#pragma unroll
            for (int m = 0; m < 4; ++m) { const int rg = rowb0 + ai * HALF + m * 16; const float rs = rsqrtf(ssq[rg + fr] * (1.0f / 256.0f) + EPS);
                u32x4 X, Y; line_xy(pack8(acc[ai][0][m][0] * rs, acc[ai][0][m][1] * rs), pack8(acc[ai][1][m][0] * rs, acc[ai][1][m][1] * rs), lo, X, Y);
                *(u32x4*)(dst + kvrow(rg + rx, u.pn) * ld + colx) = X; *(u32x4*)(dst + kvrow(rg + 8 + rx, u.pn) * ld + colx) = Y; }
    } };

struct EpiOut { static constexpr bool PERM = true; bf16_t* x1; const float* x; const float* modv;
    __device__ __forceinline__ void operator()(const Acc& acc, const Unit& u, int wr, int wc, int fr, int fq) const {
        const bool lo = fr < 8; const int rowb0 = u.pm * BM + wr * 64, rx = fr & 7, colx = u.pn * BM + wc * 64 + (fr >> 3) * 32 + 8 * fq, cown = u.pn * BM + wc * 64 + 8 * fq;
#pragma unroll
        for (int ai = 0; ai < 2; ++ai)
#pragma unroll
            for (int m = 0; m < 4; ++m) { const int rg = rowb0 + ai * HALF + m * 16, row = rg + fr; const float* gate = modv + (row >> 11) * 6144 + 2 * 1024 + cown; const float* xr = x + (size_t)row * D + cown;
                f32x4 r[2][2];
#pragma unroll
                for (int bj = 0; bj < 2; ++bj)
#pragma unroll
                    for (int n = 0; n < 2; ++n) r[bj][n] = *(const f32x4*)(xr + bj * 32 + 4 * n) + *(const f32x4*)(gate + bj * 32 + 4 * n) * acc[ai][bj][m][n];
                u32x4 X, Y; line_xy(pack8(r[0][0], r[0][1]), pack8(r[1][0], r[1][1]), lo, X, Y);
                *(u32x4*)(x1 + (size_t)(rg + rx) * D + colx) = X; *(u32x4*)(x1 + (size_t)(rg + 8 + rx) * D + colx) = Y; }
    } };

struct EpiMoe1 { static constexpr bool PERM = true; unsigned char* act; const float* bgu;
    __device__ __forceinline__ void operator()(const Acc& acc, const Unit& u, int wr, int wc, int fr, int fq) const {
        const int o0 = u.pn * 128 + wc * 16 + 4 * fq;
        f32x4 bg[2], bl[2];
#pragma unroll
        for (int bj = 0; bj < 2; ++bj) { const float* bp = bgu + u.e * 2048 + 2 * (o0 + bj * 64); const f32x4 t0 = *(const f32x4*)bp, t1 = *(const f32x4*)(bp + 4);
            bg[bj] = (f32x4){t0[0], t0[2], t1[0], t1[2]}; bl[bj] = (f32x4){t0[1], t0[3], t1[1], t1[3]}; }
        unsigned char* blk = act + ((size_t)u.pm * 8 + u.pn) * 32768 + (size_t)(wr * 4 + wc) * 1024 + (size_t)(fq * 16 + fr) * 16;
#pragma unroll
        for (int ai = 0; ai < 2; ++ai)
#pragma unroll
            for (int bj = 0; bj < 2; ++bj) { unsigned d[4];
#pragma unroll
                for (int m = 0; m < 4; ++m) { const f32x4 g4 = acc[ai][bj][m][0] + bg[bj], l4 = acc[ai][bj][m][1] + bl[bj]; float r[4];
#pragma unroll
                    for (int j = 0; j < 4; ++j) { const float glu = fminf(g4[j], 7.0f), lin = __builtin_amdgcn_fmed3f(l4[j], -7.0f, 7.0f); r[j] = 4.0f * glu * __builtin_amdgcn_rcpf(1.0f + __builtin_amdgcn_exp2f(-2.4554669595930157f * glu)) * (lin + 1.0f); }
                    d[m] = pack4_fp8(r[0], r[1], r[2], r[3]); }
                const auto s01 = __builtin_amdgcn_permlane16_swap(d[0], d[1], false, false); const auto s23 = __builtin_amdgcn_permlane16_swap(d[2], d[3], false, false);
                const auto t02 = __builtin_amdgcn_permlane32_swap(s01[0], s23[0], false, false); const auto t13 = __builtin_amdgcn_permlane32_swap(s01[1], s23[1], false, false);
                *(u32x4*)(blk + (size_t)(ai * 2 + bj) * 8192) = (u32x4){t02[0], t13[0], t02[1], t13[1]}; }
    } };

struct EpiMoe2 { static constexpr bool PERM = true; bf16_t* yp; const float* bd;
    __device__ __forceinline__ void operator()(const Acc& acc, const Unit& u, int wr, int wc, int fr, int fq) const {
        const bool lo = fr < 8; const int rowb0 = u.pm * BM + wr * 64, rx = fr & 7, colx = u.pn * BM + wc * 64 + (fr >> 3) * 32 + 8 * fq, cown = u.pn * BM + wc * 64 + 8 * fq;
        f32x4 bv[2][2];
#pragma unroll
        for (int bj = 0; bj < 2; ++bj)
#pragma unroll
            for (int n = 0; n < 2; ++n) bv[bj][n] = *(const f32x4*)(bd + u.e * 1024 + cown + bj * 32 + 4 * n);
#pragma unroll
        for (int ai = 0; ai < 2; ++ai)
#pragma unroll
            for (int m = 0; m < 4; ++m) { const int rg = rowb0 + ai * HALF + m * 16;
                u32x4 X, Y; line_xy(pack8(acc[ai][0][m][0] + bv[0][0], acc[ai][0][m][1] + bv[0][1]), pack8(acc[ai][1][m][0] + bv[1][0], acc[ai][1][m][1] + bv[1][1]), lo, X, Y);
                __builtin_nontemporal_store(X, (u32x4*)(yp + (size_t)(rg + rx) * D + colx)); __builtin_nontemporal_store(Y, (u32x4*)(yp + (size_t)(rg + 8 + rx) * D + colx)); }
    } };
}

__device__ __forceinline__ int conv_src_col(int kind, int c) {
    if (kind == 0) return c;
    if (kind == 1) { if (c < 1024) return c; if (c < 8192) return c + 64; if (c < 8256) return c - 8192 + 1024; return -1; }
    const int pn = c >> 8, p = c & 255, wc = p >> 6, bj = (p >> 5) & 1, fq = (p >> 3) & 3, n = (p >> 2) & 1, i = p & 3; const int o = 128 * pn + 64 * bj + 16 * wc + 4 * fq + i; return 2 * o + n;
}
__device__ __forceinline__ void lds_sync() { asm volatile("s_waitcnt lgkmcnt(0)\n\ts_barrier" ::: "memory"); }
template <bool F8> struct ConvPipe {
    float v[32]; bool have; bf16_t* dummy;
    int K, kind, k0, c0; void* Wt;
    __device__ __forceinline__ void issue(const float* __restrict__ W, int ldw, void* Wt_, int K_, int kind_, const float* __restrict__ kscale, int k0_, int c0_) {
        const int tid = otid(); const int cc = tid & 127, kq = tid >> 7, sc = conv_src_col(kind_, c0_ + cc);
        const int scc = sc < 0 ? 0 : sc; const float* wp = W + (size_t)(k0_ + kq) * ldw + scc;
#pragma unroll
        for (int i = 0; i < 32; ++i) v[i] = __builtin_nontemporal_load(wp + (size_t)(4 * i) * ldw);
        if (sc < 0) {
#pragma unroll
            for (int i = 0; i < 32; ++i) v[i] = 0.f; }
        if (kscale) {
#pragma unroll
            for (int i = 0; i < 32; ++i) v[i] *= kscale[k0_ + kq + 4 * i]; }
        K = K_; kind = kind_; k0 = k0_; c0 = c0_; Wt = Wt_; have = true;
    }
    __device__ __forceinline__ void flush(LAS float* tl) {
        if (!have) return; have = false;
        const int tid = otid(); const int cc = tid & 127, kq = tid >> 7;
        __syncthreads();
#pragma unroll
        for (int i = 0; i < 32; ++i) tl[(kq + 4 * i) * 129 + cc] = v[i];
        __syncthreads();
        stash(tl, tid);
    }
    __device__ __forceinline__ void to_lds(LAS float* tl) { const int tid = otid(); const int cc = tid & 127, kq = tid >> 7; lds_sync();
#pragma unroll
        for (int i = 0; i < 32; ++i) tl[(kq + 4 * i) * 129 + cc] = v[i];
        lds_sync(); }
    __device__ __forceinline__ void stash(LAS float* tl, int tid) const {
        if constexpr (F8) {
#pragma unroll
            for (int pss = 0; pss < 2; ++pss) { const int item = tid + 512 * pss, c2 = item >> 3, ch = item & 7; float t[16];
#pragma unroll
                for (int j = 0; j < 16; ++j) t[j] = tl[(16 * ch + j) * 129 + c2] * 32.f;
                u32x4 w; w.x = pack4_fp8(t[0], t[1], t[2], t[3]); w.y = pack4_fp8(t[4], t[5], t[6], t[7]); w.z = pack4_fp8(t[8], t[9], t[10], t[11]); w.w = pack4_fp8(t[12], t[13], t[14], t[15]);
                *(u32x4*)((unsigned char*)Wt + (size_t)(c0 + c2) * K + k0 + 16 * ch) = w; }
        } else {
#pragma unroll
            for (int pss = 0; pss < 4; ++pss) { const int item = tid + 512 * pss, c2 = item >> 4, ch = item & 15; float t[8];
#pragma unroll
                for (int j = 0; j < 8; ++j) t[j] = tl[(8 * ch + j) * 129 + c2];
                u32x4 w; w.x = cvt_pk_bf16(t[0], t[1]); w.y = cvt_pk_bf16(t[2], t[3]); w.z = cvt_pk_bf16(t[4], t[5]); w.w = cvt_pk_bf16(t[6], t[7]);
                *(u32x4*)((bf16_t*)Wt + (size_t)(c0 + c2) * K + k0 + 8 * ch) = w; }
        }
    }
};
template <bool F8>
__device__ __forceinline__ void conv_matrix(LAS float* tl, ConvPipe<F8>& pipe, const float* W, int ldw, void* Wt, int K, int Nout, int kind, const float* kscale, int& tctr) {
    const int nk = K / 128, ntile = nk * (Nout / 128);
    int t = ((int)blockIdx.x - tctr) % (int)gridDim.x; if (t < 0) t += gridDim.x;
    for (; t < ntile; t += gridDim.x) {
        if (pipe.have) { pipe.to_lds(tl); const int K0 = pipe.K, k00 = pipe.k0, c00 = pipe.c0; void* W0 = pipe.Wt; ConvPipe<F8> done = pipe; (void)K0; (void)k00; (void)c00; (void)W0;
            pipe.issue(W, ldw, Wt, K, kind, kscale, (t % nk) * 128, (t / nk) * 128); done.stash(tl, otid()); }
        else pipe.issue(W, ldw, Wt, K, kind, kscale, (t % nk) * 128, (t / nk) * 128);
    }
    tctr = (tctr + ntile) % (int)gridDim.x;
}
template <bool F8> __device__ __forceinline__ void conv_finish(LAS float* tl, ConvPipe<F8>& pipe) { if (pipe.have) { pipe.to_lds(tl); pipe.stash(tl, otid()); pipe.have = false; } __syncthreads(); }

__device__ __forceinline__ float half_sum256(float v, LAS float* red) {
    for (int o = 32; o > 0; o >>= 1) v += __shfl_xor(v, o);
    const int w = otid() >> 6, hb = (otid() >> 8) * 4; if ((otid() & 63) == 0) red[w] = v; __syncthreads();
    const float t = red[hb] + red[hb + 1] + red[hb + 2] + red[hb + 3]; __syncthreads(); return t;
}

__device__ __forceinline__ void phase0(const Params& p, LAS unsigned char* lds) {
    char* ws = p.ws; const int tid = otid(), gsz = gridDim.x * 512, gid = blockIdx.x * 512 + tid;
    float* lb = (float*)(ws + OFF_LB); int* cnt = (int*)(ws + OFF_CNT); float* ssqq = (float*)(ws + OFF_SSQQ); float* ssqkv = (float*)(ws + OFF_SSQKV); float* modv = (float*)(ws + OFF_MOD);
    for (int i = gid; i < 2048; i += gsz) { const int d = i >> 10, j = i & 1023; const float a = p.lbl[(d * 2 + 0) * 1024 + j], b = p.lbl[(d * 2 + 1) * 1024 + j]; lb[i] = 1.0f / (1.0f + __expf(b - a)); }
    for (int i = gid; i < 32; i += gsz) cnt[i] = 0;
    { float* ropet = (float*)(ws + OFF_ROPE); for (int i = gid; i < SEQ * 32; i += gsz) { const int t = i >> 5, j = i & 31; float cs, sn; rope_cs(t, j, cs, sn); ropet[t * 64 + j] = cs; ropet[t * 64 + 32 + j] = sn; } }
    for (int i = gid; i < L; i += gsz) ssqq[i] = 0.f;
    for (int i = gid; i < R; i += gsz) ssqkv[i] = 0.f;
    { LAS float* sil = (LAS float*)lds;
      LAS float* part = (LAS float*)(lds + 17 * 1024 * 4);
      bool loaded = false;
      for (int item = blockIdx.x; item < 192; item += gridDim.x) {
          if (!loaded) { for (int i = tid; i < 17 * 1024; i += 512) { const int r = i >> 10, k = i & 1023; sil[i] = siluf_(r < 16 ? p.c[r * 1024 + k] : p.cctx[k]); } loaded = true; __syncthreads(); }
          const int j = tid & 31, ks = tid >> 5; float a[17];
#pragma unroll
          for (int r = 0; r < 17; ++r) a[r] = 0.f;
#pragma unroll 4
          for (int k = ks * 64; k < ks * 64 + 64; ++k) { const float w = p.w_mod[(size_t)k * 6144 + item * 32 + j];
#pragma unroll
              for (int r = 0; r < 17; ++r) a[r] += sil[r * 1024 + k] * w; }
#pragma unroll
          for (int r = 0; r < 17; ++r) part[(ks * 17 + r) * 32 + j] = a[r];
          __syncthreads();
          for (int i = tid; i < 17 * 32; i += 512) { const int r = i >> 5, jj = i & 31; float s = p.b_mod[item * 32 + jj]; for (int q = 0; q < 16; ++q) s += part[(q * 17 + r) * 32 + jj]; modv[r * 6144 + item * 32 + jj] = s; }
          __syncthreads();
      } }
    __syncthreads();
    { LAS float* tl = (LAS float*)lds; int tctr = 0;
      { ConvPipe<true> pp; pp.have = false; conv_matrix<true>(tl, pp, p.w_in, 8256, (unsigned char*)(ws + OFF_WT_IN), 1024, 8448, 1, nullptr, tctr); conv_finish<true>(tl, pp); }
      { ConvPipe<true> pp; pp.have = false;
        conv_matrix<true>(tl, pp, p.w_qb, 1536, (unsigned char*)(ws + OFF_WT_QB), 768, 1536, 0, p.g_q, tctr);
        conv_matrix<true>(tl, pp, p.w_out, 1024, (unsigned char*)(ws + OFF_WT_OUT), 1024, 1024, 0, nullptr, tctr); conv_finish<true>(tl, pp); }
      { ConvPipe<false> pp; pp.have = false;
        conv_matrix<false>(tl, pp, p.w_kvb, 2048, (bf16_t*)(ws + OFF_WT_KVB), 256, 2048, 0, p.g_kv, tctr); conv_finish<false>(tl, pp); } }
}

__device__ __forceinline__ float wave_sum(float v) {
#pragma unroll
    for (int o = 32; o > 0; o >>= 1) v += __shfl_xor(v, o);
    return v; }
__device__ __forceinline__ void phase1(const Params& p, LAS unsigned char* lds) {
    const float* modv = (const float*)(p.ws + OFF_MOD); unsigned char* h = (unsigned char*)(p.ws + OFF_H);
    const int tid = otid(), lane = tid & 63, gw = blockIdx.x * 8 + (tid >> 6), nw = gridDim.x * 8, c0 = lane * 8;
    f32x4 g[4];
#pragma unroll
    for (int q = 0; q < 4; ++q) g[q] = *(const f32x4*)(p.g_mix + (q >> 1) * 512 + c0 + (q & 1) * 4);
    for (int row0 = gw; row0 < R; row0 += 4 * nw) {
        f32x4 v[4][4];
#pragma unroll
        for (int u = 0; u < 4; ++u) { const int row = row0 + u * nw < R ? row0 + u * nw : row0; const float* src = row < L ? p.x + (size_t)row * D : p.ctx + (size_t)(row - L) * D;
#pragma unroll
            for (int q = 0; q < 4; ++q) v[u][q] = __builtin_nontemporal_load((const f32x4*)(src + (q >> 1) * 512 + c0 + (q & 1) * 4)); }
#pragma unroll
        for (int u = 0; u < 4; ++u) { if (row0 + u * nw >= R) break; const int row = row0 + u * nw; const float* mod = modv + (row < L ? row / SEQ : 16) * 6144;
            float ss = 0.f;
#pragma unroll
            for (int q = 0; q < 4; ++q) ss += (v[u][q][0] * v[u][q][0] + v[u][q][1] * v[u][q][1]) + (v[u][q][2] * v[u][q][2] + v[u][q][3] * v[u][q][3]);
            const float rs = rsqrtf(wave_sum(ss) * (1.0f / D) + EPS);
#pragma unroll
            for (int j = 0; j < 2; ++j) { f32x4 o[2];
#pragma unroll
                for (int e = 0; e < 2; ++e) { const int cc = j * 512 + c0 + e * 4; const f32x4 sc = *(const f32x4*)(mod + 1024 + cc), sh = *(const f32x4*)(mod + cc); o[e] = v[u][j * 2 + e] * rs * g[j * 2 + e] * (sc + 1.0f) + sh; }
                u32x2 w; w.x = pack4_fp8(o[0][0], o[0][1], o[0][2], o[0][3]); w.y = pack4_fp8(o[1][0], o[1][1], o[1][2], o[1][3]);
                *(u32x2*)(h + (size_t)row * D + j * 512 + c0) = w; } }
    }
}


__device__ __forceinline__ void phase2(const Params& p, LAS unsigned char* lds) {
    pg8::InSched S; S.init2(p.ws + OFF_WT_IN, gridDim.x, blockIdx.x);
    pg8::EpiIn E{p.ws};
    pg8::gemm_phase<pg8::EpiIn, pg8::InSched, true, 127, 122>(lds, (const char*)(p.ws + OFF_H), 1024, S, E);
}
__device__ __forceinline__ void phase3(const Params& p, LAS unsigned char* lds) {
    char* ws = p.ws;
    { pg8::DenseSched S; S.init(L, 1536, 768, 768, ws + OFF_WT_QB, gridDim.x, blockIdx.x); pg8::EpiQ E{(bf16_t*)(ws + OFF_Q), (const float*)(ws + OFF_SSQQ)}; pg8::gemm_phase<pg8::EpiQ, pg8::DenseSched, true, 127, 122>(lds, (const char*)(ws + OFF_QA), 768, S, E); }
    { pg8::DenseSched S; S.init(R, 2048, 256 * 2, 256 * 2, ws + OFF_WT_KVB, gridDim.x, blockIdx.x); pg8::EpiKV E{(bf16_t*)(ws + OFF_K), (bf16_t*)(ws + OFF_V), (const float*)(ws + OFF_SSQKV)}; pg8::gemm_phase(lds, (const char*)(ws + OFF_CKV), 256, S, E); }
    { const bf16_t* kr = (const bf16_t*)(ws + OFF_KR); bf16_t* Kb = (bf16_t*)(ws + OFF_K); const float* ropet = (const float*)(ws + OFF_ROPE);
      for (int gid = blockIdx.x * 512 + otid(); gid < R * 32; gid += gridDim.x * 512) { const int row = gid >> 5, i = gid & 31;
          const float x1 = bf2f(kr[(size_t)row * 64 + i]), x2 = bf2f(kr[(size_t)row * 64 + 32 + i]); float o1 = x1, o2 = x2; int b, pos;
          if (row < L) { b = row / SEQ; pos = row % SEQ; const float cs = ropet[pos * 64 + i], sn = ropet[pos * 64 + 32 + i]; o1 = x1 * cs - x2 * sn; o2 = x1 * sn + x2 * cs; } else { b = (row - L) / CTXL; pos = SEQ + (row - L) % CTXL; }
          const bf16_t w1 = f2bf(o1), w2 = f2bf(o2);
          for (int h = 0; h < 8; ++h) { bf16_t* q = Kb + ((size_t)(b * 8 + h) * NKEY + pos) * 192 + 128; q[i] = w1; q[32 + i] = w2; } } }
}
__device__ __forceinline__ void unpack8_fp8(const u32x2 w, float (&o)[8]) {
    o[0] = __builtin_amdgcn_cvt_f32_fp8((int)w.x, 0); o[1] = __builtin_amdgcn_cvt_f32_fp8((int)w.x, 1); o[2] = __builtin_amdgcn_cvt_f32_fp8((int)w.x, 2); o[3] = __builtin_amdgcn_cvt_f32_fp8((int)w.x, 3);
    o[4] = __builtin_amdgcn_cvt_f32_fp8((int)w.y, 0); o[5] = __builtin_amdgcn_cvt_f32_fp8((int)w.y, 1); o[6] = __builtin_amdgcn_cvt_f32_fp8((int)w.y, 2); o[7] = __builtin_amdgcn_cvt_f32_fp8((int)w.y, 3); }
__device__ __forceinline__ void unpack8(const u32x4 w, float (&o)[8]) {
    o[0] = __uint_as_float(w.x << 16); o[1] = __uint_as_float(w.x & 0xffff0000u); o[2] = __uint_as_float(w.y << 16); o[3] = __uint_as_float(w.y & 0xffff0000u);
    o[4] = __uint_as_float(w.z << 16); o[5] = __uint_as_float(w.z & 0xffff0000u); o[6] = __uint_as_float(w.w << 16); o[7] = __uint_as_float(w.w & 0xffff0000u); }
__device__ __forceinline__ void phase4(const Params& p, LAS unsigned char*) {
    char* ws = p.ws; bf16_t* y = (bf16_t*)(ws + OFF_H); const bf16_t* of = (const bf16_t*)(ws + OFF_OF); const bf16_t* ob = (const bf16_t*)(ws + OFF_OB);
    const unsigned char* og = (const unsigned char*)(ws + OFF_OG); const unsigned char* gm = (const unsigned char*)(ws + OFF_GM); const unsigned char* gh = (const unsigned char*)(ws + OFF_GH);
    const int tid = otid(), lane = tid & 63, gw = blockIdx.x * 8 + (tid >> 6), nw = gridDim.x * 8, c0 = lane * 8;
    float gg[8];
#pragma unroll
    for (int i = 0; i < 8; ++i) gg[i] = p.g_hg[(c0 + i) & 127];
    for (int row0 = gw; row0 < L; row0 += 2 * nw) {
        u32x4 ra[2][2], rb[2][2], rm[2][2]; u32x2 r1[2][2], r2[2][2], r3[2][2];
#pragma unroll
        for (int u = 0; u < 2; ++u) { const int row = row0 + u * nw < L ? row0 + u * nw : row0;
#pragma unroll
        for (int j = 0; j < 2; ++j) { const size_t off = (size_t)row * D + j * 512 + c0; ra[u][j] = __builtin_nontemporal_load((const u32x4*)(of + off)); rb[u][j] = __builtin_nontemporal_load((const u32x4*)(ob + off)); r1[u][j] = __builtin_nontemporal_load((const u32x2*)(og + off)); r2[u][j] = __builtin_nontemporal_load((const u32x2*)(gm + off)); r3[u][j] = __builtin_nontemporal_load((const u32x2*)(gh + off)); rm[u][j] = __builtin_nontemporal_load((const u32x4*)(y + off)); } }
#pragma unroll
        for (int u = 0; u < 2; ++u) { const int row = row0 + u * nw; if (row >= L) break;
#pragma unroll
        for (int j = 0; j < 2; ++j) { float a[8], b[8], g1[8], g2[8], g3[8], ym[8], o[8]; unpack8(ra[u][j], a); unpack8(rb[u][j], b); unpack8_fp8(r1[u][j], g1); unpack8_fp8(r2[u][j], g2); unpack8_fp8(r3[u][j], g3); unpack8(rm[u][j], ym);
            float ss = 0.f;
#pragma unroll
            for (int i = 0; i < 8; ++i) { o[i] = a[i] + b[i]; ss += o[i] * o[i]; }
            ss += __shfl_xor(ss, 1); ss += __shfl_xor(ss, 2); ss += __shfl_xor(ss, 4); ss += __shfl_xor(ss, 8);
            const float rs = rsqrtf(ss * (1.0f / 128.0f) + EPS); float r[8];
#pragma unroll
            for (int i = 0; i < 8; ++i) { const float yh = o[i] * rs * gg[i] * siluf_(g1[i]); r[i] = sigmoidf_(g2[i]) * ym[i] + sigmoidf_(g3[i]) * yh; }
            u32x2 w; w.x = pack4_fp8(r[0], r[1], r[2], r[3]); w.y = pack4_fp8(r[4], r[5], r[6], r[7]);
            *(u32x2*)((unsigned char*)(ws + OFF_YF8) + (size_t)row * D + j * 512 + c0) = w; } }
    }
}

#define MC_TIE16(v, o) asm volatile("" : "+v"(v[o+0]), "+v"(v[o+1]), "+v"(v[o+2]), "+v"(v[o+3]), "+v"(v[o+4]), "+v"(v[o+5]), "+v"(v[o+6]), "+v"(v[o+7]), "+v"(v[o+8]), "+v"(v[o+9]), "+v"(v[o+10]), "+v"(v[o+11]), "+v"(v[o+12]), "+v"(v[o+13]), "+v"(v[o+14]), "+v"(v[o+15]))
__device__ __forceinline__ void mc_issue(const Params& p, int idx, float (&v)[32]) {
    const int tid = otid(); const int cc = tid & 127, kq = tid >> 7; const float* base; unsigned voff, vstep;
    if (idx < 4096) { const int e = idx >> 7, r = idx & 127; base = p.w_gu + (size_t)e * 1024 * 2048; voff = (unsigned)(((r & 7) * 128 + kq) * 2048 + conv_src_col(2, (r >> 3) * 128 + cc)) * 4u; vstep = 4u * 2048u * 4u; }
    else { const int j = idx - 4096, e = j >> 6, r = j & 63; base = p.w_dn + (size_t)e * 1024 * 1024; voff = (unsigned)(((r & 7) * 128 + kq) * 1024 + (r >> 3) * 128 + cc) * 4u; vstep = 4u * 1024u * 4u; }
#pragma unroll
    for (int i = 0; i < 32; ++i) { asm volatile("global_load_dword %0, %1, %2 nt" : "=v"(v[i]) : "v"(voff), "s"(base) : "memory"); voff += vstep; }
}
__device__ __forceinline__ void mc_stash(const Params& p, int idx, const LAS float* tl) {
    unsigned char* dst;
    if (idx < 4096) { const int e = idx >> 7, r = idx & 127; dst = (unsigned char*)(p.ws + OFF_WT_GU) + (size_t)e * 2048 * 1024 + (size_t)((r >> 3) * 128) * 1024 + (r & 7) * 128; }
    else { const int j = idx - 4096, e = j >> 6, r = j & 63; dst = (unsigned char*)(p.ws + OFF_WT_DN) + (size_t)e * 1024 * 1024 + (size_t)((r >> 3) * 128) * 1024 + (r & 7) * 128; }
    const int tid = otid();
#pragma unroll
    for (int pss = 0; pss < 2; ++pss) { const int item = tid + 512 * pss, c2 = item >> 3, ch = item & 7; float t[16];
#pragma unroll
        for (int j = 0; j < 16; ++j) t[j] = tl[(16 * ch + j) * 129 + c2] * 32.f;
        u32x4 w; w.x = pack4_fp8(t[0], t[1], t[2], t[3]); w.y = pack4_fp8(t[4], t[5], t[6], t[7]); w.z = pack4_fp8(t[8], t[9], t[10], t[11]); w.w = pack4_fp8(t[12], t[13], t[14], t[15]);
        *(u32x4*)(dst + (size_t)c2 * 1024 + 16 * ch) = w; }
}
__device__ __forceinline__ void mc_step(const Params& p, float (&v)[32], LAS float* tl, int i, int n, int stride, int wmode) {
    const int tid = otid(); const int cc = tid & 127, kq = tid >> 7; const int idx = (int)blockIdx.x + i * stride;
    if (wmode == 3) asm volatile("s_waitcnt vmcnt(36)" ::: "memory"); else if (wmode == 2) asm volatile("s_waitcnt vmcnt(34)" ::: "memory"); else if (wmode == 1) asm volatile("s_waitcnt vmcnt(32)" ::: "memory"); else asm volatile("s_waitcnt vmcnt(0)" ::: "memory");
    MC_TIE16(v, 0); MC_TIE16(v, 16);
#pragma unroll
    for (int q = 0; q < 32; ++q) tl[(kq + 4 * q) * 129 + cc] = v[q];
    lds_sync();
    if (i + 2 < n) mc_issue(p, idx + 2 * stride, v);
    mc_stash(p, idx, tl);
}
__device__ __forceinline__ void moe_conv(const Params& p, LAS unsigned char* lds) {
    LAS float* t0 = (LAS float*)lds; LAS float* t1 = t0 + 128 * 129;
    const int stride = gridDim.x, n = (6144 - (int)blockIdx.x + stride - 1) / stride;
    float va[32], vb[32];
#pragma unroll
    for (int q = 0; q < 32; ++q) { va[q] = 0.f; vb[q] = 0.f; }
    lds_sync();
    if (n >= 4) {
        mc_issue(p, (int)blockIdx.x, va); mc_issue(p, (int)blockIdx.x + stride, vb);
        mc_step(p, va, t0, 0, n, stride, 1); mc_step(p, vb, t1, 1, n, stride, 2);
#pragma unroll 1
        for (int i = 2; i < n; i += 2) { mc_step(p, va, t0, i, n, stride, i == n - 1 ? 0 : 3); if (i + 1 < n) mc_step(p, vb, t1, i + 1, n, stride, i + 1 == n - 1 ? 0 : 3); }
    } else {
        for (int i = 0; i < n; ++i) { mc_issue(p, (int)blockIdx.x + i * stride, va); mc_step(p, va, t0, i, 0, stride, 0); lds_sync(); }
    }
    __syncthreads();
}
__device__ __forceinline__ void phase5(const Params& p, LAS unsigned char* lds) {
    char* ws = p.ws;
    { pg8::DenseSched S; S.init(L, 1024, 1024, 1024, ws + OFF_WT_OUT, gridDim.x, blockIdx.x); pg8::EpiOut E{(bf16_t*)(ws + OFF_X1), p.x, (const float*)(ws + OFF_MOD)}; pg8::gemm_phase<pg8::EpiOut, pg8::DenseSched, true, 127, 122>(lds, (const char*)(ws + OFF_YF8), 1024, S, E); }
    moe_conv(p, lds);
}
__device__ __forceinline__ void phase6(const Params& p, LAS unsigned char* lds) {
    char* ws = p.ws; const float* modv = (const float*)(ws + OFF_MOD); unsigned char* h2 = (unsigned char*)(ws + OFF_H); int* topi = (int*)(ws + OFF_TOPI); float* topp = (float*)(ws + OFF_TOPP); int* cnt = (int*)(ws + OFF_CNT); int* list = (int*)(ws + OFF_LIST); int* pairpos = (int*)(ws + OFF_ROWPAIR);
    constexpr int HS_LD = 1028, HS_BYTES = 32 * HS_LD * 4;
    LAS float* hs = (LAS float*)lds;
    LAS float* lg = (LAS float*)(lds + HS_BYTES);
    LAS int* lcnt = (LAS int*)(lds + HS_BYTES + 4096);
    LAS int* lent = (LAS int*)(lds + HS_BYTES + 4096 + 512);
    LAS int* lbase = (LAS int*)(lds + HS_BYTES + 4096 + 512 + 8192);
    LAS int* lrun = (LAS int*)(lds + HS_BYTES + 4096 + 512 + 8192 + 2048);
    const int tid = otid(), lane = tid & 63, wid = tid >> 6, c0 = lane * 8;
    if (tid < 32) lcnt[tid] = 0;
    lrun[tid] = 0;
    int pending = 0;
    f32x4 g[4];
#pragma unroll
    for (int q = 0; q < 4; ++q) g[q] = *(const f32x4*)(p.g_ffn + (q >> 1) * 512 + c0 + (q & 1) * 4);
    float wB[64];
#pragma unroll
    for (int s = 0; s < 32; ++s) { const int k0 = 128 * wid + 4 * s + 2 * (lane >> 5); wB[2 * s] = p.w_r[k0 * 32 + (lane & 31)]; wB[2 * s + 1] = p.w_r[(k0 + 1) * 32 + (lane & 31)]; }
    __syncthreads();
    int it = 0;
    for (int tile = blockIdx.x; tile < L / 32; tile += gridDim.x, ++it) {
        const int rbase = tile * 32;
        f32x4 v[4][4];
#pragma unroll
        for (int u = 0; u < 4; ++u)
#pragma unroll
            for (int j = 0; j < 2; ++j) { float t8[8]; unpack8(*(const u32x4*)((const bf16_t*)(ws + OFF_X1) + (size_t)(rbase + wid * 4 + u) * D + j * 512 + c0), t8); v[u][2 * j] = (f32x4){t8[0], t8[1], t8[2], t8[3]}; v[u][2 * j + 1] = (f32x4){t8[4], t8[5], t8[6], t8[7]}; }
#pragma unroll
        for (int u = 0; u < 4; ++u) { const int rl = wid * 4 + u, row = rbase + rl; const float* mod = modv + (row / SEQ) * 6144; float ss = 0.f;
#pragma unroll
            for (int q = 0; q < 4; ++q) ss += (v[u][q][0] * v[u][q][0] + v[u][q][1] * v[u][q][1]) + (v[u][q][2] * v[u][q][2] + v[u][q][3] * v[u][q][3]);
            const float rs = rsqrtf(wave_sum(ss) * (1.0f / D) + EPS);
#pragma unroll
            for (int j = 0; j < 2; ++j) { f32x4 o[2];
#pragma unroll
                for (int e = 0; e < 2; ++e) { const int cc = j * 512 + c0 + e * 4; const f32x4 sc = *(const f32x4*)(mod + 4 * 1024 + cc), sh = *(const f32x4*)(mod + 3 * 1024 + cc); o[e] = v[u][j * 2 + e] * rs * g[j * 2 + e] * (sc + 1.0f) + sh;
                    *(LAS f32x4*)(hs + rl * HS_LD + cc) = o[e]; }
                u32x2 w; w.x = pack4_fp8(o[0][0], o[0][1], o[0][2], o[0][3]); w.y = pack4_fp8(o[1][0], o[1][1], o[1][2], o[1][3]);
                *(u32x2*)(h2 + (size_t)row * D + j * 512 + c0) = w; } }
        lds_sync();
        { f32x16 a0, a1;
#pragma unroll
          for (int r = 0; r < 16; ++r) { a0[r] = 0.f; a1[r] = 0.f; }
          const LAS float* hp = hs + (lane & 31) * HS_LD + 128 * wid + 2 * (lane >> 5);
#pragma unroll
          for (int s = 0; s < 32; ++s) { const f32x2 a = *(const LAS f32x2*)(hp + 4 * s);
              a0 = __builtin_amdgcn_mfma_f32_32x32x2f32(a[0], wB[2 * s], a0, 0, 0, 0); a1 = __builtin_amdgcn_mfma_f32_32x32x2f32(a[1], wB[2 * s + 1], a1, 0, 0, 0); }
          lds_sync();
#pragma unroll
          for (int r = 0; r < 16; ++r) { const int m = 8 * (r >> 2) + 4 * (lane >> 5) + (r & 3); hs[(wid * 32 + m) * 32 + (lane & 31)] = a0[r] + a1[r]; }
          lds_sync();
#pragma unroll
          for (int q = 0; q < 2; ++q) { const int o = tid + 512 * q; float t = p.b_r[o & 31];
#pragma unroll
              for (int w = 0; w < 8; ++w) t += hs[w * 1024 + o];
              lg[o] = t; } }
        lds_sync();
#pragma unroll
        for (int rep = 0; rep < 2; ++rep) { const int rl = wid * 4 + rep * 2 + (lane >> 5), row = rbase + rl, e = lane & 31; float cur = lg[rl * 32 + e];
            float tv0 = 0.f, sum = 0.f; int sel_i[4]; float sel_e[4];
#pragma unroll
            for (int k = 0; k < 4; ++k) { float m = cur; int mi = e;
#pragma unroll
                for (int o2 = 16; o2 > 0; o2 >>= 1) { const float om = __shfl_xor(m, o2); const int oi = __shfl_xor(mi, o2); if (om > m || (om == m && oi < mi)) { m = om; mi = oi; } }
                if (k == 0) tv0 = m; sel_i[k] = mi; sel_e[k] = __expf(m - tv0); sum += sel_e[k]; if (e == mi) cur = -3.0e38f; }
            int myk = 0; float myp = 0.f;
#pragma unroll
            for (int k = 0; k < 4; ++k) if (e == k) { myk = sel_i[k]; myp = sel_e[k] / sum; }
            if (e < 4) { const int pair = row * 4 + e; topi[pair] = myk; topp[pair] = myp; __hip_atomic_fetch_add(&lcnt[myk], 1, __ATOMIC_RELAXED, __HIP_MEMORY_SCOPE_WORKGROUP); lent[(it * 32 + rl) * 4 + e] = myk; } }
        lds_sync();
        { const int t3 = otid(); if (t3 < 32) { const int n = lcnt[t3]; if (it > 0) lbase[(it - 1) * 32 + t3] = pending; pending = n > 0 ? atomicAdd(&cnt[t3], n) : 0; lcnt[t3] = 0; } }
    }
    const int t2 = otid();
    if (t2 < 32 && it > 0) lbase[(it - 1) * 32 + t2] = pending;
    __syncthreads();
    const int nent = it * 128;
    for (int s = t2; s < nent; s += 512) { const int e = lent[s]; const int ii = s >> 7, rl = (s >> 2) & 31, k = s & 3; const int row = (blockIdx.x + ii * gridDim.x) * 32 + rl;
        const int pos = lbase[ii * 32 + e] + __hip_atomic_fetch_add(&lrun[ii * 32 + e], 1, __ATOMIC_RELAXED, __HIP_MEMORY_SCOPE_WORKGROUP); list[e * CAP + pos] = row * 4 + k; pairpos[row * 4 + k] = pos; }
}
__device__ __forceinline__ void moe_table(const int* cnt, LAS int* tab) {
    if (otid() == 0) { int t = 0; for (int e = 0; e < NE; ++e) { tab[e] = t; const int n = cnt[e]; tab[64 + e] = n; t += (n + 255) >> 8; } tab[32] = t; tab[33] = t; }
    __syncthreads();
    for (int rt = otid(); rt < tab[33]; rt += 512) { int e = 0; while (tab[e + 1] <= rt) ++e; tab[128 + rt] = e; }
    __syncthreads();
}
constexpr int LDS_TAB = pg8::STAGE_BYTES;
__device__ __forceinline__ void phase7(const Params& p, LAS unsigned char* lds) {
    char* ws = p.ws; LAS int* tab = (LAS int*)(lds + LDS_TAB); moe_table((const int*)(ws + OFF_CNT), tab);
    pg8::MoeSched<true> S; S.nN = 8; S.G = gridDim.x; S.c = blockIdx.x; S.rowb = 1024; S.Wt = ws + OFF_WT_GU; S.wexp = (size_t)2048 * 1024; S.btile = (size_t)256 * 1024; S.tab = tab; S.list = (const int*)(ws + OFF_LIST);
    pg8::EpiMoe1 E{(unsigned char*)(ws + OFF_ACT), p.b_gu};
    pg8::gemm_phase<pg8::EpiMoe1, pg8::MoeSched<true>, true, 127, 122>(lds, (const char*)(ws + OFF_H), 1024, S, E);
}
__device__ __forceinline__ void phase8(const Params& p, LAS unsigned char* lds) {
    char* ws = p.ws; LAS int* tab = (LAS int*)(lds + LDS_TAB); moe_table((const int*)(ws + OFF_CNT), tab);
    pg8::MoeSched<false> S; S.nN = 4; S.G = gridDim.x; S.c = blockIdx.x; S.rowb = 1024; S.Wt = ws + OFF_WT_DN; S.wexp = (size_t)1024 * 1024; S.btile = (size_t)256 * 1024; S.tab = tab; S.list = (const int*)(ws + OFF_LIST);
    pg8::EpiMoe2 E{(bf16_t*)(ws + OFF_YP), p.b_dn};
    pg8::gemm_phase<pg8::EpiMoe2, pg8::MoeSched<false>, true, 125, 122>(lds, (const char*)(ws + OFF_ACT), 1024, S, E);
}
__device__ __forceinline__ void phase9(const Params& p, LAS unsigned char* lds) {
    char* ws = p.ws; const float* modv = (const float*)(ws + OFF_MOD); const bf16_t* yp = (const bf16_t*)(ws + OFF_YP); const float* topp = (const float*)(ws + OFF_TOPP);
    const int* topi = (const int*)(ws + OFF_TOPI); const int* pairpos = (const int*)(ws + OFF_ROWPAIR);
    LAS int* tab = (LAS int*)lds; moe_table((const int*)(ws + OFF_CNT), tab);
    const int tid = otid(), lane = tid & 63, gw = blockIdx.x * 8 + (tid >> 6), nw = gridDim.x * 8, c0 = lane * 8;
    f32x4 fg[4];
#pragma unroll
    for (int q = 0; q < 4; ++q) fg[q] = *(const f32x4*)(p.g_fin + (q >> 1) * 512 + c0 + (q & 1) * 4);
    for (int row = gw; row < L; row += nw) {
        const float* gate = modv + (row / SEQ) * 6144 + 5 * 1024; f32x4 v[4]; u32x4 yr[4][2];
        const pg8::i32x4_t ek = *(const pg8::i32x4_t*)(topi + row * 4), pk4 = *(const pg8::i32x4_t*)(pairpos + row * 4);
#pragma unroll
        for (int j = 0; j < 2; ++j) { float t8[8]; unpack8(*(const u32x4*)((const bf16_t*)(ws + OFF_X1) + (size_t)row * D + j * 512 + c0), t8); v[2 * j] = (f32x4){t8[0], t8[1], t8[2], t8[3]}; v[2 * j + 1] = (f32x4){t8[4], t8[5], t8[6], t8[7]}; }
#pragma unroll
        for (int k = 0; k < 4; ++k) { const size_t yrow = (size_t)tab[ek[k]] * 256 + pk4[k];
#pragma unroll
            for (int j = 0; j < 2; ++j) yr[k][j] = __builtin_nontemporal_load((const u32x4*)(yp + yrow * D + j * 512 + c0)); }
        const f32x4 pk = *(const f32x4*)(topp + row * 4);
        float m[16];
#pragma unroll
        for (int i = 0; i < 16; ++i) m[i] = 0.f;
#pragma unroll
        for (int k = 0; k < 4; ++k)
#pragma unroll
            for (int j = 0; j < 2; ++j) { float t[8]; unpack8(yr[k][j], t);
#pragma unroll
                for (int i = 0; i < 8; ++i) m[j * 8 + i] += pk[k] * t[i]; }
        float ss = 0.f;
#pragma unroll
        for (int q = 0; q < 4; ++q) { const f32x4 gt = *(const f32x4*)(gate + (q >> 1) * 512 + c0 + (q & 1) * 4);
#pragma unroll
            for (int i = 0; i < 4; ++i) { v[q][i] += gt[i] * m[q * 4 + i]; ss += v[q][i] * v[q][i]; } }
        const float rs = rsqrtf(wave_sum(ss) * (1.0f / D) + EPS);
#pragma unroll
        for (int q = 0; q < 4; ++q) __builtin_nontemporal_store(v[q] * rs * fg[q], (f32x4*)(p.out + (size_t)row * D + (q >> 1) * 512 + c0 + (q & 1) * 4));
    }
}

namespace at {
using s16x4  = __attribute__((ext_vector_type(4))) short;
constexpr int NW = 8, QBLK = 32, KVBLK = 64, DK = 192, DV = 128;
constexpr float SCALE = 0.07216878364870322f;
constexpr float THR = 8.f;
constexpr int SHM_V = KVBLK * DV * 2, SHM_K = KVBLK * DK * 2, SHM_ATTN = 2 * SHM_V + 2 * SHM_K + NW * 64 * 4;
#define KSWZ(row, colB) ((row) * 384 + ((colB) ^ ((((row) ^ ((row) >> 3)) & 7) << 4)))
#define SBAR() __builtin_amdgcn_sched_barrier(0)
__device__ __forceinline__ int crow(int r, int hi) { return (r & 3) + 8 * (r >> 2) + 4 * hi; }
__device__ __forceinline__ unsigned cvtpk(float lo, float hi) { return cvt_pk_bf16(lo, hi); }

__device__ __forceinline__ void partialSM(f32x16& p0, f32x16& p1, float& m_reg, float& mn, float& alpha) {
  constexpr float C = SCALE * 1.4426950408889634f;
  float pmax = p0[0];
#pragma unroll
  for (int r = 1; r < 16; ++r) pmax = fmaxf(pmax, p0[r]);
#pragma unroll
  for (int r = 0; r < 16; ++r) pmax = fmaxf(pmax, p1[r]);
  { auto rr = __builtin_amdgcn_permlane32_swap(__float_as_uint(pmax), __float_as_uint(pmax), false, false);
    pmax = fmaxf(__uint_as_float(rr[0]), __uint_as_float(rr[1])); }
  if (__builtin_expect(__all(pmax - m_reg <= THR / SCALE), 1)) { mn = m_reg; alpha = 1.f; }
  else { mn = fmaxf(m_reg, pmax); alpha = __builtin_amdgcn_exp2f((m_reg - mn) * C); m_reg = mn; }
  float mnC = -mn * C;
#pragma unroll
  for (int r = 0; r < 16; ++r) p0[r] = fmaf(p0[r], C, mnC);
#pragma unroll
  for (int r = 0; r < 16; ++r) p1[r] = fmaf(p1[r], C, mnC);
#pragma unroll
  for (int r = 0; r < 16; ++r) p0[r] = __builtin_amdgcn_exp2f(p0[r]);
}
__device__ __forceinline__ void finishSM(f32x16& p0, f32x16& p1, float alpha, float& l_reg, bf16x8& pa0, bf16x8& pa1, bf16x8& pa2, bf16x8& pa3) {
#pragma unroll
  for (int r = 0; r < 16; ++r) p1[r] = __builtin_amdgcn_exp2f(p1[r]);
  float ps = 0;
#pragma unroll
  for (int r = 0; r < 16; ++r) ps += p0[r];
#pragma unroll
  for (int r = 0; r < 16; ++r) ps += p1[r];
  { auto rr = __builtin_amdgcn_permlane32_swap(__float_as_uint(ps), __float_as_uint(ps), false, false);
    ps = __uint_as_float(rr[0]) + __uint_as_float(rr[1]); }
  l_reg = l_reg * alpha + ps;
#define PK4(P, BASE, OUT) do { unsigned a0 = cvtpk(P[BASE + 0], P[BASE + 1]), a1 = cvtpk(P[BASE + 2], P[BASE + 3]);   \
    unsigned b0 = cvtpk(P[BASE + 4], P[BASE + 5]), b1 = cvtpk(P[BASE + 6], P[BASE + 7]);                              \
    auto r0 = __builtin_amdgcn_permlane32_swap(a0, b0, false, false); auto r1 = __builtin_amdgcn_permlane32_swap(a1, b1, false, false); \
    u32x4 w = {r0[0], r1[0], r0[1], r1[1]}; OUT = *reinterpret_cast<bf16x8*>(&w); } while (0)
  PK4(p0, 0, pa0); PK4(p0, 8, pa1); PK4(p1, 0, pa2); PK4(p1, 8, pa3);
#undef PK4
}
__device__ __forceinline__ void qkt(f32x16& p0, f32x16& p1, const LAS char* Ks, const bf16x8 (&qr)[12], int r32, int hi) {
  p0 = f32x16{}; p1 = f32x16{};
#pragma unroll
  for (int d0 = 0; d0 < 12; ++d0) { const int cb = (d0 * 16 + hi * 8) * 2;
    const bf16x8 b0 = *reinterpret_cast<const LAS bf16x8*>(Ks + KSWZ(r32, cb));
    const bf16x8 b1 = *reinterpret_cast<const LAS bf16x8*>(Ks + KSWZ(32 + r32, cb));
    p0 = __builtin_amdgcn_mfma_f32_32x32x16_bf16(b0, qr[d0], p0, 0, 0, 0);
    p1 = __builtin_amdgcn_mfma_f32_32x32x16_bf16(b1, qr[d0], p1, 0, 0, 0); }
}
__device__ __forceinline__ int v_st(int k, int c) { const int kk = (k & ~0xC) | ((k & 4) << 1) | ((k & 8) >> 1); return ((kk >> 3) * 4 + (c >> 5)) * 512 + ((kk & 7) * 32 + (c & 31)) * 2; }
__device__ __forceinline__ int v_rd_base(int lane) { return ((lane & 3) << 3) | (((lane >> 2) & 3) << 6) | (((lane >> 4) & 1) << 5) | (((lane >> 5) & 1) << 8); }
constexpr int v_rd_off(int d0, int ks, int half) { return d0 * 512 + ks * 4096 + half * 2048; }
template <int OFF> __device__ __forceinline__ s16x4 tr_read(int vb) { s16x4 r; asm volatile("ds_read_b64_tr_b16 %0, %1 offset:%2" : "=&v"(r) : "v"(vb), "i"(OFF) : "memory"); return r; }
template <int D0> __device__ __forceinline__ void pv_one(f32x16& od, int vb, bf16x8 pa0, bf16x8 pa1, bf16x8 pa2, bf16x8 pa3) {
  const s16x4 l0 = tr_read<v_rd_off(D0, 0, 0)>(vb), h0 = tr_read<v_rd_off(D0, 0, 1)>(vb), l1 = tr_read<v_rd_off(D0, 1, 0)>(vb), h1 = tr_read<v_rd_off(D0, 1, 1)>(vb);
  const s16x4 l2 = tr_read<v_rd_off(D0, 2, 0)>(vb), h2 = tr_read<v_rd_off(D0, 2, 1)>(vb), l3 = tr_read<v_rd_off(D0, 3, 0)>(vb), h3 = tr_read<v_rd_off(D0, 3, 1)>(vb);
  asm volatile("s_waitcnt lgkmcnt(0)" ::: "memory"); SBAR();
#define PK(Lo, Hi) (bf16x8){Lo[0], Lo[1], Lo[2], Lo[3], Hi[0], Hi[1], Hi[2], Hi[3]}
  od = __builtin_amdgcn_mfma_f32_32x32x16_bf16(pa0, PK(l0, h0), od, 0, 0, 0);
  od = __builtin_amdgcn_mfma_f32_32x32x16_bf16(pa1, PK(l1, h1), od, 0, 0, 0);
  od = __builtin_amdgcn_mfma_f32_32x32x16_bf16(pa2, PK(l2, h2), od, 0, 0, 0);
  od = __builtin_amdgcn_mfma_f32_32x32x16_bf16(pa3, PK(l3, h3), od, 0, 0, 0);
#undef PK
}
__device__ __forceinline__ void pv_d0(f32x16 (&o)[4], int vb, bf16x8 pa0, bf16x8 pa1, bf16x8 pa2, bf16x8 pa3) {
  pv_one<0>(o[0], vb, pa0, pa1, pa2, pa3); pv_one<1>(o[1], vb, pa0, pa1, pa2, pa3); pv_one<2>(o[2], vb, pa0, pa1, pa2, pa3); pv_one<3>(o[3], vb, pa0, pa1, pa2, pa3);
}

__device__ __forceinline__ void attn_unit(const bf16_t* __restrict__ Qb, const bf16_t* __restrict__ Kh, const bf16_t* __restrict__ Vh, bf16_t* __restrict__ Ob, int t0, const float* __restrict__ ropet, LAS char* lds) {
  constexpr int LDQ = 1536, LDO = 1024, NT = NKEY / KVBLK;
  const int tid = otid(), wid = tid >> 6, lane = tid & 63, r32 = lane & 31, hi = lane >> 5;
  LAS char* V_lds = lds; LAS char* K_lds = lds + 2 * SHM_V;
  LAS float* wsl = (LAS float*)(lds + 2 * SHM_V + 2 * SHM_K) + wid * 64; LAS float* li_l = wsl; LAS float* al_l = wsl + 32;
  float m_reg = -1e30f, l_reg = 0; f32x16 o[4] = {}; bf16x8 qr[12];
  { const bf16_t* Qw = Qb + (size_t)(wid * QBLK + r32) * LDQ + hi * 8;
#pragma unroll
    for (int d0 = 0; d0 < 12; ++d0) qr[d0] = *reinterpret_cast<const bf16x8*>(Qw + d0 * 16);
    const float* rt = ropet + (size_t)(t0 + wid * QBLK + r32) * 64 + 8 * hi;
#pragma unroll
    for (int g = 0; g < 2; ++g) {
      const f32x4 c0 = *(const f32x4*)(rt + 16 * g), c1 = *(const f32x4*)(rt + 16 * g + 4), s0 = *(const f32x4*)(rt + 32 + 16 * g), s1 = *(const f32x4*)(rt + 32 + 16 * g + 4);
      float n1[8], n2[8];
#pragma unroll
      for (int j = 0; j < 8; ++j) { const float cs = j < 4 ? c0[j & 3] : c1[j & 3], sn = j < 4 ? s0[j & 3] : s1[j & 3];
        const float x1 = bf2f((bf16_t)qr[8 + g][j]), x2 = bf2f((bf16_t)qr[10 + g][j]); n1[j] = x1 * cs - x2 * sn; n2[j] = x1 * sn + x2 * cs; }
      u32x4 w1 = {cvtpk(n1[0], n1[1]), cvtpk(n1[2], n1[3]), cvtpk(n1[4], n1[5]), cvtpk(n1[6], n1[7])}; u32x4 w2 = {cvtpk(n2[0], n2[1]), cvtpk(n2[2], n2[3]), cvtpk(n2[4], n2[5]), cvtpk(n2[6], n2[7])};
      qr[8 + g] = *reinterpret_cast<bf16x8*>(&w1); qr[10 + g] = *reinterpret_cast<bf16x8*>(&w2); } }
  const int sr = tid >> 4, sc = (tid & 15) * 8, vst0 = v_st(sr, sc), vst1 = v_st(32 + sr, sc);
  int kgo[3], kst[3];
#pragma unroll
  for (int i = 0; i < 3; ++i) { const int c = tid + 512 * i, row = c / 24, c8 = (c % 24) * 8; kgo[i] = row * DK + c8; kst[i] = KSWZ(row, c8 * 2); }
  const int vb0 = (int)(uintptr_t)V_lds + v_rd_base(lane);
  bf16x8 sv0, sv1, sk0, sk1, sk2;
#define SLOAD(k0) do { sv0 = *reinterpret_cast<const bf16x8*>(&Vh[(size_t)((k0) + sr) * DV + sc]); sv1 = *reinterpret_cast<const bf16x8*>(&Vh[(size_t)((k0) + 32 + sr) * DV + sc]); \
    sk0 = *reinterpret_cast<const bf16x8*>(&Kh[(size_t)(k0) * DK + kgo[0]]); sk1 = *reinterpret_cast<const bf16x8*>(&Kh[(size_t)(k0) * DK + kgo[1]]); sk2 = *reinterpret_cast<const bf16x8*>(&Kh[(size_t)(k0) * DK + kgo[2]]); } while (0)
#define SWRITE(b) do { *(LAS bf16x8*)(V_lds + (b) * SHM_V + vst0) = sv0; *(LAS bf16x8*)(V_lds + (b) * SHM_V + vst1) = sv1; \
    *(LAS bf16x8*)(K_lds + (b) * SHM_K + kst[0]) = sk0; *(LAS bf16x8*)(K_lds + (b) * SHM_K + kst[1]) = sk1; *(LAS bf16x8*)(K_lds + (b) * SHM_K + kst[2]) = sk2; } while (0)
#define RESC(a) do { if (__any((a) < 1.f)) { if (hi == 0) al_l[r32] = (a); asm volatile("s_waitcnt lgkmcnt(0)" ::: "memory"); \
    _Pragma("unroll") for (int d = 0; d < 4; ++d) _Pragma("unroll") for (int r = 0; r < 16; ++r) o[d][r] *= al_l[crow(r, hi)]; } } while (0)
  f32x16 p0, p1; float mn, al; bf16x8 pa0, pa1, pa2, pa3;
  SLOAD(0); asm volatile("s_waitcnt vmcnt(0)" ::: "memory"); SWRITE(0); __syncthreads();
  for (int j = 0; j < NT; ++j) {
    const int bsel = j & 1;
    if (j + 1 < NT) SLOAD((j + 1) * KVBLK);
    SBAR(); qkt(p0, p1, K_lds + bsel * SHM_K, qr, r32, hi);
    partialSM(p0, p1, m_reg, mn, al);
    RESC(al);
    finishSM(p0, p1, al, l_reg, pa0, pa1, pa2, pa3); SBAR();
    pv_d0(o, vb0 + bsel * SHM_V, pa0, pa1, pa2, pa3);
    if (j + 1 < NT) { asm volatile("s_waitcnt vmcnt(0)" ::: "memory"); SWRITE(bsel ^ 1); }
    __syncthreads();
  }
  if (hi == 0) li_l[r32] = l_reg; asm volatile("s_waitcnt lgkmcnt(0)" ::: "memory");
  float rli[16];
#pragma unroll
  for (int r = 0; r < 16; ++r) rli[r] = __builtin_amdgcn_rcpf(li_l[crow(r, hi)]);
  { LAS bf16_t* ot = (LAS bf16_t*)(lds + wid * 8192);
#pragma unroll
    for (int r = 0; r < 16; ++r) { const int orow = crow(r, hi);
#pragma unroll
      for (int d0 = 0; d0 < 4; ++d0) ot[orow * 128 + d0 * 32 + r32] = f2bf(o[d0][r] * rli[r]); }
    asm volatile("s_waitcnt lgkmcnt(0)" ::: "memory");
    bf16_t* Ow = Ob + (size_t)(wid * QBLK) * LDO;
#pragma unroll
    for (int i = 0; i < 8; ++i) { const int q = lane + 64 * i, row = q >> 4, ch = q & 15; const u32x4 w = *(const LAS u32x4*)(ot + row * 128 + ch * 8); *(u32x4*)(Ow + (size_t)row * LDO + ch * 8) = w; } }
#undef SLOAD
#undef SWRITE
#undef RESC
}
}

__device__ __forceinline__ void phase_attn(const Params& p, LAS unsigned char* lds) {
    char* ws = p.ws; const bf16_t* Q = (const bf16_t*)(ws + OFF_Q); const bf16_t* Kb = (const bf16_t*)(ws + OFF_K); const bf16_t* Vb = (const bf16_t*)(ws + OFF_V); bf16_t* Y = (bf16_t*)(ws + OFF_H);
    const int G = gridDim.x;
    for (int it = 0;; ++it) {
        int u;
        if (G == 256) { const int c = blockIdx.x, xcd = c & 7, j = c >> 3; if (it >= 4) break; u = ((it * 32 + xcd * 4 + (j >> 3)) << 3) | (j & 7); }
        else { u = it * G + blockIdx.x; if (u >= 1024) break; }
        const int bh = u >> 3, qb = u & 7, b = bh >> 3, h = bh & 7;
        at::attn_unit(Q + ((size_t)(b * SEQ + qb * 256)) * 1536 + h * 192, Kb + (size_t)bh * NKEY * 192, Vb + (size_t)bh * NKEY * 128, Y + ((size_t)(b * SEQ + qb * 256)) * D + h * 128, qb * 256, (const float*)(ws + OFF_ROPE), (LAS char*)lds);
        __syncthreads();
    }
}

namespace sc {
using f32x16 = __attribute__((ext_vector_type(16))) float;
constexpr int BUFB = 53248, O_QT = 0, O_KH = 16384, O_VT = 32768, O_AT = 49152, O_DEC = 51200, O_KD = 2 * BUFB, O_OUT = 2 * BUFB + 16384, LDS_SCAN = 2 * BUFB + 16384 + 2 * 16384;
__device__ __forceinline__ int sw256(int row, int cb) { return row * 256 + (cb ^ ((row & 15) << 4)); }
__device__ __forceinline__ int sw128(int row, int cb) { return row * 128 + (cb ^ (((row >> 1) & 7) << 4)); }
__device__ __forceinline__ int grow_of(int n, int b, int dir) { if (n < CTXL) { const int s = dir ? (CTXL - 1 - n) : n; return L + b * CTXL + s; } const int m = n - CTXL; return b * SEQ + (dir ? (SEQ - 1 - m) : m); }
__device__ __forceinline__ bf16x8 pack_acc8(const f32x16& x, int s) { u32x4 p; p.x = cvt_pk_bf16(x[8 * s], x[8 * s + 1]); p.y = cvt_pk_bf16(x[8 * s + 2], x[8 * s + 3]); p.z = cvt_pk_bf16(x[8 * s + 4], x[8 * s + 5]); p.w = cvt_pk_bf16(x[8 * s + 6], x[8 * s + 7]); return __builtin_bit_cast(bf16x8, p); }

__device__ __forceinline__ void scan_unit(const Params& p, int unit, LAS unsigned char* lds) {
    char* ws = p.ws; const int dir = unit & 1, h = (unit >> 1) & 7, b = unit >> 4;
    const bf16_t* hq = (const bf16_t*)(ws + OFF_HQ); const bf16_t* fz = (const bf16_t*)(ws + (dir ? OFF_FB : OFF_FF)); const bf16_t* iv = (const bf16_t*)(ws + OFF_IV);
    bf16_t* outp = (bf16_t*)(ws + (dir ? OFF_OB : OFF_OF)); const float* lb = (const float*)(ws + OFF_LB);
    const int tid = otid(), wid = __builtin_amdgcn_readfirstlane(tid >> 6), lane = tid & 63, r32 = lane & 31, hi = lane >> 5;
    const int sgn = dir ? -1 : 1; const long rstep = (long)sgn * D;
    __syncthreads();
    if (wid >= 4) {
        const int I = wid - 4, cp = lane, hc = h * 128 + 2 * cp;
        const float lbv0 = lb[dir * 1024 + hc], lbv1 = lb[dir * 1024 + hc + 1];
        unsigned zr[16], vr[16], qr[16];
#define SC_LOAD(c) do { const size_t o0_ = (size_t)(grow_of((c) * 64, b, dir) + sgn * (16 * I)) * D + hc; const bf16_t* pz_ = fz + o0_; const bf16_t* pv_ = iv + o0_; const bf16_t* pq_ = hq + o0_; \
        _Pragma("unroll") for (int i = 0; i < 16; ++i) { zr[i] = *(const unsigned*)pz_; pz_ += rstep; vr[i] = *(const unsigned*)pv_; pv_ += rstep; if ((c) >= 4) { qr[i] = *(const unsigned*)pq_; pq_ += rstep; } } } while (0)
        SC_LOAD(0);
        for (int it = 0; it <= 37; ++it) {
            if (it >= 6) {
                const int c = it - 2; const LAS unsigned char* OB = lds + O_OUT + (c & 1) * 16384; const int pt = I * 64 + lane;
                bf16_t* ob = outp + (size_t)grow_of(c * 64, b, dir) * D + h * 128;
#pragma unroll
                for (int q = 0; q < 4; ++q) { const int item = q * 256 + pt, t = item >> 4, c16 = item & 15;
                    *(u32x4*)(ob + (long)t * rstep + c16 * 8) = *(const LAS u32x4*)(OB + t * 256 + c16 * 16); }
            }
            if (it < 36) {
                const int c = it; const bool lat = c >= 4; LAS unsigned char* B = lds + (c & 1) * BUFB; LAS unsigned char* KD = lds + O_KD;
                float kk0[16], kk1[16], lc0[16], lc1[16]; float run0 = 0.f, run1 = 0.f;
#pragma unroll
                for (int i = 0; i < 16; ++i) { const float z0 = __uint_as_float(zr[i] << 16), z1 = __uint_as_float(zr[i] & 0xffff0000u);
                    const float f0 = lbv0 + (1.0f - lbv0) * sigmoidf_(z0), f1 = lbv1 + (1.0f - lbv1) * sigmoidf_(z1); kk0[i] = 1.0f - f0; kk1[i] = 1.0f - f1;
                    run0 += __builtin_amdgcn_logf(f0) * 0.6931471805599453f; run1 += __builtin_amdgcn_logf(f1) * 0.6931471805599453f; lc0[i] = run0; lc1[i] = run1; }
                *(LAS f32x2*)(B + O_DEC + (I * 128 + 2 * cp) * 4) = (f32x2){__expf(run0), __expf(run1)};
                unsigned kh0[8], kh1[8], vt0[8], vt1[8];
#pragma unroll
                for (int i = 0; i < 16; ++i) { const int t = 16 * I + i; const float l0 = lc0[i], l1 = lc1[i];
                    const float kd0 = kk0[i] * __expf(fminf(-l0, 80.0f)), kd1 = kk1[i] * __expf(fminf(-l1, 80.0f));
                    const float kf0 = kk0[i] * __expf(run0 - l0), kf1 = kk1[i] * __expf(run1 - l1);
                    if (lat) { const float q0 = __uint_as_float(qr[i] << 16), q1 = __uint_as_float(qr[i] & 0xffff0000u);
                        *(LAS unsigned*)(B + O_QT + sw256(t, 4 * cp)) = cvt_pk_bf16(q0 * __expf(l0), q1 * __expf(l1)); *(LAS unsigned*)(KD + sw256(t, 4 * cp)) = cvt_pk_bf16(kd0, kd1); }
                    if (i & 1) { kh0[i >> 1] = cvt_pk_bf16(__uint_as_float(kh0[i >> 1]), kf0); kh1[i >> 1] = cvt_pk_bf16(__uint_as_float(kh1[i >> 1]), kf1); vt0[i >> 1] = (vt0[i >> 1] >> 16) | (vr[i] << 16); vt1[i >> 1] = (vt1[i >> 1] >> 16) | (vr[i] & 0xffff0000u); }
                    else { kh0[i >> 1] = __float_as_uint(kf0); kh1[i >> 1] = __float_as_uint(kf1); vt0[i >> 1] = vr[i] << 16; vt1[i >> 1] = vr[i] & 0xffff0000u; } }
#pragma unroll
                for (int q = 0; q < 2; ++q) {
                    *(LAS u32x4*)(B + O_KH + sw128(2 * cp, 32 * I + 16 * q)) = (u32x4){kh0[4 * q], kh0[4 * q + 1], kh0[4 * q + 2], kh0[4 * q + 3]}; *(LAS u32x4*)(B + O_KH + sw128(2 * cp + 1, 32 * I + 16 * q)) = (u32x4){kh1[4 * q], kh1[4 * q + 1], kh1[4 * q + 2], kh1[4 * q + 3]};
                    *(LAS u32x4*)(B + O_VT + sw128(2 * cp, 32 * I + 16 * q)) = (u32x4){vt0[4 * q], vt0[4 * q + 1], vt0[4 * q + 2], vt0[4 * q + 3]}; *(LAS u32x4*)(B + O_VT + sw128(2 * cp + 1, 32 * I + 16 * q)) = (u32x4){vt1[4 * q], vt1[4 * q + 1], vt1[4 * q + 2], vt1[4 * q + 3]}; }
                if (it + 1 < 36) SC_LOAD(it + 1);
                if (lat) {
                    const int l15 = lane & 15, lq = lane >> 4; f32x4 a = {0.f, 0.f, 0.f, 0.f};
#pragma unroll
                    for (int ks = 0; ks < 4; ++ks) { const bf16x8 av = *(const LAS bf16x8*)(B + O_QT + sw256(16 * I + l15, (32 * ks + 8 * lq) * 2)); const bf16x8 bv = *(const LAS bf16x8*)(KD + sw256(16 * I + l15, (32 * ks + 8 * lq) * 2));
                        a = __builtin_amdgcn_mfma_f32_16x16x32_bf16(av, bv, a, 0, 0, 0); }
#pragma unroll
                    for (int r = 0; r < 4; ++r) { const int tl = 4 * lq + r; float v = a[r]; if (l15 > tl) v = 0.f; *(LAS bf16_t*)(B + O_AT + ((I * 16 + tl) * 16 + l15) * 2) = f2bf(v); }
                }
            }
            lds_sync();
        }
#undef SC_LOAD
    } else {
        const int bq = wid; f32x16 S[4];
#pragma unroll
        for (int a = 0; a < 4; ++a) S[a] = f32x16{};
        for (int it = 0; it <= 37; ++it) {
            if (it >= 1 && it <= 36) {
                const int c = it - 1; const bool lat = c >= 4; LAS unsigned char* B = lds + (c & 1) * BUFB;
                LAS bf16_t* po = (LAS bf16_t*)(lds + O_OUT + (c & 1) * 16384) + (4 * hi) * 128 + 32 * bq + r32;
#pragma unroll
                for (int I = 0; I < 4; ++I) {
                    const bf16x8 vtf = *(const LAS bf16x8*)(B + O_VT + sw128(32 * bq + r32, (16 * I + 8 * hi) * 2));
                    if (lat) {
                        f32x16 o = f32x16{};
#pragma unroll
                        for (int a = 0; a < 4; ++a)
#pragma unroll
                            for (int s = 0; s < 2; ++s) { const int dk0 = 32 * a + 16 * s + 4 * hi; const int row = 16 * I + (r32 & 15);
                                const u32x2 lo2 = *(const LAS u32x2*)(B + O_QT + sw256(row, dk0 * 2)), hi2 = *(const LAS u32x2*)(B + O_QT + sw256(row, (dk0 + 8) * 2));
                                const u32x4 av = {lo2.x, lo2.y, hi2.x, hi2.y};
                                o = __builtin_amdgcn_mfma_f32_32x32x16_bf16(__builtin_bit_cast(bf16x8, av), pack_acc8(S[a], s), o, 0, 0, 0); }
                        { const bf16x8 af = *(const LAS bf16x8*)(B + O_AT + ((I * 16 + (r32 & 15)) * 16 + 8 * hi) * 2); o = __builtin_amdgcn_mfma_f32_32x32x16_bf16(af, vtf, o, 0, 0, 0); }
#pragma unroll
                        for (int r = 0; r < 8; ++r) po[(16 * I + (r & 3) + 8 * (r >> 2)) * 128] = f2bf(o[r]);
                    }
#pragma unroll
                    for (int a = 0; a < 4; ++a) {
#pragma unroll
                        for (int g = 0; g < 4; ++g) { const f32x4 dc = *(const LAS f32x4*)(B + O_DEC + (I * 128 + 32 * a + 8 * g + 4 * hi) * 4); S[a][4 * g] *= dc[0]; S[a][4 * g + 1] *= dc[1]; S[a][4 * g + 2] *= dc[2]; S[a][4 * g + 3] *= dc[3]; }
                        const bf16x8 kf = *(const LAS bf16x8*)(B + O_KH + sw128(32 * a + r32, (16 * I + 8 * hi) * 2));
                        S[a] = __builtin_amdgcn_mfma_f32_32x32x16_bf16(kf, vtf, S[a], 0, 0, 0); }
                }
            }
            lds_sync();
        }
    }
    __syncthreads();
}
}
__device__ __forceinline__ void phase_scan(const Params& p, LAS unsigned char* lds) {
    for (int u = blockIdx.x; u < 256; u += gridDim.x) sc::scan_unit(p, u, lds);
}

constexpr int LDS_BYTES = 163840;
#include <cstdint>
#include <cstdlib>
#include <vector>

#define XB_TMO      128
#define XB_XCNT(j)  (256  + 64 * (j))
#define XB_XSUB(j)  (1280 + 64 * (j))
#define XB_XGEN(j)  (2304 + 64 * (j))
#define XB_TOP      3328
#define XB_TOPGEN   3392
#define XCD_BAR_WORDS 3456
#define XB_SPIN_CAP (1u << 18)

__device__ __forceinline__ unsigned xb_ld(unsigned* p)              { return __hip_atomic_load(p, __ATOMIC_RELAXED, __HIP_MEMORY_SCOPE_AGENT); }
__device__ __forceinline__ unsigned xb_add(unsigned* p, unsigned v) { return __hip_atomic_fetch_add(p, v, __ATOMIC_RELAXED, __HIP_MEMORY_SCOPE_AGENT); }
__device__ __forceinline__ unsigned xb_xcc_id() { return (unsigned)__builtin_amdgcn_s_getreg((3 << 11) | 20) & 0xFu; }
#define XB_SPIN(cond, bar) do { unsigned _sp = 0; while (cond) { __builtin_amdgcn_s_sleep(1); \
    if ((++_sp & 255u) == 0u) { if (xb_ld(&(bar)[XB_TMO])) break; if (_sp > XB_SPIN_CAP) { atomicAdd(&(bar)[XB_TMO], 1u); break; } } } } while (0)

struct XcdBarrier {
    unsigned* bar; unsigned x;
    volatile LAS unsigned* st;
};

__device__ __forceinline__ XcdBarrier xcd_barrier_post(unsigned* bar, volatile LAS unsigned* st) {
    XcdBarrier b; b.bar = bar; b.x = xb_xcc_id(); b.st = st;
    if (threadIdx.x == 0) (void)xb_add(&bar[XB_XCNT(b.x)], 1u);
    return b;
}
__device__ __forceinline__ void xcd_barrier_complete(unsigned* bar, unsigned x, unsigned& nloc, unsigned& nx) {
    const unsigned G = gridDim.x * gridDim.y * gridDim.z;
    unsigned sum, cnt, mine, sp = 0u;
    for (;;) {
        sum = 0u; cnt = 0u; mine = 0u;
#pragma unroll
        for (unsigned j = 0; j < 16; ++j) { const unsigned c = xb_ld(&bar[XB_XCNT(j)]); sum += c; cnt += (c > 0u) ? 1u : 0u; mine = (j == x) ? c : mine; }
        if (sum == G) break;
        __builtin_amdgcn_s_sleep(1);
        if ((++sp & 255u) == 0u) { if (xb_ld(&bar[XB_TMO])) break; if (sp > XB_SPIN_CAP) { atomicAdd(&bar[XB_TMO], 1u); break; } }
    }
    nloc = mine > 0u ? mine : 1u; nx = cnt > 0u ? cnt : 1u;
}

__device__ __forceinline__ void xcd_barrier(const XcdBarrier& b) {
    asm volatile("s_waitcnt vmcnt(0)" ::: "memory");
    __syncthreads();
    if (threadIdx.x == 0) {
        unsigned* bar = b.bar;
        __builtin_amdgcn_s_waitcnt(0);
        unsigned nloc = b.st[0], nx = b.st[1];
        if (nloc == 0u) { xcd_barrier_complete(bar, b.x, nloc, nx); b.st[0] = nloc; b.st[1] = nx; }
        const unsigned old = xb_add(&bar[XB_XSUB(b.x)], 1u);
        const unsigned gen = old / nloc;
        if (old + 1u == (gen + 1u) * nloc) {
            __builtin_amdgcn_fence(__ATOMIC_RELEASE, "agent");
            asm volatile("s_waitcnt vmcnt(0)" ::: "memory");
            const unsigned og = xb_add(&bar[XB_TOP], 1u);
            const unsigned tg = og / nx;
            if (og + 1u == (tg + 1u) * nx) xb_add(&bar[XB_TOPGEN], 1u);
            else XB_SPIN(xb_ld(&bar[XB_TOPGEN]) == tg, bar);
            __builtin_amdgcn_fence(__ATOMIC_ACQUIRE, "agent");
            xb_add(&bar[XB_XGEN(b.x)], 1u);
            asm volatile("s_waitcnt vmcnt(0)" ::: "memory");
        } else {
            XB_SPIN(xb_ld(&bar[XB_XGEN(b.x)]) == gen, bar);
            __builtin_amdgcn_fence(__ATOMIC_ACQUIRE, "agent");
            asm volatile("s_waitcnt vmcnt(0)" ::: "memory");
        }
    }
    __syncthreads();
}

__global__ void __launch_bounds__(512, 2) k_mega(Params p) {
    extern __shared__ __attribute__((aligned(16))) unsigned char smem[];
    LAS unsigned char* lds = (LAS unsigned char*)smem;
    volatile LAS unsigned* xbw = (volatile LAS unsigned*)(lds + LDS_BYTES - 16);
    if (threadIdx.x == 0) { xbw[0] = 0u; xbw[1] = 0u; xbw[2] = 0u; xbw[3] = 0u; }
    __syncthreads();
    XcdBarrier bar = xcd_barrier_post((unsigned*)(p.ws + OFF_BAR), xbw);
    phase0(p, lds);      xcd_barrier(bar);
    phase1(p, lds);      xcd_barrier(bar);
    phase2(p, lds);      xcd_barrier(bar);
    phase3(p, lds);      xcd_barrier(bar);
    phase_attn(p, lds);
    phase_scan(p, lds);  xcd_barrier(bar);
    phase4(p, lds);      xcd_barrier(bar);
    phase5(p, lds);      xcd_barrier(bar);
    phase6(p, lds);      xcd_barrier(bar);
    phase7(p, lds);      xcd_barrier(bar);
    phase8(p, lds);      xcd_barrier(bar);
    phase9(p, lds);
}
extern "C" void kernel_launch(void* const* d_in, const int* in_sizes, int n_in, void* d_out, int out_size, void* d_ws, size_t ws_size, hipStream_t stream) {
    static int grid = 0;
    if (grid == 0) {
        int dev = 0, cus = 0, per_cu = 0;
        if (hipGetDevice(&dev) != hipSuccess || hipDeviceGetAttribute(&cus, hipDeviceAttributeMultiprocessorCount, dev) != hipSuccess) { grid = -1; return; }
        if (hipFuncSetAttribute((const void*)k_mega, hipFuncAttributeMaxDynamicSharedMemorySize, LDS_BYTES) != hipSuccess) { grid = -1; return; }
        (void)hipOccupancyMaxActiveBlocksPerMultiprocessor(&per_cu, (const void*)k_mega, 512, LDS_BYTES);
        (void)hipGetLastError();
        grid = cus;
    }
    if (grid < 0) return;
    Params p{};
    p.x = (const float*)d_in[0]; p.c = (const float*)d_in[1]; p.ctx = (const float*)d_in[2]; p.cctx = (const float*)d_in[3]; p.w_mod = (const float*)d_in[4]; p.b_mod = (const float*)d_in[5];
    p.g_mix = (const float*)d_in[6]; p.w_in = (const float*)d_in[7]; p.g_q = (const float*)d_in[8]; p.w_qb = (const float*)d_in[9]; p.g_kv = (const float*)d_in[10]; p.w_kvb = (const float*)d_in[11];
    p.lbl = (const float*)d_in[12]; p.g_hg = (const float*)d_in[13]; p.w_out = (const float*)d_in[14]; p.g_ffn = (const float*)d_in[15]; p.w_r = (const float*)d_in[16]; p.b_r = (const float*)d_in[17];
    p.w_gu = (const float*)d_in[18]; p.b_gu = (const float*)d_in[19]; p.w_dn = (const float*)d_in[20]; p.b_dn = (const float*)d_in[21]; p.g_fin = (const float*)d_in[22];
    p.out = (float*)d_out; p.ws = (char*)d_ws;
    (void)hipMemsetAsync((char*)d_ws + OFF_BAR, 0, 16384, stream);
    hipLaunchKernelGGL(k_mega, dim3(grid), dim3(512), LDS_BYTES, stream, p);
}
```

```cpp
#include <hip/hip_runtime.h>
#include <stdint.h>

typedef unsigned short bf16_t;
__device__ __forceinline__ float bf2f(bf16_t v) { return __uint_as_float(((unsigned)v) << 16); }
__device__ __forceinline__ bf16_t f2bf(float f) { unsigned u = __float_as_uint(f); u += 0x7FFFu + ((u >> 16) & 1u); return (bf16_t)(u >> 16); }
__device__ __forceinline__ float sigmoidf_(float x) { return __builtin_amdgcn_rcpf(1.0f + __builtin_amdgcn_exp2f(-1.4426950408889634f * x)); }
__device__ __forceinline__ float siluf_(float x) { return x * __builtin_amdgcn_rcpf(1.0f + __builtin_amdgcn_exp2f(-1.4426950408889634f * x)); }

constexpr int D = 1024, NB = 16, SEQ = 2048, CTXL = 256;
constexpr int L = NB * SEQ;
constexpr int RC = NB * CTXL;
constexpr int R = L + RC;
constexpr int NKEY = SEQ + CTXL;
constexpr float EPS = 1e-6f;
constexpr int NE = 32, CAP = 32768;
constexpr int MAXROWS = 131072 + NE * 256;

constexpr size_t MiB = 1048576;
constexpr size_t OFF_SMALL = 0;
constexpr size_t OFF_BAR = 0;
constexpr size_t OFF_CNT = 16384;
constexpr size_t OFF_OFFS = 16384 + 1024;
constexpr size_t OFF_TILEE = 16384 + 2048;
constexpr size_t OFF_LB = 24576;
constexpr size_t OFF_MOD = 32768;
constexpr size_t OFF_SSQQ = 512 * 1024;
constexpr size_t OFF_SSQKV = 768 * 1024;
constexpr size_t OFF_TOPI = 1 * MiB;
constexpr size_t OFF_TOPP = 1 * MiB + 512 * 1024;
constexpr size_t OFF_ROWPAIR = 2 * MiB;
constexpr size_t OFF_LIST = 3 * MiB;
constexpr size_t OFF_H = 32 * MiB;
constexpr size_t OFF_QA = 104 * MiB;
constexpr size_t OFF_CKV = 152 * MiB;
constexpr size_t OFF_KR = 170 * MiB;
constexpr size_t OFF_OF = 104 * MiB;
constexpr size_t OFF_HQ = 175 * MiB;
constexpr size_t SEG_STRIDE = 72 * MiB;
constexpr size_t OFF_FF = OFF_HQ + 1 * SEG_STRIDE;
constexpr size_t OFF_FB = OFF_HQ + 2 * SEG_STRIDE;
constexpr size_t OFF_IV = OFF_HQ + 3 * SEG_STRIDE;
constexpr size_t OFF_OG = OFF_HQ + 4 * SEG_STRIDE;
constexpr size_t OFF_GM = OFF_HQ + 5 * SEG_STRIDE;
constexpr size_t OFF_GH = OFF_HQ + 6 * SEG_STRIDE;
constexpr size_t OFF_Q = 679 * MiB;
constexpr size_t OFF_K = 775 * MiB;
constexpr size_t OFF_V = 883 * MiB;
constexpr size_t OFF_OB = 955 * MiB;
constexpr size_t OFF_YP = 296 * MiB;
constexpr size_t OFF_ACT = 568 * MiB;


__device__ __forceinline__ void rope_cs(int t, int i, float& cs, float& sn) {
    int j = i & 15; float inv = __expf(-(float)j * (9.210340371976184f / 16.0f)); float pos = (i < 16) ? (float)(t >> 6) : (float)(t & 63);
    float ang = pos * inv; cs = cosf(ang); sn = sinf(ang);
}

#define LAS __attribute__((address_space(3)))
__device__ __forceinline__ int otid() { int t = threadIdx.x; asm volatile("" : "+v"(t)); return t; }
typedef short bf16x8 __attribute__((ext_vector_type(8)));
typedef float f32x4 __attribute__((ext_vector_type(4)));
typedef unsigned u32x4 __attribute__((ext_vector_type(4)));
typedef unsigned u32x2 __attribute__((ext_vector_type(2)));
typedef float f32x2 __attribute__((ext_vector_type(2)));
using f32x16 = __attribute__((ext_vector_type(16))) float;

constexpr size_t OFF_ROPE = 7 * MiB;
constexpr size_t OFF_WT_IN = 8 * MiB;
constexpr size_t OFF_WT_QB = 25 * MiB;
constexpr size_t OFF_WT_KVB = 28 * MiB;
constexpr size_t OFF_WT_OUT = 29 * MiB;
constexpr size_t OFF_WT_GU = 104 * MiB;
constexpr size_t OFF_WT_DN = 232 * MiB;
constexpr size_t OFF_YF8 = 775 * MiB;
constexpr size_t OFF_X1 = 704 * MiB;

struct Params {
    const float *x, *c, *ctx, *cctx, *w_mod, *b_mod, *g_mix, *w_in, *g_q, *w_qb, *g_kv, *w_kvb, *lbl, *g_hg, *w_out, *g_ffn, *w_r, *b_r, *w_gu, *b_gu, *w_dn, *b_dn, *g_fin;
    float* out; char* ws;
};

typedef __bf16 bf16v2_t __attribute__((ext_vector_type(2)));
__device__ __forceinline__ unsigned cvt_pk_bf16(float lo, float hi) { bf16v2_t v = {(__bf16)lo, (__bf16)hi}; return __builtin_bit_cast(unsigned, v); }

__device__ __forceinline__ unsigned pack4_fp8(float a, float b, float c, float d) {
    a = __builtin_amdgcn_fmed3f(a, -448.f, 448.f); b = __builtin_amdgcn_fmed3f(b, -448.f, 448.f); c = __builtin_amdgcn_fmed3f(c, -448.f, 448.f); d = __builtin_amdgcn_fmed3f(d, -448.f, 448.f);
    unsigned w = 0; w = __builtin_amdgcn_cvt_pk_fp8_f32(a, b, w, false); w = __builtin_amdgcn_cvt_pk_fp8_f32(c, d, w, true); return w; }

namespace pg8 {
constexpr int BM = 256, BK = 64, HALF = 128, HTB = HALF * BK * 2, STAGE_BYTES = 8 * HTB, NXCD = 8, WGM = 8;
constexpr int LDS_IDX = STAGE_BYTES + 8192;
__device__ __forceinline__ int lds_byte(int r, int c) { const int st = (r >> 4) * 2 + (c >> 5), rr = r & 15, cc = c & 31, ob = rr * 64 + cc * 2; return st * 1024 + (ob ^ (((ob >> 9) & 1) << 5)); }
__device__ __forceinline__ void stage_rc(int b, int& R, int& C) { const int st = b / 1024, sb = b % 1024, swz = sb ^ (((sb >> 9) & 1) << 5); R = (st >> 1) * 16 + swz / 64; C = (st & 1) * 32 + (swz % 64) / 2; }
__device__ __forceinline__ int perm32(int rho) { const int n = rho >> 4, i = rho & 15; return 8 * (i >> 2) + 4 * n + (i & 3); }
struct Unit { int pm, pn; const char* b; int e, pos0, cnt; };

__device__ __forceinline__ int xcd_remap(int L, int nwg) { const int q = nwg / NXCD, r = nwg % NXCD, xcd = L % NXCD, off = L / NXCD; return (xcd < r ? xcd * (q + 1) : r * (q + 1) + (xcd - r) * q) + off; }

struct DenseSched {
    int nM, nN, nwg, G, c, rowb; const char* Bt; size_t btile;
    __device__ void init(int M, int N, int kbytes, int rowb_, const void* Bt_, int G_, int c_) { nM = M / BM; nN = N / BM; nwg = nM * nN; G = G_; c = c_; rowb = rowb_; Bt = (const char*)Bt_; btile = (size_t)BM * kbytes; }
    static constexpr bool GATHER_LDS = false;
    __device__ __forceinline__ int kstepA() const { return 128; }
    __device__ __forceinline__ void tile(int wgid, int& pm, int& pn) const { const int nig = WGM * nN, gid = wgid / nig, fm = gid * WGM, gsz = (nM - fm) < WGM ? (nM - fm) : WGM; pm = fm + ((wgid % nig) % gsz); pn = (wgid % nig) / gsz; }
    __device__ __forceinline__ bool next(int i, Unit& u) const { const int Lx = i * G + c; if (Lx >= nwg) return false; tile(xcd_remap(Lx, nwg), u.pm, u.pn); u.b = Bt + (size_t)u.pn * btile; u.e = 0; u.pos0 = 0; u.cnt = 0; return true; }
    __device__ __forceinline__ void aoff(const Unit& u, const int (&Rr)[2], const int (&Cc)[2], unsigned (&va)[2][2]) const {
#pragma unroll
        for (int h = 0; h < 2; ++h)
#pragma unroll
            for (int i = 0; i < 2; ++i) va[h][i] = (unsigned)((u.pm * BM + h * HALF + Rr[i]) * rowb + Cc[i] * 2); }
};
struct InSched : DenseSched {
    __device__ void init2(const void* Bt_, int G_, int c_) { init(L, 8448, 1024, 1024, Bt_, G_, c_); }
    __device__ __forceinline__ bool next(int i, Unit& u) const {
        const int Lx = i * G + c; const int nlat = nwg;
        if (Lx < nlat) { tile(xcd_remap(Lx, nlat), u.pm, u.pn); }
        else { const int j = Lx - nlat; if (j >= 16 * 14) return false; const int q = j >> 4; u.pm = 128 + (j & 15); u.pn = q == 0 ? 3 : (q <= 12 ? 7 + q : 32); }
        u.b = Bt + (size_t)u.pn * btile; u.e = 0; u.pos0 = 0; u.cnt = 0; return true; }
};
__device__ __forceinline__ unsigned act_piece_off(int r, int c16) { const int s = 2 * (r >> 7) + (c16 >> 2), w = 4 * ((r >> 6) & 1) + (c16 & 3), l = 16 * ((r >> 4) & 3) + (r & 15); return (unsigned)(((s * 8 + w) * 64 + l) * 16); }
template <bool GATHER> struct MoeSched {
    int nN, G, c, rowb; const char* Wt; size_t wexp, btile; const LAS int* tab; const int* list;
    static constexpr bool GATHER_LDS = GATHER;
    __device__ __forceinline__ int kstepA() const { return GATHER ? 128 : 32768; }
    __device__ __forceinline__ bool next(int i, Unit& u) const {
        const int nwg = tab[33] * nN; const int Lx = i * G + c; if (Lx >= nwg) return false;
        const int w = xcd_remap(Lx, nwg); const int rt = w / nN; u.pn = w % nN; u.pm = rt;
        const int e = tab[128 + rt];
        u.e = e; u.pos0 = (rt - tab[e]) * BM; u.cnt = tab[64 + e]; u.b = Wt + (size_t)e * wexp + (size_t)u.pn * btile; return true; }
    __device__ __forceinline__ void aoff(const Unit& u, const int (&Rr)[2], const int (&Cc)[2], unsigned (&va)[2][2]) const {
#pragma unroll
        for (int h = 0; h < 2; ++h)
#pragma unroll
            for (int i = 0; i < 2; ++i) {
                if (GATHER) { const int pos = u.pos0 + h * HALF + Rr[i]; const int pair = pos < u.cnt ? list[u.e * CAP + pos] : 0; va[h][i] = (unsigned)((pair >> 2) * rowb + Cc[i] * 2); }
                else va[h][i] = (unsigned)u.pm * 262144u + act_piece_off(h * HALF + Rr[i], Cc[i] >> 3); } }
};

typedef int v8i_t __attribute__((ext_vector_type(8)));
typedef int i32x4_t __attribute__((ext_vector_type(4)));
template <class Epi, class Sched, bool FP8 = false, int SCA = 127, int SCB = 127>
__device__ __forceinline__ void gemm_phase(LAS unsigned char* lds, const char* Abase, const int K, const Sched& S, const Epi& E) {
    const int tid = otid(), wid = __builtin_amdgcn_readfirstlane(tid >> 6), lane = tid & 63, wr = wid >> 2, wc = wid & 3, fr = lane & 15, fq = lane >> 4;
    const int Kb = FP8 ? K : 2 * K;
    const int nt = Kb / (BK * 2);
    int Rr[2], Cc[2]; unsigned voffB[2];
#pragma unroll
    for (int i = 0; i < 2; ++i) { int R_, C_; stage_rc(tid * 16 + i * 8192, R_, C_); Rr[i] = R_; Cc[i] = C_; const int Rb = 64 * (R_ >> 5) + (Epi::PERM ? perm32(R_ & 31) : (R_ & 31)); voffB[i] = (unsigned)(Rb * Kb + C_ * 2); }
    const size_t kstep = (size_t)(BK * 2);
    const size_t kstepA = (size_t)S.kstepA();
    const size_t hstep = (size_t)32 * Kb;
    const unsigned ldsw = (unsigned)wid * 1024u;
    const int aoff = lds_byte(wr * 64 + fr, fq * 8), boff = lds_byte(wc * 32 + fr, fq * 8);
#define PG8_SA(b, h) (((b) * 2 + (h)) * HTB)
#define PG8_SB(b, h) ((4 + (b) * 2 + (h)) * HTB)
#define PG8_STAGE_B(bufoff, gbase) do { _Pragma("unroll") for (int _i = 0; _i < 2; ++_i) \
        __builtin_amdgcn_global_load_lds((const unsigned*)((const char*)(gbase) + voffB[_i]), (LAS unsigned*)(lds + (bufoff) + ldsw + _i * 8192), 16, 0, 0); } while (0)
#define PG8_STAGE_A(bufoff, v0, v1, kb) do { \
        __builtin_amdgcn_global_load_lds((const unsigned*)(Abase + (kb) + (v0)), (LAS unsigned*)(lds + (bufoff) + ldsw), 16, 0, 0); \
        __builtin_amdgcn_global_load_lds((const unsigned*)(Abase + (kb) + (v1)), (LAS unsigned*)(lds + (bufoff) + ldsw + 8192), 16, 0, 0); } while (0)
#define PG8_LD16(addr) (*(const LAS i32x4_t*)(addr))
#define PG8_LDA(dst, b, h) do { _Pragma("unroll") for (int m = 0; m < 4; ++m) { if constexpr (FP8) dst##8[m] = __builtin_shufflevector(PG8_LD16(lds + PG8_SA(b, h) + aoff + m * 2048), PG8_LD16(lds + PG8_SA(b, h) + aoff + m * 2048 + 1024), 0, 1, 2, 3, 4, 5, 6, 7); \
        else { _Pragma("unroll") for (int k = 0; k < 2; ++k) dst[m][k] = *(const LAS bf16x8*)(lds + PG8_SA(b, h) + aoff + m * 2048 + k * 1024); } } } while (0)
#define PG8_LDB(dst, b, h) do { _Pragma("unroll") for (int n = 0; n < 2; ++n) { if constexpr (FP8) dst##8[n] = __builtin_shufflevector(PG8_LD16(lds + PG8_SB(b, h) + boff + n * 2048), PG8_LD16(lds + PG8_SB(b, h) + boff + n * 2048 + 1024), 0, 1, 2, 3, 4, 5, 6, 7); \
        else { _Pragma("unroll") for (int k = 0; k < 2; ++k) dst[n][k] = *(const LAS bf16x8*)(lds + PG8_SB(b, h) + boff + n * 2048 + k * 1024); } } } while (0)
#define PG8_MMA(ai, bj, At, Bt) do { __builtin_amdgcn_s_setprio(1); _Pragma("unroll") for (int m = 0; m < 4; ++m) _Pragma("unroll") for (int n = 0; n < 2; ++n) { \
        if constexpr (FP8) asm volatile("v_mfma_scale_f32_16x16x128_f8f6f4 %0, %1, %2, %0, %3, %4 op_sel_hi:[0,0,0]" : "+v"(acc[ai][bj][m][n]) : "v"(Bt##8[n]), "v"(At##8[m]), "v"(scb_), "v"(sca_)); \
        else { _Pragma("unroll") for (int k = 0; k < 2; ++k) acc[ai][bj][m][n] = __builtin_amdgcn_mfma_f32_16x16x32_bf16(Bt[n][k], At[m][k], acc[ai][bj][m][n], 0, 0, 0); } } \
        __builtin_amdgcn_s_setprio(0); } while (0)
#define PG8_WAIT_V(n) asm volatile("s_waitcnt vmcnt(" #n ")" ::: "memory")
#define PG8_WAIT_L(n) asm volatile("s_waitcnt lgkmcnt(" #n ")" ::: "memory")
#define PG8_BAR __builtin_amdgcn_s_barrier()
#define PG8_SCHED __builtin_amdgcn_sched_barrier(0)
    Unit cur, nxt; int ui = 0;
    if (!S.next(0, cur)) return;
    f32x4 acc[2][2][4][2];
#pragma unroll
    for (int a = 0; a < 2; ++a)
#pragma unroll
        for (int b = 0; b < 2; ++b)
#pragma unroll
            for (int m = 0; m < 4; ++m)
#pragma unroll
                for (int n = 0; n < 2; ++n) acc[a][b][m][n] = (f32x4){0.f, 0.f, 0.f, 0.f};
    const int sca_ = SCA, scb_ = SCB;
    bf16x8 At[4][2], B0[2][2], B1[2][2]; v8i_t At8[4], B08[2], B18[2];
    unsigned vc[2][2], vn[2][2];
    S.aoff(cur, Rr, Cc, vc);
    const char* cB = cur.b;
    PG8_STAGE_B(PG8_SB(0, 0), cB); PG8_STAGE_A(PG8_SA(0, 0), vc[0][0], vc[0][1], 0); PG8_STAGE_B(PG8_SB(0, 1), cB + hstep); PG8_STAGE_A(PG8_SA(0, 1), vc[1][0], vc[1][1], 0);
    PG8_STAGE_B(PG8_SB(1, 0), cB + kstep); PG8_STAGE_A(PG8_SA(1, 0), vc[0][0], vc[0][1], kstepA); PG8_STAGE_B(PG8_SB(1, 1), cB + hstep + kstep);
    PG8_WAIT_V(6); PG8_BAR;
    if (wr == 1) PG8_BAR;
    for (;;) {
        const bool has_next = S.next(ui + 1, nxt);
        if constexpr (Sched::GATHER_LDS) {
            if (has_next && wid < 4) __builtin_amdgcn_global_load_lds((const unsigned*)(S.list + nxt.e * CAP + nxt.pos0 + otid()), (LAS unsigned*)(lds + LDS_IDX + wid * 256), 4, 0, 0);
        } else if (has_next) S.aoff(nxt, Rr, Cc, vn);
        if (!has_next) {
#pragma unroll
            for (int h = 0; h < 2; ++h)
#pragma unroll
                for (int i = 0; i < 2; ++i) vn[h][i] = vc[h][i]; }
        const char* nB = has_next ? nxt.b : cB;
#pragma unroll 1
        for (int t = 0; t < nt; t += 2) {
            const bool last = (t == nt - 2);
            if constexpr (Sched::GATHER_LDS) { if (last && has_next) {
#pragma unroll
                for (int h = 0; h < 2; ++h)
#pragma unroll
                    for (int i = 0; i < 2; ++i) { const int rr = h * HALF + Rr[i]; const int pair = (nxt.pos0 + rr) < nxt.cnt ? ((const LAS int*)(lds + LDS_IDX))[rr] : 0; vn[h][i] = (unsigned)((pair >> 2) * S.rowb + Cc[i] * 2); } } }
            const size_t k1 = (size_t)(t + 1) * kstepA;
            const size_t k2 = last ? 0 : (size_t)(t + 2) * kstepA;
            const unsigned s00 = last ? vn[0][0] : vc[0][0], s01 = last ? vn[0][1] : vc[0][1], s10 = last ? vn[1][0] : vc[1][0], s11 = last ? vn[1][1] : vc[1][1];
            const char* b2 = last ? nB : cB + (size_t)(t + 2) * kstep; const char* b3 = b2 + kstep;
            PG8_LDB(B0, 0, 0); PG8_LDB(B1, 0, 1); PG8_SCHED; PG8_LDA(At, 0, 0); PG8_STAGE_A(PG8_SA(1, 1), vc[1][0], vc[1][1], k1);
            PG8_WAIT_L(0); PG8_BAR; PG8_MMA(0, 0, At, B0); PG8_MMA(0, 1, At, B1); PG8_BAR; PG8_SCHED;
            PG8_LDA(At, 0, 1); PG8_SCHED; PG8_STAGE_B(PG8_SB(0, 0), b2); PG8_SCHED; PG8_STAGE_A(PG8_SA(0, 0), s00, s01, k2); PG8_SCHED; PG8_STAGE_B(PG8_SB(0, 1), b2 + hstep);
            PG8_WAIT_L(0); PG8_WAIT_V(6); PG8_BAR; PG8_MMA(1, 0, At, B0); PG8_MMA(1, 1, At, B1); PG8_BAR; PG8_SCHED;
            PG8_LDB(B0, 1, 0); PG8_LDB(B1, 1, 1); PG8_SCHED; PG8_LDA(At, 1, 0); PG8_STAGE_A(PG8_SA(0, 1), s10, s11, k2);
            PG8_WAIT_L(0); PG8_BAR; PG8_MMA(0, 0, At, B0); PG8_MMA(0, 1, At, B1); PG8_BAR; PG8_SCHED;
            PG8_LDA(At, 1, 1); PG8_SCHED; PG8_STAGE_B(PG8_SB(1, 0), b3); PG8_SCHED; PG8_STAGE_A(PG8_SA(1, 0), s00, s01, k2 + kstepA); PG8_SCHED; PG8_STAGE_B(PG8_SB(1, 1), b3 + hstep);
            PG8_WAIT_L(0); PG8_WAIT_V(6); PG8_BAR; PG8_MMA(1, 0, At, B0); PG8_MMA(1, 1, At, B1); PG8_BAR; PG8_SCHED;
        }
        if constexpr (FP8) asm volatile("s_nop 15\n\ts_nop 15" ::: "memory");
        E(acc, cur, wr, wc, fr, fq);
        if (!has_next) break;
#pragma unroll
        for (int a = 0; a < 2; ++a)
#pragma unroll
            for (int b = 0; b < 2; ++b)
#pragma unroll
                for (int m = 0; m < 4; ++m)
#pragma unroll
                    for (int n = 0; n < 2; ++n) acc[a][b][m][n] = (f32x4){0.f, 0.f, 0.f, 0.f};
        cur = nxt; cB = nB; ++ui;
#pragma unroll
        for (int h = 0; h < 2; ++h)
#pragma unroll
            for (int i = 0; i < 2; ++i) vc[h][i] = vn[h][i];
    }
    PG8_WAIT_V(0);
    if (wr == 0) PG8_BAR;
    PG8_BAR;
#undef PG8_SA
#undef PG8_SB
#undef PG8_STAGE_A
#undef PG8_STAGE_B
#undef PG8_LDA
#undef PG8_LDB
#undef PG8_MMA
#undef PG8_WAIT_V
#undef PG8_WAIT_L
#undef PG8_BAR
#undef PG8_SCHED
}

typedef f32x4 Acc[2][2][4][2];
__device__ __forceinline__ unsigned dpp_ror8(unsigned x) { return (unsigned)__builtin_amdgcn_update_dpp(0, (int)x, 0x128, 0xf, 0xf, false); }
__device__ __forceinline__ u32x4 ror8_4(const u32x4 v) { u32x4 r; r.x = dpp_ror8(v.x); r.y = dpp_ror8(v.y); r.z = dpp_ror8(v.z); r.w = dpp_ror8(v.w); return r; }
__device__ __forceinline__ void line_xy(const u32x4 a, const u32x4 b, bool lo, u32x4& X, u32x4& Y) { const u32x4 ra = ror8_4(a), rb = ror8_4(b); X = lo ? a : rb; Y = lo ? ra : b; }
__device__ __forceinline__ u32x4 pack8(const f32x4 v0, const f32x4 v1) { u32x4 w; w.x = cvt_pk_bf16(v0[0], v0[1]); w.y = cvt_pk_bf16(v0[2], v0[3]); w.z = cvt_pk_bf16(v1[0], v1[1]); w.w = cvt_pk_bf16(v1[2], v1[3]); return w; }

struct EpiIn { static constexpr bool PERM = true; char* ws;
    __device__ __forceinline__ void operator()(const Acc& acc, const Unit& u, int wr, int wc, int fr, int fq) const {
        const int pn = u.pn; size_t boff; int ld, cb;
        if (pn < 3) { boff = OFF_QA; ld = 384; cb = pn * 128; } else if (pn == 3) { boff = OFF_CKV; ld = 256; cb = 0; }
        else if (pn < 32) { boff = OFF_HQ + (size_t)((pn - 4) >> 2) * SEG_STRIDE; ld = 1024; cb = ((pn - 4) & 3) * 256; }
        else { boff = OFF_KR; ld = 64; cb = 0; }
        bf16_t* base = (bf16_t*)(ws + boff);
        if (pn == 32 && wc != 0) return;
        const bool lo = fr < 8; const int rowb0 = u.pm * BM + wr * 64, rx = fr & 7, colx = cb + wc * 64 + (fr >> 3) * 32 + 8 * fq;
        float* ssq = (float*)(ws + (pn < 3 ? OFF_SSQQ : OFF_SSQKV));
#pragma unroll
        for (int ai = 0; ai < 2; ++ai)
#pragma unroll
            for (int m = 0; m < 4; ++m) { const int rg = rowb0 + ai * HALF + m * 16;
                f32x4 v0 = acc[ai][0][m][0], v1 = acc[ai][0][m][1], w0 = acc[ai][1][m][0], w1 = acc[ai][1][m][1];
                if (pn >= 4 && pn < 8) {
#pragma unroll
                    for (int j = 0; j < 4; ++j) { v0[j] = siluf_(v0[j]) * 0.08838834764831845f; v1[j] = siluf_(v1[j]) * 0.08838834764831845f; w0[j] = siluf_(w0[j]) * 0.08838834764831845f; w1[j] = siluf_(w1[j]) * 0.08838834764831845f; } }
                if (pn < 3 || (pn >= 20 && pn < 32)) { unsigned char* qrow = pn < 3 ? (unsigned char*)base + (size_t)(rg + fr) * 768 + pn * 256 + wc * 64 + 8 * fq : (unsigned char*)base + (size_t)(rg + fr) * 1024 + (pn & 3) * 256 + wc * 64 + 8 * fq;
                    u32x2 a8; a8.x = pack4_fp8(v0[0], v0[1], v0[2], v0[3]); a8.y = pack4_fp8(v1[0], v1[1], v1[2], v1[3]); u32x2 b8; b8.x = pack4_fp8(w0[0], w0[1], w0[2], w0[3]); b8.y = pack4_fp8(w1[0], w1[1], w1[2], w1[3]);
                    *(u32x2*)qrow = a8; *(u32x2*)(qrow + 32) = b8; }
                else { u32x4 X, Y; line_xy(pack8(v0, v1), pack8(w0, w1), lo, X, Y);
                    __builtin_nontemporal_store(X, (u32x4*)(base + (size_t)(rg + rx) * ld + colx)); __builtin_nontemporal_store(Y, (u32x4*)(base + (size_t)(rg + 8 + rx) * ld + colx)); }
                if (pn <= 3) { float ss = (v0[0] * v0[0] + v0[1] * v0[1]) + (v0[2] * v0[2] + v0[3] * v0[3]) + (v1[0] * v1[0] + v1[1] * v1[1]) + (v1[2] * v1[2] + v1[3] * v1[3])
                                        + (w0[0] * w0[0] + w0[1] * w0[1]) + (w0[2] * w0[2] + w0[3] * w0[3]) + (w1[0] * w1[0] + w1[1] * w1[1]) + (w1[2] * w1[2] + w1[3] * w1[3]);
                    ss += __shfl_xor(ss, 16); ss += __shfl_xor(ss, 32); if (fq == 0) atomicAdd(ssq + rg + fr, ss); } }
    } };

struct EpiQ { static constexpr bool PERM = true; bf16_t* q; const float* ssq;
    __device__ __forceinline__ void operator()(const Acc& acc, const Unit& u, int wr, int wc, int fr, int fq) const {
        const bool lo = fr < 8; const int rowb0 = u.pm * BM + wr * 64, rx = fr & 7, colx = u.pn * BM + wc * 64 + (fr >> 3) * 32 + 8 * fq;
#pragma unroll
        for (int ai = 0; ai < 2; ++ai)
#pragma unroll
            for (int m = 0; m < 4; ++m) { const int rg = rowb0 + ai * HALF + m * 16; const float rs = rsqrtf(ssq[rg + fr] * (1.0f / 768.0f) + EPS);
                u32x4 X, Y; line_xy(pack8(acc[ai][0][m][0] * rs, acc[ai][0][m][1] * rs), pack8(acc[ai][1][m][0] * rs, acc[ai][1][m][1] * rs), lo, X, Y);
                *(u32x4*)(q + (size_t)(rg + rx) * 1536 + colx) = X; *(u32x4*)(q + (size_t)(rg + 8 + rx) * 1536 + colx) = Y; }
    } };

struct EpiKV { static constexpr bool PERM = true; bf16_t *Kb, *Vb; const float* ssq;
    __device__ __forceinline__ size_t kvrow(int row, int h) const { int b, pos; if (row < L) { b = row >> 11; pos = row & 2047; } else { b = (row - L) >> 8; pos = SEQ + ((row - L) & 255); } return (size_t)(b * 8 + h) * NKEY + pos; }
    __device__ __forceinline__ void operator()(const Acc& acc, const Unit& u, int wr, int wc, int fr, int fq) const {
        const bool lo = fr < 8; const int rowb0 = u.pm * BM + wr * 64, rx = fr & 7, colx = (wc & 1) * 64 + (fr >> 3) * 32 + 8 * fq;
        bf16_t* dst = wc < 2 ? Kb : Vb; const int ld = wc < 2 ? 192 : 128;
#pragma unroll
        for (int ai = 0; ai < 2; ++ai)
#pragma unroll
            for (int m = 0; m < 4; ++m) { const int rg = rowb0 + ai * HALF + m * 16; const float rs = rsqrtf(ssq[rg + fr] * (1.0f / 256.0f) + EPS);
                u32x4 X, Y; line_xy(pack8(acc[ai][0][m][0] * rs, acc[ai][0][m][1] * rs), pack8(acc[ai][1][m][0] * rs, acc[ai][1][m][1] * rs), lo, X, Y);
                *(u32x4*)(dst + kvrow(rg + rx, u.pn) * ld + colx) = X; *(u32x4*)(dst + kvrow(rg + 8 + rx, u.pn) * ld + colx) = Y; }
    } };

struct EpiOut { static constexpr bool PERM = true; bf16_t* x1; const float* x; const float* modv;
    __device__ __forceinline__ void operator()(const Acc& acc, const Unit& u, int wr, int wc, int fr, int fq) const {
        const bool lo = fr < 8; const int rowb0 = u.pm * BM + wr * 64, rx = fr & 7, colx = u.pn * BM + wc * 64 + (fr >> 3) * 32 + 8 * fq, cown = u.pn * BM + wc * 64 + 8 * fq;
#pragma unroll
        for (int ai = 0; ai < 2; ++ai)
#pragma unroll
            for (int m = 0; m < 4; ++m) { const int rg = rowb0 + ai * HALF + m * 16, row = rg + fr; const float* gate = modv + (row >> 11) * 6144 + 2 * 1024 + cown; const float* xr = x + (size_t)row * D + cown;
                f32x4 r[2][2];
#pragma unroll
                for (int bj = 0; bj < 2; ++bj)
#pragma unroll
                    for (int n = 0; n < 2; ++n) r[bj][n] = *(const f32x4*)(xr + bj * 32 + 4 * n) + *(const f32x4*)(gate + bj * 32 + 4 * n) * acc[ai][bj][m][n];
                u32x4 X, Y; line_xy(pack8(r[0][0], r[0][1]), pack8(r[1][0], r[1][1]), lo, X, Y);
                *(u32x4*)(x1 + (size_t)(rg + rx) * D + colx) = X; *(u32x4*)(x1 + (size_t)(rg + 8 + rx) * D + colx) = Y; }
    } };

struct EpiMoe1 { static constexpr bool PERM = true; unsigned char* act; const float* bgu;
    __device__ __forceinline__ void operator()(const Acc& acc, const Unit& u, int wr, int wc, int fr, int fq) const {
        const int o0 = u.pn * 128 + wc * 16 + 4 * fq;
        f32x4 bg[2], bl[2];
#pragma unroll
        for (int bj = 0; bj < 2; ++bj) { const float* bp = bgu + u.e * 2048 + 2 * (o0 + bj * 64); const f32x4 t0 = *(const f32x4*)bp, t1 = *(const f32x4*)(bp + 4);
            bg[bj] = (f32x4){t0[0], t0[2], t1[0], t1[2]}; bl[bj] = (f32x4){t0[1], t0[3], t1[1], t1[3]}; }
        unsigned char* blk = act + ((size_t)u.pm * 8 + u.pn) * 32768 + (size_t)(wr * 4 + wc) * 1024 + (size_t)(fq * 16 + fr) * 16;
#pragma unroll
        for (int ai = 0; ai < 2; ++ai)
#pragma unroll
            for (int bj = 0; bj < 2; ++bj) { unsigned d[4];
#pragma unroll
                for (int m = 0; m < 4; ++m) { const f32x4 g4 = acc[ai][bj][m][0] + bg[bj], l4 = acc[ai][bj][m][1] + bl[bj]; float r[4];
#pragma unroll
                    for (int j = 0; j < 4; ++j) { const float glu = fminf(g4[j], 7.0f), lin = __builtin_amdgcn_fmed3f(l4[j], -7.0f, 7.0f); r[j] = 4.0f * glu * __builtin_amdgcn_rcpf(1.0f + __builtin_amdgcn_exp2f(-2.4554669595930157f * glu)) * (lin + 1.0f); }
                    d[m] = pack4_fp8(r[0], r[1], r[2], r[3]); }
                const auto s01 = __builtin_amdgcn_permlane16_swap(d[0], d[1], false, false); const auto s23 = __builtin_amdgcn_permlane16_swap(d[2], d[3], false, false);
                const auto t02 = __builtin_amdgcn_permlane32_swap(s01[0], s23[0], false, false); const auto t13 = __builtin_amdgcn_permlane32_swap(s01[1], s23[1], false, false);
                *(u32x4*)(blk + (size_t)(ai * 2 + bj) * 8192) = (u32x4){t02[0], t13[0], t02[1], t13[1]}; }
    } };

struct EpiMoe2 { static constexpr bool PERM = true; bf16_t* yp; const float* bd;
    __device__ __forceinline__ void operator()(const Acc& acc, const Unit& u, int wr, int wc, int fr, int fq) const {
        const bool lo = fr < 8; const int rowb0 = u.pm * BM + wr * 64, rx = fr & 7, colx = u.pn * BM + wc * 64 + (fr >> 3) * 32 + 8 * fq, cown = u.pn * BM + wc * 64 + 8 * fq;
        f32x4 bv[2][2];
#pragma unroll
        for (int bj = 0; bj < 2; ++bj)
#pragma unroll
            for (int n = 0; n < 2; ++n) bv[bj][n] = *(const f32x4*)(bd + u.e * 1024 + cown + bj * 32 + 4 * n);
#pragma unroll
        for (int ai = 0; ai < 2; ++ai)
#pragma unroll
            for (int m = 0; m < 4; ++m) { const int rg = rowb0 + ai * HALF + m * 16;
                u32x4 X, Y; line_xy(pack8(acc[ai][0][m][0] + bv[0][0], acc[ai][0][m][1] + bv[0][1]), pack8(acc[ai][1][m][0] + bv[1][0], acc[ai][1][m][1] + bv[1][1]), lo, X, Y);
                __builtin_nontemporal_store(X, (u32x4*)(yp + (size_t)(rg + rx) * D + colx)); __builtin_nontemporal_store(Y, (u32x4*)(yp + (size_t)(rg + 8 + rx) * D + colx)); }
    } };
}

__device__ __forceinline__ int conv_src_col(int kind, int c) {
    if (kind == 0) return c;
    if (kind == 1) { if (c < 1024) return c; if (c < 8192) return c + 64; if (c < 8256) return c - 8192 + 1024; return -1; }
    const int pn = c >> 8, p = c & 255, wc = p >> 6, bj = (p >> 5) & 1, fq = (p >> 3) & 3, n = (p >> 2) & 1, i = p & 3; const int o = 128 * pn + 64 * bj + 16 * wc + 4 * fq + i; return 2 * o + n;
}
__device__ __forceinline__ void lds_sync() { asm volatile("s_waitcnt lgkmcnt(0)\n\ts_barrier" ::: "memory"); }
template <bool F8> struct ConvPipe {
    float v[32]; bool have; bf16_t* dummy;
    int K, kind, k0, c0; void* Wt;
    __device__ __forceinline__ void issue(const float* __restrict__ W, int ldw, void* Wt_, int K_, int kind_, const float* __restrict__ kscale, int k0_, int c0_) {
        const int tid = otid(); const int cc = tid & 127, kq = tid >> 7, sc = conv_src_col(kind_, c0_ + cc);
        const int scc = sc < 0 ? 0 : sc; const float* wp = W + (size_t)(k0_ + kq) * ldw + scc;
#pragma unroll
        for (int i = 0; i < 32; ++i) v[i] = __builtin_nontemporal_load(wp + (size_t)(4 * i) * ldw);
        if (sc < 0) {
#pragma unroll
            for (int i = 0; i < 32; ++i) v[i] = 0.f; }
        if (kscale) {
#pragma unroll
            for (int i = 0; i < 32; ++i) v[i] *= kscale[k0_ + kq + 4 * i]; }
        K = K_; kind = kind_; k0 = k0_; c0 = c0_; Wt = Wt_; have = true;
    }
    __device__ __forceinline__ void flush(LAS float* tl) {
        if (!have) return; have = false;
        const int tid = otid(); const int cc = tid & 127, kq = tid >> 7;
        __syncthreads();
#pragma unroll
        for (int i = 0; i < 32; ++i) tl[(kq + 4 * i) * 129 + cc] = v[i];
        __syncthreads();
        stash(tl, tid);
    }
    __device__ __forceinline__ void to_lds(LAS float* tl) { const int tid = otid(); const int cc = tid & 127, kq = tid >> 7; lds_sync();
#pragma unroll
        for (int i = 0; i < 32; ++i) tl[(kq + 4 * i) * 129 + cc] = v[i];
        lds_sync(); }
    __device__ __forceinline__ void stash(LAS float* tl, int tid) const {
        if constexpr (F8) {
#pragma unroll
            for (int pss = 0; pss < 2; ++pss) { const int item = tid + 512 * pss, c2 = item >> 3, ch = item & 7; float t[16];
#pragma unroll
                for (int j = 0; j < 16; ++j) t[j] = tl[(16 * ch + j) * 129 + c2] * 32.f;
                u32x4 w; w.x = pack4_fp8(t[0], t[1], t[2], t[3]); w.y = pack4_fp8(t[4], t[5], t[6], t[7]); w.z = pack4_fp8(t[8], t[9], t[10], t[11]); w.w = pack4_fp8(t[12], t[13], t[14], t[15]);
                *(u32x4*)((unsigned char*)Wt + (size_t)(c0 + c2) * K + k0 + 16 * ch) = w; }
        } else {
#pragma unroll
            for (int pss = 0; pss < 4; ++pss) { const int item = tid + 512 * pss, c2 = item >> 4, ch = item & 15; float t[8];
#pragma unroll
                for (int j = 0; j < 8; ++j) t[j] = tl[(8 * ch + j) * 129 + c2];
                u32x4 w; w.x = cvt_pk_bf16(t[0], t[1]); w.y = cvt_pk_bf16(t[2], t[3]); w.z = cvt_pk_bf16(t[4], t[5]); w.w = cvt_pk_bf16(t[6], t[7]);
                *(u32x4*)((bf16_t*)Wt + (size_t)(c0 + c2) * K + k0 + 8 * ch) = w; }
        }
    }
};
template <bool F8>
__device__ __forceinline__ void conv_matrix(LAS float* tl, ConvPipe<F8>& pipe, const float* W, int ldw, void* Wt, int K, int Nout, int kind, const float* kscale, int& tctr) {
    const int nk = K / 128, ntile = nk * (Nout / 128);
    int t = ((int)blockIdx.x - tctr) % (int)gridDim.x; if (t < 0) t += gridDim.x;
    for (; t < ntile; t += gridDim.x) {
        if (pipe.have) { pipe.to_lds(tl); const int K0 = pipe.K, k00 = pipe.k0, c00 = pipe.c0; void* W0 = pipe.Wt; ConvPipe<F8> done = pipe; (void)K0; (void)k00; (void)c00; (void)W0;
            pipe.issue(W, ldw, Wt, K, kind, kscale, (t % nk) * 128, (t / nk) * 128); done.stash(tl, otid()); }
        else pipe.issue(W, ldw, Wt, K, kind, kscale, (t % nk) * 128, (t / nk) * 128);
    }
    tctr = (tctr + ntile) % (int)gridDim.x;
}
template <bool F8> __device__ __forceinline__ void conv_finish(LAS float* tl, ConvPipe<F8>& pipe) { if (pipe.have) { pipe.to_lds(tl); pipe.stash(tl, otid()); pipe.have = false; } __syncthreads(); }

__device__ __forceinline__ float half_sum256(float v, LAS float* red) {
    for (int o = 32; o > 0; o >>= 1) v += __shfl_xor(v, o);
    const int w = otid() >> 6, hb = (otid() >> 8) * 4; if ((otid() & 63) == 0) red[w] = v; __syncthreads();
    const float t = red[hb] + red[hb + 1] + red[hb + 2] + red[hb + 3]; __syncthreads(); return t;
}

__device__ __forceinline__ void phase0(const Params& p, LAS unsigned char* lds) {
    char* ws = p.ws; const int tid = otid(), gsz = gridDim.x * 512, gid = blockIdx.x * 512 + tid;
    float* lb = (float*)(ws + OFF_LB); int* cnt = (int*)(ws + OFF_CNT); float* ssqq = (float*)(ws + OFF_SSQQ); float* ssqkv = (float*)(ws + OFF_SSQKV); float* modv = (float*)(ws + OFF_MOD);
    for (int i = gid; i < 2048; i += gsz) { const int d = i >> 10, j = i & 1023; const float a = p.lbl[(d * 2 + 0) * 1024 + j], b = p.lbl[(d * 2 + 1) * 1024 + j]; lb[i] = 1.0f / (1.0f + __expf(b - a)); }
    for (int i = gid; i < 32; i += gsz) cnt[i] = 0;
    { float* ropet = (float*)(ws + OFF_ROPE); for (int i = gid; i < SEQ * 32; i += gsz) { const int t = i >> 5, j = i & 31; float cs, sn; rope_cs(t, j, cs, sn); ropet[t * 64 + j] = cs; ropet[t * 64 + 32 + j] = sn; } }
    for (int i = gid; i < L; i += gsz) ssqq[i] = 0.f;
    for (int i = gid; i < R; i += gsz) ssqkv[i] = 0.f;
    { LAS float* sil = (LAS float*)lds;
      LAS float* part = (LAS float*)(lds + 17 * 1024 * 4);
      bool loaded = false;
      for (int item = blockIdx.x; item < 192; item += gridDim.x) {
          if (!loaded) { for (int i = tid; i < 17 * 1024; i += 512) { const int r = i >> 10, k = i & 1023; sil[i] = siluf_(r < 16 ? p.c[r * 1024 + k] : p.cctx[k]); } loaded = true; __syncthreads(); }
          const int j = tid & 31, ks = tid >> 5; float a[17];
#pragma unroll
          for (int r = 0; r < 17; ++r) a[r] = 0.f;
#pragma unroll 4
          for (int k = ks * 64; k < ks * 64 + 64; ++k) { const float w = p.w_mod[(size_t)k * 6144 + item * 32 + j];
#pragma unroll
              for (int r = 0; r < 17; ++r) a[r] += sil[r * 1024 + k] * w; }
#pragma unroll
          for (int r = 0; r < 17; ++r) part[(ks * 17 + r) * 32 + j] = a[r];
          __syncthreads();
          for (int i = tid; i < 17 * 32; i += 512) { const int r = i >> 5, jj = i & 31; float s = p.b_mod[item * 32 + jj]; for (int q = 0; q < 16; ++q) s += part[(q * 17 + r) * 32 + jj]; modv[r * 6144 + item * 32 + jj] = s; }
          __syncthreads();
      } }
    __syncthreads();
    { LAS float* tl = (LAS float*)lds; int tctr = 0;
      { ConvPipe<true> pp; pp.have = false; conv_matrix<true>(tl, pp, p.w_in, 8256, (unsigned char*)(ws + OFF_WT_IN), 1024, 8448, 1, nullptr, tctr); conv_finish<true>(tl, pp); }
      { ConvPipe<true> pp; pp.have = false;
        conv_matrix<true>(tl, pp, p.w_qb, 1536, (unsigned char*)(ws + OFF_WT_QB), 768, 1536, 0, p.g_q, tctr);
        conv_matrix<true>(tl, pp, p.w_out, 1024, (unsigned char*)(ws + OFF_WT_OUT), 1024, 1024, 0, nullptr, tctr); conv_finish<true>(tl, pp); }
      { ConvPipe<false> pp; pp.have = false;
        conv_matrix<false>(tl, pp, p.w_kvb, 2048, (bf16_t*)(ws + OFF_WT_KVB), 256, 2048, 0, p.g_kv, tctr); conv_finish<false>(tl, pp); } }
}

__device__ __forceinline__ float wave_sum(float v) {
#pragma unroll
    for (int o = 32; o > 0; o >>= 1) v += __shfl_xor(v, o);
    return v; }
__device__ __forceinline__ void phase1(const Params& p, LAS unsigned char* lds) {
    const float* modv = (const float*)(p.ws + OFF_MOD); unsigned char* h = (unsigned char*)(p.ws + OFF_H);
    const int tid = otid(), lane = tid & 63, gw = blockIdx.x * 8 + (tid >> 6), nw = gridDim.x * 8, c0 = lane * 8;
    f32x4 g[4];
#pragma unroll
    for (int q = 0; q < 4; ++q) g[q] = *(const f32x4*)(p.g_mix + (q >> 1) * 512 + c0 + (q & 1) * 4);
    for (int row0 = gw; row0 < R; row0 += 4 * nw) {
        f32x4 v[4][4];
#pragma unroll
        for (int u = 0; u < 4; ++u) { const int row = row0 + u * nw < R ? row0 + u * nw : row0; const float* src = row < L ? p.x + (size_t)row * D : p.ctx + (size_t)(row - L) * D;
#pragma unroll
            for (int q = 0; q < 4; ++q) v[u][q] = __builtin_nontemporal_load((const f32x4*)(src + (q >> 1) * 512 + c0 + (q & 1) * 4)); }
#pragma unroll
        for (int u = 0; u < 4; ++u) { if (row0 + u * nw >= R) break; const int row = row0 + u * nw; const float* mod = modv + (row < L ? row / SEQ : 16) * 6144;
            float ss = 0.f;
#pragma unroll
            for (int q = 0; q < 4; ++q) ss += (v[u][q][0] * v[u][q][0] + v[u][q][1] * v[u][q][1]) + (v[u][q][2] * v[u][q][2] + v[u][q][3] * v[u][q][3]);
            const float rs = rsqrtf(wave_sum(ss) * (1.0f / D) + EPS);
#pragma unroll
            for (int j = 0; j < 2; ++j) { f32x4 o[2];
#pragma unroll
                for (int e = 0; e < 2; ++e) { const int cc = j * 512 + c0 + e * 4; const f32x4 sc = *(const f32x4*)(mod + 1024 + cc), sh = *(const f32x4*)(mod + cc); o[e] = v[u][j * 2 + e] * rs * g[j * 2 + e] * (sc + 1.0f) + sh; }
                u32x2 w; w.x = pack4_fp8(o[0][0], o[0][1], o[0][2], o[0][3]); w.y = pack4_fp8(o[1][0], o[1][1], o[1][2], o[1][3]);
                *(u32x2*)(h + (size_t)row * D + j * 512 + c0) = w; } }
    }
}


__device__ __forceinline__ void phase2(const Params& p, LAS unsigned char* lds) {
    pg8::InSched S; S.init2(p.ws + OFF_WT_IN, gridDim.x, blockIdx.x);
    pg8::EpiIn E{p.ws};
    pg8::gemm_phase<pg8::EpiIn, pg8::InSched, true, 127, 122>(lds, (const char*)(p.ws + OFF_H), 1024, S, E);
}
__device__ __forceinline__ void phase3(const Params& p, LAS unsigned char* lds) {
    char* ws = p.ws;
    { pg8::DenseSched S; S.init(L, 1536, 768, 768, ws + OFF_WT_QB, gridDim.x, blockIdx.x); pg8::EpiQ E{(bf16_t*)(ws + OFF_Q), (const float*)(ws + OFF_SSQQ)}; pg8::gemm_phase<pg8::EpiQ, pg8::DenseSched, true, 127, 122>(lds, (const char*)(ws + OFF_QA), 768, S, E); }
    { pg8::DenseSched S; S.init(R, 2048, 256 * 2, 256 * 2, ws + OFF_WT_KVB, gridDim.x, blockIdx.x); pg8::EpiKV E{(bf16_t*)(ws + OFF_K), (bf16_t*)(ws + OFF_V), (const float*)(ws + OFF_SSQKV)}; pg8::gemm_phase(lds, (const char*)(ws + OFF_CKV), 256, S, E); }
    { const bf16_t* kr = (const bf16_t*)(ws + OFF_KR); bf16_t* Kb = (bf16_t*)(ws + OFF_K); const float* ropet = (const float*)(ws + OFF_ROPE);
      for (int gid = blockIdx.x * 512 + otid(); gid < R * 32; gid += gridDim.x * 512) { const int row = gid >> 5, i = gid & 31;
          const float x1 = bf2f(kr[(size_t)row * 64 + i]), x2 = bf2f(kr[(size_t)row * 64 + 32 + i]); float o1 = x1, o2 = x2; int b, pos;
          if (row < L) { b = row / SEQ; pos = row % SEQ; const float cs = ropet[pos * 64 + i], sn = ropet[pos * 64 + 32 + i]; o1 = x1 * cs - x2 * sn; o2 = x1 * sn + x2 * cs; } else { b = (row - L) / CTXL; pos = SEQ + (row - L) % CTXL; }
          const bf16_t w1 = f2bf(o1), w2 = f2bf(o2);
          for (int h = 0; h < 8; ++h) { bf16_t* q = Kb + ((size_t)(b * 8 + h) * NKEY + pos) * 192 + 128; q[i] = w1; q[32 + i] = w2; } } }
}
__device__ __forceinline__ void unpack8_fp8(const u32x2 w, float (&o)[8]) {
    o[0] = __builtin_amdgcn_cvt_f32_fp8((int)w.x, 0); o[1] = __builtin_amdgcn_cvt_f32_fp8((int)w.x, 1); o[2] = __builtin_amdgcn_cvt_f32_fp8((int)w.x, 2); o[3] = __builtin_amdgcn_cvt_f32_fp8((int)w.x, 3);
    o[4] = __builtin_amdgcn_cvt_f32_fp8((int)w.y, 0); o[5] = __builtin_amdgcn_cvt_f32_fp8((int)w.y, 1); o[6] = __builtin_amdgcn_cvt_f32_fp8((int)w.y, 2); o[7] = __builtin_amdgcn_cvt_f32_fp8((int)w.y, 3); }
__device__ __forceinline__ void unpack8(const u32x4 w, float (&o)[8]) {
    o[0] = __uint_as_float(w.x << 16); o[1] = __uint_as_float(w.x & 0xffff0000u); o[2] = __uint_as_float(w.y << 16); o[3] = __uint_as_float(w.y & 0xffff0000u);
    o[4] = __uint_as_float(w.z << 16); o[5] = __uint_as_float(w.z & 0xffff0000u); o[6] = __uint_as_float(w.w << 16); o[7] = __uint_as_float(w.w & 0xffff0000u); }
__device__ __forceinline__ void phase4(const Params& p, LAS unsigned char*) {
    char* ws = p.ws; bf16_t* y = (bf16_t*)(ws + OFF_H); const bf16_t* of = (const bf16_t*)(ws + OFF_OF); const bf16_t* ob = (const bf16_t*)(ws + OFF_OB);
    const unsigned char* og = (const unsigned char*)(ws + OFF_OG); const unsigned char* gm = (const unsigned char*)(ws + OFF_GM); const unsigned char* gh = (const unsigned char*)(ws + OFF_GH);
    const int tid = otid(), lane = tid & 63, gw = blockIdx.x * 8 + (tid >> 6), nw = gridDim.x * 8, c0 = lane * 8;
    float gg[8];
#pragma unroll
    for (int i = 0; i < 8; ++i) gg[i] = p.g_hg[(c0 + i) & 127];
    for (int row0 = gw; row0 < L; row0 += 2 * nw) {
        u32x4 ra[2][2], rb[2][2], rm[2][2]; u32x2 r1[2][2], r2[2][2], r3[2][2];
#pragma unroll
        for (int u = 0; u < 2; ++u) { const int row = row0 + u * nw < L ? row0 + u * nw : row0;
#pragma unroll
        for (int j = 0; j < 2; ++j) { const size_t off = (size_t)row * D + j * 512 + c0; ra[u][j] = __builtin_nontemporal_load((const u32x4*)(of + off)); rb[u][j] = __builtin_nontemporal_load((const u32x4*)(ob + off)); r1[u][j] = __builtin_nontemporal_load((const u32x2*)(og + off)); r2[u][j] = __builtin_nontemporal_load((const u32x2*)(gm + off)); r3[u][j] = __builtin_nontemporal_load((const u32x2*)(gh + off)); rm[u][j] = __builtin_nontemporal_load((const u32x4*)(y + off)); } }
#pragma unroll
        for (int u = 0; u < 2; ++u) { const int row = row0 + u * nw; if (row >= L) break;
#pragma unroll
        for (int j = 0; j < 2; ++j) { float a[8], b[8], g1[8], g2[8], g3[8], ym[8], o[8]; unpack8(ra[u][j], a); unpack8(rb[u][j], b); unpack8_fp8(r1[u][j], g1); unpack8_fp8(r2[u][j], g2); unpack8_fp8(r3[u][j], g3); unpack8(rm[u][j], ym);
            float ss = 0.f;
#pragma unroll
            for (int i = 0; i < 8; ++i) { o[i] = a[i] + b[i]; ss += o[i] * o[i]; }
            ss += __shfl_xor(ss, 1); ss += __shfl_xor(ss, 2); ss += __shfl_xor(ss, 4); ss += __shfl_xor(ss, 8);
            const float rs = rsqrtf(ss * (1.0f / 128.0f) + EPS); float r[8];
#pragma unroll
            for (int i = 0; i < 8; ++i) { const float yh = o[i] * rs * gg[i] * siluf_(g1[i]); r[i] = sigmoidf_(g2[i]) * ym[i] + sigmoidf_(g3[i]) * yh; }
            u32x2 w; w.x = pack4_fp8(r[0], r[1], r[2], r[3]); w.y = pack4_fp8(r[4], r[5], r[6], r[7]);
            *(u32x2*)((unsigned char*)(ws + OFF_YF8) + (size_t)row * D + j * 512 + c0) = w; } }
    }
}

#define MC_TIE16(v, o) asm volatile("" : "+v"(v[o+0]), "+v"(v[o+1]), "+v"(v[o+2]), "+v"(v[o+3]), "+v"(v[o+4]), "+v"(v[o+5]), "+v"(v[o+6]), "+v"(v[o+7]), "+v"(v[o+8]), "+v"(v[o+9]), "+v"(v[o+10]), "+v"(v[o+11]), "+v"(v[o+12]), "+v"(v[o+13]), "+v"(v[o+14]), "+v"(v[o+15]))
__device__ __forceinline__ void mc_issue(const Params& p, int idx, float (&v)[32]) {
    const int tid = otid(); const int cc = tid & 127, kq = tid >> 7; const float* base; unsigned voff, vstep;
    if (idx < 4096) { const int e = idx >> 7, r = idx & 127; base = p.w_gu + (size_t)e * 1024 * 2048; voff = (unsigned)(((r & 7) * 128 + kq) * 2048 + conv_src_col(2, (r >> 3) * 128 + cc)) * 4u; vstep = 4u * 2048u * 4u; }
    else { const int j = idx - 4096, e = j >> 6, r = j & 63; base = p.w_dn + (size_t)e * 1024 * 1024; voff = (unsigned)(((r & 7) * 128 + kq) * 1024 + (r >> 3) * 128 + cc) * 4u; vstep = 4u * 1024u * 4u; }
#pragma unroll
    for (int i = 0; i < 32; ++i) { asm volatile("global_load_dword %0, %1, %2 nt" : "=v"(v[i]) : "v"(voff), "s"(base) : "memory"); voff += vstep; }
}
__device__ __forceinline__ void mc_stash(const Params& p, int idx, const LAS float* tl) {
    unsigned char* dst;
    if (idx < 4096) { const int e = idx >> 7, r = idx & 127; dst = (unsigned char*)(p.ws + OFF_WT_GU) + (size_t)e * 2048 * 1024 + (size_t)((r >> 3) * 128) * 1024 + (r & 7) * 128; }
    else { const int j = idx - 4096, e = j >> 6, r = j & 63; dst = (unsigned char*)(p.ws + OFF_WT_DN) + (size_t)e * 1024 * 1024 + (size_t)((r >> 3) * 128) * 1024 + (r & 7) * 128; }
    const int tid = otid();
#pragma unroll
    for (int pss = 0; pss < 2; ++pss) { const int item = tid + 512 * pss, c2 = item >> 3, ch = item & 7; float t[16];
#pragma unroll
        for (int j = 0; j < 16; ++j) t[j] = tl[(16 * ch + j) * 129 + c2] * 32.f;
        u32x4 w; w.x = pack4_fp8(t[0], t[1], t[2], t[3]); w.y = pack4_fp8(t[4], t[5], t[6], t[7]); w.z = pack4_fp8(t[8], t[9], t[10], t[11]); w.w = pack4_fp8(t[12], t[13], t[14], t[15]);
        *(u32x4*)(dst + (size_t)c2 * 1024 + 16 * ch) = w; }
}
__device__ __forceinline__ void mc_step(const Params& p, float (&v)[32], LAS float* tl, int i, int n, int stride, int wmode) {
    const int tid = otid(); const int cc = tid & 127, kq = tid >> 7; const int idx = (int)blockIdx.x + i * stride;
    if (wmode == 3) asm volatile("s_waitcnt vmcnt(36)" ::: "memory"); else if (wmode == 2) asm volatile("s_waitcnt vmcnt(34)" ::: "memory"); else if (wmode == 1) asm volatile("s_waitcnt vmcnt(32)" ::: "memory"); else asm volatile("s_waitcnt vmcnt(0)" ::: "memory");
    MC_TIE16(v, 0); MC_TIE16(v, 16);
#pragma unroll
    for (int q = 0; q < 32; ++q) tl[(kq + 4 * q) * 129 + cc] = v[q];
    lds_sync();
    if (i + 2 < n) mc_issue(p, idx + 2 * stride, v);
    mc_stash(p, idx, tl);
}
__device__ __forceinline__ void moe_conv(const Params& p, LAS unsigned char* lds) {
    LAS float* t0 = (LAS float*)lds; LAS float* t1 = t0 + 128 * 129;
    const int stride = gridDim.x, n = (6144 - (int)blockIdx.x + stride - 1) / stride;
    float va[32], vb[32];
#pragma unroll
    for (int q = 0; q < 32; ++q) { va[q] = 0.f; vb[q] = 0.f; }
    lds_sync();
    if (n >= 4) {
        mc_issue(p, (int)blockIdx.x, va); mc_issue(p, (int)blockIdx.x + stride, vb);
        mc_step(p, va, t0, 0, n, stride, 1); mc_step(p, vb, t1, 1, n, stride, 2);
#pragma unroll 1
        for (int i = 2; i < n; i += 2) { mc_step(p, va, t0, i, n, stride, i == n - 1 ? 0 : 3); if (i + 1 < n) mc_step(p, vb, t1, i + 1, n, stride, i + 1 == n - 1 ? 0 : 3); }
    } else {
        for (int i = 0; i < n; ++i) { mc_issue(p, (int)blockIdx.x + i * stride, va); mc_step(p, va, t0, i, 0, stride, 0); lds_sync(); }
    }
    __syncthreads();
}
__device__ __forceinline__ void phase5(const Params& p, LAS unsigned char* lds) {
    char* ws = p.ws;
    { pg8::DenseSched S; S.init(L, 1024, 1024, 1024, ws + OFF_WT_OUT, gridDim.x, blockIdx.x); pg8::EpiOut E{(bf16_t*)(ws + OFF_X1), p.x, (const float*)(ws + OFF_MOD)}; pg8::gemm_phase<pg8::EpiOut, pg8::DenseSched, true, 127, 122>(lds, (const char*)(ws + OFF_YF8), 1024, S, E); }
    moe_conv(p, lds);
}
__device__ __forceinline__ void phase6(const Params& p, LAS unsigned char* lds) {
    char* ws = p.ws; const float* modv = (const float*)(ws + OFF_MOD); unsigned char* h2 = (unsigned char*)(ws + OFF_H); int* topi = (int*)(ws + OFF_TOPI); float* topp = (float*)(ws + OFF_TOPP); int* cnt = (int*)(ws + OFF_CNT); int* list = (int*)(ws + OFF_LIST); int* pairpos = (int*)(ws + OFF_ROWPAIR);
    constexpr int HS_LD = 1028, HS_BYTES = 32 * HS_LD * 4;
    LAS float* hs = (LAS float*)lds;
    LAS float* lg = (LAS float*)(lds + HS_BYTES);
    LAS int* lcnt = (LAS int*)(lds + HS_BYTES + 4096);
    LAS int* lent = (LAS int*)(lds + HS_BYTES + 4096 + 512);
    LAS int* lbase = (LAS int*)(lds + HS_BYTES + 4096 + 512 + 8192);
    LAS int* lrun = (LAS int*)(lds + HS_BYTES + 4096 + 512 + 8192 + 2048);
    LAS float* lselv = (LAS float*)(lds + HS_BYTES + 4096 + 512 + 8192 + 4096); LAS int* lseli = (LAS int*)(lds + HS_BYTES + 4096 + 512 + 8192 + 4096 + 512);
    const int tid = otid(), lane = tid & 63, wid = tid >> 6, c0 = lane * 8;
    if (tid < 32) lcnt[tid] = 0;
    lrun[tid] = 0;
    int pending = 0;
    f32x4 g[4];
#pragma unroll
    for (int q = 0; q < 4; ++q) g[q] = *(const f32x4*)(p.g_ffn + (q >> 1) * 512 + c0 + (q & 1) * 4);
    float wB[64];
#pragma unroll
    for (int s = 0; s < 32; ++s) { const int k0 = 128 * wid + 4 * s + 2 * (lane >> 5); wB[2 * s] = p.w_r[k0 * 32 + (lane & 31)]; wB[2 * s + 1] = p.w_r[(k0 + 1) * 32 + (lane & 31)]; }
    __syncthreads();
    int it = 0;
    for (int tile = blockIdx.x; tile < L / 32; tile += gridDim.x, ++it) {
        const int rbase = tile * 32;
        f32x4 v[4][4];
#pragma unroll
        for (int u = 0; u < 4; ++u)
#pragma unroll
            for (int j = 0; j < 2; ++j) { float t8[8]; unpack8(*(const u32x4*)((const bf16_t*)(ws + OFF_X1) + (size_t)(rbase + wid * 4 + u) * D + j * 512 + c0), t8); v[u][2 * j] = (f32x4){t8[0], t8[1], t8[2], t8[3]}; v[u][2 * j + 1] = (f32x4){t8[4], t8[5], t8[6], t8[7]}; }
#pragma unroll
        for (int u = 0; u < 4; ++u) { const int rl = wid * 4 + u, row = rbase + rl; const float* mod = modv + (row / SEQ) * 6144; float ss = 0.f;
#pragma unroll
            for (int q = 0; q < 4; ++q) ss += (v[u][q][0] * v[u][q][0] + v[u][q][1] * v[u][q][1]) + (v[u][q][2] * v[u][q][2] + v[u][q][3] * v[u][q][3]);
            const float rs = rsqrtf(wave_sum(ss) * (1.0f / D) + EPS);
#pragma unroll
            for (int j = 0; j < 2; ++j) { f32x4 o[2];
#pragma unroll
                for (int e = 0; e < 2; ++e) { const int cc = j * 512 + c0 + e * 4; const f32x4 sc = *(const f32x4*)(mod + 4 * 1024 + cc), sh = *(const f32x4*)(mod + 3 * 1024 + cc); o[e] = v[u][j * 2 + e] * rs * g[j * 2 + e] * (sc + 1.0f) + sh;
                    *(LAS f32x4*)(hs + rl * HS_LD + cc) = o[e]; }
                u32x2 w; w.x = pack4_fp8(o[0][0], o[0][1], o[0][2], o[0][3]); w.y = pack4_fp8(o[1][0], o[1][1], o[1][2], o[1][3]);
                *(u32x2*)(h2 + (size_t)row * D + j * 512 + c0) = w; } }
        lds_sync();
        { f32x16 a0, a1;
#pragma unroll
          for (int r = 0; r < 16; ++r) { a0[r] = 0.f; a1[r] = 0.f; }
          const LAS float* hp = hs + (lane & 31) * HS_LD + 128 * wid + 2 * (lane >> 5);
#pragma unroll
          for (int s = 0; s < 32; ++s) { const f32x2 a = *(const LAS f32x2*)(hp + 4 * s);
              a0 = __builtin_amdgcn_mfma_f32_32x32x2f32(a[0], wB[2 * s], a0, 0, 0, 0); a1 = __builtin_amdgcn_mfma_f32_32x32x2f32(a[1], wB[2 * s + 1], a1, 0, 0, 0); }
          lds_sync();
#pragma unroll
          for (int r = 0; r < 16; ++r) { const int m = 8 * (r >> 2) + 4 * (lane >> 5) + (r & 3); hs[(wid * 32 + m) * 32 + (lane & 31)] = a0[r] + a1[r]; }
          lds_sync();
#pragma unroll
          for (int q = 0; q < 2; ++q) { const int o = tid + 512 * q; float t = p.b_r[o & 31];
#pragma unroll
              for (int w = 0; w < 8; ++w) t += hs[w * 1024 + o];
              lg[o] = t; } }
        lds_sync();
#pragma unroll
        for (int rep = 0; rep < 2; ++rep) { const int rl = wid * 4 + rep * 2 + (lane >> 5), row = rbase + rl, e = lane & 31; const float v = lg[rl * 32 + e]; int rank = 0;
#pragma unroll
            for (int q = 0; q < 8; ++q) { const f32x4 t = *(const LAS f32x4*)(lg + rl * 32 + 4 * q);
#pragma unroll
                for (int i = 0; i < 4; ++i) { const int gt = t[i] > v, eq = t[i] == v, lt = (4 * q + i) < e; rank += gt | (eq & lt); } }
            if (rank < 4) { lselv[rl * 4 + rank] = v; lseli[rl * 4 + rank] = e; }
            asm volatile("s_waitcnt lgkmcnt(0)" ::: "memory");
            const f32x4 sv = *(const LAS f32x4*)(lselv + rl * 4); const int k = e & 3; const int myk = lseli[rl * 4 + k];
            const float e0 = 1.0f, e1 = __expf(sv[1] - sv[0]), e2 = __expf(sv[2] - sv[0]), e3 = __expf(sv[3] - sv[0]); const float sum = ((e0 + e1) + e2) + e3;
            const float mye = k == 0 ? e0 : (k == 1 ? e1 : (k == 2 ? e2 : e3)); const float myp = mye / sum;
            if (e < 4) { const int pair = row * 4 + e; topi[pair] = myk; topp[pair] = myp; __hip_atomic_fetch_add(&lcnt[myk], 1, __ATOMIC_RELAXED, __HIP_MEMORY_SCOPE_WORKGROUP); lent[(it * 32 + rl) * 4 + e] = myk; } }
        lds_sync();
        { const int t3 = otid(); if (t3 < 32) { const int n = lcnt[t3]; if (it > 0) lbase[(it - 1) * 32 + t3] = pending; pending = n > 0 ? atomicAdd(&cnt[t3], n) : 0; lcnt[t3] = 0; } }
    }
    const int t2 = otid();
    if (t2 < 32 && it > 0) lbase[(it - 1) * 32 + t2] = pending;
    __syncthreads();
    const int nent = it * 128;
    for (int s = t2; s < nent; s += 512) { const int e = lent[s]; const int ii = s >> 7, rl = (s >> 2) & 31, k = s & 3; const int row = (blockIdx.x + ii * gridDim.x) * 32 + rl;
        const int pos = lbase[ii * 32 + e] + __hip_atomic_fetch_add(&lrun[ii * 32 + e], 1, __ATOMIC_RELAXED, __HIP_MEMORY_SCOPE_WORKGROUP); list[e * CAP + pos] = row * 4 + k; pairpos[row * 4 + k] = pos; }
}
__device__ __forceinline__ void moe_table(const int* cnt, LAS int* tab) {
    if (otid() == 0) { int t = 0; for (int e = 0; e < NE; ++e) { tab[e] = t; const int n = cnt[e]; tab[64 + e] = n; t += (n + 255) >> 8; } tab[32] = t; tab[33] = t; }
    __syncthreads();
    for (int rt = otid(); rt < tab[33]; rt += 512) { int e = 0; while (tab[e + 1] <= rt) ++e; tab[128 + rt] = e; }
    __syncthreads();
}
constexpr int LDS_TAB = pg8::STAGE_BYTES;
__device__ __forceinline__ void phase7(const Params& p, LAS unsigned char* lds) {
    char* ws = p.ws; LAS int* tab = (LAS int*)(lds + LDS_TAB); moe_table((const int*)(ws + OFF_CNT), tab);
    pg8::MoeSched<true> S; S.nN = 8; S.G = gridDim.x; S.c = blockIdx.x; S.rowb = 1024; S.Wt = ws + OFF_WT_GU; S.wexp = (size_t)2048 * 1024; S.btile = (size_t)256 * 1024; S.tab = tab; S.list = (const int*)(ws + OFF_LIST);
    pg8::EpiMoe1 E{(unsigned char*)(ws + OFF_ACT), p.b_gu};
    pg8::gemm_phase<pg8::EpiMoe1, pg8::MoeSched<true>, true, 127, 122>(lds, (const char*)(ws + OFF_H), 1024, S, E);
}
__device__ __forceinline__ void phase8(const Params& p, LAS unsigned char* lds) {
    char* ws = p.ws; LAS int* tab = (LAS int*)(lds + LDS_TAB); moe_table((const int*)(ws + OFF_CNT), tab);
    pg8::MoeSched<false> S; S.nN = 4; S.G = gridDim.x; S.c = blockIdx.x; S.rowb = 1024; S.Wt = ws + OFF_WT_DN; S.wexp = (size_t)1024 * 1024; S.btile = (size_t)256 * 1024; S.tab = tab; S.list = (const int*)(ws + OFF_LIST);
    pg8::EpiMoe2 E{(bf16_t*)(ws + OFF_YP), p.b_dn};
    pg8::gemm_phase<pg8::EpiMoe2, pg8::MoeSched<false>, true, 125, 122>(lds, (const char*)(ws + OFF_ACT), 1024, S, E);
}
__device__ __forceinline__ void phase9(const Params& p, LAS unsigned char* lds) {
    char* ws = p.ws; const float* modv = (const float*)(ws + OFF_MOD); const bf16_t* yp = (const bf16_t*)(ws + OFF_YP); const float* topp = (const float*)(ws + OFF_TOPP);
    const int* topi = (const int*)(ws + OFF_TOPI); const int* pairpos = (const int*)(ws + OFF_ROWPAIR);
    LAS int* tab = (LAS int*)lds; moe_table((const int*)(ws + OFF_CNT), tab);
    const int tid = otid(), lane = tid & 63, gw = blockIdx.x * 8 + (tid >> 6), nw = gridDim.x * 8, c0 = lane * 8;
    f32x4 fg[4];
#pragma unroll
    for (int q = 0; q < 4; ++q) fg[q] = *(const f32x4*)(p.g_fin + (q >> 1) * 512 + c0 + (q & 1) * 4);
    for (int row = gw; row < L; row += nw) {
        const float* gate = modv + (row / SEQ) * 6144 + 5 * 1024; f32x4 v[4]; u32x4 yr[4][2];
        const pg8::i32x4_t ek = *(const pg8::i32x4_t*)(topi + row * 4), pk4 = *(const pg8::i32x4_t*)(pairpos + row * 4);
#pragma unroll
        for (int j = 0; j < 2; ++j) { float t8[8]; unpack8(*(const u32x4*)((const bf16_t*)(ws + OFF_X1) + (size_t)row * D + j * 512 + c0), t8); v[2 * j] = (f32x4){t8[0], t8[1], t8[2], t8[3]}; v[2 * j + 1] = (f32x4){t8[4], t8[5], t8[6], t8[7]}; }
#pragma unroll
        for (int k = 0; k < 4; ++k) { const size_t yrow = (size_t)tab[ek[k]] * 256 + pk4[k];
#pragma unroll
            for (int j = 0; j < 2; ++j) yr[k][j] = __builtin_nontemporal_load((const u32x4*)(yp + yrow * D + j * 512 + c0)); }
        const f32x4 pk = *(const f32x4*)(topp + row * 4);
        float m[16];
#pragma unroll
        for (int i = 0; i < 16; ++i) m[i] = 0.f;
#pragma unroll
        for (int k = 0; k < 4; ++k)
#pragma unroll
            for (int j = 0; j < 2; ++j) { float t[8]; unpack8(yr[k][j], t);
#pragma unroll
                for (int i = 0; i < 8; ++i) m[j * 8 + i] += pk[k] * t[i]; }
        float ss = 0.f;
#pragma unroll
        for (int q = 0; q < 4; ++q) { const f32x4 gt = *(const f32x4*)(gate + (q >> 1) * 512 + c0 + (q & 1) * 4);
#pragma unroll
            for (int i = 0; i < 4; ++i) { v[q][i] += gt[i] * m[q * 4 + i]; ss += v[q][i] * v[q][i]; } }
        const float rs = rsqrtf(wave_sum(ss) * (1.0f / D) + EPS);
#pragma unroll
        for (int q = 0; q < 4; ++q) __builtin_nontemporal_store(v[q] * rs * fg[q], (f32x4*)(p.out + (size_t)row * D + (q >> 1) * 512 + c0 + (q & 1) * 4));
    }
}

namespace at {
using s16x4  = __attribute__((ext_vector_type(4))) short;
constexpr int NW = 8, QBLK = 32, KVBLK = 64, DK = 192, DV = 128;
constexpr float SCALE = 0.07216878364870322f;
constexpr float THR = 8.f;
constexpr int SHM_V = KVBLK * DV * 2, SHM_K = KVBLK * DK * 2, SHM_ATTN = 2 * SHM_V + 2 * SHM_K + NW * 64 * 4;
#define KSWZ(row, colB) ((row) * 384 + ((colB) ^ ((((row) ^ ((row) >> 3)) & 7) << 4)))
#define SBAR() __builtin_amdgcn_sched_barrier(0)
__device__ __forceinline__ int crow(int r, int hi) { return (r & 3) + 8 * (r >> 2) + 4 * hi; }
__device__ __forceinline__ unsigned cvtpk(float lo, float hi) { return cvt_pk_bf16(lo, hi); }

__device__ __forceinline__ void partialSM(f32x16& p0, f32x16& p1, float& m_reg, float& mn, float& alpha) {
  constexpr float C = SCALE * 1.4426950408889634f;
  float pmax = p0[0];
#pragma unroll
  for (int r = 1; r < 16; ++r) pmax = fmaxf(pmax, p0[r]);
#pragma unroll
  for (int r = 0; r < 16; ++r) pmax = fmaxf(pmax, p1[r]);
  { auto rr = __builtin_amdgcn_permlane32_swap(__float_as_uint(pmax), __float_as_uint(pmax), false, false);
    pmax = fmaxf(__uint_as_float(rr[0]), __uint_as_float(rr[1])); }
  if (__builtin_expect(__all(pmax - m_reg <= THR / SCALE), 1)) { mn = m_reg; alpha = 1.f; }
  else { mn = fmaxf(m_reg, pmax); alpha = __builtin_amdgcn_exp2f((m_reg - mn) * C); m_reg = mn; }
  float mnC = -mn * C;
#pragma unroll
  for (int r = 0; r < 16; ++r) p0[r] = fmaf(p0[r], C, mnC);
#pragma unroll
  for (int r = 0; r < 16; ++r) p1[r] = fmaf(p1[r], C, mnC);
#pragma unroll
  for (int r = 0; r < 16; ++r) p0[r] = __builtin_amdgcn_exp2f(p0[r]);
}
__device__ __forceinline__ void finishSM(f32x16& p0, f32x16& p1, float alpha, float& l_reg, bf16x8& pa0, bf16x8& pa1, bf16x8& pa2, bf16x8& pa3) {
#pragma unroll
  for (int r = 0; r < 16; ++r) p1[r] = __builtin_amdgcn_exp2f(p1[r]);
  float ps = 0;
#pragma unroll
  for (int r = 0; r < 16; ++r) ps += p0[r];
#pragma unroll
  for (int r = 0; r < 16; ++r) ps += p1[r];
  { auto rr = __builtin_amdgcn_permlane32_swap(__float_as_uint(ps), __float_as_uint(ps), false, false);
    ps = __uint_as_float(rr[0]) + __uint_as_float(rr[1]); }
  l_reg = l_reg * alpha + ps;
#define PK4(P, BASE, OUT) do { unsigned a0 = cvtpk(P[BASE + 0], P[BASE + 1]), a1 = cvtpk(P[BASE + 2], P[BASE + 3]);   \
    unsigned b0 = cvtpk(P[BASE + 4], P[BASE + 5]), b1 = cvtpk(P[BASE + 6], P[BASE + 7]);                              \
    auto r0 = __builtin_amdgcn_permlane32_swap(a0, b0, false, false); auto r1 = __builtin_amdgcn_permlane32_swap(a1, b1, false, false); \
    u32x4 w = {r0[0], r1[0], r0[1], r1[1]}; OUT = *reinterpret_cast<bf16x8*>(&w); } while (0)
  PK4(p0, 0, pa0); PK4(p0, 8, pa1); PK4(p1, 0, pa2); PK4(p1, 8, pa3);
#undef PK4
}
__device__ __forceinline__ void qkt(f32x16& p0, f32x16& p1, const LAS char* Ks, const bf16x8 (&qr)[12], int r32, int hi) {
  p0 = f32x16{}; p1 = f32x16{};
#pragma unroll
  for (int d0 = 0; d0 < 12; ++d0) { const int cb = (d0 * 16 + hi * 8) * 2;
    const bf16x8 b0 = *reinterpret_cast<const LAS bf16x8*>(Ks + KSWZ(r32, cb));
    const bf16x8 b1 = *reinterpret_cast<const LAS bf16x8*>(Ks + KSWZ(32 + r32, cb));
    p0 = __builtin_amdgcn_mfma_f32_32x32x16_bf16(b0, qr[d0], p0, 0, 0, 0);
    p1 = __builtin_amdgcn_mfma_f32_32x32x16_bf16(b1, qr[d0], p1, 0, 0, 0); }
}
__device__ __forceinline__ int v_st(int k, int c) { const int kk = (k & ~0xC) | ((k & 4) << 1) | ((k & 8) >> 1); return ((kk >> 3) * 4 + (c >> 5)) * 512 + ((kk & 7) * 32 + (c & 31)) * 2; }
__device__ __forceinline__ int v_rd_base(int lane) { return ((lane & 3) << 3) | (((lane >> 2) & 3) << 6) | (((lane >> 4) & 1) << 5) | (((lane >> 5) & 1) << 8); }
constexpr int v_rd_off(int d0, int ks, int half) { return d0 * 512 + ks * 4096 + half * 2048; }
template <int OFF> __device__ __forceinline__ s16x4 tr_read(int vb) { s16x4 r; asm volatile("ds_read_b64_tr_b16 %0, %1 offset:%2" : "=&v"(r) : "v"(vb), "i"(OFF) : "memory"); return r; }
template <int D0> __device__ __forceinline__ void pv_one(f32x16& od, int vb, bf16x8 pa0, bf16x8 pa1, bf16x8 pa2, bf16x8 pa3) {
  const s16x4 l0 = tr_read<v_rd_off(D0, 0, 0)>(vb), h0 = tr_read<v_rd_off(D0, 0, 1)>(vb), l1 = tr_read<v_rd_off(D0, 1, 0)>(vb), h1 = tr_read<v_rd_off(D0, 1, 1)>(vb);
  const s16x4 l2 = tr_read<v_rd_off(D0, 2, 0)>(vb), h2 = tr_read<v_rd_off(D0, 2, 1)>(vb), l3 = tr_read<v_rd_off(D0, 3, 0)>(vb), h3 = tr_read<v_rd_off(D0, 3, 1)>(vb);
  asm volatile("s_waitcnt lgkmcnt(0)" ::: "memory"); SBAR();
#define PK(Lo, Hi) (bf16x8){Lo[0], Lo[1], Lo[2], Lo[3], Hi[0], Hi[1], Hi[2], Hi[3]}
  od = __builtin_amdgcn_mfma_f32_32x32x16_bf16(pa0, PK(l0, h0), od, 0, 0, 0);
  od = __builtin_amdgcn_mfma_f32_32x32x16_bf16(pa1, PK(l1, h1), od, 0, 0, 0);
  od = __builtin_amdgcn_mfma_f32_32x32x16_bf16(pa2, PK(l2, h2), od, 0, 0, 0);
  od = __builtin_amdgcn_mfma_f32_32x32x16_bf16(pa3, PK(l3, h3), od, 0, 0, 0);
#undef PK
}
__device__ __forceinline__ void pv_d0(f32x16 (&o)[4], int vb, bf16x8 pa0, bf16x8 pa1, bf16x8 pa2, bf16x8 pa3) {
  pv_one<0>(o[0], vb, pa0, pa1, pa2, pa3); pv_one<1>(o[1], vb, pa0, pa1, pa2, pa3); pv_one<2>(o[2], vb, pa0, pa1, pa2, pa3); pv_one<3>(o[3], vb, pa0, pa1, pa2, pa3);
}

__device__ __forceinline__ void attn_unit(const bf16_t* __restrict__ Qb, const bf16_t* __restrict__ Kh, const bf16_t* __restrict__ Vh, bf16_t* __restrict__ Ob, int t0, const float* __restrict__ ropet, LAS char* lds) {
  constexpr int LDQ = 1536, LDO = 1024, NT = NKEY / KVBLK;
  const int tid = otid(), wid = tid >> 6, lane = tid & 63, r32 = lane & 31, hi = lane >> 5;
  LAS char* V_lds = lds; LAS char* K_lds = lds + 2 * SHM_V;
  LAS float* wsl = (LAS float*)(lds + 2 * SHM_V + 2 * SHM_K) + wid * 64; LAS float* li_l = wsl; LAS float* al_l = wsl + 32;
  float m_reg = -1e30f, l_reg = 0; f32x16 o[4] = {}; bf16x8 qr[12];
  { const bf16_t* Qw = Qb + (size_t)(wid * QBLK + r32) * LDQ + hi * 8;
#pragma unroll
    for (int d0 = 0; d0 < 12; ++d0) qr[d0] = *reinterpret_cast<const bf16x8*>(Qw + d0 * 16);
    const float* rt = ropet + (size_t)(t0 + wid * QBLK + r32) * 64 + 8 * hi;
#pragma unroll
    for (int g = 0; g < 2; ++g) {
      const f32x4 c0 = *(const f32x4*)(rt + 16 * g), c1 = *(const f32x4*)(rt + 16 * g + 4), s0 = *(const f32x4*)(rt + 32 + 16 * g), s1 = *(const f32x4*)(rt + 32 + 16 * g + 4);
      float n1[8], n2[8];
#pragma unroll
      for (int j = 0; j < 8; ++j) { const float cs = j < 4 ? c0[j & 3] : c1[j & 3], sn = j < 4 ? s0[j & 3] : s1[j & 3];
        const float x1 = bf2f((bf16_t)qr[8 + g][j]), x2 = bf2f((bf16_t)qr[10 + g][j]); n1[j] = x1 * cs - x2 * sn; n2[j] = x1 * sn + x2 * cs; }
      u32x4 w1 = {cvtpk(n1[0], n1[1]), cvtpk(n1[2], n1[3]), cvtpk(n1[4], n1[5]), cvtpk(n1[6], n1[7])}; u32x4 w2 = {cvtpk(n2[0], n2[1]), cvtpk(n2[2], n2[3]), cvtpk(n2[4], n2[5]), cvtpk(n2[6], n2[7])};
      qr[8 + g] = *reinterpret_cast<bf16x8*>(&w1); qr[10 + g] = *reinterpret_cast<bf16x8*>(&w2); } }
  const int sr = tid >> 4, sc = (tid & 15) * 8, vst0 = v_st(sr, sc), vst1 = v_st(32 + sr, sc);
  int kgo[3], kst[3];
#pragma unroll
  for (int i = 0; i < 3; ++i) { const int c = tid + 512 * i, row = c / 24, c8 = (c % 24) * 8; kgo[i] = row * DK + c8; kst[i] = KSWZ(row, c8 * 2); }
  const int vb0 = (int)(uintptr_t)V_lds + v_rd_base(lane);
  bf16x8 sv0, sv1, sk0, sk1, sk2;
#define SLOAD(k0) do { sv0 = *reinterpret_cast<const bf16x8*>(&Vh[(size_t)((k0) + sr) * DV + sc]); sv1 = *reinterpret_cast<const bf16x8*>(&Vh[(size_t)((k0) + 32 + sr) * DV + sc]); \
    sk0 = *reinterpret_cast<const bf16x8*>(&Kh[(size_t)(k0) * DK + kgo[0]]); sk1 = *reinterpret_cast<const bf16x8*>(&Kh[(size_t)(k0) * DK + kgo[1]]); sk2 = *reinterpret_cast<const bf16x8*>(&Kh[(size_t)(k0) * DK + kgo[2]]); } while (0)
#define SWRITE(b) do { *(LAS bf16x8*)(V_lds + (b) * SHM_V + vst0) = sv0; *(LAS bf16x8*)(V_lds + (b) * SHM_V + vst1) = sv1; \
    *(LAS bf16x8*)(K_lds + (b) * SHM_K + kst[0]) = sk0; *(LAS bf16x8*)(K_lds + (b) * SHM_K + kst[1]) = sk1; *(LAS bf16x8*)(K_lds + (b) * SHM_K + kst[2]) = sk2; } while (0)
#define RESC(a) do { if (__any((a) < 1.f)) { if (hi == 0) al_l[r32] = (a); asm volatile("s_waitcnt lgkmcnt(0)" ::: "memory"); \
    _Pragma("unroll") for (int d = 0; d < 4; ++d) _Pragma("unroll") for (int r = 0; r < 16; ++r) o[d][r] *= al_l[crow(r, hi)]; } } while (0)
  f32x16 p0, p1; float mn, al; bf16x8 pa0, pa1, pa2, pa3;
  SLOAD(0); asm volatile("s_waitcnt vmcnt(0)" ::: "memory"); SWRITE(0); __syncthreads();
  for (int j = 0; j < NT; ++j) {
    const int bsel = j & 1;
    if (j + 1 < NT) SLOAD((j + 1) * KVBLK);
    SBAR(); qkt(p0, p1, K_lds + bsel * SHM_K, qr, r32, hi);
    partialSM(p0, p1, m_reg, mn, al);
    RESC(al);
    finishSM(p0, p1, al, l_reg, pa0, pa1, pa2, pa3); SBAR();
    pv_d0(o, vb0 + bsel * SHM_V, pa0, pa1, pa2, pa3);
    if (j + 1 < NT) { asm volatile("s_waitcnt vmcnt(0)" ::: "memory"); SWRITE(bsel ^ 1); }
    __syncthreads();
  }
  if (hi == 0) li_l[r32] = l_reg; asm volatile("s_waitcnt lgkmcnt(0)" ::: "memory");
  float rli[16];
#pragma unroll
  for (int r = 0; r < 16; ++r) rli[r] = __builtin_amdgcn_rcpf(li_l[crow(r, hi)]);
  { LAS bf16_t* ot = (LAS bf16_t*)(lds + wid * 8192);
#pragma unroll
    for (int r = 0; r < 16; ++r) { const int orow = crow(r, hi);
#pragma unroll
      for (int d0 = 0; d0 < 4; ++d0) ot[orow * 128 + d0 * 32 + r32] = f2bf(o[d0][r] * rli[r]); }
    asm volatile("s_waitcnt lgkmcnt(0)" ::: "memory");
    bf16_t* Ow = Ob + (size_t)(wid * QBLK) * LDO;
#pragma unroll
    for (int i = 0; i < 8; ++i) { const int q = lane + 64 * i, row = q >> 4, ch = q & 15; const u32x4 w = *(const LAS u32x4*)(ot + row * 128 + ch * 8); *(u32x4*)(Ow + (size_t)row * LDO + ch * 8) = w; } }
#undef SLOAD
#undef SWRITE
#undef RESC
}
}

__device__ __forceinline__ void phase_attn(const Params& p, LAS unsigned char* lds) {
    char* ws = p.ws; const bf16_t* Q = (const bf16_t*)(ws + OFF_Q); const bf16_t* Kb = (const bf16_t*)(ws + OFF_K); const bf16_t* Vb = (const bf16_t*)(ws + OFF_V); bf16_t* Y = (bf16_t*)(ws + OFF_H);
    const int G = gridDim.x;
    for (int it = 0;; ++it) {
        int u;
        if (G == 256) { const int c = blockIdx.x, xcd = c & 7, j = c >> 3; if (it >= 4) break; u = ((it * 32 + xcd * 4 + (j >> 3)) << 3) | (j & 7); }
        else { u = it * G + blockIdx.x; if (u >= 1024) break; }
        const int bh = u >> 3, qb = u & 7, b = bh >> 3, h = bh & 7;
        at::attn_unit(Q + ((size_t)(b * SEQ + qb * 256)) * 1536 + h * 192, Kb + (size_t)bh * NKEY * 192, Vb + (size_t)bh * NKEY * 128, Y + ((size_t)(b * SEQ + qb * 256)) * D + h * 128, qb * 256, (const float*)(ws + OFF_ROPE), (LAS char*)lds);
        __syncthreads();
    }
}

namespace sc {
using f32x16 = __attribute__((ext_vector_type(16))) float;
constexpr int BUFB = 53248, O_QT = 0, O_KH = 16384, O_VT = 32768, O_AT = 49152, O_DEC = 51200, O_KD = 2 * BUFB, O_OUT = 2 * BUFB + 16384, LDS_SCAN = 2 * BUFB + 16384 + 2 * 16384;
__device__ __forceinline__ int sw256(int row, int cb) { return row * 256 + (cb ^ ((row & 15) << 4)); }
__device__ __forceinline__ int sw128(int row, int cb) { return row * 128 + (cb ^ (((row >> 1) & 7) << 4)); }
__device__ __forceinline__ int grow_of(int n, int b, int dir) { if (n < CTXL) { const int s = dir ? (CTXL - 1 - n) : n; return L + b * CTXL + s; } const int m = n - CTXL; return b * SEQ + (dir ? (SEQ - 1 - m) : m); }
__device__ __forceinline__ bf16x8 pack_acc8(const f32x16& x, int s) { u32x4 p; p.x = cvt_pk_bf16(x[8 * s], x[8 * s + 1]); p.y = cvt_pk_bf16(x[8 * s + 2], x[8 * s + 3]); p.z = cvt_pk_bf16(x[8 * s + 4], x[8 * s + 5]); p.w = cvt_pk_bf16(x[8 * s + 6], x[8 * s + 7]); return __builtin_bit_cast(bf16x8, p); }

__device__ __forceinline__ void scan_unit(const Params& p, int unit, LAS unsigned char* lds) {
    char* ws = p.ws; const int dir = unit & 1, h = (unit >> 1) & 7, b = unit >> 4;
    const bf16_t* hq = (const bf16_t*)(ws + OFF_HQ); const bf16_t* fz = (const bf16_t*)(ws + (dir ? OFF_FB : OFF_FF)); const bf16_t* iv = (const bf16_t*)(ws + OFF_IV);
    bf16_t* outp = (bf16_t*)(ws + (dir ? OFF_OB : OFF_OF)); const float* lb = (const float*)(ws + OFF_LB);
    const int tid = otid(), wid = __builtin_amdgcn_readfirstlane(tid >> 6), lane = tid & 63, r32 = lane & 31, hi = lane >> 5;
    const int sgn = dir ? -1 : 1; const long rstep = (long)sgn * D;
    __syncthreads();
    if (wid >= 4) {
        const int I = wid - 4, cp = lane, hc = h * 128 + 2 * cp;
        const float lbv0 = lb[dir * 1024 + hc], lbv1 = lb[dir * 1024 + hc + 1];
        unsigned zr[16], vr[16], qr[16];
#define SC_LOAD(c) do { const size_t o0_ = (size_t)(grow_of((c) * 64, b, dir) + sgn * (16 * I)) * D + hc; const bf16_t* pz_ = fz + o0_; const bf16_t* pv_ = iv + o0_; const bf16_t* pq_ = hq + o0_; \
        _Pragma("unroll") for (int i = 0; i < 16; ++i) { zr[i] = *(const unsigned*)pz_; pz_ += rstep; vr[i] = *(const unsigned*)pv_; pv_ += rstep; if ((c) >= 4) { qr[i] = *(const unsigned*)pq_; pq_ += rstep; } } } while (0)
        SC_LOAD(0);
        for (int it = 0; it <= 37; ++it) {
            if (it >= 6) {
                const int c = it - 2; const LAS unsigned char* OB = lds + O_OUT + (c & 1) * 16384; const int pt = I * 64 + lane;
                bf16_t* ob = outp + (size_t)grow_of(c * 64, b, dir) * D + h * 128;
#pragma unroll
                for (int q = 0; q < 4; ++q) { const int item = q * 256 + pt, t = item >> 4, c16 = item & 15;
                    *(u32x4*)(ob + (long)t * rstep + c16 * 8) = *(const LAS u32x4*)(OB + t * 256 + c16 * 16); }
            }
            if (it < 36) {
                const int c = it; const bool lat = c >= 4; LAS unsigned char* B = lds + (c & 1) * BUFB; LAS unsigned char* KD = lds + O_KD;
                float kk0[16], kk1[16], lc0[16], lc1[16]; float run0 = 0.f, run1 = 0.f;
#pragma unroll
                for (int i = 0; i < 16; ++i) { const float z0 = __uint_as_float(zr[i] << 16), z1 = __uint_as_float(zr[i] & 0xffff0000u);
                    const float f0 = lbv0 + (1.0f - lbv0) * sigmoidf_(z0), f1 = lbv1 + (1.0f - lbv1) * sigmoidf_(z1); kk0[i] = 1.0f - f0; kk1[i] = 1.0f - f1;
                    run0 += __builtin_amdgcn_logf(f0) * 0.6931471805599453f; run1 += __builtin_amdgcn_logf(f1) * 0.6931471805599453f; lc0[i] = run0; lc1[i] = run1; }
                *(LAS f32x2*)(B + O_DEC + (I * 128 + 2 * cp) * 4) = (f32x2){__expf(run0), __expf(run1)};
                unsigned kh0[8], kh1[8], vt0[8], vt1[8];
#pragma unroll
                for (int i = 0; i < 16; ++i) { const int t = 16 * I + i; const float l0 = lc0[i], l1 = lc1[i];
                    const float kd0 = kk0[i] * __expf(fminf(-l0, 80.0f)), kd1 = kk1[i] * __expf(fminf(-l1, 80.0f));
                    const float kf0 = kk0[i] * __expf(run0 - l0), kf1 = kk1[i] * __expf(run1 - l1);
                    if (lat) { const float q0 = __uint_as_float(qr[i] << 16), q1 = __uint_as_float(qr[i] & 0xffff0000u);
                        *(LAS unsigned*)(B + O_QT + sw256(t, 4 * cp)) = cvt_pk_bf16(q0 * __expf(l0), q1 * __expf(l1)); *(LAS unsigned*)(KD + sw256(t, 4 * cp)) = cvt_pk_bf16(kd0, kd1); }
                    if (i & 1) { kh0[i >> 1] = cvt_pk_bf16(__uint_as_float(kh0[i >> 1]), kf0); kh1[i >> 1] = cvt_pk_bf16(__uint_as_float(kh1[i >> 1]), kf1); vt0[i >> 1] = (vt0[i >> 1] >> 16) | (vr[i] << 16); vt1[i >> 1] = (vt1[i >> 1] >> 16) | (vr[i] & 0xffff0000u); }
                    else { kh0[i >> 1] = __float_as_uint(kf0); kh1[i >> 1] = __float_as_uint(kf1); vt0[i >> 1] = vr[i] << 16; vt1[i >> 1] = vr[i] & 0xffff0000u; } }
#pragma unroll
                for (int q = 0; q < 2; ++q) {
                    *(LAS u32x4*)(B + O_KH + sw128(2 * cp, 32 * I + 16 * q)) = (u32x4){kh0[4 * q], kh0[4 * q + 1], kh0[4 * q + 2], kh0[4 * q + 3]}; *(LAS u32x4*)(B + O_KH + sw128(2 * cp + 1, 32 * I + 16 * q)) = (u32x4){kh1[4 * q], kh1[4 * q + 1], kh1[4 * q + 2], kh1[4 * q + 3]};
                    *(LAS u32x4*)(B + O_VT + sw128(2 * cp, 32 * I + 16 * q)) = (u32x4){vt0[4 * q], vt0[4 * q + 1], vt0[4 * q + 2], vt0[4 * q + 3]}; *(LAS u32x4*)(B + O_VT + sw128(2 * cp + 1, 32 * I + 16 * q)) = (u32x4){vt1[4 * q], vt1[4 * q + 1], vt1[4 * q + 2], vt1[4 * q + 3]}; }
                if (it + 1 < 36) SC_LOAD(it + 1);
                if (lat) {
                    const int l15 = lane & 15, lq = lane >> 4; f32x4 a = {0.f, 0.f, 0.f, 0.f};
#pragma unroll
                    for (int ks = 0; ks < 4; ++ks) { const bf16x8 av = *(const LAS bf16x8*)(B + O_QT + sw256(16 * I + l15, (32 * ks + 8 * lq) * 2)); const bf16x8 bv = *(const LAS bf16x8*)(KD + sw256(16 * I + l15, (32 * ks + 8 * lq) * 2));
                        a = __builtin_amdgcn_mfma_f32_16x16x32_bf16(av, bv, a, 0, 0, 0); }
#pragma unroll
                    for (int r = 0; r < 4; ++r) { const int tl = 4 * lq + r; float v = a[r]; if (l15 > tl) v = 0.f; *(LAS bf16_t*)(B + O_AT + ((I * 16 + tl) * 16 + l15) * 2) = f2bf(v); }
                }
            }
            lds_sync();
        }
#undef SC_LOAD
    } else {
        const int bq = wid; f32x16 S[4];
#pragma unroll
        for (int a = 0; a < 4; ++a) S[a] = f32x16{};
        for (int it = 0; it <= 37; ++it) {
            if (it >= 1 && it <= 36) {
                const int c = it - 1; const bool lat = c >= 4; LAS unsigned char* B = lds + (c & 1) * BUFB;
                LAS bf16_t* po = (LAS bf16_t*)(lds + O_OUT + (c & 1) * 16384) + (4 * hi) * 128 + 32 * bq + r32;
#pragma unroll
                for (int I = 0; I < 4; ++I) {
                    const bf16x8 vtf = *(const LAS bf16x8*)(B + O_VT + sw128(32 * bq + r32, (16 * I + 8 * hi) * 2));
                    if (lat) {
                        f32x16 o = f32x16{};
#pragma unroll
                        for (int a = 0; a < 4; ++a)
#pragma unroll
                            for (int s = 0; s < 2; ++s) { const int dk0 = 32 * a + 16 * s + 4 * hi; const int row = 16 * I + (r32 & 15);
                                const u32x2 lo2 = *(const LAS u32x2*)(B + O_QT + sw256(row, dk0 * 2)), hi2 = *(const LAS u32x2*)(B + O_QT + sw256(row, (dk0 + 8) * 2));
                                const u32x4 av = {lo2.x, lo2.y, hi2.x, hi2.y};
                                o = __builtin_amdgcn_mfma_f32_32x32x16_bf16(__builtin_bit_cast(bf16x8, av), pack_acc8(S[a], s), o, 0, 0, 0); }
                        { const bf16x8 af = *(const LAS bf16x8*)(B + O_AT + ((I * 16 + (r32 & 15)) * 16 + 8 * hi) * 2); o = __builtin_amdgcn_mfma_f32_32x32x16_bf16(af, vtf, o, 0, 0, 0); }
#pragma unroll
                        for (int r = 0; r < 8; ++r) po[(16 * I + (r & 3) + 8 * (r >> 2)) * 128] = f2bf(o[r]);
                    }
#pragma unroll
                    for (int a = 0; a < 4; ++a) {
#pragma unroll
                        for (int g = 0; g < 4; ++g) { const f32x4 dc = *(const LAS f32x4*)(B + O_DEC + (I * 128 + 32 * a + 8 * g + 4 * hi) * 4); S[a][4 * g] *= dc[0]; S[a][4 * g + 1] *= dc[1]; S[a][4 * g + 2] *= dc[2]; S[a][4 * g + 3] *= dc[3]; }
                        const bf16x8 kf = *(const LAS bf16x8*)(B + O_KH + sw128(32 * a + r32, (16 * I + 8 * hi) * 2));
                        S[a] = __builtin_amdgcn_mfma_f32_32x32x16_bf16(kf, vtf, S[a], 0, 0, 0); }
                }
            }
            lds_sync();
        }
    }
    __syncthreads();
}
}
__device__ __forceinline__ void phase_scan(const Params& p, LAS unsigned char* lds) {
    for (int u = blockIdx.x; u < 256; u += gridDim.x) sc::scan_unit(p, u, lds);
}

constexpr int LDS_BYTES = 163840;
#include <cstdint>
#include <cstdlib>
#include <vector>

#define XB_TMO      128
#define XB_XCNT(j)  (256  + 64 * (j))
#define XB_XSUB(j)  (1280 + 64 * (j))
#define XB_XGEN(j)  (2304 + 64 * (j))
#define XB_TOP      3328
#define XB_TOPGEN   3392
#define XCD_BAR_WORDS 3456
#define XB_SPIN_CAP (1u << 18)

__device__ __forceinline__ unsigned xb_ld(unsigned* p)              { return __hip_atomic_load(p, __ATOMIC_RELAXED, __HIP_MEMORY_SCOPE_AGENT); }
__device__ __forceinline__ unsigned xb_add(unsigned* p, unsigned v) { return __hip_atomic_fetch_add(p, v, __ATOMIC_RELAXED, __HIP_MEMORY_SCOPE_AGENT); }
__device__ __forceinline__ unsigned xb_xcc_id() { return (unsigned)__builtin_amdgcn_s_getreg((3 << 11) | 20) & 0xFu; }
#define XB_SPIN(cond, bar) do { unsigned _sp = 0; while (cond) { __builtin_amdgcn_s_sleep(1); \
    if ((++_sp & 255u) == 0u) { if (xb_ld(&(bar)[XB_TMO])) break; if (_sp > XB_SPIN_CAP) { atomicAdd(&(bar)[XB_TMO], 1u); break; } } } } while (0)

struct XcdBarrier {
    unsigned* bar; unsigned x;
    volatile LAS unsigned* st;
};

__device__ __forceinline__ XcdBarrier xcd_barrier_post(unsigned* bar, volatile LAS unsigned* st) {
    XcdBarrier b; b.bar = bar; b.x = xb_xcc_id(); b.st = st;
    if (threadIdx.x == 0) (void)xb_add(&bar[XB_XCNT(b.x)], 1u);
    return b;
}
__device__ __forceinline__ void xcd_barrier_complete(unsigned* bar, unsigned x, unsigned& nloc, unsigned& nx) {
    const unsigned G = gridDim.x * gridDim.y * gridDim.z;
    unsigned sum, cnt, mine, sp = 0u;
    for (;;) {
        sum = 0u; cnt = 0u; mine = 0u;
#pragma unroll
        for (unsigned j = 0; j < 16; ++j) { const unsigned c = xb_ld(&bar[XB_XCNT(j)]); sum += c; cnt += (c > 0u) ? 1u : 0u; mine = (j == x) ? c : mine; }
        if (sum == G) break;
        __builtin_amdgcn_s_sleep(1);
        if ((++sp & 255u) == 0u) { if (xb_ld(&bar[XB_TMO])) break; if (sp > XB_SPIN_CAP) { atomicAdd(&bar[XB_TMO], 1u); break; } }
    }
    nloc = mine > 0u ? mine : 1u; nx = cnt > 0u ? cnt : 1u;
}

__device__ __forceinline__ void xcd_barrier(const XcdBarrier& b) {
    asm volatile("s_waitcnt vmcnt(0)" ::: "memory");
    __syncthreads();
    if (threadIdx.x == 0) {
        unsigned* bar = b.bar;
        __builtin_amdgcn_s_waitcnt(0);
        unsigned nloc = b.st[0], nx = b.st[1];
        if (nloc == 0u) { xcd_barrier_complete(bar, b.x, nloc, nx); b.st[0] = nloc; b.st[1] = nx; }
        const unsigned old = xb_add(&bar[XB_XSUB(b.x)], 1u);
        const unsigned gen = old / nloc;
        if (old + 1u == (gen + 1u) * nloc) {
            __builtin_amdgcn_fence(__ATOMIC_RELEASE, "agent");
            asm volatile("s_waitcnt vmcnt(0)" ::: "memory");
            const unsigned og = xb_add(&bar[XB_TOP], 1u);
            const unsigned tg = og / nx;
            if (og + 1u == (tg + 1u) * nx) xb_add(&bar[XB_TOPGEN], 1u);
            else XB_SPIN(xb_ld(&bar[XB_TOPGEN]) == tg, bar);
            __builtin_amdgcn_fence(__ATOMIC_ACQUIRE, "agent");
            xb_add(&bar[XB_XGEN(b.x)], 1u);
            asm volatile("s_waitcnt vmcnt(0)" ::: "memory");
        } else {
            XB_SPIN(xb_ld(&bar[XB_XGEN(b.x)]) == gen, bar);
            __builtin_amdgcn_fence(__ATOMIC_ACQUIRE, "agent");
            asm volatile("s_waitcnt vmcnt(0)" ::: "memory");
        }
    }
    __syncthreads();
}

__global__ void __launch_bounds__(512, 2) k_mega(Params p) {
    extern __shared__ __attribute__((aligned(16))) unsigned char smem[];
    LAS unsigned char* lds = (LAS unsigned char*)smem;
    volatile LAS unsigned* xbw = (volatile LAS unsigned*)(lds + LDS_BYTES - 16);
    if (threadIdx.x == 0) { xbw[0] = 0u; xbw[1] = 0u; xbw[2] = 0u; xbw[3] = 0u; }
    __syncthreads();
    XcdBarrier bar = xcd_barrier_post((unsigned*)(p.ws + OFF_BAR), xbw);
    phase0(p, lds);      xcd_barrier(bar);
    phase1(p, lds);      xcd_barrier(bar);
    phase2(p, lds);      xcd_barrier(bar);
    phase3(p, lds);      xcd_barrier(bar);
    phase_attn(p, lds);
    phase_scan(p, lds);  xcd_barrier(bar);
    phase4(p, lds);      xcd_barrier(bar);
    phase5(p, lds);      xcd_barrier(bar);
    phase6(p, lds);      xcd_barrier(bar);
    phase7(p, lds);      xcd_barrier(bar);
    phase8(p, lds);      xcd_barrier(bar);
    phase9(p, lds);
}
extern "C" void kernel_launch(void* const* d_in, const int* in_sizes, int n_in, void* d_out, int out_size, void* d_ws, size_t ws_size, hipStream_t stream) {
    static int grid = 0;
    if (grid == 0) {
        int dev = 0, cus = 0, per_cu = 0;
        if (hipGetDevice(&dev) != hipSuccess || hipDeviceGetAttribute(&cus, hipDeviceAttributeMultiprocessorCount, dev) != hipSuccess) { grid = -1; return; }
        if (hipFuncSetAttribute((const void*)k_mega, hipFuncAttributeMaxDynamicSharedMemorySize, LDS_BYTES) != hipSuccess) { grid = -1; return; }
        (void)hipOccupancyMaxActiveBlocksPerMultiprocessor(&per_cu, (const void*)k_mega, 512, LDS_BYTES);
        (void)hipGetLastError();
        grid = cus;
    }
    if (grid < 0) return;
    Params p{};
    p.x = (const float*)d_in[0]; p.c = (const float*)d_in[1]; p.ctx = (const float*)d_in[2]; p.cctx = (const float*)d_in[3]; p.w_mod = (const float*)d_in[4]; p.b_mod = (const float*)d_in[5];
    p.g_mix = (const float*)d_in[6]; p.w_in = (const float*)d_in[7]; p.g_q = (const float*)d_in[8]; p.w_qb = (const float*)d_in[9]; p.g_kv = (const float*)d_in[10]; p.w_kvb = (const float*)d_in[11];
    p.lbl = (const float*)d_in[12]; p.g_hg = (const float*)d_in[13]; p.w_out = (const float*)d_in[14]; p.g_ffn = (const float*)d_in[15]; p.w_r = (const float*)d_in[16]; p.b_r = (const float*)d_in[17];
    p.w_gu = (const float*)d_in[18]; p.b_gu = (const float*)d_in[19]; p.w_dn = (const float*)d_in[20]; p.b_dn = (const float*)d_in[21]; p.g_fin = (const float*)d_in[22];
    p.out = (float*)d_out; p.ws = (char*)d_ws;
    (void)hipMemsetAsync((char*)d_ws + OFF_BAR, 0, 16384, stream);
    hipLaunchKernelGGL(k_mega, dim3(grid), dim3(512), LDS_BYTES, stream, p);
}
```

```cpp
#include <hip/hip_runtime.h>
#include <stdint.h>

typedef unsigned short bf16_t;
__device__ __forceinline__ float bf2f(bf16_t v) { return __uint_as_float(((unsigned)v) << 16); }
__device__ __forceinline__ bf16_t f2bf(float f) { unsigned u = __float_as_uint(f); u += 0x7FFFu + ((u >> 16) & 1u); return (bf16_t)(u >> 16); }
__device__ __forceinline__ float sigmoidf_(float x) { return __builtin_amdgcn_rcpf(1.0f + __builtin_amdgcn_exp2f(-1.4426950408889634f * x)); }
__device__ __forceinline__ float siluf_(float x) { return x * __builtin_amdgcn_rcpf(1.0f + __builtin_amdgcn_exp2f(-1.4426950408889634f * x)); }

constexpr int D = 1024, NB = 16, SEQ = 2048, CTXL = 256;
constexpr int L = NB * SEQ;
constexpr int RC = NB * CTXL;
constexpr int R = L + RC;
constexpr int NKEY = SEQ + CTXL;
constexpr float EPS = 1e-6f;
constexpr int NE = 32, CAP = 32768;
constexpr int MAXROWS = 131072 + NE * 256;

constexpr size_t MiB = 1048576;
constexpr size_t OFF_SMALL = 0;
constexpr size_t OFF_BAR = 0;
constexpr size_t OFF_CNT = 16384;
constexpr size_t OFF_OFFS = 16384 + 1024;
constexpr size_t OFF_TILEE = 16384 + 2048;
constexpr size_t OFF_LB = 24576;
constexpr size_t OFF_MOD = 32768;
constexpr size_t OFF_SSQQ = 512 * 1024;
constexpr size_t OFF_SSQKV = 768 * 1024;
constexpr size_t OFF_TOPI = 1 * MiB;
constexpr size_t OFF_TOPP = 1 * MiB + 512 * 1024;
constexpr size_t OFF_ROWPAIR = 2 * MiB;
constexpr size_t OFF_LIST = 3 * MiB;
constexpr size_t OFF_H = 32 * MiB;
constexpr size_t OFF_QA = 104 * MiB;
constexpr size_t OFF_CKV = 152 * MiB;
constexpr size_t OFF_KR = 170 * MiB;
constexpr size_t OFF_OF = 104 * MiB;
constexpr size_t OFF_HQ = 175 * MiB;
constexpr size_t SEG_STRIDE = 72 * MiB;
constexpr size_t OFF_FF = OFF_HQ + 1 * SEG_STRIDE;
constexpr size_t OFF_FB = OFF_HQ + 2 * SEG_STRIDE;
constexpr size_t OFF_IV = OFF_HQ + 3 * SEG_STRIDE;
constexpr size_t OFF_OG = OFF_HQ + 4 * SEG_STRIDE;
constexpr size_t OFF_GM = OFF_HQ + 5 * SEG_STRIDE;
constexpr size_t OFF_GH = OFF_HQ + 6 * SEG_STRIDE;
constexpr size_t OFF_Q = 679 * MiB;
constexpr size_t OFF_K = 775 * MiB;
constexpr size_t OFF_V = 883 * MiB;
constexpr size_t OFF_OB = 955 * MiB;
constexpr size_t OFF_YP = 296 * MiB;
constexpr size_t OFF_ACT = 568 * MiB;


__device__ __forceinline__ void rope_cs(int t, int i, float& cs, float& sn) {
    int j = i & 15; float inv = __expf(-(float)j * (9.210340371976184f / 16.0f)); float pos = (i < 16) ? (float)(t >> 6) : (float)(t & 63);
    float ang = pos * inv; cs = cosf(ang); sn = sinf(ang);
}

#define LAS __attribute__((address_space(3)))
__device__ __forceinline__ int otid() { int t = threadIdx.x; asm volatile("" : "+v"(t)); return t; }
typedef short bf16x8 __attribute__((ext_vector_type(8)));
typedef float f32x4 __attribute__((ext_vector_type(4)));
typedef unsigned u32x4 __attribute__((ext_vector_type(4)));
typedef unsigned u32x2 __attribute__((ext_vector_type(2)));
typedef float f32x2 __attribute__((ext_vector_type(2)));
using f32x16 = __attribute__((ext_vector_type(16))) float;

constexpr size_t OFF_ROPE = 7 * MiB;
constexpr size_t OFF_WT_IN = 8 * MiB;
constexpr size_t OFF_WT_QB = 25 * MiB;
constexpr size_t OFF_WT_KVB = 28 * MiB;
constexpr size_t OFF_WT_OUT = 29 * MiB;
constexpr size_t OFF_WT_GU = 104 * MiB;
constexpr size_t OFF_WT_DN = 232 * MiB;
constexpr size_t OFF_YF8 = 775 * MiB;
constexpr size_t OFF_X1 = 704 * MiB;

struct Params {
    const float *x, *c, *ctx, *cctx, *w_mod, *b_mod, *g_mix, *w_in, *g_q, *w_qb, *g_kv, *w_kvb, *lbl, *g_hg, *w_out, *g_ffn, *w_r, *b_r, *w_gu, *b_gu, *w_dn, *b_dn, *g_fin;
    float* out; char* ws;
};

typedef __bf16 bf16v2_t __attribute__((ext_vector_type(2)));
__device__ __forceinline__ unsigned cvt_pk_bf16(float lo, float hi) { bf16v2_t v = {(__bf16)lo, (__bf16)hi}; return __builtin_bit_cast(unsigned, v); }

__device__ __forceinline__ unsigned pack4_fp8(float a, float b, float c, float d) {
    a = __builtin_amdgcn_fmed3f(a, -448.f, 448.f); b = __builtin_amdgcn_fmed3f(b, -448.f, 448.f); c = __builtin_amdgcn_fmed3f(c, -448.f, 448.f); d = __builtin_amdgcn_fmed3f(d, -448.f, 448.f);
    unsigned w = 0; w = __builtin_amdgcn_cvt_pk_fp8_f32(a, b, w, false); w = __builtin_amdgcn_cvt_pk_fp8_f32(c, d, w, true); return w; }

namespace pg8 {
constexpr int BM = 256, BK = 64, HALF = 128, HTB = HALF * BK * 2, STAGE_BYTES = 8 * HTB, NXCD = 8, WGM = 8;
constexpr int LDS_IDX = STAGE_BYTES + 8192;
__device__ __forceinline__ int lds_byte(int r, int c) { const int st = (r >> 4) * 2 + (c >> 5), rr = r & 15, cc = c & 31, ob = rr * 64 + cc * 2; return st * 1024 + (ob ^ (((ob >> 9) & 1) << 5)); }
__device__ __forceinline__ void stage_rc(int b, int& R, int& C) { const int st = b / 1024, sb = b % 1024, swz = sb ^ (((sb >> 9) & 1) << 5); R = (st >> 1) * 16 + swz / 64; C = (st & 1) * 32 + (swz % 64) / 2; }
__device__ __forceinline__ int perm32(int rho) { const int n = rho >> 4, i = rho & 15; return 8 * (i >> 2) + 4 * n + (i & 3); }
struct Unit { int pm, pn; const char* b; int e, pos0, cnt; };

__device__ __forceinline__ int xcd_remap(int L, int nwg) { const int q = nwg / NXCD, r = nwg % NXCD, xcd = L % NXCD, off = L / NXCD; return (xcd < r ? xcd * (q + 1) : r * (q + 1) + (xcd - r) * q) + off; }

struct DenseSched {
    int nM, nN, nwg, G, c, rowb; const char* Bt; size_t btile;
    __device__ void init(int M, int N, int kbytes, int rowb_, const void* Bt_, int G_, int c_) { nM = M / BM; nN = N / BM; nwg = nM * nN; G = G_; c = c_; rowb = rowb_; Bt = (const char*)Bt_; btile = (size_t)BM * kbytes; }
    static constexpr bool GATHER_LDS = false;
    __device__ __forceinline__ int kstepA() const { return 128; }
    __device__ __forceinline__ void tile(int wgid, int& pm, int& pn) const { const int nig = WGM * nN, gid = wgid / nig, fm = gid * WGM, gsz = (nM - fm) < WGM ? (nM - fm) : WGM; pm = fm + ((wgid % nig) % gsz); pn = (wgid % nig) / gsz; }
    __device__ __forceinline__ bool next(int i, Unit& u) const { const int Lx = i * G + c; if (Lx >= nwg) return false; tile(xcd_remap(Lx, nwg), u.pm, u.pn); u.b = Bt + (size_t)u.pn * btile; u.e = 0; u.pos0 = 0; u.cnt = 0; return true; }
    __device__ __forceinline__ void aoff(const Unit& u, const int (&Rr)[2], const int (&Cc)[2], unsigned (&va)[2][2]) const {
#pragma unroll
        for (int h = 0; h < 2; ++h)
#pragma unroll
            for (int i = 0; i < 2; ++i) va[h][i] = (unsigned)((u.pm * BM + h * HALF + Rr[i]) * rowb + Cc[i] * 2); }
};
struct InSched : DenseSched {
    __device__ void init2(const void* Bt_, int G_, int c_) { init(L, 8448, 1024, 1024, Bt_, G_, c_); }
    __device__ __forceinline__ bool next(int i, Unit& u) const {
        const int Lx = i * G + c; const int nlat = nwg;
        if (Lx < nlat) { tile(xcd_remap(Lx, nlat), u.pm, u.pn); }
        else { const int j = Lx - nlat; if (j >= 16 * 14) return false; const int q = j >> 4; u.pm = 128 + (j & 15); u.pn = q == 0 ? 3 : (q <= 12 ? 7 + q : 32); }
        u.b = Bt + (size_t)u.pn * btile; u.e = 0; u.pos0 = 0; u.cnt = 0; return true; }
};
__device__ __forceinline__ unsigned act_piece_off(int r, int c16) { const int s = 2 * (r >> 7) + (c16 >> 2), w = 4 * ((r >> 6) & 1) + (c16 & 3), l = 16 * ((r >> 4) & 3) + (r & 15); return (unsigned)(((s * 8 + w) * 64 + l) * 16); }
template <bool GATHER> struct MoeSched {
    int nN, G, c, rowb; const char* Wt; size_t wexp, btile; const LAS int* tab; const int* list;
    static constexpr bool GATHER_LDS = GATHER;
    __device__ __forceinline__ int kstepA() const { return GATHER ? 128 : 32768; }
    __device__ __forceinline__ bool next(int i, Unit& u) const {
        const int nwg = tab[33] * nN; const int Lx = i * G + c; if (Lx >= nwg) return false;
        const int w = xcd_remap(Lx, nwg); const int rt = w / nN; u.pn = w % nN; u.pm = rt;
        const int e = tab[128 + rt];
        u.e = e; u.pos0 = (rt - tab[e]) * BM; u.cnt = tab[64 + e]; u.b = Wt + (size_t)e * wexp + (size_t)u.pn * btile; return true; }
    __device__ __forceinline__ void aoff(const Unit& u, const int (&Rr)[2], const int (&Cc)[2], unsigned (&va)[2][2]) const {
#pragma unroll
        for (int h = 0; h < 2; ++h)
#pragma unroll
            for (int i = 0; i < 2; ++i) {
                if (GATHER) { const int pos = u.pos0 + h * HALF + Rr[i]; const int pair = pos < u.cnt ? list[u.e * CAP + pos] : 0; va[h][i] = (unsigned)((pair >> 2) * rowb + Cc[i] * 2); }
                else va[h][i] = (unsigned)u.pm * 262144u + act_piece_off(h * HALF + Rr[i], Cc[i] >> 3); } }
};

typedef int v8i_t __attribute__((ext_vector_type(8)));
typedef int i32x4_t __attribute__((ext_vector_type(4)));
template <class Epi, class Sched, bool FP8 = false, int SCA = 127, int SCB = 127>
__device__ __forceinline__ void gemm_phase(LAS unsigned char* lds, const char* Abase, const int K, const Sched& S, const Epi& E) {
    const int tid = otid(), wid = __builtin_amdgcn_readfirstlane(tid >> 6), lane = tid & 63, wr = wid >> 2, wc = wid & 3, fr = lane & 15, fq = lane >> 4;
    const int Kb = FP8 ? K : 2 * K;
    const int nt = Kb / (BK * 2);
    int Rr[2], Cc[2]; unsigned voffB[2];
#pragma unroll
    for (int i = 0; i < 2; ++i) { int R_, C_; stage_rc(tid * 16 + i * 8192, R_, C_); Rr[i] = R_; Cc[i] = C_; const int Rb = 64 * (R_ >> 5) + (Epi::PERM ? perm32(R_ & 31) : (R_ & 31)); voffB[i] = (unsigned)(Rb * Kb + C_ * 2); }
    const size_t kstep = (size_t)(BK * 2);
    const size_t kstepA = (size_t)S.kstepA();
    const size_t hstep = (size_t)32 * Kb;
    const unsigned ldsw = (unsigned)wid * 1024u;
    const int aoff = lds_byte(wr * 64 + fr, fq * 8), boff = lds_byte(wc * 32 + fr, fq * 8);
#define PG8_SA(b, h) (((b) * 2 + (h)) * HTB)
#define PG8_SB(b, h) ((4 + (b) * 2 + (h)) * HTB)
#define PG8_STAGE_B(bufoff, gbase) do { _Pragma("unroll") for (int _i = 0; _i < 2; ++_i) \
        __builtin_amdgcn_global_load_lds((const unsigned*)((const char*)(gbase) + voffB[_i]), (LAS unsigned*)(lds + (bufoff) + ldsw + _i * 8192), 16, 0, 0); } while (0)
#define PG8_STAGE_A(bufoff, v0, v1, kb) do { \
        __builtin_amdgcn_global_load_lds((const unsigned*)(Abase + (kb) + (v0)), (LAS unsigned*)(lds + (bufoff) + ldsw), 16, 0, 0); \
        __builtin_amdgcn_global_load_lds((const unsigned*)(Abase + (kb) + (v1)), (LAS unsigned*)(lds + (bufoff) + ldsw + 8192), 16, 0, 0); } while (0)
#define PG8_LD16(addr) (*(const LAS i32x4_t*)(addr))
#define PG8_LDA(dst, b, h) do { _Pragma("unroll") for (int m = 0; m < 4; ++m) { if constexpr (FP8) dst##8[m] = __builtin_shufflevector(PG8_LD16(lds + PG8_SA(b, h) + aoff + m * 2048), PG8_LD16(lds + PG8_SA(b, h) + aoff + m * 2048 + 1024), 0, 1, 2, 3, 4, 5, 6, 7); \
        else { _Pragma("unroll") for (int k = 0; k < 2; ++k) dst[m][k] = *(const LAS bf16x8*)(lds + PG8_SA(b, h) + aoff + m * 2048 + k * 1024); } } } while (0)
#define PG8_LDB(dst, b, h) do { _Pragma("unroll") for (int n = 0; n < 2; ++n) { if constexpr (FP8) dst##8[n] = __builtin_shufflevector(PG8_LD16(lds + PG8_SB(b, h) + boff + n * 2048), PG8_LD16(lds + PG8_SB(b, h) + boff + n * 2048 + 1024), 0, 1, 2, 3, 4, 5, 6, 7); \
        else { _Pragma("unroll") for (int k = 0; k < 2; ++k) dst[n][k] = *(const LAS bf16x8*)(lds + PG8_SB(b, h) + boff + n * 2048 + k * 1024); } } } while (0)
#define PG8_MMA(ai, bj, At, Bt) do { __builtin_amdgcn_s_setprio(1); _Pragma("unroll") for (int m = 0; m < 4; ++m) _Pragma("unroll") for (int n = 0; n < 2; ++n) { \
        if constexpr (FP8) asm volatile("v_mfma_scale_f32_16x16x128_f8f6f4 %0, %1, %2, %0, %3, %4 op_sel_hi:[0,0,0]" : "+v"(acc[ai][bj][m][n]) : "v"(Bt##8[n]), "v"(At##8[m]), "v"(scb_), "v"(sca_)); \
        else { _Pragma("unroll") for (int k = 0; k < 2; ++k) acc[ai][bj][m][n] = __builtin_amdgcn_mfma_f32_16x16x32_bf16(Bt[n][k], At[m][k], acc[ai][bj][m][n], 0, 0, 0); } } \
        __builtin_amdgcn_s_setprio(0); } while (0)
#define PG8_WAIT_V(n) asm volatile("s_waitcnt vmcnt(" #n ")" ::: "memory")
#define PG8_WAIT_L(n) asm volatile("s_waitcnt lgkmcnt(" #n ")" ::: "memory")
#define PG8_BAR __builtin_amdgcn_s_barrier()
#define PG8_SCHED __builtin_amdgcn_sched_barrier(0)
    Unit cur, nxt; int ui = 0;
    if (!S.next(0, cur)) return;
    f32x4 acc[2][2][4][2];
#pragma unroll
    for (int a = 0; a < 2; ++a)
#pragma unroll
        for (int b = 0; b < 2; ++b)
#pragma unroll
            for (int m = 0; m < 4; ++m)
#pragma unroll
                for (int n = 0; n < 2; ++n) acc[a][b][m][n] = (f32x4){0.f, 0.f, 0.f, 0.f};
    const int sca_ = SCA, scb_ = SCB;
    bf16x8 At[4][2], B0[2][2], B1[2][2]; v8i_t At8[4], B08[2], B18[2];
    unsigned vc[2][2], vn[2][2];
    S.aoff(cur, Rr, Cc, vc);
    const char* cB = cur.b;
    PG8_STAGE_B(PG8_SB(0, 0), cB); PG8_STAGE_A(PG8_SA(0, 0), vc[0][0], vc[0][1], 0); PG8_STAGE_B(PG8_SB(0, 1), cB + hstep); PG8_STAGE_A(PG8_SA(0, 1), vc[1][0], vc[1][1], 0);
    PG8_STAGE_B(PG8_SB(1, 0), cB + kstep); PG8_STAGE_A(PG8_SA(1, 0), vc[0][0], vc[0][1], kstepA); PG8_STAGE_B(PG8_SB(1, 1), cB + hstep + kstep);
    PG8_WAIT_V(6); PG8_BAR;
    if (wr == 1) PG8_BAR;
    for (;;) {
        const bool has_next = S.next(ui + 1, nxt);
        if constexpr (Sched::GATHER_LDS) {
            if (has_next && wid < 4) __builtin_amdgcn_global_load_lds((const unsigned*)(S.list + nxt.e * CAP + nxt.pos0 + otid()), (LAS unsigned*)(lds + LDS_IDX + wid * 256), 4, 0, 0);
        } else if (has_next) S.aoff(nxt, Rr, Cc, vn);
        if (!has_next) {
#pragma unroll
            for (int h = 0; h < 2; ++h)
#pragma unroll
                for (int i = 0; i < 2; ++i) vn[h][i] = vc[h][i]; }
        const char* nB = has_next ? nxt.b : cB;
#pragma unroll 1
        for (int t = 0; t < nt; t += 2) {
            const bool last = (t == nt - 2);
            if constexpr (Sched::GATHER_LDS) { if (last && has_next) {
#pragma unroll
                for (int h = 0; h < 2; ++h)
#pragma unroll
                    for (int i = 0; i < 2; ++i) { const int rr = h * HALF + Rr[i]; const int pair = (nxt.pos0 + rr) < nxt.cnt ? ((const LAS int*)(lds + LDS_IDX))[rr] : 0; vn[h][i] = (unsigned)((pair >> 2) * S.rowb + Cc[i] * 2); } } }
            const size_t k1 = (size_t)(t + 1) * kstepA;
            const size_t k2 = last ? 0 : (size_t)(t + 2) * kstepA;
            const unsigned s00 = last ? vn[0][0] : vc[0][0], s01 = last ? vn[0][1] : vc[0][1], s10 = last ? vn[1][0] : vc[1][0], s11 = last ? vn[1][1] : vc[1][1];
            const char* b2 = last ? nB : cB + (size_t)(t + 2) * kstep; const char* b3 = b2 + kstep;
            PG8_LDB(B0, 0, 0); PG8_LDB(B1, 0, 1); PG8_SCHED; PG8_LDA(At, 0, 0); PG8_STAGE_A(PG8_SA(1, 1), vc[1][0], vc[1][1], k1);
            PG8_WAIT_L(0); PG8_BAR; PG8_MMA(0, 0, At, B0); PG8_MMA(0, 1, At, B1); PG8_BAR; PG8_SCHED;
            PG8_LDA(At, 0, 1); PG8_SCHED; PG8_STAGE_B(PG8_SB(0, 0), b2); PG8_SCHED; PG8_STAGE_A(PG8_SA(0, 0), s00, s01, k2); PG8_SCHED; PG8_STAGE_B(PG8_SB(0, 1), b2 + hstep);
            PG8_WAIT_L(0); PG8_WAIT_V(6); PG8_BAR; PG8_MMA(1, 0, At, B0); PG8_MMA(1, 1, At, B1); PG8_BAR; PG8_SCHED;
            PG8_LDB(B0, 1, 0); PG8_LDB(B1, 1, 1); PG8_SCHED; PG8_LDA(At, 1, 0); PG8_STAGE_A(PG8_SA(0, 1), s10, s11, k2);
            PG8_WAIT_L(0); PG8_BAR; PG8_MMA(0, 0, At, B0); PG8_MMA(0, 1, At, B1); PG8_BAR; PG8_SCHED;
            PG8_LDA(At, 1, 1); PG8_SCHED; PG8_STAGE_B(PG8_SB(1, 0), b3); PG8_SCHED; PG8_STAGE_A(PG8_SA(1, 0), s00, s01, k2 + kstepA); PG8_SCHED; PG8_STAGE_B(PG8_SB(1, 1), b3 + hstep);
            PG8_WAIT_L(0); PG8_WAIT_V(6); PG8_BAR; PG8_MMA(1, 0, At, B0); PG8_MMA(1, 1, At, B1); PG8_BAR; PG8_SCHED;
        }
        if constexpr (FP8) asm volatile("s_nop 15\n\ts_nop 15" ::: "memory");
        E(acc, cur, wr, wc, fr, fq);
        if (!has_next) break;
#pragma unroll
        for (int a = 0; a < 2; ++a)
#pragma unroll
            for (int b = 0; b < 2; ++b)
#pragma unroll
                for (int m = 0; m < 4; ++m)
#pragma unroll
                    for (int n = 0; n < 2; ++n) acc[a][b][m][n] = (f32x4){0.f, 0.f, 0.f, 0.f};
        cur = nxt; cB = nB; ++ui;
#pragma unroll
        for (int h = 0; h < 2; ++h)
#pragma unroll
            for (int i = 0; i < 2; ++i) vc[h][i] = vn[h][i];
    }
    PG8_WAIT_V(0);
    if (wr == 0) PG8_BAR;
    PG8_BAR;
#undef PG8_SA
#undef PG8_SB
#undef PG8_STAGE_A
#undef PG8_STAGE_B
#undef PG8_LDA
#undef PG8_LDB
#undef PG8_MMA
#undef PG8_WAIT_V
#undef PG8_WAIT_L
#undef PG8_BAR
#undef PG8_SCHED
}

typedef f32x4 Acc[2][2][4][2];
__device__ __forceinline__ unsigned dpp_ror8(unsigned x) { return (unsigned)__builtin_amdgcn_update_dpp(0, (int)x, 0x128, 0xf, 0xf, false); }
__device__ __forceinline__ u32x4 ror8_4(const u32x4 v) { u32x4 r; r.x = dpp_ror8(v.x); r.y = dpp_ror8(v.y); r.z = dpp_ror8(v.z); r.w = dpp_ror8(v.w); return r; }
__device__ __forceinline__ void line_xy(const u32x4 a, const u32x4 b, bool lo, u32x4& X, u32x4& Y) { const u32x4 ra = ror8_4(a), rb = ror8_4(b); X = lo ? a : rb; Y = lo ? ra : b; }
__device__ __forceinline__ u32x4 pack8(const f32x4 v0, const f32x4 v1) { u32x4 w; w.x = cvt_pk_bf16(v0[0], v0[1]); w.y = cvt_pk_bf16(v0[2], v0[3]); w.z = cvt_pk_bf16(v1[0], v1[1]); w.w = cvt_pk_bf16(v1[2], v1[3]); return w; }

struct EpiIn { static constexpr bool PERM = true; char* ws;
    __device__ __forceinline__ void operator()(const Acc& acc, const Unit& u, int wr, int wc, int fr, int fq) const {
        const int pn = u.pn; size_t boff; int ld, cb;
        if (pn < 3) { boff = OFF_QA; ld = 384; cb = pn * 128; } else if (pn == 3) { boff = OFF_CKV; ld = 256; cb = 0; }
        else if (pn < 32) { boff = OFF_HQ + (size_t)((pn - 4) >> 2) * SEG_STRIDE; ld = 1024; cb = ((pn - 4) & 3) * 256; }
        else { boff = OFF_KR; ld = 64; cb = 0; }
        bf16_t* base = (bf16_t*)(ws + boff);
        if (pn == 32 && wc != 0) return;
        const bool lo = fr < 8; const int rowb0 = u.pm * BM + wr * 64, rx = fr & 7, colx = cb + wc * 64 + (fr >> 3) * 32 + 8 * fq;
        float* ssq = (float*)(ws + (pn < 3 ? OFF_SSQQ : OFF_SSQKV));
#pragma unroll
        for (int ai = 0; ai < 2; ++ai)
#pragma unroll
            for (int m = 0; m < 4; ++m) { const int rg = rowb0 + ai * HALF + m * 16;
                f32x4 v0 = acc[ai][0][m][0], v1 = acc[ai][0][m][1], w0 = acc[ai][1][m][0], w1 = acc[ai][1][m][1];
                if (pn >= 4 && pn < 8) {
#pragma unroll
                    for (int j = 0; j < 4; ++j) { v0[j] = siluf_(v0[j]) * 0.08838834764831845f; v1[j] = siluf_(v1[j]) * 0.08838834764831845f; w0[j] = siluf_(w0[j]) * 0.08838834764831845f; w1[j] = siluf_(w1[j]) * 0.08838834764831845f; } }
                if (pn < 3 || (pn >= 20 && pn < 32)) { unsigned char* qrow = pn < 3 ? (unsigned char*)base + (size_t)(rg + fr) * 768 + pn * 256 + wc * 64 + 8 * fq : (unsigned char*)base + (size_t)(rg + fr) * 1024 + (pn & 3) * 256 + wc * 64 + 8 * fq;
                    u32x2 a8; a8.x = pack4_fp8(v0[0], v0[1], v0[2], v0[3]); a8.y = pack4_fp8(v1[0], v1[1], v1[2], v1[3]); u32x2 b8; b8.x = pack4_fp8(w0[0], w0[1], w0[2], w0[3]); b8.y = pack4_fp8(w1[0], w1[1], w1[2], w1[3]);
                    *(u32x2*)qrow = a8; *(u32x2*)(qrow + 32) = b8; }
                else { u32x4 X, Y; line_xy(pack8(v0, v1), pack8(w0, w1), lo, X, Y);
                    __builtin_nontemporal_store(X, (u32x4*)(base + (size_t)(rg + rx) * ld + colx)); __builtin_nontemporal_store(Y, (u32x4*)(base + (size_t)(rg + 8 + rx) * ld + colx)); }
                if (pn <= 3) { float ss = (v0[0] * v0[0] + v0[1] * v0[1]) + (v0[2] * v0[2] + v0[3] * v0[3]) + (v1[0] * v1[0] + v1[1] * v1[1]) + (v1[2] * v1[2] + v1[3] * v1[3])
                                        + (w0[0] * w0[0] + w0[1] * w0[1]) + (w0[2] * w0[2] + w0[3] * w0[3]) + (w1[0] * w1[0] + w1[1] * w1[1]) + (w1[2] * w1[2] + w1[3] * w1[3]);
                    ss += __shfl_xor(ss, 16); ss += __shfl_xor(ss, 32); if (fq == 0) atomicAdd(ssq + rg + fr, ss); } }
    } };

struct EpiQ { static constexpr bool PERM = true; bf16_t* q; const float* ssq;
    __device__ __forceinline__ void operator()(const Acc& acc, const Unit& u, int wr, int wc, int fr, int fq) const {
        const bool lo = fr < 8; const int rowb0 = u.pm * BM + wr * 64, rx = fr & 7, colx = u.pn * BM + wc * 64 + (fr >> 3) * 32 + 8 * fq;
#pragma unroll
        for (int ai = 0; ai < 2; ++ai)
#pragma unroll
            for (int m = 0; m < 4; ++m) { const int rg = rowb0 + ai * HALF + m * 16; const float rs = rsqrtf(ssq[rg + fr] * (1.0f / 768.0f) + EPS);
                u32x4 X, Y; line_xy(pack8(acc[ai][0][m][0] * rs, acc[ai][0][m][1] * rs), pack8(acc[ai][1][m][0] * rs, acc[ai][1][m][1] * rs), lo, X, Y);
                *(u32x4*)(q + (size_t)(rg + rx) * 1536 + colx) = X; *(u32x4*)(q + (size_t)(rg + 8 + rx) * 1536 + colx) = Y; }
    } };

struct EpiKV { static constexpr bool PERM = true; bf16_t *Kb, *Vb; const float* ssq;
    __device__ __forceinline__ size_t kvrow(int row, int h) const { int b, pos; if (row < L) { b = row >> 11; pos = row & 2047; } else { b = (row - L) >> 8; pos = SEQ + ((row - L) & 255); } return (size_t)(b * 8 + h) * NKEY + pos; }
    __device__ __forceinline__ void operator()(const Acc& acc, const Unit& u, int wr, int wc, int fr, int fq) const {
        const bool lo = fr < 8; const int rowb0 = u.pm * BM + wr * 64, rx = fr & 7, colx = (wc & 1) * 64 + (fr >> 3) * 32 + 8 * fq;
        bf16_t* dst = wc < 2 ? Kb : Vb; const int ld = wc < 2 ? 192 : 128;
#pragma unroll
        for (int ai = 0; ai < 2; ++ai)
#pragma unroll
            for (int m = 0; m < 4; ++m) { const int rg = rowb0 + ai * HALF + m * 16; const float rs = rsqrtf(ssq[rg + fr] * (1.0f / 256.0f) + EPS);
                u32x4 X, Y; line_xy(pack8(acc[ai][0][m][0] * rs, acc[ai][0][m][1] * rs), pack8(acc[ai][1][m][0] * rs, acc[ai][1][m][1] * rs), lo, X, Y);
                *(u32x4*)(dst + kvrow(rg + rx, u.pn) * ld + colx) = X; *(u32x4*)(dst + kvrow(rg + 8 + rx, u.pn) * ld + colx) = Y; }
    } };

struct EpiOut { static constexpr bool PERM = true; bf16_t* x1; const float* x; const float* modv;
    __device__ __forceinline__ void operator()(const Acc& acc, const Unit& u, int wr, int wc, int fr, int fq) const {
        const bool lo = fr < 8; const int rowb0 = u.pm * BM + wr * 64, rx = fr & 7, colx = u.pn * BM + wc * 64 + (fr >> 3) * 32 + 8 * fq, cown = u.pn * BM + wc * 64 + 8 * fq;
#pragma unroll
        for (int ai = 0; ai < 2; ++ai)
#pragma unroll
            for (int m = 0; m < 4; ++m) { const int rg = rowb0 + ai * HALF + m * 16, row = rg + fr; const float* gate = modv + (row >> 11) * 6144 + 2 * 1024 + cown; const float* xr = x + (size_t)row * D + cown;
                f32x4 r[2][2];
#pragma unroll
                for (int bj = 0; bj < 2; ++bj)
#pragma unroll
                    for (int n = 0; n < 2; ++n) r[bj][n] = *(const f32x4*)(xr + bj * 32 + 4 * n) + *(const f32x4*)(gate + bj * 32 + 4 * n) * acc[ai][bj][m][n];
                u32x4 X, Y; line_xy(pack8(r[0][0], r[0][1]), pack8(r[1][0], r[1][1]), lo, X, Y);
                *(u32x4*)(x1 + (size_t)(rg + rx) * D + colx) = X; *(u32x4*)(x1 + (size_t)(rg + 8 + rx) * D + colx) = Y; }
    } };

struct EpiMoe1 { static constexpr bool PERM = true; unsigned char* act; const float* bgu;
    __device__ __forceinline__ void operator()(const Acc& acc, const Unit& u, int wr, int wc, int fr, int fq) const {
        const int o0 = u.pn * 128 + wc * 16 + 4 * fq;
        f32x4 bg[2], bl[2];
#pragma unroll
        for (int bj = 0; bj < 2; ++bj) { const float* bp = bgu + u.e * 2048 + 2 * (o0 + bj * 64); const f32x4 t0 = *(const f32x4*)bp, t1 = *(const f32x4*)(bp + 4);
            bg[bj] = (f32x4){t0[0], t0[2], t1[0], t1[2]}; bl[bj] = (f32x4){t0[1], t0[3], t1[1], t1[3]}; }
        unsigned char* blk = act + ((size_t)u.pm * 8 + u.pn) * 32768 + (size_t)(wr * 4 + wc) * 1024 + (size_t)(fq * 16 + fr) * 16;
#pragma unroll
        for (int ai = 0; ai < 2; ++ai)
#pragma unroll
            for (int bj = 0; bj < 2; ++bj) { unsigned d[4];
#pragma unroll
                for (int m = 0; m < 4; ++m) { const f32x4 g4 = acc[ai][bj][m][0] + bg[bj], l4 = acc[ai][bj][m][1] + bl[bj]; float r[4];
#pragma unroll
                    for (int j = 0; j < 4; ++j) { const float glu = fminf(g4[j], 7.0f), lin = __builtin_amdgcn_fmed3f(l4[j], -7.0f, 7.0f); r[j] = 4.0f * glu * __builtin_amdgcn_rcpf(1.0f + __builtin_amdgcn_exp2f(-2.4554669595930157f * glu)) * (lin + 1.0f); }
                    d[m] = pack4_fp8(r[0], r[1], r[2], r[3]); }
                const auto s01 = __builtin_amdgcn_permlane16_swap(d[0], d[1], false, false); const auto s23 = __builtin_amdgcn_permlane16_swap(d[2], d[3], false, false);
                const auto t02 = __builtin_amdgcn_permlane32_swap(s01[0], s23[0], false, false); const auto t13 = __builtin_amdgcn_permlane32_swap(s01[1], s23[1], false, false);
                *(u32x4*)(blk + (size_t)(ai * 2 + bj) * 8192) = (u32x4){t02[0], t13[0], t02[1], t13[1]}; }
    } };

struct EpiMoe2 { static constexpr bool PERM = true; bf16_t* yp; const float* bd;
    __device__ __forceinline__ void operator()(const Acc& acc, const Unit& u, int wr, int wc, int fr, int fq) const {
        const bool lo = fr < 8; const int rowb0 = u.pm * BM + wr * 64, rx = fr & 7, colx = u.pn * BM + wc * 64 + (fr >> 3) * 32 + 8 * fq, cown = u.pn * BM + wc * 64 + 8 * fq;
        f32x4 bv[2][2];
#pragma unroll
        for (int bj = 0; bj < 2; ++bj)
#pragma unroll
            for (int n = 0; n < 2; ++n) bv[bj][n] = *(const f32x4*)(bd + u.e * 1024 + cown + bj * 32 + 4 * n);
#pragma unroll
        for (int ai = 0; ai < 2; ++ai)
#pragma unroll
            for (int m = 0; m < 4; ++m) { const int rg = rowb0 + ai * HALF + m * 16;
                u32x4 X, Y; line_xy(pack8(acc[ai][0][m][0] + bv[0][0], acc[ai][0][m][1] + bv[0][1]), pack8(acc[ai][1][m][0] + bv[1][0], acc[ai][1][m][1] + bv[1][1]), lo, X, Y);
                __builtin_nontemporal_store(X, (u32x4*)(yp + (size_t)(rg + rx) * D + colx)); __builtin_nontemporal_store(Y, (u32x4*)(yp + (size_t)(rg + 8 + rx) * D + colx)); }
    } };
}

__device__ __forceinline__ int conv_src_col(int kind, int c) {
    if (kind == 0) return c;
    if (kind == 1) { if (c < 1024) return c; if (c < 8192) return c + 64; if (c < 8256) return c - 8192 + 1024; return -1; }
    const int pn = c >> 8, p = c & 255, wc = p >> 6, bj = (p >> 5) & 1, fq = (p >> 3) & 3, n = (p >> 2) & 1, i = p & 3; const int o = 128 * pn + 64 * bj + 16 * wc + 4 * fq + i; return 2 * o + n;
}
__device__ __forceinline__ void lds_sync() { asm volatile("s_waitcnt lgkmcnt(0)\n\ts_barrier" ::: "memory"); }
template <bool F8> struct ConvPipe {
    float v[32]; bool have; bf16_t* dummy;
    int K, kind, k0, c0; void* Wt;
    __device__ __forceinline__ void issue(const float* __restrict__ W, int ldw, void* Wt_, int K_, int kind_, const float* __restrict__ kscale, int k0_, int c0_) {
        const int tid = otid(); const int cc = tid & 127, kq = tid >> 7, sc = conv_src_col(kind_, c0_ + cc);
        const int scc = sc < 0 ? 0 : sc; const float* wp = W + (size_t)(k0_ + kq) * ldw + scc;
#pragma unroll
        for (int i = 0; i < 32; ++i) v[i] = __builtin_nontemporal_load(wp + (size_t)(4 * i) * ldw);
        if (sc < 0) {
#pragma unroll
            for (int i = 0; i < 32; ++i) v[i] = 0.f; }
        if (kscale) {
#pragma unroll
            for (int i = 0; i < 32; ++i) v[i] *= kscale[k0_ + kq + 4 * i]; }
        K = K_; kind = kind_; k0 = k0_; c0 = c0_; Wt = Wt_; have = true;
    }
    __device__ __forceinline__ void flush(LAS float* tl) {
        if (!have) return; have = false;
        const int tid = otid(); const int cc = tid & 127, kq = tid >> 7;
        __syncthreads();
#pragma unroll
        for (int i = 0; i < 32; ++i) tl[(kq + 4 * i) * 129 + cc] = v[i];
        __syncthreads();
        stash(tl, tid);
    }
    __device__ __forceinline__ void to_lds(LAS float* tl) { const int tid = otid(); const int cc = tid & 127, kq = tid >> 7; lds_sync();
#pragma unroll
        for (int i = 0; i < 32; ++i) tl[(kq + 4 * i) * 129 + cc] = v[i];
        lds_sync(); }
    __device__ __forceinline__ void stash(LAS float* tl, int tid) const {
        if constexpr (F8) {
#pragma unroll
            for (int pss = 0; pss < 2; ++pss) { const int item = tid + 512 * pss, c2 = item >> 3, ch = item & 7; float t[16];
#pragma unroll
                for (int j = 0; j < 16; ++j) t[j] = tl[(16 * ch + j) * 129 + c2] * 32.f;
                u32x4 w; w.x = pack4_fp8(t[0], t[1], t[2], t[3]); w.y = pack4_fp8(t[4], t[5], t[6], t[7]); w.z = pack4_fp8(t[8], t[9], t[10], t[11]); w.w = pack4_fp8(t[12], t[13], t[14], t[15]);
                *(u32x4*)((unsigned char*)Wt + (size_t)(c0 + c2) * K + k0 + 16 * ch) = w; }
        } else {
#pragma unroll
            for (int pss = 0; pss < 4; ++pss) { const int item = tid + 512 * pss, c2 = item >> 4, ch = item & 15; float t[8];
#pragma unroll
                for (int j = 0; j < 8; ++j) t[j] = tl[(8 * ch + j) * 129 + c2];
                u32x4 w; w.x = cvt_pk_bf16(t[0], t[1]); w.y = cvt_pk_bf16(t[2], t[3]); w.z = cvt_pk_bf16(t[4], t[5]); w.w = cvt_pk_bf16(t[6], t[7]);
                *(u32x4*)((bf16_t*)Wt + (size_t)(c0 + c2) * K + k0 + 8 * ch) = w; }
        }
    }
};
template <bool F8>
__device__ __forceinline__ void conv_matrix(LAS float* tl, ConvPipe<F8>& pipe, const float* W, int ldw, void* Wt, int K, int Nout, int kind, const float* kscale, int& tctr) {
    const int nk = K / 128, ntile = nk * (Nout / 128);
    int t = ((int)blockIdx.x - tctr) % (int)gridDim.x; if (t < 0) t += gridDim.x;
    for (; t < ntile; t += gridDim.x) {
        if (pipe.have) { pipe.to_lds(tl); const int K0 = pipe.K, k00 = pipe.k0, c00 = pipe.c0; void* W0 = pipe.Wt; ConvPipe<F8> done = pipe; (void)K0; (void)k00; (void)c00; (void)W0;
            pipe.issue(W, ldw, Wt, K, kind, kscale, (t % nk) * 128, (t / nk) * 128); done.stash(tl, otid()); }
        else pipe.issue(W, ldw, Wt, K, kind, kscale, (t % nk) * 128, (t / nk) * 128);
    }
    tctr = (tctr + ntile) % (int)gridDim.x;
}
template <bool F8> __device__ __forceinline__ void conv_finish(LAS float* tl, ConvPipe<F8>& pipe) { if (pipe.have) { pipe.to_lds(tl); pipe.stash(tl, otid()); pipe.have = false; } __syncthreads(); }

__device__ __forceinline__ float half_sum256(float v, LAS float* red) {
    for (int o = 32; o > 0; o >>= 1) v += __shfl_xor(v, o);
    const int w = otid() >> 6, hb = (otid() >> 8) * 4; if ((otid() & 63) == 0) red[w] = v; __syncthreads();
    const float t = red[hb] + red[hb + 1] + red[hb + 2] + red[hb + 3]; __syncthreads(); return t;
}

__device__ __forceinline__ void phase0(const Params& p, LAS unsigned char* lds) {
    char* ws = p.ws; const int tid = otid(), gsz = gridDim.x * 512, gid = blockIdx.x * 512 + tid;
    float* lb = (float*)(ws + OFF_LB); int* cnt = (int*)(ws + OFF_CNT); float* ssqq = (float*)(ws + OFF_SSQQ); float* ssqkv = (float*)(ws + OFF_SSQKV); float* modv = (float*)(ws + OFF_MOD);
    for (int i = gid; i < 2048; i += gsz) { const int d = i >> 10, j = i & 1023; const float a = p.lbl[(d * 2 + 0) * 1024 + j], b = p.lbl[(d * 2 + 1) * 1024 + j]; lb[i] = 1.0f / (1.0f + __expf(b - a)); }
    for (int i = gid; i < 32; i += gsz) cnt[i] = 0;
    { float* ropet = (float*)(ws + OFF_ROPE); for (int i = gid; i < SEQ * 32; i += gsz) { const int t = i >> 5, j = i & 31; float cs, sn; rope_cs(t, j, cs, sn); ropet[t * 64 + j] = cs; ropet[t * 64 + 32 + j] = sn; } }
    for (int i = gid; i < L; i += gsz) ssqq[i] = 0.f;
    for (int i = gid; i < R; i += gsz) ssqkv[i] = 0.f;
    { LAS float* sil = (LAS float*)lds;
      LAS float* part = (LAS float*)(lds + 17 * 1024 * 4);
      bool loaded = false;
      for (int item = blockIdx.x; item < 192; item += gridDim.x) {
          if (!loaded) { for (int i = tid; i < 17 * 1024; i += 512) { const int r = i >> 10, k = i & 1023; sil[i] = siluf_(r < 16 ? p.c[r * 1024 + k] : p.cctx[k]); } loaded = true; __syncthreads(); }
          const int j = tid & 31, ks = tid >> 5; float a[17];
#pragma unroll
          for (int r = 0; r < 17; ++r) a[r] = 0.f;
#pragma unroll 4
          for (int k = ks * 64; k < ks * 64 + 64; ++k) { const float w = p.w_mod[(size_t)k * 6144 + item * 32 + j];
#pragma unroll
              for (int r = 0; r < 17; ++r) a[r] += sil[r * 1024 + k] * w; }
#pragma unroll
          for (int r = 0; r < 17; ++r) part[(ks * 17 + r) * 32 + j] = a[r];
          __syncthreads();
          for (int i = tid; i < 17 * 32; i += 512) { const int r = i >> 5, jj = i & 31; float s = p.b_mod[item * 32 + jj]; for (int q = 0; q < 16; ++q) s += part[(q * 17 + r) * 32 + jj]; modv[r * 6144 + item * 32 + jj] = s; }
          __syncthreads();
      } }
    __syncthreads();
    { LAS float* tl = (LAS float*)lds; int tctr = 0;
      { ConvPipe<true> pp; pp.have = false; conv_matrix<true>(tl, pp, p.w_in, 8256, (unsigned char*)(ws + OFF_WT_IN), 1024, 8448, 1, nullptr, tctr); conv_finish<true>(tl, pp); }
      { ConvPipe<true> pp; pp.have = false;
        conv_matrix<true>(tl, pp, p.w_qb, 1536, (unsigned char*)(ws + OFF_WT_QB), 768, 1536, 0, p.g_q, tctr);
        conv_matrix<true>(tl, pp, p.w_out, 1024, (unsigned char*)(ws + OFF_WT_OUT), 1024, 1024, 0, nullptr, tctr); conv_finish<true>(tl, pp); }
      { ConvPipe<false> pp; pp.have = false;
        conv_matrix<false>(tl, pp, p.w_kvb, 2048, (bf16_t*)(ws + OFF_WT_KVB), 256, 2048, 0, p.g_kv, tctr); conv_finish<false>(tl, pp); } }
}

__device__ __forceinline__ float wave_sum(float v) {
#pragma unroll
    for (int o = 32; o > 0; o >>= 1) v += __shfl_xor(v, o);
    return v; }
__device__ __forceinline__ void phase1(const Params& p, LAS unsigned char* lds) {
    const float* modv = (const float*)(p.ws + OFF_MOD); unsigned char* h = (unsigned char*)(p.ws + OFF_H);
    const int tid = otid(), lane = tid & 63, gw = blockIdx.x * 8 + (tid >> 6), nw = gridDim.x * 8, c0 = lane * 8;
    f32x4 g[4];
#pragma unroll
    for (int q = 0; q < 4; ++q) g[q] = *(const f32x4*)(p.g_mix + (q >> 1) * 512 + c0 + (q & 1) * 4);
    for (int row0 = gw; row0 < R; row0 += 4 * nw) {
        f32x4 v[4][4];
#pragma unroll
        for (int u = 0; u < 4; ++u) { const int row = row0 + u * nw < R ? row0 + u * nw : row0; const float* src = row < L ? p.x + (size_t)row * D : p.ctx + (size_t)(row - L) * D;
#pragma unroll
            for (int q = 0; q < 4; ++q) v[u][q] = __builtin_nontemporal_load((const f32x4*)(src + (q >> 1) * 512 + c0 + (q & 1) * 4)); }
#pragma unroll
        for (int u = 0; u < 4; ++u) { if (row0 + u * nw >= R) break; const int row = row0 + u * nw; const float* mod = modv + (row < L ? row / SEQ : 16) * 6144;
            float ss = 0.f;
#pragma unroll
            for (int q = 0; q < 4; ++q) ss += (v[u][q][0] * v[u][q][0] + v[u][q][1] * v[u][q][1]) + (v[u][q][2] * v[u][q][2] + v[u][q][3] * v[u][q][3]);
            const float rs = rsqrtf(wave_sum(ss) * (1.0f / D) + EPS);
#pragma unroll
            for (int j = 0; j < 2; ++j) { f32x4 o[2];
#pragma unroll
                for (int e = 0; e < 2; ++e) { const int cc = j * 512 + c0 + e * 4; const f32x4 sc = *(const f32x4*)(mod + 1024 + cc), sh = *(const f32x4*)(mod + cc); o[e] = v[u][j * 2 + e] * rs * g[j * 2 + e] * (sc + 1.0f) + sh; }
                u32x2 w; w.x = pack4_fp8(o[0][0], o[0][1], o[0][2], o[0][3]); w.y = pack4_fp8(o[1][0], o[1][1], o[1][2], o[1][3]);
                *(u32x2*)(h + (size_t)row * D + j * 512 + c0) = w; } }
    }
}


__device__ __forceinline__ void phase2(const Params& p, LAS unsigned char* lds) {
    pg8::InSched S; S.init2(p.ws + OFF_WT_IN, gridDim.x, blockIdx.x);
    pg8::EpiIn E{p.ws};
    pg8::gemm_phase<pg8::EpiIn, pg8::InSched, true, 127, 122>(lds, (const char*)(p.ws + OFF_H), 1024, S, E);
}
__device__ __forceinline__ void phase3(const Params& p, LAS unsigned char* lds) {
    char* ws = p.ws;
    { pg8::DenseSched S; S.init(L, 1536, 768, 768, ws + OFF_WT_QB, gridDim.x, blockIdx.x); pg8::EpiQ E{(bf16_t*)(ws + OFF_Q), (const float*)(ws + OFF_SSQQ)}; pg8::gemm_phase<pg8::EpiQ, pg8::DenseSched, true, 127, 122>(lds, (const char*)(ws + OFF_QA), 768, S, E); }
    { pg8::DenseSched S; S.init(R, 2048, 256 * 2, 256 * 2, ws + OFF_WT_KVB, gridDim.x, blockIdx.x); pg8::EpiKV E{(bf16_t*)(ws + OFF_K), (bf16_t*)(ws + OFF_V), (const float*)(ws + OFF_SSQKV)}; pg8::gemm_phase(lds, (const char*)(ws + OFF_CKV), 256, S, E); }
    { const bf16_t* kr = (const bf16_t*)(ws + OFF_KR); bf16_t* Kb = (bf16_t*)(ws + OFF_K); const float* ropet = (const float*)(ws + OFF_ROPE);
      for (int gid = blockIdx.x * 512 + otid(); gid < R * 32; gid += gridDim.x * 512) { const int row = gid >> 5, i = gid & 31;
          const float x1 = bf2f(kr[(size_t)row * 64 + i]), x2 = bf2f(kr[(size_t)row * 64 + 32 + i]); float o1 = x1, o2 = x2; int b, pos;
          if (row < L) { b = row / SEQ; pos = row % SEQ; const float cs = ropet[pos * 64 + i], sn = ropet[pos * 64 + 32 + i]; o1 = x1 * cs - x2 * sn; o2 = x1 * sn + x2 * cs; } else { b = (row - L) / CTXL; pos = SEQ + (row - L) % CTXL; }
          const bf16_t w1 = f2bf(o1), w2 = f2bf(o2);
          for (int h = 0; h < 8; ++h) { bf16_t* q = Kb + ((size_t)(b * 8 + h) * NKEY + pos) * 192 + 128; q[i] = w1; q[32 + i] = w2; } } }
}
__device__ __forceinline__ void unpack8_fp8(const u32x2 w, float (&o)[8]) {
    o[0] = __builtin_amdgcn_cvt_f32_fp8((int)w.x, 0); o[1] = __builtin_amdgcn_cvt_f32_fp8((int)w.x, 1); o[2] = __builtin_amdgcn_cvt_f32_fp8((int)w.x, 2); o[3] = __builtin_amdgcn_cvt_f32_fp8((int)w.x, 3);
    o[4] = __builtin_amdgcn_cvt_f32_fp8((int)w.y, 0); o[5] = __builtin_amdgcn_cvt_f32_fp8((int)w.y, 1); o[6] = __builtin_amdgcn_cvt_f32_fp8((int)w.y, 2); o[7] = __builtin_amdgcn_cvt_f32_fp8((int)w.y, 3); }
__device__ __forceinline__ void unpack8(const u32x4 w, float (&o)[8]) {
    o[0] = __uint_as_float(w.x << 16); o[1] = __uint_as_float(w.x & 0xffff0000u); o[2] = __uint_as_float(w.y << 16); o[3] = __uint_as_float(w.y & 0xffff0000u);
    o[4] = __uint_as_float(w.z << 16); o[5] = __uint_as_float(w.z & 0xffff0000u); o[6] = __uint_as_float(w.w << 16); o[7] = __uint_as_float(w.w & 0xffff0000u); }
__device__ __forceinline__ void phase4(const Params& p, LAS unsigned char*) {
    char* ws = p.ws; bf16_t* y = (bf16_t*)(ws + OFF_H); const bf16_t* of = (const bf16_t*)(ws + OFF_OF); const bf16_t* ob = (const bf16_t*)(ws + OFF_OB);
    const unsigned char* og = (const unsigned char*)(ws + OFF_OG); const unsigned char* gm = (const unsigned char*)(ws + OFF_GM); const unsigned char* gh = (const unsigned char*)(ws + OFF_GH);
    const int tid = otid(), lane = tid & 63, gw = blockIdx.x * 8 + (tid >> 6), nw = gridDim.x * 8, c0 = lane * 8;
    float gg[8];
#pragma unroll
    for (int i = 0; i < 8; ++i) gg[i] = p.g_hg[(c0 + i) & 127];
    for (int row0 = gw; row0 < L; row0 += 2 * nw) {
        u32x4 ra[2][2], rb[2][2], rm[2][2]; u32x2 r1[2][2], r2[2][2], r3[2][2];
#pragma unroll
        for (int u = 0; u < 2; ++u) { const int row = row0 + u * nw < L ? row0 + u * nw : row0;
#pragma unroll
        for (int j = 0; j < 2; ++j) { const size_t off = (size_t)row * D + j * 512 + c0; ra[u][j] = __builtin_nontemporal_load((const u32x4*)(of + off)); rb[u][j] = __builtin_nontemporal_load((const u32x4*)(ob + off)); r1[u][j] = __builtin_nontemporal_load((const u32x2*)(og + off)); r2[u][j] = __builtin_nontemporal_load((const u32x2*)(gm + off)); r3[u][j] = __builtin_nontemporal_load((const u32x2*)(gh + off)); rm[u][j] = __builtin_nontemporal_load((const u32x4*)(y + off)); } }
#pragma unroll
        for (int u = 0; u < 2; ++u) { const int row = row0 + u * nw; if (row >= L) break;
#pragma unroll
        for (int j = 0; j < 2; ++j) { float a[8], b[8], g1[8], g2[8], g3[8], ym[8], o[8]; unpack8(ra[u][j], a); unpack8(rb[u][j], b); unpack8_fp8(r1[u][j], g1); unpack8_fp8(r2[u][j], g2); unpack8_fp8(r3[u][j], g3); unpack8(rm[u][j], ym);
            float ss = 0.f;
#pragma unroll
            for (int i = 0; i < 8; ++i) { o[i] = a[i] + b[i]; ss += o[i] * o[i]; }
            ss += __shfl_xor(ss, 1); ss += __shfl_xor(ss, 2); ss += __shfl_xor(ss, 4); ss += __shfl_xor(ss, 8);
            const float rs = rsqrtf(ss * (1.0f / 128.0f) + EPS); float r[8];
#pragma unroll
            for (int i = 0; i < 8; ++i) { const float yh = o[i] * rs * gg[i] * siluf_(g1[i]); r[i] = sigmoidf_(g2[i]) * ym[i] + sigmoidf_(g3[i]) * yh; }
            u32x2 w; w.x = pack4_fp8(r[0], r[1], r[2], r[3]); w.y = pack4_fp8(r[4], r[5], r[6], r[7]);
            *(u32x2*)((unsigned char*)(ws + OFF_YF8) + (size_t)row * D + j * 512 + c0) = w; } }
    }
}

#define MC_TIE16(v, o) asm volatile("" : "+v"(v[o+0]), "+v"(v[o+1]), "+v"(v[o+2]), "+v"(v[o+3]), "+v"(v[o+4]), "+v"(v[o+5]), "+v"(v[o+6]), "+v"(v[o+7]), "+v"(v[o+8]), "+v"(v[o+9]), "+v"(v[o+10]), "+v"(v[o+11]), "+v"(v[o+12]), "+v"(v[o+13]), "+v"(v[o+14]), "+v"(v[o+15]))
__device__ __forceinline__ void mc_issue(const Params& p, int idx, float (&v)[32]) {
    const int tid = otid(); const int cc = tid & 127, kq = tid >> 7; const float* base; unsigned voff, vstep;
    if (idx < 4096) { const int e = idx >> 7, r = idx & 127; base = p.w_gu + (size_t)e * 1024 * 2048; voff = (unsigned)(((r & 7) * 128 + kq) * 2048 + conv_src_col(2, (r >> 3) * 128 + cc)) * 4u; vstep = 4u * 2048u * 4u; }
    else { const int j = idx - 4096, e = j >> 6, r = j & 63; base = p.w_dn + (size_t)e * 1024 * 1024; voff = (unsigned)(((r & 7) * 128 + kq) * 1024 + (r >> 3) * 128 + cc) * 4u; vstep = 4u * 1024u * 4u; }
#pragma unroll
    for (int i = 0; i < 32; ++i) { asm volatile("global_load_dword %0, %1, %2 nt" : "=v"(v[i]) : "v"(voff), "s"(base) : "memory"); voff += vstep; }
}
__device__ __forceinline__ void mc_stash(const Params& p, int idx, const LAS float* tl) {
    unsigned char* dst;
    if (idx < 4096) { const int e = idx >> 7, r = idx & 127; dst = (unsigned char*)(p.ws + OFF_WT_GU) + (size_t)e * 2048 * 1024 + (size_t)((r >> 3) * 128) * 1024 + (r & 7) * 128; }
    else { const int j = idx - 4096, e = j >> 6, r = j & 63; dst = (unsigned char*)(p.ws + OFF_WT_DN) + (size_t)e * 1024 * 1024 + (size_t)((r >> 3) * 128) * 1024 + (r & 7) * 128; }
    const int tid = otid();
#pragma unroll
    for (int pss = 0; pss < 2; ++pss) { const int item = tid + 512 * pss, c2 = item >> 3, ch = item & 7; float t[16];
#pragma unroll
        for (int j = 0; j < 16; ++j) t[j] = tl[(16 * ch + j) * 129 + c2] * 32.f;
        u32x4 w; w.x = pack4_fp8(t[0], t[1], t[2], t[3]); w.y = pack4_fp8(t[4], t[5], t[6], t[7]); w.z = pack4_fp8(t[8], t[9], t[10], t[11]); w.w = pack4_fp8(t[12], t[13], t[14], t[15]);
        *(u32x4*)(dst + (size_t)c2 * 1024 + 16 * ch) = w; }
}
__device__ __forceinline__ void mc_step(const Params& p, float (&v)[32], LAS float* tl, int i, int n, int stride, int wmode) {
    const int tid = otid(); const int cc = tid & 127, kq = tid >> 7; const int idx = (int)blockIdx.x + i * stride;
    if (wmode == 3) asm volatile("s_waitcnt vmcnt(36)" ::: "memory"); else if (wmode == 2) asm volatile("s_waitcnt vmcnt(34)" ::: "memory"); else if (wmode == 1) asm volatile("s_waitcnt vmcnt(32)" ::: "memory"); else asm volatile("s_waitcnt vmcnt(0)" ::: "memory");
    MC_TIE16(v, 0); MC_TIE16(v, 16);
#pragma unroll
    for (int q = 0; q < 32; ++q) tl[(kq + 4 * q) * 129 + cc] = v[q];
    lds_sync();
    if (i + 2 < n) mc_issue(p, idx + 2 * stride, v);
    mc_stash(p, idx, tl);
}
__device__ __forceinline__ void moe_conv(const Params& p, LAS unsigned char* lds) {
    LAS float* t0 = (LAS float*)lds; LAS float* t1 = t0 + 128 * 129;
    const int stride = gridDim.x, n = (6144 - (int)blockIdx.x + stride - 1) / stride;
    float va[32], vb[32];
#pragma unroll
    for (int q = 0; q < 32; ++q) { va[q] = 0.f; vb[q] = 0.f; }
    lds_sync();
    if (n >= 4) {
        mc_issue(p, (int)blockIdx.x, va); mc_issue(p, (int)blockIdx.x + stride, vb);
        mc_step(p, va, t0, 0, n, stride, 1); mc_step(p, vb, t1, 1, n, stride, 2);
#pragma unroll 1
        for (int i = 2; i < n; i += 2) { mc_step(p, va, t0, i, n, stride, i == n - 1 ? 0 : 3); if (i + 1 < n) mc_step(p, vb, t1, i + 1, n, stride, i + 1 == n - 1 ? 0 : 3); }
    } else {
        for (int i = 0; i < n; ++i) { mc_issue(p, (int)blockIdx.x + i * stride, va); mc_step(p, va, t0, i, 0, stride, 0); lds_sync(); }
    }
    __syncthreads();
}
__device__ __forceinline__ void phase5(const Params& p, LAS unsigned char* lds) {
    char* ws = p.ws;
    { pg8::DenseSched S; S.init(L, 1024, 1024, 1024, ws + OFF_WT_OUT, gridDim.x, blockIdx.x); pg8::EpiOut E{(bf16_t*)(ws + OFF_X1), p.x, (const float*)(ws + OFF_MOD)}; pg8::gemm_phase<pg8::EpiOut, pg8::DenseSched, true, 127, 122>(lds, (const char*)(ws + OFF_YF8), 1024, S, E); }
    moe_conv(p, lds);
}
__device__ __forceinline__ void phase6(const Params& p, LAS unsigned char* lds) {
    char* ws = p.ws; const float* modv = (const float*)(ws + OFF_MOD); unsigned char* h2 = (unsigned char*)(ws + OFF_H); int* topi = (int*)(ws + OFF_TOPI); float* topp = (float*)(ws + OFF_TOPP); int* cnt = (int*)(ws + OFF_CNT); int* list = (int*)(ws + OFF_LIST); int* pairpos = (int*)(ws + OFF_ROWPAIR);
    constexpr int HS_LD = 1028, HS_BYTES = 32 * HS_LD * 4;
    LAS float* hs = (LAS float*)lds;
    LAS float* lg = (LAS float*)(lds + HS_BYTES);
    LAS int* lcnt = (LAS int*)(lds + HS_BYTES + 4096);
    LAS int* lent = (LAS int*)(lds + HS_BYTES + 4096 + 512);
    LAS int* lbase = (LAS int*)(lds + HS_BYTES + 4096 + 512 + 8192);
    LAS int* lrun = (LAS int*)(lds + HS_BYTES + 4096 + 512 + 8192 + 2048);
    LAS float* lselv = (LAS float*)(lds + HS_BYTES + 4096 + 512 + 8192 + 4096); LAS int* lseli = (LAS int*)(lds + HS_BYTES + 4096 + 512 + 8192 + 4096 + 512);
    const int tid = otid(), lane = tid & 63, wid = tid >> 6, c0 = lane * 8;
    if (tid < 32) lcnt[tid] = 0;
    lrun[tid] = 0;
    int pending = 0;
    f32x4 g[4];
#pragma unroll
    for (int q = 0; q < 4; ++q) g[q] = *(const f32x4*)(p.g_ffn + (q >> 1) * 512 + c0 + (q & 1) * 4);
    float wB[64];
#pragma unroll
    for (int s = 0; s < 32; ++s) { const int k0 = 128 * wid + 4 * s + 2 * (lane >> 5); wB[2 * s] = p.w_r[k0 * 32 + (lane & 31)]; wB[2 * s + 1] = p.w_r[(k0 + 1) * 32 + (lane & 31)]; }
    __syncthreads();
    int it = 0;
    for (int tile = blockIdx.x; tile < L / 32; tile += gridDim.x, ++it) {
        const int rbase = tile * 32;
        f32x4 v[4][4];
#pragma unroll
        for (int u = 0; u < 4; ++u)
#pragma unroll
            for (int j = 0; j < 2; ++j) { float t8[8]; unpack8(*(const u32x4*)((const bf16_t*)(ws + OFF_X1) + (size_t)(rbase + wid * 4 + u) * D + j * 512 + c0), t8); v[u][2 * j] = (f32x4){t8[0], t8[1], t8[2], t8[3]}; v[u][2 * j + 1] = (f32x4){t8[4], t8[5], t8[6], t8[7]}; }
#pragma unroll
        for (int u = 0; u < 4; ++u) { const int rl = wid * 4 + u, row = rbase + rl; const float* mod = modv + (row / SEQ) * 6144; float ss = 0.f;
#pragma unroll
            for (int q = 0; q < 4; ++q) ss += (v[u][q][0] * v[u][q][0] + v[u][q][1] * v[u][q][1]) + (v[u][q][2] * v[u][q][2] + v[u][q][3] * v[u][q][3]);
            const float rs = rsqrtf(wave_sum(ss) * (1.0f / D) + EPS);
#pragma unroll
            for (int j = 0; j < 2; ++j) { f32x4 o[2];
#pragma unroll
                for (int e = 0; e < 2; ++e) { const int cc = j * 512 + c0 + e * 4; const f32x4 sc = *(const f32x4*)(mod + 4 * 1024 + cc), sh = *(const f32x4*)(mod + 3 * 1024 + cc); o[e] = v[u][j * 2 + e] * rs * g[j * 2 + e] * (sc + 1.0f) + sh;
                    *(LAS f32x4*)(hs + rl * HS_LD + cc) = o[e]; }
                u32x2 w; w.x = pack4_fp8(o[0][0], o[0][1], o[0][2], o[0][3]); w.y = pack4_fp8(o[1][0], o[1][1], o[1][2], o[1][3]);
                *(u32x2*)(h2 + (size_t)row * D + j * 512 + c0) = w; } }
        lds_sync();
        { f32x16 a0, a1;
#pragma unroll
          for (int r = 0; r < 16; ++r) { a0[r] = 0.f; a1[r] = 0.f; }
          const LAS float* hp = hs + (lane & 31) * HS_LD + 128 * wid + 2 * (lane >> 5);
#pragma unroll
          for (int s = 0; s < 32; ++s) { const f32x2 a = *(const LAS f32x2*)(hp + 4 * s);
              a0 = __builtin_amdgcn_mfma_f32_32x32x2f32(a[0], wB[2 * s], a0, 0, 0, 0); a1 = __builtin_amdgcn_mfma_f32_32x32x2f32(a[1], wB[2 * s + 1], a1, 0, 0, 0); }
          lds_sync();
#pragma unroll
          for (int r = 0; r < 16; ++r) { const int m = 8 * (r >> 2) + 4 * (lane >> 5) + (r & 3); hs[(wid * 32 + m) * 32 + (lane & 31)] = a0[r] + a1[r]; }
          lds_sync();
#pragma unroll
          for (int q = 0; q < 2; ++q) { const int o = tid + 512 * q; float t = p.b_r[o & 31];
#pragma unroll
              for (int w = 0; w < 8; ++w) t += hs[w * 1024 + o];
              lg[o] = t; } }
        lds_sync();
#pragma unroll
        for (int rep = 0; rep < 2; ++rep) { const int rl = wid * 4 + rep * 2 + (lane >> 5), row = rbase + rl, e = lane & 31; const float v = lg[rl * 32 + e]; int rank = 0;
#pragma unroll
            for (int q = 0; q < 8; ++q) { const f32x4 t = *(const LAS f32x4*)(lg + rl * 32 + 4 * q);
#pragma unroll
                for (int i = 0; i < 4; ++i) { const int gt = t[i] > v, eq = t[i] == v, lt = (4 * q + i) < e; rank += gt | (eq & lt); } }
            if (rank < 4) { lselv[rl * 4 + rank] = v; lseli[rl * 4 + rank] = e; }
            asm volatile("s_waitcnt lgkmcnt(0)" ::: "memory");
            const f32x4 sv = *(const LAS f32x4*)(lselv + rl * 4); const int k = e & 3; const int myk = lseli[rl * 4 + k];
            const float e0 = 1.0f, e1 = __expf(sv[1] - sv[0]), e2 = __expf(sv[2] - sv[0]), e3 = __expf(sv[3] - sv[0]); const float sum = ((e0 + e1) + e2) + e3;
            const float mye = k == 0 ? e0 : (k == 1 ? e1 : (k == 2 ? e2 : e3)); const float myp = mye / sum;
            if (e < 4) { const int pair = row * 4 + e; topi[pair] = myk; topp[pair] = myp; __hip_atomic_fetch_add(&lcnt[myk], 1, __ATOMIC_RELAXED, __HIP_MEMORY_SCOPE_WORKGROUP); lent[(it * 32 + rl) * 4 + e] = myk; } }
        lds_sync();
        { const int t3 = otid(); if (t3 < 32) { const int n = lcnt[t3]; if (it > 0) lbase[(it - 1) * 32 + t3] = pending; pending = n > 0 ? atomicAdd(&cnt[t3], n) : 0; lcnt[t3] = 0; } }
    }
    const int t2 = otid();
    if (t2 < 32 && it > 0) lbase[(it - 1) * 32 + t2] = pending;
    __syncthreads();
    const int nent = it * 128;
    for (int s = t2; s < nent; s += 512) { const int e = lent[s]; const int ii = s >> 7, rl = (s >> 2) & 31, k = s & 3; const int row = (blockIdx.x + ii * gridDim.x) * 32 + rl;
        const int pos = lbase[ii * 32 + e] + __hip_atomic_fetch_add(&lrun[ii * 32 + e], 1, __ATOMIC_RELAXED, __HIP_MEMORY_SCOPE_WORKGROUP); list[e * CAP + pos] = row * 4 + k; pairpos[row * 4 + k] = pos; }
}
__device__ __forceinline__ void moe_table(const int* cnt, LAS int* tab) {
    if (otid() == 0) { int t = 0; for (int e = 0; e < NE; ++e) { tab[e] = t; const int n = cnt[e]; tab[64 + e] = n; t += (n + 255) >> 8; } tab[32] = t; tab[33] = t; }
    __syncthreads();
    for (int rt = otid(); rt < tab[33]; rt += 512) { int e = 0; while (tab[e + 1] <= rt) ++e; tab[128 + rt] = e; }
    __syncthreads();
}
constexpr int LDS_TAB = pg8::STAGE_BYTES;
__device__ __forceinline__ void phase7(const Params& p, LAS unsigned char* lds) {
    char* ws = p.ws; LAS int* tab = (LAS int*)(lds + LDS_TAB); moe_table((const int*)(ws + OFF_CNT), tab);
    pg8::MoeSched<true> S; S.nN = 8; S.G = gridDim.x; S.c = blockIdx.x; S.rowb = 1024; S.Wt = ws + OFF_WT_GU; S.wexp = (size_t)2048 * 1024; S.btile = (size_t)256 * 1024; S.tab = tab; S.list = (const int*)(ws + OFF_LIST);
    pg8::EpiMoe1 E{(unsigned char*)(ws + OFF_ACT), p.b_gu};
    pg8::gemm_phase<pg8::EpiMoe1, pg8::MoeSched<true>, true, 127, 122>(lds, (const char*)(ws + OFF_H), 1024, S, E);
}
__device__ __forceinline__ void phase8(const Params& p, LAS unsigned char* lds) {
    char* ws = p.ws; LAS int* tab = (LAS int*)(lds + LDS_TAB);
    pg8::MoeSched<false> S; S.nN = 4; S.G = gridDim.x; S.c = blockIdx.x; S.rowb = 1024; S.Wt = ws + OFF_WT_DN; S.wexp = (size_t)1024 * 1024; S.btile = (size_t)256 * 1024; S.tab = tab; S.list = (const int*)(ws + OFF_LIST);
    pg8::EpiMoe2 E{(bf16_t*)(ws + OFF_YP), p.b_dn};
    pg8::gemm_phase<pg8::EpiMoe2, pg8::MoeSched<false>, true, 125, 122>(lds, (const char*)(ws + OFF_ACT), 1024, S, E);
}
__device__ __forceinline__ void phase9(const Params& p, LAS unsigned char* lds) {
    char* ws = p.ws; const float* modv = (const float*)(ws + OFF_MOD); const bf16_t* yp = (const bf16_t*)(ws + OFF_YP); const float* topp = (const float*)(ws + OFF_TOPP);
    const int* topi = (const int*)(ws + OFF_TOPI); const int* pairpos = (const int*)(ws + OFF_ROWPAIR);
    LAS int* tab = (LAS int*)(lds + LDS_TAB);
    const int tid = otid(), lane = tid & 63, gw = blockIdx.x * 8 + (tid >> 6), nw = gridDim.x * 8, c0 = lane * 8;
    f32x4 fg[4];
#pragma unroll
    for (int q = 0; q < 4; ++q) fg[q] = *(const f32x4*)(p.g_fin + (q >> 1) * 512 + c0 + (q & 1) * 4);
    for (int row = gw; row < L; row += nw) {
        const float* gate = modv + (row / SEQ) * 6144 + 5 * 1024; f32x4 v[4]; u32x4 yr[4][2];
        const pg8::i32x4_t ek = *(const pg8::i32x4_t*)(topi + row * 4), pk4 = *(const pg8::i32x4_t*)(pairpos + row * 4);
#pragma unroll
        for (int j = 0; j < 2; ++j) { float t8[8]; unpack8(*(const u32x4*)((const bf16_t*)(ws + OFF_X1) + (size_t)row * D + j * 512 + c0), t8); v[2 * j] = (f32x4){t8[0], t8[1], t8[2], t8[3]}; v[2 * j + 1] = (f32x4){t8[4], t8[5], t8[6], t8[7]}; }
#pragma unroll
        for (int k = 0; k < 4; ++k) { const size_t yrow = (size_t)tab[ek[k]] * 256 + pk4[k];
#pragma unroll
            for (int j = 0; j < 2; ++j) yr[k][j] = __builtin_nontemporal_load((const u32x4*)(yp + yrow * D + j * 512 + c0)); }
        const f32x4 pk = *(const f32x4*)(topp + row * 4);
        float m[16];
#pragma unroll
        for (int i = 0; i < 16; ++i) m[i] = 0.f;
#pragma unroll
        for (int k = 0; k < 4; ++k)
#pragma unroll
            for (int j = 0; j < 2; ++j) { float t[8]; unpack8(yr[k][j], t);
#pragma unroll
                for (int i = 0; i < 8; ++i) m[j * 8 + i] += pk[k] * t[i]; }
        float ss = 0.f;
#pragma unroll
        for (int q = 0; q < 4; ++q) { const f32x4 gt = *(const f32x4*)(gate + (q >> 1) * 512 + c0 + (q & 1) * 4);
#pragma unroll
            for (int i = 0; i < 4; ++i) { v[q][i] += gt[i] * m[q * 4 + i]; ss += v[q][i] * v[q][i]; } }
        const float rs = rsqrtf(wave_sum(ss) * (1.0f / D) + EPS);
#pragma unroll
        for (int q = 0; q < 4; ++q) __builtin_nontemporal_store(v[q] * rs * fg[q], (f32x4*)(p.out + (size_t)row * D + (q >> 1) * 512 + c0 + (q & 1) * 4));
    }
}

namespace at {
using s16x4  = __attribute__((ext_vector_type(4))) short;
constexpr int NW = 8, QBLK = 32, KVBLK = 64, DK = 192, DV = 128;
constexpr float SCALE = 0.07216878364870322f;
constexpr float THR = 8.f;
constexpr int SHM_V = KVBLK * DV * 2, SHM_K = KVBLK * DK * 2, SHM_ATTN = 2 * SHM_V + 2 * SHM_K + NW * 64 * 4;
#define KSWZ(row, colB) ((row) * 384 + ((colB) ^ ((((row) ^ ((row) >> 3)) & 7) << 4)))
#define SBAR() __builtin_amdgcn_sched_barrier(0)
__device__ __forceinline__ int crow(int r, int hi) { return (r & 3) + 8 * (r >> 2) + 4 * hi; }
__device__ __forceinline__ unsigned cvtpk(float lo, float hi) { return cvt_pk_bf16(lo, hi); }

__device__ __forceinline__ void partialSM(f32x16& p0, f32x16& p1, float& m_reg, float& mn, float& alpha) {
  constexpr float C = SCALE * 1.4426950408889634f;
  float pmax = p0[0];
#pragma unroll
  for (int r = 1; r < 16; ++r) pmax = fmaxf(pmax, p0[r]);
#pragma unroll
  for (int r = 0; r < 16; ++r) pmax = fmaxf(pmax, p1[r]);
  { auto rr = __builtin_amdgcn_permlane32_swap(__float_as_uint(pmax), __float_as_uint(pmax), false, false);
    pmax = fmaxf(__uint_as_float(rr[0]), __uint_as_float(rr[1])); }
  if (__builtin_expect(__all(pmax - m_reg <= THR / SCALE), 1)) { mn = m_reg; alpha = 1.f; }
  else { mn = fmaxf(m_reg, pmax); alpha = __builtin_amdgcn_exp2f((m_reg - mn) * C); m_reg = mn; }
  float mnC = -mn * C;
#pragma unroll
  for (int r = 0; r < 16; ++r) p0[r] = fmaf(p0[r], C, mnC);
#pragma unroll
  for (int r = 0; r < 16; ++r) p1[r] = fmaf(p1[r], C, mnC);
#pragma unroll
  for (int r = 0; r < 16; ++r) p0[r] = __builtin_amdgcn_exp2f(p0[r]);
}
__device__ __forceinline__ void finishSM(f32x16& p0, f32x16& p1, float alpha, float& l_reg, bf16x8& pa0, bf16x8& pa1, bf16x8& pa2, bf16x8& pa3) {
#pragma unroll
  for (int r = 0; r < 16; ++r) p1[r] = __builtin_amdgcn_exp2f(p1[r]);
  float ps = 0;
#pragma unroll
  for (int r = 0; r < 16; ++r) ps += p0[r];
#pragma unroll
  for (int r = 0; r < 16; ++r) ps += p1[r];
  { auto rr = __builtin_amdgcn_permlane32_swap(__float_as_uint(ps), __float_as_uint(ps), false, false);
    ps = __uint_as_float(rr[0]) + __uint_as_float(rr[1]); }
  l_reg = l_reg * alpha + ps;
#define PK4(P, BASE, OUT) do { unsigned a0 = cvtpk(P[BASE + 0], P[BASE + 1]), a1 = cvtpk(P[BASE + 2], P[BASE + 3]);   \
    unsigned b0 = cvtpk(P[BASE + 4], P[BASE + 5]), b1 = cvtpk(P[BASE + 6], P[BASE + 7]);                              \
    auto r0 = __builtin_amdgcn_permlane32_swap(a0, b0, false, false); auto r1 = __builtin_amdgcn_permlane32_swap(a1, b1, false, false); \
    u32x4 w = {r0[0], r1[0], r0[1], r1[1]}; OUT = *reinterpret_cast<bf16x8*>(&w); } while (0)
  PK4(p0, 0, pa0); PK4(p0, 8, pa1); PK4(p1, 0, pa2); PK4(p1, 8, pa3);
#undef PK4
}
__device__ __forceinline__ void qkt(f32x16& p0, f32x16& p1, const LAS char* Ks, const bf16x8 (&qr)[12], int r32, int hi) {
  p0 = f32x16{}; p1 = f32x16{};
#pragma unroll
  for (int d0 = 0; d0 < 12; ++d0) { const int cb = (d0 * 16 + hi * 8) * 2;
    const bf16x8 b0 = *reinterpret_cast<const LAS bf16x8*>(Ks + KSWZ(r32, cb));
    const bf16x8 b1 = *reinterpret_cast<const LAS bf16x8*>(Ks + KSWZ(32 + r32, cb));
    p0 = __builtin_amdgcn_mfma_f32_32x32x16_bf16(b0, qr[d0], p0, 0, 0, 0);
    p1 = __builtin_amdgcn_mfma_f32_32x32x16_bf16(b1, qr[d0], p1, 0, 0, 0); }
}
__device__ __forceinline__ int v_st(int k, int c) { const int kk = (k & ~0xC) | ((k & 4) << 1) | ((k & 8) >> 1); return ((kk >> 3) * 4 + (c >> 5)) * 512 + ((kk & 7) * 32 + (c & 31)) * 2; }
__device__ __forceinline__ int v_rd_base(int lane) { return ((lane & 3) << 3) | (((lane >> 2) & 3) << 6) | (((lane >> 4) & 1) << 5) | (((lane >> 5) & 1) << 8); }
constexpr int v_rd_off(int d0, int ks, int half) { return d0 * 512 + ks * 4096 + half * 2048; }
template <int OFF> __device__ __forceinline__ s16x4 tr_read(int vb) { s16x4 r; asm volatile("ds_read_b64_tr_b16 %0, %1 offset:%2" : "=&v"(r) : "v"(vb), "i"(OFF) : "memory"); return r; }
template <int D0> __device__ __forceinline__ void pv_one(f32x16& od, int vb, bf16x8 pa0, bf16x8 pa1, bf16x8 pa2, bf16x8 pa3) {
  const s16x4 l0 = tr_read<v_rd_off(D0, 0, 0)>(vb), h0 = tr_read<v_rd_off(D0, 0, 1)>(vb), l1 = tr_read<v_rd_off(D0, 1, 0)>(vb), h1 = tr_read<v_rd_off(D0, 1, 1)>(vb);
  const s16x4 l2 = tr_read<v_rd_off(D0, 2, 0)>(vb), h2 = tr_read<v_rd_off(D0, 2, 1)>(vb), l3 = tr_read<v_rd_off(D0, 3, 0)>(vb), h3 = tr_read<v_rd_off(D0, 3, 1)>(vb);
  asm volatile("s_waitcnt lgkmcnt(0)" ::: "memory"); SBAR();
#define PK(Lo, Hi) (bf16x8){Lo[0], Lo[1], Lo[2], Lo[3], Hi[0], Hi[1], Hi[2], Hi[3]}
  od = __builtin_amdgcn_mfma_f32_32x32x16_bf16(pa0, PK(l0, h0), od, 0, 0, 0);
  od = __builtin_amdgcn_mfma_f32_32x32x16_bf16(pa1, PK(l1, h1), od, 0, 0, 0);
  od = __builtin_amdgcn_mfma_f32_32x32x16_bf16(pa2, PK(l2, h2), od, 0, 0, 0);
  od = __builtin_amdgcn_mfma_f32_32x32x16_bf16(pa3, PK(l3, h3), od, 0, 0, 0);
#undef PK
}
__device__ __forceinline__ void pv_d0(f32x16 (&o)[4], int vb, bf16x8 pa0, bf16x8 pa1, bf16x8 pa2, bf16x8 pa3) {
  pv_one<0>(o[0], vb, pa0, pa1, pa2, pa3); pv_one<1>(o[1], vb, pa0, pa1, pa2, pa3); pv_one<2>(o[2], vb, pa0, pa1, pa2, pa3); pv_one<3>(o[3], vb, pa0, pa1, pa2, pa3);
}

__device__ __forceinline__ void attn_unit(const bf16_t* __restrict__ Qb, const bf16_t* __restrict__ Kh, const bf16_t* __restrict__ Vh, bf16_t* __restrict__ Ob, int t0, const float* __restrict__ ropet, LAS char* lds) {
  constexpr int LDQ = 1536, LDO = 1024, NT = NKEY / KVBLK;
  const int tid = otid(), wid = tid >> 6, lane = tid & 63, r32 = lane & 31, hi = lane >> 5;
  LAS char* V_lds = lds; LAS char* K_lds = lds + 2 * SHM_V;
  LAS float* wsl = (LAS float*)(lds + 2 * SHM_V + 2 * SHM_K) + wid * 64; LAS float* li_l = wsl; LAS float* al_l = wsl + 32;
  float m_reg = -1e30f, l_reg = 0; f32x16 o[4] = {}; bf16x8 qr[12];
  { const bf16_t* Qw = Qb + (size_t)(wid * QBLK + r32) * LDQ + hi * 8;
#pragma unroll
    for (int d0 = 0; d0 < 12; ++d0) qr[d0] = *reinterpret_cast<const bf16x8*>(Qw + d0 * 16);
    const float* rt = ropet + (size_t)(t0 + wid * QBLK + r32) * 64 + 8 * hi;
#pragma unroll
    for (int g = 0; g < 2; ++g) {
      const f32x4 c0 = *(const f32x4*)(rt + 16 * g), c1 = *(const f32x4*)(rt + 16 * g + 4), s0 = *(const f32x4*)(rt + 32 + 16 * g), s1 = *(const f32x4*)(rt + 32 + 16 * g + 4);
      float n1[8], n2[8];
#pragma unroll
      for (int j = 0; j < 8; ++j) { const float cs = j < 4 ? c0[j & 3] : c1[j & 3], sn = j < 4 ? s0[j & 3] : s1[j & 3];
        const float x1 = bf2f((bf16_t)qr[8 + g][j]), x2 = bf2f((bf16_t)qr[10 + g][j]); n1[j] = x1 * cs - x2 * sn; n2[j] = x1 * sn + x2 * cs; }
      u32x4 w1 = {cvtpk(n1[0], n1[1]), cvtpk(n1[2], n1[3]), cvtpk(n1[4], n1[5]), cvtpk(n1[6], n1[7])}; u32x4 w2 = {cvtpk(n2[0], n2[1]), cvtpk(n2[2], n2[3]), cvtpk(n2[4], n2[5]), cvtpk(n2[6], n2[7])};
      qr[8 + g] = *reinterpret_cast<bf16x8*>(&w1); qr[10 + g] = *reinterpret_cast<bf16x8*>(&w2); } }
  const int sr = tid >> 4, sc = (tid & 15) * 8, vst0 = v_st(sr, sc), vst1 = v_st(32 + sr, sc);
  int kgo[3], kst[3];
#pragma unroll
  for (int i = 0; i < 3; ++i) { const int c = tid + 512 * i, row = c / 24, c8 = (c % 24) * 8; kgo[i] = row * DK + c8; kst[i] = KSWZ(row, c8 * 2); }
  const int vb0 = (int)(uintptr_t)V_lds + v_rd_base(lane);
  bf16x8 sv0, sv1, sk0, sk1, sk2;
#define SLOAD(k0) do { sv0 = *reinterpret_cast<const bf16x8*>(&Vh[(size_t)((k0) + sr) * DV + sc]); sv1 = *reinterpret_cast<const bf16x8*>(&Vh[(size_t)((k0) + 32 + sr) * DV + sc]); \
    sk0 = *reinterpret_cast<const bf16x8*>(&Kh[(size_t)(k0) * DK + kgo[0]]); sk1 = *reinterpret_cast<const bf16x8*>(&Kh[(size_t)(k0) * DK + kgo[1]]); sk2 = *reinterpret_cast<const bf16x8*>(&Kh[(size_t)(k0) * DK + kgo[2]]); } while (0)
#define SWRITE(b) do { *(LAS bf16x8*)(V_lds + (b) * SHM_V + vst0) = sv0; *(LAS bf16x8*)(V_lds + (b) * SHM_V + vst1) = sv1; \
    *(LAS bf16x8*)(K_lds + (b) * SHM_K + kst[0]) = sk0; *(LAS bf16x8*)(K_lds + (b) * SHM_K + kst[1]) = sk1; *(LAS bf16x8*)(K_lds + (b) * SHM_K + kst[2]) = sk2; } while (0)
#define RESC(a) do { if (__any((a) < 1.f)) { if (hi == 0) al_l[r32] = (a); asm volatile("s_waitcnt lgkmcnt(0)" ::: "memory"); \
    _Pragma("unroll") for (int d = 0; d < 4; ++d) _Pragma("unroll") for (int r = 0; r < 16; ++r) o[d][r] *= al_l[crow(r, hi)]; } } while (0)
  f32x16 p0, p1; float mn, al; bf16x8 pa0, pa1, pa2, pa3;
  SLOAD(0); asm volatile("s_waitcnt vmcnt(0)" ::: "memory"); SWRITE(0); __syncthreads();
  for (int j = 0; j < NT; ++j) {
    const int bsel = j & 1;
    if (j + 1 < NT) SLOAD((j + 1) * KVBLK);
    SBAR(); qkt(p0, p1, K_lds + bsel * SHM_K, qr, r32, hi);
    partialSM(p0, p1, m_reg, mn, al);
    RESC(al);
    finishSM(p0, p1, al, l_reg, pa0, pa1, pa2, pa3); SBAR();
    pv_d0(o, vb0 + bsel * SHM_V, pa0, pa1, pa2, pa3);
    if (j + 1 < NT) { asm volatile("s_waitcnt vmcnt(0)" ::: "memory"); SWRITE(bsel ^ 1); }
    __syncthreads();
  }
  if (hi == 0) li_l[r32] = l_reg; asm volatile("s_waitcnt lgkmcnt(0)" ::: "memory");
  float rli[16];
#pragma unroll
  for (int r = 0; r < 16; ++r) rli[r] = __builtin_amdgcn_rcpf(li_l[crow(r, hi)]);
  { LAS bf16_t* ot = (LAS bf16_t*)(lds + wid * 8192);
#pragma unroll
    for (int r = 0; r < 16; ++r) { const int orow = crow(r, hi);
#pragma unroll
      for (int d0 = 0; d0 < 4; ++d0) ot[orow * 128 + d0 * 32 + r32] = f2bf(o[d0][r] * rli[r]); }
    asm volatile("s_waitcnt lgkmcnt(0)" ::: "memory");
    bf16_t* Ow = Ob + (size_t)(wid * QBLK) * LDO;
#pragma unroll
    for (int i = 0; i < 8; ++i) { const int q = lane + 64 * i, row = q >> 4, ch = q & 15; const u32x4 w = *(const LAS u32x4*)(ot + row * 128 + ch * 8); *(u32x4*)(Ow + (size_t)row * LDO + ch * 8) = w; } }
#undef SLOAD
#undef SWRITE
#undef RESC
}
}

__device__ __forceinline__ void phase_attn(const Params& p, LAS unsigned char* lds) {
    char* ws = p.ws; const bf16_t* Q = (const bf16_t*)(ws + OFF_Q); const bf16_t* Kb = (const bf16_t*)(ws + OFF_K); const bf16_t* Vb = (const bf16_t*)(ws + OFF_V); bf16_t* Y = (bf16_t*)(ws + OFF_H);
    const int G = gridDim.x;
    for (int it = 0;; ++it) {
        int u;
        if (G == 256) { const int c = blockIdx.x, xcd = c & 7, j = c >> 3; if (it >= 4) break; u = ((it * 32 + xcd * 4 + (j >> 3)) << 3) | (j & 7); }
        else { u = it * G + blockIdx.x; if (u >= 1024) break; }
        const int bh = u >> 3, qb = u & 7, b = bh >> 3, h = bh & 7;
        at::attn_unit(Q + ((size_t)(b * SEQ + qb * 256)) * 1536 + h * 192, Kb + (size_t)bh * NKEY * 192, Vb + (size_t)bh * NKEY * 128, Y + ((size_t)(b * SEQ + qb * 256)) * D + h * 128, qb * 256, (const float*)(ws + OFF_ROPE), (LAS char*)lds);
        __syncthreads();
    }
}

namespace sc {
using f32x16 = __attribute__((ext_vector_type(16))) float;
constexpr int BUFB = 53248, O_QT = 0, O_KH = 16384, O_VT = 32768, O_AT = 49152, O_DEC = 51200, O_KD = 2 * BUFB, O_OUT = 2 * BUFB + 16384, LDS_SCAN = 2 * BUFB + 16384 + 2 * 16384;
__device__ __forceinline__ int sw256(int row, int cb) { return row * 256 + (cb ^ ((row & 15) << 4)); }
__device__ __forceinline__ int sw128(int row, int cb) { return row * 128 + (cb ^ (((row >> 1) & 7) << 4)); }
__device__ __forceinline__ int grow_of(int n, int b, int dir) { if (n < CTXL) { const int s = dir ? (CTXL - 1 - n) : n; return L + b * CTXL + s; } const int m = n - CTXL; return b * SEQ + (dir ? (SEQ - 1 - m) : m); }
__device__ __forceinline__ bf16x8 pack_acc8(const f32x16& x, int s) { u32x4 p; p.x = cvt_pk_bf16(x[8 * s], x[8 * s + 1]); p.y = cvt_pk_bf16(x[8 * s + 2], x[8 * s + 3]); p.z = cvt_pk_bf16(x[8 * s + 4], x[8 * s + 5]); p.w = cvt_pk_bf16(x[8 * s + 6], x[8 * s + 7]); return __builtin_bit_cast(bf16x8, p); }

__device__ __forceinline__ void scan_unit(const Params& p, int unit, LAS unsigned char* lds) {
    char* ws = p.ws; const int dir = unit & 1, h = (unit >> 1) & 7, b = unit >> 4;
    const bf16_t* hq = (const bf16_t*)(ws + OFF_HQ); const bf16_t* fz = (const bf16_t*)(ws + (dir ? OFF_FB : OFF_FF)); const bf16_t* iv = (const bf16_t*)(ws + OFF_IV);
    bf16_t* outp = (bf16_t*)(ws + (dir ? OFF_OB : OFF_OF)); const float* lb = (const float*)(ws + OFF_LB);
    const int tid = otid(), wid = __builtin_amdgcn_readfirstlane(tid >> 6), lane = tid & 63, r32 = lane & 31, hi = lane >> 5;
    const int sgn = dir ? -1 : 1; const long rstep = (long)sgn * D;
    __syncthreads();
    if (wid >= 4) {
        const int I = wid - 4, cp = lane, hc = h * 128 + 2 * cp;
        const float lbv0 = lb[dir * 1024 + hc], lbv1 = lb[dir * 1024 + hc + 1];
        unsigned zr[16], vr[16], qr[16];
#define SC_LOAD(c) do { const size_t o0_ = (size_t)(grow_of((c) * 64, b, dir) + sgn * (16 * I)) * D + hc; const bf16_t* pz_ = fz + o0_; const bf16_t* pv_ = iv + o0_; const bf16_t* pq_ = hq + o0_; \
        _Pragma("unroll") for (int i = 0; i < 16; ++i) { zr[i] = *(const unsigned*)pz_; pz_ += rstep; vr[i] = *(const unsigned*)pv_; pv_ += rstep; if ((c) >= 4) { qr[i] = *(const unsigned*)pq_; pq_ += rstep; } } } while (0)
        SC_LOAD(0);
        for (int it = 0; it <= 37; ++it) {
            if (it >= 6) {
                const int c = it - 2; const LAS unsigned char* OB = lds + O_OUT + (c & 1) * 16384; const int pt = I * 64 + lane;
                bf16_t* ob = outp + (size_t)grow_of(c * 64, b, dir) * D + h * 128;
#pragma unroll
                for (int q = 0; q < 4; ++q) { const int item = q * 256 + pt, t = item >> 4, c16 = item & 15;
                    *(u32x4*)(ob + (long)t * rstep + c16 * 8) = *(const LAS u32x4*)(OB + t * 256 + c16 * 16); }
            }
            if (it < 36) {
                const int c = it; const bool lat = c >= 4; LAS unsigned char* B = lds + (c & 1) * BUFB; LAS unsigned char* KD = lds + O_KD;
                float kk0[16], kk1[16], lc0[16], lc1[16]; float run0 = 0.f, run1 = 0.f;
#pragma unroll
                for (int i = 0; i < 16; ++i) { const float z0 = __uint_as_float(zr[i] << 16), z1 = __uint_as_float(zr[i] & 0xffff0000u);
                    const float f0 = lbv0 + (1.0f - lbv0) * sigmoidf_(z0), f1 = lbv1 + (1.0f - lbv1) * sigmoidf_(z1); kk0[i] = 1.0f - f0; kk1[i] = 1.0f - f1;
                    run0 += __builtin_amdgcn_logf(f0) * 0.6931471805599453f; run1 += __builtin_amdgcn_logf(f1) * 0.6931471805599453f; lc0[i] = run0; lc1[i] = run1; }
                *(LAS f32x2*)(B + O_DEC + (I * 128 + 2 * cp) * 4) = (f32x2){__expf(run0), __expf(run1)};
                unsigned kh0[8], kh1[8], vt0[8], vt1[8];
#pragma unroll
                for (int i = 0; i < 16; ++i) { const int t = 16 * I + i; const float l0 = lc0[i], l1 = lc1[i];
                    const float kd0 = kk0[i] * __expf(fminf(-l0, 80.0f)), kd1 = kk1[i] * __expf(fminf(-l1, 80.0f));
                    const float kf0 = kk0[i] * __expf(run0 - l0), kf1 = kk1[i] * __expf(run1 - l1);
                    if (lat) { const float q0 = __uint_as_float(qr[i] << 16), q1 = __uint_as_float(qr[i] & 0xffff0000u);
                        *(LAS unsigned*)(B + O_QT + sw256(t, 4 * cp)) = cvt_pk_bf16(q0 * __expf(l0), q1 * __expf(l1)); *(LAS unsigned*)(KD + sw256(t, 4 * cp)) = cvt_pk_bf16(kd0, kd1); }
                    if (i & 1) { kh0[i >> 1] = cvt_pk_bf16(__uint_as_float(kh0[i >> 1]), kf0); kh1[i >> 1] = cvt_pk_bf16(__uint_as_float(kh1[i >> 1]), kf1); vt0[i >> 1] = (vt0[i >> 1] >> 16) | (vr[i] << 16); vt1[i >> 1] = (vt1[i >> 1] >> 16) | (vr[i] & 0xffff0000u); }
                    else { kh0[i >> 1] = __float_as_uint(kf0); kh1[i >> 1] = __float_as_uint(kf1); vt0[i >> 1] = vr[i] << 16; vt1[i >> 1] = vr[i] & 0xffff0000u; } }
#pragma unroll
                for (int q = 0; q < 2; ++q) {
                    *(LAS u32x4*)(B + O_KH + sw128(2 * cp, 32 * I + 16 * q)) = (u32x4){kh0[4 * q], kh0[4 * q + 1], kh0[4 * q + 2], kh0[4 * q + 3]}; *(LAS u32x4*)(B + O_KH + sw128(2 * cp + 1, 32 * I + 16 * q)) = (u32x4){kh1[4 * q], kh1[4 * q + 1], kh1[4 * q + 2], kh1[4 * q + 3]};
                    *(LAS u32x4*)(B + O_VT + sw128(2 * cp, 32 * I + 16 * q)) = (u32x4){vt0[4 * q], vt0[4 * q + 1], vt0[4 * q + 2], vt0[4 * q + 3]}; *(LAS u32x4*)(B + O_VT + sw128(2 * cp + 1, 32 * I + 16 * q)) = (u32x4){vt1[4 * q], vt1[4 * q + 1], vt1[4 * q + 2], vt1[4 * q + 3]}; }
                if (it + 1 < 36) SC_LOAD(it + 1);
                if (lat) {
                    const int l15 = lane & 15, lq = lane >> 4; f32x4 a = {0.f, 0.f, 0.f, 0.f};
#pragma unroll
                    for (int ks = 0; ks < 4; ++ks) { const bf16x8 av = *(const LAS bf16x8*)(B + O_QT + sw256(16 * I + l15, (32 * ks + 8 * lq) * 2)); const bf16x8 bv = *(const LAS bf16x8*)(KD + sw256(16 * I + l15, (32 * ks + 8 * lq) * 2));
                        a = __builtin_amdgcn_mfma_f32_16x16x32_bf16(av, bv, a, 0, 0, 0); }
#pragma unroll
                    for (int r = 0; r < 4; ++r) { const int tl = 4 * lq + r; float v = a[r]; if (l15 > tl) v = 0.f; *(LAS bf16_t*)(B + O_AT + ((I * 16 + tl) * 16 + l15) * 2) = f2bf(v); }
                }
            }
            lds_sync();
        }
#undef SC_LOAD
    } else {
        const int bq = wid; f32x16 S[4];
#pragma unroll
        for (int a = 0; a < 4; ++a) S[a] = f32x16{};
        for (int it = 0; it <= 37; ++it) {
            if (it >= 1 && it <= 36) {
                const int c = it - 1; const bool lat = c >= 4; LAS unsigned char* B = lds + (c & 1) * BUFB;
                LAS bf16_t* po = (LAS bf16_t*)(lds + O_OUT + (c & 1) * 16384) + (4 * hi) * 128 + 32 * bq + r32;
#pragma unroll
                for (int I = 0; I < 4; ++I) {
                    const bf16x8 vtf = *(const LAS bf16x8*)(B + O_VT + sw128(32 * bq + r32, (16 * I + 8 * hi) * 2));
                    if (lat) {
                        f32x16 o = f32x16{};
#pragma unroll
                        for (int a = 0; a < 4; ++a)
#pragma unroll
                            for (int s = 0; s < 2; ++s) { const int dk0 = 32 * a + 16 * s + 4 * hi; const int row = 16 * I + (r32 & 15);
                                const u32x2 lo2 = *(const LAS u32x2*)(B + O_QT + sw256(row, dk0 * 2)), hi2 = *(const LAS u32x2*)(B + O_QT + sw256(row, (dk0 + 8) * 2));
                                const u32x4 av = {lo2.x, lo2.y, hi2.x, hi2.y};
                                o = __builtin_amdgcn_mfma_f32_32x32x16_bf16(__builtin_bit_cast(bf16x8, av), pack_acc8(S[a], s), o, 0, 0, 0); }
                        { const bf16x8 af = *(const LAS bf16x8*)(B + O_AT + ((I * 16 + (r32 & 15)) * 16 + 8 * hi) * 2); o = __builtin_amdgcn_mfma_f32_32x32x16_bf16(af, vtf, o, 0, 0, 0); }
#pragma unroll
                        for (int r = 0; r < 8; ++r) po[(16 * I + (r & 3) + 8 * (r >> 2)) * 128] = f2bf(o[r]);
                    }
#pragma unroll
                    for (int a = 0; a < 4; ++a) {
#pragma unroll
                        for (int g = 0; g < 4; ++g) { const f32x4 dc = *(const LAS f32x4*)(B + O_DEC + (I * 128 + 32 * a + 8 * g + 4 * hi) * 4); S[a][4 * g] *= dc[0]; S[a][4 * g + 1] *= dc[1]; S[a][4 * g + 2] *= dc[2]; S[a][4 * g + 3] *= dc[3]; }
                        const bf16x8 kf = *(const LAS bf16x8*)(B + O_KH + sw128(32 * a + r32, (16 * I + 8 * hi) * 2));
                        S[a] = __builtin_amdgcn_mfma_f32_32x32x16_bf16(kf, vtf, S[a], 0, 0, 0); }
                }
            }
            lds_sync();
        }
    }
    __syncthreads();
}
}
__device__ __forceinline__ void phase_scan(const Params& p, LAS unsigned char* lds) {
    for (int u = blockIdx.x; u < 256; u += gridDim.x) sc::scan_unit(p, u, lds);
}

constexpr int LDS_BYTES = 163840;
#include <cstdint>
#include <cstdlib>
#include <vector>

#define XB_TMO      128
#define XB_XCNT(j)  (256  + 64 * (j))
#define XB_XSUB(j)  (1280 + 64 * (j))
#define XB_XGEN(j)  (2304 + 64 * (j))
#define XB_TOP      3328
#define XB_TOPGEN   3392
#define XCD_BAR_WORDS 3456
#define XB_SPIN_CAP (1u << 18)

__device__ __forceinline__ unsigned xb_ld(unsigned* p)              { return __hip_atomic_load(p, __ATOMIC_RELAXED, __HIP_MEMORY_SCOPE_AGENT); }
__device__ __forceinline__ unsigned xb_add(unsigned* p, unsigned v) { return __hip_atomic_fetch_add(p, v, __ATOMIC_RELAXED, __HIP_MEMORY_SCOPE_AGENT); }
__device__ __forceinline__ unsigned xb_xcc_id() { return (unsigned)__builtin_amdgcn_s_getreg((3 << 11) | 20) & 0xFu; }
#define XB_SPIN(cond, bar) do { unsigned _sp = 0; while (cond) { __builtin_amdgcn_s_sleep(1); \
    if ((++_sp & 255u) == 0u) { if (xb_ld(&(bar)[XB_TMO])) break; if (_sp > XB_SPIN_CAP) { atomicAdd(&(bar)[XB_TMO], 1u); break; } } } } while (0)

struct XcdBarrier {
    unsigned* bar; unsigned x;
    volatile LAS unsigned* st;
};

__device__ __forceinline__ XcdBarrier xcd_barrier_post(unsigned* bar, volatile LAS unsigned* st) {
    XcdBarrier b; b.bar = bar; b.x = xb_xcc_id(); b.st = st;
    if (threadIdx.x == 0) (void)xb_add(&bar[XB_XCNT(b.x)], 1u);
    return b;
}
__device__ __forceinline__ void xcd_barrier_complete(unsigned* bar, unsigned x, unsigned& nloc, unsigned& nx) {
    const unsigned G = gridDim.x * gridDim.y * gridDim.z;
    unsigned sum, cnt, mine, sp = 0u;
    for (;;) {
        sum = 0u; cnt = 0u; mine = 0u;
#pragma unroll
        for (unsigned j = 0; j < 16; ++j) { const unsigned c = xb_ld(&bar[XB_XCNT(j)]); sum += c; cnt += (c > 0u) ? 1u : 0u; mine = (j == x) ? c : mine; }
        if (sum == G) break;
        __builtin_amdgcn_s_sleep(1);
        if ((++sp & 255u) == 0u) { if (xb_ld(&bar[XB_TMO])) break; if (sp > XB_SPIN_CAP) { atomicAdd(&bar[XB_TMO], 1u); break; } }
    }
    nloc = mine > 0u ? mine : 1u; nx = cnt > 0u ? cnt : 1u;
}

__device__ __forceinline__ void xcd_barrier(const XcdBarrier& b) {
    asm volatile("s_waitcnt vmcnt(0)" ::: "memory");
    __syncthreads();
    if (threadIdx.x == 0) {
        unsigned* bar = b.bar;
        __builtin_amdgcn_s_waitcnt(0);
        unsigned nloc = b.st[0], nx = b.st[1];
        if (nloc == 0u) { xcd_barrier_complete(bar, b.x, nloc, nx); b.st[0] = nloc; b.st[1] = nx; }
        const unsigned old = xb_add(&bar[XB_XSUB(b.x)], 1u);
        const unsigned gen = old / nloc;
        if (old + 1u == (gen + 1u) * nloc) {
            __builtin_amdgcn_fence(__ATOMIC_RELEASE, "agent");
            asm volatile("s_waitcnt vmcnt(0)" ::: "memory");
            const unsigned og = xb_add(&bar[XB_TOP], 1u);
            const unsigned tg = og / nx;
            if (og + 1u == (tg + 1u) * nx) xb_add(&bar[XB_TOPGEN], 1u);
            else XB_SPIN(xb_ld(&bar[XB_TOPGEN]) == tg, bar);
            __builtin_amdgcn_fence(__ATOMIC_ACQUIRE, "agent");
            xb_add(&bar[XB_XGEN(b.x)], 1u);
            asm volatile("s_waitcnt vmcnt(0)" ::: "memory");
        } else {
            XB_SPIN(xb_ld(&bar[XB_XGEN(b.x)]) == gen, bar);
            __builtin_amdgcn_fence(__ATOMIC_ACQUIRE, "agent");
            asm volatile("s_waitcnt vmcnt(0)" ::: "memory");
        }
    }
    __syncthreads();
}

__global__ void __launch_bounds__(512, 2) k_mega(Params p) {
    extern __shared__ __attribute__((aligned(16))) unsigned char smem[];
    LAS unsigned char* lds = (LAS unsigned char*)smem;
    volatile LAS unsigned* xbw = (volatile LAS unsigned*)(lds + LDS_BYTES - 16);
    if (threadIdx.x == 0) { xbw[0] = 0u; xbw[1] = 0u; xbw[2] = 0u; xbw[3] = 0u; }
    __syncthreads();
    XcdBarrier bar = xcd_barrier_post((unsigned*)(p.ws + OFF_BAR), xbw);
    phase0(p, lds);      xcd_barrier(bar);
    phase1(p, lds);      xcd_barrier(bar);
    phase2(p, lds);      xcd_barrier(bar);
    phase3(p, lds);      xcd_barrier(bar);
    phase_attn(p, lds);
    phase_scan(p, lds);  xcd_barrier(bar);
    phase4(p, lds);      xcd_barrier(bar);
    phase5(p, lds);      xcd_barrier(bar);
    phase6(p, lds);      xcd_barrier(bar);
    phase7(p, lds);      xcd_barrier(bar);
    phase8(p, lds);      xcd_barrier(bar);
    phase9(p, lds);
}
extern "C" void kernel_launch(void* const* d_in, const int* in_sizes, int n_in, void* d_out, int out_size, void* d_ws, size_t ws_size, hipStream_t stream) {
    static int grid = 0;
    if (grid == 0) {
        int dev = 0, cus = 0, per_cu = 0;
        if (hipGetDevice(&dev) != hipSuccess || hipDeviceGetAttribute(&cus, hipDeviceAttributeMultiprocessorCount, dev) != hipSuccess) { grid = -1; return; }
        if (hipFuncSetAttribute((const void*)k_mega, hipFuncAttributeMaxDynamicSharedMemorySize, LDS_BYTES) != hipSuccess) { grid = -1; return; }
        (void)hipOccupancyMaxActiveBlocksPerMultiprocessor(&per_cu, (const void*)k_mega, 512, LDS_BYTES);
        (void)hipGetLastError();
        grid = cus;
    }
    if (grid < 0) return;
    Params p{};
    p.x = (const float*)d_in[0]; p.c = (const float*)d_in[1]; p.ctx = (const float*)d_in[2]; p.cctx = (const float*)d_in[3]; p.w_mod = (const float*)d_in[4]; p.b_mod = (const float*)d_in[5];
    p.g_mix = (const float*)d_in[6]; p.w_in = (const float*)d_in[7]; p.g_q = (const float*)d_in[8]; p.w_qb = (const float*)d_in[9]; p.g_kv = (const float*)d_in[10]; p.w_kvb = (const float*)d_in[11];
    p.lbl = (const float*)d_in[12]; p.g_hg = (const float*)d_in[13]; p.w_out = (const float*)d_in[14]; p.g_ffn = (const float*)d_in[15]; p.w_r = (const float*)d_in[16]; p.b_r = (const float*)d_in[17];
    p.w_gu = (const float*)d_in[18]; p.b_gu = (const float*)d_in[19]; p.w_dn = (const float*)d_in[20]; p.b_dn = (const float*)d_in[21]; p.g_fin = (const float*)d_in[22];
    p.out = (float*)d_out; p.ws = (char*)d_ws;
    (void)hipMemsetAsync((char*)d_ws + OFF_BAR, 0, 16384, stream);
    hipLaunchKernelGGL(k_mega, dim3(grid), dim3(512), LDS_BYTES, stream, p);
}
```

```cpp
#include <hip/hip_runtime.h>
#include <stdint.h>

typedef unsigned short bf16_t;
__device__ __forceinline__ float bf2f(bf16_t v) { return __uint_as_float(((unsigned)v) << 16); }
__device__ __forceinline__ bf16_t f2bf(float f) { unsigned u = __float_as_uint(f); u += 0x7FFFu + ((u >> 16) & 1u); return (bf16_t)(u >> 16); }
__device__ __forceinline__ float sigmoidf_(float x) { return __builtin_amdgcn_rcpf(1.0f + __builtin_amdgcn_exp2f(-1.4426950408889634f * x)); }
__device__ __forceinline__ float siluf_(float x) { return x * __builtin_amdgcn_rcpf(1.0f + __builtin_amdgcn_exp2f(-1.4426950408889634f * x)); }

constexpr int D = 1024, NB = 16, SEQ = 2048, CTXL = 256;
constexpr int L = NB * SEQ;
constexpr int RC = NB * CTXL;
constexpr int R = L + RC;
constexpr int NKEY = SEQ + CTXL;
constexpr float EPS = 1e-6f;
constexpr int NE = 32, CAP = 32768;
constexpr int MAXROWS = 131072 + NE * 256;

constexpr size_t MiB = 1048576;
constexpr size_t OFF_SMALL = 0;
constexpr size_t OFF_BAR = 0;
constexpr size_t OFF_CNT = 16384;
constexpr size_t OFF_OFFS = 16384 + 1024;
constexpr size_t OFF_TILEE = 16384 + 2048;
constexpr size_t OFF_LB = 24576;
constexpr size_t OFF_MOD = 32768;
constexpr size_t OFF_SSQQ = 512 * 1024;
constexpr size_t OFF_SSQKV = 768 * 1024;
constexpr size_t OFF_TOPI = 1 * MiB;
constexpr size_t OFF_TOPP = 1 * MiB + 512 * 1024;
constexpr size_t OFF_ROWPAIR = 2 * MiB;
constexpr size_t OFF_LIST = 3 * MiB;
constexpr size_t OFF_H = 32 * MiB;
constexpr size_t OFF_QA = 104 * MiB;
constexpr size_t OFF_CKV = 152 * MiB;
constexpr size_t OFF_KR = 170 * MiB;
constexpr size_t OFF_OF = 104 * MiB;
constexpr size_t OFF_HQ = 175 * MiB;
constexpr size_t SEG_STRIDE = 72 * MiB;
constexpr size_t OFF_FF = OFF_HQ + 1 * SEG_STRIDE;
constexpr size_t OFF_FB = OFF_HQ + 2 * SEG_STRIDE;
constexpr size_t OFF_IV = OFF_HQ + 3 * SEG_STRIDE;
constexpr size_t OFF_OG = OFF_HQ + 4 * SEG_STRIDE;
constexpr size_t OFF_GM = OFF_HQ + 5 * SEG_STRIDE;
constexpr size_t OFF_GH = OFF_HQ + 6 * SEG_STRIDE;
constexpr size_t OFF_Q = 679 * MiB;
constexpr size_t OFF_K = 775 * MiB;
constexpr size_t OFF_V = 883 * MiB;
constexpr size_t OFF_OB = 955 * MiB;
constexpr size_t OFF_YP = 296 * MiB;
constexpr size_t OFF_ACT = 568 * MiB;


__device__ __forceinline__ void rope_cs(int t, int i, float& cs, float& sn) {
    int j = i & 15; float inv = __expf(-(float)j * (9.210340371976184f / 16.0f)); float pos = (i < 16) ? (float)(t >> 6) : (float)(t & 63);
    float ang = pos * inv; cs = cosf(ang); sn = sinf(ang);
}

#define LAS __attribute__((address_space(3)))
__device__ __forceinline__ int otid() { int t = threadIdx.x; asm volatile("" : "+v"(t)); return t; }
typedef short bf16x8 __attribute__((ext_vector_type(8)));
typedef float f32x4 __attribute__((ext_vector_type(4)));
typedef unsigned u32x4 __attribute__((ext_vector_type(4)));
typedef unsigned u32x2 __attribute__((ext_vector_type(2)));
typedef float f32x2 __attribute__((ext_vector_type(2)));
using f32x16 = __attribute__((ext_vector_type(16))) float;

constexpr size_t OFF_ROPE = 7 * MiB;
constexpr size_t OFF_WT_IN = 8 * MiB;
constexpr size_t OFF_WT_QB = 25 * MiB;
constexpr size_t OFF_WT_KVB = 28 * MiB;
constexpr size_t OFF_WT_OUT = 29 * MiB;
constexpr size_t OFF_WT_GU = 104 * MiB;
constexpr size_t OFF_WT_DN = 232 * MiB;
constexpr size_t OFF_YF8 = 775 * MiB;
constexpr size_t OFF_X1 = 704 * MiB;

struct Params {
    const float *x, *c, *ctx, *cctx, *w_mod, *b_mod, *g_mix, *w_in, *g_q, *w_qb, *g_kv, *w_kvb, *lbl, *g_hg, *w_out, *g_ffn, *w_r, *b_r, *w_gu, *b_gu, *w_dn, *b_dn, *g_fin;
    float* out; char* ws;
};

typedef __bf16 bf16v2_t __attribute__((ext_vector_type(2)));
__device__ __forceinline__ unsigned cvt_pk_bf16(float lo, float hi) { bf16v2_t v = {(__bf16)lo, (__bf16)hi}; return __builtin_bit_cast(unsigned, v); }

__device__ __forceinline__ unsigned pack4_fp8(float a, float b, float c, float d) {
    a = __builtin_amdgcn_fmed3f(a, -448.f, 448.f); b = __builtin_amdgcn_fmed3f(b, -448.f, 448.f); c = __builtin_amdgcn_fmed3f(c, -448.f, 448.f); d = __builtin_amdgcn_fmed3f(d, -448.f, 448.f);
    unsigned w = 0; w = __builtin_amdgcn_cvt_pk_fp8_f32(a, b, w, false); w = __builtin_amdgcn_cvt_pk_fp8_f32(c, d, w, true); return w; }

namespace pg8 {
constexpr int BM = 256, BK = 64, HALF = 128, HTB = HALF * BK * 2, STAGE_BYTES = 8 * HTB, NXCD = 8, WGM = 8;
constexpr int LDS_IDX = STAGE_BYTES + 8192;
__device__ __forceinline__ int lds_byte(int r, int c) { const int st = (r >> 4) * 2 + (c >> 5), rr = r & 15, cc = c & 31, ob = rr * 64 + cc * 2; return st * 1024 + (ob ^ (((ob >> 9) & 1) << 5)); }
__device__ __forceinline__ void stage_rc(int b, int& R, int& C) { const int st = b / 1024, sb = b % 1024, swz = sb ^ (((sb >> 9) & 1) << 5); R = (st >> 1) * 16 + swz / 64; C = (st & 1) * 32 + (swz % 64) / 2; }
__device__ __forceinline__ int perm32(int rho) { const int n = rho >> 4, i = rho & 15; return 8 * (i >> 2) + 4 * n + (i & 3); }
struct Unit { int pm, pn; const char* b; int e, pos0, cnt; };

__device__ __forceinline__ int xcd_remap(int L, int nwg) { const int q = nwg / NXCD, r = nwg % NXCD, xcd = L % NXCD, off = L / NXCD; return (xcd < r ? xcd * (q + 1) : r * (q + 1) + (xcd - r) * q) + off; }

struct DenseSched {
    int nM, nN, nwg, G, c, rowb; const char* Bt; size_t btile;
    __device__ void init(int M, int N, int kbytes, int rowb_, const void* Bt_, int G_, int c_) { nM = M / BM; nN = N / BM; nwg = nM * nN; G = G_; c = c_; rowb = rowb_; Bt = (const char*)Bt_; btile = (size_t)BM * kbytes; }
    static constexpr bool GATHER_LDS = false;
    __device__ __forceinline__ int kstepA() const { return 128; }
    __device__ __forceinline__ void tile(int wgid, int& pm, int& pn) const { const int nig = WGM * nN, gid = wgid / nig, fm = gid * WGM, gsz = (nM - fm) < WGM ? (nM - fm) : WGM; pm = fm + ((wgid % nig) % gsz); pn = (wgid % nig) / gsz; }
    __device__ __forceinline__ bool next(int i, Unit& u) const { const int Lx = i * G + c; if (Lx >= nwg) return false; tile(xcd_remap(Lx, nwg), u.pm, u.pn); u.b = Bt + (size_t)u.pn * btile; u.e = 0; u.pos0 = 0; u.cnt = 0; return true; }
    __device__ __forceinline__ void aoff(const Unit& u, const int (&Rr)[2], const int (&Cc)[2], unsigned (&va)[2][2]) const {
#pragma unroll
        for (int h = 0; h < 2; ++h)
#pragma unroll
            for (int i = 0; i < 2; ++i) va[h][i] = (unsigned)((u.pm * BM + h * HALF + Rr[i]) * rowb + Cc[i] * 2); }
};
struct InSched : DenseSched {
    __device__ void init2(const void* Bt_, int G_, int c_) { init(L, 8448, 1024, 1024, Bt_, G_, c_); }
    __device__ __forceinline__ bool next(int i, Unit& u) const {
        const int Lx = i * G + c; const int nlat = nwg;
        if (Lx < nlat) { tile(xcd_remap(Lx, nlat), u.pm, u.pn); }
        else { const int j = Lx - nlat; if (j >= 16 * 14) return false; const int q = j >> 4; u.pm = 128 + (j & 15); u.pn = q == 0 ? 3 : (q <= 12 ? 7 + q : 32); }
        u.b = Bt + (size_t)u.pn * btile; u.e = 0; u.pos0 = 0; u.cnt = 0; return true; }
};
__device__ __forceinline__ unsigned act_piece_off(int r, int c16) { const int s = 2 * (r >> 7) + (c16 >> 2), w = 4 * ((r >> 6) & 1) + (c16 & 3), l = 16 * ((r >> 4) & 3) + (r & 15); return (unsigned)(((s * 8 + w) * 64 + l) * 16); }
template <bool GATHER> struct MoeSched {
    int nN, G, c, rowb; const char* Wt; size_t wexp, btile; const LAS int* tab; const int* list;
    static constexpr bool GATHER_LDS = GATHER;
    __device__ __forceinline__ int kstepA() const { return GATHER ? 128 : 32768; }
    __device__ __forceinline__ bool next(int i, Unit& u) const {
        const int nwg = tab[33] * nN; const int Lx = i * G + c; if (Lx >= nwg) return false;
        const int w = xcd_remap(Lx, nwg); const int rt = w / nN; u.pn = w % nN; u.pm = rt;
        const int e = tab[128 + rt];
        u.e = e; u.pos0 = (rt - tab[e]) * BM; u.cnt = tab[64 + e]; u.b = Wt + (size_t)e * wexp + (size_t)u.pn * btile; return true; }
    __device__ __forceinline__ void aoff(const Unit& u, const int (&Rr)[2], const int (&Cc)[2], unsigned (&va)[2][2]) const {
#pragma unroll
        for (int h = 0; h < 2; ++h)
#pragma unroll
            for (int i = 0; i < 2; ++i) {
                if (GATHER) { const int pos = u.pos0 + h * HALF + Rr[i]; const int pair = pos < u.cnt ? list[u.e * CAP + pos] : 0; va[h][i] = (unsigned)((pair >> 2) * rowb + Cc[i] * 2); }
                else va[h][i] = (unsigned)u.pm * 262144u + act_piece_off(h * HALF + Rr[i], Cc[i] >> 3); } }
};

typedef int v8i_t __attribute__((ext_vector_type(8)));
typedef int i32x4_t __attribute__((ext_vector_type(4)));
template <class Epi, class Sched, bool FP8 = false, int SCA = 127, int SCB = 127>
__device__ __forceinline__ void gemm_phase(LAS unsigned char* lds, const char* Abase, const int K, const Sched& S, const Epi& E) {
    const int tid = otid(), wid = __builtin_amdgcn_readfirstlane(tid >> 6), lane = tid & 63, wr = wid >> 2, wc = wid & 3, fr = lane & 15, fq = lane >> 4;
    const int Kb = FP8 ? K : 2 * K;
    const int nt = Kb / (BK * 2);
    int Rr[2], Cc[2]; unsigned voffB[2];
#pragma unroll
    for (int i = 0; i < 2; ++i) { int R_, C_; stage_rc(tid * 16 + i * 8192, R_, C_); Rr[i] = R_; Cc[i] = C_; const int Rb = 64 * (R_ >> 5) + (Epi::PERM ? perm32(R_ & 31) : (R_ & 31)); voffB[i] = (unsigned)(Rb * Kb + C_ * 2); }
    const size_t kstep = (size_t)(BK * 2);
    const size_t kstepA = (size_t)S.kstepA();
    const size_t hstep = (size_t)32 * Kb;
    const unsigned ldsw = (unsigned)wid * 1024u;
    const int aoff = lds_byte(wr * 64 + fr, fq * 8), boff = lds_byte(wc * 32 + fr, fq * 8);
#define PG8_SA(b, h) (((b) * 2 + (h)) * HTB)
#define PG8_SB(b, h) ((4 + (b) * 2 + (h)) * HTB)
#define PG8_STAGE_B(bufoff, gbase) do { _Pragma("unroll") for (int _i = 0; _i < 2; ++_i) \
        __builtin_amdgcn_global_load_lds((const unsigned*)((const char*)(gbase) + voffB[_i]), (LAS unsigned*)(lds + (bufoff) + ldsw + _i * 8192), 16, 0, 0); } while (0)
#define PG8_STAGE_A(bufoff, v0, v1, kb) do { \
        __builtin_amdgcn_global_load_lds((const unsigned*)(Abase + (kb) + (v0)), (LAS unsigned*)(lds + (bufoff) + ldsw), 16, 0, 0); \
        __builtin_amdgcn_global_load_lds((const unsigned*)(Abase + (kb) + (v1)), (LAS unsigned*)(lds + (bufoff) + ldsw + 8192), 16, 0, 0); } while (0)
#define PG8_LD16(addr) (*(const LAS i32x4_t*)(addr))
#define PG8_LDA(dst, b, h) do { _Pragma("unroll") for (int m = 0; m < 4; ++m) { if constexpr (FP8) dst##8[m] = __builtin_shufflevector(PG8_LD16(lds + PG8_SA(b, h) + aoff + m * 2048), PG8_LD16(lds + PG8_SA(b, h) + aoff + m * 2048 + 1024), 0, 1, 2, 3, 4, 5, 6, 7); \
        else { _Pragma("unroll") for (int k = 0; k < 2; ++k) dst[m][k] = *(const LAS bf16x8*)(lds + PG8_SA(b, h) + aoff + m * 2048 + k * 1024); } } } while (0)
#define PG8_LDB(dst, b, h) do { _Pragma("unroll") for (int n = 0; n < 2; ++n) { if constexpr (FP8) dst##8[n] = __builtin_shufflevector(PG8_LD16(lds + PG8_SB(b, h) + boff + n * 2048), PG8_LD16(lds + PG8_SB(b, h) + boff + n * 2048 + 1024), 0, 1, 2, 3, 4, 5, 6, 7); \
        else { _Pragma("unroll") for (int k = 0; k < 2; ++k) dst[n][k] = *(const LAS bf16x8*)(lds + PG8_SB(b, h) + boff + n * 2048 + k * 1024); } } } while (0)
#define PG8_MMA(ai, bj, At, Bt) do { __builtin_amdgcn_s_setprio(1); _Pragma("unroll") for (int m = 0; m < 4; ++m) _Pragma("unroll") for (int n = 0; n < 2; ++n) { \
        if constexpr (FP8) asm volatile("v_mfma_scale_f32_16x16x128_f8f6f4 %0, %1, %2, %0, %3, %4 op_sel_hi:[0,0,0]" : "+v"(acc[ai][bj][m][n]) : "v"(Bt##8[n]), "v"(At##8[m]), "v"(scb_), "v"(sca_)); \
        else { _Pragma("unroll") for (int k = 0; k < 2; ++k) acc[ai][bj][m][n] = __builtin_amdgcn_mfma_f32_16x16x32_bf16(Bt[n][k], At[m][k], acc[ai][bj][m][n], 0, 0, 0); } } \
        __builtin_amdgcn_s_setprio(0); } while (0)
#define PG8_WAIT_V(n) asm volatile("s_waitcnt vmcnt(" #n ")" ::: "memory")
#define PG8_WAIT_L(n) asm volatile("s_waitcnt lgkmcnt(" #n ")" ::: "memory")
#define PG8_BAR __builtin_amdgcn_s_barrier()
#define PG8_SCHED __builtin_amdgcn_sched_barrier(0)
    Unit cur, nxt; int ui = 0;
    if (!S.next(0, cur)) return;
    f32x4 acc[2][2][4][2];
#pragma unroll
    for (int a = 0; a < 2; ++a)
#pragma unroll
        for (int b = 0; b < 2; ++b)
#pragma unroll
            for (int m = 0; m < 4; ++m)
#pragma unroll
                for (int n = 0; n < 2; ++n) acc[a][b][m][n] = (f32x4){0.f, 0.f, 0.f, 0.f};
    const int sca_ = SCA, scb_ = SCB;
    bf16x8 At[4][2], B0[2][2], B1[2][2]; v8i_t At8[4], B08[2], B18[2];
    unsigned vc[2][2], vn[2][2];
    S.aoff(cur, Rr, Cc, vc);
    const char* cB = cur.b;
    PG8_STAGE_B(PG8_SB(0, 0), cB); PG8_STAGE_A(PG8_SA(0, 0), vc[0][0], vc[0][1], 0); PG8_STAGE_B(PG8_SB(0, 1), cB + hstep); PG8_STAGE_A(PG8_SA(0, 1), vc[1][0], vc[1][1], 0);
    PG8_STAGE_B(PG8_SB(1, 0), cB + kstep); PG8_STAGE_A(PG8_SA(1, 0), vc[0][0], vc[0][1], kstepA); PG8_STAGE_B(PG8_SB(1, 1), cB + hstep + kstep);
    PG8_WAIT_V(6); PG8_BAR;
    if (wr == 1) PG8_BAR;
    for (;;) {
        const bool has_next = S.next(ui + 1, nxt);
        if constexpr (Sched::GATHER_LDS) {
            if (has_next && wid < 4) __builtin_amdgcn_global_load_lds((const unsigned*)(S.list + nxt.e * CAP + nxt.pos0 + otid()), (LAS unsigned*)(lds + LDS_IDX + wid * 256), 4, 0, 0);
        } else if (has_next) S.aoff(nxt, Rr, Cc, vn);
        if (!has_next) {
#pragma unroll
            for (int h = 0; h < 2; ++h)
#pragma unroll
                for (int i = 0; i < 2; ++i) vn[h][i] = vc[h][i]; }
        const char* nB = has_next ? nxt.b : cB;
#pragma unroll 1
        for (int t = 0; t < nt; t += 2) {
            const bool last = (t == nt - 2);
            if constexpr (Sched::GATHER_LDS) { if (last && has_next) {
#pragma unroll
                for (int h = 0; h < 2; ++h)
#pragma unroll
                    for (int i = 0; i < 2; ++i) { const int rr = h * HALF + Rr[i]; const int pair = (nxt.pos0 + rr) < nxt.cnt ? ((const LAS int*)(lds + LDS_IDX))[rr] : 0; vn[h][i] = (unsigned)((pair >> 2) * S.rowb + Cc[i] * 2); } } }
            const size_t k1 = (size_t)(t + 1) * kstepA;
            const size_t k2 = last ? 0 : (size_t)(t + 2) * kstepA;
            const unsigned s00 = last ? vn[0][0] : vc[0][0], s01 = last ? vn[0][1] : vc[0][1], s10 = last ? vn[1][0] : vc[1][0], s11 = last ? vn[1][1] : vc[1][1];
            const char* b2 = last ? nB : cB + (size_t)(t + 2) * kstep; const char* b3 = b2 + kstep;
            PG8_LDB(B0, 0, 0); PG8_LDB(B1, 0, 1); PG8_SCHED; PG8_LDA(At, 0, 0); PG8_STAGE_A(PG8_SA(1, 1), vc[1][0], vc[1][1], k1);
            PG8_WAIT_L(0); PG8_BAR; PG8_MMA(0, 0, At, B0); PG8_MMA(0, 1, At, B1); PG8_BAR; PG8_SCHED;
            PG8_LDA(At, 0, 1); PG8_SCHED; PG8_STAGE_B(PG8_SB(0, 0), b2); PG8_SCHED; PG8_STAGE_A(PG8_SA(0, 0), s00, s01, k2); PG8_SCHED; PG8_STAGE_B(PG8_SB(0, 1), b2 + hstep);
            PG8_WAIT_L(0); PG8_WAIT_V(6); PG8_BAR; PG8_MMA(1, 0, At, B0); PG8_MMA(1, 1, At, B1); PG8_BAR; PG8_SCHED;
            PG8_LDB(B0, 1, 0); PG8_LDB(B1, 1, 1); PG8_SCHED; PG8_LDA(At, 1, 0); PG8_STAGE_A(PG8_SA(0, 1), s10, s11, k2);
            PG8_WAIT_L(0); PG8_BAR; PG8_MMA(0, 0, At, B0); PG8_MMA(0, 1, At, B1); PG8_BAR; PG8_SCHED;
            PG8_LDA(At, 1, 1); PG8_SCHED; PG8_STAGE_B(PG8_SB(1, 0), b3); PG8_SCHED; PG8_STAGE_A(PG8_SA(1, 0), s00, s01, k2 + kstepA); PG8_SCHED; PG8_STAGE_B(PG8_SB(1, 1), b3 + hstep);
            PG8_WAIT_L(0); PG8_WAIT_V(6); PG8_BAR; PG8_MMA(1, 0, At, B0); PG8_MMA(1, 1, At, B1); PG8_BAR; PG8_SCHED;
        }
        if constexpr (FP8) asm volatile("s_nop 15\n\ts_nop 15" ::: "memory");
        E(acc, cur, wr, wc, fr, fq);
        if (!has_next) break;
#pragma unroll
        for (int a = 0; a < 2; ++a)
#pragma unroll
            for (int b = 0; b < 2; ++b)
#pragma unroll
                for (int m = 0; m < 4; ++m)
#pragma unroll
                    for (int n = 0; n < 2; ++n) acc[a][b][m][n] = (f32x4){0.f, 0.f, 0.f, 0.f};
        cur = nxt; cB = nB; ++ui;
#pragma unroll
        for (int h = 0; h < 2; ++h)
#pragma unroll
            for (int i = 0; i < 2; ++i) vc[h][i] = vn[h][i];
    }
    PG8_WAIT_V(0);
    if (wr == 0) PG8_BAR;
    PG8_BAR;
#undef PG8_SA
#undef PG8_SB
#undef PG8_STAGE_A
#undef PG8_STAGE_B
#undef PG8_LDA
#undef PG8_LDB
#undef PG8_MMA
#undef PG8_WAIT_V
#undef PG8_WAIT_L
#undef PG8_BAR
#undef PG8_SCHED
}

typedef f32x4 Acc[2][2][4][2];
__device__ __forceinline__ unsigned dpp_ror8(unsigned x) { return (unsigned)__builtin_amdgcn_update_dpp(0, (int)x, 0x128, 0xf, 0xf, false); }
__device__ __forceinline__ u32x4 ror8_4(const u32x4 v) { u32x4 r; r.x = dpp_ror8(v.x); r.y = dpp_ror8(v.y); r.z = dpp_ror8(v.z); r.w = dpp_ror8(v.w); return r; }
__device__ __forceinline__ void line_xy(const u32x4 a, const u32x4 b, bool lo, u32x4& X, u32x4& Y) { const u32x4 ra = ror8_4(a), rb = ror8_4(b); X = lo ? a : rb; Y = lo ? ra : b; }
__device__ __forceinline__ u32x4 pack8(const f32x4 v0, const f32x4 v1) { u32x4 w; w.x = cvt_pk_bf16(v0[0], v0[1]); w.y = cvt_pk_bf16(v0[2], v0[3]); w.z = cvt_pk_bf16(v1[0], v1[1]); w.w = cvt_pk_bf16(v1[2], v1[3]); return w; }

struct EpiIn { static constexpr bool PERM = true; char* ws;
    __device__ __forceinline__ void operator()(const Acc& acc, const Unit& u, int wr, int wc, int fr, int fq) const {
        const int pn = u.pn; size_t boff; int ld, cb;
        if (pn < 3) { boff = OFF_QA; ld = 384; cb = pn * 128; } else if (pn == 3) { boff = OFF_CKV; ld = 256; cb = 0; }
        else if (pn < 32) { boff = OFF_HQ + (size_t)((pn - 4) >> 2) * SEG_STRIDE; ld = 1024; cb = ((pn - 4) & 3) * 256; }
        else { boff = OFF_KR; ld = 64; cb = 0; }
        bf16_t* base = (bf16_t*)(ws + boff);
        if (pn == 32 && wc != 0) return;
        const bool lo = fr < 8; const int rowb0 = u.pm * BM + wr * 64, rx = fr & 7, colx = cb + wc * 64 + (fr >> 3) * 32 + 8 * fq;
        float* ssq = (float*)(ws + (pn < 3 ? OFF_SSQQ : OFF_SSQKV));
#pragma unroll
        for (int ai = 0; ai < 2; ++ai)
#pragma unroll
            for (int m = 0; m < 4; ++m) { const int rg = rowb0 + ai * HALF + m * 16;
                f32x4 v0 = acc[ai][0][m][0], v1 = acc[ai][0][m][1], w0 = acc[ai][1][m][0], w1 = acc[ai][1][m][1];
                if (pn >= 4 && pn < 8) {
#pragma unroll
                    for (int j = 0; j < 4; ++j) { v0[j] = siluf_(v0[j]) * 0.08838834764831845f; v1[j] = siluf_(v1[j]) * 0.08838834764831845f; w0[j] = siluf_(w0[j]) * 0.08838834764831845f; w1[j] = siluf_(w1[j]) * 0.08838834764831845f; } }
                if (pn < 3 || (pn >= 20 && pn < 32)) { unsigned char* qrow = pn < 3 ? (unsigned char*)base + (size_t)(rg + fr) * 768 + pn * 256 + wc * 64 + 8 * fq : (unsigned char*)base + (size_t)(rg + fr) * 1024 + (pn & 3) * 256 + wc * 64 + 8 * fq;
                    u32x2 a8; a8.x = pack4_fp8(v0[0], v0[1], v0[2], v0[3]); a8.y = pack4_fp8(v1[0], v1[1], v1[2], v1[3]); u32x2 b8; b8.x = pack4_fp8(w0[0], w0[1], w0[2], w0[3]); b8.y = pack4_fp8(w1[0], w1[1], w1[2], w1[3]);
                    *(u32x2*)qrow = a8; *(u32x2*)(qrow + 32) = b8; }
                else { u32x4 X, Y; line_xy(pack8(v0, v1), pack8(w0, w1), lo, X, Y);
                    __builtin_nontemporal_store(X, (u32x4*)(base + (size_t)(rg + rx) * ld + colx)); __builtin_nontemporal_store(Y, (u32x4*)(base + (size_t)(rg + 8 + rx) * ld + colx)); }
                if (pn <= 3) { float ss = (v0[0] * v0[0] + v0[1] * v0[1]) + (v0[2] * v0[2] + v0[3] * v0[3]) + (v1[0] * v1[0] + v1[1] * v1[1]) + (v1[2] * v1[2] + v1[3] * v1[3])
                                        + (w0[0] * w0[0] + w0[1] * w0[1]) + (w0[2] * w0[2] + w0[3] * w0[3]) + (w1[0] * w1[0] + w1[1] * w1[1]) + (w1[2] * w1[2] + w1[3] * w1[3]);
                    ss += __shfl_xor(ss, 16); ss += __shfl_xor(ss, 32); if (fq == 0) atomicAdd(ssq + rg + fr, ss); } }
    } };

struct EpiQ { static constexpr bool PERM = true; bf16_t* q; const float* ssq;
    __device__ __forceinline__ void operator()(const Acc& acc, const Unit& u, int wr, int wc, int fr, int fq) const {
        const bool lo = fr < 8; const int rowb0 = u.pm * BM + wr * 64, rx = fr & 7, colx = u.pn * BM + wc * 64 + (fr >> 3) * 32 + 8 * fq;
#pragma unroll
        for (int ai = 0; ai < 2; ++ai)
#pragma unroll
            for (int m = 0; m < 4; ++m) { const int rg = rowb0 + ai * HALF + m * 16; const float rs = rsqrtf(ssq[rg + fr] * (1.0f / 768.0f) + EPS);
                u32x4 X, Y; line_xy(pack8(acc[ai][0][m][0] * rs, acc[ai][0][m][1] * rs), pack8(acc[ai][1][m][0] * rs, acc[ai][1][m][1] * rs), lo, X, Y);
                *(u32x4*)(q + (size_t)(rg + rx) * 1536 + colx) = X; *(u32x4*)(q + (size_t)(rg + 8 + rx) * 1536 + colx) = Y; }
    } };

struct EpiKV { static constexpr bool PERM = true; bf16_t *Kb, *Vb; const float* ssq;
    __device__ __forceinline__ size_t kvrow(int row, int h) const { int b, pos; if (row < L) { b = row >> 11; pos = row & 2047; } else { b = (row - L) >> 8; pos = SEQ + ((row - L) & 255); } return (size_t)(b * 8 + h) * NKEY + pos; }
    __device__ __forceinline__ void operator()(const Acc& acc, const Unit& u, int wr, int wc, int fr, int fq) const {
        const bool lo = fr < 8; const int rowb0 = u.pm * BM + wr * 64, rx = fr & 7, colx = (wc & 1) * 64 + (fr >> 3) * 32 + 8 * fq;
        bf16_t* dst = wc < 2 ? Kb : Vb; const int ld = wc < 2 ? 192 : 128;
#pragma unroll
        for (int ai = 0; ai < 2; ++ai)
#pragma unroll
            for (int m = 0; m < 4; ++m) { const int rg = rowb0 + ai * HALF + m * 16; const float rs = rsqrtf(ssq[rg + fr] * (1.0f / 256.0f) + EPS);
                u32x4 X, Y; line_xy(pack8(acc[ai][0][m][0] * rs, acc[ai][0][m][1] * rs), pack8(acc[ai][1][m][0] * rs, acc[ai][1][m][1] * rs), lo, X, Y);
                *(u32x4*)(dst + kvrow(rg + rx, u.pn) * ld + colx) = X; *(u32x4*)(dst + kvrow(rg + 8 + rx, u.pn) * ld + colx) = Y; }
    } };

struct EpiOut { static constexpr bool PERM = true; bf16_t* x1; const float* x; const float* modv;
    __device__ __forceinline__ void operator()(const Acc& acc, const Unit& u, int wr, int wc, int fr, int fq) const {
        const bool lo = fr < 8; const int rowb0 = u.pm * BM + wr * 64, rx = fr & 7, colx = u.pn * BM + wc * 64 + (fr >> 3) * 32 + 8 * fq, cown = u.pn * BM + wc * 64 + 8 * fq;
#pragma unroll
        for (int ai = 0; ai < 2; ++ai)
#pragma unroll
            for (int m = 0; m < 4; ++m) { const int rg = rowb0 + ai * HALF + m * 16, row = rg + fr; const float* gate = modv + (row >> 11) * 6144 + 2 * 1024 + cown; const float* xr = x + (size_t)row * D + cown;
                f32x4 r[2][2];
#pragma unroll
                for (int bj = 0; bj < 2; ++bj)
#pragma unroll
                    for (int n = 0; n < 2; ++n) r[bj][n] = *(const f32x4*)(xr + bj * 32 + 4 * n) + *(const f32x4*)(gate + bj * 32 + 4 * n) * acc[ai][bj][m][n];
                u32x4 X, Y; line_xy(pack8(r[0][0], r[0][1]), pack8(r[1][0], r[1][1]), lo, X, Y);
                *(u32x4*)(x1 + (size_t)(rg + rx) * D + colx) = X; *(u32x4*)(x1 + (size_t)(rg + 8 + rx) * D + colx) = Y; }
    } };

struct EpiMoe1 { static constexpr bool PERM = true; unsigned char* act; const float* bgu;
    __device__ __forceinline__ void operator()(const Acc& acc, const Unit& u, int wr, int wc, int fr, int fq) const {
        const int o0 = u.pn * 128 + wc * 16 + 4 * fq;
        f32x4 bg[2], bl[2];
#pragma unroll
        for (int bj = 0; bj < 2; ++bj) { const float* bp = bgu + u.e * 2048 + 2 * (o0 + bj * 64); const f32x4 t0 = *(const f32x4*)bp, t1 = *(const f32x4*)(bp + 4);
            bg[bj] = (f32x4){t0[0], t0[2], t1[0], t1[2]}; bl[bj] = (f32x4){t0[1], t0[3], t1[1], t1[3]}; }
        unsigned char* blk = act + ((size_t)u.pm * 8 + u.pn) * 32768 + (size_t)(wr * 4 + wc) * 1024 + (size_t)(fq * 16 + fr) * 16;
#pragma unroll
        for (int ai = 0; ai < 2; ++ai)
#pragma unroll
            for (int bj = 0; bj < 2; ++bj) { unsigned d[4];
#pragma unroll
                for (int m = 0; m < 4; ++m) { const f32x4 g4 = acc[ai][bj][m][0] + bg[bj], l4 = acc[ai][bj][m][1] + bl[bj]; float r[4];
#pragma unroll
                    for (int j = 0; j < 4; ++j) { const float glu = fminf(g4[j], 7.0f), lin = __builtin_amdgcn_fmed3f(l4[j], -7.0f, 7.0f); r[j] = 4.0f * glu * __builtin_amdgcn_rcpf(1.0f + __builtin_amdgcn_exp2f(-2.4554669595930157f * glu)) * (lin + 1.0f); }
                    d[m] = pack4_fp8(r[0], r[1], r[2], r[3]); }
                const auto s01 = __builtin_amdgcn_permlane16_swap(d[0], d[1], false, false); const auto s23 = __builtin_amdgcn_permlane16_swap(d[2], d[3], false, false);
                const auto t02 = __builtin_amdgcn_permlane32_swap(s01[0], s23[0], false, false); const auto t13 = __builtin_amdgcn_permlane32_swap(s01[1], s23[1], false, false);
                *(u32x4*)(blk + (size_t)(ai * 2 + bj) * 8192) = (u32x4){t02[0], t13[0], t02[1], t13[1]}; }
    } };

struct EpiMoe2 { static constexpr bool PERM = true; bf16_t* yp; const float* bd;
    __device__ __forceinline__ void operator()(const Acc& acc, const Unit& u, int wr, int wc, int fr, int fq) const {
        const bool lo = fr < 8; const int rowb0 = u.pm * BM + wr * 64, rx = fr & 7, colx = u.pn * BM + wc * 64 + (fr >> 3) * 32 + 8 * fq, cown = u.pn * BM + wc * 64 + 8 * fq;
        f32x4 bv[2][2];
#pragma unroll
        for (int bj = 0; bj < 2; ++bj)
#pragma unroll
            for (int n = 0; n < 2; ++n) bv[bj][n] = *(const f32x4*)(bd + u.e * 1024 + cown + bj * 32 + 4 * n);
#pragma unroll
        for (int ai = 0; ai < 2; ++ai)
#pragma unroll
            for (int m = 0; m < 4; ++m) { const int rg = rowb0 + ai * HALF + m * 16;
                u32x4 X, Y; line_xy(pack8(acc[ai][0][m][0] + bv[0][0], acc[ai][0][m][1] + bv[0][1]), pack8(acc[ai][1][m][0] + bv[1][0], acc[ai][1][m][1] + bv[1][1]), lo, X, Y);
                __builtin_nontemporal_store(X, (u32x4*)(yp + (size_t)(rg + rx) * D + colx)); __builtin_nontemporal_store(Y, (u32x4*)(yp + (size_t)(rg + 8 + rx) * D + colx)); }
    } };
}

__device__ __forceinline__ int conv_src_col(int kind, int c) {
    if (kind == 0) return c;
    if (kind == 1) { if (c < 1024) return c; if (c < 8192) return c + 64; if (c < 8256) return c - 8192 + 1024; return -1; }
    const int pn = c >> 8, p = c & 255, wc = p >> 6, bj = (p >> 5) & 1, fq = (p >> 3) & 3, n = (p >> 2) & 1, i = p & 3; const int o = 128 * pn + 64 * bj + 16 * wc + 4 * fq + i; return 2 * o + n;
}
__device__ __forceinline__ void lds_sync() { asm volatile("s_waitcnt lgkmcnt(0)\n\ts_barrier" ::: "memory"); }
template <bool F8> struct ConvPipe {
    float v[32]; bool have; bf16_t* dummy;
    int K, kind, k0, c0; void* Wt;
    __device__ __forceinline__ void issue(const float* __restrict__ W, int ldw, void* Wt_, int K_, int kind_, const float* __restrict__ kscale, int k0_, int c0_) {
        const int tid = otid(); const int cc = tid & 127, kq = tid >> 7, sc = conv_src_col(kind_, c0_ + cc);
        const int scc = sc < 0 ? 0 : sc; const float* wp = W + (size_t)(k0_ + kq) * ldw + scc;
#pragma unroll
        for (int i = 0; i < 32; ++i) v[i] = __builtin_nontemporal_load(wp + (size_t)(4 * i) * ldw);
        if (sc < 0) {
#pragma unroll
            for (int i = 0; i < 32; ++i) v[i] = 0.f; }
        if (kscale) {
#pragma unroll
            for (int i = 0; i < 32; ++i) v[i] *= kscale[k0_ + kq + 4 * i]; }
        K = K_; kind = kind_; k0 = k0_; c0 = c0_; Wt = Wt_; have = true;
    }
    __device__ __forceinline__ void flush(LAS float* tl) {
        if (!have) return; have = false;
        const int tid = otid(); const int cc = tid & 127, kq = tid >> 7;
        __syncthreads();
#pragma unroll
        for (int i = 0; i < 32; ++i) tl[(kq + 4 * i) * 129 + cc] = v[i];
        __syncthreads();
        stash(tl, tid);
    }
    __device__ __forceinline__ void to_lds(LAS float* tl) { const int tid = otid(); const int cc = tid & 127, kq = tid >> 7; lds_sync();
#pragma unroll
        for (int i = 0; i < 32; ++i) tl[(kq + 4 * i) * 129 + cc] = v[i];
        lds_sync(); }
    __device__ __forceinline__ void stash(LAS float* tl, int tid) const {
        if constexpr (F8) {
#pragma unroll
            for (int pss = 0; pss < 2; ++pss) { const int item = tid + 512 * pss, c2 = item >> 3, ch = item & 7; float t[16];
#pragma unroll
                for (int j = 0; j < 16; ++j) t[j] = tl[(16 * ch + j) * 129 + c2] * 32.f;
                u32x4 w; w.x = pack4_fp8(t[0], t[1], t[2], t[3]); w.y = pack4_fp8(t[4], t[5], t[6], t[7]); w.z = pack4_fp8(t[8], t[9], t[10], t[11]); w.w = pack4_fp8(t[12], t[13], t[14], t[15]);
                *(u32x4*)((unsigned char*)Wt + (size_t)(c0 + c2) * K + k0 + 16 * ch) = w; }
        } else {
#pragma unroll
            for (int pss = 0; pss < 4; ++pss) { const int item = tid + 512 * pss, c2 = item >> 4, ch = item & 15; float t[8];
#pragma unroll
                for (int j = 0; j < 8; ++j) t[j] = tl[(8 * ch + j) * 129 + c2];
                u32x4 w; w.x = cvt_pk_bf16(t[0], t[1]); w.y = cvt_pk_bf16(t[2], t[3]); w.z = cvt_pk_bf16(t[4], t[5]); w.w = cvt_pk_bf16(t[6], t[7]);
                *(u32x4*)((bf16_t*)Wt + (size_t)(c0 + c2) * K + k0 + 8 * ch) = w; }
        }
    }
};
template <bool F8>
__device__ __forceinline__ void conv_matrix(LAS float* tl, ConvPipe<F8>& pipe, const float* W, int ldw, void* Wt, int K, int Nout, int kind, const float* kscale, int& tctr) {
    const int nk = K / 128, ntile = nk * (Nout / 128);
    int t = ((int)blockIdx.x - tctr) % (int)gridDim.x; if (t < 0) t += gridDim.x;
    for (; t < ntile; t += gridDim.x) {
        if (pipe.have) { pipe.to_lds(tl); const int K0 = pipe.K, k00 = pipe.k0, c00 = pipe.c0; void* W0 = pipe.Wt; ConvPipe<F8> done = pipe; (void)K0; (void)k00; (void)c00; (void)W0;
            pipe.issue(W, ldw, Wt, K, kind, kscale, (t % nk) * 128, (t / nk) * 128); done.stash(tl, otid()); }
        else pipe.issue(W, ldw, Wt, K, kind, kscale, (t % nk) * 128, (t / nk) * 128);
    }
    tctr = (tctr + ntile) % (int)gridDim.x;
}
template <bool F8> __device__ __forceinline__ void conv_finish(LAS float* tl, ConvPipe<F8>& pipe) { if (pipe.have) { pipe.to_lds(tl); pipe.stash(tl, otid()); pipe.have = false; } __syncthreads(); }

__device__ __forceinline__ float half_sum256(float v, LAS float* red) {
    for (int o = 32; o > 0; o >>= 1) v += __shfl_xor(v, o);
    const int w = otid() >> 6, hb = (otid() >> 8) * 4; if ((otid() & 63) == 0) red[w] = v; __syncthreads();
    const float t = red[hb] + red[hb + 1] + red[hb + 2] + red[hb + 3]; __syncthreads(); return t;
}

__device__ __forceinline__ void phase0(const Params& p, LAS unsigned char* lds) {
    char* ws = p.ws; const int tid = otid(), gsz = gridDim.x * 512, gid = blockIdx.x * 512 + tid;
    float* lb = (float*)(ws + OFF_LB); int* cnt = (int*)(ws + OFF_CNT); float* ssqq = (float*)(ws + OFF_SSQQ); float* ssqkv = (float*)(ws + OFF_SSQKV); float* modv = (float*)(ws + OFF_MOD);
    for (int i = gid; i < 2048; i += gsz) { const int d = i >> 10, j = i & 1023; const float a = p.lbl[(d * 2 + 0) * 1024 + j], b = p.lbl[(d * 2 + 1) * 1024 + j]; lb[i] = 1.0f / (1.0f + __expf(b - a)); }
    for (int i = gid; i < 32; i += gsz) cnt[i] = 0;
    { float* ropet = (float*)(ws + OFF_ROPE); for (int i = gid; i < SEQ * 32; i += gsz) { const int t = i >> 5, j = i & 31; float cs, sn; rope_cs(t, j, cs, sn); ropet[t * 64 + j] = cs; ropet[t * 64 + 32 + j] = sn; } }
    for (int i = gid; i < L; i += gsz) ssqq[i] = 0.f;
    for (int i = gid; i < R; i += gsz) ssqkv[i] = 0.f;
    { LAS float* sil = (LAS float*)lds;
      LAS float* part = (LAS float*)(lds + 17 * 1024 * 4);
      bool loaded = false;
      for (int item = blockIdx.x; item < 192; item += gridDim.x) {
          if (!loaded) { for (int i = tid; i < 17 * 1024; i += 512) { const int r = i >> 10, k = i & 1023; sil[i] = siluf_(r < 16 ? p.c[r * 1024 + k] : p.cctx[k]); } loaded = true; __syncthreads(); }
          const int j = tid & 31, ks = tid >> 5; float a[17];
#pragma unroll
          for (int r = 0; r < 17; ++r) a[r] = 0.f;
#pragma unroll 4
          for (int k = ks * 64; k < ks * 64 + 64; ++k) { const float w = p.w_mod[(size_t)k * 6144 + item * 32 + j];
#pragma unroll
              for (int r = 0; r < 17; ++r) a[r] += sil[r * 1024 + k] * w; }
#pragma unroll
          for (int r = 0; r < 17; ++r) part[(ks * 17 + r) * 32 + j] = a[r];
          __syncthreads();
          for (int i = tid; i < 17 * 32; i += 512) { const int r = i >> 5, jj = i & 31; float s = p.b_mod[item * 32 + jj]; for (int q = 0; q < 16; ++q) s += part[(q * 17 + r) * 32 + jj]; modv[r * 6144 + item * 32 + jj] = s; }
          __syncthreads();
      } }
    __syncthreads();
    { LAS float* tl = (LAS float*)lds; int tctr = 0;
      { ConvPipe<true> pp; pp.have = false; conv_matrix<true>(tl, pp, p.w_in, 8256, (unsigned char*)(ws + OFF_WT_IN), 1024, 8448, 1, nullptr, tctr); conv_finish<true>(tl, pp); }
      { ConvPipe<true> pp; pp.have = false;
        conv_matrix<true>(tl, pp, p.w_qb, 1536, (unsigned char*)(ws + OFF_WT_QB), 768, 1536, 0, p.g_q, tctr);
        conv_matrix<true>(tl, pp, p.w_out, 1024, (unsigned char*)(ws + OFF_WT_OUT), 1024, 1024, 0, nullptr, tctr); conv_finish<true>(tl, pp); }
      { ConvPipe<false> pp; pp.have = false;
        conv_matrix<false>(tl, pp, p.w_kvb, 2048, (bf16_t*)(ws + OFF_WT_KVB), 256, 2048, 0, p.g_kv, tctr); conv_finish<false>(tl, pp); } }
}

__device__ __forceinline__ float wave_sum(float v) {
#pragma unroll
    for (int o = 32; o > 0; o >>= 1) v += __shfl_xor(v, o);
    return v; }
__device__ __forceinline__ void phase1(const Params& p, LAS unsigned char* lds) {
    const float* modv = (const float*)(p.ws + OFF_MOD); unsigned char* h = (unsigned char*)(p.ws + OFF_H);
    const int tid = otid(), lane = tid & 63, gw = blockIdx.x * 8 + (tid >> 6), nw = gridDim.x * 8, c0 = lane * 8;
    f32x4 g[4];
#pragma unroll
    for (int q = 0; q < 4; ++q) g[q] = *(const f32x4*)(p.g_mix + (q >> 1) * 512 + c0 + (q & 1) * 4);
    for (int row0 = gw; row0 < R; row0 += 4 * nw) {
        f32x4 v[4][4];
#pragma unroll
        for (int u = 0; u < 4; ++u) { const int row = row0 + u * nw < R ? row0 + u * nw : row0; const float* src = row < L ? p.x + (size_t)row * D : p.ctx + (size_t)(row - L) * D;
#pragma unroll
            for (int q = 0; q < 4; ++q) v[u][q] = __builtin_nontemporal_load((const f32x4*)(src + (q >> 1) * 512 + c0 + (q & 1) * 4)); }
#pragma unroll
        for (int u = 0; u < 4; ++u) { if (row0 + u * nw >= R) break; const int row = row0 + u * nw; const float* mod = modv + (row < L ? row / SEQ : 16) * 6144;
            float ss = 0.f;
#pragma unroll
            for (int q = 0; q < 4; ++q) ss += (v[u][q][0] * v[u][q][0] + v[u][q][1] * v[u][q][1]) + (v[u][q][2] * v[u][q][2] + v[u][q][3] * v[u][q][3]);
            const float rs = rsqrtf(wave_sum(ss) * (1.0f / D) + EPS);
#pragma unroll
            for (int j = 0; j < 2; ++j) { f32x4 o[2];
#pragma unroll
                for (int e = 0; e < 2; ++e) { const int cc = j * 512 + c0 + e * 4; const f32x4 sc = *(const f32x4*)(mod + 1024 + cc), sh = *(const f32x4*)(mod + cc); o[e] = v[u][j * 2 + e] * rs * g[j * 2 + e] * (sc + 1.0f) + sh; }
                u32x2 w; w.x = pack4_fp8(o[0][0], o[0][1], o[0][2], o[0][3]); w.y = pack4_fp8(o[1][0], o[1][1], o[1][2], o[1][3]);
                *(u32x2*)(h + (size_t)row * D + j * 512 + c0) = w; } }
    }
}


__device__ __forceinline__ void phase2(const Params& p, LAS unsigned char* lds) {
    pg8::InSched S; S.init2(p.ws + OFF_WT_IN, gridDim.x, blockIdx.x);
    pg8::EpiIn E{p.ws};
    pg8::gemm_phase<pg8::EpiIn, pg8::InSched, true, 127, 122>(lds, (const char*)(p.ws + OFF_H), 1024, S, E);
}
__device__ __forceinline__ void phase3(const Params& p, LAS unsigned char* lds) {
    char* ws = p.ws;
    { pg8::DenseSched S; S.init(L, 1536, 768, 768, ws + OFF_WT_QB, gridDim.x, blockIdx.x); pg8::EpiQ E{(bf16_t*)(ws + OFF_Q), (const float*)(ws + OFF_SSQQ)}; pg8::gemm_phase<pg8::EpiQ, pg8::DenseSched, true, 127, 122>(lds, (const char*)(ws + OFF_QA), 768, S, E); }
    { pg8::DenseSched S; S.init(R, 2048, 256 * 2, 256 * 2, ws + OFF_WT_KVB, gridDim.x, blockIdx.x); pg8::EpiKV E{(bf16_t*)(ws + OFF_K), (bf16_t*)(ws + OFF_V), (const float*)(ws + OFF_SSQKV)}; pg8::gemm_phase(lds, (const char*)(ws + OFF_CKV), 256, S, E); }
    { const bf16_t* kr = (const bf16_t*)(ws + OFF_KR); bf16_t* Kb = (bf16_t*)(ws + OFF_K); const float* ropet = (const float*)(ws + OFF_ROPE);
      for (int gid = blockIdx.x * 512 + otid(); gid < R * 32; gid += gridDim.x * 512) { const int row = gid >> 5, i = gid & 31;
          const float x1 = bf2f(kr[(size_t)row * 64 + i]), x2 = bf2f(kr[(size_t)row * 64 + 32 + i]); float o1 = x1, o2 = x2; int b, pos;
          if (row < L) { b = row / SEQ; pos = row % SEQ; const float cs = ropet[pos * 64 + i], sn = ropet[pos * 64 + 32 + i]; o1 = x1 * cs - x2 * sn; o2 = x1 * sn + x2 * cs; } else { b = (row - L) / CTXL; pos = SEQ + (row - L) % CTXL; }
          const bf16_t w1 = f2bf(o1), w2 = f2bf(o2);
          for (int h = 0; h < 8; ++h) { bf16_t* q = Kb + ((size_t)(b * 8 + h) * NKEY + pos) * 192 + 128; q[i] = w1; q[32 + i] = w2; } } }
}
__device__ __forceinline__ void unpack8_fp8(const u32x2 w, float (&o)[8]) {
    o[0] = __builtin_amdgcn_cvt_f32_fp8((int)w.x, 0); o[1] = __builtin_amdgcn_cvt_f32_fp8((int)w.x, 1); o[2] = __builtin_amdgcn_cvt_f32_fp8((int)w.x, 2); o[3] = __builtin_amdgcn_cvt_f32_fp8((int)w.x, 3);
    o[4] = __builtin_amdgcn_cvt_f32_fp8((int)w.y, 0); o[5] = __builtin_amdgcn_cvt_f32_fp8((int)w.y, 1); o[6] = __builtin_amdgcn_cvt_f32_fp8((int)w.y, 2); o[7] = __builtin_amdgcn_cvt_f32_fp8((int)w.y, 3); }
__device__ __forceinline__ void unpack8(const u32x4 w, float (&o)[8]) {
    o[0] = __uint_as_float(w.x << 16); o[1] = __uint_as_float(w.x & 0xffff0000u); o[2] = __uint_as_float(w.y << 16); o[3] = __uint_as_float(w.y & 0xffff0000u);
    o[4] = __uint_as_float(w.z << 16); o[5] = __uint_as_float(w.z & 0xffff0000u); o[6] = __uint_as_float(w.w << 16); o[7] = __uint_as_float(w.w & 0xffff0000u); }
__device__ __forceinline__ void phase4(const Params& p, LAS unsigned char*) {
    char* ws = p.ws; bf16_t* y = (bf16_t*)(ws + OFF_H); const bf16_t* of = (const bf16_t*)(ws + OFF_OF); const bf16_t* ob = (const bf16_t*)(ws + OFF_OB);
    const unsigned char* og = (const unsigned char*)(ws + OFF_OG); const unsigned char* gm = (const unsigned char*)(ws + OFF_GM); const unsigned char* gh = (const unsigned char*)(ws + OFF_GH);
    const int tid = otid(), lane = tid & 63, gw = blockIdx.x * 8 + (tid >> 6), nw = gridDim.x * 8, c0 = lane * 8;
    float gg[8];
#pragma unroll
    for (int i = 0; i < 8; ++i) gg[i] = p.g_hg[(c0 + i) & 127];
    for (int row0 = gw; row0 < L; row0 += 2 * nw) {
        u32x4 ra[2][2], rb[2][2], rm[2][2]; u32x2 r1[2][2], r2[2][2], r3[2][2];
#pragma unroll
        for (int u = 0; u < 2; ++u) { const int row = row0 + u * nw < L ? row0 + u * nw : row0;
#pragma unroll
        for (int j = 0; j < 2; ++j) { const size_t off = (size_t)row * D + j * 512 + c0; ra[u][j] = __builtin_nontemporal_load((const u32x4*)(of + off)); rb[u][j] = __builtin_nontemporal_load((const u32x4*)(ob + off)); r1[u][j] = __builtin_nontemporal_load((const u32x2*)(og + off)); r2[u][j] = __builtin_nontemporal_load((const u32x2*)(gm + off)); r3[u][j] = __builtin_nontemporal_load((const u32x2*)(gh + off)); rm[u][j] = __builtin_nontemporal_load((const u32x4*)(y + off)); } }
#pragma unroll
        for (int u = 0; u < 2; ++u) { const int row = row0 + u * nw; if (row >= L) break;
#pragma unroll
        for (int j = 0; j < 2; ++j) { float a[8], b[8], g1[8], g2[8], g3[8], ym[8], o[8]; unpack8(ra[u][j], a); unpack8(rb[u][j], b); unpack8_fp8(r1[u][j], g1); unpack8_fp8(r2[u][j], g2); unpack8_fp8(r3[u][j], g3); unpack8(rm[u][j], ym);
            float ss = 0.f;
#pragma unroll
            for (int i = 0; i < 8; ++i) { o[i] = a[i] + b[i]; ss += o[i] * o[i]; }
            ss += __shfl_xor(ss, 1); ss += __shfl_xor(ss, 2); ss += __shfl_xor(ss, 4); ss += __shfl_xor(ss, 8);
            const float rs = rsqrtf(ss * (1.0f / 128.0f) + EPS); float r[8];
#pragma unroll
            for (int i = 0; i < 8; ++i) { const float yh = o[i] * rs * gg[i] * siluf_(g1[i]); r[i] = sigmoidf_(g2[i]) * ym[i] + sigmoidf_(g3[i]) * yh; }
            u32x2 w; w.x = pack4_fp8(r[0], r[1], r[2], r[3]); w.y = pack4_fp8(r[4], r[5], r[6], r[7]);
            *(u32x2*)((unsigned char*)(ws + OFF_YF8) + (size_t)row * D + j * 512 + c0) = w; } }
    }
}

#define MC_TIE16(v, o) asm volatile("" : "+v"(v[o+0]), "+v"(v[o+1]), "+v"(v[o+2]), "+v"(v[o+3]), "+v"(v[o+4]), "+v"(v[o+5]), "+v"(v[o+6]), "+v"(v[o+7]), "+v"(v[o+8]), "+v"(v[o+9]), "+v"(v[o+10]), "+v"(v[o+11]), "+v"(v[o+12]), "+v"(v[o+13]), "+v"(v[o+14]), "+v"(v[o+15]))
__device__ __forceinline__ void mc_issue(const Params& p, int idx, float (&v)[32]) {
    const int tid = otid(); const int cc = tid & 127, kq = tid >> 7; const float* base; unsigned voff, vstep;
    if (idx < 4096) { const int e = idx >> 7, r = idx & 127; base = p.w_gu + (size_t)e * 1024 * 2048; voff = (unsigned)(((r & 7) * 128 + kq) * 2048 + conv_src_col(2, (r >> 3) * 128 + cc)) * 4u; vstep = 4u * 2048u * 4u; }
    else { const int j = idx - 4096, e = j >> 6, r = j & 63; base = p.w_dn + (size_t)e * 1024 * 1024; voff = (unsigned)(((r & 7) * 128 + kq) * 1024 + (r >> 3) * 128 + cc) * 4u; vstep = 4u * 1024u * 4u; }
#pragma unroll
    for (int i = 0; i < 32; ++i) { asm volatile("global_load_dword %0, %1, %2 nt" : "=v"(v[i]) : "v"(voff), "s"(base) : "memory"); voff += vstep; }
}
__device__ __forceinline__ void mc_stash(const Params& p, int idx, const LAS float* tl) {
    unsigned char* dst;
    if (idx < 4096) { const int e = idx >> 7, r = idx & 127; dst = (unsigned char*)(p.ws + OFF_WT_GU) + (size_t)e * 2048 * 1024 + (size_t)((r >> 3) * 128) * 1024 + (r & 7) * 128; }
    else { const int j = idx - 4096, e = j >> 6, r = j & 63; dst = (unsigned char*)(p.ws + OFF_WT_DN) + (size_t)e * 1024 * 1024 + (size_t)((r >> 3) * 128) * 1024 + (r & 7) * 128; }
    const int tid = otid();
#pragma unroll
    for (int pss = 0; pss < 2; ++pss) { const int item = tid + 512 * pss, c2 = item >> 3, ch = item & 7; float t[16];
#pragma unroll
        for (int j = 0; j < 16; ++j) t[j] = tl[(16 * ch + j) * 129 + c2] * 32.f;
        u32x4 w; w.x = pack4_fp8(t[0], t[1], t[2], t[3]); w.y = pack4_fp8(t[4], t[5], t[6], t[7]); w.z = pack4_fp8(t[8], t[9], t[10], t[11]); w.w = pack4_fp8(t[12], t[13], t[14], t[15]);
        *(u32x4*)(dst + (size_t)c2 * 1024 + 16 * ch) = w; }
}
__device__ __forceinline__ void mc_step(const Params& p, float (&v)[32], LAS float* tl, int i, int n, int stride, int wmode) {
    const int tid = otid(); const int cc = tid & 127, kq = tid >> 7; const int idx = (int)blockIdx.x + i * stride;
    if (wmode == 3) asm volatile("s_waitcnt vmcnt(36)" ::: "memory"); else if (wmode == 2) asm volatile("s_waitcnt vmcnt(34)" ::: "memory"); else if (wmode == 1) asm volatile("s_waitcnt vmcnt(32)" ::: "memory"); else asm volatile("s_waitcnt vmcnt(0)" ::: "memory");
    MC_TIE16(v, 0); MC_TIE16(v, 16);
#pragma unroll
    for (int q = 0; q < 32; ++q) tl[(kq + 4 * q) * 129 + cc] = v[q];
    lds_sync();
    if (i + 2 < n) mc_issue(p, idx + 2 * stride, v);
    mc_stash(p, idx, tl);
}
__device__ __forceinline__ void moe_conv(const Params& p, LAS unsigned char* lds) {
    LAS float* t0 = (LAS float*)lds; LAS float* t1 = t0 + 128 * 129;
    const int stride = gridDim.x, n = (6144 - (int)blockIdx.x + stride - 1) / stride;
    float va[32], vb[32];
#pragma unroll
    for (int q = 0; q < 32; ++q) { va[q] = 0.f; vb[q] = 0.f; }
    lds_sync();
    if (n >= 4) {
        mc_issue(p, (int)blockIdx.x, va); mc_issue(p, (int)blockIdx.x + stride, vb);
        mc_step(p, va, t0, 0, n, stride, 1); mc_step(p, vb, t1, 1, n, stride, 2);
#pragma unroll 1
        for (int i = 2; i < n; i += 2) { mc_step(p, va, t0, i, n, stride, i == n - 1 ? 0 : 3); if (i + 1 < n) mc_step(p, vb, t1, i + 1, n, stride, i + 1 == n - 1 ? 0 : 3); }
    } else {
        for (int i = 0; i < n; ++i) { mc_issue(p, (int)blockIdx.x + i * stride, va); mc_step(p, va, t0, i, 0, stride, 0); lds_sync(); }
    }
    __syncthreads();
}
__device__ __forceinline__ void phase5(const Params& p, LAS unsigned char* lds) {
    char* ws = p.ws;
    { pg8::DenseSched S; S.init(L, 1024, 1024, 1024, ws + OFF_WT_OUT, gridDim.x, blockIdx.x); pg8::EpiOut E{(bf16_t*)(ws + OFF_X1), p.x, (const float*)(ws + OFF_MOD)}; pg8::gemm_phase<pg8::EpiOut, pg8::DenseSched, true, 127, 122>(lds, (const char*)(ws + OFF_YF8), 1024, S, E); }
    moe_conv(p, lds);
}
__device__ __forceinline__ void phase6(const Params& p, LAS unsigned char* lds) {
    char* ws = p.ws; const float* modv = (const float*)(ws + OFF_MOD); unsigned char* h2 = (unsigned char*)(ws + OFF_H); int* topi = (int*)(ws + OFF_TOPI); float* topp = (float*)(ws + OFF_TOPP); int* cnt = (int*)(ws + OFF_CNT); int* list = (int*)(ws + OFF_LIST); int* pairpos = (int*)(ws + OFF_ROWPAIR);
    constexpr int HS_LD = 1028, HS_BYTES = 32 * HS_LD * 4;
    LAS float* hs = (LAS float*)lds;
    LAS float* lg = (LAS float*)(lds + HS_BYTES);
    LAS int* lcnt = (LAS int*)(lds + HS_BYTES + 4096);
    LAS int* lent = (LAS int*)(lds + HS_BYTES + 4096 + 512);
    LAS int* lbase = (LAS int*)(lds + HS_BYTES + 4096 + 512 + 8192);
    LAS int* lrun = (LAS int*)(lds + HS_BYTES + 4096 + 512 + 8192 + 2048);
    LAS float* lselv = (LAS float*)(lds + HS_BYTES + 4096 + 512 + 8192 + 4096); LAS int* lseli = (LAS int*)(lds + HS_BYTES + 4096 + 512 + 8192 + 4096 + 512);
    const int tid = otid(), lane = tid & 63, wid = tid >> 6, c0 = lane * 8;
    if (tid < 32) lcnt[tid] = 0;
    lrun[tid] = 0;
    int pending = 0;
    f32x4 g[4];
#pragma unroll
    for (int q = 0; q < 4; ++q) g[q] = *(const f32x4*)(p.g_ffn + (q >> 1) * 512 + c0 + (q & 1) * 4);
    float wB[64];
#pragma unroll
    for (int s = 0; s < 32; ++s) { const int k0 = 128 * wid + 4 * s + 2 * (lane >> 5); wB[2 * s] = p.w_r[k0 * 32 + (lane & 31)]; wB[2 * s + 1] = p.w_r[(k0 + 1) * 32 + (lane & 31)]; }
    __syncthreads();
    u32x4 xr[4][2]; f32x4 scr[4], shr[4];
    auto loadtile = [&](int tile) { const int rbase = min(tile, L / 32 - 1) * 32; const float* mod = modv + (rbase / SEQ) * 6144;
#pragma unroll
        for (int u = 0; u < 4; ++u)
#pragma unroll
            for (int j = 0; j < 2; ++j) xr[u][j] = *(const u32x4*)((const bf16_t*)(ws + OFF_X1) + (size_t)(rbase + wid * 4 + u) * D + j * 512 + c0);
#pragma unroll
        for (int q = 0; q < 4; ++q) { const int cc = (q >> 1) * 512 + c0 + (q & 1) * 4; scr[q] = *(const f32x4*)(mod + 4 * 1024 + cc); shr[q] = *(const f32x4*)(mod + 3 * 1024 + cc); } };
    loadtile(blockIdx.x);
    int it = 0;
    for (int tile = blockIdx.x; tile < L / 32; tile += gridDim.x, ++it) {
        const int rbase = tile * 32;
        f32x4 gs[4];
#pragma unroll
        for (int q = 0; q < 4; ++q) gs[q] = g[q] * (scr[q] + 1.0f);
#pragma unroll
        for (int u = 0; u < 4; ++u) { const int rl = wid * 4 + u, row = rbase + rl; f32x4 v[4]; float ss = 0.f;
#pragma unroll
            for (int j = 0; j < 2; ++j) { float t8[8]; unpack8(xr[u][j], t8); v[2 * j] = (f32x4){t8[0], t8[1], t8[2], t8[3]}; v[2 * j + 1] = (f32x4){t8[4], t8[5], t8[6], t8[7]}; }
#pragma unroll
            for (int q = 0; q < 4; ++q) ss += (v[q][0] * v[q][0] + v[q][1] * v[q][1]) + (v[q][2] * v[q][2] + v[q][3] * v[q][3]);
            const float rs = rsqrtf(wave_sum(ss) * (1.0f / D) + EPS);
#pragma unroll
            for (int j = 0; j < 2; ++j) { f32x4 o[2];
#pragma unroll
                for (int e = 0; e < 2; ++e) { const int cc = j * 512 + c0 + e * 4; o[e] = v[j * 2 + e] * rs * gs[j * 2 + e] + shr[j * 2 + e];
                    *(LAS f32x4*)(hs + rl * HS_LD + cc) = o[e]; }
                u32x2 w; w.x = pack4_fp8(o[0][0], o[0][1], o[0][2], o[0][3]); w.y = pack4_fp8(o[1][0], o[1][1], o[1][2], o[1][3]);
                *(u32x2*)(h2 + (size_t)row * D + j * 512 + c0) = w; } }
        lds_sync();
        loadtile(tile + gridDim.x);
        { f32x16 a0, a1;
#pragma unroll
          for (int r = 0; r < 16; ++r) { a0[r] = 0.f; a1[r] = 0.f; }
          const LAS float* hp = hs + (lane & 31) * HS_LD + 128 * wid + 2 * (lane >> 5);
#pragma unroll
          for (int s = 0; s < 32; ++s) { const f32x2 a = *(const LAS f32x2*)(hp + 4 * s);
              a0 = __builtin_amdgcn_mfma_f32_32x32x2f32(a[0], wB[2 * s], a0, 0, 0, 0); a1 = __builtin_amdgcn_mfma_f32_32x32x2f32(a[1], wB[2 * s + 1], a1, 0, 0, 0); }
          lds_sync();
#pragma unroll
          for (int r = 0; r < 16; ++r) { const int m = 8 * (r >> 2) + 4 * (lane >> 5) + (r & 3); hs[(wid * 32 + m) * 32 + (lane & 31)] = a0[r] + a1[r]; }
          lds_sync();
#pragma unroll
          for (int q = 0; q < 2; ++q) { const int o = tid + 512 * q; float t = p.b_r[o & 31];
#pragma unroll
              for (int w = 0; w < 8; ++w) t += hs[w * 1024 + o];
              lg[o] = t; } }
        lds_sync();
#pragma unroll
        for (int rep = 0; rep < 2; ++rep) { const int rl = wid * 4 + rep * 2 + (lane >> 5), row = rbase + rl, e = lane & 31; const float v = lg[rl * 32 + e]; int rank = 0;
#pragma unroll
            for (int q = 0; q < 8; ++q) { const f32x4 t = *(const LAS f32x4*)(lg + rl * 32 + 4 * q);
#pragma unroll
                for (int i = 0; i < 4; ++i) { const int gt = t[i] > v, eq = t[i] == v, lt = (4 * q + i) < e; rank += gt | (eq & lt); } }
            if (rank < 4) { lselv[rl * 4 + rank] = v; lseli[rl * 4 + rank] = e; }
            asm volatile("s_waitcnt lgkmcnt(0)" ::: "memory");
            const f32x4 sv = *(const LAS f32x4*)(lselv + rl * 4); const int k = e & 3; const int myk = lseli[rl * 4 + k];
            const float e0 = 1.0f, e1 = __expf(sv[1] - sv[0]), e2 = __expf(sv[2] - sv[0]), e3 = __expf(sv[3] - sv[0]); const float sum = ((e0 + e1) + e2) + e3;
            const float mye = k == 0 ? e0 : (k == 1 ? e1 : (k == 2 ? e2 : e3)); const float myp = mye / sum;
            if (e < 4) { const int pair = row * 4 + e; topi[pair] = myk; topp[pair] = myp; __hip_atomic_fetch_add(&lcnt[myk], 1, __ATOMIC_RELAXED, __HIP_MEMORY_SCOPE_WORKGROUP); lent[(it * 32 + rl) * 4 + e] = myk; } }
        lds_sync();
        { const int t3 = otid(); if (t3 < 32) { const int n = lcnt[t3]; if (it > 0) lbase[(it - 1) * 32 + t3] = pending; pending = n > 0 ? atomicAdd(&cnt[t3], n) : 0; lcnt[t3] = 0; } }
    }
    const int t2 = otid();
    if (t2 < 32 && it > 0) lbase[(it - 1) * 32 + t2] = pending;
    __syncthreads();
    const int nent = it * 128;
    for (int s = t2; s < nent; s += 512) { const int e = lent[s]; const int ii = s >> 7, rl = (s >> 2) & 31, k = s & 3; const int row = (blockIdx.x + ii * gridDim.x) * 32 + rl;
        const int pos = lbase[ii * 32 + e] + __hip_atomic_fetch_add(&lrun[ii * 32 + e], 1, __ATOMIC_RELAXED, __HIP_MEMORY_SCOPE_WORKGROUP); list[e * CAP + pos] = row * 4 + k; pairpos[row * 4 + k] = pos; }
}
__device__ __forceinline__ void moe_table(const int* cnt, LAS int* tab) {
    if (otid() == 0) { int t = 0; for (int e = 0; e < NE; ++e) { tab[e] = t; const int n = cnt[e]; tab[64 + e] = n; t += (n + 255) >> 8; } tab[32] = t; tab[33] = t; }
    __syncthreads();
    for (int rt = otid(); rt < tab[33]; rt += 512) { int e = 0; while (tab[e + 1] <= rt) ++e; tab[128 + rt] = e; }
    __syncthreads();
}
constexpr int LDS_TAB = pg8::STAGE_BYTES;
__device__ __forceinline__ void phase7(const Params& p, LAS unsigned char* lds) {
    char* ws = p.ws; LAS int* tab = (LAS int*)(lds + LDS_TAB); moe_table((const int*)(ws + OFF_CNT), tab);
    pg8::MoeSched<true> S; S.nN = 8; S.G = gridDim.x; S.c = blockIdx.x; S.rowb = 1024; S.Wt = ws + OFF_WT_GU; S.wexp = (size_t)2048 * 1024; S.btile = (size_t)256 * 1024; S.tab = tab; S.list = (const int*)(ws + OFF_LIST);
    pg8::EpiMoe1 E{(unsigned char*)(ws + OFF_ACT), p.b_gu};
    pg8::gemm_phase<pg8::EpiMoe1, pg8::MoeSched<true>, true, 127, 122>(lds, (const char*)(ws + OFF_H), 1024, S, E);
}
__device__ __forceinline__ void phase8(const Params& p, LAS unsigned char* lds) {
    char* ws = p.ws; LAS int* tab = (LAS int*)(lds + LDS_TAB);
    pg8::MoeSched<false> S; S.nN = 4; S.G = gridDim.x; S.c = blockIdx.x; S.rowb = 1024; S.Wt = ws + OFF_WT_DN; S.wexp = (size_t)1024 * 1024; S.btile = (size_t)256 * 1024; S.tab = tab; S.list = (const int*)(ws + OFF_LIST);
    pg8::EpiMoe2 E{(bf16_t*)(ws + OFF_YP), p.b_dn};
    pg8::gemm_phase<pg8::EpiMoe2, pg8::MoeSched<false>, true, 125, 122>(lds, (const char*)(ws + OFF_ACT), 1024, S, E);
}
__device__ __forceinline__ void phase9(const Params& p, LAS unsigned char* lds) {
    char* ws = p.ws; const float* modv = (const float*)(ws + OFF_MOD); const bf16_t* yp = (const bf16_t*)(ws + OFF_YP); const float* topp = (const float*)(ws + OFF_TOPP);
    const int* topi = (const int*)(ws + OFF_TOPI); const int* pairpos = (const int*)(ws + OFF_ROWPAIR);
    LAS int* tab = (LAS int*)(lds + LDS_TAB);
    const int tid = otid(), lane = tid & 63, gw = blockIdx.x * 8 + (tid >> 6), nw = gridDim.x * 8, c0 = lane * 8;
    f32x4 fg[4];
#pragma unroll
    for (int q = 0; q < 4; ++q) fg[q] = *(const f32x4*)(p.g_fin + (q >> 1) * 512 + c0 + (q & 1) * 4);
    for (int row = gw; row < L; row += nw) {
        const float* gate = modv + (row / SEQ) * 6144 + 5 * 1024; f32x4 v[4]; u32x4 yr[4][2];
        const pg8::i32x4_t ek = *(const pg8::i32x4_t*)(topi + row * 4), pk4 = *(const pg8::i32x4_t*)(pairpos + row * 4);
#pragma unroll
        for (int j = 0; j < 2; ++j) { float t8[8]; unpack8(*(const u32x4*)((const bf16_t*)(ws + OFF_X1) + (size_t)row * D + j * 512 + c0), t8); v[2 * j] = (f32x4){t8[0], t8[1], t8[2], t8[3]}; v[2 * j + 1] = (f32x4){t8[4], t8[5], t8[6], t8[7]}; }
#pragma unroll
        for (int k = 0; k < 4; ++k) { const size_t yrow = (size_t)tab[ek[k]] * 256 + pk4[k];
#pragma unroll
            for (int j = 0; j < 2; ++j) yr[k][j] = __builtin_nontemporal_load((const u32x4*)(yp + yrow * D + j * 512 + c0)); }
        const f32x4 pk = *(const f32x4*)(topp + row * 4);
        float m[16];
#pragma unroll
        for (int i = 0; i < 16; ++i) m[i] = 0.f;
#pragma unroll
        for (int k = 0; k < 4; ++k)
#pragma unroll
            for (int j = 0; j < 2; ++j) { float t[8]; unpack8(yr[k][j], t);
#pragma unroll
                for (int i = 0; i < 8; ++i) m[j * 8 + i] += pk[k] * t[i]; }
        float ss = 0.f;
#pragma unroll
        for (int q = 0; q < 4; ++q) { const f32x4 gt = *(const f32x4*)(gate + (q >> 1) * 512 + c0 + (q & 1) * 4);
#pragma unroll
            for (int i = 0; i < 4; ++i) { v[q][i] += gt[i] * m[q * 4 + i]; ss += v[q][i] * v[q][i]; } }
        const float rs = rsqrtf(wave_sum(ss) * (1.0f / D) + EPS);
#pragma unroll
        for (int q = 0; q < 4; ++q) __builtin_nontemporal_store(v[q] * rs * fg[q], (f32x4*)(p.out + (size_t)row * D + (q >> 1) * 512 + c0 + (q & 1) * 4));
    }
}

namespace at {
using s16x4  = __attribute__((ext_vector_type(4))) short;
constexpr int NW = 8, QBLK = 32, KVBLK = 64, DK = 192, DV = 128;
constexpr float SCALE = 0.07216878364870322f;
constexpr float THR = 8.f;
constexpr int SHM_V = KVBLK * DV * 2, SHM_K = KVBLK * DK * 2, SHM_ATTN = 2 * SHM_V + 2 * SHM_K + NW * 64 * 4;
#define KSWZ(row, colB) ((row) * 384 + ((colB) ^ ((((row) ^ ((row) >> 3)) & 7) << 4)))
#define SBAR() __builtin_amdgcn_sched_barrier(0)
__device__ __forceinline__ int crow(int r, int hi) { return (r & 3) + 8 * (r >> 2) + 4 * hi; }
__device__ __forceinline__ unsigned cvtpk(float lo, float hi) { return cvt_pk_bf16(lo, hi); }

__device__ __forceinline__ void partialSM(f32x16& p0, f32x16& p1, float& m_reg, float& mn, float& alpha) {
  constexpr float C = SCALE * 1.4426950408889634f;
  float pmax = p0[0];
#pragma unroll
  for (int r = 1; r < 16; ++r) pmax = fmaxf(pmax, p0[r]);
#pragma unroll
  for (int r = 0; r < 16; ++r) pmax = fmaxf(pmax, p1[r]);
  { auto rr = __builtin_amdgcn_permlane32_swap(__float_as_uint(pmax), __float_as_uint(pmax), false, false);
    pmax = fmaxf(__uint_as_float(rr[0]), __uint_as_float(rr[1])); }
  if (__builtin_expect(__all(pmax - m_reg <= THR / SCALE), 1)) { mn = m_reg; alpha = 1.f; }
  else { mn = fmaxf(m_reg, pmax); alpha = __builtin_amdgcn_exp2f((m_reg - mn) * C); m_reg = mn; }
  float mnC = -mn * C;
#pragma unroll
  for (int r = 0; r < 16; ++r) p0[r] = fmaf(p0[r], C, mnC);
#pragma unroll
  for (int r = 0; r < 16; ++r) p1[r] = fmaf(p1[r], C, mnC);
#pragma unroll
  for (int r = 0; r < 16; ++r) p0[r] = __builtin_amdgcn_exp2f(p0[r]);
}
__device__ __forceinline__ void finishSM(f32x16& p0, f32x16& p1, float alpha, float& l_reg, bf16x8& pa0, bf16x8& pa1, bf16x8& pa2, bf16x8& pa3) {
#pragma unroll
  for (int r = 0; r < 16; ++r) p1[r] = __builtin_amdgcn_exp2f(p1[r]);
  float ps = 0;
#pragma unroll
  for (int r = 0; r < 16; ++r) ps += p0[r];
#pragma unroll
  for (int r = 0; r < 16; ++r) ps += p1[r];
  { auto rr = __builtin_amdgcn_permlane32_swap(__float_as_uint(ps), __float_as_uint(ps), false, false);
    ps = __uint_as_float(rr[0]) + __uint_as_float(rr[1]); }
  l_reg = l_reg * alpha + ps;
#define PK4(P, BASE, OUT) do { unsigned a0 = cvtpk(P[BASE + 0], P[BASE + 1]), a1 = cvtpk(P[BASE + 2], P[BASE + 3]);   \
    unsigned b0 = cvtpk(P[BASE + 4], P[BASE + 5]), b1 = cvtpk(P[BASE + 6], P[BASE + 7]);                              \
    auto r0 = __builtin_amdgcn_permlane32_swap(a0, b0, false, false); auto r1 = __builtin_amdgcn_permlane32_swap(a1, b1, false, false); \
    u32x4 w = {r0[0], r1[0], r0[1], r1[1]}; OUT = *reinterpret_cast<bf16x8*>(&w); } while (0)
  PK4(p0, 0, pa0); PK4(p0, 8, pa1); PK4(p1, 0, pa2); PK4(p1, 8, pa3);
#undef PK4
}
__device__ __forceinline__ void qkt(f32x16& p0, f32x16& p1, const LAS char* Ks, const bf16x8 (&qr)[12], int r32, int hi) {
  p0 = f32x16{}; p1 = f32x16{};
#pragma unroll
  for (int d0 = 0; d0 < 12; ++d0) { const int cb = (d0 * 16 + hi * 8) * 2;
    const bf16x8 b0 = *reinterpret_cast<const LAS bf16x8*>(Ks + KSWZ(r32, cb));
    const bf16x8 b1 = *reinterpret_cast<const LAS bf16x8*>(Ks + KSWZ(32 + r32, cb));
    p0 = __builtin_amdgcn_mfma_f32_32x32x16_bf16(b0, qr[d0], p0, 0, 0, 0);
    p1 = __builtin_amdgcn_mfma_f32_32x32x16_bf16(b1, qr[d0], p1, 0, 0, 0); }
}
__device__ __forceinline__ int v_st(int k, int c) { const int kk = (k & ~0xC) | ((k & 4) << 1) | ((k & 8) >> 1); return ((kk >> 3) * 4 + (c >> 5)) * 512 + ((kk & 7) * 32 + (c & 31)) * 2; }
__device__ __forceinline__ int v_rd_base(int lane) { return ((lane & 3) << 3) | (((lane >> 2) & 3) << 6) | (((lane >> 4) & 1) << 5) | (((lane >> 5) & 1) << 8); }
constexpr int v_rd_off(int d0, int ks, int half) { return d0 * 512 + ks * 4096 + half * 2048; }
template <int OFF> __device__ __forceinline__ s16x4 tr_read(int vb) { s16x4 r; asm volatile("ds_read_b64_tr_b16 %0, %1 offset:%2" : "=&v"(r) : "v"(vb), "i"(OFF) : "memory"); return r; }
template <int D0> __device__ __forceinline__ void pv_one(f32x16& od, int vb, bf16x8 pa0, bf16x8 pa1, bf16x8 pa2, bf16x8 pa3) {
  const s16x4 l0 = tr_read<v_rd_off(D0, 0, 0)>(vb), h0 = tr_read<v_rd_off(D0, 0, 1)>(vb), l1 = tr_read<v_rd_off(D0, 1, 0)>(vb), h1 = tr_read<v_rd_off(D0, 1, 1)>(vb);
  const s16x4 l2 = tr_read<v_rd_off(D0, 2, 0)>(vb), h2 = tr_read<v_rd_off(D0, 2, 1)>(vb), l3 = tr_read<v_rd_off(D0, 3, 0)>(vb), h3 = tr_read<v_rd_off(D0, 3, 1)>(vb);
  asm volatile("s_waitcnt lgkmcnt(0)" ::: "memory"); SBAR();
#define PK(Lo, Hi) (bf16x8){Lo[0], Lo[1], Lo[2], Lo[3], Hi[0], Hi[1], Hi[2], Hi[3]}
  od = __builtin_amdgcn_mfma_f32_32x32x16_bf16(pa0, PK(l0, h0), od, 0, 0, 0);
  od = __builtin_amdgcn_mfma_f32_32x32x16_bf16(pa1, PK(l1, h1), od, 0, 0, 0);
  od = __builtin_amdgcn_mfma_f32_32x32x16_bf16(pa2, PK(l2, h2), od, 0, 0, 0);
  od = __builtin_amdgcn_mfma_f32_32x32x16_bf16(pa3, PK(l3, h3), od, 0, 0, 0);
#undef PK
}
__device__ __forceinline__ void pv_d0(f32x16 (&o)[4], int vb, bf16x8 pa0, bf16x8 pa1, bf16x8 pa2, bf16x8 pa3) {
  pv_one<0>(o[0], vb, pa0, pa1, pa2, pa3); pv_one<1>(o[1], vb, pa0, pa1, pa2, pa3); pv_one<2>(o[2], vb, pa0, pa1, pa2, pa3); pv_one<3>(o[3], vb, pa0, pa1, pa2, pa3);
}

__device__ __forceinline__ void attn_unit(const bf16_t* __restrict__ Qb, const bf16_t* __restrict__ Kh, const bf16_t* __restrict__ Vh, bf16_t* __restrict__ Ob, int t0, const float* __restrict__ ropet, LAS char* lds) {
  constexpr int LDQ = 1536, LDO = 1024, NT = NKEY / KVBLK;
  const int tid = otid(), wid = tid >> 6, lane = tid & 63, r32 = lane & 31, hi = lane >> 5;
  LAS char* V_lds = lds; LAS char* K_lds = lds + 2 * SHM_V;
  LAS float* wsl = (LAS float*)(lds + 2 * SHM_V + 2 * SHM_K) + wid * 64; LAS float* li_l = wsl; LAS float* al_l = wsl + 32;
  float m_reg = -1e30f, l_reg = 0; f32x16 o[4] = {}; bf16x8 qr[12];
  { const bf16_t* Qw = Qb + (size_t)(wid * QBLK + r32) * LDQ + hi * 8;
#pragma unroll
    for (int d0 = 0; d0 < 12; ++d0) qr[d0] = *reinterpret_cast<const bf16x8*>(Qw + d0 * 16);
    const float* rt = ropet + (size_t)(t0 + wid * QBLK + r32) * 64 + 8 * hi;
#pragma unroll
    for (int g = 0; g < 2; ++g) {
      const f32x4 c0 = *(const f32x4*)(rt + 16 * g), c1 = *(const f32x4*)(rt + 16 * g + 4), s0 = *(const f32x4*)(rt + 32 + 16 * g), s1 = *(const f32x4*)(rt + 32 + 16 * g + 4);
      float n1[8], n2[8];
#pragma unroll
      for (int j = 0; j < 8; ++j) { const float cs = j < 4 ? c0[j & 3] : c1[j & 3], sn = j < 4 ? s0[j & 3] : s1[j & 3];
        const float x1 = bf2f((bf16_t)qr[8 + g][j]), x2 = bf2f((bf16_t)qr[10 + g][j]); n1[j] = x1 * cs - x2 * sn; n2[j] = x1 * sn + x2 * cs; }
      u32x4 w1 = {cvtpk(n1[0], n1[1]), cvtpk(n1[2], n1[3]), cvtpk(n1[4], n1[5]), cvtpk(n1[6], n1[7])}; u32x4 w2 = {cvtpk(n2[0], n2[1]), cvtpk(n2[2], n2[3]), cvtpk(n2[4], n2[5]), cvtpk(n2[6], n2[7])};
      qr[8 + g] = *reinterpret_cast<bf16x8*>(&w1); qr[10 + g] = *reinterpret_cast<bf16x8*>(&w2); } }
  const int sr = tid >> 4, sc = (tid & 15) * 8, vst0 = v_st(sr, sc), vst1 = v_st(32 + sr, sc);
  int kgo[3], kst[3];
#pragma unroll
  for (int i = 0; i < 3; ++i) { const int c = tid + 512 * i, row = c / 24, c8 = (c % 24) * 8; kgo[i] = row * DK + c8; kst[i] = KSWZ(row, c8 * 2); }
  const int vb0 = (int)(uintptr_t)V_lds + v_rd_base(lane);
  bf16x8 sv0, sv1, sk0, sk1, sk2;
#define SLOAD(k0) do { sv0 = *reinterpret_cast<const bf16x8*>(&Vh[(size_t)((k0) + sr) * DV + sc]); sv1 = *reinterpret_cast<const bf16x8*>(&Vh[(size_t)((k0) + 32 + sr) * DV + sc]); \
    sk0 = *reinterpret_cast<const bf16x8*>(&Kh[(size_t)(k0) * DK + kgo[0]]); sk1 = *reinterpret_cast<const bf16x8*>(&Kh[(size_t)(k0) * DK + kgo[1]]); sk2 = *reinterpret_cast<const bf16x8*>(&Kh[(size_t)(k0) * DK + kgo[2]]); } while (0)
#define SWRITE(b) do { *(LAS bf16x8*)(V_lds + (b) * SHM_V + vst0) = sv0; *(LAS bf16x8*)(V_lds + (b) * SHM_V + vst1) = sv1; \
    *(LAS bf16x8*)(K_lds + (b) * SHM_K + kst[0]) = sk0; *(LAS bf16x8*)(K_lds + (b) * SHM_K + kst[1]) = sk1; *(LAS bf16x8*)(K_lds + (b) * SHM_K + kst[2]) = sk2; } while (0)
#define RESC(a) do { if (__any((a) < 1.f)) { if (hi == 0) al_l[r32] = (a); asm volatile("s_waitcnt lgkmcnt(0)" ::: "memory"); \
    _Pragma("unroll") for (int d = 0; d < 4; ++d) _Pragma("unroll") for (int r = 0; r < 16; ++r) o[d][r] *= al_l[crow(r, hi)]; } } while (0)
  f32x16 p0, p1; float mn, al; bf16x8 pa0, pa1, pa2, pa3;
  SLOAD(0); asm volatile("s_waitcnt vmcnt(0)" ::: "memory"); SWRITE(0); __syncthreads();
  for (int j = 0; j < NT; ++j) {
    const int bsel = j & 1;
    if (j + 1 < NT) SLOAD((j + 1) * KVBLK);
    SBAR(); qkt(p0, p1, K_lds + bsel * SHM_K, qr, r32, hi);
    partialSM(p0, p1, m_reg, mn, al);
    RESC(al);
    finishSM(p0, p1, al, l_reg, pa0, pa1, pa2, pa3); SBAR();
    pv_d0(o, vb0 + bsel * SHM_V, pa0, pa1, pa2, pa3);
    if (j + 1 < NT) { asm volatile("s_waitcnt vmcnt(0)" ::: "memory"); SWRITE(bsel ^ 1); }
    __syncthreads();
  }
  if (hi == 0) li_l[r32] = l_reg; asm volatile("s_waitcnt lgkmcnt(0)" ::: "memory");
  float rli[16];
#pragma unroll
  for (int r = 0; r < 16; ++r) rli[r] = __builtin_amdgcn_rcpf(li_l[crow(r, hi)]);
  { LAS bf16_t* ot = (LAS bf16_t*)(lds + wid * 8192);
#pragma unroll
    for (int r = 0; r < 16; ++r) { const int orow = crow(r, hi);
#pragma unroll
      for (int d0 = 0; d0 < 4; ++d0) ot[orow * 128 + d0 * 32 + r32] = f2bf(o[d0][r] * rli[r]); }
    asm volatile("s_waitcnt lgkmcnt(0)" ::: "memory");
    bf16_t* Ow = Ob + (size_t)(wid * QBLK) * LDO;
#pragma unroll
    for (int i = 0; i < 8; ++i) { const int q = lane + 64 * i, row = q >> 4, ch = q & 15; const u32x4 w = *(const LAS u32x4*)(ot + row * 128 + ch * 8); *(u32x4*)(Ow + (size_t)row * LDO + ch * 8) = w; } }
#undef SLOAD
#undef SWRITE
#undef RESC
}
}

__device__ __forceinline__ void phase_attn(const Params& p, LAS unsigned char* lds) {
    char* ws = p.ws; const bf16_t* Q = (const bf16_t*)(ws + OFF_Q); const bf16_t* Kb = (const bf16_t*)(ws + OFF_K); const bf16_t* Vb = (const bf16_t*)(ws + OFF_V); bf16_t* Y = (bf16_t*)(ws + OFF_H);
    const int G = gridDim.x;
    for (int it = 0;; ++it) {
        int u;
        if (G == 256) { const int c = blockIdx.x, xcd = c & 7, j = c >> 3; if (it >= 4) break; u = ((it * 32 + xcd * 4 + (j >> 3)) << 3) | (j & 7); }
        else { u = it * G + blockIdx.x; if (u >= 1024) break; }
        const int bh = u >> 3, qb = u & 7, b = bh >> 3, h = bh & 7;
        at::attn_unit(Q + ((size_t)(b * SEQ + qb * 256)) * 1536 + h * 192, Kb + (size_t)bh * NKEY * 192, Vb + (size_t)bh * NKEY * 128, Y + ((size_t)(b * SEQ + qb * 256)) * D + h * 128, qb * 256, (const float*)(ws + OFF_ROPE), (LAS char*)lds);
        __syncthreads();
    }
}

namespace sc {
using f32x16 = __attribute__((ext_vector_type(16))) float;
constexpr int BUFB = 53248, O_QT = 0, O_KH = 16384, O_VT = 32768, O_AT = 49152, O_DEC = 51200, O_KD = 2 * BUFB, O_OUT = 2 * BUFB + 16384, LDS_SCAN = 2 * BUFB + 16384 + 2 * 16384;
__device__ __forceinline__ int sw256(int row, int cb) { return row * 256 + (cb ^ ((row & 15) << 4)); }
__device__ __forceinline__ int sw128(int row, int cb) { return row * 128 + (cb ^ (((row >> 1) & 7) << 4)); }
__device__ __forceinline__ int grow_of(int n, int b, int dir) { if (n < CTXL) { const int s = dir ? (CTXL - 1 - n) : n; return L + b * CTXL + s; } const int m = n - CTXL; return b * SEQ + (dir ? (SEQ - 1 - m) : m); }
__device__ __forceinline__ bf16x8 pack_acc8(const f32x16& x, int s) { u32x4 p; p.x = cvt_pk_bf16(x[8 * s], x[8 * s + 1]); p.y = cvt_pk_bf16(x[8 * s + 2], x[8 * s + 3]); p.z = cvt_pk_bf16(x[8 * s + 4], x[8 * s + 5]); p.w = cvt_pk_bf16(x[8 * s + 6], x[8 * s + 7]); return __builtin_bit_cast(bf16x8, p); }

__device__ __forceinline__ void scan_unit(const Params& p, int unit, LAS unsigned char* lds) {
    char* ws = p.ws; const int dir = unit & 1, h = (unit >> 1) & 7, b = unit >> 4;
    const bf16_t* hq = (const bf16_t*)(ws + OFF_HQ); const bf16_t* fz = (const bf16_t*)(ws + (dir ? OFF_FB : OFF_FF)); const bf16_t* iv = (const bf16_t*)(ws + OFF_IV);
    bf16_t* outp = (bf16_t*)(ws + (dir ? OFF_OB : OFF_OF)); const float* lb = (const float*)(ws + OFF_LB);
    const int tid = otid(), wid = __builtin_amdgcn_readfirstlane(tid >> 6), lane = tid & 63, r32 = lane & 31, hi = lane >> 5;
    const int sgn = dir ? -1 : 1; const long rstep = (long)sgn * D;
    __syncthreads();
    if (wid >= 4) {
        const int I = wid - 4, cp = lane, hc = h * 128 + 2 * cp;
        const float lbv0 = lb[dir * 1024 + hc], lbv1 = lb[dir * 1024 + hc + 1];
        unsigned zr[16], vr[16], qr[16];
#define SC_LOAD(c) do { const size_t o0_ = (size_t)(grow_of((c) * 64, b, dir) + sgn * (16 * I)) * D + hc; const bf16_t* pz_ = fz + o0_; const bf16_t* pv_ = iv + o0_; const bf16_t* pq_ = hq + o0_; \
        _Pragma("unroll") for (int i = 0; i < 16; ++i) { zr[i] = *(const unsigned*)pz_; pz_ += rstep; vr[i] = *(const unsigned*)pv_; pv_ += rstep; if ((c) >= 4) { qr[i] = *(const unsigned*)pq_; pq_ += rstep; } } } while (0)
        SC_LOAD(0);
        for (int it = 0; it <= 37; ++it) {
            if (it >= 6) {
                const int c = it - 2; const LAS unsigned char* OB = lds + O_OUT + (c & 1) * 16384; const int pt = I * 64 + lane;
                bf16_t* ob = outp + (size_t)grow_of(c * 64, b, dir) * D + h * 128;
#pragma unroll
                for (int q = 0; q < 4; ++q) { const int item = q * 256 + pt, t = item >> 4, c16 = item & 15;
                    *(u32x4*)(ob + (long)t * rstep + c16 * 8) = *(const LAS u32x4*)(OB + t * 256 + c16 * 16); }
            }
            if (it < 36) {
                const int c = it; const bool lat = c >= 4; LAS unsigned char* B = lds + (c & 1) * BUFB; LAS unsigned char* KD = lds + O_KD;
                float kk0[16], kk1[16], lc0[16], lc1[16]; float run0 = 0.f, run1 = 0.f;
#pragma unroll
                for (int i = 0; i < 16; ++i) { const float z0 = __uint_as_float(zr[i] << 16), z1 = __uint_as_float(zr[i] & 0xffff0000u);
                    const float f0 = lbv0 + (1.0f - lbv0) * sigmoidf_(z0), f1 = lbv1 + (1.0f - lbv1) * sigmoidf_(z1); kk0[i] = 1.0f - f0; kk1[i] = 1.0f - f1;
                    run0 += __builtin_amdgcn_logf(f0) * 0.6931471805599453f; run1 += __builtin_amdgcn_logf(f1) * 0.6931471805599453f; lc0[i] = run0; lc1[i] = run1; }
                *(LAS f32x2*)(B + O_DEC + (I * 128 + 2 * cp) * 4) = (f32x2){__expf(run0), __expf(run1)};
                unsigned kh0[8], kh1[8], vt0[8], vt1[8];
#pragma unroll
                for (int i = 0; i < 16; ++i) { const int t = 16 * I + i; const float l0 = lc0[i], l1 = lc1[i];
                    const float kd0 = kk0[i] * __expf(fminf(-l0, 80.0f)), kd1 = kk1[i] * __expf(fminf(-l1, 80.0f));
                    const float kf0 = kk0[i] * __expf(run0 - l0), kf1 = kk1[i] * __expf(run1 - l1);
                    if (lat) { const float q0 = __uint_as_float(qr[i] << 16), q1 = __uint_as_float(qr[i] & 0xffff0000u);
                        *(LAS unsigned*)(B + O_QT + sw256(t, 4 * cp)) = cvt_pk_bf16(q0 * __expf(l0), q1 * __expf(l1)); *(LAS unsigned*)(KD + sw256(t, 4 * cp)) = cvt_pk_bf16(kd0, kd1); }
                    if (i & 1) { kh0[i >> 1] = cvt_pk_bf16(__uint_as_float(kh0[i >> 1]), kf0); kh1[i >> 1] = cvt_pk_bf16(__uint_as_float(kh1[i >> 1]), kf1); vt0[i >> 1] = (vt0[i >> 1] >> 16) | (vr[i] << 16); vt1[i >> 1] = (vt1[i >> 1] >> 16) | (vr[i] & 0xffff0000u); }
                    else { kh0[i >> 1] = __float_as_uint(kf0); kh1[i >> 1] = __float_as_uint(kf1); vt0[i >> 1] = vr[i] << 16; vt1[i >> 1] = vr[i] & 0xffff0000u; } }
#pragma unroll
                for (int q = 0; q < 2; ++q) {
                    *(LAS u32x4*)(B + O_KH + sw128(2 * cp, 32 * I + 16 * q)) = (u32x4){kh0[4 * q], kh0[4 * q + 1], kh0[4 * q + 2], kh0[4 * q + 3]}; *(LAS u32x4*)(B + O_KH + sw128(2 * cp + 1, 32 * I + 16 * q)) = (u32x4){kh1[4 * q], kh1[4 * q + 1], kh1[4 * q + 2], kh1[4 * q + 3]};
                    *(LAS u32x4*)(B + O_VT + sw128(2 * cp, 32 * I + 16 * q)) = (u32x4){vt0[4 * q], vt0[4 * q + 1], vt0[4 * q + 2], vt0[4 * q + 3]}; *(LAS u32x4*)(B + O_VT + sw128(2 * cp + 1, 32 * I + 16 * q)) = (u32x4){vt1[4 * q], vt1[4 * q + 1], vt1[4 * q + 2], vt1[4 * q + 3]}; }
                if (it + 1 < 36) SC_LOAD(it + 1);
                if (lat) {
                    const int l15 = lane & 15, lq = lane >> 4; f32x4 a = {0.f, 0.f, 0.f, 0.f};
#pragma unroll
                    for (int ks = 0; ks < 4; ++ks) { const bf16x8 av = *(const LAS bf16x8*)(B + O_QT + sw256(16 * I + l15, (32 * ks + 8 * lq) * 2)); const bf16x8 bv = *(const LAS bf16x8*)(KD + sw256(16 * I + l15, (32 * ks + 8 * lq) * 2));
                        a = __builtin_amdgcn_mfma_f32_16x16x32_bf16(av, bv, a, 0, 0, 0); }
#pragma unroll
                    for (int r = 0; r < 4; ++r) { const int tl = 4 * lq + r; float v = a[r]; if (l15 > tl) v = 0.f; *(LAS bf16_t*)(B + O_AT + ((I * 16 + tl) * 16 + l15) * 2) = f2bf(v); }
                }
            }
            lds_sync();
        }
#undef SC_LOAD
    } else {
        const int bq = wid; f32x16 S[4];
#pragma unroll
        for (int a = 0; a < 4; ++a) S[a] = f32x16{};
        for (int it = 0; it <= 37; ++it) {
            if (it >= 1 && it <= 36) {
                const int c = it - 1; const bool lat = c >= 4; LAS unsigned char* B = lds + (c & 1) * BUFB;
                LAS bf16_t* po = (LAS bf16_t*)(lds + O_OUT + (c & 1) * 16384) + (4 * hi) * 128 + 32 * bq + r32;
#pragma unroll
                for (int I = 0; I < 4; ++I) {
                    const bf16x8 vtf = *(const LAS bf16x8*)(B + O_VT + sw128(32 * bq + r32, (16 * I + 8 * hi) * 2));
                    if (lat) {
                        f32x16 o = f32x16{};
#pragma unroll
                        for (int a = 0; a < 4; ++a)
#pragma unroll
                            for (int s = 0; s < 2; ++s) { const int dk0 = 32 * a + 16 * s + 4 * hi; const int row = 16 * I + (r32 & 15);
                                const u32x2 lo2 = *(const LAS u32x2*)(B + O_QT + sw256(row, dk0 * 2)), hi2 = *(const LAS u32x2*)(B + O_QT + sw256(row, (dk0 + 8) * 2));
                                const u32x4 av = {lo2.x, lo2.y, hi2.x, hi2.y};
                                o = __builtin_amdgcn_mfma_f32_32x32x16_bf16(__builtin_bit_cast(bf16x8, av), pack_acc8(S[a], s), o, 0, 0, 0); }
                        { const bf16x8 af = *(const LAS bf16x8*)(B + O_AT + ((I * 16 + (r32 & 15)) * 16 + 8 * hi) * 2); o = __builtin_amdgcn_mfma_f32_32x32x16_bf16(af, vtf, o, 0, 0, 0); }
#pragma unroll
                        for (int r = 0; r < 8; ++r) po[(16 * I + (r & 3) + 8 * (r >> 2)) * 128] = f2bf(o[r]);
                    }
#pragma unroll
                    for (int a = 0; a < 4; ++a) {
#pragma unroll
                        for (int g = 0; g < 4; ++g) { const f32x4 dc = *(const LAS f32x4*)(B + O_DEC + (I * 128 + 32 * a + 8 * g + 4 * hi) * 4); S[a][4 * g] *= dc[0]; S[a][4 * g + 1] *= dc[1]; S[a][4 * g + 2] *= dc[2]; S[a][4 * g + 3] *= dc[3]; }
                        const bf16x8 kf = *(const LAS bf16x8*)(B + O_KH + sw128(32 * a + r32, (16 * I + 8 * hi) * 2));
                        S[a] = __builtin_amdgcn_mfma_f32_32x32x16_bf16(kf, vtf, S[a], 0, 0, 0); }
                }
            }
            lds_sync();
        }
    }
    __syncthreads();
}
}
__device__ __forceinline__ void phase_scan(const Params& p, LAS unsigned char* lds) {
    for (int u = blockIdx.x; u < 256; u += gridDim.x) sc::scan_unit(p, u, lds);
}

constexpr int LDS_BYTES = 163840;
#include <cstdint>
#include <cstdlib>
#include <vector>

#define XB_TMO      128
#define XB_XCNT(j)  (256  + 64 * (j))
#define XB_XSUB(j)  (1280 + 64 * (j))
#define XB_XGEN(j)  (2304 + 64 * (j))
#define XB_TOP      3328
#define XB_TOPGEN   3392
#define XCD_BAR_WORDS 3456
#define XB_SPIN_CAP (1u << 18)

__device__ __forceinline__ unsigned xb_ld(unsigned* p)              { return __hip_atomic_load(p, __ATOMIC_RELAXED, __HIP_MEMORY_SCOPE_AGENT); }
__device__ __forceinline__ unsigned xb_add(unsigned* p, unsigned v) { return __hip_atomic_fetch_add(p, v, __ATOMIC_RELAXED, __HIP_MEMORY_SCOPE_AGENT); }
__device__ __forceinline__ unsigned xb_xcc_id() { return (unsigned)__builtin_amdgcn_s_getreg((3 << 11) | 20) & 0xFu; }
#define XB_SPIN(cond, bar) do { unsigned _sp = 0; while (cond) { __builtin_amdgcn_s_sleep(1); \
    if ((++_sp & 255u) == 0u) { if (xb_ld(&(bar)[XB_TMO])) break; if (_sp > XB_SPIN_CAP) { atomicAdd(&(bar)[XB_TMO], 1u); break; } } } } while (0)

struct XcdBarrier {
    unsigned* bar; unsigned x;
    volatile LAS unsigned* st;
};

__device__ __forceinline__ XcdBarrier xcd_barrier_post(unsigned* bar, volatile LAS unsigned* st) {
    XcdBarrier b; b.bar = bar; b.x = xb_xcc_id(); b.st = st;
    if (threadIdx.x == 0) (void)xb_add(&bar[XB_XCNT(b.x)], 1u);
    return b;
}
__device__ __forceinline__ void xcd_barrier_complete(unsigned* bar, unsigned x, unsigned& nloc, unsigned& nx) {
    const unsigned G = gridDim.x * gridDim.y * gridDim.z;
    unsigned sum, cnt, mine, sp = 0u;
    for (;;) {
        sum = 0u; cnt = 0u; mine = 0u;
#pragma unroll
        for (unsigned j = 0; j < 16; ++j) { const unsigned c = xb_ld(&bar[XB_XCNT(j)]); sum += c; cnt += (c > 0u) ? 1u : 0u; mine = (j == x) ? c : mine; }
        if (sum == G) break;
        __builtin_amdgcn_s_sleep(1);
        if ((++sp & 255u) == 0u) { if (xb_ld(&bar[XB_TMO])) break; if (sp > XB_SPIN_CAP) { atomicAdd(&bar[XB_TMO], 1u); break; } }
    }
    nloc = mine > 0u ? mine : 1u; nx = cnt > 0u ? cnt : 1u;
}

__device__ __forceinline__ void xcd_barrier(const XcdBarrier& b) {
    asm volatile("s_waitcnt vmcnt(0)" ::: "memory");
    __syncthreads();
    if (threadIdx.x == 0) {
        unsigned* bar = b.bar;
        __builtin_amdgcn_s_waitcnt(0);
        unsigned nloc = b.st[0], nx = b.st[1];
        if (nloc == 0u) { xcd_barrier_complete(bar, b.x, nloc, nx); b.st[0] = nloc; b.st[1] = nx; }
        const unsigned old = xb_add(&bar[XB_XSUB(b.x)], 1u);
        const unsigned gen = old / nloc;
        if (old + 1u == (gen + 1u) * nloc) {
            __builtin_amdgcn_fence(__ATOMIC_RELEASE, "agent");
            asm volatile("s_waitcnt vmcnt(0)" ::: "memory");
            const unsigned og = xb_add(&bar[XB_TOP], 1u);
            const unsigned tg = og / nx;
            if (og + 1u == (tg + 1u) * nx) xb_add(&bar[XB_TOPGEN], 1u);
            else XB_SPIN(xb_ld(&bar[XB_TOPGEN]) == tg, bar);
            __builtin_amdgcn_fence(__ATOMIC_ACQUIRE, "agent");
            xb_add(&bar[XB_XGEN(b.x)], 1u);
            asm volatile("s_waitcnt vmcnt(0)" ::: "memory");
        } else {
            XB_SPIN(xb_ld(&bar[XB_XGEN(b.x)]) == gen, bar);
            __builtin_amdgcn_fence(__ATOMIC_ACQUIRE, "agent");
            asm volatile("s_waitcnt vmcnt(0)" ::: "memory");
        }
    }
    __syncthreads();
}

__global__ void __launch_bounds__(512, 2) k_mega(Params p) {
    extern __shared__ __attribute__((aligned(16))) unsigned char smem[];
    LAS unsigned char* lds = (LAS unsigned char*)smem;
    volatile LAS unsigned* xbw = (volatile LAS unsigned*)(lds + LDS_BYTES - 16);
    if (threadIdx.x == 0) { xbw[0] = 0u; xbw[1] = 0u; xbw[2] = 0u; xbw[3] = 0u; }
    __syncthreads();
    XcdBarrier bar = xcd_barrier_post((unsigned*)(p.ws + OFF_BAR), xbw);
    phase0(p, lds);      xcd_barrier(bar);
    phase1(p, lds);      xcd_barrier(bar);
    phase2(p, lds);      xcd_barrier(bar);
    phase3(p, lds);      xcd_barrier(bar);
    phase_attn(p, lds);
    phase_scan(p, lds);  xcd_barrier(bar);
    phase4(p, lds);      xcd_barrier(bar);
    phase5(p, lds);      xcd_barrier(bar);
    phase6(p, lds);      xcd_barrier(bar);
    phase7(p, lds);      xcd_barrier(bar);
    phase8(p, lds);      xcd_barrier(bar);
    phase9(p, lds);
}
extern "C" void kernel_launch(void* const* d_in, const int* in_sizes, int n_in, void* d_out, int out_size, void* d_ws, size_t ws_size, hipStream_t stream) {
    static int grid = 0;
    if (grid == 0) {
        int dev = 0, cus = 0, per_cu = 0;
        if (hipGetDevice(&dev) != hipSuccess || hipDeviceGetAttribute(&cus, hipDeviceAttributeMultiprocessorCount, dev) != hipSuccess) { grid = -1; return; }
        if (hipFuncSetAttribute((const void*)k_mega, hipFuncAttributeMaxDynamicSharedMemorySize, LDS_BYTES) != hipSuccess) { grid = -1; return; }
        (void)hipOccupancyMaxActiveBlocksPerMultiprocessor(&per_cu, (const void*)k_mega, 512, LDS_BYTES);
        (void)hipGetLastError();
        grid = cus;
    }
    if (grid < 0) return;
    Params p{};
    p.x = (const float*)d_in[0]; p.c = (const float*)d_in[1]; p.ctx = (const float*)d_in[2]; p.cctx = (const float*)d_in[3]; p.w_mod = (const float*)d_in[4]; p.b_mod = (const float*)d_in[5];
    p.g_mix = (const float*)d_in[6]; p.w_in = (const float*)d_in[7]; p.g_q = (const float*)d_in[8]; p.w_qb = (const float*)d_in[9]; p.g_kv = (const float*)d_in[10]; p.w_kvb = (const float*)d_in[11];
    p.lbl = (const float*)d_in[12]; p.g_hg = (const float*)d_in[13]; p.w_out = (const float*)d_in[14]; p.g_ffn = (const float*)d_in[15]; p.w_r = (const float*)d_in[16]; p.b_r = (const float*)d_in[17];
    p.w_gu = (const float*)d_in[18]; p.b_gu = (const float*)d_in[19]; p.w_dn = (const float*)d_in[20]; p.b_dn = (const float*)d_in[21]; p.g_fin = (const float*)d_in[22];
    p.out = (float*)d_out; p.ws = (char*)d_ws;
    (void)hipMemsetAsync((char*)d_ws + OFF_BAR, 0, 16384, stream);
    hipLaunchKernelGGL(k_mega, dim3(grid), dim3(512), LDS_BYTES, stream, p);
}
```

```cpp
#include <hip/hip_runtime.h>
#include <stdint.h>

typedef unsigned short bf16_t;
__device__ __forceinline__ float bf2f(bf16_t v) { return __uint_as_float(((unsigned)v) << 16); }
__device__ __forceinline__ bf16_t f2bf(float f) { unsigned u = __float_as_uint(f); u += 0x7FFFu + ((u >> 16) & 1u); return (bf16_t)(u >> 16); }
__device__ __forceinline__ float sigmoidf_(float x) { return __builtin_amdgcn_rcpf(1.0f + __builtin_amdgcn_exp2f(-1.4426950408889634f * x)); }
__device__ __forceinline__ float siluf_(float x) { return x * __builtin_amdgcn_rcpf(1.0f + __builtin_amdgcn_exp2f(-1.4426950408889634f * x)); }

constexpr int D = 1024, NB = 16, SEQ = 2048, CTXL = 256;
constexpr int L = NB * SEQ;
constexpr int RC = NB * CTXL;
constexpr int R = L + RC;
constexpr int NKEY = SEQ + CTXL;
constexpr float EPS = 1e-6f;
constexpr int NE = 32, CAP = 32768;
constexpr int MAXROWS = 131072 + NE * 256;

constexpr size_t MiB = 1048576;
constexpr size_t OFF_SMALL = 0;
constexpr size_t OFF_BAR = 0;
constexpr size_t OFF_CNT = 16384;
constexpr size_t OFF_OFFS = 16384 + 1024;
constexpr size_t OFF_TILEE = 16384 + 2048;
constexpr size_t OFF_LB = 24576;
constexpr size_t OFF_MOD = 32768;
constexpr size_t OFF_SSQQ = 512 * 1024;
constexpr size_t OFF_SSQKV = 768 * 1024;
constexpr size_t OFF_TOPI = 1 * MiB;
constexpr size_t OFF_TOPP = 1 * MiB + 512 * 1024;
constexpr size_t OFF_ROWPAIR = 2 * MiB;
constexpr size_t OFF_LIST = 3 * MiB;
constexpr size_t OFF_H = 32 * MiB;
constexpr size_t OFF_QA = 104 * MiB;
constexpr size_t OFF_CKV = 152 * MiB;
constexpr size_t OFF_KR = 170 * MiB;
constexpr size_t OFF_OF = 104 * MiB;
constexpr size_t OFF_HQ = 175 * MiB;
constexpr size_t SEG_STRIDE = 72 * MiB;
constexpr size_t OFF_FF = OFF_HQ + 1 * SEG_STRIDE;
constexpr size_t OFF_FB = OFF_HQ + 2 * SEG_STRIDE;
constexpr size_t OFF_IV = OFF_HQ + 3 * SEG_STRIDE;
constexpr size_t OFF_OG = OFF_HQ + 4 * SEG_STRIDE;
constexpr size_t OFF_GM = OFF_HQ + 5 * SEG_STRIDE;
constexpr size_t OFF_GH = OFF_HQ + 6 * SEG_STRIDE;
constexpr size_t OFF_Q = 679 * MiB;
constexpr size_t OFF_K = 775 * MiB;
constexpr size_t OFF_V = 883 * MiB;
constexpr size_t OFF_OB = 955 * MiB;
constexpr size_t OFF_YP = 296 * MiB;
constexpr size_t OFF_ACT = 568 * MiB;


__device__ __forceinline__ void rope_cs(int t, int i, float& cs, float& sn) {
    int j = i & 15; float inv = __expf(-(float)j * (9.210340371976184f / 16.0f)); float pos = (i < 16) ? (float)(t >> 6) : (float)(t & 63);
    float ang = pos * inv; cs = cosf(ang); sn = sinf(ang);
}

#define LAS __attribute__((address_space(3)))
__device__ __forceinline__ int otid() { int t = threadIdx.x; asm volatile("" : "+v"(t)); return t; }
typedef short bf16x8 __attribute__((ext_vector_type(8)));
typedef float f32x4 __attribute__((ext_vector_type(4)));
typedef unsigned u32x4 __attribute__((ext_vector_type(4)));
typedef unsigned u32x2 __attribute__((ext_vector_type(2)));
typedef float f32x2 __attribute__((ext_vector_type(2)));
using f32x16 = __attribute__((ext_vector_type(16))) float;

constexpr size_t OFF_ROPE = 7 * MiB;
constexpr size_t OFF_WT_IN = 8 * MiB;
constexpr size_t OFF_WT_QB = 25 * MiB;
constexpr size_t OFF_WT_KVB = 28 * MiB;
constexpr size_t OFF_WT_OUT = 29 * MiB;
constexpr size_t OFF_WT_GU = 104 * MiB;
constexpr size_t OFF_WT_DN = 232 * MiB;
constexpr size_t OFF_YF8 = 775 * MiB;
constexpr size_t OFF_X1 = 704 * MiB;

struct Params {
    const float *x, *c, *ctx, *cctx, *w_mod, *b_mod, *g_mix, *w_in, *g_q, *w_qb, *g_kv, *w_kvb, *lbl, *g_hg, *w_out, *g_ffn, *w_r, *b_r, *w_gu, *b_gu, *w_dn, *b_dn, *g_fin;
    float* out; char* ws;
};

typedef __bf16 bf16v2_t __attribute__((ext_vector_type(2)));
__device__ __forceinline__ unsigned cvt_pk_bf16(float lo, float hi) { bf16v2_t v = {(__bf16)lo, (__bf16)hi}; return __builtin_bit_cast(unsigned, v); }

__device__ __forceinline__ unsigned pack4_fp8(float a, float b, float c, float d) {
    a = __builtin_amdgcn_fmed3f(a, -448.f, 448.f); b = __builtin_amdgcn_fmed3f(b, -448.f, 448.f); c = __builtin_amdgcn_fmed3f(c, -448.f, 448.f); d = __builtin_amdgcn_fmed3f(d, -448.f, 448.f);
    unsigned w = 0; w = __builtin_amdgcn_cvt_pk_fp8_f32(a, b, w, false); w = __builtin_amdgcn_cvt_pk_fp8_f32(c, d, w, true); return w; }

namespace pg8 {
constexpr int BM = 256, BK = 64, HALF = 128, HTB = HALF * BK * 2, STAGE_BYTES = 8 * HTB, NXCD = 8, WGM = 8;
constexpr int LDS_IDX = STAGE_BYTES + 8192;
__device__ __forceinline__ int lds_byte(int r, int c) { const int st = (r >> 4) * 2 + (c >> 5), rr = r & 15, cc = c & 31, ob = rr * 64 + cc * 2; return st * 1024 + (ob ^ (((ob >> 9) & 1) << 5)); }
__device__ __forceinline__ void stage_rc(int b, int& R, int& C) { const int st = b / 1024, sb = b % 1024, swz = sb ^ (((sb >> 9) & 1) << 5); R = (st >> 1) * 16 + swz / 64; C = (st & 1) * 32 + (swz % 64) / 2; }
__device__ __forceinline__ int perm32(int rho) { const int n = rho >> 4, i = rho & 15; return 8 * (i >> 2) + 4 * n + (i & 3); }
struct Unit { int pm, pn; const char* b; int e, pos0, cnt; };

__device__ __forceinline__ int xcd_remap(int L, int nwg) { const int q = nwg / NXCD, r = nwg % NXCD, xcd = L % NXCD, off = L / NXCD; return (xcd < r ? xcd * (q + 1) : r * (q + 1) + (xcd - r) * q) + off; }

struct DenseSched {
    int nM, nN, nwg, G, c, rowb; const char* Bt; size_t btile;
    __device__ void init(int M, int N, int kbytes, int rowb_, const void* Bt_, int G_, int c_) { nM = M / BM; nN = N / BM; nwg = nM * nN; G = G_; c = c_; rowb = rowb_; Bt = (const char*)Bt_; btile = (size_t)BM * kbytes; }
    static constexpr bool GATHER_LDS = false;
    __device__ __forceinline__ int kstepA() const { return 128; }
    __device__ __forceinline__ void tile(int wgid, int& pm, int& pn) const { const int nig = WGM * nN, gid = wgid / nig, fm = gid * WGM, gsz = (nM - fm) < WGM ? (nM - fm) : WGM; pm = fm + ((wgid % nig) % gsz); pn = (wgid % nig) / gsz; }
    __device__ __forceinline__ bool next(int i, Unit& u) const { const int Lx = i * G + c; if (Lx >= nwg) return false; tile(xcd_remap(Lx, nwg), u.pm, u.pn); u.b = Bt + (size_t)u.pn * btile; u.e = 0; u.pos0 = 0; u.cnt = 0; return true; }
    __device__ __forceinline__ void aoff(const Unit& u, const int (&Rr)[2], const int (&Cc)[2], unsigned (&va)[2][2]) const {
#pragma unroll
        for (int h = 0; h < 2; ++h)
#pragma unroll
            for (int i = 0; i < 2; ++i) va[h][i] = (unsigned)((u.pm * BM + h * HALF + Rr[i]) * rowb + Cc[i] * 2); }
};
struct InSched : DenseSched {
    __device__ void init2(const void* Bt_, int G_, int c_) { init(L, 8448, 1024, 1024, Bt_, G_, c_); }
    __device__ __forceinline__ bool next(int i, Unit& u) const {
        const int Lx = i * G + c; const int nlat = nwg;
        if (Lx < nlat) { tile(xcd_remap(Lx, nlat), u.pm, u.pn); }
        else { const int j = Lx - nlat; if (j >= 16 * 14) return false; const int q = j >> 4; u.pm = 128 + (j & 15); u.pn = q == 0 ? 3 : (q <= 12 ? 7 + q : 32); }
        u.b = Bt + (size_t)u.pn * btile; u.e = 0; u.pos0 = 0; u.cnt = 0; return true; }
};
__device__ __forceinline__ unsigned act_piece_off(int r, int c16) { const int s = 2 * (r >> 7) + (c16 >> 2), w = 4 * ((r >> 6) & 1) + (c16 & 3), l = 16 * ((r >> 4) & 3) + (r & 15); return (unsigned)(((s * 8 + w) * 64 + l) * 16); }
template <bool GATHER> struct MoeSched {
    int nN, G, c, rowb; const char* Wt; size_t wexp, btile; const LAS int* tab; const int* list;
    static constexpr bool GATHER_LDS = GATHER;
    __device__ __forceinline__ int kstepA() const { return GATHER ? 128 : 32768; }
    __device__ __forceinline__ bool next(int i, Unit& u) const {
        const int nwg = tab[33] * nN; const int Lx = i * G + c; if (Lx >= nwg) return false;
        const int w = xcd_remap(Lx, nwg); const int rt = w / nN; u.pn = w % nN; u.pm = rt;
        const int e = tab[128 + rt];
        u.e = e; u.pos0 = (rt - tab[e]) * BM; u.cnt = tab[64 + e]; u.b = Wt + (size_t)e * wexp + (size_t)u.pn * btile; return true; }
    __device__ __forceinline__ void aoff(const Unit& u, const int (&Rr)[2], const int (&Cc)[2], unsigned (&va)[2][2]) const {
#pragma unroll
        for (int h = 0; h < 2; ++h)
#pragma unroll
            for (int i = 0; i < 2; ++i) {
                if (GATHER) { const int pos = u.pos0 + h * HALF + Rr[i]; const int pair = pos < u.cnt ? list[u.e * CAP + pos] : 0; va[h][i] = (unsigned)((pair >> 2) * rowb + Cc[i] * 2); }
                else va[h][i] = (unsigned)u.pm * 262144u + act_piece_off(h * HALF + Rr[i], Cc[i] >> 3); } }
};

typedef int v8i_t __attribute__((ext_vector_type(8)));
typedef int i32x4_t __attribute__((ext_vector_type(4)));
template <class Epi, class Sched, bool FP8 = false, int SCA = 127, int SCB = 127>
__device__ __forceinline__ void gemm_phase(LAS unsigned char* lds, const char* Abase, const int K, const Sched& S, const Epi& E) {
    const int tid = otid(), wid = __builtin_amdgcn_readfirstlane(tid >> 6), lane = tid & 63, wr = wid >> 2, wc = wid & 3, fr = lane & 15, fq = lane >> 4;
    const int Kb = FP8 ? K : 2 * K;
    const int nt = Kb / (BK * 2);
    int Rr[2], Cc[2]; unsigned voffB[2];
#pragma unroll
    for (int i = 0; i < 2; ++i) { int R_, C_; stage_rc(tid * 16 + i * 8192, R_, C_); Rr[i] = R_; Cc[i] = C_; const int Rb = 64 * (R_ >> 5) + (Epi::PERM ? perm32(R_ & 31) : (R_ & 31)); voffB[i] = (unsigned)(Rb * Kb + C_ * 2); }
    const size_t kstep = (size_t)(BK * 2);
    const size_t kstepA = (size_t)S.kstepA();
    const size_t hstep = (size_t)32 * Kb;
    const unsigned ldsw = (unsigned)wid * 1024u;
    const int aoff = lds_byte(wr * 64 + fr, fq * 8), boff = lds_byte(wc * 32 + fr, fq * 8);
#define PG8_SA(b, h) (((b) * 2 + (h)) * HTB)
#define PG8_SB(b, h) ((4 + (b) * 2 + (h)) * HTB)
#define PG8_STAGE_B(bufoff, gbase) do { _Pragma("unroll") for (int _i = 0; _i < 2; ++_i) \
        __builtin_amdgcn_global_load_lds((const unsigned*)((const char*)(gbase) + voffB[_i]), (LAS unsigned*)(lds + (bufoff) + ldsw + _i * 8192), 16, 0, 0); } while (0)
#define PG8_STAGE_A(bufoff, v0, v1, kb) do { \
        __builtin_amdgcn_global_load_lds((const unsigned*)(Abase + (kb) + (v0)), (LAS unsigned*)(lds + (bufoff) + ldsw), 16, 0, 0); \
        __builtin_amdgcn_global_load_lds((const unsigned*)(Abase + (kb) + (v1)), (LAS unsigned*)(lds + (bufoff) + ldsw + 8192), 16, 0, 0); } while (0)
#define PG8_LD16(addr) (*(const LAS i32x4_t*)(addr))
#define PG8_LDA(dst, b, h) do { _Pragma("unroll") for (int m = 0; m < 4; ++m) { if constexpr (FP8) dst##8[m] = __builtin_shufflevector(PG8_LD16(lds + PG8_SA(b, h) + aoff + m * 2048), PG8_LD16(lds + PG8_SA(b, h) + aoff + m * 2048 + 1024), 0, 1, 2, 3, 4, 5, 6, 7); \
        else { _Pragma("unroll") for (int k = 0; k < 2; ++k) dst[m][k] = *(const LAS bf16x8*)(lds + PG8_SA(b, h) + aoff + m * 2048 + k * 1024); } } } while (0)
#define PG8_LDB(dst, b, h) do { _Pragma("unroll") for (int n = 0; n < 2; ++n) { if constexpr (FP8) dst##8[n] = __builtin_shufflevector(PG8_LD16(lds + PG8_SB(b, h) + boff + n * 2048), PG8_LD16(lds + PG8_SB(b, h) + boff + n * 2048 + 1024), 0, 1, 2, 3, 4, 5, 6, 7); \
        else { _Pragma("unroll") for (int k = 0; k < 2; ++k) dst[n][k] = *(const LAS bf16x8*)(lds + PG8_SB(b, h) + boff + n * 2048 + k * 1024); } } } while (0)
#define PG8_MMA(ai, bj, At, Bt) do { __builtin_amdgcn_s_setprio(1); _Pragma("unroll") for (int m = 0; m < 4; ++m) _Pragma("unroll") for (int n = 0; n < 2; ++n) { \
        if constexpr (FP8) asm volatile("v_mfma_scale_f32_16x16x128_f8f6f4 %0, %1, %2, %0, %3, %4 op_sel_hi:[0,0,0]" : "+v"(acc[ai][bj][m][n]) : "v"(Bt##8[n]), "v"(At##8[m]), "v"(scb_), "v"(sca_)); \
        else { _Pragma("unroll") for (int k = 0; k < 2; ++k) acc[ai][bj][m][n] = __builtin_amdgcn_mfma_f32_16x16x32_bf16(Bt[n][k], At[m][k], acc[ai][bj][m][n], 0, 0, 0); } } \
        __builtin_amdgcn_s_setprio(0); } while (0)
#define PG8_WAIT_V(n) asm volatile("s_waitcnt vmcnt(" #n ")" ::: "memory")
#define PG8_WAIT_L(n) asm volatile("s_waitcnt lgkmcnt(" #n ")" ::: "memory")
#define PG8_BAR __builtin_amdgcn_s_barrier()
#define PG8_SCHED __builtin_amdgcn_sched_barrier(0)
    Unit cur, nxt; int ui = 0;
    if (!S.next(0, cur)) return;
    f32x4 acc[2][2][4][2];
#pragma unroll
    for (int a = 0; a < 2; ++a)
#pragma unroll
        for (int b = 0; b < 2; ++b)
#pragma unroll
            for (int m = 0; m < 4; ++m)
#pragma unroll
                for (int n = 0; n < 2; ++n) acc[a][b][m][n] = (f32x4){0.f, 0.f, 0.f, 0.f};
    const int sca_ = SCA, scb_ = SCB;
    bf16x8 At[4][2], B0[2][2], B1[2][2]; v8i_t At8[4], B08[2], B18[2];
    unsigned vc[2][2], vn[2][2];
    S.aoff(cur, Rr, Cc, vc);
    const char* cB = cur.b;
    PG8_STAGE_B(PG8_SB(0, 0), cB); PG8_STAGE_A(PG8_SA(0, 0), vc[0][0], vc[0][1], 0); PG8_STAGE_B(PG8_SB(0, 1), cB + hstep); PG8_STAGE_A(PG8_SA(0, 1), vc[1][0], vc[1][1], 0);
    PG8_STAGE_B(PG8_SB(1, 0), cB + kstep); PG8_STAGE_A(PG8_SA(1, 0), vc[0][0], vc[0][1], kstepA); PG8_STAGE_B(PG8_SB(1, 1), cB + hstep + kstep);
    PG8_WAIT_V(6); PG8_BAR;
    if (wr == 1) PG8_BAR;
    for (;;) {
        const bool has_next = S.next(ui + 1, nxt);
        if constexpr (Sched::GATHER_LDS) {
            if (has_next && wid < 4) __builtin_amdgcn_global_load_lds((const unsigned*)(S.list + nxt.e * CAP + nxt.pos0 + otid()), (LAS unsigned*)(lds + LDS_IDX + wid * 256), 4, 0, 0);
        } else if (has_next) S.aoff(nxt, Rr, Cc, vn);
        if (!has_next) {
#pragma unroll
            for (int h = 0; h < 2; ++h)
#pragma unroll
                for (int i = 0; i < 2; ++i) vn[h][i] = vc[h][i]; }
        const char* nB = has_next ? nxt.b : cB;
#pragma unroll 1
        for (int t = 0; t < nt; t += 2) {
            const bool last = (t == nt - 2);
            if constexpr (Sched::GATHER_LDS) { if (last && has_next) {
#pragma unroll
                for (int h = 0; h < 2; ++h)
#pragma unroll
                    for (int i = 0; i < 2; ++i) { const int rr = h * HALF + Rr[i]; const int pair = (nxt.pos0 + rr) < nxt.cnt ? ((const LAS int*)(lds + LDS_IDX))[rr] : 0; vn[h][i] = (unsigned)((pair >> 2) * S.rowb + Cc[i] * 2); } } }
            const size_t k1 = (size_t)(t + 1) * kstepA;
            const size_t k2 = last ? 0 : (size_t)(t + 2) * kstepA;
            const unsigned s00 = last ? vn[0][0] : vc[0][0], s01 = last ? vn[0][1] : vc[0][1], s10 = last ? vn[1][0] : vc[1][0], s11 = last ? vn[1][1] : vc[1][1];
            const char* b2 = last ? nB : cB + (size_t)(t + 2) * kstep; const char* b3 = b2 + kstep;
            PG8_LDB(B0, 0, 0); PG8_LDB(B1, 0, 1); PG8_SCHED; PG8_LDA(At, 0, 0); PG8_STAGE_A(PG8_SA(1, 1), vc[1][0], vc[1][1], k1);
            PG8_WAIT_L(0); PG8_BAR; PG8_MMA(0, 0, At, B0); PG8_MMA(0, 1, At, B1); PG8_BAR; PG8_SCHED;
            PG8_LDA(At, 0, 1); PG8_SCHED; PG8_STAGE_B(PG8_SB(0, 0), b2); PG8_SCHED; PG8_STAGE_A(PG8_SA(0, 0), s00, s01, k2); PG8_SCHED; PG8_STAGE_B(PG8_SB(0, 1), b2 + hstep);
            PG8_WAIT_L(0); PG8_WAIT_V(6); PG8_BAR; PG8_MMA(1, 0, At, B0); PG8_MMA(1, 1, At, B1); PG8_BAR; PG8_SCHED;
            PG8_LDB(B0, 1, 0); PG8_LDB(B1, 1, 1); PG8_SCHED; PG8_LDA(At, 1, 0); PG8_STAGE_A(PG8_SA(0, 1), s10, s11, k2);
            PG8_WAIT_L(0); PG8_BAR; PG8_MMA(0, 0, At, B0); PG8_MMA(0, 1, At, B1); PG8_BAR; PG8_SCHED;
            PG8_LDA(At, 1, 1); PG8_SCHED; PG8_STAGE_B(PG8_SB(1, 0), b3); PG8_SCHED; PG8_STAGE_A(PG8_SA(1, 0), s00, s01, k2 + kstepA); PG8_SCHED; PG8_STAGE_B(PG8_SB(1, 1), b3 + hstep);
            PG8_WAIT_L(0); PG8_WAIT_V(6); PG8_BAR; PG8_MMA(1, 0, At, B0); PG8_MMA(1, 1, At, B1); PG8_BAR; PG8_SCHED;
        }
        if constexpr (FP8) asm volatile("s_nop 15\n\ts_nop 15" ::: "memory");
        E(acc, cur, wr, wc, fr, fq);
        if (!has_next) break;
#pragma unroll
        for (int a = 0; a < 2; ++a)
#pragma unroll
            for (int b = 0; b < 2; ++b)
#pragma unroll
                for (int m = 0; m < 4; ++m)
#pragma unroll
                    for (int n = 0; n < 2; ++n) acc[a][b][m][n] = (f32x4){0.f, 0.f, 0.f, 0.f};
        cur = nxt; cB = nB; ++ui;
#pragma unroll
        for (int h = 0; h < 2; ++h)
#pragma unroll
            for (int i = 0; i < 2; ++i) vc[h][i] = vn[h][i];
    }
    PG8_WAIT_V(0);
    if (wr == 0) PG8_BAR;
    PG8_BAR;
#undef PG8_SA
#undef PG8_SB
#undef PG8_STAGE_A
#undef PG8_STAGE_B
#undef PG8_LDA
#undef PG8_LDB
#undef PG8_MMA
#undef PG8_WAIT_V
#undef PG8_WAIT_L
#undef PG8_BAR
#undef PG8_SCHED
}

typedef f32x4 Acc[2][2][4][2];
__device__ __forceinline__ unsigned dpp_ror8(unsigned x) { return (unsigned)__builtin_amdgcn_update_dpp(0, (int)x, 0x128, 0xf, 0xf, false); }
__device__ __forceinline__ u32x4 ror8_4(const u32x4 v) { u32x4 r; r.x = dpp_ror8(v.x); r.y = dpp_ror8(v.y); r.z = dpp_ror8(v.z); r.w = dpp_ror8(v.w); return r; }
__device__ __forceinline__ void line_xy(const u32x4 a, const u32x4 b, bool lo, u32x4& X, u32x4& Y) { const u32x4 ra = ror8_4(a), rb = ror8_4(b); X = lo ? a : rb; Y = lo ? ra : b; }
__device__ __forceinline__ u32x4 pack8(const f32x4 v0, const f32x4 v1) { u32x4 w; w.x = cvt_pk_bf16(v0[0], v0[1]); w.y = cvt_pk_bf16(v0[2], v0[3]); w.z = cvt_pk_bf16(v1[0], v1[1]); w.w = cvt_pk_bf16(v1[2], v1[3]); return w; }

struct EpiIn { static constexpr bool PERM = true; char* ws;
    __device__ __forceinline__ void operator()(const Acc& acc, const Unit& u, int wr, int wc, int fr, int fq) const {
        const int pn = u.pn; size_t boff; int ld, cb;
        if (pn < 3) { boff = OFF_QA; ld = 384; cb = pn * 128; } else if (pn == 3) { boff = OFF_CKV; ld = 256; cb = 0; }
        else if (pn < 32) { boff = OFF_HQ + (size_t)((pn - 4) >> 2) * SEG_STRIDE; ld = 1024; cb = ((pn - 4) & 3) * 256; }
        else { boff = OFF_KR; ld = 64; cb = 0; }
        bf16_t* base = (bf16_t*)(ws + boff);
        if (pn == 32 && wc != 0) return;
        const bool lo = fr < 8; const int rowb0 = u.pm * BM + wr * 64, rx = fr & 7, colx = cb + wc * 64 + (fr >> 3) * 32 + 8 * fq;
        float* ssq = (float*)(ws + (pn < 3 ? OFF_SSQQ : OFF_SSQKV));
#pragma unroll
        for (int ai = 0; ai < 2; ++ai)
#pragma unroll
            for (int m = 0; m < 4; ++m) { const int rg = rowb0 + ai * HALF + m * 16;
                f32x4 v0 = acc[ai][0][m][0], v1 = acc[ai][0][m][1], w0 = acc[ai][1][m][0], w1 = acc[ai][1][m][1];
                if (pn >= 4 && pn < 8) {
#pragma unroll
                    for (int j = 0; j < 4; ++j) { v0[j] = siluf_(v0[j]) * 0.08838834764831845f; v1[j] = siluf_(v1[j]) * 0.08838834764831845f; w0[j] = siluf_(w0[j]) * 0.08838834764831845f; w1[j] = siluf_(w1[j]) * 0.08838834764831845f; } }
                if (pn < 3 || (pn >= 20 && pn < 32)) { unsigned char* qrow = pn < 3 ? (unsigned char*)base + (size_t)(rg + fr) * 768 + pn * 256 + wc * 64 + 8 * fq : (unsigned char*)base + (size_t)(rg + fr) * 1024 + (pn & 3) * 256 + wc * 64 + 8 * fq;
                    u32x2 a8; a8.x = pack4_fp8(v0[0], v0[1], v0[2], v0[3]); a8.y = pack4_fp8(v1[0], v1[1], v1[2], v1[3]); u32x2 b8; b8.x = pack4_fp8(w0[0], w0[1], w0[2], w0[3]); b8.y = pack4_fp8(w1[0], w1[1], w1[2], w1[3]);
                    *(u32x2*)qrow = a8; *(u32x2*)(qrow + 32) = b8; }
                else { u32x4 X, Y; line_xy(pack8(v0, v1), pack8(w0, w1), lo, X, Y);
                    __builtin_nontemporal_store(X, (u32x4*)(base + (size_t)(rg + rx) * ld + colx)); __builtin_nontemporal_store(Y, (u32x4*)(base + (size_t)(rg + 8 + rx) * ld + colx)); }
                if (pn <= 3) { float ss = (v0[0] * v0[0] + v0[1] * v0[1]) + (v0[2] * v0[2] + v0[3] * v0[3]) + (v1[0] * v1[0] + v1[1] * v1[1]) + (v1[2] * v1[2] + v1[3] * v1[3])
                                        + (w0[0] * w0[0] + w0[1] * w0[1]) + (w0[2] * w0[2] + w0[3] * w0[3]) + (w1[0] * w1[0] + w1[1] * w1[1]) + (w1[2] * w1[2] + w1[3] * w1[3]);
                    ss += __shfl_xor(ss, 16); ss += __shfl_xor(ss, 32); if (fq == 0) atomicAdd(ssq + rg + fr, ss); } }
    } };

struct EpiQ { static constexpr bool PERM = true; bf16_t* q; const float* ssq;
    __device__ __forceinline__ void operator()(const Acc& acc, const Unit& u, int wr, int wc, int fr, int fq) const {
        const bool lo = fr < 8; const int rowb0 = u.pm * BM + wr * 64, rx = fr & 7, colx = u.pn * BM + wc * 64 + (fr >> 3) * 32 + 8 * fq;
#pragma unroll
        for (int ai = 0; ai < 2; ++ai)
#pragma unroll
            for (int m = 0; m < 4; ++m) { const int rg = rowb0 + ai * HALF + m * 16; const float rs = rsqrtf(ssq[rg + fr] * (1.0f / 768.0f) + EPS);
                u32x4 X, Y; line_xy(pack8(acc[ai][0][m][0] * rs, acc[ai][0][m][1] * rs), pack8(acc[ai][1][m][0] * rs, acc[ai][1][m][1] * rs), lo, X, Y);
                *(u32x4*)(q + (size_t)(rg + rx) * 1536 + colx) = X; *(u32x4*)(q + (size_t)(rg + 8 + rx) * 1536 + colx) = Y; }
    } };

struct EpiKV { static constexpr bool PERM = true; bf16_t *Kb, *Vb; const float* ssq;
    __device__ __forceinline__ size_t kvrow(int row, int h) const { int b, pos; if (row < L) { b = row >> 11; pos = row & 2047; } else { b = (row - L) >> 8; pos = SEQ + ((row - L) & 255); } return (size_t)(b * 8 + h) * NKEY + pos; }
    __device__ __forceinline__ void operator()(const Acc& acc, const Unit& u, int wr, int wc, int fr, int fq) const {
        const bool lo = fr < 8; const int rowb0 = u.pm * BM + wr * 64, rx = fr & 7, colx = (wc & 1) * 64 + (fr >> 3) * 32 + 8 * fq;
        bf16_t* dst = wc < 2 ? Kb : Vb; const int ld = wc < 2 ? 192 : 128;
#pragma unroll
        for (int ai = 0; ai < 2; ++ai)
#pragma unroll
            for (int m = 0; m < 4; ++m) { const int rg = rowb0 + ai * HALF + m * 16; const float rs = rsqrtf(ssq[rg + fr] * (1.0f / 256.0f) + EPS);
                u32x4 X, Y; line_xy(pack8(acc[ai][0][m][0] * rs, acc[ai][0][m][1] * rs), pack8(acc[ai][1][m][0] * rs, acc[ai][1][m][1] * rs), lo, X, Y);
                *(u32x4*)(dst + kvrow(rg + rx, u.pn) * ld + colx) = X; *(u32x4*)(dst + kvrow(rg + 8 + rx, u.pn) * ld + colx) = Y; }
    } };

struct EpiOut { static constexpr bool PERM = true; bf16_t* x1; const float* x; const float* modv;
    __device__ __forceinline__ void operator()(const Acc& acc, const Unit& u, int wr, int wc, int fr, int fq) const {
        const bool lo = fr < 8; const int rowb0 = u.pm * BM + wr * 64, rx = fr & 7, colx = u.pn * BM + wc * 64 + (fr >> 3) * 32 + 8 * fq, cown = u.pn * BM + wc * 64 + 8 * fq;
#pragma unroll
        for (int ai = 0; ai < 2; ++ai)
#pragma unroll
            for (int m = 0; m < 4; ++m) { const int rg = rowb0 + ai * HALF + m * 16, row = rg + fr; const float* gate = modv + (row >> 11) * 6144 + 2 * 1024 + cown; const float* xr = x + (size_t)row * D + cown;
                f32x4 r[2][2];
#pragma unroll
                for (int bj = 0; bj < 2; ++bj)
#pragma unroll
                    for (int n = 0; n < 2; ++n) r[bj][n] = *(const f32x4*)(xr + bj * 32 + 4 * n) + *(const f32x4*)(gate + bj * 32 + 4 * n) * acc[ai][bj][m][n];
                u32x4 X, Y; line_xy(pack8(r[0][0], r[0][1]), pack8(r[1][0], r[1][1]), lo, X, Y);
                *(u32x4*)(x1 + (size_t)(rg + rx) * D + colx) = X; *(u32x4*)(x1 + (size_t)(rg + 8 + rx) * D + colx) = Y; }
    } };

struct EpiMoe1 { static constexpr bool PERM = true; unsigned char* act; const float* bgu;
    __device__ __forceinline__ void operator()(const Acc& acc, const Unit& u, int wr, int wc, int fr, int fq) const {
        const int o0 = u.pn * 128 + wc * 16 + 4 * fq;
        f32x4 bg[2], bl[2];
#pragma unroll
        for (int bj = 0; bj < 2; ++bj) { const float* bp = bgu + u.e * 2048 + 2 * (o0 + bj * 64); const f32x4 t0 = *(const f32x4*)bp, t1 = *(const f32x4*)(bp + 4);
            bg[bj] = (f32x4){t0[0], t0[2], t1[0], t1[2]}; bl[bj] = (f32x4){t0[1], t0[3], t1[1], t1[3]}; }
        unsigned char* blk = act + ((size_t)u.pm * 8 + u.pn) * 32768 + (size_t)(wr * 4 + wc) * 1024 + (size_t)(fq * 16 + fr) * 16;
#pragma unroll
        for (int ai = 0; ai < 2; ++ai)
#pragma unroll
            for (int bj = 0; bj < 2; ++bj) { unsigned d[4];
#pragma unroll
                for (int m = 0; m < 4; ++m) { const f32x4 g4 = acc[ai][bj][m][0] + bg[bj], l4 = acc[ai][bj][m][1] + bl[bj]; f32x2 r[2];
#pragma unroll
                    for (int j = 0; j < 2; ++j) {
                        const f32x2 glu = {fminf(g4[2 * j], 7.0f), fminf(g4[2 * j + 1], 7.0f)}, lin = {__builtin_amdgcn_fmed3f(l4[2 * j], -7.0f, 7.0f), __builtin_amdgcn_fmed3f(l4[2 * j + 1], -7.0f, 7.0f)};
                        const f32x2 t = glu * -2.4554669595930157f; const f32x2 den = (f32x2){__builtin_amdgcn_exp2f(t[0]), __builtin_amdgcn_exp2f(t[1])} + 1.0f;
                        const f32x2 rc = {__builtin_amdgcn_rcpf(den[0]), __builtin_amdgcn_rcpf(den[1])}; r[j] = glu * rc * (lin * 4.0f + 4.0f); }
                    unsigned w = 0; w = __builtin_amdgcn_cvt_pk_fp8_f32(r[0][0], r[0][1], w, false); w = __builtin_amdgcn_cvt_pk_fp8_f32(r[1][0], r[1][1], w, true); d[m] = w; }
                const auto s01 = __builtin_amdgcn_permlane16_swap(d[0], d[1], false, false); const auto s23 = __builtin_amdgcn_permlane16_swap(d[2], d[3], false, false);
                const auto t02 = __builtin_amdgcn_permlane32_swap(s01[0], s23[0], false, false); const auto t13 = __builtin_amdgcn_permlane32_swap(s01[1], s23[1], false, false);
                *(u32x4*)(blk + (size_t)(ai * 2 + bj) * 8192) = (u32x4){t02[0], t13[0], t02[1], t13[1]}; }
    } };

struct EpiMoe2 { static constexpr bool PERM = true; bf16_t* yp; const float* bd;
    __device__ __forceinline__ void operator()(const Acc& acc, const Unit& u, int wr, int wc, int fr, int fq) const {
        const bool lo = fr < 8; const int rowb0 = u.pm * BM + wr * 64, rx = fr & 7, colx = u.pn * BM + wc * 64 + (fr >> 3) * 32 + 8 * fq, cown = u.pn * BM + wc * 64 + 8 * fq;
        f32x4 bv[2][2];
#pragma unroll
        for (int bj = 0; bj < 2; ++bj)
#pragma unroll
            for (int n = 0; n < 2; ++n) bv[bj][n] = *(const f32x4*)(bd + u.e * 1024 + cown + bj * 32 + 4 * n);
#pragma unroll
        for (int ai = 0; ai < 2; ++ai)
#pragma unroll
            for (int m = 0; m < 4; ++m) { const int rg = rowb0 + ai * HALF + m * 16;
                u32x4 X, Y; line_xy(pack8(acc[ai][0][m][0] + bv[0][0], acc[ai][0][m][1] + bv[0][1]), pack8(acc[ai][1][m][0] + bv[1][0], acc[ai][1][m][1] + bv[1][1]), lo, X, Y);
                __builtin_nontemporal_store(X, (u32x4*)(yp + (size_t)(rg + rx) * D + colx)); __builtin_nontemporal_store(Y, (u32x4*)(yp + (size_t)(rg + 8 + rx) * D + colx)); }
    } };
}

__device__ __forceinline__ int conv_src_col(int kind, int c) {
    if (kind == 0) return c;
    if (kind == 1) { if (c < 1024) return c; if (c < 8192) return c + 64; if (c < 8256) return c - 8192 + 1024; return -1; }
    const int pn = c >> 8, p = c & 255, wc = p >> 6, bj = (p >> 5) & 1, fq = (p >> 3) & 3, n = (p >> 2) & 1, i = p & 3; const int o = 128 * pn + 64 * bj + 16 * wc + 4 * fq + i; return 2 * o + n;
}
__device__ __forceinline__ void lds_sync() { asm volatile("s_waitcnt lgkmcnt(0)\n\ts_barrier" ::: "memory"); }
template <bool F8> struct ConvPipe {
    float v[32]; bool have; bf16_t* dummy;
    int K, kind, k0, c0; void* Wt;
    __device__ __forceinline__ void issue(const float* __restrict__ W, int ldw, void* Wt_, int K_, int kind_, const float* __restrict__ kscale, int k0_, int c0_) {
        const int tid = otid(); const int cc = tid & 127, kq = tid >> 7, sc = conv_src_col(kind_, c0_ + cc);
        const int scc = sc < 0 ? 0 : sc; const float* wp = W + (size_t)(k0_ + kq) * ldw + scc;
#pragma unroll
        for (int i = 0; i < 32; ++i) v[i] = __builtin_nontemporal_load(wp + (size_t)(4 * i) * ldw);
        if (sc < 0) {
#pragma unroll
            for (int i = 0; i < 32; ++i) v[i] = 0.f; }
        if (kscale) {
#pragma unroll
            for (int i = 0; i < 32; ++i) v[i] *= kscale[k0_ + kq + 4 * i]; }
        K = K_; kind = kind_; k0 = k0_; c0 = c0_; Wt = Wt_; have = true;
    }
    __device__ __forceinline__ void flush(LAS float* tl) {
        if (!have) return; have = false;
        const int tid = otid(); const int cc = tid & 127, kq = tid >> 7;
        __syncthreads();
#pragma unroll
        for (int i = 0; i < 32; ++i) tl[(kq + 4 * i) * 129 + cc] = v[i];
        __syncthreads();
        stash(tl, tid);
    }
    __device__ __forceinline__ void to_lds(LAS float* tl) { const int tid = otid(); const int cc = tid & 127, kq = tid >> 7; lds_sync();
#pragma unroll
        for (int i = 0; i < 32; ++i) tl[(kq + 4 * i) * 129 + cc] = v[i];
        lds_sync(); }
    __device__ __forceinline__ void stash(LAS float* tl, int tid) const {
        if constexpr (F8) {
#pragma unroll
            for (int pss = 0; pss < 2; ++pss) { const int item = tid + 512 * pss, c2 = item >> 3, ch = item & 7; float t[16];
#pragma unroll
                for (int j = 0; j < 16; ++j) t[j] = tl[(16 * ch + j) * 129 + c2] * 32.f;
                u32x4 w; w.x = pack4_fp8(t[0], t[1], t[2], t[3]); w.y = pack4_fp8(t[4], t[5], t[6], t[7]); w.z = pack4_fp8(t[8], t[9], t[10], t[11]); w.w = pack4_fp8(t[12], t[13], t[14], t[15]);
                *(u32x4*)((unsigned char*)Wt + (size_t)(c0 + c2) * K + k0 + 16 * ch) = w; }
        } else {
#pragma unroll
            for (int pss = 0; pss < 4; ++pss) { const int item = tid + 512 * pss, c2 = item >> 4, ch = item & 15; float t[8];
#pragma unroll
                for (int j = 0; j < 8; ++j) t[j] = tl[(8 * ch + j) * 129 + c2];
                u32x4 w; w.x = cvt_pk_bf16(t[0], t[1]); w.y = cvt_pk_bf16(t[2], t[3]); w.z = cvt_pk_bf16(t[4], t[5]); w.w = cvt_pk_bf16(t[6], t[7]);
                *(u32x4*)((bf16_t*)Wt + (size_t)(c0 + c2) * K + k0 + 8 * ch) = w; }
        }
    }
};
template <bool F8>
__device__ __forceinline__ void conv_matrix(LAS float* tl, ConvPipe<F8>& pipe, const float* W, int ldw, void* Wt, int K, int Nout, int kind, const float* kscale, int& tctr) {
    const int nk = K / 128, ntile = nk * (Nout / 128);
    int t = ((int)blockIdx.x - tctr) % (int)gridDim.x; if (t < 0) t += gridDim.x;
    for (; t < ntile; t += gridDim.x) {
        if (pipe.have) { pipe.to_lds(tl); const int K0 = pipe.K, k00 = pipe.k0, c00 = pipe.c0; void* W0 = pipe.Wt; ConvPipe<F8> done = pipe; (void)K0; (void)k00; (void)c00; (void)W0;
            pipe.issue(W, ldw, Wt, K, kind, kscale, (t % nk) * 128, (t / nk) * 128); done.stash(tl, otid()); }
        else pipe.issue(W, ldw, Wt, K, kind, kscale, (t % nk) * 128, (t / nk) * 128);
    }
    tctr = (tctr + ntile) % (int)gridDim.x;
}
template <bool F8> __device__ __forceinline__ void conv_finish(LAS float* tl, ConvPipe<F8>& pipe) { if (pipe.have) { pipe.to_lds(tl); pipe.stash(tl, otid()); pipe.have = false; } __syncthreads(); }

__device__ __forceinline__ float half_sum256(float v, LAS float* red) {
    for (int o = 32; o > 0; o >>= 1) v += __shfl_xor(v, o);
    const int w = otid() >> 6, hb = (otid() >> 8) * 4; if ((otid() & 63) == 0) red[w] = v; __syncthreads();
    const float t = red[hb] + red[hb + 1] + red[hb + 2] + red[hb + 3]; __syncthreads(); return t;
}

__device__ __forceinline__ void phase0(const Params& p, LAS unsigned char* lds) {
    char* ws = p.ws; const int tid = otid(), gsz = gridDim.x * 512, gid = blockIdx.x * 512 + tid;
    float* lb = (float*)(ws + OFF_LB); int* cnt = (int*)(ws + OFF_CNT); float* ssqq = (float*)(ws + OFF_SSQQ); float* ssqkv = (float*)(ws + OFF_SSQKV); float* modv = (float*)(ws + OFF_MOD);
    for (int i = gid; i < 2048; i += gsz) { const int d = i >> 10, j = i & 1023; const float a = p.lbl[(d * 2 + 0) * 1024 + j], b = p.lbl[(d * 2 + 1) * 1024 + j]; lb[i] = 1.0f / (1.0f + __expf(b - a)); }
    for (int i = gid; i < 32; i += gsz) cnt[i] = 0;
    { float* ropet = (float*)(ws + OFF_ROPE); for (int i = gid; i < SEQ * 32; i += gsz) { const int t = i >> 5, j = i & 31; float cs, sn; rope_cs(t, j, cs, sn); ropet[t * 64 + j] = cs; ropet[t * 64 + 32 + j] = sn; } }
    for (int i = gid; i < L; i += gsz) ssqq[i] = 0.f;
    for (int i = gid; i < R; i += gsz) ssqkv[i] = 0.f;
    { LAS float* sil = (LAS float*)lds;
      LAS float* part = (LAS float*)(lds + 17 * 1024 * 4);
      bool loaded = false;
      for (int item = blockIdx.x; item < 192; item += gridDim.x) {
          if (!loaded) { for (int i = tid; i < 17 * 1024; i += 512) { const int r = i >> 10, k = i & 1023; sil[i] = siluf_(r < 16 ? p.c[r * 1024 + k] : p.cctx[k]); } loaded = true; __syncthreads(); }
          const int j = tid & 31, ks = tid >> 5; float a[17];
#pragma unroll
          for (int r = 0; r < 17; ++r) a[r] = 0.f;
#pragma unroll 4
          for (int k = ks * 64; k < ks * 64 + 64; ++k) { const float w = p.w_mod[(size_t)k * 6144 + item * 32 + j];
#pragma unroll
              for (int r = 0; r < 17; ++r) a[r] += sil[r * 1024 + k] * w; }
#pragma unroll
          for (int r = 0; r < 17; ++r) part[(ks * 17 + r) * 32 + j] = a[r];
          __syncthreads();
          for (int i = tid; i < 17 * 32; i += 512) { const int r = i >> 5, jj = i & 31; float s = p.b_mod[item * 32 + jj]; for (int q = 0; q < 16; ++q) s += part[(q * 17 + r) * 32 + jj]; modv[r * 6144 + item * 32 + jj] = s; }
          __syncthreads();
      } }
    __syncthreads();
    { LAS float* tl = (LAS float*)lds; int tctr = 0;
      { ConvPipe<true> pp; pp.have = false; conv_matrix<true>(tl, pp, p.w_in, 8256, (unsigned char*)(ws + OFF_WT_IN), 1024, 8448, 1, nullptr, tctr); conv_finish<true>(tl, pp); }
      { ConvPipe<true> pp; pp.have = false;
        conv_matrix<true>(tl, pp, p.w_qb, 1536, (unsigned char*)(ws + OFF_WT_QB), 768, 1536, 0, p.g_q, tctr);
        conv_matrix<true>(tl, pp, p.w_out, 1024, (unsigned char*)(ws + OFF_WT_OUT), 1024, 1024, 0, nullptr, tctr); conv_finish<true>(tl, pp); }
      { ConvPipe<false> pp; pp.have = false;
        conv_matrix<false>(tl, pp, p.w_kvb, 2048, (bf16_t*)(ws + OFF_WT_KVB), 256, 2048, 0, p.g_kv, tctr); conv_finish<false>(tl, pp); } }
}

__device__ __forceinline__ float wave_sum(float v) {
#pragma unroll
    for (int o = 32; o > 0; o >>= 1) v += __shfl_xor(v, o);
    return v; }
__device__ __forceinline__ void phase1(const Params& p, LAS unsigned char* lds) {
    const float* modv = (const float*)(p.ws + OFF_MOD); unsigned char* h = (unsigned char*)(p.ws + OFF_H);
    const int tid = otid(), lane = tid & 63, gw = blockIdx.x * 8 + (tid >> 6), nw = gridDim.x * 8, c0 = lane * 8;
    f32x4 g[4];
#pragma unroll
    for (int q = 0; q < 4; ++q) g[q] = *(const f32x4*)(p.g_mix + (q >> 1) * 512 + c0 + (q & 1) * 4);
    for (int row0 = gw; row0 < R; row0 += 4 * nw) {
        f32x4 v[4][4];
#pragma unroll
        for (int u = 0; u < 4; ++u) { const int row = row0 + u * nw < R ? row0 + u * nw : row0; const float* src = row < L ? p.x + (size_t)row * D : p.ctx + (size_t)(row - L) * D;
#pragma unroll
            for (int q = 0; q < 4; ++q) v[u][q] = __builtin_nontemporal_load((const f32x4*)(src + (q >> 1) * 512 + c0 + (q & 1) * 4)); }
#pragma unroll
        for (int u = 0; u < 4; ++u) { if (row0 + u * nw >= R) break; const int row = row0 + u * nw; const float* mod = modv + (row < L ? row / SEQ : 16) * 6144;
            float ss = 0.f;
#pragma unroll
            for (int q = 0; q < 4; ++q) ss += (v[u][q][0] * v[u][q][0] + v[u][q][1] * v[u][q][1]) + (v[u][q][2] * v[u][q][2] + v[u][q][3] * v[u][q][3]);
            const float rs = rsqrtf(wave_sum(ss) * (1.0f / D) + EPS);
#pragma unroll
            for (int j = 0; j < 2; ++j) { f32x4 o[2];
#pragma unroll
                for (int e = 0; e < 2; ++e) { const int cc = j * 512 + c0 + e * 4; const f32x4 sc = *(const f32x4*)(mod + 1024 + cc), sh = *(const f32x4*)(mod + cc); o[e] = v[u][j * 2 + e] * rs * g[j * 2 + e] * (sc + 1.0f) + sh; }
                u32x2 w; w.x = pack4_fp8(o[0][0], o[0][1], o[0][2], o[0][3]); w.y = pack4_fp8(o[1][0], o[1][1], o[1][2], o[1][3]);
                *(u32x2*)(h + (size_t)row * D + j * 512 + c0) = w; } }
    }
}


__device__ __forceinline__ void phase2(const Params& p, LAS unsigned char* lds) {
    pg8::InSched S; S.init2(p.ws + OFF_WT_IN, gridDim.x, blockIdx.x);
    pg8::EpiIn E{p.ws};
    pg8::gemm_phase<pg8::EpiIn, pg8::InSched, true, 127, 122>(lds, (const char*)(p.ws + OFF_H), 1024, S, E);
}
__device__ __forceinline__ void phase3(const Params& p, LAS unsigned char* lds) {
    char* ws = p.ws;
    { pg8::DenseSched S; S.init(L, 1536, 768, 768, ws + OFF_WT_QB, gridDim.x, blockIdx.x); pg8::EpiQ E{(bf16_t*)(ws + OFF_Q), (const float*)(ws + OFF_SSQQ)}; pg8::gemm_phase<pg8::EpiQ, pg8::DenseSched, true, 127, 122>(lds, (const char*)(ws + OFF_QA), 768, S, E); }
    { pg8::DenseSched S; S.init(R, 2048, 256 * 2, 256 * 2, ws + OFF_WT_KVB, gridDim.x, blockIdx.x); pg8::EpiKV E{(bf16_t*)(ws + OFF_K), (bf16_t*)(ws + OFF_V), (const float*)(ws + OFF_SSQKV)}; pg8::gemm_phase(lds, (const char*)(ws + OFF_CKV), 256, S, E); }
    { const bf16_t* kr = (const bf16_t*)(ws + OFF_KR); bf16_t* Kb = (bf16_t*)(ws + OFF_K); const float* ropet = (const float*)(ws + OFF_ROPE);
      for (int gid = blockIdx.x * 512 + otid(); gid < R * 32; gid += gridDim.x * 512) { const int row = gid >> 5, i = gid & 31;
          const float x1 = bf2f(kr[(size_t)row * 64 + i]), x2 = bf2f(kr[(size_t)row * 64 + 32 + i]); float o1 = x1, o2 = x2; int b, pos;
          if (row < L) { b = row / SEQ; pos = row % SEQ; const float cs = ropet[pos * 64 + i], sn = ropet[pos * 64 + 32 + i]; o1 = x1 * cs - x2 * sn; o2 = x1 * sn + x2 * cs; } else { b = (row - L) / CTXL; pos = SEQ + (row - L) % CTXL; }
          const bf16_t w1 = f2bf(o1), w2 = f2bf(o2);
          for (int h = 0; h < 8; ++h) { bf16_t* q = Kb + ((size_t)(b * 8 + h) * NKEY + pos) * 192 + 128; q[i] = w1; q[32 + i] = w2; } } }
}
__device__ __forceinline__ void unpack8_fp8(const u32x2 w, float (&o)[8]) {
    o[0] = __builtin_amdgcn_cvt_f32_fp8((int)w.x, 0); o[1] = __builtin_amdgcn_cvt_f32_fp8((int)w.x, 1); o[2] = __builtin_amdgcn_cvt_f32_fp8((int)w.x, 2); o[3] = __builtin_amdgcn_cvt_f32_fp8((int)w.x, 3);
    o[4] = __builtin_amdgcn_cvt_f32_fp8((int)w.y, 0); o[5] = __builtin_amdgcn_cvt_f32_fp8((int)w.y, 1); o[6] = __builtin_amdgcn_cvt_f32_fp8((int)w.y, 2); o[7] = __builtin_amdgcn_cvt_f32_fp8((int)w.y, 3); }
__device__ __forceinline__ void unpack8(const u32x4 w, float (&o)[8]) {
    o[0] = __uint_as_float(w.x << 16); o[1] = __uint_as_float(w.x & 0xffff0000u); o[2] = __uint_as_float(w.y << 16); o[3] = __uint_as_float(w.y & 0xffff0000u);
    o[4] = __uint_as_float(w.z << 16); o[5] = __uint_as_float(w.z & 0xffff0000u); o[6] = __uint_as_float(w.w << 16); o[7] = __uint_as_float(w.w & 0xffff0000u); }
__device__ __forceinline__ void phase4(const Params& p, LAS unsigned char*) {
    char* ws = p.ws; bf16_t* y = (bf16_t*)(ws + OFF_H); const bf16_t* of = (const bf16_t*)(ws + OFF_OF); const bf16_t* ob = (const bf16_t*)(ws + OFF_OB);
    const unsigned char* og = (const unsigned char*)(ws + OFF_OG); const unsigned char* gm = (const unsigned char*)(ws + OFF_GM); const unsigned char* gh = (const unsigned char*)(ws + OFF_GH);
    const int tid = otid(), lane = tid & 63, gw = blockIdx.x * 8 + (tid >> 6), nw = gridDim.x * 8, c0 = lane * 8;
    float gg[8];
#pragma unroll
    for (int i = 0; i < 8; ++i) gg[i] = p.g_hg[(c0 + i) & 127];
    for (int row0 = gw; row0 < L; row0 += 2 * nw) {
        u32x4 ra[2][2], rb[2][2], rm[2][2]; u32x2 r1[2][2], r2[2][2], r3[2][2];
#pragma unroll
        for (int u = 0; u < 2; ++u) { const int row = row0 + u * nw < L ? row0 + u * nw : row0;
#pragma unroll
        for (int j = 0; j < 2; ++j) { const size_t off = (size_t)row * D + j * 512 + c0; ra[u][j] = __builtin_nontemporal_load((const u32x4*)(of + off)); rb[u][j] = __builtin_nontemporal_load((const u32x4*)(ob + off)); r1[u][j] = __builtin_nontemporal_load((const u32x2*)(og + off)); r2[u][j] = __builtin_nontemporal_load((const u32x2*)(gm + off)); r3[u][j] = __builtin_nontemporal_load((const u32x2*)(gh + off)); rm[u][j] = __builtin_nontemporal_load((const u32x4*)(y + off)); } }
#pragma unroll
        for (int u = 0; u < 2; ++u) { const int row = row0 + u * nw; if (row >= L) break;
#pragma unroll
        for (int j = 0; j < 2; ++j) { float a[8], b[8], g1[8], g2[8], g3[8], ym[8], o[8]; unpack8(ra[u][j], a); unpack8(rb[u][j], b); unpack8_fp8(r1[u][j], g1); unpack8_fp8(r2[u][j], g2); unpack8_fp8(r3[u][j], g3); unpack8(rm[u][j], ym);
            float ss = 0.f;
#pragma unroll
            for (int i = 0; i < 8; ++i) { o[i] = a[i] + b[i]; ss += o[i] * o[i]; }
            ss += __shfl_xor(ss, 1); ss += __shfl_xor(ss, 2); ss += __shfl_xor(ss, 4); ss += __shfl_xor(ss, 8);
            const float rs = rsqrtf(ss * (1.0f / 128.0f) + EPS); float r[8];
#pragma unroll
            for (int i = 0; i < 8; ++i) { const float yh = o[i] * rs * gg[i] * siluf_(g1[i]); r[i] = sigmoidf_(g2[i]) * ym[i] + sigmoidf_(g3[i]) * yh; }
            u32x2 w; w.x = pack4_fp8(r[0], r[1], r[2], r[3]); w.y = pack4_fp8(r[4], r[5], r[6], r[7]);
            *(u32x2*)((unsigned char*)(ws + OFF_YF8) + (size_t)row * D + j * 512 + c0) = w; } }
    }
}

#define MC_TIE16(v, o) asm volatile("" : "+v"(v[o+0]), "+v"(v[o+1]), "+v"(v[o+2]), "+v"(v[o+3]), "+v"(v[o+4]), "+v"(v[o+5]), "+v"(v[o+6]), "+v"(v[o+7]), "+v"(v[o+8]), "+v"(v[o+9]), "+v"(v[o+10]), "+v"(v[o+11]), "+v"(v[o+12]), "+v"(v[o+13]), "+v"(v[o+14]), "+v"(v[o+15]))
__device__ __forceinline__ void mc_issue(const Params& p, int idx, float (&v)[32]) {
    const int tid = otid(); const int cc = tid & 127, kq = tid >> 7; const float* base; unsigned voff, vstep;
    if (idx < 4096) { const int e = idx >> 7, r = idx & 127; base = p.w_gu + (size_t)e * 1024 * 2048; voff = (unsigned)(((r & 7) * 128 + kq) * 2048 + conv_src_col(2, (r >> 3) * 128 + cc)) * 4u; vstep = 4u * 2048u * 4u; }
    else { const int j = idx - 4096, e = j >> 6, r = j & 63; base = p.w_dn + (size_t)e * 1024 * 1024; voff = (unsigned)(((r & 7) * 128 + kq) * 1024 + (r >> 3) * 128 + cc) * 4u; vstep = 4u * 1024u * 4u; }
#pragma unroll
    for (int i = 0; i < 32; ++i) { asm volatile("global_load_dword %0, %1, %2 nt" : "=v"(v[i]) : "v"(voff), "s"(base) : "memory"); voff += vstep; }
}
__device__ __forceinline__ void mc_stash(const Params& p, int idx, const LAS float* tl) {
    unsigned char* dst;
    if (idx < 4096) { const int e = idx >> 7, r = idx & 127; dst = (unsigned char*)(p.ws + OFF_WT_GU) + (size_t)e * 2048 * 1024 + (size_t)((r >> 3) * 128) * 1024 + (r & 7) * 128; }
    else { const int j = idx - 4096, e = j >> 6, r = j & 63; dst = (unsigned char*)(p.ws + OFF_WT_DN) + (size_t)e * 1024 * 1024 + (size_t)((r >> 3) * 128) * 1024 + (r & 7) * 128; }
    const int tid = otid();
#pragma unroll
    for (int pss = 0; pss < 2; ++pss) { const int item = tid + 512 * pss, c2 = item >> 3, ch = item & 7; float t[16];
#pragma unroll
        for (int j = 0; j < 16; ++j) t[j] = tl[(16 * ch + j) * 129 + c2] * 32.f;
        u32x4 w; w.x = pack4_fp8(t[0], t[1], t[2], t[3]); w.y = pack4_fp8(t[4], t[5], t[6], t[7]); w.z = pack4_fp8(t[8], t[9], t[10], t[11]); w.w = pack4_fp8(t[12], t[13], t[14], t[15]);
        *(u32x4*)(dst + (size_t)c2 * 1024 + 16 * ch) = w; }
}
__device__ __forceinline__ void mc_step(const Params& p, float (&v)[32], LAS float* tl, int i, int n, int stride, int wmode) {
    const int tid = otid(); const int cc = tid & 127, kq = tid >> 7; const int idx = (int)blockIdx.x + i * stride;
    if (wmode == 3) asm volatile("s_waitcnt vmcnt(36)" ::: "memory"); else if (wmode == 2) asm volatile("s_waitcnt vmcnt(34)" ::: "memory"); else if (wmode == 1) asm volatile("s_waitcnt vmcnt(32)" ::: "memory"); else asm volatile("s_waitcnt vmcnt(0)" ::: "memory");
    MC_TIE16(v, 0); MC_TIE16(v, 16);
#pragma unroll
    for (int q = 0; q < 32; ++q) tl[(kq + 4 * q) * 129 + cc] = v[q];
    lds_sync();
    if (i + 2 < n) mc_issue(p, idx + 2 * stride, v);
    mc_stash(p, idx, tl);
}
__device__ __forceinline__ void moe_conv(const Params& p, LAS unsigned char* lds) {
    LAS float* t0 = (LAS float*)lds; LAS float* t1 = t0 + 128 * 129;
    const int stride = gridDim.x, n = (6144 - (int)blockIdx.x + stride - 1) / stride;
    float va[32], vb[32];
#pragma unroll
    for (int q = 0; q < 32; ++q) { va[q] = 0.f; vb[q] = 0.f; }
    lds_sync();
    if (n >= 4) {
        mc_issue(p, (int)blockIdx.x, va); mc_issue(p, (int)blockIdx.x + stride, vb);
        mc_step(p, va, t0, 0, n, stride, 1); mc_step(p, vb, t1, 1, n, stride, 2);
#pragma unroll 1
        for (int i = 2; i < n; i += 2) { mc_step(p, va, t0, i, n, stride, i == n - 1 ? 0 : 3); if (i + 1 < n) mc_step(p, vb, t1, i + 1, n, stride, i + 1 == n - 1 ? 0 : 3); }
    } else {
        for (int i = 0; i < n; ++i) { mc_issue(p, (int)blockIdx.x + i * stride, va); mc_step(p, va, t0, i, 0, stride, 0); lds_sync(); }
    }
    __syncthreads();
}
__device__ __forceinline__ void phase5(const Params& p, LAS unsigned char* lds) {
    char* ws = p.ws;
    { pg8::DenseSched S; S.init(L, 1024, 1024, 1024, ws + OFF_WT_OUT, gridDim.x, blockIdx.x); pg8::EpiOut E{(bf16_t*)(ws + OFF_X1), p.x, (const float*)(ws + OFF_MOD)}; pg8::gemm_phase<pg8::EpiOut, pg8::DenseSched, true, 127, 122>(lds, (const char*)(ws + OFF_YF8), 1024, S, E); }
    moe_conv(p, lds);
}
__device__ __forceinline__ void phase6(const Params& p, LAS unsigned char* lds) {
    char* ws = p.ws; const float* modv = (const float*)(ws + OFF_MOD); unsigned char* h2 = (unsigned char*)(ws + OFF_H); int* topi = (int*)(ws + OFF_TOPI); float* topp = (float*)(ws + OFF_TOPP); int* cnt = (int*)(ws + OFF_CNT); int* list = (int*)(ws + OFF_LIST); int* pairpos = (int*)(ws + OFF_ROWPAIR);
    constexpr int HS_LD = 1028, HS_BYTES = 32 * HS_LD * 4;
    LAS float* hs = (LAS float*)lds;
    LAS float* lg = (LAS float*)(lds + HS_BYTES);
    LAS int* lcnt = (LAS int*)(lds + HS_BYTES + 4096);
    LAS int* lent = (LAS int*)(lds + HS_BYTES + 4096 + 512);
    LAS int* lbase = (LAS int*)(lds + HS_BYTES + 4096 + 512 + 8192);
    LAS int* lrun = (LAS int*)(lds + HS_BYTES + 4096 + 512 + 8192 + 2048);
    LAS float* lselv = (LAS float*)(lds + HS_BYTES + 4096 + 512 + 8192 + 4096); LAS int* lseli = (LAS int*)(lds + HS_BYTES + 4096 + 512 + 8192 + 4096 + 512);
    const int tid = otid(), lane = tid & 63, wid = tid >> 6, c0 = lane * 8;
    if (tid < 32) lcnt[tid] = 0;
    lrun[tid] = 0;
    int pending = 0;
    f32x4 g[4];
#pragma unroll
    for (int q = 0; q < 4; ++q) g[q] = *(const f32x4*)(p.g_ffn + (q >> 1) * 512 + c0 + (q & 1) * 4);
    float wB[64];
#pragma unroll
    for (int s = 0; s < 32; ++s) { const int k0 = 128 * wid + 4 * s + 2 * (lane >> 5); wB[2 * s] = p.w_r[k0 * 32 + (lane & 31)]; wB[2 * s + 1] = p.w_r[(k0 + 1) * 32 + (lane & 31)]; }
    __syncthreads();
    u32x4 xr[4][2]; f32x4 scr[4], shr[4];
    auto loadtile = [&](int tile) { const int rbase = min(tile, L / 32 - 1) * 32; const float* mod = modv + (rbase / SEQ) * 6144;
#pragma unroll
        for (int u = 0; u < 4; ++u)
#pragma unroll
            for (int j = 0; j < 2; ++j) xr[u][j] = *(const u32x4*)((const bf16_t*)(ws + OFF_X1) + (size_t)(rbase + wid * 4 + u) * D + j * 512 + c0);
#pragma unroll
        for (int q = 0; q < 4; ++q) { const int cc = (q >> 1) * 512 + c0 + (q & 1) * 4; scr[q] = *(const f32x4*)(mod + 4 * 1024 + cc); shr[q] = *(const f32x4*)(mod + 3 * 1024 + cc); } };
    loadtile(blockIdx.x);
    int it = 0;
    for (int tile = blockIdx.x; tile < L / 32; tile += gridDim.x, ++it) {
        const int rbase = tile * 32;
        f32x4 gs[4];
#pragma unroll
        for (int q = 0; q < 4; ++q) gs[q] = g[q] * (scr[q] + 1.0f);
#pragma unroll
        for (int u = 0; u < 4; ++u) { const int rl = wid * 4 + u, row = rbase + rl; f32x4 v[4]; float ss = 0.f;
#pragma unroll
            for (int j = 0; j < 2; ++j) { float t8[8]; unpack8(xr[u][j], t8); v[2 * j] = (f32x4){t8[0], t8[1], t8[2], t8[3]}; v[2 * j + 1] = (f32x4){t8[4], t8[5], t8[6], t8[7]}; }
#pragma unroll
            for (int q = 0; q < 4; ++q) ss += (v[q][0] * v[q][0] + v[q][1] * v[q][1]) + (v[q][2] * v[q][2] + v[q][3] * v[q][3]);
            const float rs = rsqrtf(wave_sum(ss) * (1.0f / D) + EPS);
#pragma unroll
            for (int j = 0; j < 2; ++j) { f32x4 o[2];
#pragma unroll
                for (int e = 0; e < 2; ++e) { const int cc = j * 512 + c0 + e * 4; o[e] = v[j * 2 + e] * rs * gs[j * 2 + e] + shr[j * 2 + e];
                    *(LAS f32x4*)(hs + rl * HS_LD + cc) = o[e]; }
                u32x2 w; w.x = pack4_fp8(o[0][0], o[0][1], o[0][2], o[0][3]); w.y = pack4_fp8(o[1][0], o[1][1], o[1][2], o[1][3]);
                *(u32x2*)(h2 + (size_t)row * D + j * 512 + c0) = w; } }
        lds_sync();
        loadtile(tile + gridDim.x);
        { f32x16 a0, a1;
#pragma unroll
          for (int r = 0; r < 16; ++r) { a0[r] = 0.f; a1[r] = 0.f; }
          const LAS float* hp = hs + (lane & 31) * HS_LD + 128 * wid + 2 * (lane >> 5);
#pragma unroll
          for (int s = 0; s < 32; ++s) { const f32x2 a = *(const LAS f32x2*)(hp + 4 * s);
              a0 = __builtin_amdgcn_mfma_f32_32x32x2f32(a[0], wB[2 * s], a0, 0, 0, 0); a1 = __builtin_amdgcn_mfma_f32_32x32x2f32(a[1], wB[2 * s + 1], a1, 0, 0, 0); }
          lds_sync();
#pragma unroll
          for (int r = 0; r < 16; ++r) { const int m = 8 * (r >> 2) + 4 * (lane >> 5) + (r & 3); hs[(wid * 32 + m) * 32 + (lane & 31)] = a0[r] + a1[r]; }
          lds_sync();
#pragma unroll
          for (int q = 0; q < 2; ++q) { const int o = tid + 512 * q; float t = p.b_r[o & 31];
#pragma unroll
              for (int w = 0; w < 8; ++w) t += hs[w * 1024 + o];
              lg[o] = t; } }
        lds_sync();
#pragma unroll
        for (int rep = 0; rep < 2; ++rep) { const int rl = wid * 4 + rep * 2 + (lane >> 5), row = rbase + rl, e = lane & 31; const float v = lg[rl * 32 + e]; int rank = 0;
#pragma unroll
            for (int q = 0; q < 8; ++q) { const f32x4 t = *(const LAS f32x4*)(lg + rl * 32 + 4 * q);
#pragma unroll
                for (int i = 0; i < 4; ++i) { const int gt = t[i] > v, eq = t[i] == v, lt = (4 * q + i) < e; rank += gt | (eq & lt); } }
            if (rank < 4) { lselv[rl * 4 + rank] = v; lseli[rl * 4 + rank] = e; }
            asm volatile("s_waitcnt lgkmcnt(0)" ::: "memory");
            const f32x4 sv = *(const LAS f32x4*)(lselv + rl * 4); const int k = e & 3; const int myk = lseli[rl * 4 + k];
            const float e0 = 1.0f, e1 = __expf(sv[1] - sv[0]), e2 = __expf(sv[2] - sv[0]), e3 = __expf(sv[3] - sv[0]); const float sum = ((e0 + e1) + e2) + e3;
            const float mye = k == 0 ? e0 : (k == 1 ? e1 : (k == 2 ? e2 : e3)); const float myp = mye / sum;
            if (e < 4) { const int pair = row * 4 + e; topi[pair] = myk; topp[pair] = myp; __hip_atomic_fetch_add(&lcnt[myk], 1, __ATOMIC_RELAXED, __HIP_MEMORY_SCOPE_WORKGROUP); lent[(it * 32 + rl) * 4 + e] = myk; } }
        lds_sync();
        { const int t3 = otid(); if (t3 < 32) { const int n = lcnt[t3]; if (it > 0) lbase[(it - 1) * 32 + t3] = pending; pending = n > 0 ? atomicAdd(&cnt[t3], n) : 0; lcnt[t3] = 0; } }
    }
    const int t2 = otid();
    if (t2 < 32 && it > 0) lbase[(it - 1) * 32 + t2] = pending;
    __syncthreads();
    const int nent = it * 128;
    for (int s = t2; s < nent; s += 512) { const int e = lent[s]; const int ii = s >> 7, rl = (s >> 2) & 31, k = s & 3; const int row = (blockIdx.x + ii * gridDim.x) * 32 + rl;
        const int pos = lbase[ii * 32 + e] + __hip_atomic_fetch_add(&lrun[ii * 32 + e], 1, __ATOMIC_RELAXED, __HIP_MEMORY_SCOPE_WORKGROUP); list[e * CAP + pos] = row * 4 + k; pairpos[row * 4 + k] = pos; }
}
__device__ __forceinline__ void moe_table(const int* cnt, LAS int* tab) {
    if (otid() == 0) { int t = 0; for (int e = 0; e < NE; ++e) { tab[e] = t; const int n = cnt[e]; tab[64 + e] = n; t += (n + 255) >> 8; } tab[32] = t; tab[33] = t; }
    __syncthreads();
    for (int rt = otid(); rt < tab[33]; rt += 512) { int e = 0; while (tab[e + 1] <= rt) ++e; tab[128 + rt] = e; }
    __syncthreads();
}
constexpr int LDS_TAB = pg8::STAGE_BYTES;
__device__ __forceinline__ void phase7(const Params& p, LAS unsigned char* lds) {
    char* ws = p.ws; LAS int* tab = (LAS int*)(lds + LDS_TAB); moe_table((const int*)(ws + OFF_CNT), tab);
    pg8::MoeSched<true> S; S.nN = 8; S.G = gridDim.x; S.c = blockIdx.x; S.rowb = 1024; S.Wt = ws + OFF_WT_GU; S.wexp = (size_t)2048 * 1024; S.btile = (size_t)256 * 1024; S.tab = tab; S.list = (const int*)(ws + OFF_LIST);
    pg8::EpiMoe1 E{(unsigned char*)(ws + OFF_ACT), p.b_gu};
    pg8::gemm_phase<pg8::EpiMoe1, pg8::MoeSched<true>, true, 127, 122>(lds, (const char*)(ws + OFF_H), 1024, S, E);
}
__device__ __forceinline__ void phase8(const Params& p, LAS unsigned char* lds) {
    char* ws = p.ws; LAS int* tab = (LAS int*)(lds + LDS_TAB);
    pg8::MoeSched<false> S; S.nN = 4; S.G = gridDim.x; S.c = blockIdx.x; S.rowb = 1024; S.Wt = ws + OFF_WT_DN; S.wexp = (size_t)1024 * 1024; S.btile = (size_t)256 * 1024; S.tab = tab; S.list = (const int*)(ws + OFF_LIST);
    pg8::EpiMoe2 E{(bf16_t*)(ws + OFF_YP), p.b_dn};
    pg8::gemm_phase<pg8::EpiMoe2, pg8::MoeSched<false>, true, 125, 122>(lds, (const char*)(ws + OFF_ACT), 1024, S, E);
}
__device__ __forceinline__ void phase9(const Params& p, LAS unsigned char* lds) {
    char* ws = p.ws; const float* modv = (const float*)(ws + OFF_MOD); const bf16_t* yp = (const bf16_t*)(ws + OFF_YP); const float* topp = (const float*)(ws + OFF_TOPP);
    const int* topi = (const int*)(ws + OFF_TOPI); const int* pairpos = (const int*)(ws + OFF_ROWPAIR);
    LAS int* tab = (LAS int*)(lds + LDS_TAB);
    const int tid = otid(), lane = tid & 63, gw = blockIdx.x * 8 + (tid >> 6), nw = gridDim.x * 8, c0 = lane * 8;
    f32x4 fg[4];
#pragma unroll
    for (int q = 0; q < 4; ++q) fg[q] = *(const f32x4*)(p.g_fin + (q >> 1) * 512 + c0 + (q & 1) * 4);
    for (int row = gw; row < L; row += nw) {
        const float* gate = modv + (row / SEQ) * 6144 + 5 * 1024; f32x4 v[4]; u32x4 yr[4][2];
        const pg8::i32x4_t ek = *(const pg8::i32x4_t*)(topi + row * 4), pk4 = *(const pg8::i32x4_t*)(pairpos + row * 4);
#pragma unroll
        for (int j = 0; j < 2; ++j) { float t8[8]; unpack8(*(const u32x4*)((const bf16_t*)(ws + OFF_X1) + (size_t)row * D + j * 512 + c0), t8); v[2 * j] = (f32x4){t8[0], t8[1], t8[2], t8[3]}; v[2 * j + 1] = (f32x4){t8[4], t8[5], t8[6], t8[7]}; }
#pragma unroll
        for (int k = 0; k < 4; ++k) { const size_t yrow = (size_t)tab[ek[k]] * 256 + pk4[k];
#pragma unroll
            for (int j = 0; j < 2; ++j) yr[k][j] = __builtin_nontemporal_load((const u32x4*)(yp + yrow * D + j * 512 + c0)); }
        const f32x4 pk = *(const f32x4*)(topp + row * 4);
        float m[16];
#pragma unroll
        for (int i = 0; i < 16; ++i) m[i] = 0.f;
#pragma unroll
        for (int k = 0; k < 4; ++k)
#pragma unroll
            for (int j = 0; j < 2; ++j) { float t[8]; unpack8(yr[k][j], t);
#pragma unroll
                for (int i = 0; i < 8; ++i) m[j * 8 + i] += pk[k] * t[i]; }
        float ss = 0.f;
#pragma unroll
        for (int q = 0; q < 4; ++q) { const f32x4 gt = *(const f32x4*)(gate + (q >> 1) * 512 + c0 + (q & 1) * 4);
#pragma unroll
            for (int i = 0; i < 4; ++i) { v[q][i] += gt[i] * m[q * 4 + i]; ss += v[q][i] * v[q][i]; } }
        const float rs = rsqrtf(wave_sum(ss) * (1.0f / D) + EPS);
#pragma unroll
        for (int q = 0; q < 4; ++q) __builtin_nontemporal_store(v[q] * rs * fg[q], (f32x4*)(p.out + (size_t)row * D + (q >> 1) * 512 + c0 + (q & 1) * 4));
    }
}

namespace at {
using s16x4  = __attribute__((ext_vector_type(4))) short;
constexpr int NW = 8, QBLK = 32, KVBLK = 64, DK = 192, DV = 128;
constexpr float SCALE = 0.07216878364870322f;
constexpr float THR = 8.f;
constexpr int SHM_V = KVBLK * DV * 2, SHM_K = KVBLK * DK * 2, SHM_ATTN = 2 * SHM_V + 2 * SHM_K + NW * 64 * 4;
#define KSWZ(row, colB) ((row) * 384 + ((colB) ^ ((((row) ^ ((row) >> 3)) & 7) << 4)))
#define SBAR() __builtin_amdgcn_sched_barrier(0)
__device__ __forceinline__ int crow(int r, int hi) { return (r & 3) + 8 * (r >> 2) + 4 * hi; }
__device__ __forceinline__ unsigned cvtpk(float lo, float hi) { return cvt_pk_bf16(lo, hi); }

__device__ __forceinline__ void partialSM(f32x16& p0, f32x16& p1, float& m_reg, float& mn, float& alpha) {
  constexpr float C = SCALE * 1.4426950408889634f;
  float pmax = p0[0];
#pragma unroll
  for (int r = 1; r < 16; ++r) pmax = fmaxf(pmax, p0[r]);
#pragma unroll
  for (int r = 0; r < 16; ++r) pmax = fmaxf(pmax, p1[r]);
  { auto rr = __builtin_amdgcn_permlane32_swap(__float_as_uint(pmax), __float_as_uint(pmax), false, false);
    pmax = fmaxf(__uint_as_float(rr[0]), __uint_as_float(rr[1])); }
  if (__builtin_expect(__all(pmax - m_reg <= THR / SCALE), 1)) { mn = m_reg; alpha = 1.f; }
  else { mn = fmaxf(m_reg, pmax); alpha = __builtin_amdgcn_exp2f((m_reg - mn) * C); m_reg = mn; }
  float mnC = -mn * C;
#pragma unroll
  for (int r = 0; r < 16; ++r) p0[r] = fmaf(p0[r], C, mnC);
#pragma unroll
  for (int r = 0; r < 16; ++r) p1[r] = fmaf(p1[r], C, mnC);
#pragma unroll
  for (int r = 0; r < 16; ++r) p0[r] = __builtin_amdgcn_exp2f(p0[r]);
}
__device__ __forceinline__ void finishSM(f32x16& p0, f32x16& p1, float alpha, float& l_reg, bf16x8& pa0, bf16x8& pa1, bf16x8& pa2, bf16x8& pa3) {
#pragma unroll
  for (int r = 0; r < 16; ++r) p1[r] = __builtin_amdgcn_exp2f(p1[r]);
  float ps = 0;
#pragma unroll
  for (int r = 0; r < 16; ++r) ps += p0[r];
#pragma unroll
  for (int r = 0; r < 16; ++r) ps += p1[r];
  { auto rr = __builtin_amdgcn_permlane32_swap(__float_as_uint(ps), __float_as_uint(ps), false, false);
    ps = __uint_as_float(rr[0]) + __uint_as_float(rr[1]); }
  l_reg = l_reg * alpha + ps;
#define PK4(P, BASE, OUT) do { unsigned a0 = cvtpk(P[BASE + 0], P[BASE + 1]), a1 = cvtpk(P[BASE + 2], P[BASE + 3]);   \
    unsigned b0 = cvtpk(P[BASE + 4], P[BASE + 5]), b1 = cvtpk(P[BASE + 6], P[BASE + 7]);                              \
    auto r0 = __builtin_amdgcn_permlane32_swap(a0, b0, false, false); auto r1 = __builtin_amdgcn_permlane32_swap(a1, b1, false, false); \
    u32x4 w = {r0[0], r1[0], r0[1], r1[1]}; OUT = *reinterpret_cast<bf16x8*>(&w); } while (0)
  PK4(p0, 0, pa0); PK4(p0, 8, pa1); PK4(p1, 0, pa2); PK4(p1, 8, pa3);
#undef PK4
}
__device__ __forceinline__ void qkt(f32x16& p0, f32x16& p1, const LAS char* Ks, const bf16x8 (&qr)[12], int r32, int hi) {
  p0 = f32x16{}; p1 = f32x16{};
#pragma unroll
  for (int d0 = 0; d0 < 12; ++d0) { const int cb = (d0 * 16 + hi * 8) * 2;
    const bf16x8 b0 = *reinterpret_cast<const LAS bf16x8*>(Ks + KSWZ(r32, cb));
    const bf16x8 b1 = *reinterpret_cast<const LAS bf16x8*>(Ks + KSWZ(32 + r32, cb));
    p0 = __builtin_amdgcn_mfma_f32_32x32x16_bf16(b0, qr[d0], p0, 0, 0, 0);
    p1 = __builtin_amdgcn_mfma_f32_32x32x16_bf16(b1, qr[d0], p1, 0, 0, 0); }
}
__device__ __forceinline__ int v_st(int k, int c) { const int kk = (k & ~0xC) | ((k & 4) << 1) | ((k & 8) >> 1); return ((kk >> 3) * 4 + (c >> 5)) * 512 + ((kk & 7) * 32 + (c & 31)) * 2; }
__device__ __forceinline__ int v_rd_base(int lane) { return ((lane & 3) << 3) | (((lane >> 2) & 3) << 6) | (((lane >> 4) & 1) << 5) | (((lane >> 5) & 1) << 8); }
constexpr int v_rd_off(int d0, int ks, int half) { return d0 * 512 + ks * 4096 + half * 2048; }
template <int OFF> __device__ __forceinline__ s16x4 tr_read(int vb) { s16x4 r; asm volatile("ds_read_b64_tr_b16 %0, %1 offset:%2" : "=&v"(r) : "v"(vb), "i"(OFF) : "memory"); return r; }
template <int D0> __device__ __forceinline__ void pv_one(f32x16& od, int vb, bf16x8 pa0, bf16x8 pa1, bf16x8 pa2, bf16x8 pa3) {
  const s16x4 l0 = tr_read<v_rd_off(D0, 0, 0)>(vb), h0 = tr_read<v_rd_off(D0, 0, 1)>(vb), l1 = tr_read<v_rd_off(D0, 1, 0)>(vb), h1 = tr_read<v_rd_off(D0, 1, 1)>(vb);
  const s16x4 l2 = tr_read<v_rd_off(D0, 2, 0)>(vb), h2 = tr_read<v_rd_off(D0, 2, 1)>(vb), l3 = tr_read<v_rd_off(D0, 3, 0)>(vb), h3 = tr_read<v_rd_off(D0, 3, 1)>(vb);
  asm volatile("s_waitcnt lgkmcnt(0)" ::: "memory"); SBAR();
#define PK(Lo, Hi) (bf16x8){Lo[0], Lo[1], Lo[2], Lo[3], Hi[0], Hi[1], Hi[2], Hi[3]}
  od = __builtin_amdgcn_mfma_f32_32x32x16_bf16(pa0, PK(l0, h0), od, 0, 0, 0);
  od = __builtin_amdgcn_mfma_f32_32x32x16_bf16(pa1, PK(l1, h1), od, 0, 0, 0);
  od = __builtin_amdgcn_mfma_f32_32x32x16_bf16(pa2, PK(l2, h2), od, 0, 0, 0);
  od = __builtin_amdgcn_mfma_f32_32x32x16_bf16(pa3, PK(l3, h3), od, 0, 0, 0);
#undef PK
}
__device__ __forceinline__ void pv_d0(f32x16 (&o)[4], int vb, bf16x8 pa0, bf16x8 pa1, bf16x8 pa2, bf16x8 pa3) {
  pv_one<0>(o[0], vb, pa0, pa1, pa2, pa3); pv_one<1>(o[1], vb, pa0, pa1, pa2, pa3); pv_one<2>(o[2], vb, pa0, pa1, pa2, pa3); pv_one<3>(o[3], vb, pa0, pa1, pa2, pa3);
}

__device__ __forceinline__ void attn_unit(const bf16_t* __restrict__ Qb, const bf16_t* __restrict__ Kh, const bf16_t* __restrict__ Vh, bf16_t* __restrict__ Ob, int t0, const float* __restrict__ ropet, LAS char* lds) {
  constexpr int LDQ = 1536, LDO = 1024, NT = NKEY / KVBLK;
  const int tid = otid(), wid = tid >> 6, lane = tid & 63, r32 = lane & 31, hi = lane >> 5;
  LAS char* V_lds = lds; LAS char* K_lds = lds + 2 * SHM_V;
  LAS float* wsl = (LAS float*)(lds + 2 * SHM_V + 2 * SHM_K) + wid * 64; LAS float* li_l = wsl; LAS float* al_l = wsl + 32;
  float m_reg = -1e30f, l_reg = 0; f32x16 o[4] = {}; bf16x8 qr[12];
  { const bf16_t* Qw = Qb + (size_t)(wid * QBLK + r32) * LDQ + hi * 8;
#pragma unroll
    for (int d0 = 0; d0 < 12; ++d0) qr[d0] = *reinterpret_cast<const bf16x8*>(Qw + d0 * 16); }
  const int sr = tid >> 4, sc = (tid & 15) * 8, vst0 = v_st(sr, sc), vst1 = v_st(32 + sr, sc);
  int kgo[3], kst[3];
#pragma unroll
  for (int i = 0; i < 3; ++i) { const int c = tid + 512 * i, row = c / 24, c8 = (c % 24) * 8; kgo[i] = row * DK + c8; kst[i] = KSWZ(row, c8 * 2); }
  const int vb0 = (int)(uintptr_t)V_lds + v_rd_base(lane);
  bf16x8 sv0, sv1, sk0, sk1, sk2;
#define SLOAD(k0) do { sv0 = *reinterpret_cast<const bf16x8*>(&Vh[(size_t)((k0) + sr) * DV + sc]); sv1 = *reinterpret_cast<const bf16x8*>(&Vh[(size_t)((k0) + 32 + sr) * DV + sc]); \
    sk0 = *reinterpret_cast<const bf16x8*>(&Kh[(size_t)(k0) * DK + kgo[0]]); sk1 = *reinterpret_cast<const bf16x8*>(&Kh[(size_t)(k0) * DK + kgo[1]]); sk2 = *reinterpret_cast<const bf16x8*>(&Kh[(size_t)(k0) * DK + kgo[2]]); } while (0)
#define SWRITE(b) do { *(LAS bf16x8*)(V_lds + (b) * SHM_V + vst0) = sv0; *(LAS bf16x8*)(V_lds + (b) * SHM_V + vst1) = sv1; \
    *(LAS bf16x8*)(K_lds + (b) * SHM_K + kst[0]) = sk0; *(LAS bf16x8*)(K_lds + (b) * SHM_K + kst[1]) = sk1; *(LAS bf16x8*)(K_lds + (b) * SHM_K + kst[2]) = sk2; } while (0)
#define RESC(a) do { if (__any((a) < 1.f)) { if (hi == 0) al_l[r32] = (a); asm volatile("s_waitcnt lgkmcnt(0)" ::: "memory"); \
    _Pragma("unroll") for (int d = 0; d < 4; ++d) _Pragma("unroll") for (int r = 0; r < 16; ++r) o[d][r] *= al_l[crow(r, hi)]; } } while (0)
  f32x16 p0, p1; float mn, al; bf16x8 pa0, pa1, pa2, pa3;
  SLOAD(0);
  { const float* rt = ropet + (size_t)(t0 + wid * QBLK + r32) * 64 + 8 * hi;
#pragma unroll
    for (int g = 0; g < 2; ++g) {
      const f32x4 c0 = *(const f32x4*)(rt + 16 * g), c1 = *(const f32x4*)(rt + 16 * g + 4), s0 = *(const f32x4*)(rt + 32 + 16 * g), s1 = *(const f32x4*)(rt + 32 + 16 * g + 4);
      float n1[8], n2[8];
#pragma unroll
      for (int j = 0; j < 8; ++j) { const float cs = j < 4 ? c0[j & 3] : c1[j & 3], sn = j < 4 ? s0[j & 3] : s1[j & 3];
        const float x1 = bf2f((bf16_t)qr[8 + g][j]), x2 = bf2f((bf16_t)qr[10 + g][j]); n1[j] = x1 * cs - x2 * sn; n2[j] = x1 * sn + x2 * cs; }
      u32x4 w1 = {cvtpk(n1[0], n1[1]), cvtpk(n1[2], n1[3]), cvtpk(n1[4], n1[5]), cvtpk(n1[6], n1[7])}; u32x4 w2 = {cvtpk(n2[0], n2[1]), cvtpk(n2[2], n2[3]), cvtpk(n2[4], n2[5]), cvtpk(n2[6], n2[7])};
      qr[8 + g] = *reinterpret_cast<bf16x8*>(&w1); qr[10 + g] = *reinterpret_cast<bf16x8*>(&w2); } }
  asm volatile("s_waitcnt vmcnt(0)" ::: "memory"); SWRITE(0); __syncthreads();
  for (int j = 0; j < NT; ++j) {
    const int bsel = j & 1;
    if (j + 1 < NT) SLOAD((j + 1) * KVBLK);
    SBAR(); qkt(p0, p1, K_lds + bsel * SHM_K, qr, r32, hi);
    partialSM(p0, p1, m_reg, mn, al);
    RESC(al);
    finishSM(p0, p1, al, l_reg, pa0, pa1, pa2, pa3); SBAR();
    pv_d0(o, vb0 + bsel * SHM_V, pa0, pa1, pa2, pa3);
    if (j + 1 < NT) { asm volatile("s_waitcnt vmcnt(0)" ::: "memory"); SWRITE(bsel ^ 1); }
    __syncthreads();
  }
  if (hi == 0) li_l[r32] = l_reg; asm volatile("s_waitcnt lgkmcnt(0)" ::: "memory");
  float rli[16];
#pragma unroll
  for (int r = 0; r < 16; ++r) rli[r] = __builtin_amdgcn_rcpf(li_l[crow(r, hi)]);
  { LAS bf16_t* ot = (LAS bf16_t*)(lds + wid * 8192);
#pragma unroll
    for (int r = 0; r < 16; ++r) { const int orow = crow(r, hi);
#pragma unroll
      for (int d0 = 0; d0 < 4; ++d0) ot[orow * 128 + d0 * 32 + r32] = f2bf(o[d0][r] * rli[r]); }
    asm volatile("s_waitcnt lgkmcnt(0)" ::: "memory");
    bf16_t* Ow = Ob + (size_t)(wid * QBLK) * LDO;
#pragma unroll
    for (int i = 0; i < 8; ++i) { const int q = lane + 64 * i, row = q >> 4, ch = q & 15; const u32x4 w = *(const LAS u32x4*)(ot + row * 128 + ch * 8); *(u32x4*)(Ow + (size_t)row * LDO + ch * 8) = w; } }
#undef SLOAD
#undef SWRITE
#undef RESC
}
}

__device__ __forceinline__ void phase_attn(const Params& p, LAS unsigned char* lds) {
    char* ws = p.ws; const bf16_t* Q = (const bf16_t*)(ws + OFF_Q); const bf16_t* Kb = (const bf16_t*)(ws + OFF_K); const bf16_t* Vb = (const bf16_t*)(ws + OFF_V); bf16_t* Y = (bf16_t*)(ws + OFF_H);
    const int G = gridDim.x;
    for (int it = 0;; ++it) {
        int u;
        if (G == 256) { const int c = blockIdx.x, xcd = c & 7, j = c >> 3; if (it >= 4) break; u = ((it * 32 + xcd * 4 + (j >> 3)) << 3) | (j & 7); }
        else { u = it * G + blockIdx.x; if (u >= 1024) break; }
        const int bh = u >> 3, qb = u & 7, b = bh >> 3, h = bh & 7;
        at::attn_unit(Q + ((size_t)(b * SEQ + qb * 256)) * 1536 + h * 192, Kb + (size_t)bh * NKEY * 192, Vb + (size_t)bh * NKEY * 128, Y + ((size_t)(b * SEQ + qb * 256)) * D + h * 128, qb * 256, (const float*)(ws + OFF_ROPE), (LAS char*)lds);
        __syncthreads();
    }
}

namespace sc {
using f32x16 = __attribute__((ext_vector_type(16))) float;
constexpr int BUFB = 53248, O_QT = 0, O_KH = 16384, O_VT = 32768, O_AT = 49152, O_DEC = 51200, O_KD = 2 * BUFB, O_OUT = 2 * BUFB + 16384, LDS_SCAN = 2 * BUFB + 16384 + 2 * 16384;
__device__ __forceinline__ int sw256(int row, int cb) { return row * 256 + (cb ^ ((row & 15) << 4)); }
__device__ __forceinline__ int sw128(int row, int cb) { return row * 128 + (cb ^ (((row >> 1) & 7) << 4)); }
__device__ __forceinline__ int grow_of(int n, int b, int dir) { if (n < CTXL) { const int s = dir ? (CTXL - 1 - n) : n; return L + b * CTXL + s; } const int m = n - CTXL; return b * SEQ + (dir ? (SEQ - 1 - m) : m); }
__device__ __forceinline__ bf16x8 pack_acc8(const f32x16& x, int s) { u32x4 p; p.x = cvt_pk_bf16(x[8 * s], x[8 * s + 1]); p.y = cvt_pk_bf16(x[8 * s + 2], x[8 * s + 3]); p.z = cvt_pk_bf16(x[8 * s + 4], x[8 * s + 5]); p.w = cvt_pk_bf16(x[8 * s + 6], x[8 * s + 7]); return __builtin_bit_cast(bf16x8, p); }

__device__ __forceinline__ void scan_unit(const Params& p, int unit, LAS unsigned char* lds) {
    char* ws = p.ws; const int dir = unit & 1, h = (unit >> 1) & 7, b = unit >> 4;
    const bf16_t* hq = (const bf16_t*)(ws + OFF_HQ); const bf16_t* fz = (const bf16_t*)(ws + (dir ? OFF_FB : OFF_FF)); const bf16_t* iv = (const bf16_t*)(ws + OFF_IV);
    bf16_t* outp = (bf16_t*)(ws + (dir ? OFF_OB : OFF_OF)); const float* lb = (const float*)(ws + OFF_LB);
    const int tid = otid(), wid = __builtin_amdgcn_readfirstlane(tid >> 6), lane = tid & 63, r32 = lane & 31, hi = lane >> 5;
    const int sgn = dir ? -1 : 1; const long rstep = (long)sgn * D;
    __syncthreads();
    if (wid >= 4) {
        const int I = wid - 4, cp = lane, hc = h * 128 + 2 * cp;
        const float lbv0 = lb[dir * 1024 + hc], lbv1 = lb[dir * 1024 + hc + 1];
        unsigned zr[16], vr[16], qr[16];
#define SC_LOAD(c) do { const size_t o0_ = (size_t)(grow_of((c) * 64, b, dir) + sgn * (16 * I)) * D + hc; const bf16_t* pz_ = fz + o0_; const bf16_t* pv_ = iv + o0_; const bf16_t* pq_ = hq + o0_; \
        _Pragma("unroll") for (int i = 0; i < 16; ++i) { zr[i] = *(const unsigned*)pz_; pz_ += rstep; vr[i] = *(const unsigned*)pv_; pv_ += rstep; if ((c) >= 4) { qr[i] = *(const unsigned*)pq_; pq_ += rstep; } } } while (0)
        SC_LOAD(0);
        for (int it = 0; it <= 37; ++it) {
            if (it >= 6) {
                const int c = it - 2; const LAS unsigned char* OB = lds + O_OUT + (c & 1) * 16384; const int pt = I * 64 + lane;
                bf16_t* ob = outp + (size_t)grow_of(c * 64, b, dir) * D + h * 128;
#pragma unroll
                for (int q = 0; q < 4; ++q) { const int item = q * 256 + pt, t = item >> 4, c16 = item & 15;
                    *(u32x4*)(ob + (long)t * rstep + c16 * 8) = *(const LAS u32x4*)(OB + t * 256 + c16 * 16); }
            }
            if (it < 36) {
                const int c = it; const bool lat = c >= 4; LAS unsigned char* B = lds + (c & 1) * BUFB; LAS unsigned char* KD = lds + O_KD;
                float kk0[16], kk1[16], lc0[16], lc1[16]; float run0 = 0.f, run1 = 0.f;
#pragma unroll
                for (int i = 0; i < 16; ++i) { const float z0 = __uint_as_float(zr[i] << 16), z1 = __uint_as_float(zr[i] & 0xffff0000u);
                    const float f0 = lbv0 + (1.0f - lbv0) * sigmoidf_(z0), f1 = lbv1 + (1.0f - lbv1) * sigmoidf_(z1); kk0[i] = 1.0f - f0; kk1[i] = 1.0f - f1;
                    run0 += __builtin_amdgcn_logf(f0) * 0.6931471805599453f; run1 += __builtin_amdgcn_logf(f1) * 0.6931471805599453f; lc0[i] = run0; lc1[i] = run1; }
                *(LAS f32x2*)(B + O_DEC + (I * 128 + 2 * cp) * 4) = (f32x2){__expf(run0), __expf(run1)};
                unsigned kh0[8], kh1[8], vt0[8], vt1[8];
#pragma unroll
                for (int i = 0; i < 16; ++i) { const int t = 16 * I + i; const float l0 = lc0[i], l1 = lc1[i];
                    const float kd0 = kk0[i] * __expf(fminf(-l0, 80.0f)), kd1 = kk1[i] * __expf(fminf(-l1, 80.0f));
                    const float kf0 = kk0[i] * __expf(run0 - l0), kf1 = kk1[i] * __expf(run1 - l1);
                    if (lat) { const float q0 = __uint_as_float(qr[i] << 16), q1 = __uint_as_float(qr[i] & 0xffff0000u);
                        *(LAS unsigned*)(B + O_QT + sw256(t, 4 * cp)) = cvt_pk_bf16(q0 * __expf(l0), q1 * __expf(l1)); *(LAS unsigned*)(KD + sw256(t, 4 * cp)) = cvt_pk_bf16(kd0, kd1); }
                    if (i & 1) { kh0[i >> 1] = cvt_pk_bf16(__uint_as_float(kh0[i >> 1]), kf0); kh1[i >> 1] = cvt_pk_bf16(__uint_as_float(kh1[i >> 1]), kf1); vt0[i >> 1] = (vt0[i >> 1] >> 16) | (vr[i] << 16); vt1[i >> 1] = (vt1[i >> 1] >> 16) | (vr[i] & 0xffff0000u); }
                    else { kh0[i >> 1] = __float_as_uint(kf0); kh1[i >> 1] = __float_as_uint(kf1); vt0[i >> 1] = vr[i] << 16; vt1[i >> 1] = vr[i] & 0xffff0000u; } }
#pragma unroll
                for (int q = 0; q < 2; ++q) {
                    *(LAS u32x4*)(B + O_KH + sw128(2 * cp, 32 * I + 16 * q)) = (u32x4){kh0[4 * q], kh0[4 * q + 1], kh0[4 * q + 2], kh0[4 * q + 3]}; *(LAS u32x4*)(B + O_KH + sw128(2 * cp + 1, 32 * I + 16 * q)) = (u32x4){kh1[4 * q], kh1[4 * q + 1], kh1[4 * q + 2], kh1[4 * q + 3]};
                    *(LAS u32x4*)(B + O_VT + sw128(2 * cp, 32 * I + 16 * q)) = (u32x4){vt0[4 * q], vt0[4 * q + 1], vt0[4 * q + 2], vt0[4 * q + 3]}; *(LAS u32x4*)(B + O_VT + sw128(2 * cp + 1, 32 * I + 16 * q)) = (u32x4){vt1[4 * q], vt1[4 * q + 1], vt1[4 * q + 2], vt1[4 * q + 3]}; }
                if (it + 1 < 36) SC_LOAD(it + 1);
                if (lat) {
                    const int l15 = lane & 15, lq = lane >> 4; f32x4 a = {0.f, 0.f, 0.f, 0.f};
#pragma unroll
                    for (int ks = 0; ks < 4; ++ks) { const bf16x8 av = *(const LAS bf16x8*)(B + O_QT + sw256(16 * I + l15, (32 * ks + 8 * lq) * 2)); const bf16x8 bv = *(const LAS bf16x8*)(KD + sw256(16 * I + l15, (32 * ks + 8 * lq) * 2));
                        a = __builtin_amdgcn_mfma_f32_16x16x32_bf16(av, bv, a, 0, 0, 0); }
#pragma unroll
                    for (int r = 0; r < 4; ++r) { const int tl = 4 * lq + r; float v = a[r]; if (l15 > tl) v = 0.f; *(LAS bf16_t*)(B + O_AT + ((I * 16 + tl) * 16 + l15) * 2) = f2bf(v); }
                }
            }
            lds_sync();
        }
#undef SC_LOAD
    } else {
        const int bq = wid; f32x16 S[4];
#pragma unroll
        for (int a = 0; a < 4; ++a) S[a] = f32x16{};
        for (int it = 0; it <= 37; ++it) {
            if (it >= 1 && it <= 36) {
                const int c = it - 1; const bool lat = c >= 4; LAS unsigned char* B = lds + (c & 1) * BUFB;
                LAS bf16_t* po = (LAS bf16_t*)(lds + O_OUT + (c & 1) * 16384) + (4 * hi) * 128 + 32 * bq + r32;
#pragma unroll
                for (int I = 0; I < 4; ++I) {
                    const bf16x8 vtf = *(const LAS bf16x8*)(B + O_VT + sw128(32 * bq + r32, (16 * I + 8 * hi) * 2));
                    if (lat) {
                        f32x16 o = f32x16{};
#pragma unroll
                        for (int a = 0; a < 4; ++a)
#pragma unroll
                            for (int s = 0; s < 2; ++s) { const int dk0 = 32 * a + 16 * s + 4 * hi; const int row = 16 * I + (r32 & 15);
                                const u32x2 lo2 = *(const LAS u32x2*)(B + O_QT + sw256(row, dk0 * 2)), hi2 = *(const LAS u32x2*)(B + O_QT + sw256(row, (dk0 + 8) * 2));
                                const u32x4 av = {lo2.x, lo2.y, hi2.x, hi2.y};
                                o = __builtin_amdgcn_mfma_f32_32x32x16_bf16(__builtin_bit_cast(bf16x8, av), pack_acc8(S[a], s), o, 0, 0, 0); }
                        { const bf16x8 af = *(const LAS bf16x8*)(B + O_AT + ((I * 16 + (r32 & 15)) * 16 + 8 * hi) * 2); o = __builtin_amdgcn_mfma_f32_32x32x16_bf16(af, vtf, o, 0, 0, 0); }
#pragma unroll
                        for (int r = 0; r < 8; ++r) po[(16 * I + (r & 3) + 8 * (r >> 2)) * 128] = f2bf(o[r]);
                    }
#pragma unroll
                    for (int a = 0; a < 4; ++a) {
#pragma unroll
                        for (int g = 0; g < 4; ++g) { const f32x4 dc = *(const LAS f32x4*)(B + O_DEC + (I * 128 + 32 * a + 8 * g + 4 * hi) * 4); S[a][4 * g] *= dc[0]; S[a][4 * g + 1] *= dc[1]; S[a][4 * g + 2] *= dc[2]; S[a][4 * g + 3] *= dc[3]; }
                        const bf16x8 kf = *(const LAS bf16x8*)(B + O_KH + sw128(32 * a + r32, (16 * I + 8 * hi) * 2));
                        S[a] = __builtin_amdgcn_mfma_f32_32x32x16_bf16(kf, vtf, S[a], 0, 0, 0); }
                }
            }
            lds_sync();
        }
    }
    __syncthreads();
}
}
__device__ __forceinline__ void phase_scan(const Params& p, LAS unsigned char* lds) {
    for (int u = blockIdx.x; u < 256; u += gridDim.x) sc::scan_unit(p, u, lds);
}

constexpr int LDS_BYTES = 163840;
#include <cstdint>
#include <cstdlib>
#include <vector>

#define XB_TMO      128
#define XB_XCNT(j)  (256  + 64 * (j))
#define XB_XSUB(j)  (1280 + 64 * (j))
#define XB_XGEN(j)  (2304 + 64 * (j))
#define XB_TOP      3328
#define XB_TOPGEN   3392
#define XCD_BAR_WORDS 3456
#define XB_SPIN_CAP (1u << 18)

__device__ __forceinline__ unsigned xb_ld(unsigned* p)              { return __hip_atomic_load(p, __ATOMIC_RELAXED, __HIP_MEMORY_SCOPE_AGENT); }
__device__ __forceinline__ unsigned xb_add(unsigned* p, unsigned v) { return __hip_atomic_fetch_add(p, v, __ATOMIC_RELAXED, __HIP_MEMORY_SCOPE_AGENT); }
__device__ __forceinline__ unsigned xb_xcc_id() { return (unsigned)__builtin_amdgcn_s_getreg((3 << 11) | 20) & 0xFu; }
#define XB_SPIN(cond, bar) do { unsigned _sp = 0; while (cond) { __builtin_amdgcn_s_sleep(1); \
    if ((++_sp & 255u) == 0u) { if (xb_ld(&(bar)[XB_TMO])) break; if (_sp > XB_SPIN_CAP) { atomicAdd(&(bar)[XB_TMO], 1u); break; } } } } while (0)

struct XcdBarrier {
    unsigned* bar; unsigned x;
    volatile LAS unsigned* st;
};

__device__ __forceinline__ XcdBarrier xcd_barrier_post(unsigned* bar, volatile LAS unsigned* st) {
    XcdBarrier b; b.bar = bar; b.x = xb_xcc_id(); b.st = st;
    if (threadIdx.x == 0) (void)xb_add(&bar[XB_XCNT(b.x)], 1u);
    return b;
}
__device__ __forceinline__ void xcd_barrier_complete(unsigned* bar, unsigned x, unsigned& nloc, unsigned& nx) {
    const unsigned G = gridDim.x * gridDim.y * gridDim.z;
    unsigned sum, cnt, mine, sp = 0u;
    for (;;) {
        sum = 0u; cnt = 0u; mine = 0u;
#pragma unroll
        for (unsigned j = 0; j < 16; ++j) { const unsigned c = xb_ld(&bar[XB_XCNT(j)]); sum += c; cnt += (c > 0u) ? 1u : 0u; mine = (j == x) ? c : mine; }
        if (sum == G) break;
        __builtin_amdgcn_s_sleep(1);
        if ((++sp & 255u) == 0u) { if (xb_ld(&bar[XB_TMO])) break; if (sp > XB_SPIN_CAP) { atomicAdd(&bar[XB_TMO], 1u); break; } }
    }
    nloc = mine > 0u ? mine : 1u; nx = cnt > 0u ? cnt : 1u;
}

__device__ __forceinline__ void xcd_barrier(const XcdBarrier& b) {
    asm volatile("s_waitcnt vmcnt(0)" ::: "memory");
    __syncthreads();
    if (threadIdx.x == 0) {
        unsigned* bar = b.bar;
        __builtin_amdgcn_s_waitcnt(0);
        unsigned nloc = b.st[0], nx = b.st[1];
        if (nloc == 0u) { xcd_barrier_complete(bar, b.x, nloc, nx); b.st[0] = nloc; b.st[1] = nx; }
        const unsigned old = xb_add(&bar[XB_XSUB(b.x)], 1u);
        const unsigned gen = old / nloc;
        if (old + 1u == (gen + 1u) * nloc) {
            __builtin_amdgcn_fence(__ATOMIC_RELEASE, "agent");
            asm volatile("s_waitcnt vmcnt(0)" ::: "memory");
            const unsigned og = xb_add(&bar[XB_TOP], 1u);
            const unsigned tg = og / nx;
            if (og + 1u == (tg + 1u) * nx) xb_add(&bar[XB_TOPGEN], 1u);
            else XB_SPIN(xb_ld(&bar[XB_TOPGEN]) == tg, bar);
            __builtin_amdgcn_fence(__ATOMIC_ACQUIRE, "agent");
            xb_add(&bar[XB_XGEN(b.x)], 1u);
            asm volatile("s_waitcnt vmcnt(0)" ::: "memory");
        } else {
            XB_SPIN(xb_ld(&bar[XB_XGEN(b.x)]) == gen, bar);
            __builtin_amdgcn_fence(__ATOMIC_ACQUIRE, "agent");
            asm volatile("s_waitcnt vmcnt(0)" ::: "memory");
        }
    }
    __syncthreads();
}

__global__ void __launch_bounds__(512, 2) k_mega(Params p) {
    extern __shared__ __attribute__((aligned(16))) unsigned char smem[];
    LAS unsigned char* lds = (LAS unsigned char*)smem;
    volatile LAS unsigned* xbw = (volatile LAS unsigned*)(lds + LDS_BYTES - 16);
    if (threadIdx.x == 0) { xbw[0] = 0u; xbw[1] = 0u; xbw[2] = 0u; xbw[3] = 0u; }
    __syncthreads();
    XcdBarrier bar = xcd_barrier_post((unsigned*)(p.ws + OFF_BAR), xbw);
    phase0(p, lds);      xcd_barrier(bar);
    phase1(p, lds);      xcd_barrier(bar);
    phase2(p, lds);      xcd_barrier(bar);
    phase3(p, lds);      xcd_barrier(bar);
    phase_attn(p, lds);
    phase_scan(p, lds);  xcd_barrier(bar);
    phase4(p, lds);      xcd_barrier(bar);
    phase5(p, lds);      xcd_barrier(bar);
    phase6(p, lds);      xcd_barrier(bar);
    phase7(p, lds);      xcd_barrier(bar);
    phase8(p, lds);      xcd_barrier(bar);
    phase9(p, lds);
}
extern "C" void kernel_launch(void* const* d_in, const int* in_sizes, int n_in, void* d_out, int out_size, void* d_ws, size_t ws_size, hipStream_t stream) {
    static int grid = 0;
    if (grid == 0) {
        int dev = 0, cus = 0, per_cu = 0;
        if (hipGetDevice(&dev) != hipSuccess || hipDeviceGetAttribute(&cus, hipDeviceAttributeMultiprocessorCount, dev) != hipSuccess) { grid = -1; return; }
        if (hipFuncSetAttribute((const void*)k_mega, hipFuncAttributeMaxDynamicSharedMemorySize, LDS_BYTES) != hipSuccess) { grid = -1; return; }
        (void)hipOccupancyMaxActiveBlocksPerMultiprocessor(&per_cu, (const void*)k_mega, 512, LDS_BYTES);
        (void)hipGetLastError();
        grid = cus;
    }
    if (grid < 0) return;
    Params p{};
    p.x = (const float*)d_in[0]; p.c = (const float*)d_in[1]; p.ctx = (const float*)d_in[2]; p.cctx = (const float*)d_in[3]; p.w_mod = (const float*)d_in[4]; p.b_mod = (const float*)d_in[5];
    p.g_mix = (const float*)d_in[6]; p.w_in = (const float*)d_in[7]; p.g_q = (const float*)d_in[8]; p.w_qb = (const float*)d_in[9]; p.g_kv = (const float*)d_in[10]; p.w_kvb = (const float*)d_in[11];
    p.lbl = (const float*)d_in[12]; p.g_hg = (const float*)d_in[13]; p.w_out = (const float*)d_in[14]; p.g_ffn = (const float*)d_in[15]; p.w_r = (const float*)d_in[16]; p.b_r = (const float*)d_in[17];
    p.w_gu = (const float*)d_in[18]; p.b_gu = (const float*)d_in[19]; p.w_dn = (const float*)d_in[20]; p.b_dn = (const float*)d_in[21]; p.g_fin = (const float*)d_in[22];
    p.out = (float*)d_out; p.ws = (char*)d_ws;
    (void)hipMemsetAsync((char*)d_ws + OFF_BAR, 0, 16384, stream);
    hipLaunchKernelGGL(k_mega, dim3(grid), dim3(512), LDS_BYTES, stream, p);
}
```

```cpp
#include <hip/hip_runtime.h>
#include <stdint.h>

typedef unsigned short bf16_t;
__device__ __forceinline__ float bf2f(bf16_t v) { return __uint_as_float(((unsigned)v) << 16); }
__device__ __forceinline__ bf16_t f2bf(float f) { unsigned u = __float_as_uint(f); u += 0x7FFFu + ((u >> 16) & 1u); return (bf16_t)(u >> 16); }
__device__ __forceinline__ float sigmoidf_(float x) { return __builtin_amdgcn_rcpf(1.0f + __builtin_amdgcn_exp2f(-1.4426950408889634f * x)); }
__device__ __forceinline__ float siluf_(float x) { return x * __builtin_amdgcn_rcpf(1.0f + __builtin_amdgcn_exp2f(-1.4426950408889634f * x)); }

constexpr int D = 1024, NB = 16, SEQ = 2048, CTXL = 256;
constexpr int L = NB * SEQ;
constexpr int RC = NB * CTXL;
constexpr int R = L + RC;
constexpr int NKEY = SEQ + CTXL;
constexpr float EPS = 1e-6f;
constexpr int NE = 32, CAP = 32768;
constexpr int MAXROWS = 131072 + NE * 256;

constexpr size_t MiB = 1048576;
constexpr size_t OFF_SMALL = 0;
constexpr size_t OFF_BAR = 0;
constexpr size_t OFF_CNT = 16384;
constexpr size_t OFF_OFFS = 16384 + 1024;
constexpr size_t OFF_TILEE = 16384 + 2048;
constexpr size_t OFF_LB = 24576;
constexpr size_t OFF_MOD = 32768;
constexpr size_t OFF_SSQQ = 512 * 1024;
constexpr size_t OFF_SSQKV = 768 * 1024;
constexpr size_t OFF_TOPI = 1 * MiB;
constexpr size_t OFF_TOPP = 1 * MiB + 512 * 1024;
constexpr size_t OFF_ROWPAIR = 2 * MiB;
constexpr size_t OFF_LIST = 3 * MiB;
constexpr size_t OFF_H = 32 * MiB;
constexpr size_t OFF_QA = 104 * MiB;
constexpr size_t OFF_CKV = 152 * MiB;
constexpr size_t OFF_KR = 170 * MiB;
constexpr size_t OFF_OF = 104 * MiB;
constexpr size_t OFF_HQ = 175 * MiB;
constexpr size_t SEG_STRIDE = 72 * MiB;
constexpr size_t OFF_FF = OFF_HQ + 1 * SEG_STRIDE;
constexpr size_t OFF_FB = OFF_HQ + 2 * SEG_STRIDE;
constexpr size_t OFF_IV = OFF_HQ + 3 * SEG_STRIDE;
constexpr size_t OFF_OG = OFF_HQ + 4 * SEG_STRIDE;
constexpr size_t OFF_GM = OFF_HQ + 5 * SEG_STRIDE;
constexpr size_t OFF_GH = OFF_HQ + 6 * SEG_STRIDE;
constexpr size_t OFF_Q = 679 * MiB;
constexpr size_t OFF_K = 775 * MiB;
constexpr size_t OFF_V = 883 * MiB;
constexpr size_t OFF_OB = 955 * MiB;
constexpr size_t OFF_YP = 296 * MiB;
constexpr size_t OFF_ACT = 568 * MiB;


__device__ __forceinline__ void rope_cs(int t, int i, float& cs, float& sn) {
    int j = i & 15; float inv = __expf(-(float)j * (9.210340371976184f / 16.0f)); float pos = (i < 16) ? (float)(t >> 6) : (float)(t & 63);
    float ang = pos * inv; cs = cosf(ang); sn = sinf(ang);
}

#define LAS __attribute__((address_space(3)))
__device__ __forceinline__ int otid() { int t = threadIdx.x; asm volatile("" : "+v"(t)); return t; }
typedef short bf16x8 __attribute__((ext_vector_type(8)));
typedef float f32x4 __attribute__((ext_vector_type(4)));
typedef unsigned u32x4 __attribute__((ext_vector_type(4)));
typedef unsigned u32x2 __attribute__((ext_vector_type(2)));
typedef float f32x2 __attribute__((ext_vector_type(2)));
using f32x16 = __attribute__((ext_vector_type(16))) float;

constexpr size_t OFF_ROPE = 7 * MiB;
constexpr size_t OFF_WT_IN = 8 * MiB;
constexpr size_t OFF_WT_QB = 25 * MiB;
constexpr size_t OFF_WT_KVB = 28 * MiB;
constexpr size_t OFF_WT_OUT = 29 * MiB;
constexpr size_t OFF_WT_GU = 104 * MiB;
constexpr size_t OFF_WT_DN = 232 * MiB;
constexpr size_t OFF_YF8 = 775 * MiB;
constexpr size_t OFF_X1 = 704 * MiB;

struct Params {
    const float *x, *c, *ctx, *cctx, *w_mod, *b_mod, *g_mix, *w_in, *g_q, *w_qb, *g_kv, *w_kvb, *lbl, *g_hg, *w_out, *g_ffn, *w_r, *b_r, *w_gu, *b_gu, *w_dn, *b_dn, *g_fin;
    float* out; char* ws;
};

typedef __bf16 bf16v2_t __attribute__((ext_vector_type(2)));
__device__ __forceinline__ unsigned cvt_pk_bf16(float lo, float hi) { bf16v2_t v = {(__bf16)lo, (__bf16)hi}; return __builtin_bit_cast(unsigned, v); }

__device__ __forceinline__ unsigned pack4_fp8(float a, float b, float c, float d) {
    a = __builtin_amdgcn_fmed3f(a, -448.f, 448.f); b = __builtin_amdgcn_fmed3f(b, -448.f, 448.f); c = __builtin_amdgcn_fmed3f(c, -448.f, 448.f); d = __builtin_amdgcn_fmed3f(d, -448.f, 448.f);
    unsigned w = 0; w = __builtin_amdgcn_cvt_pk_fp8_f32(a, b, w, false); w = __builtin_amdgcn_cvt_pk_fp8_f32(c, d, w, true); return w; }

namespace pg8 {
constexpr int BM = 256, BK = 64, HALF = 128, HTB = HALF * BK * 2, STAGE_BYTES = 8 * HTB, NXCD = 8, WGM = 8;
constexpr int LDS_IDX = STAGE_BYTES + 8192;
constexpr int LDS_BIAS = STAGE_BYTES + 8192 + 1024;
__device__ __forceinline__ int lds_byte(int r, int c) { const int st = (r >> 4) * 2 + (c >> 5), rr = r & 15, cc = c & 31, ob = rr * 64 + cc * 2; return st * 1024 + (ob ^ (((ob >> 9) & 1) << 5)); }
__device__ __forceinline__ void stage_rc(int b, int& R, int& C) { const int st = b / 1024, sb = b % 1024, swz = sb ^ (((sb >> 9) & 1) << 5); R = (st >> 1) * 16 + swz / 64; C = (st & 1) * 32 + (swz % 64) / 2; }
__device__ __forceinline__ int perm32(int rho) { const int n = rho >> 4, i = rho & 15; return 8 * (i >> 2) + 4 * n + (i & 3); }
struct Unit { int pm, pn; const char* b; int e, pos0, cnt; };

__device__ __forceinline__ int xcd_remap(int L, int nwg) { const int q = nwg / NXCD, r = nwg % NXCD, xcd = L % NXCD, off = L / NXCD; return (xcd < r ? xcd * (q + 1) : r * (q + 1) + (xcd - r) * q) + off; }

struct DenseSched {
    int nM, nN, nwg, G, c, rowb; const char* Bt; size_t btile;
    __device__ void init(int M, int N, int kbytes, int rowb_, const void* Bt_, int G_, int c_) { nM = M / BM; nN = N / BM; nwg = nM * nN; G = G_; c = c_; rowb = rowb_; Bt = (const char*)Bt_; btile = (size_t)BM * kbytes; }
    static constexpr bool GATHER_LDS = false;
    __device__ __forceinline__ int kstepA() const { return 128; }
    __device__ __forceinline__ void tile(int wgid, int& pm, int& pn) const { const int nig = WGM * nN, gid = wgid / nig, fm = gid * WGM, gsz = (nM - fm) < WGM ? (nM - fm) : WGM; pm = fm + ((wgid % nig) % gsz); pn = (wgid % nig) / gsz; }
    __device__ __forceinline__ bool next(int i, Unit& u) const { const int Lx = i * G + c; if (Lx >= nwg) return false; tile(xcd_remap(Lx, nwg), u.pm, u.pn); u.b = Bt + (size_t)u.pn * btile; u.e = 0; u.pos0 = 0; u.cnt = 0; return true; }
    __device__ __forceinline__ void aoff(const Unit& u, const int (&Rr)[2], const int (&Cc)[2], unsigned (&va)[2][2]) const {
#pragma unroll
        for (int h = 0; h < 2; ++h)
#pragma unroll
            for (int i = 0; i < 2; ++i) va[h][i] = (unsigned)((u.pm * BM + h * HALF + Rr[i]) * rowb + Cc[i] * 2); }
};
struct InSched : DenseSched {
    __device__ void init2(const void* Bt_, int G_, int c_) { init(L, 8448, 1024, 1024, Bt_, G_, c_); }
    __device__ __forceinline__ bool next(int i, Unit& u) const {
        const int Lx = i * G + c; const int nlat = nwg;
        if (Lx < nlat) { tile(xcd_remap(Lx, nlat), u.pm, u.pn); }
        else { const int j = Lx - nlat; if (j >= 16 * 14) return false; const int q = j >> 4; u.pm = 128 + (j & 15); u.pn = q == 0 ? 3 : (q <= 12 ? 7 + q : 32); }
        u.b = Bt + (size_t)u.pn * btile; u.e = 0; u.pos0 = 0; u.cnt = 0; return true; }
};
__device__ __forceinline__ unsigned act_piece_off(int r, int c16) { const int s = 2 * (r >> 7) + (c16 >> 2), w = 4 * ((r >> 6) & 1) + (c16 & 3), l = 16 * ((r >> 4) & 3) + (r & 15); return (unsigned)(((s * 8 + w) * 64 + l) * 16); }
template <bool GATHER> struct MoeSched {
    int nN, G, c, rowb; const char* Wt; size_t wexp, btile; const LAS int* tab; const int* list;
    static constexpr bool GATHER_LDS = GATHER;
    __device__ __forceinline__ int kstepA() const { return GATHER ? 128 : 32768; }
    __device__ __forceinline__ bool next(int i, Unit& u) const {
        const int nwg = tab[33] * nN; const int Lx = i * G + c; if (Lx >= nwg) return false;
        const int w = xcd_remap(Lx, nwg); const int rt = w / nN; u.pn = w % nN; u.pm = rt;
        const int e = tab[128 + rt];
        u.e = e; u.pos0 = (rt - tab[e]) * BM; u.cnt = tab[64 + e]; u.b = Wt + (size_t)e * wexp + (size_t)u.pn * btile; return true; }
    __device__ __forceinline__ void aoff(const Unit& u, const int (&Rr)[2], const int (&Cc)[2], unsigned (&va)[2][2]) const {
#pragma unroll
        for (int h = 0; h < 2; ++h)
#pragma unroll
            for (int i = 0; i < 2; ++i) {
                if (GATHER) { const int pos = u.pos0 + h * HALF + Rr[i]; const int pair = pos < u.cnt ? list[u.e * CAP + pos] : 0; va[h][i] = (unsigned)((pair >> 2) * rowb + Cc[i] * 2); }
                else va[h][i] = (unsigned)u.pm * 262144u + act_piece_off(h * HALF + Rr[i], Cc[i] >> 3); } }
};

typedef int v8i_t __attribute__((ext_vector_type(8)));
typedef int i32x4_t __attribute__((ext_vector_type(4)));
template <class Epi, class Sched, bool FP8 = false, int SCA = 127, int SCB = 127>
__device__ __forceinline__ void gemm_phase(LAS unsigned char* lds, const char* Abase, const int K, const Sched& S, const Epi& E) {
    const int tid = otid(), wid = __builtin_amdgcn_readfirstlane(tid >> 6), lane = tid & 63, wr = wid >> 2, wc = wid & 3, fr = lane & 15, fq = lane >> 4;
    const int Kb = FP8 ? K : 2 * K;
    const int nt = Kb / (BK * 2);
    int Rr[2], Cc[2]; unsigned voffB[2];
#pragma unroll
    for (int i = 0; i < 2; ++i) { int R_, C_; stage_rc(tid * 16 + i * 8192, R_, C_); Rr[i] = R_; Cc[i] = C_; const int Rb = 64 * (R_ >> 5) + (Epi::PERM ? perm32(R_ & 31) : (R_ & 31)); voffB[i] = (unsigned)(Rb * Kb + C_ * 2); }
    const size_t kstep = (size_t)(BK * 2);
    const size_t kstepA = (size_t)S.kstepA();
    const size_t hstep = (size_t)32 * Kb;
    const unsigned ldsw = (unsigned)wid * 1024u;
    const int aoff = lds_byte(wr * 64 + fr, fq * 8), boff = lds_byte(wc * 32 + fr, fq * 8);
#define PG8_SA(b, h) (((b) * 2 + (h)) * HTB)
#define PG8_SB(b, h) ((4 + (b) * 2 + (h)) * HTB)
#define PG8_STAGE_B(bufoff, gbase) do { _Pragma("unroll") for (int _i = 0; _i < 2; ++_i) \
        __builtin_amdgcn_global_load_lds((const unsigned*)((const char*)(gbase) + voffB[_i]), (LAS unsigned*)(lds + (bufoff) + ldsw + _i * 8192), 16, 0, 0); } while (0)
#define PG8_STAGE_A(bufoff, v0, v1, kb) do { \
        __builtin_amdgcn_global_load_lds((const unsigned*)(Abase + (kb) + (v0)), (LAS unsigned*)(lds + (bufoff) + ldsw), 16, 0, 0); \
        __builtin_amdgcn_global_load_lds((const unsigned*)(Abase + (kb) + (v1)), (LAS unsigned*)(lds + (bufoff) + ldsw + 8192), 16, 0, 0); } while (0)
#define PG8_LD16(addr) (*(const LAS i32x4_t*)(addr))
#define PG8_LDA(dst, b, h) do { _Pragma("unroll") for (int m = 0; m < 4; ++m) { if constexpr (FP8) dst##8[m] = __builtin_shufflevector(PG8_LD16(lds + PG8_SA(b, h) + aoff + m * 2048), PG8_LD16(lds + PG8_SA(b, h) + aoff + m * 2048 + 1024), 0, 1, 2, 3, 4, 5, 6, 7); \
        else { _Pragma("unroll") for (int k = 0; k < 2; ++k) dst[m][k] = *(const LAS bf16x8*)(lds + PG8_SA(b, h) + aoff + m * 2048 + k * 1024); } } } while (0)
#define PG8_LDB(dst, b, h) do { _Pragma("unroll") for (int n = 0; n < 2; ++n) { if constexpr (FP8) dst##8[n] = __builtin_shufflevector(PG8_LD16(lds + PG8_SB(b, h) + boff + n * 2048), PG8_LD16(lds + PG8_SB(b, h) + boff + n * 2048 + 1024), 0, 1, 2, 3, 4, 5, 6, 7); \
        else { _Pragma("unroll") for (int k = 0; k < 2; ++k) dst[n][k] = *(const LAS bf16x8*)(lds + PG8_SB(b, h) + boff + n * 2048 + k * 1024); } } } while (0)
#define PG8_MMA(ai, bj, At, Bt) do { __builtin_amdgcn_s_setprio(1); _Pragma("unroll") for (int m = 0; m < 4; ++m) _Pragma("unroll") for (int n = 0; n < 2; ++n) { \
        if constexpr (FP8) asm volatile("v_mfma_scale_f32_16x16x128_f8f6f4 %0, %1, %2, %0, %3, %4 op_sel_hi:[0,0,0]" : "+v"(acc[ai][bj][m][n]) : "v"(Bt##8[n]), "v"(At##8[m]), "v"(scb_), "v"(sca_)); \
        else { _Pragma("unroll") for (int k = 0; k < 2; ++k) acc[ai][bj][m][n] = __builtin_amdgcn_mfma_f32_16x16x32_bf16(Bt[n][k], At[m][k], acc[ai][bj][m][n], 0, 0, 0); } } \
        __builtin_amdgcn_s_setprio(0); } while (0)
#define PG8_WAIT_V(n) asm volatile("s_waitcnt vmcnt(" #n ")" ::: "memory")
#define PG8_WAIT_L(n) asm volatile("s_waitcnt lgkmcnt(" #n ")" ::: "memory")
#define PG8_BAR __builtin_amdgcn_s_barrier()
#define PG8_SCHED __builtin_amdgcn_sched_barrier(0)
    Unit cur, nxt; int ui = 0;
    if (!S.next(0, cur)) return;
    f32x4 acc[2][2][4][2];
#pragma unroll
    for (int a = 0; a < 2; ++a)
#pragma unroll
        for (int b = 0; b < 2; ++b)
#pragma unroll
            for (int m = 0; m < 4; ++m)
#pragma unroll
                for (int n = 0; n < 2; ++n) acc[a][b][m][n] = (f32x4){0.f, 0.f, 0.f, 0.f};
    const int sca_ = SCA, scb_ = SCB;
    bf16x8 At[4][2], B0[2][2], B1[2][2]; v8i_t At8[4], B08[2], B18[2];
    unsigned vc[2][2], vn[2][2];
    S.aoff(cur, Rr, Cc, vc);
    const char* cB = cur.b;
    int bsl = 0;
    if constexpr (Epi::BIAS_LDS) E.stage(cur, lds + LDS_BIAS, tid);
    PG8_STAGE_B(PG8_SB(0, 0), cB); PG8_STAGE_A(PG8_SA(0, 0), vc[0][0], vc[0][1], 0); PG8_STAGE_B(PG8_SB(0, 1), cB + hstep); PG8_STAGE_A(PG8_SA(0, 1), vc[1][0], vc[1][1], 0);
    PG8_STAGE_B(PG8_SB(1, 0), cB + kstep); PG8_STAGE_A(PG8_SA(1, 0), vc[0][0], vc[0][1], kstepA); PG8_STAGE_B(PG8_SB(1, 1), cB + hstep + kstep);
    PG8_WAIT_V(6); PG8_BAR;
    if (wr == 1) PG8_BAR;
    for (;;) {
        const bool has_next = S.next(ui + 1, nxt);
        if constexpr (Sched::GATHER_LDS) {
            if (has_next && wid < 4) __builtin_amdgcn_global_load_lds((const unsigned*)(S.list + nxt.e * CAP + nxt.pos0 + otid()), (LAS unsigned*)(lds + LDS_IDX + wid * 256), 4, 0, 0);
        } else if (has_next) S.aoff(nxt, Rr, Cc, vn);
        if (!has_next) {
#pragma unroll
            for (int h = 0; h < 2; ++h)
#pragma unroll
                for (int i = 0; i < 2; ++i) vn[h][i] = vc[h][i]; }
        const char* nB = has_next ? nxt.b : cB;
        const int bsn = bsl == 2 ? 0 : bsl + 1;
        if constexpr (Epi::BIAS_LDS) { if (has_next) E.stage(nxt, lds + LDS_BIAS + bsn * 2048, otid()); }
#pragma unroll 1
        for (int t = 0; t < nt; t += 2) {
            const bool last = (t == nt - 2);
            if constexpr (Sched::GATHER_LDS) { if (last && has_next) {
#pragma unroll
                for (int h = 0; h < 2; ++h)
#pragma unroll
                    for (int i = 0; i < 2; ++i) { const int rr = h * HALF + Rr[i]; const int pair = (nxt.pos0 + rr) < nxt.cnt ? ((const LAS int*)(lds + LDS_IDX))[rr] : 0; vn[h][i] = (unsigned)((pair >> 2) * S.rowb + Cc[i] * 2); } } }
            const size_t k1 = (size_t)(t + 1) * kstepA;
            const size_t k2 = last ? 0 : (size_t)(t + 2) * kstepA;
            const unsigned s00 = last ? vn[0][0] : vc[0][0], s01 = last ? vn[0][1] : vc[0][1], s10 = last ? vn[1][0] : vc[1][0], s11 = last ? vn[1][1] : vc[1][1];
            const char* b2 = last ? nB : cB + (size_t)(t + 2) * kstep; const char* b3 = b2 + kstep;
            PG8_LDB(B0, 0, 0); PG8_LDB(B1, 0, 1); PG8_SCHED; PG8_LDA(At, 0, 0); PG8_STAGE_A(PG8_SA(1, 1), vc[1][0], vc[1][1], k1);
            PG8_WAIT_L(0); PG8_BAR; PG8_MMA(0, 0, At, B0); PG8_MMA(0, 1, At, B1); PG8_BAR; PG8_SCHED;
            PG8_LDA(At, 0, 1); PG8_SCHED; PG8_STAGE_B(PG8_SB(0, 0), b2); PG8_SCHED; PG8_STAGE_A(PG8_SA(0, 0), s00, s01, k2); PG8_SCHED; PG8_STAGE_B(PG8_SB(0, 1), b2 + hstep);
            PG8_WAIT_L(0); PG8_WAIT_V(6); PG8_BAR; PG8_MMA(1, 0, At, B0); PG8_MMA(1, 1, At, B1); PG8_BAR; PG8_SCHED;
            PG8_LDB(B0, 1, 0); PG8_LDB(B1, 1, 1); PG8_SCHED; PG8_LDA(At, 1, 0); PG8_STAGE_A(PG8_SA(0, 1), s10, s11, k2);
            PG8_WAIT_L(0); PG8_BAR; PG8_MMA(0, 0, At, B0); PG8_MMA(0, 1, At, B1); PG8_BAR; PG8_SCHED;
            PG8_LDA(At, 1, 1); PG8_SCHED; PG8_STAGE_B(PG8_SB(1, 0), b3); PG8_SCHED; PG8_STAGE_A(PG8_SA(1, 0), s00, s01, k2 + kstepA); PG8_SCHED; PG8_STAGE_B(PG8_SB(1, 1), b3 + hstep);
            PG8_WAIT_L(0); PG8_WAIT_V(6); PG8_BAR; PG8_MMA(1, 0, At, B0); PG8_MMA(1, 1, At, B1); PG8_BAR; PG8_SCHED;
        }
        if constexpr (FP8) asm volatile("s_nop 15\n\ts_nop 15" ::: "memory");
        E(acc, cur, wr, wc, fr, fq, (const LAS float*)(lds + LDS_BIAS + bsl * 2048));
        if (!has_next) break;
#pragma unroll
        for (int a = 0; a < 2; ++a)
#pragma unroll
            for (int b = 0; b < 2; ++b)
#pragma unroll
                for (int m = 0; m < 4; ++m)
#pragma unroll
                    for (int n = 0; n < 2; ++n) acc[a][b][m][n] = (f32x4){0.f, 0.f, 0.f, 0.f};
        cur = nxt; cB = nB; ++ui; bsl = bsn;
#pragma unroll
        for (int h = 0; h < 2; ++h)
#pragma unroll
            for (int i = 0; i < 2; ++i) vc[h][i] = vn[h][i];
    }
    PG8_WAIT_V(0);
    if (wr == 0) PG8_BAR;
    PG8_BAR;
#undef PG8_SA
#undef PG8_SB
#undef PG8_STAGE_A
#undef PG8_STAGE_B
#undef PG8_LDA
#undef PG8_LDB
#undef PG8_MMA
#undef PG8_WAIT_V
#undef PG8_WAIT_L
#undef PG8_BAR
#undef PG8_SCHED
}

typedef f32x4 Acc[2][2][4][2];
__device__ __forceinline__ unsigned dpp_ror8(unsigned x) { return (unsigned)__builtin_amdgcn_update_dpp(0, (int)x, 0x128, 0xf, 0xf, false); }
__device__ __forceinline__ u32x4 ror8_4(const u32x4 v) { u32x4 r; r.x = dpp_ror8(v.x); r.y = dpp_ror8(v.y); r.z = dpp_ror8(v.z); r.w = dpp_ror8(v.w); return r; }
__device__ __forceinline__ void line_xy(const u32x4 a, const u32x4 b, bool lo, u32x4& X, u32x4& Y) { const u32x4 ra = ror8_4(a), rb = ror8_4(b); X = lo ? a : rb; Y = lo ? ra : b; }
__device__ __forceinline__ u32x4 pack8(const f32x4 v0, const f32x4 v1) { u32x4 w; w.x = cvt_pk_bf16(v0[0], v0[1]); w.y = cvt_pk_bf16(v0[2], v0[3]); w.z = cvt_pk_bf16(v1[0], v1[1]); w.w = cvt_pk_bf16(v1[2], v1[3]); return w; }

struct EpiIn { static constexpr bool PERM = true; static constexpr bool BIAS_LDS = false; char* ws;
    __device__ __forceinline__ void operator()(const Acc& acc, const Unit& u, int wr, int wc, int fr, int fq, const LAS float* bl_) const {
        const int pn = u.pn; size_t boff; int ld, cb;
        if (pn < 3) { boff = OFF_QA; ld = 384; cb = pn * 128; } else if (pn == 3) { boff = OFF_CKV; ld = 256; cb = 0; }
        else if (pn < 32) { boff = OFF_HQ + (size_t)((pn - 4) >> 2) * SEG_STRIDE; ld = 1024; cb = ((pn - 4) & 3) * 256; }
        else { boff = OFF_KR; ld = 64; cb = 0; }
        bf16_t* base = (bf16_t*)(ws + boff);
        if (pn == 32 && wc != 0) return;
        const bool lo = fr < 8; const int rowb0 = u.pm * BM + wr * 64, rx = fr & 7, colx = cb + wc * 64 + (fr >> 3) * 32 + 8 * fq;
        float* ssq = (float*)(ws + (pn < 3 ? OFF_SSQQ : OFF_SSQKV));
#pragma unroll
        for (int ai = 0; ai < 2; ++ai)
#pragma unroll
            for (int m = 0; m < 4; ++m) { const int rg = rowb0 + ai * HALF + m * 16;
                f32x4 v0 = acc[ai][0][m][0], v1 = acc[ai][0][m][1], w0 = acc[ai][1][m][0], w1 = acc[ai][1][m][1];
                if (pn >= 4 && pn < 8) {
#pragma unroll
                    for (int j = 0; j < 4; ++j) { v0[j] = siluf_(v0[j]) * 0.08838834764831845f; v1[j] = siluf_(v1[j]) * 0.08838834764831845f; w0[j] = siluf_(w0[j]) * 0.08838834764831845f; w1[j] = siluf_(w1[j]) * 0.08838834764831845f; } }
                if (pn <= 3 || (pn >= 20 && pn < 32)) { const int c16 = wc * 64 + ((fq & 1) ? 32 : 0) + 16 * (fq >> 1);
                    unsigned char* qrow = pn < 3 ? (unsigned char*)base + (size_t)(rg + fr) * 768 + pn * 256 + c16 : (pn == 3 ? (unsigned char*)base + (size_t)(rg + fr) * 256 + c16 : (unsigned char*)base + (size_t)(rg + fr) * 1024 + (pn & 3) * 256 + c16);
                    const unsigned ax = pack4_fp8(v0[0], v0[1], v0[2], v0[3]), ay = pack4_fp8(v1[0], v1[1], v1[2], v1[3]), bx = pack4_fp8(w0[0], w0[1], w0[2], w0[3]), by = pack4_fp8(w1[0], w1[1], w1[2], w1[3]);
                    const auto s0 = __builtin_amdgcn_permlane16_swap(ax, bx, false, false); const auto s1 = __builtin_amdgcn_permlane16_swap(ay, by, false, false);
                    *(u32x4*)qrow = (u32x4){s0[0], s1[0], s0[1], s1[1]}; }
                else { u32x4 X, Y; line_xy(pack8(v0, v1), pack8(w0, w1), lo, X, Y);
                    __builtin_nontemporal_store(X, (u32x4*)(base + (size_t)(rg + rx) * ld + colx)); __builtin_nontemporal_store(Y, (u32x4*)(base + (size_t)(rg + 8 + rx) * ld + colx)); }
                if (pn <= 3) { float ss = (v0[0] * v0[0] + v0[1] * v0[1]) + (v0[2] * v0[2] + v0[3] * v0[3]) + (v1[0] * v1[0] + v1[1] * v1[1]) + (v1[2] * v1[2] + v1[3] * v1[3])
                                        + (w0[0] * w0[0] + w0[1] * w0[1]) + (w0[2] * w0[2] + w0[3] * w0[3]) + (w1[0] * w1[0] + w1[1] * w1[1]) + (w1[2] * w1[2] + w1[3] * w1[3]);
                    ss += __shfl_xor(ss, 16); ss += __shfl_xor(ss, 32); if (fq == 0) atomicAdd(ssq + rg + fr, ss); } }
    } };

struct EpiQ { static constexpr bool PERM = true; static constexpr bool BIAS_LDS = true; unsigned char* q; const float* ssq;
    __device__ __forceinline__ void stage(const Unit& u, LAS unsigned char* dst, int tid) const {
        if (tid < 256) __builtin_amdgcn_global_load_lds((const unsigned*)(ssq + u.pm * BM + tid), (LAS unsigned*)(dst + (tid >> 6) * 256), 4, 0, 0); }
    __device__ __forceinline__ void operator()(const Acc& acc, const Unit& u, int wr, int wc, int fr, int fq, const LAS float* bl_) const {
        const int rowb0 = u.pm * BM + wr * 64, col = u.pn * BM + wc * 64 + ((fq & 1) ? 32 : 0) + 16 * (fq >> 1);
#pragma unroll
        for (int ai = 0; ai < 2; ++ai)
#pragma unroll
            for (int m = 0; m < 4; ++m) { const int rg = rowb0 + ai * HALF + m * 16; const float rs = rsqrtf(bl_[wr * 64 + ai * HALF + m * 16 + fr] * (1.0f / 768.0f) + EPS) * (0.07216878364870322f * 1.4426950408889634f * 8.0f);
                const f32x4 a0 = acc[ai][0][m][0] * rs, a1 = acc[ai][0][m][1] * rs, b0 = acc[ai][1][m][0] * rs, b1 = acc[ai][1][m][1] * rs;
                const unsigned ax = pack4_fp8(a0[0], a0[1], a0[2], a0[3]), ay = pack4_fp8(a1[0], a1[1], a1[2], a1[3]), bx = pack4_fp8(b0[0], b0[1], b0[2], b0[3]), by = pack4_fp8(b1[0], b1[1], b1[2], b1[3]);
                const auto s0 = __builtin_amdgcn_permlane16_swap(ax, bx, false, false); const auto s1 = __builtin_amdgcn_permlane16_swap(ay, by, false, false);
                *(u32x4*)(q + (size_t)(rg + fr) * 1536 + col) = (u32x4){s0[0], s1[0], s0[1], s1[1]}; }
    } };

struct EpiKV { static constexpr bool PERM = true; static constexpr bool BIAS_LDS = true; unsigned char *Kb, *Vb; const float* ssq;
    __device__ __forceinline__ void stage(const Unit& u, LAS unsigned char* dst, int tid) const {
        if (tid < 256) __builtin_amdgcn_global_load_lds((const unsigned*)(ssq + u.pm * BM + tid), (LAS unsigned*)(dst + (tid >> 6) * 256), 4, 0, 0); }
    __device__ __forceinline__ size_t kvrow(int row, int h) const { int b, pos; if (row < L) { b = row >> 11; pos = row & 2047; } else { b = (row - L) >> 8; pos = SEQ + ((row - L) & 255); } return (size_t)(b * 8 + h) * NKEY + pos; }
    __device__ __forceinline__ void operator()(const Acc& acc, const Unit& u, int wr, int wc, int fr, int fq, const LAS float* bl_) const {
        const int rowb0 = u.pm * BM + wr * 64, col = (wc & 1) * 64 + ((fq & 1) ? 32 : 0) + 16 * (fq >> 1);
        unsigned char* dst = wc < 2 ? Kb : Vb; const int ld = wc < 2 ? 192 : 128;
#pragma unroll
        for (int ai = 0; ai < 2; ++ai)
#pragma unroll
            for (int m = 0; m < 4; ++m) { const int rg = rowb0 + ai * HALF + m * 16; const float rs = rsqrtf(bl_[wr * 64 + ai * HALF + m * 16 + fr] * (1.0f / 256.0f) + EPS);
                const f32x4 a0 = acc[ai][0][m][0] * rs, a1 = acc[ai][0][m][1] * rs, b0 = acc[ai][1][m][0] * rs, b1 = acc[ai][1][m][1] * rs;
                const unsigned ax = pack4_fp8(a0[0], a0[1], a0[2], a0[3]), ay = pack4_fp8(a1[0], a1[1], a1[2], a1[3]), bx = pack4_fp8(b0[0], b0[1], b0[2], b0[3]), by = pack4_fp8(b1[0], b1[1], b1[2], b1[3]);
                const auto s0 = __builtin_amdgcn_permlane16_swap(ax, bx, false, false); const auto s1 = __builtin_amdgcn_permlane16_swap(ay, by, false, false);
                *(u32x4*)(dst + kvrow(rg + fr, u.pn) * ld + col) = (u32x4){s0[0], s1[0], s0[1], s1[1]}; }
    } };

struct EpiOut { static constexpr bool PERM = true; static constexpr bool BIAS_LDS = false; bf16_t* x1; const float* x; const float* modv;
    __device__ __forceinline__ void operator()(const Acc& acc, const Unit& u, int wr, int wc, int fr, int fq, const LAS float* bl_) const {
        const bool lo = fr < 8; const int rowb0 = u.pm * BM + wr * 64, rx = fr & 7, colx = u.pn * BM + wc * 64 + (fr >> 3) * 32 + 8 * fq, cown = u.pn * BM + wc * 64 + 8 * fq;
        const float* gate = modv + (rowb0 >> 11) * 6144 + 2 * 1024 + cown; f32x4 gt[2][2];
#pragma unroll
        for (int bj = 0; bj < 2; ++bj)
#pragma unroll
            for (int n = 0; n < 2; ++n) gt[bj][n] = *(const f32x4*)(gate + bj * 32 + 4 * n);
        f32x4 xr[2][2][2];
        auto ldx = [&](int g, int buf) { const float* xp = x + (size_t)(rowb0 + (g >> 2) * HALF + (g & 3) * 16 + fr) * D + cown;
#pragma unroll
            for (int bj = 0; bj < 2; ++bj)
#pragma unroll
                for (int n = 0; n < 2; ++n) xr[buf][bj][n] = *(const f32x4*)(xp + bj * 32 + 4 * n); };
        ldx(0, 0);
#pragma unroll
        for (int g = 0; g < 8; ++g) { const int ai = g >> 2, m = g & 3, rg = rowb0 + ai * HALF + m * 16, buf = g & 1;
            if (g < 7) ldx(g + 1, buf ^ 1);
            f32x4 r[2][2];
#pragma unroll
            for (int bj = 0; bj < 2; ++bj)
#pragma unroll
                for (int n = 0; n < 2; ++n) r[bj][n] = xr[buf][bj][n] + gt[bj][n] * acc[ai][bj][m][n];
            u32x4 X, Y; line_xy(pack8(r[0][0], r[0][1]), pack8(r[1][0], r[1][1]), lo, X, Y);
            *(u32x4*)(x1 + (size_t)(rg + rx) * D + colx) = X; *(u32x4*)(x1 + (size_t)(rg + 8 + rx) * D + colx) = Y; }
    } };

struct EpiMoe1 { static constexpr bool PERM = true; static constexpr bool BIAS_LDS = true; unsigned char* act; const float* bgu;
    __device__ __forceinline__ void stage(const Unit& u, LAS unsigned char* dst, int tid) const {
        if (tid < 256) __builtin_amdgcn_global_load_lds((const unsigned*)(bgu + u.e * 2048 + u.pn * 256 + tid), (LAS unsigned*)(dst + (tid >> 6) * 256), 4, 0, 0); }
    __device__ __forceinline__ void operator()(const Acc& acc, const Unit& u, int wr, int wc, int fr, int fq, const LAS float* bl_) const {
        const int o0 = u.pn * 128 + wc * 16 + 4 * fq;
        f32x4 bg[2], bl[2];
#pragma unroll
        for (int bj = 0; bj < 2; ++bj) { const LAS float* bp = bl_ + 2 * (wc * 16 + 4 * fq + bj * 64); const f32x4 t0 = *(const LAS f32x4*)bp, t1 = *(const LAS f32x4*)(bp + 4);
            bg[bj] = (f32x4){t0[0], t0[2], t1[0], t1[2]}; bl[bj] = (f32x4){t0[1], t0[3], t1[1], t1[3]}; }
        unsigned char* blk = act + ((size_t)u.pm * 8 + u.pn) * 32768 + (size_t)(wr * 4 + wc) * 1024 + (size_t)(fq * 16 + fr) * 16;
#pragma unroll
        for (int ai = 0; ai < 2; ++ai)
#pragma unroll
            for (int bj = 0; bj < 2; ++bj) { unsigned d[4];
#pragma unroll
                for (int m = 0; m < 4; ++m) { const f32x4 g4 = acc[ai][bj][m][0] + bg[bj], l4 = acc[ai][bj][m][1] + bl[bj]; f32x2 r[2];
#pragma unroll
                    for (int j = 0; j < 2; ++j) {
                        const f32x2 glu = {fminf(g4[2 * j], 7.0f), fminf(g4[2 * j + 1], 7.0f)}, lin = {__builtin_amdgcn_fmed3f(l4[2 * j], -7.0f, 7.0f), __builtin_amdgcn_fmed3f(l4[2 * j + 1], -7.0f, 7.0f)};
                        const f32x2 t = glu * -2.4554669595930157f; const f32x2 den = (f32x2){__builtin_amdgcn_exp2f(t[0]), __builtin_amdgcn_exp2f(t[1])} + 1.0f;
                        const f32x2 rc = {__builtin_amdgcn_rcpf(den[0]), __builtin_amdgcn_rcpf(den[1])}; r[j] = glu * rc * (lin * 4.0f + 4.0f); }
                    unsigned w = 0; w = __builtin_amdgcn_cvt_pk_fp8_f32(r[0][0], r[0][1], w, false); w = __builtin_amdgcn_cvt_pk_fp8_f32(r[1][0], r[1][1], w, true); d[m] = w; }
                const auto s01 = __builtin_amdgcn_permlane16_swap(d[0], d[1], false, false); const auto s23 = __builtin_amdgcn_permlane16_swap(d[2], d[3], false, false);
                const auto t02 = __builtin_amdgcn_permlane32_swap(s01[0], s23[0], false, false); const auto t13 = __builtin_amdgcn_permlane32_swap(s01[1], s23[1], false, false);
                *(u32x4*)(blk + (size_t)(ai * 2 + bj) * 8192) = (u32x4){t02[0], t13[0], t02[1], t13[1]}; }
    } };

struct EpiMoe2 { static constexpr bool PERM = true; static constexpr bool BIAS_LDS = true; unsigned char* yp; const float* bd;
    __device__ __forceinline__ void stage(const Unit& u, LAS unsigned char* dst, int tid) const {
        if (tid < 256) __builtin_amdgcn_global_load_lds((const unsigned*)(bd + u.e * 1024 + u.pn * 256 + tid), (LAS unsigned*)(dst + (tid >> 6) * 256), 4, 0, 0); }
    __device__ __forceinline__ void operator()(const Acc& acc, const Unit& u, int wr, int wc, int fr, int fq, const LAS float* bl_) const {
        const int rowb0 = u.pm * BM + wr * 64, col = u.pn * BM + wc * 64 + ((fq & 1) ? 32 : 0) + 16 * (fq >> 1);
        f32x4 bv[2][2];
#pragma unroll
        for (int bj = 0; bj < 2; ++bj)
#pragma unroll
            for (int n = 0; n < 2; ++n) bv[bj][n] = *(const LAS f32x4*)(bl_ + wc * 64 + 8 * fq + bj * 32 + 4 * n);
#pragma unroll
        for (int ai = 0; ai < 2; ++ai)
#pragma unroll
            for (int m = 0; m < 4; ++m) { const int rg = rowb0 + ai * HALF + m * 16;
                const f32x4 a0 = (acc[ai][0][m][0] + bv[0][0]) * 8.0f, a1 = (acc[ai][0][m][1] + bv[0][1]) * 8.0f, b0 = (acc[ai][1][m][0] + bv[1][0]) * 8.0f, b1 = (acc[ai][1][m][1] + bv[1][1]) * 8.0f;
                const unsigned ax = pack4_fp8(a0[0], a0[1], a0[2], a0[3]), ay = pack4_fp8(a1[0], a1[1], a1[2], a1[3]), bx = pack4_fp8(b0[0], b0[1], b0[2], b0[3]), by = pack4_fp8(b1[0], b1[1], b1[2], b1[3]);
                const auto s0 = __builtin_amdgcn_permlane16_swap(ax, bx, false, false); const auto s1 = __builtin_amdgcn_permlane16_swap(ay, by, false, false);
                __builtin_nontemporal_store((u32x4){s0[0], s1[0], s0[1], s1[1]}, (u32x4*)(yp + (size_t)(rg + fr) * 1024 + col)); }
    } };
}

__device__ __forceinline__ int conv_src_col(int kind, int c) {
    if (kind == 0) return c;
    if (kind == 1) { if (c < 1024) return c; if (c < 8192) return c + 64; if (c < 8256) return c - 8192 + 1024; return -1; }
    const int pn = c >> 8, p = c & 255, wc = p >> 6, bj = (p >> 5) & 1, fq = (p >> 3) & 3, n = (p >> 2) & 1, i = p & 3; const int o = 128 * pn + 64 * bj + 16 * wc + 4 * fq + i; return 2 * o + n;
}
__device__ __forceinline__ void lds_sync() { asm volatile("s_waitcnt lgkmcnt(0)\n\ts_barrier" ::: "memory"); }
template <bool F8> struct ConvPipe {
    float v[32]; bool have; bf16_t* dummy;
    int K, kind, k0, c0; void* Wt;
    __device__ __forceinline__ void issue(const float* __restrict__ W, int ldw, void* Wt_, int K_, int kind_, const float* __restrict__ kscale, int k0_, int c0_) {
        const int tid = otid(); const int cc = tid & 127, kq = tid >> 7, sc = conv_src_col(kind_, c0_ + cc);
        const int scc = sc < 0 ? 0 : sc; const float* wp = W + (size_t)(k0_ + kq) * ldw + scc;
#pragma unroll
        for (int i = 0; i < 32; ++i) v[i] = __builtin_nontemporal_load(wp + (size_t)(4 * i) * ldw);
        if (sc < 0) {
#pragma unroll
            for (int i = 0; i < 32; ++i) v[i] = 0.f; }
        if (kscale) {
#pragma unroll
            for (int i = 0; i < 32; ++i) v[i] *= kscale[k0_ + kq + 4 * i]; }
        K = K_; kind = kind_; k0 = k0_; c0 = c0_; Wt = Wt_; have = true;
    }
    __device__ __forceinline__ void flush(LAS float* tl) {
        if (!have) return; have = false;
        const int tid = otid(); const int cc = tid & 127, kq = tid >> 7;
        __syncthreads();
#pragma unroll
        for (int i = 0; i < 32; ++i) tl[(kq + 4 * i) * 129 + cc] = v[i];
        __syncthreads();
        stash(tl, tid);
    }
    __device__ __forceinline__ void to_lds(LAS float* tl) { const int tid = otid(); const int cc = tid & 127, kq = tid >> 7; lds_sync();
#pragma unroll
        for (int i = 0; i < 32; ++i) tl[(kq + 4 * i) * 129 + cc] = v[i];
        lds_sync(); }
    __device__ __forceinline__ void stash(LAS float* tl, int tid) const {
        if constexpr (F8) {
#pragma unroll
            for (int pss = 0; pss < 2; ++pss) { const int item = tid + 512 * pss, c2 = item >> 3, ch = item & 7; float t[16];
#pragma unroll
                for (int j = 0; j < 16; ++j) t[j] = tl[(16 * ch + j) * 129 + c2] * 32.f;
                u32x4 w; w.x = pack4_fp8(t[0], t[1], t[2], t[3]); w.y = pack4_fp8(t[4], t[5], t[6], t[7]); w.z = pack4_fp8(t[8], t[9], t[10], t[11]); w.w = pack4_fp8(t[12], t[13], t[14], t[15]);
                *(u32x4*)((unsigned char*)Wt + (size_t)(c0 + c2) * K + k0 + 16 * ch) = w; }
        } else {
#pragma unroll
            for (int pss = 0; pss < 4; ++pss) { const int item = tid + 512 * pss, c2 = item >> 4, ch = item & 15; float t[8];
#pragma unroll
                for (int j = 0; j < 8; ++j) t[j] = tl[(8 * ch + j) * 129 + c2];
                u32x4 w; w.x = cvt_pk_bf16(t[0], t[1]); w.y = cvt_pk_bf16(t[2], t[3]); w.z = cvt_pk_bf16(t[4], t[5]); w.w = cvt_pk_bf16(t[6], t[7]);
                *(u32x4*)((bf16_t*)Wt + (size_t)(c0 + c2) * K + k0 + 8 * ch) = w; }
        }
    }
};
template <bool F8>
__device__ __forceinline__ void conv_matrix(LAS float* tl, ConvPipe<F8>& pipe, const float* W, int ldw, void* Wt, int K, int Nout, int kind, const float* kscale, int& tctr) {
    const int nk = K / 128, ntile = nk * (Nout / 128);
    int t = ((int)blockIdx.x - tctr) % (int)gridDim.x; if (t < 0) t += gridDim.x;
    for (; t < ntile; t += gridDim.x) {
        if (pipe.have) { pipe.to_lds(tl); const int K0 = pipe.K, k00 = pipe.k0, c00 = pipe.c0; void* W0 = pipe.Wt; ConvPipe<F8> done = pipe; (void)K0; (void)k00; (void)c00; (void)W0;
            pipe.issue(W, ldw, Wt, K, kind, kscale, (t % nk) * 128, (t / nk) * 128); done.stash(tl, otid()); }
        else pipe.issue(W, ldw, Wt, K, kind, kscale, (t % nk) * 128, (t / nk) * 128);
    }
    tctr = (tctr + ntile) % (int)gridDim.x;
}
template <bool F8> __device__ __forceinline__ void conv_finish(LAS float* tl, ConvPipe<F8>& pipe) { if (pipe.have) { pipe.to_lds(tl); pipe.stash(tl, otid()); pipe.have = false; } __syncthreads(); }

__device__ __forceinline__ float half_sum256(float v, LAS float* red) {
    for (int o = 32; o > 0; o >>= 1) v += __shfl_xor(v, o);
    const int w = otid() >> 6, hb = (otid() >> 8) * 4; if ((otid() & 63) == 0) red[w] = v; __syncthreads();
    const float t = red[hb] + red[hb + 1] + red[hb + 2] + red[hb + 3]; __syncthreads(); return t;
}

__device__ __forceinline__ void phase0(const Params& p, LAS unsigned char* lds) {
    char* ws = p.ws; const int tid = otid(), gsz = gridDim.x * 512, gid = blockIdx.x * 512 + tid;
    float* lb = (float*)(ws + OFF_LB); int* cnt = (int*)(ws + OFF_CNT); float* ssqq = (float*)(ws + OFF_SSQQ); float* ssqkv = (float*)(ws + OFF_SSQKV); float* modv = (float*)(ws + OFF_MOD);
    for (int i = gid; i < 2048; i += gsz) { const int d = i >> 10, j = i & 1023; const float a = p.lbl[(d * 2 + 0) * 1024 + j], b = p.lbl[(d * 2 + 1) * 1024 + j]; lb[i] = 1.0f / (1.0f + __expf(b - a)); }
    for (int i = gid; i < 32; i += gsz) cnt[i] = 0;
    { float* ropet = (float*)(ws + OFF_ROPE); for (int i = gid; i < SEQ * 32; i += gsz) { const int t = i >> 5, j = i & 31; float cs, sn; rope_cs(t, j, cs, sn); ropet[t * 64 + j] = cs; ropet[t * 64 + 32 + j] = sn; } }
    for (int i = gid; i < L; i += gsz) ssqq[i] = 0.f;
    for (int i = gid; i < R; i += gsz) ssqkv[i] = 0.f;
    { LAS float* sil = (LAS float*)lds;
      LAS float* part = (LAS float*)(lds + 17 * 1024 * 4);
      bool loaded = false;
      for (int item = blockIdx.x; item < 192; item += gridDim.x) {
          if (!loaded) { for (int i = tid; i < 17 * 1024; i += 512) { const int r = i >> 10, k = i & 1023; sil[i] = siluf_(r < 16 ? p.c[r * 1024 + k] : p.cctx[k]); } loaded = true; __syncthreads(); }
          const int j = tid & 31, ks = tid >> 5; float a[17];
#pragma unroll
          for (int r = 0; r < 17; ++r) a[r] = 0.f;
#pragma unroll 4
          for (int k = ks * 64; k < ks * 64 + 64; ++k) { const float w = p.w_mod[(size_t)k * 6144 + item * 32 + j];
#pragma unroll
              for (int r = 0; r < 17; ++r) a[r] += sil[r * 1024 + k] * w; }
#pragma unroll
          for (int r = 0; r < 17; ++r) part[(ks * 17 + r) * 32 + j] = a[r];
          __syncthreads();
          for (int i = tid; i < 17 * 32; i += 512) { const int r = i >> 5, jj = i & 31; float s = p.b_mod[item * 32 + jj]; for (int q = 0; q < 16; ++q) s += part[(q * 17 + r) * 32 + jj]; modv[r * 6144 + item * 32 + jj] = s; }
          __syncthreads();
      } }
    __syncthreads();
    { LAS float* tl = (LAS float*)lds; int tctr = 0;
      { ConvPipe<true> pp; pp.have = false; conv_matrix<true>(tl, pp, p.w_in, 8256, (unsigned char*)(ws + OFF_WT_IN), 1024, 8448, 1, nullptr, tctr); conv_finish<true>(tl, pp); }
      { ConvPipe<true> pp; pp.have = false;
        conv_matrix<true>(tl, pp, p.w_qb, 1536, (unsigned char*)(ws + OFF_WT_QB), 768, 1536, 0, p.g_q, tctr);
        conv_matrix<true>(tl, pp, p.w_out, 1024, (unsigned char*)(ws + OFF_WT_OUT), 1024, 1024, 0, nullptr, tctr);
        conv_matrix<true>(tl, pp, p.w_kvb, 2048, (unsigned char*)(ws + OFF_WT_KVB), 256, 2048, 0, p.g_kv, tctr); conv_finish<true>(tl, pp); } }
}

__device__ __forceinline__ float wave_sum(float v) {
#pragma unroll
    for (int o = 32; o > 0; o >>= 1) v += __shfl_xor(v, o);
    return v; }
__device__ __forceinline__ void phase1(const Params& p, LAS unsigned char* lds) {
    const float* modv = (const float*)(p.ws + OFF_MOD); unsigned char* h = (unsigned char*)(p.ws + OFF_H);
    const int tid = otid(), lane = tid & 63, gw = blockIdx.x * 8 + (tid >> 6), nw = gridDim.x * 8, c0 = lane * 8;
    f32x4 g[4];
#pragma unroll
    for (int q = 0; q < 4; ++q) g[q] = *(const f32x4*)(p.g_mix + (q >> 1) * 512 + c0 + (q & 1) * 4);
    for (int row0 = gw; row0 < R; row0 += 4 * nw) {
        f32x4 v[4][4];
#pragma unroll
        for (int u = 0; u < 4; ++u) { const int row = row0 + u * nw < R ? row0 + u * nw : row0; const float* src = row < L ? p.x + (size_t)row * D : p.ctx + (size_t)(row - L) * D;
#pragma unroll
            for (int q = 0; q < 4; ++q) v[u][q] = __builtin_nontemporal_load((const f32x4*)(src + (q >> 1) * 512 + c0 + (q & 1) * 4)); }
#pragma unroll
        for (int u = 0; u < 4; ++u) { if (row0 + u * nw >= R) break; const int row = row0 + u * nw; const float* mod = modv + (row < L ? row / SEQ : 16) * 6144;
            float ss = 0.f;
#pragma unroll
            for (int q = 0; q < 4; ++q) ss += (v[u][q][0] * v[u][q][0] + v[u][q][1] * v[u][q][1]) + (v[u][q][2] * v[u][q][2] + v[u][q][3] * v[u][q][3]);
            const float rs = rsqrtf(wave_sum(ss) * (1.0f / D) + EPS);
#pragma unroll
            for (int j = 0; j < 2; ++j) { f32x4 o[2];
#pragma unroll
                for (int e = 0; e < 2; ++e) { const int cc = j * 512 + c0 + e * 4; const f32x4 sc = *(const f32x4*)(mod + 1024 + cc), sh = *(const f32x4*)(mod + cc); o[e] = v[u][j * 2 + e] * rs * g[j * 2 + e] * (sc + 1.0f) + sh; }
                u32x2 w; w.x = pack4_fp8(o[0][0], o[0][1], o[0][2], o[0][3]); w.y = pack4_fp8(o[1][0], o[1][1], o[1][2], o[1][3]);
                *(u32x2*)(h + (size_t)row * D + j * 512 + c0) = w; } }
    }
}


__device__ __forceinline__ void phase2(const Params& p, LAS unsigned char* lds) {
    pg8::InSched S; S.init2(p.ws + OFF_WT_IN, gridDim.x, blockIdx.x);
    pg8::EpiIn E{p.ws};
    pg8::gemm_phase<pg8::EpiIn, pg8::InSched, true, 127, 122>(lds, (const char*)(p.ws + OFF_H), 1024, S, E);
}
__device__ __forceinline__ void phase3(const Params& p, LAS unsigned char* lds) {
    char* ws = p.ws;
    { pg8::DenseSched S; S.init(L, 1536, 768, 768, ws + OFF_WT_QB, gridDim.x, blockIdx.x); pg8::EpiQ E{(unsigned char*)(ws + OFF_Q), (const float*)(ws + OFF_SSQQ)}; pg8::gemm_phase<pg8::EpiQ, pg8::DenseSched, true, 127, 122>(lds, (const char*)(ws + OFF_QA), 768, S, E); }
    { pg8::DenseSched S; S.init(R, 2048, 256, 256, ws + OFF_WT_KVB, gridDim.x, blockIdx.x); pg8::EpiKV E{(unsigned char*)(ws + OFF_K), (unsigned char*)(ws + OFF_V), (const float*)(ws + OFF_SSQKV)}; pg8::gemm_phase<pg8::EpiKV, pg8::DenseSched, true, 127, 122>(lds, (const char*)(ws + OFF_CKV), 256, S, E); }
    { const bf16_t* kr = (const bf16_t*)(ws + OFF_KR); unsigned char* Kb = (unsigned char*)(ws + OFF_K); const float* ropet = (const float*)(ws + OFF_ROPE);
      for (int gid = blockIdx.x * 512 + otid(); gid < R * 32; gid += gridDim.x * 512) { const int row = gid >> 5, i = gid & 31;
          const float x1 = bf2f(kr[(size_t)row * 64 + i]), x2 = bf2f(kr[(size_t)row * 64 + 32 + i]); float o1 = x1, o2 = x2; int b, pos;
          if (row < L) { b = row / SEQ; pos = row % SEQ; const float cs = ropet[pos * 64 + i], sn = ropet[pos * 64 + 32 + i]; o1 = x1 * cs - x2 * sn; o2 = x1 * sn + x2 * cs; } else { b = (row - L) / CTXL; pos = SEQ + (row - L) % CTXL; }
          const unsigned w12 = pack4_fp8(o1, o2, 0.f, 0.f); const unsigned char w1 = (unsigned char)w12, w2 = (unsigned char)(w12 >> 8);
          for (int h = 0; h < 8; ++h) { unsigned char* q = Kb + ((size_t)(b * 8 + h) * NKEY + pos) * 192 + 128; q[i] = w1; q[32 + i] = w2; } } }
}
__device__ __forceinline__ void unpack8_fp8(const u32x2 w, float (&o)[8]) {
    o[0] = __builtin_amdgcn_cvt_f32_fp8((int)w.x, 0); o[1] = __builtin_amdgcn_cvt_f32_fp8((int)w.x, 1); o[2] = __builtin_amdgcn_cvt_f32_fp8((int)w.x, 2); o[3] = __builtin_amdgcn_cvt_f32_fp8((int)w.x, 3);
    o[4] = __builtin_amdgcn_cvt_f32_fp8((int)w.y, 0); o[5] = __builtin_amdgcn_cvt_f32_fp8((int)w.y, 1); o[6] = __builtin_amdgcn_cvt_f32_fp8((int)w.y, 2); o[7] = __builtin_amdgcn_cvt_f32_fp8((int)w.y, 3); }
__device__ __forceinline__ void unpack8(const u32x4 w, float (&o)[8]) {
    o[0] = __uint_as_float(w.x << 16); o[1] = __uint_as_float(w.x & 0xffff0000u); o[2] = __uint_as_float(w.y << 16); o[3] = __uint_as_float(w.y & 0xffff0000u);
    o[4] = __uint_as_float(w.z << 16); o[5] = __uint_as_float(w.z & 0xffff0000u); o[6] = __uint_as_float(w.w << 16); o[7] = __uint_as_float(w.w & 0xffff0000u); }
__device__ __forceinline__ void phase4(const Params& p, LAS unsigned char*) {
    char* ws = p.ws; const unsigned char* y = (const unsigned char*)(ws + OFF_H); const unsigned char* of = (const unsigned char*)(ws + OFF_OF); const unsigned char* ob = (const unsigned char*)(ws + OFF_OB);
    const unsigned char* og = (const unsigned char*)(ws + OFF_OG); const unsigned char* gm = (const unsigned char*)(ws + OFF_GM); const unsigned char* gh = (const unsigned char*)(ws + OFF_GH);
    const int tid = otid(), lane = tid & 63, gw = blockIdx.x * 8 + (tid >> 6), nw = gridDim.x * 8, c0 = lane * 8;
    float gg[8];
#pragma unroll
    for (int i = 0; i < 8; ++i) gg[i] = p.g_hg[(c0 + i) & 127];
    for (int row0 = gw; row0 < L; row0 += 2 * nw) {
        u32x2 rm[2][2], ra[2][2], rb[2][2], r1[2][2], r2[2][2], r3[2][2];
#pragma unroll
        for (int u = 0; u < 2; ++u) { const int row = row0 + u * nw < L ? row0 + u * nw : row0;
#pragma unroll
        for (int j = 0; j < 2; ++j) { const size_t off = (size_t)row * D + j * 512 + c0; ra[u][j] = __builtin_nontemporal_load((const u32x2*)(of + off)); rb[u][j] = __builtin_nontemporal_load((const u32x2*)(ob + off)); r1[u][j] = __builtin_nontemporal_load((const u32x2*)(og + off)); r2[u][j] = __builtin_nontemporal_load((const u32x2*)(gm + off)); r3[u][j] = __builtin_nontemporal_load((const u32x2*)(gh + off)); rm[u][j] = __builtin_nontemporal_load((const u32x2*)(y + off)); } }
#pragma unroll
        for (int u = 0; u < 2; ++u) { const int row = row0 + u * nw; if (row >= L) break;
#pragma unroll
        for (int j = 0; j < 2; ++j) { float a[8], b[8], g1[8], g2[8], g3[8], ym[8], o[8]; unpack8_fp8(ra[u][j], a); unpack8_fp8(rb[u][j], b); unpack8_fp8(r1[u][j], g1); unpack8_fp8(r2[u][j], g2); unpack8_fp8(r3[u][j], g3); unpack8_fp8(rm[u][j], ym);
            float ss = 0.f;
#pragma unroll
            for (int i = 0; i < 8; ++i) { o[i] = a[i] + b[i]; ss += o[i] * o[i]; }
            ss += __shfl_xor(ss, 1); ss += __shfl_xor(ss, 2); ss += __shfl_xor(ss, 4); ss += __shfl_xor(ss, 8);
            const float rs = rsqrtf(ss * (1.0f / 128.0f) + EPS); float r[8];
#pragma unroll
            for (int i = 0; i < 8; ++i) { const float yh = o[i] * rs * gg[i] * siluf_(g1[i]); r[i] = sigmoidf_(g2[i]) * ym[i] + sigmoidf_(g3[i]) * yh; }
            u32x2 w; w.x = pack4_fp8(r[0], r[1], r[2], r[3]); w.y = pack4_fp8(r[4], r[5], r[6], r[7]);
            *(u32x2*)((unsigned char*)(ws + OFF_YF8) + (size_t)row * D + j * 512 + c0) = w; } }
    }
}

#define MC_TIE16(v, o) asm volatile("" : "+v"(v[o+0]), "+v"(v[o+1]), "+v"(v[o+2]), "+v"(v[o+3]), "+v"(v[o+4]), "+v"(v[o+5]), "+v"(v[o+6]), "+v"(v[o+7]), "+v"(v[o+8]), "+v"(v[o+9]), "+v"(v[o+10]), "+v"(v[o+11]), "+v"(v[o+12]), "+v"(v[o+13]), "+v"(v[o+14]), "+v"(v[o+15]))
__device__ __forceinline__ void mc_issue(const Params& p, int idx, float (&v)[32]) {
    const int tid = otid(); const int cc = tid & 127, kq = tid >> 7; const float* base; unsigned voff, vstep;
    if (idx < 4096) { const int e = idx >> 7, r = idx & 127; base = p.w_gu + (size_t)e * 1024 * 2048; voff = (unsigned)(((r & 7) * 128 + kq) * 2048 + conv_src_col(2, (r >> 3) * 128 + cc)) * 4u; vstep = 4u * 2048u * 4u; }
    else { const int j = idx - 4096, e = j >> 6, r = j & 63; base = p.w_dn + (size_t)e * 1024 * 1024; voff = (unsigned)(((r & 7) * 128 + kq) * 1024 + (r >> 3) * 128 + cc) * 4u; vstep = 4u * 1024u * 4u; }
#pragma unroll
    for (int i = 0; i < 32; ++i) { asm volatile("global_load_dword %0, %1, %2 nt" : "=v"(v[i]) : "v"(voff), "s"(base) : "memory"); voff += vstep; }
}
__device__ __forceinline__ void mc_stash(const Params& p, int idx, const LAS float* tl) {
    unsigned char* dst;
    if (idx < 4096) { const int e = idx >> 7, r = idx & 127; dst = (unsigned char*)(p.ws + OFF_WT_GU) + (size_t)e * 2048 * 1024 + (size_t)((r >> 3) * 128) * 1024 + (r & 7) * 128; }
    else { const int j = idx - 4096, e = j >> 6, r = j & 63; dst = (unsigned char*)(p.ws + OFF_WT_DN) + (size_t)e * 1024 * 1024 + (size_t)((r >> 3) * 128) * 1024 + (r & 7) * 128; }
    const int tid = otid();
#pragma unroll
    for (int pss = 0; pss < 2; ++pss) { const int item = tid + 512 * pss, c2 = item >> 3, ch = item & 7; float t[16];
#pragma unroll
        for (int j = 0; j < 16; ++j) t[j] = tl[(16 * ch + j) * 129 + (c2 ^ (8 * (ch >> 1)))] * 32.f;
        u32x4 w; w.x = pack4_fp8(t[0], t[1], t[2], t[3]); w.y = pack4_fp8(t[4], t[5], t[6], t[7]); w.z = pack4_fp8(t[8], t[9], t[10], t[11]); w.w = pack4_fp8(t[12], t[13], t[14], t[15]);
        *(u32x4*)(dst + (size_t)c2 * 1024 + 16 * ch) = w; }
}
__device__ __forceinline__ void mc_step(const Params& p, float (&v)[32], LAS float* tl, int i, int n, int stride, int wmode) {
    const int tid = otid(); const int cc = tid & 127, kq = tid >> 7; const int idx = (int)blockIdx.x + i * stride;
    if (wmode == 3) asm volatile("s_waitcnt vmcnt(36)" ::: "memory"); else if (wmode == 2) asm volatile("s_waitcnt vmcnt(34)" ::: "memory"); else if (wmode == 1) asm volatile("s_waitcnt vmcnt(32)" ::: "memory"); else asm volatile("s_waitcnt vmcnt(0)" ::: "memory");
    MC_TIE16(v, 0); MC_TIE16(v, 16);
#pragma unroll
    for (int q = 0; q < 32; ++q) tl[(kq + 4 * q) * 129 + (cc ^ (8 * (q >> 3)))] = v[q];
    lds_sync();
    if (i + 2 < n) mc_issue(p, idx + 2 * stride, v);
    mc_stash(p, idx, tl);
}
__device__ __forceinline__ void moe_conv(const Params& p, LAS unsigned char* lds) {
    LAS float* t0 = (LAS float*)lds; LAS float* t1 = t0 + 128 * 129;
    const int stride = gridDim.x, n = (6144 - (int)blockIdx.x + stride - 1) / stride;
    float va[32], vb[32];
#pragma unroll
    for (int q = 0; q < 32; ++q) { va[q] = 0.f; vb[q] = 0.f; }
    lds_sync();
    if (n >= 4) {
        mc_issue(p, (int)blockIdx.x, va); mc_issue(p, (int)blockIdx.x + stride, vb);
        mc_step(p, va, t0, 0, n, stride, 1); mc_step(p, vb, t1, 1, n, stride, 2);
#pragma unroll 1
        for (int i = 2; i < n; i += 2) { mc_step(p, va, t0, i, n, stride, i == n - 1 ? 0 : 3); if (i + 1 < n) mc_step(p, vb, t1, i + 1, n, stride, i + 1 == n - 1 ? 0 : 3); }
    } else {
        for (int i = 0; i < n; ++i) { mc_issue(p, (int)blockIdx.x + i * stride, va); mc_step(p, va, t0, i, 0, stride, 0); lds_sync(); }
    }
    __syncthreads();
}
__device__ __forceinline__ void phase5(const Params& p, LAS unsigned char* lds) {
    char* ws = p.ws;
    { pg8::DenseSched S; S.init(L, 1024, 1024, 1024, ws + OFF_WT_OUT, gridDim.x, blockIdx.x); pg8::EpiOut E{(bf16_t*)(ws + OFF_X1), p.x, (const float*)(ws + OFF_MOD)}; pg8::gemm_phase<pg8::EpiOut, pg8::DenseSched, true, 127, 122>(lds, (const char*)(ws + OFF_YF8), 1024, S, E); }
    moe_conv(p, lds);
}
__device__ __forceinline__ void phase6(const Params& p, LAS unsigned char* lds) {
    char* ws = p.ws; const float* modv = (const float*)(ws + OFF_MOD); unsigned char* h2 = (unsigned char*)(ws + OFF_H); int* topi = (int*)(ws + OFF_TOPI); float* topp = (float*)(ws + OFF_TOPP); int* cnt = (int*)(ws + OFF_CNT); int* list = (int*)(ws + OFF_LIST); int* pairpos = (int*)(ws + OFF_ROWPAIR);
    constexpr int HS_LD = 1028, HS_BYTES = 32 * HS_LD * 4;
    LAS float* hs = (LAS float*)lds;
    LAS float* lg = (LAS float*)(lds + HS_BYTES);
    LAS int* lcnt = (LAS int*)(lds + HS_BYTES + 4096);
    LAS int* lent = (LAS int*)(lds + HS_BYTES + 4096 + 512);
    LAS int* lbase = (LAS int*)(lds + HS_BYTES + 4096 + 512 + 8192);
    LAS int* lrun = (LAS int*)(lds + HS_BYTES + 4096 + 512 + 8192 + 2048);
    LAS float* lselv = (LAS float*)(lds + HS_BYTES + 4096 + 512 + 8192 + 4096); LAS int* lseli = (LAS int*)(lds + HS_BYTES + 4096 + 512 + 8192 + 4096 + 512);
    const int tid = otid(), lane = tid & 63, wid = tid >> 6, c0 = lane * 8;
    if (tid < 32) lcnt[tid] = 0;
    lrun[tid] = 0;
    int pending = 0;
    f32x4 g[4];
#pragma unroll
    for (int q = 0; q < 4; ++q) g[q] = *(const f32x4*)(p.g_ffn + (q >> 1) * 512 + c0 + (q & 1) * 4);
    float wB[64];
#pragma unroll
    for (int s = 0; s < 32; ++s) { const int k0 = 128 * wid + 4 * s + 2 * (lane >> 5); wB[2 * s] = p.w_r[k0 * 32 + (lane & 31)]; wB[2 * s + 1] = p.w_r[(k0 + 1) * 32 + (lane & 31)]; }
    __syncthreads();
    u32x4 xr[4][2]; f32x4 scr[4], shr[4];
    auto loadtile = [&](int tile) { const int rbase = min(tile, L / 32 - 1) * 32; const float* mod = modv + (rbase / SEQ) * 6144;
#pragma unroll
        for (int u = 0; u < 4; ++u)
#pragma unroll
            for (int j = 0; j < 2; ++j) xr[u][j] = *(const u32x4*)((const bf16_t*)(ws + OFF_X1) + (size_t)(rbase + wid * 4 + u) * D + j * 512 + c0);
#pragma unroll
        for (int q = 0; q < 4; ++q) { const int cc = (q >> 1) * 512 + c0 + (q & 1) * 4; scr[q] = *(const f32x4*)(mod + 4 * 1024 + cc); shr[q] = *(const f32x4*)(mod + 3 * 1024 + cc); } };
    loadtile(blockIdx.x);
    int it = 0;
    for (int tile = blockIdx.x; tile < L / 32; tile += gridDim.x, ++it) {
        const int rbase = tile * 32;
        f32x4 gs[4];
#pragma unroll
        for (int q = 0; q < 4; ++q) gs[q] = g[q] * (scr[q] + 1.0f);
#pragma unroll
        for (int u = 0; u < 4; ++u) { const int rl = wid * 4 + u, row = rbase + rl; f32x4 v[4]; float ss = 0.f;
#pragma unroll
            for (int j = 0; j < 2; ++j) { float t8[8]; unpack8(xr[u][j], t8); v[2 * j] = (f32x4){t8[0], t8[1], t8[2], t8[3]}; v[2 * j + 1] = (f32x4){t8[4], t8[5], t8[6], t8[7]}; }
#pragma unroll
            for (int q = 0; q < 4; ++q) ss += (v[q][0] * v[q][0] + v[q][1] * v[q][1]) + (v[q][2] * v[q][2] + v[q][3] * v[q][3]);
            const float rs = rsqrtf(wave_sum(ss) * (1.0f / D) + EPS);
#pragma unroll
            for (int j = 0; j < 2; ++j) { f32x4 o[2];
#pragma unroll
                for (int e = 0; e < 2; ++e) { const int cc = j * 512 + c0 + e * 4; o[e] = v[j * 2 + e] * rs * gs[j * 2 + e] + shr[j * 2 + e];
                    *(LAS f32x4*)(hs + rl * HS_LD + cc) = o[e]; }
                u32x2 w; w.x = pack4_fp8(o[0][0], o[0][1], o[0][2], o[0][3]); w.y = pack4_fp8(o[1][0], o[1][1], o[1][2], o[1][3]);
                *(u32x2*)(h2 + (size_t)row * D + j * 512 + c0) = w; } }
        lds_sync();
        loadtile(tile + gridDim.x);
        { f32x16 a0, a1;
#pragma unroll
          for (int r = 0; r < 16; ++r) { a0[r] = 0.f; a1[r] = 0.f; }
          const LAS float* hp = hs + (lane & 31) * HS_LD + 128 * wid + 2 * (lane >> 5);
#pragma unroll
          for (int s = 0; s < 32; ++s) { const f32x2 a = *(const LAS f32x2*)(hp + 4 * s);
              a0 = __builtin_amdgcn_mfma_f32_32x32x2f32(a[0], wB[2 * s], a0, 0, 0, 0); a1 = __builtin_amdgcn_mfma_f32_32x32x2f32(a[1], wB[2 * s + 1], a1, 0, 0, 0); }
          lds_sync();
#pragma unroll
          for (int r = 0; r < 16; ++r) { const int m = 8 * (r >> 2) + 4 * (lane >> 5) + (r & 3); hs[(wid * 32 + m) * 32 + (lane & 31)] = a0[r] + a1[r]; }
          lds_sync();
#pragma unroll
          for (int q = 0; q < 2; ++q) { const int o = tid + 512 * q; float t = p.b_r[o & 31];
#pragma unroll
              for (int w = 0; w < 8; ++w) t += hs[w * 1024 + o];
              lg[o] = t; } }
        lds_sync();
#pragma unroll
        for (int rep = 0; rep < 2; ++rep) { const int rl = wid * 4 + rep * 2 + (lane >> 5), row = rbase + rl, e = lane & 31; const float v = lg[rl * 32 + e]; int rank = 0;
#pragma unroll
            for (int q = 0; q < 8; ++q) { const f32x4 t = *(const LAS f32x4*)(lg + rl * 32 + 4 * q);
#pragma unroll
                for (int i = 0; i < 4; ++i) { const int gt = t[i] > v, eq = t[i] == v, lt = (4 * q + i) < e; rank += gt | (eq & lt); } }
            if (rank < 4) { lselv[rl * 4 + rank] = v; lseli[rl * 4 + rank] = e; }
            asm volatile("s_waitcnt lgkmcnt(0)" ::: "memory");
            const f32x4 sv = *(const LAS f32x4*)(lselv + rl * 4); const int k = e & 3; const int myk = lseli[rl * 4 + k];
            const float e0 = 1.0f, e1 = __expf(sv[1] - sv[0]), e2 = __expf(sv[2] - sv[0]), e3 = __expf(sv[3] - sv[0]); const float sum = ((e0 + e1) + e2) + e3;
            const float mye = k == 0 ? e0 : (k == 1 ? e1 : (k == 2 ? e2 : e3)); const float myp = mye / sum;
            if (e < 4) { const int pair = row * 4 + e; topi[pair] = myk; topp[pair] = myp; __hip_atomic_fetch_add(&lcnt[myk], 1, __ATOMIC_RELAXED, __HIP_MEMORY_SCOPE_WORKGROUP); lent[(it * 32 + rl) * 4 + e] = myk; } }
        lds_sync();
        { const int t3 = otid(); if (t3 < 32) { const int n = lcnt[t3]; if (it > 0) lbase[(it - 1) * 32 + t3] = pending; pending = n > 0 ? atomicAdd(&cnt[t3], n) : 0; lcnt[t3] = 0; } }
    }
    const int t2 = otid();
    if (t2 < 32 && it > 0) lbase[(it - 1) * 32 + t2] = pending;
    __syncthreads();
    const int nent = it * 128;
    for (int s = t2; s < nent; s += 512) { const int e = lent[s]; const int ii = s >> 7, rl = (s >> 2) & 31, k = s & 3; const int row = (blockIdx.x + ii * gridDim.x) * 32 + rl;
        const int pos = lbase[ii * 32 + e] + __hip_atomic_fetch_add(&lrun[ii * 32 + e], 1, __ATOMIC_RELAXED, __HIP_MEMORY_SCOPE_WORKGROUP); list[e * CAP + pos] = row * 4 + k; pairpos[row * 4 + k] = pos; }
}
__device__ __forceinline__ void moe_table(const int* cnt, LAS int* tab) {
    if (otid() == 0) { int t = 0; for (int e = 0; e < NE; ++e) { tab[e] = t; const int n = cnt[e]; tab[64 + e] = n; t += (n + 255) >> 8; } tab[32] = t; tab[33] = t; }
    __syncthreads();
    for (int rt = otid(); rt < tab[33]; rt += 512) { int e = 0; while (tab[e + 1] <= rt) ++e; tab[128 + rt] = e; }
    __syncthreads();
}
constexpr int LDS_TAB = pg8::STAGE_BYTES;
__device__ __forceinline__ void phase7(const Params& p, LAS unsigned char* lds) {
    char* ws = p.ws; LAS int* tab = (LAS int*)(lds + LDS_TAB); moe_table((const int*)(ws + OFF_CNT), tab);
    pg8::MoeSched<true> S; S.nN = 8; S.G = gridDim.x; S.c = blockIdx.x; S.rowb = 1024; S.Wt = ws + OFF_WT_GU; S.wexp = (size_t)2048 * 1024; S.btile = (size_t)256 * 1024; S.tab = tab; S.list = (const int*)(ws + OFF_LIST);
    pg8::EpiMoe1 E{(unsigned char*)(ws + OFF_ACT), p.b_gu};
    pg8::gemm_phase<pg8::EpiMoe1, pg8::MoeSched<true>, true, 127, 122>(lds, (const char*)(ws + OFF_H), 1024, S, E);
}
__device__ __forceinline__ void phase8(const Params& p, LAS unsigned char* lds) {
    char* ws = p.ws; LAS int* tab = (LAS int*)(lds + LDS_TAB);
    pg8::MoeSched<false> S; S.nN = 4; S.G = gridDim.x; S.c = blockIdx.x; S.rowb = 1024; S.Wt = ws + OFF_WT_DN; S.wexp = (size_t)1024 * 1024; S.btile = (size_t)256 * 1024; S.tab = tab; S.list = (const int*)(ws + OFF_LIST);
    pg8::EpiMoe2 E{(unsigned char*)(ws + OFF_YP), p.b_dn};
    pg8::gemm_phase<pg8::EpiMoe2, pg8::MoeSched<false>, true, 125, 122>(lds, (const char*)(ws + OFF_ACT), 1024, S, E);
}
__device__ __forceinline__ void phase9(const Params& p, LAS unsigned char* lds) {
    char* ws = p.ws; const float* modv = (const float*)(ws + OFF_MOD); const unsigned char* yp = (const unsigned char*)(ws + OFF_YP); const float* topp = (const float*)(ws + OFF_TOPP);
    const int* topi = (const int*)(ws + OFF_TOPI); const int* pairpos = (const int*)(ws + OFF_ROWPAIR);
    LAS int* tab = (LAS int*)(lds + LDS_TAB);
    const int tid = otid(), lane = tid & 63, gw = blockIdx.x * 8 + (tid >> 6), nw = gridDim.x * 8, c0 = lane * 8;
    f32x4 fg[4];
#pragma unroll
    for (int q = 0; q < 4; ++q) fg[q] = *(const f32x4*)(p.g_fin + (q >> 1) * 512 + c0 + (q & 1) * 4);
    for (int row = gw; row < L; row += nw) {
        const float* gate = modv + (row / SEQ) * 6144 + 5 * 1024; f32x4 v[4]; u32x2 yr[4][2];
        const pg8::i32x4_t ek = *(const pg8::i32x4_t*)(topi + row * 4), pk4 = *(const pg8::i32x4_t*)(pairpos + row * 4);
#pragma unroll
        for (int j = 0; j < 2; ++j) { float t8[8]; unpack8(*(const u32x4*)((const bf16_t*)(ws + OFF_X1) + (size_t)row * D + j * 512 + c0), t8); v[2 * j] = (f32x4){t8[0], t8[1], t8[2], t8[3]}; v[2 * j + 1] = (f32x4){t8[4], t8[5], t8[6], t8[7]}; }
#pragma unroll
        for (int k = 0; k < 4; ++k) { const size_t yrow = (size_t)tab[ek[k]] * 256 + pk4[k];
#pragma unroll
            for (int j = 0; j < 2; ++j) yr[k][j] = __builtin_nontemporal_load((const u32x2*)(yp + yrow * 1024 + j * 512 + c0)); }
        const f32x4 pk = *(const f32x4*)(topp + row * 4) * 0.125f;
        float m[16];
#pragma unroll
        for (int i = 0; i < 16; ++i) m[i] = 0.f;
#pragma unroll
        for (int k = 0; k < 4; ++k)
#pragma unroll
            for (int j = 0; j < 2; ++j) { float t[8]; unpack8_fp8(yr[k][j], t);
#pragma unroll
                for (int i = 0; i < 8; ++i) m[j * 8 + i] += pk[k] * t[i]; }
        float ss = 0.f;
#pragma unroll
        for (int q = 0; q < 4; ++q) { const f32x4 gt = *(const f32x4*)(gate + (q >> 1) * 512 + c0 + (q & 1) * 4);
#pragma unroll
            for (int i = 0; i < 4; ++i) { v[q][i] += gt[i] * m[q * 4 + i]; ss += v[q][i] * v[q][i]; } }
        const float rs = rsqrtf(wave_sum(ss) * (1.0f / D) + EPS);
#pragma unroll
        for (int q = 0; q < 4; ++q) __builtin_nontemporal_store(v[q] * rs * fg[q], (f32x4*)(p.out + (size_t)row * D + (q >> 1) * 512 + c0 + (q & 1) * 4));
    }
}

namespace at {
using s16x4  = __attribute__((ext_vector_type(4))) short;
constexpr int NW = 8, QBLK = 32, KVBLK = 64, DK = 192, DV = 128;
constexpr float SCALE = 0.07216878364870322f;
constexpr float THR = 2.6f;
constexpr int KROW = 208;
constexpr int VROW = 80, VGRP = 1312;
constexpr int SHM_V = 8 * VGRP, SHM_K = KVBLK * KROW, SHM_ATTN = 2 * SHM_V + 2 * SHM_K + NW * 64 * 4;
#define KSWZ(row, colB) ((row) * 384 + ((colB) ^ ((((row) ^ ((row) >> 3)) & 7) << 4)))
#define SBAR() __builtin_amdgcn_sched_barrier(0)
__device__ __forceinline__ int crow(int r, int hi) { return (r & 3) + 8 * (r >> 2) + 4 * hi; }
__device__ __forceinline__ unsigned cvtpk(float lo, float hi) { return cvt_pk_bf16(lo, hi); }

__device__ __forceinline__ void partialSM(f32x16& p0, f32x16& p1, float& mC, float& alpha) {
  constexpr float TMAX = THR * 1.4426950408889634f + 5.0f;
  float pmax = p0[0];
#pragma unroll
  for (int r = 1; r < 16; ++r) pmax = fmaxf(pmax, p0[r]);
#pragma unroll
  for (int r = 0; r < 16; ++r) pmax = fmaxf(pmax, p1[r]);
  { auto rr = __builtin_amdgcn_permlane32_swap(__float_as_uint(pmax), __float_as_uint(pmax), false, false);
    pmax = fmaxf(__uint_as_float(rr[0]), __uint_as_float(rr[1])); }
  if (__builtin_expect(__all(pmax <= TMAX), 1)) alpha = 1.f;
  else { const float d = fmaxf(pmax - 5.0f, 0.f); alpha = __builtin_amdgcn_exp2f(-d); mC += d;
#pragma unroll
    for (int r = 0; r < 16; ++r) { p0[r] -= d; p1[r] -= d; } }
#pragma unroll
  for (int r = 0; r < 16; ++r) p0[r] = __builtin_amdgcn_exp2f(p0[r]);
}
__device__ __forceinline__ void finishSM(f32x16& p0, f32x16& p1, float alpha, float& l_reg, pg8::v8i_t& pa) {
#pragma unroll
  for (int r = 0; r < 16; ++r) p1[r] = __builtin_amdgcn_exp2f(p1[r]);
  float ps = 0;
#pragma unroll
  for (int r = 0; r < 16; ++r) ps += p0[r];
#pragma unroll
  for (int r = 0; r < 16; ++r) ps += p1[r];
  { auto rr = __builtin_amdgcn_permlane32_swap(__float_as_uint(ps), __float_as_uint(ps), false, false);
    ps = __uint_as_float(rr[0]) + __uint_as_float(rr[1]); }
  l_reg = l_reg * alpha + ps;
  unsigned d[8];
#pragma unroll
  for (int i = 0; i < 4; ++i) { unsigned t = 0; t = __builtin_amdgcn_cvt_pk_fp8_f32(p0[4 * i], p0[4 * i + 1], t, false); t = __builtin_amdgcn_cvt_pk_fp8_f32(p0[4 * i + 2], p0[4 * i + 3], t, true); d[i] = t;
    unsigned u = 0; u = __builtin_amdgcn_cvt_pk_fp8_f32(p1[4 * i], p1[4 * i + 1], u, false); u = __builtin_amdgcn_cvt_pk_fp8_f32(p1[4 * i + 2], p1[4 * i + 3], u, true); d[4 + i] = u; }
  pa = (pg8::v8i_t){(int)d[0], (int)d[1], (int)d[2], (int)d[3], (int)d[4], (int)d[5], (int)d[6], (int)d[7]};
}
__device__ __forceinline__ void qkt(f32x16& p0, f32x16& p1, const LAS char* Ks, const pg8::v8i_t (&qf)[3], int r32, int hi, float init) {
#pragma unroll
  for (int r = 0; r < 16; ++r) { p0[r] = init; p1[r] = init; }
#pragma unroll
  for (int s = 0; s < 3; ++s) { const int cb = 64 * s + 32 * hi;
    const pg8::v8i_t a0 = __builtin_shufflevector(*(const LAS pg8::i32x4_t*)(Ks + r32 * KROW + cb), *(const LAS pg8::i32x4_t*)(Ks + r32 * KROW + cb + 16), 0, 1, 2, 3, 4, 5, 6, 7);
    const pg8::v8i_t a1 = __builtin_shufflevector(*(const LAS pg8::i32x4_t*)(Ks + (32 + r32) * KROW + cb), *(const LAS pg8::i32x4_t*)(Ks + (32 + r32) * KROW + cb + 16), 0, 1, 2, 3, 4, 5, 6, 7);
    p0 = __builtin_amdgcn_mfma_scale_f32_32x32x64_f8f6f4(a0, qf[s], p0, 0, 0, 0, 127, 0, 124);
    p1 = __builtin_amdgcn_mfma_scale_f32_32x32x64_f8f6f4(a1, qf[s], p1, 0, 0, 0, 127, 0, 124); }
}
__device__ __forceinline__ u32x2 bf8_to_fp8(const bf16x8 v) { const u32x4 w = __builtin_bit_cast(u32x4, v); u32x2 r; unsigned t = 0;
  t = __builtin_amdgcn_cvt_pk_fp8_f32(__uint_as_float(w.x << 16), __uint_as_float(w.x & 0xffff0000u), t, false); t = __builtin_amdgcn_cvt_pk_fp8_f32(__uint_as_float(w.y << 16), __uint_as_float(w.y & 0xffff0000u), t, true); r.x = t; t = 0;
  t = __builtin_amdgcn_cvt_pk_fp8_f32(__uint_as_float(w.z << 16), __uint_as_float(w.z & 0xffff0000u), t, false); t = __builtin_amdgcn_cvt_pk_fp8_f32(__uint_as_float(w.w << 16), __uint_as_float(w.w & 0xffff0000u), t, true); r.y = t; return r; }
__device__ __forceinline__ u32x2 bf8_to_fp8s(const bf16x8 v, float sc) { const u32x4 w = __builtin_bit_cast(u32x4, v); u32x2 r; unsigned t = 0;
  t = __builtin_amdgcn_cvt_pk_fp8_f32(__uint_as_float(w.x << 16) * sc, __uint_as_float(w.x & 0xffff0000u) * sc, t, false); t = __builtin_amdgcn_cvt_pk_fp8_f32(__uint_as_float(w.y << 16) * sc, __uint_as_float(w.y & 0xffff0000u) * sc, t, true); r.x = t; t = 0;
  t = __builtin_amdgcn_cvt_pk_fp8_f32(__uint_as_float(w.z << 16) * sc, __uint_as_float(w.z & 0xffff0000u) * sc, t, false); t = __builtin_amdgcn_cvt_pk_fp8_f32(__uint_as_float(w.w << 16) * sc, __uint_as_float(w.w & 0xffff0000u) * sc, t, true); r.y = t; return r; }
__device__ __forceinline__ void pv_d0(f32x16 (&o)[4], const LAS char* Vt, const pg8::v8i_t pa, int r32, int hi) {
#pragma unroll
  for (int d = 0; d < 4; ++d) { const LAS char* rp = Vt + (r32 & 7) * VGRP + (4 * d + (r32 >> 3)) * VROW + 32 * hi;
    const pg8::v8i_t b = __builtin_shufflevector(*(const LAS pg8::i32x4_t*)rp, *(const LAS pg8::i32x4_t*)(rp + 16), 0, 1, 2, 3, 4, 5, 6, 7);
    o[d] = __builtin_amdgcn_mfma_scale_f32_32x32x64_f8f6f4(pa, b, o[d], 0, 0, 0, 127, 0, 127); }
}

__device__ __forceinline__ void attn_unit(const unsigned char* __restrict__ Qb, const unsigned char* __restrict__ Kh, const unsigned char* __restrict__ Vh, unsigned char* __restrict__ Ob, int t0, const float* __restrict__ ropet, LAS char* lds) {
  constexpr int LDQ = 1536, LDO = 1024, NT = NKEY / KVBLK;
  const int tid = otid(), wid = tid >> 6, lane = tid & 63, r32 = lane & 31, hi = lane >> 5;
  LAS char* V_lds = lds; LAS char* K_lds = lds + 2 * SHM_V;
  LAS float* wsl = (LAS float*)(lds + 2 * SHM_V + 2 * SHM_K) + wid * 64; LAS float* li_l = wsl; LAS float* al_l = wsl + 32;
  float mC = -64.f, l_reg = 0; f32x16 o[4] = {};
  u32x2 q8[12];
  { const unsigned char* Qw = Qb + (size_t)(wid * QBLK + r32) * LDQ + hi * 8;
#pragma unroll
    for (int d0 = 0; d0 < 12; ++d0) q8[d0] = *reinterpret_cast<const u32x2*>(Qw + d0 * 16); }
  const int sr = 2 * (tid >> 4), sc = (tid & 15) * 8, vst0 = (tid & 15) * VROW + 32 * ((sr >> 2) & 1) + 16 * (sr >> 5) + 4 * ((sr & 31) >> 3) + (sr & 3);
  int kgo[3], kst[3];
#pragma unroll
  for (int i = 0; i < 3; ++i) { const int c = tid + 512 * i, row = c / 24, ci = c % 24, c8 = ci * 8; kgo[i] = row * DK + c8; kst[i] = row * KROW + ((ci >> 3) * 8 + 4 * (ci & 1) + ((ci & 7) >> 1)) * 8; }
  u32x2 sv0, sv1, sk0, sk1, sk2;
#define SLOAD(k0) do { sv0 = *reinterpret_cast<const u32x2*>(&Vh[(size_t)((k0) + sr) * DV + sc]); sv1 = *reinterpret_cast<const u32x2*>(&Vh[(size_t)((k0) + 1 + sr) * DV + sc]); \
    sk0 = *reinterpret_cast<const u32x2*>(&Kh[(size_t)(k0) * DK + kgo[0]]); sk1 = *reinterpret_cast<const u32x2*>(&Kh[(size_t)(k0) * DK + kgo[1]]); sk2 = *reinterpret_cast<const u32x2*>(&Kh[(size_t)(k0) * DK + kgo[2]]); } while (0)
#define SWRITE(b) do { const u32x2 f0_ = sv0, f1_ = sv1; LAS unsigned char* vt_ = (LAS unsigned char*)(V_lds + (b) * SHM_V); \
    _Pragma("unroll") for (int e_ = 0; e_ < 8; ++e_) *(LAS unsigned short*)(vt_ + e_ * VGRP + vst0) = (unsigned short)__builtin_amdgcn_perm(e_ < 4 ? f1_.x : f1_.y, e_ < 4 ? f0_.x : f0_.y, 0x0c0c0400u + (e_ & 3) * 0x0101u); \
    *(LAS u32x2*)(K_lds + (b) * SHM_K + kst[0]) = sk0; *(LAS u32x2*)(K_lds + (b) * SHM_K + kst[1]) = sk1; *(LAS u32x2*)(K_lds + (b) * SHM_K + kst[2]) = sk2; } while (0)
#define RESC(a) do { if (__any((a) < 1.f)) { if (hi == 0) al_l[r32] = (a); asm volatile("s_waitcnt lgkmcnt(0)" ::: "memory"); \
    _Pragma("unroll") for (int d = 0; d < 4; ++d) _Pragma("unroll") for (int r = 0; r < 16; ++r) o[d][r] *= al_l[crow(r, hi)]; } } while (0)
  f32x16 p0, p1; float mn, al; pg8::v8i_t pa;
  SLOAD(0);
  { const float* rt = ropet + (size_t)(t0 + wid * QBLK + r32) * 64 + 8 * hi;
#pragma unroll
    for (int g = 0; g < 2; ++g) {
      const f32x4 c0 = *(const f32x4*)(rt + 16 * g), c1 = *(const f32x4*)(rt + 16 * g + 4), s0 = *(const f32x4*)(rt + 32 + 16 * g), s1 = *(const f32x4*)(rt + 32 + 16 * g + 4);
      float x1[8], x2[8], n1[8], n2[8]; unpack8_fp8(q8[8 + g], x1); unpack8_fp8(q8[10 + g], x2);
#pragma unroll
      for (int j = 0; j < 8; ++j) { const float cs = j < 4 ? c0[j & 3] : c1[j & 3], sn = j < 4 ? s0[j & 3] : s1[j & 3]; n1[j] = x1[j] * cs - x2[j] * sn; n2[j] = x1[j] * sn + x2[j] * cs; }
      q8[8 + g].x = pack4_fp8(n1[0], n1[1], n1[2], n1[3]); q8[8 + g].y = pack4_fp8(n1[4], n1[5], n1[6], n1[7]); q8[10 + g].x = pack4_fp8(n2[0], n2[1], n2[2], n2[3]); q8[10 + g].y = pack4_fp8(n2[4], n2[5], n2[6], n2[7]); } }
  pg8::v8i_t qf[3];
#pragma unroll
  for (int s = 0; s < 3; ++s) qf[s] = (pg8::v8i_t){(int)q8[4 * s].x, (int)q8[4 * s].y, (int)q8[4 * s + 1].x, (int)q8[4 * s + 1].y, (int)q8[4 * s + 2].x, (int)q8[4 * s + 2].y, (int)q8[4 * s + 3].x, (int)q8[4 * s + 3].y};
  asm volatile("s_waitcnt vmcnt(0)" ::: "memory"); SWRITE(0); __syncthreads();
  for (int j = 0; j < NT; ++j) {
    const int bsel = j & 1;
    if (j + 1 < NT) SLOAD((j + 1) * KVBLK);
    SBAR(); qkt(p0, p1, K_lds + bsel * SHM_K, qf, r32, hi, 5.0f - mC);
    partialSM(p0, p1, mC, al);
    RESC(al);
    finishSM(p0, p1, al, l_reg, pa); SBAR();
    pv_d0(o, V_lds + bsel * SHM_V, pa, r32, hi);
    if (j + 1 < NT) { asm volatile("s_waitcnt vmcnt(0)" ::: "memory"); SWRITE(bsel ^ 1); }
    __syncthreads();
  }
  if (hi == 0) li_l[r32] = l_reg; asm volatile("s_waitcnt lgkmcnt(0)" ::: "memory");
  float rli[16];
#pragma unroll
  for (int r = 0; r < 16; ++r) rli[r] = __builtin_amdgcn_rcpf(li_l[crow(r, hi)]);
  { LAS unsigned char* ot = (LAS unsigned char*)(lds + wid * 4096);
#pragma unroll
    for (int r = 0; r < 16; ++r) { const int orow = crow(r, hi);
#pragma unroll
      for (int d0 = 0; d0 < 4; ++d0) ot[orow * 128 + d0 * 32 + r32] = (unsigned char)pack4_fp8(o[d0][r] * rli[r], 0.f, 0.f, 0.f); }
    asm volatile("s_waitcnt lgkmcnt(0)" ::: "memory");
    unsigned char* Ow = Ob + (size_t)(wid * QBLK) * LDO;
#pragma unroll
    for (int i = 0; i < 4; ++i) { const int q = lane + 64 * i, row = q >> 3, ch = q & 7; const u32x4 w = *(const LAS u32x4*)(ot + row * 128 + ch * 16); __builtin_nontemporal_store(w, (u32x4*)(Ow + (size_t)row * LDO + ch * 16)); } }
#undef SLOAD
#undef SWRITE
#undef RESC
}
}

__device__ __forceinline__ void phase_attn(const Params& p, LAS unsigned char* lds) {
    char* ws = p.ws; const unsigned char* Q = (const unsigned char*)(ws + OFF_Q); const unsigned char* Kb = (const unsigned char*)(ws + OFF_K); const unsigned char* Vb = (const unsigned char*)(ws + OFF_V); unsigned char* Y = (unsigned char*)(ws + OFF_H);
    const int G = gridDim.x;
    for (int it = 0;; ++it) {
        int u;
        if (G == 256) { const int c = blockIdx.x, xcd = c & 7, j = c >> 3; if (it >= 4) break; u = ((it * 32 + xcd * 4 + (j >> 3)) << 3) | (j & 7); }
        else { u = it * G + blockIdx.x; if (u >= 1024) break; }
        const int bh = u >> 3, qb = u & 7, b = bh >> 3, h = bh & 7;
        at::attn_unit(Q + ((size_t)(b * SEQ + qb * 256)) * 1536 + h * 192, Kb + (size_t)bh * NKEY * 192, Vb + (size_t)bh * NKEY * 128, Y + ((size_t)(b * SEQ + qb * 256)) * D + h * 128, qb * 256, (const float*)(ws + OFF_ROPE), (LAS char*)lds);
        __syncthreads();
    }
}

namespace sc {
using f32x16 = __attribute__((ext_vector_type(16))) float;
constexpr int BUFB = 53248, O_QT = 0, O_KH = 16384, O_VT = 32768, O_AT = 49152, O_DEC = 51200, O_KD = 2 * BUFB, O_OUT = 2 * BUFB + 16384, LDS_SCAN = 2 * BUFB + 16384 + 2 * 16384;
__device__ __forceinline__ int sw256(int row, int cb) { return row * 256 + (cb ^ ((row & 15) << 4)); }
__device__ __forceinline__ int sw128(int row, int cb) { return row * 128 + (cb ^ (((row >> 1) & 7) << 4)); }
__device__ __forceinline__ int grow_of(int n, int b, int dir) { if (n < CTXL) { const int s = dir ? (CTXL - 1 - n) : n; return L + b * CTXL + s; } const int m = n - CTXL; return b * SEQ + (dir ? (SEQ - 1 - m) : m); }
__device__ __forceinline__ bf16x8 pack_acc8(const f32x16& x, int s) { u32x4 p; p.x = cvt_pk_bf16(x[8 * s], x[8 * s + 1]); p.y = cvt_pk_bf16(x[8 * s + 2], x[8 * s + 3]); p.z = cvt_pk_bf16(x[8 * s + 4], x[8 * s + 5]); p.w = cvt_pk_bf16(x[8 * s + 6], x[8 * s + 7]); return __builtin_bit_cast(bf16x8, p); }

__device__ __forceinline__ void scan_unit(const Params& p, int unit, LAS unsigned char* lds) {
    char* ws = p.ws; const int dir = unit & 1, h = (unit >> 1) & 7, b = unit >> 4;
    const bf16_t* hq = (const bf16_t*)(ws + OFF_HQ); const bf16_t* fz = (const bf16_t*)(ws + (dir ? OFF_FB : OFF_FF)); const bf16_t* iv = (const bf16_t*)(ws + OFF_IV);
    unsigned char* outp = (unsigned char*)(ws + (dir ? OFF_OB : OFF_OF)); const float* lb = (const float*)(ws + OFF_LB);
    const int tid = otid(), wid = __builtin_amdgcn_readfirstlane(tid >> 6), lane = tid & 63, r32 = lane & 31, hi = lane >> 5;
    const int sgn = dir ? -1 : 1; const long rstep = (long)sgn * D;
    __syncthreads();
    if (wid >= 4) {
        const int I = wid - 4, cp = lane, hc = h * 128 + 2 * cp;
        const float lbv0 = lb[dir * 1024 + hc], lbv1 = lb[dir * 1024 + hc + 1];
        unsigned zr[16], vr[16], qr[16];
#define SC_LOAD(c) do { const size_t o0_ = (size_t)(grow_of((c) * 64, b, dir) + sgn * (16 * I)) * D + hc; const bf16_t* pz_ = fz + o0_; const bf16_t* pv_ = iv + o0_; const bf16_t* pq_ = hq + o0_; \
        _Pragma("unroll") for (int i = 0; i < 16; ++i) { zr[i] = *(const unsigned*)pz_; pz_ += rstep; vr[i] = *(const unsigned*)pv_; pv_ += rstep; if ((c) >= 4) { qr[i] = *(const unsigned*)pq_; pq_ += rstep; } } } while (0)
        SC_LOAD(0);
        for (int it = 0; it <= 37; ++it) {
            if (it >= 6) {
                const int c = it - 2; const LAS unsigned char* OB = lds + O_OUT + (c & 1) * 16384; const int pt = I * 64 + lane;
                unsigned char* ob = outp + (size_t)grow_of(c * 64, b, dir) * D + h * 128;
#pragma unroll
                for (int q = 0; q < 2; ++q) { const int item = q * 256 + pt, t = item >> 3, c16 = item & 7;
                    __builtin_nontemporal_store(*(const LAS u32x4*)(OB + t * 128 + c16 * 16), (u32x4*)(ob + (long)t * rstep + c16 * 16)); }
            }
            if (it < 36) {
                const int c = it; const bool lat = c >= 4; LAS unsigned char* B = lds + (c & 1) * BUFB; LAS unsigned char* KD = lds + O_KD;
                float kk0[16], kk1[16], lc0[16], lc1[16]; float run0 = 0.f, run1 = 0.f;
#pragma unroll
                for (int i = 0; i < 16; ++i) { const float z0 = __uint_as_float(zr[i] << 16), z1 = __uint_as_float(zr[i] & 0xffff0000u);
                    const float f0 = lbv0 + (1.0f - lbv0) * sigmoidf_(z0), f1 = lbv1 + (1.0f - lbv1) * sigmoidf_(z1); kk0[i] = 1.0f - f0; kk1[i] = 1.0f - f1;
                    run0 += __builtin_amdgcn_logf(f0) * 0.6931471805599453f; run1 += __builtin_amdgcn_logf(f1) * 0.6931471805599453f; lc0[i] = run0; lc1[i] = run1; }
                *(LAS f32x2*)(B + O_DEC + (I * 128 + 2 * cp) * 4) = (f32x2){__expf(run0), __expf(run1)};
                unsigned kh0[8], kh1[8], vt0[8], vt1[8];
#pragma unroll
                for (int i = 0; i < 16; ++i) { const int t = 16 * I + i; const float l0 = lc0[i], l1 = lc1[i];
                    const float kd0 = kk0[i] * __expf(fminf(-l0, 80.0f)), kd1 = kk1[i] * __expf(fminf(-l1, 80.0f));
                    const float kf0 = kk0[i] * __expf(run0 - l0), kf1 = kk1[i] * __expf(run1 - l1);
                    if (lat) { const float q0 = __uint_as_float(qr[i] << 16), q1 = __uint_as_float(qr[i] & 0xffff0000u);
                        *(LAS unsigned*)(B + O_QT + sw256(t, 4 * cp)) = cvt_pk_bf16(q0 * __expf(l0), q1 * __expf(l1)); *(LAS unsigned*)(KD + sw256(t, 4 * cp)) = cvt_pk_bf16(kd0, kd1); }
                    if (i & 1) { kh0[i >> 1] = cvt_pk_bf16(__uint_as_float(kh0[i >> 1]), kf0); kh1[i >> 1] = cvt_pk_bf16(__uint_as_float(kh1[i >> 1]), kf1); vt0[i >> 1] = (vt0[i >> 1] >> 16) | (vr[i] << 16); vt1[i >> 1] = (vt1[i >> 1] >> 16) | (vr[i] & 0xffff0000u); }
                    else { kh0[i >> 1] = __float_as_uint(kf0); kh1[i >> 1] = __float_as_uint(kf1); vt0[i >> 1] = vr[i] << 16; vt1[i >> 1] = vr[i] & 0xffff0000u; } }
#pragma unroll
                for (int q = 0; q < 2; ++q) {
                    *(LAS u32x4*)(B + O_KH + sw128(2 * cp, 32 * I + 16 * q)) = (u32x4){kh0[4 * q], kh0[4 * q + 1], kh0[4 * q + 2], kh0[4 * q + 3]}; *(LAS u32x4*)(B + O_KH + sw128(2 * cp + 1, 32 * I + 16 * q)) = (u32x4){kh1[4 * q], kh1[4 * q + 1], kh1[4 * q + 2], kh1[4 * q + 3]};
                    *(LAS u32x4*)(B + O_VT + sw128(2 * cp, 32 * I + 16 * q)) = (u32x4){vt0[4 * q], vt0[4 * q + 1], vt0[4 * q + 2], vt0[4 * q + 3]}; *(LAS u32x4*)(B + O_VT + sw128(2 * cp + 1, 32 * I + 16 * q)) = (u32x4){vt1[4 * q], vt1[4 * q + 1], vt1[4 * q + 2], vt1[4 * q + 3]}; }
                if (it + 1 < 36) SC_LOAD(it + 1);
                if (lat) {
                    const int l15 = lane & 15, lq = lane >> 4; f32x4 a = {0.f, 0.f, 0.f, 0.f};
#pragma unroll
                    for (int ks = 0; ks < 4; ++ks) { const bf16x8 av = *(const LAS bf16x8*)(B + O_QT + sw256(16 * I + l15, (32 * ks + 8 * lq) * 2)); const bf16x8 bv = *(const LAS bf16x8*)(KD + sw256(16 * I + l15, (32 * ks + 8 * lq) * 2));
                        a = __builtin_amdgcn_mfma_f32_16x16x32_bf16(av, bv, a, 0, 0, 0); }
#pragma unroll
                    for (int r = 0; r < 4; ++r) { const int tl = 4 * lq + r; float v = a[r]; if (l15 > tl) v = 0.f; *(LAS bf16_t*)(B + O_AT + ((I * 16 + tl) * 16 + l15) * 2) = f2bf(v); }
                }
            }
            lds_sync();
        }
#undef SC_LOAD
    } else {
        const int bq = wid; f32x16 S[4];
#pragma unroll
        for (int a = 0; a < 4; ++a) S[a] = f32x16{};
        for (int it = 0; it <= 37; ++it) {
            if (it >= 1 && it <= 36) {
                const int c = it - 1; const bool lat = c >= 4; LAS unsigned char* B = lds + (c & 1) * BUFB;
                LAS unsigned char* po = (LAS unsigned char*)(lds + O_OUT + (c & 1) * 16384) + (4 * hi) * 128 + 32 * bq + r32;
#pragma unroll
                for (int I = 0; I < 4; ++I) {
                    const bf16x8 vtf = *(const LAS bf16x8*)(B + O_VT + sw128(32 * bq + r32, (16 * I + 8 * hi) * 2));
                    if (lat) {
                        f32x16 o = f32x16{};
#pragma unroll
                        for (int a = 0; a < 4; ++a)
#pragma unroll
                            for (int s = 0; s < 2; ++s) { const int dk0 = 32 * a + 16 * s + 4 * hi; const int row = 16 * I + (r32 & 15);
                                const u32x2 lo2 = *(const LAS u32x2*)(B + O_QT + sw256(row, dk0 * 2)), hi2 = *(const LAS u32x2*)(B + O_QT + sw256(row, (dk0 + 8) * 2));
                                const u32x4 av = {lo2.x, lo2.y, hi2.x, hi2.y};
                                o = __builtin_amdgcn_mfma_f32_32x32x16_bf16(__builtin_bit_cast(bf16x8, av), pack_acc8(S[a], s), o, 0, 0, 0); }
                        { const bf16x8 af = *(const LAS bf16x8*)(B + O_AT + ((I * 16 + (r32 & 15)) * 16 + 8 * hi) * 2); o = __builtin_amdgcn_mfma_f32_32x32x16_bf16(af, vtf, o, 0, 0, 0); }
#pragma unroll
                        for (int r = 0; r < 8; ++r) po[(16 * I + (r & 3) + 8 * (r >> 2)) * 128] = (unsigned char)pack4_fp8(o[r], 0.f, 0.f, 0.f);
                    }
#pragma unroll
                    for (int a = 0; a < 4; ++a) {
#pragma unroll
                        for (int g = 0; g < 4; ++g) { const f32x4 dc = *(const LAS f32x4*)(B + O_DEC + (I * 128 + 32 * a + 8 * g + 4 * hi) * 4); S[a][4 * g] *= dc[0]; S[a][4 * g + 1] *= dc[1]; S[a][4 * g + 2] *= dc[2]; S[a][4 * g + 3] *= dc[3]; }
                        const bf16x8 kf = *(const LAS bf16x8*)(B + O_KH + sw128(32 * a + r32, (16 * I + 8 * hi) * 2));
                        S[a] = __builtin_amdgcn_mfma_f32_32x32x16_bf16(kf, vtf, S[a], 0, 0, 0); }
                }
            }
            lds_sync();
        }
    }
    __syncthreads();
}
}
__device__ __forceinline__ void phase_scan(const Params& p, LAS unsigned char* lds) {
    for (int u = blockIdx.x; u < 256; u += gridDim.x) sc::scan_unit(p, u, lds);
}

constexpr int LDS_BYTES = 163840;
#include <cstdint>
#include <cstdlib>
#include <vector>

#define XB_TMO      128
#define XB_XCNT(j)  (256  + 64 * (j))
#define XB_XSUB(j)  (1280 + 64 * (j))
#define XB_XGEN(j)  (2304 + 64 * (j))
#define XB_TOP      3328
#define XB_TOPGEN   3392
#define XCD_BAR_WORDS 3456
#define XB_SPIN_CAP (1u << 18)

__device__ __forceinline__ unsigned xb_ld(unsigned* p)              { return __hip_atomic_load(p, __ATOMIC_RELAXED, __HIP_MEMORY_SCOPE_AGENT); }
__device__ __forceinline__ unsigned xb_add(unsigned* p, unsigned v) { return __hip_atomic_fetch_add(p, v, __ATOMIC_RELAXED, __HIP_MEMORY_SCOPE_AGENT); }
__device__ __forceinline__ unsigned xb_xcc_id() { return (unsigned)__builtin_amdgcn_s_getreg((3 << 11) | 20) & 0xFu; }
#define XB_SPIN(cond, bar) do { unsigned _sp = 0; while (cond) { __builtin_amdgcn_s_sleep(1); \
    if ((++_sp & 255u) == 0u) { if (xb_ld(&(bar)[XB_TMO])) break; if (_sp > XB_SPIN_CAP) { atomicAdd(&(bar)[XB_TMO], 1u); break; } } } } while (0)

struct XcdBarrier {
    unsigned* bar; unsigned x;
    volatile LAS unsigned* st;
};

__device__ __forceinline__ XcdBarrier xcd_barrier_post(unsigned* bar, volatile LAS unsigned* st) {
    XcdBarrier b; b.bar = bar; b.x = xb_xcc_id(); b.st = st;
    if (threadIdx.x == 0) (void)xb_add(&bar[XB_XCNT(b.x)], 1u);
    return b;
}
__device__ __forceinline__ void xcd_barrier_complete(unsigned* bar, unsigned x, unsigned& nloc, unsigned& nx) {
    const unsigned G = gridDim.x * gridDim.y * gridDim.z;
    unsigned sum, cnt, mine, sp = 0u;
    for (;;) {
        sum = 0u; cnt = 0u; mine = 0u;
#pragma unroll
        for (unsigned j = 0; j < 16; ++j) { const unsigned c = xb_ld(&bar[XB_XCNT(j)]); sum += c; cnt += (c > 0u) ? 1u : 0u; mine = (j == x) ? c : mine; }
        if (sum == G) break;
        __builtin_amdgcn_s_sleep(1);
        if ((++sp & 255u) == 0u) { if (xb_ld(&bar[XB_TMO])) break; if (sp > XB_SPIN_CAP) { atomicAdd(&bar[XB_TMO], 1u); break; } }
    }
    nloc = mine > 0u ? mine : 1u; nx = cnt > 0u ? cnt : 1u;
}

__device__ __forceinline__ void xcd_barrier(const XcdBarrier& b) {
    asm volatile("s_waitcnt vmcnt(0)" ::: "memory");
    __syncthreads();
    if (threadIdx.x == 0) {
        unsigned* bar = b.bar;
        __builtin_amdgcn_s_waitcnt(0);
        unsigned nloc = b.st[0], nx = b.st[1];
        if (nloc == 0u) { xcd_barrier_complete(bar, b.x, nloc, nx); b.st[0] = nloc; b.st[1] = nx; }
        const unsigned old = xb_add(&bar[XB_XSUB(b.x)], 1u);
        const unsigned gen = old / nloc;
        if (old + 1u == (gen + 1u) * nloc) {
            __builtin_amdgcn_fence(__ATOMIC_RELEASE, "agent");
            asm volatile("s_waitcnt vmcnt(0)" ::: "memory");
            const unsigned og = xb_add(&bar[XB_TOP], 1u);
            const unsigned tg = og / nx;
            if (og + 1u == (tg + 1u) * nx) xb_add(&bar[XB_TOPGEN], 1u);
            else XB_SPIN(xb_ld(&bar[XB_TOPGEN]) == tg, bar);
            __builtin_amdgcn_fence(__ATOMIC_ACQUIRE, "agent");
            xb_add(&bar[XB_XGEN(b.x)], 1u);
            asm volatile("s_waitcnt vmcnt(0)" ::: "memory");
        } else {
            XB_SPIN(xb_ld(&bar[XB_XGEN(b.x)]) == gen, bar);
            __builtin_amdgcn_fence(__ATOMIC_ACQUIRE, "agent");
            asm volatile("s_waitcnt vmcnt(0)" ::: "memory");
        }
    }
    __syncthreads();
}

__global__ void __launch_bounds__(512, 2) k_mega(Params p) {
    extern __shared__ __attribute__((aligned(16))) unsigned char smem[];
    LAS unsigned char* lds = (LAS unsigned char*)smem;
    volatile LAS unsigned* xbw = (volatile LAS unsigned*)(lds + LDS_BYTES - 16);
    if (threadIdx.x == 0) { xbw[0] = 0u; xbw[1] = 0u; xbw[2] = 0u; xbw[3] = 0u; }
    __syncthreads();
    XcdBarrier bar = xcd_barrier_post((unsigned*)(p.ws + OFF_BAR), xbw);
    phase0(p, lds);      xcd_barrier(bar);
    phase1(p, lds);      xcd_barrier(bar);
    phase2(p, lds);      xcd_barrier(bar);
    phase3(p, lds);      xcd_barrier(bar);
    phase_attn(p, lds);
    phase_scan(p, lds);  xcd_barrier(bar);
    phase4(p, lds);      xcd_barrier(bar);
    phase5(p, lds);      xcd_barrier(bar);
    phase6(p, lds);      xcd_barrier(bar);
    phase7(p, lds);      xcd_barrier(bar);
    phase8(p, lds);      xcd_barrier(bar);
    phase9(p, lds);
}
extern "C" void kernel_launch(void* const* d_in, const int* in_sizes, int n_in, void* d_out, int out_size, void* d_ws, size_t ws_size, hipStream_t stream) {
    static int grid = 0;
    if (grid == 0) {
        int dev = 0, cus = 0, per_cu = 0;
        if (hipGetDevice(&dev) != hipSuccess || hipDeviceGetAttribute(&cus, hipDeviceAttributeMultiprocessorCount, dev) != hipSuccess) { grid = -1; return; }
        if (hipFuncSetAttribute((const void*)k_mega, hipFuncAttributeMaxDynamicSharedMemorySize, LDS_BYTES) != hipSuccess) { grid = -1; return; }
        (void)hipOccupancyMaxActiveBlocksPerMultiprocessor(&per_cu, (const void*)k_mega, 512, LDS_BYTES);
        (void)hipGetLastError();
        grid = cus;
    }
    if (grid < 0) return;
    Params p{};
    p.x = (const float*)d_in[0]; p.c = (const float*)d_in[1]; p.ctx = (const float*)d_in[2]; p.cctx = (const float*)d_in[3]; p.w_mod = (const float*)d_in[4]; p.b_mod = (const float*)d_in[5];
    p.g_mix = (const float*)d_in[6]; p.w_in = (const float*)d_in[7]; p.g_q = (const float*)d_in[8]; p.w_qb = (const float*)d_in[9]; p.g_kv = (const float*)d_in[10]; p.w_kvb = (const float*)d_in[11];
    p.lbl = (const float*)d_in[12]; p.g_hg = (const float*)d_in[13]; p.w_out = (const float*)d_in[14]; p.g_ffn = (const float*)d_in[15]; p.w_r = (const float*)d_in[16]; p.b_r = (const float*)d_in[17];
    p.w_gu = (const float*)d_in[18]; p.b_gu = (const float*)d_in[19]; p.w_dn = (const float*)d_in[20]; p.b_dn = (const float*)d_in[21]; p.g_fin = (const float*)d_in[22];
    p.out = (float*)d_out; p.ws = (char*)d_ws;
    (void)hipMemsetAsync((char*)d_ws + OFF_BAR, 0, 16384, stream);
    hipLaunchKernelGGL(k_mega, dim3(grid), dim3(512), LDS_BYTES, stream, p);
}
```
